# Optimizing an MI355X kernel written in HIP

```python
import math
import jax, jax.numpy as jnp
from jax import lax
import numpy as np

D_MODEL = 1024
BATCH = 4
SEQ = 8192
DEPTH = 4

GRID_W = 64
CTX_LEN = 256
ATT_HEADS = 4
ATT_KV_HEADS = 2
ATT_GROUP = ATT_HEADS // ATT_KV_HEADS
ATT_HEAD_DIM = 64
ATT_WIDTH = ATT_HEADS * ATT_HEAD_DIM
ATT_KV_WIDTH = ATT_KV_HEADS * ATT_HEAD_DIM
Q_BLOCK = 128
ROPE_THETA = 10000.0
GLA_HEADS = 4
GLA_DK = 64
GLA_DV = 128
GLA_K_WIDTH = GLA_HEADS * GLA_DK
GLA_V_WIDTH = GLA_HEADS * GLA_DV
GLA_GATE_RANK = 16
GLA_GATE_NORM = 16.0
GLA_CHUNK = 64
S5_GROUPS = 16
S5_GROUP_CH = 16
S5_WIDTH = S5_GROUPS * S5_GROUP_CH
S5_STATE = 64
S5_DT_MIN = 0.001
S5_DT_MAX = 0.1
D_FF = 2816
N_BRANCH = 3
EPS = 1e-6

IN_SPLITS = (ATT_WIDTH, ATT_KV_WIDTH, ATT_KV_WIDTH,
             GLA_K_WIDTH, GLA_K_WIDTH, GLA_V_WIDTH, GLA_V_WIDTH,
             GLA_GATE_RANK, GLA_GATE_RANK,
             S5_WIDTH,
             N_BRANCH * D_MODEL)
D_IN = sum(IN_SPLITS)
IN_SPLIT_POINTS = tuple(int(v) for v in np.cumsum(IN_SPLITS)[:-1])

kernel_name = "hybrid_gla_s5_gqa_prefix_dit"


def rms_norm(x, gain):
    xf = x.astype(jnp.float32)
    xf = xf * lax.rsqrt(jnp.mean(xf * xf, axis=-1, keepdims=True) + EPS)
    return (xf * gain.astype(jnp.float32)).astype(x.dtype)


def modulate(h, shift, scale):
    return h * (1.0 + scale) + shift


def axial_rope_tables(n_tokens):
    rows = n_tokens // GRID_W
    row = jnp.repeat(jnp.arange(rows, dtype=jnp.float32), GRID_W)
    col = jnp.tile(jnp.arange(GRID_W, dtype=jnp.float32), rows)
    n_freq = ATT_HEAD_DIM // 4
    inv_freq = ROPE_THETA ** (-jnp.arange(n_freq, dtype=jnp.float32) / n_freq)
    ang = jnp.stack([row[:, None] * inv_freq, col[:, None] * inv_freq], axis=1)
    return jnp.cos(ang), jnp.sin(ang)


def apply_axial_rope(x, cos, sin):
    bsz, n_t, nh, hd = x.shape
    xr = x.astype(jnp.float32).reshape(bsz, n_t, nh, 2, 2, hd // 4)
    x1, x2 = xr[..., 0, :], xr[..., 1, :]
    cs, sn = cos[None, :, None], sin[None, :, None]
    out = jnp.stack([x1 * cs - x2 * sn, x2 * cs + x1 * sn], axis=-2)
    return out.reshape(bsz, n_t, nh, hd).astype(x.dtype)


def blocked_gqa(q, k, v):
    bsz, n_q = q.shape[0], q.shape[1]
    n_blk = n_q // Q_BLOCK
    qb = q.reshape(bsz, n_blk, Q_BLOCK, ATT_KV_HEADS, ATT_GROUP, ATT_HEAD_DIM)
    qb = jnp.moveaxis(qb, 1, 0)
    scale = ATT_HEAD_DIM ** -0.5

    def attend(q_blk):
        s = jnp.einsum("bqkgd,btkd->bkgqt", q_blk, k, preferred_element_type=jnp.float32) * scale
        p = jax.nn.softmax(s, axis=-1).astype(v.dtype)
        return jnp.einsum("bkgqt,btkd->bqkgd", p, v)

    o = lax.map(attend, qb)
    return jnp.moveaxis(o, 0, 1).reshape(bsz, n_q, ATT_WIDTH)


def gla_chunk_scan(q, k, v, g, s0):
    bsz, nh, n_t, _ = q.shape
    n_c = n_t // GLA_CHUNK

    def chunks(a):
        return a.astype(jnp.float32).reshape(bsz, nh, n_c, GLA_CHUNK, a.shape[-1])

    qc, kc, vc, gc = chunks(q), chunks(k), chunks(v), chunks(g)
    b = jnp.cumsum(gc, axis=3)
    b_end = b[:, :, :, -1:, :]
    q_in = qc * jnp.exp(b)
    k_in = kc * jnp.exp(-b)
    k_end = kc * jnp.exp(b_end - b)
    causal = jnp.tril(jnp.ones((GLA_CHUNK, GLA_CHUNK), dtype=bool))
    att = jnp.where(causal, jnp.einsum("bhnid,bhnjd->bhnij", q_in, k_in), 0.0)
    o_intra = jnp.einsum("bhnij,bhnje->bhnie", att, vc)
    kv_chunk = jnp.einsum("bhnjd,bhnje->nbhde", k_end, vc)
    decay = jnp.moveaxis(jnp.exp(b_end[:, :, :, 0, :]), 2, 0)

    def step(state, inp):
        dec, kv = inp
        return dec[..., None] * state + kv, state

    s_final, s_before = lax.scan(step, s0, (decay, kv_chunk))
    o_inter = jnp.einsum("bhnid,nbhde->bhnie", q_in, s_before)
    o = (o_intra + o_inter).reshape(bsz, nh, n_t, GLA_DV)
    return o.astype(q.dtype), s_final


def gla_bidir(q, k, v, g_f, g_b, s0_f, s0_b):
    o_f, s_f = gla_chunk_scan(q, k, v, g_f, s0_f)
    flip = lambda a: jnp.flip(a, axis=2)
    o_b, s_b = gla_chunk_scan(flip(q), flip(k), flip(v), flip(g_b), s0_b)
    return o_f + flip(o_b), s_f, s_b


def s5_discretize(a_re, a_im, log_dt, b_re, b_im):
    f32 = jnp.float32
    a_re, a_im, b_re, b_im = a_re.astype(f32), a_im.astype(f32), b_re.astype(f32), b_im.astype(f32)
    dt = jnp.exp(log_dt.astype(f32))[:, None]
    mag = jnp.exp(a_re * dt)
    ab_re, ab_im = mag * jnp.cos(a_im * dt), mag * jnp.sin(a_im * dt)
    den = a_re * a_re + a_im * a_im
    f_re = ((ab_re - 1.0) * a_re + ab_im * a_im) / den
    f_im = (ab_im * a_re - (ab_re - 1.0) * a_im) / den
    bb_re = f_re[..., None] * b_re - f_im[..., None] * b_im
    bb_im = f_re[..., None] * b_im + f_im[..., None] * b_re
    return ab_re, ab_im, bb_re, bb_im


def complex_affine_combine(e1, e2):
    a1r, a1i, b1r, b1i = e1
    a2r, a2i, b2r, b2i = e2
    return (a2r * a1r - a2i * a1i, a2r * a1i + a2i * a1r,
            a2r * b1r - a2i * b1i + b2r, a2r * b1i + a2i * b1r + b2i)


def s5_direction(u, lp, d, s0):
    ab_re, ab_im, bb_re, bb_im = s5_discretize(lp["s5_a_re"][d], lp["s5_a_im"][d], lp["s5_log_dt"][d],
                                               lp["s5_b_re"][d], lp["s5_b_im"][d])
    bu_re = jnp.einsum("btgh,gph->btgp", u, bb_re)
    bu_im = jnp.einsum("btgh,gph->btgp", u, bb_im)
    s0_re, s0_im = s0
    bu_re = bu_re.at[:, 0].add(ab_re * s0_re - ab_im * s0_im)
    bu_im = bu_im.at[:, 0].add(ab_re * s0_im + ab_im * s0_re)
    a_re = jnp.broadcast_to(ab_re, bu_re.shape)
    a_im = jnp.broadcast_to(ab_im, bu_im.shape)
    _, _, s_re, s_im = lax.associative_scan(complex_affine_combine, (a_re, a_im, bu_re, bu_im), axis=1)
    c_re = lp["s5_c_re"][d].astype(jnp.float32)
    c_im = lp["s5_c_im"][d].astype(jnp.float32)
    y = jnp.einsum("btgp,ghp->btgh", s_re, c_re) - jnp.einsum("btgp,ghp->btgh", s_im, c_im)
    return y, (s_re[:, -1], s_im[:, -1])


def s5_bidir(u, lp, init_f, init_b):
    f32 = jnp.float32
    bsz, n_t, _ = u.shape
    uf = u.astype(f32)
    ug = uf.reshape(bsz, n_t, S5_GROUPS, S5_GROUP_CH)
    y_f, st_f = s5_direction(ug, lp, 0, init_f)
    y_b, st_b = s5_direction(ug[:, ::-1], lp, 1, init_b)
    y = (y_f + y_b[:, ::-1]).reshape(bsz, n_t, S5_WIDTH) + lp["s5_d"].astype(f32) * uf
    y = jax.nn.gelu(y)
    y = y * jax.nn.sigmoid(y @ lp["s5_glu_w"].astype(f32) + lp["s5_glu_b"].astype(f32))
    return y.astype(u.dtype), st_f, st_b


def mixer_inputs(h, lp, rope):
    bsz, n_t, _ = h.shape
    (aq, ak, av, gq, gk, gv, gr, glf, glb, su, bg) = jnp.split(h @ lp["w_in"], IN_SPLIT_POINTS, axis=-1)
    aq = rms_norm(aq.reshape(bsz, n_t, ATT_HEADS, ATT_HEAD_DIM), lp["q_norm"])
    ak = rms_norm(ak.reshape(bsz, n_t, ATT_KV_HEADS, ATT_HEAD_DIM), lp["k_norm"])
    av = av.reshape(bsz, n_t, ATT_KV_HEADS, ATT_HEAD_DIM)
    if rope is not None:
        aq = apply_axial_rope(aq, rope[0], rope[1])
        ak = apply_axial_rope(ak, rope[0], rope[1])

    def heads(a, dim):
        return a.reshape(bsz, n_t, GLA_HEADS, dim).transpose(0, 2, 1, 3)

    def log_decay(low, d):
        z = (low @ lp["gla_gate_w"][d] + lp["gla_gate_b"][d]).astype(jnp.float32)
        return heads(jax.nn.log_sigmoid(z) / GLA_GATE_NORM, GLA_DK)

    return dict(att_q=aq, att_k=ak, att_v=av,
                gla_q=heads(gq, GLA_DK) * (GLA_DK ** -0.5), gla_k=heads(gk, GLA_DK), gla_v=heads(gv, GLA_DV),
                gla_r=gr, gla_gf=log_decay(glf, 0), gla_gb=log_decay(glb, 1),
                s5_u=su, gates=bg)


def merge_branches(o_att, o_gla, gla_r, o_s5, gates, lp):
    bsz, n_t, _ = o_att.shape
    o_gla = rms_norm(o_gla.transpose(0, 2, 1, 3), lp["gla_out_norm"]).reshape(bsz, n_t, GLA_V_WIDTH)
    o_gla = o_gla * jax.nn.silu(gla_r)
    g_att, g_gla, g_s5 = jnp.split(jax.nn.sigmoid(gates), N_BRANCH, axis=-1)
    merged = (g_att * (o_att @ lp["w_br_att"]) + g_gla * (o_gla @ lp["w_br_gla"])
              + g_s5 * (o_s5 @ lp["w_br_s5"]))
    return merged @ lp["w_out"]


def token_mixer(h_ctx, h_lat, lp, rope, with_ctx_out):
    ic = mixer_inputs(h_ctx, lp, None)
    il = mixer_inputs(h_lat, lp, rope)
    bsz = h_lat.shape[0]
    zero_gla = jnp.zeros((bsz, GLA_HEADS, GLA_DK, GLA_DV), jnp.float32)
    zero_s5 = (jnp.zeros((bsz, S5_GROUPS, S5_STATE), jnp.float32),
               jnp.zeros((bsz, S5_GROUPS, S5_STATE), jnp.float32))
    o_gla_c, gla_st_f, gla_st_b = gla_bidir(ic["gla_q"], ic["gla_k"], ic["gla_v"], ic["gla_gf"], ic["gla_gb"],
                                            zero_gla, zero_gla)
    o_s5_c, s5_st_f, s5_st_b = s5_bidir(ic["s5_u"], lp, zero_s5, zero_s5)
    k_all = jnp.concatenate([ic["att_k"], il["att_k"]], axis=1)
    v_all = jnp.concatenate([ic["att_v"], il["att_v"]], axis=1)
    o_att_l = blocked_gqa(il["att_q"], k_all, v_all)
    o_gla_l, _, _ = gla_bidir(il["gla_q"], il["gla_k"], il["gla_v"], il["gla_gf"], il["gla_gb"],
                              gla_st_f, gla_st_b)
    o_s5_l, _, _ = s5_bidir(il["s5_u"], lp, s5_st_f, s5_st_b)
    y_lat = merge_branches(o_att_l, o_gla_l, il["gla_r"], o_s5_l, il["gates"], lp)
    if not with_ctx_out:
        return None, y_lat
    o_att_c = blocked_gqa(ic["att_q"], ic["att_k"], ic["att_v"])
    y_ctx = merge_branches(o_att_c, o_gla_c, ic["gla_r"], o_s5_c, ic["gates"], lp)
    return y_ctx, y_lat


def dwconv3(x, w, b):
    xp = jnp.pad(x, ((0, 0), (1, 1), (0, 0)))
    return xp[:, :-2] * w[0] + xp[:, 1:-1] * w[1] + xp[:, 2:] * w[2] + b


def conv_ffn(h, lp):
    u = dwconv3(h @ lp["ffn_up"], lp["ffn_conv_w"], lp["ffn_conv_b"])
    a, v = jnp.split(u, 2, axis=-1)
    return (jax.nn.silu(a) * v) @ lp["ffn_down"]


def setup_inputs(seed: int = 0) -> dict:
    key = jax.random.key(seed)
    ks = iter(jax.random.split(key, 48))
    f32 = jnp.float32
    L = DEPTH

    def nrm(shape, scale):
        return jax.random.normal(next(ks), shape, f32) * scale

    def gain(shape):
        return 1.0 + nrm(shape, 0.05)

    n_idx = jnp.arange(S5_STATE, dtype=f32)
    s5_shape = (L, 2, S5_GROUPS, S5_STATE)
    return {
        "x": nrm((BATCH, SEQ, D_MODEL), 1.0),
        "c": nrm((BATCH, D_MODEL), 1.0),
        "ctx": nrm((BATCH, CTX_LEN, D_MODEL), 1.0),
        "c_ctx": nrm((D_MODEL,), 1.0),
        "ada_w": nrm((L, D_MODEL, 6 * D_MODEL), D_MODEL ** -0.5),
        "ada_b": nrm((L, 6 * D_MODEL), 0.02),
        "norm_mix_pre": gain((L, D_MODEL)),
        "norm_mix_post": gain((L, D_MODEL)),
        "norm_ffn_pre": gain((L, D_MODEL)),
        "norm_ffn_post": gain((L, D_MODEL)),
        "w_in": nrm((L, D_MODEL, D_IN), D_MODEL ** -0.5),
        "q_norm": gain((L, ATT_HEAD_DIM)),
        "k_norm": gain((L, ATT_HEAD_DIM)),
        "gla_gate_w": nrm((L, 2, GLA_GATE_RANK, GLA_K_WIDTH), GLA_GATE_RANK ** -0.5),
        "gla_gate_b": nrm((L, 2, GLA_K_WIDTH), 0.1),
        "gla_out_norm": gain((L, GLA_DV)),
        "s5_a_re": -0.5 * jnp.exp(nrm(s5_shape, 0.01)),
        "s5_a_im": math.pi * n_idx + nrm(s5_shape, 0.01),
        "s5_log_dt": jax.random.uniform(next(ks), (L, 2, S5_GROUPS), f32,
                                        math.log(S5_DT_MIN), math.log(S5_DT_MAX)),
        "s5_b_re": nrm((L, 2, S5_GROUPS, S5_STATE, S5_GROUP_CH), (2.0 * S5_GROUP_CH) ** -0.5),
        "s5_b_im": nrm((L, 2, S5_GROUPS, S5_STATE, S5_GROUP_CH), (2.0 * S5_GROUP_CH) ** -0.5),
        "s5_c_re": nrm((L, 2, S5_GROUPS, S5_GROUP_CH, S5_STATE), S5_STATE ** -0.5),
        "s5_c_im": nrm((L, 2, S5_GROUPS, S5_GROUP_CH, S5_STATE), S5_STATE ** -0.5),
        "s5_d": nrm((L, S5_WIDTH), 1.0),
        "s5_glu_w": nrm((L, S5_WIDTH, S5_WIDTH), S5_WIDTH ** -0.5),
        "s5_glu_b": nrm((L, S5_WIDTH), 0.02),
        "w_br_att": nrm((L, ATT_WIDTH, D_MODEL), ATT_WIDTH ** -0.5),
        "w_br_gla": nrm((L, GLA_V_WIDTH, D_MODEL), GLA_V_WIDTH ** -0.5),
        "w_br_s5": nrm((L, S5_WIDTH, D_MODEL), S5_WIDTH ** -0.5),
        "w_out": nrm((L, D_MODEL, D_MODEL), D_MODEL ** -0.5),
        "ffn_up": nrm((L, D_MODEL, 2 * D_FF), D_MODEL ** -0.5),
        "ffn_conv_w": nrm((L, 3, 2 * D_FF), 3.0 ** -0.5),
        "ffn_conv_b": nrm((L, 2 * D_FF), 0.02),
        "ffn_down": nrm((L, D_FF, D_MODEL), D_FF ** -0.5),
    }


def reference(x, c, ctx, c_ctx, ada_w, ada_b, norm_mix_pre, norm_mix_post, norm_ffn_pre, norm_ffn_post,
              w_in, q_norm, k_norm, gla_gate_w, gla_gate_b, gla_out_norm,
              s5_a_re, s5_a_im, s5_log_dt, s5_b_re, s5_b_im, s5_c_re, s5_c_im, s5_d, s5_glu_w, s5_glu_b,
              w_br_att, w_br_gla, w_br_s5, w_out, ffn_up, ffn_conv_w, ffn_conv_b, ffn_down):
    rope = axial_rope_tables(x.shape[1])
    for i in range(DEPTH):
        last = i == DEPTH - 1
        lp = {
            "w_in": w_in[i], "q_norm": q_norm[i], "k_norm": k_norm[i],
            "gla_gate_w": gla_gate_w[i], "gla_gate_b": gla_gate_b[i], "gla_out_norm": gla_out_norm[i],
            "s5_a_re": s5_a_re[i], "s5_a_im": s5_a_im[i], "s5_log_dt": s5_log_dt[i],
            "s5_b_re": s5_b_re[i], "s5_b_im": s5_b_im[i], "s5_c_re": s5_c_re[i], "s5_c_im": s5_c_im[i],
            "s5_d": s5_d[i], "s5_glu_w": s5_glu_w[i], "s5_glu_b": s5_glu_b[i],
            "w_br_att": w_br_att[i], "w_br_gla": w_br_gla[i], "w_br_s5": w_br_s5[i], "w_out": w_out[i],
            "ffn_up": ffn_up[i], "ffn_conv_w": ffn_conv_w[i], "ffn_conv_b": ffn_conv_b[i],
            "ffn_down": ffn_down[i],
        }
        m_lat = jnp.split((jax.nn.silu(c) @ ada_w[i] + ada_b[i])[:, None, :], 6, axis=-1)
        m_ctx = jnp.split((jax.nn.silu(c_ctx) @ ada_w[i] + ada_b[i])[None, None, :], 6, axis=-1)

        h_lat = modulate(rms_norm(x, norm_mix_pre[i]), m_lat[0], m_lat[1])
        h_ctx = modulate(rms_norm(ctx, norm_mix_pre[i]), m_ctx[0], m_ctx[1])
        y_ctx, y_lat = token_mixer(h_ctx, h_lat, lp, rope, not last)
        x = x + m_lat[2] * rms_norm(y_lat, norm_mix_post[i])
        h_lat = modulate(rms_norm(x, norm_ffn_pre[i]), m_lat[3], m_lat[4])
        x = x + m_lat[5] * rms_norm(conv_ffn(h_lat, lp), norm_ffn_post[i])

        if not last:
            ctx = ctx + m_ctx[2] * rms_norm(y_ctx, norm_mix_post[i])
            h_ctx = modulate(rms_norm(ctx, norm_ffn_pre[i]), m_ctx[3], m_ctx[4])
            ctx = ctx + m_ctx[5] * rms_norm(conv_ffn(h_ctx, lp), norm_ffn_post[i])
    return x
```

```cpp
#include <hip/hip_runtime.h>
#include <hip/hip_cooperative_groups.h>
#include <stdint.h>
#include <cstdio>
namespace cg = cooperative_groups;

#ifndef ONE_LAUNCH
#define ONE_LAUNCH 1
#endif

typedef unsigned short bf16;
typedef __attribute__((ext_vector_type(8))) short s16x8;
typedef __attribute__((ext_vector_type(4))) short s16x4;
typedef __attribute__((ext_vector_type(16))) float f32x16;
typedef __attribute__((ext_vector_type(4))) float f32x4;
typedef __attribute__((ext_vector_type(2))) float f32x2;
typedef __attribute__((ext_vector_type(4))) unsigned u32x4;
typedef __attribute__((ext_vector_type(2))) unsigned u32x2;
typedef __attribute__((ext_vector_type(2))) __bf16 bf16x2_t;

#define DI __device__ __forceinline__
#define MFMA32(a, b, c) __builtin_amdgcn_mfma_f32_32x32x16_bf16((a), (b), (c), 0, 0, 0)

DI int tidx_opaque() { int t = threadIdx.x; asm volatile("" : "+v"(t)); return t; }
#define TIDX tidx_opaque()
DI bf16 f2bf(float x) { return __builtin_bit_cast(unsigned short, (__bf16)x); }
DI float bf2f(bf16 v) { return __uint_as_float(((unsigned)v) << 16); }
DI unsigned pack2(float a, float b) {
  f32x2 v = {a, b};
  return __builtin_bit_cast(unsigned, __builtin_convertvector(v, bf16x2_t));
}
DI float bflo(unsigned u) { return __uint_as_float(u << 16); }
DI float bfhi(unsigned u) { return __uint_as_float(u & 0xffff0000u); }
DI int crow(int i, int h) { return (i & 3) + 8 * (i >> 2) + 4 * h; }
DI void sincos_cw(float x, float& sn, float& cs) {
  const float k = rintf(x * 0.63661977236758134f);
  float r = fmaf(-k, 1.57079637050628662109375f, x);
  r = fmaf(-k, -4.371139000186241e-08f, r);
  const int q = ((int)k) & 3;
  const float r2 = r * r;
  const float sp = r + r * r2 * (-1.6666667163e-01f + r2 * (8.3333337680e-03f + r2 * (-1.9841270114e-04f + r2 * 2.7557314297e-06f)));
  const float cp = 1.f + r2 * (-0.5f + r2 * (4.1666667908e-02f + r2 * (-1.3888889225e-03f + r2 * (2.4801587642e-05f - r2 * 2.7557314297e-07f))));
  sn = (q == 0) ? sp : (q == 1) ? cp : (q == 2) ? -sp : -cp;
  cs = (q == 0) ? cp : (q == 1) ? -sp : (q == 2) ? -cp : sp;
}
DI float sigmoidf_(float x) { return 1.f / (1.f + __expf(-x)); }
DI float siluf_(float x) { return x / (1.f + __expf(-x)); }

constexpr int DM = 1024, NB = 4, SEQ = 8192, CTXL = 256, TT = SEQ + CTXL, NTOK = NB * TT, NL = 4;
constexpr int DFF = 2816, DIN = 5408;
constexpr float EPSF = 1e-6f;
constexpr int NG33 = 33;
constexpr int NCH = 264;
constexpr int MS5 = NB * NCH;

constexpr size_t SZ_H = (size_t)NTOK * 1024 * 2;
constexpr size_t OFF_H = 0;
constexpr size_t OFF_P = OFF_H + SZ_H;
constexpr size_t OFF_Q = OFF_P;
constexpr size_t OFF_K = OFF_Q + (size_t)NTOK * 256 * 2;
constexpr size_t OFF_VT = OFF_K + (size_t)NTOK * 128 * 2;
constexpr size_t OFF_GQ = OFF_VT + (size_t)NTOK * 128 * 2;
constexpr size_t OFF_GK = OFF_GQ + (size_t)NTOK * 256 * 2;
constexpr size_t OFF_GVT = OFF_GK + (size_t)NTOK * 256 * 2;
constexpr size_t OFF_GR = OFF_GVT + (size_t)NTOK * 512 * 2;
constexpr size_t OFF_SU = OFF_GR + (size_t)NTOK * 512 * 2;
constexpr size_t OFF_LOW = OFF_SU + (size_t)NTOK * 256 * 2;
constexpr size_t OFF_O = OFF_LOW + (size_t)NTOK * 32 * 4;
constexpr size_t OFF_OATT = OFF_O;
constexpr size_t OFF_OGLA = OFF_OATT + (size_t)NTOK * 256 * 2;
constexpr size_t OFF_Y5 = OFF_OGLA + (size_t)NTOK * 512 * 2;
constexpr size_t OFF_EN = OFF_Y5;
constexpr size_t OFF_OS5 = OFF_Y5 + (size_t)NTOK * 256 * 2;
constexpr size_t OFF_M = OFF_OS5 + (size_t)NTOK * 256 * 2;
constexpr size_t OFF_MG = OFF_M;
constexpr size_t OFF_GS = OFF_M;
constexpr size_t OFF_DECG = OFF_GS + (size_t)32 * 33 * 8192 * 4;
constexpr size_t OFF_SB = OFF_DECG + (size_t)32 * 33 * 64 * 4;
constexpr size_t OFF_T5 = OFF_SB + (size_t)MS5 * 16 * 256 * 2;
constexpr size_t OFF_E5 = OFF_T5 + (size_t)16 * 512 * 512 * 2;
constexpr size_t OFF_F5 = OFF_E5 + (size_t)16 * 512 * 256 * 2;
constexpr size_t OFF_MEND = OFF_F5 + (size_t)16 * 256 * 512 * 2;
static_assert(OFF_MEND <= OFF_M + SZ_H, "mixer scratch overflows merged area");
constexpr size_t OFF_W = OFF_M + SZ_H;
constexpr size_t WL_WIN = 0, WL_BRA = WL_WIN + (size_t)5504 * 1024, WL_BRG = WL_BRA + 1024 * 256, WL_BRS = WL_BRG + 1024 * 512,
                 WL_WOUT = WL_BRS + 1024 * 256, WL_UP = WL_WOUT + 1024 * 1024, WL_DOWN = WL_UP + (size_t)5632 * 1024,
                 WL_GLU = WL_DOWN + (size_t)1024 * 2816, WL_TOTAL = WL_GLU + 256 * 256;
constexpr size_t OFF_XC = OFF_W + WL_TOTAL * 2 * NL;
constexpr size_t OFF_MOD = OFF_XC + (size_t)NB * CTXL * 1024 * 4;
constexpr size_t OFF_BBR = OFF_MOD + (size_t)NL * 5 * 6144 * 4;
constexpr size_t OFF_BBI = OFF_BBR + (size_t)NL * 2 * 16 * 64 * 16 * 4;
constexpr size_t OFF_PWR = OFF_BBI + (size_t)NL * 2 * 16 * 64 * 16 * 4;
constexpr size_t OFF_KTAB = OFF_PWR + (size_t)NL * 2 * 16 * 33 * 64 * 8;
constexpr size_t OFF_END = OFF_KTAB + (size_t)NL * 16 * 2 * 32 * 256 * 4;
constexpr size_t OFF_G = OFF_P;
static_assert((size_t)NTOK * DFF * 2 <= OFF_M - OFF_P, "G overflows");

constexpr int SMEM_BYTES = 73728;

struct Params {
  const float* in[34];
  float* out;
  char* ws;
};

enum { I_X = 0, I_C, I_CTX, I_CCTX, I_ADAW, I_ADAB, I_NMPRE, I_NMPOST, I_NFPRE, I_NFPOST, I_WIN, I_QN, I_KN, I_GGW, I_GGB, I_GON,
       I_ARE, I_AIM, I_LDT, I_BRE, I_BIM, I_CRE, I_CIM, I_S5D, I_GLUW, I_GLUB, I_WBA, I_WBG, I_WBS, I_WOUT, I_UP, I_CW, I_CB, I_DOWN };

constexpr int LDT = 72;
constexpr int CLD = 132;

template <class FA, class FB>
DI void gemm_main(f32x16 (&acc)[2][2], FA fa, FB fb, int K, char* smem) {
  bf16* As = (bf16*)smem;
  bf16* Bs = (bf16*)(smem + 2 * 128 * LDT * 2);
  const int tid = TIDX, lane = tid & 63, w = tid >> 6, wm = w >> 1, wn = w & 1;
  const int r = lane & 31, h = lane >> 5;
  const int lr = tid >> 3, kc = (tid & 7) * 8;
  const bf16* ap[4];
  const bf16* bp[4];
#pragma unroll
  for (int i = 0; i < 4; ++i) {
    const bf16* a = fa(lr + 32 * i);
    const bf16* b = fb(lr + 32 * i);
    ap[i] = a ? a + kc : nullptr;
    bp[i] = b ? b + kc : nullptr;
  }
  u32x4 ra[4], rb[4];
  const u32x4 z4 = {0u, 0u, 0u, 0u};
#pragma unroll
  for (int i = 0; i < 4; ++i) {
    ra[i] = ap[i] ? *(const u32x4*)(ap[i]) : z4;
    rb[i] = bp[i] ? *(const u32x4*)(bp[i]) : z4;
  }
#pragma unroll
  for (int i = 0; i < 4; ++i) {
    *(u32x4*)(As + (lr + 32 * i) * LDT + kc) = ra[i];
    *(u32x4*)(Bs + (lr + 32 * i) * LDT + kc) = rb[i];
  }
  __syncthreads();
  const int nk = K / 64;
  for (int kt = 0; kt < nk; ++kt) {
    const int buf = kt & 1;
    const bool more = (kt + 1 < nk);
    if (more) {
      const int k0 = (kt + 1) * 64;
#pragma unroll
      for (int i = 0; i < 4; ++i) {
        ra[i] = ap[i] ? *(const u32x4*)(ap[i] + k0) : z4;
        rb[i] = bp[i] ? *(const u32x4*)(bp[i] + k0) : z4;
      }
    }
    const bf16* Ab = As + buf * 128 * LDT + (wm * 64 + r) * LDT + h * 8;
    const bf16* Bb = Bs + buf * 128 * LDT + (wn * 64 + r) * LDT + h * 8;
#pragma unroll
    for (int s = 0; s < 4; ++s) {
      s16x8 a0 = *(const s16x8*)(Ab + s * 16);
      s16x8 a1 = *(const s16x8*)(Ab + 32 * LDT + s * 16);
      s16x8 b0 = *(const s16x8*)(Bb + s * 16);
      s16x8 b1 = *(const s16x8*)(Bb + 32 * LDT + s * 16);
      acc[0][0] = MFMA32(a0, b0, acc[0][0]);
      acc[0][1] = MFMA32(a0, b1, acc[0][1]);
      acc[1][0] = MFMA32(a1, b0, acc[1][0]);
      acc[1][1] = MFMA32(a1, b1, acc[1][1]);
    }
    if (more) {
      bf16* Aw = As + (buf ^ 1) * 128 * LDT;
      bf16* Bw = Bs + (buf ^ 1) * 128 * LDT;
#pragma unroll
      for (int i = 0; i < 4; ++i) {
        *(u32x4*)(Aw + (lr + 32 * i) * LDT + kc) = ra[i];
        *(u32x4*)(Bw + (lr + 32 * i) * LDT + kc) = rb[i];
      }
    }
    __syncthreads();
  }
}

DI void acc_zero(f32x16 (&acc)[2][2]) {
#pragma unroll
  for (int a = 0; a < 2; ++a)
#pragma unroll
    for (int b = 0; b < 2; ++b)
#pragma unroll
      for (int i = 0; i < 16; ++i) acc[a][b][i] = 0.f;
}

DI void acc_to_lds(const f32x16 (&acc)[2][2], float* Cs) {
  const int lane = TIDX & 63, w = TIDX >> 6, wm = w >> 1, wn = w & 1, r = lane & 31, h = lane >> 5;
#pragma unroll
  for (int tm = 0; tm < 2; ++tm)
#pragma unroll
    for (int tn = 0; tn < 2; ++tn)
#pragma unroll
      for (int i = 0; i < 16; ++i) Cs[(wm * 64 + tm * 32 + crow(i, h)) * CLD + wn * 64 + tn * 32 + r] = acc[tm][tn][i];
}

DI void store_tile_bf16(const float* Cs, bf16* dst, size_t ld, int mvalid, float scale) {
  for (int c = TIDX; c < 2048; c += 256) {
    const int row = c >> 4, cc = (c & 15) * 8;
    if (row < mvalid) {
      const float* s = Cs + row * CLD + cc;
      u32x4 v;
      v[0] = pack2(s[0] * scale, s[1] * scale);
      v[1] = pack2(s[2] * scale, s[3] * scale);
      v[2] = pack2(s[4] * scale, s[5] * scale);
      v[3] = pack2(s[6] * scale, s[7] * scale);
      *(u32x4*)(dst + (size_t)row * ld + cc) = v;
    }
  }
}

DI float* resid_row(const Params& p, int tok) {
  const int b = tok / TT, t = tok - b * TT;
  return (t < CTXL) ? (float*)(p.ws + OFF_XC) + ((size_t)b * CTXL + t) * DM : p.out + ((size_t)b * SEQ + (t - CTXL)) * DM;
}
DI const float* mod_vec(const Params& p, int l, int tok, int which) {
  const int b = tok / TT, t = tok - b * TT;
  const int m = (t < CTXL) ? 4 : b;
  return (const float*)(p.ws + OFF_MOD) + ((size_t)(l * 5 + m) * 6 + which) * DM;
}
DI float wave_sum(float v) {
#pragma unroll
  for (int o = 32; o >= 1; o >>= 1) v += __shfl_xor(v, o, 64);
  return v;
}
DI bf16* wl(const Params& p, int l, size_t off) { return (bf16*)(p.ws + OFF_W) + (size_t)l * WL_TOTAL + off; }

DI void prep_mod_job(const Params& p, int j, char* smem) {
  float* sc = (float*)smem;
  const int l = j / 24, nb = j % 24, tid = TIDX;
  for (int idx = tid; idx < 5120; idx += 256) {
    const int m = idx >> 10, k = idx & 1023;
    const float v = (m < 4) ? p.in[I_C][m * 1024 + k] : p.in[I_CCTX][k];
    sc[idx] = siluf_(v);
  }
  __syncthreads();
  const int n = nb * 256 + tid;
  const float* W = p.in[I_ADAW] + (size_t)l * 1024 * 6144 + n;
  float a0 = 0, a1 = 0, a2 = 0, a3 = 0, a4 = 0;
#pragma unroll 8
  for (int k = 0; k < 1024; ++k) {
    const float wv = W[(size_t)k * 6144];
    a0 += sc[k] * wv; a1 += sc[1024 + k] * wv; a2 += sc[2048 + k] * wv; a3 += sc[3072 + k] * wv; a4 += sc[4096 + k] * wv;
  }
  const float bb = p.in[I_ADAB][l * 6144 + n];
  float* M = (float*)(p.ws + OFF_MOD) + (size_t)l * 5 * 6144 + n;
  M[0] = a0 + bb; M[6144] = a1 + bb; M[2 * 6144] = a2 + bb; M[3 * 6144] = a3 + bb; M[4 * 6144] = a4 + bb;
  __syncthreads();
}

DI void prep_s5_job(const Params& p, int j) {
  const int idx = j * 256 + TIDX;
  const int ldg = idx >> 6, pp = idx & 63;
  const float dt = expf(p.in[I_LDT][ldg]);
  const float are = p.in[I_ARE][idx], aim = p.in[I_AIM][idx];
  const float mag = expf(are * dt);
  float sn, cs;
  sincos_cw(aim * dt, sn, cs);
  const float abr = mag * cs, abi = mag * sn;
  const float den = are * are + aim * aim;
  const float fre = ((abr - 1.f) * are + abi * aim) / den;
  const float fim = (abi * are - (abr - 1.f) * aim) / den;
  float* BBR = (float*)(p.ws + OFF_BBR);
  float* BBI = (float*)(p.ws + OFF_BBI);
  for (int hh = 0; hh < 16; ++hh) {
    const float br = p.in[I_BRE][(size_t)idx * 16 + hh], bi = p.in[I_BIM][(size_t)idx * 16 + hh];
    BBR[(size_t)idx * 16 + hh] = fre * br - fim * bi;
    BBI[(size_t)idx * 16 + hh] = fre * bi + fim * br;
  }
  float2* PW = (float2*)(p.ws + OFF_PWR);
  float pr = 1.f, pi = 0.f;
  for (int tau = 0; tau <= 32; ++tau) {
    PW[((size_t)ldg * 33 + tau) * 64 + pp] = make_float2(pr, pi);
    const float nr = pr * abr - pi * abi, ni = pr * abi + pi * abr;
    pr = nr; pi = ni;
  }
}

DI void prep_wt_job(const Params& p, int jj, char* smem) {
  float* tile = (float*)smem;
  const int l = jj / 4016;
  int r = jj % 4016;
  int mat = 0;
  const int cnt[8] = {1376, 64, 128, 64, 256, 1408, 704, 16};
#pragma unroll
  for (int m = 0; m < 8; ++m) {
    if (mat == m && r >= cnt[m]) { r -= cnt[m]; mat = m + 1; }
  }
  const float* src; int K, sld; size_t doff;
  switch (mat) {
    case 0: src = p.in[I_WIN] + (size_t)l * 1024 * DIN; K = 1024; sld = DIN; doff = WL_WIN; break;
    case 1: src = p.in[I_WBA] + (size_t)l * 256 * 1024; K = 256; sld = 1024; doff = WL_BRA; break;
    case 2: src = p.in[I_WBG] + (size_t)l * 512 * 1024; K = 512; sld = 1024; doff = WL_BRG; break;
    case 3: src = p.in[I_WBS] + (size_t)l * 256 * 1024; K = 256; sld = 1024; doff = WL_BRS; break;
    case 4: src = p.in[I_WOUT] + (size_t)l * 1024 * 1024; K = 1024; sld = 1024; doff = WL_WOUT; break;
    case 5: src = p.in[I_UP] + (size_t)l * 1024 * 5632; K = 1024; sld = 5632; doff = WL_UP; break;
    case 6: src = p.in[I_DOWN] + (size_t)l * 2816 * 1024; K = 2816; sld = 1024; doff = WL_DOWN; break;
    default: src = p.in[I_GLUW] + (size_t)l * 256 * 256; K = 256; sld = 256; doff = WL_GLU; break;
  }
  const int kt = K / 64;
  const int n0 = (r / kt) * 64, k0 = (r % kt) * 64;
  const int tid = TIDX;
  {
    const int nn = tid & 63;
    const int np = n0 + nn;
    int col;
    if (mat == 0) {
      if (np < 2048) col = np;
      else if (np < 2304) col = 2080 + (np - 2048);
      else if (np < 2336) col = 2048 + (np - 2304);
      else if (np < 2432) col = -1;
      else col = 2336 + (np - 2432);
    } else if (mat == 5) {
      const int jb = np >> 7, c = np & 127;
      col = (c < 64) ? (jb * 64 + c) : (DFF + jb * 64 + (c - 64));
    } else col = np;
#pragma unroll 4
    for (int kk = tid >> 6; kk < 64; kk += 4) tile[kk * 65 + nn] = (col >= 0) ? src[(size_t)(k0 + kk) * sld + col] : 0.f;
  }
  __syncthreads();
  {
    const int nn = tid >> 2, kq = (tid & 3) * 16;
    bf16* d = wl(p, l, doff) + (size_t)(n0 + nn) * K + k0 + kq;
    u32x4 v0, v1;
#pragma unroll
    for (int e = 0; e < 4; ++e) {
      v0[e] = pack2(tile[(kq + 2 * e) * 65 + nn], tile[(kq + 2 * e + 1) * 65 + nn]);
      v1[e] = pack2(tile[(kq + 8 + 2 * e) * 65 + nn], tile[(kq + 8 + 2 * e + 1) * 65 + nn]);
    }
    *(u32x4*)d = v0;
    *(u32x4*)(d + 8) = v1;
  }
  __syncthreads();
}

template <int MODE>
DI void row_job(const Params& p, int l, int tok) {
  const int lane = TIDX & 63;
  float x[16];
  float* xr = resid_row(p, tok);
  if (MODE == 0) {
    const int b = tok / TT, t = tok - b * TT;
    const float* src = (t < CTXL) ? p.in[I_CTX] + ((size_t)b * CTXL + t) * DM : p.in[I_X] + ((size_t)b * SEQ + (t - CTXL)) * DM;
#pragma unroll
    for (int i = 0; i < 4; ++i) {
      const f32x4 v = *(const f32x4*)(src + lane * 4 + 256 * i);
      x[4 * i] = v[0]; x[4 * i + 1] = v[1]; x[4 * i + 2] = v[2]; x[4 * i + 3] = v[3];
      *(f32x4*)(xr + lane * 4 + 256 * i) = v;
    }
  } else {
    const bf16* yr = (const bf16*)(p.ws + OFF_H) + (size_t)tok * DM;
    const float* gpost = p.in[MODE == 1 ? I_NMPOST : I_NFPOST] + l * DM;
    const float* mg = mod_vec(p, l, tok, MODE == 1 ? 2 : 5);
    float y[16];
    float ss = 0.f;
#pragma unroll
    for (int i = 0; i < 4; ++i) {
      const u32x2 u = *(const u32x2*)(yr + lane * 4 + 256 * i);
      y[4 * i] = bflo(u[0]); y[4 * i + 1] = bfhi(u[0]); y[4 * i + 2] = bflo(u[1]); y[4 * i + 3] = bfhi(u[1]);
#pragma unroll
      for (int e = 0; e < 4; ++e) ss += y[4 * i + e] * y[4 * i + e];
    }
    ss = wave_sum(ss);
    const float rstd = rsqrtf(ss * (1.f / DM) + EPSF);
#pragma unroll
    for (int i = 0; i < 4; ++i) {
      f32x4 v = *(const f32x4*)(xr + lane * 4 + 256 * i);
      const f32x4 g = *(const f32x4*)(gpost + lane * 4 + 256 * i);
      const f32x4 m = *(const f32x4*)(mg + lane * 4 + 256 * i);
#pragma unroll
      for (int e = 0; e < 4; ++e) { v[e] += m[e] * (y[4 * i + e] * rstd * g[e]); x[4 * i + e] = v[e]; }
      *(f32x4*)(xr + lane * 4 + 256 * i) = v;
    }
  }
  if (MODE == 2 && l == NL - 1) return;
  const int ln = (MODE == 2) ? l + 1 : l;
  const float* gpre = p.in[MODE == 1 ? I_NFPRE : I_NMPRE] + ln * DM;
  const float* sh = mod_vec(p, ln, tok, MODE == 1 ? 3 : 0);
  const float* scv = mod_vec(p, ln, tok, MODE == 1 ? 4 : 1);
  float ss = 0.f;
#pragma unroll
  for (int i = 0; i < 16; ++i) ss += x[i] * x[i];
  ss = wave_sum(ss);
  const float rstd = rsqrtf(ss * (1.f / DM) + EPSF);
  bf16* hr = (bf16*)(p.ws + OFF_H) + (size_t)tok * DM;
#pragma unroll
  for (int i = 0; i < 4; ++i) {
    const f32x4 g = *(const f32x4*)(gpre + lane * 4 + 256 * i);
    const f32x4 s1 = *(const f32x4*)(sh + lane * 4 + 256 * i);
    const f32x4 s2 = *(const f32x4*)(scv + lane * 4 + 256 * i);
    float o[4];
#pragma unroll
    for (int e = 0; e < 4; ++e) o[e] = (x[4 * i + e] * rstd * g[e]) * (1.f + s2[e]) + s1[e];
    u32x2 u;
    u[0] = pack2(o[0], o[1]); u[1] = pack2(o[2], o[3]);
    *(u32x2*)(hr + lane * 4 + 256 * i) = u;
  }
}

template <int MODE>
DI void row_phase(const Params& p, int l) {
  const int wg = blockIdx.x * 4 + (TIDX >> 6), nw = gridDim.x * 4;
  for (int tok = wg; tok < NTOK; tok += nw) row_job<MODE>(p, l, tok);
}

DI void ktab_phase(const Params& p) {
  const float* BBR = (const float*)(p.ws + OFF_BBR);
  const float* BBI = (const float*)(p.ws + OFF_BBI);
  const float2* PW = (const float2*)(p.ws + OFF_PWR);
  float* KT = (float*)(p.ws + OFF_KTAB);
  const int total = NL * 16 * 2 * 32 * 256;
  for (int idx = blockIdx.x * 256 + TIDX; idx < total; idx += gridDim.x * 256) {
    const int hp = idx & 15, hh = (idx >> 4) & 15, tau = (idx >> 8) & 31, d = (idx >> 13) & 1, g = (idx >> 14) & 15, l = idx >> 18;
    const int ldg = (l * 2 + d) * 16 + g;
    const float* cre = p.in[I_CRE] + ((size_t)ldg * 16 + hh) * 64;
    const float* cim = p.in[I_CIM] + ((size_t)ldg * 16 + hh) * 64;
    float acc = 0.f;
    for (int pp = 0; pp < 64; ++pp) {
      const float2 pw = PW[((size_t)ldg * 33 + tau) * 64 + pp];
      const float br = BBR[((size_t)ldg * 64 + pp) * 16 + hp], bi = BBI[((size_t)ldg * 64 + pp) * 16 + hp];
      const float zr = pw.x * br - pw.y * bi, zi = pw.x * bi + pw.y * br;
      acc += cre[pp] * zr - cim[pp] * zi;
    }
    KT[idx] = acc;
  }
}

DI void s5mat_phase(const Params& p, int l) {
  const float* BBR = (const float*)(p.ws + OFF_BBR);
  const float* BBI = (const float*)(p.ws + OFF_BBI);
  const float2* PW = (const float2*)(p.ws + OFF_PWR);
  const float* KT = (const float*)(p.ws + OFF_KTAB);
  bf16* T5 = (bf16*)(p.ws + OFF_T5);
  bf16* E5 = (bf16*)(p.ws + OFF_E5);
  bf16* F5 = (bf16*)(p.ws + OFF_F5);
  const int nT = 16 * 512 * 64, nE = 16 * 512 * 32, nF = 16 * 256 * 64;
  for (int it = blockIdx.x * 256 + TIDX; it < nT + nE + nF; it += gridDim.x * 256) {
    float v[8];
    bf16* dst;
    if (it < nT) {
      const int k8 = it & 63, n = (it >> 6) & 511, g = it >> 15;
      const int i = n >> 4, hh = n & 15, j = k8 >> 1, hp0 = (k8 & 1) * 8;
#pragma unroll
      for (int e = 0; e < 8; ++e) {
        const int hp = hp0 + e;
        float a = 0.f;
        if (j <= i) a += KT[((((size_t)l * 16 + g) * 2 + 0) * 32 + (i - j)) * 256 + hh * 16 + hp];
        if (j >= i) a += KT[((((size_t)l * 16 + g) * 2 + 1) * 32 + (j - i)) * 256 + hh * 16 + hp];
        if (i == j && hh == hp) a += p.in[I_S5D][l * 256 + g * 16 + hh];
        v[e] = a;
      }
      dst = T5 + ((size_t)g * 512 + n) * 512 + k8 * 8;
    } else if (it < nT + nE) {
      const int q = it - nT;
      const int k8 = q & 31, n = (q >> 5) & 511, g = q >> 14;
      const int i = n >> 4, hh = n & 15;
      const int k0 = k8 * 8, d = k0 >> 7, ri = (k0 >> 6) & 1, p0 = k0 & 63;
      const int ldg = (l * 2 + d) * 16 + g;
      const int ex = d ? (32 - i) : (i + 1);
#pragma unroll
      for (int e = 0; e < 8; ++e) {
        const int pp = p0 + e;
        const float2 pw = PW[((size_t)ldg * 33 + ex) * 64 + pp];
        const float cr = p.in[I_CRE][((size_t)ldg * 16 + hh) * 64 + pp], ci = p.in[I_CIM][((size_t)ldg * 16 + hh) * 64 + pp];
        const float zr = cr * pw.x - ci * pw.y, zi = cr * pw.y + ci * pw.x;
        v[e] = ri ? -zi : zr;
      }
      dst = E5 + ((size_t)g * 512 + n) * 256 + k0;
    } else {
      const int q = it - nT - nE;
      const int k8 = q & 63, n = (q >> 6) & 255, g = q >> 14;
      const int d = n >> 7, ri = (n >> 6) & 1, pp = n & 63;
      const int j = k8 >> 1, hp0 = (k8 & 1) * 8;
      const int ldg = (l * 2 + d) * 16 + g;
      const int ex = d ? j : (31 - j);
      const float2 pw = PW[((size_t)ldg * 33 + ex) * 64 + pp];
#pragma unroll
      for (int e = 0; e < 8; ++e) {
        const float br = BBR[((size_t)ldg * 64 + pp) * 16 + hp0 + e], bi = BBI[((size_t)ldg * 64 + pp) * 16 + hp0 + e];
        v[e] = ri ? (pw.x * bi + pw.y * br) : (pw.x * br - pw.y * bi);
      }
      dst = F5 + ((size_t)g * 256 + n) * 512 + k8 * 8;
    }
    u32x4 u;
    u[0] = pack2(v[0], v[1]); u[1] = pack2(v[2], v[3]); u[2] = pack2(v[4], v[5]); u[3] = pack2(v[6], v[7]);
    *(u32x4*)dst = u;
  }
}

DI void proj_tile(const Params& p, int l, int mt, int nt, char* smem) {
  const bf16* H = (const bf16*)(p.ws + OFF_H) + (size_t)mt * 128 * DM;
  const bf16* W = wl(p, l, WL_WIN) + (size_t)nt * 128 * DM;
  f32x16 acc[2][2];
  acc_zero(acc);
  gemm_main(acc, [&](int r) { return H + (size_t)r * DM; }, [&](int r) { return W + (size_t)r * DM; }, DM, smem);
  float* Cs = (float*)smem;
  acc_to_lds(acc, Cs);
  __syncthreads();
  const int tid = TIDX;
  const int tok0 = mt * 128;
  const int b = tok0 / TT, t0 = tok0 - b * TT;
  if (nt <= 2) {
    const int row = tid >> 1, seg = tid & 1;
    float* c = Cs + row * CLD + seg * 64;
    const float* gn = p.in[nt < 2 ? I_QN : I_KN] + l * 64;
    float ss = 0.f;
#pragma unroll 8
    for (int i = 0; i < 64; ++i) ss += c[i] * c[i];
    const float rstd = rsqrtf(ss * (1.f / 64.f) + EPSF);
    const int t = t0 + row;
    const bool lat = t >= CTXL;
    const int s = t - CTXL;
#pragma unroll 1
    for (int ax = 0; ax < 2; ++ax) {
      const float pos = (float)(ax ? (s & 63) : (s >> 6));
#pragma unroll 2
      for (int f = 0; f < 16; ++f) {
        float x1 = c[ax * 32 + f] * rstd * gn[ax * 32 + f];
        float x2 = c[ax * 32 + 16 + f] * rstd * gn[ax * 32 + 16 + f];
        if (lat) {
          const float invf = exp2f(-(float)f * (13.287712379549449f / 16.f));
          float sn, cs;
          sincos_cw(pos * invf, sn, cs);
          const float y1 = x1 * cs - x2 * sn, y2 = x2 * cs + x1 * sn;
          x1 = y1; x2 = y2;
        }
        c[ax * 32 + f] = x1;
        c[ax * 32 + 16 + f] = x2;
      }
    }
    __syncthreads();
    if (nt < 2) store_tile_bf16(Cs, (bf16*)(p.ws + OFF_Q) + (size_t)tok0 * 256 + nt * 128, 256, 128, 0.125f * 1.4426950408889634f);
    else store_tile_bf16(Cs, (bf16*)(p.ws + OFF_K) + (size_t)tok0 * 128, 128, 128, 1.f);
  } else if (nt == 3 || (nt >= 8 && nt <= 11)) {
    for (int c = tid; c < 2048; c += 256) {
      const int col = c & 127, rc = (c >> 7) * 8;
      u32x4 u;
#pragma unroll
      for (int e = 0; e < 4; ++e) u[e] = pack2(Cs[(rc + 2 * e) * CLD + col], Cs[(rc + 2 * e + 1) * CLD + col]);
      bf16* dst;
      if (nt == 3) dst = (bf16*)(p.ws + OFF_VT) + ((size_t)(b * 2 + (col >> 6)) * 64 + (col & 63)) * TT + t0 + rc;
      else dst = (bf16*)(p.ws + OFF_GVT) + ((size_t)(b * 4 + (nt - 8)) * 128 + col) * TT + t0 + rc;
      *(u32x4*)dst = u;
    }
  } else if (nt == 4 || nt == 5) {
    store_tile_bf16(Cs, (bf16*)(p.ws + OFF_GQ) + (size_t)tok0 * 256 + (nt - 4) * 128, 256, 128, 0.125f);
  } else if (nt == 6 || nt == 7) {
    store_tile_bf16(Cs, (bf16*)(p.ws + OFF_GK) + (size_t)tok0 * 256 + (nt - 6) * 128, 256, 128, 1.f);
  } else if (nt >= 12 && nt <= 15) {
    store_tile_bf16(Cs, (bf16*)(p.ws + OFF_GR) + (size_t)tok0 * 512 + (nt - 12) * 128, 512, 128, 1.f);
  } else if (nt == 16 || nt == 17) {
    for (int c = tid; c < 2048; c += 256) {
      const int row = c >> 4, c8 = c & 15;
      const float* s = Cs + row * CLD + c8 * 8;
      u32x4 u;
#pragma unroll
      for (int e = 0; e < 4; ++e) u[e] = pack2(s[2 * e], s[2 * e + 1]);
      const int ch = (nt - 16) * 128 + c8 * 8;
      bf16* dst = (bf16*)(p.ws + OFF_SU) + ((size_t)(b * 16 + (ch >> 4)) * TT + t0 + row) * 16 + (ch & 15);
      *(u32x4*)dst = u;
    }
  } else {
    for (int c = tid; c < 128 * 8; c += 256) {
      const int row = c >> 3, c4 = (c & 7) * 4;
      const float* s = Cs + row * CLD + c4;
      f32x4 v = {s[0], s[1], s[2], s[3]};
      *(f32x4*)((float*)(p.ws + OFF_LOW) + (size_t)(tok0 + row) * 32 + c4) = v;
    }
  }
  __syncthreads();
}

DI void attn_unit(const Params& p, int u, char* smem) {
  bf16* Ks = (bf16*)smem;
  bf16* Vs = (bf16*)(smem + 2 * 64 * LDT * 2);
  int b, head, tok0, nkt;
  if (u < 1024) { b = u >> 8; head = (u >> 6) & 3; tok0 = b * TT + CTXL + (u & 63) * 128; nkt = TT / 64; }
  else { const int v = u - 1024; b = v >> 3; head = (v >> 1) & 3; tok0 = b * TT + (v & 1) * 128; nkt = CTXL / 64; }
  const int kvh = head >> 1;
  const int tid = TIDX, lane = tid & 63, w = tid >> 6, r = lane & 31, h = lane >> 5;
  const bf16* Qp = (const bf16*)(p.ws + OFF_Q) + (size_t)(tok0 + w * 32 + r) * 256 + head * 64 + h * 8;
  s16x8 qf[4];
#pragma unroll
  for (int s = 0; s < 4; ++s) qf[s] = *(const s16x8*)(Qp + s * 16);
  const int lr = tid >> 3, kc = (tid & 7) * 8;
  const bf16* Kg = (const bf16*)(p.ws + OFF_K) + ((size_t)b * TT + lr) * 128 + kvh * 64 + kc;
  const bf16* Vg = (const bf16*)(p.ws + OFF_VT) + ((size_t)(b * 2 + kvh) * 64 + lr) * TT + kc;
  u32x4 rk[2], rv[2];
#pragma unroll
  for (int i = 0; i < 2; ++i) {
    rk[i] = *(const u32x4*)(Kg + (size_t)(32 * i) * 128);
    rv[i] = *(const u32x4*)(Vg + (size_t)(32 * i) * TT);
  }
#pragma unroll
  for (int i = 0; i < 2; ++i) {
    *(u32x4*)(Ks + (lr + 32 * i) * LDT + kc) = rk[i];
    *(u32x4*)(Vs + (lr + 32 * i) * LDT + kc) = rv[i];
  }
  __syncthreads();
  f32x16 oacc[2];
#pragma unroll
  for (int i = 0; i < 16; ++i) { oacc[0][i] = 0.f; oacc[1][i] = 0.f; }
  float mrow = -INFINITY, lrow = 0.f;
  for (int kt = 0; kt < nkt; ++kt) {
    const int buf = kt & 1;
    const bool more = kt + 1 < nkt;
    if (more) {
#pragma unroll
      for (int i = 0; i < 2; ++i) {
        rk[i] = *(const u32x4*)(Kg + (size_t)((kt + 1) * 64 + 32 * i) * 128);
        rv[i] = *(const u32x4*)(Vg + (size_t)(32 * i) * TT + (kt + 1) * 64);
      }
    }
    const bf16* Kb = Ks + buf * 64 * LDT;
    const bf16* Vb = Vs + buf * 64 * LDT;
    f32x16 sacc[2];
#pragma unroll
    for (int i = 0; i < 16; ++i) { sacc[0][i] = 0.f; sacc[1][i] = 0.f; }
#pragma unroll
    for (int s = 0; s < 4; ++s) {
      const s16x8 a0 = *(const s16x8*)(Kb + r * LDT + s * 16 + h * 8);
      const s16x8 a1 = *(const s16x8*)(Kb + (32 + r) * LDT + s * 16 + h * 8);
      sacc[0] = MFMA32(a0, qf[s], sacc[0]);
      sacc[1] = MFMA32(a1, qf[s], sacc[1]);
    }
    float mx = sacc[0][0];
#pragma unroll
    for (int i = 0; i < 16; ++i) { mx = fmaxf(mx, sacc[0][i]); mx = fmaxf(mx, sacc[1][i]); }
    mx = fmaxf(mx, __shfl_xor(mx, 32, 64));
    const float mnew = fmaxf(mrow, mx);
    const float alpha = exp2f(mrow - mnew);
    mrow = mnew;
    float psum = 0.f;
#pragma unroll
    for (int i = 0; i < 16; ++i) {
      sacc[0][i] = exp2f(sacc[0][i] - mnew); psum += sacc[0][i];
      sacc[1][i] = exp2f(sacc[1][i] - mnew); psum += sacc[1][i];
    }
    lrow = lrow * alpha + psum;
#pragma unroll
    for (int i = 0; i < 16; ++i) { oacc[0][i] *= alpha; oacc[1][i] *= alpha; }
#pragma unroll
    for (int kt2 = 0; kt2 < 2; ++kt2)
#pragma unroll
      for (int s2 = 0; s2 < 2; ++s2) {
        u32x4 pu;
#pragma unroll
        for (int e = 0; e < 4; ++e) pu[e] = pack2(sacc[kt2][8 * s2 + 2 * e], sacc[kt2][8 * s2 + 2 * e + 1]);
        const s16x8 pf = __builtin_bit_cast(s16x8, pu);
        const int kb = kt2 * 32 + 16 * s2 + 4 * h;
#pragma unroll
        for (int dt = 0; dt < 2; ++dt) {
          const s16x4 lo = *(const s16x4*)(Vb + (dt * 32 + r) * LDT + kb);
          const s16x4 hi = *(const s16x4*)(Vb + (dt * 32 + r) * LDT + kb + 8);
          const s16x8 a = __builtin_shufflevector(lo, hi, 0, 1, 2, 3, 4, 5, 6, 7);
          oacc[dt] = MFMA32(a, pf, oacc[dt]);
        }
      }
    if (more) {
      bf16* Kw = Ks + (buf ^ 1) * 64 * LDT;
      bf16* Vw = Vs + (buf ^ 1) * 64 * LDT;
#pragma unroll
      for (int i = 0; i < 2; ++i) {
        *(u32x4*)(Kw + (lr + 32 * i) * LDT + kc) = rk[i];
        *(u32x4*)(Vw + (lr + 32 * i) * LDT + kc) = rv[i];
      }
    }
    __syncthreads();
  }
  const float ltot = lrow + __shfl_xor(lrow, 32, 64);
  const float inv = 1.f / ltot;
  bf16* Op = (bf16*)(p.ws + OFF_OATT) + (size_t)(tok0 + w * 32 + r) * 256 + head * 64;
#pragma unroll
  for (int dt = 0; dt < 2; ++dt)
#pragma unroll
    for (int i = 0; i < 16; i += 4) {
      u32x2 uu;
      uu[0] = pack2(oacc[dt][i] * inv, oacc[dt][i + 1] * inv);
      uu[1] = pack2(oacc[dt][i + 2] * inv, oacc[dt][i + 3] * inv);
      *(u32x2*)(Op + dt * 32 + crow(i, h)) = uu;
    }
}

constexpr int GL_LOW = 0, GL_TOT = 4096, GL_DEC = 5120, GL_QIN = 5376, GL_KIN = 14592, GL_KET = 23808, GL_OST = 0,
              GL_VT = 33792, GL_ST = 52224;
static_assert(GL_ST + 128 * LDT * 2 <= SMEM_BYTES, "gla lds");

template <bool WITH_OUT>
DI void gla_unit(const Params& p, int l, int u, char* smem) {
  float* lowt = (float*)(smem + GL_LOW);
  float* tots = (float*)(smem + GL_TOT);
  float* decs = (float*)(smem + GL_DEC);
  bf16* qin = (bf16*)(smem + GL_QIN);
  bf16* kin = (bf16*)(smem + GL_KIN);
  bf16* ket = (bf16*)(smem + GL_KET);
  float* ost = (float*)(smem + GL_OST);
  bf16* vts = (bf16*)(smem + GL_VT);
  bf16* sts = (bf16*)(smem + GL_ST);
  const int tid = TIDX, lane = tid & 63, w = tid >> 6, r = lane & 31, h = lane >> 5;
  int b, hd, gi, dir0, ndir;
  if (WITH_OUT) { gi = u % NG33; hd = (u / NG33) & 3; b = u / (NG33 * 4); dir0 = 1; ndir = 2; }
  else { gi = u % NG33; const int v = u / NG33; dir0 = v & 1; hd = (v >> 1) & 3; b = v >> 3; ndir = 1; }
  const int dk = tid & 63, part = tid >> 6;
  const bf16* GQ = (const bf16*)(p.ws + OFF_GQ);
  const bf16* GK = (const bf16*)(p.ws + OFF_GK);
  const bf16* GVT = (const bf16*)(p.ws + OFF_GVT) + (size_t)(b * 4 + hd) * 128 * TT;
  const float* LOW = (const float*)(p.ws + OFF_LOW);
  for (int dd = 0; dd < ndir; ++dd) {
    const int dir = WITH_OUT ? (dir0 - dd) : dir0;
    float* GSu = (float*)(p.ws + OFF_GS) + ((size_t)((b * 4 + hd) * 2 + dir) * NG33 + gi) * 8192;
    float gwreg[16];
#pragma unroll
    for (int rr = 0; rr < 16; ++rr) gwreg[rr] = p.in[I_GGW][((size_t)(l * 2 + dir) * 16 + rr) * 256 + hd * 64 + dk];
    const float gb = p.in[I_GGB][(l * 2 + dir) * 256 + hd * 64 + dk];
    f32x16 sacc[2];
    if (WITH_OUT) {
#pragma unroll
      for (int dkt = 0; dkt < 2; ++dkt)
#pragma unroll
        for (int i = 0; i < 16; ++i) {
          const float v = GSu[(w * 32 + crow(i, h)) * 64 + dkt * 32 + r];
          sacc[dkt][i] = v;
          sts[(w * 32 + crow(i, h)) * LDT + dkt * 32 + r] = f2bf(v);
        }
    } else {
#pragma unroll
      for (int i = 0; i < 16; ++i) { sacc[0][i] = 0.f; sacc[1][i] = 0.f; }
    }
    float gtot = 0.f;
    for (int cc = 0; cc < 4; ++cc) {
      const int ci = dir ? 3 - cc : cc;
      const int tb = gi * 256 + ci * 64;
      const size_t tokb = (size_t)b * TT + tb;
      {
        const int row = tid >> 2, c4 = (tid & 3) * 4;
        *(f32x4*)(lowt + row * 16 + c4) = *(const f32x4*)(LOW + (tokb + row) * 32 + dir * 16 + c4);
#pragma unroll
        for (int i = 0; i < 4; ++i) {
          const int c = tid + 256 * i, e = c >> 3, k8 = (c & 7) * 8;
          *(u32x4*)(vts + e * LDT + k8) = *(const u32x4*)(GVT + (size_t)e * TT + tb + k8);
        }
      }
      __syncthreads();
      float cums[16];
      float cum = 0.f;
#pragma unroll
      for (int ii = 0; ii < 16; ++ii) {
        const int pos = part * 16 + ii, t = dir ? 63 - pos : pos;
        float z = gb;
#pragma unroll
        for (int rr = 0; rr < 16; ++rr) z += lowt[t * 16 + rr] * gwreg[rr];
        const float g = (fminf(z, 0.f) - log1pf(__expf(-fabsf(z)))) * (1.f / 16.f);
        cum += g;
        cums[ii] = cum;
      }
      tots[part * 64 + dk] = cum;
      __syncthreads();
      float offs = 0.f, total = 0.f;
#pragma unroll
      for (int pp = 0; pp < 4; ++pp) { const float tv = tots[pp * 64 + dk]; total += tv; if (pp < part) offs += tv; }
      if (part == 0) decs[dk] = __expf(total);
      gtot += total;
#pragma unroll
      for (int ii = 0; ii < 16; ++ii) {
        const int pos = part * 16 + ii, t = dir ? 63 - pos : pos;
        const float bq = offs + cums[ii];
        const float kv = bf2f(GK[(tokb + t) * 256 + hd * 64 + dk]);
        ket[dk * LDT + t] = f2bf(kv * __expf(total - bq));
        if (WITH_OUT) {
          const float qv = bf2f(GQ[(tokb + t) * 256 + hd * 64 + dk]);
          qin[t * LDT + dk] = f2bf(qv * __expf(bq));
          kin[t * LDT + dk] = f2bf(kv * __expf(-bq));
        }
      }
      __syncthreads();
      f32x16 oo[2];
      const int it = w & 1, ep = w >> 1;
      if (WITH_OUT) {
        const int ti = w >> 1, tj = w & 1;
        f32x16 aa;
#pragma unroll
        for (int i = 0; i < 16; ++i) aa[i] = 0.f;
#pragma unroll
        for (int s = 0; s < 4; ++s) {
          const s16x8 A = *(const s16x8*)(qin + (ti * 32 + r) * LDT + s * 16 + h * 8);
          const s16x8 Bv = *(const s16x8*)(kin + (tj * 32 + r) * LDT + s * 16 + h * 8);
          aa = MFMA32(A, Bv, aa);
        }
        __syncthreads();
#pragma unroll
        for (int i = 0; i < 16; ++i) {
          const int qi = ti * 32 + crow(i, h), kj = tj * 32 + r;
          const bool keep = dir ? (kj >= qi) : (kj <= qi);
          kin[qi * LDT + kj] = f2bf(keep ? aa[i] : 0.f);
        }
        __syncthreads();
#pragma unroll
        for (int i = 0; i < 16; ++i) { oo[0][i] = 0.f; oo[1][i] = 0.f; }
#pragma unroll
        for (int s = 0; s < 4; ++s) {
          const s16x8 A1 = *(const s16x8*)(kin + (it * 32 + r) * LDT + s * 16 + h * 8);
          const s16x8 A2 = *(const s16x8*)(qin + (it * 32 + r) * LDT + s * 16 + h * 8);
#pragma unroll
          for (int x = 0; x < 2; ++x) {
            const int et = 2 * ep + x;
            const s16x8 B1 = *(const s16x8*)(vts + (et * 32 + r) * LDT + s * 16 + h * 8);
            const s16x8 B2 = *(const s16x8*)(sts + (et * 32 + r) * LDT + s * 16 + h * 8);
            oo[x] = MFMA32(A1, B1, oo[x]);
            oo[x] = MFMA32(A2, B2, oo[x]);
          }
        }
      }
#pragma unroll
      for (int dkt = 0; dkt < 2; ++dkt) {
        const float dv = decs[dkt * 32 + r];
#pragma unroll
        for (int i = 0; i < 16; ++i) sacc[dkt][i] *= dv;
      }
#pragma unroll
      for (int s = 0; s < 4; ++s) {
        const s16x8 A = *(const s16x8*)(vts + (w * 32 + r) * LDT + s * 16 + h * 8);
#pragma unroll
        for (int dkt = 0; dkt < 2; ++dkt) {
          const s16x8 Bv = *(const s16x8*)(ket + (dkt * 32 + r) * LDT + s * 16 + h * 8);
          sacc[dkt] = MFMA32(A, Bv, sacc[dkt]);
        }
      }
      __syncthreads();
      if (WITH_OUT) {
#pragma unroll
        for (int dkt = 0; dkt < 2; ++dkt)
#pragma unroll
          for (int i = 0; i < 16; ++i) sts[(w * 32 + crow(i, h)) * LDT + dkt * 32 + r] = f2bf(sacc[dkt][i]);
#pragma unroll
        for (int x = 0; x < 2; ++x)
#pragma unroll
          for (int i = 0; i < 16; ++i) ost[(it * 32 + crow(i, h)) * CLD + (2 * ep + x) * 32 + r] = oo[x][i];
        __syncthreads();
        const int row = tid >> 2, qd = tid & 3;
        const size_t tok = tokb + row;
        bf16* og = (bf16*)(p.ws + OFF_OGLA) + tok * 512 + hd * 128 + qd * 32;
        const float* os = ost + row * CLD + qd * 32;
        if (dir == 1) {
#pragma unroll
          for (int i = 0; i < 4; ++i) {
            u32x4 uu;
#pragma unroll
            for (int e = 0; e < 4; ++e) uu[e] = pack2(os[i * 8 + 2 * e], os[i * 8 + 2 * e + 1]);
            *(u32x4*)(og + i * 8) = uu;
          }
        } else {
          float v[32];
          float ss = 0.f;
#pragma unroll
          for (int i = 0; i < 4; ++i) {
            const u32x4 uu = *(const u32x4*)(og + i * 8);
#pragma unroll
            for (int e = 0; e < 4; ++e) {
              v[i * 8 + 2 * e] = os[i * 8 + 2 * e] + bflo(uu[e]);
              v[i * 8 + 2 * e + 1] = os[i * 8 + 2 * e + 1] + bfhi(uu[e]);
            }
          }
#pragma unroll
          for (int i = 0; i < 32; ++i) ss += v[i] * v[i];
          ss += __shfl_xor(ss, 1, 64);
          ss += __shfl_xor(ss, 2, 64);
          const float rstd = rsqrtf(ss * (1.f / 128.f) + EPSF);
          const float* gn = p.in[I_GON] + l * 128 + qd * 32;
          const bf16* gr = (const bf16*)(p.ws + OFF_GR) + tok * 512 + hd * 128 + qd * 32;
#pragma unroll
          for (int i = 0; i < 4; ++i) {
            const u32x4 ug = *(const u32x4*)(gr + i * 8);
            u32x4 uu;
#pragma unroll
            for (int e = 0; e < 4; ++e) {
              const float a0 = v[i * 8 + 2 * e] * rstd * gn[i * 8 + 2 * e] * siluf_(bflo(ug[e]));
              const float a1 = v[i * 8 + 2 * e + 1] * rstd * gn[i * 8 + 2 * e + 1] * siluf_(bfhi(ug[e]));
              uu[e] = pack2(a0, a1);
            }
            *(u32x4*)(og + i * 8) = uu;
          }
        }
        __syncthreads();
      }
    }
    if (!WITH_OUT) {
#pragma unroll
      for (int dkt = 0; dkt < 2; ++dkt)
#pragma unroll
        for (int i = 0; i < 16; ++i) GSu[(w * 32 + crow(i, h)) * 64 + dkt * 32 + r] = sacc[dkt][i];
      if (part == 0) ((float*)(p.ws + OFF_DECG))[((size_t)((b * 4 + hd) * 2 + dir) * NG33 + gi) * 64 + dk] = __expf(gtot);
    }
    __syncthreads();
  }
}

DI void gla_scan_job(const Params& p, int j) {
  const int idx = j * 256 + TIDX;
  const int seq = idx >> 13, el = idx & 8191, dk = el & 63, dir = seq & 1;
  float* GS = (float*)(p.ws + OFF_GS) + (size_t)seq * NG33 * 8192 + el;
  const float* DG = (const float*)(p.ws + OFF_DECG) + (size_t)seq * NG33 * 64 + dk;
  float s = 0.f;
  for (int st0 = 0; st0 < 33; st0 += 11) {
    float kv[11], dc[11];
#pragma unroll
    for (int q = 0; q < 11; ++q) {
      const int st = st0 + q;
      const int g = (dir == 0 || st == 0) ? st : 33 - st;
      kv[q] = GS[(size_t)g * 8192];
      dc[q] = DG[g * 64];
    }
#pragma unroll
    for (int q = 0; q < 11; ++q) {
      const int st = st0 + q;
      const int g = (dir == 0 || st == 0) ? st : 33 - st;
      GS[(size_t)g * 8192] = s;
      s = dc[q] * s + kv[q];
    }
  }
}

DI void s5_end_tile(const Params& p, int j, char* smem) {
  const int nt = j & 1, mt = (j >> 1) % 9, g = j / 18;
  const bf16* SU = (const bf16*)(p.ws + OFF_SU);
  const bf16* F = (const bf16*)(p.ws + OFF_F5) + ((size_t)g * 256 + nt * 128) * 512;
  f32x16 acc[2][2];
  acc_zero(acc);
  gemm_main(acc,
            [&](int r) -> const bf16* {
              const int m = mt * 128 + r;
              if (m >= MS5) return nullptr;
              const int b = m / NCH, ch = m - b * NCH;
              return SU + ((size_t)(b * 16 + g) * TT + ch * 32) * 16;
            },
            [&](int r) { return F + (size_t)r * 512; }, 512, smem);
  float* Cs = (float*)smem;
  acc_to_lds(acc, Cs);
  __syncthreads();
  float* EN = (float*)(p.ws + OFF_EN);
  for (int c = TIDX; c < 128 * 32; c += 256) {
    const int row = c >> 5, c4 = (c & 31) * 4, m = mt * 128 + row;
    if (m < MS5) {
      const float* s = Cs + row * CLD + c4;
      f32x4 v = {s[0], s[1], s[2], s[3]};
      *(f32x4*)(EN + ((size_t)m * 16 + g) * 256 + nt * 128 + c4) = v;
    }
  }
  __syncthreads();
}

DI void s5_scan_job(const Params& p, int l, int j, char* smem) {
  float2* ends = (float2*)smem;
  const int dir = j & 1, g = (j >> 1) & 15, b = j >> 5;
  const int pp = TIDX & 63, seg = TIDX >> 6;
  const float2 aL = ((const float2*)(p.ws + OFF_PWR))[((size_t)((l * 2 + dir) * 16 + g) * 33 + 32) * 64 + pp];
  const float* EN = (const float*)(p.ws + OFF_EN);
  bf16* SB = (bf16*)(p.ws + OFF_SB);
  float sr = 0.f, si = 0.f;
  for (int q0 = 0; q0 < 66; q0 += 11) {
    float er[11], ei[11];
#pragma unroll
    for (int q = 0; q < 11; ++q) {
      const int pos = seg * 66 + q0 + q;
      const int ch = dir ? (pos < 8 ? 7 - pos : 271 - pos) : pos;
      const float* e = EN + ((size_t)(b * NCH + ch) * 16 + g) * 256 + dir * 128 + pp;
      er[q] = e[0]; ei[q] = e[64];
    }
#pragma unroll
    for (int q = 0; q < 11; ++q) {
      const float nr = aL.x * sr - aL.y * si + er[q], ni = aL.x * si + aL.y * sr + ei[q];
      sr = nr; si = ni;
    }
  }
  ends[seg * 64 + pp] = make_float2(sr, si);
  float pr = 1.f, pi = 0.f;
  for (int q = 0; q < 66; ++q) { const float nr = pr * aL.x - pi * aL.y, ni = pr * aL.y + pi * aL.x; pr = nr; pi = ni; }
  __syncthreads();
  sr = 0.f; si = 0.f;
  for (int k = 0; k < seg; ++k) {
    const float2 e = ends[k * 64 + pp];
    const float nr = pr * sr - pi * si + e.x, ni = pr * si + pi * sr + e.y;
    sr = nr; si = ni;
  }
  for (int q0 = 0; q0 < 66; q0 += 11) {
    float er[11], ei[11];
#pragma unroll
    for (int q = 0; q < 11; ++q) {
      const int pos = seg * 66 + q0 + q;
      const int ch = dir ? (pos < 8 ? 7 - pos : 271 - pos) : pos;
      const float* e = EN + ((size_t)(b * NCH + ch) * 16 + g) * 256 + dir * 128 + pp;
      er[q] = e[0]; ei[q] = e[64];
    }
#pragma unroll
    for (int q = 0; q < 11; ++q) {
      const int pos = seg * 66 + q0 + q;
      const int ch = dir ? (pos < 8 ? 7 - pos : 271 - pos) : pos;
      bf16* sb = SB + ((size_t)(b * NCH + ch) * 16 + g) * 256 + dir * 128 + pp;
      sb[0] = f2bf(sr); sb[64] = f2bf(si);
      const float nr = aL.x * sr - aL.y * si + er[q], ni = aL.x * si + aL.y * sr + ei[q];
      sr = nr; si = ni;
    }
  }
  __syncthreads();
}

DI float gelu_tanh(float x) {
  const float u = 0.7978845608028654f * (x + 0.044715f * x * x * x);
  return 0.5f * x * (1.f + tanhf(u));
}

DI void s5_out_tile(const Params& p, int j, char* smem) {
  const int nt = j & 3, mt = (j >> 2) % 9, g = j / 36;
  const bf16* SU = (const bf16*)(p.ws + OFF_SU);
  const bf16* SB = (const bf16*)(p.ws + OFF_SB);
  const bf16* Tm = (const bf16*)(p.ws + OFF_T5) + ((size_t)g * 512 + nt * 128) * 512;
  const bf16* Em = (const bf16*)(p.ws + OFF_E5) + ((size_t)g * 512 + nt * 128) * 256;
  f32x16 acc[2][2];
  acc_zero(acc);
  gemm_main(acc,
            [&](int r) -> const bf16* {
              const int m = mt * 128 + r;
              if (m >= MS5) return nullptr;
              const int b = m / NCH, ch = m - b * NCH;
              return SU + ((size_t)(b * 16 + g) * TT + ch * 32) * 16;
            },
            [&](int r) { return Tm + (size_t)r * 512; }, 512, smem);
  gemm_main(acc,
            [&](int r) -> const bf16* {
              const int m = mt * 128 + r;
              if (m >= MS5) return nullptr;
              return SB + ((size_t)m * 16 + g) * 256;
            },
            [&](int r) { return Em + (size_t)r * 256; }, 256, smem);
  float* Cs = (float*)smem;
  acc_to_lds(acc, Cs);
  __syncthreads();
  bf16* Y5 = (bf16*)(p.ws + OFF_Y5);
  for (int c = TIDX; c < 2048; c += 256) {
    const int row = c >> 4, c8 = c & 15, m = mt * 128 + row;
    if (m < MS5) {
      const int b = m / NCH, ch = m - b * NCH;
      const int n = nt * 128 + c8 * 8, i = n >> 4, hh = n & 15;
      const float* s = Cs + row * CLD + c8 * 8;
      u32x4 u;
#pragma unroll
      for (int e = 0; e < 4; ++e) u[e] = pack2(gelu_tanh(s[2 * e]), gelu_tanh(s[2 * e + 1]));
      *(u32x4*)(Y5 + ((size_t)b * TT + ch * 32 + i) * 256 + g * 16 + hh) = u;
    }
  }
  __syncthreads();
}

DI void glu_tile(const Params& p, int l, int j, char* smem) {
  const int nt = j & 1, mt = j >> 1;
  const bf16* Y5 = (const bf16*)(p.ws + OFF_Y5) + (size_t)mt * 128 * 256;
  const bf16* W = wl(p, l, WL_GLU) + (size_t)nt * 128 * 256;
  f32x16 acc[2][2];
  acc_zero(acc);
  gemm_main(acc, [&](int r) { return Y5 + (size_t)r * 256; }, [&](int r) { return W + (size_t)r * 256; }, 256, smem);
  float* Cs = (float*)smem;
  acc_to_lds(acc, Cs);
  __syncthreads();
  const float* gb = p.in[I_GLUB] + l * 256 + nt * 128;
  bf16* O = (bf16*)(p.ws + OFF_OS5) + (size_t)mt * 128 * 256 + nt * 128;
  for (int c = TIDX; c < 2048; c += 256) {
    const int row = c >> 4, cc = (c & 15) * 8;
    const float* s = Cs + row * CLD + cc;
    const u32x4 yu = *(const u32x4*)(Y5 + (size_t)row * 256 + nt * 128 + cc);
    u32x4 u;
#pragma unroll
    for (int e = 0; e < 4; ++e) {
      const float y0 = bflo(yu[e]), y1 = bfhi(yu[e]);
      u[e] = pack2(y0 * sigmoidf_(s[2 * e] + gb[cc + 2 * e]), y1 * sigmoidf_(s[2 * e + 1] + gb[cc + 2 * e + 1]));
    }
    *(u32x4*)(O + (size_t)row * 256 + cc) = u;
  }
  __syncthreads();
}

DI void merge_tile(const Params& p, int l, int j, char* smem) {
  const int nt = j & 7, mt = j >> 3;
  const bf16* H = (const bf16*)(p.ws + OFF_H) + (size_t)mt * 128 * DM;
  f32x16 accm[2][2];
  acc_zero(accm);
#pragma unroll 1
  for (int x = 0; x < 3; ++x) {
    const bf16* Wg = wl(p, l, WL_WIN) + ((size_t)2432 + x * 1024 + nt * 128) * DM;
    f32x16 acc[2][2];
    acc_zero(acc);
    gemm_main(acc, [&](int r) { return H + (size_t)r * DM; }, [&](int r) { return Wg + (size_t)r * DM; }, DM, smem);
    unsigned sg[2][2][8];
#pragma unroll
    for (int a = 0; a < 2; ++a)
#pragma unroll
      for (int bq = 0; bq < 2; ++bq)
#pragma unroll
        for (int i = 0; i < 8; ++i) sg[a][bq][i] = pack2(sigmoidf_(acc[a][bq][2 * i]), sigmoidf_(acc[a][bq][2 * i + 1]));
    acc_zero(acc);
    const bf16* A; const bf16* Wb; int K;
    if (x == 0) { A = (const bf16*)(p.ws + OFF_OATT) + (size_t)mt * 128 * 256; Wb = wl(p, l, WL_BRA) + (size_t)nt * 128 * 256; K = 256; }
    else if (x == 1) { A = (const bf16*)(p.ws + OFF_OGLA) + (size_t)mt * 128 * 512; Wb = wl(p, l, WL_BRG) + (size_t)nt * 128 * 512; K = 512; }
    else { A = (const bf16*)(p.ws + OFF_OS5) + (size_t)mt * 128 * 256; Wb = wl(p, l, WL_BRS) + (size_t)nt * 128 * 256; K = 256; }
    gemm_main(acc, [&](int r) { return A + (size_t)r * K; }, [&](int r) { return Wb + (size_t)r * K; }, K, smem);
#pragma unroll
    for (int a = 0; a < 2; ++a)
#pragma unroll
      for (int bq = 0; bq < 2; ++bq)
#pragma unroll
        for (int i = 0; i < 8; ++i) {
          accm[a][bq][2 * i] += bflo(sg[a][bq][i]) * acc[a][bq][2 * i];
          accm[a][bq][2 * i + 1] += bfhi(sg[a][bq][i]) * acc[a][bq][2 * i + 1];
        }
  }
  float* Cs = (float*)smem;
  acc_to_lds(accm, Cs);
  __syncthreads();
  store_tile_bf16(Cs, (bf16*)(p.ws + OFF_MG) + (size_t)mt * 128 * DM + nt * 128, DM, 128, 1.f);
  __syncthreads();
}

DI void plain_tile(const bf16* A, int K, const bf16* W, bf16* dst, int ldd, char* smem) {
  f32x16 acc[2][2];
  acc_zero(acc);
  gemm_main(acc, [&](int r) { return A + (size_t)r * K; }, [&](int r) { return W + (size_t)r * K; }, K, smem);
  float* Cs = (float*)smem;
  acc_to_lds(acc, Cs);
  __syncthreads();
  store_tile_bf16(Cs, dst, ldd, 128, 1.f);
  __syncthreads();
}

DI void up_tile(const Params& p, int l, int j, char* smem) {
  const int jn = j % 44, mtile = j / 44;
  const int b = mtile / 69, rr0 = mtile % 69;
  int seqbase, len, ti;
  if (rr0 < 3) { seqbase = b * TT; len = CTXL; ti = rr0; }
  else { seqbase = b * TT + CTXL; len = SEQ; ti = rr0 - 3; }
  const int pos0 = ti * 126 - 1;
  const bf16* H = (const bf16*)(p.ws + OFF_H);
  const bf16* W = wl(p, l, WL_UP) + (size_t)jn * 128 * DM;
  f32x16 acc[2][2];
  acc_zero(acc);
  gemm_main(acc,
            [&](int r) -> const bf16* {
              const int pos = pos0 + r;
              return (pos >= 0 && pos < len) ? H + (size_t)(seqbase + pos) * DM : nullptr;
            },
            [&](int r) { return W + (size_t)r * DM; }, DM, smem);
  float* Cs = (float*)smem;
  acc_to_lds(acc, Cs);
  __syncthreads();
  const float* cw = p.in[I_CW] + (size_t)l * 3 * 2 * DFF;
  const float* cb = p.in[I_CB] + (size_t)l * 2 * DFF;
  bf16* G = (bf16*)(p.ws + OFF_G);
  for (int idx = TIDX; idx < 126 * 32; idx += 256) {
    const int rr = 1 + (idx >> 5), c = (idx & 31) * 2;
    const int pos = pos0 + rr;
    if (pos < len) {
      float gv[2];
#pragma unroll
      for (int e = 0; e < 2; ++e) {
        const int ca = jn * 64 + c + e, cv = DFF + ca;
        const float a = cw[ca] * Cs[(rr - 1) * CLD + c + e] + cw[2 * DFF + ca] * Cs[rr * CLD + c + e] +
                        cw[4 * DFF + ca] * Cs[(rr + 1) * CLD + c + e] + cb[ca];
        const float v = cw[cv] * Cs[(rr - 1) * CLD + 64 + c + e] + cw[2 * DFF + cv] * Cs[rr * CLD + 64 + c + e] +
                        cw[4 * DFF + cv] * Cs[(rr + 1) * CLD + 64 + c + e] + cb[cv];
        gv[e] = siluf_(a) * v;
      }
      *(unsigned*)(G + (size_t)(seqbase + pos) * DFF + jn * 64 + c) = pack2(gv[0], gv[1]);
    }
  }
  __syncthreads();
}

enum { PH_PREP = 0, PH_ROW0, PH_PROJ, PH_MIX1, PH_SCAN, PH_MIX2, PH_GLU, PH_MERGE, PH_WOUT, PH_ROW1, PH_UP, PH_DOWN, PH_ROW2 };
constexpr int N_PHASES = 2 + 11 * NL;

DI void run_phase(const Params& p, int ph, int l, char* smem) {
  const int G = gridDim.x, bid = blockIdx.x;
#ifdef PHMASK
  if (!((PHMASK >> ph) & 1)) return;
#endif
  switch (ph) {
    case PH_PREP:
      for (int j = bid; j < 128 + 16064; j += G) {
        if (j < 96) prep_mod_job(p, j, smem);
        else if (j < 128) prep_s5_job(p, j - 96);
        else prep_wt_job(p, j - 128, smem);
      }
      break;
    case PH_ROW0:
      row_phase<0>(p, 0);
      ktab_phase(p);
      break;
    case PH_PROJ:
      for (int j = bid; j < 264 * 19; j += G) proj_tile(p, l, j / 19, j % 19, smem);
      s5mat_phase(p, l);
      break;
    case PH_MIX1:
      for (int j = bid; j < 1056 + 1056 + 288; j += G) {
        if (j < 1056) attn_unit(p, j, smem);
        else if (j < 2112) gla_unit<false>(p, l, j - 1056, smem);
        else s5_end_tile(p, j - 2112, smem);
      }
      break;
    case PH_SCAN:
      for (int j = bid; j < 1024 + 128; j += G) {
        if (j < 1024) gla_scan_job(p, j);
        else s5_scan_job(p, l, j - 1024, smem);
      }
      break;
    case PH_MIX2:
      for (int j = bid; j < 528 + 576; j += G) {
        if (j < 528) gla_unit<true>(p, l, j, smem);
        else s5_out_tile(p, j - 528, smem);
      }
      break;
    case PH_GLU:
      for (int j = bid; j < 528; j += G) glu_tile(p, l, j, smem);
      break;
    case PH_MERGE:
      for (int j = bid; j < 264 * 8; j += G) merge_tile(p, l, j, smem);
      break;
    case PH_WOUT:
      for (int j = bid; j < 264 * 8; j += G) {
        const int nt = j & 7, mt = j >> 3;
        plain_tile((const bf16*)(p.ws + OFF_MG) + (size_t)mt * 128 * DM, DM, wl(p, l, WL_WOUT) + (size_t)nt * 128 * DM,
                   (bf16*)(p.ws + OFF_H) + (size_t)mt * 128 * DM + nt * 128, DM, smem);
      }
      break;
    case PH_ROW1: row_phase<1>(p, l); break;
    case PH_UP:
      for (int j = bid; j < 276 * 44; j += G) up_tile(p, l, j, smem);
      break;
    case PH_DOWN:
      for (int j = bid; j < 264 * 8; j += G) {
        const int nt = j & 7, mt = j >> 3;
        plain_tile((const bf16*)(p.ws + OFF_G) + (size_t)mt * 128 * DFF, DFF, wl(p, l, WL_DOWN) + (size_t)nt * 128 * DFF,
                   (bf16*)(p.ws + OFF_H) + (size_t)mt * 128 * DM + nt * 128, DM, smem);
      }
      break;
    case PH_ROW2: row_phase<2>(p, l); break;
  }
}

__global__ void __launch_bounds__(256) hybrid_fwd(Params p, int ph_lo, int ph_hi) {
  extern __shared__ __attribute__((aligned(16))) char smem[];
  int i = 0;
#define STEP(PH, L)                                      \
  {                                                      \
    if (i >= ph_lo && i < ph_hi) {                       \
      Params q;                                          \
      q.ws = p.ws; q.out = p.out;                        \
      asm volatile("" : "+s"(q.ws), "+s"(q.out));        \
      _Pragma("unroll") for (int k = 0; k < 34; ++k) { q.in[k] = p.in[k]; asm volatile("" : "+s"(q.in[k])); } \
      run_phase(q, PH, L, smem);                         \
      if (i + 1 < ph_hi) cg::this_grid().sync();         \
    }                                                    \
    ++i;                                                 \
  }
  STEP(PH_PREP, 0)
  STEP(PH_ROW0, 0)
#pragma unroll 1
  for (int l = 0; l < NL; ++l) {
    STEP(PH_PROJ, l)
    STEP(PH_MIX1, l)
    STEP(PH_SCAN, l)
    STEP(PH_MIX2, l)
    STEP(PH_GLU, l)
    STEP(PH_MERGE, l)
    STEP(PH_WOUT, l)
    STEP(PH_ROW1, l)
    STEP(PH_UP, l)
    STEP(PH_DOWN, l)
    STEP(PH_ROW2, l)
  }
#undef STEP
}

extern "C" void kernel_launch(void* const* d_in, const int* in_sizes, int n_in, void* d_out, int out_size, void* d_ws, size_t ws_size,
                              hipStream_t stream) {
  static int grid_blocks = 0;
  if (!grid_blocks) {
    int dev = 0, cus = 0, per_cu = 0;
    hipGetDevice(&dev);
    hipDeviceGetAttribute(&cus, hipDeviceAttributeMultiprocessorCount, dev);
    hipFuncSetAttribute((const void*)hybrid_fwd, hipFuncAttributeMaxDynamicSharedMemorySize, SMEM_BYTES);
    hipOccupancyMaxActiveBlocksPerMultiprocessor(&per_cu, hybrid_fwd, 256, SMEM_BYTES);
    if (per_cu < 1) per_cu = 1;
    if (per_cu > 2) per_cu = 2;
    grid_blocks = cus * per_cu;
    if (ws_size < OFF_END) fprintf(stderr, "workspace too small: %zu < %zu\n", ws_size, (size_t)OFF_END);
  }
  Params p{};
  for (int i = 0; i < 34; ++i) p.in[i] = (const float*)d_in[i];
  p.out = (float*)d_out;
  p.ws = (char*)d_ws;
#if ONE_LAUNCH
  int lo = 0, hi = N_PHASES;
  void* args[] = {&p, &lo, &hi};
  hipError_t e = hipLaunchCooperativeKernel((void*)hybrid_fwd, dim3(grid_blocks), dim3(256), args, SMEM_BYTES, stream);
  if (e != hipSuccess) fprintf(stderr, "cooperative launch failed: %s (grid %d)\n", hipGetErrorString(e), grid_blocks);
#else
  for (int i = 0; i < N_PHASES; ++i) hipLaunchKernelGGL(hybrid_fwd, dim3(grid_blocks), dim3(256), SMEM_BYTES, stream, p, i, i + 1);
#endif
}
```

```cpp
#include <hip/hip_runtime.h>
#include <hip/hip_cooperative_groups.h>
#include <stdint.h>
#include <cstdio>
namespace cg = cooperative_groups;

#define EXP_A 1
#ifndef DUPMASK
#define DUPMASK 0
#endif
#ifndef ONE_LAUNCH
#define ONE_LAUNCH 1
#endif

typedef unsigned short bf16;
typedef __attribute__((ext_vector_type(8))) short s16x8;
typedef __attribute__((ext_vector_type(4))) short s16x4;
typedef __attribute__((ext_vector_type(16))) float f32x16;
typedef __attribute__((ext_vector_type(4))) float f32x4;
typedef __attribute__((ext_vector_type(2))) float f32x2;
typedef __attribute__((ext_vector_type(4))) unsigned u32x4;
typedef __attribute__((ext_vector_type(2))) unsigned u32x2;
typedef __attribute__((ext_vector_type(2))) __bf16 bf16x2_t;

#define DI __device__ __forceinline__
#define MFMA32(a, b, c) __builtin_amdgcn_mfma_f32_32x32x16_bf16((a), (b), (c), 0, 0, 0)

DI int tidx_opaque() { int t = threadIdx.x; asm volatile("" : "+v"(t)); return t; }
#define TIDX tidx_opaque()
DI bf16 f2bf(float x) { return __builtin_bit_cast(unsigned short, (__bf16)x); }
DI float bf2f(bf16 v) { return __uint_as_float(((unsigned)v) << 16); }
DI unsigned pack2(float a, float b) {
  f32x2 v = {a, b};
  return __builtin_bit_cast(unsigned, __builtin_convertvector(v, bf16x2_t));
}
DI float bflo(unsigned u) { return __uint_as_float(u << 16); }
DI float bfhi(unsigned u) { return __uint_as_float(u & 0xffff0000u); }
DI int crow(int i, int h) { return (i & 3) + 8 * (i >> 2) + 4 * h; }
DI void sincos_cw(float x, float& sn, float& cs) {
  const float k = rintf(x * 0.63661977236758134f);
  float r = fmaf(-k, 1.57079637050628662109375f, x);
  r = fmaf(-k, -4.371139000186241e-08f, r);
  const int q = ((int)k) & 3;
  const float r2 = r * r;
  const float sp = r + r * r2 * (-1.6666667163e-01f + r2 * (8.3333337680e-03f + r2 * (-1.9841270114e-04f + r2 * 2.7557314297e-06f)));
  const float cp = 1.f + r2 * (-0.5f + r2 * (4.1666667908e-02f + r2 * (-1.3888889225e-03f + r2 * (2.4801587642e-05f - r2 * 2.7557314297e-07f))));
  sn = (q == 0) ? sp : (q == 1) ? cp : (q == 2) ? -sp : -cp;
  cs = (q == 0) ? cp : (q == 1) ? -sp : (q == 2) ? -cp : sp;
}
DI float sigmoidf_(float x) { return 1.f / (1.f + __expf(-x)); }
DI float siluf_(float x) { return x / (1.f + __expf(-x)); }

constexpr int DM = 1024, NB = 4, SEQ = 8192, CTXL = 256, TT = SEQ + CTXL, NTOK = NB * TT, NL = 4;
constexpr int DFF = 2816, DIN = 5408;
constexpr float EPSF = 1e-6f;
constexpr int NG33 = 33;
constexpr int NCH = 264;
constexpr int MS5 = NB * NCH;

constexpr size_t SZ_H = (size_t)NTOK * 1024 * 2;
constexpr size_t OFF_H = 0;
constexpr size_t OFF_P = OFF_H + SZ_H;
constexpr size_t OFF_Q = OFF_P;
constexpr size_t OFF_K = OFF_Q + (size_t)NTOK * 256 * 2;
constexpr size_t OFF_VT = OFF_K + (size_t)NTOK * 128 * 2;
constexpr size_t OFF_GQ = OFF_VT + (size_t)NTOK * 128 * 2;
constexpr size_t OFF_GK = OFF_GQ + (size_t)NTOK * 256 * 2;
constexpr size_t OFF_GVT = OFF_GK + (size_t)NTOK * 256 * 2;
constexpr size_t OFF_GR = OFF_GVT + (size_t)NTOK * 512 * 2;
constexpr size_t OFF_SU = OFF_GR + (size_t)NTOK * 512 * 2;
constexpr size_t OFF_LOW = OFF_SU + (size_t)NTOK * 256 * 2;
constexpr size_t OFF_O = OFF_LOW + (size_t)NTOK * 32 * 4;
constexpr size_t OFF_OATT = OFF_O;
constexpr size_t OFF_OGLA = OFF_OATT + (size_t)NTOK * 256 * 2;
constexpr size_t OFF_Y5 = OFF_OGLA + (size_t)NTOK * 512 * 2;
constexpr size_t OFF_EN = OFF_Y5;
constexpr size_t OFF_OS5 = OFF_Y5 + (size_t)NTOK * 256 * 2;
constexpr size_t OFF_M = OFF_OS5 + (size_t)NTOK * 256 * 2;
constexpr size_t OFF_MG = OFF_M;
constexpr size_t OFF_GS = OFF_M;
constexpr size_t OFF_DECG = OFF_GS + (size_t)32 * 33 * 8192 * 4;
constexpr size_t OFF_SB = OFF_DECG + (size_t)32 * 33 * 64 * 4;
constexpr size_t OFF_T5 = OFF_SB + (size_t)MS5 * 16 * 256 * 2;
constexpr size_t OFF_E5 = OFF_T5 + (size_t)16 * 512 * 512 * 2;
constexpr size_t OFF_F5 = OFF_E5 + (size_t)16 * 512 * 256 * 2;
constexpr size_t OFF_MEND = OFF_F5 + (size_t)16 * 256 * 512 * 2;
static_assert(OFF_MEND <= OFF_M + SZ_H, "mixer scratch overflows merged area");
constexpr size_t OFF_W = OFF_M + SZ_H;
constexpr size_t WL_WIN = 0, WL_BRA = WL_WIN + (size_t)5504 * 1024, WL_BRG = WL_BRA + 1024 * 256, WL_BRS = WL_BRG + 1024 * 512,
                 WL_WOUT = WL_BRS + 1024 * 256, WL_UP = WL_WOUT + 1024 * 1024, WL_DOWN = WL_UP + (size_t)5632 * 1024,
                 WL_GLU = WL_DOWN + (size_t)1024 * 2816, WL_TOTAL = WL_GLU + 256 * 256;
constexpr size_t OFF_XC = OFF_W + WL_TOTAL * 2 * NL;
constexpr size_t OFF_MOD = OFF_XC + (size_t)NB * CTXL * 1024 * 4;
constexpr size_t OFF_BBR = OFF_MOD + (size_t)NL * 5 * 6144 * 4;
constexpr size_t OFF_BBI = OFF_BBR + (size_t)NL * 2 * 16 * 64 * 16 * 4;
constexpr size_t OFF_PWR = OFF_BBI + (size_t)NL * 2 * 16 * 64 * 16 * 4;
constexpr size_t OFF_KTAB = OFF_PWR + (size_t)NL * 2 * 16 * 33 * 64 * 8;
constexpr size_t OFF_END = OFF_KTAB + (size_t)NL * 16 * 2 * 32 * 256 * 4;
constexpr size_t OFF_BAR = OFF_END;
constexpr size_t OFF_G = OFF_P;
static_assert((size_t)NTOK * DFF * 2 <= OFF_M - OFF_P, "G overflows");

constexpr int SMEM_BYTES = 73728;

struct Params {
  const float* in[34];
  float* out;
  char* ws;
};

enum { I_X = 0, I_C, I_CTX, I_CCTX, I_ADAW, I_ADAB, I_NMPRE, I_NMPOST, I_NFPRE, I_NFPOST, I_WIN, I_QN, I_KN, I_GGW, I_GGB, I_GON,
       I_ARE, I_AIM, I_LDT, I_BRE, I_BIM, I_CRE, I_CIM, I_S5D, I_GLUW, I_GLUB, I_WBA, I_WBG, I_WBS, I_WOUT, I_UP, I_CW, I_CB, I_DOWN };

constexpr int LDT = 72;
constexpr int CLD = 132;

template <class FA, class FB>
DI void gemm_main(f32x16 (&acc)[2][2], FA fa, FB fb, int K, char* smem) {
  bf16* As = (bf16*)smem;
  bf16* Bs = (bf16*)(smem + 2 * 128 * LDT * 2);
  const int tid = TIDX, lane = tid & 63, w = tid >> 6, wm = w >> 1, wn = w & 1;
  const int r = lane & 31, h = lane >> 5;
  const int lr = tid >> 3, kc = (tid & 7) * 8;
  const bf16* ap[4];
  const bf16* bp[4];
#pragma unroll
  for (int i = 0; i < 4; ++i) {
    const bf16* a = fa(lr + 32 * i);
    const bf16* b = fb(lr + 32 * i);
    ap[i] = a ? a + kc : nullptr;
    bp[i] = b ? b + kc : nullptr;
  }
  u32x4 ra[4], rb[4];
  const u32x4 z4 = {0u, 0u, 0u, 0u};
#pragma unroll
  for (int i = 0; i < 4; ++i) {
    ra[i] = ap[i] ? *(const u32x4*)(ap[i]) : z4;
    rb[i] = bp[i] ? *(const u32x4*)(bp[i]) : z4;
  }
#pragma unroll
  for (int i = 0; i < 4; ++i) {
    *(u32x4*)(As + (lr + 32 * i) * LDT + kc) = ra[i];
    *(u32x4*)(Bs + (lr + 32 * i) * LDT + kc) = rb[i];
  }
  __syncthreads();
  const int nk = K / 64;
  for (int kt = 0; kt < nk; ++kt) {
    const int buf = kt & 1;
    const bool more = (kt + 1 < nk);
    if (more) {
      const int k0 = (kt + 1) * 64;
#pragma unroll
      for (int i = 0; i < 4; ++i) {
        ra[i] = ap[i] ? *(const u32x4*)(ap[i] + k0) : z4;
        rb[i] = bp[i] ? *(const u32x4*)(bp[i] + k0) : z4;
      }
    }
    const bf16* Ab = As + buf * 128 * LDT + (wm * 64 + r) * LDT + h * 8;
    const bf16* Bb = Bs + buf * 128 * LDT + (wn * 64 + r) * LDT + h * 8;
#pragma unroll
    for (int s = 0; s < 4; ++s) {
      s16x8 a0 = *(const s16x8*)(Ab + s * 16);
      s16x8 a1 = *(const s16x8*)(Ab + 32 * LDT + s * 16);
      s16x8 b0 = *(const s16x8*)(Bb + s * 16);
      s16x8 b1 = *(const s16x8*)(Bb + 32 * LDT + s * 16);
      acc[0][0] = MFMA32(a0, b0, acc[0][0]);
      acc[0][1] = MFMA32(a0, b1, acc[0][1]);
      acc[1][0] = MFMA32(a1, b0, acc[1][0]);
      acc[1][1] = MFMA32(a1, b1, acc[1][1]);
    }
    if (more) {
      bf16* Aw = As + (buf ^ 1) * 128 * LDT;
      bf16* Bw = Bs + (buf ^ 1) * 128 * LDT;
#pragma unroll
      for (int i = 0; i < 4; ++i) {
        *(u32x4*)(Aw + (lr + 32 * i) * LDT + kc) = ra[i];
        *(u32x4*)(Bw + (lr + 32 * i) * LDT + kc) = rb[i];
      }
    }
    __syncthreads();
  }
}

DI void gemm_main_s(f32x16 (&acc)[2][2], const bf16* A, int lda, const bf16* B, int ldb, int K, char* smem) {
  bf16* As = (bf16*)smem;
  bf16* Bs = (bf16*)(smem + 2 * 128 * LDT * 2);
  const int tid = TIDX, lane = tid & 63, w = tid >> 6, wm = w >> 1, wn = w & 1;
  const int r = lane & 31, h = lane >> 5;
  const int lr = tid >> 3, kc = (tid & 7) * 8;
  const bf16* ap = A + (size_t)lr * lda + kc;
  const bf16* bp = B + (size_t)lr * ldb + kc;
  const size_t sa = (size_t)32 * lda, sb = (size_t)32 * ldb;
  u32x4 ra[4], rb[4];
#pragma unroll
  for (int i = 0; i < 4; ++i) {
    ra[i] = *(const u32x4*)(ap + i * sa);
    rb[i] = *(const u32x4*)(bp + i * sb);
  }
#pragma unroll
  for (int i = 0; i < 4; ++i) {
    *(u32x4*)(As + (lr + 32 * i) * LDT + kc) = ra[i];
    *(u32x4*)(Bs + (lr + 32 * i) * LDT + kc) = rb[i];
  }
  __syncthreads();
  const int nk = K / 64;
  for (int kt = 0; kt < nk; ++kt) {
    const int buf = kt & 1;
    const bool more = (kt + 1 < nk);
    if (more) {
      ap += 64; bp += 64;
#pragma unroll
      for (int i = 0; i < 4; ++i) {
        ra[i] = *(const u32x4*)(ap + i * sa);
        rb[i] = *(const u32x4*)(bp + i * sb);
      }
    }
    const bf16* Ab = As + buf * 128 * LDT + (wm * 64 + r) * LDT + h * 8;
    const bf16* Bb = Bs + buf * 128 * LDT + (wn * 64 + r) * LDT + h * 8;
#pragma unroll
    for (int s = 0; s < 4; ++s) {
      s16x8 a0 = *(const s16x8*)(Ab + s * 16);
      s16x8 a1 = *(const s16x8*)(Ab + 32 * LDT + s * 16);
      s16x8 b0 = *(const s16x8*)(Bb + s * 16);
      s16x8 b1 = *(const s16x8*)(Bb + 32 * LDT + s * 16);
      acc[0][0] = MFMA32(a0, b0, acc[0][0]);
      acc[0][1] = MFMA32(a0, b1, acc[0][1]);
      acc[1][0] = MFMA32(a1, b0, acc[1][0]);
      acc[1][1] = MFMA32(a1, b1, acc[1][1]);
    }
    if (more) {
      bf16* Aw = As + (buf ^ 1) * 128 * LDT;
      bf16* Bw = Bs + (buf ^ 1) * 128 * LDT;
#pragma unroll
      for (int i = 0; i < 4; ++i) {
        *(u32x4*)(Aw + (lr + 32 * i) * LDT + kc) = ra[i];
        *(u32x4*)(Bw + (lr + 32 * i) * LDT + kc) = rb[i];
      }
    }
    __syncthreads();
  }
}

DI void gemm_main_half(f32x16 (&acc)[2], const bf16* A, int lda, const bf16* B, int ldb, int K, int hf, char* smem) {
  bf16* As = (bf16*)smem;
  bf16* Bs = (bf16*)(smem + 2 * 128 * LDT * 2);
  const int tid = TIDX, lane = tid & 63, w = tid >> 6, wm = w >> 1, wn = w & 1;
  const int r = lane & 31, h = lane >> 5;
  const int lr = tid >> 3, kc = (tid & 7) * 8;
  const bf16* ap = A + (size_t)lr * lda + kc;
  const bf16* bp = B + (size_t)(hf * 32 + lr) * ldb + kc;
  const size_t sa = (size_t)32 * lda, sb = (size_t)64 * ldb;
  u32x4 ra[4], rb[2];
#pragma unroll
  for (int i = 0; i < 4; ++i) ra[i] = *(const u32x4*)(ap + i * sa);
#pragma unroll
  for (int i = 0; i < 2; ++i) rb[i] = *(const u32x4*)(bp + i * sb);
#pragma unroll
  for (int i = 0; i < 4; ++i) *(u32x4*)(As + (lr + 32 * i) * LDT + kc) = ra[i];
#pragma unroll
  for (int i = 0; i < 2; ++i) *(u32x4*)(Bs + (lr + 32 * i) * LDT + kc) = rb[i];
  __syncthreads();
  const int nk = K / 64;
  for (int kt = 0; kt < nk; ++kt) {
    const int buf = kt & 1;
    const bool more = (kt + 1 < nk);
    if (more) {
      ap += 64; bp += 64;
#pragma unroll
      for (int i = 0; i < 4; ++i) ra[i] = *(const u32x4*)(ap + i * sa);
#pragma unroll
      for (int i = 0; i < 2; ++i) rb[i] = *(const u32x4*)(bp + i * sb);
    }
    const bf16* Ab = As + buf * 128 * LDT + (wm * 64 + r) * LDT + h * 8;
    const bf16* Bb = Bs + buf * 128 * LDT + (wn * 32 + r) * LDT + h * 8;
#pragma unroll
    for (int s = 0; s < 4; ++s) {
      s16x8 a0 = *(const s16x8*)(Ab + s * 16);
      s16x8 a1 = *(const s16x8*)(Ab + 32 * LDT + s * 16);
      s16x8 b0 = *(const s16x8*)(Bb + s * 16);
      acc[0] = MFMA32(a0, b0, acc[0]);
      acc[1] = MFMA32(a1, b0, acc[1]);
    }
    if (more) {
      bf16* Aw = As + (buf ^ 1) * 128 * LDT;
      bf16* Bw = Bs + (buf ^ 1) * 128 * LDT;
#pragma unroll
      for (int i = 0; i < 4; ++i) *(u32x4*)(Aw + (lr + 32 * i) * LDT + kc) = ra[i];
#pragma unroll
      for (int i = 0; i < 2; ++i) *(u32x4*)(Bw + (lr + 32 * i) * LDT + kc) = rb[i];
    }
    __syncthreads();
  }
}

DI void acc_zero(f32x16 (&acc)[2][2]) {
#pragma unroll
  for (int a = 0; a < 2; ++a)
#pragma unroll
    for (int b = 0; b < 2; ++b)
#pragma unroll
      for (int i = 0; i < 16; ++i) acc[a][b][i] = 0.f;
}

DI void acc_to_lds(const f32x16 (&acc)[2][2], float* Cs) {
  const int lane = TIDX & 63, w = TIDX >> 6, wm = w >> 1, wn = w & 1, r = lane & 31, h = lane >> 5;
#pragma unroll
  for (int tm = 0; tm < 2; ++tm)
#pragma unroll
    for (int tn = 0; tn < 2; ++tn)
#pragma unroll
      for (int i = 0; i < 16; ++i) Cs[(wm * 64 + tm * 32 + crow(i, h)) * CLD + wn * 64 + tn * 32 + r] = acc[tm][tn][i];
}

DI void store_tile_bf16(const float* Cs, bf16* dst, size_t ld, int mvalid, float scale) {
  for (int c = TIDX; c < 2048; c += 256) {
    const int row = c >> 4, cc = (c & 15) * 8;
    if (row < mvalid) {
      const float* s = Cs + row * CLD + cc;
      u32x4 v;
      v[0] = pack2(s[0] * scale, s[1] * scale);
      v[1] = pack2(s[2] * scale, s[3] * scale);
      v[2] = pack2(s[4] * scale, s[5] * scale);
      v[3] = pack2(s[6] * scale, s[7] * scale);
      *(u32x4*)(dst + (size_t)row * ld + cc) = v;
    }
  }
}

DI float* resid_row(const Params& p, int tok) {
  const int b = tok / TT, t = tok - b * TT;
  return (t < CTXL) ? (float*)(p.ws + OFF_XC) + ((size_t)b * CTXL + t) * DM : p.out + ((size_t)b * SEQ + (t - CTXL)) * DM;
}
DI const float* mod_vec(const Params& p, int l, int tok, int which) {
  const int b = tok / TT, t = tok - b * TT;
  const int m = (t < CTXL) ? 4 : b;
  return (const float*)(p.ws + OFF_MOD) + ((size_t)(l * 5 + m) * 6 + which) * DM;
}
DI float wave_sum(float v) {
#pragma unroll
  for (int o = 32; o >= 1; o >>= 1) v += __shfl_xor(v, o, 64);
  return v;
}
DI bf16* wl(const Params& p, int l, size_t off) { return (bf16*)(p.ws + OFF_W) + (size_t)l * WL_TOTAL + off; }

DI void prep_mod_job(const Params& p, int j, char* smem) {
  float* sc = (float*)smem;
  const int l = j / 24, nb = j % 24, tid = TIDX;
  for (int idx = tid; idx < 5120; idx += 256) {
    const int m = idx >> 10, k = idx & 1023;
    const float v = (m < 4) ? p.in[I_C][m * 1024 + k] : p.in[I_CCTX][k];
    sc[idx] = siluf_(v);
  }
  __syncthreads();
  const int n = nb * 256 + tid;
  const float* W = p.in[I_ADAW] + (size_t)l * 1024 * 6144 + n;
  float a0 = 0, a1 = 0, a2 = 0, a3 = 0, a4 = 0;
#pragma unroll 8
  for (int k = 0; k < 1024; ++k) {
    const float wv = W[(size_t)k * 6144];
    a0 += sc[k] * wv; a1 += sc[1024 + k] * wv; a2 += sc[2048 + k] * wv; a3 += sc[3072 + k] * wv; a4 += sc[4096 + k] * wv;
  }
  const float bb = p.in[I_ADAB][l * 6144 + n];
  float* M = (float*)(p.ws + OFF_MOD) + (size_t)l * 5 * 6144 + n;
  M[0] = a0 + bb; M[6144] = a1 + bb; M[2 * 6144] = a2 + bb; M[3 * 6144] = a3 + bb; M[4 * 6144] = a4 + bb;
  __syncthreads();
}

DI void prep_s5_job(const Params& p, int j) {
  const int idx = j * 256 + TIDX;
  const int ldg = idx >> 6, pp = idx & 63;
  const float dt = expf(p.in[I_LDT][ldg]);
  const float are = p.in[I_ARE][idx], aim = p.in[I_AIM][idx];
  const float mag = expf(are * dt);
  float sn, cs;
  sincos_cw(aim * dt, sn, cs);
  const float abr = mag * cs, abi = mag * sn;
  const float den = are * are + aim * aim;
  const float fre = ((abr - 1.f) * are + abi * aim) / den;
  const float fim = (abi * are - (abr - 1.f) * aim) / den;
  float* BBR = (float*)(p.ws + OFF_BBR);
  float* BBI = (float*)(p.ws + OFF_BBI);
  for (int hh = 0; hh < 16; ++hh) {
    const float br = p.in[I_BRE][(size_t)idx * 16 + hh], bi = p.in[I_BIM][(size_t)idx * 16 + hh];
    BBR[(size_t)idx * 16 + hh] = fre * br - fim * bi;
    BBI[(size_t)idx * 16 + hh] = fre * bi + fim * br;
  }
  float2* PW = (float2*)(p.ws + OFF_PWR);
  float pr = 1.f, pi = 0.f;
  for (int tau = 0; tau <= 32; ++tau) {
    PW[((size_t)ldg * 33 + tau) * 64 + pp] = make_float2(pr, pi);
    const float nr = pr * abr - pi * abi, ni = pr * abi + pi * abr;
    pr = nr; pi = ni;
  }
}

DI void prep_wt_job(const Params& p, int jj, char* smem) {
  float* tile = (float*)smem;
  const int l = jj / 4016;
  int r = jj % 4016;
  int mat = 0;
  const int cnt[8] = {1376, 64, 128, 64, 256, 1408, 704, 16};
#pragma unroll
  for (int m = 0; m < 8; ++m) {
    if (mat == m && r >= cnt[m]) { r -= cnt[m]; mat = m + 1; }
  }
  const float* src; int K, sld; size_t doff;
  switch (mat) {
    case 0: src = p.in[I_WIN] + (size_t)l * 1024 * DIN; K = 1024; sld = DIN; doff = WL_WIN; break;
    case 1: src = p.in[I_WBA] + (size_t)l * 256 * 1024; K = 256; sld = 1024; doff = WL_BRA; break;
    case 2: src = p.in[I_WBG] + (size_t)l * 512 * 1024; K = 512; sld = 1024; doff = WL_BRG; break;
    case 3: src = p.in[I_WBS] + (size_t)l * 256 * 1024; K = 256; sld = 1024; doff = WL_BRS; break;
    case 4: src = p.in[I_WOUT] + (size_t)l * 1024 * 1024; K = 1024; sld = 1024; doff = WL_WOUT; break;
    case 5: src = p.in[I_UP] + (size_t)l * 1024 * 5632; K = 1024; sld = 5632; doff = WL_UP; break;
    case 6: src = p.in[I_DOWN] + (size_t)l * 2816 * 1024; K = 2816; sld = 1024; doff = WL_DOWN; break;
    default: src = p.in[I_GLUW] + (size_t)l * 256 * 256; K = 256; sld = 256; doff = WL_GLU; break;
  }
  const int kt = K / 64;
  const int n0 = (r / kt) * 64, k0 = (r % kt) * 64;
  const int tid = TIDX;
  {
    const int nn = tid & 63;
    const int np = n0 + nn;
    int col;
    if (mat == 0) {
      if (np < 2048) col = np;
      else if (np < 2304) col = 2080 + (np - 2048);
      else if (np < 2336) col = 2048 + (np - 2304);
      else if (np < 2432) col = -1;
      else col = 2336 + (np - 2432);
    } else if (mat == 5) {
      const int jb = np >> 7, c = np & 127;
      col = (c < 64) ? (jb * 64 + c) : (DFF + jb * 64 + (c - 64));
    } else col = np;
#pragma unroll 4
    for (int kk = tid >> 6; kk < 64; kk += 4) tile[kk * 65 + nn] = (col >= 0) ? src[(size_t)(k0 + kk) * sld + col] : 0.f;
  }
  __syncthreads();
  {
    const int nn = tid >> 2, kq = (tid & 3) * 16;
    bf16* d = wl(p, l, doff) + (size_t)(n0 + nn) * K + k0 + kq;
    u32x4 v0, v1;
#pragma unroll
    for (int e = 0; e < 4; ++e) {
      v0[e] = pack2(tile[(kq + 2 * e) * 65 + nn], tile[(kq + 2 * e + 1) * 65 + nn]);
      v1[e] = pack2(tile[(kq + 8 + 2 * e) * 65 + nn], tile[(kq + 8 + 2 * e + 1) * 65 + nn]);
    }
    *(u32x4*)d = v0;
    *(u32x4*)(d + 8) = v1;
  }
  __syncthreads();
}

template <int MODE>
DI void row_job(const Params& p, int l, int tok) {
  const int lane = TIDX & 63;
  float x[16];
  float* xr = resid_row(p, tok);
  if (MODE == 0) {
    const int b = tok / TT, t = tok - b * TT;
    const float* src = (t < CTXL) ? p.in[I_CTX] + ((size_t)b * CTXL + t) * DM : p.in[I_X] + ((size_t)b * SEQ + (t - CTXL)) * DM;
#pragma unroll
    for (int i = 0; i < 4; ++i) {
      const f32x4 v = *(const f32x4*)(src + lane * 4 + 256 * i);
      x[4 * i] = v[0]; x[4 * i + 1] = v[1]; x[4 * i + 2] = v[2]; x[4 * i + 3] = v[3];
      *(f32x4*)(xr + lane * 4 + 256 * i) = v;
    }
  } else {
    const bf16* yr = (const bf16*)(p.ws + OFF_H) + (size_t)tok * DM;
    const float* gpost = p.in[MODE == 1 ? I_NMPOST : I_NFPOST] + l * DM;
    const float* mg = mod_vec(p, l, tok, MODE == 1 ? 2 : 5);
    float y[16];
    float ss = 0.f;
#pragma unroll
    for (int i = 0; i < 4; ++i) {
      const u32x2 u = *(const u32x2*)(yr + lane * 4 + 256 * i);
      y[4 * i] = bflo(u[0]); y[4 * i + 1] = bfhi(u[0]); y[4 * i + 2] = bflo(u[1]); y[4 * i + 3] = bfhi(u[1]);
#pragma unroll
      for (int e = 0; e < 4; ++e) ss += y[4 * i + e] * y[4 * i + e];
    }
    ss = wave_sum(ss);
    const float rstd = rsqrtf(ss * (1.f / DM) + EPSF);
#pragma unroll
    for (int i = 0; i < 4; ++i) {
      f32x4 v = *(const f32x4*)(xr + lane * 4 + 256 * i);
      const f32x4 g = *(const f32x4*)(gpost + lane * 4 + 256 * i);
      const f32x4 m = *(const f32x4*)(mg + lane * 4 + 256 * i);
#pragma unroll
      for (int e = 0; e < 4; ++e) { v[e] += m[e] * (y[4 * i + e] * rstd * g[e]); x[4 * i + e] = v[e]; }
      *(f32x4*)(xr + lane * 4 + 256 * i) = v;
    }
  }
  if (MODE == 2 && l == NL - 1) return;
  const int ln = (MODE == 2) ? l + 1 : l;
  const float* gpre = p.in[MODE == 1 ? I_NFPRE : I_NMPRE] + ln * DM;
  const float* sh = mod_vec(p, ln, tok, MODE == 1 ? 3 : 0);
  const float* scv = mod_vec(p, ln, tok, MODE == 1 ? 4 : 1);
  float ss = 0.f;
#pragma unroll
  for (int i = 0; i < 16; ++i) ss += x[i] * x[i];
  ss = wave_sum(ss);
  const float rstd = rsqrtf(ss * (1.f / DM) + EPSF);
  bf16* hr = (bf16*)(p.ws + OFF_H) + (size_t)tok * DM;
#pragma unroll
  for (int i = 0; i < 4; ++i) {
    const f32x4 g = *(const f32x4*)(gpre + lane * 4 + 256 * i);
    const f32x4 s1 = *(const f32x4*)(sh + lane * 4 + 256 * i);
    const f32x4 s2 = *(const f32x4*)(scv + lane * 4 + 256 * i);
    float o[4];
#pragma unroll
    for (int e = 0; e < 4; ++e) o[e] = (x[4 * i + e] * rstd * g[e]) * (1.f + s2[e]) + s1[e];
    u32x2 u;
    u[0] = pack2(o[0], o[1]); u[1] = pack2(o[2], o[3]);
    *(u32x2*)(hr + lane * 4 + 256 * i) = u;
  }
}

template <int MODE>
DI void row_phase(const Params& p, int l, int bid, int G) {
  const int wg = bid * 4 + (TIDX >> 6), nw = G * 4;
  for (int tok = wg; tok < NTOK; tok += nw) row_job<MODE>(p, l, tok);
}

DI void ktab_phase(const Params& p, int bid, int G) {
  const float* BBR = (const float*)(p.ws + OFF_BBR);
  const float* BBI = (const float*)(p.ws + OFF_BBI);
  const float2* PW = (const float2*)(p.ws + OFF_PWR);
  float* KT = (float*)(p.ws + OFF_KTAB);
  const int total = NL * 16 * 2 * 32 * 256;
  for (int idx = bid * 256 + TIDX; idx < total; idx += G * 256) {
    const int hp = idx & 15, hh = (idx >> 4) & 15, tau = (idx >> 8) & 31, d = (idx >> 13) & 1, g = (idx >> 14) & 15, l = idx >> 18;
    const int ldg = (l * 2 + d) * 16 + g;
    const float* cre = p.in[I_CRE] + ((size_t)ldg * 16 + hh) * 64;
    const float* cim = p.in[I_CIM] + ((size_t)ldg * 16 + hh) * 64;
    float acc = 0.f;
    for (int pp = 0; pp < 64; ++pp) {
      const float2 pw = PW[((size_t)ldg * 33 + tau) * 64 + pp];
      const float br = BBR[((size_t)ldg * 64 + pp) * 16 + hp], bi = BBI[((size_t)ldg * 64 + pp) * 16 + hp];
      const float zr = pw.x * br - pw.y * bi, zi = pw.x * bi + pw.y * br;
      acc += cre[pp] * zr - cim[pp] * zi;
    }
    KT[idx] = acc;
  }
}

DI void s5mat_phase(const Params& p, int l, int bid, int G) {
  const float* BBR = (const float*)(p.ws + OFF_BBR);
  const float* BBI = (const float*)(p.ws + OFF_BBI);
  const float2* PW = (const float2*)(p.ws + OFF_PWR);
  const float* KT = (const float*)(p.ws + OFF_KTAB);
  bf16* T5 = (bf16*)(p.ws + OFF_T5);
  bf16* E5 = (bf16*)(p.ws + OFF_E5);
  bf16* F5 = (bf16*)(p.ws + OFF_F5);
  const int nT = 16 * 512 * 64, nE = 16 * 512 * 32, nF = 16 * 256 * 64;
  for (int it = bid * 256 + TIDX; it < nT + nE + nF; it += G * 256) {
    float v[8];
    bf16* dst;
    if (it < nT) {
      const int k8 = it & 63, n = (it >> 6) & 511, g = it >> 15;
      const int i = n >> 4, hh = n & 15, j = k8 >> 1, hp0 = (k8 & 1) * 8;
#pragma unroll
      for (int e = 0; e < 8; ++e) {
        const int hp = hp0 + e;
        float a = 0.f;
        if (j <= i) a += KT[((((size_t)l * 16 + g) * 2 + 0) * 32 + (i - j)) * 256 + hh * 16 + hp];
        if (j >= i) a += KT[((((size_t)l * 16 + g) * 2 + 1) * 32 + (j - i)) * 256 + hh * 16 + hp];
        if (i == j && hh == hp) a += p.in[I_S5D][l * 256 + g * 16 + hh];
        v[e] = a;
      }
      dst = T5 + ((size_t)g * 512 + n) * 512 + k8 * 8;
    } else if (it < nT + nE) {
      const int q = it - nT;
      const int k8 = q & 31, n = (q >> 5) & 511, g = q >> 14;
      const int i = n >> 4, hh = n & 15;
      const int k0 = k8 * 8, d = k0 >> 7, ri = (k0 >> 6) & 1, p0 = k0 & 63;
      const int ldg = (l * 2 + d) * 16 + g;
      const int ex = d ? (32 - i) : (i + 1);
#pragma unroll
      for (int e = 0; e < 8; ++e) {
        const int pp = p0 + e;
        const float2 pw = PW[((size_t)ldg * 33 + ex) * 64 + pp];
        const float cr = p.in[I_CRE][((size_t)ldg * 16 + hh) * 64 + pp], ci = p.in[I_CIM][((size_t)ldg * 16 + hh) * 64 + pp];
        const float zr = cr * pw.x - ci * pw.y, zi = cr * pw.y + ci * pw.x;
        v[e] = ri ? -zi : zr;
      }
      dst = E5 + ((size_t)g * 512 + n) * 256 + k0;
    } else {
      const int q = it - nT - nE;
      const int k8 = q & 63, n = (q >> 6) & 255, g = q >> 14;
      const int d = n >> 7, ri = (n >> 6) & 1, pp = n & 63;
      const int j = k8 >> 1, hp0 = (k8 & 1) * 8;
      const int ldg = (l * 2 + d) * 16 + g;
      const int ex = d ? j : (31 - j);
      const float2 pw = PW[((size_t)ldg * 33 + ex) * 64 + pp];
#pragma unroll
      for (int e = 0; e < 8; ++e) {
        const float br = BBR[((size_t)ldg * 64 + pp) * 16 + hp0 + e], bi = BBI[((size_t)ldg * 64 + pp) * 16 + hp0 + e];
        v[e] = ri ? (pw.x * bi + pw.y * br) : (pw.x * br - pw.y * bi);
      }
      dst = F5 + ((size_t)g * 256 + n) * 512 + k8 * 8;
    }
    u32x4 u;
    u[0] = pack2(v[0], v[1]); u[1] = pack2(v[2], v[3]); u[2] = pack2(v[4], v[5]); u[3] = pack2(v[6], v[7]);
    *(u32x4*)dst = u;
  }
}

DI void proj_tile(const Params& p, int l, int mt, int nt, char* smem) {
  const bf16* H = (const bf16*)(p.ws + OFF_H) + (size_t)mt * 128 * DM;
  const bf16* W = wl(p, l, WL_WIN) + (size_t)nt * 128 * DM;
  f32x16 acc[2][2];
  acc_zero(acc);
  gemm_main_s(acc, H, DM, W, DM, DM, smem);
  float* Cs = (float*)smem;
  acc_to_lds(acc, Cs);
  __syncthreads();
  const int tid = TIDX;
  const int tok0 = mt * 128;
  const int b = tok0 / TT, t0 = tok0 - b * TT;
  if (nt <= 2) {
    const int row = tid >> 1, seg = tid & 1;
    float* c = Cs + row * CLD + seg * 64;
    const float* gn = p.in[nt < 2 ? I_QN : I_KN] + l * 64;
    float ss = 0.f;
#pragma unroll 8
    for (int i = 0; i < 64; ++i) ss += c[i] * c[i];
    const float rstd = rsqrtf(ss * (1.f / 64.f) + EPSF);
    const int t = t0 + row;
    const bool lat = t >= CTXL;
    const int s = t - CTXL;
#pragma unroll 1
    for (int ax = 0; ax < 2; ++ax) {
      const float pos = (float)(ax ? (s & 63) : (s >> 6));
#pragma unroll 2
      for (int f = 0; f < 16; ++f) {
        float x1 = c[ax * 32 + f] * rstd * gn[ax * 32 + f];
        float x2 = c[ax * 32 + 16 + f] * rstd * gn[ax * 32 + 16 + f];
        if (lat) {
          const float invf = exp2f(-(float)f * (13.287712379549449f / 16.f));
          float sn, cs;
          sincos_cw(pos * invf, sn, cs);
          const float y1 = x1 * cs - x2 * sn, y2 = x2 * cs + x1 * sn;
          x1 = y1; x2 = y2;
        }
        c[ax * 32 + f] = x1;
        c[ax * 32 + 16 + f] = x2;
      }
    }
    __syncthreads();
    if (nt < 2) store_tile_bf16(Cs, (bf16*)(p.ws + OFF_Q) + (size_t)tok0 * 256 + nt * 128, 256, 128, 0.125f * 1.4426950408889634f);
    else store_tile_bf16(Cs, (bf16*)(p.ws + OFF_K) + (size_t)tok0 * 128, 128, 128, 1.f);
  } else if (nt == 3 || (nt >= 8 && nt <= 11)) {
    for (int c = tid; c < 2048; c += 256) {
      const int col = c & 127, rc = (c >> 7) * 8;
      u32x4 u;
#pragma unroll
      for (int e = 0; e < 4; ++e) u[e] = pack2(Cs[(rc + 2 * e) * CLD + col], Cs[(rc + 2 * e + 1) * CLD + col]);
      bf16* dst;
      if (nt == 3) dst = (bf16*)(p.ws + OFF_VT) + ((size_t)(b * 2 + (col >> 6)) * 64 + (col & 63)) * TT + t0 + rc;
      else dst = (bf16*)(p.ws + OFF_GVT) + ((size_t)(b * 4 + (nt - 8)) * 128 + col) * TT + t0 + rc;
      *(u32x4*)dst = u;
    }
  } else if (nt == 4 || nt == 5) {
    store_tile_bf16(Cs, (bf16*)(p.ws + OFF_GQ) + (size_t)tok0 * 256 + (nt - 4) * 128, 256, 128, 0.125f);
  } else if (nt == 6 || nt == 7) {
    store_tile_bf16(Cs, (bf16*)(p.ws + OFF_GK) + (size_t)tok0 * 256 + (nt - 6) * 128, 256, 128, 1.f);
  } else if (nt >= 12 && nt <= 15) {
    store_tile_bf16(Cs, (bf16*)(p.ws + OFF_GR) + (size_t)tok0 * 512 + (nt - 12) * 128, 512, 128, 1.f);
  } else if (nt == 16 || nt == 17) {
    for (int c = tid; c < 2048; c += 256) {
      const int row = c >> 4, c8 = c & 15;
      const float* s = Cs + row * CLD + c8 * 8;
      u32x4 u;
#pragma unroll
      for (int e = 0; e < 4; ++e) u[e] = pack2(s[2 * e], s[2 * e + 1]);
      const int ch = (nt - 16) * 128 + c8 * 8;
      bf16* dst = (bf16*)(p.ws + OFF_SU) + ((size_t)(b * 16 + (ch >> 4)) * TT + t0 + row) * 16 + (ch & 15);
      *(u32x4*)dst = u;
    }
  } else {
    for (int c = tid; c < 128 * 8; c += 256) {
      const int row = c >> 3, c4 = (c & 7) * 4;
      const float* s = Cs + row * CLD + c4;
      f32x4 v = {s[0], s[1], s[2], s[3]};
      *(f32x4*)((float*)(p.ws + OFF_LOW) + (size_t)(tok0 + row) * 32 + c4) = v;
    }
  }
  __syncthreads();
}

DI void attn_unit(const Params& p, int u, char* smem) {
  bf16* Ks = (bf16*)smem;
  bf16* Vs = (bf16*)(smem + 2 * 64 * LDT * 2);
  int b, head, tok0, nkt;
  if (u < 1024) { b = u >> 8; head = (u >> 6) & 3; tok0 = b * TT + CTXL + (u & 63) * 128; nkt = TT / 64; }
  else { const int v = u - 1024; b = v >> 3; head = (v >> 1) & 3; tok0 = b * TT + (v & 1) * 128; nkt = CTXL / 64; }
  const int kvh = head >> 1;
  const int tid = TIDX, lane = tid & 63, w = tid >> 6, r = lane & 31, h = lane >> 5;
  const bf16* Qp = (const bf16*)(p.ws + OFF_Q) + (size_t)(tok0 + w * 32 + r) * 256 + head * 64 + h * 8;
  s16x8 qf[4];
#pragma unroll
  for (int s = 0; s < 4; ++s) qf[s] = *(const s16x8*)(Qp + s * 16);
  const int lr = tid >> 3, kc = (tid & 7) * 8;
  const bf16* Kg = (const bf16*)(p.ws + OFF_K) + ((size_t)b * TT + lr) * 128 + kvh * 64 + kc;
  const bf16* Vg = (const bf16*)(p.ws + OFF_VT) + ((size_t)(b * 2 + kvh) * 64 + lr) * TT + kc;
  u32x4 rk[2], rv[2];
#pragma unroll
  for (int i = 0; i < 2; ++i) {
    rk[i] = *(const u32x4*)(Kg + (size_t)(32 * i) * 128);
    rv[i] = *(const u32x4*)(Vg + (size_t)(32 * i) * TT);
  }
#pragma unroll
  for (int i = 0; i < 2; ++i) {
    *(u32x4*)(Ks + (lr + 32 * i) * LDT + kc) = rk[i];
    *(u32x4*)(Vs + (lr + 32 * i) * LDT + kc) = rv[i];
  }
  __syncthreads();
  f32x16 oacc[2];
#pragma unroll
  for (int i = 0; i < 16; ++i) { oacc[0][i] = 0.f; oacc[1][i] = 0.f; }
  float mrow = -INFINITY, lrow = 0.f;
  for (int kt = 0; kt < nkt; ++kt) {
    const int buf = kt & 1;
    const bool more = kt + 1 < nkt;
    if (more) {
#pragma unroll
      for (int i = 0; i < 2; ++i) {
        rk[i] = *(const u32x4*)(Kg + (size_t)((kt + 1) * 64 + 32 * i) * 128);
        rv[i] = *(const u32x4*)(Vg + (size_t)(32 * i) * TT + (kt + 1) * 64);
      }
    }
    const bf16* Kb = Ks + buf * 64 * LDT;
    const bf16* Vb = Vs + buf * 64 * LDT;
    f32x16 sacc[2];
#pragma unroll
    for (int i = 0; i < 16; ++i) { sacc[0][i] = 0.f; sacc[1][i] = 0.f; }
#pragma unroll
    for (int s = 0; s < 4; ++s) {
      const s16x8 a0 = *(const s16x8*)(Kb + r * LDT + s * 16 + h * 8);
      const s16x8 a1 = *(const s16x8*)(Kb + (32 + r) * LDT + s * 16 + h * 8);
      sacc[0] = MFMA32(a0, qf[s], sacc[0]);
      sacc[1] = MFMA32(a1, qf[s], sacc[1]);
    }
    float mx = sacc[0][0];
#pragma unroll
    for (int i = 0; i < 16; ++i) { mx = fmaxf(mx, sacc[0][i]); mx = fmaxf(mx, sacc[1][i]); }
    mx = fmaxf(mx, __shfl_xor(mx, 32, 64));
    const float mnew = fmaxf(mrow, mx);
    const float alpha = exp2f(mrow - mnew);
    mrow = mnew;
    float psum = 0.f;
#pragma unroll
    for (int i = 0; i < 16; ++i) {
      sacc[0][i] = exp2f(sacc[0][i] - mnew); psum += sacc[0][i];
      sacc[1][i] = exp2f(sacc[1][i] - mnew); psum += sacc[1][i];
    }
    lrow = lrow * alpha + psum;
#pragma unroll
    for (int i = 0; i < 16; ++i) { oacc[0][i] *= alpha; oacc[1][i] *= alpha; }
#pragma unroll
    for (int kt2 = 0; kt2 < 2; ++kt2)
#pragma unroll
      for (int s2 = 0; s2 < 2; ++s2) {
        u32x4 pu;
#pragma unroll
        for (int e = 0; e < 4; ++e) pu[e] = pack2(sacc[kt2][8 * s2 + 2 * e], sacc[kt2][8 * s2 + 2 * e + 1]);
        const s16x8 pf = __builtin_bit_cast(s16x8, pu);
        const int kb = kt2 * 32 + 16 * s2 + 4 * h;
#pragma unroll
        for (int dt = 0; dt < 2; ++dt) {
          const s16x4 lo = *(const s16x4*)(Vb + (dt * 32 + r) * LDT + kb);
          const s16x4 hi = *(const s16x4*)(Vb + (dt * 32 + r) * LDT + kb + 8);
          const s16x8 a = __builtin_shufflevector(lo, hi, 0, 1, 2, 3, 4, 5, 6, 7);
          oacc[dt] = MFMA32(a, pf, oacc[dt]);
        }
      }
    if (more) {
      bf16* Kw = Ks + (buf ^ 1) * 64 * LDT;
      bf16* Vw = Vs + (buf ^ 1) * 64 * LDT;
#pragma unroll
      for (int i = 0; i < 2; ++i) {
        *(u32x4*)(Kw + (lr + 32 * i) * LDT + kc) = rk[i];
        *(u32x4*)(Vw + (lr + 32 * i) * LDT + kc) = rv[i];
      }
    }
    __syncthreads();
  }
  const float ltot = lrow + __shfl_xor(lrow, 32, 64);
  const float inv = 1.f / ltot;
  bf16* Op = (bf16*)(p.ws + OFF_OATT) + (size_t)(tok0 + w * 32 + r) * 256 + head * 64;
#pragma unroll
  for (int dt = 0; dt < 2; ++dt)
#pragma unroll
    for (int i = 0; i < 16; i += 4) {
      u32x2 uu;
      uu[0] = pack2(oacc[dt][i] * inv, oacc[dt][i + 1] * inv);
      uu[1] = pack2(oacc[dt][i + 2] * inv, oacc[dt][i + 3] * inv);
      *(u32x2*)(Op + dt * 32 + crow(i, h)) = uu;
    }
}

constexpr int GL_LOW = 0, GL_TOT = 4096, GL_DEC = 5120, GL_QIN = 5376, GL_KIN = 14592, GL_KET = 23808, GL_OST = 0,
              GL_VT = 33792, GL_ST = 52224;
static_assert(GL_ST + 128 * LDT * 2 <= SMEM_BYTES, "gla lds");

template <bool WITH_OUT>
DI void gla_unit(const Params& p, int l, int u, char* smem) {
  float* lowt = (float*)(smem + GL_LOW);
  float* tots = (float*)(smem + GL_TOT);
  float* decs = (float*)(smem + GL_DEC);
  bf16* qin = (bf16*)(smem + GL_QIN);
  bf16* kin = (bf16*)(smem + GL_KIN);
  bf16* ket = (bf16*)(smem + GL_KET);
  float* ost = (float*)(smem + GL_OST);
  bf16* vts = (bf16*)(smem + GL_VT);
  bf16* sts = (bf16*)(smem + GL_ST);
  const int tid = TIDX, lane = tid & 63, w = tid >> 6, r = lane & 31, h = lane >> 5;
  int b, hd, gi, dir0, ndir;
  if (WITH_OUT) { gi = u % NG33; hd = (u / NG33) & 3; b = u / (NG33 * 4); dir0 = 1; ndir = 2; }
  else { gi = u % NG33; const int v = u / NG33; dir0 = v & 1; hd = (v >> 1) & 3; b = v >> 3; ndir = 1; }
  const int dk = tid & 63, part = tid >> 6;
  const bf16* GQ = (const bf16*)(p.ws + OFF_GQ);
  const bf16* GK = (const bf16*)(p.ws + OFF_GK);
  const bf16* GVT = (const bf16*)(p.ws + OFF_GVT) + (size_t)(b * 4 + hd) * 128 * TT;
  const float* LOW = (const float*)(p.ws + OFF_LOW);
  for (int dd = 0; dd < ndir; ++dd) {
    const int dir = WITH_OUT ? (dir0 - dd) : dir0;
    float* GSu = (float*)(p.ws + OFF_GS) + ((size_t)((b * 4 + hd) * 2 + dir) * NG33 + gi) * 8192;
    float gwreg[16];
#pragma unroll
    for (int rr = 0; rr < 16; ++rr) gwreg[rr] = p.in[I_GGW][((size_t)(l * 2 + dir) * 16 + rr) * 256 + hd * 64 + dk];
    const float gb = p.in[I_GGB][(l * 2 + dir) * 256 + hd * 64 + dk];
    f32x16 sacc[2];
    if (WITH_OUT) {
#pragma unroll
      for (int dkt = 0; dkt < 2; ++dkt)
#pragma unroll
        for (int i = 0; i < 16; ++i) {
          const float v = GSu[(w * 32 + crow(i, h)) * 64 + dkt * 32 + r];
          sacc[dkt][i] = v;
          sts[(w * 32 + crow(i, h)) * LDT + dkt * 32 + r] = f2bf(v);
        }
    } else {
#pragma unroll
      for (int i = 0; i < 16; ++i) { sacc[0][i] = 0.f; sacc[1][i] = 0.f; }
    }
    float gtot = 0.f;
    for (int cc = 0; cc < 4; ++cc) {
      const int ci = dir ? 3 - cc : cc;
      const int tb = gi * 256 + ci * 64;
      const size_t tokb = (size_t)b * TT + tb;
      {
        const int row = tid >> 2, c4 = (tid & 3) * 4;
        *(f32x4*)(lowt + row * 16 + c4) = *(const f32x4*)(LOW + (tokb + row) * 32 + dir * 16 + c4);
#pragma unroll
        for (int i = 0; i < 4; ++i) {
          const int c = tid + 256 * i, e = c >> 3, k8 = (c & 7) * 8;
          *(u32x4*)(vts + e * LDT + k8) = *(const u32x4*)(GVT + (size_t)e * TT + tb + k8);
        }
      }
      __syncthreads();
      float cum = 0.f;
#pragma unroll 2
      for (int ii = 0; ii < 16; ++ii) {
        const int pos = part * 16 + ii, t = dir ? 63 - pos : pos;
        float z = gb;
#pragma unroll
        for (int rr = 0; rr < 16; ++rr) z += lowt[t * 16 + rr] * gwreg[rr];
        cum += (fminf(z, 0.f) - log1pf(__expf(-fabsf(z)))) * (1.f / 16.f);
      }
      tots[part * 64 + dk] = cum;
      __syncthreads();
      float offs = 0.f, total = 0.f;
#pragma unroll
      for (int pp = 0; pp < 4; ++pp) { const float tv = tots[pp * 64 + dk]; total += tv; if (pp < part) offs += tv; }
      if (part == 0) decs[dk] = __expf(total);
      gtot += total;
      float bq = offs;
#pragma unroll 2
      for (int ii = 0; ii < 16; ++ii) {
        const int pos = part * 16 + ii, t = dir ? 63 - pos : pos;
        float z = gb;
#pragma unroll
        for (int rr = 0; rr < 16; ++rr) z += lowt[t * 16 + rr] * gwreg[rr];
        bq += (fminf(z, 0.f) - log1pf(__expf(-fabsf(z)))) * (1.f / 16.f);
        const float kv = bf2f(GK[(tokb + t) * 256 + hd * 64 + dk]);
        ket[dk * LDT + t] = f2bf(kv * __expf(total - bq));
        if (WITH_OUT) {
          const float qv = bf2f(GQ[(tokb + t) * 256 + hd * 64 + dk]);
          qin[t * LDT + dk] = f2bf(qv * __expf(bq));
          kin[t * LDT + dk] = f2bf(kv * __expf(-bq));
        }
      }
      __syncthreads();
      f32x16 oo[2];
      const int it = w & 1, ep = w >> 1;
      if (WITH_OUT) {
        const int ti = w >> 1, tj = w & 1;
        f32x16 aa;
#pragma unroll
        for (int i = 0; i < 16; ++i) aa[i] = 0.f;
#pragma unroll
        for (int s = 0; s < 4; ++s) {
          const s16x8 A = *(const s16x8*)(qin + (ti * 32 + r) * LDT + s * 16 + h * 8);
          const s16x8 Bv = *(const s16x8*)(kin + (tj * 32 + r) * LDT + s * 16 + h * 8);
          aa = MFMA32(A, Bv, aa);
        }
        __syncthreads();
#pragma unroll
        for (int i = 0; i < 16; ++i) {
          const int qi = ti * 32 + crow(i, h), kj = tj * 32 + r;
          const bool keep = dir ? (kj >= qi) : (kj <= qi);
          kin[qi * LDT + kj] = f2bf(keep ? aa[i] : 0.f);
        }
        __syncthreads();
#pragma unroll
        for (int i = 0; i < 16; ++i) { oo[0][i] = 0.f; oo[1][i] = 0.f; }
#pragma unroll
        for (int s = 0; s < 4; ++s) {
          const s16x8 A1 = *(const s16x8*)(kin + (it * 32 + r) * LDT + s * 16 + h * 8);
          const s16x8 A2 = *(const s16x8*)(qin + (it * 32 + r) * LDT + s * 16 + h * 8);
#pragma unroll
          for (int x = 0; x < 2; ++x) {
            const int et = 2 * ep + x;
            const s16x8 B1 = *(const s16x8*)(vts + (et * 32 + r) * LDT + s * 16 + h * 8);
            const s16x8 B2 = *(const s16x8*)(sts + (et * 32 + r) * LDT + s * 16 + h * 8);
            oo[x] = MFMA32(A1, B1, oo[x]);
            oo[x] = MFMA32(A2, B2, oo[x]);
          }
        }
      }
#pragma unroll
      for (int dkt = 0; dkt < 2; ++dkt) {
        const float dv = decs[dkt * 32 + r];
#pragma unroll
        for (int i = 0; i < 16; ++i) sacc[dkt][i] *= dv;
      }
#pragma unroll
      for (int s = 0; s < 4; ++s) {
        const s16x8 A = *(const s16x8*)(vts + (w * 32 + r) * LDT + s * 16 + h * 8);
#pragma unroll
        for (int dkt = 0; dkt < 2; ++dkt) {
          const s16x8 Bv = *(const s16x8*)(ket + (dkt * 32 + r) * LDT + s * 16 + h * 8);
          sacc[dkt] = MFMA32(A, Bv, sacc[dkt]);
        }
      }
      __syncthreads();
      if (WITH_OUT) {
#pragma unroll
        for (int dkt = 0; dkt < 2; ++dkt)
#pragma unroll
          for (int i = 0; i < 16; ++i) sts[(w * 32 + crow(i, h)) * LDT + dkt * 32 + r] = f2bf(sacc[dkt][i]);
#pragma unroll
        for (int x = 0; x < 2; ++x)
#pragma unroll
          for (int i = 0; i < 16; ++i) ost[(it * 32 + crow(i, h)) * CLD + (2 * ep + x) * 32 + r] = oo[x][i];
        __syncthreads();
        const int row = tid >> 2, qd = tid & 3;
        const size_t tok = tokb + row;
        bf16* og = (bf16*)(p.ws + OFF_OGLA) + tok * 512 + hd * 128 + qd * 32;
        const float* os = ost + row * CLD + qd * 32;
        if (dir == 1) {
#pragma unroll
          for (int i = 0; i < 4; ++i) {
            u32x4 uu;
#pragma unroll
            for (int e = 0; e < 4; ++e) uu[e] = pack2(os[i * 8 + 2 * e], os[i * 8 + 2 * e + 1]);
            *(u32x4*)(og + i * 8) = uu;
          }
        } else {
          float ss = 0.f;
#pragma unroll 1
          for (int i = 0; i < 4; ++i) {
            const u32x4 uu = *(const u32x4*)(og + i * 8);
#pragma unroll
            for (int e = 0; e < 4; ++e) {
              const float a0 = os[i * 8 + 2 * e] + bflo(uu[e]), a1 = os[i * 8 + 2 * e + 1] + bfhi(uu[e]);
              ss += a0 * a0 + a1 * a1;
            }
          }
          ss += __shfl_xor(ss, 1, 64);
          ss += __shfl_xor(ss, 2, 64);
          const float rstd = rsqrtf(ss * (1.f / 128.f) + EPSF);
          const float* gn = p.in[I_GON] + l * 128 + qd * 32;
          const bf16* gr = (const bf16*)(p.ws + OFF_GR) + tok * 512 + hd * 128 + qd * 32;
#pragma unroll 1
          for (int i = 0; i < 4; ++i) {
            const u32x4 uo = *(const u32x4*)(og + i * 8);
            const u32x4 ug = *(const u32x4*)(gr + i * 8);
            u32x4 uu;
#pragma unroll
            for (int e = 0; e < 4; ++e) {
              const float v0 = os[i * 8 + 2 * e] + bflo(uo[e]), v1 = os[i * 8 + 2 * e + 1] + bfhi(uo[e]);
              const float a0 = v0 * rstd * gn[i * 8 + 2 * e] * siluf_(bflo(ug[e]));
              const float a1 = v1 * rstd * gn[i * 8 + 2 * e + 1] * siluf_(bfhi(ug[e]));
              uu[e] = pack2(a0, a1);
            }
            *(u32x4*)(og + i * 8) = uu;
          }
        }
        __syncthreads();
      }
    }
    if (!WITH_OUT) {
#pragma unroll
      for (int dkt = 0; dkt < 2; ++dkt)
#pragma unroll
        for (int i = 0; i < 16; ++i) GSu[(w * 32 + crow(i, h)) * 64 + dkt * 32 + r] = sacc[dkt][i];
      if (part == 0) ((float*)(p.ws + OFF_DECG))[((size_t)((b * 4 + hd) * 2 + dir) * NG33 + gi) * 64 + dk] = __expf(gtot);
    }
    __syncthreads();
  }
}

DI void gla_scan_job(const Params& p, int j) {
  const int idx = j * 256 + TIDX;
  const int seq = idx >> 13, el = idx & 8191, dk = el & 63, dir = seq & 1;
  float* GS = (float*)(p.ws + OFF_GS) + (size_t)seq * NG33 * 8192 + el;
  const float* DG = (const float*)(p.ws + OFF_DECG) + (size_t)seq * NG33 * 64 + dk;
  float s = 0.f;
  for (int st0 = 0; st0 < 33; st0 += 11) {
    float kv[11], dc[11];
#pragma unroll
    for (int q = 0; q < 11; ++q) {
      const int st = st0 + q;
      const int g = (dir == 0 || st == 0) ? st : 33 - st;
      kv[q] = GS[(size_t)g * 8192];
      dc[q] = DG[g * 64];
    }
#pragma unroll
    for (int q = 0; q < 11; ++q) {
      const int st = st0 + q;
      const int g = (dir == 0 || st == 0) ? st : 33 - st;
      GS[(size_t)g * 8192] = s;
      s = dc[q] * s + kv[q];
    }
  }
}

DI void s5_end_tile(const Params& p, int j, char* smem) {
  const int nt = j & 1, mt = (j >> 1) % 9, g = j / 18;
  const bf16* SU = (const bf16*)(p.ws + OFF_SU);
  const bf16* F = (const bf16*)(p.ws + OFF_F5) + ((size_t)g * 256 + nt * 128) * 512;
  f32x16 acc[2][2];
  acc_zero(acc);
  gemm_main(acc,
            [&](int r) -> const bf16* {
              const int m = mt * 128 + r;
              if (m >= MS5) return nullptr;
              const int b = m / NCH, ch = m - b * NCH;
              return SU + ((size_t)(b * 16 + g) * TT + ch * 32) * 16;
            },
            [&](int r) { return F + (size_t)r * 512; }, 512, smem);
  float* Cs = (float*)smem;
  acc_to_lds(acc, Cs);
  __syncthreads();
  float* EN = (float*)(p.ws + OFF_EN);
  for (int c = TIDX; c < 128 * 32; c += 256) {
    const int row = c >> 5, c4 = (c & 31) * 4, m = mt * 128 + row;
    if (m < MS5) {
      const float* s = Cs + row * CLD + c4;
      f32x4 v = {s[0], s[1], s[2], s[3]};
      *(f32x4*)(EN + ((size_t)m * 16 + g) * 256 + nt * 128 + c4) = v;
    }
  }
  __syncthreads();
}

DI void s5_scan_job(const Params& p, int l, int j, char* smem) {
  float2* ends = (float2*)smem;
  const int dir = j & 1, g = (j >> 1) & 15, b = j >> 5;
  const int pp = TIDX & 63, seg = TIDX >> 6;
  const float2 aL = ((const float2*)(p.ws + OFF_PWR))[((size_t)((l * 2 + dir) * 16 + g) * 33 + 32) * 64 + pp];
  const float* EN = (const float*)(p.ws + OFF_EN);
  bf16* SB = (bf16*)(p.ws + OFF_SB);
  float sr = 0.f, si = 0.f;
  for (int q0 = 0; q0 < 66; q0 += 11) {
    float er[11], ei[11];
#pragma unroll
    for (int q = 0; q < 11; ++q) {
      const int pos = seg * 66 + q0 + q;
      const int ch = dir ? (pos < 8 ? 7 - pos : 271 - pos) : pos;
      const float* e = EN + ((size_t)(b * NCH + ch) * 16 + g) * 256 + dir * 128 + pp;
      er[q] = e[0]; ei[q] = e[64];
    }
#pragma unroll
    for (int q = 0; q < 11; ++q) {
      const float nr = aL.x * sr - aL.y * si + er[q], ni = aL.x * si + aL.y * sr + ei[q];
      sr = nr; si = ni;
    }
  }
  ends[seg * 64 + pp] = make_float2(sr, si);
  float pr = 1.f, pi = 0.f;
  for (int q = 0; q < 66; ++q) { const float nr = pr * aL.x - pi * aL.y, ni = pr * aL.y + pi * aL.x; pr = nr; pi = ni; }
  __syncthreads();
  sr = 0.f; si = 0.f;
  for (int k = 0; k < seg; ++k) {
    const float2 e = ends[k * 64 + pp];
    const float nr = pr * sr - pi * si + e.x, ni = pr * si + pi * sr + e.y;
    sr = nr; si = ni;
  }
  for (int q0 = 0; q0 < 66; q0 += 11) {
    float er[11], ei[11];
#pragma unroll
    for (int q = 0; q < 11; ++q) {
      const int pos = seg * 66 + q0 + q;
      const int ch = dir ? (pos < 8 ? 7 - pos : 271 - pos) : pos;
      const float* e = EN + ((size_t)(b * NCH + ch) * 16 + g) * 256 + dir * 128 + pp;
      er[q] = e[0]; ei[q] = e[64];
    }
#pragma unroll
    for (int q = 0; q < 11; ++q) {
      const int pos = seg * 66 + q0 + q;
      const int ch = dir ? (pos < 8 ? 7 - pos : 271 - pos) : pos;
      bf16* sb = SB + ((size_t)(b * NCH + ch) * 16 + g) * 256 + dir * 128 + pp;
      sb[0] = f2bf(sr); sb[64] = f2bf(si);
      const float nr = aL.x * sr - aL.y * si + er[q], ni = aL.x * si + aL.y * sr + ei[q];
      sr = nr; si = ni;
    }
  }
  __syncthreads();
}

DI float gelu_tanh(float x) {
  const float u = 0.7978845608028654f * (x + 0.044715f * x * x * x);
  return 0.5f * x * (1.f + tanhf(u));
}

DI void s5_out_tile(const Params& p, int j, char* smem) {
  const int nt = j & 3, mt = (j >> 2) % 9, g = j / 36;
  const bf16* SU = (const bf16*)(p.ws + OFF_SU);
  const bf16* SB = (const bf16*)(p.ws + OFF_SB);
  const bf16* Tm = (const bf16*)(p.ws + OFF_T5) + ((size_t)g * 512 + nt * 128) * 512;
  const bf16* Em = (const bf16*)(p.ws + OFF_E5) + ((size_t)g * 512 + nt * 128) * 256;
  f32x16 acc[2][2];
  acc_zero(acc);
  gemm_main(acc,
            [&](int r) -> const bf16* {
              const int m = mt * 128 + r;
              if (m >= MS5) return nullptr;
              const int b = m / NCH, ch = m - b * NCH;
              return SU + ((size_t)(b * 16 + g) * TT + ch * 32) * 16;
            },
            [&](int r) { return Tm + (size_t)r * 512; }, 512, smem);
  gemm_main(acc,
            [&](int r) -> const bf16* {
              const int m = mt * 128 + r;
              if (m >= MS5) return nullptr;
              return SB + ((size_t)m * 16 + g) * 256;
            },
            [&](int r) { return Em + (size_t)r * 256; }, 256, smem);
  float* Cs = (float*)smem;
  acc_to_lds(acc, Cs);
  __syncthreads();
  bf16* Y5 = (bf16*)(p.ws + OFF_Y5);
  for (int c = TIDX; c < 2048; c += 256) {
    const int row = c >> 4, c8 = c & 15, m = mt * 128 + row;
    if (m < MS5) {
      const int b = m / NCH, ch = m - b * NCH;
      const int n = nt * 128 + c8 * 8, i = n >> 4, hh = n & 15;
      const float* s = Cs + row * CLD + c8 * 8;
      u32x4 u;
#pragma unroll
      for (int e = 0; e < 4; ++e) u[e] = pack2(gelu_tanh(s[2 * e]), gelu_tanh(s[2 * e + 1]));
      *(u32x4*)(Y5 + ((size_t)b * TT + ch * 32 + i) * 256 + g * 16 + hh) = u;
    }
  }
  __syncthreads();
}

DI void glu_tile(const Params& p, int l, int j, char* smem) {
  const int nt = j & 1, mt = j >> 1;
  const bf16* Y5 = (const bf16*)(p.ws + OFF_Y5) + (size_t)mt * 128 * 256;
  const bf16* W = wl(p, l, WL_GLU) + (size_t)nt * 128 * 256;
  f32x16 acc[2][2];
  acc_zero(acc);
  gemm_main_s(acc, Y5, 256, W, 256, 256, smem);
  float* Cs = (float*)smem;
  acc_to_lds(acc, Cs);
  __syncthreads();
  const float* gb = p.in[I_GLUB] + l * 256 + nt * 128;
  bf16* O = (bf16*)(p.ws + OFF_OS5) + (size_t)mt * 128 * 256 + nt * 128;
  for (int c = TIDX; c < 2048; c += 256) {
    const int row = c >> 4, cc = (c & 15) * 8;
    const float* s = Cs + row * CLD + cc;
    const u32x4 yu = *(const u32x4*)(Y5 + (size_t)row * 256 + nt * 128 + cc);
    u32x4 u;
#pragma unroll
    for (int e = 0; e < 4; ++e) {
      const float y0 = bflo(yu[e]), y1 = bfhi(yu[e]);
      u[e] = pack2(y0 * sigmoidf_(s[2 * e] + gb[cc + 2 * e]), y1 * sigmoidf_(s[2 * e + 1] + gb[cc + 2 * e + 1]));
    }
    *(u32x4*)(O + (size_t)row * 256 + cc) = u;
  }
  __syncthreads();
}

DI void merge_tile(const Params& p, int l, int j, char* smem) {
  const int nt = j & 7, mt = j >> 3;
  const bf16* H = (const bf16*)(p.ws + OFF_H) + (size_t)mt * 128 * DM;
  unsigned am[2][2][8];
#pragma unroll
  for (int a = 0; a < 2; ++a)
#pragma unroll
    for (int bq = 0; bq < 2; ++bq)
#pragma unroll
      for (int i = 0; i < 8; ++i) am[a][bq][i] = 0u;
#pragma unroll 1
  for (int x = 0; x < 3; ++x) {
    const bf16* Wg = wl(p, l, WL_WIN) + ((size_t)2432 + x * 1024 + nt * 128) * DM;
    unsigned sg[2][2][8];
    {
      f32x16 acc[2][2];
      acc_zero(acc);
      gemm_main_s(acc, H, DM, Wg, DM, DM, smem);
#pragma unroll
      for (int a = 0; a < 2; ++a)
#pragma unroll
        for (int bq = 0; bq < 2; ++bq)
#pragma unroll
          for (int i = 0; i < 8; ++i) sg[a][bq][i] = pack2(sigmoidf_(acc[a][bq][2 * i]), sigmoidf_(acc[a][bq][2 * i + 1]));
    }
    const bf16* A; const bf16* Wb; int K;
    if (x == 0) { A = (const bf16*)(p.ws + OFF_OATT) + (size_t)mt * 128 * 256; Wb = wl(p, l, WL_BRA) + (size_t)nt * 128 * 256; K = 256; }
    else if (x == 1) { A = (const bf16*)(p.ws + OFF_OGLA) + (size_t)mt * 128 * 512; Wb = wl(p, l, WL_BRG) + (size_t)nt * 128 * 512; K = 512; }
    else { A = (const bf16*)(p.ws + OFF_OS5) + (size_t)mt * 128 * 256; Wb = wl(p, l, WL_BRS) + (size_t)nt * 128 * 256; K = 256; }
#pragma unroll
    for (int hf = 0; hf < 2; ++hf) {
      f32x16 a2[2];
#pragma unroll
      for (int i = 0; i < 16; ++i) { a2[0][i] = 0.f; a2[1][i] = 0.f; }
      gemm_main_half(a2, A, K, Wb, K, K, hf, smem);
#pragma unroll
      for (int a = 0; a < 2; ++a)
#pragma unroll
        for (int i = 0; i < 8; ++i) {
          const float v0 = bflo(am[a][hf][i]) + bflo(sg[a][hf][i]) * a2[a][2 * i];
          const float v1 = bfhi(am[a][hf][i]) + bfhi(sg[a][hf][i]) * a2[a][2 * i + 1];
          am[a][hf][i] = pack2(v0, v1);
        }
    }
  }
  f32x16 accm[2][2];
#pragma unroll
  for (int a = 0; a < 2; ++a)
#pragma unroll
    for (int bq = 0; bq < 2; ++bq)
#pragma unroll
      for (int i = 0; i < 8; ++i) { accm[a][bq][2 * i] = bflo(am[a][bq][i]); accm[a][bq][2 * i + 1] = bfhi(am[a][bq][i]); }
  float* Cs = (float*)smem;
  acc_to_lds(accm, Cs);
  __syncthreads();
  store_tile_bf16(Cs, (bf16*)(p.ws + OFF_MG) + (size_t)mt * 128 * DM + nt * 128, DM, 128, 1.f);
  __syncthreads();
}

DI void plain_tile(const bf16* A, int K, const bf16* W, bf16* dst, int ldd, char* smem) {
  f32x16 acc[2][2];
  acc_zero(acc);
  gemm_main_s(acc, A, K, W, K, K, smem);
  float* Cs = (float*)smem;
  acc_to_lds(acc, Cs);
  __syncthreads();
  store_tile_bf16(Cs, dst, ldd, 128, 1.f);
  __syncthreads();
}

DI void up_tile(const Params& p, int l, int j, char* smem) {
  const int jn = j % 44, mtile = j / 44;
  const int b = mtile / 69, rr0 = mtile % 69;
  int seqbase, len, ti;
  if (rr0 < 3) { seqbase = b * TT; len = CTXL; ti = rr0; }
  else { seqbase = b * TT + CTXL; len = SEQ; ti = rr0 - 3; }
  const int pos0 = ti * 126 - 1;
  const bf16* H = (const bf16*)(p.ws + OFF_H);
  const bf16* W = wl(p, l, WL_UP) + (size_t)jn * 128 * DM;
  f32x16 acc[2][2];
  acc_zero(acc);
  gemm_main(acc,
            [&](int r) -> const bf16* {
              const int pos = pos0 + r;
              return (pos >= 0 && pos < len) ? H + (size_t)(seqbase + pos) * DM : nullptr;
            },
            [&](int r) { return W + (size_t)r * DM; }, DM, smem);
  float* Cs = (float*)smem;
  acc_to_lds(acc, Cs);
  __syncthreads();
  const float* cw = p.in[I_CW] + (size_t)l * 3 * 2 * DFF;
  const float* cb = p.in[I_CB] + (size_t)l * 2 * DFF;
  bf16* G = (bf16*)(p.ws + OFF_G);
  for (int idx = TIDX; idx < 126 * 32; idx += 256) {
    const int rr = 1 + (idx >> 5), c = (idx & 31) * 2;
    const int pos = pos0 + rr;
    if (pos < len) {
      float gv[2];
#pragma unroll
      for (int e = 0; e < 2; ++e) {
        const int ca = jn * 64 + c + e, cv = DFF + ca;
        const float a = cw[ca] * Cs[(rr - 1) * CLD + c + e] + cw[2 * DFF + ca] * Cs[rr * CLD + c + e] +
                        cw[4 * DFF + ca] * Cs[(rr + 1) * CLD + c + e] + cb[ca];
        const float v = cw[cv] * Cs[(rr - 1) * CLD + 64 + c + e] + cw[2 * DFF + cv] * Cs[rr * CLD + 64 + c + e] +
                        cw[4 * DFF + cv] * Cs[(rr + 1) * CLD + 64 + c + e] + cb[cv];
        gv[e] = siluf_(a) * v;
      }
      *(unsigned*)(G + (size_t)(seqbase + pos) * DFF + jn * 64 + c) = pack2(gv[0], gv[1]);
    }
  }
  __syncthreads();
}

enum { PH_PREP = 0, PH_ROW0, PH_PROJ, PH_MIX1, PH_SCAN, PH_MIX2, PH_GLU, PH_MERGE, PH_WOUT, PH_ROW1, PH_UP, PH_DOWN, PH_ROW2 };
constexpr int N_PHASES = 2 + 11 * NL;

DI void run_phase(const Params& p, int ph, int l, char* smem) {
  const int bid = blockIdx.x;
#ifdef HALFMASK
  const int G = ((HALFMASK >> ph) & 1) ? 256 : gridDim.x;
  if (bid >= G) return;
#else
  const int G = gridDim.x;
#endif
#ifdef PHMASK
  if (!((PHMASK >> ph) & 1)) return;
#endif
  switch (ph) {
    case PH_PREP:
      for (int j = bid; j < 128 + 16064; j += G) {
        if (j < 96) prep_mod_job(p, j, smem);
        else if (j < 128) prep_s5_job(p, j - 96);
        else prep_wt_job(p, j - 128, smem);
      }
      break;
    case PH_ROW0:
      row_phase<0>(p, 0, bid, G);
      ktab_phase(p, bid, G);
      break;
    case PH_PROJ:
#ifdef EXP_A
      if (bid < 256) for (int j = bid; j < 264 * 19; j += 256) proj_tile(p, l, j / 19, j % 19, smem);
      s5mat_phase(p, l, bid, G);
#elif defined(EXP_C)
      if (bid < 256) for (int j = bid; j < 264 * 19; j += 256) { if ((EXP_C >> (j % 19)) & 1) proj_tile(p, l, j / 19, j % 19, smem); }
      for (int j = bid; j < 264 * 19; j += G) { if (!((EXP_C >> (j % 19)) & 1)) proj_tile(p, l, j / 19, j % 19, smem); }
      s5mat_phase(p, l, bid, G);
#elif defined(EXP_B)
      for (int j = bid; j < 264 * 19; j += G) proj_tile(p, l, j / 19, j % 19, smem);
      if (bid < 256) s5mat_phase(p, l, bid, 256);
#else
      for (int j = bid; j < 264 * 19; j += G) proj_tile(p, l, j / 19, j % 19, smem);
      s5mat_phase(p, l, bid, G);
#endif
      break;
    case PH_MIX1:
      for (int j = bid; j < 1056 + 1056 + 288; j += G) {
        if (j < 1056) attn_unit(p, j, smem);
        else if (j < 2112) gla_unit<false>(p, l, j - 1056, smem);
        else s5_end_tile(p, j - 2112, smem);
      }
      break;
    case PH_SCAN:
      for (int j = bid; j < 1024 + 128; j += G) {
        if (j < 1024) gla_scan_job(p, j);
        else s5_scan_job(p, l, j - 1024, smem);
      }
      break;
    case PH_MIX2:
      for (int j = bid; j < 528 + 576; j += G) {
        if (j < 528) gla_unit<true>(p, l, j, smem);
        else s5_out_tile(p, j - 528, smem);
      }
      break;
    case PH_GLU:
      for (int j = bid; j < 528; j += G) glu_tile(p, l, j, smem);
      break;
    case PH_MERGE:
      for (int j = bid; j < 264 * 8; j += G) merge_tile(p, l, j, smem);
      break;
    case PH_WOUT:
      for (int j = bid; j < 264 * 8; j += G) {
        const int nt = j & 7, mt = j >> 3;
        plain_tile((const bf16*)(p.ws + OFF_MG) + (size_t)mt * 128 * DM, DM, wl(p, l, WL_WOUT) + (size_t)nt * 128 * DM,
                   (bf16*)(p.ws + OFF_H) + (size_t)mt * 128 * DM + nt * 128, DM, smem);
      }
      break;
    case PH_ROW1: row_phase<1>(p, l, bid, G); break;
    case PH_UP:
      for (int j = bid; j < 276 * 44; j += G) up_tile(p, l, j, smem);
      break;
    case PH_DOWN:
      for (int j = bid; j < 264 * 8; j += G) {
        const int nt = j & 7, mt = j >> 3;
        plain_tile((const bf16*)(p.ws + OFF_G) + (size_t)mt * 128 * DFF, DFF, wl(p, l, WL_DOWN) + (size_t)nt * 128 * DFF,
                   (bf16*)(p.ws + OFF_H) + (size_t)mt * 128 * DM + nt * 128, DM, smem);
      }
      break;
    case PH_ROW2: row_phase<2>(p, l, bid, G); break;
  }
}

DI void grid_barrier(unsigned* bar, unsigned& gen) {
  asm volatile("s_waitcnt vmcnt(0)" ::: "memory");
  __syncthreads();
  gen += 1;
  if (threadIdx.x == 0) {
    __builtin_amdgcn_fence(__ATOMIC_RELEASE, "agent");
    asm volatile("s_waitcnt vmcnt(0)" ::: "memory");
    const unsigned target = gen * gridDim.x;
    __hip_atomic_fetch_add(bar, 1u, __ATOMIC_RELAXED, __HIP_MEMORY_SCOPE_AGENT);
    while (__hip_atomic_load(bar, __ATOMIC_RELAXED, __HIP_MEMORY_SCOPE_AGENT) < target) __builtin_amdgcn_s_sleep(2);
  }
  __syncthreads();
  __builtin_amdgcn_fence(__ATOMIC_ACQUIRE, "agent");
  asm volatile("s_waitcnt vmcnt(0)" ::: "memory");
}

__global__ void __launch_bounds__(256, 2) hybrid_fwd(Params p, int ph_lo, int ph_hi) {
  extern __shared__ __attribute__((aligned(16))) char smem[];
  unsigned* bar = (unsigned*)(p.ws + OFF_BAR);
  unsigned gen = 0;
  if (ph_hi - ph_lo > 1) cg::this_grid().sync();
  int i = 0;
#define STEP(PH, L)                                      \
  {                                                      \
    if (i >= ph_lo && i < ph_hi) {                       \
      Params q;                                          \
      q.ws = p.ws; q.out = p.out;                        \
      asm volatile("" : "+s"(q.ws), "+s"(q.out));        \
      _Pragma("unroll") for (int k = 0; k < 34; ++k) { q.in[k] = p.in[k]; asm volatile("" : "+s"(q.in[k])); } \
      run_phase(q, PH, L, smem);                         \
      if ((DUPMASK >> (PH)) & 1) { grid_barrier(bar, gen); run_phase(q, PH, L, smem); } \
      if (i + 1 < ph_hi) grid_barrier(bar, gen);         \
    }                                                    \
    ++i;                                                 \
  }
  STEP(PH_PREP, 0)
  STEP(PH_ROW0, 0)
#pragma unroll 1
  for (int l = 0; l < NL; ++l) {
    STEP(PH_PROJ, l)
    STEP(PH_MIX1, l)
    STEP(PH_SCAN, l)
    STEP(PH_MIX2, l)
    STEP(PH_GLU, l)
    STEP(PH_MERGE, l)
    STEP(PH_WOUT, l)
    STEP(PH_ROW1, l)
    STEP(PH_UP, l)
    STEP(PH_DOWN, l)
    STEP(PH_ROW2, l)
  }
#undef STEP
}

extern "C" void kernel_launch(void* const* d_in, const int* in_sizes, int n_in, void* d_out, int out_size, void* d_ws, size_t ws_size,
                              hipStream_t stream) {
  static int grid_blocks = 0;
  if (!grid_blocks) {
    int dev = 0, cus = 0, per_cu = 0;
    hipGetDevice(&dev);
    hipDeviceGetAttribute(&cus, hipDeviceAttributeMultiprocessorCount, dev);
    hipFuncSetAttribute((const void*)hybrid_fwd, hipFuncAttributeMaxDynamicSharedMemorySize, SMEM_BYTES);
    hipOccupancyMaxActiveBlocksPerMultiprocessor(&per_cu, hybrid_fwd, 256, SMEM_BYTES);
    if (per_cu < 1) per_cu = 1;
    if (per_cu > 2) per_cu = 2;
    grid_blocks = cus * per_cu;
    if (ws_size < OFF_END + 256) fprintf(stderr, "workspace too small: %zu < %zu\n", ws_size, (size_t)OFF_END);
  }
  Params p{};
  for (int i = 0; i < 34; ++i) p.in[i] = (const float*)d_in[i];
  p.out = (float*)d_out;
  p.ws = (char*)d_ws;
#if ONE_LAUNCH
  hipMemsetAsync((char*)d_ws + OFF_BAR, 0, 256, stream);
  int lo = 0, hi = N_PHASES;
  void* args[] = {&p, &lo, &hi};
  hipError_t e = hipLaunchCooperativeKernel((void*)hybrid_fwd, dim3(grid_blocks), dim3(256), args, SMEM_BYTES, stream);
  if (e != hipSuccess) fprintf(stderr, "cooperative launch failed: %s (grid %d)\n", hipGetErrorString(e), grid_blocks);
#else
  for (int i = 0; i < N_PHASES; ++i) hipLaunchKernelGGL(hybrid_fwd, dim3(grid_blocks), dim3(256), SMEM_BYTES, stream, p, i, i + 1);
#endif
}
```

```cpp
#include <hip/hip_runtime.h>
#include <hip/hip_cooperative_groups.h>
#include <stdint.h>
#include <cstdio>
namespace cg = cooperative_groups;

#define EXP_A 1
#ifndef DUPMASK
#define DUPMASK 0
#endif
#ifndef ONE_LAUNCH
#define ONE_LAUNCH 1
#endif

typedef unsigned short bf16;
typedef __attribute__((ext_vector_type(8))) short s16x8;
typedef __attribute__((ext_vector_type(4))) short s16x4;
typedef __attribute__((ext_vector_type(16))) float f32x16;
typedef __attribute__((ext_vector_type(4))) float f32x4;
typedef __attribute__((ext_vector_type(2))) float f32x2;
typedef __attribute__((ext_vector_type(4))) unsigned u32x4;
typedef __attribute__((ext_vector_type(2))) unsigned u32x2;
typedef __attribute__((ext_vector_type(2))) __bf16 bf16x2_t;

#define DI __device__ __forceinline__
#define MFMA32(a, b, c) __builtin_amdgcn_mfma_f32_32x32x16_bf16((a), (b), (c), 0, 0, 0)

DI int tidx_opaque() { int t = threadIdx.x; asm volatile("" : "+v"(t)); return t; }
#define TIDX tidx_opaque()
DI bf16 f2bf(float x) { return __builtin_bit_cast(unsigned short, (__bf16)x); }
DI float bf2f(bf16 v) { return __uint_as_float(((unsigned)v) << 16); }
DI unsigned pack2(float a, float b) {
  f32x2 v = {a, b};
  return __builtin_bit_cast(unsigned, __builtin_convertvector(v, bf16x2_t));
}
DI float bflo(unsigned u) { return __uint_as_float(u << 16); }
DI float bfhi(unsigned u) { return __uint_as_float(u & 0xffff0000u); }
typedef const __attribute__((address_space(1))) u32x4* gptr16;
DI u32x4 ldg16(const void* q) { return *(gptr16)(uintptr_t)q; }
#define SCHED_FENCE() __builtin_amdgcn_sched_barrier(0)
DI int crow(int i, int h) { return (i & 3) + 8 * (i >> 2) + 4 * h; }
DI void sincos_cw(float x, float& sn, float& cs) {
  const float k = rintf(x * 0.63661977236758134f);
  float r = fmaf(-k, 1.57079637050628662109375f, x);
  r = fmaf(-k, -4.371139000186241e-08f, r);
  const int q = ((int)k) & 3;
  const float r2 = r * r;
  const float sp = r + r * r2 * (-1.6666667163e-01f + r2 * (8.3333337680e-03f + r2 * (-1.9841270114e-04f + r2 * 2.7557314297e-06f)));
  const float cp = 1.f + r2 * (-0.5f + r2 * (4.1666667908e-02f + r2 * (-1.3888889225e-03f + r2 * (2.4801587642e-05f - r2 * 2.7557314297e-07f))));
  sn = (q == 0) ? sp : (q == 1) ? cp : (q == 2) ? -sp : -cp;
  cs = (q == 0) ? cp : (q == 1) ? -sp : (q == 2) ? -cp : sp;
}
DI float sigmoidf_(float x) { return 1.f / (1.f + __expf(-x)); }
DI float siluf_(float x) { return x / (1.f + __expf(-x)); }

constexpr int DM = 1024, NB = 4, SEQ = 8192, CTXL = 256, TT = SEQ + CTXL, NTOK = NB * TT, NL = 4;
constexpr int DFF = 2816, DIN = 5408;
constexpr float EPSF = 1e-6f;
constexpr int NG33 = 33;
constexpr int NCH = 264;
constexpr int MS5 = NB * NCH;

constexpr size_t SZ_H = (size_t)NTOK * 1024 * 2;
constexpr size_t OFF_H = 0;
constexpr size_t OFF_P = OFF_H + SZ_H;
constexpr size_t OFF_Q = OFF_P;
constexpr size_t OFF_K = OFF_Q + (size_t)NTOK * 256 * 2;
constexpr size_t OFF_VT = OFF_K + (size_t)NTOK * 128 * 2;
constexpr size_t OFF_GQ = OFF_VT + (size_t)NTOK * 128 * 2;
constexpr size_t OFF_GK = OFF_GQ + (size_t)NTOK * 256 * 2;
constexpr size_t OFF_GVT = OFF_GK + (size_t)NTOK * 256 * 2;
constexpr size_t OFF_GR = OFF_GVT + (size_t)NTOK * 512 * 2;
constexpr size_t OFF_SU = OFF_GR + (size_t)NTOK * 512 * 2;
constexpr size_t OFF_LOW = OFF_SU + (size_t)NTOK * 256 * 2;
constexpr size_t OFF_O = OFF_LOW + (size_t)NTOK * 32 * 4;
constexpr size_t OFF_OATT = OFF_O;
constexpr size_t OFF_OGLA = OFF_OATT + (size_t)NTOK * 256 * 2;
constexpr size_t OFF_Y5 = OFF_OGLA + (size_t)NTOK * 512 * 2;
constexpr size_t OFF_EN = OFF_Y5;
constexpr size_t OFF_OS5 = OFF_Y5 + (size_t)NTOK * 256 * 2;
constexpr size_t OFF_M = OFF_OS5 + (size_t)NTOK * 256 * 2;
constexpr size_t OFF_MG = OFF_M;
constexpr size_t OFF_GS = OFF_M;
constexpr size_t OFF_DECG = OFF_GS + (size_t)32 * 33 * 8192 * 4;
constexpr size_t OFF_SB = OFF_DECG + (size_t)32 * 33 * 64 * 4;
constexpr size_t OFF_T5 = OFF_SB + (size_t)MS5 * 16 * 256 * 2;
constexpr size_t OFF_E5 = OFF_T5 + (size_t)16 * 512 * 512 * 2;
constexpr size_t OFF_F5 = OFF_E5 + (size_t)16 * 512 * 256 * 2;
constexpr size_t OFF_MEND = OFF_F5 + (size_t)16 * 256 * 512 * 2;
static_assert(OFF_MEND <= OFF_M + SZ_H, "mixer scratch overflows merged area");
constexpr size_t OFF_W = OFF_M + SZ_H;
constexpr size_t WL_WIN = 0, WL_BRA = WL_WIN + (size_t)5504 * 1024, WL_BRG = WL_BRA + 1024 * 256, WL_BRS = WL_BRG + 1024 * 512,
                 WL_WOUT = WL_BRS + 1024 * 256, WL_UP = WL_WOUT + 1024 * 1024, WL_DOWN = WL_UP + (size_t)5632 * 1024,
                 WL_GLU = WL_DOWN + (size_t)1024 * 2816, WL_TOTAL = WL_GLU + 256 * 256;
constexpr size_t OFF_XC = OFF_W + WL_TOTAL * 2 * NL;
constexpr size_t OFF_MOD = OFF_XC + (size_t)NB * CTXL * 1024 * 4;
constexpr size_t OFF_BBR = OFF_MOD + (size_t)NL * 5 * 6144 * 4;
constexpr size_t OFF_BBI = OFF_BBR + (size_t)NL * 2 * 16 * 64 * 16 * 4;
constexpr size_t OFF_PWR = OFF_BBI + (size_t)NL * 2 * 16 * 64 * 16 * 4;
constexpr size_t OFF_KTAB = OFF_PWR + (size_t)NL * 2 * 16 * 33 * 64 * 8;
constexpr size_t OFF_END = OFF_KTAB + (size_t)NL * 16 * 2 * 32 * 256 * 4;
constexpr size_t OFF_BAR = OFF_END;
constexpr size_t OFF_G = OFF_P;
static_assert((size_t)NTOK * DFF * 2 <= OFF_M - OFF_P, "G overflows");

constexpr int SMEM_BYTES = 73728;

struct Params {
  const float* in[34];
  float* out;
  char* ws;
};

enum { I_X = 0, I_C, I_CTX, I_CCTX, I_ADAW, I_ADAB, I_NMPRE, I_NMPOST, I_NFPRE, I_NFPOST, I_WIN, I_QN, I_KN, I_GGW, I_GGB, I_GON,
       I_ARE, I_AIM, I_LDT, I_BRE, I_BIM, I_CRE, I_CIM, I_S5D, I_GLUW, I_GLUB, I_WBA, I_WBG, I_WBS, I_WOUT, I_UP, I_CW, I_CB, I_DOWN };

constexpr int LDT = 72;
constexpr int CLD = 132;

template <class FA, class FB>
DI void gemm_main(f32x16 (&acc)[2][2], FA fa, FB fb, int K, char* smem) {
  bf16* As = (bf16*)smem;
  bf16* Bs = (bf16*)(smem + 2 * 128 * LDT * 2);
  const int tid = TIDX, lane = tid & 63, w = tid >> 6, wm = w >> 1, wn = w & 1;
  const int r = lane & 31, h = lane >> 5;
  const int lr = tid >> 3, kc = (tid & 7) * 8;
  const bf16* ap[4];
  const bf16* bp[4];
#pragma unroll
  for (int i = 0; i < 4; ++i) {
    const bf16* a = fa(lr + 32 * i);
    const bf16* b = fb(lr + 32 * i);
    ap[i] = a ? a + kc : nullptr;
    bp[i] = b ? b + kc : nullptr;
  }
  u32x4 ra[4], rb[4];
  const u32x4 z4 = {0u, 0u, 0u, 0u};
#pragma unroll
  for (int i = 0; i < 4; ++i) {
    ra[i] = ap[i] ? ldg16(ap[i]) : z4;
    rb[i] = bp[i] ? ldg16(bp[i]) : z4;
  }
#pragma unroll
  for (int i = 0; i < 4; ++i) {
    *(u32x4*)(As + (lr + 32 * i) * LDT + kc) = ra[i];
    *(u32x4*)(Bs + (lr + 32 * i) * LDT + kc) = rb[i];
  }
  __syncthreads();
  const int nk = K / 64;
  for (int kt = 0; kt < nk; ++kt) {
    const int buf = kt & 1;
    const bool more = (kt + 1 < nk);
    if (more) {
      const int k0 = (kt + 1) * 64;
#pragma unroll
      for (int i = 0; i < 4; ++i) {
        ra[i] = ap[i] ? ldg16(ap[i] + k0) : z4;
        rb[i] = bp[i] ? ldg16(bp[i] + k0) : z4;
      }
    }
    SCHED_FENCE();
    const bf16* Ab = As + buf * 128 * LDT + (wm * 64 + r) * LDT + h * 8;
    const bf16* Bb = Bs + buf * 128 * LDT + (wn * 64 + r) * LDT + h * 8;
#pragma unroll
    for (int s = 0; s < 4; ++s) {
      s16x8 a0 = *(const s16x8*)(Ab + s * 16);
      s16x8 a1 = *(const s16x8*)(Ab + 32 * LDT + s * 16);
      s16x8 b0 = *(const s16x8*)(Bb + s * 16);
      s16x8 b1 = *(const s16x8*)(Bb + 32 * LDT + s * 16);
      acc[0][0] = MFMA32(a0, b0, acc[0][0]);
      acc[0][1] = MFMA32(a0, b1, acc[0][1]);
      acc[1][0] = MFMA32(a1, b0, acc[1][0]);
      acc[1][1] = MFMA32(a1, b1, acc[1][1]);
    }
    SCHED_FENCE();
    if (more) {
      bf16* Aw = As + (buf ^ 1) * 128 * LDT;
      bf16* Bw = Bs + (buf ^ 1) * 128 * LDT;
#pragma unroll
      for (int i = 0; i < 4; ++i) {
        *(u32x4*)(Aw + (lr + 32 * i) * LDT + kc) = ra[i];
        *(u32x4*)(Bw + (lr + 32 * i) * LDT + kc) = rb[i];
      }
    }
    __syncthreads();
  }
}

DI void gemm_main_s(f32x16 (&acc)[2][2], const bf16* A, int lda, const bf16* B, int ldb, int K, char* smem) {
  bf16* As = (bf16*)smem;
  bf16* Bs = (bf16*)(smem + 2 * 128 * LDT * 2);
  const int tid = TIDX, lane = tid & 63, w = tid >> 6, wm = w >> 1, wn = w & 1;
  const int r = lane & 31, h = lane >> 5;
  const int lr = tid >> 3, kc = (tid & 7) * 8;
  const bf16* ap = A + (size_t)lr * lda + kc;
  const bf16* bp = B + (size_t)lr * ldb + kc;
  const size_t sa = (size_t)32 * lda, sb = (size_t)32 * ldb;
  u32x4 ra[4], rb[4];
#pragma unroll
  for (int i = 0; i < 4; ++i) {
    ra[i] = ldg16(ap + i * sa);
    rb[i] = ldg16(bp + i * sb);
  }
#pragma unroll
  for (int i = 0; i < 4; ++i) {
    *(u32x4*)(As + (lr + 32 * i) * LDT + kc) = ra[i];
    *(u32x4*)(Bs + (lr + 32 * i) * LDT + kc) = rb[i];
  }
  __syncthreads();
  const int nk = K / 64;
  for (int kt = 0; kt < nk; ++kt) {
    const int buf = kt & 1;
    const bool more = (kt + 1 < nk);
    if (more) {
      ap += 64; bp += 64;
#pragma unroll
      for (int i = 0; i < 4; ++i) {
        ra[i] = ldg16(ap + i * sa);
        rb[i] = ldg16(bp + i * sb);
      }
    }
    SCHED_FENCE();
    const bf16* Ab = As + buf * 128 * LDT + (wm * 64 + r) * LDT + h * 8;
    const bf16* Bb = Bs + buf * 128 * LDT + (wn * 64 + r) * LDT + h * 8;
#pragma unroll
    for (int s = 0; s < 4; ++s) {
      s16x8 a0 = *(const s16x8*)(Ab + s * 16);
      s16x8 a1 = *(const s16x8*)(Ab + 32 * LDT + s * 16);
      s16x8 b0 = *(const s16x8*)(Bb + s * 16);
      s16x8 b1 = *(const s16x8*)(Bb + 32 * LDT + s * 16);
      acc[0][0] = MFMA32(a0, b0, acc[0][0]);
      acc[0][1] = MFMA32(a0, b1, acc[0][1]);
      acc[1][0] = MFMA32(a1, b0, acc[1][0]);
      acc[1][1] = MFMA32(a1, b1, acc[1][1]);
    }
    SCHED_FENCE();
    if (more) {
      bf16* Aw = As + (buf ^ 1) * 128 * LDT;
      bf16* Bw = Bs + (buf ^ 1) * 128 * LDT;
#pragma unroll
      for (int i = 0; i < 4; ++i) {
        *(u32x4*)(Aw + (lr + 32 * i) * LDT + kc) = ra[i];
        *(u32x4*)(Bw + (lr + 32 * i) * LDT + kc) = rb[i];
      }
    }
    __syncthreads();
  }
}

DI void gemm_main_half(f32x16 (&acc)[2], const bf16* A, int lda, const bf16* B, int ldb, int K, int hf, char* smem) {
  bf16* As = (bf16*)smem;
  bf16* Bs = (bf16*)(smem + 2 * 128 * LDT * 2);
  const int tid = TIDX, lane = tid & 63, w = tid >> 6, wm = w >> 1, wn = w & 1;
  const int r = lane & 31, h = lane >> 5;
  const int lr = tid >> 3, kc = (tid & 7) * 8;
  const bf16* ap = A + (size_t)lr * lda + kc;
  const bf16* bp = B + (size_t)(hf * 32 + lr) * ldb + kc;
  const size_t sa = (size_t)32 * lda, sb = (size_t)64 * ldb;
  u32x4 ra[4], rb[2];
#pragma unroll
  for (int i = 0; i < 4; ++i) ra[i] = ldg16(ap + i * sa);
#pragma unroll
  for (int i = 0; i < 2; ++i) rb[i] = ldg16(bp + i * sb);
#pragma unroll
  for (int i = 0; i < 4; ++i) *(u32x4*)(As + (lr + 32 * i) * LDT + kc) = ra[i];
#pragma unroll
  for (int i = 0; i < 2; ++i) *(u32x4*)(Bs + (lr + 32 * i) * LDT + kc) = rb[i];
  __syncthreads();
  const int nk = K / 64;
  for (int kt = 0; kt < nk; ++kt) {
    const int buf = kt & 1;
    const bool more = (kt + 1 < nk);
    if (more) {
      ap += 64; bp += 64;
#pragma unroll
      for (int i = 0; i < 4; ++i) ra[i] = ldg16(ap + i * sa);
#pragma unroll
      for (int i = 0; i < 2; ++i) rb[i] = ldg16(bp + i * sb);
    }
    SCHED_FENCE();
    const bf16* Ab = As + buf * 128 * LDT + (wm * 64 + r) * LDT + h * 8;
    const bf16* Bb = Bs + buf * 128 * LDT + (wn * 32 + r) * LDT + h * 8;
#pragma unroll
    for (int s = 0; s < 4; ++s) {
      s16x8 a0 = *(const s16x8*)(Ab + s * 16);
      s16x8 a1 = *(const s16x8*)(Ab + 32 * LDT + s * 16);
      s16x8 b0 = *(const s16x8*)(Bb + s * 16);
      acc[0] = MFMA32(a0, b0, acc[0]);
      acc[1] = MFMA32(a1, b0, acc[1]);
    }
    SCHED_FENCE();
    if (more) {
      bf16* Aw = As + (buf ^ 1) * 128 * LDT;
      bf16* Bw = Bs + (buf ^ 1) * 128 * LDT;
#pragma unroll
      for (int i = 0; i < 4; ++i) *(u32x4*)(Aw + (lr + 32 * i) * LDT + kc) = ra[i];
#pragma unroll
      for (int i = 0; i < 2; ++i) *(u32x4*)(Bw + (lr + 32 * i) * LDT + kc) = rb[i];
    }
    __syncthreads();
  }
}

DI void acc_zero(f32x16 (&acc)[2][2]) {
#pragma unroll
  for (int a = 0; a < 2; ++a)
#pragma unroll
    for (int b = 0; b < 2; ++b)
#pragma unroll
      for (int i = 0; i < 16; ++i) acc[a][b][i] = 0.f;
}

DI void acc_to_lds(const f32x16 (&acc)[2][2], float* Cs) {
  const int lane = TIDX & 63, w = TIDX >> 6, wm = w >> 1, wn = w & 1, r = lane & 31, h = lane >> 5;
#pragma unroll
  for (int tm = 0; tm < 2; ++tm)
#pragma unroll
    for (int tn = 0; tn < 2; ++tn)
#pragma unroll
      for (int i = 0; i < 16; ++i) Cs[(wm * 64 + tm * 32 + crow(i, h)) * CLD + wn * 64 + tn * 32 + r] = acc[tm][tn][i];
}

DI void store_tile_bf16(const float* Cs, bf16* dst, size_t ld, int mvalid, float scale) {
  for (int c = TIDX; c < 2048; c += 256) {
    const int row = c >> 4, cc = (c & 15) * 8;
    if (row < mvalid) {
      const float* s = Cs + row * CLD + cc;
      u32x4 v;
      v[0] = pack2(s[0] * scale, s[1] * scale);
      v[1] = pack2(s[2] * scale, s[3] * scale);
      v[2] = pack2(s[4] * scale, s[5] * scale);
      v[3] = pack2(s[6] * scale, s[7] * scale);
      *(u32x4*)(dst + (size_t)row * ld + cc) = v;
    }
  }
}

DI float* resid_row(const Params& p, int tok) {
  const int b = tok / TT, t = tok - b * TT;
  return (t < CTXL) ? (float*)(p.ws + OFF_XC) + ((size_t)b * CTXL + t) * DM : p.out + ((size_t)b * SEQ + (t - CTXL)) * DM;
}
DI const float* mod_vec(const Params& p, int l, int tok, int which) {
  const int b = tok / TT, t = tok - b * TT;
  const int m = (t < CTXL) ? 4 : b;
  return (const float*)(p.ws + OFF_MOD) + ((size_t)(l * 5 + m) * 6 + which) * DM;
}
DI float wave_sum(float v) {
#pragma unroll
  for (int o = 32; o >= 1; o >>= 1) v += __shfl_xor(v, o, 64);
  return v;
}
DI bf16* wl(const Params& p, int l, size_t off) { return (bf16*)(p.ws + OFF_W) + (size_t)l * WL_TOTAL + off; }

DI void prep_mod_job(const Params& p, int j, char* smem) {
  float* sc = (float*)smem;
  const int l = j / 24, nb = j % 24, tid = TIDX;
  for (int idx = tid; idx < 5120; idx += 256) {
    const int m = idx >> 10, k = idx & 1023;
    const float v = (m < 4) ? p.in[I_C][m * 1024 + k] : p.in[I_CCTX][k];
    sc[idx] = siluf_(v);
  }
  __syncthreads();
  const int n = nb * 256 + tid;
  const float* W = p.in[I_ADAW] + (size_t)l * 1024 * 6144 + n;
  float a0 = 0, a1 = 0, a2 = 0, a3 = 0, a4 = 0;
#pragma unroll 8
  for (int k = 0; k < 1024; ++k) {
    const float wv = W[(size_t)k * 6144];
    a0 += sc[k] * wv; a1 += sc[1024 + k] * wv; a2 += sc[2048 + k] * wv; a3 += sc[3072 + k] * wv; a4 += sc[4096 + k] * wv;
  }
  const float bb = p.in[I_ADAB][l * 6144 + n];
  float* M = (float*)(p.ws + OFF_MOD) + (size_t)l * 5 * 6144 + n;
  M[0] = a0 + bb; M[6144] = a1 + bb; M[2 * 6144] = a2 + bb; M[3 * 6144] = a3 + bb; M[4 * 6144] = a4 + bb;
  __syncthreads();
}

DI void prep_s5_job(const Params& p, int j) {
  const int idx = j * 256 + TIDX;
  const int ldg = idx >> 6, pp = idx & 63;
  const float dt = expf(p.in[I_LDT][ldg]);
  const float are = p.in[I_ARE][idx], aim = p.in[I_AIM][idx];
  const float mag = expf(are * dt);
  float sn, cs;
  sincos_cw(aim * dt, sn, cs);
  const float abr = mag * cs, abi = mag * sn;
  const float den = are * are + aim * aim;
  const float fre = ((abr - 1.f) * are + abi * aim) / den;
  const float fim = (abi * are - (abr - 1.f) * aim) / den;
  float* BBR = (float*)(p.ws + OFF_BBR);
  float* BBI = (float*)(p.ws + OFF_BBI);
  for (int hh = 0; hh < 16; ++hh) {
    const float br = p.in[I_BRE][(size_t)idx * 16 + hh], bi = p.in[I_BIM][(size_t)idx * 16 + hh];
    BBR[(size_t)idx * 16 + hh] = fre * br - fim * bi;
    BBI[(size_t)idx * 16 + hh] = fre * bi + fim * br;
  }
  float2* PW = (float2*)(p.ws + OFF_PWR);
  float pr = 1.f, pi = 0.f;
  for (int tau = 0; tau <= 32; ++tau) {
    PW[((size_t)ldg * 33 + tau) * 64 + pp] = make_float2(pr, pi);
    const float nr = pr * abr - pi * abi, ni = pr * abi + pi * abr;
    pr = nr; pi = ni;
  }
}

DI void prep_wt_job(const Params& p, int jj, char* smem) {
  float* tile = (float*)smem;
  const int l = jj / 4016;
  int r = jj % 4016;
  int mat = 0;
  const int cnt[8] = {1376, 64, 128, 64, 256, 1408, 704, 16};
#pragma unroll
  for (int m = 0; m < 8; ++m) {
    if (mat == m && r >= cnt[m]) { r -= cnt[m]; mat = m + 1; }
  }
  const float* src; int K, sld; size_t doff;
  switch (mat) {
    case 0: src = p.in[I_WIN] + (size_t)l * 1024 * DIN; K = 1024; sld = DIN; doff = WL_WIN; break;
    case 1: src = p.in[I_WBA] + (size_t)l * 256 * 1024; K = 256; sld = 1024; doff = WL_BRA; break;
    case 2: src = p.in[I_WBG] + (size_t)l * 512 * 1024; K = 512; sld = 1024; doff = WL_BRG; break;
    case 3: src = p.in[I_WBS] + (size_t)l * 256 * 1024; K = 256; sld = 1024; doff = WL_BRS; break;
    case 4: src = p.in[I_WOUT] + (size_t)l * 1024 * 1024; K = 1024; sld = 1024; doff = WL_WOUT; break;
    case 5: src = p.in[I_UP] + (size_t)l * 1024 * 5632; K = 1024; sld = 5632; doff = WL_UP; break;
    case 6: src = p.in[I_DOWN] + (size_t)l * 2816 * 1024; K = 2816; sld = 1024; doff = WL_DOWN; break;
    default: src = p.in[I_GLUW] + (size_t)l * 256 * 256; K = 256; sld = 256; doff = WL_GLU; break;
  }
  const int kt = K / 64;
  const int n0 = (r / kt) * 64, k0 = (r % kt) * 64;
  const int tid = TIDX;
  {
    const int nn = tid & 63;
    const int np = n0 + nn;
    int col;
    if (mat == 0) {
      if (np < 2048) col = np;
      else if (np < 2304) col = 2080 + (np - 2048);
      else if (np < 2336) col = 2048 + (np - 2304);
      else if (np < 2432) col = -1;
      else col = 2336 + (np - 2432);
    } else if (mat == 5) {
      const int jb = np >> 7, c = np & 127;
      col = (c < 64) ? (jb * 64 + c) : (DFF + jb * 64 + (c - 64));
    } else col = np;
#pragma unroll 4
    for (int kk = tid >> 6; kk < 64; kk += 4) tile[kk * 65 + nn] = (col >= 0) ? src[(size_t)(k0 + kk) * sld + col] : 0.f;
  }
  __syncthreads();
  {
    const int nn = tid >> 2, kq = (tid & 3) * 16;
    bf16* d = wl(p, l, doff) + (size_t)(n0 + nn) * K + k0 + kq;
    u32x4 v0, v1;
#pragma unroll
    for (int e = 0; e < 4; ++e) {
      v0[e] = pack2(tile[(kq + 2 * e) * 65 + nn], tile[(kq + 2 * e + 1) * 65 + nn]);
      v1[e] = pack2(tile[(kq + 8 + 2 * e) * 65 + nn], tile[(kq + 8 + 2 * e + 1) * 65 + nn]);
    }
    *(u32x4*)d = v0;
    *(u32x4*)(d + 8) = v1;
  }
  __syncthreads();
}

template <int MODE>
DI void row_job(const Params& p, int l, int tok) {
  const int lane = TIDX & 63;
  float x[16];
  float* xr = resid_row(p, tok);
  if (MODE == 0) {
    const int b = tok / TT, t = tok - b * TT;
    const float* src = (t < CTXL) ? p.in[I_CTX] + ((size_t)b * CTXL + t) * DM : p.in[I_X] + ((size_t)b * SEQ + (t - CTXL)) * DM;
#pragma unroll
    for (int i = 0; i < 4; ++i) {
      const f32x4 v = *(const f32x4*)(src + lane * 4 + 256 * i);
      x[4 * i] = v[0]; x[4 * i + 1] = v[1]; x[4 * i + 2] = v[2]; x[4 * i + 3] = v[3];
      *(f32x4*)(xr + lane * 4 + 256 * i) = v;
    }
  } else {
    const bf16* yr = (const bf16*)(p.ws + OFF_H) + (size_t)tok * DM;
    const float* gpost = p.in[MODE == 1 ? I_NMPOST : I_NFPOST] + l * DM;
    const float* mg = mod_vec(p, l, tok, MODE == 1 ? 2 : 5);
    float y[16];
    float ss = 0.f;
#pragma unroll
    for (int i = 0; i < 4; ++i) {
      const u32x2 u = *(const u32x2*)(yr + lane * 4 + 256 * i);
      y[4 * i] = bflo(u[0]); y[4 * i + 1] = bfhi(u[0]); y[4 * i + 2] = bflo(u[1]); y[4 * i + 3] = bfhi(u[1]);
#pragma unroll
      for (int e = 0; e < 4; ++e) ss += y[4 * i + e] * y[4 * i + e];
    }
    ss = wave_sum(ss);
    const float rstd = rsqrtf(ss * (1.f / DM) + EPSF);
#pragma unroll
    for (int i = 0; i < 4; ++i) {
      f32x4 v = *(const f32x4*)(xr + lane * 4 + 256 * i);
      const f32x4 g = *(const f32x4*)(gpost + lane * 4 + 256 * i);
      const f32x4 m = *(const f32x4*)(mg + lane * 4 + 256 * i);
#pragma unroll
      for (int e = 0; e < 4; ++e) { v[e] += m[e] * (y[4 * i + e] * rstd * g[e]); x[4 * i + e] = v[e]; }
      *(f32x4*)(xr + lane * 4 + 256 * i) = v;
    }
  }
  if (MODE == 2 && l == NL - 1) return;
  const int ln = (MODE == 2) ? l + 1 : l;
  const float* gpre = p.in[MODE == 1 ? I_NFPRE : I_NMPRE] + ln * DM;
  const float* sh = mod_vec(p, ln, tok, MODE == 1 ? 3 : 0);
  const float* scv = mod_vec(p, ln, tok, MODE == 1 ? 4 : 1);
  float ss = 0.f;
#pragma unroll
  for (int i = 0; i < 16; ++i) ss += x[i] * x[i];
  ss = wave_sum(ss);
  const float rstd = rsqrtf(ss * (1.f / DM) + EPSF);
  bf16* hr = (bf16*)(p.ws + OFF_H) + (size_t)tok * DM;
#pragma unroll
  for (int i = 0; i < 4; ++i) {
    const f32x4 g = *(const f32x4*)(gpre + lane * 4 + 256 * i);
    const f32x4 s1 = *(const f32x4*)(sh + lane * 4 + 256 * i);
    const f32x4 s2 = *(const f32x4*)(scv + lane * 4 + 256 * i);
    float o[4];
#pragma unroll
    for (int e = 0; e < 4; ++e) o[e] = (x[4 * i + e] * rstd * g[e]) * (1.f + s2[e]) + s1[e];
    u32x2 u;
    u[0] = pack2(o[0], o[1]); u[1] = pack2(o[2], o[3]);
    *(u32x2*)(hr + lane * 4 + 256 * i) = u;
  }
}

template <int MODE>
DI void row_phase(const Params& p, int l, int bid, int G) {
  const int wg = bid * 4 + (TIDX >> 6), nw = G * 4;
  for (int tok = wg; tok < NTOK; tok += nw) row_job<MODE>(p, l, tok);
}

DI void ktab_phase(const Params& p, int bid, int G) {
  const float* BBR = (const float*)(p.ws + OFF_BBR);
  const float* BBI = (const float*)(p.ws + OFF_BBI);
  const float2* PW = (const float2*)(p.ws + OFF_PWR);
  float* KT = (float*)(p.ws + OFF_KTAB);
  const int total = NL * 16 * 2 * 32 * 256;
  for (int idx = bid * 256 + TIDX; idx < total; idx += G * 256) {
    const int hp = idx & 15, hh = (idx >> 4) & 15, tau = (idx >> 8) & 31, d = (idx >> 13) & 1, g = (idx >> 14) & 15, l = idx >> 18;
    const int ldg = (l * 2 + d) * 16 + g;
    const float* cre = p.in[I_CRE] + ((size_t)ldg * 16 + hh) * 64;
    const float* cim = p.in[I_CIM] + ((size_t)ldg * 16 + hh) * 64;
    float acc = 0.f;
    for (int pp = 0; pp < 64; ++pp) {
      const float2 pw = PW[((size_t)ldg * 33 + tau) * 64 + pp];
      const float br = BBR[((size_t)ldg * 64 + pp) * 16 + hp], bi = BBI[((size_t)ldg * 64 + pp) * 16 + hp];
      const float zr = pw.x * br - pw.y * bi, zi = pw.x * bi + pw.y * br;
      acc += cre[pp] * zr - cim[pp] * zi;
    }
    KT[idx] = acc;
  }
}

DI void s5mat_phase(const Params& p, int l, int bid, int G) {
  const float* BBR = (const float*)(p.ws + OFF_BBR);
  const float* BBI = (const float*)(p.ws + OFF_BBI);
  const float2* PW = (const float2*)(p.ws + OFF_PWR);
  const float* KT = (const float*)(p.ws + OFF_KTAB);
  bf16* T5 = (bf16*)(p.ws + OFF_T5);
  bf16* E5 = (bf16*)(p.ws + OFF_E5);
  bf16* F5 = (bf16*)(p.ws + OFF_F5);
  const int nT = 16 * 512 * 64, nE = 16 * 512 * 32, nF = 16 * 256 * 64;
  for (int it = bid * 256 + TIDX; it < nT + nE + nF; it += G * 256) {
    float v[8];
    bf16* dst;
    if (it < nT) {
      const int k8 = it & 63, n = (it >> 6) & 511, g = it >> 15;
      const int i = n >> 4, hh = n & 15, j = k8 >> 1, hp0 = (k8 & 1) * 8;
#pragma unroll
      for (int e = 0; e < 8; ++e) {
        const int hp = hp0 + e;
        float a = 0.f;
        if (j <= i) a += KT[((((size_t)l * 16 + g) * 2 + 0) * 32 + (i - j)) * 256 + hh * 16 + hp];
        if (j >= i) a += KT[((((size_t)l * 16 + g) * 2 + 1) * 32 + (j - i)) * 256 + hh * 16 + hp];
        if (i == j && hh == hp) a += p.in[I_S5D][l * 256 + g * 16 + hh];
        v[e] = a;
      }
      dst = T5 + ((size_t)g * 512 + n) * 512 + k8 * 8;
    } else if (it < nT + nE) {
      const int q = it - nT;
      const int k8 = q & 31, n = (q >> 5) & 511, g = q >> 14;
      const int i = n >> 4, hh = n & 15;
      const int k0 = k8 * 8, d = k0 >> 7, ri = (k0 >> 6) & 1, p0 = k0 & 63;
      const int ldg = (l * 2 + d) * 16 + g;
      const int ex = d ? (32 - i) : (i + 1);
#pragma unroll
      for (int e = 0; e < 8; ++e) {
        const int pp = p0 + e;
        const float2 pw = PW[((size_t)ldg * 33 + ex) * 64 + pp];
        const float cr = p.in[I_CRE][((size_t)ldg * 16 + hh) * 64 + pp], ci = p.in[I_CIM][((size_t)ldg * 16 + hh) * 64 + pp];
        const float zr = cr * pw.x - ci * pw.y, zi = cr * pw.y + ci * pw.x;
        v[e] = ri ? -zi : zr;
      }
      dst = E5 + ((size_t)g * 512 + n) * 256 + k0;
    } else {
      const int q = it - nT - nE;
      const int k8 = q & 63, n = (q >> 6) & 255, g = q >> 14;
      const int d = n >> 7, ri = (n >> 6) & 1, pp = n & 63;
      const int j = k8 >> 1, hp0 = (k8 & 1) * 8;
      const int ldg = (l * 2 + d) * 16 + g;
      const int ex = d ? j : (31 - j);
      const float2 pw = PW[((size_t)ldg * 33 + ex) * 64 + pp];
#pragma unroll
      for (int e = 0; e < 8; ++e) {
        const float br = BBR[((size_t)ldg * 64 + pp) * 16 + hp0 + e], bi = BBI[((size_t)ldg * 64 + pp) * 16 + hp0 + e];
        v[e] = ri ? (pw.x * bi + pw.y * br) : (pw.x * br - pw.y * bi);
      }
      dst = F5 + ((size_t)g * 256 + n) * 512 + k8 * 8;
    }
    u32x4 u;
    u[0] = pack2(v[0], v[1]); u[1] = pack2(v[2], v[3]); u[2] = pack2(v[4], v[5]); u[3] = pack2(v[6], v[7]);
    *(u32x4*)dst = u;
  }
}

DI void proj_tile(const Params& p, int l, int mt, int nt, char* smem) {
  const bf16* H = (const bf16*)(p.ws + OFF_H) + (size_t)mt * 128 * DM;
  const bf16* W = wl(p, l, WL_WIN) + (size_t)nt * 128 * DM;
  f32x16 acc[2][2];
  acc_zero(acc);
  gemm_main_s(acc, H, DM, W, DM, DM, smem);
  float* Cs = (float*)smem;
  acc_to_lds(acc, Cs);
  __syncthreads();
  const int tid = TIDX;
  const int tok0 = mt * 128;
  const int b = tok0 / TT, t0 = tok0 - b * TT;
  if (nt <= 2) {
    const int row = tid >> 1, seg = tid & 1;
    float* c = Cs + row * CLD + seg * 64;
    const float* gn = p.in[nt < 2 ? I_QN : I_KN] + l * 64;
    float ss = 0.f;
#pragma unroll 8
    for (int i = 0; i < 64; ++i) ss += c[i] * c[i];
    const float rstd = rsqrtf(ss * (1.f / 64.f) + EPSF);
    const int t = t0 + row;
    const bool lat = t >= CTXL;
    const int s = t - CTXL;
#pragma unroll 1
    for (int ax = 0; ax < 2; ++ax) {
      const float pos = (float)(ax ? (s & 63) : (s >> 6));
#pragma unroll 2
      for (int f = 0; f < 16; ++f) {
        float x1 = c[ax * 32 + f] * rstd * gn[ax * 32 + f];
        float x2 = c[ax * 32 + 16 + f] * rstd * gn[ax * 32 + 16 + f];
        if (lat) {
          const float invf = exp2f(-(float)f * (13.287712379549449f / 16.f));
          float sn, cs;
          sincos_cw(pos * invf, sn, cs);
          const float y1 = x1 * cs - x2 * sn, y2 = x2 * cs + x1 * sn;
          x1 = y1; x2 = y2;
        }
        c[ax * 32 + f] = x1;
        c[ax * 32 + 16 + f] = x2;
      }
    }
    __syncthreads();
    if (nt < 2) store_tile_bf16(Cs, (bf16*)(p.ws + OFF_Q) + (size_t)tok0 * 256 + nt * 128, 256, 128, 0.125f * 1.4426950408889634f);
    else store_tile_bf16(Cs, (bf16*)(p.ws + OFF_K) + (size_t)tok0 * 128, 128, 128, 1.f);
  } else if (nt == 3 || (nt >= 8 && nt <= 11)) {
    for (int c = tid; c < 2048; c += 256) {
      const int col = c & 127, rc = (c >> 7) * 8;
      u32x4 u;
#pragma unroll
      for (int e = 0; e < 4; ++e) u[e] = pack2(Cs[(rc + 2 * e) * CLD + col], Cs[(rc + 2 * e + 1) * CLD + col]);
      bf16* dst;
      if (nt == 3) dst = (bf16*)(p.ws + OFF_VT) + ((size_t)(b * 2 + (col >> 6)) * 64 + (col & 63)) * TT + t0 + rc;
      else dst = (bf16*)(p.ws + OFF_GVT) + ((size_t)(b * 4 + (nt - 8)) * 128 + col) * TT + t0 + rc;
      *(u32x4*)dst = u;
    }
  } else if (nt == 4 || nt == 5) {
    store_tile_bf16(Cs, (bf16*)(p.ws + OFF_GQ) + (size_t)tok0 * 256 + (nt - 4) * 128, 256, 128, 0.125f);
  } else if (nt == 6 || nt == 7) {
    store_tile_bf16(Cs, (bf16*)(p.ws + OFF_GK) + (size_t)tok0 * 256 + (nt - 6) * 128, 256, 128, 1.f);
  } else if (nt >= 12 && nt <= 15) {
    store_tile_bf16(Cs, (bf16*)(p.ws + OFF_GR) + (size_t)tok0 * 512 + (nt - 12) * 128, 512, 128, 1.f);
  } else if (nt == 16 || nt == 17) {
    for (int c = tid; c < 2048; c += 256) {
      const int row = c >> 4, c8 = c & 15;
      const float* s = Cs + row * CLD + c8 * 8;
      u32x4 u;
#pragma unroll
      for (int e = 0; e < 4; ++e) u[e] = pack2(s[2 * e], s[2 * e + 1]);
      const int ch = (nt - 16) * 128 + c8 * 8;
      bf16* dst = (bf16*)(p.ws + OFF_SU) + ((size_t)(b * 16 + (ch >> 4)) * TT + t0 + row) * 16 + (ch & 15);
      *(u32x4*)dst = u;
    }
  } else {
    for (int c = tid; c < 128 * 8; c += 256) {
      const int row = c >> 3, c4 = (c & 7) * 4;
      const float* s = Cs + row * CLD + c4;
      f32x4 v = {s[0], s[1], s[2], s[3]};
      *(f32x4*)((float*)(p.ws + OFF_LOW) + (size_t)(tok0 + row) * 32 + c4) = v;
    }
  }
  __syncthreads();
}

DI void attn_unit(const Params& p, int u, char* smem) {
  bf16* Ks = (bf16*)smem;
  bf16* Vs = (bf16*)(smem + 2 * 64 * LDT * 2);
  int b, head, tok0, nkt;
  if (u < 1024) { b = u >> 8; head = (u >> 6) & 3; tok0 = b * TT + CTXL + (u & 63) * 128; nkt = TT / 64; }
  else { const int v = u - 1024; b = v >> 3; head = (v >> 1) & 3; tok0 = b * TT + (v & 1) * 128; nkt = CTXL / 64; }
  const int kvh = head >> 1;
  const int tid = TIDX, lane = tid & 63, w = tid >> 6, r = lane & 31, h = lane >> 5;
  const bf16* Qp = (const bf16*)(p.ws + OFF_Q) + (size_t)(tok0 + w * 32 + r) * 256 + head * 64 + h * 8;
  s16x8 qf[4];
#pragma unroll
  for (int s = 0; s < 4; ++s) qf[s] = *(const s16x8*)(Qp + s * 16);
  const int lr = tid >> 3, kc = (tid & 7) * 8;
  const bf16* Kg = (const bf16*)(p.ws + OFF_K) + ((size_t)b * TT + lr) * 128 + kvh * 64 + kc;
  const bf16* Vg = (const bf16*)(p.ws + OFF_VT) + ((size_t)(b * 2 + kvh) * 64 + lr) * TT + kc;
  u32x4 rk[2], rv[2];
#pragma unroll
  for (int i = 0; i < 2; ++i) {
    rk[i] = ldg16(Kg + (size_t)(32 * i) * 128);
    rv[i] = ldg16(Vg + (size_t)(32 * i) * TT);
  }
#pragma unroll
  for (int i = 0; i < 2; ++i) {
    *(u32x4*)(Ks + (lr + 32 * i) * LDT + kc) = rk[i];
    *(u32x4*)(Vs + (lr + 32 * i) * LDT + kc) = rv[i];
  }
  __syncthreads();
  f32x16 oacc[2];
#pragma unroll
  for (int i = 0; i < 16; ++i) { oacc[0][i] = 0.f; oacc[1][i] = 0.f; }
  float mrow = -INFINITY, lrow = 0.f;
  for (int kt = 0; kt < nkt; ++kt) {
    const int buf = kt & 1;
    const bool more = kt + 1 < nkt;
    if (more) {
#pragma unroll
      for (int i = 0; i < 2; ++i) {
        rk[i] = ldg16(Kg + (size_t)((kt + 1) * 64 + 32 * i) * 128);
        rv[i] = ldg16(Vg + (size_t)(32 * i) * TT + (kt + 1) * 64);
      }
    }
    SCHED_FENCE();
    const bf16* Kb = Ks + buf * 64 * LDT;
    const bf16* Vb = Vs + buf * 64 * LDT;
    f32x16 sacc[2];
#pragma unroll
    for (int i = 0; i < 16; ++i) { sacc[0][i] = 0.f; sacc[1][i] = 0.f; }
#pragma unroll
    for (int s = 0; s < 4; ++s) {
      const s16x8 a0 = *(const s16x8*)(Kb + r * LDT + s * 16 + h * 8);
      const s16x8 a1 = *(const s16x8*)(Kb + (32 + r) * LDT + s * 16 + h * 8);
      sacc[0] = MFMA32(a0, qf[s], sacc[0]);
      sacc[1] = MFMA32(a1, qf[s], sacc[1]);
    }
    float mx = sacc[0][0];
#pragma unroll
    for (int i = 0; i < 16; ++i) { mx = fmaxf(mx, sacc[0][i]); mx = fmaxf(mx, sacc[1][i]); }
    mx = fmaxf(mx, __shfl_xor(mx, 32, 64));
    const float mnew = fmaxf(mrow, mx);
    const float alpha = exp2f(mrow - mnew);
    mrow = mnew;
    float psum = 0.f;
#pragma unroll
    for (int i = 0; i < 16; ++i) {
      sacc[0][i] = exp2f(sacc[0][i] - mnew); psum += sacc[0][i];
      sacc[1][i] = exp2f(sacc[1][i] - mnew); psum += sacc[1][i];
    }
    lrow = lrow * alpha + psum;
#pragma unroll
    for (int i = 0; i < 16; ++i) { oacc[0][i] *= alpha; oacc[1][i] *= alpha; }
#pragma unroll
    for (int kt2 = 0; kt2 < 2; ++kt2)
#pragma unroll
      for (int s2 = 0; s2 < 2; ++s2) {
        u32x4 pu;
#pragma unroll
        for (int e = 0; e < 4; ++e) pu[e] = pack2(sacc[kt2][8 * s2 + 2 * e], sacc[kt2][8 * s2 + 2 * e + 1]);
        const s16x8 pf = __builtin_bit_cast(s16x8, pu);
        const int kb = kt2 * 32 + 16 * s2 + 4 * h;
#pragma unroll
        for (int dt = 0; dt < 2; ++dt) {
          const s16x4 lo = *(const s16x4*)(Vb + (dt * 32 + r) * LDT + kb);
          const s16x4 hi = *(const s16x4*)(Vb + (dt * 32 + r) * LDT + kb + 8);
          const s16x8 a = __builtin_shufflevector(lo, hi, 0, 1, 2, 3, 4, 5, 6, 7);
          oacc[dt] = MFMA32(a, pf, oacc[dt]);
        }
      }
    SCHED_FENCE();
    if (more) {
      bf16* Kw = Ks + (buf ^ 1) * 64 * LDT;
      bf16* Vw = Vs + (buf ^ 1) * 64 * LDT;
#pragma unroll
      for (int i = 0; i < 2; ++i) {
        *(u32x4*)(Kw + (lr + 32 * i) * LDT + kc) = rk[i];
        *(u32x4*)(Vw + (lr + 32 * i) * LDT + kc) = rv[i];
      }
    }
    __syncthreads();
  }
  const float ltot = lrow + __shfl_xor(lrow, 32, 64);
  const float inv = 1.f / ltot;
  bf16* Op = (bf16*)(p.ws + OFF_OATT) + (size_t)(tok0 + w * 32 + r) * 256 + head * 64;
#pragma unroll
  for (int dt = 0; dt < 2; ++dt)
#pragma unroll
    for (int i = 0; i < 16; i += 4) {
      u32x2 uu;
      uu[0] = pack2(oacc[dt][i] * inv, oacc[dt][i + 1] * inv);
      uu[1] = pack2(oacc[dt][i + 2] * inv, oacc[dt][i + 3] * inv);
      *(u32x2*)(Op + dt * 32 + crow(i, h)) = uu;
    }
}

constexpr int GL_LOW = 0, GL_TOT = 4096, GL_DEC = 5120, GL_QIN = 5376, GL_KIN = 14592, GL_KET = 23808, GL_OST = 0,
              GL_VT = 33792, GL_ST = 52224;
static_assert(GL_ST + 128 * LDT * 2 <= SMEM_BYTES, "gla lds");

template <bool WITH_OUT>
DI void gla_unit(const Params& p, int l, int u, char* smem) {
  float* lowt = (float*)(smem + GL_LOW);
  float* tots = (float*)(smem + GL_TOT);
  float* decs = (float*)(smem + GL_DEC);
  bf16* qin = (bf16*)(smem + GL_QIN);
  bf16* kin = (bf16*)(smem + GL_KIN);
  bf16* ket = (bf16*)(smem + GL_KET);
  float* ost = (float*)(smem + GL_OST);
  bf16* vts = (bf16*)(smem + GL_VT);
  bf16* sts = (bf16*)(smem + GL_ST);
  const int tid = TIDX, lane = tid & 63, w = tid >> 6, r = lane & 31, h = lane >> 5;
  int b, hd, gi, dir0, ndir;
  if (WITH_OUT) { gi = u % NG33; hd = (u / NG33) & 3; b = u / (NG33 * 4); dir0 = 1; ndir = 2; }
  else { gi = u % NG33; const int v = u / NG33; dir0 = v & 1; hd = (v >> 1) & 3; b = v >> 3; ndir = 1; }
  const int dk = tid & 63, part = tid >> 6;
  const bf16* GQ = (const bf16*)(p.ws + OFF_GQ);
  const bf16* GK = (const bf16*)(p.ws + OFF_GK);
  const bf16* GVT = (const bf16*)(p.ws + OFF_GVT) + (size_t)(b * 4 + hd) * 128 * TT;
  const float* LOW = (const float*)(p.ws + OFF_LOW);
  for (int dd = 0; dd < ndir; ++dd) {
    const int dir = WITH_OUT ? (dir0 - dd) : dir0;
    float* GSu = (float*)(p.ws + OFF_GS) + ((size_t)((b * 4 + hd) * 2 + dir) * NG33 + gi) * 8192;
    float gwreg[16];
#pragma unroll
    for (int rr = 0; rr < 16; ++rr) gwreg[rr] = p.in[I_GGW][((size_t)(l * 2 + dir) * 16 + rr) * 256 + hd * 64 + dk];
    const float gb = p.in[I_GGB][(l * 2 + dir) * 256 + hd * 64 + dk];
    f32x16 sacc[2];
    if (WITH_OUT) {
#pragma unroll
      for (int dkt = 0; dkt < 2; ++dkt)
#pragma unroll
        for (int i = 0; i < 16; ++i) {
          const float v = GSu[(w * 32 + crow(i, h)) * 64 + dkt * 32 + r];
          sacc[dkt][i] = v;
          sts[(w * 32 + crow(i, h)) * LDT + dkt * 32 + r] = f2bf(v);
        }
    } else {
#pragma unroll
      for (int i = 0; i < 16; ++i) { sacc[0][i] = 0.f; sacc[1][i] = 0.f; }
    }
    float gtot = 0.f;
    for (int cc = 0; cc < 4; ++cc) {
      const int ci = dir ? 3 - cc : cc;
      const int tb = gi * 256 + ci * 64;
      const size_t tokb = (size_t)b * TT + tb;
      {
        const int row = tid >> 2, c4 = (tid & 3) * 4;
        const u32x4 lw = ldg16(LOW + (tokb + row) * 32 + dir * 16 + c4);
        u32x4 vv[4], kq[2], qq[2];
#pragma unroll
        for (int i = 0; i < 4; ++i) {
          const int c = tid + 256 * i, e = c >> 3, k8 = (c & 7) * 8;
          vv[i] = ldg16(GVT + (size_t)e * TT + tb + k8);
        }
#pragma unroll
        for (int i = 0; i < 2; ++i) {
          const int c = tid + 256 * i, rw = c >> 3, k8 = (c & 7) * 8;
          kq[i] = ldg16(GK + (tokb + rw) * 256 + hd * 64 + k8);
          if (WITH_OUT) qq[i] = ldg16(GQ + (tokb + rw) * 256 + hd * 64 + k8);
        }
        *(u32x4*)(lowt + row * 16 + c4) = lw;
#pragma unroll
        for (int i = 0; i < 4; ++i) {
          const int c = tid + 256 * i, e = c >> 3, k8 = (c & 7) * 8;
          *(u32x4*)(vts + e * LDT + k8) = vv[i];
        }
#pragma unroll
        for (int i = 0; i < 2; ++i) {
          const int c = tid + 256 * i, rw = c >> 3, k8 = (c & 7) * 8;
          *(u32x4*)(kin + rw * LDT + k8) = kq[i];
          if (WITH_OUT) *(u32x4*)(qin + rw * LDT + k8) = qq[i];
        }
      }
      __syncthreads();
      float cum = 0.f;
#pragma unroll 2
      for (int ii = 0; ii < 16; ++ii) {
        const int pos = part * 16 + ii, t = dir ? 63 - pos : pos;
        float z = gb;
#pragma unroll
        for (int rr = 0; rr < 16; ++rr) z += lowt[t * 16 + rr] * gwreg[rr];
        cum += (fminf(z, 0.f) - log1pf(__expf(-fabsf(z)))) * (1.f / 16.f);
      }
      tots[part * 64 + dk] = cum;
      __syncthreads();
      float offs = 0.f, total = 0.f;
#pragma unroll
      for (int pp = 0; pp < 4; ++pp) { const float tv = tots[pp * 64 + dk]; total += tv; if (pp < part) offs += tv; }
      if (part == 0) decs[dk] = __expf(total);
      gtot += total;
      float bq = offs;
#pragma unroll 2
      for (int ii = 0; ii < 16; ++ii) {
        const int pos = part * 16 + ii, t = dir ? 63 - pos : pos;
        float z = gb;
#pragma unroll
        for (int rr = 0; rr < 16; ++rr) z += lowt[t * 16 + rr] * gwreg[rr];
        bq += (fminf(z, 0.f) - log1pf(__expf(-fabsf(z)))) * (1.f / 16.f);
        const float kv = bf2f(kin[t * LDT + dk]);
        ket[dk * LDT + t] = f2bf(kv * __expf(total - bq));
        if (WITH_OUT) {
          const float qv = bf2f(qin[t * LDT + dk]);
          qin[t * LDT + dk] = f2bf(qv * __expf(bq));
          kin[t * LDT + dk] = f2bf(kv * __expf(-bq));
        }
      }
      __syncthreads();
      f32x16 oo[2];
      const int it = w & 1, ep = w >> 1;
      if (WITH_OUT) {
        const int ti = w >> 1, tj = w & 1;
        f32x16 aa;
#pragma unroll
        for (int i = 0; i < 16; ++i) aa[i] = 0.f;
#pragma unroll
        for (int s = 0; s < 4; ++s) {
          const s16x8 A = *(const s16x8*)(qin + (ti * 32 + r) * LDT + s * 16 + h * 8);
          const s16x8 Bv = *(const s16x8*)(kin + (tj * 32 + r) * LDT + s * 16 + h * 8);
          aa = MFMA32(A, Bv, aa);
        }
        __syncthreads();
#pragma unroll
        for (int i = 0; i < 16; ++i) {
          const int qi = ti * 32 + crow(i, h), kj = tj * 32 + r;
          const bool keep = dir ? (kj >= qi) : (kj <= qi);
          kin[qi * LDT + kj] = f2bf(keep ? aa[i] : 0.f);
        }
        __syncthreads();
#pragma unroll
        for (int i = 0; i < 16; ++i) { oo[0][i] = 0.f; oo[1][i] = 0.f; }
#pragma unroll
        for (int s = 0; s < 4; ++s) {
          const s16x8 A1 = *(const s16x8*)(kin + (it * 32 + r) * LDT + s * 16 + h * 8);
          const s16x8 A2 = *(const s16x8*)(qin + (it * 32 + r) * LDT + s * 16 + h * 8);
#pragma unroll
          for (int x = 0; x < 2; ++x) {
            const int et = 2 * ep + x;
            const s16x8 B1 = *(const s16x8*)(vts + (et * 32 + r) * LDT + s * 16 + h * 8);
            const s16x8 B2 = *(const s16x8*)(sts + (et * 32 + r) * LDT + s * 16 + h * 8);
            oo[x] = MFMA32(A1, B1, oo[x]);
            oo[x] = MFMA32(A2, B2, oo[x]);
          }
        }
      }
#pragma unroll
      for (int dkt = 0; dkt < 2; ++dkt) {
        const float dv = decs[dkt * 32 + r];
#pragma unroll
        for (int i = 0; i < 16; ++i) sacc[dkt][i] *= dv;
      }
#pragma unroll
      for (int s = 0; s < 4; ++s) {
        const s16x8 A = *(const s16x8*)(vts + (w * 32 + r) * LDT + s * 16 + h * 8);
#pragma unroll
        for (int dkt = 0; dkt < 2; ++dkt) {
          const s16x8 Bv = *(const s16x8*)(ket + (dkt * 32 + r) * LDT + s * 16 + h * 8);
          sacc[dkt] = MFMA32(A, Bv, sacc[dkt]);
        }
      }
      __syncthreads();
      if (WITH_OUT) {
#pragma unroll
        for (int dkt = 0; dkt < 2; ++dkt)
#pragma unroll
          for (int i = 0; i < 16; ++i) sts[(w * 32 + crow(i, h)) * LDT + dkt * 32 + r] = f2bf(sacc[dkt][i]);
#pragma unroll
        for (int x = 0; x < 2; ++x)
#pragma unroll
          for (int i = 0; i < 16; ++i) ost[(it * 32 + crow(i, h)) * CLD + (2 * ep + x) * 32 + r] = oo[x][i];
        __syncthreads();
        const int row = tid >> 2, qd = tid & 3;
        const size_t tok = tokb + row;
        bf16* og = (bf16*)(p.ws + OFF_OGLA) + tok * 512 + hd * 128 + qd * 32;
        const float* os = ost + row * CLD + qd * 32;
        if (dir == 1) {
#pragma unroll
          for (int i = 0; i < 4; ++i) {
            u32x4 uu;
#pragma unroll
            for (int e = 0; e < 4; ++e) uu[e] = pack2(os[i * 8 + 2 * e], os[i * 8 + 2 * e + 1]);
            *(u32x4*)(og + i * 8) = uu;
          }
        } else {
          float ss = 0.f;
#pragma unroll 1
          for (int i = 0; i < 4; ++i) {
            const u32x4 uu = *(const u32x4*)(og + i * 8);
#pragma unroll
            for (int e = 0; e < 4; ++e) {
              const float a0 = os[i * 8 + 2 * e] + bflo(uu[e]), a1 = os[i * 8 + 2 * e + 1] + bfhi(uu[e]);
              ss += a0 * a0 + a1 * a1;
            }
          }
          ss += __shfl_xor(ss, 1, 64);
          ss += __shfl_xor(ss, 2, 64);
          const float rstd = rsqrtf(ss * (1.f / 128.f) + EPSF);
          const float* gn = p.in[I_GON] + l * 128 + qd * 32;
          const bf16* gr = (const bf16*)(p.ws + OFF_GR) + tok * 512 + hd * 128 + qd * 32;
#pragma unroll 1
          for (int i = 0; i < 4; ++i) {
            const u32x4 uo = *(const u32x4*)(og + i * 8);
            const u32x4 ug = *(const u32x4*)(gr + i * 8);
            u32x4 uu;
#pragma unroll
            for (int e = 0; e < 4; ++e) {
              const float v0 = os[i * 8 + 2 * e] + bflo(uo[e]), v1 = os[i * 8 + 2 * e + 1] + bfhi(uo[e]);
              const float a0 = v0 * rstd * gn[i * 8 + 2 * e] * siluf_(bflo(ug[e]));
              const float a1 = v1 * rstd * gn[i * 8 + 2 * e + 1] * siluf_(bfhi(ug[e]));
              uu[e] = pack2(a0, a1);
            }
            *(u32x4*)(og + i * 8) = uu;
          }
        }
        __syncthreads();
      }
    }
    if (!WITH_OUT) {
#pragma unroll
      for (int dkt = 0; dkt < 2; ++dkt)
#pragma unroll
        for (int i = 0; i < 16; ++i) GSu[(w * 32 + crow(i, h)) * 64 + dkt * 32 + r] = sacc[dkt][i];
      if (part == 0) ((float*)(p.ws + OFF_DECG))[((size_t)((b * 4 + hd) * 2 + dir) * NG33 + gi) * 64 + dk] = __expf(gtot);
    }
    __syncthreads();
  }
}

DI void gla_scan_job(const Params& p, int j) {
  const int idx = j * 256 + TIDX;
  const int seq = idx >> 13, el = idx & 8191, dk = el & 63, dir = seq & 1;
  float* GS = (float*)(p.ws + OFF_GS) + (size_t)seq * NG33 * 8192 + el;
  const float* DG = (const float*)(p.ws + OFF_DECG) + (size_t)seq * NG33 * 64 + dk;
  float s = 0.f;
  for (int st0 = 0; st0 < 33; st0 += 11) {
    float kv[11], dc[11];
#pragma unroll
    for (int q = 0; q < 11; ++q) {
      const int st = st0 + q;
      const int g = (dir == 0 || st == 0) ? st : 33 - st;
      kv[q] = GS[(size_t)g * 8192];
      dc[q] = DG[g * 64];
    }
#pragma unroll
    for (int q = 0; q < 11; ++q) {
      const int st = st0 + q;
      const int g = (dir == 0 || st == 0) ? st : 33 - st;
      GS[(size_t)g * 8192] = s;
      s = dc[q] * s + kv[q];
    }
  }
}

DI void s5_end_tile(const Params& p, int j, char* smem) {
  const int nt = j & 1, mt = (j >> 1) % 9, g = j / 18;
  const bf16* SU = (const bf16*)(p.ws + OFF_SU);
  const bf16* F = (const bf16*)(p.ws + OFF_F5) + ((size_t)g * 256 + nt * 128) * 512;
  f32x16 acc[2][2];
  acc_zero(acc);
  gemm_main(acc,
            [&](int r) -> const bf16* {
              const int m = mt * 128 + r;
              if (m >= MS5) return nullptr;
              const int b = m / NCH, ch = m - b * NCH;
              return SU + ((size_t)(b * 16 + g) * TT + ch * 32) * 16;
            },
            [&](int r) { return F + (size_t)r * 512; }, 512, smem);
  float* Cs = (float*)smem;
  acc_to_lds(acc, Cs);
  __syncthreads();
  float* EN = (float*)(p.ws + OFF_EN);
  for (int c = TIDX; c < 128 * 32; c += 256) {
    const int row = c >> 5, c4 = (c & 31) * 4, m = mt * 128 + row;
    if (m < MS5) {
      const float* s = Cs + row * CLD + c4;
      f32x4 v = {s[0], s[1], s[2], s[3]};
      *(f32x4*)(EN + ((size_t)m * 16 + g) * 256 + nt * 128 + c4) = v;
    }
  }
  __syncthreads();
}

DI void s5_scan_job(const Params& p, int l, int j, char* smem) {
  float2* ends = (float2*)smem;
  const int dir = j & 1, g = (j >> 1) & 15, b = j >> 5;
  const int pp = TIDX & 63, seg = TIDX >> 6;
  const float2 aL = ((const float2*)(p.ws + OFF_PWR))[((size_t)((l * 2 + dir) * 16 + g) * 33 + 32) * 64 + pp];
  const float* EN = (const float*)(p.ws + OFF_EN);
  bf16* SB = (bf16*)(p.ws + OFF_SB);
  float sr = 0.f, si = 0.f;
  for (int q0 = 0; q0 < 66; q0 += 11) {
    float er[11], ei[11];
#pragma unroll
    for (int q = 0; q < 11; ++q) {
      const int pos = seg * 66 + q0 + q;
      const int ch = dir ? (pos < 8 ? 7 - pos : 271 - pos) : pos;
      const float* e = EN + ((size_t)(b * NCH + ch) * 16 + g) * 256 + dir * 128 + pp;
      er[q] = e[0]; ei[q] = e[64];
    }
#pragma unroll
    for (int q = 0; q < 11; ++q) {
      const float nr = aL.x * sr - aL.y * si + er[q], ni = aL.x * si + aL.y * sr + ei[q];
      sr = nr; si = ni;
    }
  }
  ends[seg * 64 + pp] = make_float2(sr, si);
  float pr = 1.f, pi = 0.f;
  for (int q = 0; q < 66; ++q) { const float nr = pr * aL.x - pi * aL.y, ni = pr * aL.y + pi * aL.x; pr = nr; pi = ni; }
  __syncthreads();
  sr = 0.f; si = 0.f;
  for (int k = 0; k < seg; ++k) {
    const float2 e = ends[k * 64 + pp];
    const float nr = pr * sr - pi * si + e.x, ni = pr * si + pi * sr + e.y;
    sr = nr; si = ni;
  }
  for (int q0 = 0; q0 < 66; q0 += 11) {
    float er[11], ei[11];
#pragma unroll
    for (int q = 0; q < 11; ++q) {
      const int pos = seg * 66 + q0 + q;
      const int ch = dir ? (pos < 8 ? 7 - pos : 271 - pos) : pos;
      const float* e = EN + ((size_t)(b * NCH + ch) * 16 + g) * 256 + dir * 128 + pp;
      er[q] = e[0]; ei[q] = e[64];
    }
#pragma unroll
    for (int q = 0; q < 11; ++q) {
      const int pos = seg * 66 + q0 + q;
      const int ch = dir ? (pos < 8 ? 7 - pos : 271 - pos) : pos;
      bf16* sb = SB + ((size_t)(b * NCH + ch) * 16 + g) * 256 + dir * 128 + pp;
      sb[0] = f2bf(sr); sb[64] = f2bf(si);
      const float nr = aL.x * sr - aL.y * si + er[q], ni = aL.x * si + aL.y * sr + ei[q];
      sr = nr; si = ni;
    }
  }
  __syncthreads();
}

DI float gelu_tanh(float x) {
  const float u = 0.7978845608028654f * (x + 0.044715f * x * x * x);
  return 0.5f * x * (1.f + tanhf(u));
}

DI void s5_out_tile(const Params& p, int j, char* smem) {
  const int nt = j & 3, mt = (j >> 2) % 9, g = j / 36;
  const bf16* SU = (const bf16*)(p.ws + OFF_SU);
  const bf16* SB = (const bf16*)(p.ws + OFF_SB);
  const bf16* Tm = (const bf16*)(p.ws + OFF_T5) + ((size_t)g * 512 + nt * 128) * 512;
  const bf16* Em = (const bf16*)(p.ws + OFF_E5) + ((size_t)g * 512 + nt * 128) * 256;
  f32x16 acc[2][2];
  acc_zero(acc);
  gemm_main(acc,
            [&](int r) -> const bf16* {
              const int m = mt * 128 + r;
              if (m >= MS5) return nullptr;
              const int b = m / NCH, ch = m - b * NCH;
              return SU + ((size_t)(b * 16 + g) * TT + ch * 32) * 16;
            },
            [&](int r) { return Tm + (size_t)r * 512; }, 512, smem);
  gemm_main(acc,
            [&](int r) -> const bf16* {
              const int m = mt * 128 + r;
              if (m >= MS5) return nullptr;
              return SB + ((size_t)m * 16 + g) * 256;
            },
            [&](int r) { return Em + (size_t)r * 256; }, 256, smem);
  float* Cs = (float*)smem;
  acc_to_lds(acc, Cs);
  __syncthreads();
  bf16* Y5 = (bf16*)(p.ws + OFF_Y5);
  for (int c = TIDX; c < 2048; c += 256) {
    const int row = c >> 4, c8 = c & 15, m = mt * 128 + row;
    if (m < MS5) {
      const int b = m / NCH, ch = m - b * NCH;
      const int n = nt * 128 + c8 * 8, i = n >> 4, hh = n & 15;
      const float* s = Cs + row * CLD + c8 * 8;
      u32x4 u;
#pragma unroll
      for (int e = 0; e < 4; ++e) u[e] = pack2(gelu_tanh(s[2 * e]), gelu_tanh(s[2 * e + 1]));
      *(u32x4*)(Y5 + ((size_t)b * TT + ch * 32 + i) * 256 + g * 16 + hh) = u;
    }
  }
  __syncthreads();
}

DI void glu_tile(const Params& p, int l, int j, char* smem) {
  const int nt = j & 1, mt = j >> 1;
  const bf16* Y5 = (const bf16*)(p.ws + OFF_Y5) + (size_t)mt * 128 * 256;
  const bf16* W = wl(p, l, WL_GLU) + (size_t)nt * 128 * 256;
  f32x16 acc[2][2];
  acc_zero(acc);
  gemm_main_s(acc, Y5, 256, W, 256, 256, smem);
  float* Cs = (float*)smem;
  acc_to_lds(acc, Cs);
  __syncthreads();
  const float* gb = p.in[I_GLUB] + l * 256 + nt * 128;
  bf16* O = (bf16*)(p.ws + OFF_OS5) + (size_t)mt * 128 * 256 + nt * 128;
  for (int c = TIDX; c < 2048; c += 256) {
    const int row = c >> 4, cc = (c & 15) * 8;
    const float* s = Cs + row * CLD + cc;
    const u32x4 yu = *(const u32x4*)(Y5 + (size_t)row * 256 + nt * 128 + cc);
    u32x4 u;
#pragma unroll
    for (int e = 0; e < 4; ++e) {
      const float y0 = bflo(yu[e]), y1 = bfhi(yu[e]);
      u[e] = pack2(y0 * sigmoidf_(s[2 * e] + gb[cc + 2 * e]), y1 * sigmoidf_(s[2 * e + 1] + gb[cc + 2 * e + 1]));
    }
    *(u32x4*)(O + (size_t)row * 256 + cc) = u;
  }
  __syncthreads();
}

DI void merge_tile(const Params& p, int l, int j, char* smem) {
  const int nt = j & 7, mt = j >> 3;
  const bf16* H = (const bf16*)(p.ws + OFF_H) + (size_t)mt * 128 * DM;
  unsigned am[2][2][8];
#pragma unroll
  for (int a = 0; a < 2; ++a)
#pragma unroll
    for (int bq = 0; bq < 2; ++bq)
#pragma unroll
      for (int i = 0; i < 8; ++i) am[a][bq][i] = 0u;
#pragma unroll 1
  for (int x = 0; x < 3; ++x) {
    const bf16* Wg = wl(p, l, WL_WIN) + ((size_t)2432 + x * 1024 + nt * 128) * DM;
    unsigned sg[2][2][8];
    {
      f32x16 acc[2][2];
      acc_zero(acc);
      gemm_main_s(acc, H, DM, Wg, DM, DM, smem);
#pragma unroll
      for (int a = 0; a < 2; ++a)
#pragma unroll
        for (int bq = 0; bq < 2; ++bq)
#pragma unroll
          for (int i = 0; i < 8; ++i) sg[a][bq][i] = pack2(sigmoidf_(acc[a][bq][2 * i]), sigmoidf_(acc[a][bq][2 * i + 1]));
    }
    const bf16* A; const bf16* Wb; int K;
    if (x == 0) { A = (const bf16*)(p.ws + OFF_OATT) + (size_t)mt * 128 * 256; Wb = wl(p, l, WL_BRA) + (size_t)nt * 128 * 256; K = 256; }
    else if (x == 1) { A = (const bf16*)(p.ws + OFF_OGLA) + (size_t)mt * 128 * 512; Wb = wl(p, l, WL_BRG) + (size_t)nt * 128 * 512; K = 512; }
    else { A = (const bf16*)(p.ws + OFF_OS5) + (size_t)mt * 128 * 256; Wb = wl(p, l, WL_BRS) + (size_t)nt * 128 * 256; K = 256; }
#pragma unroll
    for (int hf = 0; hf < 2; ++hf) {
      f32x16 a2[2];
#pragma unroll
      for (int i = 0; i < 16; ++i) { a2[0][i] = 0.f; a2[1][i] = 0.f; }
      gemm_main_half(a2, A, K, Wb, K, K, hf, smem);
#pragma unroll
      for (int a = 0; a < 2; ++a)
#pragma unroll
        for (int i = 0; i < 8; ++i) {
          const float v0 = bflo(am[a][hf][i]) + bflo(sg[a][hf][i]) * a2[a][2 * i];
          const float v1 = bfhi(am[a][hf][i]) + bfhi(sg[a][hf][i]) * a2[a][2 * i + 1];
          am[a][hf][i] = pack2(v0, v1);
        }
    }
  }
  f32x16 accm[2][2];
#pragma unroll
  for (int a = 0; a < 2; ++a)
#pragma unroll
    for (int bq = 0; bq < 2; ++bq)
#pragma unroll
      for (int i = 0; i < 8; ++i) { accm[a][bq][2 * i] = bflo(am[a][bq][i]); accm[a][bq][2 * i + 1] = bfhi(am[a][bq][i]); }
  float* Cs = (float*)smem;
  acc_to_lds(accm, Cs);
  __syncthreads();
  store_tile_bf16(Cs, (bf16*)(p.ws + OFF_MG) + (size_t)mt * 128 * DM + nt * 128, DM, 128, 1.f);
  __syncthreads();
}

DI void plain_tile(const bf16* A, int K, const bf16* W, bf16* dst, int ldd, char* smem) {
  f32x16 acc[2][2];
  acc_zero(acc);
  gemm_main_s(acc, A, K, W, K, K, smem);
  float* Cs = (float*)smem;
  acc_to_lds(acc, Cs);
  __syncthreads();
  store_tile_bf16(Cs, dst, ldd, 128, 1.f);
  __syncthreads();
}

DI void up_tile(const Params& p, int l, int j, char* smem) {
  const int jn = j % 44, mtile = j / 44;
  const int b = mtile / 69, rr0 = mtile % 69;
  int seqbase, len, ti;
  if (rr0 < 3) { seqbase = b * TT; len = CTXL; ti = rr0; }
  else { seqbase = b * TT + CTXL; len = SEQ; ti = rr0 - 3; }
  const int pos0 = ti * 126 - 1;
  const bf16* H = (const bf16*)(p.ws + OFF_H);
  const bf16* W = wl(p, l, WL_UP) + (size_t)jn * 128 * DM;
  f32x16 acc[2][2];
  acc_zero(acc);
  gemm_main(acc,
            [&](int r) -> const bf16* {
              const int pos = pos0 + r;
              return (pos >= 0 && pos < len) ? H + (size_t)(seqbase + pos) * DM : nullptr;
            },
            [&](int r) { return W + (size_t)r * DM; }, DM, smem);
  float* Cs = (float*)smem;
  acc_to_lds(acc, Cs);
  __syncthreads();
  const float* cw = p.in[I_CW] + (size_t)l * 3 * 2 * DFF;
  const float* cb = p.in[I_CB] + (size_t)l * 2 * DFF;
  bf16* G = (bf16*)(p.ws + OFF_G);
  for (int idx = TIDX; idx < 126 * 32; idx += 256) {
    const int rr = 1 + (idx >> 5), c = (idx & 31) * 2;
    const int pos = pos0 + rr;
    if (pos < len) {
      float gv[2];
#pragma unroll
      for (int e = 0; e < 2; ++e) {
        const int ca = jn * 64 + c + e, cv = DFF + ca;
        const float a = cw[ca] * Cs[(rr - 1) * CLD + c + e] + cw[2 * DFF + ca] * Cs[rr * CLD + c + e] +
                        cw[4 * DFF + ca] * Cs[(rr + 1) * CLD + c + e] + cb[ca];
        const float v = cw[cv] * Cs[(rr - 1) * CLD + 64 + c + e] + cw[2 * DFF + cv] * Cs[rr * CLD + 64 + c + e] +
                        cw[4 * DFF + cv] * Cs[(rr + 1) * CLD + 64 + c + e] + cb[cv];
        gv[e] = siluf_(a) * v;
      }
      *(unsigned*)(G + (size_t)(seqbase + pos) * DFF + jn * 64 + c) = pack2(gv[0], gv[1]);
    }
  }
  __syncthreads();
}

DI bool gemm_job(int bid, int G, int it, int MT, int NTL, int& mt, int& nt) {
  const int x = bid & 7, q = bid >> 3, Q = G >> 3;
  const int m0 = (x * MT) >> 3, m1 = ((x + 1) * MT) >> 3, Mx = m1 - m0;
  const int jl = q + Q * it;
  if (jl >= Mx * NTL) return false;
  const int full = Mx * 8;
  const int c = jl / full, rem = jl - c * full;
  const int wc = min(8, NTL - 8 * c);
  const int mi = rem / wc;
  mt = m0 + mi;
  nt = 8 * c + (rem - mi * wc);
  return true;
}

enum { PH_PREP = 0, PH_ROW0, PH_PROJ, PH_MIX1, PH_SCAN, PH_MIX2, PH_GLU, PH_MERGE, PH_WOUT, PH_ROW1, PH_UP, PH_DOWN, PH_ROW2 };
constexpr int N_PHASES = 2 + 11 * NL;

DI void run_phase(const Params& p, int ph, int l, char* smem) {
  const int bid = blockIdx.x;
#ifdef HALFMASK
  const int G = ((HALFMASK >> ph) & 1) ? 256 : gridDim.x;
  if (bid >= G) return;
#else
  const int G = gridDim.x;
#endif
#ifdef PHMASK
  if (!((PHMASK >> ph) & 1)) return;
#endif
  switch (ph) {
    case PH_PREP:
      for (int j = bid; j < 128 + 16064; j += G) {
        if (j < 96) prep_mod_job(p, j, smem);
        else if (j < 128) prep_s5_job(p, j - 96);
        else prep_wt_job(p, j - 128, smem);
      }
      break;
    case PH_ROW0:
      row_phase<0>(p, 0, bid, G);
      ktab_phase(p, bid, G);
      break;
    case PH_PROJ:
#ifdef EXP_A
      if (bid < 256) { int mt, nt; for (int it = 0; gemm_job(bid, 256, it, 264, 19, mt, nt); ++it) proj_tile(p, l, mt, nt, smem); }
      s5mat_phase(p, l, bid, G);
#elif defined(EXP_C)
      if (bid < 256) for (int j = bid; j < 264 * 19; j += 256) { if ((EXP_C >> (j % 19)) & 1) proj_tile(p, l, j / 19, j % 19, smem); }
      for (int j = bid; j < 264 * 19; j += G) { if (!((EXP_C >> (j % 19)) & 1)) proj_tile(p, l, j / 19, j % 19, smem); }
      s5mat_phase(p, l, bid, G);
#elif defined(EXP_B)
      for (int j = bid; j < 264 * 19; j += G) proj_tile(p, l, j / 19, j % 19, smem);
      if (bid < 256) s5mat_phase(p, l, bid, 256);
#else
      for (int j = bid; j < 264 * 19; j += G) proj_tile(p, l, j / 19, j % 19, smem);
      s5mat_phase(p, l, bid, G);
#endif
      break;
    case PH_MIX1:
      for (int j = bid; j < 1056 + 1056 + 288; j += G) {
        if (j < 1056) attn_unit(p, j, smem);
        else if (j < 2112) gla_unit<false>(p, l, j - 1056, smem);
        else s5_end_tile(p, j - 2112, smem);
      }
      break;
    case PH_SCAN:
      for (int j = bid; j < 1024 + 128; j += G) {
        if (j < 1024) gla_scan_job(p, j);
        else s5_scan_job(p, l, j - 1024, smem);
      }
      break;
    case PH_MIX2:
      for (int j = bid; j < 528 + 576; j += G) {
        if (j < 528) gla_unit<true>(p, l, j, smem);
        else s5_out_tile(p, j - 528, smem);
      }
      break;
    case PH_GLU:
      { int mt, nt; for (int it = 0; gemm_job(bid, G, it, 264, 2, mt, nt); ++it) glu_tile(p, l, mt * 2 + nt, smem); }
      break;
    case PH_MERGE:
      { int mt, nt; for (int it = 0; gemm_job(bid, G, it, 264, 8, mt, nt); ++it) merge_tile(p, l, mt * 8 + nt, smem); }
      break;
    case PH_WOUT:
      for (int it = 0;; ++it) {
        int mt, nt;
        if (!gemm_job(bid, G, it, 264, 8, mt, nt)) break;
        plain_tile((const bf16*)(p.ws + OFF_MG) + (size_t)mt * 128 * DM, DM, wl(p, l, WL_WOUT) + (size_t)nt * 128 * DM,
                   (bf16*)(p.ws + OFF_H) + (size_t)mt * 128 * DM + nt * 128, DM, smem);
      }
      break;
    case PH_ROW1: row_phase<1>(p, l, bid, G); break;
    case PH_UP:
      { int mt, nt; for (int it = 0; gemm_job(bid, G, it, 276, 44, mt, nt); ++it) up_tile(p, l, mt * 44 + nt, smem); }
      break;
    case PH_DOWN:
      for (int it = 0;; ++it) {
        int mt, nt;
        if (!gemm_job(bid, G, it, 264, 8, mt, nt)) break;
        plain_tile((const bf16*)(p.ws + OFF_G) + (size_t)mt * 128 * DFF, DFF, wl(p, l, WL_DOWN) + (size_t)nt * 128 * DFF,
                   (bf16*)(p.ws + OFF_H) + (size_t)mt * 128 * DM + nt * 128, DM, smem);
      }
      break;
    case PH_ROW2: row_phase<2>(p, l, bid, G); break;
  }
}

DI void grid_barrier(unsigned* bar, unsigned& gen) {
  asm volatile("s_waitcnt vmcnt(0)" ::: "memory");
  __syncthreads();
  gen += 1;
  if (threadIdx.x == 0) {
    __builtin_amdgcn_fence(__ATOMIC_RELEASE, "agent");
    asm volatile("s_waitcnt vmcnt(0)" ::: "memory");
    const unsigned target = gen * gridDim.x;
    __hip_atomic_fetch_add(bar, 1u, __ATOMIC_RELAXED, __HIP_MEMORY_SCOPE_AGENT);
    while (__hip_atomic_load(bar, __ATOMIC_RELAXED, __HIP_MEMORY_SCOPE_AGENT) < target) __builtin_amdgcn_s_sleep(2);
  }
  __syncthreads();
  __builtin_amdgcn_fence(__ATOMIC_ACQUIRE, "agent");
  asm volatile("s_waitcnt vmcnt(0)" ::: "memory");
}

__global__ void __launch_bounds__(256, 2) hybrid_fwd(Params p, int ph_lo, int ph_hi) {
  extern __shared__ __attribute__((aligned(16))) char smem[];
  unsigned* bar = (unsigned*)(p.ws + OFF_BAR);
  unsigned gen = 0;
  if (ph_hi - ph_lo > 1) cg::this_grid().sync();
  int i = 0;
#define STEP(PH, L)                                      \
  {                                                      \
    if (i >= ph_lo && i < ph_hi) {                       \
      Params q;                                          \
      q.ws = p.ws; q.out = p.out;                        \
      asm volatile("" : "+s"(q.ws), "+s"(q.out));        \
      _Pragma("unroll") for (int k = 0; k < 34; ++k) { q.in[k] = p.in[k]; asm volatile("" : "+s"(q.in[k])); } \
      run_phase(q, PH, L, smem);                         \
      if ((DUPMASK >> (PH)) & 1) { grid_barrier(bar, gen); run_phase(q, PH, L, smem); } \
      if (i + 1 < ph_hi) grid_barrier(bar, gen);         \
    }                                                    \
    ++i;                                                 \
  }
  STEP(PH_PREP, 0)
  STEP(PH_ROW0, 0)
#pragma unroll 1
  for (int l = 0; l < NL; ++l) {
    STEP(PH_PROJ, l)
    STEP(PH_MIX1, l)
    STEP(PH_SCAN, l)
    STEP(PH_MIX2, l)
    STEP(PH_GLU, l)
    STEP(PH_MERGE, l)
    STEP(PH_WOUT, l)
    STEP(PH_ROW1, l)
    STEP(PH_UP, l)
    STEP(PH_DOWN, l)
    STEP(PH_ROW2, l)
  }
#undef STEP
}

extern "C" void kernel_launch(void* const* d_in, const int* in_sizes, int n_in, void* d_out, int out_size, void* d_ws, size_t ws_size,
                              hipStream_t stream) {
  static int grid_blocks = 0;
  if (!grid_blocks) {
    int dev = 0, cus = 0, per_cu = 0;
    hipGetDevice(&dev);
    hipDeviceGetAttribute(&cus, hipDeviceAttributeMultiprocessorCount, dev);
    hipFuncSetAttribute((const void*)hybrid_fwd, hipFuncAttributeMaxDynamicSharedMemorySize, SMEM_BYTES);
    hipOccupancyMaxActiveBlocksPerMultiprocessor(&per_cu, hybrid_fwd, 256, SMEM_BYTES);
    if (per_cu < 1) per_cu = 1;
    if (per_cu > 2) per_cu = 2;
    grid_blocks = cus * per_cu;
    if (ws_size < OFF_END + 256) fprintf(stderr, "workspace too small: %zu < %zu\n", ws_size, (size_t)OFF_END);
  }
  Params p{};
  for (int i = 0; i < 34; ++i) p.in[i] = (const float*)d_in[i];
  p.out = (float*)d_out;
  p.ws = (char*)d_ws;
#if ONE_LAUNCH
  hipMemsetAsync((char*)d_ws + OFF_BAR, 0, 256, stream);
  int lo = 0, hi = N_PHASES;
  void* args[] = {&p, &lo, &hi};
  hipError_t e = hipLaunchCooperativeKernel((void*)hybrid_fwd, dim3(grid_blocks), dim3(256), args, SMEM_BYTES, stream);
  if (e != hipSuccess) fprintf(stderr, "cooperative launch failed: %s (grid %d)\n", hipGetErrorString(e), grid_blocks);
#else
  for (int i = 0; i < N_PHASES; ++i) hipLaunchKernelGGL(hybrid_fwd, dim3(grid_blocks), dim3(256), SMEM_BYTES, stream, p, i, i + 1);
#endif
}
```

```cpp
#include <hip/hip_runtime.h>
#include <hip/hip_cooperative_groups.h>
#include <stdint.h>
#include <cstdio>
namespace cg = cooperative_groups;

#define EXP_A 1
#ifndef DUPMASK
#define DUPMASK 0
#endif
#ifndef ONE_LAUNCH
#define ONE_LAUNCH 1
#endif

typedef unsigned short bf16;
typedef __attribute__((ext_vector_type(8))) short s16x8;
typedef __attribute__((ext_vector_type(4))) short s16x4;
typedef __attribute__((ext_vector_type(16))) float f32x16;
typedef __attribute__((ext_vector_type(4))) float f32x4;
typedef __attribute__((ext_vector_type(2))) float f32x2;
typedef __attribute__((ext_vector_type(4))) unsigned u32x4;
typedef __attribute__((ext_vector_type(2))) unsigned u32x2;
typedef __attribute__((ext_vector_type(2))) __bf16 bf16x2_t;

#define DI __device__ __forceinline__
#define MFMA32(a, b, c) __builtin_amdgcn_mfma_f32_32x32x16_bf16((a), (b), (c), 0, 0, 0)

DI int tidx_opaque() { int t = threadIdx.x; asm volatile("" : "+v"(t)); return t; }
#define TIDX tidx_opaque()
DI bf16 f2bf(float x) { return __builtin_bit_cast(unsigned short, (__bf16)x); }
DI float bf2f(bf16 v) { return __uint_as_float(((unsigned)v) << 16); }
DI unsigned pack2(float a, float b) {
  f32x2 v = {a, b};
  return __builtin_bit_cast(unsigned, __builtin_convertvector(v, bf16x2_t));
}
DI float bflo(unsigned u) { return __uint_as_float(u << 16); }
DI float bfhi(unsigned u) { return __uint_as_float(u & 0xffff0000u); }
typedef const __attribute__((address_space(1))) u32x4* gptr16;
DI u32x4 ldg16(const void* q) { return *(gptr16)(uintptr_t)q; }
#define SCHED_FENCE() __builtin_amdgcn_sched_barrier(0)
DI int crow(int i, int h) { return (i & 3) + 8 * (i >> 2) + 4 * h; }
DI void sincos_cw(float x, float& sn, float& cs) {
  const float k = rintf(x * 0.63661977236758134f);
  float r = fmaf(-k, 1.57079637050628662109375f, x);
  r = fmaf(-k, -4.371139000186241e-08f, r);
  const int q = ((int)k) & 3;
  const float r2 = r * r;
  const float sp = r + r * r2 * (-1.6666667163e-01f + r2 * (8.3333337680e-03f + r2 * (-1.9841270114e-04f + r2 * 2.7557314297e-06f)));
  const float cp = 1.f + r2 * (-0.5f + r2 * (4.1666667908e-02f + r2 * (-1.3888889225e-03f + r2 * (2.4801587642e-05f - r2 * 2.7557314297e-07f))));
  sn = (q == 0) ? sp : (q == 1) ? cp : (q == 2) ? -sp : -cp;
  cs = (q == 0) ? cp : (q == 1) ? -sp : (q == 2) ? -cp : sp;
}
DI float sigmoidf_(float x) { return 1.f / (1.f + __expf(-x)); }
DI float siluf_(float x) { return x / (1.f + __expf(-x)); }

constexpr int DM = 1024, NB = 4, SEQ = 8192, CTXL = 256, TT = SEQ + CTXL, NTOK = NB * TT, NL = 4;
constexpr int DFF = 2816, DIN = 5408;
constexpr float EPSF = 1e-6f;
constexpr int NG33 = 33;
constexpr int NCH = 264;
constexpr int MS5 = NB * NCH;

constexpr size_t SZ_H = (size_t)NTOK * 1024 * 2;
constexpr size_t OFF_H = 0;
constexpr size_t OFF_P = OFF_H + SZ_H;
constexpr size_t OFF_Q = OFF_P;
constexpr size_t OFF_K = OFF_Q + (size_t)NTOK * 256 * 2;
constexpr size_t OFF_VT = OFF_K + (size_t)NTOK * 128 * 2;
constexpr size_t OFF_GQ = OFF_VT + (size_t)NTOK * 128 * 2;
constexpr size_t OFF_GK = OFF_GQ + (size_t)NTOK * 256 * 2;
constexpr size_t OFF_GVT = OFF_GK + (size_t)NTOK * 256 * 2;
constexpr size_t OFF_GR = OFF_GVT + (size_t)NTOK * 512 * 2;
constexpr size_t OFF_SU = OFF_GR + (size_t)NTOK * 512 * 2;
constexpr size_t OFF_LOW = OFF_SU + (size_t)NTOK * 256 * 2;
constexpr size_t OFF_O = OFF_LOW + (size_t)NTOK * 32 * 4;
constexpr size_t OFF_OATT = OFF_O;
constexpr size_t OFF_OGLA = OFF_OATT + (size_t)NTOK * 256 * 2;
constexpr size_t OFF_Y5 = OFF_OGLA + (size_t)NTOK * 512 * 2;
constexpr size_t OFF_EN = OFF_Y5;
constexpr size_t OFF_OS5 = OFF_Y5 + (size_t)NTOK * 256 * 2;
constexpr size_t OFF_M = OFF_OS5 + (size_t)NTOK * 256 * 2;
constexpr size_t OFF_MG = OFF_M;
constexpr size_t OFF_GS = OFF_M;
constexpr size_t OFF_DECG = OFF_GS + (size_t)32 * 33 * 8192 * 4;
constexpr size_t OFF_SB = OFF_DECG + (size_t)32 * 33 * 64 * 4;
constexpr size_t OFF_T5 = OFF_SB + (size_t)MS5 * 16 * 256 * 2;
constexpr size_t OFF_E5 = OFF_T5 + (size_t)16 * 512 * 512 * 2;
constexpr size_t OFF_F5 = OFF_E5 + (size_t)16 * 512 * 256 * 2;
constexpr size_t OFF_MEND = OFF_F5 + (size_t)16 * 256 * 512 * 2;
static_assert(OFF_MEND <= OFF_M + SZ_H, "mixer scratch overflows merged area");
constexpr size_t OFF_W = OFF_M + SZ_H;
constexpr size_t WL_WIN = 0, WL_BRA = WL_WIN + (size_t)5504 * 1024, WL_BRG = WL_BRA + 1024 * 256, WL_BRS = WL_BRG + 1024 * 512,
                 WL_WOUT = WL_BRS + 1024 * 256, WL_UP = WL_WOUT + 1024 * 1024, WL_DOWN = WL_UP + (size_t)5632 * 1024,
                 WL_GLU = WL_DOWN + (size_t)1024 * 2816, WL_TOTAL = WL_GLU + 256 * 256;
constexpr size_t OFF_XC = OFF_W + WL_TOTAL * 2 * NL;
constexpr size_t OFF_MOD = OFF_XC + (size_t)NB * CTXL * 1024 * 4;
constexpr size_t OFF_BBR = OFF_MOD + (size_t)NL * 5 * 6144 * 4;
constexpr size_t OFF_BBI = OFF_BBR + (size_t)NL * 2 * 16 * 64 * 16 * 4;
constexpr size_t OFF_PWR = OFF_BBI + (size_t)NL * 2 * 16 * 64 * 16 * 4;
constexpr size_t OFF_KTAB = OFF_PWR + (size_t)NL * 2 * 16 * 33 * 64 * 8;
constexpr size_t OFF_END = OFF_KTAB + (size_t)NL * 16 * 2 * 32 * 256 * 4;
constexpr size_t OFF_BAR = OFF_END;
constexpr size_t OFF_ZERO = OFF_BAR + 256;
constexpr size_t OFF_G = OFF_P;
static_assert((size_t)NTOK * DFF * 2 <= OFF_M - OFF_P, "G overflows");

constexpr int SMEM_BYTES = 73728;

struct Params {
  const float* in[34];
  float* out;
  char* ws;
};

enum { I_X = 0, I_C, I_CTX, I_CCTX, I_ADAW, I_ADAB, I_NMPRE, I_NMPOST, I_NFPRE, I_NFPOST, I_WIN, I_QN, I_KN, I_GGW, I_GGB, I_GON,
       I_ARE, I_AIM, I_LDT, I_BRE, I_BIM, I_CRE, I_CIM, I_S5D, I_GLUW, I_GLUB, I_WBA, I_WBG, I_WBS, I_WOUT, I_UP, I_CW, I_CB, I_DOWN };

constexpr int LDT = 72;
constexpr int CLD = 132;

template <class FA, class FB>
DI void gemm_main(f32x16 (&acc)[2][2], FA fa, FB fb, int K, char* smem) {
  bf16* As = (bf16*)smem;
  bf16* Bs = (bf16*)(smem + 2 * 128 * LDT * 2);
  const int tid = TIDX, lane = tid & 63, w = tid >> 6, wm = w >> 1, wn = w & 1;
  const int r = lane & 31, h = lane >> 5;
  const int lr = tid >> 3, kc = (tid & 7) * 8;
  const bf16* ap[4];
  const bf16* bp[4];
#pragma unroll
  for (int i = 0; i < 4; ++i) {
    const bf16* a = fa(lr + 32 * i);
    const bf16* b = fb(lr + 32 * i);
    ap[i] = a ? a + kc : nullptr;
    bp[i] = b ? b + kc : nullptr;
  }
  u32x4 ra[4], rb[4];
  const u32x4 z4 = {0u, 0u, 0u, 0u};
#pragma unroll
  for (int i = 0; i < 4; ++i) {
    ra[i] = ap[i] ? ldg16(ap[i]) : z4;
    rb[i] = bp[i] ? ldg16(bp[i]) : z4;
  }
#pragma unroll
  for (int i = 0; i < 4; ++i) {
    *(u32x4*)(As + (lr + 32 * i) * LDT + kc) = ra[i];
    *(u32x4*)(Bs + (lr + 32 * i) * LDT + kc) = rb[i];
  }
  __syncthreads();
  const int nk = K / 64;
  for (int kt = 0; kt < nk; ++kt) {
    const int buf = kt & 1;
    const bool more = (kt + 1 < nk);
    if (more) {
      const int k0 = (kt + 1) * 64;
#pragma unroll
      for (int i = 0; i < 4; ++i) {
        ra[i] = ap[i] ? ldg16(ap[i] + k0) : z4;
        rb[i] = bp[i] ? ldg16(bp[i] + k0) : z4;
      }
    }
    SCHED_FENCE();
    const bf16* Ab = As + buf * 128 * LDT + (wm * 64 + r) * LDT + h * 8;
    const bf16* Bb = Bs + buf * 128 * LDT + (wn * 64 + r) * LDT + h * 8;
#pragma unroll
    for (int s = 0; s < 4; ++s) {
      s16x8 a0 = *(const s16x8*)(Ab + s * 16);
      s16x8 a1 = *(const s16x8*)(Ab + 32 * LDT + s * 16);
      s16x8 b0 = *(const s16x8*)(Bb + s * 16);
      s16x8 b1 = *(const s16x8*)(Bb + 32 * LDT + s * 16);
      acc[0][0] = MFMA32(a0, b0, acc[0][0]);
      acc[0][1] = MFMA32(a0, b1, acc[0][1]);
      acc[1][0] = MFMA32(a1, b0, acc[1][0]);
      acc[1][1] = MFMA32(a1, b1, acc[1][1]);
    }
    SCHED_FENCE();
    if (more) {
      bf16* Aw = As + (buf ^ 1) * 128 * LDT;
      bf16* Bw = Bs + (buf ^ 1) * 128 * LDT;
#pragma unroll
      for (int i = 0; i < 4; ++i) {
        *(u32x4*)(Aw + (lr + 32 * i) * LDT + kc) = ra[i];
        *(u32x4*)(Bw + (lr + 32 * i) * LDT + kc) = rb[i];
      }
    }
    __syncthreads();
  }
}

template <class FA, class FB>
DI void gemm_main_deep(f32x16 (&acc)[2][2], FA fa, FB fb, int K, char* smem) {
  bf16* As = (bf16*)smem;
  bf16* Bs = (bf16*)(smem + 2 * 128 * LDT * 2);
  const int tid = TIDX, lane = tid & 63, w = tid >> 6, wm = w >> 1, wn = w & 1;
  const int r = lane & 31, h = lane >> 5;
  const int lr = tid >> 3, kc = (tid & 7) * 8;
  const bf16* ap[4];
  const bf16* bp[4];
#pragma unroll
  for (int i = 0; i < 4; ++i) {
    const bf16* a = fa(lr + 32 * i);
    const bf16* b = fb(lr + 32 * i);
    ap[i] = a ? a + kc : nullptr;
    bp[i] = b ? b + kc : nullptr;
  }
  const u32x4 z4 = {0u, 0u, 0u, 0u};
  u32x4 a0[4], b0[4], a1[4], b1[4];
  const int nk = K / 64;
#define GD_LOAD(RA, RB, T)                                               \
  {                                                                      \
    const int k0_ = (T) * 64;                                            \
    _Pragma("unroll") for (int i = 0; i < 4; ++i) {                      \
      RA[i] = ap[i] ? ldg16(ap[i] + k0_) : z4;                           \
      RB[i] = bp[i] ? ldg16(bp[i] + k0_) : z4;                           \
    }                                                                    \
  }
#define GD_STORE(RA, RB, BUF)                                            \
  {                                                                      \
    _Pragma("unroll") for (int i = 0; i < 4; ++i) {                      \
      *(u32x4*)(As + (BUF) * 128 * LDT + (lr + 32 * i) * LDT + kc) = RA[i]; \
      *(u32x4*)(Bs + (BUF) * 128 * LDT + (lr + 32 * i) * LDT + kc) = RB[i]; \
    }                                                                    \
  }
#define GD_COMPUTE(BUF)                                                  \
  {                                                                      \
    const bf16* Ab = As + (BUF) * 128 * LDT + (wm * 64 + r) * LDT + h * 8; \
    const bf16* Bb = Bs + (BUF) * 128 * LDT + (wn * 64 + r) * LDT + h * 8; \
    _Pragma("unroll") for (int s = 0; s < 4; ++s) {                      \
      s16x8 fa0 = *(const s16x8*)(Ab + s * 16);                          \
      s16x8 fa1 = *(const s16x8*)(Ab + 32 * LDT + s * 16);               \
      s16x8 fb0 = *(const s16x8*)(Bb + s * 16);                          \
      s16x8 fb1 = *(const s16x8*)(Bb + 32 * LDT + s * 16);               \
      acc[0][0] = MFMA32(fa0, fb0, acc[0][0]);                           \
      acc[0][1] = MFMA32(fa0, fb1, acc[0][1]);                           \
      acc[1][0] = MFMA32(fa1, fb0, acc[1][0]);                           \
      acc[1][1] = MFMA32(fa1, fb1, acc[1][1]);                           \
    }                                                                    \
  }
  GD_LOAD(a0, b0, 0)
  GD_LOAD(a1, b1, 1)
  GD_STORE(a0, b0, 0)
  __syncthreads();
  if (nk > 2) GD_LOAD(a0, b0, 2)
  for (int kt = 0; kt < nk; kt += 2) {
    SCHED_FENCE();
    GD_COMPUTE(0)
    SCHED_FENCE();
    GD_STORE(a1, b1, 1)
    if (kt + 3 < nk) GD_LOAD(a1, b1, kt + 3)
    __syncthreads();
    SCHED_FENCE();
    GD_COMPUTE(1)
    SCHED_FENCE();
    if (kt + 2 < nk) {
      GD_STORE(a0, b0, 0)
      if (kt + 4 < nk) GD_LOAD(a0, b0, kt + 4)
    }
    __syncthreads();
  }
#undef GD_LOAD
#undef GD_STORE
#undef GD_COMPUTE
}

template <class FA, class FB>
DI void gemm_main_dma(f32x16 (&acc)[2][2], FA fa, FB fb, int K, char* smem) {
  char* As = smem;
  char* Bs = smem + 32768;
  const int tid = TIDX, lane = tid & 63, w = tid >> 6, wm = w >> 1, wn = w & 1;
  const int r = lane & 31, h = lane >> 5;
  const bf16* ap[4];
  const bf16* bp[4];
#pragma unroll
  for (int i = 0; i < 4; ++i) {
    const int row = w * 32 + i * 8 + (lane >> 3);
    const int c = (lane & 7) ^ ((row >> 1) & 7);
    ap[i] = fa(row) + c * 8;
    bp[i] = fb(row) + c * 8;
  }
  const int ldst = (w * 256 + lane) * 16;
#define GM_DMA(BUF, T)                                                                                        \
  {                                                                                                           \
    const int k0_ = (T) * 64;                                                                                 \
    _Pragma("unroll") for (int i = 0; i < 4; ++i) {                                                           \
      __builtin_amdgcn_global_load_lds((const unsigned*)(ap[i] + k0_), (unsigned*)(As + (BUF) * 16384 + ldst + i * 1024), 16, 0, 0); \
      __builtin_amdgcn_global_load_lds((const unsigned*)(bp[i] + k0_), (unsigned*)(Bs + (BUF) * 16384 + ldst + i * 1024), 16, 0, 0); \
    }                                                                                                         \
  }
  const int xr = (r >> 1) & 7;
  const int arow = (wm * 64 + r) * 128, brow = (wn * 64 + r) * 128;
  GM_DMA(0, 0)
  asm volatile("s_waitcnt vmcnt(0)" ::: "memory");
  __syncthreads();
  const int nk = K / 64;
  for (int kt = 0; kt < nk; ++kt) {
    const int buf = kt & 1;
    if (kt + 1 < nk) GM_DMA(buf ^ 1, kt + 1)
    const char* Ab = As + buf * 16384 + arow;
    const char* Bb = Bs + buf * 16384 + brow;
#pragma unroll
    for (int s = 0; s < 4; ++s) {
      const int co = ((2 * s + h) ^ xr) * 16;
      s16x8 a0 = *(const s16x8*)(Ab + co);
      s16x8 a1 = *(const s16x8*)(Ab + 32 * 128 + co);
      s16x8 b0 = *(const s16x8*)(Bb + co);
      s16x8 b1 = *(const s16x8*)(Bb + 32 * 128 + co);
      acc[0][0] = MFMA32(a0, b0, acc[0][0]);
      acc[0][1] = MFMA32(a0, b1, acc[0][1]);
      acc[1][0] = MFMA32(a1, b0, acc[1][0]);
      acc[1][1] = MFMA32(a1, b1, acc[1][1]);
    }
    asm volatile("s_waitcnt vmcnt(0)" ::: "memory");
    __syncthreads();
  }
#undef GM_DMA
}

DI void gemm_main_s(f32x16 (&acc)[2][2], const bf16* A, int lda, const bf16* B, int ldb, int K, char* smem) {
  bf16* As = (bf16*)smem;
  bf16* Bs = (bf16*)(smem + 2 * 128 * LDT * 2);
  const int tid = TIDX, lane = tid & 63, w = tid >> 6, wm = w >> 1, wn = w & 1;
  const int r = lane & 31, h = lane >> 5;
  const int lr = tid >> 3, kc = (tid & 7) * 8;
  const bf16* ap = A + (size_t)lr * lda + kc;
  const bf16* bp = B + (size_t)lr * ldb + kc;
  const size_t sa = (size_t)32 * lda, sb = (size_t)32 * ldb;
  u32x4 ra[4], rb[4];
#pragma unroll
  for (int i = 0; i < 4; ++i) {
    ra[i] = ldg16(ap + i * sa);
    rb[i] = ldg16(bp + i * sb);
  }
#pragma unroll
  for (int i = 0; i < 4; ++i) {
    *(u32x4*)(As + (lr + 32 * i) * LDT + kc) = ra[i];
    *(u32x4*)(Bs + (lr + 32 * i) * LDT + kc) = rb[i];
  }
  __syncthreads();
  const int nk = K / 64;
  for (int kt = 0; kt < nk; ++kt) {
    const int buf = kt & 1;
    const bool more = (kt + 1 < nk);
    if (more) {
      ap += 64; bp += 64;
#pragma unroll
      for (int i = 0; i < 4; ++i) {
        ra[i] = ldg16(ap + i * sa);
        rb[i] = ldg16(bp + i * sb);
      }
    }
    SCHED_FENCE();
    const bf16* Ab = As + buf * 128 * LDT + (wm * 64 + r) * LDT + h * 8;
    const bf16* Bb = Bs + buf * 128 * LDT + (wn * 64 + r) * LDT + h * 8;
#pragma unroll
    for (int s = 0; s < 4; ++s) {
      s16x8 a0 = *(const s16x8*)(Ab + s * 16);
      s16x8 a1 = *(const s16x8*)(Ab + 32 * LDT + s * 16);
      s16x8 b0 = *(const s16x8*)(Bb + s * 16);
      s16x8 b1 = *(const s16x8*)(Bb + 32 * LDT + s * 16);
      acc[0][0] = MFMA32(a0, b0, acc[0][0]);
      acc[0][1] = MFMA32(a0, b1, acc[0][1]);
      acc[1][0] = MFMA32(a1, b0, acc[1][0]);
      acc[1][1] = MFMA32(a1, b1, acc[1][1]);
    }
    SCHED_FENCE();
    if (more) {
      bf16* Aw = As + (buf ^ 1) * 128 * LDT;
      bf16* Bw = Bs + (buf ^ 1) * 128 * LDT;
#pragma unroll
      for (int i = 0; i < 4; ++i) {
        *(u32x4*)(Aw + (lr + 32 * i) * LDT + kc) = ra[i];
        *(u32x4*)(Bw + (lr + 32 * i) * LDT + kc) = rb[i];
      }
    }
    __syncthreads();
  }
}

DI void gemm_main_half(f32x16 (&acc)[2], const bf16* A, int lda, const bf16* B, int ldb, int K, int hf, char* smem) {
  bf16* As = (bf16*)smem;
  bf16* Bs = (bf16*)(smem + 2 * 128 * LDT * 2);
  const int tid = TIDX, lane = tid & 63, w = tid >> 6, wm = w >> 1, wn = w & 1;
  const int r = lane & 31, h = lane >> 5;
  const int lr = tid >> 3, kc = (tid & 7) * 8;
  const bf16* ap = A + (size_t)lr * lda + kc;
  const bf16* bp = B + (size_t)(hf * 32 + lr) * ldb + kc;
  const size_t sa = (size_t)32 * lda, sb = (size_t)64 * ldb;
  u32x4 ra[4], rb[2];
#pragma unroll
  for (int i = 0; i < 4; ++i) ra[i] = ldg16(ap + i * sa);
#pragma unroll
  for (int i = 0; i < 2; ++i) rb[i] = ldg16(bp + i * sb);
#pragma unroll
  for (int i = 0; i < 4; ++i) *(u32x4*)(As + (lr + 32 * i) * LDT + kc) = ra[i];
#pragma unroll
  for (int i = 0; i < 2; ++i) *(u32x4*)(Bs + (lr + 32 * i) * LDT + kc) = rb[i];
  __syncthreads();
  const int nk = K / 64;
  for (int kt = 0; kt < nk; ++kt) {
    const int buf = kt & 1;
    const bool more = (kt + 1 < nk);
    if (more) {
      ap += 64; bp += 64;
#pragma unroll
      for (int i = 0; i < 4; ++i) ra[i] = ldg16(ap + i * sa);
#pragma unroll
      for (int i = 0; i < 2; ++i) rb[i] = ldg16(bp + i * sb);
    }
    SCHED_FENCE();
    const bf16* Ab = As + buf * 128 * LDT + (wm * 64 + r) * LDT + h * 8;
    const bf16* Bb = Bs + buf * 128 * LDT + (wn * 32 + r) * LDT + h * 8;
#pragma unroll
    for (int s = 0; s < 4; ++s) {
      s16x8 a0 = *(const s16x8*)(Ab + s * 16);
      s16x8 a1 = *(const s16x8*)(Ab + 32 * LDT + s * 16);
      s16x8 b0 = *(const s16x8*)(Bb + s * 16);
      acc[0] = MFMA32(a0, b0, acc[0]);
      acc[1] = MFMA32(a1, b0, acc[1]);
    }
    SCHED_FENCE();
    if (more) {
      bf16* Aw = As + (buf ^ 1) * 128 * LDT;
      bf16* Bw = Bs + (buf ^ 1) * 128 * LDT;
#pragma unroll
      for (int i = 0; i < 4; ++i) *(u32x4*)(Aw + (lr + 32 * i) * LDT + kc) = ra[i];
#pragma unroll
      for (int i = 0; i < 2; ++i) *(u32x4*)(Bw + (lr + 32 * i) * LDT + kc) = rb[i];
    }
    __syncthreads();
  }
}

DI void acc_zero(f32x16 (&acc)[2][2]) {
#pragma unroll
  for (int a = 0; a < 2; ++a)
#pragma unroll
    for (int b = 0; b < 2; ++b)
#pragma unroll
      for (int i = 0; i < 16; ++i) acc[a][b][i] = 0.f;
}

DI void acc_to_lds(const f32x16 (&acc)[2][2], float* Cs) {
  const int lane = TIDX & 63, w = TIDX >> 6, wm = w >> 1, wn = w & 1, r = lane & 31, h = lane >> 5;
#pragma unroll
  for (int tm = 0; tm < 2; ++tm)
#pragma unroll
    for (int tn = 0; tn < 2; ++tn)
#pragma unroll
      for (int i = 0; i < 16; ++i) Cs[(wm * 64 + tm * 32 + crow(i, h)) * CLD + wn * 64 + tn * 32 + r] = acc[tm][tn][i];
}

DI void store_tile_bf16(const float* Cs, bf16* dst, size_t ld, int mvalid, float scale) {
  for (int c = TIDX; c < 2048; c += 256) {
    const int row = c >> 4, cc = (c & 15) * 8;
    if (row < mvalid) {
      const float* s = Cs + row * CLD + cc;
      u32x4 v;
      v[0] = pack2(s[0] * scale, s[1] * scale);
      v[1] = pack2(s[2] * scale, s[3] * scale);
      v[2] = pack2(s[4] * scale, s[5] * scale);
      v[3] = pack2(s[6] * scale, s[7] * scale);
      *(u32x4*)(dst + (size_t)row * ld + cc) = v;
    }
  }
}

DI float* resid_row(const Params& p, int tok) {
  const int b = tok / TT, t = tok - b * TT;
  return (t < CTXL) ? (float*)(p.ws + OFF_XC) + ((size_t)b * CTXL + t) * DM : p.out + ((size_t)b * SEQ + (t - CTXL)) * DM;
}
DI const float* mod_vec(const Params& p, int l, int tok, int which) {
  const int b = tok / TT, t = tok - b * TT;
  const int m = (t < CTXL) ? 4 : b;
  return (const float*)(p.ws + OFF_MOD) + ((size_t)(l * 5 + m) * 6 + which) * DM;
}
DI float wave_sum(float v) {
#pragma unroll
  for (int o = 32; o >= 1; o >>= 1) v += __shfl_xor(v, o, 64);
  return v;
}
DI bf16* wl(const Params& p, int l, size_t off) { return (bf16*)(p.ws + OFF_W) + (size_t)l * WL_TOTAL + off; }

DI void prep_mod_job(const Params& p, int j, char* smem) {
  float* sc = (float*)smem;
  const int l = j / 24, nb = j % 24, tid = TIDX;
  for (int idx = tid; idx < 5120; idx += 256) {
    const int m = idx >> 10, k = idx & 1023;
    const float v = (m < 4) ? p.in[I_C][m * 1024 + k] : p.in[I_CCTX][k];
    sc[idx] = siluf_(v);
  }
  __syncthreads();
  const int n = nb * 256 + tid;
  const float* W = p.in[I_ADAW] + (size_t)l * 1024 * 6144 + n;
  float a0 = 0, a1 = 0, a2 = 0, a3 = 0, a4 = 0;
#pragma unroll 8
  for (int k = 0; k < 1024; ++k) {
    const float wv = W[(size_t)k * 6144];
    a0 += sc[k] * wv; a1 += sc[1024 + k] * wv; a2 += sc[2048 + k] * wv; a3 += sc[3072 + k] * wv; a4 += sc[4096 + k] * wv;
  }
  const float bb = p.in[I_ADAB][l * 6144 + n];
  float* M = (float*)(p.ws + OFF_MOD) + (size_t)l * 5 * 6144 + n;
  M[0] = a0 + bb; M[6144] = a1 + bb; M[2 * 6144] = a2 + bb; M[3 * 6144] = a3 + bb; M[4 * 6144] = a4 + bb;
  __syncthreads();
}

DI void prep_s5_job(const Params& p, int j) {
  const int idx = j * 256 + TIDX;
  const int ldg = idx >> 6, pp = idx & 63;
  const float dt = expf(p.in[I_LDT][ldg]);
  const float are = p.in[I_ARE][idx], aim = p.in[I_AIM][idx];
  const float mag = expf(are * dt);
  float sn, cs;
  sincos_cw(aim * dt, sn, cs);
  const float abr = mag * cs, abi = mag * sn;
  const float den = are * are + aim * aim;
  const float fre = ((abr - 1.f) * are + abi * aim) / den;
  const float fim = (abi * are - (abr - 1.f) * aim) / den;
  float* BBR = (float*)(p.ws + OFF_BBR);
  float* BBI = (float*)(p.ws + OFF_BBI);
  for (int hh = 0; hh < 16; ++hh) {
    const float br = p.in[I_BRE][(size_t)idx * 16 + hh], bi = p.in[I_BIM][(size_t)idx * 16 + hh];
    BBR[(size_t)idx * 16 + hh] = fre * br - fim * bi;
    BBI[(size_t)idx * 16 + hh] = fre * bi + fim * br;
  }
  float2* PW = (float2*)(p.ws + OFF_PWR);
  float pr = 1.f, pi = 0.f;
  for (int tau = 0; tau <= 32; ++tau) {
    PW[((size_t)ldg * 33 + tau) * 64 + pp] = make_float2(pr, pi);
    const float nr = pr * abr - pi * abi, ni = pr * abi + pi * abr;
    pr = nr; pi = ni;
  }
}

DI void prep_wt_job(const Params& p, int jj, char* smem) {
  float* tile = (float*)smem;
  const int l = jj / 4016;
  int r = jj % 4016;
  int mat = 0;
  const int cnt[8] = {1376, 64, 128, 64, 256, 1408, 704, 16};
#pragma unroll
  for (int m = 0; m < 8; ++m) {
    if (mat == m && r >= cnt[m]) { r -= cnt[m]; mat = m + 1; }
  }
  const float* src; int K, sld; size_t doff;
  switch (mat) {
    case 0: src = p.in[I_WIN] + (size_t)l * 1024 * DIN; K = 1024; sld = DIN; doff = WL_WIN; break;
    case 1: src = p.in[I_WBA] + (size_t)l * 256 * 1024; K = 256; sld = 1024; doff = WL_BRA; break;
    case 2: src = p.in[I_WBG] + (size_t)l * 512 * 1024; K = 512; sld = 1024; doff = WL_BRG; break;
    case 3: src = p.in[I_WBS] + (size_t)l * 256 * 1024; K = 256; sld = 1024; doff = WL_BRS; break;
    case 4: src = p.in[I_WOUT] + (size_t)l * 1024 * 1024; K = 1024; sld = 1024; doff = WL_WOUT; break;
    case 5: src = p.in[I_UP] + (size_t)l * 1024 * 5632; K = 1024; sld = 5632; doff = WL_UP; break;
    case 6: src = p.in[I_DOWN] + (size_t)l * 2816 * 1024; K = 2816; sld = 1024; doff = WL_DOWN; break;
    default: src = p.in[I_GLUW] + (size_t)l * 256 * 256; K = 256; sld = 256; doff = WL_GLU; break;
  }
  const int kt = K / 64;
  const int n0 = (r / kt) * 64, k0 = (r % kt) * 64;
  const int tid = TIDX;
  {
    const int nn = tid & 63;
    const int np = n0 + nn;
    int col;
    if (mat == 0) {
      if (np < 2048) col = np;
      else if (np < 2304) col = 2080 + (np - 2048);
      else if (np < 2336) col = 2048 + (np - 2304);
      else if (np < 2432) col = -1;
      else col = 2336 + (np - 2432);
    } else if (mat == 5) {
      const int jb = np >> 7, c = np & 127;
      col = (c < 64) ? (jb * 64 + c) : (DFF + jb * 64 + (c - 64));
    } else col = np;
#pragma unroll 4
    for (int kk = tid >> 6; kk < 64; kk += 4) tile[kk * 65 + nn] = (col >= 0) ? src[(size_t)(k0 + kk) * sld + col] : 0.f;
  }
  __syncthreads();
  {
    const int nn = tid >> 2, kq = (tid & 3) * 16;
    bf16* d = wl(p, l, doff) + (size_t)(n0 + nn) * K + k0 + kq;
    u32x4 v0, v1;
#pragma unroll
    for (int e = 0; e < 4; ++e) {
      v0[e] = pack2(tile[(kq + 2 * e) * 65 + nn], tile[(kq + 2 * e + 1) * 65 + nn]);
      v1[e] = pack2(tile[(kq + 8 + 2 * e) * 65 + nn], tile[(kq + 8 + 2 * e + 1) * 65 + nn]);
    }
    *(u32x4*)d = v0;
    *(u32x4*)(d + 8) = v1;
  }
  __syncthreads();
}

template <int MODE>
DI void row_job(const Params& p, int l, int tok) {
  const int lane = TIDX & 63;
  float x[16];
  float* xr = resid_row(p, tok);
  if (MODE == 0) {
    const int b = tok / TT, t = tok - b * TT;
    const float* src = (t < CTXL) ? p.in[I_CTX] + ((size_t)b * CTXL + t) * DM : p.in[I_X] + ((size_t)b * SEQ + (t - CTXL)) * DM;
#pragma unroll
    for (int i = 0; i < 4; ++i) {
      const f32x4 v = *(const f32x4*)(src + lane * 4 + 256 * i);
      x[4 * i] = v[0]; x[4 * i + 1] = v[1]; x[4 * i + 2] = v[2]; x[4 * i + 3] = v[3];
      *(f32x4*)(xr + lane * 4 + 256 * i) = v;
    }
  } else {
    const bf16* yr = (const bf16*)(p.ws + OFF_H) + (size_t)tok * DM;
    const float* gpost = p.in[MODE == 1 ? I_NMPOST : I_NFPOST] + l * DM;
    const float* mg = mod_vec(p, l, tok, MODE == 1 ? 2 : 5);
    float y[16];
    float ss = 0.f;
#pragma unroll
    for (int i = 0; i < 4; ++i) {
      const u32x2 u = *(const u32x2*)(yr + lane * 4 + 256 * i);
      y[4 * i] = bflo(u[0]); y[4 * i + 1] = bfhi(u[0]); y[4 * i + 2] = bflo(u[1]); y[4 * i + 3] = bfhi(u[1]);
#pragma unroll
      for (int e = 0; e < 4; ++e) ss += y[4 * i + e] * y[4 * i + e];
    }
    ss = wave_sum(ss);
    const float rstd = rsqrtf(ss * (1.f / DM) + EPSF);
#pragma unroll
    for (int i = 0; i < 4; ++i) {
      f32x4 v = *(const f32x4*)(xr + lane * 4 + 256 * i);
      const f32x4 g = *(const f32x4*)(gpost + lane * 4 + 256 * i);
      const f32x4 m = *(const f32x4*)(mg + lane * 4 + 256 * i);
#pragma unroll
      for (int e = 0; e < 4; ++e) { v[e] += m[e] * (y[4 * i + e] * rstd * g[e]); x[4 * i + e] = v[e]; }
      *(f32x4*)(xr + lane * 4 + 256 * i) = v;
    }
  }
  if (MODE == 2 && l == NL - 1) return;
  const int ln = (MODE == 2) ? l + 1 : l;
  const float* gpre = p.in[MODE == 1 ? I_NFPRE : I_NMPRE] + ln * DM;
  const float* sh = mod_vec(p, ln, tok, MODE == 1 ? 3 : 0);
  const float* scv = mod_vec(p, ln, tok, MODE == 1 ? 4 : 1);
  float ss = 0.f;
#pragma unroll
  for (int i = 0; i < 16; ++i) ss += x[i] * x[i];
  ss = wave_sum(ss);
  const float rstd = rsqrtf(ss * (1.f / DM) + EPSF);
  bf16* hr = (bf16*)(p.ws + OFF_H) + (size_t)tok * DM;
#pragma unroll
  for (int i = 0; i < 4; ++i) {
    const f32x4 g = *(const f32x4*)(gpre + lane * 4 + 256 * i);
    const f32x4 s1 = *(const f32x4*)(sh + lane * 4 + 256 * i);
    const f32x4 s2 = *(const f32x4*)(scv + lane * 4 + 256 * i);
    float o[4];
#pragma unroll
    for (int e = 0; e < 4; ++e) o[e] = (x[4 * i + e] * rstd * g[e]) * (1.f + s2[e]) + s1[e];
    u32x2 u;
    u[0] = pack2(o[0], o[1]); u[1] = pack2(o[2], o[3]);
    *(u32x2*)(hr + lane * 4 + 256 * i) = u;
  }
}

template <int MODE>
DI void row_phase(const Params& p, int l, int bid, int G) {
  const int wg = bid * 4 + (TIDX >> 6), nw = G * 4;
  for (int tok = wg; tok < NTOK; tok += nw) row_job<MODE>(p, l, tok);
}

DI void ktab_phase(const Params& p, int bid, int G) {
  const float* BBR = (const float*)(p.ws + OFF_BBR);
  const float* BBI = (const float*)(p.ws + OFF_BBI);
  const float2* PW = (const float2*)(p.ws + OFF_PWR);
  float* KT = (float*)(p.ws + OFF_KTAB);
  const int total = NL * 16 * 2 * 32 * 256;
  for (int idx = bid * 256 + TIDX; idx < total; idx += G * 256) {
    const int hp = idx & 15, hh = (idx >> 4) & 15, tau = (idx >> 8) & 31, d = (idx >> 13) & 1, g = (idx >> 14) & 15, l = idx >> 18;
    const int ldg = (l * 2 + d) * 16 + g;
    const float* cre = p.in[I_CRE] + ((size_t)ldg * 16 + hh) * 64;
    const float* cim = p.in[I_CIM] + ((size_t)ldg * 16 + hh) * 64;
    float acc = 0.f;
    for (int pp = 0; pp < 64; ++pp) {
      const float2 pw = PW[((size_t)ldg * 33 + tau) * 64 + pp];
      const float br = BBR[((size_t)ldg * 64 + pp) * 16 + hp], bi = BBI[((size_t)ldg * 64 + pp) * 16 + hp];
      const float zr = pw.x * br - pw.y * bi, zi = pw.x * bi + pw.y * br;
      acc += cre[pp] * zr - cim[pp] * zi;
    }
    KT[idx] = acc;
  }
}

DI void s5mat_phase(const Params& p, int l, int bid, int G) {
  const float* BBR = (const float*)(p.ws + OFF_BBR);
  const float* BBI = (const float*)(p.ws + OFF_BBI);
  const float2* PW = (const float2*)(p.ws + OFF_PWR);
  const float* KT = (const float*)(p.ws + OFF_KTAB);
  bf16* T5 = (bf16*)(p.ws + OFF_T5);
  bf16* E5 = (bf16*)(p.ws + OFF_E5);
  bf16* F5 = (bf16*)(p.ws + OFF_F5);
  const int nT = 16 * 512 * 64, nE = 16 * 512 * 32, nF = 16 * 256 * 64;
  for (int it = bid * 256 + TIDX; it < nT + nE + nF; it += G * 256) {
    float v[8];
    bf16* dst;
    if (it < nT) {
      const int k8 = it & 63, n = (it >> 6) & 511, g = it >> 15;
      const int i = n >> 4, hh = n & 15, j = k8 >> 1, hp0 = (k8 & 1) * 8;
#pragma unroll
      for (int e = 0; e < 8; ++e) {
        const int hp = hp0 + e;
        float a = 0.f;
        if (j <= i) a += KT[((((size_t)l * 16 + g) * 2 + 0) * 32 + (i - j)) * 256 + hh * 16 + hp];
        if (j >= i) a += KT[((((size_t)l * 16 + g) * 2 + 1) * 32 + (j - i)) * 256 + hh * 16 + hp];
        if (i == j && hh == hp) a += p.in[I_S5D][l * 256 + g * 16 + hh];
        v[e] = a;
      }
      dst = T5 + ((size_t)g * 512 + n) * 512 + k8 * 8;
    } else if (it < nT + nE) {
      const int q = it - nT;
      const int k8 = q & 31, n = (q >> 5) & 511, g = q >> 14;
      const int i = n >> 4, hh = n & 15;
      const int k0 = k8 * 8, d = k0 >> 7, ri = (k0 >> 6) & 1, p0 = k0 & 63;
      const int ldg = (l * 2 + d) * 16 + g;
      const int ex = d ? (32 - i) : (i + 1);
#pragma unroll
      for (int e = 0; e < 8; ++e) {
        const int pp = p0 + e;
        const float2 pw = PW[((size_t)ldg * 33 + ex) * 64 + pp];
        const float cr = p.in[I_CRE][((size_t)ldg * 16 + hh) * 64 + pp], ci = p.in[I_CIM][((size_t)ldg * 16 + hh) * 64 + pp];
        const float zr = cr * pw.x - ci * pw.y, zi = cr * pw.y + ci * pw.x;
        v[e] = ri ? -zi : zr;
      }
      dst = E5 + ((size_t)g * 512 + n) * 256 + k0;
    } else {
      const int q = it - nT - nE;
      const int k8 = q & 63, n = (q >> 6) & 255, g = q >> 14;
      const int d = n >> 7, ri = (n >> 6) & 1, pp = n & 63;
      const int j = k8 >> 1, hp0 = (k8 & 1) * 8;
      const int ldg = (l * 2 + d) * 16 + g;
      const int ex = d ? j : (31 - j);
      const float2 pw = PW[((size_t)ldg * 33 + ex) * 64 + pp];
#pragma unroll
      for (int e = 0; e < 8; ++e) {
        const float br = BBR[((size_t)ldg * 64 + pp) * 16 + hp0 + e], bi = BBI[((size_t)ldg * 64 + pp) * 16 + hp0 + e];
        v[e] = ri ? (pw.x * bi + pw.y * br) : (pw.x * br - pw.y * bi);
      }
      dst = F5 + ((size_t)g * 256 + n) * 512 + k8 * 8;
    }
    u32x4 u;
    u[0] = pack2(v[0], v[1]); u[1] = pack2(v[2], v[3]); u[2] = pack2(v[4], v[5]); u[3] = pack2(v[6], v[7]);
    *(u32x4*)dst = u;
  }
}

DI void proj_tile(const Params& p, int l, int mt, int nt, char* smem) {
  const bf16* H = (const bf16*)(p.ws + OFF_H) + (size_t)mt * 128 * DM;
  const bf16* W = wl(p, l, WL_WIN) + (size_t)nt * 128 * DM;
  f32x16 acc[2][2];
  acc_zero(acc);
  gemm_main_dma(acc, [&](int r) { return H + (size_t)r * DM; }, [&](int r) { return W + (size_t)r * DM; }, DM, smem);
  float* Cs = (float*)smem;
  acc_to_lds(acc, Cs);
  __syncthreads();
  const int tid = TIDX;
  const int tok0 = mt * 128;
  const int b = tok0 / TT, t0 = tok0 - b * TT;
  if (nt <= 2) {
    const int row = tid >> 1, seg = tid & 1;
    float* c = Cs + row * CLD + seg * 64;
    const float* gn = p.in[nt < 2 ? I_QN : I_KN] + l * 64;
    float ss = 0.f;
#pragma unroll 8
    for (int i = 0; i < 64; ++i) ss += c[i] * c[i];
    const float rstd = rsqrtf(ss * (1.f / 64.f) + EPSF);
    const int t = t0 + row;
    const bool lat = t >= CTXL;
    const int s = t - CTXL;
#pragma unroll 1
    for (int ax = 0; ax < 2; ++ax) {
      const float pos = (float)(ax ? (s & 63) : (s >> 6));
#pragma unroll 2
      for (int f = 0; f < 16; ++f) {
        float x1 = c[ax * 32 + f] * rstd * gn[ax * 32 + f];
        float x2 = c[ax * 32 + 16 + f] * rstd * gn[ax * 32 + 16 + f];
        if (lat) {
          const float invf = exp2f(-(float)f * (13.287712379549449f / 16.f));
          float sn, cs;
          sincos_cw(pos * invf, sn, cs);
          const float y1 = x1 * cs - x2 * sn, y2 = x2 * cs + x1 * sn;
          x1 = y1; x2 = y2;
        }
        c[ax * 32 + f] = x1;
        c[ax * 32 + 16 + f] = x2;
      }
    }
    __syncthreads();
    if (nt < 2) store_tile_bf16(Cs, (bf16*)(p.ws + OFF_Q) + (size_t)tok0 * 256 + nt * 128, 256, 128, 0.125f * 1.4426950408889634f);
    else store_tile_bf16(Cs, (bf16*)(p.ws + OFF_K) + (size_t)tok0 * 128, 128, 128, 1.f);
  } else if (nt == 3 || (nt >= 8 && nt <= 11)) {
    for (int c = tid; c < 2048; c += 256) {
      const int col = c & 127, rc = (c >> 7) * 8;
      u32x4 u;
#pragma unroll
      for (int e = 0; e < 4; ++e) u[e] = pack2(Cs[(rc + 2 * e) * CLD + col], Cs[(rc + 2 * e + 1) * CLD + col]);
      bf16* dst;
      if (nt == 3) dst = (bf16*)(p.ws + OFF_VT) + ((size_t)(b * 2 + (col >> 6)) * 64 + (col & 63)) * TT + t0 + rc;
      else dst = (bf16*)(p.ws + OFF_GVT) + ((size_t)(b * 4 + (nt - 8)) * 128 + col) * TT + t0 + rc;
      *(u32x4*)dst = u;
    }
  } else if (nt == 4 || nt == 5) {
    store_tile_bf16(Cs, (bf16*)(p.ws + OFF_GQ) + (size_t)tok0 * 256 + (nt - 4) * 128, 256, 128, 0.125f);
  } else if (nt == 6 || nt == 7) {
    store_tile_bf16(Cs, (bf16*)(p.ws + OFF_GK) + (size_t)tok0 * 256 + (nt - 6) * 128, 256, 128, 1.f);
  } else if (nt >= 12 && nt <= 15) {
    store_tile_bf16(Cs, (bf16*)(p.ws + OFF_GR) + (size_t)tok0 * 512 + (nt - 12) * 128, 512, 128, 1.f);
  } else if (nt == 16 || nt == 17) {
    for (int c = tid; c < 2048; c += 256) {
      const int row = c >> 4, c8 = c & 15;
      const float* s = Cs + row * CLD + c8 * 8;
      u32x4 u;
#pragma unroll
      for (int e = 0; e < 4; ++e) u[e] = pack2(s[2 * e], s[2 * e + 1]);
      const int ch = (nt - 16) * 128 + c8 * 8;
      bf16* dst = (bf16*)(p.ws + OFF_SU) + ((size_t)(b * 16 + (ch >> 4)) * TT + t0 + row) * 16 + (ch & 15);
      *(u32x4*)dst = u;
    }
  } else {
    for (int c = tid; c < 128 * 8; c += 256) {
      const int row = c >> 3, c4 = (c & 7) * 4;
      const float* s = Cs + row * CLD + c4;
      f32x4 v = {s[0], s[1], s[2], s[3]};
      *(f32x4*)((float*)(p.ws + OFF_LOW) + (size_t)(tok0 + row) * 32 + c4) = v;
    }
  }
  __syncthreads();
}

DI void attn_unit(const Params& p, int u, char* smem) {
  bf16* Ks = (bf16*)smem;
  bf16* Vs = (bf16*)(smem + 2 * 64 * LDT * 2);
  int b, head, tok0, nkt;
  if (u < 1024) { b = u >> 8; head = (u >> 6) & 3; tok0 = b * TT + CTXL + (u & 63) * 128; nkt = TT / 64; }
  else { const int v = u - 1024; b = v >> 3; head = (v >> 1) & 3; tok0 = b * TT + (v & 1) * 128; nkt = CTXL / 64; }
  const int kvh = head >> 1;
  const int tid = TIDX, lane = tid & 63, w = tid >> 6, r = lane & 31, h = lane >> 5;
  const bf16* Qp = (const bf16*)(p.ws + OFF_Q) + (size_t)(tok0 + w * 32 + r) * 256 + head * 64 + h * 8;
  s16x8 qf[4];
#pragma unroll
  for (int s = 0; s < 4; ++s) qf[s] = *(const s16x8*)(Qp + s * 16);
  const int lr = tid >> 3, kc = (tid & 7) * 8;
  const bf16* Kg = (const bf16*)(p.ws + OFF_K) + ((size_t)b * TT + lr) * 128 + kvh * 64 + kc;
  const bf16* Vg = (const bf16*)(p.ws + OFF_VT) + ((size_t)(b * 2 + kvh) * 64 + lr) * TT + kc;
  u32x4 rk[2], rv[2];
#pragma unroll
  for (int i = 0; i < 2; ++i) {
    rk[i] = ldg16(Kg + (size_t)(32 * i) * 128);
    rv[i] = ldg16(Vg + (size_t)(32 * i) * TT);
  }
#pragma unroll
  for (int i = 0; i < 2; ++i) {
    *(u32x4*)(Ks + (lr + 32 * i) * LDT + kc) = rk[i];
    *(u32x4*)(Vs + (lr + 32 * i) * LDT + kc) = rv[i];
  }
  __syncthreads();
  f32x16 oacc[2];
#pragma unroll
  for (int i = 0; i < 16; ++i) { oacc[0][i] = 0.f; oacc[1][i] = 0.f; }
  float mrow = -INFINITY, lrow = 0.f;
  for (int kt = 0; kt < nkt; ++kt) {
    const int buf = kt & 1;
    const bool more = kt + 1 < nkt;
    if (more) {
#pragma unroll
      for (int i = 0; i < 2; ++i) {
        rk[i] = ldg16(Kg + (size_t)((kt + 1) * 64 + 32 * i) * 128);
        rv[i] = ldg16(Vg + (size_t)(32 * i) * TT + (kt + 1) * 64);
      }
    }
    SCHED_FENCE();
    const bf16* Kb = Ks + buf * 64 * LDT;
    const bf16* Vb = Vs + buf * 64 * LDT;
    f32x16 sacc[2];
#pragma unroll
    for (int i = 0; i < 16; ++i) { sacc[0][i] = 0.f; sacc[1][i] = 0.f; }
#pragma unroll
    for (int s = 0; s < 4; ++s) {
      const s16x8 a0 = *(const s16x8*)(Kb + r * LDT + s * 16 + h * 8);
      const s16x8 a1 = *(const s16x8*)(Kb + (32 + r) * LDT + s * 16 + h * 8);
      sacc[0] = MFMA32(a0, qf[s], sacc[0]);
      sacc[1] = MFMA32(a1, qf[s], sacc[1]);
    }
    float mx = sacc[0][0];
#pragma unroll
    for (int i = 0; i < 16; ++i) { mx = fmaxf(mx, sacc[0][i]); mx = fmaxf(mx, sacc[1][i]); }
    mx = fmaxf(mx, __shfl_xor(mx, 32, 64));
    const float mnew = fmaxf(mrow, mx);
    const float alpha = exp2f(mrow - mnew);
    mrow = mnew;
    float psum = 0.f;
#pragma unroll
    for (int i = 0; i < 16; ++i) {
      sacc[0][i] = exp2f(sacc[0][i] - mnew); psum += sacc[0][i];
      sacc[1][i] = exp2f(sacc[1][i] - mnew); psum += sacc[1][i];
    }
    lrow = lrow * alpha + psum;
#pragma unroll
    for (int i = 0; i < 16; ++i) { oacc[0][i] *= alpha; oacc[1][i] *= alpha; }
#pragma unroll
    for (int kt2 = 0; kt2 < 2; ++kt2)
#pragma unroll
      for (int s2 = 0; s2 < 2; ++s2) {
        u32x4 pu;
#pragma unroll
        for (int e = 0; e < 4; ++e) pu[e] = pack2(sacc[kt2][8 * s2 + 2 * e], sacc[kt2][8 * s2 + 2 * e + 1]);
        const s16x8 pf = __builtin_bit_cast(s16x8, pu);
        const int kb = kt2 * 32 + 16 * s2 + 4 * h;
#pragma unroll
        for (int dt = 0; dt < 2; ++dt) {
          const s16x4 lo = *(const s16x4*)(Vb + (dt * 32 + r) * LDT + kb);
          const s16x4 hi = *(const s16x4*)(Vb + (dt * 32 + r) * LDT + kb + 8);
          const s16x8 a = __builtin_shufflevector(lo, hi, 0, 1, 2, 3, 4, 5, 6, 7);
          oacc[dt] = MFMA32(a, pf, oacc[dt]);
        }
      }
    SCHED_FENCE();
    if (more) {
      bf16* Kw = Ks + (buf ^ 1) * 64 * LDT;
      bf16* Vw = Vs + (buf ^ 1) * 64 * LDT;
#pragma unroll
      for (int i = 0; i < 2; ++i) {
        *(u32x4*)(Kw + (lr + 32 * i) * LDT + kc) = rk[i];
        *(u32x4*)(Vw + (lr + 32 * i) * LDT + kc) = rv[i];
      }
    }
    __syncthreads();
  }
  const float ltot = lrow + __shfl_xor(lrow, 32, 64);
  const float inv = 1.f / ltot;
  bf16* Op = (bf16*)(p.ws + OFF_OATT) + (size_t)(tok0 + w * 32 + r) * 256 + head * 64;
#pragma unroll
  for (int dt = 0; dt < 2; ++dt)
#pragma unroll
    for (int i = 0; i < 16; i += 4) {
      u32x2 uu;
      uu[0] = pack2(oacc[dt][i] * inv, oacc[dt][i + 1] * inv);
      uu[1] = pack2(oacc[dt][i + 2] * inv, oacc[dt][i + 3] * inv);
      *(u32x2*)(Op + dt * 32 + crow(i, h)) = uu;
    }
}

constexpr int GL_LOW = 0, GL_TOT = 4096, GL_DEC = 5120, GL_QIN = 5376, GL_KIN = 14592, GL_KET = 23808, GL_OST = 0,
              GL_VT = 33792, GL_ST = 52224;
static_assert(GL_ST + 128 * LDT * 2 <= SMEM_BYTES, "gla lds");

template <bool WITH_OUT>
DI void gla_unit(const Params& p, int l, int u, char* smem) {
  float* lowt = (float*)(smem + GL_LOW);
  float* tots = (float*)(smem + GL_TOT);
  float* decs = (float*)(smem + GL_DEC);
  bf16* qin = (bf16*)(smem + GL_QIN);
  bf16* kin = (bf16*)(smem + GL_KIN);
  bf16* ket = (bf16*)(smem + GL_KET);
  float* ost = (float*)(smem + GL_OST);
  bf16* vts = (bf16*)(smem + GL_VT);
  bf16* sts = (bf16*)(smem + GL_ST);
  const int tid = TIDX, lane = tid & 63, w = tid >> 6, r = lane & 31, h = lane >> 5;
  int b, hd, gi, dir0, ndir;
  if (WITH_OUT) { gi = u % NG33; hd = (u / NG33) & 3; b = u / (NG33 * 4); dir0 = 1; ndir = 2; }
  else { gi = u % NG33; const int v = u / NG33; dir0 = v & 1; hd = (v >> 1) & 3; b = v >> 3; ndir = 1; }
  const int dk = tid & 63, part = tid >> 6;
  const bf16* GQ = (const bf16*)(p.ws + OFF_GQ);
  const bf16* GK = (const bf16*)(p.ws + OFF_GK);
  const bf16* GVT = (const bf16*)(p.ws + OFF_GVT) + (size_t)(b * 4 + hd) * 128 * TT;
  const float* LOW = (const float*)(p.ws + OFF_LOW);
  for (int dd = 0; dd < ndir; ++dd) {
    const int dir = WITH_OUT ? (dir0 - dd) : dir0;
    float* GSu = (float*)(p.ws + OFF_GS) + ((size_t)((b * 4 + hd) * 2 + dir) * NG33 + gi) * 8192;
    float gwreg[16];
#pragma unroll
    for (int rr = 0; rr < 16; ++rr) gwreg[rr] = p.in[I_GGW][((size_t)(l * 2 + dir) * 16 + rr) * 256 + hd * 64 + dk];
    const float gb = p.in[I_GGB][(l * 2 + dir) * 256 + hd * 64 + dk];
    f32x16 sacc[2];
    if (WITH_OUT) {
#pragma unroll
      for (int dkt = 0; dkt < 2; ++dkt)
#pragma unroll
        for (int i = 0; i < 16; ++i) {
          const float v = GSu[(w * 32 + crow(i, h)) * 64 + dkt * 32 + r];
          sacc[dkt][i] = v;
          sts[(w * 32 + crow(i, h)) * LDT + dkt * 32 + r] = f2bf(v);
        }
    } else {
#pragma unroll
      for (int i = 0; i < 16; ++i) { sacc[0][i] = 0.f; sacc[1][i] = 0.f; }
    }
    float gtot = 0.f;
    for (int cc = 0; cc < 4; ++cc) {
      const int ci = dir ? 3 - cc : cc;
      const int tb = gi * 256 + ci * 64;
      const size_t tokb = (size_t)b * TT + tb;
      {
        const int row = tid >> 2, c4 = (tid & 3) * 4;
        const u32x4 lw = ldg16(LOW + (tokb + row) * 32 + dir * 16 + c4);
        u32x4 vv[4], kq[2], qq[2];
#pragma unroll
        for (int i = 0; i < 4; ++i) {
          const int c = tid + 256 * i, e = c >> 3, k8 = (c & 7) * 8;
          vv[i] = ldg16(GVT + (size_t)e * TT + tb + k8);
        }
#pragma unroll
        for (int i = 0; i < 2; ++i) {
          const int c = tid + 256 * i, rw = c >> 3, k8 = (c & 7) * 8;
          kq[i] = ldg16(GK + (tokb + rw) * 256 + hd * 64 + k8);
          if (WITH_OUT) qq[i] = ldg16(GQ + (tokb + rw) * 256 + hd * 64 + k8);
        }
        *(u32x4*)(lowt + row * 16 + c4) = lw;
#pragma unroll
        for (int i = 0; i < 4; ++i) {
          const int c = tid + 256 * i, e = c >> 3, k8 = (c & 7) * 8;
          *(u32x4*)(vts + e * LDT + k8) = vv[i];
        }
#pragma unroll
        for (int i = 0; i < 2; ++i) {
          const int c = tid + 256 * i, rw = c >> 3, k8 = (c & 7) * 8;
          *(u32x4*)(kin + rw * LDT + k8) = kq[i];
          if (WITH_OUT) *(u32x4*)(qin + rw * LDT + k8) = qq[i];
        }
      }
      __syncthreads();
      float cum = 0.f;
#pragma unroll 2
      for (int ii = 0; ii < 16; ++ii) {
        const int pos = part * 16 + ii, t = dir ? 63 - pos : pos;
        float z = gb;
#pragma unroll
        for (int rr = 0; rr < 16; ++rr) z += lowt[t * 16 + rr] * gwreg[rr];
        cum += (fminf(z, 0.f) - log1pf(__expf(-fabsf(z)))) * (1.f / 16.f);
      }
      tots[part * 64 + dk] = cum;
      __syncthreads();
      float offs = 0.f, total = 0.f;
#pragma unroll
      for (int pp = 0; pp < 4; ++pp) { const float tv = tots[pp * 64 + dk]; total += tv; if (pp < part) offs += tv; }
      if (part == 0) decs[dk] = __expf(total);
      gtot += total;
      float bq = offs;
#pragma unroll 2
      for (int ii = 0; ii < 16; ++ii) {
        const int pos = part * 16 + ii, t = dir ? 63 - pos : pos;
        float z = gb;
#pragma unroll
        for (int rr = 0; rr < 16; ++rr) z += lowt[t * 16 + rr] * gwreg[rr];
        bq += (fminf(z, 0.f) - log1pf(__expf(-fabsf(z)))) * (1.f / 16.f);
        const float kv = bf2f(kin[t * LDT + dk]);
        ket[dk * LDT + t] = f2bf(kv * __expf(total - bq));
        if (WITH_OUT) {
          const float qv = bf2f(qin[t * LDT + dk]);
          qin[t * LDT + dk] = f2bf(qv * __expf(bq));
          kin[t * LDT + dk] = f2bf(kv * __expf(-bq));
        }
      }
      __syncthreads();
      f32x16 oo[2];
      const int it = w & 1, ep = w >> 1;
      if (WITH_OUT) {
        const int ti = w >> 1, tj = w & 1;
        f32x16 aa;
#pragma unroll
        for (int i = 0; i < 16; ++i) aa[i] = 0.f;
#pragma unroll
        for (int s = 0; s < 4; ++s) {
          const s16x8 A = *(const s16x8*)(qin + (ti * 32 + r) * LDT + s * 16 + h * 8);
          const s16x8 Bv = *(const s16x8*)(kin + (tj * 32 + r) * LDT + s * 16 + h * 8);
          aa = MFMA32(A, Bv, aa);
        }
        __syncthreads();
#pragma unroll
        for (int i = 0; i < 16; ++i) {
          const int qi = ti * 32 + crow(i, h), kj = tj * 32 + r;
          const bool keep = dir ? (kj >= qi) : (kj <= qi);
          kin[qi * LDT + kj] = f2bf(keep ? aa[i] : 0.f);
        }
        __syncthreads();
#pragma unroll
        for (int i = 0; i < 16; ++i) { oo[0][i] = 0.f; oo[1][i] = 0.f; }
#pragma unroll
        for (int s = 0; s < 4; ++s) {
          const s16x8 A1 = *(const s16x8*)(kin + (it * 32 + r) * LDT + s * 16 + h * 8);
          const s16x8 A2 = *(const s16x8*)(qin + (it * 32 + r) * LDT + s * 16 + h * 8);
#pragma unroll
          for (int x = 0; x < 2; ++x) {
            const int et = 2 * ep + x;
            const s16x8 B1 = *(const s16x8*)(vts + (et * 32 + r) * LDT + s * 16 + h * 8);
            const s16x8 B2 = *(const s16x8*)(sts + (et * 32 + r) * LDT + s * 16 + h * 8);
            oo[x] = MFMA32(A1, B1, oo[x]);
            oo[x] = MFMA32(A2, B2, oo[x]);
          }
        }
      }
#pragma unroll
      for (int dkt = 0; dkt < 2; ++dkt) {
        const float dv = decs[dkt * 32 + r];
#pragma unroll
        for (int i = 0; i < 16; ++i) sacc[dkt][i] *= dv;
      }
#pragma unroll
      for (int s = 0; s < 4; ++s) {
        const s16x8 A = *(const s16x8*)(vts + (w * 32 + r) * LDT + s * 16 + h * 8);
#pragma unroll
        for (int dkt = 0; dkt < 2; ++dkt) {
          const s16x8 Bv = *(const s16x8*)(ket + (dkt * 32 + r) * LDT + s * 16 + h * 8);
          sacc[dkt] = MFMA32(A, Bv, sacc[dkt]);
        }
      }
      __syncthreads();
      if (WITH_OUT) {
#pragma unroll
        for (int dkt = 0; dkt < 2; ++dkt)
#pragma unroll
          for (int i = 0; i < 16; ++i) sts[(w * 32 + crow(i, h)) * LDT + dkt * 32 + r] = f2bf(sacc[dkt][i]);
#pragma unroll
        for (int x = 0; x < 2; ++x)
#pragma unroll
          for (int i = 0; i < 16; ++i) ost[(it * 32 + crow(i, h)) * CLD + (2 * ep + x) * 32 + r] = oo[x][i];
        __syncthreads();
        const int row = tid >> 2, qd = tid & 3;
        const size_t tok = tokb + row;
        bf16* og = (bf16*)(p.ws + OFF_OGLA) + tok * 512 + hd * 128 + qd * 32;
        const float* os = ost + row * CLD + qd * 32;
        if (dir == 1) {
#pragma unroll
          for (int i = 0; i < 4; ++i) {
            u32x4 uu;
#pragma unroll
            for (int e = 0; e < 4; ++e) uu[e] = pack2(os[i * 8 + 2 * e], os[i * 8 + 2 * e + 1]);
            *(u32x4*)(og + i * 8) = uu;
          }
        } else {
          float ss = 0.f;
#pragma unroll 1
          for (int i = 0; i < 4; ++i) {
            const u32x4 uu = *(const u32x4*)(og + i * 8);
#pragma unroll
            for (int e = 0; e < 4; ++e) {
              const float a0 = os[i * 8 + 2 * e] + bflo(uu[e]), a1 = os[i * 8 + 2 * e + 1] + bfhi(uu[e]);
              ss += a0 * a0 + a1 * a1;
            }
          }
          ss += __shfl_xor(ss, 1, 64);
          ss += __shfl_xor(ss, 2, 64);
          const float rstd = rsqrtf(ss * (1.f / 128.f) + EPSF);
          const float* gn = p.in[I_GON] + l * 128 + qd * 32;
          const bf16* gr = (const bf16*)(p.ws + OFF_GR) + tok * 512 + hd * 128 + qd * 32;
#pragma unroll 1
          for (int i = 0; i < 4; ++i) {
            const u32x4 uo = *(const u32x4*)(og + i * 8);
            const u32x4 ug = *(const u32x4*)(gr + i * 8);
            u32x4 uu;
#pragma unroll
            for (int e = 0; e < 4; ++e) {
              const float v0 = os[i * 8 + 2 * e] + bflo(uo[e]), v1 = os[i * 8 + 2 * e + 1] + bfhi(uo[e]);
              const float a0 = v0 * rstd * gn[i * 8 + 2 * e] * siluf_(bflo(ug[e]));
              const float a1 = v1 * rstd * gn[i * 8 + 2 * e + 1] * siluf_(bfhi(ug[e]));
              uu[e] = pack2(a0, a1);
            }
            *(u32x4*)(og + i * 8) = uu;
          }
        }
        __syncthreads();
      }
    }
    if (!WITH_OUT) {
#pragma unroll
      for (int dkt = 0; dkt < 2; ++dkt)
#pragma unroll
        for (int i = 0; i < 16; ++i) GSu[(w * 32 + crow(i, h)) * 64 + dkt * 32 + r] = sacc[dkt][i];
      if (part == 0) ((float*)(p.ws + OFF_DECG))[((size_t)((b * 4 + hd) * 2 + dir) * NG33 + gi) * 64 + dk] = __expf(gtot);
    }
    __syncthreads();
  }
}

DI void gla_scan_job(const Params& p, int j) {
  const int idx = j * 256 + TIDX;
  const int seq = idx >> 13, el = idx & 8191, dk = el & 63, dir = seq & 1;
  float* GS = (float*)(p.ws + OFF_GS) + (size_t)seq * NG33 * 8192 + el;
  const float* DG = (const float*)(p.ws + OFF_DECG) + (size_t)seq * NG33 * 64 + dk;
  float s = 0.f;
  for (int st0 = 0; st0 < 33; st0 += 11) {
    float kv[11], dc[11];
#pragma unroll
    for (int q = 0; q < 11; ++q) {
      const int st = st0 + q;
      const int g = (dir == 0 || st == 0) ? st : 33 - st;
      kv[q] = GS[(size_t)g * 8192];
      dc[q] = DG[g * 64];
    }
#pragma unroll
    for (int q = 0; q < 11; ++q) {
      const int st = st0 + q;
      const int g = (dir == 0 || st == 0) ? st : 33 - st;
      GS[(size_t)g * 8192] = s;
      s = dc[q] * s + kv[q];
    }
  }
}

DI void s5_end_tile(const Params& p, int j, char* smem) {
  const int nt = j & 1, mt = (j >> 1) % 9, g = j / 18;
  const bf16* SU = (const bf16*)(p.ws + OFF_SU);
  const bf16* F = (const bf16*)(p.ws + OFF_F5) + ((size_t)g * 256 + nt * 128) * 512;
  f32x16 acc[2][2];
  acc_zero(acc);
  gemm_main_dma(acc,
            [&](int r) -> const bf16* {
              const int m = mt * 128 + r;
              if (m >= MS5) return (const bf16*)(p.ws + OFF_ZERO);
              const int b = m / NCH, ch = m - b * NCH;
              return SU + ((size_t)(b * 16 + g) * TT + ch * 32) * 16;
            },
            [&](int r) { return F + (size_t)r * 512; }, 512, smem);
  float* Cs = (float*)smem;
  acc_to_lds(acc, Cs);
  __syncthreads();
  float* EN = (float*)(p.ws + OFF_EN);
  for (int c = TIDX; c < 128 * 32; c += 256) {
    const int row = c >> 5, c4 = (c & 31) * 4, m = mt * 128 + row;
    if (m < MS5) {
      const float* s = Cs + row * CLD + c4;
      f32x4 v = {s[0], s[1], s[2], s[3]};
      *(f32x4*)(EN + ((size_t)m * 16 + g) * 256 + nt * 128 + c4) = v;
    }
  }
  __syncthreads();
}

DI void s5_scan_job(const Params& p, int l, int j, char* smem) {
  float2* ends = (float2*)smem;
  const int dir = j & 1, g = (j >> 1) & 15, b = j >> 5;
  const int pp = TIDX & 63, seg = TIDX >> 6;
  const float2 aL = ((const float2*)(p.ws + OFF_PWR))[((size_t)((l * 2 + dir) * 16 + g) * 33 + 32) * 64 + pp];
  const float* EN = (const float*)(p.ws + OFF_EN);
  bf16* SB = (bf16*)(p.ws + OFF_SB);
  float sr = 0.f, si = 0.f;
  for (int q0 = 0; q0 < 66; q0 += 11) {
    float er[11], ei[11];
#pragma unroll
    for (int q = 0; q < 11; ++q) {
      const int pos = seg * 66 + q0 + q;
      const int ch = dir ? (pos < 8 ? 7 - pos : 271 - pos) : pos;
      const float* e = EN + ((size_t)(b * NCH + ch) * 16 + g) * 256 + dir * 128 + pp;
      er[q] = e[0]; ei[q] = e[64];
    }
#pragma unroll
    for (int q = 0; q < 11; ++q) {
      const float nr = aL.x * sr - aL.y * si + er[q], ni = aL.x * si + aL.y * sr + ei[q];
      sr = nr; si = ni;
    }
  }
  ends[seg * 64 + pp] = make_float2(sr, si);
  float pr = 1.f, pi = 0.f;
  for (int q = 0; q < 66; ++q) { const float nr = pr * aL.x - pi * aL.y, ni = pr * aL.y + pi * aL.x; pr = nr; pi = ni; }
  __syncthreads();
  sr = 0.f; si = 0.f;
  for (int k = 0; k < seg; ++k) {
    const float2 e = ends[k * 64 + pp];
    const float nr = pr * sr - pi * si + e.x, ni = pr * si + pi * sr + e.y;
    sr = nr; si = ni;
  }
  for (int q0 = 0; q0 < 66; q0 += 11) {
    float er[11], ei[11];
#pragma unroll
    for (int q = 0; q < 11; ++q) {
      const int pos = seg * 66 + q0 + q;
      const int ch = dir ? (pos < 8 ? 7 - pos : 271 - pos) : pos;
      const float* e = EN + ((size_t)(b * NCH + ch) * 16 + g) * 256 + dir * 128 + pp;
      er[q] = e[0]; ei[q] = e[64];
    }
#pragma unroll
    for (int q = 0; q < 11; ++q) {
      const int pos = seg * 66 + q0 + q;
      const int ch = dir ? (pos < 8 ? 7 - pos : 271 - pos) : pos;
      bf16* sb = SB + ((size_t)(b * NCH + ch) * 16 + g) * 256 + dir * 128 + pp;
      sb[0] = f2bf(sr); sb[64] = f2bf(si);
      const float nr = aL.x * sr - aL.y * si + er[q], ni = aL.x * si + aL.y * sr + ei[q];
      sr = nr; si = ni;
    }
  }
  __syncthreads();
}

DI float gelu_tanh(float x) {
  const float u = 0.7978845608028654f * (x + 0.044715f * x * x * x);
  return 0.5f * x * (1.f + tanhf(u));
}

DI void s5_out_tile(const Params& p, int j, char* smem) {
  const int nt = j & 3, mt = (j >> 2) % 9, g = j / 36;
  const bf16* SU = (const bf16*)(p.ws + OFF_SU);
  const bf16* SB = (const bf16*)(p.ws + OFF_SB);
  const bf16* Tm = (const bf16*)(p.ws + OFF_T5) + ((size_t)g * 512 + nt * 128) * 512;
  const bf16* Em = (const bf16*)(p.ws + OFF_E5) + ((size_t)g * 512 + nt * 128) * 256;
  f32x16 acc[2][2];
  acc_zero(acc);
  gemm_main_dma(acc,
            [&](int r) -> const bf16* {
              const int m = mt * 128 + r;
              if (m >= MS5) return (const bf16*)(p.ws + OFF_ZERO);
              const int b = m / NCH, ch = m - b * NCH;
              return SU + ((size_t)(b * 16 + g) * TT + ch * 32) * 16;
            },
            [&](int r) { return Tm + (size_t)r * 512; }, 512, smem);
  gemm_main_dma(acc,
            [&](int r) -> const bf16* {
              const int m = mt * 128 + r;
              if (m >= MS5) return (const bf16*)(p.ws + OFF_ZERO);
              return SB + ((size_t)m * 16 + g) * 256;
            },
            [&](int r) { return Em + (size_t)r * 256; }, 256, smem);
  float* Cs = (float*)smem;
  acc_to_lds(acc, Cs);
  __syncthreads();
  bf16* Y5 = (bf16*)(p.ws + OFF_Y5);
  for (int c = TIDX; c < 2048; c += 256) {
    const int row = c >> 4, c8 = c & 15, m = mt * 128 + row;
    if (m < MS5) {
      const int b = m / NCH, ch = m - b * NCH;
      const int n = nt * 128 + c8 * 8, i = n >> 4, hh = n & 15;
      const float* s = Cs + row * CLD + c8 * 8;
      u32x4 u;
#pragma unroll
      for (int e = 0; e < 4; ++e) u[e] = pack2(gelu_tanh(s[2 * e]), gelu_tanh(s[2 * e + 1]));
      *(u32x4*)(Y5 + ((size_t)b * TT + ch * 32 + i) * 256 + g * 16 + hh) = u;
    }
  }
  __syncthreads();
}

DI void glu_tile(const Params& p, int l, int j, char* smem) {
  const int nt = j & 1, mt = j >> 1;
  const bf16* Y5 = (const bf16*)(p.ws + OFF_Y5) + (size_t)mt * 128 * 256;
  const bf16* W = wl(p, l, WL_GLU) + (size_t)nt * 128 * 256;
  f32x16 acc[2][2];
  acc_zero(acc);
  gemm_main_dma(acc, [&](int r) { return Y5 + (size_t)r * 256; }, [&](int r) { return W + (size_t)r * 256; }, 256, smem);
  float* Cs = (float*)smem;
  acc_to_lds(acc, Cs);
  __syncthreads();
  const float* gb = p.in[I_GLUB] + l * 256 + nt * 128;
  bf16* O = (bf16*)(p.ws + OFF_OS5) + (size_t)mt * 128 * 256 + nt * 128;
  for (int c = TIDX; c < 2048; c += 256) {
    const int row = c >> 4, cc = (c & 15) * 8;
    const float* s = Cs + row * CLD + cc;
    const u32x4 yu = *(const u32x4*)(Y5 + (size_t)row * 256 + nt * 128 + cc);
    u32x4 u;
#pragma unroll
    for (int e = 0; e < 4; ++e) {
      const float y0 = bflo(yu[e]), y1 = bfhi(yu[e]);
      u[e] = pack2(y0 * sigmoidf_(s[2 * e] + gb[cc + 2 * e]), y1 * sigmoidf_(s[2 * e + 1] + gb[cc + 2 * e + 1]));
    }
    *(u32x4*)(O + (size_t)row * 256 + cc) = u;
  }
  __syncthreads();
}

DI void merge_tile(const Params& p, int l, int j, char* smem) {
  const int nt = j & 7, mt = j >> 3;
  const bf16* H = (const bf16*)(p.ws + OFF_H) + (size_t)mt * 128 * DM;
  unsigned am[2][2][8];
#pragma unroll
  for (int a = 0; a < 2; ++a)
#pragma unroll
    for (int bq = 0; bq < 2; ++bq)
#pragma unroll
      for (int i = 0; i < 8; ++i) am[a][bq][i] = 0u;
#pragma unroll 1
  for (int x = 0; x < 3; ++x) {
    const bf16* Wg = wl(p, l, WL_WIN) + ((size_t)2432 + x * 1024 + nt * 128) * DM;
    unsigned sg[2][2][8];
    {
      f32x16 acc[2][2];
      acc_zero(acc);
      gemm_main_s(acc, H, DM, Wg, DM, DM, smem);
#pragma unroll
      for (int a = 0; a < 2; ++a)
#pragma unroll
        for (int bq = 0; bq < 2; ++bq)
#pragma unroll
          for (int i = 0; i < 8; ++i) sg[a][bq][i] = pack2(sigmoidf_(acc[a][bq][2 * i]), sigmoidf_(acc[a][bq][2 * i + 1]));
    }
    const bf16* A; const bf16* Wb; int K;
    if (x == 0) { A = (const bf16*)(p.ws + OFF_OATT) + (size_t)mt * 128 * 256; Wb = wl(p, l, WL_BRA) + (size_t)nt * 128 * 256; K = 256; }
    else if (x == 1) { A = (const bf16*)(p.ws + OFF_OGLA) + (size_t)mt * 128 * 512; Wb = wl(p, l, WL_BRG) + (size_t)nt * 128 * 512; K = 512; }
    else { A = (const bf16*)(p.ws + OFF_OS5) + (size_t)mt * 128 * 256; Wb = wl(p, l, WL_BRS) + (size_t)nt * 128 * 256; K = 256; }
#pragma unroll
    for (int hf = 0; hf < 2; ++hf) {
      f32x16 a2[2];
#pragma unroll
      for (int i = 0; i < 16; ++i) { a2[0][i] = 0.f; a2[1][i] = 0.f; }
      gemm_main_half(a2, A, K, Wb, K, K, hf, smem);
#pragma unroll
      for (int a = 0; a < 2; ++a)
#pragma unroll
        for (int i = 0; i < 8; ++i) {
          const float v0 = bflo(am[a][hf][i]) + bflo(sg[a][hf][i]) * a2[a][2 * i];
          const float v1 = bfhi(am[a][hf][i]) + bfhi(sg[a][hf][i]) * a2[a][2 * i + 1];
          am[a][hf][i] = pack2(v0, v1);
        }
    }
  }
  f32x16 accm[2][2];
#pragma unroll
  for (int a = 0; a < 2; ++a)
#pragma unroll
    for (int bq = 0; bq < 2; ++bq)
#pragma unroll
      for (int i = 0; i < 8; ++i) { accm[a][bq][2 * i] = bflo(am[a][bq][i]); accm[a][bq][2 * i + 1] = bfhi(am[a][bq][i]); }
  float* Cs = (float*)smem;
  acc_to_lds(accm, Cs);
  __syncthreads();
  store_tile_bf16(Cs, (bf16*)(p.ws + OFF_MG) + (size_t)mt * 128 * DM + nt * 128, DM, 128, 1.f);
  __syncthreads();
}

DI void plain_tile(const bf16* A, int K, const bf16* W, bf16* dst, int ldd, char* smem) {
  f32x16 acc[2][2];
  acc_zero(acc);
  gemm_main_dma(acc, [&](int r) { return A + (size_t)r * K; }, [&](int r) { return W + (size_t)r * K; }, K, smem);
  float* Cs = (float*)smem;
  acc_to_lds(acc, Cs);
  __syncthreads();
  store_tile_bf16(Cs, dst, ldd, 128, 1.f);
  __syncthreads();
}

DI void up_tile(const Params& p, int l, int j, char* smem) {
  const int jn = j % 44, mtile = j / 44;
  const int b = mtile / 69, rr0 = mtile % 69;
  int seqbase, len, ti;
  if (rr0 < 3) { seqbase = b * TT; len = CTXL; ti = rr0; }
  else { seqbase = b * TT + CTXL; len = SEQ; ti = rr0 - 3; }
  const int pos0 = ti * 126 - 1;
  const bf16* H = (const bf16*)(p.ws + OFF_H);
  const bf16* W = wl(p, l, WL_UP) + (size_t)jn * 128 * DM;
  f32x16 acc[2][2];
  acc_zero(acc);
  gemm_main_dma(acc,
            [&](int r) -> const bf16* {
              const int pos = pos0 + r;
              return (pos >= 0 && pos < len) ? H + (size_t)(seqbase + pos) * DM : (const bf16*)(p.ws + OFF_ZERO);
            },
            [&](int r) { return W + (size_t)r * DM; }, DM, smem);
  float* Cs = (float*)smem;
  acc_to_lds(acc, Cs);
  __syncthreads();
  const float* cw = p.in[I_CW] + (size_t)l * 3 * 2 * DFF;
  const float* cb = p.in[I_CB] + (size_t)l * 2 * DFF;
  bf16* G = (bf16*)(p.ws + OFF_G);
  for (int idx = TIDX; idx < 126 * 32; idx += 256) {
    const int rr = 1 + (idx >> 5), c = (idx & 31) * 2;
    const int pos = pos0 + rr;
    if (pos < len) {
      float gv[2];
#pragma unroll
      for (int e = 0; e < 2; ++e) {
        const int ca = jn * 64 + c + e, cv = DFF + ca;
        const float a = cw[ca] * Cs[(rr - 1) * CLD + c + e] + cw[2 * DFF + ca] * Cs[rr * CLD + c + e] +
                        cw[4 * DFF + ca] * Cs[(rr + 1) * CLD + c + e] + cb[ca];
        const float v = cw[cv] * Cs[(rr - 1) * CLD + 64 + c + e] + cw[2 * DFF + cv] * Cs[rr * CLD + 64 + c + e] +
                        cw[4 * DFF + cv] * Cs[(rr + 1) * CLD + 64 + c + e] + cb[cv];
        gv[e] = siluf_(a) * v;
      }
      *(unsigned*)(G + (size_t)(seqbase + pos) * DFF + jn * 64 + c) = pack2(gv[0], gv[1]);
    }
  }
  __syncthreads();
}

DI bool gemm_job(int bid, int G, int it, int MT, int NTL, int& mt, int& nt) {
  const int x = bid & 7, q = bid >> 3, Q = G >> 3;
  const int m0 = (x * MT) >> 3, m1 = ((x + 1) * MT) >> 3, Mx = m1 - m0;
  const int jl = q + Q * it;
  if (jl >= Mx * NTL) return false;
  const int full = Mx * 8;
  const int c = jl / full, rem = jl - c * full;
  const int wc = min(8, NTL - 8 * c);
  const int mi = rem / wc;
  mt = m0 + mi;
  nt = 8 * c + (rem - mi * wc);
  return true;
}

enum { PH_PREP = 0, PH_ROW0, PH_PROJ, PH_MIX1, PH_SCAN, PH_MIX2, PH_GLU, PH_MERGE, PH_WOUT, PH_ROW1, PH_UP, PH_DOWN, PH_ROW2 };
constexpr int N_PHASES = 2 + 11 * NL;

DI void run_phase(const Params& p, int ph, int l, char* smem) {
  const int bid = blockIdx.x;
#ifdef HALFMASK
  const int G = ((HALFMASK >> ph) & 1) ? 256 : gridDim.x;
  if (bid >= G) return;
#else
  const int G = gridDim.x;
#endif
#ifdef PHMASK
  if (!((PHMASK >> ph) & 1)) return;
#endif
  switch (ph) {
    case PH_PREP:
      if (bid < 8) { for (int i = TIDX; i < 512; i += 256) ((u32x4*)(p.ws + OFF_ZERO))[i] = u32x4{0u, 0u, 0u, 0u}; }
      for (int j = bid; j < 128 + 16064; j += G) {
        if (j < 96) prep_mod_job(p, j, smem);
        else if (j < 128) prep_s5_job(p, j - 96);
        else prep_wt_job(p, j - 128, smem);
      }
      break;
    case PH_ROW0:
      row_phase<0>(p, 0, bid, G);
      ktab_phase(p, bid, G);
      break;
    case PH_PROJ:
#ifdef EXP_A
      if (bid < 256) { int mt, nt; for (int it = 0; gemm_job(bid, 256, it, 264, 19, mt, nt); ++it) proj_tile(p, l, mt, nt, smem); }
      s5mat_phase(p, l, bid, G);
#elif defined(EXP_C)
      if (bid < 256) for (int j = bid; j < 264 * 19; j += 256) { if ((EXP_C >> (j % 19)) & 1) proj_tile(p, l, j / 19, j % 19, smem); }
      for (int j = bid; j < 264 * 19; j += G) { if (!((EXP_C >> (j % 19)) & 1)) proj_tile(p, l, j / 19, j % 19, smem); }
      s5mat_phase(p, l, bid, G);
#elif defined(EXP_B)
      for (int j = bid; j < 264 * 19; j += G) proj_tile(p, l, j / 19, j % 19, smem);
      if (bid < 256) s5mat_phase(p, l, bid, 256);
#else
      for (int j = bid; j < 264 * 19; j += G) proj_tile(p, l, j / 19, j % 19, smem);
      s5mat_phase(p, l, bid, G);
#endif
      break;
    case PH_MIX1:
      for (int j = bid; j < 1056 + 1056 + 288; j += G) {
        if (j < 1056) attn_unit(p, j, smem);
        else if (j < 2112) gla_unit<false>(p, l, j - 1056, smem);
        else s5_end_tile(p, j - 2112, smem);
      }
      break;
    case PH_SCAN:
      for (int j = bid; j < 1024 + 128; j += G) {
        if (j < 1024) gla_scan_job(p, j);
        else s5_scan_job(p, l, j - 1024, smem);
      }
      break;
    case PH_MIX2:
      for (int j = bid; j < 528 + 576; j += G) {
        if (j < 528) gla_unit<true>(p, l, j, smem);
        else s5_out_tile(p, j - 528, smem);
      }
      break;
    case PH_GLU:
      { int mt, nt; for (int it = 0; gemm_job(bid, G, it, 264, 2, mt, nt); ++it) glu_tile(p, l, mt * 2 + nt, smem); }
      break;
    case PH_MERGE:
      { int mt, nt; for (int it = 0; gemm_job(bid, G, it, 264, 8, mt, nt); ++it) merge_tile(p, l, mt * 8 + nt, smem); }
      break;
    case PH_WOUT:
      for (int it = 0;; ++it) {
        int mt, nt;
        if (!gemm_job(bid, G, it, 264, 8, mt, nt)) break;
        plain_tile((const bf16*)(p.ws + OFF_MG) + (size_t)mt * 128 * DM, DM, wl(p, l, WL_WOUT) + (size_t)nt * 128 * DM,
                   (bf16*)(p.ws + OFF_H) + (size_t)mt * 128 * DM + nt * 128, DM, smem);
      }
      break;
    case PH_ROW1: row_phase<1>(p, l, bid, G); break;
    case PH_UP:
      { int mt, nt; for (int it = 0; gemm_job(bid, G, it, 276, 44, mt, nt); ++it) up_tile(p, l, mt * 44 + nt, smem); }
      break;
    case PH_DOWN:
      for (int it = 0;; ++it) {
        int mt, nt;
        if (!gemm_job(bid, G, it, 264, 8, mt, nt)) break;
        plain_tile((const bf16*)(p.ws + OFF_G) + (size_t)mt * 128 * DFF, DFF, wl(p, l, WL_DOWN) + (size_t)nt * 128 * DFF,
                   (bf16*)(p.ws + OFF_H) + (size_t)mt * 128 * DM + nt * 128, DM, smem);
      }
      break;
    case PH_ROW2: row_phase<2>(p, l, bid, G); break;
  }
}

DI void grid_barrier(unsigned* bar, unsigned& gen) {
  asm volatile("s_waitcnt vmcnt(0)" ::: "memory");
  __syncthreads();
  gen += 1;
  if (threadIdx.x == 0) {
    __builtin_amdgcn_fence(__ATOMIC_RELEASE, "agent");
    asm volatile("s_waitcnt vmcnt(0)" ::: "memory");
    const unsigned target = gen * gridDim.x;
    __hip_atomic_fetch_add(bar, 1u, __ATOMIC_RELAXED, __HIP_MEMORY_SCOPE_AGENT);
    while (__hip_atomic_load(bar, __ATOMIC_RELAXED, __HIP_MEMORY_SCOPE_AGENT) < target) __builtin_amdgcn_s_sleep(2);
  }
  __syncthreads();
  __builtin_amdgcn_fence(__ATOMIC_ACQUIRE, "agent");
  asm volatile("s_waitcnt vmcnt(0)" ::: "memory");
}

__global__ void __launch_bounds__(256, 2) hybrid_fwd(Params p, int ph_lo, int ph_hi) {
  extern __shared__ __attribute__((aligned(16))) char smem[];
  unsigned* bar = (unsigned*)(p.ws + OFF_BAR);
  unsigned gen = 0;
  if (ph_hi - ph_lo > 1) cg::this_grid().sync();
  int i = 0;
#define STEP(PH, L)                                      \
  {                                                      \
    if (i >= ph_lo && i < ph_hi) {                       \
      Params q;                                          \
      q.ws = p.ws; q.out = p.out;                        \
      asm volatile("" : "+s"(q.ws), "+s"(q.out));        \
      _Pragma("unroll") for (int k = 0; k < 34; ++k) { q.in[k] = p.in[k]; asm volatile("" : "+s"(q.in[k])); } \
      run_phase(q, PH, L, smem);                         \
      if ((DUPMASK >> (PH)) & 1) { grid_barrier(bar, gen); run_phase(q, PH, L, smem); } \
      if (i + 1 < ph_hi) grid_barrier(bar, gen);         \
    }                                                    \
    ++i;                                                 \
  }
  STEP(PH_PREP, 0)
  STEP(PH_ROW0, 0)
#pragma unroll 1
  for (int l = 0; l < NL; ++l) {
    STEP(PH_PROJ, l)
    STEP(PH_MIX1, l)
    STEP(PH_SCAN, l)
    STEP(PH_MIX2, l)
    STEP(PH_GLU, l)
    STEP(PH_MERGE, l)
    STEP(PH_WOUT, l)
    STEP(PH_ROW1, l)
    STEP(PH_UP, l)
    STEP(PH_DOWN, l)
    STEP(PH_ROW2, l)
  }
#undef STEP
}

extern "C" void kernel_launch(void* const* d_in, const int* in_sizes, int n_in, void* d_out, int out_size, void* d_ws, size_t ws_size,
                              hipStream_t stream) {
  static int grid_blocks = 0;
  if (!grid_blocks) {
    int dev = 0, cus = 0, per_cu = 0;
    hipGetDevice(&dev);
    hipDeviceGetAttribute(&cus, hipDeviceAttributeMultiprocessorCount, dev);
    hipFuncSetAttribute((const void*)hybrid_fwd, hipFuncAttributeMaxDynamicSharedMemorySize, SMEM_BYTES);
    hipOccupancyMaxActiveBlocksPerMultiprocessor(&per_cu, hybrid_fwd, 256, SMEM_BYTES);
    if (per_cu < 1) per_cu = 1;
    if (per_cu > 2) per_cu = 2;
    grid_blocks = cus * per_cu;
    if (ws_size < OFF_ZERO + 8192) fprintf(stderr, "workspace too small: %zu < %zu\n", ws_size, (size_t)OFF_END);
  }
  Params p{};
  for (int i = 0; i < 34; ++i) p.in[i] = (const float*)d_in[i];
  p.out = (float*)d_out;
  p.ws = (char*)d_ws;
#if ONE_LAUNCH
  hipMemsetAsync((char*)d_ws + OFF_BAR, 0, 256, stream);
  int lo = 0, hi = N_PHASES;
  void* args[] = {&p, &lo, &hi};
  hipError_t e = hipLaunchCooperativeKernel((void*)hybrid_fwd, dim3(grid_blocks), dim3(256), args, SMEM_BYTES, stream);
  if (e != hipSuccess) fprintf(stderr, "cooperative launch failed: %s (grid %d)\n", hipGetErrorString(e), grid_blocks);
#else
  for (int i = 0; i < N_PHASES; ++i) hipLaunchKernelGGL(hybrid_fwd, dim3(grid_blocks), dim3(256), SMEM_BYTES, stream, p, i, i + 1);
#endif
}
```

```cpp
#include <hip/hip_runtime.h>
#include <hip/hip_cooperative_groups.h>
#include <stdint.h>
#include <cstdio>
namespace cg = cooperative_groups;

#define EXP_A 1
#ifndef DUPMASK
#define DUPMASK 0
#endif
#ifndef ONE_LAUNCH
#define ONE_LAUNCH 1
#endif

typedef unsigned short bf16;
typedef __attribute__((ext_vector_type(8))) short s16x8;
typedef __attribute__((ext_vector_type(4))) short s16x4;
typedef __attribute__((ext_vector_type(16))) float f32x16;
typedef __attribute__((ext_vector_type(4))) float f32x4;
typedef __attribute__((ext_vector_type(2))) float f32x2;
typedef __attribute__((ext_vector_type(4))) unsigned u32x4;
typedef __attribute__((ext_vector_type(2))) unsigned u32x2;
typedef __attribute__((ext_vector_type(2))) __bf16 bf16x2_t;

#define DI __device__ __forceinline__
#define MFMA32(a, b, c) __builtin_amdgcn_mfma_f32_32x32x16_bf16((a), (b), (c), 0, 0, 0)

DI int tidx_opaque() { int t = threadIdx.x; asm volatile("" : "+v"(t)); return t; }
#define TIDX tidx_opaque()
DI bf16 f2bf(float x) { return __builtin_bit_cast(unsigned short, (__bf16)x); }
DI float bf2f(bf16 v) { return __uint_as_float(((unsigned)v) << 16); }
DI unsigned pack2(float a, float b) {
  f32x2 v = {a, b};
  return __builtin_bit_cast(unsigned, __builtin_convertvector(v, bf16x2_t));
}
DI float bflo(unsigned u) { return __uint_as_float(u << 16); }
DI float bfhi(unsigned u) { return __uint_as_float(u & 0xffff0000u); }
typedef const __attribute__((address_space(1))) u32x4* gptr16;
DI u32x4 ldg16(const void* q) { return *(gptr16)(uintptr_t)q; }
#define SCHED_FENCE() __builtin_amdgcn_sched_barrier(0)
DI int crow(int i, int h) { return (i & 3) + 8 * (i >> 2) + 4 * h; }
DI void sincos_cw(float x, float& sn, float& cs) {
  const float k = rintf(x * 0.63661977236758134f);
  float r = fmaf(-k, 1.57079637050628662109375f, x);
  r = fmaf(-k, -4.371139000186241e-08f, r);
  const int q = ((int)k) & 3;
  const float r2 = r * r;
  const float sp = r + r * r2 * (-1.6666667163e-01f + r2 * (8.3333337680e-03f + r2 * (-1.9841270114e-04f + r2 * 2.7557314297e-06f)));
  const float cp = 1.f + r2 * (-0.5f + r2 * (4.1666667908e-02f + r2 * (-1.3888889225e-03f + r2 * (2.4801587642e-05f - r2 * 2.7557314297e-07f))));
  sn = (q == 0) ? sp : (q == 1) ? cp : (q == 2) ? -sp : -cp;
  cs = (q == 0) ? cp : (q == 1) ? -sp : (q == 2) ? -cp : sp;
}
DI float sigmoidf_(float x) { return 1.f / (1.f + __expf(-x)); }
DI float siluf_(float x) { return x / (1.f + __expf(-x)); }

constexpr int DM = 1024, NB = 4, SEQ = 8192, CTXL = 256, TT = SEQ + CTXL, NTOK = NB * TT, NL = 4;
constexpr int DFF = 2816, DIN = 5408;
constexpr float EPSF = 1e-6f;
constexpr int NG33 = 33;
constexpr int NCH = 264;
constexpr int MS5 = NB * NCH;

constexpr size_t SZ_H = (size_t)NTOK * 1024 * 2;
constexpr size_t OFF_H = 0;
constexpr size_t OFF_P = OFF_H + SZ_H;
constexpr size_t OFF_Q = OFF_P;
constexpr size_t OFF_K = OFF_Q + (size_t)NTOK * 256 * 2;
constexpr size_t OFF_VT = OFF_K + (size_t)NTOK * 128 * 2;
constexpr size_t OFF_GQ = OFF_VT + (size_t)NTOK * 128 * 2;
constexpr size_t OFF_GK = OFF_GQ + (size_t)NTOK * 256 * 2;
constexpr size_t OFF_GVT = OFF_GK + (size_t)NTOK * 256 * 2;
constexpr size_t OFF_GR = OFF_GVT + (size_t)NTOK * 512 * 2;
constexpr size_t OFF_SU = OFF_GR + (size_t)NTOK * 512 * 2;
constexpr size_t OFF_LOW = OFF_SU + (size_t)NTOK * 256 * 2;
constexpr size_t OFF_O = OFF_LOW + (size_t)NTOK * 32 * 4;
constexpr size_t OFF_OATT = OFF_O;
constexpr size_t OFF_OGLA = OFF_OATT + (size_t)NTOK * 256 * 2;
constexpr size_t OFF_Y5 = OFF_OGLA + (size_t)NTOK * 512 * 2;
constexpr size_t OFF_EN = OFF_Y5;
constexpr size_t OFF_OS5 = OFF_Y5 + (size_t)NTOK * 256 * 2;
constexpr size_t OFF_M = OFF_OS5 + (size_t)NTOK * 256 * 2;
constexpr size_t OFF_MG = OFF_M;
constexpr size_t OFF_GS = OFF_M;
constexpr size_t OFF_DECG = OFF_GS + (size_t)32 * 33 * 8192 * 4;
constexpr size_t OFF_SB = OFF_DECG + (size_t)32 * 33 * 64 * 4;
constexpr size_t OFF_T5 = OFF_SB + (size_t)MS5 * 16 * 256 * 2;
constexpr size_t OFF_E5 = OFF_T5 + (size_t)16 * 512 * 512 * 2;
constexpr size_t OFF_F5 = OFF_E5 + (size_t)16 * 512 * 256 * 2;
constexpr size_t OFF_MEND = OFF_F5 + (size_t)16 * 256 * 512 * 2;
static_assert(OFF_MEND <= OFF_M + SZ_H, "mixer scratch overflows merged area");
constexpr size_t OFF_W = OFF_M + SZ_H;
constexpr size_t WL_WIN = 0, WL_BRA = WL_WIN + (size_t)5504 * 1024, WL_BRG = WL_BRA + 1024 * 256, WL_BRS = WL_BRG + 1024 * 512,
                 WL_WOUT = WL_BRS + 1024 * 256, WL_UP = WL_WOUT + 1024 * 1024, WL_DOWN = WL_UP + (size_t)5632 * 1024,
                 WL_GLU = WL_DOWN + (size_t)1024 * 2816, WL_TOTAL = WL_GLU + 256 * 256;
constexpr size_t OFF_XC = OFF_W + WL_TOTAL * 2 * NL;
constexpr size_t OFF_MOD = OFF_XC + (size_t)NB * CTXL * 1024 * 4;
constexpr size_t OFF_BBR = OFF_MOD + (size_t)NL * 5 * 6144 * 4;
constexpr size_t OFF_BBI = OFF_BBR + (size_t)NL * 2 * 16 * 64 * 16 * 4;
constexpr size_t OFF_PWR = OFF_BBI + (size_t)NL * 2 * 16 * 64 * 16 * 4;
constexpr size_t OFF_KTAB = OFF_PWR + (size_t)NL * 2 * 16 * 33 * 64 * 8;
constexpr size_t OFF_END = OFF_KTAB + (size_t)NL * 16 * 2 * 32 * 256 * 4;
constexpr size_t OFF_BAR = OFF_END;
constexpr size_t OFF_ZERO = OFF_BAR + 256;
constexpr size_t OFF_G = OFF_P;
static_assert((size_t)NTOK * DFF * 2 <= OFF_M - OFF_P, "G overflows");

constexpr int SMEM_BYTES = 73728;

struct Params {
  const float* in[34];
  float* out;
  char* ws;
};

enum { I_X = 0, I_C, I_CTX, I_CCTX, I_ADAW, I_ADAB, I_NMPRE, I_NMPOST, I_NFPRE, I_NFPOST, I_WIN, I_QN, I_KN, I_GGW, I_GGB, I_GON,
       I_ARE, I_AIM, I_LDT, I_BRE, I_BIM, I_CRE, I_CIM, I_S5D, I_GLUW, I_GLUB, I_WBA, I_WBG, I_WBS, I_WOUT, I_UP, I_CW, I_CB, I_DOWN };

constexpr int LDT = 72;
constexpr int CLD = 132;

template <class FA, class FB>
DI void gemm_main(f32x16 (&acc)[2][2], FA fa, FB fb, int K, char* smem) {
  bf16* As = (bf16*)smem;
  bf16* Bs = (bf16*)(smem + 2 * 128 * LDT * 2);
  const int tid = TIDX, lane = tid & 63, w = tid >> 6, wm = w >> 1, wn = w & 1;
  const int r = lane & 31, h = lane >> 5;
  const int lr = tid >> 3, kc = (tid & 7) * 8;
  const bf16* ap[4];
  const bf16* bp[4];
#pragma unroll
  for (int i = 0; i < 4; ++i) {
    const bf16* a = fa(lr + 32 * i);
    const bf16* b = fb(lr + 32 * i);
    ap[i] = a ? a + kc : nullptr;
    bp[i] = b ? b + kc : nullptr;
  }
  u32x4 ra[4], rb[4];
  const u32x4 z4 = {0u, 0u, 0u, 0u};
#pragma unroll
  for (int i = 0; i < 4; ++i) {
    ra[i] = ap[i] ? ldg16(ap[i]) : z4;
    rb[i] = bp[i] ? ldg16(bp[i]) : z4;
  }
#pragma unroll
  for (int i = 0; i < 4; ++i) {
    *(u32x4*)(As + (lr + 32 * i) * LDT + kc) = ra[i];
    *(u32x4*)(Bs + (lr + 32 * i) * LDT + kc) = rb[i];
  }
  __syncthreads();
  const int nk = K / 64;
  for (int kt = 0; kt < nk; ++kt) {
    const int buf = kt & 1;
    const bool more = (kt + 1 < nk);
    if (more) {
      const int k0 = (kt + 1) * 64;
#pragma unroll
      for (int i = 0; i < 4; ++i) {
        ra[i] = ap[i] ? ldg16(ap[i] + k0) : z4;
        rb[i] = bp[i] ? ldg16(bp[i] + k0) : z4;
      }
    }
    SCHED_FENCE();
    const bf16* Ab = As + buf * 128 * LDT + (wm * 64 + r) * LDT + h * 8;
    const bf16* Bb = Bs + buf * 128 * LDT + (wn * 64 + r) * LDT + h * 8;
#pragma unroll
    for (int s = 0; s < 4; ++s) {
      s16x8 a0 = *(const s16x8*)(Ab + s * 16);
      s16x8 a1 = *(const s16x8*)(Ab + 32 * LDT + s * 16);
      s16x8 b0 = *(const s16x8*)(Bb + s * 16);
      s16x8 b1 = *(const s16x8*)(Bb + 32 * LDT + s * 16);
      acc[0][0] = MFMA32(a0, b0, acc[0][0]);
      acc[0][1] = MFMA32(a0, b1, acc[0][1]);
      acc[1][0] = MFMA32(a1, b0, acc[1][0]);
      acc[1][1] = MFMA32(a1, b1, acc[1][1]);
    }
    SCHED_FENCE();
    if (more) {
      bf16* Aw = As + (buf ^ 1) * 128 * LDT;
      bf16* Bw = Bs + (buf ^ 1) * 128 * LDT;
#pragma unroll
      for (int i = 0; i < 4; ++i) {
        *(u32x4*)(Aw + (lr + 32 * i) * LDT + kc) = ra[i];
        *(u32x4*)(Bw + (lr + 32 * i) * LDT + kc) = rb[i];
      }
    }
    __syncthreads();
  }
}

template <class FA, class FB>
DI void gemm_main_deep(f32x16 (&acc)[2][2], FA fa, FB fb, int K, char* smem) {
  bf16* As = (bf16*)smem;
  bf16* Bs = (bf16*)(smem + 2 * 128 * LDT * 2);
  const int tid = TIDX, lane = tid & 63, w = tid >> 6, wm = w >> 1, wn = w & 1;
  const int r = lane & 31, h = lane >> 5;
  const int lr = tid >> 3, kc = (tid & 7) * 8;
  const bf16* ap[4];
  const bf16* bp[4];
#pragma unroll
  for (int i = 0; i < 4; ++i) {
    const bf16* a = fa(lr + 32 * i);
    const bf16* b = fb(lr + 32 * i);
    ap[i] = a ? a + kc : nullptr;
    bp[i] = b ? b + kc : nullptr;
  }
  const u32x4 z4 = {0u, 0u, 0u, 0u};
  u32x4 a0[4], b0[4], a1[4], b1[4];
  const int nk = K / 64;
#define GD_LOAD(RA, RB, T)                                               \
  {                                                                      \
    const int k0_ = (T) * 64;                                            \
    _Pragma("unroll") for (int i = 0; i < 4; ++i) {                      \
      RA[i] = ap[i] ? ldg16(ap[i] + k0_) : z4;                           \
      RB[i] = bp[i] ? ldg16(bp[i] + k0_) : z4;                           \
    }                                                                    \
  }
#define GD_STORE(RA, RB, BUF)                                            \
  {                                                                      \
    _Pragma("unroll") for (int i = 0; i < 4; ++i) {                      \
      *(u32x4*)(As + (BUF) * 128 * LDT + (lr + 32 * i) * LDT + kc) = RA[i]; \
      *(u32x4*)(Bs + (BUF) * 128 * LDT + (lr + 32 * i) * LDT + kc) = RB[i]; \
    }                                                                    \
  }
#define GD_COMPUTE(BUF)                                                  \
  {                                                                      \
    const bf16* Ab = As + (BUF) * 128 * LDT + (wm * 64 + r) * LDT + h * 8; \
    const bf16* Bb = Bs + (BUF) * 128 * LDT + (wn * 64 + r) * LDT + h * 8; \
    _Pragma("unroll") for (int s = 0; s < 4; ++s) {                      \
      s16x8 fa0 = *(const s16x8*)(Ab + s * 16);                          \
      s16x8 fa1 = *(const s16x8*)(Ab + 32 * LDT + s * 16);               \
      s16x8 fb0 = *(const s16x8*)(Bb + s * 16);                          \
      s16x8 fb1 = *(const s16x8*)(Bb + 32 * LDT + s * 16);               \
      acc[0][0] = MFMA32(fa0, fb0, acc[0][0]);                           \
      acc[0][1] = MFMA32(fa0, fb1, acc[0][1]);                           \
      acc[1][0] = MFMA32(fa1, fb0, acc[1][0]);                           \
      acc[1][1] = MFMA32(fa1, fb1, acc[1][1]);                           \
    }                                                                    \
  }
  GD_LOAD(a0, b0, 0)
  GD_LOAD(a1, b1, 1)
  GD_STORE(a0, b0, 0)
  __syncthreads();
  if (nk > 2) GD_LOAD(a0, b0, 2)
  for (int kt = 0; kt < nk; kt += 2) {
    SCHED_FENCE();
    GD_COMPUTE(0)
    SCHED_FENCE();
    GD_STORE(a1, b1, 1)
    if (kt + 3 < nk) GD_LOAD(a1, b1, kt + 3)
    __syncthreads();
    SCHED_FENCE();
    GD_COMPUTE(1)
    SCHED_FENCE();
    if (kt + 2 < nk) {
      GD_STORE(a0, b0, 0)
      if (kt + 4 < nk) GD_LOAD(a0, b0, kt + 4)
    }
    __syncthreads();
  }
#undef GD_LOAD
#undef GD_STORE
#undef GD_COMPUTE
}

template <class FA, class FB>
DI void gemm_main_dma(f32x16 (&acc)[2][2], FA fa, FB fb, int K, char* smem) {
  char* As = smem;
  char* Bs = smem + 32768;
  const int tid = TIDX, lane = tid & 63, w = tid >> 6, wm = w >> 1, wn = w & 1;
  const int r = lane & 31, h = lane >> 5;
  const bf16* ap[4];
  const bf16* bp[4];
#pragma unroll
  for (int i = 0; i < 4; ++i) {
    const int row = w * 32 + i * 8 + (lane >> 3);
    const int c = (lane & 7) ^ ((row >> 1) & 7);
    ap[i] = fa(row) + c * 8;
    bp[i] = fb(row) + c * 8;
  }
  const int ldst = (w * 256 + lane) * 16;
#define GM_DMA(BUF, T)                                                                                        \
  {                                                                                                           \
    const int k0_ = (T) * 64;                                                                                 \
    _Pragma("unroll") for (int i = 0; i < 4; ++i) {                                                           \
      __builtin_amdgcn_global_load_lds((const unsigned*)(ap[i] + k0_), (unsigned*)(As + (BUF) * 16384 + ldst + i * 1024), 16, 0, 0); \
      __builtin_amdgcn_global_load_lds((const unsigned*)(bp[i] + k0_), (unsigned*)(Bs + (BUF) * 16384 + ldst + i * 1024), 16, 0, 0); \
    }                                                                                                         \
  }
  const int xr = (r >> 1) & 7;
  const int arow = (wm * 64 + r) * 128, brow = (wn * 64 + r) * 128;
  GM_DMA(0, 0)
  asm volatile("s_waitcnt vmcnt(0)" ::: "memory");
  __syncthreads();
  const int nk = K / 64;
  for (int kt = 0; kt < nk; ++kt) {
    const int buf = kt & 1;
    if (kt + 1 < nk) GM_DMA(buf ^ 1, kt + 1)
    const char* Ab = As + buf * 16384 + arow;
    const char* Bb = Bs + buf * 16384 + brow;
#pragma unroll
    for (int s = 0; s < 4; ++s) {
      const int co = ((2 * s + h) ^ xr) * 16;
      s16x8 a0 = *(const s16x8*)(Ab + co);
      s16x8 a1 = *(const s16x8*)(Ab + 32 * 128 + co);
      s16x8 b0 = *(const s16x8*)(Bb + co);
      s16x8 b1 = *(const s16x8*)(Bb + 32 * 128 + co);
      acc[0][0] = MFMA32(a0, b0, acc[0][0]);
      acc[0][1] = MFMA32(a0, b1, acc[0][1]);
      acc[1][0] = MFMA32(a1, b0, acc[1][0]);
      acc[1][1] = MFMA32(a1, b1, acc[1][1]);
    }
    asm volatile("s_waitcnt vmcnt(0)" ::: "memory");
    __syncthreads();
  }
#undef GM_DMA
}

DI void gemm_main_dma_half(f32x16 (&acc)[2], const bf16* A, int lda, const bf16* B, int ldb, int K, int hf, char* smem) {
  char* As = smem;
  char* Bs = smem + 32768;
  const int tid = TIDX, lane = tid & 63, w = tid >> 6, wm = w >> 1, wn = w & 1;
  const int r = lane & 31, h = lane >> 5;
  const bf16* ap[4];
  const bf16* bp[2];
#pragma unroll
  for (int i = 0; i < 4; ++i) {
    const int row = w * 32 + i * 8 + (lane >> 3);
    ap[i] = A + (size_t)row * lda + ((lane & 7) ^ ((row >> 1) & 7)) * 8;
  }
#pragma unroll
  for (int i = 0; i < 2; ++i) {
    const int lrow = w * 16 + i * 8 + (lane >> 3);
    const int grow = (lrow >> 5) * 64 + hf * 32 + (lrow & 31);
    bp[i] = B + (size_t)grow * ldb + ((lane & 7) ^ ((lrow >> 1) & 7)) * 8;
  }
  const int lda_ = (w * 256 + lane) * 16, ldb_ = (w * 128 + lane) * 16;
#define GH_DMA(BUF, T)                                                                                        \
  {                                                                                                           \
    const int k0_ = (T) * 64;                                                                                 \
    _Pragma("unroll") for (int i = 0; i < 4; ++i)                                                             \
      __builtin_amdgcn_global_load_lds((const unsigned*)(ap[i] + k0_), (unsigned*)(As + (BUF) * 16384 + lda_ + i * 1024), 16, 0, 0); \
    _Pragma("unroll") for (int i = 0; i < 2; ++i)                                                             \
      __builtin_amdgcn_global_load_lds((const unsigned*)(bp[i] + k0_), (unsigned*)(Bs + (BUF) * 8192 + ldb_ + i * 1024), 16, 0, 0); \
  }
  const int xr = (r >> 1) & 7;
  const int arow = (wm * 64 + r) * 128, brow = (wn * 32 + r) * 128;
  GH_DMA(0, 0)
  asm volatile("s_waitcnt vmcnt(0)" ::: "memory");
  __syncthreads();
  const int nk = K / 64;
  for (int kt = 0; kt < nk; ++kt) {
    const int buf = kt & 1;
    if (kt + 1 < nk) GH_DMA(buf ^ 1, kt + 1)
    const char* Ab = As + buf * 16384 + arow;
    const char* Bb = Bs + buf * 8192 + brow;
#pragma unroll
    for (int s = 0; s < 4; ++s) {
      const int co = ((2 * s + h) ^ xr) * 16;
      s16x8 a0 = *(const s16x8*)(Ab + co);
      s16x8 a1 = *(const s16x8*)(Ab + 32 * 128 + co);
      s16x8 b0 = *(const s16x8*)(Bb + co);
      acc[0] = MFMA32(a0, b0, acc[0]);
      acc[1] = MFMA32(a1, b0, acc[1]);
    }
    asm volatile("s_waitcnt vmcnt(0)" ::: "memory");
    __syncthreads();
  }
#undef GH_DMA
}

DI void gemm_main_s(f32x16 (&acc)[2][2], const bf16* A, int lda, const bf16* B, int ldb, int K, char* smem) {
  bf16* As = (bf16*)smem;
  bf16* Bs = (bf16*)(smem + 2 * 128 * LDT * 2);
  const int tid = TIDX, lane = tid & 63, w = tid >> 6, wm = w >> 1, wn = w & 1;
  const int r = lane & 31, h = lane >> 5;
  const int lr = tid >> 3, kc = (tid & 7) * 8;
  const bf16* ap = A + (size_t)lr * lda + kc;
  const bf16* bp = B + (size_t)lr * ldb + kc;
  const size_t sa = (size_t)32 * lda, sb = (size_t)32 * ldb;
  u32x4 ra[4], rb[4];
#pragma unroll
  for (int i = 0; i < 4; ++i) {
    ra[i] = ldg16(ap + i * sa);
    rb[i] = ldg16(bp + i * sb);
  }
#pragma unroll
  for (int i = 0; i < 4; ++i) {
    *(u32x4*)(As + (lr + 32 * i) * LDT + kc) = ra[i];
    *(u32x4*)(Bs + (lr + 32 * i) * LDT + kc) = rb[i];
  }
  __syncthreads();
  const int nk = K / 64;
  for (int kt = 0; kt < nk; ++kt) {
    const int buf = kt & 1;
    const bool more = (kt + 1 < nk);
    if (more) {
      ap += 64; bp += 64;
#pragma unroll
      for (int i = 0; i < 4; ++i) {
        ra[i] = ldg16(ap + i * sa);
        rb[i] = ldg16(bp + i * sb);
      }
    }
    SCHED_FENCE();
    const bf16* Ab = As + buf * 128 * LDT + (wm * 64 + r) * LDT + h * 8;
    const bf16* Bb = Bs + buf * 128 * LDT + (wn * 64 + r) * LDT + h * 8;
#pragma unroll
    for (int s = 0; s < 4; ++s) {
      s16x8 a0 = *(const s16x8*)(Ab + s * 16);
      s16x8 a1 = *(const s16x8*)(Ab + 32 * LDT + s * 16);
      s16x8 b0 = *(const s16x8*)(Bb + s * 16);
      s16x8 b1 = *(const s16x8*)(Bb + 32 * LDT + s * 16);
      acc[0][0] = MFMA32(a0, b0, acc[0][0]);
      acc[0][1] = MFMA32(a0, b1, acc[0][1]);
      acc[1][0] = MFMA32(a1, b0, acc[1][0]);
      acc[1][1] = MFMA32(a1, b1, acc[1][1]);
    }
    SCHED_FENCE();
    if (more) {
      bf16* Aw = As + (buf ^ 1) * 128 * LDT;
      bf16* Bw = Bs + (buf ^ 1) * 128 * LDT;
#pragma unroll
      for (int i = 0; i < 4; ++i) {
        *(u32x4*)(Aw + (lr + 32 * i) * LDT + kc) = ra[i];
        *(u32x4*)(Bw + (lr + 32 * i) * LDT + kc) = rb[i];
      }
    }
    __syncthreads();
  }
}

DI void gemm_main_half(f32x16 (&acc)[2], const bf16* A, int lda, const bf16* B, int ldb, int K, int hf, char* smem) {
  bf16* As = (bf16*)smem;
  bf16* Bs = (bf16*)(smem + 2 * 128 * LDT * 2);
  const int tid = TIDX, lane = tid & 63, w = tid >> 6, wm = w >> 1, wn = w & 1;
  const int r = lane & 31, h = lane >> 5;
  const int lr = tid >> 3, kc = (tid & 7) * 8;
  const bf16* ap = A + (size_t)lr * lda + kc;
  const bf16* bp = B + (size_t)(hf * 32 + lr) * ldb + kc;
  const size_t sa = (size_t)32 * lda, sb = (size_t)64 * ldb;
  u32x4 ra[4], rb[2];
#pragma unroll
  for (int i = 0; i < 4; ++i) ra[i] = ldg16(ap + i * sa);
#pragma unroll
  for (int i = 0; i < 2; ++i) rb[i] = ldg16(bp + i * sb);
#pragma unroll
  for (int i = 0; i < 4; ++i) *(u32x4*)(As + (lr + 32 * i) * LDT + kc) = ra[i];
#pragma unroll
  for (int i = 0; i < 2; ++i) *(u32x4*)(Bs + (lr + 32 * i) * LDT + kc) = rb[i];
  __syncthreads();
  const int nk = K / 64;
  for (int kt = 0; kt < nk; ++kt) {
    const int buf = kt & 1;
    const bool more = (kt + 1 < nk);
    if (more) {
      ap += 64; bp += 64;
#pragma unroll
      for (int i = 0; i < 4; ++i) ra[i] = ldg16(ap + i * sa);
#pragma unroll
      for (int i = 0; i < 2; ++i) rb[i] = ldg16(bp + i * sb);
    }
    SCHED_FENCE();
    const bf16* Ab = As + buf * 128 * LDT + (wm * 64 + r) * LDT + h * 8;
    const bf16* Bb = Bs + buf * 128 * LDT + (wn * 32 + r) * LDT + h * 8;
#pragma unroll
    for (int s = 0; s < 4; ++s) {
      s16x8 a0 = *(const s16x8*)(Ab + s * 16);
      s16x8 a1 = *(const s16x8*)(Ab + 32 * LDT + s * 16);
      s16x8 b0 = *(const s16x8*)(Bb + s * 16);
      acc[0] = MFMA32(a0, b0, acc[0]);
      acc[1] = MFMA32(a1, b0, acc[1]);
    }
    SCHED_FENCE();
    if (more) {
      bf16* Aw = As + (buf ^ 1) * 128 * LDT;
      bf16* Bw = Bs + (buf ^ 1) * 128 * LDT;
#pragma unroll
      for (int i = 0; i < 4; ++i) *(u32x4*)(Aw + (lr + 32 * i) * LDT + kc) = ra[i];
#pragma unroll
      for (int i = 0; i < 2; ++i) *(u32x4*)(Bw + (lr + 32 * i) * LDT + kc) = rb[i];
    }
    __syncthreads();
  }
}

DI void acc_zero(f32x16 (&acc)[2][2]) {
#pragma unroll
  for (int a = 0; a < 2; ++a)
#pragma unroll
    for (int b = 0; b < 2; ++b)
#pragma unroll
      for (int i = 0; i < 16; ++i) acc[a][b][i] = 0.f;
}

DI void acc_to_lds(const f32x16 (&acc)[2][2], float* Cs) {
  const int lane = TIDX & 63, w = TIDX >> 6, wm = w >> 1, wn = w & 1, r = lane & 31, h = lane >> 5;
#pragma unroll
  for (int tm = 0; tm < 2; ++tm)
#pragma unroll
    for (int tn = 0; tn < 2; ++tn)
#pragma unroll
      for (int i = 0; i < 16; ++i) Cs[(wm * 64 + tm * 32 + crow(i, h)) * CLD + wn * 64 + tn * 32 + r] = acc[tm][tn][i];
}

DI void store_tile_bf16(const float* Cs, bf16* dst, size_t ld, int mvalid, float scale) {
  for (int c = TIDX; c < 2048; c += 256) {
    const int row = c >> 4, cc = (c & 15) * 8;
    if (row < mvalid) {
      const float* s = Cs + row * CLD + cc;
      u32x4 v;
      v[0] = pack2(s[0] * scale, s[1] * scale);
      v[1] = pack2(s[2] * scale, s[3] * scale);
      v[2] = pack2(s[4] * scale, s[5] * scale);
      v[3] = pack2(s[6] * scale, s[7] * scale);
      *(u32x4*)(dst + (size_t)row * ld + cc) = v;
    }
  }
}

DI float* resid_row(const Params& p, int tok) {
  const int b = tok / TT, t = tok - b * TT;
  return (t < CTXL) ? (float*)(p.ws + OFF_XC) + ((size_t)b * CTXL + t) * DM : p.out + ((size_t)b * SEQ + (t - CTXL)) * DM;
}
DI const float* mod_vec(const Params& p, int l, int tok, int which) {
  const int b = tok / TT, t = tok - b * TT;
  const int m = (t < CTXL) ? 4 : b;
  return (const float*)(p.ws + OFF_MOD) + ((size_t)(l * 5 + m) * 6 + which) * DM;
}
DI float wave_sum(float v) {
#pragma unroll
  for (int o = 32; o >= 1; o >>= 1) v += __shfl_xor(v, o, 64);
  return v;
}
DI bf16* wl(const Params& p, int l, size_t off) { return (bf16*)(p.ws + OFF_W) + (size_t)l * WL_TOTAL + off; }

DI void prep_mod_job(const Params& p, int j, char* smem) {
  float* sc = (float*)smem;
  const int l = j / 24, nb = j % 24, tid = TIDX;
  for (int idx = tid; idx < 5120; idx += 256) {
    const int m = idx >> 10, k = idx & 1023;
    const float v = (m < 4) ? p.in[I_C][m * 1024 + k] : p.in[I_CCTX][k];
    sc[idx] = siluf_(v);
  }
  __syncthreads();
  const int n = nb * 256 + tid;
  const float* W = p.in[I_ADAW] + (size_t)l * 1024 * 6144 + n;
  float a0 = 0, a1 = 0, a2 = 0, a3 = 0, a4 = 0;
#pragma unroll 8
  for (int k = 0; k < 1024; ++k) {
    const float wv = W[(size_t)k * 6144];
    a0 += sc[k] * wv; a1 += sc[1024 + k] * wv; a2 += sc[2048 + k] * wv; a3 += sc[3072 + k] * wv; a4 += sc[4096 + k] * wv;
  }
  const float bb = p.in[I_ADAB][l * 6144 + n];
  float* M = (float*)(p.ws + OFF_MOD) + (size_t)l * 5 * 6144 + n;
  M[0] = a0 + bb; M[6144] = a1 + bb; M[2 * 6144] = a2 + bb; M[3 * 6144] = a3 + bb; M[4 * 6144] = a4 + bb;
  __syncthreads();
}

DI void prep_s5_job(const Params& p, int j) {
  const int idx = j * 256 + TIDX;
  const int ldg = idx >> 6, pp = idx & 63;
  const float dt = expf(p.in[I_LDT][ldg]);
  const float are = p.in[I_ARE][idx], aim = p.in[I_AIM][idx];
  const float mag = expf(are * dt);
  float sn, cs;
  sincos_cw(aim * dt, sn, cs);
  const float abr = mag * cs, abi = mag * sn;
  const float den = are * are + aim * aim;
  const float fre = ((abr - 1.f) * are + abi * aim) / den;
  const float fim = (abi * are - (abr - 1.f) * aim) / den;
  float* BBR = (float*)(p.ws + OFF_BBR);
  float* BBI = (float*)(p.ws + OFF_BBI);
  for (int hh = 0; hh < 16; ++hh) {
    const float br = p.in[I_BRE][(size_t)idx * 16 + hh], bi = p.in[I_BIM][(size_t)idx * 16 + hh];
    BBR[(size_t)idx * 16 + hh] = fre * br - fim * bi;
    BBI[(size_t)idx * 16 + hh] = fre * bi + fim * br;
  }
  float2* PW = (float2*)(p.ws + OFF_PWR);
  float pr = 1.f, pi = 0.f;
  for (int tau = 0; tau <= 32; ++tau) {
    PW[((size_t)ldg * 33 + tau) * 64 + pp] = make_float2(pr, pi);
    const float nr = pr * abr - pi * abi, ni = pr * abi + pi * abr;
    pr = nr; pi = ni;
  }
}

DI void prep_wt_job(const Params& p, int jj, char* smem) {
  float* tile = (float*)smem;
  const int l = jj / 4016;
  int r = jj % 4016;
  int mat = 0;
  const int cnt[8] = {1376, 64, 128, 64, 256, 1408, 704, 16};
#pragma unroll
  for (int m = 0; m < 8; ++m) {
    if (mat == m && r >= cnt[m]) { r -= cnt[m]; mat = m + 1; }
  }
  const float* src; int K, sld; size_t doff;
  switch (mat) {
    case 0: src = p.in[I_WIN] + (size_t)l * 1024 * DIN; K = 1024; sld = DIN; doff = WL_WIN; break;
    case 1: src = p.in[I_WBA] + (size_t)l * 256 * 1024; K = 256; sld = 1024; doff = WL_BRA; break;
    case 2: src = p.in[I_WBG] + (size_t)l * 512 * 1024; K = 512; sld = 1024; doff = WL_BRG; break;
    case 3: src = p.in[I_WBS] + (size_t)l * 256 * 1024; K = 256; sld = 1024; doff = WL_BRS; break;
    case 4: src = p.in[I_WOUT] + (size_t)l * 1024 * 1024; K = 1024; sld = 1024; doff = WL_WOUT; break;
    case 5: src = p.in[I_UP] + (size_t)l * 1024 * 5632; K = 1024; sld = 5632; doff = WL_UP; break;
    case 6: src = p.in[I_DOWN] + (size_t)l * 2816 * 1024; K = 2816; sld = 1024; doff = WL_DOWN; break;
    default: src = p.in[I_GLUW] + (size_t)l * 256 * 256; K = 256; sld = 256; doff = WL_GLU; break;
  }
  const int kt = K / 64;
  const int n0 = (r / kt) * 64, k0 = (r % kt) * 64;
  const int tid = TIDX;
  {
    const int nn = tid & 63;
    const int np = n0 + nn;
    int col;
    if (mat == 0) {
      if (np < 2048) col = np;
      else if (np < 2304) col = 2080 + (np - 2048);
      else if (np < 2336) col = 2048 + (np - 2304);
      else if (np < 2432) col = -1;
      else col = 2336 + (np - 2432);
    } else if (mat == 5) {
      const int jb = np >> 7, c = np & 127;
      col = (c < 64) ? (jb * 64 + c) : (DFF + jb * 64 + (c - 64));
    } else col = np;
#pragma unroll 4
    for (int kk = tid >> 6; kk < 64; kk += 4) tile[kk * 65 + nn] = (col >= 0) ? src[(size_t)(k0 + kk) * sld + col] : 0.f;
  }
  __syncthreads();
  {
    const int nn = tid >> 2, kq = (tid & 3) * 16;
    bf16* d = wl(p, l, doff) + (size_t)(n0 + nn) * K + k0 + kq;
    u32x4 v0, v1;
#pragma unroll
    for (int e = 0; e < 4; ++e) {
      v0[e] = pack2(tile[(kq + 2 * e) * 65 + nn], tile[(kq + 2 * e + 1) * 65 + nn]);
      v1[e] = pack2(tile[(kq + 8 + 2 * e) * 65 + nn], tile[(kq + 8 + 2 * e + 1) * 65 + nn]);
    }
    *(u32x4*)d = v0;
    *(u32x4*)(d + 8) = v1;
  }
  __syncthreads();
}

template <int MODE>
DI void row_job(const Params& p, int l, int tok) {
  const int lane = TIDX & 63;
  float x[16];
  float* xr = resid_row(p, tok);
  if (MODE == 0) {
    const int b = tok / TT, t = tok - b * TT;
    const float* src = (t < CTXL) ? p.in[I_CTX] + ((size_t)b * CTXL + t) * DM : p.in[I_X] + ((size_t)b * SEQ + (t - CTXL)) * DM;
#pragma unroll
    for (int i = 0; i < 4; ++i) {
      const f32x4 v = *(const f32x4*)(src + lane * 4 + 256 * i);
      x[4 * i] = v[0]; x[4 * i + 1] = v[1]; x[4 * i + 2] = v[2]; x[4 * i + 3] = v[3];
      *(f32x4*)(xr + lane * 4 + 256 * i) = v;
    }
  } else {
    const bf16* yr = (const bf16*)(p.ws + OFF_H) + (size_t)tok * DM;
    const float* gpost = p.in[MODE == 1 ? I_NMPOST : I_NFPOST] + l * DM;
    const float* mg = mod_vec(p, l, tok, MODE == 1 ? 2 : 5);
    float y[16];
    float ss = 0.f;
#pragma unroll
    for (int i = 0; i < 4; ++i) {
      const u32x2 u = *(const u32x2*)(yr + lane * 4 + 256 * i);
      y[4 * i] = bflo(u[0]); y[4 * i + 1] = bfhi(u[0]); y[4 * i + 2] = bflo(u[1]); y[4 * i + 3] = bfhi(u[1]);
#pragma unroll
      for (int e = 0; e < 4; ++e) ss += y[4 * i + e] * y[4 * i + e];
    }
    ss = wave_sum(ss);
    const float rstd = rsqrtf(ss * (1.f / DM) + EPSF);
#pragma unroll
    for (int i = 0; i < 4; ++i) {
      f32x4 v = *(const f32x4*)(xr + lane * 4 + 256 * i);
      const f32x4 g = *(const f32x4*)(gpost + lane * 4 + 256 * i);
      const f32x4 m = *(const f32x4*)(mg + lane * 4 + 256 * i);
#pragma unroll
      for (int e = 0; e < 4; ++e) { v[e] += m[e] * (y[4 * i + e] * rstd * g[e]); x[4 * i + e] = v[e]; }
      *(f32x4*)(xr + lane * 4 + 256 * i) = v;
    }
  }
  if (MODE == 2 && l == NL - 1) return;
  const int ln = (MODE == 2) ? l + 1 : l;
  const float* gpre = p.in[MODE == 1 ? I_NFPRE : I_NMPRE] + ln * DM;
  const float* sh = mod_vec(p, ln, tok, MODE == 1 ? 3 : 0);
  const float* scv = mod_vec(p, ln, tok, MODE == 1 ? 4 : 1);
  float ss = 0.f;
#pragma unroll
  for (int i = 0; i < 16; ++i) ss += x[i] * x[i];
  ss = wave_sum(ss);
  const float rstd = rsqrtf(ss * (1.f / DM) + EPSF);
  bf16* hr = (bf16*)(p.ws + OFF_H) + (size_t)tok * DM;
#pragma unroll
  for (int i = 0; i < 4; ++i) {
    const f32x4 g = *(const f32x4*)(gpre + lane * 4 + 256 * i);
    const f32x4 s1 = *(const f32x4*)(sh + lane * 4 + 256 * i);
    const f32x4 s2 = *(const f32x4*)(scv + lane * 4 + 256 * i);
    float o[4];
#pragma unroll
    for (int e = 0; e < 4; ++e) o[e] = (x[4 * i + e] * rstd * g[e]) * (1.f + s2[e]) + s1[e];
    u32x2 u;
    u[0] = pack2(o[0], o[1]); u[1] = pack2(o[2], o[3]);
    *(u32x2*)(hr + lane * 4 + 256 * i) = u;
  }
}

template <int MODE>
DI void row_phase(const Params& p, int l, int bid, int G) {
  const int wg = bid * 4 + (TIDX >> 6), nw = G * 4;
  for (int tok = wg; tok < NTOK; tok += nw) row_job<MODE>(p, l, tok);
}

DI void ktab_phase(const Params& p, int bid, int G) {
  const float* BBR = (const float*)(p.ws + OFF_BBR);
  const float* BBI = (const float*)(p.ws + OFF_BBI);
  const float2* PW = (const float2*)(p.ws + OFF_PWR);
  float* KT = (float*)(p.ws + OFF_KTAB);
  const int total = NL * 16 * 2 * 32 * 256;
  for (int idx = bid * 256 + TIDX; idx < total; idx += G * 256) {
    const int hp = idx & 15, hh = (idx >> 4) & 15, tau = (idx >> 8) & 31, d = (idx >> 13) & 1, g = (idx >> 14) & 15, l = idx >> 18;
    const int ldg = (l * 2 + d) * 16 + g;
    const float* cre = p.in[I_CRE] + ((size_t)ldg * 16 + hh) * 64;
    const float* cim = p.in[I_CIM] + ((size_t)ldg * 16 + hh) * 64;
    float acc = 0.f;
    for (int pp = 0; pp < 64; ++pp) {
      const float2 pw = PW[((size_t)ldg * 33 + tau) * 64 + pp];
      const float br = BBR[((size_t)ldg * 64 + pp) * 16 + hp], bi = BBI[((size_t)ldg * 64 + pp) * 16 + hp];
      const float zr = pw.x * br - pw.y * bi, zi = pw.x * bi + pw.y * br;
      acc += cre[pp] * zr - cim[pp] * zi;
    }
    KT[idx] = acc;
  }
}

DI void s5mat_phase(const Params& p, int l, int bid, int G) {
  const float* BBR = (const float*)(p.ws + OFF_BBR);
  const float* BBI = (const float*)(p.ws + OFF_BBI);
  const float2* PW = (const float2*)(p.ws + OFF_PWR);
  const float* KT = (const float*)(p.ws + OFF_KTAB);
  bf16* T5 = (bf16*)(p.ws + OFF_T5);
  bf16* E5 = (bf16*)(p.ws + OFF_E5);
  bf16* F5 = (bf16*)(p.ws + OFF_F5);
  const int nT = 16 * 512 * 64, nE = 16 * 512 * 32, nF = 16 * 256 * 64;
  for (int it = bid * 256 + TIDX; it < nT + nE + nF; it += G * 256) {
    float v[8];
    bf16* dst;
    if (it < nT) {
      const int k8 = it & 63, n = (it >> 6) & 511, g = it >> 15;
      const int i = n >> 4, hh = n & 15, j = k8 >> 1, hp0 = (k8 & 1) * 8;
#pragma unroll
      for (int e = 0; e < 8; ++e) {
        const int hp = hp0 + e;
        float a = 0.f;
        if (j <= i) a += KT[((((size_t)l * 16 + g) * 2 + 0) * 32 + (i - j)) * 256 + hh * 16 + hp];
        if (j >= i) a += KT[((((size_t)l * 16 + g) * 2 + 1) * 32 + (j - i)) * 256 + hh * 16 + hp];
        if (i == j && hh == hp) a += p.in[I_S5D][l * 256 + g * 16 + hh];
        v[e] = a;
      }
      dst = T5 + ((size_t)g * 512 + n) * 512 + k8 * 8;
    } else if (it < nT + nE) {
      const int q = it - nT;
      const int k8 = q & 31, n = (q >> 5) & 511, g = q >> 14;
      const int i = n >> 4, hh = n & 15;
      const int k0 = k8 * 8, d = k0 >> 7, ri = (k0 >> 6) & 1, p0 = k0 & 63;
      const int ldg = (l * 2 + d) * 16 + g;
      const int ex = d ? (32 - i) : (i + 1);
#pragma unroll
      for (int e = 0; e < 8; ++e) {
        const int pp = p0 + e;
        const float2 pw = PW[((size_t)ldg * 33 + ex) * 64 + pp];
        const float cr = p.in[I_CRE][((size_t)ldg * 16 + hh) * 64 + pp], ci = p.in[I_CIM][((size_t)ldg * 16 + hh) * 64 + pp];
        const float zr = cr * pw.x - ci * pw.y, zi = cr * pw.y + ci * pw.x;
        v[e] = ri ? -zi : zr;
      }
      dst = E5 + ((size_t)g * 512 + n) * 256 + k0;
    } else {
      const int q = it - nT - nE;
      const int k8 = q & 63, n = (q >> 6) & 255, g = q >> 14;
      const int d = n >> 7, ri = (n >> 6) & 1, pp = n & 63;
      const int j = k8 >> 1, hp0 = (k8 & 1) * 8;
      const int ldg = (l * 2 + d) * 16 + g;
      const int ex = d ? j : (31 - j);
      const float2 pw = PW[((size_t)ldg * 33 + ex) * 64 + pp];
#pragma unroll
      for (int e = 0; e < 8; ++e) {
        const float br = BBR[((size_t)ldg * 64 + pp) * 16 + hp0 + e], bi = BBI[((size_t)ldg * 64 + pp) * 16 + hp0 + e];
        v[e] = ri ? (pw.x * bi + pw.y * br) : (pw.x * br - pw.y * bi);
      }
      dst = F5 + ((size_t)g * 256 + n) * 512 + k8 * 8;
    }
    u32x4 u;
    u[0] = pack2(v[0], v[1]); u[1] = pack2(v[2], v[3]); u[2] = pack2(v[4], v[5]); u[3] = pack2(v[6], v[7]);
    *(u32x4*)dst = u;
  }
}

DI void proj_tile(const Params& p, int l, int mt, int nt, char* smem) {
  const bf16* H = (const bf16*)(p.ws + OFF_H) + (size_t)mt * 128 * DM;
  const bf16* W = wl(p, l, WL_WIN) + (size_t)nt * 128 * DM;
  f32x16 acc[2][2];
  acc_zero(acc);
  gemm_main_dma(acc, [&](int r) { return H + (size_t)r * DM; }, [&](int r) { return W + (size_t)r * DM; }, DM, smem);
  float* Cs = (float*)smem;
  acc_to_lds(acc, Cs);
  __syncthreads();
  const int tid = TIDX;
  const int tok0 = mt * 128;
  const int b = tok0 / TT, t0 = tok0 - b * TT;
  if (nt <= 2) {
    const int row = tid >> 1, seg = tid & 1;
    float* c = Cs + row * CLD + seg * 64;
    const float* gn = p.in[nt < 2 ? I_QN : I_KN] + l * 64;
    float ss = 0.f;
#pragma unroll 8
    for (int i = 0; i < 64; ++i) ss += c[i] * c[i];
    const float rstd = rsqrtf(ss * (1.f / 64.f) + EPSF);
    const int t = t0 + row;
    const bool lat = t >= CTXL;
    const int s = t - CTXL;
#pragma unroll 1
    for (int ax = 0; ax < 2; ++ax) {
      const float pos = (float)(ax ? (s & 63) : (s >> 6));
#pragma unroll 2
      for (int f = 0; f < 16; ++f) {
        float x1 = c[ax * 32 + f] * rstd * gn[ax * 32 + f];
        float x2 = c[ax * 32 + 16 + f] * rstd * gn[ax * 32 + 16 + f];
        if (lat) {
          const float invf = exp2f(-(float)f * (13.287712379549449f / 16.f));
          float sn, cs;
          sincos_cw(pos * invf, sn, cs);
          const float y1 = x1 * cs - x2 * sn, y2 = x2 * cs + x1 * sn;
          x1 = y1; x2 = y2;
        }
        c[ax * 32 + f] = x1;
        c[ax * 32 + 16 + f] = x2;
      }
    }
    __syncthreads();
    if (nt < 2) store_tile_bf16(Cs, (bf16*)(p.ws + OFF_Q) + (size_t)tok0 * 256 + nt * 128, 256, 128, 0.125f * 1.4426950408889634f);
    else store_tile_bf16(Cs, (bf16*)(p.ws + OFF_K) + (size_t)tok0 * 128, 128, 128, 1.f);
  } else if (nt == 3 || (nt >= 8 && nt <= 11)) {
    for (int c = tid; c < 2048; c += 256) {
      const int col = c & 127, rc = (c >> 7) * 8;
      u32x4 u;
#pragma unroll
      for (int e = 0; e < 4; ++e) u[e] = pack2(Cs[(rc + 2 * e) * CLD + col], Cs[(rc + 2 * e + 1) * CLD + col]);
      bf16* dst;
      if (nt == 3) dst = (bf16*)(p.ws + OFF_VT) + ((size_t)(b * 2 + (col >> 6)) * 64 + (col & 63)) * TT + t0 + rc;
      else dst = (bf16*)(p.ws + OFF_GVT) + ((size_t)(b * 4 + (nt - 8)) * 128 + col) * TT + t0 + rc;
      *(u32x4*)dst = u;
    }
  } else if (nt == 4 || nt == 5) {
    store_tile_bf16(Cs, (bf16*)(p.ws + OFF_GQ) + (size_t)tok0 * 256 + (nt - 4) * 128, 256, 128, 0.125f);
  } else if (nt == 6 || nt == 7) {
    store_tile_bf16(Cs, (bf16*)(p.ws + OFF_GK) + (size_t)tok0 * 256 + (nt - 6) * 128, 256, 128, 1.f);
  } else if (nt >= 12 && nt <= 15) {
    store_tile_bf16(Cs, (bf16*)(p.ws + OFF_GR) + (size_t)tok0 * 512 + (nt - 12) * 128, 512, 128, 1.f);
  } else if (nt == 16 || nt == 17) {
    for (int c = tid; c < 2048; c += 256) {
      const int row = c >> 4, c8 = c & 15;
      const float* s = Cs + row * CLD + c8 * 8;
      u32x4 u;
#pragma unroll
      for (int e = 0; e < 4; ++e) u[e] = pack2(s[2 * e], s[2 * e + 1]);
      const int ch = (nt - 16) * 128 + c8 * 8;
      bf16* dst = (bf16*)(p.ws + OFF_SU) + ((size_t)(b * 16 + (ch >> 4)) * TT + t0 + row) * 16 + (ch & 15);
      *(u32x4*)dst = u;
    }
  } else {
    for (int c = tid; c < 128 * 8; c += 256) {
      const int row = c >> 3, c4 = (c & 7) * 4;
      const float* s = Cs + row * CLD + c4;
      f32x4 v = {s[0], s[1], s[2], s[3]};
      *(f32x4*)((float*)(p.ws + OFF_LOW) + (size_t)(tok0 + row) * 32 + c4) = v;
    }
  }
  __syncthreads();
}

DI void attn_unit(const Params& p, int u, char* smem) {
  char* Ks = smem;
  char* Vs = smem + 16384;
  int b, head, tok0, nkt;
  if (u < 1024) { b = u >> 8; head = (u >> 6) & 3; tok0 = b * TT + CTXL + (u & 63) * 128; nkt = TT / 64; }
  else { const int v = u - 1024; b = v >> 3; head = (v >> 1) & 3; tok0 = b * TT + (v & 1) * 128; nkt = CTXL / 64; }
  const int kvh = head >> 1;
  const int tid = TIDX, lane = tid & 63, w = tid >> 6, r = lane & 31, h = lane >> 5;
  const bf16* Qp = (const bf16*)(p.ws + OFF_Q) + (size_t)(tok0 + w * 32 + r) * 256 + head * 64 + h * 8;
  s16x8 qf[4];
#pragma unroll
  for (int s = 0; s < 4; ++s) qf[s] = __builtin_bit_cast(s16x8, ldg16(Qp + s * 16));
  const bf16* kp[2];
  const bf16* vp[2];
#pragma unroll
  for (int i = 0; i < 2; ++i) {
    const int row = w * 16 + i * 8 + (lane >> 3);
    const int c = (lane & 7) ^ ((row >> 1) & 7);
    kp[i] = (const bf16*)(p.ws + OFF_K) + ((size_t)b * TT + row) * 128 + kvh * 64 + c * 8;
    vp[i] = (const bf16*)(p.ws + OFF_VT) + ((size_t)(b * 2 + kvh) * 64 + row) * TT + c * 8;
  }
  const int ldst = (w * 128 + lane) * 16;
#define AT_DMA(BUF, T)                                                                                              \
  {                                                                                                                 \
    _Pragma("unroll") for (int i = 0; i < 2; ++i) {                                                                 \
      __builtin_amdgcn_global_load_lds((const unsigned*)(kp[i] + (size_t)(T) * 64 * 128), (unsigned*)(Ks + (BUF) * 8192 + ldst + i * 1024), 16, 0, 0); \
      __builtin_amdgcn_global_load_lds((const unsigned*)(vp[i] + (T) * 64), (unsigned*)(Vs + (BUF) * 8192 + ldst + i * 1024), 16, 0, 0);               \
    }                                                                                                               \
  }
  const int xr = (r >> 1) & 7;
  AT_DMA(0, 0)
  asm volatile("s_waitcnt vmcnt(0)" ::: "memory");
  __syncthreads();
  f32x16 oacc[2];
#pragma unroll
  for (int i = 0; i < 16; ++i) { oacc[0][i] = 0.f; oacc[1][i] = 0.f; }
  float mrow = -INFINITY, lrow = 0.f;
  for (int kt = 0; kt < nkt; ++kt) {
    const int buf = kt & 1;
    if (kt + 1 < nkt) AT_DMA(buf ^ 1, kt + 1)
    const char* Kb = Ks + buf * 8192;
    const char* Vb = Vs + buf * 8192;
    f32x16 sacc[2];
#pragma unroll
    for (int i = 0; i < 16; ++i) { sacc[0][i] = 0.f; sacc[1][i] = 0.f; }
#pragma unroll
    for (int s = 0; s < 4; ++s) {
      const int co = ((2 * s + h) ^ xr) * 16;
      const s16x8 a0 = *(const s16x8*)(Kb + r * 128 + co);
      const s16x8 a1 = *(const s16x8*)(Kb + (32 + r) * 128 + co);
      sacc[0] = MFMA32(a0, qf[s], sacc[0]);
      sacc[1] = MFMA32(a1, qf[s], sacc[1]);
    }
    float mx = sacc[0][0];
#pragma unroll
    for (int i = 0; i < 16; ++i) { mx = fmaxf(mx, sacc[0][i]); mx = fmaxf(mx, sacc[1][i]); }
    mx = fmaxf(mx, __shfl_xor(mx, 32, 64));
    const float mnew = fmaxf(mrow, mx);
    const float alpha = __builtin_amdgcn_exp2f(mrow - mnew);
    mrow = mnew;
    float psum = 0.f;
#pragma unroll
    for (int i = 0; i < 16; ++i) {
      sacc[0][i] = __builtin_amdgcn_exp2f(sacc[0][i] - mnew); psum += sacc[0][i];
      sacc[1][i] = __builtin_amdgcn_exp2f(sacc[1][i] - mnew); psum += sacc[1][i];
    }
    lrow = lrow * alpha + psum;
#pragma unroll
    for (int i = 0; i < 16; ++i) { oacc[0][i] *= alpha; oacc[1][i] *= alpha; }
#pragma unroll
    for (int kt2 = 0; kt2 < 2; ++kt2)
#pragma unroll
      for (int s2 = 0; s2 < 2; ++s2) {
        u32x4 pu;
#pragma unroll
        for (int e = 0; e < 4; ++e) pu[e] = pack2(sacc[kt2][8 * s2 + 2 * e], sacc[kt2][8 * s2 + 2 * e + 1]);
        const s16x8 pf = __builtin_bit_cast(s16x8, pu);
        const int c0 = kt2 * 4 + 2 * s2;
        const int o0 = ((c0 ^ xr) * 16) + 8 * h, o1 = (((c0 + 1) ^ xr) * 16) + 8 * h;
#pragma unroll
        for (int dt = 0; dt < 2; ++dt) {
          const s16x4 lo = *(const s16x4*)(Vb + (dt * 32 + r) * 128 + o0);
          const s16x4 hi = *(const s16x4*)(Vb + (dt * 32 + r) * 128 + o1);
          const s16x8 a = __builtin_shufflevector(lo, hi, 0, 1, 2, 3, 4, 5, 6, 7);
          oacc[dt] = MFMA32(a, pf, oacc[dt]);
        }
      }
    asm volatile("s_waitcnt vmcnt(0)" ::: "memory");
    __syncthreads();
  }
#undef AT_DMA
  const float ltot = lrow + __shfl_xor(lrow, 32, 64);
  const float inv = 1.f / ltot;
  bf16* Op = (bf16*)(p.ws + OFF_OATT) + (size_t)(tok0 + w * 32 + r) * 256 + head * 64;
#pragma unroll
  for (int dt = 0; dt < 2; ++dt)
#pragma unroll
    for (int i = 0; i < 16; i += 4) {
      u32x2 uu;
      uu[0] = pack2(oacc[dt][i] * inv, oacc[dt][i + 1] * inv);
      uu[1] = pack2(oacc[dt][i + 2] * inv, oacc[dt][i + 3] * inv);
      *(u32x2*)(Op + dt * 32 + crow(i, h)) = uu;
    }
}

constexpr int GL_LOW = 0, GL_TOT = 4096, GL_DEC = 5120, GL_QIN = 5376, GL_KIN = 14592, GL_KET = 23808, GL_OST = 0,
              GL_VT = 33792, GL_ST = 52224;
static_assert(GL_ST + 128 * LDT * 2 <= SMEM_BYTES, "gla lds");

template <bool WITH_OUT>
DI void gla_unit(const Params& p, int l, int u, char* smem) {
  float* lowt = (float*)(smem + GL_LOW);
  float* tots = (float*)(smem + GL_TOT);
  float* decs = (float*)(smem + GL_DEC);
  bf16* qin = (bf16*)(smem + GL_QIN);
  bf16* kin = (bf16*)(smem + GL_KIN);
  bf16* ket = (bf16*)(smem + GL_KET);
  float* ost = (float*)(smem + GL_OST);
  bf16* vts = (bf16*)(smem + GL_VT);
  bf16* sts = (bf16*)(smem + GL_ST);
  const int tid = TIDX, lane = tid & 63, w = tid >> 6, r = lane & 31, h = lane >> 5;
  int b, hd, gi, dir0, ndir;
  if (WITH_OUT) { gi = u % NG33; hd = (u / NG33) & 3; b = u / (NG33 * 4); dir0 = 1; ndir = 2; }
  else { gi = u % NG33; const int v = u / NG33; dir0 = v & 1; hd = (v >> 1) & 3; b = v >> 3; ndir = 1; }
  const int dk = tid & 63, part = tid >> 6;
  const bf16* GQ = (const bf16*)(p.ws + OFF_GQ);
  const bf16* GK = (const bf16*)(p.ws + OFF_GK);
  const bf16* GVT = (const bf16*)(p.ws + OFF_GVT) + (size_t)(b * 4 + hd) * 128 * TT;
  const float* LOW = (const float*)(p.ws + OFF_LOW);
  for (int dd = 0; dd < ndir; ++dd) {
    const int dir = WITH_OUT ? (dir0 - dd) : dir0;
    float* GSu = (float*)(p.ws + OFF_GS) + ((size_t)((b * 4 + hd) * 2 + dir) * NG33 + gi) * 8192;
    float gwreg[16];
#pragma unroll
    for (int rr = 0; rr < 16; ++rr) gwreg[rr] = p.in[I_GGW][((size_t)(l * 2 + dir) * 16 + rr) * 256 + hd * 64 + dk];
    const float gb = p.in[I_GGB][(l * 2 + dir) * 256 + hd * 64 + dk];
    f32x16 sacc[2];
    if (WITH_OUT) {
#pragma unroll
      for (int dkt = 0; dkt < 2; ++dkt)
#pragma unroll
        for (int i = 0; i < 16; ++i) {
          const float v = GSu[(w * 32 + crow(i, h)) * 64 + dkt * 32 + r];
          sacc[dkt][i] = v;
          sts[(w * 32 + crow(i, h)) * LDT + dkt * 32 + r] = f2bf(v);
        }
    } else {
#pragma unroll
      for (int i = 0; i < 16; ++i) { sacc[0][i] = 0.f; sacc[1][i] = 0.f; }
    }
    float gtot = 0.f;
    for (int cc = 0; cc < 4; ++cc) {
      const int ci = dir ? 3 - cc : cc;
      const int tb = gi * 256 + ci * 64;
      const size_t tokb = (size_t)b * TT + tb;
      {
        const int row = tid >> 2, c4 = (tid & 3) * 4;
        const u32x4 lw = ldg16(LOW + (tokb + row) * 32 + dir * 16 + c4);
        u32x4 vv[4], kq[2], qq[2];
#pragma unroll
        for (int i = 0; i < 4; ++i) {
          const int c = tid + 256 * i, e = c >> 3, k8 = (c & 7) * 8;
          vv[i] = ldg16(GVT + (size_t)e * TT + tb + k8);
        }
#pragma unroll
        for (int i = 0; i < 2; ++i) {
          const int c = tid + 256 * i, rw = c >> 3, k8 = (c & 7) * 8;
          kq[i] = ldg16(GK + (tokb + rw) * 256 + hd * 64 + k8);
          if (WITH_OUT) qq[i] = ldg16(GQ + (tokb + rw) * 256 + hd * 64 + k8);
        }
        *(u32x4*)(lowt + row * 16 + c4) = lw;
#pragma unroll
        for (int i = 0; i < 4; ++i) {
          const int c = tid + 256 * i, e = c >> 3, k8 = (c & 7) * 8;
          *(u32x4*)(vts + e * LDT + k8) = vv[i];
        }
#pragma unroll
        for (int i = 0; i < 2; ++i) {
          const int c = tid + 256 * i, rw = c >> 3, k8 = (c & 7) * 8;
          *(u32x4*)(kin + rw * LDT + k8) = kq[i];
          if (WITH_OUT) *(u32x4*)(qin + rw * LDT + k8) = qq[i];
        }
      }
      __syncthreads();
      float cum = 0.f;
#pragma unroll 2
      for (int ii = 0; ii < 16; ++ii) {
        const int pos = part * 16 + ii, t = dir ? 63 - pos : pos;
        float z = gb;
#pragma unroll
        for (int rr = 0; rr < 16; ++rr) z += lowt[t * 16 + rr] * gwreg[rr];
        cum += (fminf(z, 0.f) - log1pf(__expf(-fabsf(z)))) * (1.f / 16.f);
      }
      tots[part * 64 + dk] = cum;
      __syncthreads();
      float offs = 0.f, total = 0.f;
#pragma unroll
      for (int pp = 0; pp < 4; ++pp) { const float tv = tots[pp * 64 + dk]; total += tv; if (pp < part) offs += tv; }
      if (part == 0) decs[dk] = __expf(total);
      gtot += total;
      float bq = offs;
#pragma unroll 2
      for (int ii = 0; ii < 16; ++ii) {
        const int pos = part * 16 + ii, t = dir ? 63 - pos : pos;
        float z = gb;
#pragma unroll
        for (int rr = 0; rr < 16; ++rr) z += lowt[t * 16 + rr] * gwreg[rr];
        bq += (fminf(z, 0.f) - log1pf(__expf(-fabsf(z)))) * (1.f / 16.f);
        const float kv = bf2f(kin[t * LDT + dk]);
        ket[dk * LDT + t] = f2bf(kv * __expf(total - bq));
        if (WITH_OUT) {
          const float qv = bf2f(qin[t * LDT + dk]);
          qin[t * LDT + dk] = f2bf(qv * __expf(bq));
          kin[t * LDT + dk] = f2bf(kv * __expf(-bq));
        }
      }
      __syncthreads();
      f32x16 oo[2];
      const int it = w & 1, ep = w >> 1;
      if (WITH_OUT) {
        const int ti = w >> 1, tj = w & 1;
        f32x16 aa;
#pragma unroll
        for (int i = 0; i < 16; ++i) aa[i] = 0.f;
#pragma unroll
        for (int s = 0; s < 4; ++s) {
          const s16x8 A = *(const s16x8*)(qin + (ti * 32 + r) * LDT + s * 16 + h * 8);
          const s16x8 Bv = *(const s16x8*)(kin + (tj * 32 + r) * LDT + s * 16 + h * 8);
          aa = MFMA32(A, Bv, aa);
        }
        __syncthreads();
#pragma unroll
        for (int i = 0; i < 16; ++i) {
          const int qi = ti * 32 + crow(i, h), kj = tj * 32 + r;
          const bool keep = dir ? (kj >= qi) : (kj <= qi);
          kin[qi * LDT + kj] = f2bf(keep ? aa[i] : 0.f);
        }
        __syncthreads();
#pragma unroll
        for (int i = 0; i < 16; ++i) { oo[0][i] = 0.f; oo[1][i] = 0.f; }
#pragma unroll
        for (int s = 0; s < 4; ++s) {
          const s16x8 A1 = *(const s16x8*)(kin + (it * 32 + r) * LDT + s * 16 + h * 8);
          const s16x8 A2 = *(const s16x8*)(qin + (it * 32 + r) * LDT + s * 16 + h * 8);
#pragma unroll
          for (int x = 0; x < 2; ++x) {
            const int et = 2 * ep + x;
            const s16x8 B1 = *(const s16x8*)(vts + (et * 32 + r) * LDT + s * 16 + h * 8);
            const s16x8 B2 = *(const s16x8*)(sts + (et * 32 + r) * LDT + s * 16 + h * 8);
            oo[x] = MFMA32(A1, B1, oo[x]);
            oo[x] = MFMA32(A2, B2, oo[x]);
          }
        }
      }
#pragma unroll
      for (int dkt = 0; dkt < 2; ++dkt) {
        const float dv = decs[dkt * 32 + r];
#pragma unroll
        for (int i = 0; i < 16; ++i) sacc[dkt][i] *= dv;
      }
#pragma unroll
      for (int s = 0; s < 4; ++s) {
        const s16x8 A = *(const s16x8*)(vts + (w * 32 + r) * LDT + s * 16 + h * 8);
#pragma unroll
        for (int dkt = 0; dkt < 2; ++dkt) {
          const s16x8 Bv = *(const s16x8*)(ket + (dkt * 32 + r) * LDT + s * 16 + h * 8);
          sacc[dkt] = MFMA32(A, Bv, sacc[dkt]);
        }
      }
      __syncthreads();
      if (WITH_OUT) {
#pragma unroll
        for (int dkt = 0; dkt < 2; ++dkt)
#pragma unroll
          for (int i = 0; i < 16; ++i) sts[(w * 32 + crow(i, h)) * LDT + dkt * 32 + r] = f2bf(sacc[dkt][i]);
#pragma unroll
        for (int x = 0; x < 2; ++x)
#pragma unroll
          for (int i = 0; i < 16; ++i) ost[(it * 32 + crow(i, h)) * CLD + (2 * ep + x) * 32 + r] = oo[x][i];
        __syncthreads();
        const int row = tid >> 2, qd = tid & 3;
        const size_t tok = tokb + row;
        bf16* og = (bf16*)(p.ws + OFF_OGLA) + tok * 512 + hd * 128 + qd * 32;
        const float* os = ost + row * CLD + qd * 32;
        if (dir == 1) {
#pragma unroll
          for (int i = 0; i < 4; ++i) {
            u32x4 uu;
#pragma unroll
            for (int e = 0; e < 4; ++e) uu[e] = pack2(os[i * 8 + 2 * e], os[i * 8 + 2 * e + 1]);
            *(u32x4*)(og + i * 8) = uu;
          }
        } else {
          float ss = 0.f;
#pragma unroll 1
          for (int i = 0; i < 4; ++i) {
            const u32x4 uu = *(const u32x4*)(og + i * 8);
#pragma unroll
            for (int e = 0; e < 4; ++e) {
              const float a0 = os[i * 8 + 2 * e] + bflo(uu[e]), a1 = os[i * 8 + 2 * e + 1] + bfhi(uu[e]);
              ss += a0 * a0 + a1 * a1;
            }
          }
          ss += __shfl_xor(ss, 1, 64);
          ss += __shfl_xor(ss, 2, 64);
          const float rstd = rsqrtf(ss * (1.f / 128.f) + EPSF);
          const float* gn = p.in[I_GON] + l * 128 + qd * 32;
          const bf16* gr = (const bf16*)(p.ws + OFF_GR) + tok * 512 + hd * 128 + qd * 32;
#pragma unroll 1
          for (int i = 0; i < 4; ++i) {
            const u32x4 uo = *(const u32x4*)(og + i * 8);
            const u32x4 ug = *(const u32x4*)(gr + i * 8);
            u32x4 uu;
#pragma unroll
            for (int e = 0; e < 4; ++e) {
              const float v0 = os[i * 8 + 2 * e] + bflo(uo[e]), v1 = os[i * 8 + 2 * e + 1] + bfhi(uo[e]);
              const float a0 = v0 * rstd * gn[i * 8 + 2 * e] * siluf_(bflo(ug[e]));
              const float a1 = v1 * rstd * gn[i * 8 + 2 * e + 1] * siluf_(bfhi(ug[e]));
              uu[e] = pack2(a0, a1);
            }
            *(u32x4*)(og + i * 8) = uu;
          }
        }
        __syncthreads();
      }
    }
    if (!WITH_OUT) {
#pragma unroll
      for (int dkt = 0; dkt < 2; ++dkt)
#pragma unroll
        for (int i = 0; i < 16; ++i) GSu[(w * 32 + crow(i, h)) * 64 + dkt * 32 + r] = sacc[dkt][i];
      if (part == 0) ((float*)(p.ws + OFF_DECG))[((size_t)((b * 4 + hd) * 2 + dir) * NG33 + gi) * 64 + dk] = __expf(gtot);
    }
    __syncthreads();
  }
}

DI void gla_scan_job(const Params& p, int j) {
  const int idx = j * 256 + TIDX;
  const int seq = idx >> 13, el = idx & 8191, dk = el & 63, dir = seq & 1;
  float* GS = (float*)(p.ws + OFF_GS) + (size_t)seq * NG33 * 8192 + el;
  const float* DG = (const float*)(p.ws + OFF_DECG) + (size_t)seq * NG33 * 64 + dk;
  float s = 0.f;
  for (int st0 = 0; st0 < 33; st0 += 11) {
    float kv[11], dc[11];
#pragma unroll
    for (int q = 0; q < 11; ++q) {
      const int st = st0 + q;
      const int g = (dir == 0 || st == 0) ? st : 33 - st;
      kv[q] = GS[(size_t)g * 8192];
      dc[q] = DG[g * 64];
    }
#pragma unroll
    for (int q = 0; q < 11; ++q) {
      const int st = st0 + q;
      const int g = (dir == 0 || st == 0) ? st : 33 - st;
      GS[(size_t)g * 8192] = s;
      s = dc[q] * s + kv[q];
    }
  }
}

DI void s5_end_tile(const Params& p, int j, char* smem) {
  const int nt = j & 1, mt = (j >> 1) % 9, g = j / 18;
  const bf16* SU = (const bf16*)(p.ws + OFF_SU);
  const bf16* F = (const bf16*)(p.ws + OFF_F5) + ((size_t)g * 256 + nt * 128) * 512;
  f32x16 acc[2][2];
  acc_zero(acc);
  gemm_main_dma(acc,
            [&](int r) -> const bf16* {
              const int m = mt * 128 + r;
              if (m >= MS5) return (const bf16*)(p.ws + OFF_ZERO);
              const int b = m / NCH, ch = m - b * NCH;
              return SU + ((size_t)(b * 16 + g) * TT + ch * 32) * 16;
            },
            [&](int r) { return F + (size_t)r * 512; }, 512, smem);
  float* Cs = (float*)smem;
  acc_to_lds(acc, Cs);
  __syncthreads();
  float* EN = (float*)(p.ws + OFF_EN);
  for (int c = TIDX; c < 128 * 32; c += 256) {
    const int row = c >> 5, c4 = (c & 31) * 4, m = mt * 128 + row;
    if (m < MS5) {
      const float* s = Cs + row * CLD + c4;
      f32x4 v = {s[0], s[1], s[2], s[3]};
      *(f32x4*)(EN + ((size_t)m * 16 + g) * 256 + nt * 128 + c4) = v;
    }
  }
  __syncthreads();
}

DI void s5_scan_job(const Params& p, int l, int j, char* smem) {
  float2* ends = (float2*)smem;
  const int dir = j & 1, g = (j >> 1) & 15, b = j >> 5;
  const int pp = TIDX & 63, seg = TIDX >> 6;
  const float2 aL = ((const float2*)(p.ws + OFF_PWR))[((size_t)((l * 2 + dir) * 16 + g) * 33 + 32) * 64 + pp];
  const float* EN = (const float*)(p.ws + OFF_EN);
  bf16* SB = (bf16*)(p.ws + OFF_SB);
  float sr = 0.f, si = 0.f;
  for (int q0 = 0; q0 < 66; q0 += 11) {
    float er[11], ei[11];
#pragma unroll
    for (int q = 0; q < 11; ++q) {
      const int pos = seg * 66 + q0 + q;
      const int ch = dir ? (pos < 8 ? 7 - pos : 271 - pos) : pos;
      const float* e = EN + ((size_t)(b * NCH + ch) * 16 + g) * 256 + dir * 128 + pp;
      er[q] = e[0]; ei[q] = e[64];
    }
#pragma unroll
    for (int q = 0; q < 11; ++q) {
      const float nr = aL.x * sr - aL.y * si + er[q], ni = aL.x * si + aL.y * sr + ei[q];
      sr = nr; si = ni;
    }
  }
  ends[seg * 64 + pp] = make_float2(sr, si);
  float pr = 1.f, pi = 0.f;
  for (int q = 0; q < 66; ++q) { const float nr = pr * aL.x - pi * aL.y, ni = pr * aL.y + pi * aL.x; pr = nr; pi = ni; }
  __syncthreads();
  sr = 0.f; si = 0.f;
  for (int k = 0; k < seg; ++k) {
    const float2 e = ends[k * 64 + pp];
    const float nr = pr * sr - pi * si + e.x, ni = pr * si + pi * sr + e.y;
    sr = nr; si = ni;
  }
  for (int q0 = 0; q0 < 66; q0 += 11) {
    float er[11], ei[11];
#pragma unroll
    for (int q = 0; q < 11; ++q) {
      const int pos = seg * 66 + q0 + q;
      const int ch = dir ? (pos < 8 ? 7 - pos : 271 - pos) : pos;
      const float* e = EN + ((size_t)(b * NCH + ch) * 16 + g) * 256 + dir * 128 + pp;
      er[q] = e[0]; ei[q] = e[64];
    }
#pragma unroll
    for (int q = 0; q < 11; ++q) {
      const int pos = seg * 66 + q0 + q;
      const int ch = dir ? (pos < 8 ? 7 - pos : 271 - pos) : pos;
      bf16* sb = SB + ((size_t)(b * NCH + ch) * 16 + g) * 256 + dir * 128 + pp;
      sb[0] = f2bf(sr); sb[64] = f2bf(si);
      const float nr = aL.x * sr - aL.y * si + er[q], ni = aL.x * si + aL.y * sr + ei[q];
      sr = nr; si = ni;
    }
  }
  __syncthreads();
}

DI float gelu_tanh(float x) {
  const float u = 0.7978845608028654f * (x + 0.044715f * x * x * x);
  return 0.5f * x * (1.f + tanhf(u));
}

DI void s5_out_tile(const Params& p, int j, char* smem) {
  const int nt = j & 3, mt = (j >> 2) % 9, g = j / 36;
  const bf16* SU = (const bf16*)(p.ws + OFF_SU);
  const bf16* SB = (const bf16*)(p.ws + OFF_SB);
  const bf16* Tm = (const bf16*)(p.ws + OFF_T5) + ((size_t)g * 512 + nt * 128) * 512;
  const bf16* Em = (const bf16*)(p.ws + OFF_E5) + ((size_t)g * 512 + nt * 128) * 256;
  f32x16 acc[2][2];
  acc_zero(acc);
  gemm_main_dma(acc,
            [&](int r) -> const bf16* {
              const int m = mt * 128 + r;
              if (m >= MS5) return (const bf16*)(p.ws + OFF_ZERO);
              const int b = m / NCH, ch = m - b * NCH;
              return SU + ((size_t)(b * 16 + g) * TT + ch * 32) * 16;
            },
            [&](int r) { return Tm + (size_t)r * 512; }, 512, smem);
  gemm_main_dma(acc,
            [&](int r) -> const bf16* {
              const int m = mt * 128 + r;
              if (m >= MS5) return (const bf16*)(p.ws + OFF_ZERO);
              return SB + ((size_t)m * 16 + g) * 256;
            },
            [&](int r) { return Em + (size_t)r * 256; }, 256, smem);
  float* Cs = (float*)smem;
  acc_to_lds(acc, Cs);
  __syncthreads();
  bf16* Y5 = (bf16*)(p.ws + OFF_Y5);
  for (int c = TIDX; c < 2048; c += 256) {
    const int row = c >> 4, c8 = c & 15, m = mt * 128 + row;
    if (m < MS5) {
      const int b = m / NCH, ch = m - b * NCH;
      const int n = nt * 128 + c8 * 8, i = n >> 4, hh = n & 15;
      const float* s = Cs + row * CLD + c8 * 8;
      u32x4 u;
#pragma unroll
      for (int e = 0; e < 4; ++e) u[e] = pack2(gelu_tanh(s[2 * e]), gelu_tanh(s[2 * e + 1]));
      *(u32x4*)(Y5 + ((size_t)b * TT + ch * 32 + i) * 256 + g * 16 + hh) = u;
    }
  }
  __syncthreads();
}

DI void glu_tile(const Params& p, int l, int j, char* smem) {
  const int nt = j & 1, mt = j >> 1;
  const bf16* Y5 = (const bf16*)(p.ws + OFF_Y5) + (size_t)mt * 128 * 256;
  const bf16* W = wl(p, l, WL_GLU) + (size_t)nt * 128 * 256;
  f32x16 acc[2][2];
  acc_zero(acc);
  gemm_main_dma(acc, [&](int r) { return Y5 + (size_t)r * 256; }, [&](int r) { return W + (size_t)r * 256; }, 256, smem);
  float* Cs = (float*)smem;
  acc_to_lds(acc, Cs);
  __syncthreads();
  const float* gb = p.in[I_GLUB] + l * 256 + nt * 128;
  bf16* O = (bf16*)(p.ws + OFF_OS5) + (size_t)mt * 128 * 256 + nt * 128;
  for (int c = TIDX; c < 2048; c += 256) {
    const int row = c >> 4, cc = (c & 15) * 8;
    const float* s = Cs + row * CLD + cc;
    const u32x4 yu = *(const u32x4*)(Y5 + (size_t)row * 256 + nt * 128 + cc);
    u32x4 u;
#pragma unroll
    for (int e = 0; e < 4; ++e) {
      const float y0 = bflo(yu[e]), y1 = bfhi(yu[e]);
      u[e] = pack2(y0 * sigmoidf_(s[2 * e] + gb[cc + 2 * e]), y1 * sigmoidf_(s[2 * e + 1] + gb[cc + 2 * e + 1]));
    }
    *(u32x4*)(O + (size_t)row * 256 + cc) = u;
  }
  __syncthreads();
}

DI void merge_tile(const Params& p, int l, int j, char* smem) {
  const int nt = j & 7, mt = j >> 3;
  const bf16* H = (const bf16*)(p.ws + OFF_H) + (size_t)mt * 128 * DM;
  unsigned am[2][2][8];
#pragma unroll
  for (int a = 0; a < 2; ++a)
#pragma unroll
    for (int bq = 0; bq < 2; ++bq)
#pragma unroll
      for (int i = 0; i < 8; ++i) am[a][bq][i] = 0u;
#pragma unroll 1
  for (int x = 0; x < 3; ++x) {
    const bf16* Wg = wl(p, l, WL_WIN) + ((size_t)2432 + x * 1024 + nt * 128) * DM;
    unsigned sg[2][2][8];
    {
      f32x16 acc[2][2];
      acc_zero(acc);
      gemm_main_dma(acc, [&](int r) { return H + (size_t)r * DM; }, [&](int r) { return Wg + (size_t)r * DM; }, DM, smem);
#pragma unroll
      for (int a = 0; a < 2; ++a)
#pragma unroll
        for (int bq = 0; bq < 2; ++bq)
#pragma unroll
          for (int i = 0; i < 8; ++i) sg[a][bq][i] = pack2(sigmoidf_(acc[a][bq][2 * i]), sigmoidf_(acc[a][bq][2 * i + 1]));
    }
    const bf16* A; const bf16* Wb; int K;
    if (x == 0) { A = (const bf16*)(p.ws + OFF_OATT) + (size_t)mt * 128 * 256; Wb = wl(p, l, WL_BRA) + (size_t)nt * 128 * 256; K = 256; }
    else if (x == 1) { A = (const bf16*)(p.ws + OFF_OGLA) + (size_t)mt * 128 * 512; Wb = wl(p, l, WL_BRG) + (size_t)nt * 128 * 512; K = 512; }
    else { A = (const bf16*)(p.ws + OFF_OS5) + (size_t)mt * 128 * 256; Wb = wl(p, l, WL_BRS) + (size_t)nt * 128 * 256; K = 256; }
#pragma unroll
    for (int hf = 0; hf < 2; ++hf) {
      f32x16 a2[2];
#pragma unroll
      for (int i = 0; i < 16; ++i) { a2[0][i] = 0.f; a2[1][i] = 0.f; }
      gemm_main_dma_half(a2, A, K, Wb, K, K, hf, smem);
#pragma unroll
      for (int a = 0; a < 2; ++a)
#pragma unroll
        for (int i = 0; i < 8; ++i) {
          const float v0 = bflo(am[a][hf][i]) + bflo(sg[a][hf][i]) * a2[a][2 * i];
          const float v1 = bfhi(am[a][hf][i]) + bfhi(sg[a][hf][i]) * a2[a][2 * i + 1];
          am[a][hf][i] = pack2(v0, v1);
        }
    }
  }
  f32x16 accm[2][2];
#pragma unroll
  for (int a = 0; a < 2; ++a)
#pragma unroll
    for (int bq = 0; bq < 2; ++bq)
#pragma unroll
      for (int i = 0; i < 8; ++i) { accm[a][bq][2 * i] = bflo(am[a][bq][i]); accm[a][bq][2 * i + 1] = bfhi(am[a][bq][i]); }
  float* Cs = (float*)smem;
  acc_to_lds(accm, Cs);
  __syncthreads();
  store_tile_bf16(Cs, (bf16*)(p.ws + OFF_MG) + (size_t)mt * 128 * DM + nt * 128, DM, 128, 1.f);
  __syncthreads();
}

DI void plain_tile(const bf16* A, int K, const bf16* W, bf16* dst, int ldd, char* smem) {
  f32x16 acc[2][2];
  acc_zero(acc);
  gemm_main_dma(acc, [&](int r) { return A + (size_t)r * K; }, [&](int r) { return W + (size_t)r * K; }, K, smem);
  float* Cs = (float*)smem;
  acc_to_lds(acc, Cs);
  __syncthreads();
  store_tile_bf16(Cs, dst, ldd, 128, 1.f);
  __syncthreads();
}

DI void up_tile(const Params& p, int l, int j, char* smem) {
  const int jn = j % 44, mtile = j / 44;
  const int b = mtile / 69, rr0 = mtile % 69;
  int seqbase, len, ti;
  if (rr0 < 3) { seqbase = b * TT; len = CTXL; ti = rr0; }
  else { seqbase = b * TT + CTXL; len = SEQ; ti = rr0 - 3; }
  const int pos0 = ti * 126 - 1;
  const bf16* H = (const bf16*)(p.ws + OFF_H);
  const bf16* W = wl(p, l, WL_UP) + (size_t)jn * 128 * DM;
  f32x16 acc[2][2];
  acc_zero(acc);
  gemm_main_dma(acc,
            [&](int r) -> const bf16* {
              const int pos = pos0 + r;
              return (pos >= 0 && pos < len) ? H + (size_t)(seqbase + pos) * DM : (const bf16*)(p.ws + OFF_ZERO);
            },
            [&](int r) { return W + (size_t)r * DM; }, DM, smem);
  float* Cs = (float*)smem;
  acc_to_lds(acc, Cs);
  __syncthreads();
  const float* cw = p.in[I_CW] + (size_t)l * 3 * 2 * DFF;
  const float* cb = p.in[I_CB] + (size_t)l * 2 * DFF;
  bf16* G = (bf16*)(p.ws + OFF_G);
  for (int idx = TIDX; idx < 126 * 32; idx += 256) {
    const int rr = 1 + (idx >> 5), c = (idx & 31) * 2;
    const int pos = pos0 + rr;
    if (pos < len) {
      float gv[2];
#pragma unroll
      for (int e = 0; e < 2; ++e) {
        const int ca = jn * 64 + c + e, cv = DFF + ca;
        const float a = cw[ca] * Cs[(rr - 1) * CLD + c + e] + cw[2 * DFF + ca] * Cs[rr * CLD + c + e] +
                        cw[4 * DFF + ca] * Cs[(rr + 1) * CLD + c + e] + cb[ca];
        const float v = cw[cv] * Cs[(rr - 1) * CLD + 64 + c + e] + cw[2 * DFF + cv] * Cs[rr * CLD + 64 + c + e] +
                        cw[4 * DFF + cv] * Cs[(rr + 1) * CLD + 64 + c + e] + cb[cv];
        gv[e] = siluf_(a) * v;
      }
      *(unsigned*)(G + (size_t)(seqbase + pos) * DFF + jn * 64 + c) = pack2(gv[0], gv[1]);
    }
  }
  __syncthreads();
}

DI bool gemm_job(int bid, int G, int it, int MT, int NTL, int& mt, int& nt) {
  const int x = bid & 7, q = bid >> 3, Q = G >> 3;
  const int m0 = (x * MT) >> 3, m1 = ((x + 1) * MT) >> 3, Mx = m1 - m0;
  const int jl = q + Q * it;
  if (jl >= Mx * NTL) return false;
  const int full = Mx * 8;
  const int c = jl / full, rem = jl - c * full;
  const int wc = min(8, NTL - 8 * c);
  const int mi = rem / wc;
  mt = m0 + mi;
  nt = 8 * c + (rem - mi * wc);
  return true;
}

enum { PH_PREP = 0, PH_ROW0, PH_PROJ, PH_MIX1, PH_SCAN, PH_MIX2, PH_GLU, PH_MERGE, PH_WOUT, PH_ROW1, PH_UP, PH_DOWN, PH_ROW2 };
constexpr int N_PHASES = 2 + 11 * NL;

DI void run_phase(const Params& p, int ph, int l, char* smem) {
  const int bid = blockIdx.x;
#ifdef HALFMASK
  const int G = ((HALFMASK >> ph) & 1) ? 256 : gridDim.x;
  if (bid >= G) return;
#else
  const int G = gridDim.x;
#endif
#ifdef PHMASK
  if (!((PHMASK >> ph) & 1)) return;
#endif
  switch (ph) {
    case PH_PREP:
      if (bid < 8) { for (int i = TIDX; i < 512; i += 256) ((u32x4*)(p.ws + OFF_ZERO))[i] = u32x4{0u, 0u, 0u, 0u}; }
      for (int j = bid; j < 128 + 16064; j += G) {
        if (j < 96) prep_mod_job(p, j, smem);
        else if (j < 128) prep_s5_job(p, j - 96);
        else prep_wt_job(p, j - 128, smem);
      }
      break;
    case PH_ROW0:
      row_phase<0>(p, 0, bid, G);
      ktab_phase(p, bid, G);
      break;
    case PH_PROJ:
#ifdef EXP_A
      if (bid < 256) { int mt, nt; for (int it = 0; gemm_job(bid, 256, it, 264, 19, mt, nt); ++it) proj_tile(p, l, mt, nt, smem); }
      s5mat_phase(p, l, bid, G);
#elif defined(EXP_C)
      if (bid < 256) for (int j = bid; j < 264 * 19; j += 256) { if ((EXP_C >> (j % 19)) & 1) proj_tile(p, l, j / 19, j % 19, smem); }
      for (int j = bid; j < 264 * 19; j += G) { if (!((EXP_C >> (j % 19)) & 1)) proj_tile(p, l, j / 19, j % 19, smem); }
      s5mat_phase(p, l, bid, G);
#elif defined(EXP_B)
      for (int j = bid; j < 264 * 19; j += G) proj_tile(p, l, j / 19, j % 19, smem);
      if (bid < 256) s5mat_phase(p, l, bid, 256);
#else
      for (int j = bid; j < 264 * 19; j += G) proj_tile(p, l, j / 19, j % 19, smem);
      s5mat_phase(p, l, bid, G);
#endif
      break;
    case PH_MIX1:
      for (int j = bid; j < 1056 + 1056 + 288; j += G) {
        if (j < 1056) attn_unit(p, j, smem);
        else if (j < 2112) gla_unit<false>(p, l, j - 1056, smem);
        else s5_end_tile(p, j - 2112, smem);
      }
      break;
    case PH_SCAN:
      for (int j = bid; j < 1024 + 128; j += G) {
        if (j < 1024) gla_scan_job(p, j);
        else s5_scan_job(p, l, j - 1024, smem);
      }
      break;
    case PH_MIX2:
      for (int j = bid; j < 528 + 576; j += G) {
        if (j < 528) gla_unit<true>(p, l, j, smem);
        else s5_out_tile(p, j - 528, smem);
      }
      break;
    case PH_GLU:
      { int mt, nt; for (int it = 0; gemm_job(bid, G, it, 264, 2, mt, nt); ++it) glu_tile(p, l, mt * 2 + nt, smem); }
      break;
    case PH_MERGE:
      { int mt, nt; for (int it = 0; gemm_job(bid, G, it, 264, 8, mt, nt); ++it) merge_tile(p, l, mt * 8 + nt, smem); }
      break;
    case PH_WOUT:
      for (int it = 0;; ++it) {
        int mt, nt;
        if (!gemm_job(bid, G, it, 264, 8, mt, nt)) break;
        plain_tile((const bf16*)(p.ws + OFF_MG) + (size_t)mt * 128 * DM, DM, wl(p, l, WL_WOUT) + (size_t)nt * 128 * DM,
                   (bf16*)(p.ws + OFF_H) + (size_t)mt * 128 * DM + nt * 128, DM, smem);
      }
      break;
    case PH_ROW1: row_phase<1>(p, l, bid, G); break;
    case PH_UP:
      { int mt, nt; for (int it = 0; gemm_job(bid, G, it, 276, 44, mt, nt); ++it) up_tile(p, l, mt * 44 + nt, smem); }
      break;
    case PH_DOWN:
      for (int it = 0;; ++it) {
        int mt, nt;
        if (!gemm_job(bid, G, it, 264, 8, mt, nt)) break;
        plain_tile((const bf16*)(p.ws + OFF_G) + (size_t)mt * 128 * DFF, DFF, wl(p, l, WL_DOWN) + (size_t)nt * 128 * DFF,
                   (bf16*)(p.ws + OFF_H) + (size_t)mt * 128 * DM + nt * 128, DM, smem);
      }
      break;
    case PH_ROW2: row_phase<2>(p, l, bid, G); break;
  }
}

DI void grid_barrier(unsigned* bar, unsigned& gen) {
  asm volatile("s_waitcnt vmcnt(0)" ::: "memory");
  __syncthreads();
  gen += 1;
  if (threadIdx.x == 0) {
    __builtin_amdgcn_fence(__ATOMIC_RELEASE, "agent");
    asm volatile("s_waitcnt vmcnt(0)" ::: "memory");
    const unsigned target = gen * gridDim.x;
    __hip_atomic_fetch_add(bar, 1u, __ATOMIC_RELAXED, __HIP_MEMORY_SCOPE_AGENT);
    while (__hip_atomic_load(bar, __ATOMIC_RELAXED, __HIP_MEMORY_SCOPE_AGENT) < target) __builtin_amdgcn_s_sleep(2);
  }
  __syncthreads();
  __builtin_amdgcn_fence(__ATOMIC_ACQUIRE, "agent");
  asm volatile("s_waitcnt vmcnt(0)" ::: "memory");
}

__global__ void __launch_bounds__(256, 2) hybrid_fwd(Params p, int ph_lo, int ph_hi) {
  extern __shared__ __attribute__((aligned(16))) char smem[];
  unsigned* bar = (unsigned*)(p.ws + OFF_BAR);
  unsigned gen = 0;
  if (ph_hi - ph_lo > 1) cg::this_grid().sync();
  int i = 0;
#define STEP(PH, L)                                      \
  {                                                      \
    if (i >= ph_lo && i < ph_hi) {                       \
      Params q;                                          \
      q.ws = p.ws; q.out = p.out;                        \
      asm volatile("" : "+s"(q.ws), "+s"(q.out));        \
      _Pragma("unroll") for (int k = 0; k < 34; ++k) { q.in[k] = p.in[k]; asm volatile("" : "+s"(q.in[k])); } \
      run_phase(q, PH, L, smem);                         \
      if ((DUPMASK >> (PH)) & 1) { grid_barrier(bar, gen); run_phase(q, PH, L, smem); } \
      if (i + 1 < ph_hi) grid_barrier(bar, gen);         \
    }                                                    \
    ++i;                                                 \
  }
  STEP(PH_PREP, 0)
  STEP(PH_ROW0, 0)
#pragma unroll 1
  for (int l = 0; l < NL; ++l) {
    STEP(PH_PROJ, l)
    STEP(PH_MIX1, l)
    STEP(PH_SCAN, l)
    STEP(PH_MIX2, l)
    STEP(PH_GLU, l)
    STEP(PH_MERGE, l)
    STEP(PH_WOUT, l)
    STEP(PH_ROW1, l)
    STEP(PH_UP, l)
    STEP(PH_DOWN, l)
    STEP(PH_ROW2, l)
  }
#undef STEP
}

extern "C" void kernel_launch(void* const* d_in, const int* in_sizes, int n_in, void* d_out, int out_size, void* d_ws, size_t ws_size,
                              hipStream_t stream) {
  static int grid_blocks = 0;
  if (!grid_blocks) {
    int dev = 0, cus = 0, per_cu = 0;
    hipGetDevice(&dev);
    hipDeviceGetAttribute(&cus, hipDeviceAttributeMultiprocessorCount, dev);
    hipFuncSetAttribute((const void*)hybrid_fwd, hipFuncAttributeMaxDynamicSharedMemorySize, SMEM_BYTES);
    hipOccupancyMaxActiveBlocksPerMultiprocessor(&per_cu, hybrid_fwd, 256, SMEM_BYTES);
    if (per_cu < 1) per_cu = 1;
    if (per_cu > 2) per_cu = 2;
    grid_blocks = cus * per_cu;
    if (ws_size < OFF_ZERO + 8192) fprintf(stderr, "workspace too small: %zu < %zu\n", ws_size, (size_t)OFF_END);
  }
  Params p{};
  for (int i = 0; i < 34; ++i) p.in[i] = (const float*)d_in[i];
  p.out = (float*)d_out;
  p.ws = (char*)d_ws;
#if ONE_LAUNCH
  hipMemsetAsync((char*)d_ws + OFF_BAR, 0, 256, stream);
  int lo = 0, hi = N_PHASES;
  void* args[] = {&p, &lo, &hi};
  hipError_t e = hipLaunchCooperativeKernel((void*)hybrid_fwd, dim3(grid_blocks), dim3(256), args, SMEM_BYTES, stream);
  if (e != hipSuccess) fprintf(stderr, "cooperative launch failed: %s (grid %d)\n", hipGetErrorString(e), grid_blocks);
#else
  for (int i = 0; i < N_PHASES; ++i) hipLaunchKernelGGL(hybrid_fwd, dim3(grid_blocks), dim3(256), SMEM_BYTES, stream, p, i, i + 1);
#endif
}
```

```cpp
#include <hip/hip_runtime.h>
#include <hip/hip_cooperative_groups.h>
#include <stdint.h>
#include <cstdio>
namespace cg = cooperative_groups;

#define EXP_A 1
#ifndef DUPMASK
#define DUPMASK 0
#endif
#ifndef ONE_LAUNCH
#define ONE_LAUNCH 1
#endif

typedef unsigned short bf16;
typedef __attribute__((ext_vector_type(8))) short s16x8;
typedef __attribute__((ext_vector_type(4))) short s16x4;
typedef __attribute__((ext_vector_type(16))) float f32x16;
typedef __attribute__((ext_vector_type(4))) float f32x4;
typedef __attribute__((ext_vector_type(2))) float f32x2;
typedef __attribute__((ext_vector_type(4))) unsigned u32x4;
typedef __attribute__((ext_vector_type(2))) unsigned u32x2;
typedef __attribute__((ext_vector_type(2))) __bf16 bf16x2_t;

#define DI __device__ __forceinline__
#define MFMA32(a, b, c) __builtin_amdgcn_mfma_f32_32x32x16_bf16((a), (b), (c), 0, 0, 0)

DI int tidx_opaque() { int t = threadIdx.x; asm volatile("" : "+v"(t)); return t; }
#define TIDX tidx_opaque()
DI bf16 f2bf(float x) { return __builtin_bit_cast(unsigned short, (__bf16)x); }
DI float bf2f(bf16 v) { return __uint_as_float(((unsigned)v) << 16); }
DI unsigned pack2(float a, float b) {
  f32x2 v = {a, b};
  return __builtin_bit_cast(unsigned, __builtin_convertvector(v, bf16x2_t));
}
DI float bflo(unsigned u) { return __uint_as_float(u << 16); }
DI float bfhi(unsigned u) { return __uint_as_float(u & 0xffff0000u); }
typedef const __attribute__((address_space(1))) u32x4* gptr16;
DI u32x4 ldg16(const void* q) { return *(gptr16)(uintptr_t)q; }
#define SCHED_FENCE() __builtin_amdgcn_sched_barrier(0)
DI int crow(int i, int h) { return (i & 3) + 8 * (i >> 2) + 4 * h; }
DI void sincos_cw(float x, float& sn, float& cs) {
  const float k = rintf(x * 0.63661977236758134f);
  float r = fmaf(-k, 1.57079637050628662109375f, x);
  r = fmaf(-k, -4.371139000186241e-08f, r);
  const int q = ((int)k) & 3;
  const float r2 = r * r;
  const float sp = r + r * r2 * (-1.6666667163e-01f + r2 * (8.3333337680e-03f + r2 * (-1.9841270114e-04f + r2 * 2.7557314297e-06f)));
  const float cp = 1.f + r2 * (-0.5f + r2 * (4.1666667908e-02f + r2 * (-1.3888889225e-03f + r2 * (2.4801587642e-05f - r2 * 2.7557314297e-07f))));
  sn = (q == 0) ? sp : (q == 1) ? cp : (q == 2) ? -sp : -cp;
  cs = (q == 0) ? cp : (q == 1) ? -sp : (q == 2) ? -cp : sp;
}
DI float sigmoidf_(float x) { return 1.f / (1.f + __expf(-x)); }
DI float siluf_(float x) { return x / (1.f + __expf(-x)); }

constexpr int DM = 1024, NB = 4, SEQ = 8192, CTXL = 256, TT = SEQ + CTXL, NTOK = NB * TT, NL = 4;
constexpr int DFF = 2816, DIN = 5408;
constexpr float EPSF = 1e-6f;
constexpr int NG33 = 33;
constexpr int NCH = 264;
constexpr int MS5 = NB * NCH;

constexpr size_t SZ_H = (size_t)NTOK * 1024 * 2;
constexpr size_t OFF_H = 0;
constexpr size_t OFF_P = OFF_H + SZ_H;
constexpr size_t OFF_Q = OFF_P;
constexpr size_t OFF_K = OFF_Q + (size_t)NTOK * 256 * 2;
constexpr size_t OFF_VT = OFF_K + (size_t)NTOK * 128 * 2;
constexpr size_t OFF_GQ = OFF_VT + (size_t)NTOK * 128 * 2;
constexpr size_t OFF_GK = OFF_GQ + (size_t)NTOK * 256 * 2;
constexpr size_t OFF_GVT = OFF_GK + (size_t)NTOK * 256 * 2;
constexpr size_t OFF_GR = OFF_GVT + (size_t)NTOK * 512 * 2;
constexpr size_t OFF_SU = OFF_GR + (size_t)NTOK * 512 * 2;
constexpr size_t OFF_LOW = OFF_SU + (size_t)NTOK * 256 * 2;
constexpr size_t OFF_O = OFF_LOW + (size_t)NTOK * 32 * 4;
constexpr size_t OFF_OATT = OFF_O;
constexpr size_t OFF_OGLA = OFF_OATT + (size_t)NTOK * 256 * 2;
constexpr size_t OFF_Y5 = OFF_OGLA + (size_t)NTOK * 512 * 2;
constexpr size_t OFF_EN = OFF_Y5;
constexpr size_t OFF_OS5 = OFF_Y5 + (size_t)NTOK * 256 * 2;
constexpr size_t OFF_M = OFF_OS5 + (size_t)NTOK * 256 * 2;
constexpr size_t OFF_MG = OFF_M;
constexpr size_t OFF_GS = OFF_M;
constexpr size_t OFF_DECG = OFF_GS + (size_t)32 * 33 * 8192 * 4;
constexpr size_t OFF_SB = OFF_DECG + (size_t)32 * 33 * 64 * 4;
constexpr size_t OFF_T5 = OFF_SB + (size_t)MS5 * 16 * 256 * 2;
constexpr size_t OFF_E5 = OFF_T5 + (size_t)16 * 512 * 512 * 2;
constexpr size_t OFF_F5 = OFF_E5 + (size_t)16 * 512 * 256 * 2;
constexpr size_t OFF_MEND = OFF_F5 + (size_t)16 * 256 * 512 * 2;
static_assert(OFF_MEND <= OFF_M + SZ_H, "mixer scratch overflows merged area");
constexpr size_t OFF_W = OFF_M + SZ_H;
constexpr size_t WL_WIN = 0, WL_BRA = WL_WIN + (size_t)5504 * 1024, WL_BRG = WL_BRA + 1024 * 256, WL_BRS = WL_BRG + 1024 * 512,
                 WL_WOUT = WL_BRS + 1024 * 256, WL_UP = WL_WOUT + 1024 * 1024, WL_DOWN = WL_UP + (size_t)5632 * 1024,
                 WL_GLU = WL_DOWN + (size_t)1024 * 2816, WL_TOTAL = WL_GLU + 256 * 256;
constexpr size_t OFF_XC = OFF_W + WL_TOTAL * 2 * NL;
constexpr size_t OFF_MOD = OFF_XC + (size_t)NB * CTXL * 1024 * 4;
constexpr size_t OFF_BBR = OFF_MOD + (size_t)NL * 5 * 6144 * 4;
constexpr size_t OFF_BBI = OFF_BBR + (size_t)NL * 2 * 16 * 64 * 16 * 4;
constexpr size_t OFF_PWR = OFF_BBI + (size_t)NL * 2 * 16 * 64 * 16 * 4;
constexpr size_t OFF_KTAB = OFF_PWR + (size_t)NL * 2 * 16 * 33 * 64 * 8;
constexpr size_t OFF_END = OFF_KTAB + (size_t)NL * 16 * 2 * 32 * 256 * 4;
constexpr size_t OFF_BAR = OFF_END;
constexpr size_t OFF_ZERO = OFF_BAR + 256;
constexpr size_t OFF_G = OFF_P;
static_assert((size_t)NTOK * DFF * 2 <= OFF_M - OFF_P, "G overflows");

constexpr int SMEM_BYTES = 73728;

struct Params {
  const float* in[34];
  float* out;
  char* ws;
};

enum { I_X = 0, I_C, I_CTX, I_CCTX, I_ADAW, I_ADAB, I_NMPRE, I_NMPOST, I_NFPRE, I_NFPOST, I_WIN, I_QN, I_KN, I_GGW, I_GGB, I_GON,
       I_ARE, I_AIM, I_LDT, I_BRE, I_BIM, I_CRE, I_CIM, I_S5D, I_GLUW, I_GLUB, I_WBA, I_WBG, I_WBS, I_WOUT, I_UP, I_CW, I_CB, I_DOWN };

constexpr int LDT = 72;
constexpr int CLD = 132;

template <class FA, class FB>
DI void gemm_main(f32x16 (&acc)[2][2], FA fa, FB fb, int K, char* smem) {
  bf16* As = (bf16*)smem;
  bf16* Bs = (bf16*)(smem + 2 * 128 * LDT * 2);
  const int tid = TIDX, lane = tid & 63, w = tid >> 6, wm = w >> 1, wn = w & 1;
  const int r = lane & 31, h = lane >> 5;
  const int lr = tid >> 3, kc = (tid & 7) * 8;
  const bf16* ap[4];
  const bf16* bp[4];
#pragma unroll
  for (int i = 0; i < 4; ++i) {
    const bf16* a = fa(lr + 32 * i);
    const bf16* b = fb(lr + 32 * i);
    ap[i] = a ? a + kc : nullptr;
    bp[i] = b ? b + kc : nullptr;
  }
  u32x4 ra[4], rb[4];
  const u32x4 z4 = {0u, 0u, 0u, 0u};
#pragma unroll
  for (int i = 0; i < 4; ++i) {
    ra[i] = ap[i] ? ldg16(ap[i]) : z4;
    rb[i] = bp[i] ? ldg16(bp[i]) : z4;
  }
#pragma unroll
  for (int i = 0; i < 4; ++i) {
    *(u32x4*)(As + (lr + 32 * i) * LDT + kc) = ra[i];
    *(u32x4*)(Bs + (lr + 32 * i) * LDT + kc) = rb[i];
  }
  __syncthreads();
  const int nk = K / 64;
  for (int kt = 0; kt < nk; ++kt) {
    const int buf = kt & 1;
    const bool more = (kt + 1 < nk);
    if (more) {
      const int k0 = (kt + 1) * 64;
#pragma unroll
      for (int i = 0; i < 4; ++i) {
        ra[i] = ap[i] ? ldg16(ap[i] + k0) : z4;
        rb[i] = bp[i] ? ldg16(bp[i] + k0) : z4;
      }
    }
    SCHED_FENCE();
    const bf16* Ab = As + buf * 128 * LDT + (wm * 64 + r) * LDT + h * 8;
    const bf16* Bb = Bs + buf * 128 * LDT + (wn * 64 + r) * LDT + h * 8;
#pragma unroll
    for (int s = 0; s < 4; ++s) {
      s16x8 a0 = *(const s16x8*)(Ab + s * 16);
      s16x8 a1 = *(const s16x8*)(Ab + 32 * LDT + s * 16);
      s16x8 b0 = *(const s16x8*)(Bb + s * 16);
      s16x8 b1 = *(const s16x8*)(Bb + 32 * LDT + s * 16);
      acc[0][0] = MFMA32(a0, b0, acc[0][0]);
      acc[0][1] = MFMA32(a0, b1, acc[0][1]);
      acc[1][0] = MFMA32(a1, b0, acc[1][0]);
      acc[1][1] = MFMA32(a1, b1, acc[1][1]);
    }
    SCHED_FENCE();
    if (more) {
      bf16* Aw = As + (buf ^ 1) * 128 * LDT;
      bf16* Bw = Bs + (buf ^ 1) * 128 * LDT;
#pragma unroll
      for (int i = 0; i < 4; ++i) {
        *(u32x4*)(Aw + (lr + 32 * i) * LDT + kc) = ra[i];
        *(u32x4*)(Bw + (lr + 32 * i) * LDT + kc) = rb[i];
      }
    }
    __syncthreads();
  }
}

template <class FA, class FB>
DI void gemm_main_deep(f32x16 (&acc)[2][2], FA fa, FB fb, int K, char* smem) {
  bf16* As = (bf16*)smem;
  bf16* Bs = (bf16*)(smem + 2 * 128 * LDT * 2);
  const int tid = TIDX, lane = tid & 63, w = tid >> 6, wm = w >> 1, wn = w & 1;
  const int r = lane & 31, h = lane >> 5;
  const int lr = tid >> 3, kc = (tid & 7) * 8;
  const bf16* ap[4];
  const bf16* bp[4];
#pragma unroll
  for (int i = 0; i < 4; ++i) {
    const bf16* a = fa(lr + 32 * i);
    const bf16* b = fb(lr + 32 * i);
    ap[i] = a ? a + kc : nullptr;
    bp[i] = b ? b + kc : nullptr;
  }
  const u32x4 z4 = {0u, 0u, 0u, 0u};
  u32x4 a0[4], b0[4], a1[4], b1[4];
  const int nk = K / 64;
#define GD_LOAD(RA, RB, T)                                               \
  {                                                                      \
    const int k0_ = (T) * 64;                                            \
    _Pragma("unroll") for (int i = 0; i < 4; ++i) {                      \
      RA[i] = ap[i] ? ldg16(ap[i] + k0_) : z4;                           \
      RB[i] = bp[i] ? ldg16(bp[i] + k0_) : z4;                           \
    }                                                                    \
  }
#define GD_STORE(RA, RB, BUF)                                            \
  {                                                                      \
    _Pragma("unroll") for (int i = 0; i < 4; ++i) {                      \
      *(u32x4*)(As + (BUF) * 128 * LDT + (lr + 32 * i) * LDT + kc) = RA[i]; \
      *(u32x4*)(Bs + (BUF) * 128 * LDT + (lr + 32 * i) * LDT + kc) = RB[i]; \
    }                                                                    \
  }
#define GD_COMPUTE(BUF)                                                  \
  {                                                                      \
    const bf16* Ab = As + (BUF) * 128 * LDT + (wm * 64 + r) * LDT + h * 8; \
    const bf16* Bb = Bs + (BUF) * 128 * LDT + (wn * 64 + r) * LDT + h * 8; \
    _Pragma("unroll") for (int s = 0; s < 4; ++s) {                      \
      s16x8 fa0 = *(const s16x8*)(Ab + s * 16);                          \
      s16x8 fa1 = *(const s16x8*)(Ab + 32 * LDT + s * 16);               \
      s16x8 fb0 = *(const s16x8*)(Bb + s * 16);                          \
      s16x8 fb1 = *(const s16x8*)(Bb + 32 * LDT + s * 16);               \
      acc[0][0] = MFMA32(fa0, fb0, acc[0][0]);                           \
      acc[0][1] = MFMA32(fa0, fb1, acc[0][1]);                           \
      acc[1][0] = MFMA32(fa1, fb0, acc[1][0]);                           \
      acc[1][1] = MFMA32(fa1, fb1, acc[1][1]);                           \
    }                                                                    \
  }
  GD_LOAD(a0, b0, 0)
  GD_LOAD(a1, b1, 1)
  GD_STORE(a0, b0, 0)
  __syncthreads();
  if (nk > 2) GD_LOAD(a0, b0, 2)
  for (int kt = 0; kt < nk; kt += 2) {
    SCHED_FENCE();
    GD_COMPUTE(0)
    SCHED_FENCE();
    GD_STORE(a1, b1, 1)
    if (kt + 3 < nk) GD_LOAD(a1, b1, kt + 3)
    __syncthreads();
    SCHED_FENCE();
    GD_COMPUTE(1)
    SCHED_FENCE();
    if (kt + 2 < nk) {
      GD_STORE(a0, b0, 0)
      if (kt + 4 < nk) GD_LOAD(a0, b0, kt + 4)
    }
    __syncthreads();
  }
#undef GD_LOAD
#undef GD_STORE
#undef GD_COMPUTE
}

template <class FA, class FB>
DI void gemm_main_dma(f32x16 (&acc)[2][2], FA fa, FB fb, int K, char* smem) {
  char* As = smem;
  char* Bs = smem + 32768;
  const int tid = TIDX, lane = tid & 63, w = tid >> 6, wm = w >> 1, wn = w & 1;
  const int r = lane & 31, h = lane >> 5;
  const bf16* ap[4];
  const bf16* bp[4];
#pragma unroll
  for (int i = 0; i < 4; ++i) {
    const int row = w * 32 + i * 8 + (lane >> 3);
    const int c = (lane & 7) ^ ((row >> 1) & 7);
    ap[i] = fa(row) + c * 8;
    bp[i] = fb(row) + c * 8;
  }
  const int ldst = (w * 256 + lane) * 16;
#define GM_DMA(BUF, T)                                                                                        \
  {                                                                                                           \
    const int k0_ = (T) * 64;                                                                                 \
    _Pragma("unroll") for (int i = 0; i < 4; ++i) {                                                           \
      __builtin_amdgcn_global_load_lds((const unsigned*)(ap[i] + k0_), (unsigned*)(As + (BUF) * 16384 + ldst + i * 1024), 16, 0, 0); \
      __builtin_amdgcn_global_load_lds((const unsigned*)(bp[i] + k0_), (unsigned*)(Bs + (BUF) * 16384 + ldst + i * 1024), 16, 0, 0); \
    }                                                                                                         \
  }
  const int xr = (r >> 1) & 7;
  const int arow = (wm * 64 + r) * 128, brow = (wn * 64 + r) * 128;
  GM_DMA(0, 0)
  asm volatile("s_waitcnt vmcnt(0)" ::: "memory");
  __syncthreads();
  const int nk = K / 64;
  for (int kt = 0; kt < nk; ++kt) {
    const int buf = kt & 1;
    if (kt + 1 < nk) GM_DMA(buf ^ 1, kt + 1)
    const char* Ab = As + buf * 16384 + arow;
    const char* Bb = Bs + buf * 16384 + brow;
#pragma unroll
    for (int s = 0; s < 4; ++s) {
      const int co = ((2 * s + h) ^ xr) * 16;
      s16x8 a0 = *(const s16x8*)(Ab + co);
      s16x8 a1 = *(const s16x8*)(Ab + 32 * 128 + co);
      s16x8 b0 = *(const s16x8*)(Bb + co);
      s16x8 b1 = *(const s16x8*)(Bb + 32 * 128 + co);
      acc[0][0] = MFMA32(a0, b0, acc[0][0]);
      acc[0][1] = MFMA32(a0, b1, acc[0][1]);
      acc[1][0] = MFMA32(a1, b0, acc[1][0]);
      acc[1][1] = MFMA32(a1, b1, acc[1][1]);
    }
    asm volatile("s_waitcnt vmcnt(0)" ::: "memory");
    __syncthreads();
  }
#undef GM_DMA
}

DI void gemm_main_dma_half(f32x16 (&acc)[2], const bf16* A, int lda, const bf16* B, int ldb, int K, int hf, char* smem) {
  char* As = smem;
  char* Bs = smem + 32768;
  const int tid = TIDX, lane = tid & 63, w = tid >> 6, wm = w >> 1, wn = w & 1;
  const int r = lane & 31, h = lane >> 5;
  const bf16* ap[4];
  const bf16* bp[2];
#pragma unroll
  for (int i = 0; i < 4; ++i) {
    const int row = w * 32 + i * 8 + (lane >> 3);
    ap[i] = A + (size_t)row * lda + ((lane & 7) ^ ((row >> 1) & 7)) * 8;
  }
#pragma unroll
  for (int i = 0; i < 2; ++i) {
    const int lrow = w * 16 + i * 8 + (lane >> 3);
    const int grow = (lrow >> 5) * 64 + hf * 32 + (lrow & 31);
    bp[i] = B + (size_t)grow * ldb + ((lane & 7) ^ ((lrow >> 1) & 7)) * 8;
  }
  const int lda_ = (w * 256 + lane) * 16, ldb_ = (w * 128 + lane) * 16;
#define GH_DMA(BUF, T)                                                                                        \
  {                                                                                                           \
    const int k0_ = (T) * 64;                                                                                 \
    _Pragma("unroll") for (int i = 0; i < 4; ++i)                                                             \
      __builtin_amdgcn_global_load_lds((const unsigned*)(ap[i] + k0_), (unsigned*)(As + (BUF) * 16384 + lda_ + i * 1024), 16, 0, 0); \
    _Pragma("unroll") for (int i = 0; i < 2; ++i)                                                             \
      __builtin_amdgcn_global_load_lds((const unsigned*)(bp[i] + k0_), (unsigned*)(Bs + (BUF) * 8192 + ldb_ + i * 1024), 16, 0, 0); \
  }
  const int xr = (r >> 1) & 7;
  const int arow = (wm * 64 + r) * 128, brow = (wn * 32 + r) * 128;
  GH_DMA(0, 0)
  asm volatile("s_waitcnt vmcnt(0)" ::: "memory");
  __syncthreads();
  const int nk = K / 64;
  for (int kt = 0; kt < nk; ++kt) {
    const int buf = kt & 1;
    if (kt + 1 < nk) GH_DMA(buf ^ 1, kt + 1)
    const char* Ab = As + buf * 16384 + arow;
    const char* Bb = Bs + buf * 8192 + brow;
#pragma unroll
    for (int s = 0; s < 4; ++s) {
      const int co = ((2 * s + h) ^ xr) * 16;
      s16x8 a0 = *(const s16x8*)(Ab + co);
      s16x8 a1 = *(const s16x8*)(Ab + 32 * 128 + co);
      s16x8 b0 = *(const s16x8*)(Bb + co);
      acc[0] = MFMA32(a0, b0, acc[0]);
      acc[1] = MFMA32(a1, b0, acc[1]);
    }
    asm volatile("s_waitcnt vmcnt(0)" ::: "memory");
    __syncthreads();
  }
#undef GH_DMA
}

template <class FA, class FB>
DI void gemm_wide(f32x16 (&acc)[2][4], FA fa, FB fb, int K, char* smem) {
  const int tid = TIDX, lane = tid & 63, w = tid >> 6, wm = w >> 1, wn = w & 1;
  const int r = lane & 31, h = lane >> 5;
  const bf16* ap[2];
  const bf16* bp[4];
#pragma unroll
  for (int i = 0; i < 2; ++i) {
    const int row = w * 32 + i * 16 + (lane >> 2);
    ap[i] = fa(row) + ((lane & 3) ^ ((row >> 2) & 3)) * 8;
  }
#pragma unroll
  for (int i = 0; i < 4; ++i) {
    const int row = w * 64 + i * 16 + (lane >> 2);
    bp[i] = fb(row) + ((lane & 3) ^ ((row >> 2) & 3)) * 8;
  }
  const int lda_ = (w * 128 + lane) * 16;
  const int ldb_ = 8192 + (w * 256 + lane) * 16;
#define GW_DMA(T)                                                                                                   \
  {                                                                                                                 \
    char* st_ = smem + ((T) % 3) * 24576;                                                                           \
    const int k0_ = (T) * 32;                                                                                       \
    _Pragma("unroll") for (int i = 0; i < 2; ++i)                                                                   \
      __builtin_amdgcn_global_load_lds((const unsigned*)(ap[i] + k0_), (unsigned*)(st_ + lda_ + i * 1024), 16, 0, 0); \
    _Pragma("unroll") for (int i = 0; i < 4; ++i)                                                                   \
      __builtin_amdgcn_global_load_lds((const unsigned*)(bp[i] + k0_), (unsigned*)(st_ + ldb_ + i * 1024), 16, 0, 0); \
  }
  const int xr = (r >> 2) & 3;
  const int arow = (wm * 64 + r) * 64;
  const int brow = 8192 + (wn * 64 + r) * 64;
  const int nt = K / 32;
  GW_DMA(0)
  if (nt > 1) GW_DMA(1)
  for (int t = 0; t < nt; ++t) {
    if (t + 1 < nt) asm volatile("s_waitcnt vmcnt(6)" ::: "memory");
    else asm volatile("s_waitcnt vmcnt(0)" ::: "memory");
    __syncthreads();
    if (t + 2 < nt) GW_DMA(t + 2)
    const char* st = smem + (t % 3) * 24576;
#pragma unroll
    for (int s = 0; s < 2; ++s) {
      const int co = ((2 * s + h) ^ xr) * 16;
      const s16x8 a0 = *(const s16x8*)(st + arow + co);
      const s16x8 a1 = *(const s16x8*)(st + arow + 32 * 64 + co);
#pragma unroll
      for (int hn = 0; hn < 2; ++hn) {
        const s16x8 b0 = *(const s16x8*)(st + brow + hn * 128 * 64 + co);
        const s16x8 b1 = *(const s16x8*)(st + brow + hn * 128 * 64 + 32 * 64 + co);
        acc[0][hn * 2 + 0] = MFMA32(a0, b0, acc[0][hn * 2 + 0]);
        acc[0][hn * 2 + 1] = MFMA32(a0, b1, acc[0][hn * 2 + 1]);
        acc[1][hn * 2 + 0] = MFMA32(a1, b0, acc[1][hn * 2 + 0]);
        acc[1][hn * 2 + 1] = MFMA32(a1, b1, acc[1][hn * 2 + 1]);
      }
    }
  }
  __syncthreads();
#undef GW_DMA
}

DI void accw_zero(f32x16 (&acc)[2][4]) {
#pragma unroll
  for (int a = 0; a < 2; ++a)
#pragma unroll
    for (int b = 0; b < 4; ++b)
#pragma unroll
      for (int i = 0; i < 16; ++i) acc[a][b][i] = 0.f;
}

DI void gemm_main_s(f32x16 (&acc)[2][2], const bf16* A, int lda, const bf16* B, int ldb, int K, char* smem) {
  bf16* As = (bf16*)smem;
  bf16* Bs = (bf16*)(smem + 2 * 128 * LDT * 2);
  const int tid = TIDX, lane = tid & 63, w = tid >> 6, wm = w >> 1, wn = w & 1;
  const int r = lane & 31, h = lane >> 5;
  const int lr = tid >> 3, kc = (tid & 7) * 8;
  const bf16* ap = A + (size_t)lr * lda + kc;
  const bf16* bp = B + (size_t)lr * ldb + kc;
  const size_t sa = (size_t)32 * lda, sb = (size_t)32 * ldb;
  u32x4 ra[4], rb[4];
#pragma unroll
  for (int i = 0; i < 4; ++i) {
    ra[i] = ldg16(ap + i * sa);
    rb[i] = ldg16(bp + i * sb);
  }
#pragma unroll
  for (int i = 0; i < 4; ++i) {
    *(u32x4*)(As + (lr + 32 * i) * LDT + kc) = ra[i];
    *(u32x4*)(Bs + (lr + 32 * i) * LDT + kc) = rb[i];
  }
  __syncthreads();
  const int nk = K / 64;
  for (int kt = 0; kt < nk; ++kt) {
    const int buf = kt & 1;
    const bool more = (kt + 1 < nk);
    if (more) {
      ap += 64; bp += 64;
#pragma unroll
      for (int i = 0; i < 4; ++i) {
        ra[i] = ldg16(ap + i * sa);
        rb[i] = ldg16(bp + i * sb);
      }
    }
    SCHED_FENCE();
    const bf16* Ab = As + buf * 128 * LDT + (wm * 64 + r) * LDT + h * 8;
    const bf16* Bb = Bs + buf * 128 * LDT + (wn * 64 + r) * LDT + h * 8;
#pragma unroll
    for (int s = 0; s < 4; ++s) {
      s16x8 a0 = *(const s16x8*)(Ab + s * 16);
      s16x8 a1 = *(const s16x8*)(Ab + 32 * LDT + s * 16);
      s16x8 b0 = *(const s16x8*)(Bb + s * 16);
      s16x8 b1 = *(const s16x8*)(Bb + 32 * LDT + s * 16);
      acc[0][0] = MFMA32(a0, b0, acc[0][0]);
      acc[0][1] = MFMA32(a0, b1, acc[0][1]);
      acc[1][0] = MFMA32(a1, b0, acc[1][0]);
      acc[1][1] = MFMA32(a1, b1, acc[1][1]);
    }
    SCHED_FENCE();
    if (more) {
      bf16* Aw = As + (buf ^ 1) * 128 * LDT;
      bf16* Bw = Bs + (buf ^ 1) * 128 * LDT;
#pragma unroll
      for (int i = 0; i < 4; ++i) {
        *(u32x4*)(Aw + (lr + 32 * i) * LDT + kc) = ra[i];
        *(u32x4*)(Bw + (lr + 32 * i) * LDT + kc) = rb[i];
      }
    }
    __syncthreads();
  }
}

DI void gemm_main_half(f32x16 (&acc)[2], const bf16* A, int lda, const bf16* B, int ldb, int K, int hf, char* smem) {
  bf16* As = (bf16*)smem;
  bf16* Bs = (bf16*)(smem + 2 * 128 * LDT * 2);
  const int tid = TIDX, lane = tid & 63, w = tid >> 6, wm = w >> 1, wn = w & 1;
  const int r = lane & 31, h = lane >> 5;
  const int lr = tid >> 3, kc = (tid & 7) * 8;
  const bf16* ap = A + (size_t)lr * lda + kc;
  const bf16* bp = B + (size_t)(hf * 32 + lr) * ldb + kc;
  const size_t sa = (size_t)32 * lda, sb = (size_t)64 * ldb;
  u32x4 ra[4], rb[2];
#pragma unroll
  for (int i = 0; i < 4; ++i) ra[i] = ldg16(ap + i * sa);
#pragma unroll
  for (int i = 0; i < 2; ++i) rb[i] = ldg16(bp + i * sb);
#pragma unroll
  for (int i = 0; i < 4; ++i) *(u32x4*)(As + (lr + 32 * i) * LDT + kc) = ra[i];
#pragma unroll
  for (int i = 0; i < 2; ++i) *(u32x4*)(Bs + (lr + 32 * i) * LDT + kc) = rb[i];
  __syncthreads();
  const int nk = K / 64;
  for (int kt = 0; kt < nk; ++kt) {
    const int buf = kt & 1;
    const bool more = (kt + 1 < nk);
    if (more) {
      ap += 64; bp += 64;
#pragma unroll
      for (int i = 0; i < 4; ++i) ra[i] = ldg16(ap + i * sa);
#pragma unroll
      for (int i = 0; i < 2; ++i) rb[i] = ldg16(bp + i * sb);
    }
    SCHED_FENCE();
    const bf16* Ab = As + buf * 128 * LDT + (wm * 64 + r) * LDT + h * 8;
    const bf16* Bb = Bs + buf * 128 * LDT + (wn * 32 + r) * LDT + h * 8;
#pragma unroll
    for (int s = 0; s < 4; ++s) {
      s16x8 a0 = *(const s16x8*)(Ab + s * 16);
      s16x8 a1 = *(const s16x8*)(Ab + 32 * LDT + s * 16);
      s16x8 b0 = *(const s16x8*)(Bb + s * 16);
      acc[0] = MFMA32(a0, b0, acc[0]);
      acc[1] = MFMA32(a1, b0, acc[1]);
    }
    SCHED_FENCE();
    if (more) {
      bf16* Aw = As + (buf ^ 1) * 128 * LDT;
      bf16* Bw = Bs + (buf ^ 1) * 128 * LDT;
#pragma unroll
      for (int i = 0; i < 4; ++i) *(u32x4*)(Aw + (lr + 32 * i) * LDT + kc) = ra[i];
#pragma unroll
      for (int i = 0; i < 2; ++i) *(u32x4*)(Bw + (lr + 32 * i) * LDT + kc) = rb[i];
    }
    __syncthreads();
  }
}

DI void acc_zero(f32x16 (&acc)[2][2]) {
#pragma unroll
  for (int a = 0; a < 2; ++a)
#pragma unroll
    for (int b = 0; b < 2; ++b)
#pragma unroll
      for (int i = 0; i < 16; ++i) acc[a][b][i] = 0.f;
}

DI void acc_to_lds(const f32x16 (&acc)[2][2], float* Cs) {
  const int lane = TIDX & 63, w = TIDX >> 6, wm = w >> 1, wn = w & 1, r = lane & 31, h = lane >> 5;
#pragma unroll
  for (int tm = 0; tm < 2; ++tm)
#pragma unroll
    for (int tn = 0; tn < 2; ++tn)
#pragma unroll
      for (int i = 0; i < 16; ++i) Cs[(wm * 64 + tm * 32 + crow(i, h)) * CLD + wn * 64 + tn * 32 + r] = acc[tm][tn][i];
}

template <int HN>
DI void accw_to_lds(const f32x16 (&acc)[2][4], float* Cs) {
  const int lane = TIDX & 63, w = TIDX >> 6, wm = w >> 1, wn = w & 1, r = lane & 31, h = lane >> 5;
#pragma unroll
  for (int tm = 0; tm < 2; ++tm)
#pragma unroll
    for (int tn = 0; tn < 2; ++tn)
#pragma unroll
      for (int i = 0; i < 16; ++i) Cs[(wm * 64 + tm * 32 + crow(i, h)) * CLD + wn * 64 + tn * 32 + r] = acc[tm][HN * 2 + tn][i];
}

DI void store_tile_bf16(const float* Cs, bf16* dst, size_t ld, int mvalid, float scale) {
  for (int c = TIDX; c < 2048; c += 256) {
    const int row = c >> 4, cc = (c & 15) * 8;
    if (row < mvalid) {
      const float* s = Cs + row * CLD + cc;
      u32x4 v;
      v[0] = pack2(s[0] * scale, s[1] * scale);
      v[1] = pack2(s[2] * scale, s[3] * scale);
      v[2] = pack2(s[4] * scale, s[5] * scale);
      v[3] = pack2(s[6] * scale, s[7] * scale);
      *(u32x4*)(dst + (size_t)row * ld + cc) = v;
    }
  }
}

DI float* resid_row(const Params& p, int tok) {
  const int b = tok / TT, t = tok - b * TT;
  return (t < CTXL) ? (float*)(p.ws + OFF_XC) + ((size_t)b * CTXL + t) * DM : p.out + ((size_t)b * SEQ + (t - CTXL)) * DM;
}
DI const float* mod_vec(const Params& p, int l, int tok, int which) {
  const int b = tok / TT, t = tok - b * TT;
  const int m = (t < CTXL) ? 4 : b;
  return (const float*)(p.ws + OFF_MOD) + ((size_t)(l * 5 + m) * 6 + which) * DM;
}
DI float wave_sum(float v) {
#pragma unroll
  for (int o = 32; o >= 1; o >>= 1) v += __shfl_xor(v, o, 64);
  return v;
}
DI bf16* wl(const Params& p, int l, size_t off) { return (bf16*)(p.ws + OFF_W) + (size_t)l * WL_TOTAL + off; }

DI void prep_mod_job(const Params& p, int j, char* smem) {
  float* sc = (float*)smem;
  const int l = j / 24, nb = j % 24, tid = TIDX;
  for (int idx = tid; idx < 5120; idx += 256) {
    const int m = idx >> 10, k = idx & 1023;
    const float v = (m < 4) ? p.in[I_C][m * 1024 + k] : p.in[I_CCTX][k];
    sc[idx] = siluf_(v);
  }
  __syncthreads();
  const int n = nb * 256 + tid;
  const float* W = p.in[I_ADAW] + (size_t)l * 1024 * 6144 + n;
  float a0 = 0, a1 = 0, a2 = 0, a3 = 0, a4 = 0;
#pragma unroll 8
  for (int k = 0; k < 1024; ++k) {
    const float wv = W[(size_t)k * 6144];
    a0 += sc[k] * wv; a1 += sc[1024 + k] * wv; a2 += sc[2048 + k] * wv; a3 += sc[3072 + k] * wv; a4 += sc[4096 + k] * wv;
  }
  const float bb = p.in[I_ADAB][l * 6144 + n];
  float* M = (float*)(p.ws + OFF_MOD) + (size_t)l * 5 * 6144 + n;
  M[0] = a0 + bb; M[6144] = a1 + bb; M[2 * 6144] = a2 + bb; M[3 * 6144] = a3 + bb; M[4 * 6144] = a4 + bb;
  __syncthreads();
}

DI void prep_s5_job(const Params& p, int j) {
  const int idx = j * 256 + TIDX;
  const int ldg = idx >> 6, pp = idx & 63;
  const float dt = expf(p.in[I_LDT][ldg]);
  const float are = p.in[I_ARE][idx], aim = p.in[I_AIM][idx];
  const float mag = expf(are * dt);
  float sn, cs;
  sincos_cw(aim * dt, sn, cs);
  const float abr = mag * cs, abi = mag * sn;
  const float den = are * are + aim * aim;
  const float fre = ((abr - 1.f) * are + abi * aim) / den;
  const float fim = (abi * are - (abr - 1.f) * aim) / den;
  float* BBR = (float*)(p.ws + OFF_BBR);
  float* BBI = (float*)(p.ws + OFF_BBI);
  for (int hh = 0; hh < 16; ++hh) {
    const float br = p.in[I_BRE][(size_t)idx * 16 + hh], bi = p.in[I_BIM][(size_t)idx * 16 + hh];
    BBR[(size_t)idx * 16 + hh] = fre * br - fim * bi;
    BBI[(size_t)idx * 16 + hh] = fre * bi + fim * br;
  }
  float2* PW = (float2*)(p.ws + OFF_PWR);
  float pr = 1.f, pi = 0.f;
  for (int tau = 0; tau <= 32; ++tau) {
    PW[((size_t)ldg * 33 + tau) * 64 + pp] = make_float2(pr, pi);
    const float nr = pr * abr - pi * abi, ni = pr * abi + pi * abr;
    pr = nr; pi = ni;
  }
}

DI void prep_wt_job(const Params& p, int jj, char* smem) {
  float* tile = (float*)smem;
  const int l = jj / 4016;
  int r = jj % 4016;
  int mat = 0;
  const int cnt[8] = {1376, 64, 128, 64, 256, 1408, 704, 16};
#pragma unroll
  for (int m = 0; m < 8; ++m) {
    if (mat == m && r >= cnt[m]) { r -= cnt[m]; mat = m + 1; }
  }
  const float* src; int K, sld; size_t doff;
  switch (mat) {
    case 0: src = p.in[I_WIN] + (size_t)l * 1024 * DIN; K = 1024; sld = DIN; doff = WL_WIN; break;
    case 1: src = p.in[I_WBA] + (size_t)l * 256 * 1024; K = 256; sld = 1024; doff = WL_BRA; break;
    case 2: src = p.in[I_WBG] + (size_t)l * 512 * 1024; K = 512; sld = 1024; doff = WL_BRG; break;
    case 3: src = p.in[I_WBS] + (size_t)l * 256 * 1024; K = 256; sld = 1024; doff = WL_BRS; break;
    case 4: src = p.in[I_WOUT] + (size_t)l * 1024 * 1024; K = 1024; sld = 1024; doff = WL_WOUT; break;
    case 5: src = p.in[I_UP] + (size_t)l * 1024 * 5632; K = 1024; sld = 5632; doff = WL_UP; break;
    case 6: src = p.in[I_DOWN] + (size_t)l * 2816 * 1024; K = 2816; sld = 1024; doff = WL_DOWN; break;
    default: src = p.in[I_GLUW] + (size_t)l * 256 * 256; K = 256; sld = 256; doff = WL_GLU; break;
  }
  const int kt = K / 64;
  const int n0 = (r / kt) * 64, k0 = (r % kt) * 64;
  const int tid = TIDX;
  {
    const int nn = tid & 63;
    const int np = n0 + nn;
    int col;
    if (mat == 0) {
      if (np < 2048) col = np;
      else if (np < 2304) col = 2080 + (np - 2048);
      else if (np < 2336) col = 2048 + (np - 2304);
      else if (np < 2432) col = -1;
      else col = 2336 + (np - 2432);
    } else if (mat == 5) {
      const int jb = np >> 7, c = np & 127;
      col = (c < 64) ? (jb * 64 + c) : (DFF + jb * 64 + (c - 64));
    } else col = np;
#pragma unroll 4
    for (int kk = tid >> 6; kk < 64; kk += 4) tile[kk * 65 + nn] = (col >= 0) ? src[(size_t)(k0 + kk) * sld + col] : 0.f;
  }
  __syncthreads();
  {
    const int nn = tid >> 2, kq = (tid & 3) * 16;
    bf16* d = wl(p, l, doff) + (size_t)(n0 + nn) * K + k0 + kq;
    u32x4 v0, v1;
#pragma unroll
    for (int e = 0; e < 4; ++e) {
      v0[e] = pack2(tile[(kq + 2 * e) * 65 + nn], tile[(kq + 2 * e + 1) * 65 + nn]);
      v1[e] = pack2(tile[(kq + 8 + 2 * e) * 65 + nn], tile[(kq + 8 + 2 * e + 1) * 65 + nn]);
    }
    *(u32x4*)d = v0;
    *(u32x4*)(d + 8) = v1;
  }
  __syncthreads();
}

template <int MODE>
DI void row_job(const Params& p, int l, int tok) {
  const int lane = TIDX & 63;
  float x[16];
  float* xr = resid_row(p, tok);
  if (MODE == 0) {
    const int b = tok / TT, t = tok - b * TT;
    const float* src = (t < CTXL) ? p.in[I_CTX] + ((size_t)b * CTXL + t) * DM : p.in[I_X] + ((size_t)b * SEQ + (t - CTXL)) * DM;
#pragma unroll
    for (int i = 0; i < 4; ++i) {
      const f32x4 v = *(const f32x4*)(src + lane * 4 + 256 * i);
      x[4 * i] = v[0]; x[4 * i + 1] = v[1]; x[4 * i + 2] = v[2]; x[4 * i + 3] = v[3];
      *(f32x4*)(xr + lane * 4 + 256 * i) = v;
    }
  } else {
    const bf16* yr = (const bf16*)(p.ws + OFF_H) + (size_t)tok * DM;
    const float* gpost = p.in[MODE == 1 ? I_NMPOST : I_NFPOST] + l * DM;
    const float* mg = mod_vec(p, l, tok, MODE == 1 ? 2 : 5);
    float y[16];
    float ss = 0.f;
#pragma unroll
    for (int i = 0; i < 4; ++i) {
      const u32x2 u = *(const u32x2*)(yr + lane * 4 + 256 * i);
      y[4 * i] = bflo(u[0]); y[4 * i + 1] = bfhi(u[0]); y[4 * i + 2] = bflo(u[1]); y[4 * i + 3] = bfhi(u[1]);
#pragma unroll
      for (int e = 0; e < 4; ++e) ss += y[4 * i + e] * y[4 * i + e];
    }
    ss = wave_sum(ss);
    const float rstd = rsqrtf(ss * (1.f / DM) + EPSF);
#pragma unroll
    for (int i = 0; i < 4; ++i) {
      f32x4 v = *(const f32x4*)(xr + lane * 4 + 256 * i);
      const f32x4 g = *(const f32x4*)(gpost + lane * 4 + 256 * i);
      const f32x4 m = *(const f32x4*)(mg + lane * 4 + 256 * i);
#pragma unroll
      for (int e = 0; e < 4; ++e) { v[e] += m[e] * (y[4 * i + e] * rstd * g[e]); x[4 * i + e] = v[e]; }
      *(f32x4*)(xr + lane * 4 + 256 * i) = v;
    }
  }
  if (MODE == 2 && l == NL - 1) return;
  const int ln = (MODE == 2) ? l + 1 : l;
  const float* gpre = p.in[MODE == 1 ? I_NFPRE : I_NMPRE] + ln * DM;
  const float* sh = mod_vec(p, ln, tok, MODE == 1 ? 3 : 0);
  const float* scv = mod_vec(p, ln, tok, MODE == 1 ? 4 : 1);
  float ss = 0.f;
#pragma unroll
  for (int i = 0; i < 16; ++i) ss += x[i] * x[i];
  ss = wave_sum(ss);
  const float rstd = rsqrtf(ss * (1.f / DM) + EPSF);
  bf16* hr = (bf16*)(p.ws + OFF_H) + (size_t)tok * DM;
#pragma unroll
  for (int i = 0; i < 4; ++i) {
    const f32x4 g = *(const f32x4*)(gpre + lane * 4 + 256 * i);
    const f32x4 s1 = *(const f32x4*)(sh + lane * 4 + 256 * i);
    const f32x4 s2 = *(const f32x4*)(scv + lane * 4 + 256 * i);
    float o[4];
#pragma unroll
    for (int e = 0; e < 4; ++e) o[e] = (x[4 * i + e] * rstd * g[e]) * (1.f + s2[e]) + s1[e];
    u32x2 u;
    u[0] = pack2(o[0], o[1]); u[1] = pack2(o[2], o[3]);
    *(u32x2*)(hr + lane * 4 + 256 * i) = u;
  }
}

template <int MODE>
DI void row_phase(const Params& p, int l, int bid, int G) {
  const int wg = bid * 4 + (TIDX >> 6), nw = G * 4;
  for (int tok = wg; tok < NTOK; tok += nw) row_job<MODE>(p, l, tok);
}

DI void ktab_phase(const Params& p, int bid, int G) {
  const float* BBR = (const float*)(p.ws + OFF_BBR);
  const float* BBI = (const float*)(p.ws + OFF_BBI);
  const float2* PW = (const float2*)(p.ws + OFF_PWR);
  float* KT = (float*)(p.ws + OFF_KTAB);
  const int total = NL * 16 * 2 * 32 * 256;
  for (int idx = bid * 256 + TIDX; idx < total; idx += G * 256) {
    const int hp = idx & 15, hh = (idx >> 4) & 15, tau = (idx >> 8) & 31, d = (idx >> 13) & 1, g = (idx >> 14) & 15, l = idx >> 18;
    const int ldg = (l * 2 + d) * 16 + g;
    const float* cre = p.in[I_CRE] + ((size_t)ldg * 16 + hh) * 64;
    const float* cim = p.in[I_CIM] + ((size_t)ldg * 16 + hh) * 64;
    float acc = 0.f;
    for (int pp = 0; pp < 64; ++pp) {
      const float2 pw = PW[((size_t)ldg * 33 + tau) * 64 + pp];
      const float br = BBR[((size_t)ldg * 64 + pp) * 16 + hp], bi = BBI[((size_t)ldg * 64 + pp) * 16 + hp];
      const float zr = pw.x * br - pw.y * bi, zi = pw.x * bi + pw.y * br;
      acc += cre[pp] * zr - cim[pp] * zi;
    }
    KT[idx] = acc;
  }
}

DI void s5mat_phase(const Params& p, int l, int bid, int G) {
  const float* BBR = (const float*)(p.ws + OFF_BBR);
  const float* BBI = (const float*)(p.ws + OFF_BBI);
  const float2* PW = (const float2*)(p.ws + OFF_PWR);
  const float* KT = (const float*)(p.ws + OFF_KTAB);
  bf16* T5 = (bf16*)(p.ws + OFF_T5);
  bf16* E5 = (bf16*)(p.ws + OFF_E5);
  bf16* F5 = (bf16*)(p.ws + OFF_F5);
  const int nT = 16 * 512 * 64, nE = 16 * 512 * 32, nF = 16 * 256 * 64;
  for (int it = bid * 256 + TIDX; it < nT + nE + nF; it += G * 256) {
    float v[8];
    bf16* dst;
    if (it < nT) {
      const int k8 = it & 63, n = (it >> 6) & 511, g = it >> 15;
      const int i = n >> 4, hh = n & 15, j = k8 >> 1, hp0 = (k8 & 1) * 8;
#pragma unroll
      for (int e = 0; e < 8; ++e) {
        const int hp = hp0 + e;
        float a = 0.f;
        if (j <= i) a += KT[((((size_t)l * 16 + g) * 2 + 0) * 32 + (i - j)) * 256 + hh * 16 + hp];
        if (j >= i) a += KT[((((size_t)l * 16 + g) * 2 + 1) * 32 + (j - i)) * 256 + hh * 16 + hp];
        if (i == j && hh == hp) a += p.in[I_S5D][l * 256 + g * 16 + hh];
        v[e] = a;
      }
      dst = T5 + ((size_t)g * 512 + n) * 512 + k8 * 8;
    } else if (it < nT + nE) {
      const int q = it - nT;
      const int k8 = q & 31, n = (q >> 5) & 511, g = q >> 14;
      const int i = n >> 4, hh = n & 15;
      const int k0 = k8 * 8, d = k0 >> 7, ri = (k0 >> 6) & 1, p0 = k0 & 63;
      const int ldg = (l * 2 + d) * 16 + g;
      const int ex = d ? (32 - i) : (i + 1);
#pragma unroll
      for (int e = 0; e < 8; ++e) {
        const int pp = p0 + e;
        const float2 pw = PW[((size_t)ldg * 33 + ex) * 64 + pp];
        const float cr = p.in[I_CRE][((size_t)ldg * 16 + hh) * 64 + pp], ci = p.in[I_CIM][((size_t)ldg * 16 + hh) * 64 + pp];
        const float zr = cr * pw.x - ci * pw.y, zi = cr * pw.y + ci * pw.x;
        v[e] = ri ? -zi : zr;
      }
      dst = E5 + ((size_t)g * 512 + n) * 256 + k0;
    } else {
      const int q = it - nT - nE;
      const int k8 = q & 63, n = (q >> 6) & 255, g = q >> 14;
      const int d = n >> 7, ri = (n >> 6) & 1, pp = n & 63;
      const int j = k8 >> 1, hp0 = (k8 & 1) * 8;
      const int ldg = (l * 2 + d) * 16 + g;
      const int ex = d ? j : (31 - j);
      const float2 pw = PW[((size_t)ldg * 33 + ex) * 64 + pp];
#pragma unroll
      for (int e = 0; e < 8; ++e) {
        const float br = BBR[((size_t)ldg * 64 + pp) * 16 + hp0 + e], bi = BBI[((size_t)ldg * 64 + pp) * 16 + hp0 + e];
        v[e] = ri ? (pw.x * bi + pw.y * br) : (pw.x * br - pw.y * bi);
      }
      dst = F5 + ((size_t)g * 256 + n) * 512 + k8 * 8;
    }
    u32x4 u;
    u[0] = pack2(v[0], v[1]); u[1] = pack2(v[2], v[3]); u[2] = pack2(v[4], v[5]); u[3] = pack2(v[6], v[7]);
    *(u32x4*)dst = u;
  }
}

DI void proj_epi(const Params& p, int l, int mt, int nt, char* smem);
DI void proj_wide(const Params& p, int l, int mt, int np, char* smem) {
  const bf16* H = (const bf16*)(p.ws + OFF_H) + (size_t)mt * 128 * DM;
  const bf16* W = wl(p, l, WL_WIN) + (size_t)np * 256 * DM;
  f32x16 acc[2][4];
  accw_zero(acc);
  gemm_wide(acc, [&](int r) { return H + (size_t)r * DM; }, [&](int r) { return W + (size_t)r * DM; }, DM, smem);
  float* Cs = (float*)smem;
  accw_to_lds<0>(acc, Cs);
  __syncthreads();
  proj_epi(p, l, mt, np * 2, smem);
  if (np * 2 + 1 < 19) {
    accw_to_lds<1>(acc, Cs);
    __syncthreads();
    proj_epi(p, l, mt, np * 2 + 1, smem);
  }
}
DI void proj_epi(const Params& p, int l, int mt, int nt, char* smem) {
  float* Cs = (float*)smem;
  const int tid = TIDX;
  const int tok0 = mt * 128;
  const int b = tok0 / TT, t0 = tok0 - b * TT;
  if (nt <= 2) {
    const int row = tid >> 1, seg = tid & 1;
    float* c = Cs + row * CLD + seg * 64;
    const float* gn = p.in[nt < 2 ? I_QN : I_KN] + l * 64;
    float ss = 0.f;
#pragma unroll 8
    for (int i = 0; i < 64; ++i) ss += c[i] * c[i];
    const float rstd = rsqrtf(ss * (1.f / 64.f) + EPSF);
    const int t = t0 + row;
    const bool lat = t >= CTXL;
    const int s = t - CTXL;
#pragma unroll 1
    for (int ax = 0; ax < 2; ++ax) {
      const float pos = (float)(ax ? (s & 63) : (s >> 6));
#pragma unroll 2
      for (int f = 0; f < 16; ++f) {
        float x1 = c[ax * 32 + f] * rstd * gn[ax * 32 + f];
        float x2 = c[ax * 32 + 16 + f] * rstd * gn[ax * 32 + 16 + f];
        if (lat) {
          const float invf = exp2f(-(float)f * (13.287712379549449f / 16.f));
          float sn, cs;
          sincos_cw(pos * invf, sn, cs);
          const float y1 = x1 * cs - x2 * sn, y2 = x2 * cs + x1 * sn;
          x1 = y1; x2 = y2;
        }
        c[ax * 32 + f] = x1;
        c[ax * 32 + 16 + f] = x2;
      }
    }
    __syncthreads();
    if (nt < 2) store_tile_bf16(Cs, (bf16*)(p.ws + OFF_Q) + (size_t)tok0 * 256 + nt * 128, 256, 128, 0.125f * 1.4426950408889634f);
    else store_tile_bf16(Cs, (bf16*)(p.ws + OFF_K) + (size_t)tok0 * 128, 128, 128, 1.f);
  } else if (nt == 3 || (nt >= 8 && nt <= 11)) {
    for (int c = tid; c < 2048; c += 256) {
      const int col = c & 127, rc = (c >> 7) * 8;
      u32x4 u;
#pragma unroll
      for (int e = 0; e < 4; ++e) u[e] = pack2(Cs[(rc + 2 * e) * CLD + col], Cs[(rc + 2 * e + 1) * CLD + col]);
      bf16* dst;
      if (nt == 3) dst = (bf16*)(p.ws + OFF_VT) + ((size_t)(b * 2 + (col >> 6)) * 64 + (col & 63)) * TT + t0 + rc;
      else dst = (bf16*)(p.ws + OFF_GVT) + ((size_t)(b * 4 + (nt - 8)) * 128 + col) * TT + t0 + rc;
      *(u32x4*)dst = u;
    }
  } else if (nt == 4 || nt == 5) {
    store_tile_bf16(Cs, (bf16*)(p.ws + OFF_GQ) + (size_t)tok0 * 256 + (nt - 4) * 128, 256, 128, 0.125f);
  } else if (nt == 6 || nt == 7) {
    store_tile_bf16(Cs, (bf16*)(p.ws + OFF_GK) + (size_t)tok0 * 256 + (nt - 6) * 128, 256, 128, 1.f);
  } else if (nt >= 12 && nt <= 15) {
    store_tile_bf16(Cs, (bf16*)(p.ws + OFF_GR) + (size_t)tok0 * 512 + (nt - 12) * 128, 512, 128, 1.f);
  } else if (nt == 16 || nt == 17) {
    for (int c = tid; c < 2048; c += 256) {
      const int row = c >> 4, c8 = c & 15;
      const float* s = Cs + row * CLD + c8 * 8;
      u32x4 u;
#pragma unroll
      for (int e = 0; e < 4; ++e) u[e] = pack2(s[2 * e], s[2 * e + 1]);
      const int ch = (nt - 16) * 128 + c8 * 8;
      bf16* dst = (bf16*)(p.ws + OFF_SU) + ((size_t)(b * 16 + (ch >> 4)) * TT + t0 + row) * 16 + (ch & 15);
      *(u32x4*)dst = u;
    }
  } else {
    for (int c = tid; c < 128 * 8; c += 256) {
      const int row = c >> 3, c4 = (c & 7) * 4;
      const float* s = Cs + row * CLD + c4;
      f32x4 v = {s[0], s[1], s[2], s[3]};
      *(f32x4*)((float*)(p.ws + OFF_LOW) + (size_t)(tok0 + row) * 32 + c4) = v;
    }
  }
  __syncthreads();
}

DI void attn_unit(const Params& p, int u, char* smem) {
  char* Ks = smem;
  char* Vs = smem + 16384;
  int b, head, tok0, nkt;
  if (u < 1024) { b = u >> 8; head = (u >> 6) & 3; tok0 = b * TT + CTXL + (u & 63) * 128; nkt = TT / 64; }
  else { const int v = u - 1024; b = v >> 3; head = (v >> 1) & 3; tok0 = b * TT + (v & 1) * 128; nkt = CTXL / 64; }
  const int kvh = head >> 1;
  const int tid = TIDX, lane = tid & 63, w = tid >> 6, r = lane & 31, h = lane >> 5;
  const bf16* Qp = (const bf16*)(p.ws + OFF_Q) + (size_t)(tok0 + w * 32 + r) * 256 + head * 64 + h * 8;
  s16x8 qf[4];
#pragma unroll
  for (int s = 0; s < 4; ++s) qf[s] = __builtin_bit_cast(s16x8, ldg16(Qp + s * 16));
  const bf16* kp[2];
  const bf16* vp[2];
#pragma unroll
  for (int i = 0; i < 2; ++i) {
    const int row = w * 16 + i * 8 + (lane >> 3);
    const int c = (lane & 7) ^ ((row >> 1) & 7);
    kp[i] = (const bf16*)(p.ws + OFF_K) + ((size_t)b * TT + row) * 128 + kvh * 64 + c * 8;
    vp[i] = (const bf16*)(p.ws + OFF_VT) + ((size_t)(b * 2 + kvh) * 64 + row) * TT + c * 8;
  }
  const int ldst = (w * 128 + lane) * 16;
#define AT_DMA(BUF, T)                                                                                              \
  {                                                                                                                 \
    _Pragma("unroll") for (int i = 0; i < 2; ++i) {                                                                 \
      __builtin_amdgcn_global_load_lds((const unsigned*)(kp[i] + (size_t)(T) * 64 * 128), (unsigned*)(Ks + (BUF) * 8192 + ldst + i * 1024), 16, 0, 0); \
      __builtin_amdgcn_global_load_lds((const unsigned*)(vp[i] + (T) * 64), (unsigned*)(Vs + (BUF) * 8192 + ldst + i * 1024), 16, 0, 0);               \
    }                                                                                                               \
  }
  const int xr = (r >> 1) & 7;
  AT_DMA(0, 0)
  asm volatile("s_waitcnt vmcnt(0)" ::: "memory");
  __syncthreads();
  f32x16 oacc[2];
#pragma unroll
  for (int i = 0; i < 16; ++i) { oacc[0][i] = 0.f; oacc[1][i] = 0.f; }
  float mrow = -INFINITY, lrow = 0.f;
  for (int kt = 0; kt < nkt; ++kt) {
    const int buf = kt & 1;
    if (kt + 1 < nkt) AT_DMA(buf ^ 1, kt + 1)
    const char* Kb = Ks + buf * 8192;
    const char* Vb = Vs + buf * 8192;
    f32x16 sacc[2];
#pragma unroll
    for (int i = 0; i < 16; ++i) { sacc[0][i] = 0.f; sacc[1][i] = 0.f; }
#pragma unroll
    for (int s = 0; s < 4; ++s) {
      const int co = ((2 * s + h) ^ xr) * 16;
      const s16x8 a0 = *(const s16x8*)(Kb + r * 128 + co);
      const s16x8 a1 = *(const s16x8*)(Kb + (32 + r) * 128 + co);
      sacc[0] = MFMA32(a0, qf[s], sacc[0]);
      sacc[1] = MFMA32(a1, qf[s], sacc[1]);
    }
    float mx = sacc[0][0];
#pragma unroll
    for (int i = 0; i < 16; ++i) { mx = fmaxf(mx, sacc[0][i]); mx = fmaxf(mx, sacc[1][i]); }
    mx = fmaxf(mx, __shfl_xor(mx, 32, 64));
    const float mnew = fmaxf(mrow, mx);
    const float alpha = __builtin_amdgcn_exp2f(mrow - mnew);
    mrow = mnew;
    float psum = 0.f;
#pragma unroll
    for (int i = 0; i < 16; ++i) {
      sacc[0][i] = __builtin_amdgcn_exp2f(sacc[0][i] - mnew); psum += sacc[0][i];
      sacc[1][i] = __builtin_amdgcn_exp2f(sacc[1][i] - mnew); psum += sacc[1][i];
    }
    lrow = lrow * alpha + psum;
#pragma unroll
    for (int i = 0; i < 16; ++i) { oacc[0][i] *= alpha; oacc[1][i] *= alpha; }
#pragma unroll
    for (int kt2 = 0; kt2 < 2; ++kt2)
#pragma unroll
      for (int s2 = 0; s2 < 2; ++s2) {
        u32x4 pu;
#pragma unroll
        for (int e = 0; e < 4; ++e) pu[e] = pack2(sacc[kt2][8 * s2 + 2 * e], sacc[kt2][8 * s2 + 2 * e + 1]);
        const s16x8 pf = __builtin_bit_cast(s16x8, pu);
        const int c0 = kt2 * 4 + 2 * s2;
        const int o0 = ((c0 ^ xr) * 16) + 8 * h, o1 = (((c0 + 1) ^ xr) * 16) + 8 * h;
#pragma unroll
        for (int dt = 0; dt < 2; ++dt) {
          const s16x4 lo = *(const s16x4*)(Vb + (dt * 32 + r) * 128 + o0);
          const s16x4 hi = *(const s16x4*)(Vb + (dt * 32 + r) * 128 + o1);
          const s16x8 a = __builtin_shufflevector(lo, hi, 0, 1, 2, 3, 4, 5, 6, 7);
          oacc[dt] = MFMA32(a, pf, oacc[dt]);
        }
      }
    asm volatile("s_waitcnt vmcnt(0)" ::: "memory");
    __syncthreads();
  }
#undef AT_DMA
  const float ltot = lrow + __shfl_xor(lrow, 32, 64);
  const float inv = 1.f / ltot;
  bf16* Op = (bf16*)(p.ws + OFF_OATT) + (size_t)(tok0 + w * 32 + r) * 256 + head * 64;
#pragma unroll
  for (int dt = 0; dt < 2; ++dt)
#pragma unroll
    for (int i = 0; i < 16; i += 4) {
      u32x2 uu;
      uu[0] = pack2(oacc[dt][i] * inv, oacc[dt][i + 1] * inv);
      uu[1] = pack2(oacc[dt][i + 2] * inv, oacc[dt][i + 3] * inv);
      *(u32x2*)(Op + dt * 32 + crow(i, h)) = uu;
    }
}

constexpr int GL_LOW = 0, GL_TOT = 4096, GL_DEC = 5120, GL_QIN = 5376, GL_KIN = 14592, GL_KET = 23808, GL_OST = 0,
              GL_VT = 33792, GL_ST = 52224;
static_assert(GL_ST + 128 * LDT * 2 <= SMEM_BYTES, "gla lds");

template <bool WITH_OUT>
DI void gla_unit(const Params& p, int l, int u, char* smem) {
  float* lowt = (float*)(smem + GL_LOW);
  float* tots = (float*)(smem + GL_TOT);
  float* decs = (float*)(smem + GL_DEC);
  bf16* qin = (bf16*)(smem + GL_QIN);
  bf16* kin = (bf16*)(smem + GL_KIN);
  bf16* ket = (bf16*)(smem + GL_KET);
  float* ost = (float*)(smem + GL_OST);
  bf16* vts = (bf16*)(smem + GL_VT);
  bf16* sts = (bf16*)(smem + GL_ST);
  const int tid = TIDX, lane = tid & 63, w = tid >> 6, r = lane & 31, h = lane >> 5;
  int b, hd, gi, dir0, ndir;
  if (WITH_OUT) { gi = u % NG33; hd = (u / NG33) & 3; b = u / (NG33 * 4); dir0 = 1; ndir = 2; }
  else { gi = u % NG33; const int v = u / NG33; dir0 = v & 1; hd = (v >> 1) & 3; b = v >> 3; ndir = 1; }
  const int dk = tid & 63, part = tid >> 6;
  const bf16* GQ = (const bf16*)(p.ws + OFF_GQ);
  const bf16* GK = (const bf16*)(p.ws + OFF_GK);
  const bf16* GVT = (const bf16*)(p.ws + OFF_GVT) + (size_t)(b * 4 + hd) * 128 * TT;
  const float* LOW = (const float*)(p.ws + OFF_LOW);
  for (int dd = 0; dd < ndir; ++dd) {
    const int dir = WITH_OUT ? (dir0 - dd) : dir0;
    float* GSu = (float*)(p.ws + OFF_GS) + ((size_t)((b * 4 + hd) * 2 + dir) * NG33 + gi) * 8192;
    float gwreg[16];
#pragma unroll
    for (int rr = 0; rr < 16; ++rr) gwreg[rr] = p.in[I_GGW][((size_t)(l * 2 + dir) * 16 + rr) * 256 + hd * 64 + dk];
    const float gb = p.in[I_GGB][(l * 2 + dir) * 256 + hd * 64 + dk];
    f32x16 sacc[2];
    if (WITH_OUT) {
#pragma unroll
      for (int dkt = 0; dkt < 2; ++dkt)
#pragma unroll
        for (int i = 0; i < 16; ++i) {
          const float v = GSu[(w * 32 + crow(i, h)) * 64 + dkt * 32 + r];
          sacc[dkt][i] = v;
          sts[(w * 32 + crow(i, h)) * LDT + dkt * 32 + r] = f2bf(v);
        }
    } else {
#pragma unroll
      for (int i = 0; i < 16; ++i) { sacc[0][i] = 0.f; sacc[1][i] = 0.f; }
    }
    float gtot = 0.f;
    for (int cc = 0; cc < 4; ++cc) {
      const int ci = dir ? 3 - cc : cc;
      const int tb = gi * 256 + ci * 64;
      const size_t tokb = (size_t)b * TT + tb;
      {
        const int row = tid >> 2, c4 = (tid & 3) * 4;
        const u32x4 lw = ldg16(LOW + (tokb + row) * 32 + dir * 16 + c4);
        u32x4 vv[4], kq[2], qq[2];
#pragma unroll
        for (int i = 0; i < 4; ++i) {
          const int c = tid + 256 * i, e = c >> 3, k8 = (c & 7) * 8;
          vv[i] = ldg16(GVT + (size_t)e * TT + tb + k8);
        }
#pragma unroll
        for (int i = 0; i < 2; ++i) {
          const int c = tid + 256 * i, rw = c >> 3, k8 = (c & 7) * 8;
          kq[i] = ldg16(GK + (tokb + rw) * 256 + hd * 64 + k8);
          if (WITH_OUT) qq[i] = ldg16(GQ + (tokb + rw) * 256 + hd * 64 + k8);
        }
        *(u32x4*)(lowt + row * 16 + c4) = lw;
#pragma unroll
        for (int i = 0; i < 4; ++i) {
          const int c = tid + 256 * i, e = c >> 3, k8 = (c & 7) * 8;
          *(u32x4*)(vts + e * LDT + k8) = vv[i];
        }
#pragma unroll
        for (int i = 0; i < 2; ++i) {
          const int c = tid + 256 * i, rw = c >> 3, k8 = (c & 7) * 8;
          *(u32x4*)(kin + rw * LDT + k8) = kq[i];
          if (WITH_OUT) *(u32x4*)(qin + rw * LDT + k8) = qq[i];
        }
      }
      __syncthreads();
      float cum = 0.f;
#pragma unroll 2
      for (int ii = 0; ii < 16; ++ii) {
        const int pos = part * 16 + ii, t = dir ? 63 - pos : pos;
        float z = gb;
#pragma unroll
        for (int rr = 0; rr < 16; ++rr) z += lowt[t * 16 + rr] * gwreg[rr];
        cum += (fminf(z, 0.f) - log1pf(__expf(-fabsf(z)))) * (1.f / 16.f);
      }
      tots[part * 64 + dk] = cum;
      __syncthreads();
      float offs = 0.f, total = 0.f;
#pragma unroll
      for (int pp = 0; pp < 4; ++pp) { const float tv = tots[pp * 64 + dk]; total += tv; if (pp < part) offs += tv; }
      if (part == 0) decs[dk] = __expf(total);
      gtot += total;
      float bq = offs;
#pragma unroll 2
      for (int ii = 0; ii < 16; ++ii) {
        const int pos = part * 16 + ii, t = dir ? 63 - pos : pos;
        float z = gb;
#pragma unroll
        for (int rr = 0; rr < 16; ++rr) z += lowt[t * 16 + rr] * gwreg[rr];
        bq += (fminf(z, 0.f) - log1pf(__expf(-fabsf(z)))) * (1.f / 16.f);
        const float kv = bf2f(kin[t * LDT + dk]);
        ket[dk * LDT + t] = f2bf(kv * __expf(total - bq));
        if (WITH_OUT) {
          const float qv = bf2f(qin[t * LDT + dk]);
          qin[t * LDT + dk] = f2bf(qv * __expf(bq));
          kin[t * LDT + dk] = f2bf(kv * __expf(-bq));
        }
      }
      __syncthreads();
      f32x16 oo[2];
      const int it = w & 1, ep = w >> 1;
      if (WITH_OUT) {
        const int ti = w >> 1, tj = w & 1;
        f32x16 aa;
#pragma unroll
        for (int i = 0; i < 16; ++i) aa[i] = 0.f;
#pragma unroll
        for (int s = 0; s < 4; ++s) {
          const s16x8 A = *(const s16x8*)(qin + (ti * 32 + r) * LDT + s * 16 + h * 8);
          const s16x8 Bv = *(const s16x8*)(kin + (tj * 32 + r) * LDT + s * 16 + h * 8);
          aa = MFMA32(A, Bv, aa);
        }
        __syncthreads();
#pragma unroll
        for (int i = 0; i < 16; ++i) {
          const int qi = ti * 32 + crow(i, h), kj = tj * 32 + r;
          const bool keep = dir ? (kj >= qi) : (kj <= qi);
          kin[qi * LDT + kj] = f2bf(keep ? aa[i] : 0.f);
        }
        __syncthreads();
#pragma unroll
        for (int i = 0; i < 16; ++i) { oo[0][i] = 0.f; oo[1][i] = 0.f; }
#pragma unroll
        for (int s = 0; s < 4; ++s) {
          const s16x8 A1 = *(const s16x8*)(kin + (it * 32 + r) * LDT + s * 16 + h * 8);
          const s16x8 A2 = *(const s16x8*)(qin + (it * 32 + r) * LDT + s * 16 + h * 8);
#pragma unroll
          for (int x = 0; x < 2; ++x) {
            const int et = 2 * ep + x;
            const s16x8 B1 = *(const s16x8*)(vts + (et * 32 + r) * LDT + s * 16 + h * 8);
            const s16x8 B2 = *(const s16x8*)(sts + (et * 32 + r) * LDT + s * 16 + h * 8);
            oo[x] = MFMA32(A1, B1, oo[x]);
            oo[x] = MFMA32(A2, B2, oo[x]);
          }
        }
      }
#pragma unroll
      for (int dkt = 0; dkt < 2; ++dkt) {
        const float dv = decs[dkt * 32 + r];
#pragma unroll
        for (int i = 0; i < 16; ++i) sacc[dkt][i] *= dv;
      }
#pragma unroll
      for (int s = 0; s < 4; ++s) {
        const s16x8 A = *(const s16x8*)(vts + (w * 32 + r) * LDT + s * 16 + h * 8);
#pragma unroll
        for (int dkt = 0; dkt < 2; ++dkt) {
          const s16x8 Bv = *(const s16x8*)(ket + (dkt * 32 + r) * LDT + s * 16 + h * 8);
          sacc[dkt] = MFMA32(A, Bv, sacc[dkt]);
        }
      }
      __syncthreads();
      if (WITH_OUT) {
#pragma unroll
        for (int dkt = 0; dkt < 2; ++dkt)
#pragma unroll
          for (int i = 0; i < 16; ++i) sts[(w * 32 + crow(i, h)) * LDT + dkt * 32 + r] = f2bf(sacc[dkt][i]);
#pragma unroll
        for (int x = 0; x < 2; ++x)
#pragma unroll
          for (int i = 0; i < 16; ++i) ost[(it * 32 + crow(i, h)) * CLD + (2 * ep + x) * 32 + r] = oo[x][i];
        __syncthreads();
        const int row = tid >> 2, qd = tid & 3;
        const size_t tok = tokb + row;
        bf16* og = (bf16*)(p.ws + OFF_OGLA) + tok * 512 + hd * 128 + qd * 32;
        const float* os = ost + row * CLD + qd * 32;
        if (dir == 1) {
#pragma unroll
          for (int i = 0; i < 4; ++i) {
            u32x4 uu;
#pragma unroll
            for (int e = 0; e < 4; ++e) uu[e] = pack2(os[i * 8 + 2 * e], os[i * 8 + 2 * e + 1]);
            *(u32x4*)(og + i * 8) = uu;
          }
        } else {
          float ss = 0.f;
#pragma unroll 1
          for (int i = 0; i < 4; ++i) {
            const u32x4 uu = *(const u32x4*)(og + i * 8);
#pragma unroll
            for (int e = 0; e < 4; ++e) {
              const float a0 = os[i * 8 + 2 * e] + bflo(uu[e]), a1 = os[i * 8 + 2 * e + 1] + bfhi(uu[e]);
              ss += a0 * a0 + a1 * a1;
            }
          }
          ss += __shfl_xor(ss, 1, 64);
          ss += __shfl_xor(ss, 2, 64);
          const float rstd = rsqrtf(ss * (1.f / 128.f) + EPSF);
          const float* gn = p.in[I_GON] + l * 128 + qd * 32;
          const bf16* gr = (const bf16*)(p.ws + OFF_GR) + tok * 512 + hd * 128 + qd * 32;
#pragma unroll 1
          for (int i = 0; i < 4; ++i) {
            const u32x4 uo = *(const u32x4*)(og + i * 8);
            const u32x4 ug = *(const u32x4*)(gr + i * 8);
            u32x4 uu;
#pragma unroll
            for (int e = 0; e < 4; ++e) {
              const float v0 = os[i * 8 + 2 * e] + bflo(uo[e]), v1 = os[i * 8 + 2 * e + 1] + bfhi(uo[e]);
              const float a0 = v0 * rstd * gn[i * 8 + 2 * e] * siluf_(bflo(ug[e]));
              const float a1 = v1 * rstd * gn[i * 8 + 2 * e + 1] * siluf_(bfhi(ug[e]));
              uu[e] = pack2(a0, a1);
            }
            *(u32x4*)(og + i * 8) = uu;
          }
        }
        __syncthreads();
      }
    }
    if (!WITH_OUT) {
#pragma unroll
      for (int dkt = 0; dkt < 2; ++dkt)
#pragma unroll
        for (int i = 0; i < 16; ++i) GSu[(w * 32 + crow(i, h)) * 64 + dkt * 32 + r] = sacc[dkt][i];
      if (part == 0) ((float*)(p.ws + OFF_DECG))[((size_t)((b * 4 + hd) * 2 + dir) * NG33 + gi) * 64 + dk] = __expf(gtot);
    }
    __syncthreads();
  }
}

DI void gla_scan_job(const Params& p, int j) {
  const int idx = j * 256 + TIDX;
  const int seq = idx >> 13, el = idx & 8191, dk = el & 63, dir = seq & 1;
  float* GS = (float*)(p.ws + OFF_GS) + (size_t)seq * NG33 * 8192 + el;
  const float* DG = (const float*)(p.ws + OFF_DECG) + (size_t)seq * NG33 * 64 + dk;
  float s = 0.f;
  for (int st0 = 0; st0 < 33; st0 += 11) {
    float kv[11], dc[11];
#pragma unroll
    for (int q = 0; q < 11; ++q) {
      const int st = st0 + q;
      const int g = (dir == 0 || st == 0) ? st : 33 - st;
      kv[q] = GS[(size_t)g * 8192];
      dc[q] = DG[g * 64];
    }
#pragma unroll
    for (int q = 0; q < 11; ++q) {
      const int st = st0 + q;
      const int g = (dir == 0 || st == 0) ? st : 33 - st;
      GS[(size_t)g * 8192] = s;
      s = dc[q] * s + kv[q];
    }
  }
}

DI void s5_end_tile(const Params& p, int j, char* smem) {
  const int nt = j & 1, mt = (j >> 1) % 9, g = j / 18;
  const bf16* SU = (const bf16*)(p.ws + OFF_SU);
  const bf16* F = (const bf16*)(p.ws + OFF_F5) + ((size_t)g * 256 + nt * 128) * 512;
  f32x16 acc[2][2];
  acc_zero(acc);
  gemm_main_dma(acc,
            [&](int r) -> const bf16* {
              const int m = mt * 128 + r;
              if (m >= MS5) return (const bf16*)(p.ws + OFF_ZERO);
              const int b = m / NCH, ch = m - b * NCH;
              return SU + ((size_t)(b * 16 + g) * TT + ch * 32) * 16;
            },
            [&](int r) { return F + (size_t)r * 512; }, 512, smem);
  float* Cs = (float*)smem;
  acc_to_lds(acc, Cs);
  __syncthreads();
  float* EN = (float*)(p.ws + OFF_EN);
  for (int c = TIDX; c < 128 * 32; c += 256) {
    const int row = c >> 5, c4 = (c & 31) * 4, m = mt * 128 + row;
    if (m < MS5) {
      const float* s = Cs + row * CLD + c4;
      f32x4 v = {s[0], s[1], s[2], s[3]};
      *(f32x4*)(EN + ((size_t)m * 16 + g) * 256 + nt * 128 + c4) = v;
    }
  }
  __syncthreads();
}

DI void s5_scan_job(const Params& p, int l, int j, char* smem) {
  float2* ends = (float2*)smem;
  const int dir = j & 1, g = (j >> 1) & 15, b = j >> 5;
  const int pp = TIDX & 63, seg = TIDX >> 6;
  const float2 aL = ((const float2*)(p.ws + OFF_PWR))[((size_t)((l * 2 + dir) * 16 + g) * 33 + 32) * 64 + pp];
  const float* EN = (const float*)(p.ws + OFF_EN);
  bf16* SB = (bf16*)(p.ws + OFF_SB);
  float sr = 0.f, si = 0.f;
  for (int q0 = 0; q0 < 66; q0 += 11) {
    float er[11], ei[11];
#pragma unroll
    for (int q = 0; q < 11; ++q) {
      const int pos = seg * 66 + q0 + q;
      const int ch = dir ? (pos < 8 ? 7 - pos : 271 - pos) : pos;
      const float* e = EN + ((size_t)(b * NCH + ch) * 16 + g) * 256 + dir * 128 + pp;
      er[q] = e[0]; ei[q] = e[64];
    }
#pragma unroll
    for (int q = 0; q < 11; ++q) {
      const float nr = aL.x * sr - aL.y * si + er[q], ni = aL.x * si + aL.y * sr + ei[q];
      sr = nr; si = ni;
    }
  }
  ends[seg * 64 + pp] = make_float2(sr, si);
  float pr = 1.f, pi = 0.f;
  for (int q = 0; q < 66; ++q) { const float nr = pr * aL.x - pi * aL.y, ni = pr * aL.y + pi * aL.x; pr = nr; pi = ni; }
  __syncthreads();
  sr = 0.f; si = 0.f;
  for (int k = 0; k < seg; ++k) {
    const float2 e = ends[k * 64 + pp];
    const float nr = pr * sr - pi * si + e.x, ni = pr * si + pi * sr + e.y;
    sr = nr; si = ni;
  }
  for (int q0 = 0; q0 < 66; q0 += 11) {
    float er[11], ei[11];
#pragma unroll
    for (int q = 0; q < 11; ++q) {
      const int pos = seg * 66 + q0 + q;
      const int ch = dir ? (pos < 8 ? 7 - pos : 271 - pos) : pos;
      const float* e = EN + ((size_t)(b * NCH + ch) * 16 + g) * 256 + dir * 128 + pp;
      er[q] = e[0]; ei[q] = e[64];
    }
#pragma unroll
    for (int q = 0; q < 11; ++q) {
      const int pos = seg * 66 + q0 + q;
      const int ch = dir ? (pos < 8 ? 7 - pos : 271 - pos) : pos;
      bf16* sb = SB + ((size_t)(b * NCH + ch) * 16 + g) * 256 + dir * 128 + pp;
      sb[0] = f2bf(sr); sb[64] = f2bf(si);
      const float nr = aL.x * sr - aL.y * si + er[q], ni = aL.x * si + aL.y * sr + ei[q];
      sr = nr; si = ni;
    }
  }
  __syncthreads();
}

DI float gelu_tanh(float x) {
  const float u = 0.7978845608028654f * (x + 0.044715f * x * x * x);
  return 0.5f * x * (1.f + tanhf(u));
}

DI void s5_out_tile(const Params& p, int j, char* smem) {
  const int nt = j & 3, mt = (j >> 2) % 9, g = j / 36;
  const bf16* SU = (const bf16*)(p.ws + OFF_SU);
  const bf16* SB = (const bf16*)(p.ws + OFF_SB);
  const bf16* Tm = (const bf16*)(p.ws + OFF_T5) + ((size_t)g * 512 + nt * 128) * 512;
  const bf16* Em = (const bf16*)(p.ws + OFF_E5) + ((size_t)g * 512 + nt * 128) * 256;
  f32x16 acc[2][2];
  acc_zero(acc);
  gemm_main_dma(acc,
            [&](int r) -> const bf16* {
              const int m = mt * 128 + r;
              if (m >= MS5) return (const bf16*)(p.ws + OFF_ZERO);
              const int b = m / NCH, ch = m - b * NCH;
              return SU + ((size_t)(b * 16 + g) * TT + ch * 32) * 16;
            },
            [&](int r) { return Tm + (size_t)r * 512; }, 512, smem);
  gemm_main_dma(acc,
            [&](int r) -> const bf16* {
              const int m = mt * 128 + r;
              if (m >= MS5) return (const bf16*)(p.ws + OFF_ZERO);
              return SB + ((size_t)m * 16 + g) * 256;
            },
            [&](int r) { return Em + (size_t)r * 256; }, 256, smem);
  float* Cs = (float*)smem;
  acc_to_lds(acc, Cs);
  __syncthreads();
  bf16* Y5 = (bf16*)(p.ws + OFF_Y5);
  for (int c = TIDX; c < 2048; c += 256) {
    const int row = c >> 4, c8 = c & 15, m = mt * 128 + row;
    if (m < MS5) {
      const int b = m / NCH, ch = m - b * NCH;
      const int n = nt * 128 + c8 * 8, i = n >> 4, hh = n & 15;
      const float* s = Cs + row * CLD + c8 * 8;
      u32x4 u;
#pragma unroll
      for (int e = 0; e < 4; ++e) u[e] = pack2(gelu_tanh(s[2 * e]), gelu_tanh(s[2 * e + 1]));
      *(u32x4*)(Y5 + ((size_t)b * TT + ch * 32 + i) * 256 + g * 16 + hh) = u;
    }
  }
  __syncthreads();
}

DI void glu_tile(const Params& p, int l, int j, char* smem) {
  const int nt = j & 1, mt = j >> 1;
  const bf16* Y5 = (const bf16*)(p.ws + OFF_Y5) + (size_t)mt * 128 * 256;
  const bf16* W = wl(p, l, WL_GLU) + (size_t)nt * 128 * 256;
  f32x16 acc[2][2];
  acc_zero(acc);
  gemm_main_dma(acc, [&](int r) { return Y5 + (size_t)r * 256; }, [&](int r) { return W + (size_t)r * 256; }, 256, smem);
  float* Cs = (float*)smem;
  acc_to_lds(acc, Cs);
  __syncthreads();
  const float* gb = p.in[I_GLUB] + l * 256 + nt * 128;
  bf16* O = (bf16*)(p.ws + OFF_OS5) + (size_t)mt * 128 * 256 + nt * 128;
  for (int c = TIDX; c < 2048; c += 256) {
    const int row = c >> 4, cc = (c & 15) * 8;
    const float* s = Cs + row * CLD + cc;
    const u32x4 yu = *(const u32x4*)(Y5 + (size_t)row * 256 + nt * 128 + cc);
    u32x4 u;
#pragma unroll
    for (int e = 0; e < 4; ++e) {
      const float y0 = bflo(yu[e]), y1 = bfhi(yu[e]);
      u[e] = pack2(y0 * sigmoidf_(s[2 * e] + gb[cc + 2 * e]), y1 * sigmoidf_(s[2 * e + 1] + gb[cc + 2 * e + 1]));
    }
    *(u32x4*)(O + (size_t)row * 256 + cc) = u;
  }
  __syncthreads();
}

DI void merge_tile(const Params& p, int l, int j, char* smem) {
  const int nt = j & 7, mt = j >> 3;
  const bf16* H = (const bf16*)(p.ws + OFF_H) + (size_t)mt * 128 * DM;
  unsigned am[2][2][8];
#pragma unroll
  for (int a = 0; a < 2; ++a)
#pragma unroll
    for (int bq = 0; bq < 2; ++bq)
#pragma unroll
      for (int i = 0; i < 8; ++i) am[a][bq][i] = 0u;
#pragma unroll 1
  for (int x = 0; x < 3; ++x) {
    const bf16* Wg = wl(p, l, WL_WIN) + ((size_t)2432 + x * 1024 + nt * 128) * DM;
    unsigned sg[2][2][8];
    {
      f32x16 acc[2][2];
      acc_zero(acc);
      gemm_main_dma(acc, [&](int r) { return H + (size_t)r * DM; }, [&](int r) { return Wg + (size_t)r * DM; }, DM, smem);
#pragma unroll
      for (int a = 0; a < 2; ++a)
#pragma unroll
        for (int bq = 0; bq < 2; ++bq)
#pragma unroll
          for (int i = 0; i < 8; ++i) sg[a][bq][i] = pack2(sigmoidf_(acc[a][bq][2 * i]), sigmoidf_(acc[a][bq][2 * i + 1]));
    }
    const bf16* A; const bf16* Wb; int K;
    if (x == 0) { A = (const bf16*)(p.ws + OFF_OATT) + (size_t)mt * 128 * 256; Wb = wl(p, l, WL_BRA) + (size_t)nt * 128 * 256; K = 256; }
    else if (x == 1) { A = (const bf16*)(p.ws + OFF_OGLA) + (size_t)mt * 128 * 512; Wb = wl(p, l, WL_BRG) + (size_t)nt * 128 * 512; K = 512; }
    else { A = (const bf16*)(p.ws + OFF_OS5) + (size_t)mt * 128 * 256; Wb = wl(p, l, WL_BRS) + (size_t)nt * 128 * 256; K = 256; }
#pragma unroll
    for (int hf = 0; hf < 2; ++hf) {
      f32x16 a2[2];
#pragma unroll
      for (int i = 0; i < 16; ++i) { a2[0][i] = 0.f; a2[1][i] = 0.f; }
      gemm_main_dma_half(a2, A, K, Wb, K, K, hf, smem);
#pragma unroll
      for (int a = 0; a < 2; ++a)
#pragma unroll
        for (int i = 0; i < 8; ++i) {
          const float v0 = bflo(am[a][hf][i]) + bflo(sg[a][hf][i]) * a2[a][2 * i];
          const float v1 = bfhi(am[a][hf][i]) + bfhi(sg[a][hf][i]) * a2[a][2 * i + 1];
          am[a][hf][i] = pack2(v0, v1);
        }
    }
  }
  f32x16 accm[2][2];
#pragma unroll
  for (int a = 0; a < 2; ++a)
#pragma unroll
    for (int bq = 0; bq < 2; ++bq)
#pragma unroll
      for (int i = 0; i < 8; ++i) { accm[a][bq][2 * i] = bflo(am[a][bq][i]); accm[a][bq][2 * i + 1] = bfhi(am[a][bq][i]); }
  float* Cs = (float*)smem;
  acc_to_lds(accm, Cs);
  __syncthreads();
  store_tile_bf16(Cs, (bf16*)(p.ws + OFF_MG) + (size_t)mt * 128 * DM + nt * 128, DM, 128, 1.f);
  __syncthreads();
}

DI void plain_tile(const bf16* A, int K, const bf16* W, bf16* dst, int ldd, char* smem) {
  f32x16 acc[2][2];
  acc_zero(acc);
  gemm_main_dma(acc, [&](int r) { return A + (size_t)r * K; }, [&](int r) { return W + (size_t)r * K; }, K, smem);
  float* Cs = (float*)smem;
  acc_to_lds(acc, Cs);
  __syncthreads();
  store_tile_bf16(Cs, dst, ldd, 128, 1.f);
  __syncthreads();
}

DI void plain_wide(const bf16* A, int K, const bf16* W, bf16* dst, int ldd, char* smem) {
  f32x16 acc[2][4];
  accw_zero(acc);
  gemm_wide(acc, [&](int r) { return A + (size_t)r * K; }, [&](int r) { return W + (size_t)r * K; }, K, smem);
  float* Cs = (float*)smem;
  accw_to_lds<0>(acc, Cs);
  __syncthreads();
  store_tile_bf16(Cs, dst, ldd, 128, 1.f);
  __syncthreads();
  accw_to_lds<1>(acc, Cs);
  __syncthreads();
  store_tile_bf16(Cs, dst + 128, ldd, 128, 1.f);
  __syncthreads();
}

DI void up_epi(const Params& p, int l, int jn, int seqbase, int len, int pos0, char* smem) {
  float* Cs = (float*)smem;
  const float* cw = p.in[I_CW] + (size_t)l * 3 * 2 * DFF;
  const float* cb = p.in[I_CB] + (size_t)l * 2 * DFF;
  bf16* G = (bf16*)(p.ws + OFF_G);
  const int tid = TIDX;
  const int c = (tid & 31) * 2;
  float wa[2][3], wv[2][3], ba[2], bv[2];
#pragma unroll
  for (int e = 0; e < 2; ++e) {
    const int ca = jn * 64 + c + e, cv = DFF + ca;
#pragma unroll
    for (int k = 0; k < 3; ++k) { wa[e][k] = cw[k * 2 * DFF + ca]; wv[e][k] = cw[k * 2 * DFF + cv]; }
    ba[e] = cb[ca]; bv[e] = cb[cv];
  }
#pragma unroll 4
  for (int rr = 1 + (tid >> 5); rr < 127; rr += 8) {
    const int pos = pos0 + rr;
    if (pos < len) {
      float gv[2];
#pragma unroll
      for (int e = 0; e < 2; ++e) {
        const float a = wa[e][0] * Cs[(rr - 1) * CLD + c + e] + wa[e][1] * Cs[rr * CLD + c + e] + wa[e][2] * Cs[(rr + 1) * CLD + c + e] + ba[e];
        const float v = wv[e][0] * Cs[(rr - 1) * CLD + 64 + c + e] + wv[e][1] * Cs[rr * CLD + 64 + c + e] +
                        wv[e][2] * Cs[(rr + 1) * CLD + 64 + c + e] + bv[e];
        gv[e] = siluf_(a) * v;
      }
      *(unsigned*)(G + (size_t)(seqbase + pos) * DFF + jn * 64 + c) = pack2(gv[0], gv[1]);
    }
  }
  __syncthreads();
}

DI void up_wide(const Params& p, int l, int mtile, int jp, char* smem) {
  const int b = mtile / 69, rr0 = mtile % 69;
  int seqbase, len, ti;
  if (rr0 < 3) { seqbase = b * TT; len = CTXL; ti = rr0; }
  else { seqbase = b * TT + CTXL; len = SEQ; ti = rr0 - 3; }
  const int pos0 = ti * 126 - 1;
  const bf16* H = (const bf16*)(p.ws + OFF_H);
  const bf16* W = wl(p, l, WL_UP) + (size_t)jp * 256 * DM;
  f32x16 acc[2][4];
  accw_zero(acc);
  gemm_wide(acc,
            [&](int r) -> const bf16* {
              const int pos = pos0 + r;
              return (pos >= 0 && pos < len) ? H + (size_t)(seqbase + pos) * DM : (const bf16*)(p.ws + OFF_ZERO);
            },
            [&](int r) { return W + (size_t)r * DM; }, DM, smem);
  float* Cs = (float*)smem;
  accw_to_lds<0>(acc, Cs);
  __syncthreads();
  up_epi(p, l, jp * 2, seqbase, len, pos0, smem);
  accw_to_lds<1>(acc, Cs);
  __syncthreads();
  up_epi(p, l, jp * 2 + 1, seqbase, len, pos0, smem);
}

DI bool gemm_job(int bid, int G, int it, int MT, int NTL, int& mt, int& nt, int CW = 8) {
  const int x = bid & 7, q = bid >> 3, Q = G >> 3;
  const int m0 = (x * MT) >> 3, m1 = ((x + 1) * MT) >> 3, Mx = m1 - m0;
  const int jl = q + Q * it;
  if (jl >= Mx * NTL) return false;
  const int full = Mx * CW;
  const int c = jl / full, rem = jl - c * full;
  const int wc = min(CW, NTL - CW * c);
  const int mi = rem / wc;
  mt = m0 + mi;
  nt = CW * c + (rem - mi * wc);
  return true;
}

enum { PH_PREP = 0, PH_ROW0, PH_PROJ, PH_MIX1, PH_SCAN, PH_MIX2, PH_GLU, PH_MERGE, PH_WOUT, PH_ROW1, PH_UP, PH_DOWN, PH_ROW2 };
constexpr int N_PHASES = 2 + 11 * NL;

DI void run_phase(const Params& p, int ph, int l, char* smem) {
  const int bid = blockIdx.x;
#ifdef HALFMASK
  const int G = ((HALFMASK >> ph) & 1) ? 256 : gridDim.x;
  if (bid >= G) return;
#else
  const int G = gridDim.x;
#endif
#ifdef PHMASK
  if (!((PHMASK >> ph) & 1)) return;
#endif
  switch (ph) {
    case PH_PREP:
      if (bid < 8) { for (int i = TIDX; i < 512; i += 256) ((u32x4*)(p.ws + OFF_ZERO))[i] = u32x4{0u, 0u, 0u, 0u}; }
      for (int j = bid; j < 128 + 16064; j += G) {
        if (j < 96) prep_mod_job(p, j, smem);
        else if (j < 128) prep_s5_job(p, j - 96);
        else prep_wt_job(p, j - 128, smem);
      }
      break;
    case PH_ROW0:
      row_phase<0>(p, 0, bid, G);
      ktab_phase(p, bid, G);
      break;
    case PH_PROJ:
#ifdef EXP_A
      if (bid < 256) { int mt, nt; for (int it = 0; gemm_job(bid, 256, it, 264, 10, mt, nt, 4); ++it) proj_wide(p, l, mt, nt, smem); }
      s5mat_phase(p, l, bid, G);
#elif defined(EXP_C)
      if (bid < 256) for (int j = bid; j < 264 * 19; j += 256) { if ((EXP_C >> (j % 19)) & 1) proj_tile(p, l, j / 19, j % 19, smem); }
      for (int j = bid; j < 264 * 19; j += G) { if (!((EXP_C >> (j % 19)) & 1)) proj_tile(p, l, j / 19, j % 19, smem); }
      s5mat_phase(p, l, bid, G);
#elif defined(EXP_B)
      for (int j = bid; j < 264 * 19; j += G) proj_tile(p, l, j / 19, j % 19, smem);
      if (bid < 256) s5mat_phase(p, l, bid, 256);
#else
      for (int j = bid; j < 264 * 19; j += G) proj_tile(p, l, j / 19, j % 19, smem);
      s5mat_phase(p, l, bid, G);
#endif
      break;
    case PH_MIX1:
      for (int j = bid; j < 1056 + 1056 + 288; j += G) {
        if (j < 1056) attn_unit(p, j, smem);
        else if (j < 2112) gla_unit<false>(p, l, j - 1056, smem);
        else s5_end_tile(p, j - 2112, smem);
      }
      break;
    case PH_SCAN:
      for (int j = bid; j < 1024 + 128; j += G) {
        if (j < 1024) gla_scan_job(p, j);
        else s5_scan_job(p, l, j - 1024, smem);
      }
      break;
    case PH_MIX2:
      for (int j = bid; j < 528 + 576; j += G) {
        if (j < 528) gla_unit<true>(p, l, j, smem);
        else s5_out_tile(p, j - 528, smem);
      }
      break;
    case PH_GLU:
      { int mt, nt; for (int it = 0; gemm_job(bid, G, it, 264, 2, mt, nt); ++it) glu_tile(p, l, mt * 2 + nt, smem); }
      break;
    case PH_MERGE:
      { int mt, nt; for (int it = 0; gemm_job(bid, G, it, 264, 8, mt, nt); ++it) merge_tile(p, l, mt * 8 + nt, smem); }
      break;
    case PH_WOUT:
      for (int it = 0;; ++it) {
        int mt, nt;
        if (!gemm_job(bid, G, it, 264, 4, mt, nt, 4)) break;
        plain_wide((const bf16*)(p.ws + OFF_MG) + (size_t)mt * 128 * DM, DM, wl(p, l, WL_WOUT) + (size_t)nt * 256 * DM,
                   (bf16*)(p.ws + OFF_H) + (size_t)mt * 128 * DM + nt * 256, DM, smem);
      }
      break;
    case PH_ROW1: row_phase<1>(p, l, bid, G); break;
    case PH_UP:
      { int mt, nt; for (int it = 0; gemm_job(bid, G, it, 276, 22, mt, nt, 4); ++it) up_wide(p, l, mt, nt, smem); }
      break;
    case PH_DOWN:
      for (int it = 0;; ++it) {
        int mt, nt;
        if (!gemm_job(bid, G, it, 264, 4, mt, nt, 4)) break;
        plain_wide((const bf16*)(p.ws + OFF_G) + (size_t)mt * 128 * DFF, DFF, wl(p, l, WL_DOWN) + (size_t)nt * 256 * DFF,
                   (bf16*)(p.ws + OFF_H) + (size_t)mt * 128 * DM + nt * 256, DM, smem);
      }
      break;
    case PH_ROW2: row_phase<2>(p, l, bid, G); break;
  }
}

DI void grid_barrier(unsigned* bar, unsigned& gen) {
  asm volatile("s_waitcnt vmcnt(0)" ::: "memory");
  __syncthreads();
  gen += 1;
  if (threadIdx.x == 0) {
    __builtin_amdgcn_fence(__ATOMIC_RELEASE, "agent");
    asm volatile("s_waitcnt vmcnt(0)" ::: "memory");
    const unsigned target = gen * gridDim.x;
    __hip_atomic_fetch_add(bar, 1u, __ATOMIC_RELAXED, __HIP_MEMORY_SCOPE_AGENT);
    while (__hip_atomic_load(bar, __ATOMIC_RELAXED, __HIP_MEMORY_SCOPE_AGENT) < target) __builtin_amdgcn_s_sleep(2);
  }
  __syncthreads();
  __builtin_amdgcn_fence(__ATOMIC_ACQUIRE, "agent");
  asm volatile("s_waitcnt vmcnt(0)" ::: "memory");
}

__global__ void __launch_bounds__(256, 2) hybrid_fwd(Params p, int ph_lo, int ph_hi) {
  extern __shared__ __attribute__((aligned(16))) char smem[];
  unsigned* bar = (unsigned*)(p.ws + OFF_BAR);
  unsigned gen = 0;
  if (ph_hi - ph_lo > 1) cg::this_grid().sync();
  int i = 0;
#define STEP(PH, L)                                      \
  {                                                      \
    if (i >= ph_lo && i < ph_hi) {                       \
      Params q;                                          \
      q.ws = p.ws; q.out = p.out;                        \
      asm volatile("" : "+s"(q.ws), "+s"(q.out));        \
      _Pragma("unroll") for (int k = 0; k < 34; ++k) { q.in[k] = p.in[k]; asm volatile("" : "+s"(q.in[k])); } \
      run_phase(q, PH, L, smem);                         \
      if ((DUPMASK >> (PH)) & 1) { grid_barrier(bar, gen); run_phase(q, PH, L, smem); } \
      if (i + 1 < ph_hi) grid_barrier(bar, gen);         \
    }                                                    \
    ++i;                                                 \
  }
  STEP(PH_PREP, 0)
  STEP(PH_ROW0, 0)
#pragma unroll 1
  for (int l = 0; l < NL; ++l) {
    STEP(PH_PROJ, l)
    STEP(PH_MIX1, l)
    STEP(PH_SCAN, l)
    STEP(PH_MIX2, l)
    STEP(PH_GLU, l)
    STEP(PH_MERGE, l)
    STEP(PH_WOUT, l)
    STEP(PH_ROW1, l)
    STEP(PH_UP, l)
    STEP(PH_DOWN, l)
    STEP(PH_ROW2, l)
  }
#undef STEP
}

extern "C" void kernel_launch(void* const* d_in, const int* in_sizes, int n_in, void* d_out, int out_size, void* d_ws, size_t ws_size,
                              hipStream_t stream) {
  static int grid_blocks = 0;
  if (!grid_blocks) {
    int dev = 0, cus = 0, per_cu = 0;
    hipGetDevice(&dev);
    hipDeviceGetAttribute(&cus, hipDeviceAttributeMultiprocessorCount, dev);
    hipFuncSetAttribute((const void*)hybrid_fwd, hipFuncAttributeMaxDynamicSharedMemorySize, SMEM_BYTES);
    hipOccupancyMaxActiveBlocksPerMultiprocessor(&per_cu, hybrid_fwd, 256, SMEM_BYTES);
    if (per_cu < 1) per_cu = 1;
    if (per_cu > 2) per_cu = 2;
    grid_blocks = cus * per_cu;
    if (ws_size < OFF_ZERO + 8192) fprintf(stderr, "workspace too small: %zu < %zu\n", ws_size, (size_t)OFF_END);
  }
  Params p{};
  for (int i = 0; i < 34; ++i) p.in[i] = (const float*)d_in[i];
  p.out = (float*)d_out;
  p.ws = (char*)d_ws;
#if ONE_LAUNCH
  hipMemsetAsync((char*)d_ws + OFF_BAR, 0, 256, stream);
  int lo = 0, hi = N_PHASES;
  void* args[] = {&p, &lo, &hi};
  hipError_t e = hipLaunchCooperativeKernel((void*)hybrid_fwd, dim3(grid_blocks), dim3(256), args, SMEM_BYTES, stream);
  if (e != hipSuccess) fprintf(stderr, "cooperative launch failed: %s (grid %d)\n", hipGetErrorString(e), grid_blocks);
#else
  for (int i = 0; i < N_PHASES; ++i) hipLaunchKernelGGL(hybrid_fwd, dim3(grid_blocks), dim3(256), SMEM_BYTES, stream, p, i, i + 1);
#endif
}
```

```cpp
#include <hip/hip_runtime.h>
#include <hip/hip_cooperative_groups.h>
#include <stdint.h>
#include <cstdio>
namespace cg = cooperative_groups;

#define EXP_A 1
#ifndef DUPMASK
#define DUPMASK 0
#endif
#ifndef ONE_LAUNCH
#define ONE_LAUNCH 1
#endif

typedef unsigned short bf16;
typedef __attribute__((ext_vector_type(8))) short s16x8;
typedef __attribute__((ext_vector_type(4))) short s16x4;
typedef __attribute__((ext_vector_type(16))) float f32x16;
typedef __attribute__((ext_vector_type(4))) float f32x4;
typedef __attribute__((ext_vector_type(2))) float f32x2;
typedef __attribute__((ext_vector_type(4))) unsigned u32x4;
typedef __attribute__((ext_vector_type(2))) unsigned u32x2;
typedef __attribute__((ext_vector_type(2))) __bf16 bf16x2_t;

#define DI __device__ __forceinline__
#define MFMA32(a, b, c) __builtin_amdgcn_mfma_f32_32x32x16_bf16((a), (b), (c), 0, 0, 0)

DI int tidx_opaque() { int t = threadIdx.x; asm volatile("" : "+v"(t)); return t; }
#define TIDX tidx_opaque()
DI bf16 f2bf(float x) { return __builtin_bit_cast(unsigned short, (__bf16)x); }
DI float bf2f(bf16 v) { return __uint_as_float(((unsigned)v) << 16); }
DI unsigned pack2(float a, float b) {
  f32x2 v = {a, b};
  return __builtin_bit_cast(unsigned, __builtin_convertvector(v, bf16x2_t));
}
DI float bflo(unsigned u) { return __uint_as_float(u << 16); }
DI float bfhi(unsigned u) { return __uint_as_float(u & 0xffff0000u); }
typedef const __attribute__((address_space(1))) u32x4* gptr16;
DI u32x4 ldg16(const void* q) { return *(gptr16)(uintptr_t)q; }
#define SCHED_FENCE() __builtin_amdgcn_sched_barrier(0)
DI int crow(int i, int h) { return (i & 3) + 8 * (i >> 2) + 4 * h; }
DI void sincos_cw(float x, float& sn, float& cs) {
  const float k = rintf(x * 0.63661977236758134f);
  float r = fmaf(-k, 1.57079637050628662109375f, x);
  r = fmaf(-k, -4.371139000186241e-08f, r);
  const int q = ((int)k) & 3;
  const float r2 = r * r;
  const float sp = r + r * r2 * (-1.6666667163e-01f + r2 * (8.3333337680e-03f + r2 * (-1.9841270114e-04f + r2 * 2.7557314297e-06f)));
  const float cp = 1.f + r2 * (-0.5f + r2 * (4.1666667908e-02f + r2 * (-1.3888889225e-03f + r2 * (2.4801587642e-05f - r2 * 2.7557314297e-07f))));
  sn = (q == 0) ? sp : (q == 1) ? cp : (q == 2) ? -sp : -cp;
  cs = (q == 0) ? cp : (q == 1) ? -sp : (q == 2) ? -cp : sp;
}
DI float sigmoidf_(float x) { return 1.f / (1.f + __expf(-x)); }
DI float siluf_(float x) { return x / (1.f + __expf(-x)); }

constexpr int DM = 1024, NB = 4, SEQ = 8192, CTXL = 256, TT = SEQ + CTXL, NTOK = NB * TT, NL = 4;
constexpr int DFF = 2816, DIN = 5408;
constexpr float EPSF = 1e-6f;
constexpr int NG33 = 33;
constexpr int NCH = 264;
constexpr int MS5 = NB * NCH;

constexpr size_t SZ_H = (size_t)NTOK * 1024 * 2;
constexpr size_t OFF_H = 0;
constexpr size_t OFF_P = OFF_H + SZ_H;
constexpr size_t OFF_Q = OFF_P;
constexpr size_t OFF_K = OFF_Q + (size_t)NTOK * 256 * 2;
constexpr size_t OFF_VT = OFF_K + (size_t)NTOK * 128 * 2;
constexpr size_t OFF_GQ = OFF_VT + (size_t)NTOK * 128 * 2;
constexpr size_t OFF_GK = OFF_GQ + (size_t)NTOK * 256 * 2;
constexpr size_t OFF_GVT = OFF_GK + (size_t)NTOK * 256 * 2;
constexpr size_t OFF_GR = OFF_GVT + (size_t)NTOK * 512 * 2;
constexpr size_t OFF_SU = OFF_GR + (size_t)NTOK * 512 * 2;
constexpr size_t OFF_LOW = OFF_SU + (size_t)NTOK * 256 * 2;
constexpr size_t OFF_O = OFF_LOW + (size_t)NTOK * 32 * 4;
constexpr size_t OFF_OATT = OFF_O;
constexpr size_t OFF_OGLA = OFF_OATT + (size_t)NTOK * 256 * 2;
constexpr size_t OFF_Y5 = OFF_OGLA + (size_t)NTOK * 512 * 2;
constexpr size_t OFF_EN = OFF_Y5;
constexpr size_t OFF_OS5 = OFF_Y5 + (size_t)NTOK * 256 * 2;
constexpr size_t OFF_M = OFF_OS5 + (size_t)NTOK * 256 * 2;
constexpr size_t OFF_MG = OFF_M;
constexpr size_t OFF_GS = OFF_M;
constexpr size_t OFF_DECG = OFF_GS + (size_t)32 * 33 * 8192 * 4;
constexpr size_t OFF_SB = OFF_DECG + (size_t)32 * 33 * 64 * 4;
constexpr size_t OFF_T5 = OFF_SB + (size_t)MS5 * 16 * 256 * 2;
constexpr size_t OFF_E5 = OFF_T5 + (size_t)16 * 512 * 512 * 2;
constexpr size_t OFF_F5 = OFF_E5 + (size_t)16 * 512 * 256 * 2;
constexpr size_t OFF_MEND = OFF_F5 + (size_t)16 * 256 * 512 * 2;
static_assert(OFF_MEND <= OFF_M + SZ_H, "mixer scratch overflows merged area");
constexpr size_t OFF_W = OFF_M + SZ_H;
constexpr size_t WL_WIN = 0, WL_BRA = WL_WIN + (size_t)5504 * 1024, WL_BRG = WL_BRA + 1024 * 256, WL_BRS = WL_BRG + 1024 * 512,
                 WL_WOUT = WL_BRS + 1024 * 256, WL_UP = WL_WOUT + 1024 * 1024, WL_DOWN = WL_UP + (size_t)5632 * 1024,
                 WL_GLU = WL_DOWN + (size_t)1024 * 2816, WL_TOTAL = WL_GLU + 256 * 256;
constexpr size_t OFF_XC = OFF_W + WL_TOTAL * 2 * NL;
constexpr size_t OFF_MOD = OFF_XC + (size_t)NB * CTXL * 1024 * 4;
constexpr size_t OFF_BBR = OFF_MOD + (size_t)NL * 5 * 6144 * 4;
constexpr size_t OFF_BBI = OFF_BBR + (size_t)NL * 2 * 16 * 64 * 16 * 4;
constexpr size_t OFF_PWR = OFF_BBI + (size_t)NL * 2 * 16 * 64 * 16 * 4;
constexpr size_t OFF_KTAB = OFF_PWR + (size_t)NL * 2 * 16 * 33 * 64 * 8;
constexpr size_t OFF_END = OFF_KTAB + (size_t)NL * 16 * 2 * 32 * 256 * 4;
constexpr size_t OFF_BAR = OFF_END;
constexpr size_t OFF_ZERO = OFF_BAR + 256;
constexpr size_t OFF_G = OFF_P;
static_assert((size_t)NTOK * DFF * 2 <= OFF_M - OFF_P, "G overflows");

constexpr int SMEM_BYTES = 73728;

struct Params {
  const float* in[34];
  float* out;
  char* ws;
};

enum { I_X = 0, I_C, I_CTX, I_CCTX, I_ADAW, I_ADAB, I_NMPRE, I_NMPOST, I_NFPRE, I_NFPOST, I_WIN, I_QN, I_KN, I_GGW, I_GGB, I_GON,
       I_ARE, I_AIM, I_LDT, I_BRE, I_BIM, I_CRE, I_CIM, I_S5D, I_GLUW, I_GLUB, I_WBA, I_WBG, I_WBS, I_WOUT, I_UP, I_CW, I_CB, I_DOWN };

constexpr int LDT = 72;
constexpr int CLD = 132;

template <class FA, class FB>
DI void gemm_main(f32x16 (&acc)[2][2], FA fa, FB fb, int K, char* smem) {
  bf16* As = (bf16*)smem;
  bf16* Bs = (bf16*)(smem + 2 * 128 * LDT * 2);
  const int tid = TIDX, lane = tid & 63, w = tid >> 6, wm = w >> 1, wn = w & 1;
  const int r = lane & 31, h = lane >> 5;
  const int lr = tid >> 3, kc = (tid & 7) * 8;
  const bf16* ap[4];
  const bf16* bp[4];
#pragma unroll
  for (int i = 0; i < 4; ++i) {
    const bf16* a = fa(lr + 32 * i);
    const bf16* b = fb(lr + 32 * i);
    ap[i] = a ? a + kc : nullptr;
    bp[i] = b ? b + kc : nullptr;
  }
  u32x4 ra[4], rb[4];
  const u32x4 z4 = {0u, 0u, 0u, 0u};
#pragma unroll
  for (int i = 0; i < 4; ++i) {
    ra[i] = ap[i] ? ldg16(ap[i]) : z4;
    rb[i] = bp[i] ? ldg16(bp[i]) : z4;
  }
#pragma unroll
  for (int i = 0; i < 4; ++i) {
    *(u32x4*)(As + (lr + 32 * i) * LDT + kc) = ra[i];
    *(u32x4*)(Bs + (lr + 32 * i) * LDT + kc) = rb[i];
  }
  __syncthreads();
  const int nk = K / 64;
  for (int kt = 0; kt < nk; ++kt) {
    const int buf = kt & 1;
    const bool more = (kt + 1 < nk);
    if (more) {
      const int k0 = (kt + 1) * 64;
#pragma unroll
      for (int i = 0; i < 4; ++i) {
        ra[i] = ap[i] ? ldg16(ap[i] + k0) : z4;
        rb[i] = bp[i] ? ldg16(bp[i] + k0) : z4;
      }
    }
    SCHED_FENCE();
    const bf16* Ab = As + buf * 128 * LDT + (wm * 64 + r) * LDT + h * 8;
    const bf16* Bb = Bs + buf * 128 * LDT + (wn * 64 + r) * LDT + h * 8;
#pragma unroll
    for (int s = 0; s < 4; ++s) {
      s16x8 a0 = *(const s16x8*)(Ab + s * 16);
      s16x8 a1 = *(const s16x8*)(Ab + 32 * LDT + s * 16);
      s16x8 b0 = *(const s16x8*)(Bb + s * 16);
      s16x8 b1 = *(const s16x8*)(Bb + 32 * LDT + s * 16);
      acc[0][0] = MFMA32(a0, b0, acc[0][0]);
      acc[0][1] = MFMA32(a0, b1, acc[0][1]);
      acc[1][0] = MFMA32(a1, b0, acc[1][0]);
      acc[1][1] = MFMA32(a1, b1, acc[1][1]);
    }
    SCHED_FENCE();
    if (more) {
      bf16* Aw = As + (buf ^ 1) * 128 * LDT;
      bf16* Bw = Bs + (buf ^ 1) * 128 * LDT;
#pragma unroll
      for (int i = 0; i < 4; ++i) {
        *(u32x4*)(Aw + (lr + 32 * i) * LDT + kc) = ra[i];
        *(u32x4*)(Bw + (lr + 32 * i) * LDT + kc) = rb[i];
      }
    }
    __syncthreads();
  }
}

template <class FA, class FB>
DI void gemm_main_deep(f32x16 (&acc)[2][2], FA fa, FB fb, int K, char* smem) {
  bf16* As = (bf16*)smem;
  bf16* Bs = (bf16*)(smem + 2 * 128 * LDT * 2);
  const int tid = TIDX, lane = tid & 63, w = tid >> 6, wm = w >> 1, wn = w & 1;
  const int r = lane & 31, h = lane >> 5;
  const int lr = tid >> 3, kc = (tid & 7) * 8;
  const bf16* ap[4];
  const bf16* bp[4];
#pragma unroll
  for (int i = 0; i < 4; ++i) {
    const bf16* a = fa(lr + 32 * i);
    const bf16* b = fb(lr + 32 * i);
    ap[i] = a ? a + kc : nullptr;
    bp[i] = b ? b + kc : nullptr;
  }
  const u32x4 z4 = {0u, 0u, 0u, 0u};
  u32x4 a0[4], b0[4], a1[4], b1[4];
  const int nk = K / 64;
#define GD_LOAD(RA, RB, T)                                               \
  {                                                                      \
    const int k0_ = (T) * 64;                                            \
    _Pragma("unroll") for (int i = 0; i < 4; ++i) {                      \
      RA[i] = ap[i] ? ldg16(ap[i] + k0_) : z4;                           \
      RB[i] = bp[i] ? ldg16(bp[i] + k0_) : z4;                           \
    }                                                                    \
  }
#define GD_STORE(RA, RB, BUF)                                            \
  {                                                                      \
    _Pragma("unroll") for (int i = 0; i < 4; ++i) {                      \
      *(u32x4*)(As + (BUF) * 128 * LDT + (lr + 32 * i) * LDT + kc) = RA[i]; \
      *(u32x4*)(Bs + (BUF) * 128 * LDT + (lr + 32 * i) * LDT + kc) = RB[i]; \
    }                                                                    \
  }
#define GD_COMPUTE(BUF)                                                  \
  {                                                                      \
    const bf16* Ab = As + (BUF) * 128 * LDT + (wm * 64 + r) * LDT + h * 8; \
    const bf16* Bb = Bs + (BUF) * 128 * LDT + (wn * 64 + r) * LDT + h * 8; \
    _Pragma("unroll") for (int s = 0; s < 4; ++s) {                      \
      s16x8 fa0 = *(const s16x8*)(Ab + s * 16);                          \
      s16x8 fa1 = *(const s16x8*)(Ab + 32 * LDT + s * 16);               \
      s16x8 fb0 = *(const s16x8*)(Bb + s * 16);                          \
      s16x8 fb1 = *(const s16x8*)(Bb + 32 * LDT + s * 16);               \
      acc[0][0] = MFMA32(fa0, fb0, acc[0][0]);                           \
      acc[0][1] = MFMA32(fa0, fb1, acc[0][1]);                           \
      acc[1][0] = MFMA32(fa1, fb0, acc[1][0]);                           \
      acc[1][1] = MFMA32(fa1, fb1, acc[1][1]);                           \
    }                                                                    \
  }
  GD_LOAD(a0, b0, 0)
  GD_LOAD(a1, b1, 1)
  GD_STORE(a0, b0, 0)
  __syncthreads();
  if (nk > 2) GD_LOAD(a0, b0, 2)
  for (int kt = 0; kt < nk; kt += 2) {
    SCHED_FENCE();
    GD_COMPUTE(0)
    SCHED_FENCE();
    GD_STORE(a1, b1, 1)
    if (kt + 3 < nk) GD_LOAD(a1, b1, kt + 3)
    __syncthreads();
    SCHED_FENCE();
    GD_COMPUTE(1)
    SCHED_FENCE();
    if (kt + 2 < nk) {
      GD_STORE(a0, b0, 0)
      if (kt + 4 < nk) GD_LOAD(a0, b0, kt + 4)
    }
    __syncthreads();
  }
#undef GD_LOAD
#undef GD_STORE
#undef GD_COMPUTE
}

template <class FA, class FB>
DI void gemm_main_dma(f32x16 (&acc)[2][2], FA fa, FB fb, int K, char* smem) {
  char* As = smem;
  char* Bs = smem + 32768;
  const int tid = TIDX, lane = tid & 63, w = tid >> 6, wm = w >> 1, wn = w & 1;
  const int r = lane & 31, h = lane >> 5;
  const bf16* ap[4];
  const bf16* bp[4];
#pragma unroll
  for (int i = 0; i < 4; ++i) {
    const int row = w * 32 + i * 8 + (lane >> 3);
    const int c = (lane & 7) ^ ((row >> 1) & 7);
    ap[i] = fa(row) + c * 8;
    bp[i] = fb(row) + c * 8;
  }
  const int ldst = (w * 256 + lane) * 16;
#define GM_DMA(BUF, T)                                                                                        \
  {                                                                                                           \
    const int k0_ = (T) * 64;                                                                                 \
    _Pragma("unroll") for (int i = 0; i < 4; ++i) {                                                           \
      __builtin_amdgcn_global_load_lds((const unsigned*)(ap[i] + k0_), (unsigned*)(As + (BUF) * 16384 + ldst + i * 1024), 16, 0, 0); \
      __builtin_amdgcn_global_load_lds((const unsigned*)(bp[i] + k0_), (unsigned*)(Bs + (BUF) * 16384 + ldst + i * 1024), 16, 0, 0); \
    }                                                                                                         \
  }
  const int xr = (r >> 1) & 7;
  const int arow = (wm * 64 + r) * 128, brow = (wn * 64 + r) * 128;
  GM_DMA(0, 0)
  asm volatile("s_waitcnt vmcnt(0)" ::: "memory");
  __syncthreads();
  const int nk = K / 64;
  for (int kt = 0; kt < nk; ++kt) {
    const int buf = kt & 1;
    if (kt + 1 < nk) GM_DMA(buf ^ 1, kt + 1)
    const char* Ab = As + buf * 16384 + arow;
    const char* Bb = Bs + buf * 16384 + brow;
#pragma unroll
    for (int s = 0; s < 4; ++s) {
      const int co = ((2 * s + h) ^ xr) * 16;
      s16x8 a0 = *(const s16x8*)(Ab + co);
      s16x8 a1 = *(const s16x8*)(Ab + 32 * 128 + co);
      s16x8 b0 = *(const s16x8*)(Bb + co);
      s16x8 b1 = *(const s16x8*)(Bb + 32 * 128 + co);
      acc[0][0] = MFMA32(a0, b0, acc[0][0]);
      acc[0][1] = MFMA32(a0, b1, acc[0][1]);
      acc[1][0] = MFMA32(a1, b0, acc[1][0]);
      acc[1][1] = MFMA32(a1, b1, acc[1][1]);
    }
    asm volatile("s_waitcnt vmcnt(0)" ::: "memory");
    __syncthreads();
  }
#undef GM_DMA
}

DI void gemm_main_dma_half(f32x16 (&acc)[2], const bf16* A, int lda, const bf16* B, int ldb, int K, int hf, char* smem) {
  char* As = smem;
  char* Bs = smem + 32768;
  const int tid = TIDX, lane = tid & 63, w = tid >> 6, wm = w >> 1, wn = w & 1;
  const int r = lane & 31, h = lane >> 5;
  const bf16* ap[4];
  const bf16* bp[2];
#pragma unroll
  for (int i = 0; i < 4; ++i) {
    const int row = w * 32 + i * 8 + (lane >> 3);
    ap[i] = A + (size_t)row * lda + ((lane & 7) ^ ((row >> 1) & 7)) * 8;
  }
#pragma unroll
  for (int i = 0; i < 2; ++i) {
    const int lrow = w * 16 + i * 8 + (lane >> 3);
    const int grow = (lrow >> 5) * 64 + hf * 32 + (lrow & 31);
    bp[i] = B + (size_t)grow * ldb + ((lane & 7) ^ ((lrow >> 1) & 7)) * 8;
  }
  const int lda_ = (w * 256 + lane) * 16, ldb_ = (w * 128 + lane) * 16;
#define GH_DMA(BUF, T)                                                                                        \
  {                                                                                                           \
    const int k0_ = (T) * 64;                                                                                 \
    _Pragma("unroll") for (int i = 0; i < 4; ++i)                                                             \
      __builtin_amdgcn_global_load_lds((const unsigned*)(ap[i] + k0_), (unsigned*)(As + (BUF) * 16384 + lda_ + i * 1024), 16, 0, 0); \
    _Pragma("unroll") for (int i = 0; i < 2; ++i)                                                             \
      __builtin_amdgcn_global_load_lds((const unsigned*)(bp[i] + k0_), (unsigned*)(Bs + (BUF) * 8192 + ldb_ + i * 1024), 16, 0, 0); \
  }
  const int xr = (r >> 1) & 7;
  const int arow = (wm * 64 + r) * 128, brow = (wn * 32 + r) * 128;
  GH_DMA(0, 0)
  asm volatile("s_waitcnt vmcnt(0)" ::: "memory");
  __syncthreads();
  const int nk = K / 64;
  for (int kt = 0; kt < nk; ++kt) {
    const int buf = kt & 1;
    if (kt + 1 < nk) GH_DMA(buf ^ 1, kt + 1)
    const char* Ab = As + buf * 16384 + arow;
    const char* Bb = Bs + buf * 8192 + brow;
#pragma unroll
    for (int s = 0; s < 4; ++s) {
      const int co = ((2 * s + h) ^ xr) * 16;
      s16x8 a0 = *(const s16x8*)(Ab + co);
      s16x8 a1 = *(const s16x8*)(Ab + 32 * 128 + co);
      s16x8 b0 = *(const s16x8*)(Bb + co);
      acc[0] = MFMA32(a0, b0, acc[0]);
      acc[1] = MFMA32(a1, b0, acc[1]);
    }
    asm volatile("s_waitcnt vmcnt(0)" ::: "memory");
    __syncthreads();
  }
#undef GH_DMA
}

template <class FA, class FB>
DI void gemm_wide(f32x16 (&acc)[2][4], FA fa, FB fb, int K, char* smem) {
  const int tid = TIDX, lane = tid & 63, w = tid >> 6, wm = w >> 1, wn = w & 1;
  const int r = lane & 31, h = lane >> 5;
  const bf16* ap[2];
  const bf16* bp[4];
#pragma unroll
  for (int i = 0; i < 2; ++i) {
    const int row = w * 32 + i * 16 + (lane >> 2);
    ap[i] = fa(row) + ((lane & 3) ^ ((row >> 2) & 3)) * 8;
  }
#pragma unroll
  for (int i = 0; i < 4; ++i) {
    const int row = w * 64 + i * 16 + (lane >> 2);
    bp[i] = fb(row) + ((lane & 3) ^ ((row >> 2) & 3)) * 8;
  }
  const int lda_ = (w * 128 + lane) * 16;
  const int ldb_ = 8192 + (w * 256 + lane) * 16;
#define GW_DMA(T)                                                                                                   \
  {                                                                                                                 \
    char* st_ = smem + ((T) % 3) * 24576;                                                                           \
    const int k0_ = (T) * 32;                                                                                       \
    _Pragma("unroll") for (int i = 0; i < 2; ++i)                                                                   \
      __builtin_amdgcn_global_load_lds((const unsigned*)(ap[i] + k0_), (unsigned*)(st_ + lda_ + i * 1024), 16, 0, 0); \
    _Pragma("unroll") for (int i = 0; i < 4; ++i)                                                                   \
      __builtin_amdgcn_global_load_lds((const unsigned*)(bp[i] + k0_), (unsigned*)(st_ + ldb_ + i * 1024), 16, 0, 0); \
  }
  const int xr = (r >> 2) & 3;
  const int arow = (wm * 64 + r) * 64;
  const int brow = 8192 + (wn * 64 + r) * 64;
  const int nt = K / 32;
  GW_DMA(0)
  if (nt > 1) GW_DMA(1)
  for (int t = 0; t < nt; ++t) {
    if (t + 1 < nt) asm volatile("s_waitcnt vmcnt(6)" ::: "memory");
    else asm volatile("s_waitcnt vmcnt(0)" ::: "memory");
    __syncthreads();
    if (t + 2 < nt) GW_DMA(t + 2)
    const char* st = smem + (t % 3) * 24576;
#pragma unroll
    for (int s = 0; s < 2; ++s) {
      const int co = ((2 * s + h) ^ xr) * 16;
      const s16x8 a0 = *(const s16x8*)(st + arow + co);
      const s16x8 a1 = *(const s16x8*)(st + arow + 32 * 64 + co);
#pragma unroll
      for (int hn = 0; hn < 2; ++hn) {
        const s16x8 b0 = *(const s16x8*)(st + brow + hn * 128 * 64 + co);
        const s16x8 b1 = *(const s16x8*)(st + brow + hn * 128 * 64 + 32 * 64 + co);
        acc[0][hn * 2 + 0] = MFMA32(a0, b0, acc[0][hn * 2 + 0]);
        acc[0][hn * 2 + 1] = MFMA32(a0, b1, acc[0][hn * 2 + 1]);
        acc[1][hn * 2 + 0] = MFMA32(a1, b0, acc[1][hn * 2 + 0]);
        acc[1][hn * 2 + 1] = MFMA32(a1, b1, acc[1][hn * 2 + 1]);
      }
    }
  }
  __syncthreads();
#undef GW_DMA
}

DI void accw_zero(f32x16 (&acc)[2][4]) {
#pragma unroll
  for (int a = 0; a < 2; ++a)
#pragma unroll
    for (int b = 0; b < 4; ++b)
#pragma unroll
      for (int i = 0; i < 16; ++i) acc[a][b][i] = 0.f;
}

DI void gemm_main_s(f32x16 (&acc)[2][2], const bf16* A, int lda, const bf16* B, int ldb, int K, char* smem) {
  bf16* As = (bf16*)smem;
  bf16* Bs = (bf16*)(smem + 2 * 128 * LDT * 2);
  const int tid = TIDX, lane = tid & 63, w = tid >> 6, wm = w >> 1, wn = w & 1;
  const int r = lane & 31, h = lane >> 5;
  const int lr = tid >> 3, kc = (tid & 7) * 8;
  const bf16* ap = A + (size_t)lr * lda + kc;
  const bf16* bp = B + (size_t)lr * ldb + kc;
  const size_t sa = (size_t)32 * lda, sb = (size_t)32 * ldb;
  u32x4 ra[4], rb[4];
#pragma unroll
  for (int i = 0; i < 4; ++i) {
    ra[i] = ldg16(ap + i * sa);
    rb[i] = ldg16(bp + i * sb);
  }
#pragma unroll
  for (int i = 0; i < 4; ++i) {
    *(u32x4*)(As + (lr + 32 * i) * LDT + kc) = ra[i];
    *(u32x4*)(Bs + (lr + 32 * i) * LDT + kc) = rb[i];
  }
  __syncthreads();
  const int nk = K / 64;
  for (int kt = 0; kt < nk; ++kt) {
    const int buf = kt & 1;
    const bool more = (kt + 1 < nk);
    if (more) {
      ap += 64; bp += 64;
#pragma unroll
      for (int i = 0; i < 4; ++i) {
        ra[i] = ldg16(ap + i * sa);
        rb[i] = ldg16(bp + i * sb);
      }
    }
    SCHED_FENCE();
    const bf16* Ab = As + buf * 128 * LDT + (wm * 64 + r) * LDT + h * 8;
    const bf16* Bb = Bs + buf * 128 * LDT + (wn * 64 + r) * LDT + h * 8;
#pragma unroll
    for (int s = 0; s < 4; ++s) {
      s16x8 a0 = *(const s16x8*)(Ab + s * 16);
      s16x8 a1 = *(const s16x8*)(Ab + 32 * LDT + s * 16);
      s16x8 b0 = *(const s16x8*)(Bb + s * 16);
      s16x8 b1 = *(const s16x8*)(Bb + 32 * LDT + s * 16);
      acc[0][0] = MFMA32(a0, b0, acc[0][0]);
      acc[0][1] = MFMA32(a0, b1, acc[0][1]);
      acc[1][0] = MFMA32(a1, b0, acc[1][0]);
      acc[1][1] = MFMA32(a1, b1, acc[1][1]);
    }
    SCHED_FENCE();
    if (more) {
      bf16* Aw = As + (buf ^ 1) * 128 * LDT;
      bf16* Bw = Bs + (buf ^ 1) * 128 * LDT;
#pragma unroll
      for (int i = 0; i < 4; ++i) {
        *(u32x4*)(Aw + (lr + 32 * i) * LDT + kc) = ra[i];
        *(u32x4*)(Bw + (lr + 32 * i) * LDT + kc) = rb[i];
      }
    }
    __syncthreads();
  }
}

DI void gemm_main_half(f32x16 (&acc)[2], const bf16* A, int lda, const bf16* B, int ldb, int K, int hf, char* smem) {
  bf16* As = (bf16*)smem;
  bf16* Bs = (bf16*)(smem + 2 * 128 * LDT * 2);
  const int tid = TIDX, lane = tid & 63, w = tid >> 6, wm = w >> 1, wn = w & 1;
  const int r = lane & 31, h = lane >> 5;
  const int lr = tid >> 3, kc = (tid & 7) * 8;
  const bf16* ap = A + (size_t)lr * lda + kc;
  const bf16* bp = B + (size_t)(hf * 32 + lr) * ldb + kc;
  const size_t sa = (size_t)32 * lda, sb = (size_t)64 * ldb;
  u32x4 ra[4], rb[2];
#pragma unroll
  for (int i = 0; i < 4; ++i) ra[i] = ldg16(ap + i * sa);
#pragma unroll
  for (int i = 0; i < 2; ++i) rb[i] = ldg16(bp + i * sb);
#pragma unroll
  for (int i = 0; i < 4; ++i) *(u32x4*)(As + (lr + 32 * i) * LDT + kc) = ra[i];
#pragma unroll
  for (int i = 0; i < 2; ++i) *(u32x4*)(Bs + (lr + 32 * i) * LDT + kc) = rb[i];
  __syncthreads();
  const int nk = K / 64;
  for (int kt = 0; kt < nk; ++kt) {
    const int buf = kt & 1;
    const bool more = (kt + 1 < nk);
    if (more) {
      ap += 64; bp += 64;
#pragma unroll
      for (int i = 0; i < 4; ++i) ra[i] = ldg16(ap + i * sa);
#pragma unroll
      for (int i = 0; i < 2; ++i) rb[i] = ldg16(bp + i * sb);
    }
    SCHED_FENCE();
    const bf16* Ab = As + buf * 128 * LDT + (wm * 64 + r) * LDT + h * 8;
    const bf16* Bb = Bs + buf * 128 * LDT + (wn * 32 + r) * LDT + h * 8;
#pragma unroll
    for (int s = 0; s < 4; ++s) {
      s16x8 a0 = *(const s16x8*)(Ab + s * 16);
      s16x8 a1 = *(const s16x8*)(Ab + 32 * LDT + s * 16);
      s16x8 b0 = *(const s16x8*)(Bb + s * 16);
      acc[0] = MFMA32(a0, b0, acc[0]);
      acc[1] = MFMA32(a1, b0, acc[1]);
    }
    SCHED_FENCE();
    if (more) {
      bf16* Aw = As + (buf ^ 1) * 128 * LDT;
      bf16* Bw = Bs + (buf ^ 1) * 128 * LDT;
#pragma unroll
      for (int i = 0; i < 4; ++i) *(u32x4*)(Aw + (lr + 32 * i) * LDT + kc) = ra[i];
#pragma unroll
      for (int i = 0; i < 2; ++i) *(u32x4*)(Bw + (lr + 32 * i) * LDT + kc) = rb[i];
    }
    __syncthreads();
  }
}

DI void acc_zero(f32x16 (&acc)[2][2]) {
#pragma unroll
  for (int a = 0; a < 2; ++a)
#pragma unroll
    for (int b = 0; b < 2; ++b)
#pragma unroll
      for (int i = 0; i < 16; ++i) acc[a][b][i] = 0.f;
}

DI void acc_to_lds(const f32x16 (&acc)[2][2], float* Cs) {
  const int lane = TIDX & 63, w = TIDX >> 6, wm = w >> 1, wn = w & 1, r = lane & 31, h = lane >> 5;
#pragma unroll
  for (int tm = 0; tm < 2; ++tm)
#pragma unroll
    for (int tn = 0; tn < 2; ++tn)
#pragma unroll
      for (int i = 0; i < 16; ++i) Cs[(wm * 64 + tm * 32 + crow(i, h)) * CLD + wn * 64 + tn * 32 + r] = acc[tm][tn][i];
}

template <int HN>
DI void accw_to_lds(const f32x16 (&acc)[2][4], float* Cs) {
  const int lane = TIDX & 63, w = TIDX >> 6, wm = w >> 1, wn = w & 1, r = lane & 31, h = lane >> 5;
#pragma unroll
  for (int tm = 0; tm < 2; ++tm)
#pragma unroll
    for (int tn = 0; tn < 2; ++tn)
#pragma unroll
      for (int i = 0; i < 16; ++i) Cs[(wm * 64 + tm * 32 + crow(i, h)) * CLD + wn * 64 + tn * 32 + r] = acc[tm][HN * 2 + tn][i];
}

DI void store_tile_bf16(const float* Cs, bf16* dst, size_t ld, int mvalid, float scale) {
  for (int c = TIDX; c < 2048; c += 256) {
    const int row = c >> 4, cc = (c & 15) * 8;
    if (row < mvalid) {
      const float* s = Cs + row * CLD + cc;
      u32x4 v;
      v[0] = pack2(s[0] * scale, s[1] * scale);
      v[1] = pack2(s[2] * scale, s[3] * scale);
      v[2] = pack2(s[4] * scale, s[5] * scale);
      v[3] = pack2(s[6] * scale, s[7] * scale);
      *(u32x4*)(dst + (size_t)row * ld + cc) = v;
    }
  }
}

DI float* resid_row(const Params& p, int tok) {
  const int b = tok / TT, t = tok - b * TT;
  return (t < CTXL) ? (float*)(p.ws + OFF_XC) + ((size_t)b * CTXL + t) * DM : p.out + ((size_t)b * SEQ + (t - CTXL)) * DM;
}
DI const float* mod_vec(const Params& p, int l, int tok, int which) {
  const int b = tok / TT, t = tok - b * TT;
  const int m = (t < CTXL) ? 4 : b;
  return (const float*)(p.ws + OFF_MOD) + ((size_t)(l * 5 + m) * 6 + which) * DM;
}
DI float wave_sum(float v) {
#pragma unroll
  for (int o = 32; o >= 1; o >>= 1) v += __shfl_xor(v, o, 64);
  return v;
}
DI bf16* wl(const Params& p, int l, size_t off) { return (bf16*)(p.ws + OFF_W) + (size_t)l * WL_TOTAL + off; }

DI void prep_mod_job(const Params& p, int j, char* smem) {
  float* sc = (float*)smem;
  float* part = (float*)(smem + 20480);
  const int l = j / 24, nb = j % 24, tid = TIDX, lane = tid & 63, w = tid >> 6;
  for (int idx = tid; idx < 5120; idx += 256) {
    const int m = idx >> 10, k = idx & 1023;
    const float v = (m < 4) ? p.in[I_C][m * 1024 + k] : p.in[I_CCTX][k];
    sc[idx] = siluf_(v);
  }
  __syncthreads();
  const float* W = p.in[I_ADAW] + (size_t)l * 1024 * 6144 + nb * 256 + lane;
  float a[5][4];
#pragma unroll
  for (int m = 0; m < 5; ++m)
#pragma unroll
    for (int c = 0; c < 4; ++c) a[m][c] = 0.f;
#pragma unroll 4
  for (int kk = 0; kk < 256; ++kk) {
    const int k = w * 256 + kk;
    float wv[4];
#pragma unroll
    for (int c = 0; c < 4; ++c) wv[c] = W[(size_t)k * 6144 + 64 * c];
#pragma unroll
    for (int m = 0; m < 5; ++m) {
      const float sv = sc[m * 1024 + k];
#pragma unroll
      for (int c = 0; c < 4; ++c) a[m][c] += sv * wv[c];
    }
  }
#pragma unroll
  for (int m = 0; m < 5; ++m)
#pragma unroll
    for (int c = 0; c < 4; ++c) part[(w * 5 + m) * 256 + lane + 64 * c] = a[m][c];
  __syncthreads();
  const int n = nb * 256 + tid;
  const float bb = p.in[I_ADAB][l * 6144 + n];
  float* M = (float*)(p.ws + OFF_MOD) + (size_t)l * 5 * 6144 + n;
#pragma unroll
  for (int m = 0; m < 5; ++m)
    M[m * 6144] = part[(0 * 5 + m) * 256 + tid] + part[(1 * 5 + m) * 256 + tid] + part[(2 * 5 + m) * 256 + tid] + part[(3 * 5 + m) * 256 + tid] + bb;
  __syncthreads();
}

DI void prep_s5_job(const Params& p, int j) {
  const int idx = j * 256 + TIDX;
  const int ldg = idx >> 6, pp = idx & 63;
  const float dt = expf(p.in[I_LDT][ldg]);
  const float are = p.in[I_ARE][idx], aim = p.in[I_AIM][idx];
  const float mag = expf(are * dt);
  float sn, cs;
  sincos_cw(aim * dt, sn, cs);
  const float abr = mag * cs, abi = mag * sn;
  const float den = are * are + aim * aim;
  const float fre = ((abr - 1.f) * are + abi * aim) / den;
  const float fim = (abi * are - (abr - 1.f) * aim) / den;
  float* BBR = (float*)(p.ws + OFF_BBR);
  float* BBI = (float*)(p.ws + OFF_BBI);
  for (int hh = 0; hh < 16; ++hh) {
    const float br = p.in[I_BRE][(size_t)idx * 16 + hh], bi = p.in[I_BIM][(size_t)idx * 16 + hh];
    BBR[(size_t)idx * 16 + hh] = fre * br - fim * bi;
    BBI[(size_t)idx * 16 + hh] = fre * bi + fim * br;
  }
  float2* PW = (float2*)(p.ws + OFF_PWR);
  float pr = 1.f, pi = 0.f;
  for (int tau = 0; tau <= 32; ++tau) {
    PW[((size_t)ldg * 33 + tau) * 64 + pp] = make_float2(pr, pi);
    const float nr = pr * abr - pi * abi, ni = pr * abi + pi * abr;
    pr = nr; pi = ni;
  }
}

DI void prep_wt_job(const Params& p, int jj, char* smem) {
  float* tile = (float*)smem;
  const int l = jj / 4016;
  int r = jj % 4016;
  int mat = 0;
  const int cnt[8] = {1376, 64, 128, 64, 256, 1408, 704, 16};
#pragma unroll
  for (int m = 0; m < 8; ++m) {
    if (mat == m && r >= cnt[m]) { r -= cnt[m]; mat = m + 1; }
  }
  const float* src; int K, sld; size_t doff;
  switch (mat) {
    case 0: src = p.in[I_WIN] + (size_t)l * 1024 * DIN; K = 1024; sld = DIN; doff = WL_WIN; break;
    case 1: src = p.in[I_WBA] + (size_t)l * 256 * 1024; K = 256; sld = 1024; doff = WL_BRA; break;
    case 2: src = p.in[I_WBG] + (size_t)l * 512 * 1024; K = 512; sld = 1024; doff = WL_BRG; break;
    case 3: src = p.in[I_WBS] + (size_t)l * 256 * 1024; K = 256; sld = 1024; doff = WL_BRS; break;
    case 4: src = p.in[I_WOUT] + (size_t)l * 1024 * 1024; K = 1024; sld = 1024; doff = WL_WOUT; break;
    case 5: src = p.in[I_UP] + (size_t)l * 1024 * 5632; K = 1024; sld = 5632; doff = WL_UP; break;
    case 6: src = p.in[I_DOWN] + (size_t)l * 2816 * 1024; K = 2816; sld = 1024; doff = WL_DOWN; break;
    default: src = p.in[I_GLUW] + (size_t)l * 256 * 256; K = 256; sld = 256; doff = WL_GLU; break;
  }
  const int kt = K / 64;
  const int n0 = (r / kt) * 64, k0 = (r % kt) * 64;
  const int tid = TIDX;
  {
    const int nn = tid & 63;
    const int np = n0 + nn;
    int col;
    if (mat == 0) {
      if (np < 2048) col = np;
      else if (np < 2304) col = 2080 + (np - 2048);
      else if (np < 2336) col = 2048 + (np - 2304);
      else if (np < 2432) col = -1;
      else col = 2336 + (np - 2432);
    } else if (mat == 5) {
      const int jb = np >> 7, c = np & 127;
      col = (c < 64) ? (jb * 64 + c) : (DFF + jb * 64 + (c - 64));
    } else col = np;
#pragma unroll 4
    for (int kk = tid >> 6; kk < 64; kk += 4) tile[kk * 65 + nn] = (col >= 0) ? src[(size_t)(k0 + kk) * sld + col] : 0.f;
  }
  __syncthreads();
  {
    const int nn = tid >> 2, kq = (tid & 3) * 16;
    bf16* d = wl(p, l, doff) + (size_t)(n0 + nn) * K + k0 + kq;
    u32x4 v0, v1;
#pragma unroll
    for (int e = 0; e < 4; ++e) {
      v0[e] = pack2(tile[(kq + 2 * e) * 65 + nn], tile[(kq + 2 * e + 1) * 65 + nn]);
      v1[e] = pack2(tile[(kq + 8 + 2 * e) * 65 + nn], tile[(kq + 8 + 2 * e + 1) * 65 + nn]);
    }
    *(u32x4*)d = v0;
    *(u32x4*)(d + 8) = v1;
  }
  __syncthreads();
}

template <int MODE>
DI void row_job(const Params& p, int l, int tok) {
  const int lane = TIDX & 63;
  float x[16];
  float* xr = resid_row(p, tok);
  if (MODE == 0) {
    const int b = tok / TT, t = tok - b * TT;
    const float* src = (t < CTXL) ? p.in[I_CTX] + ((size_t)b * CTXL + t) * DM : p.in[I_X] + ((size_t)b * SEQ + (t - CTXL)) * DM;
#pragma unroll
    for (int i = 0; i < 4; ++i) {
      const f32x4 v = *(const f32x4*)(src + lane * 4 + 256 * i);
      x[4 * i] = v[0]; x[4 * i + 1] = v[1]; x[4 * i + 2] = v[2]; x[4 * i + 3] = v[3];
      *(f32x4*)(xr + lane * 4 + 256 * i) = v;
    }
  } else {
    const bf16* yr = (const bf16*)(p.ws + OFF_H) + (size_t)tok * DM;
    const float* gpost = p.in[MODE == 1 ? I_NMPOST : I_NFPOST] + l * DM;
    const float* mg = mod_vec(p, l, tok, MODE == 1 ? 2 : 5);
    float y[16];
    float ss = 0.f;
#pragma unroll
    for (int i = 0; i < 4; ++i) {
      const u32x2 u = *(const u32x2*)(yr + lane * 4 + 256 * i);
      y[4 * i] = bflo(u[0]); y[4 * i + 1] = bfhi(u[0]); y[4 * i + 2] = bflo(u[1]); y[4 * i + 3] = bfhi(u[1]);
#pragma unroll
      for (int e = 0; e < 4; ++e) ss += y[4 * i + e] * y[4 * i + e];
    }
    ss = wave_sum(ss);
    const float rstd = rsqrtf(ss * (1.f / DM) + EPSF);
#pragma unroll
    for (int i = 0; i < 4; ++i) {
      f32x4 v = *(const f32x4*)(xr + lane * 4 + 256 * i);
      const f32x4 g = *(const f32x4*)(gpost + lane * 4 + 256 * i);
      const f32x4 m = *(const f32x4*)(mg + lane * 4 + 256 * i);
#pragma unroll
      for (int e = 0; e < 4; ++e) { v[e] += m[e] * (y[4 * i + e] * rstd * g[e]); x[4 * i + e] = v[e]; }
      *(f32x4*)(xr + lane * 4 + 256 * i) = v;
    }
  }
  if (MODE == 2 && l == NL - 1) return;
  const int ln = (MODE == 2) ? l + 1 : l;
  const float* gpre = p.in[MODE == 1 ? I_NFPRE : I_NMPRE] + ln * DM;
  const float* sh = mod_vec(p, ln, tok, MODE == 1 ? 3 : 0);
  const float* scv = mod_vec(p, ln, tok, MODE == 1 ? 4 : 1);
  float ss = 0.f;
#pragma unroll
  for (int i = 0; i < 16; ++i) ss += x[i] * x[i];
  ss = wave_sum(ss);
  const float rstd = rsqrtf(ss * (1.f / DM) + EPSF);
  bf16* hr = (bf16*)(p.ws + OFF_H) + (size_t)tok * DM;
#pragma unroll
  for (int i = 0; i < 4; ++i) {
    const f32x4 g = *(const f32x4*)(gpre + lane * 4 + 256 * i);
    const f32x4 s1 = *(const f32x4*)(sh + lane * 4 + 256 * i);
    const f32x4 s2 = *(const f32x4*)(scv + lane * 4 + 256 * i);
    float o[4];
#pragma unroll
    for (int e = 0; e < 4; ++e) o[e] = (x[4 * i + e] * rstd * g[e]) * (1.f + s2[e]) + s1[e];
    u32x2 u;
    u[0] = pack2(o[0], o[1]); u[1] = pack2(o[2], o[3]);
    *(u32x2*)(hr + lane * 4 + 256 * i) = u;
  }
}

template <int MODE>
DI void row_phase(const Params& p, int l, int bid, int G) {
  const int lane = TIDX & 63;
  const int wg = bid * 4 + (TIDX >> 6), nw = G * 4;
  const int R = (NTOK + nw - 1) / nw;
  const int t0 = wg * R, t1 = min(NTOK, t0 + R);
  if (t0 >= t1) return;
  const bool has_next = !(MODE == 2 && l == NL - 1);
  const int ln = (MODE == 2) ? l + 1 : l;
  f32x4 gpost[4], gpre[4], mg[4], sh[4], scl[4];
#pragma unroll
  for (int i = 0; i < 4; ++i) {
    if (MODE != 0) gpost[i] = *(const f32x4*)(p.in[MODE == 1 ? I_NMPOST : I_NFPOST] + l * DM + lane * 4 + 256 * i);
    if (has_next) gpre[i] = *(const f32x4*)(p.in[MODE == 1 ? I_NFPRE : I_NMPRE] + ln * DM + lane * 4 + 256 * i);
  }
  int cur_m = -1;
  u32x2 yb[4], yn[4];
  f32x4 xb[4], xn[4];
  const bf16* Hb = (const bf16*)(p.ws + OFF_H);
#define ROW_LOAD(TOK, YY, XX)                                                                              \
  {                                                                                                        \
    const int b_ = (TOK) / TT, t_ = (TOK) - b_ * TT;                                                       \
    const float* src_ = (MODE == 0) ? ((t_ < CTXL) ? p.in[I_CTX] + ((size_t)b_ * CTXL + t_) * DM           \
                                                   : p.in[I_X] + ((size_t)b_ * SEQ + (t_ - CTXL)) * DM)    \
                                    : resid_row(p, (TOK));                                                 \
    _Pragma("unroll") for (int i = 0; i < 4; ++i) {                                                        \
      XX[i] = *(const f32x4*)(src_ + lane * 4 + 256 * i);                                                  \
      if (MODE != 0) YY[i] = *(const u32x2*)(Hb + (size_t)(TOK) * DM + lane * 4 + 256 * i);                \
    }                                                                                                      \
  }
  ROW_LOAD(t0, yb, xb)
  for (int tok = t0; tok < t1; ++tok) {
    if (tok + 1 < t1) ROW_LOAD(tok + 1, yn, xn)
    const int b = tok / TT, t = tok - b * TT;
    const int m = (t < CTXL) ? 4 : b;
    if (m != cur_m) {
      cur_m = m;
      const float* Mv = (const float*)(p.ws + OFF_MOD);
#pragma unroll
      for (int i = 0; i < 4; ++i) {
        if (MODE != 0) mg[i] = *(const f32x4*)(Mv + ((size_t)(l * 5 + m) * 6 + (MODE == 1 ? 2 : 5)) * DM + lane * 4 + 256 * i);
        if (has_next) {
          sh[i] = *(const f32x4*)(Mv + ((size_t)(ln * 5 + m) * 6 + (MODE == 1 ? 3 : 0)) * DM + lane * 4 + 256 * i);
          scl[i] = *(const f32x4*)(Mv + ((size_t)(ln * 5 + m) * 6 + (MODE == 1 ? 4 : 1)) * DM + lane * 4 + 256 * i);
        }
      }
    }
    float* xr = resid_row(p, tok);
    f32x4 x[4];
    if (MODE == 0) {
#pragma unroll
      for (int i = 0; i < 4; ++i) { x[i] = xb[i]; *(f32x4*)(xr + lane * 4 + 256 * i) = x[i]; }
    } else {
      float y[16];
      float ss = 0.f;
#pragma unroll
      for (int i = 0; i < 4; ++i) {
        y[4 * i] = bflo(yb[i][0]); y[4 * i + 1] = bfhi(yb[i][0]); y[4 * i + 2] = bflo(yb[i][1]); y[4 * i + 3] = bfhi(yb[i][1]);
#pragma unroll
        for (int e = 0; e < 4; ++e) ss += y[4 * i + e] * y[4 * i + e];
      }
      ss = wave_sum(ss);
      const float rstd = rsqrtf(ss * (1.f / DM) + EPSF);
#pragma unroll
      for (int i = 0; i < 4; ++i) {
        f32x4 v = xb[i];
#pragma unroll
        for (int e = 0; e < 4; ++e) v[e] += mg[i][e] * (y[4 * i + e] * rstd * gpost[i][e]);
        x[i] = v;
        *(f32x4*)(xr + lane * 4 + 256 * i) = v;
      }
    }
    if (has_next) {
      float ss = 0.f;
#pragma unroll
      for (int i = 0; i < 4; ++i)
#pragma unroll
        for (int e = 0; e < 4; ++e) ss += x[i][e] * x[i][e];
      ss = wave_sum(ss);
      const float rstd = rsqrtf(ss * (1.f / DM) + EPSF);
      bf16* hr = (bf16*)(p.ws + OFF_H) + (size_t)tok * DM;
#pragma unroll
      for (int i = 0; i < 4; ++i) {
        float o[4];
#pragma unroll
        for (int e = 0; e < 4; ++e) o[e] = (x[i][e] * rstd * gpre[i][e]) * (1.f + scl[i][e]) + sh[i][e];
        u32x2 u;
        u[0] = pack2(o[0], o[1]); u[1] = pack2(o[2], o[3]);
        *(u32x2*)(hr + lane * 4 + 256 * i) = u;
      }
    }
#pragma unroll
    for (int i = 0; i < 4; ++i) { yb[i] = yn[i]; xb[i] = xn[i]; }
  }
#undef ROW_LOAD
}

DI void ktab_phase(const Params& p, int bid, int G) {
  const float* BBR = (const float*)(p.ws + OFF_BBR);
  const float* BBI = (const float*)(p.ws + OFF_BBI);
  const float2* PW = (const float2*)(p.ws + OFF_PWR);
  float* KT = (float*)(p.ws + OFF_KTAB);
  const int total = NL * 16 * 2 * 32 * 256;
  for (int idx = bid * 256 + TIDX; idx < total; idx += G * 256) {
    const int hp = idx & 15, hh = (idx >> 4) & 15, tau = (idx >> 8) & 31, d = (idx >> 13) & 1, g = (idx >> 14) & 15, l = idx >> 18;
    const int ldg = (l * 2 + d) * 16 + g;
    const float* cre = p.in[I_CRE] + ((size_t)ldg * 16 + hh) * 64;
    const float* cim = p.in[I_CIM] + ((size_t)ldg * 16 + hh) * 64;
    float acc = 0.f;
    for (int pp = 0; pp < 64; ++pp) {
      const float2 pw = PW[((size_t)ldg * 33 + tau) * 64 + pp];
      const float br = BBR[((size_t)ldg * 64 + pp) * 16 + hp], bi = BBI[((size_t)ldg * 64 + pp) * 16 + hp];
      const float zr = pw.x * br - pw.y * bi, zi = pw.x * bi + pw.y * br;
      acc += cre[pp] * zr - cim[pp] * zi;
    }
    KT[idx] = acc;
  }
}

DI void s5mat_phase(const Params& p, int l, int bid, int G) {
  const float* BBR = (const float*)(p.ws + OFF_BBR);
  const float* BBI = (const float*)(p.ws + OFF_BBI);
  const float2* PW = (const float2*)(p.ws + OFF_PWR);
  const float* KT = (const float*)(p.ws + OFF_KTAB);
  bf16* T5 = (bf16*)(p.ws + OFF_T5);
  bf16* E5 = (bf16*)(p.ws + OFF_E5);
  bf16* F5 = (bf16*)(p.ws + OFF_F5);
  const int nT = 16 * 512 * 64, nE = 16 * 512 * 32, nF = 16 * 256 * 64;
  for (int it = bid * 256 + TIDX; it < nT + nE + nF; it += G * 256) {
    float v[8];
    bf16* dst;
    if (it < nT) {
      const int k8 = it & 63, n = (it >> 6) & 511, g = it >> 15;
      const int i = n >> 4, hh = n & 15, j = k8 >> 1, hp0 = (k8 & 1) * 8;
#pragma unroll
      for (int e = 0; e < 8; ++e) {
        const int hp = hp0 + e;
        float a = 0.f;
        if (j <= i) a += KT[((((size_t)l * 16 + g) * 2 + 0) * 32 + (i - j)) * 256 + hh * 16 + hp];
        if (j >= i) a += KT[((((size_t)l * 16 + g) * 2 + 1) * 32 + (j - i)) * 256 + hh * 16 + hp];
        if (i == j && hh == hp) a += p.in[I_S5D][l * 256 + g * 16 + hh];
        v[e] = a;
      }
      dst = T5 + ((size_t)g * 512 + n) * 512 + k8 * 8;
    } else if (it < nT + nE) {
      const int q = it - nT;
      const int k8 = q & 31, n = (q >> 5) & 511, g = q >> 14;
      const int i = n >> 4, hh = n & 15;
      const int k0 = k8 * 8, d = k0 >> 7, ri = (k0 >> 6) & 1, p0 = k0 & 63;
      const int ldg = (l * 2 + d) * 16 + g;
      const int ex = d ? (32 - i) : (i + 1);
#pragma unroll
      for (int e = 0; e < 8; ++e) {
        const int pp = p0 + e;
        const float2 pw = PW[((size_t)ldg * 33 + ex) * 64 + pp];
        const float cr = p.in[I_CRE][((size_t)ldg * 16 + hh) * 64 + pp], ci = p.in[I_CIM][((size_t)ldg * 16 + hh) * 64 + pp];
        const float zr = cr * pw.x - ci * pw.y, zi = cr * pw.y + ci * pw.x;
        v[e] = ri ? -zi : zr;
      }
      dst = E5 + ((size_t)g * 512 + n) * 256 + k0;
    } else {
      const int q = it - nT - nE;
      const int k8 = q & 63, n = (q >> 6) & 255, g = q >> 14;
      const int d = n >> 7, ri = (n >> 6) & 1, pp = n & 63;
      const int j = k8 >> 1, hp0 = (k8 & 1) * 8;
      const int ldg = (l * 2 + d) * 16 + g;
      const int ex = d ? j : (31 - j);
      const float2 pw = PW[((size_t)ldg * 33 + ex) * 64 + pp];
#pragma unroll
      for (int e = 0; e < 8; ++e) {
        const float br = BBR[((size_t)ldg * 64 + pp) * 16 + hp0 + e], bi = BBI[((size_t)ldg * 64 + pp) * 16 + hp0 + e];
        v[e] = ri ? (pw.x * bi + pw.y * br) : (pw.x * br - pw.y * bi);
      }
      dst = F5 + ((size_t)g * 256 + n) * 512 + k8 * 8;
    }
    u32x4 u;
    u[0] = pack2(v[0], v[1]); u[1] = pack2(v[2], v[3]); u[2] = pack2(v[4], v[5]); u[3] = pack2(v[6], v[7]);
    *(u32x4*)dst = u;
  }
}

DI void proj_epi(const Params& p, int l, int mt, int nt, char* smem);
DI void proj_wide(const Params& p, int l, int mt, int np, char* smem) {
  const bf16* H = (const bf16*)(p.ws + OFF_H) + (size_t)mt * 128 * DM;
  const bf16* W = wl(p, l, WL_WIN) + (size_t)np * 256 * DM;
  f32x16 acc[2][4];
  accw_zero(acc);
  gemm_wide(acc, [&](int r) { return H + (size_t)r * DM; }, [&](int r) { return W + (size_t)r * DM; }, DM, smem);
  float* Cs = (float*)smem;
  accw_to_lds<0>(acc, Cs);
  __syncthreads();
  proj_epi(p, l, mt, np * 2, smem);
  if (np * 2 + 1 < 19) {
    accw_to_lds<1>(acc, Cs);
    __syncthreads();
    proj_epi(p, l, mt, np * 2 + 1, smem);
  }
}
DI void proj_epi(const Params& p, int l, int mt, int nt, char* smem) {
  float* Cs = (float*)smem;
  const int tid = TIDX;
  const int tok0 = mt * 128;
  const int b = tok0 / TT, t0 = tok0 - b * TT;
  if (nt <= 2) {
    const int row = tid >> 1, seg = tid & 1;
    float* c = Cs + row * CLD + seg * 64;
    const float* gn = p.in[nt < 2 ? I_QN : I_KN] + l * 64;
    float ss = 0.f;
#pragma unroll 8
    for (int i = 0; i < 64; ++i) ss += c[i] * c[i];
    const float rstd = rsqrtf(ss * (1.f / 64.f) + EPSF);
    const int t = t0 + row;
    const bool lat = t >= CTXL;
    const int s = t - CTXL;
#pragma unroll 1
    for (int ax = 0; ax < 2; ++ax) {
      const float pos = (float)(ax ? (s & 63) : (s >> 6));
#pragma unroll 2
      for (int f = 0; f < 16; ++f) {
        float x1 = c[ax * 32 + f] * rstd * gn[ax * 32 + f];
        float x2 = c[ax * 32 + 16 + f] * rstd * gn[ax * 32 + 16 + f];
        if (lat) {
          const float invf = exp2f(-(float)f * (13.287712379549449f / 16.f));
          float sn, cs;
          sincos_cw(pos * invf, sn, cs);
          const float y1 = x1 * cs - x2 * sn, y2 = x2 * cs + x1 * sn;
          x1 = y1; x2 = y2;
        }
        c[ax * 32 + f] = x1;
        c[ax * 32 + 16 + f] = x2;
      }
    }
    __syncthreads();
    if (nt < 2) store_tile_bf16(Cs, (bf16*)(p.ws + OFF_Q) + (size_t)tok0 * 256 + nt * 128, 256, 128, 0.125f * 1.4426950408889634f);
    else store_tile_bf16(Cs, (bf16*)(p.ws + OFF_K) + (size_t)tok0 * 128, 128, 128, 1.f);
  } else if (nt == 3 || (nt >= 8 && nt <= 11)) {
    for (int c = tid; c < 2048; c += 256) {
      const int col = c & 127, rc = (c >> 7) * 8;
      u32x4 u;
#pragma unroll
      for (int e = 0; e < 4; ++e) u[e] = pack2(Cs[(rc + 2 * e) * CLD + col], Cs[(rc + 2 * e + 1) * CLD + col]);
      bf16* dst;
      if (nt == 3) dst = (bf16*)(p.ws + OFF_VT) + ((size_t)(b * 2 + (col >> 6)) * 64 + (col & 63)) * TT + t0 + rc;
      else dst = (bf16*)(p.ws + OFF_GVT) + ((size_t)(b * 4 + (nt - 8)) * 128 + col) * TT + t0 + rc;
      *(u32x4*)dst = u;
    }
  } else if (nt == 4 || nt == 5) {
    store_tile_bf16(Cs, (bf16*)(p.ws + OFF_GQ) + (size_t)tok0 * 256 + (nt - 4) * 128, 256, 128, 0.125f);
  } else if (nt == 6 || nt == 7) {
    store_tile_bf16(Cs, (bf16*)(p.ws + OFF_GK) + (size_t)tok0 * 256 + (nt - 6) * 128, 256, 128, 1.f);
  } else if (nt >= 12 && nt <= 15) {
    store_tile_bf16(Cs, (bf16*)(p.ws + OFF_GR) + (size_t)tok0 * 512 + (nt - 12) * 128, 512, 128, 1.f);
  } else if (nt == 16 || nt == 17) {
    for (int c = tid; c < 2048; c += 256) {
      const int row = c >> 4, c8 = c & 15;
      const float* s = Cs + row * CLD + c8 * 8;
      u32x4 u;
#pragma unroll
      for (int e = 0; e < 4; ++e) u[e] = pack2(s[2 * e], s[2 * e + 1]);
      const int ch = (nt - 16) * 128 + c8 * 8;
      bf16* dst = (bf16*)(p.ws + OFF_SU) + ((size_t)(b * 16 + (ch >> 4)) * TT + t0 + row) * 16 + (ch & 15);
      *(u32x4*)dst = u;
    }
  } else {
    for (int c = tid; c < 128 * 8; c += 256) {
      const int row = c >> 3, c4 = (c & 7) * 4;
      const float* s = Cs + row * CLD + c4;
      f32x4 v = {s[0], s[1], s[2], s[3]};
      *(f32x4*)((float*)(p.ws + OFF_LOW) + (size_t)(tok0 + row) * 32 + c4) = v;
    }
  }
  __syncthreads();
}

DI void attn_unit(const Params& p, int u, char* smem) {
  char* Ks = smem;
  char* Vs = smem + 16384;
  int b, head, tok0, nkt;
  if (u < 1024) { b = u >> 8; head = (u >> 6) & 3; tok0 = b * TT + CTXL + (u & 63) * 128; nkt = TT / 64; }
  else { const int v = u - 1024; b = v >> 3; head = (v >> 1) & 3; tok0 = b * TT + (v & 1) * 128; nkt = CTXL / 64; }
  const int kvh = head >> 1;
  const int tid = TIDX, lane = tid & 63, w = tid >> 6, r = lane & 31, h = lane >> 5;
  const bf16* Qp = (const bf16*)(p.ws + OFF_Q) + (size_t)(tok0 + w * 32 + r) * 256 + head * 64 + h * 8;
  s16x8 qf[4];
#pragma unroll
  for (int s = 0; s < 4; ++s) qf[s] = __builtin_bit_cast(s16x8, ldg16(Qp + s * 16));
  const bf16* kp[2];
  const bf16* vp[2];
#pragma unroll
  for (int i = 0; i < 2; ++i) {
    const int row = w * 16 + i * 8 + (lane >> 3);
    const int c = (lane & 7) ^ ((row >> 1) & 7);
    kp[i] = (const bf16*)(p.ws + OFF_K) + ((size_t)b * TT + row) * 128 + kvh * 64 + c * 8;
    vp[i] = (const bf16*)(p.ws + OFF_VT) + ((size_t)(b * 2 + kvh) * 64 + row) * TT + c * 8;
  }
  const int ldst = (w * 128 + lane) * 16;
#define AT_DMA(BUF, T)                                                                                              \
  {                                                                                                                 \
    _Pragma("unroll") for (int i = 0; i < 2; ++i) {                                                                 \
      __builtin_amdgcn_global_load_lds((const unsigned*)(kp[i] + (size_t)(T) * 64 * 128), (unsigned*)(Ks + (BUF) * 8192 + ldst + i * 1024), 16, 0, 0); \
      __builtin_amdgcn_global_load_lds((const unsigned*)(vp[i] + (T) * 64), (unsigned*)(Vs + (BUF) * 8192 + ldst + i * 1024), 16, 0, 0);               \
    }                                                                                                               \
  }
  const int xr = (r >> 1) & 7;
  AT_DMA(0, 0)
  asm volatile("s_waitcnt vmcnt(0)" ::: "memory");
  __syncthreads();
  f32x16 oacc[2];
#pragma unroll
  for (int i = 0; i < 16; ++i) { oacc[0][i] = 0.f; oacc[1][i] = 0.f; }
  float mrow = -INFINITY, lrow = 0.f;
  for (int kt = 0; kt < nkt; ++kt) {
    const int buf = kt & 1;
    if (kt + 1 < nkt) AT_DMA(buf ^ 1, kt + 1)
    const char* Kb = Ks + buf * 8192;
    const char* Vb = Vs + buf * 8192;
    f32x16 sacc[2];
#pragma unroll
    for (int i = 0; i < 16; ++i) { sacc[0][i] = 0.f; sacc[1][i] = 0.f; }
#pragma unroll
    for (int s = 0; s < 4; ++s) {
      const int co = ((2 * s + h) ^ xr) * 16;
      const s16x8 a0 = *(const s16x8*)(Kb + r * 128 + co);
      const s16x8 a1 = *(const s16x8*)(Kb + (32 + r) * 128 + co);
      sacc[0] = MFMA32(a0, qf[s], sacc[0]);
      sacc[1] = MFMA32(a1, qf[s], sacc[1]);
    }
    float mx = sacc[0][0];
#pragma unroll
    for (int i = 0; i < 16; ++i) { mx = fmaxf(mx, sacc[0][i]); mx = fmaxf(mx, sacc[1][i]); }
    mx = fmaxf(mx, __shfl_xor(mx, 32, 64));
    const float mnew = fmaxf(mrow, mx);
    const float alpha = __builtin_amdgcn_exp2f(mrow - mnew);
    mrow = mnew;
    float psum = 0.f;
#pragma unroll
    for (int i = 0; i < 16; ++i) {
      sacc[0][i] = __builtin_amdgcn_exp2f(sacc[0][i] - mnew); psum += sacc[0][i];
      sacc[1][i] = __builtin_amdgcn_exp2f(sacc[1][i] - mnew); psum += sacc[1][i];
    }
    lrow = lrow * alpha + psum;
#pragma unroll
    for (int i = 0; i < 16; ++i) { oacc[0][i] *= alpha; oacc[1][i] *= alpha; }
#pragma unroll
    for (int kt2 = 0; kt2 < 2; ++kt2)
#pragma unroll
      for (int s2 = 0; s2 < 2; ++s2) {
        u32x4 pu;
#pragma unroll
        for (int e = 0; e < 4; ++e) pu[e] = pack2(sacc[kt2][8 * s2 + 2 * e], sacc[kt2][8 * s2 + 2 * e + 1]);
        const s16x8 pf = __builtin_bit_cast(s16x8, pu);
        const int c0 = kt2 * 4 + 2 * s2;
        const int o0 = ((c0 ^ xr) * 16) + 8 * h, o1 = (((c0 + 1) ^ xr) * 16) + 8 * h;
#pragma unroll
        for (int dt = 0; dt < 2; ++dt) {
          const s16x4 lo = *(const s16x4*)(Vb + (dt * 32 + r) * 128 + o0);
          const s16x4 hi = *(const s16x4*)(Vb + (dt * 32 + r) * 128 + o1);
          const s16x8 a = __builtin_shufflevector(lo, hi, 0, 1, 2, 3, 4, 5, 6, 7);
          oacc[dt] = MFMA32(a, pf, oacc[dt]);
        }
      }
    asm volatile("s_waitcnt vmcnt(0)" ::: "memory");
    __syncthreads();
  }
#undef AT_DMA
  const float ltot = lrow + __shfl_xor(lrow, 32, 64);
  const float inv = 1.f / ltot;
  bf16* Op = (bf16*)(p.ws + OFF_OATT) + (size_t)(tok0 + w * 32 + r) * 256 + head * 64;
#pragma unroll
  for (int dt = 0; dt < 2; ++dt)
#pragma unroll
    for (int i = 0; i < 16; i += 4) {
      u32x2 uu;
      uu[0] = pack2(oacc[dt][i] * inv, oacc[dt][i + 1] * inv);
      uu[1] = pack2(oacc[dt][i + 2] * inv, oacc[dt][i + 3] * inv);
      *(u32x2*)(Op + dt * 32 + crow(i, h)) = uu;
    }
}

constexpr int GL_LOW = 0, GL_TOT = 4096, GL_DEC = 5120, GL_QIN = 5376, GL_KIN = 14592, GL_KET = 23808, GL_OST = 0,
              GL_VT = 33792, GL_ST = 52224;
static_assert(GL_ST + 128 * LDT * 2 <= SMEM_BYTES, "gla lds");

template <bool WITH_OUT>
DI void gla_unit(const Params& p, int l, int u, char* smem) {
  float* lowt = (float*)(smem + GL_LOW);
  float* tots = (float*)(smem + GL_TOT);
  float* decs = (float*)(smem + GL_DEC);
  bf16* qin = (bf16*)(smem + GL_QIN);
  bf16* kin = (bf16*)(smem + GL_KIN);
  bf16* ket = (bf16*)(smem + GL_KET);
  float* ost = (float*)(smem + GL_OST);
  bf16* vts = (bf16*)(smem + GL_VT);
  bf16* sts = (bf16*)(smem + GL_ST);
  const int tid = TIDX, lane = tid & 63, w = tid >> 6, r = lane & 31, h = lane >> 5;
  int b, hd, gi, dir0, ndir;
  if (WITH_OUT) { gi = u % NG33; hd = (u / NG33) & 3; b = u / (NG33 * 4); dir0 = 1; ndir = 2; }
  else { gi = u % NG33; const int v = u / NG33; dir0 = v & 1; hd = (v >> 1) & 3; b = v >> 3; ndir = 1; }
  const int dk = tid & 63, part = tid >> 6;
  const bf16* GQ = (const bf16*)(p.ws + OFF_GQ);
  const bf16* GK = (const bf16*)(p.ws + OFF_GK);
  const bf16* GVT = (const bf16*)(p.ws + OFF_GVT) + (size_t)(b * 4 + hd) * 128 * TT;
  const float* LOW = (const float*)(p.ws + OFF_LOW);
  for (int dd = 0; dd < ndir; ++dd) {
    const int dir = WITH_OUT ? (dir0 - dd) : dir0;
    float* GSu = (float*)(p.ws + OFF_GS) + ((size_t)((b * 4 + hd) * 2 + dir) * NG33 + gi) * 8192;
    float gwreg[16];
#pragma unroll
    for (int rr = 0; rr < 16; ++rr) gwreg[rr] = p.in[I_GGW][((size_t)(l * 2 + dir) * 16 + rr) * 256 + hd * 64 + dk];
    const float gb = p.in[I_GGB][(l * 2 + dir) * 256 + hd * 64 + dk];
    f32x16 sacc[2];
    if (WITH_OUT) {
#pragma unroll
      for (int dkt = 0; dkt < 2; ++dkt)
#pragma unroll
        for (int i = 0; i < 16; ++i) {
          const float v = GSu[(w * 32 + crow(i, h)) * 64 + dkt * 32 + r];
          sacc[dkt][i] = v;
          sts[(w * 32 + crow(i, h)) * LDT + dkt * 32 + r] = f2bf(v);
        }
    } else {
#pragma unroll
      for (int i = 0; i < 16; ++i) { sacc[0][i] = 0.f; sacc[1][i] = 0.f; }
    }
    float gtot = 0.f;
    for (int cc = 0; cc < 4; ++cc) {
      const int ci = dir ? 3 - cc : cc;
      const int tb = gi * 256 + ci * 64;
      const size_t tokb = (size_t)b * TT + tb;
      {
        const int row = tid >> 2, c4 = (tid & 3) * 4;
        const u32x4 lw = ldg16(LOW + (tokb + row) * 32 + dir * 16 + c4);
        u32x4 vv[4], kq[2], qq[2];
#pragma unroll
        for (int i = 0; i < 4; ++i) {
          const int c = tid + 256 * i, e = c >> 3, k8 = (c & 7) * 8;
          vv[i] = ldg16(GVT + (size_t)e * TT + tb + k8);
        }
#pragma unroll
        for (int i = 0; i < 2; ++i) {
          const int c = tid + 256 * i, rw = c >> 3, k8 = (c & 7) * 8;
          kq[i] = ldg16(GK + (tokb + rw) * 256 + hd * 64 + k8);
          if (WITH_OUT) qq[i] = ldg16(GQ + (tokb + rw) * 256 + hd * 64 + k8);
        }
        *(u32x4*)(lowt + row * 16 + c4) = lw;
#pragma unroll
        for (int i = 0; i < 4; ++i) {
          const int c = tid + 256 * i, e = c >> 3, k8 = (c & 7) * 8;
          *(u32x4*)(vts + e * LDT + k8) = vv[i];
        }
#pragma unroll
        for (int i = 0; i < 2; ++i) {
          const int c = tid + 256 * i, rw = c >> 3, k8 = (c & 7) * 8;
          *(u32x4*)(kin + rw * LDT + k8) = kq[i];
          if (WITH_OUT) *(u32x4*)(qin + rw * LDT + k8) = qq[i];
        }
      }
      __syncthreads();
      float cum = 0.f;
#pragma unroll 2
      for (int ii = 0; ii < 16; ++ii) {
        const int pos = part * 16 + ii, t = dir ? 63 - pos : pos;
        float z = gb;
#pragma unroll
        for (int rr = 0; rr < 16; ++rr) z += lowt[t * 16 + rr] * gwreg[rr];
        cum += (fminf(z, 0.f) - log1pf(__expf(-fabsf(z)))) * (1.f / 16.f);
      }
      tots[part * 64 + dk] = cum;
      __syncthreads();
      float offs = 0.f, total = 0.f;
#pragma unroll
      for (int pp = 0; pp < 4; ++pp) { const float tv = tots[pp * 64 + dk]; total += tv; if (pp < part) offs += tv; }
      if (part == 0) decs[dk] = __expf(total);
      gtot += total;
      float bq = offs;
#pragma unroll 2
      for (int ii = 0; ii < 16; ++ii) {
        const int pos = part * 16 + ii, t = dir ? 63 - pos : pos;
        float z = gb;
#pragma unroll
        for (int rr = 0; rr < 16; ++rr) z += lowt[t * 16 + rr] * gwreg[rr];
        bq += (fminf(z, 0.f) - log1pf(__expf(-fabsf(z)))) * (1.f / 16.f);
        const float kv = bf2f(kin[t * LDT + dk]);
        ket[dk * LDT + t] = f2bf(kv * __expf(total - bq));
        if (WITH_OUT) {
          const float qv = bf2f(qin[t * LDT + dk]);
          qin[t * LDT + dk] = f2bf(qv * __expf(bq));
          kin[t * LDT + dk] = f2bf(kv * __expf(-bq));
        }
      }
      __syncthreads();
      f32x16 oo[2];
      const int it = w & 1, ep = w >> 1;
      if (WITH_OUT) {
        const int ti = w >> 1, tj = w & 1;
        f32x16 aa;
#pragma unroll
        for (int i = 0; i < 16; ++i) aa[i] = 0.f;
#pragma unroll
        for (int s = 0; s < 4; ++s) {
          const s16x8 A = *(const s16x8*)(qin + (ti * 32 + r) * LDT + s * 16 + h * 8);
          const s16x8 Bv = *(const s16x8*)(kin + (tj * 32 + r) * LDT + s * 16 + h * 8);
          aa = MFMA32(A, Bv, aa);
        }
        __syncthreads();
#pragma unroll
        for (int i = 0; i < 16; ++i) {
          const int qi = ti * 32 + crow(i, h), kj = tj * 32 + r;
          const bool keep = dir ? (kj >= qi) : (kj <= qi);
          kin[qi * LDT + kj] = f2bf(keep ? aa[i] : 0.f);
        }
        __syncthreads();
#pragma unroll
        for (int i = 0; i < 16; ++i) { oo[0][i] = 0.f; oo[1][i] = 0.f; }
#pragma unroll
        for (int s = 0; s < 4; ++s) {
          const s16x8 A1 = *(const s16x8*)(kin + (it * 32 + r) * LDT + s * 16 + h * 8);
          const s16x8 A2 = *(const s16x8*)(qin + (it * 32 + r) * LDT + s * 16 + h * 8);
#pragma unroll
          for (int x = 0; x < 2; ++x) {
            const int et = 2 * ep + x;
            const s16x8 B1 = *(const s16x8*)(vts + (et * 32 + r) * LDT + s * 16 + h * 8);
            const s16x8 B2 = *(const s16x8*)(sts + (et * 32 + r) * LDT + s * 16 + h * 8);
            oo[x] = MFMA32(A1, B1, oo[x]);
            oo[x] = MFMA32(A2, B2, oo[x]);
          }
        }
      }
#pragma unroll
      for (int dkt = 0; dkt < 2; ++dkt) {
        const float dv = decs[dkt * 32 + r];
#pragma unroll
        for (int i = 0; i < 16; ++i) sacc[dkt][i] *= dv;
      }
#pragma unroll
      for (int s = 0; s < 4; ++s) {
        const s16x8 A = *(const s16x8*)(vts + (w * 32 + r) * LDT + s * 16 + h * 8);
#pragma unroll
        for (int dkt = 0; dkt < 2; ++dkt) {
          const s16x8 Bv = *(const s16x8*)(ket + (dkt * 32 + r) * LDT + s * 16 + h * 8);
          sacc[dkt] = MFMA32(A, Bv, sacc[dkt]);
        }
      }
      __syncthreads();
      if (WITH_OUT) {
#pragma unroll
        for (int dkt = 0; dkt < 2; ++dkt)
#pragma unroll
          for (int i = 0; i < 16; ++i) sts[(w * 32 + crow(i, h)) * LDT + dkt * 32 + r] = f2bf(sacc[dkt][i]);
#pragma unroll
        for (int x = 0; x < 2; ++x)
#pragma unroll
          for (int i = 0; i < 16; ++i) ost[(it * 32 + crow(i, h)) * CLD + (2 * ep + x) * 32 + r] = oo[x][i];
        __syncthreads();
        const int row = tid >> 2, qd = tid & 3;
        const size_t tok = tokb + row;
        bf16* og = (bf16*)(p.ws + OFF_OGLA) + tok * 512 + hd * 128 + qd * 32;
        const float* os = ost + row * CLD + qd * 32;
        if (dir == 1) {
#pragma unroll
          for (int i = 0; i < 4; ++i) {
            u32x4 uu;
#pragma unroll
            for (int e = 0; e < 4; ++e) uu[e] = pack2(os[i * 8 + 2 * e], os[i * 8 + 2 * e + 1]);
            *(u32x4*)(og + i * 8) = uu;
          }
        } else {
          float ss = 0.f;
#pragma unroll 1
          for (int i = 0; i < 4; ++i) {
            const u32x4 uu = *(const u32x4*)(og + i * 8);
#pragma unroll
            for (int e = 0; e < 4; ++e) {
              const float a0 = os[i * 8 + 2 * e] + bflo(uu[e]), a1 = os[i * 8 + 2 * e + 1] + bfhi(uu[e]);
              ss += a0 * a0 + a1 * a1;
            }
          }
          ss += __shfl_xor(ss, 1, 64);
          ss += __shfl_xor(ss, 2, 64);
          const float rstd = rsqrtf(ss * (1.f / 128.f) + EPSF);
          const float* gn = p.in[I_GON] + l * 128 + qd * 32;
          const bf16* gr = (const bf16*)(p.ws + OFF_GR) + tok * 512 + hd * 128 + qd * 32;
#pragma unroll 1
          for (int i = 0; i < 4; ++i) {
            const u32x4 uo = *(const u32x4*)(og + i * 8);
            const u32x4 ug = *(const u32x4*)(gr + i * 8);
            u32x4 uu;
#pragma unroll
            for (int e = 0; e < 4; ++e) {
              const float v0 = os[i * 8 + 2 * e] + bflo(uo[e]), v1 = os[i * 8 + 2 * e + 1] + bfhi(uo[e]);
              const float a0 = v0 * rstd * gn[i * 8 + 2 * e] * siluf_(bflo(ug[e]));
              const float a1 = v1 * rstd * gn[i * 8 + 2 * e + 1] * siluf_(bfhi(ug[e]));
              uu[e] = pack2(a0, a1);
            }
            *(u32x4*)(og + i * 8) = uu;
          }
        }
        __syncthreads();
      }
    }
    if (!WITH_OUT) {
#pragma unroll
      for (int dkt = 0; dkt < 2; ++dkt)
#pragma unroll
        for (int i = 0; i < 16; ++i) GSu[(w * 32 + crow(i, h)) * 64 + dkt * 32 + r] = sacc[dkt][i];
      if (part == 0) ((float*)(p.ws + OFF_DECG))[((size_t)((b * 4 + hd) * 2 + dir) * NG33 + gi) * 64 + dk] = __expf(gtot);
    }
    __syncthreads();
  }
}

DI void gla_scan_job(const Params& p, int j) {
  const int idx = j * 256 + TIDX;
  const int seq = idx >> 13, el = idx & 8191, dk = el & 63, dir = seq & 1;
  float* GS = (float*)(p.ws + OFF_GS) + (size_t)seq * NG33 * 8192 + el;
  const float* DG = (const float*)(p.ws + OFF_DECG) + (size_t)seq * NG33 * 64 + dk;
  float s = 0.f;
  for (int st0 = 0; st0 < 33; st0 += 11) {
    float kv[11], dc[11];
#pragma unroll
    for (int q = 0; q < 11; ++q) {
      const int st = st0 + q;
      const int g = (dir == 0 || st == 0) ? st : 33 - st;
      kv[q] = GS[(size_t)g * 8192];
      dc[q] = DG[g * 64];
    }
#pragma unroll
    for (int q = 0; q < 11; ++q) {
      const int st = st0 + q;
      const int g = (dir == 0 || st == 0) ? st : 33 - st;
      GS[(size_t)g * 8192] = s;
      s = dc[q] * s + kv[q];
    }
  }
}

DI void s5_end_tile(const Params& p, int j, char* smem) {
  const int nt = j & 1, mt = (j >> 1) % 9, g = j / 18;
  const bf16* SU = (const bf16*)(p.ws + OFF_SU);
  const bf16* F = (const bf16*)(p.ws + OFF_F5) + ((size_t)g * 256 + nt * 128) * 512;
  f32x16 acc[2][2];
  acc_zero(acc);
  gemm_main_dma(acc,
            [&](int r) -> const bf16* {
              const int m = mt * 128 + r;
              if (m >= MS5) return (const bf16*)(p.ws + OFF_ZERO);
              const int b = m / NCH, ch = m - b * NCH;
              return SU + ((size_t)(b * 16 + g) * TT + ch * 32) * 16;
            },
            [&](int r) { return F + (size_t)r * 512; }, 512, smem);
  float* Cs = (float*)smem;
  acc_to_lds(acc, Cs);
  __syncthreads();
  float* EN = (float*)(p.ws + OFF_EN);
  for (int c = TIDX; c < 128 * 32; c += 256) {
    const int row = c >> 5, c4 = (c & 31) * 4, m = mt * 128 + row;
    if (m < MS5) {
      const float* s = Cs + row * CLD + c4;
      f32x4 v = {s[0], s[1], s[2], s[3]};
      *(f32x4*)(EN + ((size_t)m * 16 + g) * 256 + nt * 128 + c4) = v;
    }
  }
  __syncthreads();
}

DI void s5_scan_job(const Params& p, int l, int j, char* smem) {
  float2* ends = (float2*)smem;
  const int dir = j & 1, g = (j >> 1) & 15, b = j >> 5;
  const int pp = TIDX & 63, seg = TIDX >> 6;
  const float2 aL = ((const float2*)(p.ws + OFF_PWR))[((size_t)((l * 2 + dir) * 16 + g) * 33 + 32) * 64 + pp];
  const float* EN = (const float*)(p.ws + OFF_EN);
  bf16* SB = (bf16*)(p.ws + OFF_SB);
  float sr = 0.f, si = 0.f;
  for (int q0 = 0; q0 < 66; q0 += 11) {
    float er[11], ei[11];
#pragma unroll
    for (int q = 0; q < 11; ++q) {
      const int pos = seg * 66 + q0 + q;
      const int ch = dir ? (pos < 8 ? 7 - pos : 271 - pos) : pos;
      const float* e = EN + ((size_t)(b * NCH + ch) * 16 + g) * 256 + dir * 128 + pp;
      er[q] = e[0]; ei[q] = e[64];
    }
#pragma unroll
    for (int q = 0; q < 11; ++q) {
      const float nr = aL.x * sr - aL.y * si + er[q], ni = aL.x * si + aL.y * sr + ei[q];
      sr = nr; si = ni;
    }
  }
  ends[seg * 64 + pp] = make_float2(sr, si);
  float pr = 1.f, pi = 0.f;
  for (int q = 0; q < 66; ++q) { const float nr = pr * aL.x - pi * aL.y, ni = pr * aL.y + pi * aL.x; pr = nr; pi = ni; }
  __syncthreads();
  sr = 0.f; si = 0.f;
  for (int k = 0; k < seg; ++k) {
    const float2 e = ends[k * 64 + pp];
    const float nr = pr * sr - pi * si + e.x, ni = pr * si + pi * sr + e.y;
    sr = nr; si = ni;
  }
  for (int q0 = 0; q0 < 66; q0 += 11) {
    float er[11], ei[11];
#pragma unroll
    for (int q = 0; q < 11; ++q) {
      const int pos = seg * 66 + q0 + q;
      const int ch = dir ? (pos < 8 ? 7 - pos : 271 - pos) : pos;
      const float* e = EN + ((size_t)(b * NCH + ch) * 16 + g) * 256 + dir * 128 + pp;
      er[q] = e[0]; ei[q] = e[64];
    }
#pragma unroll
    for (int q = 0; q < 11; ++q) {
      const int pos = seg * 66 + q0 + q;
      const int ch = dir ? (pos < 8 ? 7 - pos : 271 - pos) : pos;
      bf16* sb = SB + ((size_t)(b * NCH + ch) * 16 + g) * 256 + dir * 128 + pp;
      sb[0] = f2bf(sr); sb[64] = f2bf(si);
      const float nr = aL.x * sr - aL.y * si + er[q], ni = aL.x * si + aL.y * sr + ei[q];
      sr = nr; si = ni;
    }
  }
  __syncthreads();
}

DI float gelu_tanh(float x) {
  const float u = 0.7978845608028654f * (x + 0.044715f * x * x * x);
  return 0.5f * x * (1.f + tanhf(u));
}

DI void s5_out_tile(const Params& p, int j, char* smem) {
  const int nt = j & 3, mt = (j >> 2) % 9, g = j / 36;
  const bf16* SU = (const bf16*)(p.ws + OFF_SU);
  const bf16* SB = (const bf16*)(p.ws + OFF_SB);
  const bf16* Tm = (const bf16*)(p.ws + OFF_T5) + ((size_t)g * 512 + nt * 128) * 512;
  const bf16* Em = (const bf16*)(p.ws + OFF_E5) + ((size_t)g * 512 + nt * 128) * 256;
  f32x16 acc[2][2];
  acc_zero(acc);
  gemm_main_dma(acc,
            [&](int r) -> const bf16* {
              const int m = mt * 128 + r;
              if (m >= MS5) return (const bf16*)(p.ws + OFF_ZERO);
              const int b = m / NCH, ch = m - b * NCH;
              return SU + ((size_t)(b * 16 + g) * TT + ch * 32) * 16;
            },
            [&](int r) { return Tm + (size_t)r * 512; }, 512, smem);
  gemm_main_dma(acc,
            [&](int r) -> const bf16* {
              const int m = mt * 128 + r;
              if (m >= MS5) return (const bf16*)(p.ws + OFF_ZERO);
              return SB + ((size_t)m * 16 + g) * 256;
            },
            [&](int r) { return Em + (size_t)r * 256; }, 256, smem);
  float* Cs = (float*)smem;
  acc_to_lds(acc, Cs);
  __syncthreads();
  bf16* Y5 = (bf16*)(p.ws + OFF_Y5);
  for (int c = TIDX; c < 2048; c += 256) {
    const int row = c >> 4, c8 = c & 15, m = mt * 128 + row;
    if (m < MS5) {
      const int b = m / NCH, ch = m - b * NCH;
      const int n = nt * 128 + c8 * 8, i = n >> 4, hh = n & 15;
      const float* s = Cs + row * CLD + c8 * 8;
      u32x4 u;
#pragma unroll
      for (int e = 0; e < 4; ++e) u[e] = pack2(gelu_tanh(s[2 * e]), gelu_tanh(s[2 * e + 1]));
      *(u32x4*)(Y5 + ((size_t)b * TT + ch * 32 + i) * 256 + g * 16 + hh) = u;
    }
  }
  __syncthreads();
}

DI void glu_tile(const Params& p, int l, int j, char* smem) {
  const int nt = j & 1, mt = j >> 1;
  const bf16* Y5 = (const bf16*)(p.ws + OFF_Y5) + (size_t)mt * 128 * 256;
  const bf16* W = wl(p, l, WL_GLU) + (size_t)nt * 128 * 256;
  f32x16 acc[2][2];
  acc_zero(acc);
  gemm_main_dma(acc, [&](int r) { return Y5 + (size_t)r * 256; }, [&](int r) { return W + (size_t)r * 256; }, 256, smem);
  float* Cs = (float*)smem;
  acc_to_lds(acc, Cs);
  __syncthreads();
  const float* gb = p.in[I_GLUB] + l * 256 + nt * 128;
  bf16* O = (bf16*)(p.ws + OFF_OS5) + (size_t)mt * 128 * 256 + nt * 128;
  for (int c = TIDX; c < 2048; c += 256) {
    const int row = c >> 4, cc = (c & 15) * 8;
    const float* s = Cs + row * CLD + cc;
    const u32x4 yu = *(const u32x4*)(Y5 + (size_t)row * 256 + nt * 128 + cc);
    u32x4 u;
#pragma unroll
    for (int e = 0; e < 4; ++e) {
      const float y0 = bflo(yu[e]), y1 = bfhi(yu[e]);
      u[e] = pack2(y0 * sigmoidf_(s[2 * e] + gb[cc + 2 * e]), y1 * sigmoidf_(s[2 * e + 1] + gb[cc + 2 * e + 1]));
    }
    *(u32x4*)(O + (size_t)row * 256 + cc) = u;
  }
  __syncthreads();
}

DI void merge_tile(const Params& p, int l, int j, char* smem) {
  const int nt = j & 7, mt = j >> 3;
  const bf16* H = (const bf16*)(p.ws + OFF_H) + (size_t)mt * 128 * DM;
  unsigned am[2][2][8];
#pragma unroll
  for (int a = 0; a < 2; ++a)
#pragma unroll
    for (int bq = 0; bq < 2; ++bq)
#pragma unroll
      for (int i = 0; i < 8; ++i) am[a][bq][i] = 0u;
#pragma unroll 1
  for (int x = 0; x < 3; ++x) {
    const bf16* Wg = wl(p, l, WL_WIN) + ((size_t)2432 + x * 1024 + nt * 128) * DM;
    unsigned sg[2][2][8];
    {
      f32x16 acc[2][2];
      acc_zero(acc);
      gemm_main_dma(acc, [&](int r) { return H + (size_t)r * DM; }, [&](int r) { return Wg + (size_t)r * DM; }, DM, smem);
#pragma unroll
      for (int a = 0; a < 2; ++a)
#pragma unroll
        for (int bq = 0; bq < 2; ++bq)
#pragma unroll
          for (int i = 0; i < 8; ++i) sg[a][bq][i] = pack2(sigmoidf_(acc[a][bq][2 * i]), sigmoidf_(acc[a][bq][2 * i + 1]));
    }
    const bf16* A; const bf16* Wb; int K;
    if (x == 0) { A = (const bf16*)(p.ws + OFF_OATT) + (size_t)mt * 128 * 256; Wb = wl(p, l, WL_BRA) + (size_t)nt * 128 * 256; K = 256; }
    else if (x == 1) { A = (const bf16*)(p.ws + OFF_OGLA) + (size_t)mt * 128 * 512; Wb = wl(p, l, WL_BRG) + (size_t)nt * 128 * 512; K = 512; }
    else { A = (const bf16*)(p.ws + OFF_OS5) + (size_t)mt * 128 * 256; Wb = wl(p, l, WL_BRS) + (size_t)nt * 128 * 256; K = 256; }
#pragma unroll
    for (int hf = 0; hf < 2; ++hf) {
      f32x16 a2[2];
#pragma unroll
      for (int i = 0; i < 16; ++i) { a2[0][i] = 0.f; a2[1][i] = 0.f; }
      gemm_main_dma_half(a2, A, K, Wb, K, K, hf, smem);
#pragma unroll
      for (int a = 0; a < 2; ++a)
#pragma unroll
        for (int i = 0; i < 8; ++i) {
          const float v0 = bflo(am[a][hf][i]) + bflo(sg[a][hf][i]) * a2[a][2 * i];
          const float v1 = bfhi(am[a][hf][i]) + bfhi(sg[a][hf][i]) * a2[a][2 * i + 1];
          am[a][hf][i] = pack2(v0, v1);
        }
    }
  }
  f32x16 accm[2][2];
#pragma unroll
  for (int a = 0; a < 2; ++a)
#pragma unroll
    for (int bq = 0; bq < 2; ++bq)
#pragma unroll
      for (int i = 0; i < 8; ++i) { accm[a][bq][2 * i] = bflo(am[a][bq][i]); accm[a][bq][2 * i + 1] = bfhi(am[a][bq][i]); }
  float* Cs = (float*)smem;
  acc_to_lds(accm, Cs);
  __syncthreads();
  store_tile_bf16(Cs, (bf16*)(p.ws + OFF_MG) + (size_t)mt * 128 * DM + nt * 128, DM, 128, 1.f);
  __syncthreads();
}

DI void plain_tile(const bf16* A, int K, const bf16* W, bf16* dst, int ldd, char* smem) {
  f32x16 acc[2][2];
  acc_zero(acc);
  gemm_main_dma(acc, [&](int r) { return A + (size_t)r * K; }, [&](int r) { return W + (size_t)r * K; }, K, smem);
  float* Cs = (float*)smem;
  acc_to_lds(acc, Cs);
  __syncthreads();
  store_tile_bf16(Cs, dst, ldd, 128, 1.f);
  __syncthreads();
}

DI void plain_wide(const bf16* A, int K, const bf16* W, bf16* dst, int ldd, char* smem) {
  f32x16 acc[2][4];
  accw_zero(acc);
  gemm_wide(acc, [&](int r) { return A + (size_t)r * K; }, [&](int r) { return W + (size_t)r * K; }, K, smem);
  float* Cs = (float*)smem;
  accw_to_lds<0>(acc, Cs);
  __syncthreads();
  store_tile_bf16(Cs, dst, ldd, 128, 1.f);
  __syncthreads();
  accw_to_lds<1>(acc, Cs);
  __syncthreads();
  store_tile_bf16(Cs, dst + 128, ldd, 128, 1.f);
  __syncthreads();
}

DI void up_epi(const Params& p, int l, int jn, int seqbase, int len, int pos0, char* smem) {
  float* Cs = (float*)smem;
  const float* cw = p.in[I_CW] + (size_t)l * 3 * 2 * DFF;
  const float* cb = p.in[I_CB] + (size_t)l * 2 * DFF;
  bf16* G = (bf16*)(p.ws + OFF_G);
  const int tid = TIDX;
  const int c = (tid & 31) * 2;
  float wa[2][3], wv[2][3], ba[2], bv[2];
#pragma unroll
  for (int e = 0; e < 2; ++e) {
    const int ca = jn * 64 + c + e, cv = DFF + ca;
#pragma unroll
    for (int k = 0; k < 3; ++k) { wa[e][k] = cw[k * 2 * DFF + ca]; wv[e][k] = cw[k * 2 * DFF + cv]; }
    ba[e] = cb[ca]; bv[e] = cb[cv];
  }
#pragma unroll 4
  for (int rr = 1 + (tid >> 5); rr < 127; rr += 8) {
    const int pos = pos0 + rr;
    if (pos < len) {
      float gv[2];
#pragma unroll
      for (int e = 0; e < 2; ++e) {
        const float a = wa[e][0] * Cs[(rr - 1) * CLD + c + e] + wa[e][1] * Cs[rr * CLD + c + e] + wa[e][2] * Cs[(rr + 1) * CLD + c + e] + ba[e];
        const float v = wv[e][0] * Cs[(rr - 1) * CLD + 64 + c + e] + wv[e][1] * Cs[rr * CLD + 64 + c + e] +
                        wv[e][2] * Cs[(rr + 1) * CLD + 64 + c + e] + bv[e];
        gv[e] = siluf_(a) * v;
      }
      *(unsigned*)(G + (size_t)(seqbase + pos) * DFF + jn * 64 + c) = pack2(gv[0], gv[1]);
    }
  }
  __syncthreads();
}

DI void up_wide(const Params& p, int l, int mtile, int jp, char* smem) {
  const int b = mtile / 69, rr0 = mtile % 69;
  int seqbase, len, ti;
  if (rr0 < 3) { seqbase = b * TT; len = CTXL; ti = rr0; }
  else { seqbase = b * TT + CTXL; len = SEQ; ti = rr0 - 3; }
  const int pos0 = ti * 126 - 1;
  const bf16* H = (const bf16*)(p.ws + OFF_H);
  const bf16* W = wl(p, l, WL_UP) + (size_t)jp * 256 * DM;
  f32x16 acc[2][4];
  accw_zero(acc);
  gemm_wide(acc,
            [&](int r) -> const bf16* {
              const int pos = pos0 + r;
              return (pos >= 0 && pos < len) ? H + (size_t)(seqbase + pos) * DM : (const bf16*)(p.ws + OFF_ZERO);
            },
            [&](int r) { return W + (size_t)r * DM; }, DM, smem);
  float* Cs = (float*)smem;
  accw_to_lds<0>(acc, Cs);
  __syncthreads();
  up_epi(p, l, jp * 2, seqbase, len, pos0, smem);
  accw_to_lds<1>(acc, Cs);
  __syncthreads();
  up_epi(p, l, jp * 2 + 1, seqbase, len, pos0, smem);
}

DI bool gemm_job(int bid, int G, int it, int MT, int NTL, int& mt, int& nt, int CW = 8) {
  const int x = bid & 7, q = bid >> 3, Q = G >> 3;
  const int m0 = (x * MT) >> 3, m1 = ((x + 1) * MT) >> 3, Mx = m1 - m0;
  const int jl = q + Q * it;
  if (jl >= Mx * NTL) return false;
  const int full = Mx * CW;
  const int c = jl / full, rem = jl - c * full;
  const int wc = min(CW, NTL - CW * c);
  const int mi = rem / wc;
  mt = m0 + mi;
  nt = CW * c + (rem - mi * wc);
  return true;
}

enum { PH_PREP = 0, PH_ROW0, PH_PROJ, PH_MIX1, PH_SCAN, PH_MIX2, PH_GLU, PH_MERGE, PH_WOUT, PH_ROW1, PH_UP, PH_DOWN, PH_ROW2 };
constexpr int N_PHASES = 2 + 11 * NL;

DI void run_phase(const Params& p, int ph, int l, char* smem) {
  const int bid = blockIdx.x;
#ifdef HALFMASK
  const int G = ((HALFMASK >> ph) & 1) ? 256 : gridDim.x;
  if (bid >= G) return;
#else
  const int G = gridDim.x;
#endif
#ifdef PHMASK
  if (!((PHMASK >> ph) & 1)) return;
#endif
  switch (ph) {
    case PH_PREP:
      if (bid < 8) { for (int i = TIDX; i < 512; i += 256) ((u32x4*)(p.ws + OFF_ZERO))[i] = u32x4{0u, 0u, 0u, 0u}; }
      for (int j = bid; j < 128 + 16064; j += G) {
        if (j < 96) prep_mod_job(p, j, smem);
        else if (j < 128) prep_s5_job(p, j - 96);
        else prep_wt_job(p, j - 128, smem);
      }
      break;
    case PH_ROW0:
      row_phase<0>(p, 0, bid, G);
      ktab_phase(p, bid, G);
      break;
    case PH_PROJ:
#ifdef EXP_A
      if (bid < 256) { int mt, nt; for (int it = 0; gemm_job(bid, 256, it, 264, 10, mt, nt, 4); ++it) proj_wide(p, l, mt, nt, smem); }
      s5mat_phase(p, l, bid, G);
#elif defined(EXP_C)
      if (bid < 256) for (int j = bid; j < 264 * 19; j += 256) { if ((EXP_C >> (j % 19)) & 1) proj_tile(p, l, j / 19, j % 19, smem); }
      for (int j = bid; j < 264 * 19; j += G) { if (!((EXP_C >> (j % 19)) & 1)) proj_tile(p, l, j / 19, j % 19, smem); }
      s5mat_phase(p, l, bid, G);
#elif defined(EXP_B)
      for (int j = bid; j < 264 * 19; j += G) proj_tile(p, l, j / 19, j % 19, smem);
      if (bid < 256) s5mat_phase(p, l, bid, 256);
#else
      for (int j = bid; j < 264 * 19; j += G) proj_tile(p, l, j / 19, j % 19, smem);
      s5mat_phase(p, l, bid, G);
#endif
      break;
    case PH_MIX1:
      for (int j = bid; j < 1056 + 1056 + 288; j += G) {
        if (j < 1056) attn_unit(p, j, smem);
        else if (j < 2112) gla_unit<false>(p, l, j - 1056, smem);
        else s5_end_tile(p, j - 2112, smem);
      }
      break;
    case PH_SCAN:
      for (int j = bid; j < 1024 + 128; j += G) {
        if (j < 1024) gla_scan_job(p, j);
        else s5_scan_job(p, l, j - 1024, smem);
      }
      break;
    case PH_MIX2:
      for (int j = bid; j < 528 + 576; j += G) {
        if (j < 528) gla_unit<true>(p, l, j, smem);
        else s5_out_tile(p, j - 528, smem);
      }
      break;
    case PH_GLU:
      { int mt, nt; for (int it = 0; gemm_job(bid, G, it, 264, 2, mt, nt); ++it) glu_tile(p, l, mt * 2 + nt, smem); }
      break;
    case PH_MERGE:
      { int mt, nt; for (int it = 0; gemm_job(bid, G, it, 264, 8, mt, nt); ++it) merge_tile(p, l, mt * 8 + nt, smem); }
      break;
    case PH_WOUT:
      for (int it = 0;; ++it) {
        int mt, nt;
        if (!gemm_job(bid, G, it, 264, 4, mt, nt, 4)) break;
        plain_wide((const bf16*)(p.ws + OFF_MG) + (size_t)mt * 128 * DM, DM, wl(p, l, WL_WOUT) + (size_t)nt * 256 * DM,
                   (bf16*)(p.ws + OFF_H) + (size_t)mt * 128 * DM + nt * 256, DM, smem);
      }
      break;
    case PH_ROW1: row_phase<1>(p, l, bid, G); break;
    case PH_UP:
      { int mt, nt; for (int it = 0; gemm_job(bid, G, it, 276, 22, mt, nt, 4); ++it) up_wide(p, l, mt, nt, smem); }
      break;
    case PH_DOWN:
      for (int it = 0;; ++it) {
        int mt, nt;
        if (!gemm_job(bid, G, it, 264, 4, mt, nt, 4)) break;
        plain_wide((const bf16*)(p.ws + OFF_G) + (size_t)mt * 128 * DFF, DFF, wl(p, l, WL_DOWN) + (size_t)nt * 256 * DFF,
                   (bf16*)(p.ws + OFF_H) + (size_t)mt * 128 * DM + nt * 256, DM, smem);
      }
      break;
    case PH_ROW2: row_phase<2>(p, l, bid, G); break;
  }
}

DI void grid_barrier(unsigned* bar, unsigned& gen) {
  asm volatile("s_waitcnt vmcnt(0)" ::: "memory");
  __syncthreads();
  gen += 1;
  if (threadIdx.x == 0) {
    __builtin_amdgcn_fence(__ATOMIC_RELEASE, "agent");
    asm volatile("s_waitcnt vmcnt(0)" ::: "memory");
    const unsigned target = gen * gridDim.x;
    __hip_atomic_fetch_add(bar, 1u, __ATOMIC_RELAXED, __HIP_MEMORY_SCOPE_AGENT);
    while (__hip_atomic_load(bar, __ATOMIC_RELAXED, __HIP_MEMORY_SCOPE_AGENT) < target) __builtin_amdgcn_s_sleep(2);
  }
  __syncthreads();
  __builtin_amdgcn_fence(__ATOMIC_ACQUIRE, "agent");
  asm volatile("s_waitcnt vmcnt(0)" ::: "memory");
}

__global__ void __launch_bounds__(256, 2) hybrid_fwd(Params p, int ph_lo, int ph_hi) {
  extern __shared__ __attribute__((aligned(16))) char smem[];
  unsigned* bar = (unsigned*)(p.ws + OFF_BAR);
  unsigned gen = 0;
  if (ph_hi - ph_lo > 1) cg::this_grid().sync();
  int i = 0;
#define STEP(PH, L)                                      \
  {                                                      \
    if (i >= ph_lo && i < ph_hi) {                       \
      Params q;                                          \
      q.ws = p.ws; q.out = p.out;                        \
      asm volatile("" : "+s"(q.ws), "+s"(q.out));        \
      _Pragma("unroll") for (int k = 0; k < 34; ++k) { q.in[k] = p.in[k]; asm volatile("" : "+s"(q.in[k])); } \
      run_phase(q, PH, L, smem);                         \
      if ((DUPMASK >> (PH)) & 1) { grid_barrier(bar, gen); run_phase(q, PH, L, smem); } \
      if (i + 1 < ph_hi) grid_barrier(bar, gen);         \
    }                                                    \
    ++i;                                                 \
  }
  STEP(PH_PREP, 0)
  STEP(PH_ROW0, 0)
#pragma unroll 1
  for (int l = 0; l < NL; ++l) {
    STEP(PH_PROJ, l)
    STEP(PH_MIX1, l)
    STEP(PH_SCAN, l)
    STEP(PH_MIX2, l)
    STEP(PH_GLU, l)
    STEP(PH_MERGE, l)
    STEP(PH_WOUT, l)
    STEP(PH_ROW1, l)
    STEP(PH_UP, l)
    STEP(PH_DOWN, l)
    STEP(PH_ROW2, l)
  }
#undef STEP
}

extern "C" void kernel_launch(void* const* d_in, const int* in_sizes, int n_in, void* d_out, int out_size, void* d_ws, size_t ws_size,
                              hipStream_t stream) {
  static int grid_blocks = 0;
  if (!grid_blocks) {
    int dev = 0, cus = 0, per_cu = 0;
    hipGetDevice(&dev);
    hipDeviceGetAttribute(&cus, hipDeviceAttributeMultiprocessorCount, dev);
    hipFuncSetAttribute((const void*)hybrid_fwd, hipFuncAttributeMaxDynamicSharedMemorySize, SMEM_BYTES);
    hipOccupancyMaxActiveBlocksPerMultiprocessor(&per_cu, hybrid_fwd, 256, SMEM_BYTES);
    if (per_cu < 1) per_cu = 1;
    if (per_cu > 2) per_cu = 2;
    grid_blocks = cus * per_cu;
    if (ws_size < OFF_ZERO + 8192) fprintf(stderr, "workspace too small: %zu < %zu\n", ws_size, (size_t)OFF_END);
  }
  Params p{};
  for (int i = 0; i < 34; ++i) p.in[i] = (const float*)d_in[i];
  p.out = (float*)d_out;
  p.ws = (char*)d_ws;
#if ONE_LAUNCH
  hipMemsetAsync((char*)d_ws + OFF_BAR, 0, 256, stream);
  int lo = 0, hi = N_PHASES;
  void* args[] = {&p, &lo, &hi};
  hipError_t e = hipLaunchCooperativeKernel((void*)hybrid_fwd, dim3(grid_blocks), dim3(256), args, SMEM_BYTES, stream);
  if (e != hipSuccess) fprintf(stderr, "cooperative launch failed: %s (grid %d)\n", hipGetErrorString(e), grid_blocks);
#else
  for (int i = 0; i < N_PHASES; ++i) hipLaunchKernelGGL(hybrid_fwd, dim3(grid_blocks), dim3(256), SMEM_BYTES, stream, p, i, i + 1);
#endif
}
```

```cpp
#include <hip/hip_runtime.h>
#include <hip/hip_cooperative_groups.h>
#include <stdint.h>
#include <cstdio>
namespace cg = cooperative_groups;

#define EXP_A 1
#ifndef DUPMASK
#define DUPMASK 0
#endif
#ifndef ONE_LAUNCH
#define ONE_LAUNCH 1
#endif

typedef unsigned short bf16;
typedef __attribute__((ext_vector_type(8))) short s16x8;
typedef __attribute__((ext_vector_type(4))) short s16x4;
typedef __attribute__((ext_vector_type(16))) float f32x16;
typedef __attribute__((ext_vector_type(4))) float f32x4;
typedef __attribute__((ext_vector_type(2))) float f32x2;
typedef __attribute__((ext_vector_type(4))) unsigned u32x4;
typedef __attribute__((ext_vector_type(2))) unsigned u32x2;
typedef __attribute__((ext_vector_type(2))) __bf16 bf16x2_t;

#define DI __device__ __forceinline__
#define MFMA32(a, b, c) __builtin_amdgcn_mfma_f32_32x32x16_bf16((a), (b), (c), 0, 0, 0)

DI int tidx_opaque() { int t = threadIdx.x; asm volatile("" : "+v"(t)); return t; }
#define TIDX tidx_opaque()
DI bf16 f2bf(float x) { return __builtin_bit_cast(unsigned short, (__bf16)x); }
DI float bf2f(bf16 v) { return __uint_as_float(((unsigned)v) << 16); }
DI unsigned pack2(float a, float b) {
  f32x2 v = {a, b};
  return __builtin_bit_cast(unsigned, __builtin_convertvector(v, bf16x2_t));
}
DI float bflo(unsigned u) { return __uint_as_float(u << 16); }
DI float bfhi(unsigned u) { return __uint_as_float(u & 0xffff0000u); }
typedef const __attribute__((address_space(1))) u32x4* gptr16;
DI u32x4 ldg16(const void* q) { return *(gptr16)(uintptr_t)q; }
#define SCHED_FENCE() __builtin_amdgcn_sched_barrier(0)
DI int crow(int i, int h) { return (i & 3) + 8 * (i >> 2) + 4 * h; }
DI void sincos_cw(float x, float& sn, float& cs) {
  const float k = rintf(x * 0.63661977236758134f);
  float r = fmaf(-k, 1.57079637050628662109375f, x);
  r = fmaf(-k, -4.371139000186241e-08f, r);
  const int q = ((int)k) & 3;
  const float r2 = r * r;
  const float sp = r + r * r2 * (-1.6666667163e-01f + r2 * (8.3333337680e-03f + r2 * (-1.9841270114e-04f + r2 * 2.7557314297e-06f)));
  const float cp = 1.f + r2 * (-0.5f + r2 * (4.1666667908e-02f + r2 * (-1.3888889225e-03f + r2 * (2.4801587642e-05f - r2 * 2.7557314297e-07f))));
  sn = (q == 0) ? sp : (q == 1) ? cp : (q == 2) ? -sp : -cp;
  cs = (q == 0) ? cp : (q == 1) ? -sp : (q == 2) ? -cp : sp;
}
DI float sigmoidf_(float x) { return 1.f / (1.f + __expf(-x)); }
DI float siluf_(float x) { return x / (1.f + __expf(-x)); }

constexpr int DM = 1024, NB = 4, SEQ = 8192, CTXL = 256, TT = SEQ + CTXL, NTOK = NB * TT, NL = 4;
constexpr int DFF = 2816, DIN = 5408;
constexpr float EPSF = 1e-6f;
constexpr int NG33 = 33;
constexpr int NCH = 264;
constexpr int MS5 = NB * NCH;

constexpr size_t SZ_H = (size_t)NTOK * 1024 * 2;
constexpr size_t OFF_H = 0;
constexpr size_t OFF_P = OFF_H + SZ_H;
constexpr size_t OFF_Q = OFF_P;
constexpr size_t OFF_K = OFF_Q + (size_t)NTOK * 256 * 2;
constexpr size_t OFF_VT = OFF_K + (size_t)NTOK * 128 * 2;
constexpr size_t OFF_GQ = OFF_VT + (size_t)NTOK * 128 * 2;
constexpr size_t OFF_GK = OFF_GQ + (size_t)NTOK * 256 * 2;
constexpr size_t OFF_GVT = OFF_GK + (size_t)NTOK * 256 * 2;
constexpr size_t OFF_GR = OFF_GVT + (size_t)NTOK * 512 * 2;
constexpr size_t OFF_SU = OFF_GR + (size_t)NTOK * 512 * 2;
constexpr size_t OFF_LOW = OFF_SU + (size_t)NTOK * 256 * 2;
constexpr size_t OFF_O = OFF_LOW + (size_t)NTOK * 32 * 4;
constexpr size_t OFF_OATT = OFF_O;
constexpr size_t OFF_OGLA = OFF_OATT + (size_t)NTOK * 256 * 2;
constexpr size_t OFF_Y5 = OFF_OGLA + (size_t)NTOK * 512 * 2;
constexpr size_t OFF_EN = OFF_Y5;
constexpr size_t OFF_OS5 = OFF_Y5 + (size_t)NTOK * 256 * 2;
constexpr size_t OFF_M = OFF_OS5 + (size_t)NTOK * 256 * 2;
constexpr size_t OFF_MG = OFF_M;
constexpr size_t OFF_GS = OFF_M;
constexpr size_t OFF_DECG = OFF_GS + (size_t)32 * 33 * 8192 * 4;
constexpr size_t OFF_SB = OFF_DECG + (size_t)32 * 33 * 64 * 4;
constexpr size_t OFF_T5 = OFF_SB + (size_t)MS5 * 16 * 256 * 2;
constexpr size_t OFF_E5 = OFF_T5 + (size_t)16 * 512 * 512 * 2;
constexpr size_t OFF_F5 = OFF_E5 + (size_t)16 * 512 * 256 * 2;
constexpr size_t OFF_MEND = OFF_F5 + (size_t)16 * 256 * 512 * 2;
static_assert(OFF_MEND <= OFF_M + SZ_H, "mixer scratch overflows merged area");
constexpr size_t OFF_W = OFF_M + SZ_H;
constexpr size_t WL_WIN = 0, WL_BRA = WL_WIN + (size_t)5504 * 1024, WL_BRG = WL_BRA + 1024 * 256, WL_BRS = WL_BRG + 1024 * 512,
                 WL_WOUT = WL_BRS + 1024 * 256, WL_UP = WL_WOUT + 1024 * 1024, WL_DOWN = WL_UP + (size_t)5632 * 1024,
                 WL_GLU = WL_DOWN + (size_t)1024 * 2816, WL_TOTAL = WL_GLU + 256 * 256;
constexpr size_t OFF_XC = OFF_W + WL_TOTAL * 2 * NL;
constexpr size_t OFF_MOD = OFF_XC + (size_t)NB * CTXL * 1024 * 4;
constexpr size_t OFF_BBR = OFF_MOD + (size_t)NL * 5 * 6144 * 4;
constexpr size_t OFF_BBI = OFF_BBR + (size_t)NL * 2 * 16 * 64 * 16 * 4;
constexpr size_t OFF_PWR = OFF_BBI + (size_t)NL * 2 * 16 * 64 * 16 * 4;
constexpr size_t OFF_KTAB = OFF_PWR + (size_t)NL * 2 * 16 * 33 * 64 * 8;
constexpr size_t OFF_END = OFF_KTAB + (size_t)NL * 16 * 2 * 32 * 256 * 4;
constexpr size_t OFF_BAR = OFF_END;
constexpr size_t OFF_ZERO = OFF_BAR + 16384;
constexpr size_t OFF_G = OFF_P;
static_assert((size_t)NTOK * DFF * 2 <= OFF_M - OFF_P, "G overflows");

constexpr int SMEM_BYTES = 73728;

struct Params {
  const float* in[34];
  float* out;
  char* ws;
};

enum { I_X = 0, I_C, I_CTX, I_CCTX, I_ADAW, I_ADAB, I_NMPRE, I_NMPOST, I_NFPRE, I_NFPOST, I_WIN, I_QN, I_KN, I_GGW, I_GGB, I_GON,
       I_ARE, I_AIM, I_LDT, I_BRE, I_BIM, I_CRE, I_CIM, I_S5D, I_GLUW, I_GLUB, I_WBA, I_WBG, I_WBS, I_WOUT, I_UP, I_CW, I_CB, I_DOWN };

constexpr int LDT = 72;
constexpr int CLD = 132;

template <class FA, class FB>
DI void gemm_main(f32x16 (&acc)[2][2], FA fa, FB fb, int K, char* smem) {
  bf16* As = (bf16*)smem;
  bf16* Bs = (bf16*)(smem + 2 * 128 * LDT * 2);
  const int tid = TIDX, lane = tid & 63, w = tid >> 6, wm = w >> 1, wn = w & 1;
  const int r = lane & 31, h = lane >> 5;
  const int lr = tid >> 3, kc = (tid & 7) * 8;
  const bf16* ap[4];
  const bf16* bp[4];
#pragma unroll
  for (int i = 0; i < 4; ++i) {
    const bf16* a = fa(lr + 32 * i);
    const bf16* b = fb(lr + 32 * i);
    ap[i] = a ? a + kc : nullptr;
    bp[i] = b ? b + kc : nullptr;
  }
  u32x4 ra[4], rb[4];
  const u32x4 z4 = {0u, 0u, 0u, 0u};
#pragma unroll
  for (int i = 0; i < 4; ++i) {
    ra[i] = ap[i] ? ldg16(ap[i]) : z4;
    rb[i] = bp[i] ? ldg16(bp[i]) : z4;
  }
#pragma unroll
  for (int i = 0; i < 4; ++i) {
    *(u32x4*)(As + (lr + 32 * i) * LDT + kc) = ra[i];
    *(u32x4*)(Bs + (lr + 32 * i) * LDT + kc) = rb[i];
  }
  __syncthreads();
  const int nk = K / 64;
  for (int kt = 0; kt < nk; ++kt) {
    const int buf = kt & 1;
    const bool more = (kt + 1 < nk);
    if (more) {
      const int k0 = (kt + 1) * 64;
#pragma unroll
      for (int i = 0; i < 4; ++i) {
        ra[i] = ap[i] ? ldg16(ap[i] + k0) : z4;
        rb[i] = bp[i] ? ldg16(bp[i] + k0) : z4;
      }
    }
    SCHED_FENCE();
    const bf16* Ab = As + buf * 128 * LDT + (wm * 64 + r) * LDT + h * 8;
    const bf16* Bb = Bs + buf * 128 * LDT + (wn * 64 + r) * LDT + h * 8;
#pragma unroll
    for (int s = 0; s < 4; ++s) {
      s16x8 a0 = *(const s16x8*)(Ab + s * 16);
      s16x8 a1 = *(const s16x8*)(Ab + 32 * LDT + s * 16);
      s16x8 b0 = *(const s16x8*)(Bb + s * 16);
      s16x8 b1 = *(const s16x8*)(Bb + 32 * LDT + s * 16);
      acc[0][0] = MFMA32(a0, b0, acc[0][0]);
      acc[0][1] = MFMA32(a0, b1, acc[0][1]);
      acc[1][0] = MFMA32(a1, b0, acc[1][0]);
      acc[1][1] = MFMA32(a1, b1, acc[1][1]);
    }
    SCHED_FENCE();
    if (more) {
      bf16* Aw = As + (buf ^ 1) * 128 * LDT;
      bf16* Bw = Bs + (buf ^ 1) * 128 * LDT;
#pragma unroll
      for (int i = 0; i < 4; ++i) {
        *(u32x4*)(Aw + (lr + 32 * i) * LDT + kc) = ra[i];
        *(u32x4*)(Bw + (lr + 32 * i) * LDT + kc) = rb[i];
      }
    }
    __syncthreads();
  }
}

template <class FA, class FB>
DI void gemm_main_deep(f32x16 (&acc)[2][2], FA fa, FB fb, int K, char* smem) {
  bf16* As = (bf16*)smem;
  bf16* Bs = (bf16*)(smem + 2 * 128 * LDT * 2);
  const int tid = TIDX, lane = tid & 63, w = tid >> 6, wm = w >> 1, wn = w & 1;
  const int r = lane & 31, h = lane >> 5;
  const int lr = tid >> 3, kc = (tid & 7) * 8;
  const bf16* ap[4];
  const bf16* bp[4];
#pragma unroll
  for (int i = 0; i < 4; ++i) {
    const bf16* a = fa(lr + 32 * i);
    const bf16* b = fb(lr + 32 * i);
    ap[i] = a ? a + kc : nullptr;
    bp[i] = b ? b + kc : nullptr;
  }
  const u32x4 z4 = {0u, 0u, 0u, 0u};
  u32x4 a0[4], b0[4], a1[4], b1[4];
  const int nk = K / 64;
#define GD_LOAD(RA, RB, T)                                               \
  {                                                                      \
    const int k0_ = (T) * 64;                                            \
    _Pragma("unroll") for (int i = 0; i < 4; ++i) {                      \
      RA[i] = ap[i] ? ldg16(ap[i] + k0_) : z4;                           \
      RB[i] = bp[i] ? ldg16(bp[i] + k0_) : z4;                           \
    }                                                                    \
  }
#define GD_STORE(RA, RB, BUF)                                            \
  {                                                                      \
    _Pragma("unroll") for (int i = 0; i < 4; ++i) {                      \
      *(u32x4*)(As + (BUF) * 128 * LDT + (lr + 32 * i) * LDT + kc) = RA[i]; \
      *(u32x4*)(Bs + (BUF) * 128 * LDT + (lr + 32 * i) * LDT + kc) = RB[i]; \
    }                                                                    \
  }
#define GD_COMPUTE(BUF)                                                  \
  {                                                                      \
    const bf16* Ab = As + (BUF) * 128 * LDT + (wm * 64 + r) * LDT + h * 8; \
    const bf16* Bb = Bs + (BUF) * 128 * LDT + (wn * 64 + r) * LDT + h * 8; \
    _Pragma("unroll") for (int s = 0; s < 4; ++s) {                      \
      s16x8 fa0 = *(const s16x8*)(Ab + s * 16);                          \
      s16x8 fa1 = *(const s16x8*)(Ab + 32 * LDT + s * 16);               \
      s16x8 fb0 = *(const s16x8*)(Bb + s * 16);                          \
      s16x8 fb1 = *(const s16x8*)(Bb + 32 * LDT + s * 16);               \
      acc[0][0] = MFMA32(fa0, fb0, acc[0][0]);                           \
      acc[0][1] = MFMA32(fa0, fb1, acc[0][1]);                           \
      acc[1][0] = MFMA32(fa1, fb0, acc[1][0]);                           \
      acc[1][1] = MFMA32(fa1, fb1, acc[1][1]);                           \
    }                                                                    \
  }
  GD_LOAD(a0, b0, 0)
  GD_LOAD(a1, b1, 1)
  GD_STORE(a0, b0, 0)
  __syncthreads();
  if (nk > 2) GD_LOAD(a0, b0, 2)
  for (int kt = 0; kt < nk; kt += 2) {
    SCHED_FENCE();
    GD_COMPUTE(0)
    SCHED_FENCE();
    GD_STORE(a1, b1, 1)
    if (kt + 3 < nk) GD_LOAD(a1, b1, kt + 3)
    __syncthreads();
    SCHED_FENCE();
    GD_COMPUTE(1)
    SCHED_FENCE();
    if (kt + 2 < nk) {
      GD_STORE(a0, b0, 0)
      if (kt + 4 < nk) GD_LOAD(a0, b0, kt + 4)
    }
    __syncthreads();
  }
#undef GD_LOAD
#undef GD_STORE
#undef GD_COMPUTE
}

template <class FA, class FB>
DI void gemm_main_dma(f32x16 (&acc)[2][2], FA fa, FB fb, int K, char* smem) {
  char* As = smem;
  char* Bs = smem + 32768;
  const int tid = TIDX, lane = tid & 63, w = tid >> 6, wm = w >> 1, wn = w & 1;
  const int r = lane & 31, h = lane >> 5;
  const bf16* ap[4];
  const bf16* bp[4];
#pragma unroll
  for (int i = 0; i < 4; ++i) {
    const int row = w * 32 + i * 8 + (lane >> 3);
    const int c = (lane & 7) ^ ((row >> 1) & 7);
    ap[i] = fa(row) + c * 8;
    bp[i] = fb(row) + c * 8;
  }
  const int ldst = (w * 256 + lane) * 16;
#define GM_DMA(BUF, T)                                                                                        \
  {                                                                                                           \
    const int k0_ = (T) * 64;                                                                                 \
    _Pragma("unroll") for (int i = 0; i < 4; ++i) {                                                           \
      __builtin_amdgcn_global_load_lds((const unsigned*)(ap[i] + k0_), (unsigned*)(As + (BUF) * 16384 + ldst + i * 1024), 16, 0, 0); \
      __builtin_amdgcn_global_load_lds((const unsigned*)(bp[i] + k0_), (unsigned*)(Bs + (BUF) * 16384 + ldst + i * 1024), 16, 0, 0); \
    }                                                                                                         \
  }
  const int xr = (r >> 1) & 7;
  const int arow = (wm * 64 + r) * 128, brow = (wn * 64 + r) * 128;
  GM_DMA(0, 0)
  asm volatile("s_waitcnt vmcnt(0)" ::: "memory");
  __syncthreads();
  const int nk = K / 64;
  for (int kt = 0; kt < nk; ++kt) {
    const int buf = kt & 1;
    if (kt + 1 < nk) GM_DMA(buf ^ 1, kt + 1)
    const char* Ab = As + buf * 16384 + arow;
    const char* Bb = Bs + buf * 16384 + brow;
#pragma unroll
    for (int s = 0; s < 4; ++s) {
      const int co = ((2 * s + h) ^ xr) * 16;
      s16x8 a0 = *(const s16x8*)(Ab + co);
      s16x8 a1 = *(const s16x8*)(Ab + 32 * 128 + co);
      s16x8 b0 = *(const s16x8*)(Bb + co);
      s16x8 b1 = *(const s16x8*)(Bb + 32 * 128 + co);
      acc[0][0] = MFMA32(a0, b0, acc[0][0]);
      acc[0][1] = MFMA32(a0, b1, acc[0][1]);
      acc[1][0] = MFMA32(a1, b0, acc[1][0]);
      acc[1][1] = MFMA32(a1, b1, acc[1][1]);
    }
    asm volatile("s_waitcnt vmcnt(0)" ::: "memory");
    __syncthreads();
  }
#undef GM_DMA
}

DI void gemm_main_dma_half(f32x16 (&acc)[2], const bf16* A, int lda, const bf16* B, int ldb, int K, int hf, char* smem) {
  char* As = smem;
  char* Bs = smem + 32768;
  const int tid = TIDX, lane = tid & 63, w = tid >> 6, wm = w >> 1, wn = w & 1;
  const int r = lane & 31, h = lane >> 5;
  const bf16* ap[4];
  const bf16* bp[2];
#pragma unroll
  for (int i = 0; i < 4; ++i) {
    const int row = w * 32 + i * 8 + (lane >> 3);
    ap[i] = A + (size_t)row * lda + ((lane & 7) ^ ((row >> 1) & 7)) * 8;
  }
#pragma unroll
  for (int i = 0; i < 2; ++i) {
    const int lrow = w * 16 + i * 8 + (lane >> 3);
    const int grow = (lrow >> 5) * 64 + hf * 32 + (lrow & 31);
    bp[i] = B + (size_t)grow * ldb + ((lane & 7) ^ ((lrow >> 1) & 7)) * 8;
  }
  const int lda_ = (w * 256 + lane) * 16, ldb_ = (w * 128 + lane) * 16;
#define GH_DMA(BUF, T)                                                                                        \
  {                                                                                                           \
    const int k0_ = (T) * 64;                                                                                 \
    _Pragma("unroll") for (int i = 0; i < 4; ++i)                                                             \
      __builtin_amdgcn_global_load_lds((const unsigned*)(ap[i] + k0_), (unsigned*)(As + (BUF) * 16384 + lda_ + i * 1024), 16, 0, 0); \
    _Pragma("unroll") for (int i = 0; i < 2; ++i)                                                             \
      __builtin_amdgcn_global_load_lds((const unsigned*)(bp[i] + k0_), (unsigned*)(Bs + (BUF) * 8192 + ldb_ + i * 1024), 16, 0, 0); \
  }
  const int xr = (r >> 1) & 7;
  const int arow = (wm * 64 + r) * 128, brow = (wn * 32 + r) * 128;
  GH_DMA(0, 0)
  asm volatile("s_waitcnt vmcnt(0)" ::: "memory");
  __syncthreads();
  const int nk = K / 64;
  for (int kt = 0; kt < nk; ++kt) {
    const int buf = kt & 1;
    if (kt + 1 < nk) GH_DMA(buf ^ 1, kt + 1)
    const char* Ab = As + buf * 16384 + arow;
    const char* Bb = Bs + buf * 8192 + brow;
#pragma unroll
    for (int s = 0; s < 4; ++s) {
      const int co = ((2 * s + h) ^ xr) * 16;
      s16x8 a0 = *(const s16x8*)(Ab + co);
      s16x8 a1 = *(const s16x8*)(Ab + 32 * 128 + co);
      s16x8 b0 = *(const s16x8*)(Bb + co);
      acc[0] = MFMA32(a0, b0, acc[0]);
      acc[1] = MFMA32(a1, b0, acc[1]);
    }
    asm volatile("s_waitcnt vmcnt(0)" ::: "memory");
    __syncthreads();
  }
#undef GH_DMA
}

template <class FA, class FB>
DI void gemm_wide(f32x16 (&acc)[2][4], FA fa, FB fb, int K, char* smem) {
  const int tid = TIDX, lane = tid & 63, w = tid >> 6, wm = w >> 1, wn = w & 1;
  const int r = lane & 31, h = lane >> 5;
  const bf16* ap[2];
  const bf16* bp[4];
#pragma unroll
  for (int i = 0; i < 2; ++i) {
    const int row = w * 32 + i * 16 + (lane >> 2);
    ap[i] = fa(row) + ((lane & 3) ^ ((row >> 2) & 3)) * 8;
  }
#pragma unroll
  for (int i = 0; i < 4; ++i) {
    const int row = w * 64 + i * 16 + (lane >> 2);
    bp[i] = fb(row) + ((lane & 3) ^ ((row >> 2) & 3)) * 8;
  }
  const int lda_ = (w * 128 + lane) * 16;
  const int ldb_ = 8192 + (w * 256 + lane) * 16;
#define GW_DMA(T)                                                                                                   \
  {                                                                                                                 \
    char* st_ = smem + ((T) % 3) * 24576;                                                                           \
    const int k0_ = (T) * 32;                                                                                       \
    _Pragma("unroll") for (int i = 0; i < 2; ++i)                                                                   \
      __builtin_amdgcn_global_load_lds((const unsigned*)(ap[i] + k0_), (unsigned*)(st_ + lda_ + i * 1024), 16, 0, 0); \
    _Pragma("unroll") for (int i = 0; i < 4; ++i)                                                                   \
      __builtin_amdgcn_global_load_lds((const unsigned*)(bp[i] + k0_), (unsigned*)(st_ + ldb_ + i * 1024), 16, 0, 0); \
  }
  const int xr = (r >> 2) & 3;
  const int arow = (wm * 64 + r) * 64;
  const int brow = 8192 + (wn * 64 + r) * 64;
  const int nt = K / 32;
  GW_DMA(0)
  if (nt > 1) GW_DMA(1)
  for (int t = 0; t < nt; ++t) {
    if (t + 1 < nt) asm volatile("s_waitcnt vmcnt(6)" ::: "memory");
    else asm volatile("s_waitcnt vmcnt(0)" ::: "memory");
    __syncthreads();
    if (t + 2 < nt) GW_DMA(t + 2)
    const char* st = smem + (t % 3) * 24576;
#pragma unroll
    for (int s = 0; s < 2; ++s) {
      const int co = ((2 * s + h) ^ xr) * 16;
      const s16x8 a0 = *(const s16x8*)(st + arow + co);
      const s16x8 a1 = *(const s16x8*)(st + arow + 32 * 64 + co);
#pragma unroll
      for (int hn = 0; hn < 2; ++hn) {
        const s16x8 b0 = *(const s16x8*)(st + brow + hn * 128 * 64 + co);
        const s16x8 b1 = *(const s16x8*)(st + brow + hn * 128 * 64 + 32 * 64 + co);
        acc[0][hn * 2 + 0] = MFMA32(a0, b0, acc[0][hn * 2 + 0]);
        acc[0][hn * 2 + 1] = MFMA32(a0, b1, acc[0][hn * 2 + 1]);
        acc[1][hn * 2 + 0] = MFMA32(a1, b0, acc[1][hn * 2 + 0]);
        acc[1][hn * 2 + 1] = MFMA32(a1, b1, acc[1][hn * 2 + 1]);
      }
    }
  }
  __syncthreads();
#undef GW_DMA
}

DI void accw_zero(f32x16 (&acc)[2][4]) {
#pragma unroll
  for (int a = 0; a < 2; ++a)
#pragma unroll
    for (int b = 0; b < 4; ++b)
#pragma unroll
      for (int i = 0; i < 16; ++i) acc[a][b][i] = 0.f;
}

DI void gemm_main_s(f32x16 (&acc)[2][2], const bf16* A, int lda, const bf16* B, int ldb, int K, char* smem) {
  bf16* As = (bf16*)smem;
  bf16* Bs = (bf16*)(smem + 2 * 128 * LDT * 2);
  const int tid = TIDX, lane = tid & 63, w = tid >> 6, wm = w >> 1, wn = w & 1;
  const int r = lane & 31, h = lane >> 5;
  const int lr = tid >> 3, kc = (tid & 7) * 8;
  const bf16* ap = A + (size_t)lr * lda + kc;
  const bf16* bp = B + (size_t)lr * ldb + kc;
  const size_t sa = (size_t)32 * lda, sb = (size_t)32 * ldb;
  u32x4 ra[4], rb[4];
#pragma unroll
  for (int i = 0; i < 4; ++i) {
    ra[i] = ldg16(ap + i * sa);
    rb[i] = ldg16(bp + i * sb);
  }
#pragma unroll
  for (int i = 0; i < 4; ++i) {
    *(u32x4*)(As + (lr + 32 * i) * LDT + kc) = ra[i];
    *(u32x4*)(Bs + (lr + 32 * i) * LDT + kc) = rb[i];
  }
  __syncthreads();
  const int nk = K / 64;
  for (int kt = 0; kt < nk; ++kt) {
    const int buf = kt & 1;
    const bool more = (kt + 1 < nk);
    if (more) {
      ap += 64; bp += 64;
#pragma unroll
      for (int i = 0; i < 4; ++i) {
        ra[i] = ldg16(ap + i * sa);
        rb[i] = ldg16(bp + i * sb);
      }
    }
    SCHED_FENCE();
    const bf16* Ab = As + buf * 128 * LDT + (wm * 64 + r) * LDT + h * 8;
    const bf16* Bb = Bs + buf * 128 * LDT + (wn * 64 + r) * LDT + h * 8;
#pragma unroll
    for (int s = 0; s < 4; ++s) {
      s16x8 a0 = *(const s16x8*)(Ab + s * 16);
      s16x8 a1 = *(const s16x8*)(Ab + 32 * LDT + s * 16);
      s16x8 b0 = *(const s16x8*)(Bb + s * 16);
      s16x8 b1 = *(const s16x8*)(Bb + 32 * LDT + s * 16);
      acc[0][0] = MFMA32(a0, b0, acc[0][0]);
      acc[0][1] = MFMA32(a0, b1, acc[0][1]);
      acc[1][0] = MFMA32(a1, b0, acc[1][0]);
      acc[1][1] = MFMA32(a1, b1, acc[1][1]);
    }
    SCHED_FENCE();
    if (more) {
      bf16* Aw = As + (buf ^ 1) * 128 * LDT;
      bf16* Bw = Bs + (buf ^ 1) * 128 * LDT;
#pragma unroll
      for (int i = 0; i < 4; ++i) {
        *(u32x4*)(Aw + (lr + 32 * i) * LDT + kc) = ra[i];
        *(u32x4*)(Bw + (lr + 32 * i) * LDT + kc) = rb[i];
      }
    }
    __syncthreads();
  }
}

DI void gemm_main_half(f32x16 (&acc)[2], const bf16* A, int lda, const bf16* B, int ldb, int K, int hf, char* smem) {
  bf16* As = (bf16*)smem;
  bf16* Bs = (bf16*)(smem + 2 * 128 * LDT * 2);
  const int tid = TIDX, lane = tid & 63, w = tid >> 6, wm = w >> 1, wn = w & 1;
  const int r = lane & 31, h = lane >> 5;
  const int lr = tid >> 3, kc = (tid & 7) * 8;
  const bf16* ap = A + (size_t)lr * lda + kc;
  const bf16* bp = B + (size_t)(hf * 32 + lr) * ldb + kc;
  const size_t sa = (size_t)32 * lda, sb = (size_t)64 * ldb;
  u32x4 ra[4], rb[2];
#pragma unroll
  for (int i = 0; i < 4; ++i) ra[i] = ldg16(ap + i * sa);
#pragma unroll
  for (int i = 0; i < 2; ++i) rb[i] = ldg16(bp + i * sb);
#pragma unroll
  for (int i = 0; i < 4; ++i) *(u32x4*)(As + (lr + 32 * i) * LDT + kc) = ra[i];
#pragma unroll
  for (int i = 0; i < 2; ++i) *(u32x4*)(Bs + (lr + 32 * i) * LDT + kc) = rb[i];
  __syncthreads();
  const int nk = K / 64;
  for (int kt = 0; kt < nk; ++kt) {
    const int buf = kt & 1;
    const bool more = (kt + 1 < nk);
    if (more) {
      ap += 64; bp += 64;
#pragma unroll
      for (int i = 0; i < 4; ++i) ra[i] = ldg16(ap + i * sa);
#pragma unroll
      for (int i = 0; i < 2; ++i) rb[i] = ldg16(bp + i * sb);
    }
    SCHED_FENCE();
    const bf16* Ab = As + buf * 128 * LDT + (wm * 64 + r) * LDT + h * 8;
    const bf16* Bb = Bs + buf * 128 * LDT + (wn * 32 + r) * LDT + h * 8;
#pragma unroll
    for (int s = 0; s < 4; ++s) {
      s16x8 a0 = *(const s16x8*)(Ab + s * 16);
      s16x8 a1 = *(const s16x8*)(Ab + 32 * LDT + s * 16);
      s16x8 b0 = *(const s16x8*)(Bb + s * 16);
      acc[0] = MFMA32(a0, b0, acc[0]);
      acc[1] = MFMA32(a1, b0, acc[1]);
    }
    SCHED_FENCE();
    if (more) {
      bf16* Aw = As + (buf ^ 1) * 128 * LDT;
      bf16* Bw = Bs + (buf ^ 1) * 128 * LDT;
#pragma unroll
      for (int i = 0; i < 4; ++i) *(u32x4*)(Aw + (lr + 32 * i) * LDT + kc) = ra[i];
#pragma unroll
      for (int i = 0; i < 2; ++i) *(u32x4*)(Bw + (lr + 32 * i) * LDT + kc) = rb[i];
    }
    __syncthreads();
  }
}

DI void acc_zero(f32x16 (&acc)[2][2]) {
#pragma unroll
  for (int a = 0; a < 2; ++a)
#pragma unroll
    for (int b = 0; b < 2; ++b)
#pragma unroll
      for (int i = 0; i < 16; ++i) acc[a][b][i] = 0.f;
}

DI void acc_to_lds(const f32x16 (&acc)[2][2], float* Cs) {
  const int lane = TIDX & 63, w = TIDX >> 6, wm = w >> 1, wn = w & 1, r = lane & 31, h = lane >> 5;
#pragma unroll
  for (int tm = 0; tm < 2; ++tm)
#pragma unroll
    for (int tn = 0; tn < 2; ++tn)
#pragma unroll
      for (int i = 0; i < 16; ++i) Cs[(wm * 64 + tm * 32 + crow(i, h)) * CLD + wn * 64 + tn * 32 + r] = acc[tm][tn][i];
}

template <int HN>
DI void accw_to_lds(const f32x16 (&acc)[2][4], float* Cs) {
  const int lane = TIDX & 63, w = TIDX >> 6, wm = w >> 1, wn = w & 1, r = lane & 31, h = lane >> 5;
#pragma unroll
  for (int tm = 0; tm < 2; ++tm)
#pragma unroll
    for (int tn = 0; tn < 2; ++tn)
#pragma unroll
      for (int i = 0; i < 16; ++i) Cs[(wm * 64 + tm * 32 + crow(i, h)) * CLD + wn * 64 + tn * 32 + r] = acc[tm][HN * 2 + tn][i];
}

DI void store_tile_bf16(const float* Cs, bf16* dst, size_t ld, int mvalid, float scale) {
  for (int c = TIDX; c < 2048; c += 256) {
    const int row = c >> 4, cc = (c & 15) * 8;
    if (row < mvalid) {
      const float* s = Cs + row * CLD + cc;
      u32x4 v;
      v[0] = pack2(s[0] * scale, s[1] * scale);
      v[1] = pack2(s[2] * scale, s[3] * scale);
      v[2] = pack2(s[4] * scale, s[5] * scale);
      v[3] = pack2(s[6] * scale, s[7] * scale);
      *(u32x4*)(dst + (size_t)row * ld + cc) = v;
    }
  }
}

DI float* resid_row(const Params& p, int tok) {
  const int b = tok / TT, t = tok - b * TT;
  return (t < CTXL) ? (float*)(p.ws + OFF_XC) + ((size_t)b * CTXL + t) * DM : p.out + ((size_t)b * SEQ + (t - CTXL)) * DM;
}
DI const float* mod_vec(const Params& p, int l, int tok, int which) {
  const int b = tok / TT, t = tok - b * TT;
  const int m = (t < CTXL) ? 4 : b;
  return (const float*)(p.ws + OFF_MOD) + ((size_t)(l * 5 + m) * 6 + which) * DM;
}
DI float wave_sum(float v) {
#pragma unroll
  for (int o = 32; o >= 1; o >>= 1) v += __shfl_xor(v, o, 64);
  return v;
}
DI bf16* wl(const Params& p, int l, size_t off) { return (bf16*)(p.ws + OFF_W) + (size_t)l * WL_TOTAL + off; }

DI void prep_mod_job(const Params& p, int j, char* smem) {
  float* sc = (float*)smem;
  float* part = (float*)(smem + 20480);
  const int l = j / 24, nb = j % 24, tid = TIDX, lane = tid & 63, w = tid >> 6;
  for (int idx = tid; idx < 5120; idx += 256) {
    const int m = idx >> 10, k = idx & 1023;
    const float v = (m < 4) ? p.in[I_C][m * 1024 + k] : p.in[I_CCTX][k];
    sc[idx] = siluf_(v);
  }
  __syncthreads();
  const float* W = p.in[I_ADAW] + (size_t)l * 1024 * 6144 + nb * 256 + lane;
  float a[5][4];
#pragma unroll
  for (int m = 0; m < 5; ++m)
#pragma unroll
    for (int c = 0; c < 4; ++c) a[m][c] = 0.f;
#pragma unroll 4
  for (int kk = 0; kk < 256; ++kk) {
    const int k = w * 256 + kk;
    float wv[4];
#pragma unroll
    for (int c = 0; c < 4; ++c) wv[c] = W[(size_t)k * 6144 + 64 * c];
#pragma unroll
    for (int m = 0; m < 5; ++m) {
      const float sv = sc[m * 1024 + k];
#pragma unroll
      for (int c = 0; c < 4; ++c) a[m][c] += sv * wv[c];
    }
  }
#pragma unroll
  for (int m = 0; m < 5; ++m)
#pragma unroll
    for (int c = 0; c < 4; ++c) part[(w * 5 + m) * 256 + lane + 64 * c] = a[m][c];
  __syncthreads();
  const int n = nb * 256 + tid;
  const float bb = p.in[I_ADAB][l * 6144 + n];
  float* M = (float*)(p.ws + OFF_MOD) + (size_t)l * 5 * 6144 + n;
#pragma unroll
  for (int m = 0; m < 5; ++m)
    M[m * 6144] = part[(0 * 5 + m) * 256 + tid] + part[(1 * 5 + m) * 256 + tid] + part[(2 * 5 + m) * 256 + tid] + part[(3 * 5 + m) * 256 + tid] + bb;
  __syncthreads();
}

DI void prep_s5_job(const Params& p, int j) {
  const int idx = j * 256 + TIDX;
  const int ldg = idx >> 6, pp = idx & 63;
  const float dt = expf(p.in[I_LDT][ldg]);
  const float are = p.in[I_ARE][idx], aim = p.in[I_AIM][idx];
  const float mag = expf(are * dt);
  float sn, cs;
  sincos_cw(aim * dt, sn, cs);
  const float abr = mag * cs, abi = mag * sn;
  const float den = are * are + aim * aim;
  const float fre = ((abr - 1.f) * are + abi * aim) / den;
  const float fim = (abi * are - (abr - 1.f) * aim) / den;
  float* BBR = (float*)(p.ws + OFF_BBR);
  float* BBI = (float*)(p.ws + OFF_BBI);
  for (int hh = 0; hh < 16; ++hh) {
    const float br = p.in[I_BRE][(size_t)idx * 16 + hh], bi = p.in[I_BIM][(size_t)idx * 16 + hh];
    BBR[(size_t)idx * 16 + hh] = fre * br - fim * bi;
    BBI[(size_t)idx * 16 + hh] = fre * bi + fim * br;
  }
  float2* PW = (float2*)(p.ws + OFF_PWR);
  float pr = 1.f, pi = 0.f;
  for (int tau = 0; tau <= 32; ++tau) {
    PW[((size_t)ldg * 33 + tau) * 64 + pp] = make_float2(pr, pi);
    const float nr = pr * abr - pi * abi, ni = pr * abi + pi * abr;
    pr = nr; pi = ni;
  }
}

DI void prep_wt_job(const Params& p, int jj, char* smem) {
  float* tile = (float*)smem;
  const int l = jj / 4016;
  int r = jj % 4016;
  int mat = 0;
  const int cnt[8] = {1376, 64, 128, 64, 256, 1408, 704, 16};
#pragma unroll
  for (int m = 0; m < 8; ++m) {
    if (mat == m && r >= cnt[m]) { r -= cnt[m]; mat = m + 1; }
  }
  const float* src; int K, sld; size_t doff;
  switch (mat) {
    case 0: src = p.in[I_WIN] + (size_t)l * 1024 * DIN; K = 1024; sld = DIN; doff = WL_WIN; break;
    case 1: src = p.in[I_WBA] + (size_t)l * 256 * 1024; K = 256; sld = 1024; doff = WL_BRA; break;
    case 2: src = p.in[I_WBG] + (size_t)l * 512 * 1024; K = 512; sld = 1024; doff = WL_BRG; break;
    case 3: src = p.in[I_WBS] + (size_t)l * 256 * 1024; K = 256; sld = 1024; doff = WL_BRS; break;
    case 4: src = p.in[I_WOUT] + (size_t)l * 1024 * 1024; K = 1024; sld = 1024; doff = WL_WOUT; break;
    case 5: src = p.in[I_UP] + (size_t)l * 1024 * 5632; K = 1024; sld = 5632; doff = WL_UP; break;
    case 6: src = p.in[I_DOWN] + (size_t)l * 2816 * 1024; K = 2816; sld = 1024; doff = WL_DOWN; break;
    default: src = p.in[I_GLUW] + (size_t)l * 256 * 256; K = 256; sld = 256; doff = WL_GLU; break;
  }
  const int kt = K / 64;
  const int n0 = (r / kt) * 64, k0 = (r % kt) * 64;
  const int tid = TIDX;
  {
    const int nn = tid & 63;
    const int np = n0 + nn;
    int col;
    if (mat == 0) {
      if (np < 2048) col = np;
      else if (np < 2304) col = 2080 + (np - 2048);
      else if (np < 2336) col = 2048 + (np - 2304);
      else if (np < 2432) col = -1;
      else col = 2336 + (np - 2432);
    } else if (mat == 5) {
      const int jb = np >> 7, c = np & 127;
      col = (c < 64) ? (jb * 64 + c) : (DFF + jb * 64 + (c - 64));
    } else col = np;
#pragma unroll 4
    for (int kk = tid >> 6; kk < 64; kk += 4) tile[kk * 65 + nn] = (col >= 0) ? src[(size_t)(k0 + kk) * sld + col] : 0.f;
  }
  __syncthreads();
  {
    const int nn = tid >> 2, kq = (tid & 3) * 16;
    bf16* d = wl(p, l, doff) + (size_t)(n0 + nn) * K + k0 + kq;
    u32x4 v0, v1;
#pragma unroll
    for (int e = 0; e < 4; ++e) {
      v0[e] = pack2(tile[(kq + 2 * e) * 65 + nn], tile[(kq + 2 * e + 1) * 65 + nn]);
      v1[e] = pack2(tile[(kq + 8 + 2 * e) * 65 + nn], tile[(kq + 8 + 2 * e + 1) * 65 + nn]);
    }
    *(u32x4*)d = v0;
    *(u32x4*)(d + 8) = v1;
  }
  __syncthreads();
}

template <int MODE>
DI void row_job(const Params& p, int l, int tok) {
  const int lane = TIDX & 63;
  float x[16];
  float* xr = resid_row(p, tok);
  if (MODE == 0) {
    const int b = tok / TT, t = tok - b * TT;
    const float* src = (t < CTXL) ? p.in[I_CTX] + ((size_t)b * CTXL + t) * DM : p.in[I_X] + ((size_t)b * SEQ + (t - CTXL)) * DM;
#pragma unroll
    for (int i = 0; i < 4; ++i) {
      const f32x4 v = *(const f32x4*)(src + lane * 4 + 256 * i);
      x[4 * i] = v[0]; x[4 * i + 1] = v[1]; x[4 * i + 2] = v[2]; x[4 * i + 3] = v[3];
      *(f32x4*)(xr + lane * 4 + 256 * i) = v;
    }
  } else {
    const bf16* yr = (const bf16*)(p.ws + OFF_H) + (size_t)tok * DM;
    const float* gpost = p.in[MODE == 1 ? I_NMPOST : I_NFPOST] + l * DM;
    const float* mg = mod_vec(p, l, tok, MODE == 1 ? 2 : 5);
    float y[16];
    float ss = 0.f;
#pragma unroll
    for (int i = 0; i < 4; ++i) {
      const u32x2 u = *(const u32x2*)(yr + lane * 4 + 256 * i);
      y[4 * i] = bflo(u[0]); y[4 * i + 1] = bfhi(u[0]); y[4 * i + 2] = bflo(u[1]); y[4 * i + 3] = bfhi(u[1]);
#pragma unroll
      for (int e = 0; e < 4; ++e) ss += y[4 * i + e] * y[4 * i + e];
    }
    ss = wave_sum(ss);
    const float rstd = rsqrtf(ss * (1.f / DM) + EPSF);
#pragma unroll
    for (int i = 0; i < 4; ++i) {
      f32x4 v = *(const f32x4*)(xr + lane * 4 + 256 * i);
      const f32x4 g = *(const f32x4*)(gpost + lane * 4 + 256 * i);
      const f32x4 m = *(const f32x4*)(mg + lane * 4 + 256 * i);
#pragma unroll
      for (int e = 0; e < 4; ++e) { v[e] += m[e] * (y[4 * i + e] * rstd * g[e]); x[4 * i + e] = v[e]; }
      *(f32x4*)(xr + lane * 4 + 256 * i) = v;
    }
  }
  if (MODE == 2 && l == NL - 1) return;
  const int ln = (MODE == 2) ? l + 1 : l;
  const float* gpre = p.in[MODE == 1 ? I_NFPRE : I_NMPRE] + ln * DM;
  const float* sh = mod_vec(p, ln, tok, MODE == 1 ? 3 : 0);
  const float* scv = mod_vec(p, ln, tok, MODE == 1 ? 4 : 1);
  float ss = 0.f;
#pragma unroll
  for (int i = 0; i < 16; ++i) ss += x[i] * x[i];
  ss = wave_sum(ss);
  const float rstd = rsqrtf(ss * (1.f / DM) + EPSF);
  bf16* hr = (bf16*)(p.ws + OFF_H) + (size_t)tok * DM;
#pragma unroll
  for (int i = 0; i < 4; ++i) {
    const f32x4 g = *(const f32x4*)(gpre + lane * 4 + 256 * i);
    const f32x4 s1 = *(const f32x4*)(sh + lane * 4 + 256 * i);
    const f32x4 s2 = *(const f32x4*)(scv + lane * 4 + 256 * i);
    float o[4];
#pragma unroll
    for (int e = 0; e < 4; ++e) o[e] = (x[4 * i + e] * rstd * g[e]) * (1.f + s2[e]) + s1[e];
    u32x2 u;
    u[0] = pack2(o[0], o[1]); u[1] = pack2(o[2], o[3]);
    *(u32x2*)(hr + lane * 4 + 256 * i) = u;
  }
}

template <int MODE>
DI void row_phase(const Params& p, int l, int bid, int G) {
  const int lane = TIDX & 63;
  const int wg = bid * 4 + (TIDX >> 6), nw = G * 4;
  const int R = (NTOK + nw - 1) / nw;
  const int t0 = wg * R, t1 = min(NTOK, t0 + R);
  if (t0 >= t1) return;
  const bool has_next = !(MODE == 2 && l == NL - 1);
  const int ln = (MODE == 2) ? l + 1 : l;
  f32x4 gpost[4], gpre[4], mg[4], sh[4], scl[4];
#pragma unroll
  for (int i = 0; i < 4; ++i) {
    if (MODE != 0) gpost[i] = *(const f32x4*)(p.in[MODE == 1 ? I_NMPOST : I_NFPOST] + l * DM + lane * 4 + 256 * i);
    if (has_next) gpre[i] = *(const f32x4*)(p.in[MODE == 1 ? I_NFPRE : I_NMPRE] + ln * DM + lane * 4 + 256 * i);
  }
  int cur_m = -1;
  u32x2 yb[4], yn[4];
  f32x4 xb[4], xn[4];
  const bf16* Hb = (const bf16*)(p.ws + OFF_H);
#define ROW_LOAD(TOK, YY, XX)                                                                              \
  {                                                                                                        \
    const int b_ = (TOK) / TT, t_ = (TOK) - b_ * TT;                                                       \
    const float* src_ = (MODE == 0) ? ((t_ < CTXL) ? p.in[I_CTX] + ((size_t)b_ * CTXL + t_) * DM           \
                                                   : p.in[I_X] + ((size_t)b_ * SEQ + (t_ - CTXL)) * DM)    \
                                    : resid_row(p, (TOK));                                                 \
    _Pragma("unroll") for (int i = 0; i < 4; ++i) {                                                        \
      XX[i] = *(const f32x4*)(src_ + lane * 4 + 256 * i);                                                  \
      if (MODE != 0) YY[i] = *(const u32x2*)(Hb + (size_t)(TOK) * DM + lane * 4 + 256 * i);                \
    }                                                                                                      \
  }
  ROW_LOAD(t0, yb, xb)
  for (int tok = t0; tok < t1; ++tok) {
    if (tok + 1 < t1) ROW_LOAD(tok + 1, yn, xn)
    const int b = tok / TT, t = tok - b * TT;
    const int m = (t < CTXL) ? 4 : b;
    if (m != cur_m) {
      cur_m = m;
      const float* Mv = (const float*)(p.ws + OFF_MOD);
#pragma unroll
      for (int i = 0; i < 4; ++i) {
        if (MODE != 0) mg[i] = *(const f32x4*)(Mv + ((size_t)(l * 5 + m) * 6 + (MODE == 1 ? 2 : 5)) * DM + lane * 4 + 256 * i);
        if (has_next) {
          sh[i] = *(const f32x4*)(Mv + ((size_t)(ln * 5 + m) * 6 + (MODE == 1 ? 3 : 0)) * DM + lane * 4 + 256 * i);
          scl[i] = *(const f32x4*)(Mv + ((size_t)(ln * 5 + m) * 6 + (MODE == 1 ? 4 : 1)) * DM + lane * 4 + 256 * i);
        }
      }
    }
    float* xr = resid_row(p, tok);
    f32x4 x[4];
    if (MODE == 0) {
#pragma unroll
      for (int i = 0; i < 4; ++i) { x[i] = xb[i]; *(f32x4*)(xr + lane * 4 + 256 * i) = x[i]; }
    } else {
      float y[16];
      float ss = 0.f;
#pragma unroll
      for (int i = 0; i < 4; ++i) {
        y[4 * i] = bflo(yb[i][0]); y[4 * i + 1] = bfhi(yb[i][0]); y[4 * i + 2] = bflo(yb[i][1]); y[4 * i + 3] = bfhi(yb[i][1]);
#pragma unroll
        for (int e = 0; e < 4; ++e) ss += y[4 * i + e] * y[4 * i + e];
      }
      ss = wave_sum(ss);
      const float rstd = rsqrtf(ss * (1.f / DM) + EPSF);
#pragma unroll
      for (int i = 0; i < 4; ++i) {
        f32x4 v = xb[i];
#pragma unroll
        for (int e = 0; e < 4; ++e) v[e] += mg[i][e] * (y[4 * i + e] * rstd * gpost[i][e]);
        x[i] = v;
        *(f32x4*)(xr + lane * 4 + 256 * i) = v;
      }
    }
    if (has_next) {
      float ss = 0.f;
#pragma unroll
      for (int i = 0; i < 4; ++i)
#pragma unroll
        for (int e = 0; e < 4; ++e) ss += x[i][e] * x[i][e];
      ss = wave_sum(ss);
      const float rstd = rsqrtf(ss * (1.f / DM) + EPSF);
      bf16* hr = (bf16*)(p.ws + OFF_H) + (size_t)tok * DM;
#pragma unroll
      for (int i = 0; i < 4; ++i) {
        float o[4];
#pragma unroll
        for (int e = 0; e < 4; ++e) o[e] = (x[i][e] * rstd * gpre[i][e]) * (1.f + scl[i][e]) + sh[i][e];
        u32x2 u;
        u[0] = pack2(o[0], o[1]); u[1] = pack2(o[2], o[3]);
        *(u32x2*)(hr + lane * 4 + 256 * i) = u;
      }
    }
#pragma unroll
    for (int i = 0; i < 4; ++i) { yb[i] = yn[i]; xb[i] = xn[i]; }
  }
#undef ROW_LOAD
}

DI void ktab_phase(const Params& p, int bid, int G) {
  const float* BBR = (const float*)(p.ws + OFF_BBR);
  const float* BBI = (const float*)(p.ws + OFF_BBI);
  const float2* PW = (const float2*)(p.ws + OFF_PWR);
  float* KT = (float*)(p.ws + OFF_KTAB);
  const int total = NL * 16 * 2 * 32 * 256;
  for (int idx = bid * 256 + TIDX; idx < total; idx += G * 256) {
    const int hp = idx & 15, hh = (idx >> 4) & 15, tau = (idx >> 8) & 31, d = (idx >> 13) & 1, g = (idx >> 14) & 15, l = idx >> 18;
    const int ldg = (l * 2 + d) * 16 + g;
    const float* cre = p.in[I_CRE] + ((size_t)ldg * 16 + hh) * 64;
    const float* cim = p.in[I_CIM] + ((size_t)ldg * 16 + hh) * 64;
    float acc = 0.f;
    for (int pp = 0; pp < 64; ++pp) {
      const float2 pw = PW[((size_t)ldg * 33 + tau) * 64 + pp];
      const float br = BBR[((size_t)ldg * 64 + pp) * 16 + hp], bi = BBI[((size_t)ldg * 64 + pp) * 16 + hp];
      const float zr = pw.x * br - pw.y * bi, zi = pw.x * bi + pw.y * br;
      acc += cre[pp] * zr - cim[pp] * zi;
    }
    KT[idx] = acc;
  }
}

DI void s5mat_phase(const Params& p, int l, int bid, int G) {
  const float* BBR = (const float*)(p.ws + OFF_BBR);
  const float* BBI = (const float*)(p.ws + OFF_BBI);
  const float2* PW = (const float2*)(p.ws + OFF_PWR);
  const float* KT = (const float*)(p.ws + OFF_KTAB);
  bf16* T5 = (bf16*)(p.ws + OFF_T5);
  bf16* E5 = (bf16*)(p.ws + OFF_E5);
  bf16* F5 = (bf16*)(p.ws + OFF_F5);
  const int nT = 16 * 512 * 64, nE = 16 * 512 * 32, nF = 16 * 256 * 64;
  for (int it = bid * 256 + TIDX; it < nT + nE + nF; it += G * 256) {
    float v[8];
    bf16* dst;
    if (it < nT) {
      const int k8 = it & 63, n = (it >> 6) & 511, g = it >> 15;
      const int i = n >> 4, hh = n & 15, j = k8 >> 1, hp0 = (k8 & 1) * 8;
#pragma unroll
      for (int e = 0; e < 8; ++e) {
        const int hp = hp0 + e;
        float a = 0.f;
        if (j <= i) a += KT[((((size_t)l * 16 + g) * 2 + 0) * 32 + (i - j)) * 256 + hh * 16 + hp];
        if (j >= i) a += KT[((((size_t)l * 16 + g) * 2 + 1) * 32 + (j - i)) * 256 + hh * 16 + hp];
        if (i == j && hh == hp) a += p.in[I_S5D][l * 256 + g * 16 + hh];
        v[e] = a;
      }
      dst = T5 + ((size_t)g * 512 + n) * 512 + k8 * 8;
    } else if (it < nT + nE) {
      const int q = it - nT;
      const int k8 = q & 31, n = (q >> 5) & 511, g = q >> 14;
      const int i = n >> 4, hh = n & 15;
      const int k0 = k8 * 8, d = k0 >> 7, ri = (k0 >> 6) & 1, p0 = k0 & 63;
      const int ldg = (l * 2 + d) * 16 + g;
      const int ex = d ? (32 - i) : (i + 1);
#pragma unroll
      for (int e = 0; e < 8; ++e) {
        const int pp = p0 + e;
        const float2 pw = PW[((size_t)ldg * 33 + ex) * 64 + pp];
        const float cr = p.in[I_CRE][((size_t)ldg * 16 + hh) * 64 + pp], ci = p.in[I_CIM][((size_t)ldg * 16 + hh) * 64 + pp];
        const float zr = cr * pw.x - ci * pw.y, zi = cr * pw.y + ci * pw.x;
        v[e] = ri ? -zi : zr;
      }
      dst = E5 + ((size_t)g * 512 + n) * 256 + k0;
    } else {
      const int q = it - nT - nE;
      const int k8 = q & 63, n = (q >> 6) & 255, g = q >> 14;
      const int d = n >> 7, ri = (n >> 6) & 1, pp = n & 63;
      const int j = k8 >> 1, hp0 = (k8 & 1) * 8;
      const int ldg = (l * 2 + d) * 16 + g;
      const int ex = d ? j : (31 - j);
      const float2 pw = PW[((size_t)ldg * 33 + ex) * 64 + pp];
#pragma unroll
      for (int e = 0; e < 8; ++e) {
        const float br = BBR[((size_t)ldg * 64 + pp) * 16 + hp0 + e], bi = BBI[((size_t)ldg * 64 + pp) * 16 + hp0 + e];
        v[e] = ri ? (pw.x * bi + pw.y * br) : (pw.x * br - pw.y * bi);
      }
      dst = F5 + ((size_t)g * 256 + n) * 512 + k8 * 8;
    }
    u32x4 u;
    u[0] = pack2(v[0], v[1]); u[1] = pack2(v[2], v[3]); u[2] = pack2(v[4], v[5]); u[3] = pack2(v[6], v[7]);
    *(u32x4*)dst = u;
  }
}

DI void proj_epi(const Params& p, int l, int mt, int nt, char* smem);
DI void proj_wide(const Params& p, int l, int mt, int np, char* smem) {
  const bf16* H = (const bf16*)(p.ws + OFF_H) + (size_t)mt * 128 * DM;
  const bf16* W = wl(p, l, WL_WIN) + (size_t)np * 256 * DM;
  f32x16 acc[2][4];
  accw_zero(acc);
  gemm_wide(acc, [&](int r) { return H + (size_t)r * DM; }, [&](int r) { return W + (size_t)r * DM; }, DM, smem);
  float* Cs = (float*)smem;
  accw_to_lds<0>(acc, Cs);
  __syncthreads();
  proj_epi(p, l, mt, np * 2, smem);
  if (np * 2 + 1 < 19) {
    accw_to_lds<1>(acc, Cs);
    __syncthreads();
    proj_epi(p, l, mt, np * 2 + 1, smem);
  }
}
DI void proj_epi(const Params& p, int l, int mt, int nt, char* smem) {
  float* Cs = (float*)smem;
  const int tid = TIDX;
  const int tok0 = mt * 128;
  const int b = tok0 / TT, t0 = tok0 - b * TT;
  if (nt <= 2) {
    const int row = tid >> 1, seg = tid & 1;
    float* c = Cs + row * CLD + seg * 64;
    const float* gn = p.in[nt < 2 ? I_QN : I_KN] + l * 64;
    float ss = 0.f;
#pragma unroll 8
    for (int i = 0; i < 64; ++i) ss += c[i] * c[i];
    const float rstd = rsqrtf(ss * (1.f / 64.f) + EPSF);
    const int t = t0 + row;
    const bool lat = t >= CTXL;
    const int s = t - CTXL;
#pragma unroll 1
    for (int ax = 0; ax < 2; ++ax) {
      const float pos = (float)(ax ? (s & 63) : (s >> 6));
#pragma unroll 2
      for (int f = 0; f < 16; ++f) {
        float x1 = c[ax * 32 + f] * rstd * gn[ax * 32 + f];
        float x2 = c[ax * 32 + 16 + f] * rstd * gn[ax * 32 + 16 + f];
        if (lat) {
          const float invf = exp2f(-(float)f * (13.287712379549449f / 16.f));
          float sn, cs;
          sincos_cw(pos * invf, sn, cs);
          const float y1 = x1 * cs - x2 * sn, y2 = x2 * cs + x1 * sn;
          x1 = y1; x2 = y2;
        }
        c[ax * 32 + f] = x1;
        c[ax * 32 + 16 + f] = x2;
      }
    }
    __syncthreads();
    if (nt < 2) store_tile_bf16(Cs, (bf16*)(p.ws + OFF_Q) + (size_t)tok0 * 256 + nt * 128, 256, 128, 0.125f * 1.4426950408889634f);
    else store_tile_bf16(Cs, (bf16*)(p.ws + OFF_K) + (size_t)tok0 * 128, 128, 128, 1.f);
  } else if (nt == 3 || (nt >= 8 && nt <= 11)) {
    for (int c = tid; c < 2048; c += 256) {
      const int col = c & 127, rc = (c >> 7) * 8;
      u32x4 u;
#pragma unroll
      for (int e = 0; e < 4; ++e) u[e] = pack2(Cs[(rc + 2 * e) * CLD + col], Cs[(rc + 2 * e + 1) * CLD + col]);
      bf16* dst;
      if (nt == 3) dst = (bf16*)(p.ws + OFF_VT) + ((size_t)(b * 2 + (col >> 6)) * 64 + (col & 63)) * TT + t0 + rc;
      else dst = (bf16*)(p.ws + OFF_GVT) + ((size_t)(b * 4 + (nt - 8)) * 128 + col) * TT + t0 + rc;
      *(u32x4*)dst = u;
    }
  } else if (nt == 4 || nt == 5) {
    store_tile_bf16(Cs, (bf16*)(p.ws + OFF_GQ) + (size_t)tok0 * 256 + (nt - 4) * 128, 256, 128, 0.125f);
  } else if (nt == 6 || nt == 7) {
    store_tile_bf16(Cs, (bf16*)(p.ws + OFF_GK) + (size_t)tok0 * 256 + (nt - 6) * 128, 256, 128, 1.f);
  } else if (nt >= 12 && nt <= 15) {
    store_tile_bf16(Cs, (bf16*)(p.ws + OFF_GR) + (size_t)tok0 * 512 + (nt - 12) * 128, 512, 128, 1.f);
  } else if (nt == 16 || nt == 17) {
    for (int c = tid; c < 2048; c += 256) {
      const int row = c >> 4, c8 = c & 15;
      const float* s = Cs + row * CLD + c8 * 8;
      u32x4 u;
#pragma unroll
      for (int e = 0; e < 4; ++e) u[e] = pack2(s[2 * e], s[2 * e + 1]);
      const int ch = (nt - 16) * 128 + c8 * 8;
      bf16* dst = (bf16*)(p.ws + OFF_SU) + ((size_t)(b * 16 + (ch >> 4)) * TT + t0 + row) * 16 + (ch & 15);
      *(u32x4*)dst = u;
    }
  } else {
    for (int c = tid; c < 128 * 8; c += 256) {
      const int row = c >> 3, c4 = (c & 7) * 4;
      const float* s = Cs + row * CLD + c4;
      f32x4 v = {s[0], s[1], s[2], s[3]};
      *(f32x4*)((float*)(p.ws + OFF_LOW) + (size_t)(tok0 + row) * 32 + c4) = v;
    }
  }
  __syncthreads();
}

DI void attn_unit(const Params& p, int u, char* smem) {
  char* Ks = smem;
  char* Vs = smem + 16384;
  int b, head, tok0, nkt;
  if (u < 1024) { b = u >> 8; head = (u >> 6) & 3; tok0 = b * TT + CTXL + (u & 63) * 128; nkt = TT / 64; }
  else { const int v = u - 1024; b = v >> 3; head = (v >> 1) & 3; tok0 = b * TT + (v & 1) * 128; nkt = CTXL / 64; }
  const int kvh = head >> 1;
  const int tid = TIDX, lane = tid & 63, w = tid >> 6, r = lane & 31, h = lane >> 5;
  const bf16* Qp = (const bf16*)(p.ws + OFF_Q) + (size_t)(tok0 + w * 32 + r) * 256 + head * 64 + h * 8;
  s16x8 qf[4];
#pragma unroll
  for (int s = 0; s < 4; ++s) qf[s] = __builtin_bit_cast(s16x8, ldg16(Qp + s * 16));
  const bf16* kp[2];
  const bf16* vp[2];
#pragma unroll
  for (int i = 0; i < 2; ++i) {
    const int row = w * 16 + i * 8 + (lane >> 3);
    const int c = (lane & 7) ^ ((row >> 1) & 7);
    kp[i] = (const bf16*)(p.ws + OFF_K) + ((size_t)b * TT + row) * 128 + kvh * 64 + c * 8;
    vp[i] = (const bf16*)(p.ws + OFF_VT) + ((size_t)(b * 2 + kvh) * 64 + row) * TT + c * 8;
  }
  const int ldst = (w * 128 + lane) * 16;
#define AT_DMA(BUF, T)                                                                                              \
  {                                                                                                                 \
    _Pragma("unroll") for (int i = 0; i < 2; ++i) {                                                                 \
      __builtin_amdgcn_global_load_lds((const unsigned*)(kp[i] + (size_t)(T) * 64 * 128), (unsigned*)(Ks + (BUF) * 8192 + ldst + i * 1024), 16, 0, 0); \
      __builtin_amdgcn_global_load_lds((const unsigned*)(vp[i] + (T) * 64), (unsigned*)(Vs + (BUF) * 8192 + ldst + i * 1024), 16, 0, 0);               \
    }                                                                                                               \
  }
  const int xr = (r >> 1) & 7;
  AT_DMA(0, 0)
  asm volatile("s_waitcnt vmcnt(0)" ::: "memory");
  __syncthreads();
  f32x16 oacc[2];
#pragma unroll
  for (int i = 0; i < 16; ++i) { oacc[0][i] = 0.f; oacc[1][i] = 0.f; }
  float mrow = -INFINITY, lrow = 0.f;
  for (int kt = 0; kt < nkt; ++kt) {
    const int buf = kt & 1;
    if (kt + 1 < nkt) AT_DMA(buf ^ 1, kt + 1)
    const char* Kb = Ks + buf * 8192;
    const char* Vb = Vs + buf * 8192;
    f32x16 sacc[2];
#pragma unroll
    for (int i = 0; i < 16; ++i) { sacc[0][i] = 0.f; sacc[1][i] = 0.f; }
#pragma unroll
    for (int s = 0; s < 4; ++s) {
      const int co = ((2 * s + h) ^ xr) * 16;
      const s16x8 a0 = *(const s16x8*)(Kb + r * 128 + co);
      const s16x8 a1 = *(const s16x8*)(Kb + (32 + r) * 128 + co);
      sacc[0] = MFMA32(a0, qf[s], sacc[0]);
      sacc[1] = MFMA32(a1, qf[s], sacc[1]);
    }
    float mx = sacc[0][0];
#pragma unroll
    for (int i = 0; i < 16; ++i) { mx = fmaxf(mx, sacc[0][i]); mx = fmaxf(mx, sacc[1][i]); }
    mx = fmaxf(mx, __shfl_xor(mx, 32, 64));
    const float mnew = fmaxf(mrow, mx);
    const float alpha = __builtin_amdgcn_exp2f(mrow - mnew);
    mrow = mnew;
    float psum = 0.f;
#pragma unroll
    for (int i = 0; i < 16; ++i) {
      sacc[0][i] = __builtin_amdgcn_exp2f(sacc[0][i] - mnew); psum += sacc[0][i];
      sacc[1][i] = __builtin_amdgcn_exp2f(sacc[1][i] - mnew); psum += sacc[1][i];
    }
    lrow = lrow * alpha + psum;
#pragma unroll
    for (int i = 0; i < 16; ++i) { oacc[0][i] *= alpha; oacc[1][i] *= alpha; }
#pragma unroll
    for (int kt2 = 0; kt2 < 2; ++kt2)
#pragma unroll
      for (int s2 = 0; s2 < 2; ++s2) {
        u32x4 pu;
#pragma unroll
        for (int e = 0; e < 4; ++e) pu[e] = pack2(sacc[kt2][8 * s2 + 2 * e], sacc[kt2][8 * s2 + 2 * e + 1]);
        const s16x8 pf = __builtin_bit_cast(s16x8, pu);
        const int c0 = kt2 * 4 + 2 * s2;
        const int o0 = ((c0 ^ xr) * 16) + 8 * h, o1 = (((c0 + 1) ^ xr) * 16) + 8 * h;
#pragma unroll
        for (int dt = 0; dt < 2; ++dt) {
          const s16x4 lo = *(const s16x4*)(Vb + (dt * 32 + r) * 128 + o0);
          const s16x4 hi = *(const s16x4*)(Vb + (dt * 32 + r) * 128 + o1);
          const s16x8 a = __builtin_shufflevector(lo, hi, 0, 1, 2, 3, 4, 5, 6, 7);
          oacc[dt] = MFMA32(a, pf, oacc[dt]);
        }
      }
    asm volatile("s_waitcnt vmcnt(0)" ::: "memory");
    __syncthreads();
  }
#undef AT_DMA
  const float ltot = lrow + __shfl_xor(lrow, 32, 64);
  const float inv = 1.f / ltot;
  bf16* Op = (bf16*)(p.ws + OFF_OATT) + (size_t)(tok0 + w * 32 + r) * 256 + head * 64;
#pragma unroll
  for (int dt = 0; dt < 2; ++dt)
#pragma unroll
    for (int i = 0; i < 16; i += 4) {
      u32x2 uu;
      uu[0] = pack2(oacc[dt][i] * inv, oacc[dt][i + 1] * inv);
      uu[1] = pack2(oacc[dt][i + 2] * inv, oacc[dt][i + 3] * inv);
      *(u32x2*)(Op + dt * 32 + crow(i, h)) = uu;
    }
}

constexpr int GL_LOW = 0, GL_TOT = 4096, GL_DEC = 5120, GL_QIN = 5376, GL_KIN = 14592, GL_KET = 23808, GL_OST = 0,
              GL_VT = 33792, GL_ST = 52224;
static_assert(GL_ST + 128 * LDT * 2 <= SMEM_BYTES, "gla lds");

template <bool WITH_OUT>
DI void gla_unit(const Params& p, int l, int u, char* smem) {
  float* lowt = (float*)(smem + GL_LOW);
  float* tots = (float*)(smem + GL_TOT);
  float* decs = (float*)(smem + GL_DEC);
  bf16* qin = (bf16*)(smem + GL_QIN);
  bf16* kin = (bf16*)(smem + GL_KIN);
  bf16* ket = (bf16*)(smem + GL_KET);
  float* ost = (float*)(smem + GL_OST);
  bf16* vts = (bf16*)(smem + GL_VT);
  bf16* sts = (bf16*)(smem + GL_ST);
  const int tid = TIDX, lane = tid & 63, w = tid >> 6, r = lane & 31, h = lane >> 5;
  int b, hd, gi, dir0, ndir;
  if (WITH_OUT) { gi = u % NG33; hd = (u / NG33) & 3; b = u / (NG33 * 4); dir0 = 1; ndir = 2; }
  else { gi = u % NG33; const int v = u / NG33; dir0 = v & 1; hd = (v >> 1) & 3; b = v >> 3; ndir = 1; }
  const int dk = tid & 63, part = tid >> 6;
  const bf16* GQ = (const bf16*)(p.ws + OFF_GQ);
  const bf16* GK = (const bf16*)(p.ws + OFF_GK);
  const bf16* GVT = (const bf16*)(p.ws + OFF_GVT) + (size_t)(b * 4 + hd) * 128 * TT;
  const float* LOW = (const float*)(p.ws + OFF_LOW);
  for (int dd = 0; dd < ndir; ++dd) {
    const int dir = WITH_OUT ? (dir0 - dd) : dir0;
    float* GSu = (float*)(p.ws + OFF_GS) + ((size_t)((b * 4 + hd) * 2 + dir) * NG33 + gi) * 8192;
    float gwreg[16];
#pragma unroll
    for (int rr = 0; rr < 16; ++rr) gwreg[rr] = p.in[I_GGW][((size_t)(l * 2 + dir) * 16 + rr) * 256 + hd * 64 + dk];
    const float gb = p.in[I_GGB][(l * 2 + dir) * 256 + hd * 64 + dk];
    f32x16 sacc[2];
    if (WITH_OUT) {
#pragma unroll
      for (int dkt = 0; dkt < 2; ++dkt)
#pragma unroll
        for (int i = 0; i < 16; ++i) {
          const float v = GSu[(w * 32 + crow(i, h)) * 64 + dkt * 32 + r];
          sacc[dkt][i] = v;
          sts[(w * 32 + crow(i, h)) * LDT + dkt * 32 + r] = f2bf(v);
        }
    } else {
#pragma unroll
      for (int i = 0; i < 16; ++i) { sacc[0][i] = 0.f; sacc[1][i] = 0.f; }
    }
    float gtot = 0.f;
    for (int cc = 0; cc < 4; ++cc) {
      const int ci = dir ? 3 - cc : cc;
      const int tb = gi * 256 + ci * 64;
      const size_t tokb = (size_t)b * TT + tb;
      {
        const int row = tid >> 2, c4 = (tid & 3) * 4;
        const u32x4 lw = ldg16(LOW + (tokb + row) * 32 + dir * 16 + c4);
        u32x4 vv[4], kq[2], qq[2];
#pragma unroll
        for (int i = 0; i < 4; ++i) {
          const int c = tid + 256 * i, e = c >> 3, k8 = (c & 7) * 8;
          vv[i] = ldg16(GVT + (size_t)e * TT + tb + k8);
        }
#pragma unroll
        for (int i = 0; i < 2; ++i) {
          const int c = tid + 256 * i, rw = c >> 3, k8 = (c & 7) * 8;
          kq[i] = ldg16(GK + (tokb + rw) * 256 + hd * 64 + k8);
          if (WITH_OUT) qq[i] = ldg16(GQ + (tokb + rw) * 256 + hd * 64 + k8);
        }
        *(u32x4*)(lowt + row * 16 + c4) = lw;
#pragma unroll
        for (int i = 0; i < 4; ++i) {
          const int c = tid + 256 * i, e = c >> 3, k8 = (c & 7) * 8;
          *(u32x4*)(vts + e * LDT + k8) = vv[i];
        }
#pragma unroll
        for (int i = 0; i < 2; ++i) {
          const int c = tid + 256 * i, rw = c >> 3, k8 = (c & 7) * 8;
          *(u32x4*)(kin + rw * LDT + k8) = kq[i];
          if (WITH_OUT) *(u32x4*)(qin + rw * LDT + k8) = qq[i];
        }
      }
      __syncthreads();
      float cum = 0.f;
#pragma unroll 2
      for (int ii = 0; ii < 16; ++ii) {
        const int pos = part * 16 + ii, t = dir ? 63 - pos : pos;
        float z = gb;
#pragma unroll
        for (int rr = 0; rr < 16; ++rr) z += lowt[t * 16 + rr] * gwreg[rr];
        cum += (fminf(z, 0.f) - log1pf(__expf(-fabsf(z)))) * (1.f / 16.f);
      }
      tots[part * 64 + dk] = cum;
      __syncthreads();
      float offs = 0.f, total = 0.f;
#pragma unroll
      for (int pp = 0; pp < 4; ++pp) { const float tv = tots[pp * 64 + dk]; total += tv; if (pp < part) offs += tv; }
      if (part == 0) decs[dk] = __expf(total);
      gtot += total;
      float bq = offs;
#pragma unroll 2
      for (int ii = 0; ii < 16; ++ii) {
        const int pos = part * 16 + ii, t = dir ? 63 - pos : pos;
        float z = gb;
#pragma unroll
        for (int rr = 0; rr < 16; ++rr) z += lowt[t * 16 + rr] * gwreg[rr];
        bq += (fminf(z, 0.f) - log1pf(__expf(-fabsf(z)))) * (1.f / 16.f);
        const float kv = bf2f(kin[t * LDT + dk]);
        ket[dk * LDT + t] = f2bf(kv * __expf(total - bq));
        if (WITH_OUT) {
          const float qv = bf2f(qin[t * LDT + dk]);
          qin[t * LDT + dk] = f2bf(qv * __expf(bq));
          kin[t * LDT + dk] = f2bf(kv * __expf(-bq));
        }
      }
      __syncthreads();
      f32x16 oo[2];
      const int it = w & 1, ep = w >> 1;
      if (WITH_OUT) {
        const int ti = w >> 1, tj = w & 1;
        f32x16 aa;
#pragma unroll
        for (int i = 0; i < 16; ++i) aa[i] = 0.f;
#pragma unroll
        for (int s = 0; s < 4; ++s) {
          const s16x8 A = *(const s16x8*)(qin + (ti * 32 + r) * LDT + s * 16 + h * 8);
          const s16x8 Bv = *(const s16x8*)(kin + (tj * 32 + r) * LDT + s * 16 + h * 8);
          aa = MFMA32(A, Bv, aa);
        }
        __syncthreads();
#pragma unroll
        for (int i = 0; i < 16; ++i) {
          const int qi = ti * 32 + crow(i, h), kj = tj * 32 + r;
          const bool keep = dir ? (kj >= qi) : (kj <= qi);
          kin[qi * LDT + kj] = f2bf(keep ? aa[i] : 0.f);
        }
        __syncthreads();
#pragma unroll
        for (int i = 0; i < 16; ++i) { oo[0][i] = 0.f; oo[1][i] = 0.f; }
#pragma unroll
        for (int s = 0; s < 4; ++s) {
          const s16x8 A1 = *(const s16x8*)(kin + (it * 32 + r) * LDT + s * 16 + h * 8);
          const s16x8 A2 = *(const s16x8*)(qin + (it * 32 + r) * LDT + s * 16 + h * 8);
#pragma unroll
          for (int x = 0; x < 2; ++x) {
            const int et = 2 * ep + x;
            const s16x8 B1 = *(const s16x8*)(vts + (et * 32 + r) * LDT + s * 16 + h * 8);
            const s16x8 B2 = *(const s16x8*)(sts + (et * 32 + r) * LDT + s * 16 + h * 8);
            oo[x] = MFMA32(A1, B1, oo[x]);
            oo[x] = MFMA32(A2, B2, oo[x]);
          }
        }
      }
#pragma unroll
      for (int dkt = 0; dkt < 2; ++dkt) {
        const float dv = decs[dkt * 32 + r];
#pragma unroll
        for (int i = 0; i < 16; ++i) sacc[dkt][i] *= dv;
      }
#pragma unroll
      for (int s = 0; s < 4; ++s) {
        const s16x8 A = *(const s16x8*)(vts + (w * 32 + r) * LDT + s * 16 + h * 8);
#pragma unroll
        for (int dkt = 0; dkt < 2; ++dkt) {
          const s16x8 Bv = *(const s16x8*)(ket + (dkt * 32 + r) * LDT + s * 16 + h * 8);
          sacc[dkt] = MFMA32(A, Bv, sacc[dkt]);
        }
      }
      __syncthreads();
      if (WITH_OUT) {
#pragma unroll
        for (int dkt = 0; dkt < 2; ++dkt)
#pragma unroll
          for (int i = 0; i < 16; ++i) sts[(w * 32 + crow(i, h)) * LDT + dkt * 32 + r] = f2bf(sacc[dkt][i]);
#pragma unroll
        for (int x = 0; x < 2; ++x)
#pragma unroll
          for (int i = 0; i < 16; ++i) ost[(it * 32 + crow(i, h)) * CLD + (2 * ep + x) * 32 + r] = oo[x][i];
        __syncthreads();
        const int row = tid >> 2, qd = tid & 3;
        const size_t tok = tokb + row;
        bf16* og = (bf16*)(p.ws + OFF_OGLA) + tok * 512 + hd * 128 + qd * 32;
        const float* os = ost + row * CLD + qd * 32;
        if (dir == 1) {
#pragma unroll
          for (int i = 0; i < 4; ++i) {
            u32x4 uu;
#pragma unroll
            for (int e = 0; e < 4; ++e) uu[e] = pack2(os[i * 8 + 2 * e], os[i * 8 + 2 * e + 1]);
            *(u32x4*)(og + i * 8) = uu;
          }
        } else {
          float ss = 0.f;
#pragma unroll 1
          for (int i = 0; i < 4; ++i) {
            const u32x4 uu = *(const u32x4*)(og + i * 8);
#pragma unroll
            for (int e = 0; e < 4; ++e) {
              const float a0 = os[i * 8 + 2 * e] + bflo(uu[e]), a1 = os[i * 8 + 2 * e + 1] + bfhi(uu[e]);
              ss += a0 * a0 + a1 * a1;
            }
          }
          ss += __shfl_xor(ss, 1, 64);
          ss += __shfl_xor(ss, 2, 64);
          const float rstd = rsqrtf(ss * (1.f / 128.f) + EPSF);
          const float* gn = p.in[I_GON] + l * 128 + qd * 32;
          const bf16* gr = (const bf16*)(p.ws + OFF_GR) + tok * 512 + hd * 128 + qd * 32;
#pragma unroll 1
          for (int i = 0; i < 4; ++i) {
            const u32x4 uo = *(const u32x4*)(og + i * 8);
            const u32x4 ug = *(const u32x4*)(gr + i * 8);
            u32x4 uu;
#pragma unroll
            for (int e = 0; e < 4; ++e) {
              const float v0 = os[i * 8 + 2 * e] + bflo(uo[e]), v1 = os[i * 8 + 2 * e + 1] + bfhi(uo[e]);
              const float a0 = v0 * rstd * gn[i * 8 + 2 * e] * siluf_(bflo(ug[e]));
              const float a1 = v1 * rstd * gn[i * 8 + 2 * e + 1] * siluf_(bfhi(ug[e]));
              uu[e] = pack2(a0, a1);
            }
            *(u32x4*)(og + i * 8) = uu;
          }
        }
        __syncthreads();
      }
    }
    if (!WITH_OUT) {
#pragma unroll
      for (int dkt = 0; dkt < 2; ++dkt)
#pragma unroll
        for (int i = 0; i < 16; ++i) GSu[(w * 32 + crow(i, h)) * 64 + dkt * 32 + r] = sacc[dkt][i];
      if (part == 0) ((float*)(p.ws + OFF_DECG))[((size_t)((b * 4 + hd) * 2 + dir) * NG33 + gi) * 64 + dk] = __expf(gtot);
    }
    __syncthreads();
  }
}

DI void gla_scan_job(const Params& p, int j) {
  const int idx = j * 256 + TIDX;
  const int seq = idx >> 13, el = idx & 8191, dk = el & 63, dir = seq & 1;
  float* GS = (float*)(p.ws + OFF_GS) + (size_t)seq * NG33 * 8192 + el;
  const float* DG = (const float*)(p.ws + OFF_DECG) + (size_t)seq * NG33 * 64 + dk;
  float s = 0.f;
  for (int st0 = 0; st0 < 33; st0 += 11) {
    float kv[11], dc[11];
#pragma unroll
    for (int q = 0; q < 11; ++q) {
      const int st = st0 + q;
      const int g = (dir == 0 || st == 0) ? st : 33 - st;
      kv[q] = GS[(size_t)g * 8192];
      dc[q] = DG[g * 64];
    }
#pragma unroll
    for (int q = 0; q < 11; ++q) {
      const int st = st0 + q;
      const int g = (dir == 0 || st == 0) ? st : 33 - st;
      GS[(size_t)g * 8192] = s;
      s = dc[q] * s + kv[q];
    }
  }
}

DI void s5_end_tile(const Params& p, int j, char* smem) {
  const int nt = j & 1, mt = (j >> 1) % 9, g = j / 18;
  const bf16* SU = (const bf16*)(p.ws + OFF_SU);
  const bf16* F = (const bf16*)(p.ws + OFF_F5) + ((size_t)g * 256 + nt * 128) * 512;
  f32x16 acc[2][2];
  acc_zero(acc);
  gemm_main_dma(acc,
            [&](int r) -> const bf16* {
              const int m = mt * 128 + r;
              if (m >= MS5) return (const bf16*)(p.ws + OFF_ZERO);
              const int b = m / NCH, ch = m - b * NCH;
              return SU + ((size_t)(b * 16 + g) * TT + ch * 32) * 16;
            },
            [&](int r) { return F + (size_t)r * 512; }, 512, smem);
  float* Cs = (float*)smem;
  acc_to_lds(acc, Cs);
  __syncthreads();
  float* EN = (float*)(p.ws + OFF_EN);
  for (int c = TIDX; c < 128 * 32; c += 256) {
    const int row = c >> 5, c4 = (c & 31) * 4, m = mt * 128 + row;
    if (m < MS5) {
      const float* s = Cs + row * CLD + c4;
      f32x4 v = {s[0], s[1], s[2], s[3]};
      *(f32x4*)(EN + ((size_t)m * 16 + g) * 256 + nt * 128 + c4) = v;
    }
  }
  __syncthreads();
}

DI void s5_scan_job(const Params& p, int l, int j, char* smem) {
  float2* ends = (float2*)smem;
  const int dir = j & 1, g = (j >> 1) & 15, b = j >> 5;
  const int pp = TIDX & 63, seg = TIDX >> 6;
  const float2 aL = ((const float2*)(p.ws + OFF_PWR))[((size_t)((l * 2 + dir) * 16 + g) * 33 + 32) * 64 + pp];
  const float* EN = (const float*)(p.ws + OFF_EN);
  bf16* SB = (bf16*)(p.ws + OFF_SB);
  float sr = 0.f, si = 0.f;
  for (int q0 = 0; q0 < 66; q0 += 11) {
    float er[11], ei[11];
#pragma unroll
    for (int q = 0; q < 11; ++q) {
      const int pos = seg * 66 + q0 + q;
      const int ch = dir ? (pos < 8 ? 7 - pos : 271 - pos) : pos;
      const float* e = EN + ((size_t)(b * NCH + ch) * 16 + g) * 256 + dir * 128 + pp;
      er[q] = e[0]; ei[q] = e[64];
    }
#pragma unroll
    for (int q = 0; q < 11; ++q) {
      const float nr = aL.x * sr - aL.y * si + er[q], ni = aL.x * si + aL.y * sr + ei[q];
      sr = nr; si = ni;
    }
  }
  ends[seg * 64 + pp] = make_float2(sr, si);
  float pr = 1.f, pi = 0.f;
  for (int q = 0; q < 66; ++q) { const float nr = pr * aL.x - pi * aL.y, ni = pr * aL.y + pi * aL.x; pr = nr; pi = ni; }
  __syncthreads();
  sr = 0.f; si = 0.f;
  for (int k = 0; k < seg; ++k) {
    const float2 e = ends[k * 64 + pp];
    const float nr = pr * sr - pi * si + e.x, ni = pr * si + pi * sr + e.y;
    sr = nr; si = ni;
  }
  for (int q0 = 0; q0 < 66; q0 += 11) {
    float er[11], ei[11];
#pragma unroll
    for (int q = 0; q < 11; ++q) {
      const int pos = seg * 66 + q0 + q;
      const int ch = dir ? (pos < 8 ? 7 - pos : 271 - pos) : pos;
      const float* e = EN + ((size_t)(b * NCH + ch) * 16 + g) * 256 + dir * 128 + pp;
      er[q] = e[0]; ei[q] = e[64];
    }
#pragma unroll
    for (int q = 0; q < 11; ++q) {
      const int pos = seg * 66 + q0 + q;
      const int ch = dir ? (pos < 8 ? 7 - pos : 271 - pos) : pos;
      bf16* sb = SB + ((size_t)(b * NCH + ch) * 16 + g) * 256 + dir * 128 + pp;
      sb[0] = f2bf(sr); sb[64] = f2bf(si);
      const float nr = aL.x * sr - aL.y * si + er[q], ni = aL.x * si + aL.y * sr + ei[q];
      sr = nr; si = ni;
    }
  }
  __syncthreads();
}

DI float gelu_tanh(float x) {
  const float u = 0.7978845608028654f * (x + 0.044715f * x * x * x);
  return 0.5f * x * (1.f + tanhf(u));
}

DI void s5_out_tile(const Params& p, int j, char* smem) {
  const int nt = j & 3, mt = (j >> 2) % 9, g = j / 36;
  const bf16* SU = (const bf16*)(p.ws + OFF_SU);
  const bf16* SB = (const bf16*)(p.ws + OFF_SB);
  const bf16* Tm = (const bf16*)(p.ws + OFF_T5) + ((size_t)g * 512 + nt * 128) * 512;
  const bf16* Em = (const bf16*)(p.ws + OFF_E5) + ((size_t)g * 512 + nt * 128) * 256;
  f32x16 acc[2][2];
  acc_zero(acc);
  gemm_main_dma(acc,
            [&](int r) -> const bf16* {
              const int m = mt * 128 + r;
              if (m >= MS5) return (const bf16*)(p.ws + OFF_ZERO);
              const int b = m / NCH, ch = m - b * NCH;
              return SU + ((size_t)(b * 16 + g) * TT + ch * 32) * 16;
            },
            [&](int r) { return Tm + (size_t)r * 512; }, 512, smem);
  gemm_main_dma(acc,
            [&](int r) -> const bf16* {
              const int m = mt * 128 + r;
              if (m >= MS5) return (const bf16*)(p.ws + OFF_ZERO);
              return SB + ((size_t)m * 16 + g) * 256;
            },
            [&](int r) { return Em + (size_t)r * 256; }, 256, smem);
  float* Cs = (float*)smem;
  acc_to_lds(acc, Cs);
  __syncthreads();
  bf16* Y5 = (bf16*)(p.ws + OFF_Y5);
  for (int c = TIDX; c < 2048; c += 256) {
    const int row = c >> 4, c8 = c & 15, m = mt * 128 + row;
    if (m < MS5) {
      const int b = m / NCH, ch = m - b * NCH;
      const int n = nt * 128 + c8 * 8, i = n >> 4, hh = n & 15;
      const float* s = Cs + row * CLD + c8 * 8;
      u32x4 u;
#pragma unroll
      for (int e = 0; e < 4; ++e) u[e] = pack2(gelu_tanh(s[2 * e]), gelu_tanh(s[2 * e + 1]));
      *(u32x4*)(Y5 + ((size_t)b * TT + ch * 32 + i) * 256 + g * 16 + hh) = u;
    }
  }
  __syncthreads();
}

DI void glu_tile(const Params& p, int l, int j, char* smem) {
  const int nt = j & 1, mt = j >> 1;
  const bf16* Y5 = (const bf16*)(p.ws + OFF_Y5) + (size_t)mt * 128 * 256;
  const bf16* W = wl(p, l, WL_GLU) + (size_t)nt * 128 * 256;
  f32x16 acc[2][2];
  acc_zero(acc);
  gemm_main_dma(acc, [&](int r) { return Y5 + (size_t)r * 256; }, [&](int r) { return W + (size_t)r * 256; }, 256, smem);
  float* Cs = (float*)smem;
  acc_to_lds(acc, Cs);
  __syncthreads();
  const float* gb = p.in[I_GLUB] + l * 256 + nt * 128;
  bf16* O = (bf16*)(p.ws + OFF_OS5) + (size_t)mt * 128 * 256 + nt * 128;
  for (int c = TIDX; c < 2048; c += 256) {
    const int row = c >> 4, cc = (c & 15) * 8;
    const float* s = Cs + row * CLD + cc;
    const u32x4 yu = *(const u32x4*)(Y5 + (size_t)row * 256 + nt * 128 + cc);
    u32x4 u;
#pragma unroll
    for (int e = 0; e < 4; ++e) {
      const float y0 = bflo(yu[e]), y1 = bfhi(yu[e]);
      u[e] = pack2(y0 * sigmoidf_(s[2 * e] + gb[cc + 2 * e]), y1 * sigmoidf_(s[2 * e + 1] + gb[cc + 2 * e + 1]));
    }
    *(u32x4*)(O + (size_t)row * 256 + cc) = u;
  }
  __syncthreads();
}

DI void merge_tile(const Params& p, int l, int j, char* smem) {
  const int nt = j & 7, mt = j >> 3;
  const bf16* H = (const bf16*)(p.ws + OFF_H) + (size_t)mt * 128 * DM;
  unsigned am[2][2][8];
#pragma unroll
  for (int a = 0; a < 2; ++a)
#pragma unroll
    for (int bq = 0; bq < 2; ++bq)
#pragma unroll
      for (int i = 0; i < 8; ++i) am[a][bq][i] = 0u;
#pragma unroll 1
  for (int x = 0; x < 3; ++x) {
    const bf16* Wg = wl(p, l, WL_WIN) + ((size_t)2432 + x * 1024 + nt * 128) * DM;
    unsigned sg[2][2][8];
    {
      f32x16 acc[2][2];
      acc_zero(acc);
      gemm_main_dma(acc, [&](int r) { return H + (size_t)r * DM; }, [&](int r) { return Wg + (size_t)r * DM; }, DM, smem);
#pragma unroll
      for (int a = 0; a < 2; ++a)
#pragma unroll
        for (int bq = 0; bq < 2; ++bq)
#pragma unroll
          for (int i = 0; i < 8; ++i) sg[a][bq][i] = pack2(sigmoidf_(acc[a][bq][2 * i]), sigmoidf_(acc[a][bq][2 * i + 1]));
    }
    const bf16* A; const bf16* Wb; int K;
    if (x == 0) { A = (const bf16*)(p.ws + OFF_OATT) + (size_t)mt * 128 * 256; Wb = wl(p, l, WL_BRA) + (size_t)nt * 128 * 256; K = 256; }
    else if (x == 1) { A = (const bf16*)(p.ws + OFF_OGLA) + (size_t)mt * 128 * 512; Wb = wl(p, l, WL_BRG) + (size_t)nt * 128 * 512; K = 512; }
    else { A = (const bf16*)(p.ws + OFF_OS5) + (size_t)mt * 128 * 256; Wb = wl(p, l, WL_BRS) + (size_t)nt * 128 * 256; K = 256; }
#pragma unroll
    for (int hf = 0; hf < 2; ++hf) {
      f32x16 a2[2];
#pragma unroll
      for (int i = 0; i < 16; ++i) { a2[0][i] = 0.f; a2[1][i] = 0.f; }
      gemm_main_dma_half(a2, A, K, Wb, K, K, hf, smem);
#pragma unroll
      for (int a = 0; a < 2; ++a)
#pragma unroll
        for (int i = 0; i < 8; ++i) {
          const float v0 = bflo(am[a][hf][i]) + bflo(sg[a][hf][i]) * a2[a][2 * i];
          const float v1 = bfhi(am[a][hf][i]) + bfhi(sg[a][hf][i]) * a2[a][2 * i + 1];
          am[a][hf][i] = pack2(v0, v1);
        }
    }
  }
  f32x16 accm[2][2];
#pragma unroll
  for (int a = 0; a < 2; ++a)
#pragma unroll
    for (int bq = 0; bq < 2; ++bq)
#pragma unroll
      for (int i = 0; i < 8; ++i) { accm[a][bq][2 * i] = bflo(am[a][bq][i]); accm[a][bq][2 * i + 1] = bfhi(am[a][bq][i]); }
  float* Cs = (float*)smem;
  acc_to_lds(accm, Cs);
  __syncthreads();
  store_tile_bf16(Cs, (bf16*)(p.ws + OFF_MG) + (size_t)mt * 128 * DM + nt * 128, DM, 128, 1.f);
  __syncthreads();
}

DI void plain_tile(const bf16* A, int K, const bf16* W, bf16* dst, int ldd, char* smem) {
  f32x16 acc[2][2];
  acc_zero(acc);
  gemm_main_dma(acc, [&](int r) { return A + (size_t)r * K; }, [&](int r) { return W + (size_t)r * K; }, K, smem);
  float* Cs = (float*)smem;
  acc_to_lds(acc, Cs);
  __syncthreads();
  store_tile_bf16(Cs, dst, ldd, 128, 1.f);
  __syncthreads();
}

DI void plain_wide(const bf16* A, int K, const bf16* W, bf16* dst, int ldd, char* smem) {
  f32x16 acc[2][4];
  accw_zero(acc);
  gemm_wide(acc, [&](int r) { return A + (size_t)r * K; }, [&](int r) { return W + (size_t)r * K; }, K, smem);
  float* Cs = (float*)smem;
  accw_to_lds<0>(acc, Cs);
  __syncthreads();
  store_tile_bf16(Cs, dst, ldd, 128, 1.f);
  __syncthreads();
  accw_to_lds<1>(acc, Cs);
  __syncthreads();
  store_tile_bf16(Cs, dst + 128, ldd, 128, 1.f);
  __syncthreads();
}

DI void up_epi(const Params& p, int l, int jn, int seqbase, int len, int pos0, char* smem) {
  float* Cs = (float*)smem;
  const float* cw = p.in[I_CW] + (size_t)l * 3 * 2 * DFF;
  const float* cb = p.in[I_CB] + (size_t)l * 2 * DFF;
  bf16* G = (bf16*)(p.ws + OFF_G);
  const int tid = TIDX;
  const int c = (tid & 31) * 2;
  float wa[2][3], wv[2][3], ba[2], bv[2];
#pragma unroll
  for (int e = 0; e < 2; ++e) {
    const int ca = jn * 64 + c + e, cv = DFF + ca;
#pragma unroll
    for (int k = 0; k < 3; ++k) { wa[e][k] = cw[k * 2 * DFF + ca]; wv[e][k] = cw[k * 2 * DFF + cv]; }
    ba[e] = cb[ca]; bv[e] = cb[cv];
  }
#pragma unroll 4
  for (int rr = 1 + (tid >> 5); rr < 127; rr += 8) {
    const int pos = pos0 + rr;
    if (pos < len) {
      float gv[2];
#pragma unroll
      for (int e = 0; e < 2; ++e) {
        const float a = wa[e][0] * Cs[(rr - 1) * CLD + c + e] + wa[e][1] * Cs[rr * CLD + c + e] + wa[e][2] * Cs[(rr + 1) * CLD + c + e] + ba[e];
        const float v = wv[e][0] * Cs[(rr - 1) * CLD + 64 + c + e] + wv[e][1] * Cs[rr * CLD + 64 + c + e] +
                        wv[e][2] * Cs[(rr + 1) * CLD + 64 + c + e] + bv[e];
        gv[e] = siluf_(a) * v;
      }
      *(unsigned*)(G + (size_t)(seqbase + pos) * DFF + jn * 64 + c) = pack2(gv[0], gv[1]);
    }
  }
  __syncthreads();
}

DI void up_wide(const Params& p, int l, int mtile, int jp, char* smem) {
  const int b = mtile / 69, rr0 = mtile % 69;
  int seqbase, len, ti;
  if (rr0 < 3) { seqbase = b * TT; len = CTXL; ti = rr0; }
  else { seqbase = b * TT + CTXL; len = SEQ; ti = rr0 - 3; }
  const int pos0 = ti * 126 - 1;
  const bf16* H = (const bf16*)(p.ws + OFF_H);
  const bf16* W = wl(p, l, WL_UP) + (size_t)jp * 256 * DM;
  f32x16 acc[2][4];
  accw_zero(acc);
  gemm_wide(acc,
            [&](int r) -> const bf16* {
              const int pos = pos0 + r;
              return (pos >= 0 && pos < len) ? H + (size_t)(seqbase + pos) * DM : (const bf16*)(p.ws + OFF_ZERO);
            },
            [&](int r) { return W + (size_t)r * DM; }, DM, smem);
  float* Cs = (float*)smem;
  accw_to_lds<0>(acc, Cs);
  __syncthreads();
  up_epi(p, l, jp * 2, seqbase, len, pos0, smem);
  accw_to_lds<1>(acc, Cs);
  __syncthreads();
  up_epi(p, l, jp * 2 + 1, seqbase, len, pos0, smem);
}

DI bool gemm_job(int bid, int G, int it, int MT, int NTL, int& mt, int& nt, int CW = 8) {
  const int x = bid & 7, q = bid >> 3, Q = G >> 3;
  const int m0 = (x * MT) >> 3, m1 = ((x + 1) * MT) >> 3, Mx = m1 - m0;
  const int jl = q + Q * it;
  if (jl >= Mx * NTL) return false;
  const int full = Mx * CW;
  const int c = jl / full, rem = jl - c * full;
  const int wc = min(CW, NTL - CW * c);
  const int mi = rem / wc;
  mt = m0 + mi;
  nt = CW * c + (rem - mi * wc);
  return true;
}

enum { PH_PREP = 0, PH_ROW0, PH_PROJ, PH_MIX1, PH_SCAN, PH_MIX2, PH_GLU, PH_MERGE, PH_WOUT, PH_ROW1, PH_UP, PH_DOWN, PH_ROW2 };
constexpr int N_PHASES = 2 + 11 * NL;

DI void run_phase(const Params& p, int ph, int l, char* smem) {
  const int bid = blockIdx.x;
#ifdef HALFMASK
  const int G = ((HALFMASK >> ph) & 1) ? 256 : gridDim.x;
  if (bid >= G) return;
#else
  const int G = gridDim.x;
#endif
#ifdef PHMASK
  if (!((PHMASK >> ph) & 1)) return;
#endif
  switch (ph) {
    case PH_PREP:
      if (bid < 8) { for (int i = TIDX; i < 512; i += 256) ((u32x4*)(p.ws + OFF_ZERO))[i] = u32x4{0u, 0u, 0u, 0u}; }
      for (int j = bid; j < 128 + 16064; j += G) {
        if (j < 96) prep_mod_job(p, j, smem);
        else if (j < 128) prep_s5_job(p, j - 96);
        else prep_wt_job(p, j - 128, smem);
      }
      break;
    case PH_ROW0:
      row_phase<0>(p, 0, bid, G);
      ktab_phase(p, bid, G);
      break;
    case PH_PROJ:
#ifdef EXP_A
      if (bid < 256) { int mt, nt; for (int it = 0; gemm_job(bid, 256, it, 264, 10, mt, nt, 4); ++it) proj_wide(p, l, mt, nt, smem); }
      s5mat_phase(p, l, bid, G);
#elif defined(EXP_C)
      if (bid < 256) for (int j = bid; j < 264 * 19; j += 256) { if ((EXP_C >> (j % 19)) & 1) proj_tile(p, l, j / 19, j % 19, smem); }
      for (int j = bid; j < 264 * 19; j += G) { if (!((EXP_C >> (j % 19)) & 1)) proj_tile(p, l, j / 19, j % 19, smem); }
      s5mat_phase(p, l, bid, G);
#elif defined(EXP_B)
      for (int j = bid; j < 264 * 19; j += G) proj_tile(p, l, j / 19, j % 19, smem);
      if (bid < 256) s5mat_phase(p, l, bid, 256);
#else
      for (int j = bid; j < 264 * 19; j += G) proj_tile(p, l, j / 19, j % 19, smem);
      s5mat_phase(p, l, bid, G);
#endif
      break;
    case PH_MIX1:
      for (int j = bid; j < 1056 + 1056 + 288; j += G) {
        if (j < 1056) attn_unit(p, j, smem);
        else if (j < 2112) gla_unit<false>(p, l, j - 1056, smem);
        else s5_end_tile(p, j - 2112, smem);
      }
      break;
    case PH_SCAN:
      for (int j = bid; j < 1024 + 128; j += G) {
        if (j < 1024) gla_scan_job(p, j);
        else s5_scan_job(p, l, j - 1024, smem);
      }
      break;
    case PH_MIX2:
      for (int j = bid; j < 528 + 576; j += G) {
        if (j < 528) gla_unit<true>(p, l, j, smem);
        else s5_out_tile(p, j - 528, smem);
      }
      break;
    case PH_GLU:
      { int mt, nt; for (int it = 0; gemm_job(bid, G, it, 264, 2, mt, nt); ++it) glu_tile(p, l, mt * 2 + nt, smem); }
      break;
    case PH_MERGE:
      { int mt, nt; for (int it = 0; gemm_job(bid, G, it, 264, 8, mt, nt); ++it) merge_tile(p, l, mt * 8 + nt, smem); }
      break;
    case PH_WOUT:
      for (int it = 0;; ++it) {
        int mt, nt;
        if (!gemm_job(bid, G, it, 264, 4, mt, nt, 4)) break;
        plain_wide((const bf16*)(p.ws + OFF_MG) + (size_t)mt * 128 * DM, DM, wl(p, l, WL_WOUT) + (size_t)nt * 256 * DM,
                   (bf16*)(p.ws + OFF_H) + (size_t)mt * 128 * DM + nt * 256, DM, smem);
      }
      break;
    case PH_ROW1: row_phase<1>(p, l, bid, G); break;
    case PH_UP:
      { int mt, nt; for (int it = 0; gemm_job(bid, G, it, 276, 22, mt, nt, 4); ++it) up_wide(p, l, mt, nt, smem); }
      break;
    case PH_DOWN:
      for (int it = 0;; ++it) {
        int mt, nt;
        if (!gemm_job(bid, G, it, 264, 4, mt, nt, 4)) break;
        plain_wide((const bf16*)(p.ws + OFF_G) + (size_t)mt * 128 * DFF, DFF, wl(p, l, WL_DOWN) + (size_t)nt * 256 * DFF,
                   (bf16*)(p.ws + OFF_H) + (size_t)mt * 128 * DM + nt * 256, DM, smem);
      }
      break;
    case PH_ROW2: row_phase<2>(p, l, bid, G); break;
  }
}

#define XB_TMO      128
#define XB_XCNT(j)  (256  + 64 * (j))
#define XB_XSUB(j)  (1280 + 64 * (j))
#define XB_XGEN(j)  (2304 + 64 * (j))
#define XB_TOP      3328
#define XB_TOPGEN   3392
#define XCD_BAR_WORDS 3456
#define XB_SPIN_CAP (1u << 18)
#define LAS __attribute__((address_space(3)))

__device__ __forceinline__ unsigned xb_ld(unsigned* p)              { return __hip_atomic_load(p, __ATOMIC_RELAXED, __HIP_MEMORY_SCOPE_AGENT); }
__device__ __forceinline__ unsigned xb_add(unsigned* p, unsigned v) { return __hip_atomic_fetch_add(p, v, __ATOMIC_RELAXED, __HIP_MEMORY_SCOPE_AGENT); }
__device__ __forceinline__ unsigned xb_xcc_id() { return (unsigned)__builtin_amdgcn_s_getreg((3 << 11) | 20) & 0xFu; }
#define XB_SPIN(cond, bar) do { unsigned _sp = 0; while (cond) { __builtin_amdgcn_s_sleep(1); \
    if ((++_sp & 255u) == 0u) { if (xb_ld(&(bar)[XB_TMO])) break; if (_sp > XB_SPIN_CAP) { atomicAdd(&(bar)[XB_TMO], 1u); break; } } } } while (0)

struct XcdBarrier {
    unsigned* bar; unsigned x;
    volatile LAS unsigned* st;
};

__device__ __forceinline__ XcdBarrier xcd_barrier_post(unsigned* bar, volatile LAS unsigned* st) {
    XcdBarrier b; b.bar = bar; b.x = xb_xcc_id(); b.st = st;
    if (threadIdx.x == 0) (void)xb_add(&bar[XB_XCNT(b.x)], 1u);
    return b;
}
__device__ __forceinline__ void xcd_barrier_complete(unsigned* bar, unsigned x, unsigned& nloc, unsigned& nx) {
    const unsigned G = gridDim.x * gridDim.y * gridDim.z;
    unsigned sum, cnt, mine, sp = 0u;
    for (;;) {
        sum = 0u; cnt = 0u; mine = 0u;
#pragma unroll
        for (unsigned j = 0; j < 16; ++j) { const unsigned c = xb_ld(&bar[XB_XCNT(j)]); sum += c; cnt += (c > 0u) ? 1u : 0u; mine = (j == x) ? c : mine; }
        if (sum == G) break;
        __builtin_amdgcn_s_sleep(1);
        if ((++sp & 255u) == 0u) { if (xb_ld(&bar[XB_TMO])) break; if (sp > XB_SPIN_CAP) { atomicAdd(&bar[XB_TMO], 1u); break; } }
    }
    nloc = mine > 0u ? mine : 1u; nx = cnt > 0u ? cnt : 1u;
}

__device__ __forceinline__ void xcd_barrier(const XcdBarrier& b) {
    asm volatile("s_waitcnt vmcnt(0)" ::: "memory");
    __syncthreads();
    if (threadIdx.x == 0) {
        unsigned* bar = b.bar;
        __builtin_amdgcn_s_waitcnt(0);
        unsigned nloc = b.st[0], nx = b.st[1];
        if (nloc == 0u) { xcd_barrier_complete(bar, b.x, nloc, nx); b.st[0] = nloc; b.st[1] = nx; }
        const unsigned old = xb_add(&bar[XB_XSUB(b.x)], 1u);
        const unsigned gen = old / nloc;
        if (old + 1u == (gen + 1u) * nloc) {
            __builtin_amdgcn_fence(__ATOMIC_RELEASE, "agent");
            asm volatile("s_waitcnt vmcnt(0)" ::: "memory");
            const unsigned og = xb_add(&bar[XB_TOP], 1u);
            const unsigned tg = og / nx;
            if (og + 1u == (tg + 1u) * nx) xb_add(&bar[XB_TOPGEN], 1u);
            else XB_SPIN(xb_ld(&bar[XB_TOPGEN]) == tg, bar);
            __builtin_amdgcn_fence(__ATOMIC_ACQUIRE, "agent");
            xb_add(&bar[XB_XGEN(b.x)], 1u);
            asm volatile("s_waitcnt vmcnt(0)" ::: "memory");
        } else {
            XB_SPIN(xb_ld(&bar[XB_XGEN(b.x)]) == gen, bar);
            __builtin_amdgcn_fence(__ATOMIC_ACQUIRE, "agent");
            asm volatile("s_waitcnt vmcnt(0)" ::: "memory");
        }
    }
    __syncthreads();
}


DI void grid_barrier(unsigned* bar, unsigned& gen) {
  asm volatile("s_waitcnt vmcnt(0)" ::: "memory");
  __syncthreads();
  gen += 1;
  if (threadIdx.x == 0) {
    __builtin_amdgcn_fence(__ATOMIC_RELEASE, "agent");
    asm volatile("s_waitcnt vmcnt(0)" ::: "memory");
    const unsigned target = gen * gridDim.x;
    __hip_atomic_fetch_add(bar, 1u, __ATOMIC_RELAXED, __HIP_MEMORY_SCOPE_AGENT);
    while (__hip_atomic_load(bar, __ATOMIC_RELAXED, __HIP_MEMORY_SCOPE_AGENT) < target) __builtin_amdgcn_s_sleep(2);
  }
  __syncthreads();
  __builtin_amdgcn_fence(__ATOMIC_ACQUIRE, "agent");
  asm volatile("s_waitcnt vmcnt(0)" ::: "memory");
}

__global__ void __launch_bounds__(256, 2) hybrid_fwd(Params p, int ph_lo, int ph_hi) {
  extern __shared__ __attribute__((aligned(16))) char smem[];
  unsigned* bar = (unsigned*)(p.ws + OFF_BAR);
  unsigned gen = 0;
  __shared__ uint4 xb_words;
  if (threadIdx.x == 0) xb_words = make_uint4(0u, 0u, 0u, 0u);
  __syncthreads();
  XcdBarrier xb = xcd_barrier_post(bar + 64, (volatile LAS unsigned*)&xb_words);
  if (ph_hi - ph_lo > 1) cg::this_grid().sync();
  int i = 0;
#define STEP(PH, L)                                      \
  {                                                      \
    if (i >= ph_lo && i < ph_hi) {                       \
      Params q;                                          \
      q.ws = p.ws; q.out = p.out;                        \
      asm volatile("" : "+s"(q.ws), "+s"(q.out));        \
      _Pragma("unroll") for (int k = 0; k < 34; ++k) { q.in[k] = p.in[k]; asm volatile("" : "+s"(q.in[k])); } \
      run_phase(q, PH, L, smem);                         \
      if ((DUPMASK >> (PH)) & 1) { xcd_barrier(xb); run_phase(q, PH, L, smem); } \
      if (i + 1 < ph_hi) xcd_barrier(xb);                \
    }                                                    \
    ++i;                                                 \
  }
  STEP(PH_PREP, 0)
  STEP(PH_ROW0, 0)
#pragma unroll 1
  for (int l = 0; l < NL; ++l) {
    STEP(PH_PROJ, l)
    STEP(PH_MIX1, l)
    STEP(PH_SCAN, l)
    STEP(PH_MIX2, l)
    STEP(PH_GLU, l)
    STEP(PH_MERGE, l)
    STEP(PH_WOUT, l)
    STEP(PH_ROW1, l)
    STEP(PH_UP, l)
    STEP(PH_DOWN, l)
    STEP(PH_ROW2, l)
  }
#undef STEP
}

extern "C" void kernel_launch(void* const* d_in, const int* in_sizes, int n_in, void* d_out, int out_size, void* d_ws, size_t ws_size,
                              hipStream_t stream) {
  static int grid_blocks = 0;
  if (!grid_blocks) {
    int dev = 0, cus = 0, per_cu = 0;
    hipGetDevice(&dev);
    hipDeviceGetAttribute(&cus, hipDeviceAttributeMultiprocessorCount, dev);
    hipFuncSetAttribute((const void*)hybrid_fwd, hipFuncAttributeMaxDynamicSharedMemorySize, SMEM_BYTES);
    hipOccupancyMaxActiveBlocksPerMultiprocessor(&per_cu, hybrid_fwd, 256, SMEM_BYTES);
    if (per_cu < 1) per_cu = 1;
    if (per_cu > 2) per_cu = 2;
    grid_blocks = cus * per_cu;
    if (ws_size < OFF_ZERO + 8192) fprintf(stderr, "workspace too small: %zu < %zu\n", ws_size, (size_t)OFF_END);
  }
  Params p{};
  for (int i = 0; i < 34; ++i) p.in[i] = (const float*)d_in[i];
  p.out = (float*)d_out;
  p.ws = (char*)d_ws;
#if ONE_LAUNCH
  hipMemsetAsync((char*)d_ws + OFF_BAR, 0, 16384, stream);
  int lo = 0, hi = N_PHASES;
  void* args[] = {&p, &lo, &hi};
  hipError_t e = hipLaunchCooperativeKernel((void*)hybrid_fwd, dim3(grid_blocks), dim3(256), args, SMEM_BYTES, stream);
  if (e != hipSuccess) fprintf(stderr, "cooperative launch failed: %s (grid %d)\n", hipGetErrorString(e), grid_blocks);
#else
  for (int i = 0; i < N_PHASES; ++i) hipLaunchKernelGGL(hybrid_fwd, dim3(grid_blocks), dim3(256), SMEM_BYTES, stream, p, i, i + 1);
#endif
}
```

```cpp
#include <hip/hip_runtime.h>
#include <hip/hip_cooperative_groups.h>
#include <stdint.h>
#include <cstdio>
namespace cg = cooperative_groups;

#define EXP_A 1
#ifndef DUPMASK
#define DUPMASK 0
#endif
#ifndef ONE_LAUNCH
#define ONE_LAUNCH 1
#endif

typedef unsigned short bf16;
typedef __attribute__((ext_vector_type(8))) short s16x8;
typedef __attribute__((ext_vector_type(4))) short s16x4;
typedef __attribute__((ext_vector_type(16))) float f32x16;
typedef __attribute__((ext_vector_type(4))) float f32x4;
typedef __attribute__((ext_vector_type(2))) float f32x2;
typedef __attribute__((ext_vector_type(4))) unsigned u32x4;
typedef __attribute__((ext_vector_type(2))) unsigned u32x2;
typedef __attribute__((ext_vector_type(2))) __bf16 bf16x2_t;

#define DI __device__ __forceinline__
#define MFMA32(a, b, c) __builtin_amdgcn_mfma_f32_32x32x16_bf16((a), (b), (c), 0, 0, 0)

DI int tidx_opaque() { int t = threadIdx.x; asm volatile("" : "+v"(t)); return t; }
#define TIDX tidx_opaque()
DI bf16 f2bf(float x) { return __builtin_bit_cast(unsigned short, (__bf16)x); }
DI float bf2f(bf16 v) { return __uint_as_float(((unsigned)v) << 16); }
DI unsigned pack2(float a, float b) {
  f32x2 v = {a, b};
  return __builtin_bit_cast(unsigned, __builtin_convertvector(v, bf16x2_t));
}
DI float bflo(unsigned u) { return __uint_as_float(u << 16); }
DI float bfhi(unsigned u) { return __uint_as_float(u & 0xffff0000u); }
typedef const __attribute__((address_space(1))) u32x4* gptr16;
DI u32x4 ldg16(const void* q) { return *(gptr16)(uintptr_t)q; }
#define SCHED_FENCE() __builtin_amdgcn_sched_barrier(0)
DI int crow(int i, int h) { return (i & 3) + 8 * (i >> 2) + 4 * h; }
DI void sincos_cw(float x, float& sn, float& cs) {
  const float k = rintf(x * 0.63661977236758134f);
  float r = fmaf(-k, 1.57079637050628662109375f, x);
  r = fmaf(-k, -4.371139000186241e-08f, r);
  const int q = ((int)k) & 3;
  const float r2 = r * r;
  const float sp = r + r * r2 * (-1.6666667163e-01f + r2 * (8.3333337680e-03f + r2 * (-1.9841270114e-04f + r2 * 2.7557314297e-06f)));
  const float cp = 1.f + r2 * (-0.5f + r2 * (4.1666667908e-02f + r2 * (-1.3888889225e-03f + r2 * (2.4801587642e-05f - r2 * 2.7557314297e-07f))));
  sn = (q == 0) ? sp : (q == 1) ? cp : (q == 2) ? -sp : -cp;
  cs = (q == 0) ? cp : (q == 1) ? -sp : (q == 2) ? -cp : sp;
}
DI float sigmoidf_(float x) { return 1.f / (1.f + __expf(-x)); }
DI float siluf_(float x) { return x / (1.f + __expf(-x)); }

constexpr int DM = 1024, NB = 4, SEQ = 8192, CTXL = 256, TT = SEQ + CTXL, NTOK = NB * TT, NL = 4;
constexpr int DFF = 2816, DIN = 5408;
constexpr float EPSF = 1e-6f;
constexpr int NG33 = 33;
constexpr int NCH = 264;
constexpr int MS5 = NB * NCH;

constexpr size_t SZ_H = (size_t)NTOK * 1024 * 2;
constexpr size_t OFF_H = 0;
constexpr size_t OFF_P = OFF_H + SZ_H;
constexpr size_t OFF_Q = OFF_P;
constexpr size_t OFF_K = OFF_Q + (size_t)NTOK * 256 * 2;
constexpr size_t OFF_VT = OFF_K + (size_t)NTOK * 128 * 2;
constexpr size_t OFF_GQ = OFF_VT + (size_t)NTOK * 128 * 2;
constexpr size_t OFF_GK = OFF_GQ + (size_t)NTOK * 256 * 2;
constexpr size_t OFF_GVT = OFF_GK + (size_t)NTOK * 256 * 2;
constexpr size_t OFF_GR = OFF_GVT + (size_t)NTOK * 512 * 2;
constexpr size_t OFF_SU = OFF_GR + (size_t)NTOK * 512 * 2;
constexpr size_t OFF_LOW = OFF_SU + (size_t)NTOK * 256 * 2;
constexpr size_t OFF_O = OFF_LOW + (size_t)NTOK * 32 * 4;
constexpr size_t OFF_OATT = OFF_O;
constexpr size_t OFF_OGLA = OFF_OATT + (size_t)NTOK * 256 * 2;
constexpr size_t OFF_Y5 = OFF_OGLA + (size_t)NTOK * 512 * 2;
constexpr size_t OFF_EN = OFF_Y5;
constexpr size_t OFF_OS5 = OFF_Y5 + (size_t)NTOK * 256 * 2;
constexpr size_t OFF_M = OFF_OS5 + (size_t)NTOK * 256 * 2;
constexpr size_t OFF_MG = OFF_M;
constexpr size_t OFF_GS = OFF_M;
constexpr size_t OFF_DECG = OFF_GS + (size_t)32 * 33 * 8192 * 4;
constexpr size_t OFF_SB = OFF_DECG + (size_t)32 * 33 * 64 * 4;
constexpr size_t OFF_T5 = OFF_SB + (size_t)MS5 * 16 * 256 * 2;
constexpr size_t OFF_E5 = OFF_T5 + (size_t)16 * 512 * 512 * 2;
constexpr size_t OFF_F5 = OFF_E5 + (size_t)16 * 512 * 256 * 2;
constexpr size_t OFF_MEND = OFF_F5 + (size_t)16 * 256 * 512 * 2;
static_assert(OFF_MEND <= OFF_M + SZ_H, "mixer scratch overflows merged area");
constexpr size_t OFF_W = OFF_M + SZ_H;
constexpr size_t WL_WIN = 0, WL_BRA = WL_WIN + (size_t)5504 * 1024, WL_BRG = WL_BRA + 1024 * 256, WL_BRS = WL_BRG + 1024 * 512,
                 WL_WOUT = WL_BRS + 1024 * 256, WL_UP = WL_WOUT + 1024 * 1024, WL_DOWN = WL_UP + (size_t)5632 * 1024,
                 WL_GLU = WL_DOWN + (size_t)1024 * 2816, WL_TOTAL = WL_GLU + 256 * 256;
constexpr size_t OFF_XC = OFF_W + WL_TOTAL * 2 * NL;
constexpr size_t OFF_MOD = OFF_XC + (size_t)NB * CTXL * 1024 * 4;
constexpr size_t OFF_BBR = OFF_MOD + (size_t)NL * 5 * 6144 * 4;
constexpr size_t OFF_BBI = OFF_BBR + (size_t)NL * 2 * 16 * 64 * 16 * 4;
constexpr size_t OFF_PWR = OFF_BBI + (size_t)NL * 2 * 16 * 64 * 16 * 4;
constexpr size_t OFF_KTAB = OFF_PWR + (size_t)NL * 2 * 16 * 33 * 64 * 8;
constexpr size_t OFF_END = OFF_KTAB + (size_t)NL * 16 * 2 * 32 * 256 * 4;
constexpr size_t OFF_BAR = OFF_END;
constexpr size_t OFF_ZERO = OFF_BAR + 16384;
constexpr size_t OFF_G = OFF_P;
static_assert((size_t)NTOK * DFF * 2 <= OFF_M - OFF_P, "G overflows");

constexpr int SMEM_BYTES = 73728;

struct Params {
  const float* in[34];
  float* out;
  char* ws;
};

enum { I_X = 0, I_C, I_CTX, I_CCTX, I_ADAW, I_ADAB, I_NMPRE, I_NMPOST, I_NFPRE, I_NFPOST, I_WIN, I_QN, I_KN, I_GGW, I_GGB, I_GON,
       I_ARE, I_AIM, I_LDT, I_BRE, I_BIM, I_CRE, I_CIM, I_S5D, I_GLUW, I_GLUB, I_WBA, I_WBG, I_WBS, I_WOUT, I_UP, I_CW, I_CB, I_DOWN };

constexpr int LDT = 72;
constexpr int CLD = 132;

template <class FA, class FB>
DI void gemm_main(f32x16 (&acc)[2][2], FA fa, FB fb, int K, char* smem) {
  bf16* As = (bf16*)smem;
  bf16* Bs = (bf16*)(smem + 2 * 128 * LDT * 2);
  const int tid = TIDX, lane = tid & 63, w = tid >> 6, wm = w >> 1, wn = w & 1;
  const int r = lane & 31, h = lane >> 5;
  const int lr = tid >> 3, kc = (tid & 7) * 8;
  const bf16* ap[4];
  const bf16* bp[4];
#pragma unroll
  for (int i = 0; i < 4; ++i) {
    const bf16* a = fa(lr + 32 * i);
    const bf16* b = fb(lr + 32 * i);
    ap[i] = a ? a + kc : nullptr;
    bp[i] = b ? b + kc : nullptr;
  }
  u32x4 ra[4], rb[4];
  const u32x4 z4 = {0u, 0u, 0u, 0u};
#pragma unroll
  for (int i = 0; i < 4; ++i) {
    ra[i] = ap[i] ? ldg16(ap[i]) : z4;
    rb[i] = bp[i] ? ldg16(bp[i]) : z4;
  }
#pragma unroll
  for (int i = 0; i < 4; ++i) {
    *(u32x4*)(As + (lr + 32 * i) * LDT + kc) = ra[i];
    *(u32x4*)(Bs + (lr + 32 * i) * LDT + kc) = rb[i];
  }
  __syncthreads();
  const int nk = K / 64;
  for (int kt = 0; kt < nk; ++kt) {
    const int buf = kt & 1;
    const bool more = (kt + 1 < nk);
    if (more) {
      const int k0 = (kt + 1) * 64;
#pragma unroll
      for (int i = 0; i < 4; ++i) {
        ra[i] = ap[i] ? ldg16(ap[i] + k0) : z4;
        rb[i] = bp[i] ? ldg16(bp[i] + k0) : z4;
      }
    }
    SCHED_FENCE();
    const bf16* Ab = As + buf * 128 * LDT + (wm * 64 + r) * LDT + h * 8;
    const bf16* Bb = Bs + buf * 128 * LDT + (wn * 64 + r) * LDT + h * 8;
#pragma unroll
    for (int s = 0; s < 4; ++s) {
      s16x8 a0 = *(const s16x8*)(Ab + s * 16);
      s16x8 a1 = *(const s16x8*)(Ab + 32 * LDT + s * 16);
      s16x8 b0 = *(const s16x8*)(Bb + s * 16);
      s16x8 b1 = *(const s16x8*)(Bb + 32 * LDT + s * 16);
      acc[0][0] = MFMA32(a0, b0, acc[0][0]);
      acc[0][1] = MFMA32(a0, b1, acc[0][1]);
      acc[1][0] = MFMA32(a1, b0, acc[1][0]);
      acc[1][1] = MFMA32(a1, b1, acc[1][1]);
    }
    SCHED_FENCE();
    if (more) {
      bf16* Aw = As + (buf ^ 1) * 128 * LDT;
      bf16* Bw = Bs + (buf ^ 1) * 128 * LDT;
#pragma unroll
      for (int i = 0; i < 4; ++i) {
        *(u32x4*)(Aw + (lr + 32 * i) * LDT + kc) = ra[i];
        *(u32x4*)(Bw + (lr + 32 * i) * LDT + kc) = rb[i];
      }
    }
    __syncthreads();
  }
}

template <class FA, class FB>
DI void gemm_main_deep(f32x16 (&acc)[2][2], FA fa, FB fb, int K, char* smem) {
  bf16* As = (bf16*)smem;
  bf16* Bs = (bf16*)(smem + 2 * 128 * LDT * 2);
  const int tid = TIDX, lane = tid & 63, w = tid >> 6, wm = w >> 1, wn = w & 1;
  const int r = lane & 31, h = lane >> 5;
  const int lr = tid >> 3, kc = (tid & 7) * 8;
  const bf16* ap[4];
  const bf16* bp[4];
#pragma unroll
  for (int i = 0; i < 4; ++i) {
    const bf16* a = fa(lr + 32 * i);
    const bf16* b = fb(lr + 32 * i);
    ap[i] = a ? a + kc : nullptr;
    bp[i] = b ? b + kc : nullptr;
  }
  const u32x4 z4 = {0u, 0u, 0u, 0u};
  u32x4 a0[4], b0[4], a1[4], b1[4];
  const int nk = K / 64;
#define GD_LOAD(RA, RB, T)                                               \
  {                                                                      \
    const int k0_ = (T) * 64;                                            \
    _Pragma("unroll") for (int i = 0; i < 4; ++i) {                      \
      RA[i] = ap[i] ? ldg16(ap[i] + k0_) : z4;                           \
      RB[i] = bp[i] ? ldg16(bp[i] + k0_) : z4;                           \
    }                                                                    \
  }
#define GD_STORE(RA, RB, BUF)                                            \
  {                                                                      \
    _Pragma("unroll") for (int i = 0; i < 4; ++i) {                      \
      *(u32x4*)(As + (BUF) * 128 * LDT + (lr + 32 * i) * LDT + kc) = RA[i]; \
      *(u32x4*)(Bs + (BUF) * 128 * LDT + (lr + 32 * i) * LDT + kc) = RB[i]; \
    }                                                                    \
  }
#define GD_COMPUTE(BUF)                                                  \
  {                                                                      \
    const bf16* Ab = As + (BUF) * 128 * LDT + (wm * 64 + r) * LDT + h * 8; \
    const bf16* Bb = Bs + (BUF) * 128 * LDT + (wn * 64 + r) * LDT + h * 8; \
    _Pragma("unroll") for (int s = 0; s < 4; ++s) {                      \
      s16x8 fa0 = *(const s16x8*)(Ab + s * 16);                          \
      s16x8 fa1 = *(const s16x8*)(Ab + 32 * LDT + s * 16);               \
      s16x8 fb0 = *(const s16x8*)(Bb + s * 16);                          \
      s16x8 fb1 = *(const s16x8*)(Bb + 32 * LDT + s * 16);               \
      acc[0][0] = MFMA32(fa0, fb0, acc[0][0]);                           \
      acc[0][1] = MFMA32(fa0, fb1, acc[0][1]);                           \
      acc[1][0] = MFMA32(fa1, fb0, acc[1][0]);                           \
      acc[1][1] = MFMA32(fa1, fb1, acc[1][1]);                           \
    }                                                                    \
  }
  GD_LOAD(a0, b0, 0)
  GD_LOAD(a1, b1, 1)
  GD_STORE(a0, b0, 0)
  __syncthreads();
  if (nk > 2) GD_LOAD(a0, b0, 2)
  for (int kt = 0; kt < nk; kt += 2) {
    SCHED_FENCE();
    GD_COMPUTE(0)
    SCHED_FENCE();
    GD_STORE(a1, b1, 1)
    if (kt + 3 < nk) GD_LOAD(a1, b1, kt + 3)
    __syncthreads();
    SCHED_FENCE();
    GD_COMPUTE(1)
    SCHED_FENCE();
    if (kt + 2 < nk) {
      GD_STORE(a0, b0, 0)
      if (kt + 4 < nk) GD_LOAD(a0, b0, kt + 4)
    }
    __syncthreads();
  }
#undef GD_LOAD
#undef GD_STORE
#undef GD_COMPUTE
}

template <class FA, class FB>
DI void gemm_main_dma(f32x16 (&acc)[2][2], FA fa, FB fb, int K, char* smem) {
  char* As = smem;
  char* Bs = smem + 32768;
  const int tid = TIDX, lane = tid & 63, w = tid >> 6, wm = w >> 1, wn = w & 1;
  const int r = lane & 31, h = lane >> 5;
  const bf16* ap[4];
  const bf16* bp[4];
#pragma unroll
  for (int i = 0; i < 4; ++i) {
    const int row = w * 32 + i * 8 + (lane >> 3);
    const int c = (lane & 7) ^ ((row >> 1) & 7);
    ap[i] = fa(row) + c * 8;
    bp[i] = fb(row) + c * 8;
  }
  const int ldst = (w * 256 + lane) * 16;
#define GM_DMA(BUF, T)                                                                                        \
  {                                                                                                           \
    const int k0_ = (T) * 64;                                                                                 \
    _Pragma("unroll") for (int i = 0; i < 4; ++i) {                                                           \
      __builtin_amdgcn_global_load_lds((const unsigned*)(ap[i] + k0_), (unsigned*)(As + (BUF) * 16384 + ldst + i * 1024), 16, 0, 0); \
      __builtin_amdgcn_global_load_lds((const unsigned*)(bp[i] + k0_), (unsigned*)(Bs + (BUF) * 16384 + ldst + i * 1024), 16, 0, 0); \
    }                                                                                                         \
  }
  const int xr = (r >> 1) & 7;
  const int arow = (wm * 64 + r) * 128, brow = (wn * 64 + r) * 128;
  GM_DMA(0, 0)
  asm volatile("s_waitcnt vmcnt(0)" ::: "memory");
  __syncthreads();
  const int nk = K / 64;
  for (int kt = 0; kt < nk; ++kt) {
    const int buf = kt & 1;
    if (kt + 1 < nk) GM_DMA(buf ^ 1, kt + 1)
    const char* Ab = As + buf * 16384 + arow;
    const char* Bb = Bs + buf * 16384 + brow;
#pragma unroll
    for (int s = 0; s < 4; ++s) {
      const int co = ((2 * s + h) ^ xr) * 16;
      s16x8 a0 = *(const s16x8*)(Ab + co);
      s16x8 a1 = *(const s16x8*)(Ab + 32 * 128 + co);
      s16x8 b0 = *(const s16x8*)(Bb + co);
      s16x8 b1 = *(const s16x8*)(Bb + 32 * 128 + co);
      acc[0][0] = MFMA32(a0, b0, acc[0][0]);
      acc[0][1] = MFMA32(a0, b1, acc[0][1]);
      acc[1][0] = MFMA32(a1, b0, acc[1][0]);
      acc[1][1] = MFMA32(a1, b1, acc[1][1]);
    }
    asm volatile("s_waitcnt vmcnt(0)" ::: "memory");
    __syncthreads();
  }
#undef GM_DMA
}

DI void gemm_main_dma_half(f32x16 (&acc)[2], const bf16* A, int lda, const bf16* B, int ldb, int K, int hf, char* smem) {
  char* As = smem;
  char* Bs = smem + 32768;
  const int tid = TIDX, lane = tid & 63, w = tid >> 6, wm = w >> 1, wn = w & 1;
  const int r = lane & 31, h = lane >> 5;
  const bf16* ap[4];
  const bf16* bp[2];
#pragma unroll
  for (int i = 0; i < 4; ++i) {
    const int row = w * 32 + i * 8 + (lane >> 3);
    ap[i] = A + (size_t)row * lda + ((lane & 7) ^ ((row >> 1) & 7)) * 8;
  }
#pragma unroll
  for (int i = 0; i < 2; ++i) {
    const int lrow = w * 16 + i * 8 + (lane >> 3);
    const int grow = (lrow >> 5) * 64 + hf * 32 + (lrow & 31);
    bp[i] = B + (size_t)grow * ldb + ((lane & 7) ^ ((lrow >> 1) & 7)) * 8;
  }
  const int lda_ = (w * 256 + lane) * 16, ldb_ = (w * 128 + lane) * 16;
#define GH_DMA(BUF, T)                                                                                        \
  {                                                                                                           \
    const int k0_ = (T) * 64;                                                                                 \
    _Pragma("unroll") for (int i = 0; i < 4; ++i)                                                             \
      __builtin_amdgcn_global_load_lds((const unsigned*)(ap[i] + k0_), (unsigned*)(As + (BUF) * 16384 + lda_ + i * 1024), 16, 0, 0); \
    _Pragma("unroll") for (int i = 0; i < 2; ++i)                                                             \
      __builtin_amdgcn_global_load_lds((const unsigned*)(bp[i] + k0_), (unsigned*)(Bs + (BUF) * 8192 + ldb_ + i * 1024), 16, 0, 0); \
  }
  const int xr = (r >> 1) & 7;
  const int arow = (wm * 64 + r) * 128, brow = (wn * 32 + r) * 128;
  GH_DMA(0, 0)
  asm volatile("s_waitcnt vmcnt(0)" ::: "memory");
  __syncthreads();
  const int nk = K / 64;
  for (int kt = 0; kt < nk; ++kt) {
    const int buf = kt & 1;
    if (kt + 1 < nk) GH_DMA(buf ^ 1, kt + 1)
    const char* Ab = As + buf * 16384 + arow;
    const char* Bb = Bs + buf * 8192 + brow;
#pragma unroll
    for (int s = 0; s < 4; ++s) {
      const int co = ((2 * s + h) ^ xr) * 16;
      s16x8 a0 = *(const s16x8*)(Ab + co);
      s16x8 a1 = *(const s16x8*)(Ab + 32 * 128 + co);
      s16x8 b0 = *(const s16x8*)(Bb + co);
      acc[0] = MFMA32(a0, b0, acc[0]);
      acc[1] = MFMA32(a1, b0, acc[1]);
    }
    asm volatile("s_waitcnt vmcnt(0)" ::: "memory");
    __syncthreads();
  }
#undef GH_DMA
}

template <class FA, class FB>
DI void gemm_wide(f32x16 (&acc)[2][4], FA fa, FB fb, int K, char* smem) {
  const int tid = TIDX, lane = tid & 63, w = tid >> 6, wm = w >> 1, wn = w & 1;
  const int r = lane & 31, h = lane >> 5;
  const bf16* ap[2];
  const bf16* bp[4];
#pragma unroll
  for (int i = 0; i < 2; ++i) {
    const int row = w * 32 + i * 16 + (lane >> 2);
    ap[i] = fa(row) + ((lane & 3) ^ ((row >> 2) & 3)) * 8;
  }
#pragma unroll
  for (int i = 0; i < 4; ++i) {
    const int row = w * 64 + i * 16 + (lane >> 2);
    bp[i] = fb(row) + ((lane & 3) ^ ((row >> 2) & 3)) * 8;
  }
  const int lda_ = (w * 128 + lane) * 16;
  const int ldb_ = 8192 + (w * 256 + lane) * 16;
#define GW_DMA(T)                                                                                                   \
  {                                                                                                                 \
    char* st_ = smem + ((T) % 3) * 24576;                                                                           \
    const int k0_ = (T) * 32;                                                                                       \
    _Pragma("unroll") for (int i = 0; i < 2; ++i)                                                                   \
      __builtin_amdgcn_global_load_lds((const unsigned*)(ap[i] + k0_), (unsigned*)(st_ + lda_ + i * 1024), 16, 0, 0); \
    _Pragma("unroll") for (int i = 0; i < 4; ++i)                                                                   \
      __builtin_amdgcn_global_load_lds((const unsigned*)(bp[i] + k0_), (unsigned*)(st_ + ldb_ + i * 1024), 16, 0, 0); \
  }
  const int xr = (r >> 2) & 3;
  const int arow = (wm * 64 + r) * 64;
  const int brow = 8192 + (wn * 64 + r) * 64;
  const int nt = K / 32;
  GW_DMA(0)
  if (nt > 1) GW_DMA(1)
  for (int t = 0; t < nt; ++t) {
    if (t + 1 < nt) asm volatile("s_waitcnt vmcnt(6)" ::: "memory");
    else asm volatile("s_waitcnt vmcnt(0)" ::: "memory");
    __syncthreads();
    if (t + 2 < nt) GW_DMA(t + 2)
    const char* st = smem + (t % 3) * 24576;
#pragma unroll
    for (int s = 0; s < 2; ++s) {
      const int co = ((2 * s + h) ^ xr) * 16;
      const s16x8 a0 = *(const s16x8*)(st + arow + co);
      const s16x8 a1 = *(const s16x8*)(st + arow + 32 * 64 + co);
#pragma unroll
      for (int hn = 0; hn < 2; ++hn) {
        const s16x8 b0 = *(const s16x8*)(st + brow + hn * 128 * 64 + co);
        const s16x8 b1 = *(const s16x8*)(st + brow + hn * 128 * 64 + 32 * 64 + co);
        acc[0][hn * 2 + 0] = MFMA32(a0, b0, acc[0][hn * 2 + 0]);
        acc[0][hn * 2 + 1] = MFMA32(a0, b1, acc[0][hn * 2 + 1]);
        acc[1][hn * 2 + 0] = MFMA32(a1, b0, acc[1][hn * 2 + 0]);
        acc[1][hn * 2 + 1] = MFMA32(a1, b1, acc[1][hn * 2 + 1]);
      }
    }
  }
  __syncthreads();
#undef GW_DMA
}

DI void accw_zero(f32x16 (&acc)[2][4]) {
#pragma unroll
  for (int a = 0; a < 2; ++a)
#pragma unroll
    for (int b = 0; b < 4; ++b)
#pragma unroll
      for (int i = 0; i < 16; ++i) acc[a][b][i] = 0.f;
}

DI void gemm_main_s(f32x16 (&acc)[2][2], const bf16* A, int lda, const bf16* B, int ldb, int K, char* smem) {
  bf16* As = (bf16*)smem;
  bf16* Bs = (bf16*)(smem + 2 * 128 * LDT * 2);
  const int tid = TIDX, lane = tid & 63, w = tid >> 6, wm = w >> 1, wn = w & 1;
  const int r = lane & 31, h = lane >> 5;
  const int lr = tid >> 3, kc = (tid & 7) * 8;
  const bf16* ap = A + (size_t)lr * lda + kc;
  const bf16* bp = B + (size_t)lr * ldb + kc;
  const size_t sa = (size_t)32 * lda, sb = (size_t)32 * ldb;
  u32x4 ra[4], rb[4];
#pragma unroll
  for (int i = 0; i < 4; ++i) {
    ra[i] = ldg16(ap + i * sa);
    rb[i] = ldg16(bp + i * sb);
  }
#pragma unroll
  for (int i = 0; i < 4; ++i) {
    *(u32x4*)(As + (lr + 32 * i) * LDT + kc) = ra[i];
    *(u32x4*)(Bs + (lr + 32 * i) * LDT + kc) = rb[i];
  }
  __syncthreads();
  const int nk = K / 64;
  for (int kt = 0; kt < nk; ++kt) {
    const int buf = kt & 1;
    const bool more = (kt + 1 < nk);
    if (more) {
      ap += 64; bp += 64;
#pragma unroll
      for (int i = 0; i < 4; ++i) {
        ra[i] = ldg16(ap + i * sa);
        rb[i] = ldg16(bp + i * sb);
      }
    }
    SCHED_FENCE();
    const bf16* Ab = As + buf * 128 * LDT + (wm * 64 + r) * LDT + h * 8;
    const bf16* Bb = Bs + buf * 128 * LDT + (wn * 64 + r) * LDT + h * 8;
#pragma unroll
    for (int s = 0; s < 4; ++s) {
      s16x8 a0 = *(const s16x8*)(Ab + s * 16);
      s16x8 a1 = *(const s16x8*)(Ab + 32 * LDT + s * 16);
      s16x8 b0 = *(const s16x8*)(Bb + s * 16);
      s16x8 b1 = *(const s16x8*)(Bb + 32 * LDT + s * 16);
      acc[0][0] = MFMA32(a0, b0, acc[0][0]);
      acc[0][1] = MFMA32(a0, b1, acc[0][1]);
      acc[1][0] = MFMA32(a1, b0, acc[1][0]);
      acc[1][1] = MFMA32(a1, b1, acc[1][1]);
    }
    SCHED_FENCE();
    if (more) {
      bf16* Aw = As + (buf ^ 1) * 128 * LDT;
      bf16* Bw = Bs + (buf ^ 1) * 128 * LDT;
#pragma unroll
      for (int i = 0; i < 4; ++i) {
        *(u32x4*)(Aw + (lr + 32 * i) * LDT + kc) = ra[i];
        *(u32x4*)(Bw + (lr + 32 * i) * LDT + kc) = rb[i];
      }
    }
    __syncthreads();
  }
}

DI void gemm_main_half(f32x16 (&acc)[2], const bf16* A, int lda, const bf16* B, int ldb, int K, int hf, char* smem) {
  bf16* As = (bf16*)smem;
  bf16* Bs = (bf16*)(smem + 2 * 128 * LDT * 2);
  const int tid = TIDX, lane = tid & 63, w = tid >> 6, wm = w >> 1, wn = w & 1;
  const int r = lane & 31, h = lane >> 5;
  const int lr = tid >> 3, kc = (tid & 7) * 8;
  const bf16* ap = A + (size_t)lr * lda + kc;
  const bf16* bp = B + (size_t)(hf * 32 + lr) * ldb + kc;
  const size_t sa = (size_t)32 * lda, sb = (size_t)64 * ldb;
  u32x4 ra[4], rb[2];
#pragma unroll
  for (int i = 0; i < 4; ++i) ra[i] = ldg16(ap + i * sa);
#pragma unroll
  for (int i = 0; i < 2; ++i) rb[i] = ldg16(bp + i * sb);
#pragma unroll
  for (int i = 0; i < 4; ++i) *(u32x4*)(As + (lr + 32 * i) * LDT + kc) = ra[i];
#pragma unroll
  for (int i = 0; i < 2; ++i) *(u32x4*)(Bs + (lr + 32 * i) * LDT + kc) = rb[i];
  __syncthreads();
  const int nk = K / 64;
  for (int kt = 0; kt < nk; ++kt) {
    const int buf = kt & 1;
    const bool more = (kt + 1 < nk);
    if (more) {
      ap += 64; bp += 64;
#pragma unroll
      for (int i = 0; i < 4; ++i) ra[i] = ldg16(ap + i * sa);
#pragma unroll
      for (int i = 0; i < 2; ++i) rb[i] = ldg16(bp + i * sb);
    }
    SCHED_FENCE();
    const bf16* Ab = As + buf * 128 * LDT + (wm * 64 + r) * LDT + h * 8;
    const bf16* Bb = Bs + buf * 128 * LDT + (wn * 32 + r) * LDT + h * 8;
#pragma unroll
    for (int s = 0; s < 4; ++s) {
      s16x8 a0 = *(const s16x8*)(Ab + s * 16);
      s16x8 a1 = *(const s16x8*)(Ab + 32 * LDT + s * 16);
      s16x8 b0 = *(const s16x8*)(Bb + s * 16);
      acc[0] = MFMA32(a0, b0, acc[0]);
      acc[1] = MFMA32(a1, b0, acc[1]);
    }
    SCHED_FENCE();
    if (more) {
      bf16* Aw = As + (buf ^ 1) * 128 * LDT;
      bf16* Bw = Bs + (buf ^ 1) * 128 * LDT;
#pragma unroll
      for (int i = 0; i < 4; ++i) *(u32x4*)(Aw + (lr + 32 * i) * LDT + kc) = ra[i];
#pragma unroll
      for (int i = 0; i < 2; ++i) *(u32x4*)(Bw + (lr + 32 * i) * LDT + kc) = rb[i];
    }
    __syncthreads();
  }
}

DI void acc_zero(f32x16 (&acc)[2][2]) {
#pragma unroll
  for (int a = 0; a < 2; ++a)
#pragma unroll
    for (int b = 0; b < 2; ++b)
#pragma unroll
      for (int i = 0; i < 16; ++i) acc[a][b][i] = 0.f;
}

DI void acc_to_lds(const f32x16 (&acc)[2][2], float* Cs) {
  const int lane = TIDX & 63, w = TIDX >> 6, wm = w >> 1, wn = w & 1, r = lane & 31, h = lane >> 5;
#pragma unroll
  for (int tm = 0; tm < 2; ++tm)
#pragma unroll
    for (int tn = 0; tn < 2; ++tn)
#pragma unroll
      for (int i = 0; i < 16; ++i) Cs[(wm * 64 + tm * 32 + crow(i, h)) * CLD + wn * 64 + tn * 32 + r] = acc[tm][tn][i];
}

template <int HN>
DI void accw_to_lds(const f32x16 (&acc)[2][4], float* Cs) {
  const int lane = TIDX & 63, w = TIDX >> 6, wm = w >> 1, wn = w & 1, r = lane & 31, h = lane >> 5;
#pragma unroll
  for (int tm = 0; tm < 2; ++tm)
#pragma unroll
    for (int tn = 0; tn < 2; ++tn)
#pragma unroll
      for (int i = 0; i < 16; ++i) Cs[(wm * 64 + tm * 32 + crow(i, h)) * CLD + wn * 64 + tn * 32 + r] = acc[tm][HN * 2 + tn][i];
}

DI void store_tile_bf16(const float* Cs, bf16* dst, size_t ld, int mvalid, float scale) {
  for (int c = TIDX; c < 2048; c += 256) {
    const int row = c >> 4, cc = (c & 15) * 8;
    if (row < mvalid) {
      const float* s = Cs + row * CLD + cc;
      u32x4 v;
      v[0] = pack2(s[0] * scale, s[1] * scale);
      v[1] = pack2(s[2] * scale, s[3] * scale);
      v[2] = pack2(s[4] * scale, s[5] * scale);
      v[3] = pack2(s[6] * scale, s[7] * scale);
      *(u32x4*)(dst + (size_t)row * ld + cc) = v;
    }
  }
}

DI float* resid_row(const Params& p, int tok) {
  const int b = tok / TT, t = tok - b * TT;
  return (t < CTXL) ? (float*)(p.ws + OFF_XC) + ((size_t)b * CTXL + t) * DM : p.out + ((size_t)b * SEQ + (t - CTXL)) * DM;
}
DI const float* mod_vec(const Params& p, int l, int tok, int which) {
  const int b = tok / TT, t = tok - b * TT;
  const int m = (t < CTXL) ? 4 : b;
  return (const float*)(p.ws + OFF_MOD) + ((size_t)(l * 5 + m) * 6 + which) * DM;
}
DI float wave_sum(float v) {
#pragma unroll
  for (int o = 32; o >= 1; o >>= 1) v += __shfl_xor(v, o, 64);
  return v;
}
DI bf16* wl(const Params& p, int l, size_t off) { return (bf16*)(p.ws + OFF_W) + (size_t)l * WL_TOTAL + off; }

DI void prep_mod_job(const Params& p, int j, char* smem) {
  float* sc = (float*)smem;
  float* part = (float*)(smem + 20480);
  const int l = j / 24, nb = j % 24, tid = TIDX, lane = tid & 63, w = tid >> 6;
  for (int idx = tid; idx < 5120; idx += 256) {
    const int m = idx >> 10, k = idx & 1023;
    const float v = (m < 4) ? p.in[I_C][m * 1024 + k] : p.in[I_CCTX][k];
    sc[idx] = siluf_(v);
  }
  __syncthreads();
  const float* W = p.in[I_ADAW] + (size_t)l * 1024 * 6144 + nb * 256 + lane;
  float a[5][4];
#pragma unroll
  for (int m = 0; m < 5; ++m)
#pragma unroll
    for (int c = 0; c < 4; ++c) a[m][c] = 0.f;
#pragma unroll 4
  for (int kk = 0; kk < 256; ++kk) {
    const int k = w * 256 + kk;
    float wv[4];
#pragma unroll
    for (int c = 0; c < 4; ++c) wv[c] = W[(size_t)k * 6144 + 64 * c];
#pragma unroll
    for (int m = 0; m < 5; ++m) {
      const float sv = sc[m * 1024 + k];
#pragma unroll
      for (int c = 0; c < 4; ++c) a[m][c] += sv * wv[c];
    }
  }
#pragma unroll
  for (int m = 0; m < 5; ++m)
#pragma unroll
    for (int c = 0; c < 4; ++c) part[(w * 5 + m) * 256 + lane + 64 * c] = a[m][c];
  __syncthreads();
  const int n = nb * 256 + tid;
  const float bb = p.in[I_ADAB][l * 6144 + n];
  float* M = (float*)(p.ws + OFF_MOD) + (size_t)l * 5 * 6144 + n;
#pragma unroll
  for (int m = 0; m < 5; ++m)
    M[m * 6144] = part[(0 * 5 + m) * 256 + tid] + part[(1 * 5 + m) * 256 + tid] + part[(2 * 5 + m) * 256 + tid] + part[(3 * 5 + m) * 256 + tid] + bb;
  __syncthreads();
}

DI void prep_s5_job(const Params& p, int j) {
  const int idx = j * 256 + TIDX;
  const int ldg = idx >> 6, pp = idx & 63;
  const float dt = expf(p.in[I_LDT][ldg]);
  const float are = p.in[I_ARE][idx], aim = p.in[I_AIM][idx];
  const float mag = expf(are * dt);
  float sn, cs;
  sincos_cw(aim * dt, sn, cs);
  const float abr = mag * cs, abi = mag * sn;
  const float den = are * are + aim * aim;
  const float fre = ((abr - 1.f) * are + abi * aim) / den;
  const float fim = (abi * are - (abr - 1.f) * aim) / den;
  float* BBR = (float*)(p.ws + OFF_BBR);
  float* BBI = (float*)(p.ws + OFF_BBI);
  for (int hh = 0; hh < 16; ++hh) {
    const float br = p.in[I_BRE][(size_t)idx * 16 + hh], bi = p.in[I_BIM][(size_t)idx * 16 + hh];
    BBR[(size_t)idx * 16 + hh] = fre * br - fim * bi;
    BBI[(size_t)idx * 16 + hh] = fre * bi + fim * br;
  }
  float2* PW = (float2*)(p.ws + OFF_PWR);
  float pr = 1.f, pi = 0.f;
  for (int tau = 0; tau <= 32; ++tau) {
    PW[((size_t)ldg * 33 + tau) * 64 + pp] = make_float2(pr, pi);
    const float nr = pr * abr - pi * abi, ni = pr * abi + pi * abr;
    pr = nr; pi = ni;
  }
}

DI void prep_wt_job(const Params& p, int jj, char* smem) {
  float* tile = (float*)smem;
  const int l = jj / 4016;
  int r = jj % 4016;
  int mat = 0;
  const int cnt[8] = {1376, 64, 128, 64, 256, 1408, 704, 16};
#pragma unroll
  for (int m = 0; m < 8; ++m) {
    if (mat == m && r >= cnt[m]) { r -= cnt[m]; mat = m + 1; }
  }
  const float* src; int K, sld; size_t doff;
  switch (mat) {
    case 0: src = p.in[I_WIN] + (size_t)l * 1024 * DIN; K = 1024; sld = DIN; doff = WL_WIN; break;
    case 1: src = p.in[I_WBA] + (size_t)l * 256 * 1024; K = 256; sld = 1024; doff = WL_BRA; break;
    case 2: src = p.in[I_WBG] + (size_t)l * 512 * 1024; K = 512; sld = 1024; doff = WL_BRG; break;
    case 3: src = p.in[I_WBS] + (size_t)l * 256 * 1024; K = 256; sld = 1024; doff = WL_BRS; break;
    case 4: src = p.in[I_WOUT] + (size_t)l * 1024 * 1024; K = 1024; sld = 1024; doff = WL_WOUT; break;
    case 5: src = p.in[I_UP] + (size_t)l * 1024 * 5632; K = 1024; sld = 5632; doff = WL_UP; break;
    case 6: src = p.in[I_DOWN] + (size_t)l * 2816 * 1024; K = 2816; sld = 1024; doff = WL_DOWN; break;
    default: src = p.in[I_GLUW] + (size_t)l * 256 * 256; K = 256; sld = 256; doff = WL_GLU; break;
  }
  const int kt = K / 64;
  const int n0 = (r / kt) * 64, k0 = (r % kt) * 64;
  const int tid = TIDX;
  {
    const int nn = tid & 63;
    const int np = n0 + nn;
    int col;
    if (mat == 0) {
      if (np < 2048) col = np;
      else if (np < 2304) col = 2080 + (np - 2048);
      else if (np < 2336) col = 2048 + (np - 2304);
      else if (np < 2432) col = -1;
      else col = 2336 + (np - 2432);
    } else if (mat == 5) {
      const int jb = np >> 7, c = np & 127;
      col = (c < 64) ? (jb * 64 + c) : (DFF + jb * 64 + (c - 64));
    } else col = np;
#pragma unroll 4
    for (int kk = tid >> 6; kk < 64; kk += 4) tile[kk * 65 + nn] = (col >= 0) ? src[(size_t)(k0 + kk) * sld + col] : 0.f;
  }
  __syncthreads();
  {
    const int nn = tid >> 2, kq = (tid & 3) * 16;
    bf16* d = wl(p, l, doff) + (size_t)(n0 + nn) * K + k0 + kq;
    u32x4 v0, v1;
#pragma unroll
    for (int e = 0; e < 4; ++e) {
      v0[e] = pack2(tile[(kq + 2 * e) * 65 + nn], tile[(kq + 2 * e + 1) * 65 + nn]);
      v1[e] = pack2(tile[(kq + 8 + 2 * e) * 65 + nn], tile[(kq + 8 + 2 * e + 1) * 65 + nn]);
    }
    *(u32x4*)d = v0;
    *(u32x4*)(d + 8) = v1;
  }
  __syncthreads();
}

template <int MODE>
DI void row_job(const Params& p, int l, int tok) {
  const int lane = TIDX & 63;
  float x[16];
  float* xr = resid_row(p, tok);
  if (MODE == 0) {
    const int b = tok / TT, t = tok - b * TT;
    const float* src = (t < CTXL) ? p.in[I_CTX] + ((size_t)b * CTXL + t) * DM : p.in[I_X] + ((size_t)b * SEQ + (t - CTXL)) * DM;
#pragma unroll
    for (int i = 0; i < 4; ++i) {
      const f32x4 v = *(const f32x4*)(src + lane * 4 + 256 * i);
      x[4 * i] = v[0]; x[4 * i + 1] = v[1]; x[4 * i + 2] = v[2]; x[4 * i + 3] = v[3];
      *(f32x4*)(xr + lane * 4 + 256 * i) = v;
    }
  } else {
    const bf16* yr = (const bf16*)(p.ws + OFF_H) + (size_t)tok * DM;
    const float* gpost = p.in[MODE == 1 ? I_NMPOST : I_NFPOST] + l * DM;
    const float* mg = mod_vec(p, l, tok, MODE == 1 ? 2 : 5);
    float y[16];
    float ss = 0.f;
#pragma unroll
    for (int i = 0; i < 4; ++i) {
      const u32x2 u = *(const u32x2*)(yr + lane * 4 + 256 * i);
      y[4 * i] = bflo(u[0]); y[4 * i + 1] = bfhi(u[0]); y[4 * i + 2] = bflo(u[1]); y[4 * i + 3] = bfhi(u[1]);
#pragma unroll
      for (int e = 0; e < 4; ++e) ss += y[4 * i + e] * y[4 * i + e];
    }
    ss = wave_sum(ss);
    const float rstd = rsqrtf(ss * (1.f / DM) + EPSF);
#pragma unroll
    for (int i = 0; i < 4; ++i) {
      f32x4 v = *(const f32x4*)(xr + lane * 4 + 256 * i);
      const f32x4 g = *(const f32x4*)(gpost + lane * 4 + 256 * i);
      const f32x4 m = *(const f32x4*)(mg + lane * 4 + 256 * i);
#pragma unroll
      for (int e = 0; e < 4; ++e) { v[e] += m[e] * (y[4 * i + e] * rstd * g[e]); x[4 * i + e] = v[e]; }
      *(f32x4*)(xr + lane * 4 + 256 * i) = v;
    }
  }
  if (MODE == 2 && l == NL - 1) return;
  const int ln = (MODE == 2) ? l + 1 : l;
  const float* gpre = p.in[MODE == 1 ? I_NFPRE : I_NMPRE] + ln * DM;
  const float* sh = mod_vec(p, ln, tok, MODE == 1 ? 3 : 0);
  const float* scv = mod_vec(p, ln, tok, MODE == 1 ? 4 : 1);
  float ss = 0.f;
#pragma unroll
  for (int i = 0; i < 16; ++i) ss += x[i] * x[i];
  ss = wave_sum(ss);
  const float rstd = rsqrtf(ss * (1.f / DM) + EPSF);
  bf16* hr = (bf16*)(p.ws + OFF_H) + (size_t)tok * DM;
#pragma unroll
  for (int i = 0; i < 4; ++i) {
    const f32x4 g = *(const f32x4*)(gpre + lane * 4 + 256 * i);
    const f32x4 s1 = *(const f32x4*)(sh + lane * 4 + 256 * i);
    const f32x4 s2 = *(const f32x4*)(scv + lane * 4 + 256 * i);
    float o[4];
#pragma unroll
    for (int e = 0; e < 4; ++e) o[e] = (x[4 * i + e] * rstd * g[e]) * (1.f + s2[e]) + s1[e];
    u32x2 u;
    u[0] = pack2(o[0], o[1]); u[1] = pack2(o[2], o[3]);
    *(u32x2*)(hr + lane * 4 + 256 * i) = u;
  }
}

template <int MODE>
DI void row_phase(const Params& p, int l, int bid, int G) {
  const int lane = TIDX & 63;
  const int wg = bid * 4 + (TIDX >> 6), nw = G * 4;
  const int R = (NTOK + nw - 1) / nw;
  const int t0 = wg * R, t1 = min(NTOK, t0 + R);
  if (t0 >= t1) return;
  const bool has_next = !(MODE == 2 && l == NL - 1);
  const int ln = (MODE == 2) ? l + 1 : l;
  f32x4 gpost[4], gpre[4], mg[4], sh[4], scl[4];
#pragma unroll
  for (int i = 0; i < 4; ++i) {
    if (MODE != 0) gpost[i] = *(const f32x4*)(p.in[MODE == 1 ? I_NMPOST : I_NFPOST] + l * DM + lane * 4 + 256 * i);
    if (has_next) gpre[i] = *(const f32x4*)(p.in[MODE == 1 ? I_NFPRE : I_NMPRE] + ln * DM + lane * 4 + 256 * i);
  }
  int cur_m = -1;
  u32x2 yb[4], yn[4];
  f32x4 xb[4], xn[4];
  const bf16* Hb = (const bf16*)(p.ws + OFF_H);
#define ROW_LOAD(TOK, YY, XX)                                                                              \
  {                                                                                                        \
    const int b_ = (TOK) / TT, t_ = (TOK) - b_ * TT;                                                       \
    const float* src_ = (MODE == 0) ? ((t_ < CTXL) ? p.in[I_CTX] + ((size_t)b_ * CTXL + t_) * DM           \
                                                   : p.in[I_X] + ((size_t)b_ * SEQ + (t_ - CTXL)) * DM)    \
                                    : resid_row(p, (TOK));                                                 \
    _Pragma("unroll") for (int i = 0; i < 4; ++i) {                                                        \
      XX[i] = *(const f32x4*)(src_ + lane * 4 + 256 * i);                                                  \
      if (MODE != 0) YY[i] = *(const u32x2*)(Hb + (size_t)(TOK) * DM + lane * 4 + 256 * i);                \
    }                                                                                                      \
  }
  ROW_LOAD(t0, yb, xb)
  for (int tok = t0; tok < t1; ++tok) {
    if (tok + 1 < t1) ROW_LOAD(tok + 1, yn, xn)
    const int b = tok / TT, t = tok - b * TT;
    const int m = (t < CTXL) ? 4 : b;
    if (m != cur_m) {
      cur_m = m;
      const float* Mv = (const float*)(p.ws + OFF_MOD);
#pragma unroll
      for (int i = 0; i < 4; ++i) {
        if (MODE != 0) mg[i] = *(const f32x4*)(Mv + ((size_t)(l * 5 + m) * 6 + (MODE == 1 ? 2 : 5)) * DM + lane * 4 + 256 * i);
        if (has_next) {
          sh[i] = *(const f32x4*)(Mv + ((size_t)(ln * 5 + m) * 6 + (MODE == 1 ? 3 : 0)) * DM + lane * 4 + 256 * i);
          scl[i] = *(const f32x4*)(Mv + ((size_t)(ln * 5 + m) * 6 + (MODE == 1 ? 4 : 1)) * DM + lane * 4 + 256 * i);
        }
      }
    }
    float* xr = resid_row(p, tok);
    f32x4 x[4];
    if (MODE == 0) {
#pragma unroll
      for (int i = 0; i < 4; ++i) { x[i] = xb[i]; *(f32x4*)(xr + lane * 4 + 256 * i) = x[i]; }
    } else {
      float y[16];
      float ss = 0.f;
#pragma unroll
      for (int i = 0; i < 4; ++i) {
        y[4 * i] = bflo(yb[i][0]); y[4 * i + 1] = bfhi(yb[i][0]); y[4 * i + 2] = bflo(yb[i][1]); y[4 * i + 3] = bfhi(yb[i][1]);
#pragma unroll
        for (int e = 0; e < 4; ++e) ss += y[4 * i + e] * y[4 * i + e];
      }
      ss = wave_sum(ss);
      const float rstd = rsqrtf(ss * (1.f / DM) + EPSF);
#pragma unroll
      for (int i = 0; i < 4; ++i) {
        f32x4 v = xb[i];
#pragma unroll
        for (int e = 0; e < 4; ++e) v[e] += mg[i][e] * (y[4 * i + e] * rstd * gpost[i][e]);
        x[i] = v;
        *(f32x4*)(xr + lane * 4 + 256 * i) = v;
      }
    }
    if (has_next) {
      float ss = 0.f;
#pragma unroll
      for (int i = 0; i < 4; ++i)
#pragma unroll
        for (int e = 0; e < 4; ++e) ss += x[i][e] * x[i][e];
      ss = wave_sum(ss);
      const float rstd = rsqrtf(ss * (1.f / DM) + EPSF);
      bf16* hr = (bf16*)(p.ws + OFF_H) + (size_t)tok * DM;
#pragma unroll
      for (int i = 0; i < 4; ++i) {
        float o[4];
#pragma unroll
        for (int e = 0; e < 4; ++e) o[e] = (x[i][e] * rstd * gpre[i][e]) * (1.f + scl[i][e]) + sh[i][e];
        u32x2 u;
        u[0] = pack2(o[0], o[1]); u[1] = pack2(o[2], o[3]);
        *(u32x2*)(hr + lane * 4 + 256 * i) = u;
      }
    }
#pragma unroll
    for (int i = 0; i < 4; ++i) { yb[i] = yn[i]; xb[i] = xn[i]; }
  }
#undef ROW_LOAD
}

DI void ktab_phase(const Params& p, int bid, int G) {
  const float* BBR = (const float*)(p.ws + OFF_BBR);
  const float* BBI = (const float*)(p.ws + OFF_BBI);
  const float2* PW = (const float2*)(p.ws + OFF_PWR);
  float* KT = (float*)(p.ws + OFF_KTAB);
  const int total = NL * 16 * 2 * 32 * 256;
  for (int idx = bid * 256 + TIDX; idx < total; idx += G * 256) {
    const int hp = idx & 15, hh = (idx >> 4) & 15, tau = (idx >> 8) & 31, d = (idx >> 13) & 1, g = (idx >> 14) & 15, l = idx >> 18;
    const int ldg = (l * 2 + d) * 16 + g;
    const float* cre = p.in[I_CRE] + ((size_t)ldg * 16 + hh) * 64;
    const float* cim = p.in[I_CIM] + ((size_t)ldg * 16 + hh) * 64;
    float acc = 0.f;
    for (int pp = 0; pp < 64; ++pp) {
      const float2 pw = PW[((size_t)ldg * 33 + tau) * 64 + pp];
      const float br = BBR[((size_t)ldg * 64 + pp) * 16 + hp], bi = BBI[((size_t)ldg * 64 + pp) * 16 + hp];
      const float zr = pw.x * br - pw.y * bi, zi = pw.x * bi + pw.y * br;
      acc += cre[pp] * zr - cim[pp] * zi;
    }
    KT[idx] = acc;
  }
}

DI void s5mat_phase(const Params& p, int l, int bid, int G) {
  const float* BBR = (const float*)(p.ws + OFF_BBR);
  const float* BBI = (const float*)(p.ws + OFF_BBI);
  const float2* PW = (const float2*)(p.ws + OFF_PWR);
  const float* KT = (const float*)(p.ws + OFF_KTAB);
  bf16* T5 = (bf16*)(p.ws + OFF_T5);
  bf16* E5 = (bf16*)(p.ws + OFF_E5);
  bf16* F5 = (bf16*)(p.ws + OFF_F5);
  const int nT = 16 * 512 * 64, nE = 16 * 512 * 32, nF = 16 * 256 * 64;
  for (int it = bid * 256 + TIDX; it < nT + nE + nF; it += G * 256) {
    float v[8];
    bf16* dst;
    if (it < nT) {
      const int k8 = it & 63, n = (it >> 6) & 511, g = it >> 15;
      const int i = n >> 4, hh = n & 15, j = k8 >> 1, hp0 = (k8 & 1) * 8;
#pragma unroll
      for (int e = 0; e < 8; ++e) {
        const int hp = hp0 + e;
        float a = 0.f;
        if (j <= i) a += KT[((((size_t)l * 16 + g) * 2 + 0) * 32 + (i - j)) * 256 + hh * 16 + hp];
        if (j >= i) a += KT[((((size_t)l * 16 + g) * 2 + 1) * 32 + (j - i)) * 256 + hh * 16 + hp];
        if (i == j && hh == hp) a += p.in[I_S5D][l * 256 + g * 16 + hh];
        v[e] = a;
      }
      dst = T5 + ((size_t)g * 512 + n) * 512 + k8 * 8;
    } else if (it < nT + nE) {
      const int q = it - nT;
      const int k8 = q & 31, n = (q >> 5) & 511, g = q >> 14;
      const int i = n >> 4, hh = n & 15;
      const int k0 = k8 * 8, d = k0 >> 7, ri = (k0 >> 6) & 1, p0 = k0 & 63;
      const int ldg = (l * 2 + d) * 16 + g;
      const int ex = d ? (32 - i) : (i + 1);
#pragma unroll
      for (int e = 0; e < 8; ++e) {
        const int pp = p0 + e;
        const float2 pw = PW[((size_t)ldg * 33 + ex) * 64 + pp];
        const float cr = p.in[I_CRE][((size_t)ldg * 16 + hh) * 64 + pp], ci = p.in[I_CIM][((size_t)ldg * 16 + hh) * 64 + pp];
        const float zr = cr * pw.x - ci * pw.y, zi = cr * pw.y + ci * pw.x;
        v[e] = ri ? -zi : zr;
      }
      dst = E5 + ((size_t)g * 512 + n) * 256 + k0;
    } else {
      const int q = it - nT - nE;
      const int k8 = q & 63, n = (q >> 6) & 255, g = q >> 14;
      const int d = n >> 7, ri = (n >> 6) & 1, pp = n & 63;
      const int j = k8 >> 1, hp0 = (k8 & 1) * 8;
      const int ldg = (l * 2 + d) * 16 + g;
      const int ex = d ? j : (31 - j);
      const float2 pw = PW[((size_t)ldg * 33 + ex) * 64 + pp];
#pragma unroll
      for (int e = 0; e < 8; ++e) {
        const float br = BBR[((size_t)ldg * 64 + pp) * 16 + hp0 + e], bi = BBI[((size_t)ldg * 64 + pp) * 16 + hp0 + e];
        v[e] = ri ? (pw.x * bi + pw.y * br) : (pw.x * br - pw.y * bi);
      }
      dst = F5 + ((size_t)g * 256 + n) * 512 + k8 * 8;
    }
    u32x4 u;
    u[0] = pack2(v[0], v[1]); u[1] = pack2(v[2], v[3]); u[2] = pack2(v[4], v[5]); u[3] = pack2(v[6], v[7]);
    *(u32x4*)dst = u;
  }
}

DI void proj_epi(const Params& p, int l, int mt, int nt, char* smem);
DI void proj_wide(const Params& p, int l, int mt, int np, char* smem) {
  const bf16* H = (const bf16*)(p.ws + OFF_H) + (size_t)mt * 128 * DM;
  const bf16* W = wl(p, l, WL_WIN) + (size_t)np * 256 * DM;
  f32x16 acc[2][4];
  accw_zero(acc);
  gemm_wide(acc, [&](int r) { return H + (size_t)r * DM; }, [&](int r) { return W + (size_t)r * DM; }, DM, smem);
  float* Cs = (float*)smem;
  accw_to_lds<0>(acc, Cs);
  __syncthreads();
  proj_epi(p, l, mt, np * 2, smem);
  if (np * 2 + 1 < 19) {
    accw_to_lds<1>(acc, Cs);
    __syncthreads();
    proj_epi(p, l, mt, np * 2 + 1, smem);
  }
}
DI void proj_epi(const Params& p, int l, int mt, int nt, char* smem) {
  float* Cs = (float*)smem;
  const int tid = TIDX;
  const int tok0 = mt * 128;
  const int b = tok0 / TT, t0 = tok0 - b * TT;
  if (nt <= 2) {
    const int row = tid >> 1, seg = tid & 1;
    float* c = Cs + row * CLD + seg * 64;
    const float* gn = p.in[nt < 2 ? I_QN : I_KN] + l * 64;
    float ss = 0.f;
#pragma unroll 8
    for (int i = 0; i < 64; ++i) ss += c[i] * c[i];
    const float rstd = rsqrtf(ss * (1.f / 64.f) + EPSF);
    const int t = t0 + row;
    const bool lat = t >= CTXL;
    const int s = t - CTXL;
#pragma unroll 1
    for (int ax = 0; ax < 2; ++ax) {
      const float pos = (float)(ax ? (s & 63) : (s >> 6));
#pragma unroll 2
      for (int f = 0; f < 16; ++f) {
        float x1 = c[ax * 32 + f] * rstd * gn[ax * 32 + f];
        float x2 = c[ax * 32 + 16 + f] * rstd * gn[ax * 32 + 16 + f];
        if (lat) {
          const float invf = exp2f(-(float)f * (13.287712379549449f / 16.f));
          float sn, cs;
          sincos_cw(pos * invf, sn, cs);
          const float y1 = x1 * cs - x2 * sn, y2 = x2 * cs + x1 * sn;
          x1 = y1; x2 = y2;
        }
        c[ax * 32 + f] = x1;
        c[ax * 32 + 16 + f] = x2;
      }
    }
    __syncthreads();
    if (nt < 2) store_tile_bf16(Cs, (bf16*)(p.ws + OFF_Q) + (size_t)tok0 * 256 + nt * 128, 256, 128, 0.125f * 1.4426950408889634f);
    else store_tile_bf16(Cs, (bf16*)(p.ws + OFF_K) + (size_t)tok0 * 128, 128, 128, 1.f);
  } else if (nt == 3 || (nt >= 8 && nt <= 11)) {
    for (int c = tid; c < 2048; c += 256) {
      const int col = c & 127, rc = (c >> 7) * 8;
      u32x4 u;
#pragma unroll
      for (int e = 0; e < 4; ++e) u[e] = pack2(Cs[(rc + 2 * e) * CLD + col], Cs[(rc + 2 * e + 1) * CLD + col]);
      bf16* dst;
      if (nt == 3) dst = (bf16*)(p.ws + OFF_VT) + ((size_t)(b * 2 + (col >> 6)) * 64 + (col & 63)) * TT + t0 + rc;
      else dst = (bf16*)(p.ws + OFF_GVT) + ((size_t)(b * 4 + (nt - 8)) * 128 + col) * TT + t0 + rc;
      *(u32x4*)dst = u;
    }
  } else if (nt == 4 || nt == 5) {
    store_tile_bf16(Cs, (bf16*)(p.ws + OFF_GQ) + (size_t)tok0 * 256 + (nt - 4) * 128, 256, 128, 0.125f);
  } else if (nt == 6 || nt == 7) {
    store_tile_bf16(Cs, (bf16*)(p.ws + OFF_GK) + (size_t)tok0 * 256 + (nt - 6) * 128, 256, 128, 1.f);
  } else if (nt >= 12 && nt <= 15) {
    store_tile_bf16(Cs, (bf16*)(p.ws + OFF_GR) + (size_t)tok0 * 512 + (nt - 12) * 128, 512, 128, 1.f);
  } else if (nt == 16 || nt == 17) {
    for (int c = tid; c < 2048; c += 256) {
      const int row = c >> 4, c8 = c & 15;
      const float* s = Cs + row * CLD + c8 * 8;
      u32x4 u;
#pragma unroll
      for (int e = 0; e < 4; ++e) u[e] = pack2(s[2 * e], s[2 * e + 1]);
      const int ch = (nt - 16) * 128 + c8 * 8;
      bf16* dst = (bf16*)(p.ws + OFF_SU) + ((size_t)(b * 16 + (ch >> 4)) * TT + t0 + row) * 16 + (ch & 15);
      *(u32x4*)dst = u;
    }
  } else {
    for (int c = tid; c < 128 * 8; c += 256) {
      const int row = c >> 3, c4 = (c & 7) * 4;
      const float* s = Cs + row * CLD + c4;
      f32x4 v = {s[0], s[1], s[2], s[3]};
      *(f32x4*)((float*)(p.ws + OFF_LOW) + (size_t)(tok0 + row) * 32 + c4) = v;
    }
  }
  __syncthreads();
}

DI void attn_unit(const Params& p, int u, char* smem) {
  int b, head, tok0, nkt;
  if (u < 1024) { b = u >> 8; head = (u >> 6) & 3; tok0 = b * TT + CTXL + (u & 63) * 128; nkt = TT / 128; }
  else { const int v = u - 1024; b = v >> 3; head = (v >> 1) & 3; tok0 = b * TT + (v & 1) * 128; nkt = CTXL / 128; }
  const int kvh = head >> 1;
  const int tid = TIDX, lane = tid & 63, w = tid >> 6, r = lane & 31, h = lane >> 5;
  const bf16* Qp = (const bf16*)(p.ws + OFF_Q) + (size_t)(tok0 + w * 32 + r) * 256 + head * 64 + h * 8;
  s16x8 qf[4];
#pragma unroll
  for (int s = 0; s < 4; ++s) qf[s] = __builtin_bit_cast(s16x8, ldg16(Qp + s * 16));
  const bf16* kp[2];
  const bf16* vp[2];
#pragma unroll
  for (int i = 0; i < 2; ++i) {
    const int row = w * 16 + i * 8 + (lane >> 3);
    const int c = (lane & 7) ^ ((row >> 1) & 7);
    kp[i] = (const bf16*)(p.ws + OFF_K) + ((size_t)b * TT + row) * 128 + kvh * 64 + c * 8;
    vp[i] = (const bf16*)(p.ws + OFF_VT) + ((size_t)(b * 2 + kvh) * 64 + row) * TT + c * 8;
  }
  const int ldst = (w * 128 + lane) * 16;
#define AT_DMA(BUF, T)                                                                                              \
  {                                                                                                                 \
    char* sb_ = smem + (BUF) * 32768;                                                                               \
    _Pragma("unroll") for (int hh = 0; hh < 2; ++hh)                                                                \
    _Pragma("unroll") for (int i = 0; i < 2; ++i) {                                                                 \
      __builtin_amdgcn_global_load_lds((const unsigned*)(kp[i] + (size_t)((T) * 128 + hh * 64) * 128), (unsigned*)(sb_ + hh * 8192 + ldst + i * 1024), 16, 0, 0); \
      __builtin_amdgcn_global_load_lds((const unsigned*)(vp[i] + (T) * 128 + hh * 64), (unsigned*)(sb_ + 16384 + hh * 8192 + ldst + i * 1024), 16, 0, 0);        \
    }                                                                                                               \
  }
  const int xr = (r >> 1) & 7;
  AT_DMA(0, 0)
  asm volatile("s_waitcnt vmcnt(0)" ::: "memory");
  __syncthreads();
  f32x16 oacc[2];
#pragma unroll
  for (int i = 0; i < 16; ++i) { oacc[0][i] = 0.f; oacc[1][i] = 0.f; }
  float mrow = -INFINITY, lrow = 0.f;
  for (int kt = 0; kt < nkt; ++kt) {
    const int buf = kt & 1;
    if (kt + 1 < nkt) AT_DMA(buf ^ 1, kt + 1)
    const char* Kb = smem + buf * 32768;
    const char* Vb = Kb + 16384;
    f32x16 sacc[4];
#pragma unroll
    for (int q = 0; q < 4; ++q)
#pragma unroll
      for (int i = 0; i < 16; ++i) sacc[q][i] = 0.f;
#pragma unroll
    for (int s = 0; s < 4; ++s) {
      const int co = ((2 * s + h) ^ xr) * 16;
#pragma unroll
      for (int q = 0; q < 4; ++q) {
        const s16x8 a = *(const s16x8*)(Kb + (q >> 1) * 8192 + ((q & 1) * 32 + r) * 128 + co);
        sacc[q] = MFMA32(a, qf[s], sacc[q]);
      }
    }
    float mx = sacc[0][0];
#pragma unroll
    for (int q = 0; q < 4; ++q)
#pragma unroll
      for (int i = 0; i < 16; ++i) mx = fmaxf(mx, sacc[q][i]);
    mx = fmaxf(mx, __shfl_xor(mx, 32, 64));
    const float mnew = fmaxf(mrow, mx);
    const float alpha = __builtin_amdgcn_exp2f(mrow - mnew);
    mrow = mnew;
    float psum = 0.f;
#pragma unroll
    for (int q = 0; q < 4; ++q)
#pragma unroll
      for (int i = 0; i < 16; ++i) { sacc[q][i] = __builtin_amdgcn_exp2f(sacc[q][i] - mnew); psum += sacc[q][i]; }
    lrow = lrow * alpha + psum;
#pragma unroll
    for (int i = 0; i < 16; ++i) { oacc[0][i] *= alpha; oacc[1][i] *= alpha; }
#pragma unroll
    for (int q = 0; q < 4; ++q)
#pragma unroll
      for (int s2 = 0; s2 < 2; ++s2) {
        u32x4 pu;
#pragma unroll
        for (int e = 0; e < 4; ++e) pu[e] = pack2(sacc[q][8 * s2 + 2 * e], sacc[q][8 * s2 + 2 * e + 1]);
        const s16x8 pf = __builtin_bit_cast(s16x8, pu);
        const int c0 = (q & 1) * 4 + 2 * s2;
        const int o0 = ((c0 ^ xr) * 16) + 8 * h, o1 = (((c0 + 1) ^ xr) * 16) + 8 * h;
#pragma unroll
        for (int dt = 0; dt < 2; ++dt) {
          const s16x4 lo = *(const s16x4*)(Vb + (q >> 1) * 8192 + (dt * 32 + r) * 128 + o0);
          const s16x4 hi = *(const s16x4*)(Vb + (q >> 1) * 8192 + (dt * 32 + r) * 128 + o1);
          const s16x8 a = __builtin_shufflevector(lo, hi, 0, 1, 2, 3, 4, 5, 6, 7);
          oacc[dt] = MFMA32(a, pf, oacc[dt]);
        }
      }
    asm volatile("s_waitcnt vmcnt(0)" ::: "memory");
    __syncthreads();
  }
#undef AT_DMA
  const float ltot = lrow + __shfl_xor(lrow, 32, 64);
  const float inv = 1.f / ltot;
  bf16* Op = (bf16*)(p.ws + OFF_OATT) + (size_t)(tok0 + w * 32 + r) * 256 + head * 64;
#pragma unroll
  for (int dt = 0; dt < 2; ++dt)
#pragma unroll
    for (int i = 0; i < 16; i += 4) {
      u32x2 uu;
      uu[0] = pack2(oacc[dt][i] * inv, oacc[dt][i + 1] * inv);
      uu[1] = pack2(oacc[dt][i + 2] * inv, oacc[dt][i + 3] * inv);
      *(u32x2*)(Op + dt * 32 + crow(i, h)) = uu;
    }
}

constexpr int GL_LOW = 0, GL_TOT = 4096, GL_DEC = 5120, GL_QIN = 5376, GL_KIN = 14592, GL_KET = 23808, GL_OST = 0,
              GL_VT = 33792, GL_ST = 52224;
static_assert(GL_ST + 128 * LDT * 2 <= SMEM_BYTES, "gla lds");

template <bool WITH_OUT>
DI void gla_unit(const Params& p, int l, int u, char* smem) {
  float* lowt = (float*)(smem + GL_LOW);
  float* tots = (float*)(smem + GL_TOT);
  float* decs = (float*)(smem + GL_DEC);
  bf16* qin = (bf16*)(smem + GL_QIN);
  bf16* kin = (bf16*)(smem + GL_KIN);
  bf16* ket = (bf16*)(smem + GL_KET);
  float* ost = (float*)(smem + GL_OST);
  bf16* vts = (bf16*)(smem + GL_VT);
  bf16* sts = (bf16*)(smem + GL_ST);
  const int tid = TIDX, lane = tid & 63, w = tid >> 6, r = lane & 31, h = lane >> 5;
  int b, hd, gi, dir0, ndir;
  if (WITH_OUT) { gi = u % NG33; hd = (u / NG33) & 3; b = u / (NG33 * 4); dir0 = 1; ndir = 2; }
  else { gi = u % NG33; const int v = u / NG33; dir0 = v & 1; hd = (v >> 1) & 3; b = v >> 3; ndir = 1; }
  const int dk = tid & 63, part = tid >> 6;
  const bf16* GQ = (const bf16*)(p.ws + OFF_GQ);
  const bf16* GK = (const bf16*)(p.ws + OFF_GK);
  const bf16* GVT = (const bf16*)(p.ws + OFF_GVT) + (size_t)(b * 4 + hd) * 128 * TT;
  const float* LOW = (const float*)(p.ws + OFF_LOW);
  for (int dd = 0; dd < ndir; ++dd) {
    const int dir = WITH_OUT ? (dir0 - dd) : dir0;
    float* GSu = (float*)(p.ws + OFF_GS) + ((size_t)((b * 4 + hd) * 2 + dir) * NG33 + gi) * 8192;
    float gwreg[16];
#pragma unroll
    for (int rr = 0; rr < 16; ++rr) gwreg[rr] = p.in[I_GGW][((size_t)(l * 2 + dir) * 16 + rr) * 256 + hd * 64 + dk];
    const float gb = p.in[I_GGB][(l * 2 + dir) * 256 + hd * 64 + dk];
    f32x16 sacc[2];
    if (WITH_OUT) {
#pragma unroll
      for (int dkt = 0; dkt < 2; ++dkt)
#pragma unroll
        for (int i = 0; i < 16; ++i) {
          const float v = GSu[(w * 32 + crow(i, h)) * 64 + dkt * 32 + r];
          sacc[dkt][i] = v;
          sts[(w * 32 + crow(i, h)) * LDT + dkt * 32 + r] = f2bf(v);
        }
    } else {
#pragma unroll
      for (int i = 0; i < 16; ++i) { sacc[0][i] = 0.f; sacc[1][i] = 0.f; }
    }
    float gtot = 0.f;
    for (int cc = 0; cc < 4; ++cc) {
      const int ci = dir ? 3 - cc : cc;
      const int tb = gi * 256 + ci * 64;
      const size_t tokb = (size_t)b * TT + tb;
      {
        const int row = tid >> 2, c4 = (tid & 3) * 4;
        const u32x4 lw = ldg16(LOW + (tokb + row) * 32 + dir * 16 + c4);
        u32x4 vv[4], kq[2], qq[2];
#pragma unroll
        for (int i = 0; i < 4; ++i) {
          const int c = tid + 256 * i, e = c >> 3, k8 = (c & 7) * 8;
          vv[i] = ldg16(GVT + (size_t)e * TT + tb + k8);
        }
#pragma unroll
        for (int i = 0; i < 2; ++i) {
          const int c = tid + 256 * i, rw = c >> 3, k8 = (c & 7) * 8;
          kq[i] = ldg16(GK + (tokb + rw) * 256 + hd * 64 + k8);
          if (WITH_OUT) qq[i] = ldg16(GQ + (tokb + rw) * 256 + hd * 64 + k8);
        }
        *(u32x4*)(lowt + row * 16 + c4) = lw;
#pragma unroll
        for (int i = 0; i < 4; ++i) {
          const int c = tid + 256 * i, e = c >> 3, k8 = (c & 7) * 8;
          *(u32x4*)(vts + e * LDT + k8) = vv[i];
        }
#pragma unroll
        for (int i = 0; i < 2; ++i) {
          const int c = tid + 256 * i, rw = c >> 3, k8 = (c & 7) * 8;
          *(u32x4*)(kin + rw * LDT + k8) = kq[i];
          if (WITH_OUT) *(u32x4*)(qin + rw * LDT + k8) = qq[i];
        }
      }
      __syncthreads();
      float cum = 0.f;
#pragma unroll 2
      for (int ii = 0; ii < 16; ++ii) {
        const int pos = part * 16 + ii, t = dir ? 63 - pos : pos;
        float z = gb;
#pragma unroll
        for (int rr = 0; rr < 16; ++rr) z += lowt[t * 16 + rr] * gwreg[rr];
        cum += (fminf(z, 0.f) - log1pf(__expf(-fabsf(z)))) * (1.f / 16.f);
      }
      tots[part * 64 + dk] = cum;
      __syncthreads();
      float offs = 0.f, total = 0.f;
#pragma unroll
      for (int pp = 0; pp < 4; ++pp) { const float tv = tots[pp * 64 + dk]; total += tv; if (pp < part) offs += tv; }
      if (part == 0) decs[dk] = __expf(total);
      gtot += total;
      float bq = offs;
#pragma unroll 2
      for (int ii = 0; ii < 16; ++ii) {
        const int pos = part * 16 + ii, t = dir ? 63 - pos : pos;
        float z = gb;
#pragma unroll
        for (int rr = 0; rr < 16; ++rr) z += lowt[t * 16 + rr] * gwreg[rr];
        bq += (fminf(z, 0.f) - log1pf(__expf(-fabsf(z)))) * (1.f / 16.f);
        const float kv = bf2f(kin[t * LDT + dk]);
        ket[dk * LDT + t] = f2bf(kv * __expf(total - bq));
        if (WITH_OUT) {
          const float qv = bf2f(qin[t * LDT + dk]);
          qin[t * LDT + dk] = f2bf(qv * __expf(bq));
          kin[t * LDT + dk] = f2bf(kv * __expf(-bq));
        }
      }
      __syncthreads();
      f32x16 oo[2];
      const int it = w & 1, ep = w >> 1;
      if (WITH_OUT) {
        const int ti = w >> 1, tj = w & 1;
        f32x16 aa;
#pragma unroll
        for (int i = 0; i < 16; ++i) aa[i] = 0.f;
#pragma unroll
        for (int s = 0; s < 4; ++s) {
          const s16x8 A = *(const s16x8*)(qin + (ti * 32 + r) * LDT + s * 16 + h * 8);
          const s16x8 Bv = *(const s16x8*)(kin + (tj * 32 + r) * LDT + s * 16 + h * 8);
          aa = MFMA32(A, Bv, aa);
        }
        __syncthreads();
#pragma unroll
        for (int i = 0; i < 16; ++i) {
          const int qi = ti * 32 + crow(i, h), kj = tj * 32 + r;
          const bool keep = dir ? (kj >= qi) : (kj <= qi);
          kin[qi * LDT + kj] = f2bf(keep ? aa[i] : 0.f);
        }
        __syncthreads();
#pragma unroll
        for (int i = 0; i < 16; ++i) { oo[0][i] = 0.f; oo[1][i] = 0.f; }
#pragma unroll
        for (int s = 0; s < 4; ++s) {
          const s16x8 A1 = *(const s16x8*)(kin + (it * 32 + r) * LDT + s * 16 + h * 8);
          const s16x8 A2 = *(const s16x8*)(qin + (it * 32 + r) * LDT + s * 16 + h * 8);
#pragma unroll
          for (int x = 0; x < 2; ++x) {
            const int et = 2 * ep + x;
            const s16x8 B1 = *(const s16x8*)(vts + (et * 32 + r) * LDT + s * 16 + h * 8);
            const s16x8 B2 = *(const s16x8*)(sts + (et * 32 + r) * LDT + s * 16 + h * 8);
            oo[x] = MFMA32(A1, B1, oo[x]);
            oo[x] = MFMA32(A2, B2, oo[x]);
          }
        }
      }
#pragma unroll
      for (int dkt = 0; dkt < 2; ++dkt) {
        const float dv = decs[dkt * 32 + r];
#pragma unroll
        for (int i = 0; i < 16; ++i) sacc[dkt][i] *= dv;
      }
#pragma unroll
      for (int s = 0; s < 4; ++s) {
        const s16x8 A = *(const s16x8*)(vts + (w * 32 + r) * LDT + s * 16 + h * 8);
#pragma unroll
        for (int dkt = 0; dkt < 2; ++dkt) {
          const s16x8 Bv = *(const s16x8*)(ket + (dkt * 32 + r) * LDT + s * 16 + h * 8);
          sacc[dkt] = MFMA32(A, Bv, sacc[dkt]);
        }
      }
      __syncthreads();
      if (WITH_OUT) {
#pragma unroll
        for (int dkt = 0; dkt < 2; ++dkt)
#pragma unroll
          for (int i = 0; i < 16; ++i) sts[(w * 32 + crow(i, h)) * LDT + dkt * 32 + r] = f2bf(sacc[dkt][i]);
#pragma unroll
        for (int x = 0; x < 2; ++x)
#pragma unroll
          for (int i = 0; i < 16; ++i) ost[(it * 32 + crow(i, h)) * CLD + (2 * ep + x) * 32 + r] = oo[x][i];
        __syncthreads();
        const int row = tid >> 2, qd = tid & 3;
        const size_t tok = tokb + row;
        bf16* og = (bf16*)(p.ws + OFF_OGLA) + tok * 512 + hd * 128 + qd * 32;
        const float* os = ost + row * CLD + qd * 32;
        if (dir == 1) {
#pragma unroll
          for (int i = 0; i < 4; ++i) {
            u32x4 uu;
#pragma unroll
            for (int e = 0; e < 4; ++e) uu[e] = pack2(os[i * 8 + 2 * e], os[i * 8 + 2 * e + 1]);
            *(u32x4*)(og + i * 8) = uu;
          }
        } else {
          float ss = 0.f;
#pragma unroll 1
          for (int i = 0; i < 4; ++i) {
            const u32x4 uu = *(const u32x4*)(og + i * 8);
#pragma unroll
            for (int e = 0; e < 4; ++e) {
              const float a0 = os[i * 8 + 2 * e] + bflo(uu[e]), a1 = os[i * 8 + 2 * e + 1] + bfhi(uu[e]);
              ss += a0 * a0 + a1 * a1;
            }
          }
          ss += __shfl_xor(ss, 1, 64);
          ss += __shfl_xor(ss, 2, 64);
          const float rstd = rsqrtf(ss * (1.f / 128.f) + EPSF);
          const float* gn = p.in[I_GON] + l * 128 + qd * 32;
          const bf16* gr = (const bf16*)(p.ws + OFF_GR) + tok * 512 + hd * 128 + qd * 32;
#pragma unroll 1
          for (int i = 0; i < 4; ++i) {
            const u32x4 uo = *(const u32x4*)(og + i * 8);
            const u32x4 ug = *(const u32x4*)(gr + i * 8);
            u32x4 uu;
#pragma unroll
            for (int e = 0; e < 4; ++e) {
              const float v0 = os[i * 8 + 2 * e] + bflo(uo[e]), v1 = os[i * 8 + 2 * e + 1] + bfhi(uo[e]);
              const float a0 = v0 * rstd * gn[i * 8 + 2 * e] * siluf_(bflo(ug[e]));
              const float a1 = v1 * rstd * gn[i * 8 + 2 * e + 1] * siluf_(bfhi(ug[e]));
              uu[e] = pack2(a0, a1);
            }
            *(u32x4*)(og + i * 8) = uu;
          }
        }
        __syncthreads();
      }
    }
    if (!WITH_OUT) {
#pragma unroll
      for (int dkt = 0; dkt < 2; ++dkt)
#pragma unroll
        for (int i = 0; i < 16; ++i) GSu[(w * 32 + crow(i, h)) * 64 + dkt * 32 + r] = sacc[dkt][i];
      if (part == 0) ((float*)(p.ws + OFF_DECG))[((size_t)((b * 4 + hd) * 2 + dir) * NG33 + gi) * 64 + dk] = __expf(gtot);
    }
    __syncthreads();
  }
}

DI void gla_scan_job(const Params& p, int j) {
  const int idx = j * 256 + TIDX;
  const int seq = idx >> 13, el = idx & 8191, dk = el & 63, dir = seq & 1;
  float* GS = (float*)(p.ws + OFF_GS) + (size_t)seq * NG33 * 8192 + el;
  const float* DG = (const float*)(p.ws + OFF_DECG) + (size_t)seq * NG33 * 64 + dk;
  float s = 0.f;
  for (int st0 = 0; st0 < 33; st0 += 11) {
    float kv[11], dc[11];
#pragma unroll
    for (int q = 0; q < 11; ++q) {
      const int st = st0 + q;
      const int g = (dir == 0 || st == 0) ? st : 33 - st;
      kv[q] = GS[(size_t)g * 8192];
      dc[q] = DG[g * 64];
    }
#pragma unroll
    for (int q = 0; q < 11; ++q) {
      const int st = st0 + q;
      const int g = (dir == 0 || st == 0) ? st : 33 - st;
      GS[(size_t)g * 8192] = s;
      s = dc[q] * s + kv[q];
    }
  }
}

DI void s5_end_tile(const Params& p, int j, char* smem) {
  const int nt = j & 1, mt = (j >> 1) % 9, g = j / 18;
  const bf16* SU = (const bf16*)(p.ws + OFF_SU);
  const bf16* F = (const bf16*)(p.ws + OFF_F5) + ((size_t)g * 256 + nt * 128) * 512;
  f32x16 acc[2][2];
  acc_zero(acc);
  gemm_main_dma(acc,
            [&](int r) -> const bf16* {
              const int m = mt * 128 + r;
              if (m >= MS5) return (const bf16*)(p.ws + OFF_ZERO);
              const int b = m / NCH, ch = m - b * NCH;
              return SU + ((size_t)(b * 16 + g) * TT + ch * 32) * 16;
            },
            [&](int r) { return F + (size_t)r * 512; }, 512, smem);
  float* Cs = (float*)smem;
  acc_to_lds(acc, Cs);
  __syncthreads();
  float* EN = (float*)(p.ws + OFF_EN);
  for (int c = TIDX; c < 128 * 32; c += 256) {
    const int row = c >> 5, c4 = (c & 31) * 4, m = mt * 128 + row;
    if (m < MS5) {
      const float* s = Cs + row * CLD + c4;
      f32x4 v = {s[0], s[1], s[2], s[3]};
      *(f32x4*)(EN + ((size_t)m * 16 + g) * 256 + nt * 128 + c4) = v;
    }
  }
  __syncthreads();
}

DI void s5_scan_job(const Params& p, int l, int j, char* smem) {
  float2* ends = (float2*)smem;
  const int dir = j & 1, g = (j >> 1) & 15, b = j >> 5;
  const int pp = TIDX & 63, seg = TIDX >> 6;
  const float2 aL = ((const float2*)(p.ws + OFF_PWR))[((size_t)((l * 2 + dir) * 16 + g) * 33 + 32) * 64 + pp];
  const float* EN = (const float*)(p.ws + OFF_EN);
  bf16* SB = (bf16*)(p.ws + OFF_SB);
  float sr = 0.f, si = 0.f;
  for (int q0 = 0; q0 < 66; q0 += 11) {
    float er[11], ei[11];
#pragma unroll
    for (int q = 0; q < 11; ++q) {
      const int pos = seg * 66 + q0 + q;
      const int ch = dir ? (pos < 8 ? 7 - pos : 271 - pos) : pos;
      const float* e = EN + ((size_t)(b * NCH + ch) * 16 + g) * 256 + dir * 128 + pp;
      er[q] = e[0]; ei[q] = e[64];
    }
#pragma unroll
    for (int q = 0; q < 11; ++q) {
      const float nr = aL.x * sr - aL.y * si + er[q], ni = aL.x * si + aL.y * sr + ei[q];
      sr = nr; si = ni;
    }
  }
  ends[seg * 64 + pp] = make_float2(sr, si);
  float pr = 1.f, pi = 0.f;
  for (int q = 0; q < 66; ++q) { const float nr = pr * aL.x - pi * aL.y, ni = pr * aL.y + pi * aL.x; pr = nr; pi = ni; }
  __syncthreads();
  sr = 0.f; si = 0.f;
  for (int k = 0; k < seg; ++k) {
    const float2 e = ends[k * 64 + pp];
    const float nr = pr * sr - pi * si + e.x, ni = pr * si + pi * sr + e.y;
    sr = nr; si = ni;
  }
  for (int q0 = 0; q0 < 66; q0 += 11) {
    float er[11], ei[11];
#pragma unroll
    for (int q = 0; q < 11; ++q) {
      const int pos = seg * 66 + q0 + q;
      const int ch = dir ? (pos < 8 ? 7 - pos : 271 - pos) : pos;
      const float* e = EN + ((size_t)(b * NCH + ch) * 16 + g) * 256 + dir * 128 + pp;
      er[q] = e[0]; ei[q] = e[64];
    }
#pragma unroll
    for (int q = 0; q < 11; ++q) {
      const int pos = seg * 66 + q0 + q;
      const int ch = dir ? (pos < 8 ? 7 - pos : 271 - pos) : pos;
      bf16* sb = SB + ((size_t)(b * NCH + ch) * 16 + g) * 256 + dir * 128 + pp;
      sb[0] = f2bf(sr); sb[64] = f2bf(si);
      const float nr = aL.x * sr - aL.y * si + er[q], ni = aL.x * si + aL.y * sr + ei[q];
      sr = nr; si = ni;
    }
  }
  __syncthreads();
}

DI float gelu_tanh(float x) {
  const float u = 0.7978845608028654f * (x + 0.044715f * x * x * x);
  return 0.5f * x * (1.f + tanhf(u));
}

DI void s5_out_tile(const Params& p, int j, char* smem) {
  const int nt = j & 3, mt = (j >> 2) % 9, g = j / 36;
  const bf16* SU = (const bf16*)(p.ws + OFF_SU);
  const bf16* SB = (const bf16*)(p.ws + OFF_SB);
  const bf16* Tm = (const bf16*)(p.ws + OFF_T5) + ((size_t)g * 512 + nt * 128) * 512;
  const bf16* Em = (const bf16*)(p.ws + OFF_E5) + ((size_t)g * 512 + nt * 128) * 256;
  f32x16 acc[2][2];
  acc_zero(acc);
  gemm_main_dma(acc,
            [&](int r) -> const bf16* {
              const int m = mt * 128 + r;
              if (m >= MS5) return (const bf16*)(p.ws + OFF_ZERO);
              const int b = m / NCH, ch = m - b * NCH;
              return SU + ((size_t)(b * 16 + g) * TT + ch * 32) * 16;
            },
            [&](int r) { return Tm + (size_t)r * 512; }, 512, smem);
  gemm_main_dma(acc,
            [&](int r) -> const bf16* {
              const int m = mt * 128 + r;
              if (m >= MS5) return (const bf16*)(p.ws + OFF_ZERO);
              return SB + ((size_t)m * 16 + g) * 256;
            },
            [&](int r) { return Em + (size_t)r * 256; }, 256, smem);
  float* Cs = (float*)smem;
  acc_to_lds(acc, Cs);
  __syncthreads();
  bf16* Y5 = (bf16*)(p.ws + OFF_Y5);
  for (int c = TIDX; c < 2048; c += 256) {
    const int row = c >> 4, c8 = c & 15, m = mt * 128 + row;
    if (m < MS5) {
      const int b = m / NCH, ch = m - b * NCH;
      const int n = nt * 128 + c8 * 8, i = n >> 4, hh = n & 15;
      const float* s = Cs + row * CLD + c8 * 8;
      u32x4 u;
#pragma unroll
      for (int e = 0; e < 4; ++e) u[e] = pack2(gelu_tanh(s[2 * e]), gelu_tanh(s[2 * e + 1]));
      *(u32x4*)(Y5 + ((size_t)b * TT + ch * 32 + i) * 256 + g * 16 + hh) = u;
    }
  }
  __syncthreads();
}

DI void glu_tile(const Params& p, int l, int j, char* smem) {
  const int nt = j & 1, mt = j >> 1;
  const bf16* Y5 = (const bf16*)(p.ws + OFF_Y5) + (size_t)mt * 128 * 256;
  const bf16* W = wl(p, l, WL_GLU) + (size_t)nt * 128 * 256;
  f32x16 acc[2][2];
  acc_zero(acc);
  gemm_main_dma(acc, [&](int r) { return Y5 + (size_t)r * 256; }, [&](int r) { return W + (size_t)r * 256; }, 256, smem);
  float* Cs = (float*)smem;
  acc_to_lds(acc, Cs);
  __syncthreads();
  const float* gb = p.in[I_GLUB] + l * 256 + nt * 128;
  bf16* O = (bf16*)(p.ws + OFF_OS5) + (size_t)mt * 128 * 256 + nt * 128;
  for (int c = TIDX; c < 2048; c += 256) {
    const int row = c >> 4, cc = (c & 15) * 8;
    const float* s = Cs + row * CLD + cc;
    const u32x4 yu = *(const u32x4*)(Y5 + (size_t)row * 256 + nt * 128 + cc);
    u32x4 u;
#pragma unroll
    for (int e = 0; e < 4; ++e) {
      const float y0 = bflo(yu[e]), y1 = bfhi(yu[e]);
      u[e] = pack2(y0 * sigmoidf_(s[2 * e] + gb[cc + 2 * e]), y1 * sigmoidf_(s[2 * e + 1] + gb[cc + 2 * e + 1]));
    }
    *(u32x4*)(O + (size_t)row * 256 + cc) = u;
  }
  __syncthreads();
}

DI void merge_tile(const Params& p, int l, int j, char* smem) {
  const int nt = j & 7, mt = j >> 3;
  const bf16* H = (const bf16*)(p.ws + OFF_H) + (size_t)mt * 128 * DM;
  unsigned am[2][2][8];
#pragma unroll
  for (int a = 0; a < 2; ++a)
#pragma unroll
    for (int bq = 0; bq < 2; ++bq)
#pragma unroll
      for (int i = 0; i < 8; ++i) am[a][bq][i] = 0u;
#pragma unroll 1
  for (int x = 0; x < 3; ++x) {
    const bf16* Wg = wl(p, l, WL_WIN) + ((size_t)2432 + x * 1024 + nt * 128) * DM;
    unsigned sg[2][2][8];
    {
      f32x16 acc[2][2];
      acc_zero(acc);
      gemm_main_dma(acc, [&](int r) { return H + (size_t)r * DM; }, [&](int r) { return Wg + (size_t)r * DM; }, DM, smem);
#pragma unroll
      for (int a = 0; a < 2; ++a)
#pragma unroll
        for (int bq = 0; bq < 2; ++bq)
#pragma unroll
          for (int i = 0; i < 8; ++i) sg[a][bq][i] = pack2(sigmoidf_(acc[a][bq][2 * i]), sigmoidf_(acc[a][bq][2 * i + 1]));
    }
    const bf16* A; const bf16* Wb; int K;
    if (x == 0) { A = (const bf16*)(p.ws + OFF_OATT) + (size_t)mt * 128 * 256; Wb = wl(p, l, WL_BRA) + (size_t)nt * 128 * 256; K = 256; }
    else if (x == 1) { A = (const bf16*)(p.ws + OFF_OGLA) + (size_t)mt * 128 * 512; Wb = wl(p, l, WL_BRG) + (size_t)nt * 128 * 512; K = 512; }
    else { A = (const bf16*)(p.ws + OFF_OS5) + (size_t)mt * 128 * 256; Wb = wl(p, l, WL_BRS) + (size_t)nt * 128 * 256; K = 256; }
#pragma unroll
    for (int hf = 0; hf < 2; ++hf) {
      f32x16 a2[2];
#pragma unroll
      for (int i = 0; i < 16; ++i) { a2[0][i] = 0.f; a2[1][i] = 0.f; }
      gemm_main_dma_half(a2, A, K, Wb, K, K, hf, smem);
#pragma unroll
      for (int a = 0; a < 2; ++a)
#pragma unroll
        for (int i = 0; i < 8; ++i) {
          const float v0 = bflo(am[a][hf][i]) + bflo(sg[a][hf][i]) * a2[a][2 * i];
          const float v1 = bfhi(am[a][hf][i]) + bfhi(sg[a][hf][i]) * a2[a][2 * i + 1];
          am[a][hf][i] = pack2(v0, v1);
        }
    }
  }
  f32x16 accm[2][2];
#pragma unroll
  for (int a = 0; a < 2; ++a)
#pragma unroll
    for (int bq = 0; bq < 2; ++bq)
#pragma unroll
      for (int i = 0; i < 8; ++i) { accm[a][bq][2 * i] = bflo(am[a][bq][i]); accm[a][bq][2 * i + 1] = bfhi(am[a][bq][i]); }
  float* Cs = (float*)smem;
  acc_to_lds(accm, Cs);
  __syncthreads();
  store_tile_bf16(Cs, (bf16*)(p.ws + OFF_MG) + (size_t)mt * 128 * DM + nt * 128, DM, 128, 1.f);
  __syncthreads();
}

DI void plain_tile(const bf16* A, int K, const bf16* W, bf16* dst, int ldd, char* smem) {
  f32x16 acc[2][2];
  acc_zero(acc);
  gemm_main_dma(acc, [&](int r) { return A + (size_t)r * K; }, [&](int r) { return W + (size_t)r * K; }, K, smem);
  float* Cs = (float*)smem;
  acc_to_lds(acc, Cs);
  __syncthreads();
  store_tile_bf16(Cs, dst, ldd, 128, 1.f);
  __syncthreads();
}

DI void plain_wide(const bf16* A, int K, const bf16* W, bf16* dst, int ldd, char* smem) {
  f32x16 acc[2][4];
  accw_zero(acc);
  gemm_wide(acc, [&](int r) { return A + (size_t)r * K; }, [&](int r) { return W + (size_t)r * K; }, K, smem);
  float* Cs = (float*)smem;
  accw_to_lds<0>(acc, Cs);
  __syncthreads();
  store_tile_bf16(Cs, dst, ldd, 128, 1.f);
  __syncthreads();
  accw_to_lds<1>(acc, Cs);
  __syncthreads();
  store_tile_bf16(Cs, dst + 128, ldd, 128, 1.f);
  __syncthreads();
}

DI void up_epi(const Params& p, int l, int jn, int seqbase, int len, int pos0, char* smem) {
  float* Cs = (float*)smem;
  const float* cw = p.in[I_CW] + (size_t)l * 3 * 2 * DFF;
  const float* cb = p.in[I_CB] + (size_t)l * 2 * DFF;
  bf16* G = (bf16*)(p.ws + OFF_G);
  const int tid = TIDX;
  const int c = (tid & 31) * 2;
  float wa[2][3], wv[2][3], ba[2], bv[2];
#pragma unroll
  for (int e = 0; e < 2; ++e) {
    const int ca = jn * 64 + c + e, cv = DFF + ca;
#pragma unroll
    for (int k = 0; k < 3; ++k) { wa[e][k] = cw[k * 2 * DFF + ca]; wv[e][k] = cw[k * 2 * DFF + cv]; }
    ba[e] = cb[ca]; bv[e] = cb[cv];
  }
#pragma unroll 4
  for (int rr = 1 + (tid >> 5); rr < 127; rr += 8) {
    const int pos = pos0 + rr;
    if (pos < len) {
      float gv[2];
#pragma unroll
      for (int e = 0; e < 2; ++e) {
        const float a = wa[e][0] * Cs[(rr - 1) * CLD + c + e] + wa[e][1] * Cs[rr * CLD + c + e] + wa[e][2] * Cs[(rr + 1) * CLD + c + e] + ba[e];
        const float v = wv[e][0] * Cs[(rr - 1) * CLD + 64 + c + e] + wv[e][1] * Cs[rr * CLD + 64 + c + e] +
                        wv[e][2] * Cs[(rr + 1) * CLD + 64 + c + e] + bv[e];
        gv[e] = siluf_(a) * v;
      }
      *(unsigned*)(G + (size_t)(seqbase + pos) * DFF + jn * 64 + c) = pack2(gv[0], gv[1]);
    }
  }
  __syncthreads();
}

DI void up_wide(const Params& p, int l, int mtile, int jp, char* smem) {
  const int b = mtile / 69, rr0 = mtile % 69;
  int seqbase, len, ti;
  if (rr0 < 3) { seqbase = b * TT; len = CTXL; ti = rr0; }
  else { seqbase = b * TT + CTXL; len = SEQ; ti = rr0 - 3; }
  const int pos0 = ti * 126 - 1;
  const bf16* H = (const bf16*)(p.ws + OFF_H);
  const bf16* W = wl(p, l, WL_UP) + (size_t)jp * 256 * DM;
  f32x16 acc[2][4];
  accw_zero(acc);
  gemm_wide(acc,
            [&](int r) -> const bf16* {
              const int pos = pos0 + r;
              return (pos >= 0 && pos < len) ? H + (size_t)(seqbase + pos) * DM : (const bf16*)(p.ws + OFF_ZERO);
            },
            [&](int r) { return W + (size_t)r * DM; }, DM, smem);
  float* Cs = (float*)smem;
  accw_to_lds<0>(acc, Cs);
  __syncthreads();
  up_epi(p, l, jp * 2, seqbase, len, pos0, smem);
  accw_to_lds<1>(acc, Cs);
  __syncthreads();
  up_epi(p, l, jp * 2 + 1, seqbase, len, pos0, smem);
}

DI bool gemm_job(int bid, int G, int it, int MT, int NTL, int& mt, int& nt, int CW = 8) {
  const int x = bid & 7, q = bid >> 3, Q = G >> 3;
  const int m0 = (x * MT) >> 3, m1 = ((x + 1) * MT) >> 3, Mx = m1 - m0;
  const int jl = q + Q * it;
  if (jl >= Mx * NTL) return false;
  const int full = Mx * CW;
  const int c = jl / full, rem = jl - c * full;
  const int wc = min(CW, NTL - CW * c);
  const int mi = rem / wc;
  mt = m0 + mi;
  nt = CW * c + (rem - mi * wc);
  return true;
}

enum { PH_PREP = 0, PH_ROW0, PH_PROJ, PH_MIX1, PH_SCAN, PH_MIX2, PH_GLU, PH_MERGE, PH_WOUT, PH_ROW1, PH_UP, PH_DOWN, PH_ROW2 };
constexpr int N_PHASES = 2 + 11 * NL;

DI void run_phase(const Params& p, int ph, int l, char* smem) {
  const int bid = blockIdx.x;
#ifdef HALFMASK
  const int G = ((HALFMASK >> ph) & 1) ? 256 : gridDim.x;
  if (bid >= G) return;
#else
  const int G = gridDim.x;
#endif
#ifdef PHMASK
  if (!((PHMASK >> ph) & 1)) return;
#endif
  switch (ph) {
    case PH_PREP:
      if (bid < 8) { for (int i = TIDX; i < 512; i += 256) ((u32x4*)(p.ws + OFF_ZERO))[i] = u32x4{0u, 0u, 0u, 0u}; }
      for (int j = bid; j < 128 + 16064; j += G) {
        if (j < 96) prep_mod_job(p, j, smem);
        else if (j < 128) prep_s5_job(p, j - 96);
        else prep_wt_job(p, j - 128, smem);
      }
      break;
    case PH_ROW0:
      row_phase<0>(p, 0, bid, G);
      ktab_phase(p, bid, G);
      break;
    case PH_PROJ:
#ifdef EXP_A
      if (bid < 256) { int mt, nt; for (int it = 0; gemm_job(bid, 256, it, 264, 10, mt, nt, 4); ++it) proj_wide(p, l, mt, nt, smem); }
      s5mat_phase(p, l, bid, G);
#elif defined(EXP_C)
      if (bid < 256) for (int j = bid; j < 264 * 19; j += 256) { if ((EXP_C >> (j % 19)) & 1) proj_tile(p, l, j / 19, j % 19, smem); }
      for (int j = bid; j < 264 * 19; j += G) { if (!((EXP_C >> (j % 19)) & 1)) proj_tile(p, l, j / 19, j % 19, smem); }
      s5mat_phase(p, l, bid, G);
#elif defined(EXP_B)
      for (int j = bid; j < 264 * 19; j += G) proj_tile(p, l, j / 19, j % 19, smem);
      if (bid < 256) s5mat_phase(p, l, bid, 256);
#else
      for (int j = bid; j < 264 * 19; j += G) proj_tile(p, l, j / 19, j % 19, smem);
      s5mat_phase(p, l, bid, G);
#endif
      break;
    case PH_MIX1:
      for (int j = bid; j < 1056 + 1056 + 288; j += G) {
        if (j < 1056) attn_unit(p, j, smem);
        else if (j < 2112) gla_unit<false>(p, l, j - 1056, smem);
        else s5_end_tile(p, j - 2112, smem);
      }
      break;
    case PH_SCAN:
      for (int j = bid; j < 1024 + 128; j += G) {
        if (j < 1024) gla_scan_job(p, j);
        else s5_scan_job(p, l, j - 1024, smem);
      }
      break;
    case PH_MIX2:
      for (int j = bid; j < 528 + 576; j += G) {
        if (j < 528) gla_unit<true>(p, l, j, smem);
        else s5_out_tile(p, j - 528, smem);
      }
      break;
    case PH_GLU:
      { int mt, nt; for (int it = 0; gemm_job(bid, G, it, 264, 2, mt, nt); ++it) glu_tile(p, l, mt * 2 + nt, smem); }
      break;
    case PH_MERGE:
      { int mt, nt; for (int it = 0; gemm_job(bid, G, it, 264, 8, mt, nt); ++it) merge_tile(p, l, mt * 8 + nt, smem); }
      break;
    case PH_WOUT:
      for (int it = 0;; ++it) {
        int mt, nt;
        if (!gemm_job(bid, G, it, 264, 8, mt, nt)) break;
        plain_tile((const bf16*)(p.ws + OFF_MG) + (size_t)mt * 128 * DM, DM, wl(p, l, WL_WOUT) + (size_t)nt * 128 * DM,
                   (bf16*)(p.ws + OFF_H) + (size_t)mt * 128 * DM + nt * 128, DM, smem);
      }
      break;
    case PH_ROW1: row_phase<1>(p, l, bid, G); break;
    case PH_UP:
      { int mt, nt; for (int it = 0; gemm_job(bid, G, it, 276, 22, mt, nt, 4); ++it) up_wide(p, l, mt, nt, smem); }
      break;
    case PH_DOWN:
      for (int it = 0;; ++it) {
        int mt, nt;
        if (!gemm_job(bid, G, it, 264, 8, mt, nt)) break;
        plain_tile((const bf16*)(p.ws + OFF_G) + (size_t)mt * 128 * DFF, DFF, wl(p, l, WL_DOWN) + (size_t)nt * 128 * DFF,
                   (bf16*)(p.ws + OFF_H) + (size_t)mt * 128 * DM + nt * 128, DM, smem);
      }
      break;
    case PH_ROW2: row_phase<2>(p, l, bid, G); break;
  }
}

#define XB_TMO      128
#define XB_XCNT(j)  (256  + 64 * (j))
#define XB_XSUB(j)  (1280 + 64 * (j))
#define XB_XGEN(j)  (2304 + 64 * (j))
#define XB_TOP      3328
#define XB_TOPGEN   3392
#define XCD_BAR_WORDS 3456
#define XB_SPIN_CAP (1u << 18)
#define LAS __attribute__((address_space(3)))

__device__ __forceinline__ unsigned xb_ld(unsigned* p)              { return __hip_atomic_load(p, __ATOMIC_RELAXED, __HIP_MEMORY_SCOPE_AGENT); }
__device__ __forceinline__ unsigned xb_add(unsigned* p, unsigned v) { return __hip_atomic_fetch_add(p, v, __ATOMIC_RELAXED, __HIP_MEMORY_SCOPE_AGENT); }
__device__ __forceinline__ unsigned xb_xcc_id() { return (unsigned)__builtin_amdgcn_s_getreg((3 << 11) | 20) & 0xFu; }
#define XB_SPIN(cond, bar) do { unsigned _sp = 0; while (cond) { __builtin_amdgcn_s_sleep(1); \
    if ((++_sp & 255u) == 0u) { if (xb_ld(&(bar)[XB_TMO])) break; if (_sp > XB_SPIN_CAP) { atomicAdd(&(bar)[XB_TMO], 1u); break; } } } } while (0)

struct XcdBarrier {
    unsigned* bar; unsigned x;
    volatile LAS unsigned* st;
};

__device__ __forceinline__ XcdBarrier xcd_barrier_post(unsigned* bar, volatile LAS unsigned* st) {
    XcdBarrier b; b.bar = bar; b.x = xb_xcc_id(); b.st = st;
    if (threadIdx.x == 0) (void)xb_add(&bar[XB_XCNT(b.x)], 1u);
    return b;
}
__device__ __forceinline__ void xcd_barrier_complete(unsigned* bar, unsigned x, unsigned& nloc, unsigned& nx) {
    const unsigned G = gridDim.x * gridDim.y * gridDim.z;
    unsigned sum, cnt, mine, sp = 0u;
    for (;;) {
        sum = 0u; cnt = 0u; mine = 0u;
#pragma unroll
        for (unsigned j = 0; j < 16; ++j) { const unsigned c = xb_ld(&bar[XB_XCNT(j)]); sum += c; cnt += (c > 0u) ? 1u : 0u; mine = (j == x) ? c : mine; }
        if (sum == G) break;
        __builtin_amdgcn_s_sleep(1);
        if ((++sp & 255u) == 0u) { if (xb_ld(&bar[XB_TMO])) break; if (sp > XB_SPIN_CAP) { atomicAdd(&bar[XB_TMO], 1u); break; } }
    }
    nloc = mine > 0u ? mine : 1u; nx = cnt > 0u ? cnt : 1u;
}

__device__ __forceinline__ void xcd_barrier(const XcdBarrier& b) {
    asm volatile("s_waitcnt vmcnt(0)" ::: "memory");
    __syncthreads();
    if (threadIdx.x == 0) {
        unsigned* bar = b.bar;
        __builtin_amdgcn_s_waitcnt(0);
        unsigned nloc = b.st[0], nx = b.st[1];
        if (nloc == 0u) { xcd_barrier_complete(bar, b.x, nloc, nx); b.st[0] = nloc; b.st[1] = nx; }
        const unsigned old = xb_add(&bar[XB_XSUB(b.x)], 1u);
        const unsigned gen = old / nloc;
        if (old + 1u == (gen + 1u) * nloc) {
            __builtin_amdgcn_fence(__ATOMIC_RELEASE, "agent");
            asm volatile("s_waitcnt vmcnt(0)" ::: "memory");
            const unsigned og = xb_add(&bar[XB_TOP], 1u);
            const unsigned tg = og / nx;
            if (og + 1u == (tg + 1u) * nx) xb_add(&bar[XB_TOPGEN], 1u);
            else XB_SPIN(xb_ld(&bar[XB_TOPGEN]) == tg, bar);
            __builtin_amdgcn_fence(__ATOMIC_ACQUIRE, "agent");
            xb_add(&bar[XB_XGEN(b.x)], 1u);
            asm volatile("s_waitcnt vmcnt(0)" ::: "memory");
        } else {
            XB_SPIN(xb_ld(&bar[XB_XGEN(b.x)]) == gen, bar);
            __builtin_amdgcn_fence(__ATOMIC_ACQUIRE, "agent");
            asm volatile("s_waitcnt vmcnt(0)" ::: "memory");
        }
    }
    __syncthreads();
}


DI void grid_barrier(unsigned* bar, unsigned& gen) {
  asm volatile("s_waitcnt vmcnt(0)" ::: "memory");
  __syncthreads();
  gen += 1;
  if (threadIdx.x == 0) {
    __builtin_amdgcn_fence(__ATOMIC_RELEASE, "agent");
    asm volatile("s_waitcnt vmcnt(0)" ::: "memory");
    const unsigned target = gen * gridDim.x;
    __hip_atomic_fetch_add(bar, 1u, __ATOMIC_RELAXED, __HIP_MEMORY_SCOPE_AGENT);
    while (__hip_atomic_load(bar, __ATOMIC_RELAXED, __HIP_MEMORY_SCOPE_AGENT) < target) __builtin_amdgcn_s_sleep(2);
  }
  __syncthreads();
  __builtin_amdgcn_fence(__ATOMIC_ACQUIRE, "agent");
  asm volatile("s_waitcnt vmcnt(0)" ::: "memory");
}

__global__ void __launch_bounds__(256, 2) hybrid_fwd(Params p, int ph_lo, int ph_hi) {
  extern __shared__ __attribute__((aligned(16))) char smem[];
  unsigned* bar = (unsigned*)(p.ws + OFF_BAR);
  unsigned gen = 0;
  __shared__ uint4 xb_words;
  if (threadIdx.x == 0) xb_words = make_uint4(0u, 0u, 0u, 0u);
  __syncthreads();
  XcdBarrier xb = xcd_barrier_post(bar + 64, (volatile LAS unsigned*)&xb_words);
  if (ph_hi - ph_lo > 1) cg::this_grid().sync();
  int i = 0;
#define STEP(PH, L)                                      \
  {                                                      \
    if (i >= ph_lo && i < ph_hi) {                       \
      Params q;                                          \
      q.ws = p.ws; q.out = p.out;                        \
      asm volatile("" : "+s"(q.ws), "+s"(q.out));        \
      _Pragma("unroll") for (int k = 0; k < 34; ++k) { q.in[k] = p.in[k]; asm volatile("" : "+s"(q.in[k])); } \
      run_phase(q, PH, L, smem);                         \
      if ((DUPMASK >> (PH)) & 1) { xcd_barrier(xb); run_phase(q, PH, L, smem); } \
      if (i + 1 < ph_hi) xcd_barrier(xb);                \
    }                                                    \
    ++i;                                                 \
  }
  STEP(PH_PREP, 0)
  STEP(PH_ROW0, 0)
#pragma unroll 1
  for (int l = 0; l < NL; ++l) {
    STEP(PH_PROJ, l)
    STEP(PH_MIX1, l)
    STEP(PH_SCAN, l)
    STEP(PH_MIX2, l)
    STEP(PH_GLU, l)
    STEP(PH_MERGE, l)
    STEP(PH_WOUT, l)
    STEP(PH_ROW1, l)
    STEP(PH_UP, l)
    STEP(PH_DOWN, l)
    STEP(PH_ROW2, l)
  }
#undef STEP
}

extern "C" void kernel_launch(void* const* d_in, const int* in_sizes, int n_in, void* d_out, int out_size, void* d_ws, size_t ws_size,
                              hipStream_t stream) {
  static int grid_blocks = 0;
  if (!grid_blocks) {
    int dev = 0, cus = 0, per_cu = 0;
    hipGetDevice(&dev);
    hipDeviceGetAttribute(&cus, hipDeviceAttributeMultiprocessorCount, dev);
    hipFuncSetAttribute((const void*)hybrid_fwd, hipFuncAttributeMaxDynamicSharedMemorySize, SMEM_BYTES);
    hipOccupancyMaxActiveBlocksPerMultiprocessor(&per_cu, hybrid_fwd, 256, SMEM_BYTES);
    if (per_cu < 1) per_cu = 1;
    if (per_cu > 2) per_cu = 2;
    grid_blocks = cus * per_cu;
    if (ws_size < OFF_ZERO + 8192) fprintf(stderr, "workspace too small: %zu < %zu\n", ws_size, (size_t)OFF_END);
  }
  Params p{};
  for (int i = 0; i < 34; ++i) p.in[i] = (const float*)d_in[i];
  p.out = (float*)d_out;
  p.ws = (char*)d_ws;
#if ONE_LAUNCH
  hipMemsetAsync((char*)d_ws + OFF_BAR, 0, 16384, stream);
  int lo = 0, hi = N_PHASES;
  void* args[] = {&p, &lo, &hi};
  hipError_t e = hipLaunchCooperativeKernel((void*)hybrid_fwd, dim3(grid_blocks), dim3(256), args, SMEM_BYTES, stream);
  if (e != hipSuccess) fprintf(stderr, "cooperative launch failed: %s (grid %d)\n", hipGetErrorString(e), grid_blocks);
#else
  for (int i = 0; i < N_PHASES; ++i) hipLaunchKernelGGL(hybrid_fwd, dim3(grid_blocks), dim3(256), SMEM_BYTES, stream, p, i, i + 1);
#endif
}
```

```cpp
#include <hip/hip_runtime.h>
#include <hip/hip_cooperative_groups.h>
#include <stdint.h>
#include <cstdio>
namespace cg = cooperative_groups;

#define EXP_A 1
#ifndef DUPMASK
#define DUPMASK 0
#endif
#ifndef ONE_LAUNCH
#define ONE_LAUNCH 1
#endif

typedef unsigned short bf16;
typedef __attribute__((ext_vector_type(8))) short s16x8;
typedef __attribute__((ext_vector_type(4))) short s16x4;
typedef __attribute__((ext_vector_type(16))) float f32x16;
typedef __attribute__((ext_vector_type(4))) float f32x4;
typedef __attribute__((ext_vector_type(2))) float f32x2;
typedef __attribute__((ext_vector_type(4))) unsigned u32x4;
typedef __attribute__((ext_vector_type(2))) unsigned u32x2;
typedef __attribute__((ext_vector_type(2))) __bf16 bf16x2_t;

#define DI __device__ __forceinline__
#define MFMA32(a, b, c) __builtin_amdgcn_mfma_f32_32x32x16_bf16((a), (b), (c), 0, 0, 0)

DI int tidx_opaque() { int t = threadIdx.x; asm volatile("" : "+v"(t)); return t; }
#define TIDX tidx_opaque()
DI bf16 f2bf(float x) { return __builtin_bit_cast(unsigned short, (__bf16)x); }
DI float bf2f(bf16 v) { return __uint_as_float(((unsigned)v) << 16); }
DI unsigned pack2(float a, float b) {
  f32x2 v = {a, b};
  return __builtin_bit_cast(unsigned, __builtin_convertvector(v, bf16x2_t));
}
DI float bflo(unsigned u) { return __uint_as_float(u << 16); }
DI float bfhi(unsigned u) { return __uint_as_float(u & 0xffff0000u); }
typedef const __attribute__((address_space(1))) u32x4* gptr16;
DI u32x4 ldg16(const void* q) { return *(gptr16)(uintptr_t)q; }
#define SCHED_FENCE() __builtin_amdgcn_sched_barrier(0)
DI int crow(int i, int h) { return (i & 3) + 8 * (i >> 2) + 4 * h; }
DI void sincos_cw(float x, float& sn, float& cs) {
  const float k = rintf(x * 0.63661977236758134f);
  float r = fmaf(-k, 1.57079637050628662109375f, x);
  r = fmaf(-k, -4.371139000186241e-08f, r);
  const int q = ((int)k) & 3;
  const float r2 = r * r;
  const float sp = r + r * r2 * (-1.6666667163e-01f + r2 * (8.3333337680e-03f + r2 * (-1.9841270114e-04f + r2 * 2.7557314297e-06f)));
  const float cp = 1.f + r2 * (-0.5f + r2 * (4.1666667908e-02f + r2 * (-1.3888889225e-03f + r2 * (2.4801587642e-05f - r2 * 2.7557314297e-07f))));
  sn = (q == 0) ? sp : (q == 1) ? cp : (q == 2) ? -sp : -cp;
  cs = (q == 0) ? cp : (q == 1) ? -sp : (q == 2) ? -cp : sp;
}
DI float sigmoidf_(float x) { return 1.f / (1.f + __expf(-x)); }
DI float siluf_(float x) { return x / (1.f + __expf(-x)); }

constexpr int DM = 1024, NB = 4, SEQ = 8192, CTXL = 256, TT = SEQ + CTXL, NTOK = NB * TT, NL = 4;
constexpr int DFF = 2816, DIN = 5408;
constexpr float EPSF = 1e-6f;
constexpr int NG33 = 33;
constexpr int NCH = 264;
constexpr int MS5 = NB * NCH;

constexpr size_t SZ_H = (size_t)NTOK * 1024 * 2;
constexpr size_t OFF_H = 0;
constexpr size_t OFF_P = OFF_H + SZ_H;
constexpr size_t OFF_Q = OFF_P;
constexpr size_t OFF_K = OFF_Q + (size_t)NTOK * 256 * 2;
constexpr size_t OFF_VT = OFF_K + (size_t)NTOK * 128 * 2;
constexpr size_t OFF_GQ = OFF_VT + (size_t)NTOK * 128 * 2;
constexpr size_t OFF_GK = OFF_GQ + (size_t)NTOK * 256 * 2;
constexpr size_t OFF_GVT = OFF_GK + (size_t)NTOK * 256 * 2;
constexpr size_t OFF_GR = OFF_GVT + (size_t)NTOK * 512 * 2;
constexpr size_t OFF_SU = OFF_GR + (size_t)NTOK * 512 * 2;
constexpr size_t OFF_LOW = OFF_SU + (size_t)NTOK * 256 * 2;
constexpr size_t OFF_O = OFF_LOW + (size_t)NTOK * 32 * 4;
constexpr size_t OFF_OATT = OFF_O;
constexpr size_t OFF_OGLA = OFF_OATT + (size_t)NTOK * 256 * 2;
constexpr size_t OFF_Y5 = OFF_OGLA + (size_t)NTOK * 512 * 2;
constexpr size_t OFF_EN = OFF_Y5;
constexpr size_t OFF_OS5 = OFF_Y5 + (size_t)NTOK * 256 * 2;
constexpr size_t OFF_M = OFF_OS5 + (size_t)NTOK * 256 * 2;
constexpr size_t OFF_MG = OFF_M;
constexpr size_t OFF_GS = OFF_M;
constexpr size_t OFF_DECG = OFF_GS + (size_t)32 * 33 * 8192 * 4;
constexpr size_t OFF_SB = OFF_DECG + (size_t)32 * 33 * 64 * 4;
constexpr size_t OFF_T5 = OFF_SB + (size_t)MS5 * 16 * 256 * 2;
constexpr size_t OFF_E5 = OFF_T5 + (size_t)16 * 512 * 512 * 2;
constexpr size_t OFF_F5 = OFF_E5 + (size_t)16 * 512 * 256 * 2;
constexpr size_t OFF_MEND = OFF_F5 + (size_t)16 * 256 * 512 * 2;
static_assert(OFF_MEND <= OFF_M + SZ_H, "mixer scratch overflows merged area");
constexpr size_t OFF_W = OFF_M + SZ_H;
constexpr size_t WL_WIN = 0, WL_BRA = WL_WIN + (size_t)5504 * 1024, WL_BRG = WL_BRA + 1024 * 256, WL_BRS = WL_BRG + 1024 * 512,
                 WL_WOUT = WL_BRS + 1024 * 256, WL_UP = WL_WOUT + 1024 * 1024, WL_DOWN = WL_UP + (size_t)5632 * 1024,
                 WL_GLU = WL_DOWN + (size_t)1024 * 2816, WL_TOTAL = WL_GLU + 256 * 256;
constexpr size_t OFF_XC = OFF_W + WL_TOTAL * 2 * NL;
constexpr size_t OFF_MOD = OFF_XC + (size_t)NB * CTXL * 1024 * 4;
constexpr size_t OFF_BBR = OFF_MOD + (size_t)NL * 5 * 6144 * 4;
constexpr size_t OFF_BBI = OFF_BBR + (size_t)NL * 2 * 16 * 64 * 16 * 4;
constexpr size_t OFF_PWR = OFF_BBI + (size_t)NL * 2 * 16 * 64 * 16 * 4;
constexpr size_t OFF_KTAB = OFF_PWR + (size_t)NL * 2 * 16 * 33 * 64 * 8;
constexpr size_t OFF_END = OFF_KTAB + (size_t)NL * 16 * 2 * 32 * 256 * 4;
constexpr size_t OFF_BAR = OFF_END;
constexpr size_t OFF_ZERO = OFF_BAR + 16384;
constexpr size_t OFF_G = OFF_P;
static_assert((size_t)NTOK * DFF * 2 <= OFF_M - OFF_P, "G overflows");

constexpr int SMEM_BYTES = 73728;

struct Params {
  const float* in[34];
  float* out;
  char* ws;
};

enum { I_X = 0, I_C, I_CTX, I_CCTX, I_ADAW, I_ADAB, I_NMPRE, I_NMPOST, I_NFPRE, I_NFPOST, I_WIN, I_QN, I_KN, I_GGW, I_GGB, I_GON,
       I_ARE, I_AIM, I_LDT, I_BRE, I_BIM, I_CRE, I_CIM, I_S5D, I_GLUW, I_GLUB, I_WBA, I_WBG, I_WBS, I_WOUT, I_UP, I_CW, I_CB, I_DOWN };

constexpr int LDT = 72;
constexpr int CLD = 132;

template <class FA, class FB>
DI void gemm_main(f32x16 (&acc)[2][2], FA fa, FB fb, int K, char* smem) {
  bf16* As = (bf16*)smem;
  bf16* Bs = (bf16*)(smem + 2 * 128 * LDT * 2);
  const int tid = TIDX, lane = tid & 63, w = tid >> 6, wm = w >> 1, wn = w & 1;
  const int r = lane & 31, h = lane >> 5;
  const int lr = tid >> 3, kc = (tid & 7) * 8;
  const bf16* ap[4];
  const bf16* bp[4];
#pragma unroll
  for (int i = 0; i < 4; ++i) {
    const bf16* a = fa(lr + 32 * i);
    const bf16* b = fb(lr + 32 * i);
    ap[i] = a ? a + kc : nullptr;
    bp[i] = b ? b + kc : nullptr;
  }
  u32x4 ra[4], rb[4];
  const u32x4 z4 = {0u, 0u, 0u, 0u};
#pragma unroll
  for (int i = 0; i < 4; ++i) {
    ra[i] = ap[i] ? ldg16(ap[i]) : z4;
    rb[i] = bp[i] ? ldg16(bp[i]) : z4;
  }
#pragma unroll
  for (int i = 0; i < 4; ++i) {
    *(u32x4*)(As + (lr + 32 * i) * LDT + kc) = ra[i];
    *(u32x4*)(Bs + (lr + 32 * i) * LDT + kc) = rb[i];
  }
  __syncthreads();
  const int nk = K / 64;
  for (int kt = 0; kt < nk; ++kt) {
    const int buf = kt & 1;
    const bool more = (kt + 1 < nk);
    if (more) {
      const int k0 = (kt + 1) * 64;
#pragma unroll
      for (int i = 0; i < 4; ++i) {
        ra[i] = ap[i] ? ldg16(ap[i] + k0) : z4;
        rb[i] = bp[i] ? ldg16(bp[i] + k0) : z4;
      }
    }
    SCHED_FENCE();
    const bf16* Ab = As + buf * 128 * LDT + (wm * 64 + r) * LDT + h * 8;
    const bf16* Bb = Bs + buf * 128 * LDT + (wn * 64 + r) * LDT + h * 8;
#pragma unroll
    for (int s = 0; s < 4; ++s) {
      s16x8 a0 = *(const s16x8*)(Ab + s * 16);
      s16x8 a1 = *(const s16x8*)(Ab + 32 * LDT + s * 16);
      s16x8 b0 = *(const s16x8*)(Bb + s * 16);
      s16x8 b1 = *(const s16x8*)(Bb + 32 * LDT + s * 16);
      acc[0][0] = MFMA32(a0, b0, acc[0][0]);
      acc[0][1] = MFMA32(a0, b1, acc[0][1]);
      acc[1][0] = MFMA32(a1, b0, acc[1][0]);
      acc[1][1] = MFMA32(a1, b1, acc[1][1]);
    }
    SCHED_FENCE();
    if (more) {
      bf16* Aw = As + (buf ^ 1) * 128 * LDT;
      bf16* Bw = Bs + (buf ^ 1) * 128 * LDT;
#pragma unroll
      for (int i = 0; i < 4; ++i) {
        *(u32x4*)(Aw + (lr + 32 * i) * LDT + kc) = ra[i];
        *(u32x4*)(Bw + (lr + 32 * i) * LDT + kc) = rb[i];
      }
    }
    __syncthreads();
  }
}

template <class FA, class FB>
DI void gemm_main_deep(f32x16 (&acc)[2][2], FA fa, FB fb, int K, char* smem) {
  bf16* As = (bf16*)smem;
  bf16* Bs = (bf16*)(smem + 2 * 128 * LDT * 2);
  const int tid = TIDX, lane = tid & 63, w = tid >> 6, wm = w >> 1, wn = w & 1;
  const int r = lane & 31, h = lane >> 5;
  const int lr = tid >> 3, kc = (tid & 7) * 8;
  const bf16* ap[4];
  const bf16* bp[4];
#pragma unroll
  for (int i = 0; i < 4; ++i) {
    const bf16* a = fa(lr + 32 * i);
    const bf16* b = fb(lr + 32 * i);
    ap[i] = a ? a + kc : nullptr;
    bp[i] = b ? b + kc : nullptr;
  }
  const u32x4 z4 = {0u, 0u, 0u, 0u};
  u32x4 a0[4], b0[4], a1[4], b1[4];
  const int nk = K / 64;
#define GD_LOAD(RA, RB, T)                                               \
  {                                                                      \
    const int k0_ = (T) * 64;                                            \
    _Pragma("unroll") for (int i = 0; i < 4; ++i) {                      \
      RA[i] = ap[i] ? ldg16(ap[i] + k0_) : z4;                           \
      RB[i] = bp[i] ? ldg16(bp[i] + k0_) : z4;                           \
    }                                                                    \
  }
#define GD_STORE(RA, RB, BUF)                                            \
  {                                                                      \
    _Pragma("unroll") for (int i = 0; i < 4; ++i) {                      \
      *(u32x4*)(As + (BUF) * 128 * LDT + (lr + 32 * i) * LDT + kc) = RA[i]; \
      *(u32x4*)(Bs + (BUF) * 128 * LDT + (lr + 32 * i) * LDT + kc) = RB[i]; \
    }                                                                    \
  }
#define GD_COMPUTE(BUF)                                                  \
  {                                                                      \
    const bf16* Ab = As + (BUF) * 128 * LDT + (wm * 64 + r) * LDT + h * 8; \
    const bf16* Bb = Bs + (BUF) * 128 * LDT + (wn * 64 + r) * LDT + h * 8; \
    _Pragma("unroll") for (int s = 0; s < 4; ++s) {                      \
      s16x8 fa0 = *(const s16x8*)(Ab + s * 16);                          \
      s16x8 fa1 = *(const s16x8*)(Ab + 32 * LDT + s * 16);               \
      s16x8 fb0 = *(const s16x8*)(Bb + s * 16);                          \
      s16x8 fb1 = *(const s16x8*)(Bb + 32 * LDT + s * 16);               \
      acc[0][0] = MFMA32(fa0, fb0, acc[0][0]);                           \
      acc[0][1] = MFMA32(fa0, fb1, acc[0][1]);                           \
      acc[1][0] = MFMA32(fa1, fb0, acc[1][0]);                           \
      acc[1][1] = MFMA32(fa1, fb1, acc[1][1]);                           \
    }                                                                    \
  }
  GD_LOAD(a0, b0, 0)
  GD_LOAD(a1, b1, 1)
  GD_STORE(a0, b0, 0)
  __syncthreads();
  if (nk > 2) GD_LOAD(a0, b0, 2)
  for (int kt = 0; kt < nk; kt += 2) {
    SCHED_FENCE();
    GD_COMPUTE(0)
    SCHED_FENCE();
    GD_STORE(a1, b1, 1)
    if (kt + 3 < nk) GD_LOAD(a1, b1, kt + 3)
    __syncthreads();
    SCHED_FENCE();
    GD_COMPUTE(1)
    SCHED_FENCE();
    if (kt + 2 < nk) {
      GD_STORE(a0, b0, 0)
      if (kt + 4 < nk) GD_LOAD(a0, b0, kt + 4)
    }
    __syncthreads();
  }
#undef GD_LOAD
#undef GD_STORE
#undef GD_COMPUTE
}

template <class FA, class FB>
DI void gemm_main_dma(f32x16 (&acc)[2][2], FA fa, FB fb, int K, char* smem) {
  char* As = smem;
  char* Bs = smem + 32768;
  const int tid = TIDX, lane = tid & 63, w = tid >> 6, wm = w >> 1, wn = w & 1;
  const int r = lane & 31, h = lane >> 5;
  const bf16* ap[4];
  const bf16* bp[4];
#pragma unroll
  for (int i = 0; i < 4; ++i) {
    const int row = w * 32 + i * 8 + (lane >> 3);
    const int c = (lane & 7) ^ ((row >> 1) & 7);
    ap[i] = fa(row) + c * 8;
    bp[i] = fb(row) + c * 8;
  }
  const int ldst = (w * 256 + lane) * 16;
#define GM_DMA(BUF, T)                                                                                        \
  {                                                                                                           \
    const int k0_ = (T) * 64;                                                                                 \
    _Pragma("unroll") for (int i = 0; i < 4; ++i) {                                                           \
      __builtin_amdgcn_global_load_lds((const unsigned*)(ap[i] + k0_), (unsigned*)(As + (BUF) * 16384 + ldst + i * 1024), 16, 0, 0); \
      __builtin_amdgcn_global_load_lds((const unsigned*)(bp[i] + k0_), (unsigned*)(Bs + (BUF) * 16384 + ldst + i * 1024), 16, 0, 0); \
    }                                                                                                         \
  }
  const int xr = (r >> 1) & 7;
  const int arow = (wm * 64 + r) * 128, brow = (wn * 64 + r) * 128;
  GM_DMA(0, 0)
  asm volatile("s_waitcnt vmcnt(0)" ::: "memory");
  __syncthreads();
  const int nk = K / 64;
  for (int kt = 0; kt < nk; ++kt) {
    const int buf = kt & 1;
    if (kt + 1 < nk) GM_DMA(buf ^ 1, kt + 1)
    const char* Ab = As + buf * 16384 + arow;
    const char* Bb = Bs + buf * 16384 + brow;
#pragma unroll
    for (int s = 0; s < 4; ++s) {
      const int co = ((2 * s + h) ^ xr) * 16;
      s16x8 a0 = *(const s16x8*)(Ab + co);
      s16x8 a1 = *(const s16x8*)(Ab + 32 * 128 + co);
      s16x8 b0 = *(const s16x8*)(Bb + co);
      s16x8 b1 = *(const s16x8*)(Bb + 32 * 128 + co);
      acc[0][0] = MFMA32(a0, b0, acc[0][0]);
      acc[0][1] = MFMA32(a0, b1, acc[0][1]);
      acc[1][0] = MFMA32(a1, b0, acc[1][0]);
      acc[1][1] = MFMA32(a1, b1, acc[1][1]);
    }
    asm volatile("s_waitcnt vmcnt(0)" ::: "memory");
    __syncthreads();
  }
#undef GM_DMA
}

DI void gemm_main_dma_half(f32x16 (&acc)[2], const bf16* A, int lda, const bf16* B, int ldb, int K, int hf, char* smem) {
  char* As = smem;
  char* Bs = smem + 32768;
  const int tid = TIDX, lane = tid & 63, w = tid >> 6, wm = w >> 1, wn = w & 1;
  const int r = lane & 31, h = lane >> 5;
  const bf16* ap[4];
  const bf16* bp[2];
#pragma unroll
  for (int i = 0; i < 4; ++i) {
    const int row = w * 32 + i * 8 + (lane >> 3);
    ap[i] = A + (size_t)row * lda + ((lane & 7) ^ ((row >> 1) & 7)) * 8;
  }
#pragma unroll
  for (int i = 0; i < 2; ++i) {
    const int lrow = w * 16 + i * 8 + (lane >> 3);
    const int grow = (lrow >> 5) * 64 + hf * 32 + (lrow & 31);
    bp[i] = B + (size_t)grow * ldb + ((lane & 7) ^ ((lrow >> 1) & 7)) * 8;
  }
  const int lda_ = (w * 256 + lane) * 16, ldb_ = (w * 128 + lane) * 16;
#define GH_DMA(BUF, T)                                                                                        \
  {                                                                                                           \
    const int k0_ = (T) * 64;                                                                                 \
    _Pragma("unroll") for (int i = 0; i < 4; ++i)                                                             \
      __builtin_amdgcn_global_load_lds((const unsigned*)(ap[i] + k0_), (unsigned*)(As + (BUF) * 16384 + lda_ + i * 1024), 16, 0, 0); \
    _Pragma("unroll") for (int i = 0; i < 2; ++i)                                                             \
      __builtin_amdgcn_global_load_lds((const unsigned*)(bp[i] + k0_), (unsigned*)(Bs + (BUF) * 8192 + ldb_ + i * 1024), 16, 0, 0); \
  }
  const int xr = (r >> 1) & 7;
  const int arow = (wm * 64 + r) * 128, brow = (wn * 32 + r) * 128;
  GH_DMA(0, 0)
  asm volatile("s_waitcnt vmcnt(0)" ::: "memory");
  __syncthreads();
  const int nk = K / 64;
  for (int kt = 0; kt < nk; ++kt) {
    const int buf = kt & 1;
    if (kt + 1 < nk) GH_DMA(buf ^ 1, kt + 1)
    const char* Ab = As + buf * 16384 + arow;
    const char* Bb = Bs + buf * 8192 + brow;
#pragma unroll
    for (int s = 0; s < 4; ++s) {
      const int co = ((2 * s + h) ^ xr) * 16;
      s16x8 a0 = *(const s16x8*)(Ab + co);
      s16x8 a1 = *(const s16x8*)(Ab + 32 * 128 + co);
      s16x8 b0 = *(const s16x8*)(Bb + co);
      acc[0] = MFMA32(a0, b0, acc[0]);
      acc[1] = MFMA32(a1, b0, acc[1]);
    }
    asm volatile("s_waitcnt vmcnt(0)" ::: "memory");
    __syncthreads();
  }
#undef GH_DMA
}

template <class FA, class FB>
DI void gemm_wide(f32x16 (&acc)[2][4], FA fa, FB fb, int K, char* smem) {
  const int tid = TIDX, lane = tid & 63, w = tid >> 6, wm = w >> 1, wn = w & 1;
  const int r = lane & 31, h = lane >> 5;
  const bf16* ap[2];
  const bf16* bp[4];
#pragma unroll
  for (int i = 0; i < 2; ++i) {
    const int row = w * 32 + i * 16 + (lane >> 2);
    ap[i] = fa(row) + ((lane & 3) ^ ((row >> 2) & 3)) * 8;
  }
#pragma unroll
  for (int i = 0; i < 4; ++i) {
    const int row = w * 64 + i * 16 + (lane >> 2);
    bp[i] = fb(row) + ((lane & 3) ^ ((row >> 2) & 3)) * 8;
  }
  const int lda_ = (w * 128 + lane) * 16;
  const int ldb_ = 8192 + (w * 256 + lane) * 16;
#define GW_DMA(T)                                                                                                   \
  {                                                                                                                 \
    char* st_ = smem + ((T) % 3) * 24576;                                                                           \
    const int k0_ = (T) * 32;                                                                                       \
    _Pragma("unroll") for (int i = 0; i < 2; ++i)                                                                   \
      __builtin_amdgcn_global_load_lds((const unsigned*)(ap[i] + k0_), (unsigned*)(st_ + lda_ + i * 1024), 16, 0, 0); \
    _Pragma("unroll") for (int i = 0; i < 4; ++i)                                                                   \
      __builtin_amdgcn_global_load_lds((const unsigned*)(bp[i] + k0_), (unsigned*)(st_ + ldb_ + i * 1024), 16, 0, 0); \
  }
  const int xr = (r >> 2) & 3;
  const int arow = (wm * 64 + r) * 64;
  const int brow = 8192 + (wn * 64 + r) * 64;
  const int nt = K / 32;
  GW_DMA(0)
  if (nt > 1) GW_DMA(1)
  for (int t = 0; t < nt; ++t) {
    if (t + 1 < nt) asm volatile("s_waitcnt vmcnt(6)" ::: "memory");
    else asm volatile("s_waitcnt vmcnt(0)" ::: "memory");
    __syncthreads();
    if (t + 2 < nt) GW_DMA(t + 2)
    const char* st = smem + (t % 3) * 24576;
#pragma unroll
    for (int s = 0; s < 2; ++s) {
      const int co = ((2 * s + h) ^ xr) * 16;
      const s16x8 a0 = *(const s16x8*)(st + arow + co);
      const s16x8 a1 = *(const s16x8*)(st + arow + 32 * 64 + co);
#pragma unroll
      for (int hn = 0; hn < 2; ++hn) {
        const s16x8 b0 = *(const s16x8*)(st + brow + hn * 128 * 64 + co);
        const s16x8 b1 = *(const s16x8*)(st + brow + hn * 128 * 64 + 32 * 64 + co);
        acc[0][hn * 2 + 0] = MFMA32(a0, b0, acc[0][hn * 2 + 0]);
        acc[0][hn * 2 + 1] = MFMA32(a0, b1, acc[0][hn * 2 + 1]);
        acc[1][hn * 2 + 0] = MFMA32(a1, b0, acc[1][hn * 2 + 0]);
        acc[1][hn * 2 + 1] = MFMA32(a1, b1, acc[1][hn * 2 + 1]);
      }
    }
  }
  __syncthreads();
#undef GW_DMA
}

DI void accw_zero(f32x16 (&acc)[2][4]) {
#pragma unroll
  for (int a = 0; a < 2; ++a)
#pragma unroll
    for (int b = 0; b < 4; ++b)
#pragma unroll
      for (int i = 0; i < 16; ++i) acc[a][b][i] = 0.f;
}

DI void gemm_main_s(f32x16 (&acc)[2][2], const bf16* A, int lda, const bf16* B, int ldb, int K, char* smem) {
  bf16* As = (bf16*)smem;
  bf16* Bs = (bf16*)(smem + 2 * 128 * LDT * 2);
  const int tid = TIDX, lane = tid & 63, w = tid >> 6, wm = w >> 1, wn = w & 1;
  const int r = lane & 31, h = lane >> 5;
  const int lr = tid >> 3, kc = (tid & 7) * 8;
  const bf16* ap = A + (size_t)lr * lda + kc;
  const bf16* bp = B + (size_t)lr * ldb + kc;
  const size_t sa = (size_t)32 * lda, sb = (size_t)32 * ldb;
  u32x4 ra[4], rb[4];
#pragma unroll
  for (int i = 0; i < 4; ++i) {
    ra[i] = ldg16(ap + i * sa);
    rb[i] = ldg16(bp + i * sb);
  }
#pragma unroll
  for (int i = 0; i < 4; ++i) {
    *(u32x4*)(As + (lr + 32 * i) * LDT + kc) = ra[i];
    *(u32x4*)(Bs + (lr + 32 * i) * LDT + kc) = rb[i];
  }
  __syncthreads();
  const int nk = K / 64;
  for (int kt = 0; kt < nk; ++kt) {
    const int buf = kt & 1;
    const bool more = (kt + 1 < nk);
    if (more) {
      ap += 64; bp += 64;
#pragma unroll
      for (int i = 0; i < 4; ++i) {
        ra[i] = ldg16(ap + i * sa);
        rb[i] = ldg16(bp + i * sb);
      }
    }
    SCHED_FENCE();
    const bf16* Ab = As + buf * 128 * LDT + (wm * 64 + r) * LDT + h * 8;
    const bf16* Bb = Bs + buf * 128 * LDT + (wn * 64 + r) * LDT + h * 8;
#pragma unroll
    for (int s = 0; s < 4; ++s) {
      s16x8 a0 = *(const s16x8*)(Ab + s * 16);
      s16x8 a1 = *(const s16x8*)(Ab + 32 * LDT + s * 16);
      s16x8 b0 = *(const s16x8*)(Bb + s * 16);
      s16x8 b1 = *(const s16x8*)(Bb + 32 * LDT + s * 16);
      acc[0][0] = MFMA32(a0, b0, acc[0][0]);
      acc[0][1] = MFMA32(a0, b1, acc[0][1]);
      acc[1][0] = MFMA32(a1, b0, acc[1][0]);
      acc[1][1] = MFMA32(a1, b1, acc[1][1]);
    }
    SCHED_FENCE();
    if (more) {
      bf16* Aw = As + (buf ^ 1) * 128 * LDT;
      bf16* Bw = Bs + (buf ^ 1) * 128 * LDT;
#pragma unroll
      for (int i = 0; i < 4; ++i) {
        *(u32x4*)(Aw + (lr + 32 * i) * LDT + kc) = ra[i];
        *(u32x4*)(Bw + (lr + 32 * i) * LDT + kc) = rb[i];
      }
    }
    __syncthreads();
  }
}

DI void gemm_main_half(f32x16 (&acc)[2], const bf16* A, int lda, const bf16* B, int ldb, int K, int hf, char* smem) {
  bf16* As = (bf16*)smem;
  bf16* Bs = (bf16*)(smem + 2 * 128 * LDT * 2);
  const int tid = TIDX, lane = tid & 63, w = tid >> 6, wm = w >> 1, wn = w & 1;
  const int r = lane & 31, h = lane >> 5;
  const int lr = tid >> 3, kc = (tid & 7) * 8;
  const bf16* ap = A + (size_t)lr * lda + kc;
  const bf16* bp = B + (size_t)(hf * 32 + lr) * ldb + kc;
  const size_t sa = (size_t)32 * lda, sb = (size_t)64 * ldb;
  u32x4 ra[4], rb[2];
#pragma unroll
  for (int i = 0; i < 4; ++i) ra[i] = ldg16(ap + i * sa);
#pragma unroll
  for (int i = 0; i < 2; ++i) rb[i] = ldg16(bp + i * sb);
#pragma unroll
  for (int i = 0; i < 4; ++i) *(u32x4*)(As + (lr + 32 * i) * LDT + kc) = ra[i];
#pragma unroll
  for (int i = 0; i < 2; ++i) *(u32x4*)(Bs + (lr + 32 * i) * LDT + kc) = rb[i];
  __syncthreads();
  const int nk = K / 64;
  for (int kt = 0; kt < nk; ++kt) {
    const int buf = kt & 1;
    const bool more = (kt + 1 < nk);
    if (more) {
      ap += 64; bp += 64;
#pragma unroll
      for (int i = 0; i < 4; ++i) ra[i] = ldg16(ap + i * sa);
#pragma unroll
      for (int i = 0; i < 2; ++i) rb[i] = ldg16(bp + i * sb);
    }
    SCHED_FENCE();
    const bf16* Ab = As + buf * 128 * LDT + (wm * 64 + r) * LDT + h * 8;
    const bf16* Bb = Bs + buf * 128 * LDT + (wn * 32 + r) * LDT + h * 8;
#pragma unroll
    for (int s = 0; s < 4; ++s) {
      s16x8 a0 = *(const s16x8*)(Ab + s * 16);
      s16x8 a1 = *(const s16x8*)(Ab + 32 * LDT + s * 16);
      s16x8 b0 = *(const s16x8*)(Bb + s * 16);
      acc[0] = MFMA32(a0, b0, acc[0]);
      acc[1] = MFMA32(a1, b0, acc[1]);
    }
    SCHED_FENCE();
    if (more) {
      bf16* Aw = As + (buf ^ 1) * 128 * LDT;
      bf16* Bw = Bs + (buf ^ 1) * 128 * LDT;
#pragma unroll
      for (int i = 0; i < 4; ++i) *(u32x4*)(Aw + (lr + 32 * i) * LDT + kc) = ra[i];
#pragma unroll
      for (int i = 0; i < 2; ++i) *(u32x4*)(Bw + (lr + 32 * i) * LDT + kc) = rb[i];
    }
    __syncthreads();
  }
}

DI void acc_zero(f32x16 (&acc)[2][2]) {
#pragma unroll
  for (int a = 0; a < 2; ++a)
#pragma unroll
    for (int b = 0; b < 2; ++b)
#pragma unroll
      for (int i = 0; i < 16; ++i) acc[a][b][i] = 0.f;
}

DI void acc_to_lds(const f32x16 (&acc)[2][2], float* Cs) {
  const int lane = TIDX & 63, w = TIDX >> 6, wm = w >> 1, wn = w & 1, r = lane & 31, h = lane >> 5;
#pragma unroll
  for (int tm = 0; tm < 2; ++tm)
#pragma unroll
    for (int tn = 0; tn < 2; ++tn)
#pragma unroll
      for (int i = 0; i < 16; ++i) Cs[(wm * 64 + tm * 32 + crow(i, h)) * CLD + wn * 64 + tn * 32 + r] = acc[tm][tn][i];
}

template <int HN>
DI void accw_to_lds(const f32x16 (&acc)[2][4], float* Cs) {
  const int lane = TIDX & 63, w = TIDX >> 6, wm = w >> 1, wn = w & 1, r = lane & 31, h = lane >> 5;
#pragma unroll
  for (int tm = 0; tm < 2; ++tm)
#pragma unroll
    for (int tn = 0; tn < 2; ++tn)
#pragma unroll
      for (int i = 0; i < 16; ++i) Cs[(wm * 64 + tm * 32 + crow(i, h)) * CLD + wn * 64 + tn * 32 + r] = acc[tm][HN * 2 + tn][i];
}

DI void store_tile_bf16(const float* Cs, bf16* dst, size_t ld, int mvalid, float scale) {
  for (int c = TIDX; c < 2048; c += 256) {
    const int row = c >> 4, cc = (c & 15) * 8;
    if (row < mvalid) {
      const float* s = Cs + row * CLD + cc;
      u32x4 v;
      v[0] = pack2(s[0] * scale, s[1] * scale);
      v[1] = pack2(s[2] * scale, s[3] * scale);
      v[2] = pack2(s[4] * scale, s[5] * scale);
      v[3] = pack2(s[6] * scale, s[7] * scale);
      *(u32x4*)(dst + (size_t)row * ld + cc) = v;
    }
  }
}

DI float* resid_row(const Params& p, int tok) {
  const int b = tok / TT, t = tok - b * TT;
  return (t < CTXL) ? (float*)(p.ws + OFF_XC) + ((size_t)b * CTXL + t) * DM : p.out + ((size_t)b * SEQ + (t - CTXL)) * DM;
}
DI const float* mod_vec(const Params& p, int l, int tok, int which) {
  const int b = tok / TT, t = tok - b * TT;
  const int m = (t < CTXL) ? 4 : b;
  return (const float*)(p.ws + OFF_MOD) + ((size_t)(l * 5 + m) * 6 + which) * DM;
}
DI float wave_sum(float v) {
#pragma unroll
  for (int o = 32; o >= 1; o >>= 1) v += __shfl_xor(v, o, 64);
  return v;
}
DI bf16* wl(const Params& p, int l, size_t off) { return (bf16*)(p.ws + OFF_W) + (size_t)l * WL_TOTAL + off; }

DI void prep_mod_job(const Params& p, int j, char* smem) {
  float* sc = (float*)smem;
  float* part = (float*)(smem + 20480);
  const int l = j / 24, nb = j % 24, tid = TIDX, lane = tid & 63, w = tid >> 6;
  for (int idx = tid; idx < 5120; idx += 256) {
    const int m = idx >> 10, k = idx & 1023;
    const float v = (m < 4) ? p.in[I_C][m * 1024 + k] : p.in[I_CCTX][k];
    sc[idx] = siluf_(v);
  }
  __syncthreads();
  const float* W = p.in[I_ADAW] + (size_t)l * 1024 * 6144 + nb * 256 + lane;
  float a[5][4];
#pragma unroll
  for (int m = 0; m < 5; ++m)
#pragma unroll
    for (int c = 0; c < 4; ++c) a[m][c] = 0.f;
#pragma unroll 4
  for (int kk = 0; kk < 256; ++kk) {
    const int k = w * 256 + kk;
    float wv[4];
#pragma unroll
    for (int c = 0; c < 4; ++c) wv[c] = W[(size_t)k * 6144 + 64 * c];
#pragma unroll
    for (int m = 0; m < 5; ++m) {
      const float sv = sc[m * 1024 + k];
#pragma unroll
      for (int c = 0; c < 4; ++c) a[m][c] += sv * wv[c];
    }
  }
#pragma unroll
  for (int m = 0; m < 5; ++m)
#pragma unroll
    for (int c = 0; c < 4; ++c) part[(w * 5 + m) * 256 + lane + 64 * c] = a[m][c];
  __syncthreads();
  const int n = nb * 256 + tid;
  const float bb = p.in[I_ADAB][l * 6144 + n];
  float* M = (float*)(p.ws + OFF_MOD) + (size_t)l * 5 * 6144 + n;
#pragma unroll
  for (int m = 0; m < 5; ++m)
    M[m * 6144] = part[(0 * 5 + m) * 256 + tid] + part[(1 * 5 + m) * 256 + tid] + part[(2 * 5 + m) * 256 + tid] + part[(3 * 5 + m) * 256 + tid] + bb;
  __syncthreads();
}

DI void prep_s5_job(const Params& p, int j) {
  const int idx = j * 256 + TIDX;
  const int ldg = idx >> 6, pp = idx & 63;
  const float dt = expf(p.in[I_LDT][ldg]);
  const float are = p.in[I_ARE][idx], aim = p.in[I_AIM][idx];
  const float mag = expf(are * dt);
  float sn, cs;
  sincos_cw(aim * dt, sn, cs);
  const float abr = mag * cs, abi = mag * sn;
  const float den = are * are + aim * aim;
  const float fre = ((abr - 1.f) * are + abi * aim) / den;
  const float fim = (abi * are - (abr - 1.f) * aim) / den;
  float* BBR = (float*)(p.ws + OFF_BBR);
  float* BBI = (float*)(p.ws + OFF_BBI);
  for (int hh = 0; hh < 16; ++hh) {
    const float br = p.in[I_BRE][(size_t)idx * 16 + hh], bi = p.in[I_BIM][(size_t)idx * 16 + hh];
    BBR[(size_t)idx * 16 + hh] = fre * br - fim * bi;
    BBI[(size_t)idx * 16 + hh] = fre * bi + fim * br;
  }
  float2* PW = (float2*)(p.ws + OFF_PWR);
  float pr = 1.f, pi = 0.f;
  for (int tau = 0; tau <= 32; ++tau) {
    PW[((size_t)ldg * 33 + tau) * 64 + pp] = make_float2(pr, pi);
    const float nr = pr * abr - pi * abi, ni = pr * abi + pi * abr;
    pr = nr; pi = ni;
  }
}

DI void prep_wt_job(const Params& p, int jj, char* smem) {
  float* tile = (float*)smem;
  const int l = jj / 4016;
  int r = jj % 4016;
  int mat = 0;
  const int cnt[8] = {1376, 64, 128, 64, 256, 1408, 704, 16};
#pragma unroll
  for (int m = 0; m < 8; ++m) {
    if (mat == m && r >= cnt[m]) { r -= cnt[m]; mat = m + 1; }
  }
  const float* src; int K, sld; size_t doff;
  switch (mat) {
    case 0: src = p.in[I_WIN] + (size_t)l * 1024 * DIN; K = 1024; sld = DIN; doff = WL_WIN; break;
    case 1: src = p.in[I_WBA] + (size_t)l * 256 * 1024; K = 256; sld = 1024; doff = WL_BRA; break;
    case 2: src = p.in[I_WBG] + (size_t)l * 512 * 1024; K = 512; sld = 1024; doff = WL_BRG; break;
    case 3: src = p.in[I_WBS] + (size_t)l * 256 * 1024; K = 256; sld = 1024; doff = WL_BRS; break;
    case 4: src = p.in[I_WOUT] + (size_t)l * 1024 * 1024; K = 1024; sld = 1024; doff = WL_WOUT; break;
    case 5: src = p.in[I_UP] + (size_t)l * 1024 * 5632; K = 1024; sld = 5632; doff = WL_UP; break;
    case 6: src = p.in[I_DOWN] + (size_t)l * 2816 * 1024; K = 2816; sld = 1024; doff = WL_DOWN; break;
    default: src = p.in[I_GLUW] + (size_t)l * 256 * 256; K = 256; sld = 256; doff = WL_GLU; break;
  }
  const int kt = K / 64;
  const int n0 = (r / kt) * 64, k0 = (r % kt) * 64;
  const int tid = TIDX;
  {
    const int nn = tid & 63;
    const int np = n0 + nn;
    int col;
    if (mat == 0) {
      if (np < 2048) col = np;
      else if (np < 2304) col = 2080 + (np - 2048);
      else if (np < 2336) col = 2048 + (np - 2304);
      else if (np < 2432) col = -1;
      else col = 2336 + (np - 2432);
    } else if (mat == 5) {
      const int jb = np >> 7, c = np & 127;
      col = (c < 64) ? (jb * 64 + c) : (DFF + jb * 64 + (c - 64));
    } else col = np;
#pragma unroll 4
    for (int kk = tid >> 6; kk < 64; kk += 4) tile[kk * 65 + nn] = (col >= 0) ? src[(size_t)(k0 + kk) * sld + col] : 0.f;
  }
  __syncthreads();
  {
    const int nn = tid >> 2, kq = (tid & 3) * 16;
    bf16* d = wl(p, l, doff) + (size_t)(n0 + nn) * K + k0 + kq;
    u32x4 v0, v1;
#pragma unroll
    for (int e = 0; e < 4; ++e) {
      v0[e] = pack2(tile[(kq + 2 * e) * 65 + nn], tile[(kq + 2 * e + 1) * 65 + nn]);
      v1[e] = pack2(tile[(kq + 8 + 2 * e) * 65 + nn], tile[(kq + 8 + 2 * e + 1) * 65 + nn]);
    }
    *(u32x4*)d = v0;
    *(u32x4*)(d + 8) = v1;
  }
  __syncthreads();
}

template <int MODE>
DI void row_job(const Params& p, int l, int tok) {
  const int lane = TIDX & 63;
  float x[16];
  float* xr = resid_row(p, tok);
  if (MODE == 0) {
    const int b = tok / TT, t = tok - b * TT;
    const float* src = (t < CTXL) ? p.in[I_CTX] + ((size_t)b * CTXL + t) * DM : p.in[I_X] + ((size_t)b * SEQ + (t - CTXL)) * DM;
#pragma unroll
    for (int i = 0; i < 4; ++i) {
      const f32x4 v = *(const f32x4*)(src + lane * 4 + 256 * i);
      x[4 * i] = v[0]; x[4 * i + 1] = v[1]; x[4 * i + 2] = v[2]; x[4 * i + 3] = v[3];
      *(f32x4*)(xr + lane * 4 + 256 * i) = v;
    }
  } else {
    const bf16* yr = (const bf16*)(p.ws + OFF_H) + (size_t)tok * DM;
    const float* gpost = p.in[MODE == 1 ? I_NMPOST : I_NFPOST] + l * DM;
    const float* mg = mod_vec(p, l, tok, MODE == 1 ? 2 : 5);
    float y[16];
    float ss = 0.f;
#pragma unroll
    for (int i = 0; i < 4; ++i) {
      const u32x2 u = *(const u32x2*)(yr + lane * 4 + 256 * i);
      y[4 * i] = bflo(u[0]); y[4 * i + 1] = bfhi(u[0]); y[4 * i + 2] = bflo(u[1]); y[4 * i + 3] = bfhi(u[1]);
#pragma unroll
      for (int e = 0; e < 4; ++e) ss += y[4 * i + e] * y[4 * i + e];
    }
    ss = wave_sum(ss);
    const float rstd = rsqrtf(ss * (1.f / DM) + EPSF);
#pragma unroll
    for (int i = 0; i < 4; ++i) {
      f32x4 v = *(const f32x4*)(xr + lane * 4 + 256 * i);
      const f32x4 g = *(const f32x4*)(gpost + lane * 4 + 256 * i);
      const f32x4 m = *(const f32x4*)(mg + lane * 4 + 256 * i);
#pragma unroll
      for (int e = 0; e < 4; ++e) { v[e] += m[e] * (y[4 * i + e] * rstd * g[e]); x[4 * i + e] = v[e]; }
      *(f32x4*)(xr + lane * 4 + 256 * i) = v;
    }
  }
  if (MODE == 2 && l == NL - 1) return;
  const int ln = (MODE == 2) ? l + 1 : l;
  const float* gpre = p.in[MODE == 1 ? I_NFPRE : I_NMPRE] + ln * DM;
  const float* sh = mod_vec(p, ln, tok, MODE == 1 ? 3 : 0);
  const float* scv = mod_vec(p, ln, tok, MODE == 1 ? 4 : 1);
  float ss = 0.f;
#pragma unroll
  for (int i = 0; i < 16; ++i) ss += x[i] * x[i];
  ss = wave_sum(ss);
  const float rstd = rsqrtf(ss * (1.f / DM) + EPSF);
  bf16* hr = (bf16*)(p.ws + OFF_H) + (size_t)tok * DM;
#pragma unroll
  for (int i = 0; i < 4; ++i) {
    const f32x4 g = *(const f32x4*)(gpre + lane * 4 + 256 * i);
    const f32x4 s1 = *(const f32x4*)(sh + lane * 4 + 256 * i);
    const f32x4 s2 = *(const f32x4*)(scv + lane * 4 + 256 * i);
    float o[4];
#pragma unroll
    for (int e = 0; e < 4; ++e) o[e] = (x[4 * i + e] * rstd * g[e]) * (1.f + s2[e]) + s1[e];
    u32x2 u;
    u[0] = pack2(o[0], o[1]); u[1] = pack2(o[2], o[3]);
    *(u32x2*)(hr + lane * 4 + 256 * i) = u;
  }
}

template <int MODE>
DI void row_phase(const Params& p, int l, int bid, int G) {
  const int lane = TIDX & 63;
  const int wg = bid * 4 + (TIDX >> 6), nw = G * 4;
  const int R = (NTOK + nw - 1) / nw;
  const int t0 = wg * R, t1 = min(NTOK, t0 + R);
  if (t0 >= t1) return;
  const bool has_next = !(MODE == 2 && l == NL - 1);
  const int ln = (MODE == 2) ? l + 1 : l;
  f32x4 gpost[4], gpre[4], mg[4], sh[4], scl[4];
#pragma unroll
  for (int i = 0; i < 4; ++i) {
    if (MODE != 0) gpost[i] = *(const f32x4*)(p.in[MODE == 1 ? I_NMPOST : I_NFPOST] + l * DM + lane * 4 + 256 * i);
    if (has_next) gpre[i] = *(const f32x4*)(p.in[MODE == 1 ? I_NFPRE : I_NMPRE] + ln * DM + lane * 4 + 256 * i);
  }
  int cur_m = -1;
  u32x2 yb[4], yn[4];
  f32x4 xb[4], xn[4];
  const bf16* Hb = (const bf16*)(p.ws + OFF_H);
#define ROW_LOAD(TOK, YY, XX)                                                                              \
  {                                                                                                        \
    const int b_ = (TOK) / TT, t_ = (TOK) - b_ * TT;                                                       \
    const float* src_ = (MODE == 0) ? ((t_ < CTXL) ? p.in[I_CTX] + ((size_t)b_ * CTXL + t_) * DM           \
                                                   : p.in[I_X] + ((size_t)b_ * SEQ + (t_ - CTXL)) * DM)    \
                                    : resid_row(p, (TOK));                                                 \
    _Pragma("unroll") for (int i = 0; i < 4; ++i) {                                                        \
      XX[i] = *(const f32x4*)(src_ + lane * 4 + 256 * i);                                                  \
      if (MODE != 0) YY[i] = *(const u32x2*)(Hb + (size_t)(TOK) * DM + lane * 4 + 256 * i);                \
    }                                                                                                      \
  }
  ROW_LOAD(t0, yb, xb)
  for (int tok = t0; tok < t1; ++tok) {
    if (tok + 1 < t1) ROW_LOAD(tok + 1, yn, xn)
    const int b = tok / TT, t = tok - b * TT;
    const int m = (t < CTXL) ? 4 : b;
    if (m != cur_m) {
      cur_m = m;
      const float* Mv = (const float*)(p.ws + OFF_MOD);
#pragma unroll
      for (int i = 0; i < 4; ++i) {
        if (MODE != 0) mg[i] = *(const f32x4*)(Mv + ((size_t)(l * 5 + m) * 6 + (MODE == 1 ? 2 : 5)) * DM + lane * 4 + 256 * i);
        if (has_next) {
          sh[i] = *(const f32x4*)(Mv + ((size_t)(ln * 5 + m) * 6 + (MODE == 1 ? 3 : 0)) * DM + lane * 4 + 256 * i);
          scl[i] = *(const f32x4*)(Mv + ((size_t)(ln * 5 + m) * 6 + (MODE == 1 ? 4 : 1)) * DM + lane * 4 + 256 * i);
        }
      }
    }
    float* xr = resid_row(p, tok);
    f32x4 x[4];
    if (MODE == 0) {
#pragma unroll
      for (int i = 0; i < 4; ++i) { x[i] = xb[i]; *(f32x4*)(xr + lane * 4 + 256 * i) = x[i]; }
    } else {
      float y[16];
      float ss = 0.f;
#pragma unroll
      for (int i = 0; i < 4; ++i) {
        y[4 * i] = bflo(yb[i][0]); y[4 * i + 1] = bfhi(yb[i][0]); y[4 * i + 2] = bflo(yb[i][1]); y[4 * i + 3] = bfhi(yb[i][1]);
#pragma unroll
        for (int e = 0; e < 4; ++e) ss += y[4 * i + e] * y[4 * i + e];
      }
      ss = wave_sum(ss);
      const float rstd = rsqrtf(ss * (1.f / DM) + EPSF);
#pragma unroll
      for (int i = 0; i < 4; ++i) {
        f32x4 v = xb[i];
#pragma unroll
        for (int e = 0; e < 4; ++e) v[e] += mg[i][e] * (y[4 * i + e] * rstd * gpost[i][e]);
        x[i] = v;
        *(f32x4*)(xr + lane * 4 + 256 * i) = v;
      }
    }
    if (has_next) {
      float ss = 0.f;
#pragma unroll
      for (int i = 0; i < 4; ++i)
#pragma unroll
        for (int e = 0; e < 4; ++e) ss += x[i][e] * x[i][e];
      ss = wave_sum(ss);
      const float rstd = rsqrtf(ss * (1.f / DM) + EPSF);
      bf16* hr = (bf16*)(p.ws + OFF_H) + (size_t)tok * DM;
#pragma unroll
      for (int i = 0; i < 4; ++i) {
        float o[4];
#pragma unroll
        for (int e = 0; e < 4; ++e) o[e] = (x[i][e] * rstd * gpre[i][e]) * (1.f + scl[i][e]) + sh[i][e];
        u32x2 u;
        u[0] = pack2(o[0], o[1]); u[1] = pack2(o[2], o[3]);
        *(u32x2*)(hr + lane * 4 + 256 * i) = u;
      }
    }
#pragma unroll
    for (int i = 0; i < 4; ++i) { yb[i] = yn[i]; xb[i] = xn[i]; }
  }
#undef ROW_LOAD
}

DI void ktab_phase(const Params& p, int bid, int G) {
  const float* BBR = (const float*)(p.ws + OFF_BBR);
  const float* BBI = (const float*)(p.ws + OFF_BBI);
  const float2* PW = (const float2*)(p.ws + OFF_PWR);
  float* KT = (float*)(p.ws + OFF_KTAB);
  const int total = NL * 16 * 2 * 32 * 256;
  for (int idx = bid * 256 + TIDX; idx < total; idx += G * 256) {
    const int hp = idx & 15, hh = (idx >> 4) & 15, tau = (idx >> 8) & 31, d = (idx >> 13) & 1, g = (idx >> 14) & 15, l = idx >> 18;
    const int ldg = (l * 2 + d) * 16 + g;
    const float* cre = p.in[I_CRE] + ((size_t)ldg * 16 + hh) * 64;
    const float* cim = p.in[I_CIM] + ((size_t)ldg * 16 + hh) * 64;
    float acc = 0.f;
    for (int pp = 0; pp < 64; ++pp) {
      const float2 pw = PW[((size_t)ldg * 33 + tau) * 64 + pp];
      const float br = BBR[((size_t)ldg * 64 + pp) * 16 + hp], bi = BBI[((size_t)ldg * 64 + pp) * 16 + hp];
      const float zr = pw.x * br - pw.y * bi, zi = pw.x * bi + pw.y * br;
      acc += cre[pp] * zr - cim[pp] * zi;
    }
    KT[idx] = acc;
  }
}

DI void s5mat_phase(const Params& p, int l, int bid, int G) {
  const float* BBR = (const float*)(p.ws + OFF_BBR);
  const float* BBI = (const float*)(p.ws + OFF_BBI);
  const float2* PW = (const float2*)(p.ws + OFF_PWR);
  const float* KT = (const float*)(p.ws + OFF_KTAB);
  bf16* T5 = (bf16*)(p.ws + OFF_T5);
  bf16* E5 = (bf16*)(p.ws + OFF_E5);
  bf16* F5 = (bf16*)(p.ws + OFF_F5);
  const int nT = 16 * 512 * 64, nE = 16 * 512 * 32, nF = 16 * 256 * 64;
  for (int it = bid * 256 + TIDX; it < nT + nE + nF; it += G * 256) {
    float v[8];
    bf16* dst;
    if (it < nT) {
      const int k8 = it & 63, n = (it >> 6) & 511, g = it >> 15;
      const int i = n >> 4, hh = n & 15, j = k8 >> 1, hp0 = (k8 & 1) * 8;
#pragma unroll
      for (int e = 0; e < 8; ++e) {
        const int hp = hp0 + e;
        float a = 0.f;
        if (j <= i) a += KT[((((size_t)l * 16 + g) * 2 + 0) * 32 + (i - j)) * 256 + hh * 16 + hp];
        if (j >= i) a += KT[((((size_t)l * 16 + g) * 2 + 1) * 32 + (j - i)) * 256 + hh * 16 + hp];
        if (i == j && hh == hp) a += p.in[I_S5D][l * 256 + g * 16 + hh];
        v[e] = a;
      }
      dst = T5 + ((size_t)g * 512 + n) * 512 + k8 * 8;
    } else if (it < nT + nE) {
      const int q = it - nT;
      const int k8 = q & 31, n = (q >> 5) & 511, g = q >> 14;
      const int i = n >> 4, hh = n & 15;
      const int k0 = k8 * 8, d = k0 >> 7, ri = (k0 >> 6) & 1, p0 = k0 & 63;
      const int ldg = (l * 2 + d) * 16 + g;
      const int ex = d ? (32 - i) : (i + 1);
#pragma unroll
      for (int e = 0; e < 8; ++e) {
        const int pp = p0 + e;
        const float2 pw = PW[((size_t)ldg * 33 + ex) * 64 + pp];
        const float cr = p.in[I_CRE][((size_t)ldg * 16 + hh) * 64 + pp], ci = p.in[I_CIM][((size_t)ldg * 16 + hh) * 64 + pp];
        const float zr = cr * pw.x - ci * pw.y, zi = cr * pw.y + ci * pw.x;
        v[e] = ri ? -zi : zr;
      }
      dst = E5 + ((size_t)g * 512 + n) * 256 + k0;
    } else {
      const int q = it - nT - nE;
      const int k8 = q & 63, n = (q >> 6) & 255, g = q >> 14;
      const int d = n >> 7, ri = (n >> 6) & 1, pp = n & 63;
      const int j = k8 >> 1, hp0 = (k8 & 1) * 8;
      const int ldg = (l * 2 + d) * 16 + g;
      const int ex = d ? j : (31 - j);
      const float2 pw = PW[((size_t)ldg * 33 + ex) * 64 + pp];
#pragma unroll
      for (int e = 0; e < 8; ++e) {
        const float br = BBR[((size_t)ldg * 64 + pp) * 16 + hp0 + e], bi = BBI[((size_t)ldg * 64 + pp) * 16 + hp0 + e];
        v[e] = ri ? (pw.x * bi + pw.y * br) : (pw.x * br - pw.y * bi);
      }
      dst = F5 + ((size_t)g * 256 + n) * 512 + k8 * 8;
    }
    u32x4 u;
    u[0] = pack2(v[0], v[1]); u[1] = pack2(v[2], v[3]); u[2] = pack2(v[4], v[5]); u[3] = pack2(v[6], v[7]);
    *(u32x4*)dst = u;
  }
}

DI void proj_epi(const Params& p, int l, int mt, int nt, char* smem);
DI void proj_wide(const Params& p, int l, int mt, int np, char* smem) {
  const bf16* H = (const bf16*)(p.ws + OFF_H) + (size_t)mt * 128 * DM;
  const bf16* W = wl(p, l, WL_WIN) + (size_t)np * 256 * DM;
  f32x16 acc[2][4];
  accw_zero(acc);
  gemm_wide(acc, [&](int r) { return H + (size_t)r * DM; }, [&](int r) { return W + (size_t)r * DM; }, DM, smem);
  float* Cs = (float*)smem;
  accw_to_lds<0>(acc, Cs);
  __syncthreads();
  proj_epi(p, l, mt, np * 2, smem);
  if (np * 2 + 1 < 19) {
    accw_to_lds<1>(acc, Cs);
    __syncthreads();
    proj_epi(p, l, mt, np * 2 + 1, smem);
  }
}
DI void proj_epi(const Params& p, int l, int mt, int nt, char* smem) {
  float* Cs = (float*)smem;
  const int tid = TIDX;
  const int tok0 = mt * 128;
  const int b = tok0 / TT, t0 = tok0 - b * TT;
  if (nt <= 2) {
    const int row = tid >> 1, seg = tid & 1;
    float* c = Cs + row * CLD + seg * 64;
    const float* gn = p.in[nt < 2 ? I_QN : I_KN] + l * 64;
    float ss = 0.f;
#pragma unroll 8
    for (int i = 0; i < 64; ++i) ss += c[i] * c[i];
    const float rstd = rsqrtf(ss * (1.f / 64.f) + EPSF);
    const int t = t0 + row;
    const bool lat = t >= CTXL;
    const int s = t - CTXL;
#pragma unroll 1
    for (int ax = 0; ax < 2; ++ax) {
      const float pos = (float)(ax ? (s & 63) : (s >> 6));
#pragma unroll 2
      for (int f = 0; f < 16; ++f) {
        float x1 = c[ax * 32 + f] * rstd * gn[ax * 32 + f];
        float x2 = c[ax * 32 + 16 + f] * rstd * gn[ax * 32 + 16 + f];
        if (lat) {
          const float invf = exp2f(-(float)f * (13.287712379549449f / 16.f));
          float sn, cs;
          sincos_cw(pos * invf, sn, cs);
          const float y1 = x1 * cs - x2 * sn, y2 = x2 * cs + x1 * sn;
          x1 = y1; x2 = y2;
        }
        c[ax * 32 + f] = x1;
        c[ax * 32 + 16 + f] = x2;
      }
    }
    __syncthreads();
    if (nt < 2) store_tile_bf16(Cs, (bf16*)(p.ws + OFF_Q) + (size_t)tok0 * 256 + nt * 128, 256, 128, 0.125f * 1.4426950408889634f);
    else store_tile_bf16(Cs, (bf16*)(p.ws + OFF_K) + (size_t)tok0 * 128, 128, 128, 1.f);
  } else if (nt == 3 || (nt >= 8 && nt <= 11)) {
    for (int c = tid; c < 2048; c += 256) {
      const int col = c & 127, rc = (c >> 7) * 8;
      u32x4 u;
#pragma unroll
      for (int e = 0; e < 4; ++e) u[e] = pack2(Cs[(rc + 2 * e) * CLD + col], Cs[(rc + 2 * e + 1) * CLD + col]);
      bf16* dst;
      if (nt == 3) dst = (bf16*)(p.ws + OFF_VT) + ((size_t)(b * 2 + (col >> 6)) * 64 + (col & 63)) * TT + t0 + rc;
      else dst = (bf16*)(p.ws + OFF_GVT) + ((size_t)(b * 4 + (nt - 8)) * 128 + col) * TT + t0 + rc;
      *(u32x4*)dst = u;
    }
  } else if (nt == 4 || nt == 5) {
    store_tile_bf16(Cs, (bf16*)(p.ws + OFF_GQ) + (size_t)tok0 * 256 + (nt - 4) * 128, 256, 128, 0.125f);
  } else if (nt == 6 || nt == 7) {
    store_tile_bf16(Cs, (bf16*)(p.ws + OFF_GK) + (size_t)tok0 * 256 + (nt - 6) * 128, 256, 128, 1.f);
  } else if (nt >= 12 && nt <= 15) {
    store_tile_bf16(Cs, (bf16*)(p.ws + OFF_GR) + (size_t)tok0 * 512 + (nt - 12) * 128, 512, 128, 1.f);
  } else if (nt == 16 || nt == 17) {
    for (int c = tid; c < 2048; c += 256) {
      const int row = c >> 4, c8 = c & 15;
      const float* s = Cs + row * CLD + c8 * 8;
      u32x4 u;
#pragma unroll
      for (int e = 0; e < 4; ++e) u[e] = pack2(s[2 * e], s[2 * e + 1]);
      const int ch = (nt - 16) * 128 + c8 * 8;
      bf16* dst = (bf16*)(p.ws + OFF_SU) + ((size_t)(b * 16 + (ch >> 4)) * TT + t0 + row) * 16 + (ch & 15);
      *(u32x4*)dst = u;
    }
  } else {
    for (int c = tid; c < 128 * 8; c += 256) {
      const int row = c >> 3, c4 = (c & 7) * 4;
      const float* s = Cs + row * CLD + c4;
      f32x4 v = {s[0], s[1], s[2], s[3]};
      *(f32x4*)((float*)(p.ws + OFF_LOW) + (size_t)(tok0 + row) * 32 + c4) = v;
    }
  }
  __syncthreads();
}

DI void attn_unit(const Params& p, int u, char* smem) {
  int b, head, tok0, nkt;
  if (u < 1024) { b = u >> 8; head = (u >> 6) & 3; tok0 = b * TT + CTXL + (u & 63) * 128; nkt = TT / 128; }
  else { const int v = u - 1024; b = v >> 3; head = (v >> 1) & 3; tok0 = b * TT + (v & 1) * 128; nkt = CTXL / 128; }
  const int kvh = head >> 1;
  const int tid = TIDX, lane = tid & 63, w = tid >> 6, r = lane & 31, h = lane >> 5;
  const bf16* Qp = (const bf16*)(p.ws + OFF_Q) + (size_t)(tok0 + w * 32 + r) * 256 + head * 64 + h * 8;
  s16x8 qf[4];
#pragma unroll
  for (int s = 0; s < 4; ++s) qf[s] = __builtin_bit_cast(s16x8, ldg16(Qp + s * 16));
  const bf16* kp[2];
  const bf16* vp[2];
#pragma unroll
  for (int i = 0; i < 2; ++i) {
    const int row = w * 16 + i * 8 + (lane >> 3);
    const int c = (lane & 7) ^ ((row >> 1) & 7);
    kp[i] = (const bf16*)(p.ws + OFF_K) + ((size_t)b * TT + row) * 128 + kvh * 64 + c * 8;
    vp[i] = (const bf16*)(p.ws + OFF_VT) + ((size_t)(b * 2 + kvh) * 64 + row) * TT + c * 8;
  }
  const int ldst = (w * 128 + lane) * 16;
#define AT_DMA(BUF, T)                                                                                              \
  {                                                                                                                 \
    char* sb_ = smem + (BUF) * 32768;                                                                               \
    _Pragma("unroll") for (int hh = 0; hh < 2; ++hh)                                                                \
    _Pragma("unroll") for (int i = 0; i < 2; ++i) {                                                                 \
      __builtin_amdgcn_global_load_lds((const unsigned*)(kp[i] + (size_t)((T) * 128 + hh * 64) * 128), (unsigned*)(sb_ + hh * 8192 + ldst + i * 1024), 16, 0, 0); \
      __builtin_amdgcn_global_load_lds((const unsigned*)(vp[i] + (T) * 128 + hh * 64), (unsigned*)(sb_ + 16384 + hh * 8192 + ldst + i * 1024), 16, 0, 0);        \
    }                                                                                                               \
  }
  const int xr = (r >> 1) & 7;
  AT_DMA(0, 0)
  asm volatile("s_waitcnt vmcnt(0)" ::: "memory");
  __syncthreads();
  f32x16 oacc[2];
#pragma unroll
  for (int i = 0; i < 16; ++i) { oacc[0][i] = 0.f; oacc[1][i] = 0.f; }
  float mrow = -INFINITY, lrow = 0.f;
  for (int kt = 0; kt < nkt; ++kt) {
    const int buf = kt & 1;
    if (kt + 1 < nkt) AT_DMA(buf ^ 1, kt + 1)
    const char* Kb = smem + buf * 32768;
    const char* Vb = Kb + 16384;
    f32x16 sacc[4];
#pragma unroll
    for (int q = 0; q < 4; ++q)
#pragma unroll
      for (int i = 0; i < 16; ++i) sacc[q][i] = 0.f;
#pragma unroll
    for (int s = 0; s < 4; ++s) {
      const int co = ((2 * s + h) ^ xr) * 16;
#pragma unroll
      for (int q = 0; q < 4; ++q) {
        const s16x8 a = *(const s16x8*)(Kb + (q >> 1) * 8192 + ((q & 1) * 32 + r) * 128 + co);
        sacc[q] = MFMA32(a, qf[s], sacc[q]);
      }
    }
    float mx = sacc[0][0];
#pragma unroll
    for (int q = 0; q < 4; ++q)
#pragma unroll
      for (int i = 0; i < 16; ++i) mx = fmaxf(mx, sacc[q][i]);
    mx = fmaxf(mx, __shfl_xor(mx, 32, 64));
    const float mnew = fmaxf(mrow, mx);
    const float alpha = __builtin_amdgcn_exp2f(mrow - mnew);
    mrow = mnew;
    float psum = 0.f;
#pragma unroll
    for (int q = 0; q < 4; ++q)
#pragma unroll
      for (int i = 0; i < 16; ++i) { sacc[q][i] = __builtin_amdgcn_exp2f(sacc[q][i] - mnew); psum += sacc[q][i]; }
    lrow = lrow * alpha + psum;
#pragma unroll
    for (int i = 0; i < 16; ++i) { oacc[0][i] *= alpha; oacc[1][i] *= alpha; }
#pragma unroll
    for (int q = 0; q < 4; ++q)
#pragma unroll
      for (int s2 = 0; s2 < 2; ++s2) {
        u32x4 pu;
#pragma unroll
        for (int e = 0; e < 4; ++e) pu[e] = pack2(sacc[q][8 * s2 + 2 * e], sacc[q][8 * s2 + 2 * e + 1]);
        const s16x8 pf = __builtin_bit_cast(s16x8, pu);
        const int c0 = (q & 1) * 4 + 2 * s2;
        const int o0 = ((c0 ^ xr) * 16) + 8 * h, o1 = (((c0 + 1) ^ xr) * 16) + 8 * h;
#pragma unroll
        for (int dt = 0; dt < 2; ++dt) {
          const s16x4 lo = *(const s16x4*)(Vb + (q >> 1) * 8192 + (dt * 32 + r) * 128 + o0);
          const s16x4 hi = *(const s16x4*)(Vb + (q >> 1) * 8192 + (dt * 32 + r) * 128 + o1);
          const s16x8 a = __builtin_shufflevector(lo, hi, 0, 1, 2, 3, 4, 5, 6, 7);
          oacc[dt] = MFMA32(a, pf, oacc[dt]);
        }
      }
    asm volatile("s_waitcnt vmcnt(0)" ::: "memory");
    __syncthreads();
  }
#undef AT_DMA
  const float ltot = lrow + __shfl_xor(lrow, 32, 64);
  const float inv = 1.f / ltot;
  bf16* Op = (bf16*)(p.ws + OFF_OATT) + (size_t)(tok0 + w * 32 + r) * 256 + head * 64;
#pragma unroll
  for (int dt = 0; dt < 2; ++dt)
#pragma unroll
    for (int i = 0; i < 16; i += 4) {
      u32x2 uu;
      uu[0] = pack2(oacc[dt][i] * inv, oacc[dt][i + 1] * inv);
      uu[1] = pack2(oacc[dt][i + 2] * inv, oacc[dt][i + 3] * inv);
      *(u32x2*)(Op + dt * 32 + crow(i, h)) = uu;
    }
}

constexpr int GL_LOW = 0, GL_TOT = 4096, GL_DEC = 5120, GL_QIN = 5376, GL_KIN = 14592, GL_KET = 23808, GL_OST = 0,
              GL_VT = 33792, GL_ST = 52224;
static_assert(GL_ST + 128 * LDT * 2 <= SMEM_BYTES, "gla lds");

template <bool WITH_OUT>
DI void gla_unit(const Params& p, int l, int u, char* smem) {
  float* lowt = (float*)(smem + GL_LOW);
  float* tots = (float*)(smem + GL_TOT);
  float* decs = (float*)(smem + GL_DEC);
  bf16* qin = (bf16*)(smem + GL_QIN);
  bf16* kin = (bf16*)(smem + GL_KIN);
  bf16* ket = (bf16*)(smem + GL_KET);
  float* ost = (float*)(smem + GL_OST);
  bf16* vts = (bf16*)(smem + GL_VT);
  bf16* sts = (bf16*)(smem + GL_ST);
  const int tid = TIDX, lane = tid & 63, w = tid >> 6, r = lane & 31, h = lane >> 5;
  int b, hd, gi, dir0, ndir;
  if (WITH_OUT) { gi = u % NG33; hd = (u / NG33) & 3; b = u / (NG33 * 4); dir0 = 1; ndir = 2; }
  else { gi = u % NG33; const int v = u / NG33; dir0 = v & 1; hd = (v >> 1) & 3; b = v >> 3; ndir = 1; }
  const int dk = tid & 63, part = tid >> 6;
  const bf16* GQ = (const bf16*)(p.ws + OFF_GQ);
  const bf16* GK = (const bf16*)(p.ws + OFF_GK);
  const bf16* GVT = (const bf16*)(p.ws + OFF_GVT) + (size_t)(b * 4 + hd) * 128 * TT;
  const float* LOW = (const float*)(p.ws + OFF_LOW);
  for (int dd = 0; dd < ndir; ++dd) {
    const int dir = WITH_OUT ? (dir0 - dd) : dir0;
    float* GSu = (float*)(p.ws + OFF_GS) + ((size_t)((b * 4 + hd) * 2 + dir) * NG33 + gi) * 8192;
    float gwreg[16];
#pragma unroll
    for (int rr = 0; rr < 16; ++rr) gwreg[rr] = p.in[I_GGW][((size_t)(l * 2 + dir) * 16 + rr) * 256 + hd * 64 + dk];
    const float gb = p.in[I_GGB][(l * 2 + dir) * 256 + hd * 64 + dk];
    f32x16 sacc[2];
    if (WITH_OUT) {
#pragma unroll
      for (int dkt = 0; dkt < 2; ++dkt)
#pragma unroll
        for (int i = 0; i < 16; ++i) {
          const float v = GSu[(w * 32 + crow(i, h)) * 64 + dkt * 32 + r];
          sacc[dkt][i] = v;
          sts[(w * 32 + crow(i, h)) * LDT + dkt * 32 + r] = f2bf(v);
        }
    } else {
#pragma unroll
      for (int i = 0; i < 16; ++i) { sacc[0][i] = 0.f; sacc[1][i] = 0.f; }
    }
    float gtot = 0.f;
    for (int cc = 0; cc < 4; ++cc) {
      const int ci = dir ? 3 - cc : cc;
      const int tb = gi * 256 + ci * 64;
      const size_t tokb = (size_t)b * TT + tb;
      {
        const int row = tid >> 2, c4 = (tid & 3) * 4;
        const u32x4 lw = ldg16(LOW + (tokb + row) * 32 + dir * 16 + c4);
        u32x4 vv[4], kq[2], qq[2];
#pragma unroll
        for (int i = 0; i < 4; ++i) {
          const int c = tid + 256 * i, e = c >> 3, k8 = (c & 7) * 8;
          vv[i] = ldg16(GVT + (size_t)e * TT + tb + k8);
        }
#pragma unroll
        for (int i = 0; i < 2; ++i) {
          const int c = tid + 256 * i, rw = c >> 3, k8 = (c & 7) * 8;
          kq[i] = ldg16(GK + (tokb + rw) * 256 + hd * 64 + k8);
          if (WITH_OUT) qq[i] = ldg16(GQ + (tokb + rw) * 256 + hd * 64 + k8);
        }
        *(u32x4*)(lowt + row * 16 + c4) = lw;
#pragma unroll
        for (int i = 0; i < 4; ++i) {
          const int c = tid + 256 * i, e = c >> 3, k8 = (c & 7) * 8;
          *(u32x4*)(vts + e * LDT + k8) = vv[i];
        }
#pragma unroll
        for (int i = 0; i < 2; ++i) {
          const int c = tid + 256 * i, rw = c >> 3, k8 = (c & 7) * 8;
          *(u32x4*)(kin + rw * LDT + k8) = kq[i];
          if (WITH_OUT) *(u32x4*)(qin + rw * LDT + k8) = qq[i];
        }
      }
      __syncthreads();
      float cum = 0.f;
#pragma unroll 2
      for (int ii = 0; ii < 16; ++ii) {
        const int pos = part * 16 + ii, t = dir ? 63 - pos : pos;
        float z = gb;
#pragma unroll
        for (int rr = 0; rr < 16; ++rr) z += lowt[t * 16 + rr] * gwreg[rr];
        cum += (fminf(z, 0.f) - log1pf(__expf(-fabsf(z)))) * (1.f / 16.f);
      }
      tots[part * 64 + dk] = cum;
      __syncthreads();
      float offs = 0.f, total = 0.f;
#pragma unroll
      for (int pp = 0; pp < 4; ++pp) { const float tv = tots[pp * 64 + dk]; total += tv; if (pp < part) offs += tv; }
      if (part == 0) decs[dk] = __expf(total);
      gtot += total;
      float bq = offs;
#pragma unroll 2
      for (int ii = 0; ii < 16; ++ii) {
        const int pos = part * 16 + ii, t = dir ? 63 - pos : pos;
        float z = gb;
#pragma unroll
        for (int rr = 0; rr < 16; ++rr) z += lowt[t * 16 + rr] * gwreg[rr];
        bq += (fminf(z, 0.f) - log1pf(__expf(-fabsf(z)))) * (1.f / 16.f);
        const float kv = bf2f(kin[t * LDT + dk]);
        ket[dk * LDT + t] = f2bf(kv * __expf(total - bq));
        if (WITH_OUT) {
          const float qv = bf2f(qin[t * LDT + dk]);
          qin[t * LDT + dk] = f2bf(qv * __expf(bq));
          kin[t * LDT + dk] = f2bf(kv * __expf(-bq));
        }
      }
      __syncthreads();
      f32x16 oo[2];
      const int it = w & 1, ep = w >> 1;
      if (WITH_OUT) {
        const int ti = w >> 1, tj = w & 1;
        f32x16 aa;
#pragma unroll
        for (int i = 0; i < 16; ++i) aa[i] = 0.f;
#pragma unroll
        for (int s = 0; s < 4; ++s) {
          const s16x8 A = *(const s16x8*)(qin + (ti * 32 + r) * LDT + s * 16 + h * 8);
          const s16x8 Bv = *(const s16x8*)(kin + (tj * 32 + r) * LDT + s * 16 + h * 8);
          aa = MFMA32(A, Bv, aa);
        }
        __syncthreads();
#pragma unroll
        for (int i = 0; i < 16; ++i) {
          const int qi = ti * 32 + crow(i, h), kj = tj * 32 + r;
          const bool keep = dir ? (kj >= qi) : (kj <= qi);
          kin[qi * LDT + kj] = f2bf(keep ? aa[i] : 0.f);
        }
        __syncthreads();
#pragma unroll
        for (int i = 0; i < 16; ++i) { oo[0][i] = 0.f; oo[1][i] = 0.f; }
#pragma unroll
        for (int s = 0; s < 4; ++s) {
          const s16x8 A1 = *(const s16x8*)(kin + (it * 32 + r) * LDT + s * 16 + h * 8);
          const s16x8 A2 = *(const s16x8*)(qin + (it * 32 + r) * LDT + s * 16 + h * 8);
#pragma unroll
          for (int x = 0; x < 2; ++x) {
            const int et = 2 * ep + x;
            const s16x8 B1 = *(const s16x8*)(vts + (et * 32 + r) * LDT + s * 16 + h * 8);
            const s16x8 B2 = *(const s16x8*)(sts + (et * 32 + r) * LDT + s * 16 + h * 8);
            oo[x] = MFMA32(A1, B1, oo[x]);
            oo[x] = MFMA32(A2, B2, oo[x]);
          }
        }
      }
#pragma unroll
      for (int dkt = 0; dkt < 2; ++dkt) {
        const float dv = decs[dkt * 32 + r];
#pragma unroll
        for (int i = 0; i < 16; ++i) sacc[dkt][i] *= dv;
      }
#pragma unroll
      for (int s = 0; s < 4; ++s) {
        const s16x8 A = *(const s16x8*)(vts + (w * 32 + r) * LDT + s * 16 + h * 8);
#pragma unroll
        for (int dkt = 0; dkt < 2; ++dkt) {
          const s16x8 Bv = *(const s16x8*)(ket + (dkt * 32 + r) * LDT + s * 16 + h * 8);
          sacc[dkt] = MFMA32(A, Bv, sacc[dkt]);
        }
      }
      __syncthreads();
      if (WITH_OUT) {
#pragma unroll
        for (int dkt = 0; dkt < 2; ++dkt)
#pragma unroll
          for (int i = 0; i < 16; ++i) sts[(w * 32 + crow(i, h)) * LDT + dkt * 32 + r] = f2bf(sacc[dkt][i]);
#pragma unroll
        for (int x = 0; x < 2; ++x)
#pragma unroll
          for (int i = 0; i < 16; ++i) ost[(it * 32 + crow(i, h)) * CLD + (2 * ep + x) * 32 + r] = oo[x][i];
        __syncthreads();
        const int row = tid >> 2, qd = tid & 3;
        const size_t tok = tokb + row;
        bf16* og = (bf16*)(p.ws + OFF_OGLA) + tok * 512 + hd * 128 + qd * 32;
        const float* os = ost + row * CLD + qd * 32;
        if (dir == 1) {
#pragma unroll
          for (int i = 0; i < 4; ++i) {
            u32x4 uu;
#pragma unroll
            for (int e = 0; e < 4; ++e) uu[e] = pack2(os[i * 8 + 2 * e], os[i * 8 + 2 * e + 1]);
            *(u32x4*)(og + i * 8) = uu;
          }
        } else {
          float ss = 0.f;
#pragma unroll 1
          for (int i = 0; i < 4; ++i) {
            const u32x4 uu = *(const u32x4*)(og + i * 8);
#pragma unroll
            for (int e = 0; e < 4; ++e) {
              const float a0 = os[i * 8 + 2 * e] + bflo(uu[e]), a1 = os[i * 8 + 2 * e + 1] + bfhi(uu[e]);
              ss += a0 * a0 + a1 * a1;
            }
          }
          ss += __shfl_xor(ss, 1, 64);
          ss += __shfl_xor(ss, 2, 64);
          const float rstd = rsqrtf(ss * (1.f / 128.f) + EPSF);
          const float* gn = p.in[I_GON] + l * 128 + qd * 32;
          const bf16* gr = (const bf16*)(p.ws + OFF_GR) + tok * 512 + hd * 128 + qd * 32;
#pragma unroll 1
          for (int i = 0; i < 4; ++i) {
            const u32x4 uo = *(const u32x4*)(og + i * 8);
            const u32x4 ug = *(const u32x4*)(gr + i * 8);
            u32x4 uu;
#pragma unroll
            for (int e = 0; e < 4; ++e) {
              const float v0 = os[i * 8 + 2 * e] + bflo(uo[e]), v1 = os[i * 8 + 2 * e + 1] + bfhi(uo[e]);
              const float a0 = v0 * rstd * gn[i * 8 + 2 * e] * siluf_(bflo(ug[e]));
              const float a1 = v1 * rstd * gn[i * 8 + 2 * e + 1] * siluf_(bfhi(ug[e]));
              uu[e] = pack2(a0, a1);
            }
            *(u32x4*)(og + i * 8) = uu;
          }
        }
        __syncthreads();
      }
    }
    if (!WITH_OUT) {
#pragma unroll
      for (int dkt = 0; dkt < 2; ++dkt)
#pragma unroll
        for (int i = 0; i < 16; ++i) GSu[(w * 32 + crow(i, h)) * 64 + dkt * 32 + r] = sacc[dkt][i];
      if (part == 0) ((float*)(p.ws + OFF_DECG))[((size_t)((b * 4 + hd) * 2 + dir) * NG33 + gi) * 64 + dk] = __expf(gtot);
    }
    __syncthreads();
  }
}

DI void gla_scan_job(const Params& p, int j) {
  const int idx = j * 256 + TIDX;
  const int seq = idx >> 13, el = idx & 8191, dk = el & 63, dir = seq & 1;
  float* GS = (float*)(p.ws + OFF_GS) + (size_t)seq * NG33 * 8192 + el;
  const float* DG = (const float*)(p.ws + OFF_DECG) + (size_t)seq * NG33 * 64 + dk;
  float s = 0.f;
  for (int st0 = 0; st0 < 33; st0 += 11) {
    float kv[11], dc[11];
#pragma unroll
    for (int q = 0; q < 11; ++q) {
      const int st = st0 + q;
      const int g = (dir == 0 || st == 0) ? st : 33 - st;
      kv[q] = GS[(size_t)g * 8192];
      dc[q] = DG[g * 64];
    }
#pragma unroll
    for (int q = 0; q < 11; ++q) {
      const int st = st0 + q;
      const int g = (dir == 0 || st == 0) ? st : 33 - st;
      GS[(size_t)g * 8192] = s;
      s = dc[q] * s + kv[q];
    }
  }
}

DI void s5_end_tile(const Params& p, int j, char* smem) {
  const int nt = j & 1, mt = (j >> 1) % 9, g = j / 18;
  const bf16* SU = (const bf16*)(p.ws + OFF_SU);
  const bf16* F = (const bf16*)(p.ws + OFF_F5) + ((size_t)g * 256 + nt * 128) * 512;
  f32x16 acc[2][2];
  acc_zero(acc);
  gemm_main_dma(acc,
            [&](int r) -> const bf16* {
              const int m = mt * 128 + r;
              if (m >= MS5) return (const bf16*)(p.ws + OFF_ZERO);
              const int b = m / NCH, ch = m - b * NCH;
              return SU + ((size_t)(b * 16 + g) * TT + ch * 32) * 16;
            },
            [&](int r) { return F + (size_t)r * 512; }, 512, smem);
  float* Cs = (float*)smem;
  acc_to_lds(acc, Cs);
  __syncthreads();
  float* EN = (float*)(p.ws + OFF_EN);
  for (int c = TIDX; c < 128 * 32; c += 256) {
    const int row = c >> 5, c4 = (c & 31) * 4, m = mt * 128 + row;
    if (m < MS5) {
      const float* s = Cs + row * CLD + c4;
      f32x4 v = {s[0], s[1], s[2], s[3]};
      *(f32x4*)(EN + ((size_t)m * 16 + g) * 256 + nt * 128 + c4) = v;
    }
  }
  __syncthreads();
}

DI void s5_scan_job(const Params& p, int l, int j, char* smem) {
  float2* ends = (float2*)smem;
  const int dir = j & 1, g = (j >> 1) & 15, b = j >> 5;
  const int pp = TIDX & 63, seg = TIDX >> 6;
  const float2 aL = ((const float2*)(p.ws + OFF_PWR))[((size_t)((l * 2 + dir) * 16 + g) * 33 + 32) * 64 + pp];
  const float* EN = (const float*)(p.ws + OFF_EN);
  bf16* SB = (bf16*)(p.ws + OFF_SB);
  float sr = 0.f, si = 0.f;
  for (int q0 = 0; q0 < 66; q0 += 11) {
    float er[11], ei[11];
#pragma unroll
    for (int q = 0; q < 11; ++q) {
      const int pos = seg * 66 + q0 + q;
      const int ch = dir ? (pos < 8 ? 7 - pos : 271 - pos) : pos;
      const float* e = EN + ((size_t)(b * NCH + ch) * 16 + g) * 256 + dir * 128 + pp;
      er[q] = e[0]; ei[q] = e[64];
    }
#pragma unroll
    for (int q = 0; q < 11; ++q) {
      const float nr = aL.x * sr - aL.y * si + er[q], ni = aL.x * si + aL.y * sr + ei[q];
      sr = nr; si = ni;
    }
  }
  ends[seg * 64 + pp] = make_float2(sr, si);
  float pr = 1.f, pi = 0.f;
  for (int q = 0; q < 66; ++q) { const float nr = pr * aL.x - pi * aL.y, ni = pr * aL.y + pi * aL.x; pr = nr; pi = ni; }
  __syncthreads();
  sr = 0.f; si = 0.f;
  for (int k = 0; k < seg; ++k) {
    const float2 e = ends[k * 64 + pp];
    const float nr = pr * sr - pi * si + e.x, ni = pr * si + pi * sr + e.y;
    sr = nr; si = ni;
  }
  for (int q0 = 0; q0 < 66; q0 += 11) {
    float er[11], ei[11];
#pragma unroll
    for (int q = 0; q < 11; ++q) {
      const int pos = seg * 66 + q0 + q;
      const int ch = dir ? (pos < 8 ? 7 - pos : 271 - pos) : pos;
      const float* e = EN + ((size_t)(b * NCH + ch) * 16 + g) * 256 + dir * 128 + pp;
      er[q] = e[0]; ei[q] = e[64];
    }
#pragma unroll
    for (int q = 0; q < 11; ++q) {
      const int pos = seg * 66 + q0 + q;
      const int ch = dir ? (pos < 8 ? 7 - pos : 271 - pos) : pos;
      bf16* sb = SB + ((size_t)(b * NCH + ch) * 16 + g) * 256 + dir * 128 + pp;
      sb[0] = f2bf(sr); sb[64] = f2bf(si);
      const float nr = aL.x * sr - aL.y * si + er[q], ni = aL.x * si + aL.y * sr + ei[q];
      sr = nr; si = ni;
    }
  }
  __syncthreads();
}

DI float gelu_tanh(float x) {
  const float u = 0.7978845608028654f * (x + 0.044715f * x * x * x);
  return 0.5f * x * (1.f + tanhf(u));
}

DI void s5_out_tile(const Params& p, int j, char* smem) {
  const int nt = j & 3, mt = (j >> 2) % 9, g = j / 36;
  const bf16* SU = (const bf16*)(p.ws + OFF_SU);
  const bf16* SB = (const bf16*)(p.ws + OFF_SB);
  const bf16* Tm = (const bf16*)(p.ws + OFF_T5) + ((size_t)g * 512 + nt * 128) * 512;
  const bf16* Em = (const bf16*)(p.ws + OFF_E5) + ((size_t)g * 512 + nt * 128) * 256;
  f32x16 acc[2][2];
  acc_zero(acc);
  gemm_main_dma(acc,
            [&](int r) -> const bf16* {
              const int m = mt * 128 + r;
              if (m >= MS5) return (const bf16*)(p.ws + OFF_ZERO);
              const int b = m / NCH, ch = m - b * NCH;
              return SU + ((size_t)(b * 16 + g) * TT + ch * 32) * 16;
            },
            [&](int r) { return Tm + (size_t)r * 512; }, 512, smem);
  gemm_main_dma(acc,
            [&](int r) -> const bf16* {
              const int m = mt * 128 + r;
              if (m >= MS5) return (const bf16*)(p.ws + OFF_ZERO);
              return SB + ((size_t)m * 16 + g) * 256;
            },
            [&](int r) { return Em + (size_t)r * 256; }, 256, smem);
  float* Cs = (float*)smem;
  acc_to_lds(acc, Cs);
  __syncthreads();
  bf16* Y5 = (bf16*)(p.ws + OFF_Y5);
  for (int c = TIDX; c < 2048; c += 256) {
    const int row = c >> 4, c8 = c & 15, m = mt * 128 + row;
    if (m < MS5) {
      const int b = m / NCH, ch = m - b * NCH;
      const int n = nt * 128 + c8 * 8, i = n >> 4, hh = n & 15;
      const float* s = Cs + row * CLD + c8 * 8;
      u32x4 u;
#pragma unroll
      for (int e = 0; e < 4; ++e) u[e] = pack2(gelu_tanh(s[2 * e]), gelu_tanh(s[2 * e + 1]));
      *(u32x4*)(Y5 + ((size_t)b * TT + ch * 32 + i) * 256 + g * 16 + hh) = u;
    }
  }
  __syncthreads();
}

DI void glu_tile(const Params& p, int l, int j, char* smem) {
  const int nt = j & 1, mt = j >> 1;
  const bf16* Y5 = (const bf16*)(p.ws + OFF_Y5) + (size_t)mt * 128 * 256;
  const bf16* W = wl(p, l, WL_GLU) + (size_t)nt * 128 * 256;
  f32x16 acc[2][2];
  acc_zero(acc);
  gemm_main_dma(acc, [&](int r) { return Y5 + (size_t)r * 256; }, [&](int r) { return W + (size_t)r * 256; }, 256, smem);
  float* Cs = (float*)smem;
  acc_to_lds(acc, Cs);
  __syncthreads();
  const float* gb = p.in[I_GLUB] + l * 256 + nt * 128;
  bf16* O = (bf16*)(p.ws + OFF_OS5) + (size_t)mt * 128 * 256 + nt * 128;
  for (int c = TIDX; c < 2048; c += 256) {
    const int row = c >> 4, cc = (c & 15) * 8;
    const float* s = Cs + row * CLD + cc;
    const u32x4 yu = *(const u32x4*)(Y5 + (size_t)row * 256 + nt * 128 + cc);
    u32x4 u;
#pragma unroll
    for (int e = 0; e < 4; ++e) {
      const float y0 = bflo(yu[e]), y1 = bfhi(yu[e]);
      u[e] = pack2(y0 * sigmoidf_(s[2 * e] + gb[cc + 2 * e]), y1 * sigmoidf_(s[2 * e + 1] + gb[cc + 2 * e + 1]));
    }
    *(u32x4*)(O + (size_t)row * 256 + cc) = u;
  }
  __syncthreads();
}

DI void merge_tile(const Params& p, int l, int j, char* smem) {
  const int nt = j & 7, mt = j >> 3;
  const bf16* H = (const bf16*)(p.ws + OFF_H) + (size_t)mt * 128 * DM;
  unsigned am[2][2][8];
#pragma unroll
  for (int a = 0; a < 2; ++a)
#pragma unroll
    for (int bq = 0; bq < 2; ++bq)
#pragma unroll
      for (int i = 0; i < 8; ++i) am[a][bq][i] = 0u;
#pragma unroll 1
  for (int x = 0; x < 3; ++x) {
    const bf16* Wg = wl(p, l, WL_WIN) + ((size_t)2432 + x * 1024 + nt * 128) * DM;
    unsigned sg[2][2][8];
    {
      f32x16 acc[2][2];
      acc_zero(acc);
      gemm_main_dma(acc, [&](int r) { return H + (size_t)r * DM; }, [&](int r) { return Wg + (size_t)r * DM; }, DM, smem);
#pragma unroll
      for (int a = 0; a < 2; ++a)
#pragma unroll
        for (int bq = 0; bq < 2; ++bq)
#pragma unroll
          for (int i = 0; i < 8; ++i) sg[a][bq][i] = pack2(sigmoidf_(acc[a][bq][2 * i]), sigmoidf_(acc[a][bq][2 * i + 1]));
    }
    const bf16* A; const bf16* Wb; int K;
    if (x == 0) { A = (const bf16*)(p.ws + OFF_OATT) + (size_t)mt * 128 * 256; Wb = wl(p, l, WL_BRA) + (size_t)nt * 128 * 256; K = 256; }
    else if (x == 1) { A = (const bf16*)(p.ws + OFF_OGLA) + (size_t)mt * 128 * 512; Wb = wl(p, l, WL_BRG) + (size_t)nt * 128 * 512; K = 512; }
    else { A = (const bf16*)(p.ws + OFF_OS5) + (size_t)mt * 128 * 256; Wb = wl(p, l, WL_BRS) + (size_t)nt * 128 * 256; K = 256; }
#pragma unroll
    for (int hf = 0; hf < 2; ++hf) {
      f32x16 a2[2];
#pragma unroll
      for (int i = 0; i < 16; ++i) { a2[0][i] = 0.f; a2[1][i] = 0.f; }
      gemm_main_dma_half(a2, A, K, Wb, K, K, hf, smem);
#pragma unroll
      for (int a = 0; a < 2; ++a)
#pragma unroll
        for (int i = 0; i < 8; ++i) {
          const float v0 = bflo(am[a][hf][i]) + bflo(sg[a][hf][i]) * a2[a][2 * i];
          const float v1 = bfhi(am[a][hf][i]) + bfhi(sg[a][hf][i]) * a2[a][2 * i + 1];
          am[a][hf][i] = pack2(v0, v1);
        }
    }
  }
  f32x16 accm[2][2];
#pragma unroll
  for (int a = 0; a < 2; ++a)
#pragma unroll
    for (int bq = 0; bq < 2; ++bq)
#pragma unroll
      for (int i = 0; i < 8; ++i) { accm[a][bq][2 * i] = bflo(am[a][bq][i]); accm[a][bq][2 * i + 1] = bfhi(am[a][bq][i]); }
  float* Cs = (float*)smem;
  acc_to_lds(accm, Cs);
  __syncthreads();
  store_tile_bf16(Cs, (bf16*)(p.ws + OFF_MG) + (size_t)mt * 128 * DM + nt * 128, DM, 128, 1.f);
  __syncthreads();
}

DI void plain_tile(const bf16* A, int K, const bf16* W, bf16* dst, int ldd, char* smem) {
  f32x16 acc[2][2];
  acc_zero(acc);
  gemm_main_dma(acc, [&](int r) { return A + (size_t)r * K; }, [&](int r) { return W + (size_t)r * K; }, K, smem);
  float* Cs = (float*)smem;
  acc_to_lds(acc, Cs);
  __syncthreads();
  store_tile_bf16(Cs, dst, ldd, 128, 1.f);
  __syncthreads();
}

DI void plain_wide(const bf16* A, int K, const bf16* W, bf16* dst, int ldd, char* smem) {
  f32x16 acc[2][4];
  accw_zero(acc);
  gemm_wide(acc, [&](int r) { return A + (size_t)r * K; }, [&](int r) { return W + (size_t)r * K; }, K, smem);
  float* Cs = (float*)smem;
  accw_to_lds<0>(acc, Cs);
  __syncthreads();
  store_tile_bf16(Cs, dst, ldd, 128, 1.f);
  __syncthreads();
  accw_to_lds<1>(acc, Cs);
  __syncthreads();
  store_tile_bf16(Cs, dst + 128, ldd, 128, 1.f);
  __syncthreads();
}

DI void up_epi(const Params& p, int l, int jn, int seqbase, int len, int pos0, char* smem) {
  float* Cs = (float*)smem;
  const float* cw = p.in[I_CW] + (size_t)l * 3 * 2 * DFF;
  const float* cb = p.in[I_CB] + (size_t)l * 2 * DFF;
  bf16* G = (bf16*)(p.ws + OFF_G);
  const int tid = TIDX;
  const int c = (tid & 31) * 2;
  float wa[2][3], wv[2][3], ba[2], bv[2];
#pragma unroll
  for (int e = 0; e < 2; ++e) {
    const int ca = jn * 64 + c + e, cv = DFF + ca;
#pragma unroll
    for (int k = 0; k < 3; ++k) { wa[e][k] = cw[k * 2 * DFF + ca]; wv[e][k] = cw[k * 2 * DFF + cv]; }
    ba[e] = cb[ca]; bv[e] = cb[cv];
  }
#pragma unroll 4
  for (int rr = 1 + (tid >> 5); rr < 127; rr += 8) {
    const int pos = pos0 + rr;
    if (pos < len) {
      float gv[2];
#pragma unroll
      for (int e = 0; e < 2; ++e) {
        const float a = wa[e][0] * Cs[(rr - 1) * CLD + c + e] + wa[e][1] * Cs[rr * CLD + c + e] + wa[e][2] * Cs[(rr + 1) * CLD + c + e] + ba[e];
        const float v = wv[e][0] * Cs[(rr - 1) * CLD + 64 + c + e] + wv[e][1] * Cs[rr * CLD + 64 + c + e] +
                        wv[e][2] * Cs[(rr + 1) * CLD + 64 + c + e] + bv[e];
        gv[e] = siluf_(a) * v;
      }
      *(unsigned*)(G + (size_t)(seqbase + pos) * DFF + jn * 64 + c) = pack2(gv[0], gv[1]);
    }
  }
  __syncthreads();
}

DI void up_wide(const Params& p, int l, int mtile, int jp, char* smem) {
  const int b = mtile / 69, rr0 = mtile % 69;
  int seqbase, len, ti;
  if (rr0 < 3) { seqbase = b * TT; len = CTXL; ti = rr0; }
  else { seqbase = b * TT + CTXL; len = SEQ; ti = rr0 - 3; }
  const int pos0 = ti * 126 - 1;
  const bf16* H = (const bf16*)(p.ws + OFF_H);
  const bf16* W = wl(p, l, WL_UP) + (size_t)jp * 256 * DM;
  f32x16 acc[2][4];
  accw_zero(acc);
  gemm_wide(acc,
            [&](int r) -> const bf16* {
              const int pos = pos0 + r;
              return (pos >= 0 && pos < len) ? H + (size_t)(seqbase + pos) * DM : (const bf16*)(p.ws + OFF_ZERO);
            },
            [&](int r) { return W + (size_t)r * DM; }, DM, smem);
  float* Cs = (float*)smem;
  accw_to_lds<0>(acc, Cs);
  __syncthreads();
  up_epi(p, l, jp * 2, seqbase, len, pos0, smem);
  accw_to_lds<1>(acc, Cs);
  __syncthreads();
  up_epi(p, l, jp * 2 + 1, seqbase, len, pos0, smem);
}

DI bool gemm_job(int bid, int G, int it, int MT, int NTL, int& mt, int& nt, int CW = 8) {
  const int x = bid & 7, q = bid >> 3, Q = G >> 3;
  const int m0 = (x * MT) >> 3, m1 = ((x + 1) * MT) >> 3, Mx = m1 - m0;
  const int jl = q + Q * it;
  if (jl >= Mx * NTL) return false;
  const int full = Mx * CW;
  const int c = jl / full, rem = jl - c * full;
  const int wc = min(CW, NTL - CW * c);
  const int mi = rem / wc;
  mt = m0 + mi;
  nt = CW * c + (rem - mi * wc);
  return true;
}

enum { PH_PREP = 0, PH_ROW0, PH_PROJ, PH_MIX1, PH_SCAN, PH_MIX2, PH_GLU, PH_MERGE, PH_WOUT, PH_ROW1, PH_UP, PH_DOWN, PH_ROW2 };
constexpr int N_PHASES = 2 + 11 * NL;

DI void run_phase(const Params& p, int ph, int l, char* smem) {
  const int bid = blockIdx.x;
#ifdef HALFMASK
  const int G = ((HALFMASK >> ph) & 1) ? 256 : gridDim.x;
  if (bid >= G) return;
#else
  const int G = gridDim.x;
#endif
#ifdef PHMASK
  if (!((PHMASK >> ph) & 1)) return;
#endif
  switch (ph) {
    case PH_PREP:
      if (bid < 8) { for (int i = TIDX; i < 512; i += 256) ((u32x4*)(p.ws + OFF_ZERO))[i] = u32x4{0u, 0u, 0u, 0u}; }
      for (int j = bid; j < 128 + 4016; j += G) {
        if (j < 96) prep_mod_job(p, j, smem);
        else if (j < 128) prep_s5_job(p, j - 96);
        else prep_wt_job(p, j - 128, smem);
      }
      break;
    case PH_ROW0:
      row_phase<0>(p, 0, bid, G);
      ktab_phase(p, bid, G);
      break;
    case PH_PROJ:
#ifdef EXP_A
      if (bid < 256) { int mt, nt; for (int it = 0; gemm_job(bid, 256, it, 264, 10, mt, nt, 4); ++it) proj_wide(p, l, mt, nt, smem); }
      else if (l + 1 < NL) { for (int jj = (l + 1) * 4016 + (bid - 256); jj < (l + 2) * 4016; jj += G - 256) prep_wt_job(p, jj, smem); }
      s5mat_phase(p, l, bid, G);
#elif defined(EXP_C)
      if (bid < 256) for (int j = bid; j < 264 * 19; j += 256) { if ((EXP_C >> (j % 19)) & 1) proj_tile(p, l, j / 19, j % 19, smem); }
      for (int j = bid; j < 264 * 19; j += G) { if (!((EXP_C >> (j % 19)) & 1)) proj_tile(p, l, j / 19, j % 19, smem); }
      s5mat_phase(p, l, bid, G);
#elif defined(EXP_B)
      for (int j = bid; j < 264 * 19; j += G) proj_tile(p, l, j / 19, j % 19, smem);
      if (bid < 256) s5mat_phase(p, l, bid, 256);
#else
      for (int j = bid; j < 264 * 19; j += G) proj_tile(p, l, j / 19, j % 19, smem);
      s5mat_phase(p, l, bid, G);
#endif
      break;
    case PH_MIX1:
      for (int j = bid; j < 1056 + 1056 + 288; j += G) {
        if (j < 1056) attn_unit(p, j, smem);
        else if (j < 2112) gla_unit<false>(p, l, j - 1056, smem);
        else s5_end_tile(p, j - 2112, smem);
      }
      break;
    case PH_SCAN:
      for (int j = bid; j < 1024 + 128; j += G) {
        if (j < 1024) gla_scan_job(p, j);
        else s5_scan_job(p, l, j - 1024, smem);
      }
      break;
    case PH_MIX2:
      for (int j = bid; j < 528 + 576; j += G) {
        if (j < 528) gla_unit<true>(p, l, j, smem);
        else s5_out_tile(p, j - 528, smem);
      }
      break;
    case PH_GLU:
      { int mt, nt; for (int it = 0; gemm_job(bid, G, it, 264, 2, mt, nt); ++it) glu_tile(p, l, mt * 2 + nt, smem); }
      break;
    case PH_MERGE:
      { int mt, nt; for (int it = 0; gemm_job(bid, G, it, 264, 8, mt, nt); ++it) merge_tile(p, l, mt * 8 + nt, smem); }
      break;
    case PH_WOUT:
      for (int it = 0;; ++it) {
        int mt, nt;
        if (!gemm_job(bid, G, it, 264, 8, mt, nt)) break;
        plain_tile((const bf16*)(p.ws + OFF_MG) + (size_t)mt * 128 * DM, DM, wl(p, l, WL_WOUT) + (size_t)nt * 128 * DM,
                   (bf16*)(p.ws + OFF_H) + (size_t)mt * 128 * DM + nt * 128, DM, smem);
      }
      break;
    case PH_ROW1: row_phase<1>(p, l, bid, G); break;
    case PH_UP:
      { int mt, nt; for (int it = 0; gemm_job(bid, G, it, 276, 22, mt, nt, 4); ++it) up_wide(p, l, mt, nt, smem); }
      break;
    case PH_DOWN:
      for (int it = 0;; ++it) {
        int mt, nt;
        if (!gemm_job(bid, G, it, 264, 8, mt, nt)) break;
        plain_tile((const bf16*)(p.ws + OFF_G) + (size_t)mt * 128 * DFF, DFF, wl(p, l, WL_DOWN) + (size_t)nt * 128 * DFF,
                   (bf16*)(p.ws + OFF_H) + (size_t)mt * 128 * DM + nt * 128, DM, smem);
      }
      break;
    case PH_ROW2: row_phase<2>(p, l, bid, G); break;
  }
}

#define XB_TMO      128
#define XB_XCNT(j)  (256  + 64 * (j))
#define XB_XSUB(j)  (1280 + 64 * (j))
#define XB_XGEN(j)  (2304 + 64 * (j))
#define XB_TOP      3328
#define XB_TOPGEN   3392
#define XCD_BAR_WORDS 3456
#define XB_SPIN_CAP (1u << 18)
#define LAS __attribute__((address_space(3)))

__device__ __forceinline__ unsigned xb_ld(unsigned* p)              { return __hip_atomic_load(p, __ATOMIC_RELAXED, __HIP_MEMORY_SCOPE_AGENT); }
__device__ __forceinline__ unsigned xb_add(unsigned* p, unsigned v) { return __hip_atomic_fetch_add(p, v, __ATOMIC_RELAXED, __HIP_MEMORY_SCOPE_AGENT); }
__device__ __forceinline__ unsigned xb_xcc_id() { return (unsigned)__builtin_amdgcn_s_getreg((3 << 11) | 20) & 0xFu; }
#define XB_SPIN(cond, bar) do { unsigned _sp = 0; while (cond) { __builtin_amdgcn_s_sleep(1); \
    if ((++_sp & 255u) == 0u) { if (xb_ld(&(bar)[XB_TMO])) break; if (_sp > XB_SPIN_CAP) { atomicAdd(&(bar)[XB_TMO], 1u); break; } } } } while (0)

struct XcdBarrier {
    unsigned* bar; unsigned x;
    volatile LAS unsigned* st;
};

__device__ __forceinline__ XcdBarrier xcd_barrier_post(unsigned* bar, volatile LAS unsigned* st) {
    XcdBarrier b; b.bar = bar; b.x = xb_xcc_id(); b.st = st;
    if (threadIdx.x == 0) (void)xb_add(&bar[XB_XCNT(b.x)], 1u);
    return b;
}
__device__ __forceinline__ void xcd_barrier_complete(unsigned* bar, unsigned x, unsigned& nloc, unsigned& nx) {
    const unsigned G = gridDim.x * gridDim.y * gridDim.z;
    unsigned sum, cnt, mine, sp = 0u;
    for (;;) {
        sum = 0u; cnt = 0u; mine = 0u;
#pragma unroll
        for (unsigned j = 0; j < 16; ++j) { const unsigned c = xb_ld(&bar[XB_XCNT(j)]); sum += c; cnt += (c > 0u) ? 1u : 0u; mine = (j == x) ? c : mine; }
        if (sum == G) break;
        __builtin_amdgcn_s_sleep(1);
        if ((++sp & 255u) == 0u) { if (xb_ld(&bar[XB_TMO])) break; if (sp > XB_SPIN_CAP) { atomicAdd(&bar[XB_TMO], 1u); break; } }
    }
    nloc = mine > 0u ? mine : 1u; nx = cnt > 0u ? cnt : 1u;
}

__device__ __forceinline__ void xcd_barrier(const XcdBarrier& b) {
    asm volatile("s_waitcnt vmcnt(0)" ::: "memory");
    __syncthreads();
    if (threadIdx.x == 0) {
        unsigned* bar = b.bar;
        __builtin_amdgcn_s_waitcnt(0);
        unsigned nloc = b.st[0], nx = b.st[1];
        if (nloc == 0u) { xcd_barrier_complete(bar, b.x, nloc, nx); b.st[0] = nloc; b.st[1] = nx; }
        const unsigned old = xb_add(&bar[XB_XSUB(b.x)], 1u);
        const unsigned gen = old / nloc;
        if (old + 1u == (gen + 1u) * nloc) {
            __builtin_amdgcn_fence(__ATOMIC_RELEASE, "agent");
            asm volatile("s_waitcnt vmcnt(0)" ::: "memory");
            const unsigned og = xb_add(&bar[XB_TOP], 1u);
            const unsigned tg = og / nx;
            if (og + 1u == (tg + 1u) * nx) xb_add(&bar[XB_TOPGEN], 1u);
            else XB_SPIN(xb_ld(&bar[XB_TOPGEN]) == tg, bar);
            __builtin_amdgcn_fence(__ATOMIC_ACQUIRE, "agent");
            xb_add(&bar[XB_XGEN(b.x)], 1u);
            asm volatile("s_waitcnt vmcnt(0)" ::: "memory");
        } else {
            XB_SPIN(xb_ld(&bar[XB_XGEN(b.x)]) == gen, bar);
            __builtin_amdgcn_fence(__ATOMIC_ACQUIRE, "agent");
            asm volatile("s_waitcnt vmcnt(0)" ::: "memory");
        }
    }
    __syncthreads();
}


DI void grid_barrier(unsigned* bar, unsigned& gen) {
  asm volatile("s_waitcnt vmcnt(0)" ::: "memory");
  __syncthreads();
  gen += 1;
  if (threadIdx.x == 0) {
    __builtin_amdgcn_fence(__ATOMIC_RELEASE, "agent");
    asm volatile("s_waitcnt vmcnt(0)" ::: "memory");
    const unsigned target = gen * gridDim.x;
    __hip_atomic_fetch_add(bar, 1u, __ATOMIC_RELAXED, __HIP_MEMORY_SCOPE_AGENT);
    while (__hip_atomic_load(bar, __ATOMIC_RELAXED, __HIP_MEMORY_SCOPE_AGENT) < target) __builtin_amdgcn_s_sleep(2);
  }
  __syncthreads();
  __builtin_amdgcn_fence(__ATOMIC_ACQUIRE, "agent");
  asm volatile("s_waitcnt vmcnt(0)" ::: "memory");
}

__global__ void __launch_bounds__(256, 2) hybrid_fwd(Params p, int ph_lo, int ph_hi) {
  extern __shared__ __attribute__((aligned(16))) char smem[];
  unsigned* bar = (unsigned*)(p.ws + OFF_BAR);
  unsigned gen = 0;
  __shared__ uint4 xb_words;
  if (threadIdx.x == 0) xb_words = make_uint4(0u, 0u, 0u, 0u);
  __syncthreads();
  XcdBarrier xb = xcd_barrier_post(bar + 64, (volatile LAS unsigned*)&xb_words);
  if (ph_hi - ph_lo > 1) cg::this_grid().sync();
  int i = 0;
#define STEP(PH, L)                                      \
  {                                                      \
    if (i >= ph_lo && i < ph_hi) {                       \
      Params q;                                          \
      q.ws = p.ws; q.out = p.out;                        \
      asm volatile("" : "+s"(q.ws), "+s"(q.out));        \
      _Pragma("unroll") for (int k = 0; k < 34; ++k) { q.in[k] = p.in[k]; asm volatile("" : "+s"(q.in[k])); } \
      run_phase(q, PH, L, smem);                         \
      if ((DUPMASK >> (PH)) & 1) { xcd_barrier(xb); run_phase(q, PH, L, smem); } \
      if (i + 1 < ph_hi) xcd_barrier(xb);                \
    }                                                    \
    ++i;                                                 \
  }
  STEP(PH_PREP, 0)
  STEP(PH_ROW0, 0)
#pragma unroll 1
  for (int l = 0; l < NL; ++l) {
    STEP(PH_PROJ, l)
    STEP(PH_MIX1, l)
    STEP(PH_SCAN, l)
    STEP(PH_MIX2, l)
    STEP(PH_GLU, l)
    STEP(PH_MERGE, l)
    STEP(PH_WOUT, l)
    STEP(PH_ROW1, l)
    STEP(PH_UP, l)
    STEP(PH_DOWN, l)
    STEP(PH_ROW2, l)
  }
#undef STEP
}

extern "C" void kernel_launch(void* const* d_in, const int* in_sizes, int n_in, void* d_out, int out_size, void* d_ws, size_t ws_size,
                              hipStream_t stream) {
  static int grid_blocks = 0;
  if (!grid_blocks) {
    int dev = 0, cus = 0, per_cu = 0;
    hipGetDevice(&dev);
    hipDeviceGetAttribute(&cus, hipDeviceAttributeMultiprocessorCount, dev);
    hipFuncSetAttribute((const void*)hybrid_fwd, hipFuncAttributeMaxDynamicSharedMemorySize, SMEM_BYTES);
    hipOccupancyMaxActiveBlocksPerMultiprocessor(&per_cu, hybrid_fwd, 256, SMEM_BYTES);
    if (per_cu < 1) per_cu = 1;
    if (per_cu > 2) per_cu = 2;
    grid_blocks = cus * per_cu;
    if (ws_size < OFF_ZERO + 8192) fprintf(stderr, "workspace too small: %zu < %zu\n", ws_size, (size_t)OFF_END);
  }
  Params p{};
  for (int i = 0; i < 34; ++i) p.in[i] = (const float*)d_in[i];
  p.out = (float*)d_out;
  p.ws = (char*)d_ws;
#if ONE_LAUNCH
  hipMemsetAsync((char*)d_ws + OFF_BAR, 0, 16384, stream);
  int lo = 0, hi = N_PHASES;
  void* args[] = {&p, &lo, &hi};
  hipError_t e = hipLaunchCooperativeKernel((void*)hybrid_fwd, dim3(grid_blocks), dim3(256), args, SMEM_BYTES, stream);
  if (e != hipSuccess) fprintf(stderr, "cooperative launch failed: %s (grid %d)\n", hipGetErrorString(e), grid_blocks);
#else
  for (int i = 0; i < N_PHASES; ++i) hipLaunchKernelGGL(hybrid_fwd, dim3(grid_blocks), dim3(256), SMEM_BYTES, stream, p, i, i + 1);
#endif
}
```

```cpp
#include <hip/hip_runtime.h>
#include <hip/hip_cooperative_groups.h>
#include <stdint.h>
#include <cstdio>
namespace cg = cooperative_groups;

#define EXP_A 1
#ifndef DUPMASK
#define DUPMASK 0
#endif
#ifndef ONE_LAUNCH
#define ONE_LAUNCH 1
#endif

typedef unsigned short bf16;
typedef __attribute__((ext_vector_type(8))) short s16x8;
typedef __attribute__((ext_vector_type(4))) short s16x4;
typedef __attribute__((ext_vector_type(16))) float f32x16;
typedef __attribute__((ext_vector_type(4))) float f32x4;
typedef __attribute__((ext_vector_type(2))) float f32x2;
typedef __attribute__((ext_vector_type(4))) unsigned u32x4;
typedef __attribute__((ext_vector_type(2))) unsigned u32x2;
typedef __attribute__((ext_vector_type(2))) __bf16 bf16x2_t;

#define DI __device__ __forceinline__
#define MFMA32(a, b, c) __builtin_amdgcn_mfma_f32_32x32x16_bf16((a), (b), (c), 0, 0, 0)

DI int tidx_opaque() { int t = threadIdx.x; asm volatile("" : "+v"(t)); return t; }
#define TIDX tidx_opaque()
DI bf16 f2bf(float x) { return __builtin_bit_cast(unsigned short, (__bf16)x); }
DI float bf2f(bf16 v) { return __uint_as_float(((unsigned)v) << 16); }
DI unsigned pack2(float a, float b) {
  f32x2 v = {a, b};
  return __builtin_bit_cast(unsigned, __builtin_convertvector(v, bf16x2_t));
}
DI float bflo(unsigned u) { return __uint_as_float(u << 16); }
DI float bfhi(unsigned u) { return __uint_as_float(u & 0xffff0000u); }
typedef const __attribute__((address_space(1))) u32x4* gptr16;
DI u32x4 ldg16(const void* q) { return *(gptr16)(uintptr_t)q; }
#define SCHED_FENCE() __builtin_amdgcn_sched_barrier(0)
DI int crow(int i, int h) { return (i & 3) + 8 * (i >> 2) + 4 * h; }
DI void sincos_cw(float x, float& sn, float& cs) {
  const float k = rintf(x * 0.63661977236758134f);
  float r = fmaf(-k, 1.57079637050628662109375f, x);
  r = fmaf(-k, -4.371139000186241e-08f, r);
  const int q = ((int)k) & 3;
  const float r2 = r * r;
  const float sp = r + r * r2 * (-1.6666667163e-01f + r2 * (8.3333337680e-03f + r2 * (-1.9841270114e-04f + r2 * 2.7557314297e-06f)));
  const float cp = 1.f + r2 * (-0.5f + r2 * (4.1666667908e-02f + r2 * (-1.3888889225e-03f + r2 * (2.4801587642e-05f - r2 * 2.7557314297e-07f))));
  sn = (q == 0) ? sp : (q == 1) ? cp : (q == 2) ? -sp : -cp;
  cs = (q == 0) ? cp : (q == 1) ? -sp : (q == 2) ? -cp : sp;
}
DI float sigmoidf_(float x) { return 1.f / (1.f + __expf(-x)); }
DI float siluf_(float x) { return x / (1.f + __expf(-x)); }

constexpr int DM = 1024, NB = 4, SEQ = 8192, CTXL = 256, TT = SEQ + CTXL, NTOK = NB * TT, NL = 4;
constexpr int DFF = 2816, DIN = 5408;
constexpr float EPSF = 1e-6f;
constexpr int NG33 = 33;
constexpr int NCH = 264;
constexpr int MS5 = NB * NCH;

constexpr size_t SZ_H = (size_t)NTOK * 1024 * 2;
constexpr size_t OFF_H = 0;
constexpr size_t OFF_P = OFF_H + SZ_H;
constexpr size_t OFF_Q = OFF_P;
constexpr size_t OFF_K = OFF_Q + (size_t)NTOK * 256 * 2;
constexpr size_t OFF_VT = OFF_K + (size_t)NTOK * 128 * 2;
constexpr size_t OFF_GQ = OFF_VT + (size_t)NTOK * 128 * 2;
constexpr size_t OFF_GK = OFF_GQ + (size_t)NTOK * 256 * 2;
constexpr size_t OFF_GVT = OFF_GK + (size_t)NTOK * 256 * 2;
constexpr size_t OFF_GR = OFF_GVT + (size_t)NTOK * 512 * 2;
constexpr size_t OFF_SU = OFF_GR + (size_t)NTOK * 512 * 2;
constexpr size_t OFF_LOW = OFF_SU + (size_t)NTOK * 256 * 2;
constexpr size_t OFF_O = OFF_LOW + (size_t)NTOK * 32 * 4;
constexpr size_t OFF_OATT = OFF_O;
constexpr size_t OFF_OGLA = OFF_OATT + (size_t)NTOK * 256 * 2;
constexpr size_t OFF_Y5 = OFF_OGLA + (size_t)NTOK * 512 * 2;
constexpr size_t OFF_EN = OFF_Y5;
constexpr size_t OFF_OS5 = OFF_Y5 + (size_t)NTOK * 256 * 2;
constexpr size_t OFF_M = OFF_OS5 + (size_t)NTOK * 256 * 2;
constexpr size_t OFF_MG = OFF_M;
constexpr size_t OFF_GS = OFF_M;
constexpr size_t OFF_DECG = OFF_GS + (size_t)32 * 33 * 8192 * 4;
constexpr size_t OFF_SB = OFF_DECG + (size_t)32 * 33 * 64 * 4;
constexpr size_t OFF_T5 = OFF_SB + (size_t)MS5 * 16 * 256 * 2;
constexpr size_t OFF_E5 = OFF_T5 + (size_t)16 * 512 * 512 * 2;
constexpr size_t OFF_F5 = OFF_E5 + (size_t)16 * 512 * 256 * 2;
constexpr size_t OFF_MEND = OFF_F5 + (size_t)16 * 256 * 512 * 2;
static_assert(OFF_MEND <= OFF_M + SZ_H, "mixer scratch overflows merged area");
constexpr size_t OFF_W = OFF_M + SZ_H;
constexpr size_t WL_WIN = 0, WL_BRA = WL_WIN + (size_t)5504 * 1024, WL_BRG = WL_BRA + 1024 * 256, WL_BRS = WL_BRG + 1024 * 512,
                 WL_WOUT = WL_BRS + 1024 * 256, WL_UP = WL_WOUT + 1024 * 1024, WL_DOWN = WL_UP + (size_t)5632 * 1024,
                 WL_GLU = WL_DOWN + (size_t)1024 * 2816, WL_TOTAL = WL_GLU + 256 * 256;
constexpr size_t OFF_XC = OFF_W + WL_TOTAL * 2 * NL;
constexpr size_t OFF_MOD = OFF_XC + (size_t)NB * CTXL * 1024 * 4;
constexpr size_t OFF_BBR = OFF_MOD + (size_t)NL * 5 * 6144 * 4;
constexpr size_t OFF_BBI = OFF_BBR + (size_t)NL * 2 * 16 * 64 * 16 * 4;
constexpr size_t OFF_PWR = OFF_BBI + (size_t)NL * 2 * 16 * 64 * 16 * 4;
constexpr size_t OFF_KTAB = OFF_PWR + (size_t)NL * 2 * 16 * 33 * 64 * 8;
constexpr size_t OFF_END = OFF_KTAB + (size_t)NL * 16 * 2 * 32 * 256 * 4;
constexpr size_t OFF_BAR = OFF_END;
constexpr size_t OFF_ZERO = OFF_BAR + 16384;
constexpr size_t OFF_G = OFF_P;
static_assert((size_t)NTOK * DFF * 2 <= OFF_M - OFF_P, "G overflows");

constexpr int SMEM_BYTES = 73728;

struct Params {
  const float* in[34];
  float* out;
  char* ws;
};

enum { I_X = 0, I_C, I_CTX, I_CCTX, I_ADAW, I_ADAB, I_NMPRE, I_NMPOST, I_NFPRE, I_NFPOST, I_WIN, I_QN, I_KN, I_GGW, I_GGB, I_GON,
       I_ARE, I_AIM, I_LDT, I_BRE, I_BIM, I_CRE, I_CIM, I_S5D, I_GLUW, I_GLUB, I_WBA, I_WBG, I_WBS, I_WOUT, I_UP, I_CW, I_CB, I_DOWN };

constexpr int LDT = 72;
constexpr int CLD = 132;

template <class FA, class FB>
DI void gemm_main(f32x16 (&acc)[2][2], FA fa, FB fb, int K, char* smem) {
  bf16* As = (bf16*)smem;
  bf16* Bs = (bf16*)(smem + 2 * 128 * LDT * 2);
  const int tid = TIDX, lane = tid & 63, w = tid >> 6, wm = w >> 1, wn = w & 1;
  const int r = lane & 31, h = lane >> 5;
  const int lr = tid >> 3, kc = (tid & 7) * 8;
  const bf16* ap[4];
  const bf16* bp[4];
#pragma unroll
  for (int i = 0; i < 4; ++i) {
    const bf16* a = fa(lr + 32 * i);
    const bf16* b = fb(lr + 32 * i);
    ap[i] = a ? a + kc : nullptr;
    bp[i] = b ? b + kc : nullptr;
  }
  u32x4 ra[4], rb[4];
  const u32x4 z4 = {0u, 0u, 0u, 0u};
#pragma unroll
  for (int i = 0; i < 4; ++i) {
    ra[i] = ap[i] ? ldg16(ap[i]) : z4;
    rb[i] = bp[i] ? ldg16(bp[i]) : z4;
  }
#pragma unroll
  for (int i = 0; i < 4; ++i) {
    *(u32x4*)(As + (lr + 32 * i) * LDT + kc) = ra[i];
    *(u32x4*)(Bs + (lr + 32 * i) * LDT + kc) = rb[i];
  }
  __syncthreads();
  const int nk = K / 64;
  for (int kt = 0; kt < nk; ++kt) {
    const int buf = kt & 1;
    const bool more = (kt + 1 < nk);
    if (more) {
      const int k0 = (kt + 1) * 64;
#pragma unroll
      for (int i = 0; i < 4; ++i) {
        ra[i] = ap[i] ? ldg16(ap[i] + k0) : z4;
        rb[i] = bp[i] ? ldg16(bp[i] + k0) : z4;
      }
    }
    SCHED_FENCE();
    const bf16* Ab = As + buf * 128 * LDT + (wm * 64 + r) * LDT + h * 8;
    const bf16* Bb = Bs + buf * 128 * LDT + (wn * 64 + r) * LDT + h * 8;
#pragma unroll
    for (int s = 0; s < 4; ++s) {
      s16x8 a0 = *(const s16x8*)(Ab + s * 16);
      s16x8 a1 = *(const s16x8*)(Ab + 32 * LDT + s * 16);
      s16x8 b0 = *(const s16x8*)(Bb + s * 16);
      s16x8 b1 = *(const s16x8*)(Bb + 32 * LDT + s * 16);
      acc[0][0] = MFMA32(a0, b0, acc[0][0]);
      acc[0][1] = MFMA32(a0, b1, acc[0][1]);
      acc[1][0] = MFMA32(a1, b0, acc[1][0]);
      acc[1][1] = MFMA32(a1, b1, acc[1][1]);
    }
    SCHED_FENCE();
    if (more) {
      bf16* Aw = As + (buf ^ 1) * 128 * LDT;
      bf16* Bw = Bs + (buf ^ 1) * 128 * LDT;
#pragma unroll
      for (int i = 0; i < 4; ++i) {
        *(u32x4*)(Aw + (lr + 32 * i) * LDT + kc) = ra[i];
        *(u32x4*)(Bw + (lr + 32 * i) * LDT + kc) = rb[i];
      }
    }
    __syncthreads();
  }
}

template <class FA, class FB>
DI void gemm_main_deep(f32x16 (&acc)[2][2], FA fa, FB fb, int K, char* smem) {
  bf16* As = (bf16*)smem;
  bf16* Bs = (bf16*)(smem + 2 * 128 * LDT * 2);
  const int tid = TIDX, lane = tid & 63, w = tid >> 6, wm = w >> 1, wn = w & 1;
  const int r = lane & 31, h = lane >> 5;
  const int lr = tid >> 3, kc = (tid & 7) * 8;
  const bf16* ap[4];
  const bf16* bp[4];
#pragma unroll
  for (int i = 0; i < 4; ++i) {
    const bf16* a = fa(lr + 32 * i);
    const bf16* b = fb(lr + 32 * i);
    ap[i] = a ? a + kc : nullptr;
    bp[i] = b ? b + kc : nullptr;
  }
  const u32x4 z4 = {0u, 0u, 0u, 0u};
  u32x4 a0[4], b0[4], a1[4], b1[4];
  const int nk = K / 64;
#define GD_LOAD(RA, RB, T)                                               \
  {                                                                      \
    const int k0_ = (T) * 64;                                            \
    _Pragma("unroll") for (int i = 0; i < 4; ++i) {                      \
      RA[i] = ap[i] ? ldg16(ap[i] + k0_) : z4;                           \
      RB[i] = bp[i] ? ldg16(bp[i] + k0_) : z4;                           \
    }                                                                    \
  }
#define GD_STORE(RA, RB, BUF)                                            \
  {                                                                      \
    _Pragma("unroll") for (int i = 0; i < 4; ++i) {                      \
      *(u32x4*)(As + (BUF) * 128 * LDT + (lr + 32 * i) * LDT + kc) = RA[i]; \
      *(u32x4*)(Bs + (BUF) * 128 * LDT + (lr + 32 * i) * LDT + kc) = RB[i]; \
    }                                                                    \
  }
#define GD_COMPUTE(BUF)                                                  \
  {                                                                      \
    const bf16* Ab = As + (BUF) * 128 * LDT + (wm * 64 + r) * LDT + h * 8; \
    const bf16* Bb = Bs + (BUF) * 128 * LDT + (wn * 64 + r) * LDT + h * 8; \
    _Pragma("unroll") for (int s = 0; s < 4; ++s) {                      \
      s16x8 fa0 = *(const s16x8*)(Ab + s * 16);                          \
      s16x8 fa1 = *(const s16x8*)(Ab + 32 * LDT + s * 16);               \
      s16x8 fb0 = *(const s16x8*)(Bb + s * 16);                          \
      s16x8 fb1 = *(const s16x8*)(Bb + 32 * LDT + s * 16);               \
      acc[0][0] = MFMA32(fa0, fb0, acc[0][0]);                           \
      acc[0][1] = MFMA32(fa0, fb1, acc[0][1]);                           \
      acc[1][0] = MFMA32(fa1, fb0, acc[1][0]);                           \
      acc[1][1] = MFMA32(fa1, fb1, acc[1][1]);                           \
    }                                                                    \
  }
  GD_LOAD(a0, b0, 0)
  GD_LOAD(a1, b1, 1)
  GD_STORE(a0, b0, 0)
  __syncthreads();
  if (nk > 2) GD_LOAD(a0, b0, 2)
  for (int kt = 0; kt < nk; kt += 2) {
    SCHED_FENCE();
    GD_COMPUTE(0)
    SCHED_FENCE();
    GD_STORE(a1, b1, 1)
    if (kt + 3 < nk) GD_LOAD(a1, b1, kt + 3)
    __syncthreads();
    SCHED_FENCE();
    GD_COMPUTE(1)
    SCHED_FENCE();
    if (kt + 2 < nk) {
      GD_STORE(a0, b0, 0)
      if (kt + 4 < nk) GD_LOAD(a0, b0, kt + 4)
    }
    __syncthreads();
  }
#undef GD_LOAD
#undef GD_STORE
#undef GD_COMPUTE
}

template <class FA, class FB>
DI void gemm_main_dma(f32x16 (&acc)[2][2], FA fa, FB fb, int K, char* smem) {
  char* As = smem;
  char* Bs = smem + 32768;
  const int tid = TIDX, lane = tid & 63, w = tid >> 6, wm = w >> 1, wn = w & 1;
  const int r = lane & 31, h = lane >> 5;
  const bf16* ap[4];
  const bf16* bp[4];
#pragma unroll
  for (int i = 0; i < 4; ++i) {
    const int row = w * 32 + i * 8 + (lane >> 3);
    const int c = (lane & 7) ^ ((row >> 1) & 7);
    ap[i] = fa(row) + c * 8;
    bp[i] = fb(row) + c * 8;
  }
  const int ldst = (w * 256 + lane) * 16;
#define GM_DMA(BUF, T)                                                                                        \
  {                                                                                                           \
    const int k0_ = (T) * 64;                                                                                 \
    _Pragma("unroll") for (int i = 0; i < 4; ++i) {                                                           \
      __builtin_amdgcn_global_load_lds((const unsigned*)(ap[i] + k0_), (unsigned*)(As + (BUF) * 16384 + ldst + i * 1024), 16, 0, 0); \
      __builtin_amdgcn_global_load_lds((const unsigned*)(bp[i] + k0_), (unsigned*)(Bs + (BUF) * 16384 + ldst + i * 1024), 16, 0, 0); \
    }                                                                                                         \
  }
  const int xr = (r >> 1) & 7;
  const int arow = (wm * 64 + r) * 128, brow = (wn * 64 + r) * 128;
  GM_DMA(0, 0)
  asm volatile("s_waitcnt vmcnt(0)" ::: "memory");
  __syncthreads();
  const int nk = K / 64;
  for (int kt = 0; kt < nk; ++kt) {
    const int buf = kt & 1;
    if (kt + 1 < nk) GM_DMA(buf ^ 1, kt + 1)
    const char* Ab = As + buf * 16384 + arow;
    const char* Bb = Bs + buf * 16384 + brow;
#pragma unroll
    for (int s = 0; s < 4; ++s) {
      const int co = ((2 * s + h) ^ xr) * 16;
      s16x8 a0 = *(const s16x8*)(Ab + co);
      s16x8 a1 = *(const s16x8*)(Ab + 32 * 128 + co);
      s16x8 b0 = *(const s16x8*)(Bb + co);
      s16x8 b1 = *(const s16x8*)(Bb + 32 * 128 + co);
      acc[0][0] = MFMA32(a0, b0, acc[0][0]);
      acc[0][1] = MFMA32(a0, b1, acc[0][1]);
      acc[1][0] = MFMA32(a1, b0, acc[1][0]);
      acc[1][1] = MFMA32(a1, b1, acc[1][1]);
    }
    asm volatile("s_waitcnt vmcnt(0)" ::: "memory");
    __syncthreads();
  }
#undef GM_DMA
}

DI void gemm_main_dma_half(f32x16 (&acc)[2], const bf16* A, int lda, const bf16* B, int ldb, int K, int hf, char* smem) {
  char* As = smem;
  char* Bs = smem + 32768;
  const int tid = TIDX, lane = tid & 63, w = tid >> 6, wm = w >> 1, wn = w & 1;
  const int r = lane & 31, h = lane >> 5;
  const bf16* ap[4];
  const bf16* bp[2];
#pragma unroll
  for (int i = 0; i < 4; ++i) {
    const int row = w * 32 + i * 8 + (lane >> 3);
    ap[i] = A + (size_t)row * lda + ((lane & 7) ^ ((row >> 1) & 7)) * 8;
  }
#pragma unroll
  for (int i = 0; i < 2; ++i) {
    const int lrow = w * 16 + i * 8 + (lane >> 3);
    const int grow = (lrow >> 5) * 64 + hf * 32 + (lrow & 31);
    bp[i] = B + (size_t)grow * ldb + ((lane & 7) ^ ((lrow >> 1) & 7)) * 8;
  }
  const int lda_ = (w * 256 + lane) * 16, ldb_ = (w * 128 + lane) * 16;
#define GH_DMA(BUF, T)                                                                                        \
  {                                                                                                           \
    const int k0_ = (T) * 64;                                                                                 \
    _Pragma("unroll") for (int i = 0; i < 4; ++i)                                                             \
      __builtin_amdgcn_global_load_lds((const unsigned*)(ap[i] + k0_), (unsigned*)(As + (BUF) * 16384 + lda_ + i * 1024), 16, 0, 0); \
    _Pragma("unroll") for (int i = 0; i < 2; ++i)                                                             \
      __builtin_amdgcn_global_load_lds((const unsigned*)(bp[i] + k0_), (unsigned*)(Bs + (BUF) * 8192 + ldb_ + i * 1024), 16, 0, 0); \
  }
  const int xr = (r >> 1) & 7;
  const int arow = (wm * 64 + r) * 128, brow = (wn * 32 + r) * 128;
  GH_DMA(0, 0)
  asm volatile("s_waitcnt vmcnt(0)" ::: "memory");
  __syncthreads();
  const int nk = K / 64;
  for (int kt = 0; kt < nk; ++kt) {
    const int buf = kt & 1;
    if (kt + 1 < nk) GH_DMA(buf ^ 1, kt + 1)
    const char* Ab = As + buf * 16384 + arow;
    const char* Bb = Bs + buf * 8192 + brow;
#pragma unroll
    for (int s = 0; s < 4; ++s) {
      const int co = ((2 * s + h) ^ xr) * 16;
      s16x8 a0 = *(const s16x8*)(Ab + co);
      s16x8 a1 = *(const s16x8*)(Ab + 32 * 128 + co);
      s16x8 b0 = *(const s16x8*)(Bb + co);
      acc[0] = MFMA32(a0, b0, acc[0]);
      acc[1] = MFMA32(a1, b0, acc[1]);
    }
    asm volatile("s_waitcnt vmcnt(0)" ::: "memory");
    __syncthreads();
  }
#undef GH_DMA
}

template <class FA, class FB>
DI void gemm_wide(f32x16 (&acc)[2][4], FA fa, FB fb, int K, char* smem) {
  const int tid = TIDX, lane = tid & 63, w = tid >> 6, wm = w >> 1, wn = w & 1;
  const int r = lane & 31, h = lane >> 5;
  const bf16* ap[2];
  const bf16* bp[4];
#pragma unroll
  for (int i = 0; i < 2; ++i) {
    const int row = w * 32 + i * 16 + (lane >> 2);
    ap[i] = fa(row) + ((lane & 3) ^ ((row >> 2) & 3)) * 8;
  }
#pragma unroll
  for (int i = 0; i < 4; ++i) {
    const int row = w * 64 + i * 16 + (lane >> 2);
    bp[i] = fb(row) + ((lane & 3) ^ ((row >> 2) & 3)) * 8;
  }
  const int lda_ = (w * 128 + lane) * 16;
  const int ldb_ = 8192 + (w * 256 + lane) * 16;
#define GW_DMA(T)                                                                                                   \
  {                                                                                                                 \
    char* st_ = smem + ((T) % 3) * 24576;                                                                           \
    const int k0_ = (T) * 32;                                                                                       \
    _Pragma("unroll") for (int i = 0; i < 2; ++i)                                                                   \
      __builtin_amdgcn_global_load_lds((const unsigned*)(ap[i] + k0_), (unsigned*)(st_ + lda_ + i * 1024), 16, 0, 0); \
    _Pragma("unroll") for (int i = 0; i < 4; ++i)                                                                   \
      __builtin_amdgcn_global_load_lds((const unsigned*)(bp[i] + k0_), (unsigned*)(st_ + ldb_ + i * 1024), 16, 0, 0); \
  }
  const int xr = (r >> 2) & 3;
  const int arow = (wm * 64 + r) * 64;
  const int brow = 8192 + (wn * 64 + r) * 64;
  const int nt = K / 32;
  GW_DMA(0)
  if (nt > 1) GW_DMA(1)
  for (int t = 0; t < nt; ++t) {
    if (t + 1 < nt) asm volatile("s_waitcnt vmcnt(6)" ::: "memory");
    else asm volatile("s_waitcnt vmcnt(0)" ::: "memory");
    __syncthreads();
    if (t + 2 < nt) GW_DMA(t + 2)
    const char* st = smem + (t % 3) * 24576;
#pragma unroll
    for (int s = 0; s < 2; ++s) {
      const int co = ((2 * s + h) ^ xr) * 16;
      const s16x8 a0 = *(const s16x8*)(st + arow + co);
      const s16x8 a1 = *(const s16x8*)(st + arow + 32 * 64 + co);
#pragma unroll
      for (int hn = 0; hn < 2; ++hn) {
        const s16x8 b0 = *(const s16x8*)(st + brow + hn * 128 * 64 + co);
        const s16x8 b1 = *(const s16x8*)(st + brow + hn * 128 * 64 + 32 * 64 + co);
        acc[0][hn * 2 + 0] = MFMA32(a0, b0, acc[0][hn * 2 + 0]);
        acc[0][hn * 2 + 1] = MFMA32(a0, b1, acc[0][hn * 2 + 1]);
        acc[1][hn * 2 + 0] = MFMA32(a1, b0, acc[1][hn * 2 + 0]);
        acc[1][hn * 2 + 1] = MFMA32(a1, b1, acc[1][hn * 2 + 1]);
      }
    }
  }
  __syncthreads();
#undef GW_DMA
}

DI void accw_zero(f32x16 (&acc)[2][4]) {
#pragma unroll
  for (int a = 0; a < 2; ++a)
#pragma unroll
    for (int b = 0; b < 4; ++b)
#pragma unroll
      for (int i = 0; i < 16; ++i) acc[a][b][i] = 0.f;
}

DI void gemm_main_s(f32x16 (&acc)[2][2], const bf16* A, int lda, const bf16* B, int ldb, int K, char* smem) {
  bf16* As = (bf16*)smem;
  bf16* Bs = (bf16*)(smem + 2 * 128 * LDT * 2);
  const int tid = TIDX, lane = tid & 63, w = tid >> 6, wm = w >> 1, wn = w & 1;
  const int r = lane & 31, h = lane >> 5;
  const int lr = tid >> 3, kc = (tid & 7) * 8;
  const bf16* ap = A + (size_t)lr * lda + kc;
  const bf16* bp = B + (size_t)lr * ldb + kc;
  const size_t sa = (size_t)32 * lda, sb = (size_t)32 * ldb;
  u32x4 ra[4], rb[4];
#pragma unroll
  for (int i = 0; i < 4; ++i) {
    ra[i] = ldg16(ap + i * sa);
    rb[i] = ldg16(bp + i * sb);
  }
#pragma unroll
  for (int i = 0; i < 4; ++i) {
    *(u32x4*)(As + (lr + 32 * i) * LDT + kc) = ra[i];
    *(u32x4*)(Bs + (lr + 32 * i) * LDT + kc) = rb[i];
  }
  __syncthreads();
  const int nk = K / 64;
  for (int kt = 0; kt < nk; ++kt) {
    const int buf = kt & 1;
    const bool more = (kt + 1 < nk);
    if (more) {
      ap += 64; bp += 64;
#pragma unroll
      for (int i = 0; i < 4; ++i) {
        ra[i] = ldg16(ap + i * sa);
        rb[i] = ldg16(bp + i * sb);
      }
    }
    SCHED_FENCE();
    const bf16* Ab = As + buf * 128 * LDT + (wm * 64 + r) * LDT + h * 8;
    const bf16* Bb = Bs + buf * 128 * LDT + (wn * 64 + r) * LDT + h * 8;
#pragma unroll
    for (int s = 0; s < 4; ++s) {
      s16x8 a0 = *(const s16x8*)(Ab + s * 16);
      s16x8 a1 = *(const s16x8*)(Ab + 32 * LDT + s * 16);
      s16x8 b0 = *(const s16x8*)(Bb + s * 16);
      s16x8 b1 = *(const s16x8*)(Bb + 32 * LDT + s * 16);
      acc[0][0] = MFMA32(a0, b0, acc[0][0]);
      acc[0][1] = MFMA32(a0, b1, acc[0][1]);
      acc[1][0] = MFMA32(a1, b0, acc[1][0]);
      acc[1][1] = MFMA32(a1, b1, acc[1][1]);
    }
    SCHED_FENCE();
    if (more) {
      bf16* Aw = As + (buf ^ 1) * 128 * LDT;
      bf16* Bw = Bs + (buf ^ 1) * 128 * LDT;
#pragma unroll
      for (int i = 0; i < 4; ++i) {
        *(u32x4*)(Aw + (lr + 32 * i) * LDT + kc) = ra[i];
        *(u32x4*)(Bw + (lr + 32 * i) * LDT + kc) = rb[i];
      }
    }
    __syncthreads();
  }
}

DI void gemm_main_half(f32x16 (&acc)[2], const bf16* A, int lda, const bf16* B, int ldb, int K, int hf, char* smem) {
  bf16* As = (bf16*)smem;
  bf16* Bs = (bf16*)(smem + 2 * 128 * LDT * 2);
  const int tid = TIDX, lane = tid & 63, w = tid >> 6, wm = w >> 1, wn = w & 1;
  const int r = lane & 31, h = lane >> 5;
  const int lr = tid >> 3, kc = (tid & 7) * 8;
  const bf16* ap = A + (size_t)lr * lda + kc;
  const bf16* bp = B + (size_t)(hf * 32 + lr) * ldb + kc;
  const size_t sa = (size_t)32 * lda, sb = (size_t)64 * ldb;
  u32x4 ra[4], rb[2];
#pragma unroll
  for (int i = 0; i < 4; ++i) ra[i] = ldg16(ap + i * sa);
#pragma unroll
  for (int i = 0; i < 2; ++i) rb[i] = ldg16(bp + i * sb);
#pragma unroll
  for (int i = 0; i < 4; ++i) *(u32x4*)(As + (lr + 32 * i) * LDT + kc) = ra[i];
#pragma unroll
  for (int i = 0; i < 2; ++i) *(u32x4*)(Bs + (lr + 32 * i) * LDT + kc) = rb[i];
  __syncthreads();
  const int nk = K / 64;
  for (int kt = 0; kt < nk; ++kt) {
    const int buf = kt & 1;
    const bool more = (kt + 1 < nk);
    if (more) {
      ap += 64; bp += 64;
#pragma unroll
      for (int i = 0; i < 4; ++i) ra[i] = ldg16(ap + i * sa);
#pragma unroll
      for (int i = 0; i < 2; ++i) rb[i] = ldg16(bp + i * sb);
    }
    SCHED_FENCE();
    const bf16* Ab = As + buf * 128 * LDT + (wm * 64 + r) * LDT + h * 8;
    const bf16* Bb = Bs + buf * 128 * LDT + (wn * 32 + r) * LDT + h * 8;
#pragma unroll
    for (int s = 0; s < 4; ++s) {
      s16x8 a0 = *(const s16x8*)(Ab + s * 16);
      s16x8 a1 = *(const s16x8*)(Ab + 32 * LDT + s * 16);
      s16x8 b0 = *(const s16x8*)(Bb + s * 16);
      acc[0] = MFMA32(a0, b0, acc[0]);
      acc[1] = MFMA32(a1, b0, acc[1]);
    }
    SCHED_FENCE();
    if (more) {
      bf16* Aw = As + (buf ^ 1) * 128 * LDT;
      bf16* Bw = Bs + (buf ^ 1) * 128 * LDT;
#pragma unroll
      for (int i = 0; i < 4; ++i) *(u32x4*)(Aw + (lr + 32 * i) * LDT + kc) = ra[i];
#pragma unroll
      for (int i = 0; i < 2; ++i) *(u32x4*)(Bw + (lr + 32 * i) * LDT + kc) = rb[i];
    }
    __syncthreads();
  }
}

DI void acc_zero(f32x16 (&acc)[2][2]) {
#pragma unroll
  for (int a = 0; a < 2; ++a)
#pragma unroll
    for (int b = 0; b < 2; ++b)
#pragma unroll
      for (int i = 0; i < 16; ++i) acc[a][b][i] = 0.f;
}

DI void acc_to_lds(const f32x16 (&acc)[2][2], float* Cs) {
  const int lane = TIDX & 63, w = TIDX >> 6, wm = w >> 1, wn = w & 1, r = lane & 31, h = lane >> 5;
#pragma unroll
  for (int tm = 0; tm < 2; ++tm)
#pragma unroll
    for (int tn = 0; tn < 2; ++tn)
#pragma unroll
      for (int i = 0; i < 16; ++i) Cs[(wm * 64 + tm * 32 + crow(i, h)) * CLD + wn * 64 + tn * 32 + r] = acc[tm][tn][i];
}

template <int HN>
DI void accw_to_lds(const f32x16 (&acc)[2][4], float* Cs) {
  const int lane = TIDX & 63, w = TIDX >> 6, wm = w >> 1, wn = w & 1, r = lane & 31, h = lane >> 5;
#pragma unroll
  for (int tm = 0; tm < 2; ++tm)
#pragma unroll
    for (int tn = 0; tn < 2; ++tn)
#pragma unroll
      for (int i = 0; i < 16; ++i) Cs[(wm * 64 + tm * 32 + crow(i, h)) * CLD + wn * 64 + tn * 32 + r] = acc[tm][HN * 2 + tn][i];
}

DI void store_tile_bf16(const float* Cs, bf16* dst, size_t ld, int mvalid, float scale) {
  for (int c = TIDX; c < 2048; c += 256) {
    const int row = c >> 4, cc = (c & 15) * 8;
    if (row < mvalid) {
      const float* s = Cs + row * CLD + cc;
      u32x4 v;
      v[0] = pack2(s[0] * scale, s[1] * scale);
      v[1] = pack2(s[2] * scale, s[3] * scale);
      v[2] = pack2(s[4] * scale, s[5] * scale);
      v[3] = pack2(s[6] * scale, s[7] * scale);
      *(u32x4*)(dst + (size_t)row * ld + cc) = v;
    }
  }
}

DI float* resid_row(const Params& p, int tok) {
  const int b = tok / TT, t = tok - b * TT;
  return (t < CTXL) ? (float*)(p.ws + OFF_XC) + ((size_t)b * CTXL + t) * DM : p.out + ((size_t)b * SEQ + (t - CTXL)) * DM;
}
DI const float* mod_vec(const Params& p, int l, int tok, int which) {
  const int b = tok / TT, t = tok - b * TT;
  const int m = (t < CTXL) ? 4 : b;
  return (const float*)(p.ws + OFF_MOD) + ((size_t)(l * 5 + m) * 6 + which) * DM;
}
DI float wave_sum(float v) {
#pragma unroll
  for (int o = 32; o >= 1; o >>= 1) v += __shfl_xor(v, o, 64);
  return v;
}
DI bf16* wl(const Params& p, int l, size_t off) { return (bf16*)(p.ws + OFF_W) + (size_t)l * WL_TOTAL + off; }

DI void prep_mod_job(const Params& p, int j, char* smem) {
  float* sc = (float*)smem;
  float* part = (float*)(smem + 20480);
  const int l = j / 24, nb = j % 24, tid = TIDX, lane = tid & 63, w = tid >> 6;
  for (int idx = tid; idx < 5120; idx += 256) {
    const int m = idx >> 10, k = idx & 1023;
    const float v = (m < 4) ? p.in[I_C][m * 1024 + k] : p.in[I_CCTX][k];
    sc[idx] = siluf_(v);
  }
  __syncthreads();
  const float* W = p.in[I_ADAW] + (size_t)l * 1024 * 6144 + nb * 256 + lane;
  float a[5][4];
#pragma unroll
  for (int m = 0; m < 5; ++m)
#pragma unroll
    for (int c = 0; c < 4; ++c) a[m][c] = 0.f;
#pragma unroll 4
  for (int kk = 0; kk < 256; ++kk) {
    const int k = w * 256 + kk;
    float wv[4];
#pragma unroll
    for (int c = 0; c < 4; ++c) wv[c] = W[(size_t)k * 6144 + 64 * c];
#pragma unroll
    for (int m = 0; m < 5; ++m) {
      const float sv = sc[m * 1024 + k];
#pragma unroll
      for (int c = 0; c < 4; ++c) a[m][c] += sv * wv[c];
    }
  }
#pragma unroll
  for (int m = 0; m < 5; ++m)
#pragma unroll
    for (int c = 0; c < 4; ++c) part[(w * 5 + m) * 256 + lane + 64 * c] = a[m][c];
  __syncthreads();
  const int n = nb * 256 + tid;
  const float bb = p.in[I_ADAB][l * 6144 + n];
  float* M = (float*)(p.ws + OFF_MOD) + (size_t)l * 5 * 6144 + n;
#pragma unroll
  for (int m = 0; m < 5; ++m)
    M[m * 6144] = part[(0 * 5 + m) * 256 + tid] + part[(1 * 5 + m) * 256 + tid] + part[(2 * 5 + m) * 256 + tid] + part[(3 * 5 + m) * 256 + tid] + bb;
  __syncthreads();
}

DI void prep_s5_job(const Params& p, int j) {
  const int idx = j * 256 + TIDX;
  const int ldg = idx >> 6, pp = idx & 63;
  const float dt = expf(p.in[I_LDT][ldg]);
  const float are = p.in[I_ARE][idx], aim = p.in[I_AIM][idx];
  const float mag = expf(are * dt);
  float sn, cs;
  sincos_cw(aim * dt, sn, cs);
  const float abr = mag * cs, abi = mag * sn;
  const float den = are * are + aim * aim;
  const float fre = ((abr - 1.f) * are + abi * aim) / den;
  const float fim = (abi * are - (abr - 1.f) * aim) / den;
  float* BBR = (float*)(p.ws + OFF_BBR);
  float* BBI = (float*)(p.ws + OFF_BBI);
  for (int hh = 0; hh < 16; ++hh) {
    const float br = p.in[I_BRE][(size_t)idx * 16 + hh], bi = p.in[I_BIM][(size_t)idx * 16 + hh];
    BBR[(size_t)idx * 16 + hh] = fre * br - fim * bi;
    BBI[(size_t)idx * 16 + hh] = fre * bi + fim * br;
  }
  float2* PW = (float2*)(p.ws + OFF_PWR);
  float pr = 1.f, pi = 0.f;
  for (int tau = 0; tau <= 32; ++tau) {
    PW[((size_t)ldg * 33 + tau) * 64 + pp] = make_float2(pr, pi);
    const float nr = pr * abr - pi * abi, ni = pr * abi + pi * abr;
    pr = nr; pi = ni;
  }
}

DI void prep_wt_job(const Params& p, int jj, char* smem) {
  float* tile = (float*)smem;
  const int l = jj / 4016;
  int r = jj % 4016;
  int mat = 0;
  const int cnt[8] = {1376, 64, 128, 64, 256, 1408, 704, 16};
#pragma unroll
  for (int m = 0; m < 8; ++m) {
    if (mat == m && r >= cnt[m]) { r -= cnt[m]; mat = m + 1; }
  }
  const float* src; int K, sld; size_t doff;
  switch (mat) {
    case 0: src = p.in[I_WIN] + (size_t)l * 1024 * DIN; K = 1024; sld = DIN; doff = WL_WIN; break;
    case 1: src = p.in[I_WBA] + (size_t)l * 256 * 1024; K = 256; sld = 1024; doff = WL_BRA; break;
    case 2: src = p.in[I_WBG] + (size_t)l * 512 * 1024; K = 512; sld = 1024; doff = WL_BRG; break;
    case 3: src = p.in[I_WBS] + (size_t)l * 256 * 1024; K = 256; sld = 1024; doff = WL_BRS; break;
    case 4: src = p.in[I_WOUT] + (size_t)l * 1024 * 1024; K = 1024; sld = 1024; doff = WL_WOUT; break;
    case 5: src = p.in[I_UP] + (size_t)l * 1024 * 5632; K = 1024; sld = 5632; doff = WL_UP; break;
    case 6: src = p.in[I_DOWN] + (size_t)l * 2816 * 1024; K = 2816; sld = 1024; doff = WL_DOWN; break;
    default: src = p.in[I_GLUW] + (size_t)l * 256 * 256; K = 256; sld = 256; doff = WL_GLU; break;
  }
  const int kt = K / 64;
  const int n0 = (r / kt) * 64, k0 = (r % kt) * 64;
  const int tid = TIDX;
  {
    const int nn = tid & 63;
    const int np = n0 + nn;
    int col;
    if (mat == 0) {
      if (np < 2048) col = np;
      else if (np < 2304) col = 2080 + (np - 2048);
      else if (np < 2336) col = 2048 + (np - 2304);
      else if (np < 2432) col = -1;
      else col = 2336 + (np - 2432);
    } else if (mat == 5) {
      const int jb = np >> 7, c = np & 127;
      col = (c < 64) ? (jb * 64 + c) : (DFF + jb * 64 + (c - 64));
    } else col = np;
#pragma unroll 4
    for (int kk = tid >> 6; kk < 64; kk += 4) tile[kk * 65 + nn] = (col >= 0) ? src[(size_t)(k0 + kk) * sld + col] : 0.f;
  }
  __syncthreads();
  {
    const int nn = tid >> 2, kq = (tid & 3) * 16;
    bf16* d = wl(p, l, doff) + (size_t)(n0 + nn) * K + k0 + kq;
    u32x4 v0, v1;
#pragma unroll
    for (int e = 0; e < 4; ++e) {
      v0[e] = pack2(tile[(kq + 2 * e) * 65 + nn], tile[(kq + 2 * e + 1) * 65 + nn]);
      v1[e] = pack2(tile[(kq + 8 + 2 * e) * 65 + nn], tile[(kq + 8 + 2 * e + 1) * 65 + nn]);
    }
    *(u32x4*)d = v0;
    *(u32x4*)(d + 8) = v1;
  }
  __syncthreads();
}

template <int MODE>
DI void row_job(const Params& p, int l, int tok) {
  const int lane = TIDX & 63;
  float x[16];
  float* xr = resid_row(p, tok);
  if (MODE == 0) {
    const int b = tok / TT, t = tok - b * TT;
    const float* src = (t < CTXL) ? p.in[I_CTX] + ((size_t)b * CTXL + t) * DM : p.in[I_X] + ((size_t)b * SEQ + (t - CTXL)) * DM;
#pragma unroll
    for (int i = 0; i < 4; ++i) {
      const f32x4 v = *(const f32x4*)(src + lane * 4 + 256 * i);
      x[4 * i] = v[0]; x[4 * i + 1] = v[1]; x[4 * i + 2] = v[2]; x[4 * i + 3] = v[3];
      *(f32x4*)(xr + lane * 4 + 256 * i) = v;
    }
  } else {
    const bf16* yr = (const bf16*)(p.ws + OFF_H) + (size_t)tok * DM;
    const float* gpost = p.in[MODE == 1 ? I_NMPOST : I_NFPOST] + l * DM;
    const float* mg = mod_vec(p, l, tok, MODE == 1 ? 2 : 5);
    float y[16];
    float ss = 0.f;
#pragma unroll
    for (int i = 0; i < 4; ++i) {
      const u32x2 u = *(const u32x2*)(yr + lane * 4 + 256 * i);
      y[4 * i] = bflo(u[0]); y[4 * i + 1] = bfhi(u[0]); y[4 * i + 2] = bflo(u[1]); y[4 * i + 3] = bfhi(u[1]);
#pragma unroll
      for (int e = 0; e < 4; ++e) ss += y[4 * i + e] * y[4 * i + e];
    }
    ss = wave_sum(ss);
    const float rstd = rsqrtf(ss * (1.f / DM) + EPSF);
#pragma unroll
    for (int i = 0; i < 4; ++i) {
      f32x4 v = *(const f32x4*)(xr + lane * 4 + 256 * i);
      const f32x4 g = *(const f32x4*)(gpost + lane * 4 + 256 * i);
      const f32x4 m = *(const f32x4*)(mg + lane * 4 + 256 * i);
#pragma unroll
      for (int e = 0; e < 4; ++e) { v[e] += m[e] * (y[4 * i + e] * rstd * g[e]); x[4 * i + e] = v[e]; }
      *(f32x4*)(xr + lane * 4 + 256 * i) = v;
    }
  }
  if (MODE == 2 && l == NL - 1) return;
  const int ln = (MODE == 2) ? l + 1 : l;
  const float* gpre = p.in[MODE == 1 ? I_NFPRE : I_NMPRE] + ln * DM;
  const float* sh = mod_vec(p, ln, tok, MODE == 1 ? 3 : 0);
  const float* scv = mod_vec(p, ln, tok, MODE == 1 ? 4 : 1);
  float ss = 0.f;
#pragma unroll
  for (int i = 0; i < 16; ++i) ss += x[i] * x[i];
  ss = wave_sum(ss);
  const float rstd = rsqrtf(ss * (1.f / DM) + EPSF);
  bf16* hr = (bf16*)(p.ws + OFF_H) + (size_t)tok * DM;
#pragma unroll
  for (int i = 0; i < 4; ++i) {
    const f32x4 g = *(const f32x4*)(gpre + lane * 4 + 256 * i);
    const f32x4 s1 = *(const f32x4*)(sh + lane * 4 + 256 * i);
    const f32x4 s2 = *(const f32x4*)(scv + lane * 4 + 256 * i);
    float o[4];
#pragma unroll
    for (int e = 0; e < 4; ++e) o[e] = (x[4 * i + e] * rstd * g[e]) * (1.f + s2[e]) + s1[e];
    u32x2 u;
    u[0] = pack2(o[0], o[1]); u[1] = pack2(o[2], o[3]);
    *(u32x2*)(hr + lane * 4 + 256 * i) = u;
  }
}

template <int MODE>
DI void row_phase(const Params& p, int l, int bid, int G) {
  const int lane = TIDX & 63;
  const int wg = bid * 4 + (TIDX >> 6), nw = G * 4;
  const int R = (NTOK + nw - 1) / nw;
  const int t0 = wg * R, t1 = min(NTOK, t0 + R);
  if (t0 >= t1) return;
  const bool has_next = !(MODE == 2 && l == NL - 1);
  const int ln = (MODE == 2) ? l + 1 : l;
  f32x4 gpost[4], gpre[4], mg[4], sh[4], scl[4];
#pragma unroll
  for (int i = 0; i < 4; ++i) {
    if (MODE != 0) gpost[i] = *(const f32x4*)(p.in[MODE == 1 ? I_NMPOST : I_NFPOST] + l * DM + lane * 4 + 256 * i);
    if (has_next) gpre[i] = *(const f32x4*)(p.in[MODE == 1 ? I_NFPRE : I_NMPRE] + ln * DM + lane * 4 + 256 * i);
  }
  int cur_m = -1;
  u32x2 yb[4], yn[4];
  f32x4 xb[4], xn[4];
  const bf16* Hb = (const bf16*)(p.ws + OFF_H);
#define ROW_LOAD(TOK, YY, XX)                                                                              \
  {                                                                                                        \
    const int b_ = (TOK) / TT, t_ = (TOK) - b_ * TT;                                                       \
    const float* src_ = (MODE == 0) ? ((t_ < CTXL) ? p.in[I_CTX] + ((size_t)b_ * CTXL + t_) * DM           \
                                                   : p.in[I_X] + ((size_t)b_ * SEQ + (t_ - CTXL)) * DM)    \
                                    : resid_row(p, (TOK));                                                 \
    _Pragma("unroll") for (int i = 0; i < 4; ++i) {                                                        \
      XX[i] = *(const f32x4*)(src_ + lane * 4 + 256 * i);                                                  \
      if (MODE != 0) YY[i] = *(const u32x2*)(Hb + (size_t)(TOK) * DM + lane * 4 + 256 * i);                \
    }                                                                                                      \
  }
  ROW_LOAD(t0, yb, xb)
  for (int tok = t0; tok < t1; ++tok) {
    if (tok + 1 < t1) ROW_LOAD(tok + 1, yn, xn)
    const int b = tok / TT, t = tok - b * TT;
    const int m = (t < CTXL) ? 4 : b;
    if (m != cur_m) {
      cur_m = m;
      const float* Mv = (const float*)(p.ws + OFF_MOD);
#pragma unroll
      for (int i = 0; i < 4; ++i) {
        if (MODE != 0) mg[i] = *(const f32x4*)(Mv + ((size_t)(l * 5 + m) * 6 + (MODE == 1 ? 2 : 5)) * DM + lane * 4 + 256 * i);
        if (has_next) {
          sh[i] = *(const f32x4*)(Mv + ((size_t)(ln * 5 + m) * 6 + (MODE == 1 ? 3 : 0)) * DM + lane * 4 + 256 * i);
          scl[i] = *(const f32x4*)(Mv + ((size_t)(ln * 5 + m) * 6 + (MODE == 1 ? 4 : 1)) * DM + lane * 4 + 256 * i);
        }
      }
    }
    float* xr = resid_row(p, tok);
    f32x4 x[4];
    if (MODE == 0) {
#pragma unroll
      for (int i = 0; i < 4; ++i) { x[i] = xb[i]; *(f32x4*)(xr + lane * 4 + 256 * i) = x[i]; }
    } else {
      float y[16];
      float ss = 0.f;
#pragma unroll
      for (int i = 0; i < 4; ++i) {
        y[4 * i] = bflo(yb[i][0]); y[4 * i + 1] = bfhi(yb[i][0]); y[4 * i + 2] = bflo(yb[i][1]); y[4 * i + 3] = bfhi(yb[i][1]);
#pragma unroll
        for (int e = 0; e < 4; ++e) ss += y[4 * i + e] * y[4 * i + e];
      }
      ss = wave_sum(ss);
      const float rstd = rsqrtf(ss * (1.f / DM) + EPSF);
#pragma unroll
      for (int i = 0; i < 4; ++i) {
        f32x4 v = xb[i];
#pragma unroll
        for (int e = 0; e < 4; ++e) v[e] += mg[i][e] * (y[4 * i + e] * rstd * gpost[i][e]);
        x[i] = v;
        *(f32x4*)(xr + lane * 4 + 256 * i) = v;
      }
    }
    if (has_next) {
      float ss = 0.f;
#pragma unroll
      for (int i = 0; i < 4; ++i)
#pragma unroll
        for (int e = 0; e < 4; ++e) ss += x[i][e] * x[i][e];
      ss = wave_sum(ss);
      const float rstd = rsqrtf(ss * (1.f / DM) + EPSF);
      bf16* hr = (bf16*)(p.ws + OFF_H) + (size_t)tok * DM;
#pragma unroll
      for (int i = 0; i < 4; ++i) {
        float o[4];
#pragma unroll
        for (int e = 0; e < 4; ++e) o[e] = (x[i][e] * rstd * gpre[i][e]) * (1.f + scl[i][e]) + sh[i][e];
        u32x2 u;
        u[0] = pack2(o[0], o[1]); u[1] = pack2(o[2], o[3]);
        *(u32x2*)(hr + lane * 4 + 256 * i) = u;
      }
    }
#pragma unroll
    for (int i = 0; i < 4; ++i) { yb[i] = yn[i]; xb[i] = xn[i]; }
  }
#undef ROW_LOAD
}

DI void ktab_phase(const Params& p, int bid, int G, int l_lo, int l_hi) {
  const float* BBR = (const float*)(p.ws + OFF_BBR);
  const float* BBI = (const float*)(p.ws + OFF_BBI);
  const float2* PW = (const float2*)(p.ws + OFF_PWR);
  float* KT = (float*)(p.ws + OFF_KTAB);
  const int per_layer = 16 * 2 * 32 * 256;
  for (int idx = l_lo * per_layer + bid * 256 + TIDX; idx < l_hi * per_layer; idx += G * 256) {
    const int hp = idx & 15, hh = (idx >> 4) & 15, tau = (idx >> 8) & 31, d = (idx >> 13) & 1, g = (idx >> 14) & 15, l = idx >> 18;
    const int ldg = (l * 2 + d) * 16 + g;
    const float* cre = p.in[I_CRE] + ((size_t)ldg * 16 + hh) * 64;
    const float* cim = p.in[I_CIM] + ((size_t)ldg * 16 + hh) * 64;
    float acc = 0.f;
    for (int pp = 0; pp < 64; ++pp) {
      const float2 pw = PW[((size_t)ldg * 33 + tau) * 64 + pp];
      const float br = BBR[((size_t)ldg * 64 + pp) * 16 + hp], bi = BBI[((size_t)ldg * 64 + pp) * 16 + hp];
      const float zr = pw.x * br - pw.y * bi, zi = pw.x * bi + pw.y * br;
      acc += cre[pp] * zr - cim[pp] * zi;
    }
    KT[idx] = acc;
  }
}

DI void s5mat_phase(const Params& p, int l, int bid, int G) {
  const float* BBR = (const float*)(p.ws + OFF_BBR);
  const float* BBI = (const float*)(p.ws + OFF_BBI);
  const float2* PW = (const float2*)(p.ws + OFF_PWR);
  const float* KT = (const float*)(p.ws + OFF_KTAB);
  bf16* T5 = (bf16*)(p.ws + OFF_T5);
  bf16* E5 = (bf16*)(p.ws + OFF_E5);
  bf16* F5 = (bf16*)(p.ws + OFF_F5);
  const int nT = 16 * 512 * 64, nE = 16 * 512 * 32, nF = 16 * 256 * 64;
  for (int it = bid * 256 + TIDX; it < nT + nE + nF; it += G * 256) {
    float v[8];
    bf16* dst;
    if (it < nT) {
      const int k8 = it & 63, n = (it >> 6) & 511, g = it >> 15;
      const int i = n >> 4, hh = n & 15, j = k8 >> 1, hp0 = (k8 & 1) * 8;
#pragma unroll
      for (int e = 0; e < 8; ++e) {
        const int hp = hp0 + e;
        float a = 0.f;
        if (j <= i) a += KT[((((size_t)l * 16 + g) * 2 + 0) * 32 + (i - j)) * 256 + hh * 16 + hp];
        if (j >= i) a += KT[((((size_t)l * 16 + g) * 2 + 1) * 32 + (j - i)) * 256 + hh * 16 + hp];
        if (i == j && hh == hp) a += p.in[I_S5D][l * 256 + g * 16 + hh];
        v[e] = a;
      }
      dst = T5 + ((size_t)g * 512 + n) * 512 + k8 * 8;
    } else if (it < nT + nE) {
      const int q = it - nT;
      const int k8 = q & 31, n = (q >> 5) & 511, g = q >> 14;
      const int i = n >> 4, hh = n & 15;
      const int k0 = k8 * 8, d = k0 >> 7, ri = (k0 >> 6) & 1, p0 = k0 & 63;
      const int ldg = (l * 2 + d) * 16 + g;
      const int ex = d ? (32 - i) : (i + 1);
#pragma unroll
      for (int e = 0; e < 8; ++e) {
        const int pp = p0 + e;
        const float2 pw = PW[((size_t)ldg * 33 + ex) * 64 + pp];
        const float cr = p.in[I_CRE][((size_t)ldg * 16 + hh) * 64 + pp], ci = p.in[I_CIM][((size_t)ldg * 16 + hh) * 64 + pp];
        const float zr = cr * pw.x - ci * pw.y, zi = cr * pw.y + ci * pw.x;
        v[e] = ri ? -zi : zr;
      }
      dst = E5 + ((size_t)g * 512 + n) * 256 + k0;
    } else {
      const int q = it - nT - nE;
      const int k8 = q & 63, n = (q >> 6) & 255, g = q >> 14;
      const int d = n >> 7, ri = (n >> 6) & 1, pp = n & 63;
      const int j = k8 >> 1, hp0 = (k8 & 1) * 8;
      const int ldg = (l * 2 + d) * 16 + g;
      const int ex = d ? j : (31 - j);
      const float2 pw = PW[((size_t)ldg * 33 + ex) * 64 + pp];
#pragma unroll
      for (int e = 0; e < 8; ++e) {
        const float br = BBR[((size_t)ldg * 64 + pp) * 16 + hp0 + e], bi = BBI[((size_t)ldg * 64 + pp) * 16 + hp0 + e];
        v[e] = ri ? (pw.x * bi + pw.y * br) : (pw.x * br - pw.y * bi);
      }
      dst = F5 + ((size_t)g * 256 + n) * 512 + k8 * 8;
    }
    u32x4 u;
    u[0] = pack2(v[0], v[1]); u[1] = pack2(v[2], v[3]); u[2] = pack2(v[4], v[5]); u[3] = pack2(v[6], v[7]);
    *(u32x4*)dst = u;
  }
}

DI void proj_epi(const Params& p, int l, int mt, int nt, char* smem);
DI void proj_wide(const Params& p, int l, int mt, int np, char* smem) {
  const bf16* H = (const bf16*)(p.ws + OFF_H) + (size_t)mt * 128 * DM;
  const bf16* W = wl(p, l, WL_WIN) + (size_t)np * 256 * DM;
  f32x16 acc[2][4];
  accw_zero(acc);
  gemm_wide(acc, [&](int r) { return H + (size_t)r * DM; }, [&](int r) { return W + (size_t)r * DM; }, DM, smem);
  float* Cs = (float*)smem;
  accw_to_lds<0>(acc, Cs);
  __syncthreads();
  proj_epi(p, l, mt, np * 2, smem);
  if (np * 2 + 1 < 19) {
    accw_to_lds<1>(acc, Cs);
    __syncthreads();
    proj_epi(p, l, mt, np * 2 + 1, smem);
  }
}
DI void proj_epi(const Params& p, int l, int mt, int nt, char* smem) {
  float* Cs = (float*)smem;
  const int tid = TIDX;
  const int tok0 = mt * 128;
  const int b = tok0 / TT, t0 = tok0 - b * TT;
  if (nt <= 2) {
    const int row = tid >> 1, seg = tid & 1;
    float* c = Cs + row * CLD + seg * 64;
    const float* gn = p.in[nt < 2 ? I_QN : I_KN] + l * 64;
    float ss = 0.f;
#pragma unroll 8
    for (int i = 0; i < 64; ++i) ss += c[i] * c[i];
    const float rstd = rsqrtf(ss * (1.f / 64.f) + EPSF);
    const int t = t0 + row;
    const bool lat = t >= CTXL;
    const int s = t - CTXL;
#pragma unroll 1
    for (int ax = 0; ax < 2; ++ax) {
      const float pos = (float)(ax ? (s & 63) : (s >> 6));
#pragma unroll 2
      for (int f = 0; f < 16; ++f) {
        float x1 = c[ax * 32 + f] * rstd * gn[ax * 32 + f];
        float x2 = c[ax * 32 + 16 + f] * rstd * gn[ax * 32 + 16 + f];
        if (lat) {
          const float invf = exp2f(-(float)f * (13.287712379549449f / 16.f));
          float sn, cs;
          sincos_cw(pos * invf, sn, cs);
          const float y1 = x1 * cs - x2 * sn, y2 = x2 * cs + x1 * sn;
          x1 = y1; x2 = y2;
        }
        c[ax * 32 + f] = x1;
        c[ax * 32 + 16 + f] = x2;
      }
    }
    __syncthreads();
    if (nt < 2) store_tile_bf16(Cs, (bf16*)(p.ws + OFF_Q) + (size_t)tok0 * 256 + nt * 128, 256, 128, 0.125f * 1.4426950408889634f);
    else store_tile_bf16(Cs, (bf16*)(p.ws + OFF_K) + (size_t)tok0 * 128, 128, 128, 1.f);
  } else if (nt == 3 || (nt >= 8 && nt <= 11)) {
    for (int c = tid; c < 2048; c += 256) {
      const int col = c & 127, rc = (c >> 7) * 8;
      u32x4 u;
#pragma unroll
      for (int e = 0; e < 4; ++e) u[e] = pack2(Cs[(rc + 2 * e) * CLD + col], Cs[(rc + 2 * e + 1) * CLD + col]);
      bf16* dst;
      if (nt == 3) dst = (bf16*)(p.ws + OFF_VT) + ((size_t)(b * 2 + (col >> 6)) * 64 + (col & 63)) * TT + t0 + rc;
      else dst = (bf16*)(p.ws + OFF_GVT) + ((size_t)(b * 4 + (nt - 8)) * 128 + col) * TT + t0 + rc;
      *(u32x4*)dst = u;
    }
  } else if (nt == 4 || nt == 5) {
    store_tile_bf16(Cs, (bf16*)(p.ws + OFF_GQ) + (size_t)tok0 * 256 + (nt - 4) * 128, 256, 128, 0.125f);
  } else if (nt == 6 || nt == 7) {
    store_tile_bf16(Cs, (bf16*)(p.ws + OFF_GK) + (size_t)tok0 * 256 + (nt - 6) * 128, 256, 128, 1.f);
  } else if (nt >= 12 && nt <= 15) {
    store_tile_bf16(Cs, (bf16*)(p.ws + OFF_GR) + (size_t)tok0 * 512 + (nt - 12) * 128, 512, 128, 1.f);
  } else if (nt == 16 || nt == 17) {
    for (int c = tid; c < 2048; c += 256) {
      const int row = c >> 4, c8 = c & 15;
      const float* s = Cs + row * CLD + c8 * 8;
      u32x4 u;
#pragma unroll
      for (int e = 0; e < 4; ++e) u[e] = pack2(s[2 * e], s[2 * e + 1]);
      const int ch = (nt - 16) * 128 + c8 * 8;
      bf16* dst = (bf16*)(p.ws + OFF_SU) + ((size_t)(b * 16 + (ch >> 4)) * TT + t0 + row) * 16 + (ch & 15);
      *(u32x4*)dst = u;
    }
  } else {
    for (int c = tid; c < 128 * 8; c += 256) {
      const int row = c >> 3, c4 = (c & 7) * 4;
      const float* s = Cs + row * CLD + c4;
      f32x4 v = {s[0], s[1], s[2], s[3]};
      *(f32x4*)((float*)(p.ws + OFF_LOW) + (size_t)(tok0 + row) * 32 + c4) = v;
    }
  }
  __syncthreads();
}

DI void attn_unit(const Params& p, int u, char* smem) {
  int b, head, tok0, nkt;
  if (u < 1024) { b = u >> 8; head = (u >> 6) & 3; tok0 = b * TT + CTXL + (u & 63) * 128; nkt = TT / 128; }
  else { const int v = u - 1024; b = v >> 3; head = (v >> 1) & 3; tok0 = b * TT + (v & 1) * 128; nkt = CTXL / 128; }
  const int kvh = head >> 1;
  const int tid = TIDX, lane = tid & 63, w = tid >> 6, r = lane & 31, h = lane >> 5;
  const bf16* Qp = (const bf16*)(p.ws + OFF_Q) + (size_t)(tok0 + w * 32 + r) * 256 + head * 64 + h * 8;
  s16x8 qf[4];
#pragma unroll
  for (int s = 0; s < 4; ++s) qf[s] = __builtin_bit_cast(s16x8, ldg16(Qp + s * 16));
  const bf16* kp[2];
  const bf16* vp[2];
#pragma unroll
  for (int i = 0; i < 2; ++i) {
    const int row = w * 16 + i * 8 + (lane >> 3);
    const int c = (lane & 7) ^ ((row >> 1) & 7);
    kp[i] = (const bf16*)(p.ws + OFF_K) + ((size_t)b * TT + row) * 128 + kvh * 64 + c * 8;
    vp[i] = (const bf16*)(p.ws + OFF_VT) + ((size_t)(b * 2 + kvh) * 64 + row) * TT + c * 8;
  }
  const int ldst = (w * 128 + lane) * 16;
#define AT_DMA(BUF, T)                                                                                              \
  {                                                                                                                 \
    char* sb_ = smem + (BUF) * 32768;                                                                               \
    _Pragma("unroll") for (int hh = 0; hh < 2; ++hh)                                                                \
    _Pragma("unroll") for (int i = 0; i < 2; ++i) {                                                                 \
      __builtin_amdgcn_global_load_lds((const unsigned*)(kp[i] + (size_t)((T) * 128 + hh * 64) * 128), (unsigned*)(sb_ + hh * 8192 + ldst + i * 1024), 16, 0, 0); \
      __builtin_amdgcn_global_load_lds((const unsigned*)(vp[i] + (T) * 128 + hh * 64), (unsigned*)(sb_ + 16384 + hh * 8192 + ldst + i * 1024), 16, 0, 0);        \
    }                                                                                                               \
  }
  const int xr = (r >> 1) & 7;
  AT_DMA(0, 0)
  asm volatile("s_waitcnt vmcnt(0)" ::: "memory");
  __syncthreads();
  f32x16 oacc[2];
#pragma unroll
  for (int i = 0; i < 16; ++i) { oacc[0][i] = 0.f; oacc[1][i] = 0.f; }
  float mrow = -INFINITY, lrow = 0.f;
  for (int kt = 0; kt < nkt; ++kt) {
    const int buf = kt & 1;
    if (kt + 1 < nkt) AT_DMA(buf ^ 1, kt + 1)
    const char* Kb = smem + buf * 32768;
    const char* Vb = Kb + 16384;
    f32x16 sacc[4];
#pragma unroll
    for (int q = 0; q < 4; ++q)
#pragma unroll
      for (int i = 0; i < 16; ++i) sacc[q][i] = 0.f;
#pragma unroll
    for (int s = 0; s < 4; ++s) {
      const int co = ((2 * s + h) ^ xr) * 16;
#pragma unroll
      for (int q = 0; q < 4; ++q) {
        const s16x8 a = *(const s16x8*)(Kb + (q >> 1) * 8192 + ((q & 1) * 32 + r) * 128 + co);
        sacc[q] = MFMA32(a, qf[s], sacc[q]);
      }
    }
    float mx = sacc[0][0];
#pragma unroll
    for (int q = 0; q < 4; ++q)
#pragma unroll
      for (int i = 0; i < 16; ++i) mx = fmaxf(mx, sacc[q][i]);
    mx = fmaxf(mx, __shfl_xor(mx, 32, 64));
    const float mnew = fmaxf(mrow, mx);
    const float alpha = __builtin_amdgcn_exp2f(mrow - mnew);
    mrow = mnew;
    float psum = 0.f;
#pragma unroll
    for (int q = 0; q < 4; ++q)
#pragma unroll
      for (int i = 0; i < 16; ++i) { sacc[q][i] = __builtin_amdgcn_exp2f(sacc[q][i] - mnew); psum += sacc[q][i]; }
    lrow = lrow * alpha + psum;
#pragma unroll
    for (int i = 0; i < 16; ++i) { oacc[0][i] *= alpha; oacc[1][i] *= alpha; }
#pragma unroll
    for (int q = 0; q < 4; ++q)
#pragma unroll
      for (int s2 = 0; s2 < 2; ++s2) {
        u32x4 pu;
#pragma unroll
        for (int e = 0; e < 4; ++e) pu[e] = pack2(sacc[q][8 * s2 + 2 * e], sacc[q][8 * s2 + 2 * e + 1]);
        const s16x8 pf = __builtin_bit_cast(s16x8, pu);
        const int c0 = (q & 1) * 4 + 2 * s2;
        const int o0 = ((c0 ^ xr) * 16) + 8 * h, o1 = (((c0 + 1) ^ xr) * 16) + 8 * h;
#pragma unroll
        for (int dt = 0; dt < 2; ++dt) {
          const s16x4 lo = *(const s16x4*)(Vb + (q >> 1) * 8192 + (dt * 32 + r) * 128 + o0);
          const s16x4 hi = *(const s16x4*)(Vb + (q >> 1) * 8192 + (dt * 32 + r) * 128 + o1);
          const s16x8 a = __builtin_shufflevector(lo, hi, 0, 1, 2, 3, 4, 5, 6, 7);
          oacc[dt] = MFMA32(a, pf, oacc[dt]);
        }
      }
    asm volatile("s_waitcnt vmcnt(0)" ::: "memory");
    __syncthreads();
  }
#undef AT_DMA
  const float ltot = lrow + __shfl_xor(lrow, 32, 64);
  const float inv = 1.f / ltot;
  bf16* Op = (bf16*)(p.ws + OFF_OATT) + (size_t)(tok0 + w * 32 + r) * 256 + head * 64;
#pragma unroll
  for (int dt = 0; dt < 2; ++dt)
#pragma unroll
    for (int i = 0; i < 16; i += 4) {
      u32x2 uu;
      uu[0] = pack2(oacc[dt][i] * inv, oacc[dt][i + 1] * inv);
      uu[1] = pack2(oacc[dt][i + 2] * inv, oacc[dt][i + 3] * inv);
      *(u32x2*)(Op + dt * 32 + crow(i, h)) = uu;
    }
}

constexpr int GL_LOW = 0, GL_TOT = 4096, GL_DEC = 5120, GL_QIN = 5376, GL_KIN = 14592, GL_KET = 23808, GL_OST = 0,
              GL_VT = 33792, GL_ST = 52224;
static_assert(GL_ST + 128 * LDT * 2 <= SMEM_BYTES, "gla lds");

template <bool WITH_OUT>
DI void gla_unit(const Params& p, int l, int u, char* smem) {
  float* lowt = (float*)(smem + GL_LOW);
  float* tots = (float*)(smem + GL_TOT);
  float* decs = (float*)(smem + GL_DEC);
  bf16* qin = (bf16*)(smem + GL_QIN);
  bf16* kin = (bf16*)(smem + GL_KIN);
  bf16* ket = (bf16*)(smem + GL_KET);
  float* ost = (float*)(smem + GL_OST);
  bf16* vts = (bf16*)(smem + GL_VT);
  bf16* sts = (bf16*)(smem + GL_ST);
  const int tid = TIDX, lane = tid & 63, w = tid >> 6, r = lane & 31, h = lane >> 5;
  int b, hd, gi, dir0, ndir;
  if (WITH_OUT) { gi = u % NG33; hd = (u / NG33) & 3; b = u / (NG33 * 4); dir0 = 1; ndir = 2; }
  else { gi = u % NG33; const int v = u / NG33; dir0 = v & 1; hd = (v >> 1) & 3; b = v >> 3; ndir = 1; }
  const int dk = tid & 63, part = tid >> 6;
  const bf16* GQ = (const bf16*)(p.ws + OFF_GQ);
  const bf16* GK = (const bf16*)(p.ws + OFF_GK);
  const bf16* GVT = (const bf16*)(p.ws + OFF_GVT) + (size_t)(b * 4 + hd) * 128 * TT;
  const float* LOW = (const float*)(p.ws + OFF_LOW);
  for (int dd = 0; dd < ndir; ++dd) {
    const int dir = WITH_OUT ? (dir0 - dd) : dir0;
    float* GSu = (float*)(p.ws + OFF_GS) + ((size_t)((b * 4 + hd) * 2 + dir) * NG33 + gi) * 8192;
    float gwreg[16];
#pragma unroll
    for (int rr = 0; rr < 16; ++rr) gwreg[rr] = p.in[I_GGW][((size_t)(l * 2 + dir) * 16 + rr) * 256 + hd * 64 + dk];
    const float gb = p.in[I_GGB][(l * 2 + dir) * 256 + hd * 64 + dk];
    f32x16 sacc[2];
    if (WITH_OUT) {
#pragma unroll
      for (int dkt = 0; dkt < 2; ++dkt)
#pragma unroll
        for (int i = 0; i < 16; ++i) {
          const float v = GSu[(w * 32 + crow(i, h)) * 64 + dkt * 32 + r];
          sacc[dkt][i] = v;
          sts[(w * 32 + crow(i, h)) * LDT + dkt * 32 + r] = f2bf(v);
        }
    } else {
#pragma unroll
      for (int i = 0; i < 16; ++i) { sacc[0][i] = 0.f; sacc[1][i] = 0.f; }
    }
    float gtot = 0.f;
    for (int cc = 0; cc < 4; ++cc) {
      const int ci = dir ? 3 - cc : cc;
      const int tb = gi * 256 + ci * 64;
      const size_t tokb = (size_t)b * TT + tb;
      {
        const int row = tid >> 2, c4 = (tid & 3) * 4;
        const u32x4 lw = ldg16(LOW + (tokb + row) * 32 + dir * 16 + c4);
        u32x4 vv[4], kq[2], qq[2];
#pragma unroll
        for (int i = 0; i < 4; ++i) {
          const int c = tid + 256 * i, e = c >> 3, k8 = (c & 7) * 8;
          vv[i] = ldg16(GVT + (size_t)e * TT + tb + k8);
        }
#pragma unroll
        for (int i = 0; i < 2; ++i) {
          const int c = tid + 256 * i, rw = c >> 3, k8 = (c & 7) * 8;
          kq[i] = ldg16(GK + (tokb + rw) * 256 + hd * 64 + k8);
          if (WITH_OUT) qq[i] = ldg16(GQ + (tokb + rw) * 256 + hd * 64 + k8);
        }
        *(u32x4*)(lowt + row * 16 + c4) = lw;
#pragma unroll
        for (int i = 0; i < 4; ++i) {
          const int c = tid + 256 * i, e = c >> 3, k8 = (c & 7) * 8;
          *(u32x4*)(vts + e * LDT + k8) = vv[i];
        }
#pragma unroll
        for (int i = 0; i < 2; ++i) {
          const int c = tid + 256 * i, rw = c >> 3, k8 = (c & 7) * 8;
          *(u32x4*)(kin + rw * LDT + k8) = kq[i];
          if (WITH_OUT) *(u32x4*)(qin + rw * LDT + k8) = qq[i];
        }
      }
      __syncthreads();
      float cum = 0.f;
#pragma unroll 2
      for (int ii = 0; ii < 16; ++ii) {
        const int pos = part * 16 + ii, t = dir ? 63 - pos : pos;
        float z = gb;
#pragma unroll
        for (int rr = 0; rr < 16; ++rr) z += lowt[t * 16 + rr] * gwreg[rr];
        cum += (fminf(z, 0.f) - log1pf(__expf(-fabsf(z)))) * (1.f / 16.f);
      }
      tots[part * 64 + dk] = cum;
      __syncthreads();
      float offs = 0.f, total = 0.f;
#pragma unroll
      for (int pp = 0; pp < 4; ++pp) { const float tv = tots[pp * 64 + dk]; total += tv; if (pp < part) offs += tv; }
      if (part == 0) decs[dk] = __expf(total);
      gtot += total;
      float bq = offs;
#pragma unroll 2
      for (int ii = 0; ii < 16; ++ii) {
        const int pos = part * 16 + ii, t = dir ? 63 - pos : pos;
        float z = gb;
#pragma unroll
        for (int rr = 0; rr < 16; ++rr) z += lowt[t * 16 + rr] * gwreg[rr];
        bq += (fminf(z, 0.f) - log1pf(__expf(-fabsf(z)))) * (1.f / 16.f);
        const float kv = bf2f(kin[t * LDT + dk]);
        ket[dk * LDT + t] = f2bf(kv * __expf(total - bq));
        if (WITH_OUT) {
          const float qv = bf2f(qin[t * LDT + dk]);
          qin[t * LDT + dk] = f2bf(qv * __expf(bq));
          kin[t * LDT + dk] = f2bf(kv * __expf(-bq));
        }
      }
      __syncthreads();
      f32x16 oo[2];
      const int it = w & 1, ep = w >> 1;
      if (WITH_OUT) {
        const int ti = w >> 1, tj = w & 1;
        f32x16 aa;
#pragma unroll
        for (int i = 0; i < 16; ++i) aa[i] = 0.f;
#pragma unroll
        for (int s = 0; s < 4; ++s) {
          const s16x8 A = *(const s16x8*)(qin + (ti * 32 + r) * LDT + s * 16 + h * 8);
          const s16x8 Bv = *(const s16x8*)(kin + (tj * 32 + r) * LDT + s * 16 + h * 8);
          aa = MFMA32(A, Bv, aa);
        }
        __syncthreads();
#pragma unroll
        for (int i = 0; i < 16; ++i) {
          const int qi = ti * 32 + crow(i, h), kj = tj * 32 + r;
          const bool keep = dir ? (kj >= qi) : (kj <= qi);
          kin[qi * LDT + kj] = f2bf(keep ? aa[i] : 0.f);
        }
        __syncthreads();
#pragma unroll
        for (int i = 0; i < 16; ++i) { oo[0][i] = 0.f; oo[1][i] = 0.f; }
#pragma unroll
        for (int s = 0; s < 4; ++s) {
          const s16x8 A1 = *(const s16x8*)(kin + (it * 32 + r) * LDT + s * 16 + h * 8);
          const s16x8 A2 = *(const s16x8*)(qin + (it * 32 + r) * LDT + s * 16 + h * 8);
#pragma unroll
          for (int x = 0; x < 2; ++x) {
            const int et = 2 * ep + x;
            const s16x8 B1 = *(const s16x8*)(vts + (et * 32 + r) * LDT + s * 16 + h * 8);
            const s16x8 B2 = *(const s16x8*)(sts + (et * 32 + r) * LDT + s * 16 + h * 8);
            oo[x] = MFMA32(A1, B1, oo[x]);
            oo[x] = MFMA32(A2, B2, oo[x]);
          }
        }
      }
#pragma unroll
      for (int dkt = 0; dkt < 2; ++dkt) {
        const float dv = decs[dkt * 32 + r];
#pragma unroll
        for (int i = 0; i < 16; ++i) sacc[dkt][i] *= dv;
      }
#pragma unroll
      for (int s = 0; s < 4; ++s) {
        const s16x8 A = *(const s16x8*)(vts + (w * 32 + r) * LDT + s * 16 + h * 8);
#pragma unroll
        for (int dkt = 0; dkt < 2; ++dkt) {
          const s16x8 Bv = *(const s16x8*)(ket + (dkt * 32 + r) * LDT + s * 16 + h * 8);
          sacc[dkt] = MFMA32(A, Bv, sacc[dkt]);
        }
      }
      __syncthreads();
      if (WITH_OUT) {
#pragma unroll
        for (int dkt = 0; dkt < 2; ++dkt)
#pragma unroll
          for (int i = 0; i < 16; ++i) sts[(w * 32 + crow(i, h)) * LDT + dkt * 32 + r] = f2bf(sacc[dkt][i]);
#pragma unroll
        for (int x = 0; x < 2; ++x)
#pragma unroll
          for (int i = 0; i < 16; ++i) ost[(it * 32 + crow(i, h)) * CLD + (2 * ep + x) * 32 + r] = oo[x][i];
        __syncthreads();
        const int row = tid >> 2, qd = tid & 3;
        const size_t tok = tokb + row;
        bf16* og = (bf16*)(p.ws + OFF_OGLA) + tok * 512 + hd * 128 + qd * 32;
        const float* os = ost + row * CLD + qd * 32;
        if (dir == 1) {
#pragma unroll
          for (int i = 0; i < 4; ++i) {
            u32x4 uu;
#pragma unroll
            for (int e = 0; e < 4; ++e) uu[e] = pack2(os[i * 8 + 2 * e], os[i * 8 + 2 * e + 1]);
            *(u32x4*)(og + i * 8) = uu;
          }
        } else {
          float ss = 0.f;
#pragma unroll 1
          for (int i = 0; i < 4; ++i) {
            const u32x4 uu = *(const u32x4*)(og + i * 8);
#pragma unroll
            for (int e = 0; e < 4; ++e) {
              const float a0 = os[i * 8 + 2 * e] + bflo(uu[e]), a1 = os[i * 8 + 2 * e + 1] + bfhi(uu[e]);
              ss += a0 * a0 + a1 * a1;
            }
          }
          ss += __shfl_xor(ss, 1, 64);
          ss += __shfl_xor(ss, 2, 64);
          const float rstd = rsqrtf(ss * (1.f / 128.f) + EPSF);
          const float* gn = p.in[I_GON] + l * 128 + qd * 32;
          const bf16* gr = (const bf16*)(p.ws + OFF_GR) + tok * 512 + hd * 128 + qd * 32;
#pragma unroll 1
          for (int i = 0; i < 4; ++i) {
            const u32x4 uo = *(const u32x4*)(og + i * 8);
            const u32x4 ug = *(const u32x4*)(gr + i * 8);
            u32x4 uu;
#pragma unroll
            for (int e = 0; e < 4; ++e) {
              const float v0 = os[i * 8 + 2 * e] + bflo(uo[e]), v1 = os[i * 8 + 2 * e + 1] + bfhi(uo[e]);
              const float a0 = v0 * rstd * gn[i * 8 + 2 * e] * siluf_(bflo(ug[e]));
              const float a1 = v1 * rstd * gn[i * 8 + 2 * e + 1] * siluf_(bfhi(ug[e]));
              uu[e] = pack2(a0, a1);
            }
            *(u32x4*)(og + i * 8) = uu;
          }
        }
        __syncthreads();
      }
    }
    if (!WITH_OUT) {
#pragma unroll
      for (int dkt = 0; dkt < 2; ++dkt)
#pragma unroll
        for (int i = 0; i < 16; ++i) GSu[(w * 32 + crow(i, h)) * 64 + dkt * 32 + r] = sacc[dkt][i];
      if (part == 0) ((float*)(p.ws + OFF_DECG))[((size_t)((b * 4 + hd) * 2 + dir) * NG33 + gi) * 64 + dk] = __expf(gtot);
    }
    __syncthreads();
  }
}

DI void gla_scan_job(const Params& p, int j) {
  const int idx = j * 256 + TIDX;
  const int seq = idx >> 13, el = idx & 8191, dk = el & 63, dir = seq & 1;
  float* GS = (float*)(p.ws + OFF_GS) + (size_t)seq * NG33 * 8192 + el;
  const float* DG = (const float*)(p.ws + OFF_DECG) + (size_t)seq * NG33 * 64 + dk;
  float s = 0.f;
  for (int st0 = 0; st0 < 33; st0 += 11) {
    float kv[11], dc[11];
#pragma unroll
    for (int q = 0; q < 11; ++q) {
      const int st = st0 + q;
      const int g = (dir == 0 || st == 0) ? st : 33 - st;
      kv[q] = GS[(size_t)g * 8192];
      dc[q] = DG[g * 64];
    }
#pragma unroll
    for (int q = 0; q < 11; ++q) {
      const int st = st0 + q;
      const int g = (dir == 0 || st == 0) ? st : 33 - st;
      GS[(size_t)g * 8192] = s;
      s = dc[q] * s + kv[q];
    }
  }
}

DI void s5_end_tile(const Params& p, int j, char* smem) {
  const int nt = j & 1, mt = (j >> 1) % 9, g = j / 18;
  const bf16* SU = (const bf16*)(p.ws + OFF_SU);
  const bf16* F = (const bf16*)(p.ws + OFF_F5) + ((size_t)g * 256 + nt * 128) * 512;
  f32x16 acc[2][2];
  acc_zero(acc);
  gemm_main_dma(acc,
            [&](int r) -> const bf16* {
              const int m = mt * 128 + r;
              if (m >= MS5) return (const bf16*)(p.ws + OFF_ZERO);
              const int b = m / NCH, ch = m - b * NCH;
              return SU + ((size_t)(b * 16 + g) * TT + ch * 32) * 16;
            },
            [&](int r) { return F + (size_t)r * 512; }, 512, smem);
  float* Cs = (float*)smem;
  acc_to_lds(acc, Cs);
  __syncthreads();
  float* EN = (float*)(p.ws + OFF_EN);
  for (int c = TIDX; c < 128 * 32; c += 256) {
    const int row = c >> 5, c4 = (c & 31) * 4, m = mt * 128 + row;
    if (m < MS5) {
      const float* s = Cs + row * CLD + c4;
      f32x4 v = {s[0], s[1], s[2], s[3]};
      *(f32x4*)(EN + ((size_t)m * 16 + g) * 256 + nt * 128 + c4) = v;
    }
  }
  __syncthreads();
}

DI void s5_scan_job(const Params& p, int l, int j, char* smem) {
  float2* ends = (float2*)smem;
  const int dir = j & 1, g = (j >> 1) & 15, b = j >> 5;
  const int pp = TIDX & 63, seg = TIDX >> 6;
  const float2 aL = ((const float2*)(p.ws + OFF_PWR))[((size_t)((l * 2 + dir) * 16 + g) * 33 + 32) * 64 + pp];
  const float* EN = (const float*)(p.ws + OFF_EN);
  bf16* SB = (bf16*)(p.ws + OFF_SB);
  float sr = 0.f, si = 0.f;
  for (int q0 = 0; q0 < 66; q0 += 11) {
    float er[11], ei[11];
#pragma unroll
    for (int q = 0; q < 11; ++q) {
      const int pos = seg * 66 + q0 + q;
      const int ch = dir ? (pos < 8 ? 7 - pos : 271 - pos) : pos;
      const float* e = EN + ((size_t)(b * NCH + ch) * 16 + g) * 256 + dir * 128 + pp;
      er[q] = e[0]; ei[q] = e[64];
    }
#pragma unroll
    for (int q = 0; q < 11; ++q) {
      const float nr = aL.x * sr - aL.y * si + er[q], ni = aL.x * si + aL.y * sr + ei[q];
      sr = nr; si = ni;
    }
  }
  ends[seg * 64 + pp] = make_float2(sr, si);
  float pr = 1.f, pi = 0.f;
  for (int q = 0; q < 66; ++q) { const float nr = pr * aL.x - pi * aL.y, ni = pr * aL.y + pi * aL.x; pr = nr; pi = ni; }
  __syncthreads();
  sr = 0.f; si = 0.f;
  for (int k = 0; k < seg; ++k) {
    const float2 e = ends[k * 64 + pp];
    const float nr = pr * sr - pi * si + e.x, ni = pr * si + pi * sr + e.y;
    sr = nr; si = ni;
  }
  for (int q0 = 0; q0 < 66; q0 += 11) {
    float er[11], ei[11];
#pragma unroll
    for (int q = 0; q < 11; ++q) {
      const int pos = seg * 66 + q0 + q;
      const int ch = dir ? (pos < 8 ? 7 - pos : 271 - pos) : pos;
      const float* e = EN + ((size_t)(b * NCH + ch) * 16 + g) * 256 + dir * 128 + pp;
      er[q] = e[0]; ei[q] = e[64];
    }
#pragma unroll
    for (int q = 0; q < 11; ++q) {
      const int pos = seg * 66 + q0 + q;
      const int ch = dir ? (pos < 8 ? 7 - pos : 271 - pos) : pos;
      bf16* sb = SB + ((size_t)(b * NCH + ch) * 16 + g) * 256 + dir * 128 + pp;
      sb[0] = f2bf(sr); sb[64] = f2bf(si);
      const float nr = aL.x * sr - aL.y * si + er[q], ni = aL.x * si + aL.y * sr + ei[q];
      sr = nr; si = ni;
    }
  }
  __syncthreads();
}

DI float gelu_tanh(float x) {
  const float u = 0.7978845608028654f * (x + 0.044715f * x * x * x);
  return 0.5f * x * (1.f + tanhf(u));
}

DI void s5_out_tile(const Params& p, int j, char* smem) {
  const int nt = j & 3, mt = (j >> 2) % 9, g = j / 36;
  const bf16* SU = (const bf16*)(p.ws + OFF_SU);
  const bf16* SB = (const bf16*)(p.ws + OFF_SB);
  const bf16* Tm = (const bf16*)(p.ws + OFF_T5) + ((size_t)g * 512 + nt * 128) * 512;
  const bf16* Em = (const bf16*)(p.ws + OFF_E5) + ((size_t)g * 512 + nt * 128) * 256;
  f32x16 acc[2][2];
  acc_zero(acc);
  gemm_main_dma(acc,
            [&](int r) -> const bf16* {
              const int m = mt * 128 + r;
              if (m >= MS5) return (const bf16*)(p.ws + OFF_ZERO);
              const int b = m / NCH, ch = m - b * NCH;
              return SU + ((size_t)(b * 16 + g) * TT + ch * 32) * 16;
            },
            [&](int r) { return Tm + (size_t)r * 512; }, 512, smem);
  gemm_main_dma(acc,
            [&](int r) -> const bf16* {
              const int m = mt * 128 + r;
              if (m >= MS5) return (const bf16*)(p.ws + OFF_ZERO);
              return SB + ((size_t)m * 16 + g) * 256;
            },
            [&](int r) { return Em + (size_t)r * 256; }, 256, smem);
  float* Cs = (float*)smem;
  acc_to_lds(acc, Cs);
  __syncthreads();
  bf16* Y5 = (bf16*)(p.ws + OFF_Y5);
  for (int c = TIDX; c < 2048; c += 256) {
    const int row = c >> 4, c8 = c & 15, m = mt * 128 + row;
    if (m < MS5) {
      const int b = m / NCH, ch = m - b * NCH;
      const int n = nt * 128 + c8 * 8, i = n >> 4, hh = n & 15;
      const float* s = Cs + row * CLD + c8 * 8;
      u32x4 u;
#pragma unroll
      for (int e = 0; e < 4; ++e) u[e] = pack2(gelu_tanh(s[2 * e]), gelu_tanh(s[2 * e + 1]));
      *(u32x4*)(Y5 + ((size_t)b * TT + ch * 32 + i) * 256 + g * 16 + hh) = u;
    }
  }
  __syncthreads();
}

DI void glu_tile(const Params& p, int l, int j, char* smem) {
  const int nt = j & 1, mt = j >> 1;
  const bf16* Y5 = (const bf16*)(p.ws + OFF_Y5) + (size_t)mt * 128 * 256;
  const bf16* W = wl(p, l, WL_GLU) + (size_t)nt * 128 * 256;
  f32x16 acc[2][2];
  acc_zero(acc);
  gemm_main_dma(acc, [&](int r) { return Y5 + (size_t)r * 256; }, [&](int r) { return W + (size_t)r * 256; }, 256, smem);
  float* Cs = (float*)smem;
  acc_to_lds(acc, Cs);
  __syncthreads();
  const float* gb = p.in[I_GLUB] + l * 256 + nt * 128;
  bf16* O = (bf16*)(p.ws + OFF_OS5) + (size_t)mt * 128 * 256 + nt * 128;
  for (int c = TIDX; c < 2048; c += 256) {
    const int row = c >> 4, cc = (c & 15) * 8;
    const float* s = Cs + row * CLD + cc;
    const u32x4 yu = *(const u32x4*)(Y5 + (size_t)row * 256 + nt * 128 + cc);
    u32x4 u;
#pragma unroll
    for (int e = 0; e < 4; ++e) {
      const float y0 = bflo(yu[e]), y1 = bfhi(yu[e]);
      u[e] = pack2(y0 * sigmoidf_(s[2 * e] + gb[cc + 2 * e]), y1 * sigmoidf_(s[2 * e + 1] + gb[cc + 2 * e + 1]));
    }
    *(u32x4*)(O + (size_t)row * 256 + cc) = u;
  }
  __syncthreads();
}

DI void merge_tile(const Params& p, int l, int j, char* smem) {
  const int nt = j & 7, mt = j >> 3;
  const bf16* H = (const bf16*)(p.ws + OFF_H) + (size_t)mt * 128 * DM;
  unsigned am[2][2][8];
#pragma unroll
  for (int a = 0; a < 2; ++a)
#pragma unroll
    for (int bq = 0; bq < 2; ++bq)
#pragma unroll
      for (int i = 0; i < 8; ++i) am[a][bq][i] = 0u;
#pragma unroll 1
  for (int x = 0; x < 3; ++x) {
    const bf16* Wg = wl(p, l, WL_WIN) + ((size_t)2432 + x * 1024 + nt * 128) * DM;
    unsigned sg[2][2][8];
    {
      f32x16 acc[2][2];
      acc_zero(acc);
      gemm_main_dma(acc, [&](int r) { return H + (size_t)r * DM; }, [&](int r) { return Wg + (size_t)r * DM; }, DM, smem);
#pragma unroll
      for (int a = 0; a < 2; ++a)
#pragma unroll
        for (int bq = 0; bq < 2; ++bq)
#pragma unroll
          for (int i = 0; i < 8; ++i) sg[a][bq][i] = pack2(sigmoidf_(acc[a][bq][2 * i]), sigmoidf_(acc[a][bq][2 * i + 1]));
    }
    const bf16* A; const bf16* Wb; int K;
    if (x == 0) { A = (const bf16*)(p.ws + OFF_OATT) + (size_t)mt * 128 * 256; Wb = wl(p, l, WL_BRA) + (size_t)nt * 128 * 256; K = 256; }
    else if (x == 1) { A = (const bf16*)(p.ws + OFF_OGLA) + (size_t)mt * 128 * 512; Wb = wl(p, l, WL_BRG) + (size_t)nt * 128 * 512; K = 512; }
    else { A = (const bf16*)(p.ws + OFF_OS5) + (size_t)mt * 128 * 256; Wb = wl(p, l, WL_BRS) + (size_t)nt * 128 * 256; K = 256; }
#pragma unroll
    for (int hf = 0; hf < 2; ++hf) {
      f32x16 a2[2];
#pragma unroll
      for (int i = 0; i < 16; ++i) { a2[0][i] = 0.f; a2[1][i] = 0.f; }
      gemm_main_dma_half(a2, A, K, Wb, K, K, hf, smem);
#pragma unroll
      for (int a = 0; a < 2; ++a)
#pragma unroll
        for (int i = 0; i < 8; ++i) {
          const float v0 = bflo(am[a][hf][i]) + bflo(sg[a][hf][i]) * a2[a][2 * i];
          const float v1 = bfhi(am[a][hf][i]) + bfhi(sg[a][hf][i]) * a2[a][2 * i + 1];
          am[a][hf][i] = pack2(v0, v1);
        }
    }
  }
  f32x16 accm[2][2];
#pragma unroll
  for (int a = 0; a < 2; ++a)
#pragma unroll
    for (int bq = 0; bq < 2; ++bq)
#pragma unroll
      for (int i = 0; i < 8; ++i) { accm[a][bq][2 * i] = bflo(am[a][bq][i]); accm[a][bq][2 * i + 1] = bfhi(am[a][bq][i]); }
  float* Cs = (float*)smem;
  acc_to_lds(accm, Cs);
  __syncthreads();
  store_tile_bf16(Cs, (bf16*)(p.ws + OFF_MG) + (size_t)mt * 128 * DM + nt * 128, DM, 128, 1.f);
  __syncthreads();
}

DI void plain_tile(const bf16* A, int K, const bf16* W, bf16* dst, int ldd, char* smem) {
  f32x16 acc[2][2];
  acc_zero(acc);
  gemm_main_dma(acc, [&](int r) { return A + (size_t)r * K; }, [&](int r) { return W + (size_t)r * K; }, K, smem);
  float* Cs = (float*)smem;
  acc_to_lds(acc, Cs);
  __syncthreads();
  store_tile_bf16(Cs, dst, ldd, 128, 1.f);
  __syncthreads();
}

DI void plain_wide(const bf16* A, int K, const bf16* W, bf16* dst, int ldd, char* smem) {
  f32x16 acc[2][4];
  accw_zero(acc);
  gemm_wide(acc, [&](int r) { return A + (size_t)r * K; }, [&](int r) { return W + (size_t)r * K; }, K, smem);
  float* Cs = (float*)smem;
  accw_to_lds<0>(acc, Cs);
  __syncthreads();
  store_tile_bf16(Cs, dst, ldd, 128, 1.f);
  __syncthreads();
  accw_to_lds<1>(acc, Cs);
  __syncthreads();
  store_tile_bf16(Cs, dst + 128, ldd, 128, 1.f);
  __syncthreads();
}

DI void up_epi(const Params& p, int l, int jn, int seqbase, int len, int pos0, char* smem) {
  float* Cs = (float*)smem;
  const float* cw = p.in[I_CW] + (size_t)l * 3 * 2 * DFF;
  const float* cb = p.in[I_CB] + (size_t)l * 2 * DFF;
  bf16* G = (bf16*)(p.ws + OFF_G);
  const int tid = TIDX;
  const int c = (tid & 31) * 2;
  float wa[2][3], wv[2][3], ba[2], bv[2];
#pragma unroll
  for (int e = 0; e < 2; ++e) {
    const int ca = jn * 64 + c + e, cv = DFF + ca;
#pragma unroll
    for (int k = 0; k < 3; ++k) { wa[e][k] = cw[k * 2 * DFF + ca]; wv[e][k] = cw[k * 2 * DFF + cv]; }
    ba[e] = cb[ca]; bv[e] = cb[cv];
  }
#pragma unroll 4
  for (int rr = 1 + (tid >> 5); rr < 127; rr += 8) {
    const int pos = pos0 + rr;
    if (pos < len) {
      float gv[2];
#pragma unroll
      for (int e = 0; e < 2; ++e) {
        const float a = wa[e][0] * Cs[(rr - 1) * CLD + c + e] + wa[e][1] * Cs[rr * CLD + c + e] + wa[e][2] * Cs[(rr + 1) * CLD + c + e] + ba[e];
        const float v = wv[e][0] * Cs[(rr - 1) * CLD + 64 + c + e] + wv[e][1] * Cs[rr * CLD + 64 + c + e] +
                        wv[e][2] * Cs[(rr + 1) * CLD + 64 + c + e] + bv[e];
        gv[e] = siluf_(a) * v;
      }
      *(unsigned*)(G + (size_t)(seqbase + pos) * DFF + jn * 64 + c) = pack2(gv[0], gv[1]);
    }
  }
  __syncthreads();
}

DI void up_wide(const Params& p, int l, int mtile, int jp, char* smem) {
  const int b = mtile / 69, rr0 = mtile % 69;
  int seqbase, len, ti;
  if (rr0 < 3) { seqbase = b * TT; len = CTXL; ti = rr0; }
  else { seqbase = b * TT + CTXL; len = SEQ; ti = rr0 - 3; }
  const int pos0 = ti * 126 - 1;
  const bf16* H = (const bf16*)(p.ws + OFF_H);
  const bf16* W = wl(p, l, WL_UP) + (size_t)jp * 256 * DM;
  f32x16 acc[2][4];
  accw_zero(acc);
  gemm_wide(acc,
            [&](int r) -> const bf16* {
              const int pos = pos0 + r;
              return (pos >= 0 && pos < len) ? H + (size_t)(seqbase + pos) * DM : (const bf16*)(p.ws + OFF_ZERO);
            },
            [&](int r) { return W + (size_t)r * DM; }, DM, smem);
  float* Cs = (float*)smem;
  accw_to_lds<0>(acc, Cs);
  __syncthreads();
  up_epi(p, l, jp * 2, seqbase, len, pos0, smem);
  accw_to_lds<1>(acc, Cs);
  __syncthreads();
  up_epi(p, l, jp * 2 + 1, seqbase, len, pos0, smem);
}

DI bool gemm_job(int bid, int G, int it, int MT, int NTL, int& mt, int& nt, int CW = 8) {
  const int x = bid & 7, q = bid >> 3, Q = G >> 3;
  const int m0 = (x * MT) >> 3, m1 = ((x + 1) * MT) >> 3, Mx = m1 - m0;
  const int jl = q + Q * it;
  if (jl >= Mx * NTL) return false;
  const int full = Mx * CW;
  const int c = jl / full, rem = jl - c * full;
  const int wc = min(CW, NTL - CW * c);
  const int mi = rem / wc;
  mt = m0 + mi;
  nt = CW * c + (rem - mi * wc);
  return true;
}

enum { PH_PREP = 0, PH_ROW0, PH_PROJ, PH_MIX1, PH_SCAN, PH_MIX2, PH_GLU, PH_MERGE, PH_WOUT, PH_ROW1, PH_UP, PH_DOWN, PH_ROW2 };
constexpr int N_PHASES = 2 + 11 * NL;

DI void run_phase(const Params& p, int ph, int l, char* smem) {
  const int bid = blockIdx.x;
#ifdef HALFMASK
  const int G = ((HALFMASK >> ph) & 1) ? 256 : gridDim.x;
  if (bid >= G) return;
#else
  const int G = gridDim.x;
#endif
#ifdef PHMASK
  if (!((PHMASK >> ph) & 1)) return;
#endif
  switch (ph) {
    case PH_PREP:
      if (bid < 8) { for (int i = TIDX; i < 512; i += 256) ((u32x4*)(p.ws + OFF_ZERO))[i] = u32x4{0u, 0u, 0u, 0u}; }
      for (int j = bid; j < 128 + 4016; j += G) {
        if (j < 96) prep_mod_job(p, j, smem);
        else if (j < 128) prep_s5_job(p, j - 96);
        else prep_wt_job(p, j - 128, smem);
      }
      break;
    case PH_ROW0:
      row_phase<0>(p, 0, bid, G);
      ktab_phase(p, bid, G, 0, 1);
      break;
    case PH_PROJ:
#ifdef EXP_A
      if (bid < 256) { int mt, nt; for (int it = 0; gemm_job(bid, 256, it, 264, 10, mt, nt, 4); ++it) proj_wide(p, l, mt, nt, smem); }
      else {
        s5mat_phase(p, l, bid - 256, G - 256);
        if (l + 1 < NL) ktab_phase(p, bid - 256, G - 256, l + 1, l + 2);
        if (l + 1 < NL) { for (int jj = (l + 1) * 4016 + (bid - 256); jj < (l + 2) * 4016; jj += G - 256) prep_wt_job(p, jj, smem); }
      }
#elif defined(EXP_C)
      if (bid < 256) for (int j = bid; j < 264 * 19; j += 256) { if ((EXP_C >> (j % 19)) & 1) proj_tile(p, l, j / 19, j % 19, smem); }
      for (int j = bid; j < 264 * 19; j += G) { if (!((EXP_C >> (j % 19)) & 1)) proj_tile(p, l, j / 19, j % 19, smem); }
      s5mat_phase(p, l, bid, G);
#elif defined(EXP_B)
      for (int j = bid; j < 264 * 19; j += G) proj_tile(p, l, j / 19, j % 19, smem);
      if (bid < 256) s5mat_phase(p, l, bid, 256);
#else
      for (int j = bid; j < 264 * 19; j += G) proj_tile(p, l, j / 19, j % 19, smem);
      s5mat_phase(p, l, bid, G);
#endif
      break;
    case PH_MIX1:
      for (int j = bid; j < 1056 + 1056 + 288; j += G) {
        if (j < 1056) attn_unit(p, j, smem);
        else if (j < 2112) gla_unit<false>(p, l, j - 1056, smem);
        else s5_end_tile(p, j - 2112, smem);
      }
      break;
    case PH_SCAN:
      for (int j = bid; j < 1024 + 128; j += G) {
        if (j < 1024) gla_scan_job(p, j);
        else s5_scan_job(p, l, j - 1024, smem);
      }
      break;
    case PH_MIX2:
      for (int j = bid; j < 528 + 576; j += G) {
        if (j < 528) gla_unit<true>(p, l, j, smem);
        else s5_out_tile(p, j - 528, smem);
      }
      break;
    case PH_GLU:
      { int mt, nt; for (int it = 0; gemm_job(bid, G, it, 264, 2, mt, nt); ++it) glu_tile(p, l, mt * 2 + nt, smem); }
      break;
    case PH_MERGE:
      { int mt, nt; for (int it = 0; gemm_job(bid, G, it, 264, 8, mt, nt); ++it) merge_tile(p, l, mt * 8 + nt, smem); }
      break;
    case PH_WOUT:
      for (int it = 0;; ++it) {
        int mt, nt;
        if (!gemm_job(bid, G, it, 264, 8, mt, nt)) break;
        plain_tile((const bf16*)(p.ws + OFF_MG) + (size_t)mt * 128 * DM, DM, wl(p, l, WL_WOUT) + (size_t)nt * 128 * DM,
                   (bf16*)(p.ws + OFF_H) + (size_t)mt * 128 * DM + nt * 128, DM, smem);
      }
      break;
    case PH_ROW1: row_phase<1>(p, l, bid, G); break;
    case PH_UP:
      { int mt, nt; for (int it = 0; gemm_job(bid, G, it, 276, 22, mt, nt, 4); ++it) up_wide(p, l, mt, nt, smem); }
      break;
    case PH_DOWN:
      for (int it = 0;; ++it) {
        int mt, nt;
        if (!gemm_job(bid, G, it, 264, 8, mt, nt)) break;
        plain_tile((const bf16*)(p.ws + OFF_G) + (size_t)mt * 128 * DFF, DFF, wl(p, l, WL_DOWN) + (size_t)nt * 128 * DFF,
                   (bf16*)(p.ws + OFF_H) + (size_t)mt * 128 * DM + nt * 128, DM, smem);
      }
      break;
    case PH_ROW2: row_phase<2>(p, l, bid, G); break;
  }
}

#define XB_TMO      128
#define XB_XCNT(j)  (256  + 64 * (j))
#define XB_XSUB(j)  (1280 + 64 * (j))
#define XB_XGEN(j)  (2304 + 64 * (j))
#define XB_TOP      3328
#define XB_TOPGEN   3392
#define XCD_BAR_WORDS 3456
#define XB_SPIN_CAP (1u << 18)
#define LAS __attribute__((address_space(3)))

__device__ __forceinline__ unsigned xb_ld(unsigned* p)              { return __hip_atomic_load(p, __ATOMIC_RELAXED, __HIP_MEMORY_SCOPE_AGENT); }
__device__ __forceinline__ unsigned xb_add(unsigned* p, unsigned v) { return __hip_atomic_fetch_add(p, v, __ATOMIC_RELAXED, __HIP_MEMORY_SCOPE_AGENT); }
__device__ __forceinline__ unsigned xb_xcc_id() { return (unsigned)__builtin_amdgcn_s_getreg((3 << 11) | 20) & 0xFu; }
#define XB_SPIN(cond, bar) do { unsigned _sp = 0; while (cond) { __builtin_amdgcn_s_sleep(1); \
    if ((++_sp & 255u) == 0u) { if (xb_ld(&(bar)[XB_TMO])) break; if (_sp > XB_SPIN_CAP) { atomicAdd(&(bar)[XB_TMO], 1u); break; } } } } while (0)

struct XcdBarrier {
    unsigned* bar; unsigned x;
    volatile LAS unsigned* st;
};

__device__ __forceinline__ XcdBarrier xcd_barrier_post(unsigned* bar, volatile LAS unsigned* st) {
    XcdBarrier b; b.bar = bar; b.x = xb_xcc_id(); b.st = st;
    if (threadIdx.x == 0) (void)xb_add(&bar[XB_XCNT(b.x)], 1u);
    return b;
}
__device__ __forceinline__ void xcd_barrier_complete(unsigned* bar, unsigned x, unsigned& nloc, unsigned& nx) {
    const unsigned G = gridDim.x * gridDim.y * gridDim.z;
    unsigned sum, cnt, mine, sp = 0u;
    for (;;) {
        sum = 0u; cnt = 0u; mine = 0u;
#pragma unroll
        for (unsigned j = 0; j < 16; ++j) { const unsigned c = xb_ld(&bar[XB_XCNT(j)]); sum += c; cnt += (c > 0u) ? 1u : 0u; mine = (j == x) ? c : mine; }
        if (sum == G) break;
        __builtin_amdgcn_s_sleep(1);
        if ((++sp & 255u) == 0u) { if (xb_ld(&bar[XB_TMO])) break; if (sp > XB_SPIN_CAP) { atomicAdd(&bar[XB_TMO], 1u); break; } }
    }
    nloc = mine > 0u ? mine : 1u; nx = cnt > 0u ? cnt : 1u;
}

__device__ __forceinline__ void xcd_barrier(const XcdBarrier& b) {
    asm volatile("s_waitcnt vmcnt(0)" ::: "memory");
    __syncthreads();
    if (threadIdx.x == 0) {
        unsigned* bar = b.bar;
        __builtin_amdgcn_s_waitcnt(0);
        unsigned nloc = b.st[0], nx = b.st[1];
        if (nloc == 0u) { xcd_barrier_complete(bar, b.x, nloc, nx); b.st[0] = nloc; b.st[1] = nx; }
        const unsigned old = xb_add(&bar[XB_XSUB(b.x)], 1u);
        const unsigned gen = old / nloc;
        if (old + 1u == (gen + 1u) * nloc) {
            __builtin_amdgcn_fence(__ATOMIC_RELEASE, "agent");
            asm volatile("s_waitcnt vmcnt(0)" ::: "memory");
            const unsigned og = xb_add(&bar[XB_TOP], 1u);
            const unsigned tg = og / nx;
            if (og + 1u == (tg + 1u) * nx) xb_add(&bar[XB_TOPGEN], 1u);
            else XB_SPIN(xb_ld(&bar[XB_TOPGEN]) == tg, bar);
            __builtin_amdgcn_fence(__ATOMIC_ACQUIRE, "agent");
            xb_add(&bar[XB_XGEN(b.x)], 1u);
            asm volatile("s_waitcnt vmcnt(0)" ::: "memory");
        } else {
            XB_SPIN(xb_ld(&bar[XB_XGEN(b.x)]) == gen, bar);
            __builtin_amdgcn_fence(__ATOMIC_ACQUIRE, "agent");
            asm volatile("s_waitcnt vmcnt(0)" ::: "memory");
        }
    }
    __syncthreads();
}


DI void grid_barrier(unsigned* bar, unsigned& gen) {
  asm volatile("s_waitcnt vmcnt(0)" ::: "memory");
  __syncthreads();
  gen += 1;
  if (threadIdx.x == 0) {
    __builtin_amdgcn_fence(__ATOMIC_RELEASE, "agent");
    asm volatile("s_waitcnt vmcnt(0)" ::: "memory");
    const unsigned target = gen * gridDim.x;
    __hip_atomic_fetch_add(bar, 1u, __ATOMIC_RELAXED, __HIP_MEMORY_SCOPE_AGENT);
    while (__hip_atomic_load(bar, __ATOMIC_RELAXED, __HIP_MEMORY_SCOPE_AGENT) < target) __builtin_amdgcn_s_sleep(2);
  }
  __syncthreads();
  __builtin_amdgcn_fence(__ATOMIC_ACQUIRE, "agent");
  asm volatile("s_waitcnt vmcnt(0)" ::: "memory");
}

__global__ void __launch_bounds__(256, 2) hybrid_fwd(Params p, int ph_lo, int ph_hi) {
  extern __shared__ __attribute__((aligned(16))) char smem[];
  unsigned* bar = (unsigned*)(p.ws + OFF_BAR);
  unsigned gen = 0;
  __shared__ uint4 xb_words;
  if (threadIdx.x == 0) xb_words = make_uint4(0u, 0u, 0u, 0u);
  __syncthreads();
  XcdBarrier xb = xcd_barrier_post(bar + 64, (volatile LAS unsigned*)&xb_words);
  if (ph_hi - ph_lo > 1) cg::this_grid().sync();
  int i = 0;
#define STEP(PH, L)                                      \
  {                                                      \
    if (i >= ph_lo && i < ph_hi) {                       \
      Params q;                                          \
      q.ws = p.ws; q.out = p.out;                        \
      asm volatile("" : "+s"(q.ws), "+s"(q.out));        \
      _Pragma("unroll") for (int k = 0; k < 34; ++k) { q.in[k] = p.in[k]; asm volatile("" : "+s"(q.in[k])); } \
      run_phase(q, PH, L, smem);                         \
      if ((DUPMASK >> (PH)) & 1) { xcd_barrier(xb); run_phase(q, PH, L, smem); } \
      if (i + 1 < ph_hi) xcd_barrier(xb);                \
    }                                                    \
    ++i;                                                 \
  }
  STEP(PH_PREP, 0)
  STEP(PH_ROW0, 0)
#pragma unroll 1
  for (int l = 0; l < NL; ++l) {
    STEP(PH_PROJ, l)
    STEP(PH_MIX1, l)
    STEP(PH_SCAN, l)
    STEP(PH_MIX2, l)
    STEP(PH_GLU, l)
    STEP(PH_MERGE, l)
    STEP(PH_WOUT, l)
    STEP(PH_ROW1, l)
    STEP(PH_UP, l)
    STEP(PH_DOWN, l)
    STEP(PH_ROW2, l)
  }
#undef STEP
}

extern "C" void kernel_launch(void* const* d_in, const int* in_sizes, int n_in, void* d_out, int out_size, void* d_ws, size_t ws_size,
                              hipStream_t stream) {
  static int grid_blocks = 0;
  if (!grid_blocks) {
    int dev = 0, cus = 0, per_cu = 0;
    hipGetDevice(&dev);
    hipDeviceGetAttribute(&cus, hipDeviceAttributeMultiprocessorCount, dev);
    hipFuncSetAttribute((const void*)hybrid_fwd, hipFuncAttributeMaxDynamicSharedMemorySize, SMEM_BYTES);
    hipOccupancyMaxActiveBlocksPerMultiprocessor(&per_cu, hybrid_fwd, 256, SMEM_BYTES);
    if (per_cu < 1) per_cu = 1;
    if (per_cu > 2) per_cu = 2;
    grid_blocks = cus * per_cu;
    if (ws_size < OFF_ZERO + 8192) fprintf(stderr, "workspace too small: %zu < %zu\n", ws_size, (size_t)OFF_END);
  }
  Params p{};
  for (int i = 0; i < 34; ++i) p.in[i] = (const float*)d_in[i];
  p.out = (float*)d_out;
  p.ws = (char*)d_ws;
#if ONE_LAUNCH
  hipMemsetAsync((char*)d_ws + OFF_BAR, 0, 16384, stream);
  int lo = 0, hi = N_PHASES;
  void* args[] = {&p, &lo, &hi};
  hipError_t e = hipLaunchCooperativeKernel((void*)hybrid_fwd, dim3(grid_blocks), dim3(256), args, SMEM_BYTES, stream);
  if (e != hipSuccess) fprintf(stderr, "cooperative launch failed: %s (grid %d)\n", hipGetErrorString(e), grid_blocks);
#else
  for (int i = 0; i < N_PHASES; ++i) hipLaunchKernelGGL(hybrid_fwd, dim3(grid_blocks), dim3(256), SMEM_BYTES, stream, p, i, i + 1);
#endif
}
```

```cpp
#include <hip/hip_runtime.h>
#include <hip/hip_cooperative_groups.h>
#include <stdint.h>
#include <cstdio>
namespace cg = cooperative_groups;

#define EXP_A 1
#ifndef DUPMASK
#define DUPMASK 0
#endif
#ifndef ONE_LAUNCH
#define ONE_LAUNCH 1
#endif

typedef unsigned short bf16;
typedef __attribute__((ext_vector_type(8))) short s16x8;
typedef __attribute__((ext_vector_type(4))) short s16x4;
typedef __attribute__((ext_vector_type(16))) float f32x16;
typedef __attribute__((ext_vector_type(4))) float f32x4;
typedef __attribute__((ext_vector_type(2))) float f32x2;
typedef __attribute__((ext_vector_type(4))) unsigned u32x4;
typedef __attribute__((ext_vector_type(2))) unsigned u32x2;
typedef __attribute__((ext_vector_type(2))) __bf16 bf16x2_t;

#define DI __device__ __forceinline__
#define MFMA32(a, b, c) __builtin_amdgcn_mfma_f32_32x32x16_bf16((a), (b), (c), 0, 0, 0)

DI int tidx_opaque() { int t = threadIdx.x; asm volatile("" : "+v"(t)); return t; }
#define TIDX tidx_opaque()
DI bf16 f2bf(float x) { return __builtin_bit_cast(unsigned short, (__bf16)x); }
DI float bf2f(bf16 v) { return __uint_as_float(((unsigned)v) << 16); }
DI unsigned pack2(float a, float b) {
  f32x2 v = {a, b};
  return __builtin_bit_cast(unsigned, __builtin_convertvector(v, bf16x2_t));
}
DI float bflo(unsigned u) { return __uint_as_float(u << 16); }
DI float bfhi(unsigned u) { return __uint_as_float(u & 0xffff0000u); }
typedef const __attribute__((address_space(1))) u32x4* gptr16;
DI u32x4 ldg16(const void* q) { return *(gptr16)(uintptr_t)q; }
#define SCHED_FENCE() __builtin_amdgcn_sched_barrier(0)
DI int crow(int i, int h) { return (i & 3) + 8 * (i >> 2) + 4 * h; }
DI void sincos_cw(float x, float& sn, float& cs) {
  const float k = rintf(x * 0.63661977236758134f);
  float r = fmaf(-k, 1.57079637050628662109375f, x);
  r = fmaf(-k, -4.371139000186241e-08f, r);
  const int q = ((int)k) & 3;
  const float r2 = r * r;
  const float sp = r + r * r2 * (-1.6666667163e-01f + r2 * (8.3333337680e-03f + r2 * (-1.9841270114e-04f + r2 * 2.7557314297e-06f)));
  const float cp = 1.f + r2 * (-0.5f + r2 * (4.1666667908e-02f + r2 * (-1.3888889225e-03f + r2 * (2.4801587642e-05f - r2 * 2.7557314297e-07f))));
  sn = (q == 0) ? sp : (q == 1) ? cp : (q == 2) ? -sp : -cp;
  cs = (q == 0) ? cp : (q == 1) ? -sp : (q == 2) ? -cp : sp;
}
DI float sigmoidf_(float x) { return 1.f / (1.f + __expf(-x)); }
DI float siluf_(float x) { return x / (1.f + __expf(-x)); }

constexpr int DM = 1024, NB = 4, SEQ = 8192, CTXL = 256, TT = SEQ + CTXL, NTOK = NB * TT, NL = 4;
constexpr int DFF = 2816, DIN = 5408;
constexpr float EPSF = 1e-6f;
constexpr int NG33 = 33;
constexpr int NCH = 264;
constexpr int MS5 = NB * NCH;

constexpr size_t SZ_H = (size_t)NTOK * 1024 * 2;
constexpr size_t OFF_H = 0;
constexpr size_t OFF_P = OFF_H + SZ_H;
constexpr size_t OFF_Q = OFF_P;
constexpr size_t OFF_K = OFF_Q + (size_t)NTOK * 256 * 2;
constexpr size_t OFF_VT = OFF_K + (size_t)NTOK * 128 * 2;
constexpr size_t OFF_GQ = OFF_VT + (size_t)NTOK * 128 * 2;
constexpr size_t OFF_GK = OFF_GQ + (size_t)NTOK * 256 * 2;
constexpr size_t OFF_GVT = OFF_GK + (size_t)NTOK * 256 * 2;
constexpr size_t OFF_GR = OFF_GVT + (size_t)NTOK * 512 * 2;
constexpr size_t OFF_SU = OFF_GR + (size_t)NTOK * 512 * 2;
constexpr size_t OFF_LOW = OFF_SU + (size_t)NTOK * 256 * 2;
constexpr size_t OFF_O = OFF_LOW + (size_t)NTOK * 32 * 4;
constexpr size_t OFF_OATT = OFF_O;
constexpr size_t OFF_OGLA = OFF_OATT + (size_t)NTOK * 256 * 2;
constexpr size_t OFF_Y5 = OFF_OGLA + (size_t)NTOK * 512 * 2;
constexpr size_t OFF_EN = OFF_Y5;
constexpr size_t OFF_OS5 = OFF_Y5 + (size_t)NTOK * 256 * 2;
constexpr size_t OFF_M = OFF_OS5 + (size_t)NTOK * 256 * 2;
constexpr size_t OFF_MG = OFF_M;
constexpr size_t OFF_GS = OFF_M;
constexpr size_t OFF_DECG = OFF_GS + (size_t)32 * 33 * 8192 * 4;
constexpr size_t OFF_SB = OFF_DECG + (size_t)32 * 33 * 64 * 4;
constexpr size_t OFF_T5 = OFF_SB + (size_t)MS5 * 16 * 256 * 2;
constexpr size_t OFF_E5 = OFF_T5 + (size_t)16 * 512 * 512 * 2;
constexpr size_t OFF_F5 = OFF_E5 + (size_t)16 * 512 * 256 * 2;
constexpr size_t OFF_MEND = OFF_F5 + (size_t)16 * 256 * 512 * 2;
static_assert(OFF_MEND <= OFF_M + SZ_H, "mixer scratch overflows merged area");
constexpr size_t OFF_W = OFF_M + SZ_H;
constexpr size_t WL_WIN = 0, WL_BRA = WL_WIN + (size_t)5504 * 1024, WL_BRG = WL_BRA + 1024 * 256, WL_BRS = WL_BRG + 1024 * 512,
                 WL_WOUT = WL_BRS + 1024 * 256, WL_UP = WL_WOUT + 1024 * 1024, WL_DOWN = WL_UP + (size_t)5632 * 1024,
                 WL_GLU = WL_DOWN + (size_t)1024 * 2816, WL_TOTAL = WL_GLU + 256 * 256;
constexpr size_t OFF_XC = OFF_W + WL_TOTAL * 2 * NL;
constexpr size_t OFF_MOD = OFF_XC + (size_t)NB * CTXL * 1024 * 4;
constexpr size_t OFF_BBR = OFF_MOD + (size_t)NL * 5 * 6144 * 4;
constexpr size_t OFF_BBI = OFF_BBR + (size_t)NL * 2 * 16 * 64 * 16 * 4;
constexpr size_t OFF_PWR = OFF_BBI + (size_t)NL * 2 * 16 * 64 * 16 * 4;
constexpr size_t OFF_KTAB = OFF_PWR + (size_t)NL * 2 * 16 * 33 * 64 * 8;
constexpr size_t OFF_END = OFF_KTAB + (size_t)NL * 16 * 2 * 32 * 256 * 4;
constexpr size_t OFF_BAR = OFF_END;
constexpr size_t OFF_ZERO = OFF_BAR + 16384;
constexpr size_t OFF_G = OFF_P;
static_assert((size_t)NTOK * DFF * 2 <= OFF_M - OFF_P, "G overflows");

constexpr int SMEM_BYTES = 73728;

struct Params {
  const float* in[34];
  float* out;
  char* ws;
};

enum { I_X = 0, I_C, I_CTX, I_CCTX, I_ADAW, I_ADAB, I_NMPRE, I_NMPOST, I_NFPRE, I_NFPOST, I_WIN, I_QN, I_KN, I_GGW, I_GGB, I_GON,
       I_ARE, I_AIM, I_LDT, I_BRE, I_BIM, I_CRE, I_CIM, I_S5D, I_GLUW, I_GLUB, I_WBA, I_WBG, I_WBS, I_WOUT, I_UP, I_CW, I_CB, I_DOWN };

constexpr int LDT = 72;
constexpr int CLD = 132;

template <class FA, class FB>
DI void gemm_main(f32x16 (&acc)[2][2], FA fa, FB fb, int K, char* smem) {
  bf16* As = (bf16*)smem;
  bf16* Bs = (bf16*)(smem + 2 * 128 * LDT * 2);
  const int tid = TIDX, lane = tid & 63, w = tid >> 6, wm = w >> 1, wn = w & 1;
  const int r = lane & 31, h = lane >> 5;
  const int lr = tid >> 3, kc = (tid & 7) * 8;
  const bf16* ap[4];
  const bf16* bp[4];
#pragma unroll
  for (int i = 0; i < 4; ++i) {
    const bf16* a = fa(lr + 32 * i);
    const bf16* b = fb(lr + 32 * i);
    ap[i] = a ? a + kc : nullptr;
    bp[i] = b ? b + kc : nullptr;
  }
  u32x4 ra[4], rb[4];
  const u32x4 z4 = {0u, 0u, 0u, 0u};
#pragma unroll
  for (int i = 0; i < 4; ++i) {
    ra[i] = ap[i] ? ldg16(ap[i]) : z4;
    rb[i] = bp[i] ? ldg16(bp[i]) : z4;
  }
#pragma unroll
  for (int i = 0; i < 4; ++i) {
    *(u32x4*)(As + (lr + 32 * i) * LDT + kc) = ra[i];
    *(u32x4*)(Bs + (lr + 32 * i) * LDT + kc) = rb[i];
  }
  __syncthreads();
  const int nk = K / 64;
  for (int kt = 0; kt < nk; ++kt) {
    const int buf = kt & 1;
    const bool more = (kt + 1 < nk);
    if (more) {
      const int k0 = (kt + 1) * 64;
#pragma unroll
      for (int i = 0; i < 4; ++i) {
        ra[i] = ap[i] ? ldg16(ap[i] + k0) : z4;
        rb[i] = bp[i] ? ldg16(bp[i] + k0) : z4;
      }
    }
    SCHED_FENCE();
    const bf16* Ab = As + buf * 128 * LDT + (wm * 64 + r) * LDT + h * 8;
    const bf16* Bb = Bs + buf * 128 * LDT + (wn * 64 + r) * LDT + h * 8;
#pragma unroll
    for (int s = 0; s < 4; ++s) {
      s16x8 a0 = *(const s16x8*)(Ab + s * 16);
      s16x8 a1 = *(const s16x8*)(Ab + 32 * LDT + s * 16);
      s16x8 b0 = *(const s16x8*)(Bb + s * 16);
      s16x8 b1 = *(const s16x8*)(Bb + 32 * LDT + s * 16);
      acc[0][0] = MFMA32(a0, b0, acc[0][0]);
      acc[0][1] = MFMA32(a0, b1, acc[0][1]);
      acc[1][0] = MFMA32(a1, b0, acc[1][0]);
      acc[1][1] = MFMA32(a1, b1, acc[1][1]);
    }
    SCHED_FENCE();
    if (more) {
      bf16* Aw = As + (buf ^ 1) * 128 * LDT;
      bf16* Bw = Bs + (buf ^ 1) * 128 * LDT;
#pragma unroll
      for (int i = 0; i < 4; ++i) {
        *(u32x4*)(Aw + (lr + 32 * i) * LDT + kc) = ra[i];
        *(u32x4*)(Bw + (lr + 32 * i) * LDT + kc) = rb[i];
      }
    }
    __syncthreads();
  }
}

template <class FA, class FB>
DI void gemm_main_deep(f32x16 (&acc)[2][2], FA fa, FB fb, int K, char* smem) {
  bf16* As = (bf16*)smem;
  bf16* Bs = (bf16*)(smem + 2 * 128 * LDT * 2);
  const int tid = TIDX, lane = tid & 63, w = tid >> 6, wm = w >> 1, wn = w & 1;
  const int r = lane & 31, h = lane >> 5;
  const int lr = tid >> 3, kc = (tid & 7) * 8;
  const bf16* ap[4];
  const bf16* bp[4];
#pragma unroll
  for (int i = 0; i < 4; ++i) {
    const bf16* a = fa(lr + 32 * i);
    const bf16* b = fb(lr + 32 * i);
    ap[i] = a ? a + kc : nullptr;
    bp[i] = b ? b + kc : nullptr;
  }
  const u32x4 z4 = {0u, 0u, 0u, 0u};
  u32x4 a0[4], b0[4], a1[4], b1[4];
  const int nk = K / 64;
#define GD_LOAD(RA, RB, T)                                               \
  {                                                                      \
    const int k0_ = (T) * 64;                                            \
    _Pragma("unroll") for (int i = 0; i < 4; ++i) {                      \
      RA[i] = ap[i] ? ldg16(ap[i] + k0_) : z4;                           \
      RB[i] = bp[i] ? ldg16(bp[i] + k0_) : z4;                           \
    }                                                                    \
  }
#define GD_STORE(RA, RB, BUF)                                            \
  {                                                                      \
    _Pragma("unroll") for (int i = 0; i < 4; ++i) {                      \
      *(u32x4*)(As + (BUF) * 128 * LDT + (lr + 32 * i) * LDT + kc) = RA[i]; \
      *(u32x4*)(Bs + (BUF) * 128 * LDT + (lr + 32 * i) * LDT + kc) = RB[i]; \
    }                                                                    \
  }
#define GD_COMPUTE(BUF)                                                  \
  {                                                                      \
    const bf16* Ab = As + (BUF) * 128 * LDT + (wm * 64 + r) * LDT + h * 8; \
    const bf16* Bb = Bs + (BUF) * 128 * LDT + (wn * 64 + r) * LDT + h * 8; \
    _Pragma("unroll") for (int s = 0; s < 4; ++s) {                      \
      s16x8 fa0 = *(const s16x8*)(Ab + s * 16);                          \
      s16x8 fa1 = *(const s16x8*)(Ab + 32 * LDT + s * 16);               \
      s16x8 fb0 = *(const s16x8*)(Bb + s * 16);                          \
      s16x8 fb1 = *(const s16x8*)(Bb + 32 * LDT + s * 16);               \
      acc[0][0] = MFMA32(fa0, fb0, acc[0][0]);                           \
      acc[0][1] = MFMA32(fa0, fb1, acc[0][1]);                           \
      acc[1][0] = MFMA32(fa1, fb0, acc[1][0]);                           \
      acc[1][1] = MFMA32(fa1, fb1, acc[1][1]);                           \
    }                                                                    \
  }
  GD_LOAD(a0, b0, 0)
  GD_LOAD(a1, b1, 1)
  GD_STORE(a0, b0, 0)
  __syncthreads();
  if (nk > 2) GD_LOAD(a0, b0, 2)
  for (int kt = 0; kt < nk; kt += 2) {
    SCHED_FENCE();
    GD_COMPUTE(0)
    SCHED_FENCE();
    GD_STORE(a1, b1, 1)
    if (kt + 3 < nk) GD_LOAD(a1, b1, kt + 3)
    __syncthreads();
    SCHED_FENCE();
    GD_COMPUTE(1)
    SCHED_FENCE();
    if (kt + 2 < nk) {
      GD_STORE(a0, b0, 0)
      if (kt + 4 < nk) GD_LOAD(a0, b0, kt + 4)
    }
    __syncthreads();
  }
#undef GD_LOAD
#undef GD_STORE
#undef GD_COMPUTE
}

template <class FA, class FB>
DI void gemm_main_dma(f32x16 (&acc)[2][2], FA fa, FB fb, int K, char* smem) {
  char* As = smem;
  char* Bs = smem + 32768;
  const int tid = TIDX, lane = tid & 63, w = tid >> 6, wm = w >> 1, wn = w & 1;
  const int r = lane & 31, h = lane >> 5;
  const bf16* ap[4];
  const bf16* bp[4];
#pragma unroll
  for (int i = 0; i < 4; ++i) {
    const int row = w * 32 + i * 8 + (lane >> 3);
    const int c = (lane & 7) ^ ((row >> 1) & 7);
    ap[i] = fa(row) + c * 8;
    bp[i] = fb(row) + c * 8;
  }
  const int ldst = (w * 256 + lane) * 16;
#define GM_DMA(BUF, T)                                                                                        \
  {                                                                                                           \
    const int k0_ = (T) * 64;                                                                                 \
    _Pragma("unroll") for (int i = 0; i < 4; ++i) {                                                           \
      __builtin_amdgcn_global_load_lds((const unsigned*)(ap[i] + k0_), (unsigned*)(As + (BUF) * 16384 + ldst + i * 1024), 16, 0, 0); \
      __builtin_amdgcn_global_load_lds((const unsigned*)(bp[i] + k0_), (unsigned*)(Bs + (BUF) * 16384 + ldst + i * 1024), 16, 0, 0); \
    }                                                                                                         \
  }
  const int xr = (r >> 1) & 7;
  const int arow = (wm * 64 + r) * 128, brow = (wn * 64 + r) * 128;
  GM_DMA(0, 0)
  asm volatile("s_waitcnt vmcnt(0)" ::: "memory");
  __syncthreads();
  const int nk = K / 64;
  for (int kt = 0; kt < nk; ++kt) {
    const int buf = kt & 1;
    if (kt + 1 < nk) GM_DMA(buf ^ 1, kt + 1)
    const char* Ab = As + buf * 16384 + arow;
    const char* Bb = Bs + buf * 16384 + brow;
#pragma unroll
    for (int s = 0; s < 4; ++s) {
      const int co = ((2 * s + h) ^ xr) * 16;
      s16x8 a0 = *(const s16x8*)(Ab + co);
      s16x8 a1 = *(const s16x8*)(Ab + 32 * 128 + co);
      s16x8 b0 = *(const s16x8*)(Bb + co);
      s16x8 b1 = *(const s16x8*)(Bb + 32 * 128 + co);
      acc[0][0] = MFMA32(a0, b0, acc[0][0]);
      acc[0][1] = MFMA32(a0, b1, acc[0][1]);
      acc[1][0] = MFMA32(a1, b0, acc[1][0]);
      acc[1][1] = MFMA32(a1, b1, acc[1][1]);
    }
    asm volatile("s_waitcnt vmcnt(0)" ::: "memory");
    __syncthreads();
  }
#undef GM_DMA
}

DI void gemm_main_dma_half(f32x16 (&acc)[2], const bf16* A, int lda, const bf16* B, int ldb, int K, int hf, char* smem) {
  char* As = smem;
  char* Bs = smem + 32768;
  const int tid = TIDX, lane = tid & 63, w = tid >> 6, wm = w >> 1, wn = w & 1;
  const int r = lane & 31, h = lane >> 5;
  const bf16* ap[4];
  const bf16* bp[2];
#pragma unroll
  for (int i = 0; i < 4; ++i) {
    const int row = w * 32 + i * 8 + (lane >> 3);
    ap[i] = A + (size_t)row * lda + ((lane & 7) ^ ((row >> 1) & 7)) * 8;
  }
#pragma unroll
  for (int i = 0; i < 2; ++i) {
    const int lrow = w * 16 + i * 8 + (lane >> 3);
    const int grow = (lrow >> 5) * 64 + hf * 32 + (lrow & 31);
    bp[i] = B + (size_t)grow * ldb + ((lane & 7) ^ ((lrow >> 1) & 7)) * 8;
  }
  const int lda_ = (w * 256 + lane) * 16, ldb_ = (w * 128 + lane) * 16;
#define GH_DMA(BUF, T)                                                                                        \
  {                                                                                                           \
    const int k0_ = (T) * 64;                                                                                 \
    _Pragma("unroll") for (int i = 0; i < 4; ++i)                                                             \
      __builtin_amdgcn_global_load_lds((const unsigned*)(ap[i] + k0_), (unsigned*)(As + (BUF) * 16384 + lda_ + i * 1024), 16, 0, 0); \
    _Pragma("unroll") for (int i = 0; i < 2; ++i)                                                             \
      __builtin_amdgcn_global_load_lds((const unsigned*)(bp[i] + k0_), (unsigned*)(Bs + (BUF) * 8192 + ldb_ + i * 1024), 16, 0, 0); \
  }
  const int xr = (r >> 1) & 7;
  const int arow = (wm * 64 + r) * 128, brow = (wn * 32 + r) * 128;
  GH_DMA(0, 0)
  asm volatile("s_waitcnt vmcnt(0)" ::: "memory");
  __syncthreads();
  const int nk = K / 64;
  for (int kt = 0; kt < nk; ++kt) {
    const int buf = kt & 1;
    if (kt + 1 < nk) GH_DMA(buf ^ 1, kt + 1)
    const char* Ab = As + buf * 16384 + arow;
    const char* Bb = Bs + buf * 8192 + brow;
#pragma unroll
    for (int s = 0; s < 4; ++s) {
      const int co = ((2 * s + h) ^ xr) * 16;
      s16x8 a0 = *(const s16x8*)(Ab + co);
      s16x8 a1 = *(const s16x8*)(Ab + 32 * 128 + co);
      s16x8 b0 = *(const s16x8*)(Bb + co);
      acc[0] = MFMA32(a0, b0, acc[0]);
      acc[1] = MFMA32(a1, b0, acc[1]);
    }
    asm volatile("s_waitcnt vmcnt(0)" ::: "memory");
    __syncthreads();
  }
#undef GH_DMA
}

template <class FA, class FB>
DI void gemm_wide(f32x16 (&acc)[2][4], FA fa, FB fb, int K, char* smem) {
  const int tid = TIDX, lane = tid & 63, w = tid >> 6, wm = w >> 1, wn = w & 1;
  const int r = lane & 31, h = lane >> 5;
  const bf16* ap[2];
  const bf16* bp[4];
#pragma unroll
  for (int i = 0; i < 2; ++i) {
    const int row = w * 32 + i * 16 + (lane >> 2);
    ap[i] = fa(row) + ((lane & 3) ^ ((row >> 2) & 3)) * 8;
  }
#pragma unroll
  for (int i = 0; i < 4; ++i) {
    const int row = w * 64 + i * 16 + (lane >> 2);
    bp[i] = fb(row) + ((lane & 3) ^ ((row >> 2) & 3)) * 8;
  }
  const int lda_ = (w * 128 + lane) * 16;
  const int ldb_ = 8192 + (w * 256 + lane) * 16;
#define GW_DMA(T)                                                                                                   \
  {                                                                                                                 \
    char* st_ = smem + ((T) % 3) * 24576;                                                                           \
    const int k0_ = (T) * 32;                                                                                       \
    _Pragma("unroll") for (int i = 0; i < 2; ++i)                                                                   \
      __builtin_amdgcn_global_load_lds((const unsigned*)(ap[i] + k0_), (unsigned*)(st_ + lda_ + i * 1024), 16, 0, 0); \
    _Pragma("unroll") for (int i = 0; i < 4; ++i)                                                                   \
      __builtin_amdgcn_global_load_lds((const unsigned*)(bp[i] + k0_), (unsigned*)(st_ + ldb_ + i * 1024), 16, 0, 0); \
  }
  const int xr = (r >> 2) & 3;
  const int arow = (wm * 64 + r) * 64;
  const int brow = 8192 + (wn * 64 + r) * 64;
  const int nt = K / 32;
  GW_DMA(0)
  if (nt > 1) GW_DMA(1)
  for (int t = 0; t < nt; ++t) {
    if (t + 1 < nt) asm volatile("s_waitcnt vmcnt(6)" ::: "memory");
    else asm volatile("s_waitcnt vmcnt(0)" ::: "memory");
    __syncthreads();
    if (t + 2 < nt) GW_DMA(t + 2)
    const char* st = smem + (t % 3) * 24576;
#pragma unroll
    for (int s = 0; s < 2; ++s) {
      const int co = ((2 * s + h) ^ xr) * 16;
      const s16x8 a0 = *(const s16x8*)(st + arow + co);
      const s16x8 a1 = *(const s16x8*)(st + arow + 32 * 64 + co);
#pragma unroll
      for (int hn = 0; hn < 2; ++hn) {
        const s16x8 b0 = *(const s16x8*)(st + brow + hn * 128 * 64 + co);
        const s16x8 b1 = *(const s16x8*)(st + brow + hn * 128 * 64 + 32 * 64 + co);
        acc[0][hn * 2 + 0] = MFMA32(a0, b0, acc[0][hn * 2 + 0]);
        acc[0][hn * 2 + 1] = MFMA32(a0, b1, acc[0][hn * 2 + 1]);
        acc[1][hn * 2 + 0] = MFMA32(a1, b0, acc[1][hn * 2 + 0]);
        acc[1][hn * 2 + 1] = MFMA32(a1, b1, acc[1][hn * 2 + 1]);
      }
    }
  }
  __syncthreads();
#undef GW_DMA
}

DI void accw_zero(f32x16 (&acc)[2][4]) {
#pragma unroll
  for (int a = 0; a < 2; ++a)
#pragma unroll
    for (int b = 0; b < 4; ++b)
#pragma unroll
      for (int i = 0; i < 16; ++i) acc[a][b][i] = 0.f;
}

DI void gemm_main_s(f32x16 (&acc)[2][2], const bf16* A, int lda, const bf16* B, int ldb, int K, char* smem) {
  bf16* As = (bf16*)smem;
  bf16* Bs = (bf16*)(smem + 2 * 128 * LDT * 2);
  const int tid = TIDX, lane = tid & 63, w = tid >> 6, wm = w >> 1, wn = w & 1;
  const int r = lane & 31, h = lane >> 5;
  const int lr = tid >> 3, kc = (tid & 7) * 8;
  const bf16* ap = A + (size_t)lr * lda + kc;
  const bf16* bp = B + (size_t)lr * ldb + kc;
  const size_t sa = (size_t)32 * lda, sb = (size_t)32 * ldb;
  u32x4 ra[4], rb[4];
#pragma unroll
  for (int i = 0; i < 4; ++i) {
    ra[i] = ldg16(ap + i * sa);
    rb[i] = ldg16(bp + i * sb);
  }
#pragma unroll
  for (int i = 0; i < 4; ++i) {
    *(u32x4*)(As + (lr + 32 * i) * LDT + kc) = ra[i];
    *(u32x4*)(Bs + (lr + 32 * i) * LDT + kc) = rb[i];
  }
  __syncthreads();
  const int nk = K / 64;
  for (int kt = 0; kt < nk; ++kt) {
    const int buf = kt & 1;
    const bool more = (kt + 1 < nk);
    if (more) {
      ap += 64; bp += 64;
#pragma unroll
      for (int i = 0; i < 4; ++i) {
        ra[i] = ldg16(ap + i * sa);
        rb[i] = ldg16(bp + i * sb);
      }
    }
    SCHED_FENCE();
    const bf16* Ab = As + buf * 128 * LDT + (wm * 64 + r) * LDT + h * 8;
    const bf16* Bb = Bs + buf * 128 * LDT + (wn * 64 + r) * LDT + h * 8;
#pragma unroll
    for (int s = 0; s < 4; ++s) {
      s16x8 a0 = *(const s16x8*)(Ab + s * 16);
      s16x8 a1 = *(const s16x8*)(Ab + 32 * LDT + s * 16);
      s16x8 b0 = *(const s16x8*)(Bb + s * 16);
      s16x8 b1 = *(const s16x8*)(Bb + 32 * LDT + s * 16);
      acc[0][0] = MFMA32(a0, b0, acc[0][0]);
      acc[0][1] = MFMA32(a0, b1, acc[0][1]);
      acc[1][0] = MFMA32(a1, b0, acc[1][0]);
      acc[1][1] = MFMA32(a1, b1, acc[1][1]);
    }
    SCHED_FENCE();
    if (more) {
      bf16* Aw = As + (buf ^ 1) * 128 * LDT;
      bf16* Bw = Bs + (buf ^ 1) * 128 * LDT;
#pragma unroll
      for (int i = 0; i < 4; ++i) {
        *(u32x4*)(Aw + (lr + 32 * i) * LDT + kc) = ra[i];
        *(u32x4*)(Bw + (lr + 32 * i) * LDT + kc) = rb[i];
      }
    }
    __syncthreads();
  }
}

DI void gemm_main_half(f32x16 (&acc)[2], const bf16* A, int lda, const bf16* B, int ldb, int K, int hf, char* smem) {
  bf16* As = (bf16*)smem;
  bf16* Bs = (bf16*)(smem + 2 * 128 * LDT * 2);
  const int tid = TIDX, lane = tid & 63, w = tid >> 6, wm = w >> 1, wn = w & 1;
  const int r = lane & 31, h = lane >> 5;
  const int lr = tid >> 3, kc = (tid & 7) * 8;
  const bf16* ap = A + (size_t)lr * lda + kc;
  const bf16* bp = B + (size_t)(hf * 32 + lr) * ldb + kc;
  const size_t sa = (size_t)32 * lda, sb = (size_t)64 * ldb;
  u32x4 ra[4], rb[2];
#pragma unroll
  for (int i = 0; i < 4; ++i) ra[i] = ldg16(ap + i * sa);
#pragma unroll
  for (int i = 0; i < 2; ++i) rb[i] = ldg16(bp + i * sb);
#pragma unroll
  for (int i = 0; i < 4; ++i) *(u32x4*)(As + (lr + 32 * i) * LDT + kc) = ra[i];
#pragma unroll
  for (int i = 0; i < 2; ++i) *(u32x4*)(Bs + (lr + 32 * i) * LDT + kc) = rb[i];
  __syncthreads();
  const int nk = K / 64;
  for (int kt = 0; kt < nk; ++kt) {
    const int buf = kt & 1;
    const bool more = (kt + 1 < nk);
    if (more) {
      ap += 64; bp += 64;
#pragma unroll
      for (int i = 0; i < 4; ++i) ra[i] = ldg16(ap + i * sa);
#pragma unroll
      for (int i = 0; i < 2; ++i) rb[i] = ldg16(bp + i * sb);
    }
    SCHED_FENCE();
    const bf16* Ab = As + buf * 128 * LDT + (wm * 64 + r) * LDT + h * 8;
    const bf16* Bb = Bs + buf * 128 * LDT + (wn * 32 + r) * LDT + h * 8;
#pragma unroll
    for (int s = 0; s < 4; ++s) {
      s16x8 a0 = *(const s16x8*)(Ab + s * 16);
      s16x8 a1 = *(const s16x8*)(Ab + 32 * LDT + s * 16);
      s16x8 b0 = *(const s16x8*)(Bb + s * 16);
      acc[0] = MFMA32(a0, b0, acc[0]);
      acc[1] = MFMA32(a1, b0, acc[1]);
    }
    SCHED_FENCE();
    if (more) {
      bf16* Aw = As + (buf ^ 1) * 128 * LDT;
      bf16* Bw = Bs + (buf ^ 1) * 128 * LDT;
#pragma unroll
      for (int i = 0; i < 4; ++i) *(u32x4*)(Aw + (lr + 32 * i) * LDT + kc) = ra[i];
#pragma unroll
      for (int i = 0; i < 2; ++i) *(u32x4*)(Bw + (lr + 32 * i) * LDT + kc) = rb[i];
    }
    __syncthreads();
  }
}

DI void acc_zero(f32x16 (&acc)[2][2]) {
#pragma unroll
  for (int a = 0; a < 2; ++a)
#pragma unroll
    for (int b = 0; b < 2; ++b)
#pragma unroll
      for (int i = 0; i < 16; ++i) acc[a][b][i] = 0.f;
}

DI void acc_to_lds(const f32x16 (&acc)[2][2], float* Cs) {
  const int lane = TIDX & 63, w = TIDX >> 6, wm = w >> 1, wn = w & 1, r = lane & 31, h = lane >> 5;
#pragma unroll
  for (int tm = 0; tm < 2; ++tm)
#pragma unroll
    for (int tn = 0; tn < 2; ++tn)
#pragma unroll
      for (int i = 0; i < 16; ++i) Cs[(wm * 64 + tm * 32 + crow(i, h)) * CLD + wn * 64 + tn * 32 + r] = acc[tm][tn][i];
}

template <int HN>
DI void accw_to_lds(const f32x16 (&acc)[2][4], float* Cs) {
  const int lane = TIDX & 63, w = TIDX >> 6, wm = w >> 1, wn = w & 1, r = lane & 31, h = lane >> 5;
#pragma unroll
  for (int tm = 0; tm < 2; ++tm)
#pragma unroll
    for (int tn = 0; tn < 2; ++tn)
#pragma unroll
      for (int i = 0; i < 16; ++i) Cs[(wm * 64 + tm * 32 + crow(i, h)) * CLD + wn * 64 + tn * 32 + r] = acc[tm][HN * 2 + tn][i];
}

DI void store_tile_bf16(const float* Cs, bf16* dst, size_t ld, int mvalid, float scale) {
  for (int c = TIDX; c < 2048; c += 256) {
    const int row = c >> 4, cc = (c & 15) * 8;
    if (row < mvalid) {
      const float* s = Cs + row * CLD + cc;
      u32x4 v;
      v[0] = pack2(s[0] * scale, s[1] * scale);
      v[1] = pack2(s[2] * scale, s[3] * scale);
      v[2] = pack2(s[4] * scale, s[5] * scale);
      v[3] = pack2(s[6] * scale, s[7] * scale);
      *(u32x4*)(dst + (size_t)row * ld + cc) = v;
    }
  }
}

DI float* resid_row(const Params& p, int tok) {
  const int b = tok / TT, t = tok - b * TT;
  return (t < CTXL) ? (float*)(p.ws + OFF_XC) + ((size_t)b * CTXL + t) * DM : p.out + ((size_t)b * SEQ + (t - CTXL)) * DM;
}
DI const float* mod_vec(const Params& p, int l, int tok, int which) {
  const int b = tok / TT, t = tok - b * TT;
  const int m = (t < CTXL) ? 4 : b;
  return (const float*)(p.ws + OFF_MOD) + ((size_t)(l * 5 + m) * 6 + which) * DM;
}
DI float wave_sum(float v) {
#pragma unroll
  for (int o = 32; o >= 1; o >>= 1) v += __shfl_xor(v, o, 64);
  return v;
}
DI bf16* wl(const Params& p, int l, size_t off) { return (bf16*)(p.ws + OFF_W) + (size_t)l * WL_TOTAL + off; }

DI void prep_mod_job(const Params& p, int j, char* smem) {
  float* sc = (float*)smem;
  float* part = (float*)(smem + 20480);
  const int l = j / 24, nb = j % 24, tid = TIDX, lane = tid & 63, w = tid >> 6;
  for (int idx = tid; idx < 5120; idx += 256) {
    const int m = idx >> 10, k = idx & 1023;
    const float v = (m < 4) ? p.in[I_C][m * 1024 + k] : p.in[I_CCTX][k];
    sc[idx] = siluf_(v);
  }
  __syncthreads();
  const float* W = p.in[I_ADAW] + (size_t)l * 1024 * 6144 + nb * 256 + lane;
  float a[5][4];
#pragma unroll
  for (int m = 0; m < 5; ++m)
#pragma unroll
    for (int c = 0; c < 4; ++c) a[m][c] = 0.f;
#pragma unroll 4
  for (int kk = 0; kk < 256; ++kk) {
    const int k = w * 256 + kk;
    float wv[4];
#pragma unroll
    for (int c = 0; c < 4; ++c) wv[c] = W[(size_t)k * 6144 + 64 * c];
#pragma unroll
    for (int m = 0; m < 5; ++m) {
      const float sv = sc[m * 1024 + k];
#pragma unroll
      for (int c = 0; c < 4; ++c) a[m][c] += sv * wv[c];
    }
  }
#pragma unroll
  for (int m = 0; m < 5; ++m)
#pragma unroll
    for (int c = 0; c < 4; ++c) part[(w * 5 + m) * 256 + lane + 64 * c] = a[m][c];
  __syncthreads();
  const int n = nb * 256 + tid;
  const float bb = p.in[I_ADAB][l * 6144 + n];
  float* M = (float*)(p.ws + OFF_MOD) + (size_t)l * 5 * 6144 + n;
#pragma unroll
  for (int m = 0; m < 5; ++m)
    M[m * 6144] = part[(0 * 5 + m) * 256 + tid] + part[(1 * 5 + m) * 256 + tid] + part[(2 * 5 + m) * 256 + tid] + part[(3 * 5 + m) * 256 + tid] + bb;
  __syncthreads();
}

DI void prep_s5_job(const Params& p, int j) {
  const int idx = j * 256 + TIDX;
  const int ldg = idx >> 6, pp = idx & 63;
  const float dt = expf(p.in[I_LDT][ldg]);
  const float are = p.in[I_ARE][idx], aim = p.in[I_AIM][idx];
  const float mag = expf(are * dt);
  float sn, cs;
  sincos_cw(aim * dt, sn, cs);
  const float abr = mag * cs, abi = mag * sn;
  const float den = are * are + aim * aim;
  const float fre = ((abr - 1.f) * are + abi * aim) / den;
  const float fim = (abi * are - (abr - 1.f) * aim) / den;
  float* BBR = (float*)(p.ws + OFF_BBR);
  float* BBI = (float*)(p.ws + OFF_BBI);
  for (int hh = 0; hh < 16; ++hh) {
    const float br = p.in[I_BRE][(size_t)idx * 16 + hh], bi = p.in[I_BIM][(size_t)idx * 16 + hh];
    BBR[(size_t)idx * 16 + hh] = fre * br - fim * bi;
    BBI[(size_t)idx * 16 + hh] = fre * bi + fim * br;
  }
  float2* PW = (float2*)(p.ws + OFF_PWR);
  float pr = 1.f, pi = 0.f;
  for (int tau = 0; tau <= 32; ++tau) {
    PW[((size_t)ldg * 33 + tau) * 64 + pp] = make_float2(pr, pi);
    const float nr = pr * abr - pi * abi, ni = pr * abi + pi * abr;
    pr = nr; pi = ni;
  }
}

DI void prep_wt_job(const Params& p, int jj, char* smem) {
  float* tile = (float*)smem;
  const int l = jj / 4016;
  int r = jj % 4016;
  int mat = 0;
  const int cnt[8] = {1376, 64, 128, 64, 256, 1408, 704, 16};
#pragma unroll
  for (int m = 0; m < 8; ++m) {
    if (mat == m && r >= cnt[m]) { r -= cnt[m]; mat = m + 1; }
  }
  const float* src; int K, sld; size_t doff;
  switch (mat) {
    case 0: src = p.in[I_WIN] + (size_t)l * 1024 * DIN; K = 1024; sld = DIN; doff = WL_WIN; break;
    case 1: src = p.in[I_WBA] + (size_t)l * 256 * 1024; K = 256; sld = 1024; doff = WL_BRA; break;
    case 2: src = p.in[I_WBG] + (size_t)l * 512 * 1024; K = 512; sld = 1024; doff = WL_BRG; break;
    case 3: src = p.in[I_WBS] + (size_t)l * 256 * 1024; K = 256; sld = 1024; doff = WL_BRS; break;
    case 4: src = p.in[I_WOUT] + (size_t)l * 1024 * 1024; K = 1024; sld = 1024; doff = WL_WOUT; break;
    case 5: src = p.in[I_UP] + (size_t)l * 1024 * 5632; K = 1024; sld = 5632; doff = WL_UP; break;
    case 6: src = p.in[I_DOWN] + (size_t)l * 2816 * 1024; K = 2816; sld = 1024; doff = WL_DOWN; break;
    default: src = p.in[I_GLUW] + (size_t)l * 256 * 256; K = 256; sld = 256; doff = WL_GLU; break;
  }
  const int kt = K / 64;
  const int n0 = (r / kt) * 64, k0 = (r % kt) * 64;
  const int tid = TIDX;
  {
    const int nn = tid & 63;
    const int np = n0 + nn;
    int col;
    if (mat == 0) {
      if (np < 2048) col = np;
      else if (np < 2304) col = 2080 + (np - 2048);
      else if (np < 2336) col = 2048 + (np - 2304);
      else if (np < 2432) col = -1;
      else col = 2336 + (np - 2432);
    } else if (mat == 5) {
      const int jb = np >> 7, c = np & 127;
      col = (c < 64) ? (jb * 64 + c) : (DFF + jb * 64 + (c - 64));
    } else col = np;
#pragma unroll 4
    for (int kk = tid >> 6; kk < 64; kk += 4) tile[kk * 65 + nn] = (col >= 0) ? src[(size_t)(k0 + kk) * sld + col] : 0.f;
  }
  __syncthreads();
  {
    const int nn = tid >> 2, kq = (tid & 3) * 16;
    bf16* d = wl(p, l, doff) + (size_t)(n0 + nn) * K + k0 + kq;
    u32x4 v0, v1;
#pragma unroll
    for (int e = 0; e < 4; ++e) {
      v0[e] = pack2(tile[(kq + 2 * e) * 65 + nn], tile[(kq + 2 * e + 1) * 65 + nn]);
      v1[e] = pack2(tile[(kq + 8 + 2 * e) * 65 + nn], tile[(kq + 8 + 2 * e + 1) * 65 + nn]);
    }
    *(u32x4*)d = v0;
    *(u32x4*)(d + 8) = v1;
  }
  __syncthreads();
}

template <int MODE>
DI void row_job(const Params& p, int l, int tok) {
  const int lane = TIDX & 63;
  float x[16];
  float* xr = resid_row(p, tok);
  if (MODE == 0) {
    const int b = tok / TT, t = tok - b * TT;
    const float* src = (t < CTXL) ? p.in[I_CTX] + ((size_t)b * CTXL + t) * DM : p.in[I_X] + ((size_t)b * SEQ + (t - CTXL)) * DM;
#pragma unroll
    for (int i = 0; i < 4; ++i) {
      const f32x4 v = *(const f32x4*)(src + lane * 4 + 256 * i);
      x[4 * i] = v[0]; x[4 * i + 1] = v[1]; x[4 * i + 2] = v[2]; x[4 * i + 3] = v[3];
      *(f32x4*)(xr + lane * 4 + 256 * i) = v;
    }
  } else {
    const bf16* yr = (const bf16*)(p.ws + OFF_H) + (size_t)tok * DM;
    const float* gpost = p.in[MODE == 1 ? I_NMPOST : I_NFPOST] + l * DM;
    const float* mg = mod_vec(p, l, tok, MODE == 1 ? 2 : 5);
    float y[16];
    float ss = 0.f;
#pragma unroll
    for (int i = 0; i < 4; ++i) {
      const u32x2 u = *(const u32x2*)(yr + lane * 4 + 256 * i);
      y[4 * i] = bflo(u[0]); y[4 * i + 1] = bfhi(u[0]); y[4 * i + 2] = bflo(u[1]); y[4 * i + 3] = bfhi(u[1]);
#pragma unroll
      for (int e = 0; e < 4; ++e) ss += y[4 * i + e] * y[4 * i + e];
    }
    ss = wave_sum(ss);
    const float rstd = rsqrtf(ss * (1.f / DM) + EPSF);
#pragma unroll
    for (int i = 0; i < 4; ++i) {
      f32x4 v = *(const f32x4*)(xr + lane * 4 + 256 * i);
      const f32x4 g = *(const f32x4*)(gpost + lane * 4 + 256 * i);
      const f32x4 m = *(const f32x4*)(mg + lane * 4 + 256 * i);
#pragma unroll
      for (int e = 0; e < 4; ++e) { v[e] += m[e] * (y[4 * i + e] * rstd * g[e]); x[4 * i + e] = v[e]; }
      *(f32x4*)(xr + lane * 4 + 256 * i) = v;
    }
  }
  if (MODE == 2 && l == NL - 1) return;
  const int ln = (MODE == 2) ? l + 1 : l;
  const float* gpre = p.in[MODE == 1 ? I_NFPRE : I_NMPRE] + ln * DM;
  const float* sh = mod_vec(p, ln, tok, MODE == 1 ? 3 : 0);
  const float* scv = mod_vec(p, ln, tok, MODE == 1 ? 4 : 1);
  float ss = 0.f;
#pragma unroll
  for (int i = 0; i < 16; ++i) ss += x[i] * x[i];
  ss = wave_sum(ss);
  const float rstd = rsqrtf(ss * (1.f / DM) + EPSF);
  bf16* hr = (bf16*)(p.ws + OFF_H) + (size_t)tok * DM;
#pragma unroll
  for (int i = 0; i < 4; ++i) {
    const f32x4 g = *(const f32x4*)(gpre + lane * 4 + 256 * i);
    const f32x4 s1 = *(const f32x4*)(sh + lane * 4 + 256 * i);
    const f32x4 s2 = *(const f32x4*)(scv + lane * 4 + 256 * i);
    float o[4];
#pragma unroll
    for (int e = 0; e < 4; ++e) o[e] = (x[4 * i + e] * rstd * g[e]) * (1.f + s2[e]) + s1[e];
    u32x2 u;
    u[0] = pack2(o[0], o[1]); u[1] = pack2(o[2], o[3]);
    *(u32x2*)(hr + lane * 4 + 256 * i) = u;
  }
}

template <int MODE>
DI void row_phase(const Params& p, int l, int bid, int G) {
  const int lane = TIDX & 63;
  const int wg = bid * 4 + (TIDX >> 6), nw = G * 4;
  const int R = (NTOK + nw - 1) / nw;
  const int t0 = wg * R, t1 = min(NTOK, t0 + R);
  if (t0 >= t1) return;
  const bool has_next = !(MODE == 2 && l == NL - 1);
  const int ln = (MODE == 2) ? l + 1 : l;
  f32x4 gpost[4], gpre[4], mg[4], sh[4], scl[4];
#pragma unroll
  for (int i = 0; i < 4; ++i) {
    if (MODE != 0) gpost[i] = *(const f32x4*)(p.in[MODE == 1 ? I_NMPOST : I_NFPOST] + l * DM + lane * 4 + 256 * i);
    if (has_next) gpre[i] = *(const f32x4*)(p.in[MODE == 1 ? I_NFPRE : I_NMPRE] + ln * DM + lane * 4 + 256 * i);
  }
  int cur_m = -1;
  u32x2 yb[4], yn[4];
  f32x4 xb[4], xn[4];
  const bf16* Hb = (const bf16*)(p.ws + OFF_H);
#define ROW_LOAD(TOK, YY, XX)                                                                              \
  {                                                                                                        \
    const int b_ = (TOK) / TT, t_ = (TOK) - b_ * TT;                                                       \
    const float* src_ = (MODE == 0) ? ((t_ < CTXL) ? p.in[I_CTX] + ((size_t)b_ * CTXL + t_) * DM           \
                                                   : p.in[I_X] + ((size_t)b_ * SEQ + (t_ - CTXL)) * DM)    \
                                    : resid_row(p, (TOK));                                                 \
    _Pragma("unroll") for (int i = 0; i < 4; ++i) {                                                        \
      XX[i] = *(const f32x4*)(src_ + lane * 4 + 256 * i);                                                  \
      if (MODE != 0) YY[i] = *(const u32x2*)(Hb + (size_t)(TOK) * DM + lane * 4 + 256 * i);                \
    }                                                                                                      \
  }
  ROW_LOAD(t0, yb, xb)
  for (int tok = t0; tok < t1; ++tok) {
    if (tok + 1 < t1) ROW_LOAD(tok + 1, yn, xn)
    const int b = tok / TT, t = tok - b * TT;
    const int m = (t < CTXL) ? 4 : b;
    if (m != cur_m) {
      cur_m = m;
      const float* Mv = (const float*)(p.ws + OFF_MOD);
#pragma unroll
      for (int i = 0; i < 4; ++i) {
        if (MODE != 0) mg[i] = *(const f32x4*)(Mv + ((size_t)(l * 5 + m) * 6 + (MODE == 1 ? 2 : 5)) * DM + lane * 4 + 256 * i);
        if (has_next) {
          sh[i] = *(const f32x4*)(Mv + ((size_t)(ln * 5 + m) * 6 + (MODE == 1 ? 3 : 0)) * DM + lane * 4 + 256 * i);
          scl[i] = *(const f32x4*)(Mv + ((size_t)(ln * 5 + m) * 6 + (MODE == 1 ? 4 : 1)) * DM + lane * 4 + 256 * i);
        }
      }
    }
    float* xr = resid_row(p, tok);
    f32x4 x[4];
    if (MODE == 0) {
#pragma unroll
      for (int i = 0; i < 4; ++i) { x[i] = xb[i]; *(f32x4*)(xr + lane * 4 + 256 * i) = x[i]; }
    } else {
      float y[16];
      float ss = 0.f;
#pragma unroll
      for (int i = 0; i < 4; ++i) {
        y[4 * i] = bflo(yb[i][0]); y[4 * i + 1] = bfhi(yb[i][0]); y[4 * i + 2] = bflo(yb[i][1]); y[4 * i + 3] = bfhi(yb[i][1]);
#pragma unroll
        for (int e = 0; e < 4; ++e) ss += y[4 * i + e] * y[4 * i + e];
      }
      ss = wave_sum(ss);
      const float rstd = rsqrtf(ss * (1.f / DM) + EPSF);
#pragma unroll
      for (int i = 0; i < 4; ++i) {
        f32x4 v = xb[i];
#pragma unroll
        for (int e = 0; e < 4; ++e) v[e] += mg[i][e] * (y[4 * i + e] * rstd * gpost[i][e]);
        x[i] = v;
        *(f32x4*)(xr + lane * 4 + 256 * i) = v;
      }
    }
    if (has_next) {
      float ss = 0.f;
#pragma unroll
      for (int i = 0; i < 4; ++i)
#pragma unroll
        for (int e = 0; e < 4; ++e) ss += x[i][e] * x[i][e];
      ss = wave_sum(ss);
      const float rstd = rsqrtf(ss * (1.f / DM) + EPSF);
      bf16* hr = (bf16*)(p.ws + OFF_H) + (size_t)tok * DM;
#pragma unroll
      for (int i = 0; i < 4; ++i) {
        float o[4];
#pragma unroll
        for (int e = 0; e < 4; ++e) o[e] = (x[i][e] * rstd * gpre[i][e]) * (1.f + scl[i][e]) + sh[i][e];
        u32x2 u;
        u[0] = pack2(o[0], o[1]); u[1] = pack2(o[2], o[3]);
        *(u32x2*)(hr + lane * 4 + 256 * i) = u;
      }
    }
#pragma unroll
    for (int i = 0; i < 4; ++i) { yb[i] = yn[i]; xb[i] = xn[i]; }
  }
#undef ROW_LOAD
}

DI void ktab_phase(const Params& p, int bid, int G, int l_lo, int l_hi) {
  const float* BBR = (const float*)(p.ws + OFF_BBR);
  const float* BBI = (const float*)(p.ws + OFF_BBI);
  const float2* PW = (const float2*)(p.ws + OFF_PWR);
  float* KT = (float*)(p.ws + OFF_KTAB);
  const int per_layer = 16 * 2 * 32 * 256;
  for (int idx = l_lo * per_layer + bid * 256 + TIDX; idx < l_hi * per_layer; idx += G * 256) {
    const int hp = idx & 15, hh = (idx >> 4) & 15, tau = (idx >> 8) & 31, d = (idx >> 13) & 1, g = (idx >> 14) & 15, l = idx >> 18;
    const int ldg = (l * 2 + d) * 16 + g;
    const float* cre = p.in[I_CRE] + ((size_t)ldg * 16 + hh) * 64;
    const float* cim = p.in[I_CIM] + ((size_t)ldg * 16 + hh) * 64;
    float acc = 0.f;
    for (int pp = 0; pp < 64; ++pp) {
      const float2 pw = PW[((size_t)ldg * 33 + tau) * 64 + pp];
      const float br = BBR[((size_t)ldg * 64 + pp) * 16 + hp], bi = BBI[((size_t)ldg * 64 + pp) * 16 + hp];
      const float zr = pw.x * br - pw.y * bi, zi = pw.x * bi + pw.y * br;
      acc += cre[pp] * zr - cim[pp] * zi;
    }
    KT[idx] = acc;
  }
}

DI void s5mat_phase(const Params& p, int l, int bid, int G) {
  const float* BBR = (const float*)(p.ws + OFF_BBR);
  const float* BBI = (const float*)(p.ws + OFF_BBI);
  const float2* PW = (const float2*)(p.ws + OFF_PWR);
  const float* KT = (const float*)(p.ws + OFF_KTAB);
  bf16* T5 = (bf16*)(p.ws + OFF_T5);
  bf16* E5 = (bf16*)(p.ws + OFF_E5);
  bf16* F5 = (bf16*)(p.ws + OFF_F5);
  const int nT = 16 * 512 * 64, nE = 16 * 512 * 32, nF = 16 * 256 * 64;
  for (int it = bid * 256 + TIDX; it < nT + nE + nF; it += G * 256) {
    float v[8];
    bf16* dst;
    if (it < nT) {
      const int k8 = it & 63, n = (it >> 6) & 511, g = it >> 15;
      const int i = n >> 4, hh = n & 15, j = k8 >> 1, hp0 = (k8 & 1) * 8;
#pragma unroll
      for (int e = 0; e < 8; ++e) {
        const int hp = hp0 + e;
        float a = 0.f;
        if (j <= i) a += KT[((((size_t)l * 16 + g) * 2 + 0) * 32 + (i - j)) * 256 + hh * 16 + hp];
        if (j >= i) a += KT[((((size_t)l * 16 + g) * 2 + 1) * 32 + (j - i)) * 256 + hh * 16 + hp];
        if (i == j && hh == hp) a += p.in[I_S5D][l * 256 + g * 16 + hh];
        v[e] = a;
      }
      dst = T5 + ((size_t)g * 512 + n) * 512 + k8 * 8;
    } else if (it < nT + nE) {
      const int q = it - nT;
      const int k8 = q & 31, n = (q >> 5) & 511, g = q >> 14;
      const int i = n >> 4, hh = n & 15;
      const int k0 = k8 * 8, d = k0 >> 7, ri = (k0 >> 6) & 1, p0 = k0 & 63;
      const int ldg = (l * 2 + d) * 16 + g;
      const int ex = d ? (32 - i) : (i + 1);
#pragma unroll
      for (int e = 0; e < 8; ++e) {
        const int pp = p0 + e;
        const float2 pw = PW[((size_t)ldg * 33 + ex) * 64 + pp];
        const float cr = p.in[I_CRE][((size_t)ldg * 16 + hh) * 64 + pp], ci = p.in[I_CIM][((size_t)ldg * 16 + hh) * 64 + pp];
        const float zr = cr * pw.x - ci * pw.y, zi = cr * pw.y + ci * pw.x;
        v[e] = ri ? -zi : zr;
      }
      dst = E5 + ((size_t)g * 512 + n) * 256 + k0;
    } else {
      const int q = it - nT - nE;
      const int k8 = q & 63, n = (q >> 6) & 255, g = q >> 14;
      const int d = n >> 7, ri = (n >> 6) & 1, pp = n & 63;
      const int j = k8 >> 1, hp0 = (k8 & 1) * 8;
      const int ldg = (l * 2 + d) * 16 + g;
      const int ex = d ? j : (31 - j);
      const float2 pw = PW[((size_t)ldg * 33 + ex) * 64 + pp];
#pragma unroll
      for (int e = 0; e < 8; ++e) {
        const float br = BBR[((size_t)ldg * 64 + pp) * 16 + hp0 + e], bi = BBI[((size_t)ldg * 64 + pp) * 16 + hp0 + e];
        v[e] = ri ? (pw.x * bi + pw.y * br) : (pw.x * br - pw.y * bi);
      }
      dst = F5 + ((size_t)g * 256 + n) * 512 + k8 * 8;
    }
    u32x4 u;
    u[0] = pack2(v[0], v[1]); u[1] = pack2(v[2], v[3]); u[2] = pack2(v[4], v[5]); u[3] = pack2(v[6], v[7]);
    *(u32x4*)dst = u;
  }
}

DI void proj_epi(const Params& p, int l, int mt, int nt, char* smem);
DI void proj_wide(const Params& p, int l, int mt, int np, char* smem) {
  const bf16* H = (const bf16*)(p.ws + OFF_H) + (size_t)mt * 128 * DM;
  const bf16* W = wl(p, l, WL_WIN) + (size_t)np * 256 * DM;
  f32x16 acc[2][4];
  accw_zero(acc);
  gemm_wide(acc, [&](int r) { return H + (size_t)r * DM; }, [&](int r) { return W + (size_t)r * DM; }, DM, smem);
  float* Cs = (float*)smem;
  accw_to_lds<0>(acc, Cs);
  __syncthreads();
  proj_epi(p, l, mt, np * 2, smem);
  if (np * 2 + 1 < 19) {
    accw_to_lds<1>(acc, Cs);
    __syncthreads();
    proj_epi(p, l, mt, np * 2 + 1, smem);
  }
}
DI void proj_epi(const Params& p, int l, int mt, int nt, char* smem) {
  float* Cs = (float*)smem;
  const int tid = TIDX;
  const int tok0 = mt * 128;
  const int b = tok0 / TT, t0 = tok0 - b * TT;
  if (nt <= 2) {
    const int row = tid >> 1, seg = tid & 1;
    float* c = Cs + row * CLD + seg * 64;
    const float* gn = p.in[nt < 2 ? I_QN : I_KN] + l * 64;
    float ss = 0.f;
#pragma unroll 8
    for (int i = 0; i < 64; ++i) ss += c[i] * c[i];
    const float rstd = rsqrtf(ss * (1.f / 64.f) + EPSF);
    const int t = t0 + row;
    const bool lat = t >= CTXL;
    const int s = t - CTXL;
#pragma unroll 1
    for (int ax = 0; ax < 2; ++ax) {
      const float pos = (float)(ax ? (s & 63) : (s >> 6));
#pragma unroll 2
      for (int f = 0; f < 16; ++f) {
        float x1 = c[ax * 32 + f] * rstd * gn[ax * 32 + f];
        float x2 = c[ax * 32 + 16 + f] * rstd * gn[ax * 32 + 16 + f];
        if (lat) {
          const float invf = exp2f(-(float)f * (13.287712379549449f / 16.f));
          float sn, cs;
          sincos_cw(pos * invf, sn, cs);
          const float y1 = x1 * cs - x2 * sn, y2 = x2 * cs + x1 * sn;
          x1 = y1; x2 = y2;
        }
        c[ax * 32 + f] = x1;
        c[ax * 32 + 16 + f] = x2;
      }
    }
    __syncthreads();
    if (nt < 2) store_tile_bf16(Cs, (bf16*)(p.ws + OFF_Q) + (size_t)tok0 * 256 + nt * 128, 256, 128, 0.125f * 1.4426950408889634f);
    else store_tile_bf16(Cs, (bf16*)(p.ws + OFF_K) + (size_t)tok0 * 128, 128, 128, 1.f);
  } else if (nt == 3 || (nt >= 8 && nt <= 11)) {
    for (int c = tid; c < 2048; c += 256) {
      const int col = c & 127, rc = (c >> 7) * 8;
      u32x4 u;
#pragma unroll
      for (int e = 0; e < 4; ++e) u[e] = pack2(Cs[(rc + 2 * e) * CLD + col], Cs[(rc + 2 * e + 1) * CLD + col]);
      bf16* dst;
      if (nt == 3) dst = (bf16*)(p.ws + OFF_VT) + ((size_t)(b * 2 + (col >> 6)) * 64 + (col & 63)) * TT + t0 + rc;
      else dst = (bf16*)(p.ws + OFF_GVT) + ((size_t)(b * 4 + (nt - 8)) * 128 + col) * TT + t0 + rc;
      *(u32x4*)dst = u;
    }
  } else if (nt == 4 || nt == 5) {
    store_tile_bf16(Cs, (bf16*)(p.ws + OFF_GQ) + (size_t)tok0 * 256 + (nt - 4) * 128, 256, 128, 0.125f);
  } else if (nt == 6 || nt == 7) {
    store_tile_bf16(Cs, (bf16*)(p.ws + OFF_GK) + (size_t)tok0 * 256 + (nt - 6) * 128, 256, 128, 1.f);
  } else if (nt >= 12 && nt <= 15) {
    store_tile_bf16(Cs, (bf16*)(p.ws + OFF_GR) + (size_t)tok0 * 512 + (nt - 12) * 128, 512, 128, 1.f);
  } else if (nt == 16 || nt == 17) {
    for (int c = tid; c < 2048; c += 256) {
      const int row = c >> 4, c8 = c & 15;
      const float* s = Cs + row * CLD + c8 * 8;
      u32x4 u;
#pragma unroll
      for (int e = 0; e < 4; ++e) u[e] = pack2(s[2 * e], s[2 * e + 1]);
      const int ch = (nt - 16) * 128 + c8 * 8;
      bf16* dst = (bf16*)(p.ws + OFF_SU) + ((size_t)(b * 16 + (ch >> 4)) * TT + t0 + row) * 16 + (ch & 15);
      *(u32x4*)dst = u;
    }
  } else {
    for (int c = tid; c < 128 * 8; c += 256) {
      const int row = c >> 3, c4 = (c & 7) * 4;
      const float* s = Cs + row * CLD + c4;
      f32x4 v = {s[0], s[1], s[2], s[3]};
      *(f32x4*)((float*)(p.ws + OFF_LOW) + (size_t)(tok0 + row) * 32 + c4) = v;
    }
  }
  __syncthreads();
}

DI void attn_unit(const Params& p, int u, char* smem) {
  int b, head, tok0, nkt;
  if (u < 1024) { b = u >> 8; head = (u >> 6) & 3; tok0 = b * TT + CTXL + (u & 63) * 128; nkt = TT / 128; }
  else { const int v = u - 1024; b = v >> 3; head = (v >> 1) & 3; tok0 = b * TT + (v & 1) * 128; nkt = CTXL / 128; }
  const int kvh = head >> 1;
  const int tid = TIDX, lane = tid & 63, w = tid >> 6, r = lane & 31, h = lane >> 5;
  const bf16* Qp = (const bf16*)(p.ws + OFF_Q) + (size_t)(tok0 + w * 32 + r) * 256 + head * 64 + h * 8;
  s16x8 qf[4];
#pragma unroll
  for (int s = 0; s < 4; ++s) qf[s] = __builtin_bit_cast(s16x8, ldg16(Qp + s * 16));
  const bf16* kp[2];
  const bf16* vp[2];
#pragma unroll
  for (int i = 0; i < 2; ++i) {
    const int row = w * 16 + i * 8 + (lane >> 3);
    const int c = (lane & 7) ^ ((row >> 1) & 7);
    kp[i] = (const bf16*)(p.ws + OFF_K) + ((size_t)b * TT + row) * 128 + kvh * 64 + c * 8;
    vp[i] = (const bf16*)(p.ws + OFF_VT) + ((size_t)(b * 2 + kvh) * 64 + row) * TT + c * 8;
  }
  const int ldst = (w * 128 + lane) * 16;
#define AT_DMA(BUF, T)                                                                                              \
  {                                                                                                                 \
    char* sb_ = smem + (BUF) * 32768;                                                                               \
    _Pragma("unroll") for (int hh = 0; hh < 2; ++hh)                                                                \
    _Pragma("unroll") for (int i = 0; i < 2; ++i) {                                                                 \
      __builtin_amdgcn_global_load_lds((const unsigned*)(kp[i] + (size_t)((T) * 128 + hh * 64) * 128), (unsigned*)(sb_ + hh * 8192 + ldst + i * 1024), 16, 0, 0); \
      __builtin_amdgcn_global_load_lds((const unsigned*)(vp[i] + (T) * 128 + hh * 64), (unsigned*)(sb_ + 16384 + hh * 8192 + ldst + i * 1024), 16, 0, 0);        \
    }                                                                                                               \
  }
  const int xr = (r >> 1) & 7;
  AT_DMA(0, 0)
  asm volatile("s_waitcnt vmcnt(0)" ::: "memory");
  __syncthreads();
  f32x16 oacc[2];
#pragma unroll
  for (int i = 0; i < 16; ++i) { oacc[0][i] = 0.f; oacc[1][i] = 0.f; }
  float mrow = -INFINITY, lrow = 0.f;
  for (int kt = 0; kt < nkt; ++kt) {
    const int buf = kt & 1;
    if (kt + 1 < nkt) AT_DMA(buf ^ 1, kt + 1)
    const char* Kb = smem + buf * 32768;
    const char* Vb = Kb + 16384;
    f32x16 sacc[4];
#pragma unroll
    for (int q = 0; q < 4; ++q)
#pragma unroll
      for (int i = 0; i < 16; ++i) sacc[q][i] = 0.f;
#pragma unroll
    for (int s = 0; s < 4; ++s) {
      const int co = ((2 * s + h) ^ xr) * 16;
#pragma unroll
      for (int q = 0; q < 4; ++q) {
        const s16x8 a = *(const s16x8*)(Kb + (q >> 1) * 8192 + ((q & 1) * 32 + r) * 128 + co);
        sacc[q] = MFMA32(a, qf[s], sacc[q]);
      }
    }
    float mx = sacc[0][0];
#pragma unroll
    for (int q = 0; q < 4; ++q)
#pragma unroll
      for (int i = 0; i < 16; ++i) mx = fmaxf(mx, sacc[q][i]);
    mx = fmaxf(mx, __shfl_xor(mx, 32, 64));
    const float mnew = fmaxf(mrow, mx);
    const float alpha = __builtin_amdgcn_exp2f(mrow - mnew);
    mrow = mnew;
    float psum = 0.f;
#pragma unroll
    for (int q = 0; q < 4; ++q)
#pragma unroll
      for (int i = 0; i < 16; ++i) { sacc[q][i] = __builtin_amdgcn_exp2f(sacc[q][i] - mnew); psum += sacc[q][i]; }
    lrow = lrow * alpha + psum;
#pragma unroll
    for (int i = 0; i < 16; ++i) { oacc[0][i] *= alpha; oacc[1][i] *= alpha; }
#pragma unroll
    for (int q = 0; q < 4; ++q)
#pragma unroll
      for (int s2 = 0; s2 < 2; ++s2) {
        u32x4 pu;
#pragma unroll
        for (int e = 0; e < 4; ++e) pu[e] = pack2(sacc[q][8 * s2 + 2 * e], sacc[q][8 * s2 + 2 * e + 1]);
        const s16x8 pf = __builtin_bit_cast(s16x8, pu);
        const int c0 = (q & 1) * 4 + 2 * s2;
        const int o0 = ((c0 ^ xr) * 16) + 8 * h, o1 = (((c0 + 1) ^ xr) * 16) + 8 * h;
#pragma unroll
        for (int dt = 0; dt < 2; ++dt) {
          const s16x4 lo = *(const s16x4*)(Vb + (q >> 1) * 8192 + (dt * 32 + r) * 128 + o0);
          const s16x4 hi = *(const s16x4*)(Vb + (q >> 1) * 8192 + (dt * 32 + r) * 128 + o1);
          const s16x8 a = __builtin_shufflevector(lo, hi, 0, 1, 2, 3, 4, 5, 6, 7);
          oacc[dt] = MFMA32(a, pf, oacc[dt]);
        }
      }
    asm volatile("s_waitcnt vmcnt(0)" ::: "memory");
    __syncthreads();
  }
#undef AT_DMA
  const float ltot = lrow + __shfl_xor(lrow, 32, 64);
  const float inv = 1.f / ltot;
  bf16* Op = (bf16*)(p.ws + OFF_OATT) + (size_t)(tok0 + w * 32 + r) * 256 + head * 64;
#pragma unroll
  for (int dt = 0; dt < 2; ++dt)
#pragma unroll
    for (int i = 0; i < 16; i += 4) {
      u32x2 uu;
      uu[0] = pack2(oacc[dt][i] * inv, oacc[dt][i + 1] * inv);
      uu[1] = pack2(oacc[dt][i + 2] * inv, oacc[dt][i + 3] * inv);
      *(u32x2*)(Op + dt * 32 + crow(i, h)) = uu;
    }
}

constexpr int GL_LOW = 0, GL_TOT = 4096, GL_DEC = 5120, GL_QIN = 5376, GL_KIN = 14592, GL_KET = 23808, GL_OST = 0,
              GL_VT = 33792, GL_ST = 52224;
static_assert(GL_ST + 128 * LDT * 2 <= SMEM_BYTES, "gla lds");

template <bool WITH_OUT>
DI void gla_unit(const Params& p, int l, int u, char* smem) {
  float* lowt = (float*)(smem + GL_LOW);
  float* tots = (float*)(smem + GL_TOT);
  float* decs = (float*)(smem + GL_DEC);
  bf16* qin = (bf16*)(smem + GL_QIN);
  bf16* kin = (bf16*)(smem + GL_KIN);
  bf16* ket = (bf16*)(smem + GL_KET);
  float* ost = (float*)(smem + GL_OST);
  bf16* vts = (bf16*)(smem + GL_VT);
  bf16* sts = (bf16*)(smem + GL_ST);
  const int tid = TIDX, lane = tid & 63, w = tid >> 6, r = lane & 31, h = lane >> 5;
  int b, hd, gi, dir0, ndir;
  if (WITH_OUT) { gi = u % NG33; hd = (u / NG33) & 3; b = u / (NG33 * 4); dir0 = 1; ndir = 2; }
  else { gi = u % NG33; const int v = u / NG33; dir0 = v & 1; hd = (v >> 1) & 3; b = v >> 3; ndir = 1; }
  const int dk = tid & 63, part = tid >> 6;
  const bf16* GQ = (const bf16*)(p.ws + OFF_GQ);
  const bf16* GK = (const bf16*)(p.ws + OFF_GK);
  const bf16* GVT = (const bf16*)(p.ws + OFF_GVT) + (size_t)(b * 4 + hd) * 128 * TT;
  const float* LOW = (const float*)(p.ws + OFF_LOW);
  for (int dd = 0; dd < ndir; ++dd) {
    const int dir = WITH_OUT ? (dir0 - dd) : dir0;
    float* GSu = (float*)(p.ws + OFF_GS) + ((size_t)((b * 4 + hd) * 2 + dir) * NG33 + gi) * 8192;
    float gwreg[16];
#pragma unroll
    for (int rr = 0; rr < 16; ++rr) gwreg[rr] = p.in[I_GGW][((size_t)(l * 2 + dir) * 16 + rr) * 256 + hd * 64 + dk];
    const float gb = p.in[I_GGB][(l * 2 + dir) * 256 + hd * 64 + dk];
    f32x16 sacc[2];
    if (WITH_OUT) {
#pragma unroll
      for (int dkt = 0; dkt < 2; ++dkt)
#pragma unroll
        for (int i = 0; i < 16; ++i) {
          const float v = GSu[(w * 32 + crow(i, h)) * 64 + dkt * 32 + r];
          sacc[dkt][i] = v;
          sts[(w * 32 + crow(i, h)) * LDT + dkt * 32 + r] = f2bf(v);
        }
    } else {
#pragma unroll
      for (int i = 0; i < 16; ++i) { sacc[0][i] = 0.f; sacc[1][i] = 0.f; }
    }
    float gtot = 0.f;
    for (int cc = 0; cc < 4; ++cc) {
      const int ci = dir ? 3 - cc : cc;
      const int tb = gi * 256 + ci * 64;
      const size_t tokb = (size_t)b * TT + tb;
      {
        const int row = tid >> 2, c4 = (tid & 3) * 4;
        const u32x4 lw = ldg16(LOW + (tokb + row) * 32 + dir * 16 + c4);
        u32x4 vv[4], kq[2], qq[2];
#pragma unroll
        for (int i = 0; i < 4; ++i) {
          const int c = tid + 256 * i, e = c >> 3, k8 = (c & 7) * 8;
          vv[i] = ldg16(GVT + (size_t)e * TT + tb + k8);
        }
#pragma unroll
        for (int i = 0; i < 2; ++i) {
          const int c = tid + 256 * i, rw = c >> 3, k8 = (c & 7) * 8;
          kq[i] = ldg16(GK + (tokb + rw) * 256 + hd * 64 + k8);
          if (WITH_OUT) qq[i] = ldg16(GQ + (tokb + rw) * 256 + hd * 64 + k8);
        }
        *(u32x4*)(lowt + row * 16 + c4) = lw;
#pragma unroll
        for (int i = 0; i < 4; ++i) {
          const int c = tid + 256 * i, e = c >> 3, k8 = (c & 7) * 8;
          *(u32x4*)(vts + e * LDT + k8) = vv[i];
        }
#pragma unroll
        for (int i = 0; i < 2; ++i) {
          const int c = tid + 256 * i, rw = c >> 3, k8 = (c & 7) * 8;
          *(u32x4*)(kin + rw * LDT + k8) = kq[i];
          if (WITH_OUT) *(u32x4*)(qin + rw * LDT + k8) = qq[i];
        }
      }
      __syncthreads();
      float cum = 0.f;
#pragma unroll 2
      for (int ii = 0; ii < 16; ++ii) {
        const int pos = part * 16 + ii, t = dir ? 63 - pos : pos;
        float z = gb;
#pragma unroll
        for (int rr = 0; rr < 16; ++rr) z += lowt[t * 16 + rr] * gwreg[rr];
        cum += (fminf(z, 0.f) - log1pf(__expf(-fabsf(z)))) * (1.f / 16.f);
      }
      tots[part * 64 + dk] = cum;
      __syncthreads();
      float offs = 0.f, total = 0.f;
#pragma unroll
      for (int pp = 0; pp < 4; ++pp) { const float tv = tots[pp * 64 + dk]; total += tv; if (pp < part) offs += tv; }
      if (part == 0) decs[dk] = __expf(total);
      gtot += total;
      float bq = offs;
#pragma unroll 2
      for (int ii = 0; ii < 16; ++ii) {
        const int pos = part * 16 + ii, t = dir ? 63 - pos : pos;
        float z = gb;
#pragma unroll
        for (int rr = 0; rr < 16; ++rr) z += lowt[t * 16 + rr] * gwreg[rr];
        bq += (fminf(z, 0.f) - log1pf(__expf(-fabsf(z)))) * (1.f / 16.f);
        const float kv = bf2f(kin[t * LDT + dk]);
        ket[dk * LDT + t] = f2bf(kv * __expf(total - bq));
        if (WITH_OUT) {
          const float qv = bf2f(qin[t * LDT + dk]);
          qin[t * LDT + dk] = f2bf(qv * __expf(bq));
          kin[t * LDT + dk] = f2bf(kv * __expf(-bq));
        }
      }
      __syncthreads();
      f32x16 oo[2];
      const int it = w & 1, ep = w >> 1;
      if (WITH_OUT) {
        const int ti = w >> 1, tj = w & 1;
        f32x16 aa;
#pragma unroll
        for (int i = 0; i < 16; ++i) aa[i] = 0.f;
#pragma unroll
        for (int s = 0; s < 4; ++s) {
          const s16x8 A = *(const s16x8*)(qin + (ti * 32 + r) * LDT + s * 16 + h * 8);
          const s16x8 Bv = *(const s16x8*)(kin + (tj * 32 + r) * LDT + s * 16 + h * 8);
          aa = MFMA32(A, Bv, aa);
        }
        __syncthreads();
#pragma unroll
        for (int i = 0; i < 16; ++i) {
          const int qi = ti * 32 + crow(i, h), kj = tj * 32 + r;
          const bool keep = dir ? (kj >= qi) : (kj <= qi);
          kin[qi * LDT + kj] = f2bf(keep ? aa[i] : 0.f);
        }
        __syncthreads();
#pragma unroll
        for (int i = 0; i < 16; ++i) { oo[0][i] = 0.f; oo[1][i] = 0.f; }
#pragma unroll
        for (int s = 0; s < 4; ++s) {
          const s16x8 A1 = *(const s16x8*)(kin + (it * 32 + r) * LDT + s * 16 + h * 8);
          const s16x8 A2 = *(const s16x8*)(qin + (it * 32 + r) * LDT + s * 16 + h * 8);
#pragma unroll
          for (int x = 0; x < 2; ++x) {
            const int et = 2 * ep + x;
            const s16x8 B1 = *(const s16x8*)(vts + (et * 32 + r) * LDT + s * 16 + h * 8);
            const s16x8 B2 = *(const s16x8*)(sts + (et * 32 + r) * LDT + s * 16 + h * 8);
            oo[x] = MFMA32(A1, B1, oo[x]);
            oo[x] = MFMA32(A2, B2, oo[x]);
          }
        }
      }
#pragma unroll
      for (int dkt = 0; dkt < 2; ++dkt) {
        const float dv = decs[dkt * 32 + r];
#pragma unroll
        for (int i = 0; i < 16; ++i) sacc[dkt][i] *= dv;
      }
#pragma unroll
      for (int s = 0; s < 4; ++s) {
        const s16x8 A = *(const s16x8*)(vts + (w * 32 + r) * LDT + s * 16 + h * 8);
#pragma unroll
        for (int dkt = 0; dkt < 2; ++dkt) {
          const s16x8 Bv = *(const s16x8*)(ket + (dkt * 32 + r) * LDT + s * 16 + h * 8);
          sacc[dkt] = MFMA32(A, Bv, sacc[dkt]);
        }
      }
      __syncthreads();
      if (WITH_OUT) {
#pragma unroll
        for (int dkt = 0; dkt < 2; ++dkt)
#pragma unroll
          for (int i = 0; i < 16; ++i) sts[(w * 32 + crow(i, h)) * LDT + dkt * 32 + r] = f2bf(sacc[dkt][i]);
#pragma unroll
        for (int x = 0; x < 2; ++x)
#pragma unroll
          for (int i = 0; i < 16; ++i) ost[(it * 32 + crow(i, h)) * CLD + (2 * ep + x) * 32 + r] = oo[x][i];
        __syncthreads();
        const int row = tid >> 2, qd = tid & 3;
        const size_t tok = tokb + row;
        bf16* og = (bf16*)(p.ws + OFF_OGLA) + tok * 512 + hd * 128 + qd * 32;
        const float* os = ost + row * CLD + qd * 32;
        if (dir == 1) {
#pragma unroll
          for (int i = 0; i < 4; ++i) {
            u32x4 uu;
#pragma unroll
            for (int e = 0; e < 4; ++e) uu[e] = pack2(os[i * 8 + 2 * e], os[i * 8 + 2 * e + 1]);
            *(u32x4*)(og + i * 8) = uu;
          }
        } else {
          float ss = 0.f;
#pragma unroll 1
          for (int i = 0; i < 4; ++i) {
            const u32x4 uu = *(const u32x4*)(og + i * 8);
#pragma unroll
            for (int e = 0; e < 4; ++e) {
              const float a0 = os[i * 8 + 2 * e] + bflo(uu[e]), a1 = os[i * 8 + 2 * e + 1] + bfhi(uu[e]);
              ss += a0 * a0 + a1 * a1;
            }
          }
          ss += __shfl_xor(ss, 1, 64);
          ss += __shfl_xor(ss, 2, 64);
          const float rstd = rsqrtf(ss * (1.f / 128.f) + EPSF);
          const float* gn = p.in[I_GON] + l * 128 + qd * 32;
          const bf16* gr = (const bf16*)(p.ws + OFF_GR) + tok * 512 + hd * 128 + qd * 32;
#pragma unroll 1
          for (int i = 0; i < 4; ++i) {
            const u32x4 uo = *(const u32x4*)(og + i * 8);
            const u32x4 ug = *(const u32x4*)(gr + i * 8);
            u32x4 uu;
#pragma unroll
            for (int e = 0; e < 4; ++e) {
              const float v0 = os[i * 8 + 2 * e] + bflo(uo[e]), v1 = os[i * 8 + 2 * e + 1] + bfhi(uo[e]);
              const float a0 = v0 * rstd * gn[i * 8 + 2 * e] * siluf_(bflo(ug[e]));
              const float a1 = v1 * rstd * gn[i * 8 + 2 * e + 1] * siluf_(bfhi(ug[e]));
              uu[e] = pack2(a0, a1);
            }
            *(u32x4*)(og + i * 8) = uu;
          }
        }
        __syncthreads();
      }
    }
    if (!WITH_OUT) {
#pragma unroll
      for (int dkt = 0; dkt < 2; ++dkt)
#pragma unroll
        for (int i = 0; i < 16; ++i) GSu[(w * 32 + crow(i, h)) * 64 + dkt * 32 + r] = sacc[dkt][i];
      if (part == 0) ((float*)(p.ws + OFF_DECG))[((size_t)((b * 4 + hd) * 2 + dir) * NG33 + gi) * 64 + dk] = __expf(gtot);
    }
    __syncthreads();
  }
}

DI void gla_scan_job(const Params& p, int j) {
  const int idx = j * 256 + TIDX;
  const int seq = idx >> 13, el = idx & 8191, dk = el & 63, dir = seq & 1;
  float* GS = (float*)(p.ws + OFF_GS) + (size_t)seq * NG33 * 8192 + el;
  const float* DG = (const float*)(p.ws + OFF_DECG) + (size_t)seq * NG33 * 64 + dk;
  float s = 0.f;
  for (int st0 = 0; st0 < 33; st0 += 11) {
    float kv[11], dc[11];
#pragma unroll
    for (int q = 0; q < 11; ++q) {
      const int st = st0 + q;
      const int g = (dir == 0 || st == 0) ? st : 33 - st;
      kv[q] = GS[(size_t)g * 8192];
      dc[q] = DG[g * 64];
    }
#pragma unroll
    for (int q = 0; q < 11; ++q) {
      const int st = st0 + q;
      const int g = (dir == 0 || st == 0) ? st : 33 - st;
      GS[(size_t)g * 8192] = s;
      s = dc[q] * s + kv[q];
    }
  }
}

DI void s5_end_tile(const Params& p, int j, char* smem) {
  const int nt = j & 1, mt = (j >> 1) % 9, g = j / 18;
  const bf16* SU = (const bf16*)(p.ws + OFF_SU);
  const bf16* F = (const bf16*)(p.ws + OFF_F5) + ((size_t)g * 256 + nt * 128) * 512;
  f32x16 acc[2][2];
  acc_zero(acc);
  gemm_main_dma(acc,
            [&](int r) -> const bf16* {
              const int m = mt * 128 + r;
              if (m >= MS5) return (const bf16*)(p.ws + OFF_ZERO);
              const int b = m / NCH, ch = m - b * NCH;
              return SU + ((size_t)(b * 16 + g) * TT + ch * 32) * 16;
            },
            [&](int r) { return F + (size_t)r * 512; }, 512, smem);
  float* Cs = (float*)smem;
  acc_to_lds(acc, Cs);
  __syncthreads();
  float* EN = (float*)(p.ws + OFF_EN);
  for (int c = TIDX; c < 128 * 32; c += 256) {
    const int row = c >> 5, c4 = (c & 31) * 4, m = mt * 128 + row;
    if (m < MS5) {
      const float* s = Cs + row * CLD + c4;
      f32x4 v = {s[0], s[1], s[2], s[3]};
      *(f32x4*)(EN + ((size_t)m * 16 + g) * 256 + nt * 128 + c4) = v;
    }
  }
  __syncthreads();
}

DI void s5_scan_job(const Params& p, int l, int j, char* smem) {
  float2* ends = (float2*)smem;
  const int dir = j & 1, g = (j >> 1) & 15, b = j >> 5;
  const int pp = TIDX & 63, seg = TIDX >> 6;
  const float2 aL = ((const float2*)(p.ws + OFF_PWR))[((size_t)((l * 2 + dir) * 16 + g) * 33 + 32) * 64 + pp];
  const float* EN = (const float*)(p.ws + OFF_EN);
  bf16* SB = (bf16*)(p.ws + OFF_SB);
  float sr = 0.f, si = 0.f;
  for (int q0 = 0; q0 < 66; q0 += 11) {
    float er[11], ei[11];
#pragma unroll
    for (int q = 0; q < 11; ++q) {
      const int pos = seg * 66 + q0 + q;
      const int ch = dir ? (pos < 8 ? 7 - pos : 271 - pos) : pos;
      const float* e = EN + ((size_t)(b * NCH + ch) * 16 + g) * 256 + dir * 128 + pp;
      er[q] = e[0]; ei[q] = e[64];
    }
#pragma unroll
    for (int q = 0; q < 11; ++q) {
      const float nr = aL.x * sr - aL.y * si + er[q], ni = aL.x * si + aL.y * sr + ei[q];
      sr = nr; si = ni;
    }
  }
  ends[seg * 64 + pp] = make_float2(sr, si);
  float pr = 1.f, pi = 0.f;
  for (int q = 0; q < 66; ++q) { const float nr = pr * aL.x - pi * aL.y, ni = pr * aL.y + pi * aL.x; pr = nr; pi = ni; }
  __syncthreads();
  sr = 0.f; si = 0.f;
  for (int k = 0; k < seg; ++k) {
    const float2 e = ends[k * 64 + pp];
    const float nr = pr * sr - pi * si + e.x, ni = pr * si + pi * sr + e.y;
    sr = nr; si = ni;
  }
  for (int q0 = 0; q0 < 66; q0 += 11) {
    float er[11], ei[11];
#pragma unroll
    for (int q = 0; q < 11; ++q) {
      const int pos = seg * 66 + q0 + q;
      const int ch = dir ? (pos < 8 ? 7 - pos : 271 - pos) : pos;
      const float* e = EN + ((size_t)(b * NCH + ch) * 16 + g) * 256 + dir * 128 + pp;
      er[q] = e[0]; ei[q] = e[64];
    }
#pragma unroll
    for (int q = 0; q < 11; ++q) {
      const int pos = seg * 66 + q0 + q;
      const int ch = dir ? (pos < 8 ? 7 - pos : 271 - pos) : pos;
      bf16* sb = SB + ((size_t)(b * NCH + ch) * 16 + g) * 256 + dir * 128 + pp;
      sb[0] = f2bf(sr); sb[64] = f2bf(si);
      const float nr = aL.x * sr - aL.y * si + er[q], ni = aL.x * si + aL.y * sr + ei[q];
      sr = nr; si = ni;
    }
  }
  __syncthreads();
}

DI float gelu_tanh(float x) {
  const float u = 0.7978845608028654f * (x + 0.044715f * x * x * x);
  return 0.5f * x * (1.f + tanhf(u));
}

DI void s5_out_tile(const Params& p, int j, char* smem) {
  const int nt = j & 3, mt = (j >> 2) % 9, g = j / 36;
  const bf16* SU = (const bf16*)(p.ws + OFF_SU);
  const bf16* SB = (const bf16*)(p.ws + OFF_SB);
  const bf16* Tm = (const bf16*)(p.ws + OFF_T5) + ((size_t)g * 512 + nt * 128) * 512;
  const bf16* Em = (const bf16*)(p.ws + OFF_E5) + ((size_t)g * 512 + nt * 128) * 256;
  f32x16 acc[2][2];
  acc_zero(acc);
  gemm_main_dma(acc,
            [&](int r) -> const bf16* {
              const int m = mt * 128 + r;
              if (m >= MS5) return (const bf16*)(p.ws + OFF_ZERO);
              const int b = m / NCH, ch = m - b * NCH;
              return SU + ((size_t)(b * 16 + g) * TT + ch * 32) * 16;
            },
            [&](int r) { return Tm + (size_t)r * 512; }, 512, smem);
  gemm_main_dma(acc,
            [&](int r) -> const bf16* {
              const int m = mt * 128 + r;
              if (m >= MS5) return (const bf16*)(p.ws + OFF_ZERO);
              return SB + ((size_t)m * 16 + g) * 256;
            },
            [&](int r) { return Em + (size_t)r * 256; }, 256, smem);
  float* Cs = (float*)smem;
  acc_to_lds(acc, Cs);
  __syncthreads();
  bf16* Y5 = (bf16*)(p.ws + OFF_Y5);
  for (int c = TIDX; c < 2048; c += 256) {
    const int row = c >> 4, c8 = c & 15, m = mt * 128 + row;
    if (m < MS5) {
      const int b = m / NCH, ch = m - b * NCH;
      const int n = nt * 128 + c8 * 8, i = n >> 4, hh = n & 15;
      const float* s = Cs + row * CLD + c8 * 8;
      u32x4 u;
#pragma unroll
      for (int e = 0; e < 4; ++e) u[e] = pack2(gelu_tanh(s[2 * e]), gelu_tanh(s[2 * e + 1]));
      *(u32x4*)(Y5 + ((size_t)b * TT + ch * 32 + i) * 256 + g * 16 + hh) = u;
    }
  }
  __syncthreads();
}

DI void glu_tile(const Params& p, int l, int j, char* smem) {
  const int nt = j & 1, mt = j >> 1;
  const bf16* Y5 = (const bf16*)(p.ws + OFF_Y5) + (size_t)mt * 128 * 256;
  const bf16* W = wl(p, l, WL_GLU) + (size_t)nt * 128 * 256;
  f32x16 acc[2][2];
  acc_zero(acc);
  gemm_main_dma(acc, [&](int r) { return Y5 + (size_t)r * 256; }, [&](int r) { return W + (size_t)r * 256; }, 256, smem);
  float* Cs = (float*)smem;
  acc_to_lds(acc, Cs);
  __syncthreads();
  const float* gb = p.in[I_GLUB] + l * 256 + nt * 128;
  bf16* O = (bf16*)(p.ws + OFF_OS5) + (size_t)mt * 128 * 256 + nt * 128;
  for (int c = TIDX; c < 2048; c += 256) {
    const int row = c >> 4, cc = (c & 15) * 8;
    const float* s = Cs + row * CLD + cc;
    const u32x4 yu = *(const u32x4*)(Y5 + (size_t)row * 256 + nt * 128 + cc);
    u32x4 u;
#pragma unroll
    for (int e = 0; e < 4; ++e) {
      const float y0 = bflo(yu[e]), y1 = bfhi(yu[e]);
      u[e] = pack2(y0 * sigmoidf_(s[2 * e] + gb[cc + 2 * e]), y1 * sigmoidf_(s[2 * e + 1] + gb[cc + 2 * e + 1]));
    }
    *(u32x4*)(O + (size_t)row * 256 + cc) = u;
  }
  __syncthreads();
}

DI void merge_tile(const Params& p, int l, int j, char* smem) {
  const int nt = j & 7, mt = j >> 3;
  const bf16* H = (const bf16*)(p.ws + OFF_H) + (size_t)mt * 128 * DM;
  unsigned am[2][2][8];
#pragma unroll
  for (int a = 0; a < 2; ++a)
#pragma unroll
    for (int bq = 0; bq < 2; ++bq)
#pragma unroll
      for (int i = 0; i < 8; ++i) am[a][bq][i] = 0u;
#pragma unroll 1
  for (int x = 0; x < 3; ++x) {
    const bf16* A; const bf16* Wb; int K;
    if (x == 0) { A = (const bf16*)(p.ws + OFF_OATT) + (size_t)mt * 128 * 256; Wb = wl(p, l, WL_BRA) + (size_t)nt * 128 * 256; K = 256; }
    else if (x == 1) { A = (const bf16*)(p.ws + OFF_OGLA) + (size_t)mt * 128 * 512; Wb = wl(p, l, WL_BRG) + (size_t)nt * 128 * 512; K = 512; }
    else { A = (const bf16*)(p.ws + OFF_OS5) + (size_t)mt * 128 * 256; Wb = wl(p, l, WL_BRS) + (size_t)nt * 128 * 256; K = 256; }
    unsigned br[2][2][8];
    {
      f32x16 acc[2][2];
      acc_zero(acc);
      gemm_main_dma(acc, [&](int r) { return A + (size_t)r * K; }, [&](int r) { return Wb + (size_t)r * K; }, K, smem);
#pragma unroll
      for (int a = 0; a < 2; ++a)
#pragma unroll
        for (int bq = 0; bq < 2; ++bq)
#pragma unroll
          for (int i = 0; i < 8; ++i) br[a][bq][i] = pack2(acc[a][bq][2 * i], acc[a][bq][2 * i + 1]);
    }
    const bf16* Wg = wl(p, l, WL_WIN) + ((size_t)2432 + x * 1024 + nt * 128) * DM;
    f32x16 acc[2][2];
    acc_zero(acc);
    gemm_main_dma(acc, [&](int r) { return H + (size_t)r * DM; }, [&](int r) { return Wg + (size_t)r * DM; }, DM, smem);
#pragma unroll
    for (int a = 0; a < 2; ++a)
#pragma unroll
      for (int bq = 0; bq < 2; ++bq)
#pragma unroll
        for (int i = 0; i < 8; ++i) {
          const float v0 = bflo(am[a][bq][i]) + sigmoidf_(acc[a][bq][2 * i]) * bflo(br[a][bq][i]);
          const float v1 = bfhi(am[a][bq][i]) + sigmoidf_(acc[a][bq][2 * i + 1]) * bfhi(br[a][bq][i]);
          am[a][bq][i] = pack2(v0, v1);
        }
  }
  f32x16 accm[2][2];
#pragma unroll
  for (int a = 0; a < 2; ++a)
#pragma unroll
    for (int bq = 0; bq < 2; ++bq)
#pragma unroll
      for (int i = 0; i < 8; ++i) { accm[a][bq][2 * i] = bflo(am[a][bq][i]); accm[a][bq][2 * i + 1] = bfhi(am[a][bq][i]); }
  float* Cs = (float*)smem;
  acc_to_lds(accm, Cs);
  __syncthreads();
  store_tile_bf16(Cs, (bf16*)(p.ws + OFF_MG) + (size_t)mt * 128 * DM + nt * 128, DM, 128, 1.f);
  __syncthreads();
}

DI void plain_tile(const bf16* A, int K, const bf16* W, bf16* dst, int ldd, char* smem) {
  f32x16 acc[2][2];
  acc_zero(acc);
  gemm_main_dma(acc, [&](int r) { return A + (size_t)r * K; }, [&](int r) { return W + (size_t)r * K; }, K, smem);
  float* Cs = (float*)smem;
  acc_to_lds(acc, Cs);
  __syncthreads();
  store_tile_bf16(Cs, dst, ldd, 128, 1.f);
  __syncthreads();
}

DI void plain_wide(const bf16* A, int K, const bf16* W, bf16* dst, int ldd, char* smem) {
  f32x16 acc[2][4];
  accw_zero(acc);
  gemm_wide(acc, [&](int r) { return A + (size_t)r * K; }, [&](int r) { return W + (size_t)r * K; }, K, smem);
  float* Cs = (float*)smem;
  accw_to_lds<0>(acc, Cs);
  __syncthreads();
  store_tile_bf16(Cs, dst, ldd, 128, 1.f);
  __syncthreads();
  accw_to_lds<1>(acc, Cs);
  __syncthreads();
  store_tile_bf16(Cs, dst + 128, ldd, 128, 1.f);
  __syncthreads();
}

DI void up_epi(const Params& p, int l, int jn, int seqbase, int len, int pos0, char* smem) {
  float* Cs = (float*)smem;
  const float* cw = p.in[I_CW] + (size_t)l * 3 * 2 * DFF;
  const float* cb = p.in[I_CB] + (size_t)l * 2 * DFF;
  bf16* G = (bf16*)(p.ws + OFF_G);
  const int tid = TIDX;
  const int c = (tid & 31) * 2;
  float wa[2][3], wv[2][3], ba[2], bv[2];
#pragma unroll
  for (int e = 0; e < 2; ++e) {
    const int ca = jn * 64 + c + e, cv = DFF + ca;
#pragma unroll
    for (int k = 0; k < 3; ++k) { wa[e][k] = cw[k * 2 * DFF + ca]; wv[e][k] = cw[k * 2 * DFF + cv]; }
    ba[e] = cb[ca]; bv[e] = cb[cv];
  }
#pragma unroll 4
  for (int rr = 1 + (tid >> 5); rr < 127; rr += 8) {
    const int pos = pos0 + rr;
    if (pos < len) {
      float gv[2];
#pragma unroll
      for (int e = 0; e < 2; ++e) {
        const float a = wa[e][0] * Cs[(rr - 1) * CLD + c + e] + wa[e][1] * Cs[rr * CLD + c + e] + wa[e][2] * Cs[(rr + 1) * CLD + c + e] + ba[e];
        const float v = wv[e][0] * Cs[(rr - 1) * CLD + 64 + c + e] + wv[e][1] * Cs[rr * CLD + 64 + c + e] +
                        wv[e][2] * Cs[(rr + 1) * CLD + 64 + c + e] + bv[e];
        gv[e] = siluf_(a) * v;
      }
      *(unsigned*)(G + (size_t)(seqbase + pos) * DFF + jn * 64 + c) = pack2(gv[0], gv[1]);
    }
  }
  __syncthreads();
}

DI void up_wide(const Params& p, int l, int mtile, int jp, char* smem) {
  const int b = mtile / 69, rr0 = mtile % 69;
  int seqbase, len, ti;
  if (rr0 < 3) { seqbase = b * TT; len = CTXL; ti = rr0; }
  else { seqbase = b * TT + CTXL; len = SEQ; ti = rr0 - 3; }
  const int pos0 = ti * 126 - 1;
  const bf16* H = (const bf16*)(p.ws + OFF_H);
  const bf16* W = wl(p, l, WL_UP) + (size_t)jp * 256 * DM;
  f32x16 acc[2][4];
  accw_zero(acc);
  gemm_wide(acc,
            [&](int r) -> const bf16* {
              const int pos = pos0 + r;
              return (pos >= 0 && pos < len) ? H + (size_t)(seqbase + pos) * DM : (const bf16*)(p.ws + OFF_ZERO);
            },
            [&](int r) { return W + (size_t)r * DM; }, DM, smem);
  float* Cs = (float*)smem;
  accw_to_lds<0>(acc, Cs);
  __syncthreads();
  up_epi(p, l, jp * 2, seqbase, len, pos0, smem);
  accw_to_lds<1>(acc, Cs);
  __syncthreads();
  up_epi(p, l, jp * 2 + 1, seqbase, len, pos0, smem);
}

DI bool gemm_job(int bid, int G, int it, int MT, int NTL, int& mt, int& nt, int CW = 8) {
  const int x = bid & 7, q = bid >> 3, Q = G >> 3;
  const int m0 = (x * MT) >> 3, m1 = ((x + 1) * MT) >> 3, Mx = m1 - m0;
  const int jl = q + Q * it;
  if (jl >= Mx * NTL) return false;
  const int full = Mx * CW;
  const int c = jl / full, rem = jl - c * full;
  const int wc = min(CW, NTL - CW * c);
  const int mi = rem / wc;
  mt = m0 + mi;
  nt = CW * c + (rem - mi * wc);
  return true;
}

enum { PH_PREP = 0, PH_ROW0, PH_PROJ, PH_MIX1, PH_SCAN, PH_MIX2, PH_GLU, PH_MERGE, PH_WOUT, PH_ROW1, PH_UP, PH_DOWN, PH_ROW2 };
constexpr int N_PHASES = 2 + 11 * NL;

DI void run_phase(const Params& p, int ph, int l, char* smem) {
  const int bid = blockIdx.x;
#ifdef HALFMASK
  const int G = ((HALFMASK >> ph) & 1) ? 256 : gridDim.x;
  if (bid >= G) return;
#else
  const int G = gridDim.x;
#endif
#ifdef PHMASK
  if (!((PHMASK >> ph) & 1)) return;
#endif
  switch (ph) {
    case PH_PREP:
      if (bid < 8) { for (int i = TIDX; i < 512; i += 256) ((u32x4*)(p.ws + OFF_ZERO))[i] = u32x4{0u, 0u, 0u, 0u}; }
      for (int j = bid; j < 128 + 4016; j += G) {
        if (j < 96) prep_mod_job(p, j, smem);
        else if (j < 128) prep_s5_job(p, j - 96);
        else prep_wt_job(p, j - 128, smem);
      }
      break;
    case PH_ROW0:
      row_phase<0>(p, 0, bid, G);
      ktab_phase(p, bid, G, 0, 1);
      break;
    case PH_PROJ:
#ifdef EXP_A
      if (bid < 256) { int mt, nt; for (int it = 0; gemm_job(bid, 256, it, 264, 10, mt, nt, 4); ++it) proj_wide(p, l, mt, nt, smem); }
      else {
        s5mat_phase(p, l, bid - 256, G - 256);
        if (l + 1 < NL) ktab_phase(p, bid - 256, G - 256, l + 1, l + 2);
        if (l + 1 < NL) { for (int jj = (l + 1) * 4016 + (bid - 256); jj < (l + 2) * 4016; jj += G - 256) prep_wt_job(p, jj, smem); }
      }
#elif defined(EXP_C)
      if (bid < 256) for (int j = bid; j < 264 * 19; j += 256) { if ((EXP_C >> (j % 19)) & 1) proj_tile(p, l, j / 19, j % 19, smem); }
      for (int j = bid; j < 264 * 19; j += G) { if (!((EXP_C >> (j % 19)) & 1)) proj_tile(p, l, j / 19, j % 19, smem); }
      s5mat_phase(p, l, bid, G);
#elif defined(EXP_B)
      for (int j = bid; j < 264 * 19; j += G) proj_tile(p, l, j / 19, j % 19, smem);
      if (bid < 256) s5mat_phase(p, l, bid, 256);
#else
      for (int j = bid; j < 264 * 19; j += G) proj_tile(p, l, j / 19, j % 19, smem);
      s5mat_phase(p, l, bid, G);
#endif
      break;
    case PH_MIX1:
      for (int j = bid; j < 1056 + 1056 + 288; j += G) {
        if (j < 1056) attn_unit(p, j, smem);
        else if (j < 2112) gla_unit<false>(p, l, j - 1056, smem);
        else s5_end_tile(p, j - 2112, smem);
      }
      break;
    case PH_SCAN:
      for (int j = bid; j < 1024 + 128; j += G) {
        if (j < 1024) gla_scan_job(p, j);
        else s5_scan_job(p, l, j - 1024, smem);
      }
      break;
    case PH_MIX2:
      for (int j = bid; j < 528 + 576; j += G) {
        if (j < 528) gla_unit<true>(p, l, j, smem);
        else s5_out_tile(p, j - 528, smem);
      }
      break;
    case PH_GLU:
      { int mt, nt; for (int it = 0; gemm_job(bid, G, it, 264, 2, mt, nt); ++it) glu_tile(p, l, mt * 2 + nt, smem); }
      break;
    case PH_MERGE:
      { int mt, nt; for (int it = 0; gemm_job(bid, G, it, 264, 8, mt, nt); ++it) merge_tile(p, l, mt * 8 + nt, smem); }
      break;
    case PH_WOUT:
      for (int it = 0;; ++it) {
        int mt, nt;
        if (!gemm_job(bid, G, it, 264, 8, mt, nt)) break;
        plain_tile((const bf16*)(p.ws + OFF_MG) + (size_t)mt * 128 * DM, DM, wl(p, l, WL_WOUT) + (size_t)nt * 128 * DM,
                   (bf16*)(p.ws + OFF_H) + (size_t)mt * 128 * DM + nt * 128, DM, smem);
      }
      break;
    case PH_ROW1: row_phase<1>(p, l, bid, G); break;
    case PH_UP:
      { int mt, nt; for (int it = 0; gemm_job(bid, G, it, 276, 22, mt, nt, 4); ++it) up_wide(p, l, mt, nt, smem); }
      break;
    case PH_DOWN:
      for (int it = 0;; ++it) {
        int mt, nt;
        if (!gemm_job(bid, G, it, 264, 8, mt, nt)) break;
        plain_tile((const bf16*)(p.ws + OFF_G) + (size_t)mt * 128 * DFF, DFF, wl(p, l, WL_DOWN) + (size_t)nt * 128 * DFF,
                   (bf16*)(p.ws + OFF_H) + (size_t)mt * 128 * DM + nt * 128, DM, smem);
      }
      break;
    case PH_ROW2: row_phase<2>(p, l, bid, G); break;
  }
}

#define XB_TMO      128
#define XB_XCNT(j)  (256  + 64 * (j))
#define XB_XSUB(j)  (1280 + 64 * (j))
#define XB_XGEN(j)  (2304 + 64 * (j))
#define XB_TOP      3328
#define XB_TOPGEN   3392
#define XCD_BAR_WORDS 3456
#define XB_SPIN_CAP (1u << 18)
#define LAS __attribute__((address_space(3)))

__device__ __forceinline__ unsigned xb_ld(unsigned* p)              { return __hip_atomic_load(p, __ATOMIC_RELAXED, __HIP_MEMORY_SCOPE_AGENT); }
__device__ __forceinline__ unsigned xb_add(unsigned* p, unsigned v) { return __hip_atomic_fetch_add(p, v, __ATOMIC_RELAXED, __HIP_MEMORY_SCOPE_AGENT); }
__device__ __forceinline__ unsigned xb_xcc_id() { return (unsigned)__builtin_amdgcn_s_getreg((3 << 11) | 20) & 0xFu; }
#define XB_SPIN(cond, bar) do { unsigned _sp = 0; while (cond) { __builtin_amdgcn_s_sleep(1); \
    if ((++_sp & 255u) == 0u) { if (xb_ld(&(bar)[XB_TMO])) break; if (_sp > XB_SPIN_CAP) { atomicAdd(&(bar)[XB_TMO], 1u); break; } } } } while (0)

struct XcdBarrier {
    unsigned* bar; unsigned x;
    volatile LAS unsigned* st;
};

__device__ __forceinline__ XcdBarrier xcd_barrier_post(unsigned* bar, volatile LAS unsigned* st) {
    XcdBarrier b; b.bar = bar; b.x = xb_xcc_id(); b.st = st;
    if (threadIdx.x == 0) (void)xb_add(&bar[XB_XCNT(b.x)], 1u);
    return b;
}
__device__ __forceinline__ void xcd_barrier_complete(unsigned* bar, unsigned x, unsigned& nloc, unsigned& nx) {
    const unsigned G = gridDim.x * gridDim.y * gridDim.z;
    unsigned sum, cnt, mine, sp = 0u;
    for (;;) {
        sum = 0u; cnt = 0u; mine = 0u;
#pragma unroll
        for (unsigned j = 0; j < 16; ++j) { const unsigned c = xb_ld(&bar[XB_XCNT(j)]); sum += c; cnt += (c > 0u) ? 1u : 0u; mine = (j == x) ? c : mine; }
        if (sum == G) break;
        __builtin_amdgcn_s_sleep(1);
        if ((++sp & 255u) == 0u) { if (xb_ld(&bar[XB_TMO])) break; if (sp > XB_SPIN_CAP) { atomicAdd(&bar[XB_TMO], 1u); break; } }
    }
    nloc = mine > 0u ? mine : 1u; nx = cnt > 0u ? cnt : 1u;
}

__device__ __forceinline__ void xcd_barrier(const XcdBarrier& b) {
    asm volatile("s_waitcnt vmcnt(0)" ::: "memory");
    __syncthreads();
    if (threadIdx.x == 0) {
        unsigned* bar = b.bar;
        __builtin_amdgcn_s_waitcnt(0);
        unsigned nloc = b.st[0], nx = b.st[1];
        if (nloc == 0u) { xcd_barrier_complete(bar, b.x, nloc, nx); b.st[0] = nloc; b.st[1] = nx; }
        const unsigned old = xb_add(&bar[XB_XSUB(b.x)], 1u);
        const unsigned gen = old / nloc;
        if (old + 1u == (gen + 1u) * nloc) {
            __builtin_amdgcn_fence(__ATOMIC_RELEASE, "agent");
            asm volatile("s_waitcnt vmcnt(0)" ::: "memory");
            const unsigned og = xb_add(&bar[XB_TOP], 1u);
            const unsigned tg = og / nx;
            if (og + 1u == (tg + 1u) * nx) xb_add(&bar[XB_TOPGEN], 1u);
            else XB_SPIN(xb_ld(&bar[XB_TOPGEN]) == tg, bar);
            __builtin_amdgcn_fence(__ATOMIC_ACQUIRE, "agent");
            xb_add(&bar[XB_XGEN(b.x)], 1u);
            asm volatile("s_waitcnt vmcnt(0)" ::: "memory");
        } else {
            XB_SPIN(xb_ld(&bar[XB_XGEN(b.x)]) == gen, bar);
            __builtin_amdgcn_fence(__ATOMIC_ACQUIRE, "agent");
            asm volatile("s_waitcnt vmcnt(0)" ::: "memory");
        }
    }
    __syncthreads();
}


DI void grid_barrier(unsigned* bar, unsigned& gen) {
  asm volatile("s_waitcnt vmcnt(0)" ::: "memory");
  __syncthreads();
  gen += 1;
  if (threadIdx.x == 0) {
    __builtin_amdgcn_fence(__ATOMIC_RELEASE, "agent");
    asm volatile("s_waitcnt vmcnt(0)" ::: "memory");
    const unsigned target = gen * gridDim.x;
    __hip_atomic_fetch_add(bar, 1u, __ATOMIC_RELAXED, __HIP_MEMORY_SCOPE_AGENT);
    while (__hip_atomic_load(bar, __ATOMIC_RELAXED, __HIP_MEMORY_SCOPE_AGENT) < target) __builtin_amdgcn_s_sleep(2);
  }
  __syncthreads();
  __builtin_amdgcn_fence(__ATOMIC_ACQUIRE, "agent");
  asm volatile("s_waitcnt vmcnt(0)" ::: "memory");
}

__global__ void __launch_bounds__(256, 2) hybrid_fwd(Params p, int ph_lo, int ph_hi) {
  extern __shared__ __attribute__((aligned(16))) char smem[];
  unsigned* bar = (unsigned*)(p.ws + OFF_BAR);
  unsigned gen = 0;
  __shared__ uint4 xb_words;
  if (threadIdx.x == 0) xb_words = make_uint4(0u, 0u, 0u, 0u);
  __syncthreads();
  XcdBarrier xb = xcd_barrier_post(bar + 64, (volatile LAS unsigned*)&xb_words);
  if (ph_hi - ph_lo > 1) cg::this_grid().sync();
  int i = 0;
#define STEP(PH, L)                                      \
  {                                                      \
    if (i >= ph_lo && i < ph_hi) {                       \
      Params q;                                          \
      q.ws = p.ws; q.out = p.out;                        \
      asm volatile("" : "+s"(q.ws), "+s"(q.out));        \
      _Pragma("unroll") for (int k = 0; k < 34; ++k) { q.in[k] = p.in[k]; asm volatile("" : "+s"(q.in[k])); } \
      run_phase(q, PH, L, smem);                         \
      if ((DUPMASK >> (PH)) & 1) { xcd_barrier(xb); run_phase(q, PH, L, smem); } \
      if (i + 1 < ph_hi) xcd_barrier(xb);                \
    }                                                    \
    ++i;                                                 \
  }
  STEP(PH_PREP, 0)
  STEP(PH_ROW0, 0)
#pragma unroll 1
  for (int l = 0; l < NL; ++l) {
    STEP(PH_PROJ, l)
    STEP(PH_MIX1, l)
    STEP(PH_SCAN, l)
    STEP(PH_MIX2, l)
    STEP(PH_GLU, l)
    STEP(PH_MERGE, l)
    STEP(PH_WOUT, l)
    STEP(PH_ROW1, l)
    STEP(PH_UP, l)
    STEP(PH_DOWN, l)
    STEP(PH_ROW2, l)
  }
#undef STEP
}

extern "C" void kernel_launch(void* const* d_in, const int* in_sizes, int n_in, void* d_out, int out_size, void* d_ws, size_t ws_size,
                              hipStream_t stream) {
  static int grid_blocks = 0;
  if (!grid_blocks) {
    int dev = 0, cus = 0, per_cu = 0;
    hipGetDevice(&dev);
    hipDeviceGetAttribute(&cus, hipDeviceAttributeMultiprocessorCount, dev);
    hipFuncSetAttribute((const void*)hybrid_fwd, hipFuncAttributeMaxDynamicSharedMemorySize, SMEM_BYTES);
    hipOccupancyMaxActiveBlocksPerMultiprocessor(&per_cu, hybrid_fwd, 256, SMEM_BYTES);
    if (per_cu < 1) per_cu = 1;
    if (per_cu > 2) per_cu = 2;
    grid_blocks = cus * per_cu;
    if (ws_size < OFF_ZERO + 8192) fprintf(stderr, "workspace too small: %zu < %zu\n", ws_size, (size_t)OFF_END);
  }
  Params p{};
  for (int i = 0; i < 34; ++i) p.in[i] = (const float*)d_in[i];
  p.out = (float*)d_out;
  p.ws = (char*)d_ws;
#if ONE_LAUNCH
  hipMemsetAsync((char*)d_ws + OFF_BAR, 0, 16384, stream);
  int lo = 0, hi = N_PHASES;
  void* args[] = {&p, &lo, &hi};
  hipError_t e = hipLaunchCooperativeKernel((void*)hybrid_fwd, dim3(grid_blocks), dim3(256), args, SMEM_BYTES, stream);
  if (e != hipSuccess) fprintf(stderr, "cooperative launch failed: %s (grid %d)\n", hipGetErrorString(e), grid_blocks);
#else
  for (int i = 0; i < N_PHASES; ++i) hipLaunchKernelGGL(hybrid_fwd, dim3(grid_blocks), dim3(256), SMEM_BYTES, stream, p, i, i + 1);
#endif
}
```

```cpp
#include <hip/hip_runtime.h>
#include <hip/hip_cooperative_groups.h>
#include <stdint.h>
#include <cstdio>
namespace cg = cooperative_groups;

#define EXP_A 1
#ifndef DUPMASK
#define DUPMASK 0
#endif
#ifndef ONE_LAUNCH
#define ONE_LAUNCH 1
#endif

typedef unsigned short bf16;
typedef __attribute__((ext_vector_type(8))) short s16x8;
typedef __attribute__((ext_vector_type(4))) short s16x4;
typedef __attribute__((ext_vector_type(16))) float f32x16;
typedef __attribute__((ext_vector_type(4))) float f32x4;
typedef __attribute__((ext_vector_type(2))) float f32x2;
typedef __attribute__((ext_vector_type(4))) unsigned u32x4;
typedef __attribute__((ext_vector_type(2))) unsigned u32x2;
typedef __attribute__((ext_vector_type(2))) __bf16 bf16x2_t;

#define DI __device__ __forceinline__
#define MFMA32(a, b, c) __builtin_amdgcn_mfma_f32_32x32x16_bf16((a), (b), (c), 0, 0, 0)

DI int tidx_opaque() { int t = threadIdx.x; asm volatile("" : "+v"(t)); return t; }
#define TIDX tidx_opaque()
DI bf16 f2bf(float x) { return __builtin_bit_cast(unsigned short, (__bf16)x); }
DI float bf2f(bf16 v) { return __uint_as_float(((unsigned)v) << 16); }
DI unsigned pack2(float a, float b) {
  f32x2 v = {a, b};
  return __builtin_bit_cast(unsigned, __builtin_convertvector(v, bf16x2_t));
}
DI float bflo(unsigned u) { return __uint_as_float(u << 16); }
DI float bfhi(unsigned u) { return __uint_as_float(u & 0xffff0000u); }
typedef const __attribute__((address_space(1))) u32x4* gptr16;
DI u32x4 ldg16(const void* q) { return *(gptr16)(uintptr_t)q; }
#define SCHED_FENCE() __builtin_amdgcn_sched_barrier(0)
DI int crow(int i, int h) { return (i & 3) + 8 * (i >> 2) + 4 * h; }
DI void sincos_cw(float x, float& sn, float& cs) {
  const float k = rintf(x * 0.63661977236758134f);
  float r = fmaf(-k, 1.57079637050628662109375f, x);
  r = fmaf(-k, -4.371139000186241e-08f, r);
  const int q = ((int)k) & 3;
  const float r2 = r * r;
  const float sp = r + r * r2 * (-1.6666667163e-01f + r2 * (8.3333337680e-03f + r2 * (-1.9841270114e-04f + r2 * 2.7557314297e-06f)));
  const float cp = 1.f + r2 * (-0.5f + r2 * (4.1666667908e-02f + r2 * (-1.3888889225e-03f + r2 * (2.4801587642e-05f - r2 * 2.7557314297e-07f))));
  sn = (q == 0) ? sp : (q == 1) ? cp : (q == 2) ? -sp : -cp;
  cs = (q == 0) ? cp : (q == 1) ? -sp : (q == 2) ? -cp : sp;
}
DI float sigmoidf_(float x) { return 1.f / (1.f + __expf(-x)); }
DI float siluf_(float x) { return x / (1.f + __expf(-x)); }

constexpr int DM = 1024, NB = 4, SEQ = 8192, CTXL = 256, TT = SEQ + CTXL, NTOK = NB * TT, NL = 4;
constexpr int DFF = 2816, DIN = 5408;
constexpr float EPSF = 1e-6f;
constexpr int NG33 = 33;
constexpr int NCH = 264;
constexpr int MS5 = NB * NCH;

constexpr size_t SZ_H = (size_t)NTOK * 1024 * 2;
constexpr size_t OFF_H = 0;
constexpr size_t OFF_P = OFF_H + SZ_H;
constexpr size_t OFF_Q = OFF_P;
constexpr size_t OFF_K = OFF_Q + (size_t)NTOK * 256 * 2;
constexpr size_t OFF_VT = OFF_K + (size_t)NTOK * 128 * 2;
constexpr size_t OFF_GQ = OFF_VT + (size_t)NTOK * 128 * 2;
constexpr size_t OFF_GK = OFF_GQ + (size_t)NTOK * 256 * 2;
constexpr size_t OFF_GVT = OFF_GK + (size_t)NTOK * 256 * 2;
constexpr size_t OFF_GR = OFF_GVT + (size_t)NTOK * 512 * 2;
constexpr size_t OFF_SU = OFF_GR + (size_t)NTOK * 512 * 2;
constexpr size_t OFF_LOW = OFF_SU + (size_t)NTOK * 256 * 2;
constexpr size_t OFF_O = OFF_LOW + (size_t)NTOK * 32 * 4;
constexpr size_t OFF_OATT = OFF_O;
constexpr size_t OFF_OGLA = OFF_OATT + (size_t)NTOK * 256 * 2;
constexpr size_t OFF_Y5 = OFF_OGLA + (size_t)NTOK * 512 * 2;
constexpr size_t OFF_EN = OFF_Y5;
constexpr size_t OFF_OS5 = OFF_Y5 + (size_t)NTOK * 256 * 2;
constexpr size_t OFF_M = OFF_OS5 + (size_t)NTOK * 256 * 2;
constexpr size_t OFF_MG = OFF_M;
constexpr size_t OFF_GS = OFF_M;
constexpr size_t OFF_DECG = OFF_GS + (size_t)32 * 33 * 8192 * 4;
constexpr size_t OFF_SB = OFF_DECG + (size_t)32 * 33 * 64 * 4;
constexpr size_t OFF_T5 = OFF_SB + (size_t)MS5 * 16 * 256 * 2;
constexpr size_t OFF_E5 = OFF_T5 + (size_t)16 * 512 * 512 * 2;
constexpr size_t OFF_F5 = OFF_E5 + (size_t)16 * 512 * 256 * 2;
constexpr size_t OFF_MEND = OFF_F5 + (size_t)16 * 256 * 512 * 2;
static_assert(OFF_MEND <= OFF_M + SZ_H, "mixer scratch overflows merged area");
constexpr size_t OFF_W = OFF_M + SZ_H;
constexpr size_t WL_WIN = 0, WL_BRA = WL_WIN + (size_t)5504 * 1024, WL_BRG = WL_BRA + 1024 * 256, WL_BRS = WL_BRG + 1024 * 512,
                 WL_WOUT = WL_BRS + 1024 * 256, WL_UP = WL_WOUT + 1024 * 1024, WL_DOWN = WL_UP + (size_t)5632 * 1024,
                 WL_GLU = WL_DOWN + (size_t)1024 * 2816, WL_TOTAL = WL_GLU + 256 * 256;
constexpr size_t OFF_XC = OFF_W + WL_TOTAL * 2 * NL;
constexpr size_t OFF_MOD = OFF_XC + (size_t)NB * CTXL * 1024 * 4;
constexpr size_t OFF_BBR = OFF_MOD + (size_t)NL * 5 * 6144 * 4;
constexpr size_t OFF_BBI = OFF_BBR + (size_t)NL * 2 * 16 * 64 * 16 * 4;
constexpr size_t OFF_PWR = OFF_BBI + (size_t)NL * 2 * 16 * 64 * 16 * 4;
constexpr size_t OFF_KTAB = OFF_PWR + (size_t)NL * 2 * 16 * 33 * 64 * 8;
constexpr size_t OFF_END = OFF_KTAB + (size_t)NL * 16 * 2 * 32 * 256 * 4;
constexpr size_t OFF_BAR = OFF_END;
constexpr size_t OFF_ZERO = OFF_BAR + 16384;
constexpr size_t OFF_G = OFF_P;
static_assert((size_t)NTOK * DFF * 2 <= OFF_M - OFF_P, "G overflows");

constexpr int SMEM_BYTES = 73728;

struct Params {
  const float* in[34];
  float* out;
  char* ws;
};

enum { I_X = 0, I_C, I_CTX, I_CCTX, I_ADAW, I_ADAB, I_NMPRE, I_NMPOST, I_NFPRE, I_NFPOST, I_WIN, I_QN, I_KN, I_GGW, I_GGB, I_GON,
       I_ARE, I_AIM, I_LDT, I_BRE, I_BIM, I_CRE, I_CIM, I_S5D, I_GLUW, I_GLUB, I_WBA, I_WBG, I_WBS, I_WOUT, I_UP, I_CW, I_CB, I_DOWN };

constexpr int LDT = 72;
constexpr int CLD = 132;

template <class FA, class FB>
DI void gemm_main(f32x16 (&acc)[2][2], FA fa, FB fb, int K, char* smem) {
  bf16* As = (bf16*)smem;
  bf16* Bs = (bf16*)(smem + 2 * 128 * LDT * 2);
  const int tid = TIDX, lane = tid & 63, w = tid >> 6, wm = w >> 1, wn = w & 1;
  const int r = lane & 31, h = lane >> 5;
  const int lr = tid >> 3, kc = (tid & 7) * 8;
  const bf16* ap[4];
  const bf16* bp[4];
#pragma unroll
  for (int i = 0; i < 4; ++i) {
    const bf16* a = fa(lr + 32 * i);
    const bf16* b = fb(lr + 32 * i);
    ap[i] = a ? a + kc : nullptr;
    bp[i] = b ? b + kc : nullptr;
  }
  u32x4 ra[4], rb[4];
  const u32x4 z4 = {0u, 0u, 0u, 0u};
#pragma unroll
  for (int i = 0; i < 4; ++i) {
    ra[i] = ap[i] ? ldg16(ap[i]) : z4;
    rb[i] = bp[i] ? ldg16(bp[i]) : z4;
  }
#pragma unroll
  for (int i = 0; i < 4; ++i) {
    *(u32x4*)(As + (lr + 32 * i) * LDT + kc) = ra[i];
    *(u32x4*)(Bs + (lr + 32 * i) * LDT + kc) = rb[i];
  }
  __syncthreads();
  const int nk = K / 64;
  for (int kt = 0; kt < nk; ++kt) {
    const int buf = kt & 1;
    const bool more = (kt + 1 < nk);
    if (more) {
      const int k0 = (kt + 1) * 64;
#pragma unroll
      for (int i = 0; i < 4; ++i) {
        ra[i] = ap[i] ? ldg16(ap[i] + k0) : z4;
        rb[i] = bp[i] ? ldg16(bp[i] + k0) : z4;
      }
    }
    SCHED_FENCE();
    const bf16* Ab = As + buf * 128 * LDT + (wm * 64 + r) * LDT + h * 8;
    const bf16* Bb = Bs + buf * 128 * LDT + (wn * 64 + r) * LDT + h * 8;
#pragma unroll
    for (int s = 0; s < 4; ++s) {
      s16x8 a0 = *(const s16x8*)(Ab + s * 16);
      s16x8 a1 = *(const s16x8*)(Ab + 32 * LDT + s * 16);
      s16x8 b0 = *(const s16x8*)(Bb + s * 16);
      s16x8 b1 = *(const s16x8*)(Bb + 32 * LDT + s * 16);
      acc[0][0] = MFMA32(a0, b0, acc[0][0]);
      acc[0][1] = MFMA32(a0, b1, acc[0][1]);
      acc[1][0] = MFMA32(a1, b0, acc[1][0]);
      acc[1][1] = MFMA32(a1, b1, acc[1][1]);
    }
    SCHED_FENCE();
    if (more) {
      bf16* Aw = As + (buf ^ 1) * 128 * LDT;
      bf16* Bw = Bs + (buf ^ 1) * 128 * LDT;
#pragma unroll
      for (int i = 0; i < 4; ++i) {
        *(u32x4*)(Aw + (lr + 32 * i) * LDT + kc) = ra[i];
        *(u32x4*)(Bw + (lr + 32 * i) * LDT + kc) = rb[i];
      }
    }
    __syncthreads();
  }
}

template <class FA, class FB>
DI void gemm_main_deep(f32x16 (&acc)[2][2], FA fa, FB fb, int K, char* smem) {
  bf16* As = (bf16*)smem;
  bf16* Bs = (bf16*)(smem + 2 * 128 * LDT * 2);
  const int tid = TIDX, lane = tid & 63, w = tid >> 6, wm = w >> 1, wn = w & 1;
  const int r = lane & 31, h = lane >> 5;
  const int lr = tid >> 3, kc = (tid & 7) * 8;
  const bf16* ap[4];
  const bf16* bp[4];
#pragma unroll
  for (int i = 0; i < 4; ++i) {
    const bf16* a = fa(lr + 32 * i);
    const bf16* b = fb(lr + 32 * i);
    ap[i] = a ? a + kc : nullptr;
    bp[i] = b ? b + kc : nullptr;
  }
  const u32x4 z4 = {0u, 0u, 0u, 0u};
  u32x4 a0[4], b0[4], a1[4], b1[4];
  const int nk = K / 64;
#define GD_LOAD(RA, RB, T)                                               \
  {                                                                      \
    const int k0_ = (T) * 64;                                            \
    _Pragma("unroll") for (int i = 0; i < 4; ++i) {                      \
      RA[i] = ap[i] ? ldg16(ap[i] + k0_) : z4;                           \
      RB[i] = bp[i] ? ldg16(bp[i] + k0_) : z4;                           \
    }                                                                    \
  }
#define GD_STORE(RA, RB, BUF)                                            \
  {                                                                      \
    _Pragma("unroll") for (int i = 0; i < 4; ++i) {                      \
      *(u32x4*)(As + (BUF) * 128 * LDT + (lr + 32 * i) * LDT + kc) = RA[i]; \
      *(u32x4*)(Bs + (BUF) * 128 * LDT + (lr + 32 * i) * LDT + kc) = RB[i]; \
    }                                                                    \
  }
#define GD_COMPUTE(BUF)                                                  \
  {                                                                      \
    const bf16* Ab = As + (BUF) * 128 * LDT + (wm * 64 + r) * LDT + h * 8; \
    const bf16* Bb = Bs + (BUF) * 128 * LDT + (wn * 64 + r) * LDT + h * 8; \
    _Pragma("unroll") for (int s = 0; s < 4; ++s) {                      \
      s16x8 fa0 = *(const s16x8*)(Ab + s * 16);                          \
      s16x8 fa1 = *(const s16x8*)(Ab + 32 * LDT + s * 16);               \
      s16x8 fb0 = *(const s16x8*)(Bb + s * 16);                          \
      s16x8 fb1 = *(const s16x8*)(Bb + 32 * LDT + s * 16);               \
      acc[0][0] = MFMA32(fa0, fb0, acc[0][0]);                           \
      acc[0][1] = MFMA32(fa0, fb1, acc[0][1]);                           \
      acc[1][0] = MFMA32(fa1, fb0, acc[1][0]);                           \
      acc[1][1] = MFMA32(fa1, fb1, acc[1][1]);                           \
    }                                                                    \
  }
  GD_LOAD(a0, b0, 0)
  GD_LOAD(a1, b1, 1)
  GD_STORE(a0, b0, 0)
  __syncthreads();
  if (nk > 2) GD_LOAD(a0, b0, 2)
  for (int kt = 0; kt < nk; kt += 2) {
    SCHED_FENCE();
    GD_COMPUTE(0)
    SCHED_FENCE();
    GD_STORE(a1, b1, 1)
    if (kt + 3 < nk) GD_LOAD(a1, b1, kt + 3)
    __syncthreads();
    SCHED_FENCE();
    GD_COMPUTE(1)
    SCHED_FENCE();
    if (kt + 2 < nk) {
      GD_STORE(a0, b0, 0)
      if (kt + 4 < nk) GD_LOAD(a0, b0, kt + 4)
    }
    __syncthreads();
  }
#undef GD_LOAD
#undef GD_STORE
#undef GD_COMPUTE
}

template <class FA, class FB>
DI void gemm_main_dma(f32x16 (&acc)[2][2], FA fa, FB fb, int K, char* smem) {
  char* As = smem;
  char* Bs = smem + 32768;
  const int tid = TIDX, lane = tid & 63, w = tid >> 6, wm = w >> 1, wn = w & 1;
  const int r = lane & 31, h = lane >> 5;
  const bf16* ap[4];
  const bf16* bp[4];
#pragma unroll
  for (int i = 0; i < 4; ++i) {
    const int row = w * 32 + i * 8 + (lane >> 3);
    const int c = (lane & 7) ^ ((row >> 1) & 7);
    ap[i] = fa(row) + c * 8;
    bp[i] = fb(row) + c * 8;
  }
  const int ldst = (w * 256 + lane) * 16;
#define GM_DMA(BUF, T)                                                                                        \
  {                                                                                                           \
    const int k0_ = (T) * 64;                                                                                 \
    _Pragma("unroll") for (int i = 0; i < 4; ++i) {                                                           \
      __builtin_amdgcn_global_load_lds((const unsigned*)(ap[i] + k0_), (unsigned*)(As + (BUF) * 16384 + ldst + i * 1024), 16, 0, 0); \
      __builtin_amdgcn_global_load_lds((const unsigned*)(bp[i] + k0_), (unsigned*)(Bs + (BUF) * 16384 + ldst + i * 1024), 16, 0, 0); \
    }                                                                                                         \
  }
  const int xr = (r >> 1) & 7;
  const int arow = (wm * 64 + r) * 128, brow = (wn * 64 + r) * 128;
  GM_DMA(0, 0)
  asm volatile("s_waitcnt vmcnt(0)" ::: "memory");
  __syncthreads();
  const int nk = K / 64;
  for (int kt = 0; kt < nk; ++kt) {
    const int buf = kt & 1;
    if (kt + 1 < nk) GM_DMA(buf ^ 1, kt + 1)
    const char* Ab = As + buf * 16384 + arow;
    const char* Bb = Bs + buf * 16384 + brow;
#pragma unroll
    for (int s = 0; s < 4; ++s) {
      const int co = ((2 * s + h) ^ xr) * 16;
      s16x8 a0 = *(const s16x8*)(Ab + co);
      s16x8 a1 = *(const s16x8*)(Ab + 32 * 128 + co);
      s16x8 b0 = *(const s16x8*)(Bb + co);
      s16x8 b1 = *(const s16x8*)(Bb + 32 * 128 + co);
      acc[0][0] = MFMA32(a0, b0, acc[0][0]);
      acc[0][1] = MFMA32(a0, b1, acc[0][1]);
      acc[1][0] = MFMA32(a1, b0, acc[1][0]);
      acc[1][1] = MFMA32(a1, b1, acc[1][1]);
    }
    asm volatile("s_waitcnt vmcnt(0)" ::: "memory");
    __syncthreads();
  }
#undef GM_DMA
}

DI void gemm_main_dma_half(f32x16 (&acc)[2], const bf16* A, int lda, const bf16* B, int ldb, int K, int hf, char* smem) {
  char* As = smem;
  char* Bs = smem + 32768;
  const int tid = TIDX, lane = tid & 63, w = tid >> 6, wm = w >> 1, wn = w & 1;
  const int r = lane & 31, h = lane >> 5;
  const bf16* ap[4];
  const bf16* bp[2];
#pragma unroll
  for (int i = 0; i < 4; ++i) {
    const int row = w * 32 + i * 8 + (lane >> 3);
    ap[i] = A + (size_t)row * lda + ((lane & 7) ^ ((row >> 1) & 7)) * 8;
  }
#pragma unroll
  for (int i = 0; i < 2; ++i) {
    const int lrow = w * 16 + i * 8 + (lane >> 3);
    const int grow = (lrow >> 5) * 64 + hf * 32 + (lrow & 31);
    bp[i] = B + (size_t)grow * ldb + ((lane & 7) ^ ((lrow >> 1) & 7)) * 8;
  }
  const int lda_ = (w * 256 + lane) * 16, ldb_ = (w * 128 + lane) * 16;
#define GH_DMA(BUF, T)                                                                                        \
  {                                                                                                           \
    const int k0_ = (T) * 64;                                                                                 \
    _Pragma("unroll") for (int i = 0; i < 4; ++i)                                                             \
      __builtin_amdgcn_global_load_lds((const unsigned*)(ap[i] + k0_), (unsigned*)(As + (BUF) * 16384 + lda_ + i * 1024), 16, 0, 0); \
    _Pragma("unroll") for (int i = 0; i < 2; ++i)                                                             \
      __builtin_amdgcn_global_load_lds((const unsigned*)(bp[i] + k0_), (unsigned*)(Bs + (BUF) * 8192 + ldb_ + i * 1024), 16, 0, 0); \
  }
  const int xr = (r >> 1) & 7;
  const int arow = (wm * 64 + r) * 128, brow = (wn * 32 + r) * 128;
  GH_DMA(0, 0)
  asm volatile("s_waitcnt vmcnt(0)" ::: "memory");
  __syncthreads();
  const int nk = K / 64;
  for (int kt = 0; kt < nk; ++kt) {
    const int buf = kt & 1;
    if (kt + 1 < nk) GH_DMA(buf ^ 1, kt + 1)
    const char* Ab = As + buf * 16384 + arow;
    const char* Bb = Bs + buf * 8192 + brow;
#pragma unroll
    for (int s = 0; s < 4; ++s) {
      const int co = ((2 * s + h) ^ xr) * 16;
      s16x8 a0 = *(const s16x8*)(Ab + co);
      s16x8 a1 = *(const s16x8*)(Ab + 32 * 128 + co);
      s16x8 b0 = *(const s16x8*)(Bb + co);
      acc[0] = MFMA32(a0, b0, acc[0]);
      acc[1] = MFMA32(a1, b0, acc[1]);
    }
    asm volatile("s_waitcnt vmcnt(0)" ::: "memory");
    __syncthreads();
  }
#undef GH_DMA
}

template <class FA, class FB>
DI void gemm_wide(f32x16 (&acc)[2][4], FA fa, FB fb, int K, char* smem) {
  const int tid = TIDX, lane = tid & 63, w = tid >> 6, wm = w >> 1, wn = w & 1;
  const int r = lane & 31, h = lane >> 5;
  const bf16* ap[2];
  const bf16* bp[4];
#pragma unroll
  for (int i = 0; i < 2; ++i) {
    const int row = w * 32 + i * 16 + (lane >> 2);
    ap[i] = fa(row) + ((lane & 3) ^ ((row >> 2) & 3)) * 8;
  }
#pragma unroll
  for (int i = 0; i < 4; ++i) {
    const int row = w * 64 + i * 16 + (lane >> 2);
    bp[i] = fb(row) + ((lane & 3) ^ ((row >> 2) & 3)) * 8;
  }
  const int lda_ = (w * 128 + lane) * 16;
  const int ldb_ = 8192 + (w * 256 + lane) * 16;
#define GW_DMA(T)                                                                                                   \
  {                                                                                                                 \
    char* st_ = smem + ((T) % 3) * 24576;                                                                           \
    const int k0_ = (T) * 32;                                                                                       \
    _Pragma("unroll") for (int i = 0; i < 2; ++i)                                                                   \
      __builtin_amdgcn_global_load_lds((const unsigned*)(ap[i] + k0_), (unsigned*)(st_ + lda_ + i * 1024), 16, 0, 0); \
    _Pragma("unroll") for (int i = 0; i < 4; ++i)                                                                   \
      __builtin_amdgcn_global_load_lds((const unsigned*)(bp[i] + k0_), (unsigned*)(st_ + ldb_ + i * 1024), 16, 0, 0); \
  }
  const int xr = (r >> 2) & 3;
  const int arow = (wm * 64 + r) * 64;
  const int brow = 8192 + (wn * 64 + r) * 64;
  const int nt = K / 32;
  GW_DMA(0)
  if (nt > 1) GW_DMA(1)
  for (int t = 0; t < nt; ++t) {
    if (t + 1 < nt) asm volatile("s_waitcnt vmcnt(6)" ::: "memory");
    else asm volatile("s_waitcnt vmcnt(0)" ::: "memory");
    __syncthreads();
    if (t + 2 < nt) GW_DMA(t + 2)
    const char* st = smem + (t % 3) * 24576;
#pragma unroll
    for (int s = 0; s < 2; ++s) {
      const int co = ((2 * s + h) ^ xr) * 16;
      const s16x8 a0 = *(const s16x8*)(st + arow + co);
      const s16x8 a1 = *(const s16x8*)(st + arow + 32 * 64 + co);
#pragma unroll
      for (int hn = 0; hn < 2; ++hn) {
        const s16x8 b0 = *(const s16x8*)(st + brow + hn * 128 * 64 + co);
        const s16x8 b1 = *(const s16x8*)(st + brow + hn * 128 * 64 + 32 * 64 + co);
        acc[0][hn * 2 + 0] = MFMA32(a0, b0, acc[0][hn * 2 + 0]);
        acc[0][hn * 2 + 1] = MFMA32(a0, b1, acc[0][hn * 2 + 1]);
        acc[1][hn * 2 + 0] = MFMA32(a1, b0, acc[1][hn * 2 + 0]);
        acc[1][hn * 2 + 1] = MFMA32(a1, b1, acc[1][hn * 2 + 1]);
      }
    }
  }
  __syncthreads();
#undef GW_DMA
}

DI void accw_zero(f32x16 (&acc)[2][4]) {
#pragma unroll
  for (int a = 0; a < 2; ++a)
#pragma unroll
    for (int b = 0; b < 4; ++b)
#pragma unroll
      for (int i = 0; i < 16; ++i) acc[a][b][i] = 0.f;
}

DI void gemm_main_s(f32x16 (&acc)[2][2], const bf16* A, int lda, const bf16* B, int ldb, int K, char* smem) {
  bf16* As = (bf16*)smem;
  bf16* Bs = (bf16*)(smem + 2 * 128 * LDT * 2);
  const int tid = TIDX, lane = tid & 63, w = tid >> 6, wm = w >> 1, wn = w & 1;
  const int r = lane & 31, h = lane >> 5;
  const int lr = tid >> 3, kc = (tid & 7) * 8;
  const bf16* ap = A + (size_t)lr * lda + kc;
  const bf16* bp = B + (size_t)lr * ldb + kc;
  const size_t sa = (size_t)32 * lda, sb = (size_t)32 * ldb;
  u32x4 ra[4], rb[4];
#pragma unroll
  for (int i = 0; i < 4; ++i) {
    ra[i] = ldg16(ap + i * sa);
    rb[i] = ldg16(bp + i * sb);
  }
#pragma unroll
  for (int i = 0; i < 4; ++i) {
    *(u32x4*)(As + (lr + 32 * i) * LDT + kc) = ra[i];
    *(u32x4*)(Bs + (lr + 32 * i) * LDT + kc) = rb[i];
  }
  __syncthreads();
  const int nk = K / 64;
  for (int kt = 0; kt < nk; ++kt) {
    const int buf = kt & 1;
    const bool more = (kt + 1 < nk);
    if (more) {
      ap += 64; bp += 64;
#pragma unroll
      for (int i = 0; i < 4; ++i) {
        ra[i] = ldg16(ap + i * sa);
        rb[i] = ldg16(bp + i * sb);
      }
    }
    SCHED_FENCE();
    const bf16* Ab = As + buf * 128 * LDT + (wm * 64 + r) * LDT + h * 8;
    const bf16* Bb = Bs + buf * 128 * LDT + (wn * 64 + r) * LDT + h * 8;
#pragma unroll
    for (int s = 0; s < 4; ++s) {
      s16x8 a0 = *(const s16x8*)(Ab + s * 16);
      s16x8 a1 = *(const s16x8*)(Ab + 32 * LDT + s * 16);
      s16x8 b0 = *(const s16x8*)(Bb + s * 16);
      s16x8 b1 = *(const s16x8*)(Bb + 32 * LDT + s * 16);
      acc[0][0] = MFMA32(a0, b0, acc[0][0]);
      acc[0][1] = MFMA32(a0, b1, acc[0][1]);
      acc[1][0] = MFMA32(a1, b0, acc[1][0]);
      acc[1][1] = MFMA32(a1, b1, acc[1][1]);
    }
    SCHED_FENCE();
    if (more) {
      bf16* Aw = As + (buf ^ 1) * 128 * LDT;
      bf16* Bw = Bs + (buf ^ 1) * 128 * LDT;
#pragma unroll
      for (int i = 0; i < 4; ++i) {
        *(u32x4*)(Aw + (lr + 32 * i) * LDT + kc) = ra[i];
        *(u32x4*)(Bw + (lr + 32 * i) * LDT + kc) = rb[i];
      }
    }
    __syncthreads();
  }
}

DI void gemm_main_half(f32x16 (&acc)[2], const bf16* A, int lda, const bf16* B, int ldb, int K, int hf, char* smem) {
  bf16* As = (bf16*)smem;
  bf16* Bs = (bf16*)(smem + 2 * 128 * LDT * 2);
  const int tid = TIDX, lane = tid & 63, w = tid >> 6, wm = w >> 1, wn = w & 1;
  const int r = lane & 31, h = lane >> 5;
  const int lr = tid >> 3, kc = (tid & 7) * 8;
  const bf16* ap = A + (size_t)lr * lda + kc;
  const bf16* bp = B + (size_t)(hf * 32 + lr) * ldb + kc;
  const size_t sa = (size_t)32 * lda, sb = (size_t)64 * ldb;
  u32x4 ra[4], rb[2];
#pragma unroll
  for (int i = 0; i < 4; ++i) ra[i] = ldg16(ap + i * sa);
#pragma unroll
  for (int i = 0; i < 2; ++i) rb[i] = ldg16(bp + i * sb);
#pragma unroll
  for (int i = 0; i < 4; ++i) *(u32x4*)(As + (lr + 32 * i) * LDT + kc) = ra[i];
#pragma unroll
  for (int i = 0; i < 2; ++i) *(u32x4*)(Bs + (lr + 32 * i) * LDT + kc) = rb[i];
  __syncthreads();
  const int nk = K / 64;
  for (int kt = 0; kt < nk; ++kt) {
    const int buf = kt & 1;
    const bool more = (kt + 1 < nk);
    if (more) {
      ap += 64; bp += 64;
#pragma unroll
      for (int i = 0; i < 4; ++i) ra[i] = ldg16(ap + i * sa);
#pragma unroll
      for (int i = 0; i < 2; ++i) rb[i] = ldg16(bp + i * sb);
    }
    SCHED_FENCE();
    const bf16* Ab = As + buf * 128 * LDT + (wm * 64 + r) * LDT + h * 8;
    const bf16* Bb = Bs + buf * 128 * LDT + (wn * 32 + r) * LDT + h * 8;
#pragma unroll
    for (int s = 0; s < 4; ++s) {
      s16x8 a0 = *(const s16x8*)(Ab + s * 16);
      s16x8 a1 = *(const s16x8*)(Ab + 32 * LDT + s * 16);
      s16x8 b0 = *(const s16x8*)(Bb + s * 16);
      acc[0] = MFMA32(a0, b0, acc[0]);
      acc[1] = MFMA32(a1, b0, acc[1]);
    }
    SCHED_FENCE();
    if (more) {
      bf16* Aw = As + (buf ^ 1) * 128 * LDT;
      bf16* Bw = Bs + (buf ^ 1) * 128 * LDT;
#pragma unroll
      for (int i = 0; i < 4; ++i) *(u32x4*)(Aw + (lr + 32 * i) * LDT + kc) = ra[i];
#pragma unroll
      for (int i = 0; i < 2; ++i) *(u32x4*)(Bw + (lr + 32 * i) * LDT + kc) = rb[i];
    }
    __syncthreads();
  }
}

DI void acc_zero(f32x16 (&acc)[2][2]) {
#pragma unroll
  for (int a = 0; a < 2; ++a)
#pragma unroll
    for (int b = 0; b < 2; ++b)
#pragma unroll
      for (int i = 0; i < 16; ++i) acc[a][b][i] = 0.f;
}

DI void acc_to_lds(const f32x16 (&acc)[2][2], float* Cs) {
  const int lane = TIDX & 63, w = TIDX >> 6, wm = w >> 1, wn = w & 1, r = lane & 31, h = lane >> 5;
#pragma unroll
  for (int tm = 0; tm < 2; ++tm)
#pragma unroll
    for (int tn = 0; tn < 2; ++tn)
#pragma unroll
      for (int i = 0; i < 16; ++i) Cs[(wm * 64 + tm * 32 + crow(i, h)) * CLD + wn * 64 + tn * 32 + r] = acc[tm][tn][i];
}

template <int HN>
DI void accw_to_lds(const f32x16 (&acc)[2][4], float* Cs) {
  const int lane = TIDX & 63, w = TIDX >> 6, wm = w >> 1, wn = w & 1, r = lane & 31, h = lane >> 5;
#pragma unroll
  for (int tm = 0; tm < 2; ++tm)
#pragma unroll
    for (int tn = 0; tn < 2; ++tn)
#pragma unroll
      for (int i = 0; i < 16; ++i) Cs[(wm * 64 + tm * 32 + crow(i, h)) * CLD + wn * 64 + tn * 32 + r] = acc[tm][HN * 2 + tn][i];
}

DI void store_tile_bf16(const float* Cs, bf16* dst, size_t ld, int mvalid, float scale) {
  for (int c = TIDX; c < 2048; c += 256) {
    const int row = c >> 4, cc = (c & 15) * 8;
    if (row < mvalid) {
      const float* s = Cs + row * CLD + cc;
      u32x4 v;
      v[0] = pack2(s[0] * scale, s[1] * scale);
      v[1] = pack2(s[2] * scale, s[3] * scale);
      v[2] = pack2(s[4] * scale, s[5] * scale);
      v[3] = pack2(s[6] * scale, s[7] * scale);
      *(u32x4*)(dst + (size_t)row * ld + cc) = v;
    }
  }
}

DI float* resid_row(const Params& p, int tok) {
  const int b = tok / TT, t = tok - b * TT;
  return (t < CTXL) ? (float*)(p.ws + OFF_XC) + ((size_t)b * CTXL + t) * DM : p.out + ((size_t)b * SEQ + (t - CTXL)) * DM;
}
DI const float* mod_vec(const Params& p, int l, int tok, int which) {
  const int b = tok / TT, t = tok - b * TT;
  const int m = (t < CTXL) ? 4 : b;
  return (const float*)(p.ws + OFF_MOD) + ((size_t)(l * 5 + m) * 6 + which) * DM;
}
DI float wave_sum(float v) {
#pragma unroll
  for (int o = 32; o >= 1; o >>= 1) v += __shfl_xor(v, o, 64);
  return v;
}
DI bf16* wl(const Params& p, int l, size_t off) { return (bf16*)(p.ws + OFF_W) + (size_t)l * WL_TOTAL + off; }

DI void prep_mod_job(const Params& p, int j, char* smem) {
  float* sc = (float*)smem;
  float* part = (float*)(smem + 20480);
  const int l = j / 24, nb = j % 24, tid = TIDX, lane = tid & 63, w = tid >> 6;
  for (int idx = tid; idx < 5120; idx += 256) {
    const int m = idx >> 10, k = idx & 1023;
    const float v = (m < 4) ? p.in[I_C][m * 1024 + k] : p.in[I_CCTX][k];
    sc[idx] = siluf_(v);
  }
  __syncthreads();
  const float* W = p.in[I_ADAW] + (size_t)l * 1024 * 6144 + nb * 256 + lane;
  float a[5][4];
#pragma unroll
  for (int m = 0; m < 5; ++m)
#pragma unroll
    for (int c = 0; c < 4; ++c) a[m][c] = 0.f;
#pragma unroll 4
  for (int kk = 0; kk < 256; ++kk) {
    const int k = w * 256 + kk;
    float wv[4];
#pragma unroll
    for (int c = 0; c < 4; ++c) wv[c] = W[(size_t)k * 6144 + 64 * c];
#pragma unroll
    for (int m = 0; m < 5; ++m) {
      const float sv = sc[m * 1024 + k];
#pragma unroll
      for (int c = 0; c < 4; ++c) a[m][c] += sv * wv[c];
    }
  }
#pragma unroll
  for (int m = 0; m < 5; ++m)
#pragma unroll
    for (int c = 0; c < 4; ++c) part[(w * 5 + m) * 256 + lane + 64 * c] = a[m][c];
  __syncthreads();
  const int n = nb * 256 + tid;
  const float bb = p.in[I_ADAB][l * 6144 + n];
  float* M = (float*)(p.ws + OFF_MOD) + (size_t)l * 5 * 6144 + n;
#pragma unroll
  for (int m = 0; m < 5; ++m)
    M[m * 6144] = part[(0 * 5 + m) * 256 + tid] + part[(1 * 5 + m) * 256 + tid] + part[(2 * 5 + m) * 256 + tid] + part[(3 * 5 + m) * 256 + tid] + bb;
  __syncthreads();
}

DI void prep_s5_job(const Params& p, int j) {
  const int idx = j * 256 + TIDX;
  const int ldg = idx >> 6, pp = idx & 63;
  const float dt = expf(p.in[I_LDT][ldg]);
  const float are = p.in[I_ARE][idx], aim = p.in[I_AIM][idx];
  const float mag = expf(are * dt);
  float sn, cs;
  sincos_cw(aim * dt, sn, cs);
  const float abr = mag * cs, abi = mag * sn;
  const float den = are * are + aim * aim;
  const float fre = ((abr - 1.f) * are + abi * aim) / den;
  const float fim = (abi * are - (abr - 1.f) * aim) / den;
  float* BBR = (float*)(p.ws + OFF_BBR);
  float* BBI = (float*)(p.ws + OFF_BBI);
  for (int hh = 0; hh < 16; ++hh) {
    const float br = p.in[I_BRE][(size_t)idx * 16 + hh], bi = p.in[I_BIM][(size_t)idx * 16 + hh];
    BBR[(size_t)idx * 16 + hh] = fre * br - fim * bi;
    BBI[(size_t)idx * 16 + hh] = fre * bi + fim * br;
  }
  float2* PW = (float2*)(p.ws + OFF_PWR);
  float pr = 1.f, pi = 0.f;
  for (int tau = 0; tau <= 32; ++tau) {
    PW[((size_t)ldg * 33 + tau) * 64 + pp] = make_float2(pr, pi);
    const float nr = pr * abr - pi * abi, ni = pr * abi + pi * abr;
    pr = nr; pi = ni;
  }
}

DI void prep_wt_job(const Params& p, int jj, char* smem) {
  float* tile = (float*)smem;
  const int l = jj / 4016;
  int r = jj % 4016;
  int mat = 0;
  const int cnt[8] = {1376, 64, 128, 64, 256, 1408, 704, 16};
#pragma unroll
  for (int m = 0; m < 8; ++m) {
    if (mat == m && r >= cnt[m]) { r -= cnt[m]; mat = m + 1; }
  }
  const float* src; int K, sld; size_t doff;
  switch (mat) {
    case 0: src = p.in[I_WIN] + (size_t)l * 1024 * DIN; K = 1024; sld = DIN; doff = WL_WIN; break;
    case 1: src = p.in[I_WBA] + (size_t)l * 256 * 1024; K = 256; sld = 1024; doff = WL_BRA; break;
    case 2: src = p.in[I_WBG] + (size_t)l * 512 * 1024; K = 512; sld = 1024; doff = WL_BRG; break;
    case 3: src = p.in[I_WBS] + (size_t)l * 256 * 1024; K = 256; sld = 1024; doff = WL_BRS; break;
    case 4: src = p.in[I_WOUT] + (size_t)l * 1024 * 1024; K = 1024; sld = 1024; doff = WL_WOUT; break;
    case 5: src = p.in[I_UP] + (size_t)l * 1024 * 5632; K = 1024; sld = 5632; doff = WL_UP; break;
    case 6: src = p.in[I_DOWN] + (size_t)l * 2816 * 1024; K = 2816; sld = 1024; doff = WL_DOWN; break;
    default: src = p.in[I_GLUW] + (size_t)l * 256 * 256; K = 256; sld = 256; doff = WL_GLU; break;
  }
  const int kt = K / 64;
  const int n0 = (r / kt) * 64, k0 = (r % kt) * 64;
  const int tid = TIDX;
  {
    const int nn = tid & 63;
    const int np = n0 + nn;
    int col;
    if (mat == 0) {
      if (np < 2048) col = np;
      else if (np < 2304) col = 2080 + (np - 2048);
      else if (np < 2336) col = 2048 + (np - 2304);
      else if (np < 2432) col = -1;
      else col = 2336 + (np - 2432);
    } else if (mat == 5) {
      const int jb = np >> 7, c = np & 127;
      col = (c < 64) ? (jb * 64 + c) : (DFF + jb * 64 + (c - 64));
    } else col = np;
#pragma unroll 4
    for (int kk = tid >> 6; kk < 64; kk += 4) tile[kk * 65 + nn] = (col >= 0) ? src[(size_t)(k0 + kk) * sld + col] : 0.f;
  }
  __syncthreads();
  {
    const int nn = tid >> 2, kq = (tid & 3) * 16;
    bf16* d = wl(p, l, doff) + (size_t)(n0 + nn) * K + k0 + kq;
    u32x4 v0, v1;
#pragma unroll
    for (int e = 0; e < 4; ++e) {
      v0[e] = pack2(tile[(kq + 2 * e) * 65 + nn], tile[(kq + 2 * e + 1) * 65 + nn]);
      v1[e] = pack2(tile[(kq + 8 + 2 * e) * 65 + nn], tile[(kq + 8 + 2 * e + 1) * 65 + nn]);
    }
    *(u32x4*)d = v0;
    *(u32x4*)(d + 8) = v1;
  }
  __syncthreads();
}

template <int MODE>
DI void row_job(const Params& p, int l, int tok) {
  const int lane = TIDX & 63;
  float x[16];
  float* xr = resid_row(p, tok);
  if (MODE == 0) {
    const int b = tok / TT, t = tok - b * TT;
    const float* src = (t < CTXL) ? p.in[I_CTX] + ((size_t)b * CTXL + t) * DM : p.in[I_X] + ((size_t)b * SEQ + (t - CTXL)) * DM;
#pragma unroll
    for (int i = 0; i < 4; ++i) {
      const f32x4 v = *(const f32x4*)(src + lane * 4 + 256 * i);
      x[4 * i] = v[0]; x[4 * i + 1] = v[1]; x[4 * i + 2] = v[2]; x[4 * i + 3] = v[3];
      *(f32x4*)(xr + lane * 4 + 256 * i) = v;
    }
  } else {
    const bf16* yr = (const bf16*)(p.ws + OFF_H) + (size_t)tok * DM;
    const float* gpost = p.in[MODE == 1 ? I_NMPOST : I_NFPOST] + l * DM;
    const float* mg = mod_vec(p, l, tok, MODE == 1 ? 2 : 5);
    float y[16];
    float ss = 0.f;
#pragma unroll
    for (int i = 0; i < 4; ++i) {
      const u32x2 u = *(const u32x2*)(yr + lane * 4 + 256 * i);
      y[4 * i] = bflo(u[0]); y[4 * i + 1] = bfhi(u[0]); y[4 * i + 2] = bflo(u[1]); y[4 * i + 3] = bfhi(u[1]);
#pragma unroll
      for (int e = 0; e < 4; ++e) ss += y[4 * i + e] * y[4 * i + e];
    }
    ss = wave_sum(ss);
    const float rstd = rsqrtf(ss * (1.f / DM) + EPSF);
#pragma unroll
    for (int i = 0; i < 4; ++i) {
      f32x4 v = *(const f32x4*)(xr + lane * 4 + 256 * i);
      const f32x4 g = *(const f32x4*)(gpost + lane * 4 + 256 * i);
      const f32x4 m = *(const f32x4*)(mg + lane * 4 + 256 * i);
#pragma unroll
      for (int e = 0; e < 4; ++e) { v[e] += m[e] * (y[4 * i + e] * rstd * g[e]); x[4 * i + e] = v[e]; }
      *(f32x4*)(xr + lane * 4 + 256 * i) = v;
    }
  }
  if (MODE == 2 && l == NL - 1) return;
  const int ln = (MODE == 2) ? l + 1 : l;
  const float* gpre = p.in[MODE == 1 ? I_NFPRE : I_NMPRE] + ln * DM;
  const float* sh = mod_vec(p, ln, tok, MODE == 1 ? 3 : 0);
  const float* scv = mod_vec(p, ln, tok, MODE == 1 ? 4 : 1);
  float ss = 0.f;
#pragma unroll
  for (int i = 0; i < 16; ++i) ss += x[i] * x[i];
  ss = wave_sum(ss);
  const float rstd = rsqrtf(ss * (1.f / DM) + EPSF);
  bf16* hr = (bf16*)(p.ws + OFF_H) + (size_t)tok * DM;
#pragma unroll
  for (int i = 0; i < 4; ++i) {
    const f32x4 g = *(const f32x4*)(gpre + lane * 4 + 256 * i);
    const f32x4 s1 = *(const f32x4*)(sh + lane * 4 + 256 * i);
    const f32x4 s2 = *(const f32x4*)(scv + lane * 4 + 256 * i);
    float o[4];
#pragma unroll
    for (int e = 0; e < 4; ++e) o[e] = (x[4 * i + e] * rstd * g[e]) * (1.f + s2[e]) + s1[e];
    u32x2 u;
    u[0] = pack2(o[0], o[1]); u[1] = pack2(o[2], o[3]);
    *(u32x2*)(hr + lane * 4 + 256 * i) = u;
  }
}

template <int MODE>
DI void row_phase(const Params& p, int l, int bid, int G) {
  const int lane = TIDX & 63;
  const int wg = bid * 4 + (TIDX >> 6), nw = G * 4;
  const int R = (NTOK + nw - 1) / nw;
  const int t0 = wg * R, t1 = min(NTOK, t0 + R);
  if (t0 >= t1) return;
  const bool has_next = !(MODE == 2 && l == NL - 1);
  const int ln = (MODE == 2) ? l + 1 : l;
  f32x4 gpost[4], gpre[4], mg[4], sh[4], scl[4];
#pragma unroll
  for (int i = 0; i < 4; ++i) {
    if (MODE != 0) gpost[i] = *(const f32x4*)(p.in[MODE == 1 ? I_NMPOST : I_NFPOST] + l * DM + lane * 4 + 256 * i);
    if (has_next) gpre[i] = *(const f32x4*)(p.in[MODE == 1 ? I_NFPRE : I_NMPRE] + ln * DM + lane * 4 + 256 * i);
  }
  int cur_m = -1;
  u32x2 yb[4], yn[4];
  f32x4 xb[4], xn[4];
  const bf16* Hb = (const bf16*)(p.ws + OFF_H);
#define ROW_LOAD(TOK, YY, XX)                                                                              \
  {                                                                                                        \
    const int b_ = (TOK) / TT, t_ = (TOK) - b_ * TT;                                                       \
    const float* src_ = (MODE == 0) ? ((t_ < CTXL) ? p.in[I_CTX] + ((size_t)b_ * CTXL + t_) * DM           \
                                                   : p.in[I_X] + ((size_t)b_ * SEQ + (t_ - CTXL)) * DM)    \
                                    : resid_row(p, (TOK));                                                 \
    _Pragma("unroll") for (int i = 0; i < 4; ++i) {                                                        \
      XX[i] = *(const f32x4*)(src_ + lane * 4 + 256 * i);                                                  \
      if (MODE != 0) YY[i] = *(const u32x2*)(Hb + (size_t)(TOK) * DM + lane * 4 + 256 * i);                \
    }                                                                                                      \
  }
  ROW_LOAD(t0, yb, xb)
  for (int tok = t0; tok < t1; ++tok) {
    if (tok + 1 < t1) ROW_LOAD(tok + 1, yn, xn)
    const int b = tok / TT, t = tok - b * TT;
    const int m = (t < CTXL) ? 4 : b;
    if (m != cur_m) {
      cur_m = m;
      const float* Mv = (const float*)(p.ws + OFF_MOD);
#pragma unroll
      for (int i = 0; i < 4; ++i) {
        if (MODE != 0) mg[i] = *(const f32x4*)(Mv + ((size_t)(l * 5 + m) * 6 + (MODE == 1 ? 2 : 5)) * DM + lane * 4 + 256 * i);
        if (has_next) {
          sh[i] = *(const f32x4*)(Mv + ((size_t)(ln * 5 + m) * 6 + (MODE == 1 ? 3 : 0)) * DM + lane * 4 + 256 * i);
          scl[i] = *(const f32x4*)(Mv + ((size_t)(ln * 5 + m) * 6 + (MODE == 1 ? 4 : 1)) * DM + lane * 4 + 256 * i);
        }
      }
    }
    float* xr = resid_row(p, tok);
    f32x4 x[4];
    if (MODE == 0) {
#pragma unroll
      for (int i = 0; i < 4; ++i) { x[i] = xb[i]; *(f32x4*)(xr + lane * 4 + 256 * i) = x[i]; }
    } else {
      float y[16];
      float ss = 0.f;
#pragma unroll
      for (int i = 0; i < 4; ++i) {
        y[4 * i] = bflo(yb[i][0]); y[4 * i + 1] = bfhi(yb[i][0]); y[4 * i + 2] = bflo(yb[i][1]); y[4 * i + 3] = bfhi(yb[i][1]);
#pragma unroll
        for (int e = 0; e < 4; ++e) ss += y[4 * i + e] * y[4 * i + e];
      }
      ss = wave_sum(ss);
      const float rstd = rsqrtf(ss * (1.f / DM) + EPSF);
#pragma unroll
      for (int i = 0; i < 4; ++i) {
        f32x4 v = xb[i];
#pragma unroll
        for (int e = 0; e < 4; ++e) v[e] += mg[i][e] * (y[4 * i + e] * rstd * gpost[i][e]);
        x[i] = v;
        *(f32x4*)(xr + lane * 4 + 256 * i) = v;
      }
    }
    if (has_next) {
      float ss = 0.f;
#pragma unroll
      for (int i = 0; i < 4; ++i)
#pragma unroll
        for (int e = 0; e < 4; ++e) ss += x[i][e] * x[i][e];
      ss = wave_sum(ss);
      const float rstd = rsqrtf(ss * (1.f / DM) + EPSF);
      bf16* hr = (bf16*)(p.ws + OFF_H) + (size_t)tok * DM;
#pragma unroll
      for (int i = 0; i < 4; ++i) {
        float o[4];
#pragma unroll
        for (int e = 0; e < 4; ++e) o[e] = (x[i][e] * rstd * gpre[i][e]) * (1.f + scl[i][e]) + sh[i][e];
        u32x2 u;
        u[0] = pack2(o[0], o[1]); u[1] = pack2(o[2], o[3]);
        *(u32x2*)(hr + lane * 4 + 256 * i) = u;
      }
    }
#pragma unroll
    for (int i = 0; i < 4; ++i) { yb[i] = yn[i]; xb[i] = xn[i]; }
  }
#undef ROW_LOAD
}

DI void ktab_phase(const Params& p, int bid, int G, int l_lo, int l_hi) {
  const float* BBR = (const float*)(p.ws + OFF_BBR);
  const float* BBI = (const float*)(p.ws + OFF_BBI);
  const float2* PW = (const float2*)(p.ws + OFF_PWR);
  float* KT = (float*)(p.ws + OFF_KTAB);
  const int per_layer = 16 * 2 * 32 * 256;
  for (int idx = l_lo * per_layer + bid * 256 + TIDX; idx < l_hi * per_layer; idx += G * 256) {
    const int hp = idx & 15, hh = (idx >> 4) & 15, tau = (idx >> 8) & 31, d = (idx >> 13) & 1, g = (idx >> 14) & 15, l = idx >> 18;
    const int ldg = (l * 2 + d) * 16 + g;
    const float* cre = p.in[I_CRE] + ((size_t)ldg * 16 + hh) * 64;
    const float* cim = p.in[I_CIM] + ((size_t)ldg * 16 + hh) * 64;
    float acc = 0.f;
    for (int pp = 0; pp < 64; ++pp) {
      const float2 pw = PW[((size_t)ldg * 33 + tau) * 64 + pp];
      const float br = BBR[((size_t)ldg * 64 + pp) * 16 + hp], bi = BBI[((size_t)ldg * 64 + pp) * 16 + hp];
      const float zr = pw.x * br - pw.y * bi, zi = pw.x * bi + pw.y * br;
      acc += cre[pp] * zr - cim[pp] * zi;
    }
    KT[idx] = acc;
  }
}

DI void s5mat_phase(const Params& p, int l, int bid, int G) {
  const float* BBR = (const float*)(p.ws + OFF_BBR);
  const float* BBI = (const float*)(p.ws + OFF_BBI);
  const float2* PW = (const float2*)(p.ws + OFF_PWR);
  const float* KT = (const float*)(p.ws + OFF_KTAB);
  bf16* T5 = (bf16*)(p.ws + OFF_T5);
  bf16* E5 = (bf16*)(p.ws + OFF_E5);
  bf16* F5 = (bf16*)(p.ws + OFF_F5);
  const int nT = 16 * 512 * 64, nE = 16 * 512 * 32, nF = 16 * 256 * 64;
  for (int it = bid * 256 + TIDX; it < nT + nE + nF; it += G * 256) {
    float v[8];
    bf16* dst;
    if (it < nT) {
      const int k8 = it & 63, n = (it >> 6) & 511, g = it >> 15;
      const int i = n >> 4, hh = n & 15, j = k8 >> 1, hp0 = (k8 & 1) * 8;
#pragma unroll
      for (int e = 0; e < 8; ++e) {
        const int hp = hp0 + e;
        float a = 0.f;
        if (j <= i) a += KT[((((size_t)l * 16 + g) * 2 + 0) * 32 + (i - j)) * 256 + hh * 16 + hp];
        if (j >= i) a += KT[((((size_t)l * 16 + g) * 2 + 1) * 32 + (j - i)) * 256 + hh * 16 + hp];
        if (i == j && hh == hp) a += p.in[I_S5D][l * 256 + g * 16 + hh];
        v[e] = a;
      }
      dst = T5 + ((size_t)g * 512 + n) * 512 + k8 * 8;
    } else if (it < nT + nE) {
      const int q = it - nT;
      const int k8 = q & 31, n = (q >> 5) & 511, g = q >> 14;
      const int i = n >> 4, hh = n & 15;
      const int k0 = k8 * 8, d = k0 >> 7, ri = (k0 >> 6) & 1, p0 = k0 & 63;
      const int ldg = (l * 2 + d) * 16 + g;
      const int ex = d ? (32 - i) : (i + 1);
#pragma unroll
      for (int e = 0; e < 8; ++e) {
        const int pp = p0 + e;
        const float2 pw = PW[((size_t)ldg * 33 + ex) * 64 + pp];
        const float cr = p.in[I_CRE][((size_t)ldg * 16 + hh) * 64 + pp], ci = p.in[I_CIM][((size_t)ldg * 16 + hh) * 64 + pp];
        const float zr = cr * pw.x - ci * pw.y, zi = cr * pw.y + ci * pw.x;
        v[e] = ri ? -zi : zr;
      }
      dst = E5 + ((size_t)g * 512 + n) * 256 + k0;
    } else {
      const int q = it - nT - nE;
      const int k8 = q & 63, n = (q >> 6) & 255, g = q >> 14;
      const int d = n >> 7, ri = (n >> 6) & 1, pp = n & 63;
      const int j = k8 >> 1, hp0 = (k8 & 1) * 8;
      const int ldg = (l * 2 + d) * 16 + g;
      const int ex = d ? j : (31 - j);
      const float2 pw = PW[((size_t)ldg * 33 + ex) * 64 + pp];
#pragma unroll
      for (int e = 0; e < 8; ++e) {
        const float br = BBR[((size_t)ldg * 64 + pp) * 16 + hp0 + e], bi = BBI[((size_t)ldg * 64 + pp) * 16 + hp0 + e];
        v[e] = ri ? (pw.x * bi + pw.y * br) : (pw.x * br - pw.y * bi);
      }
      dst = F5 + ((size_t)g * 256 + n) * 512 + k8 * 8;
    }
    u32x4 u;
    u[0] = pack2(v[0], v[1]); u[1] = pack2(v[2], v[3]); u[2] = pack2(v[4], v[5]); u[3] = pack2(v[6], v[7]);
    *(u32x4*)dst = u;
  }
}

DI void proj_epi(const Params& p, int l, int mt, int nt, char* smem);
DI void proj_wide(const Params& p, int l, int mt, int np, char* smem) {
  const bf16* H = (const bf16*)(p.ws + OFF_H) + (size_t)mt * 128 * DM;
  const bf16* W = wl(p, l, WL_WIN) + (size_t)np * 256 * DM;
  if (np == 9) {
    f32x16 acc1[2][2];
    acc_zero(acc1);
    gemm_main_dma(acc1, [&](int r) { return H + (size_t)r * DM; }, [&](int r) { return W + (size_t)r * DM; }, DM, smem);
    acc_to_lds(acc1, (float*)smem);
    __syncthreads();
    proj_epi(p, l, mt, 18, smem);
    return;
  }
  f32x16 acc[2][4];
  accw_zero(acc);
  gemm_wide(acc, [&](int r) { return H + (size_t)r * DM; }, [&](int r) { return W + (size_t)r * DM; }, DM, smem);
  float* Cs = (float*)smem;
  accw_to_lds<0>(acc, Cs);
  __syncthreads();
  proj_epi(p, l, mt, np * 2, smem);
  if (np * 2 + 1 < 19) {
    accw_to_lds<1>(acc, Cs);
    __syncthreads();
    proj_epi(p, l, mt, np * 2 + 1, smem);
  }
}
DI void proj_epi(const Params& p, int l, int mt, int nt, char* smem) {
  float* Cs = (float*)smem;
  const int tid = TIDX;
  const int tok0 = mt * 128;
  const int b = tok0 / TT, t0 = tok0 - b * TT;
  if (nt <= 2) {
    const int row = tid >> 1, seg = tid & 1;
    float* c = Cs + row * CLD + seg * 64;
    const float* gn = p.in[nt < 2 ? I_QN : I_KN] + l * 64;
    float ss = 0.f;
#pragma unroll 8
    for (int i = 0; i < 64; ++i) ss += c[i] * c[i];
    const float rstd = rsqrtf(ss * (1.f / 64.f) + EPSF);
    const int t = t0 + row;
    const bool lat = t >= CTXL;
    const int s = t - CTXL;
#pragma unroll 1
    for (int ax = 0; ax < 2; ++ax) {
      const float pos = (float)(ax ? (s & 63) : (s >> 6));
#pragma unroll 2
      for (int f = 0; f < 16; ++f) {
        float x1 = c[ax * 32 + f] * rstd * gn[ax * 32 + f];
        float x2 = c[ax * 32 + 16 + f] * rstd * gn[ax * 32 + 16 + f];
        if (lat) {
          const float invf = exp2f(-(float)f * (13.287712379549449f / 16.f));
          float sn, cs;
          sincos_cw(pos * invf, sn, cs);
          const float y1 = x1 * cs - x2 * sn, y2 = x2 * cs + x1 * sn;
          x1 = y1; x2 = y2;
        }
        c[ax * 32 + f] = x1;
        c[ax * 32 + 16 + f] = x2;
      }
    }
    __syncthreads();
    if (nt < 2) store_tile_bf16(Cs, (bf16*)(p.ws + OFF_Q) + (size_t)tok0 * 256 + nt * 128, 256, 128, 0.125f * 1.4426950408889634f);
    else store_tile_bf16(Cs, (bf16*)(p.ws + OFF_K) + (size_t)tok0 * 128, 128, 128, 1.f);
  } else if (nt == 3 || (nt >= 8 && nt <= 11)) {
    for (int c = tid; c < 2048; c += 256) {
      const int col = c & 127, rc = (c >> 7) * 8;
      u32x4 u;
#pragma unroll
      for (int e = 0; e < 4; ++e) u[e] = pack2(Cs[(rc + 2 * e) * CLD + col], Cs[(rc + 2 * e + 1) * CLD + col]);
      bf16* dst;
      if (nt == 3) dst = (bf16*)(p.ws + OFF_VT) + ((size_t)(b * 2 + (col >> 6)) * 64 + (col & 63)) * TT + t0 + rc;
      else dst = (bf16*)(p.ws + OFF_GVT) + ((size_t)(b * 4 + (nt - 8)) * 128 + col) * TT + t0 + rc;
      *(u32x4*)dst = u;
    }
  } else if (nt == 4 || nt == 5) {
    store_tile_bf16(Cs, (bf16*)(p.ws + OFF_GQ) + (size_t)tok0 * 256 + (nt - 4) * 128, 256, 128, 0.125f);
  } else if (nt == 6 || nt == 7) {
    store_tile_bf16(Cs, (bf16*)(p.ws + OFF_GK) + (size_t)tok0 * 256 + (nt - 6) * 128, 256, 128, 1.f);
  } else if (nt >= 12 && nt <= 15) {
    store_tile_bf16(Cs, (bf16*)(p.ws + OFF_GR) + (size_t)tok0 * 512 + (nt - 12) * 128, 512, 128, 1.f);
  } else if (nt == 16 || nt == 17) {
    for (int c = tid; c < 2048; c += 256) {
      const int row = c >> 4, c8 = c & 15;
      const float* s = Cs + row * CLD + c8 * 8;
      u32x4 u;
#pragma unroll
      for (int e = 0; e < 4; ++e) u[e] = pack2(s[2 * e], s[2 * e + 1]);
      const int ch = (nt - 16) * 128 + c8 * 8;
      bf16* dst = (bf16*)(p.ws + OFF_SU) + ((size_t)(b * 16 + (ch >> 4)) * TT + t0 + row) * 16 + (ch & 15);
      *(u32x4*)dst = u;
    }
  } else {
    for (int c = tid; c < 128 * 8; c += 256) {
      const int row = c >> 3, c4 = (c & 7) * 4;
      const float* s = Cs + row * CLD + c4;
      f32x4 v = {s[0], s[1], s[2], s[3]};
      *(f32x4*)((float*)(p.ws + OFF_LOW) + (size_t)(tok0 + row) * 32 + c4) = v;
    }
  }
  __syncthreads();
}

DI void attn_unit(const Params& p, int u, char* smem) {
  int b, head, tok0, nkt;
  if (u < 1024) { b = u >> 8; head = (u >> 6) & 3; tok0 = b * TT + CTXL + (u & 63) * 128; nkt = TT / 128; }
  else { const int v = u - 1024; b = v >> 3; head = (v >> 1) & 3; tok0 = b * TT + (v & 1) * 128; nkt = CTXL / 128; }
  const int kvh = head >> 1;
  const int tid = TIDX, lane = tid & 63, w = tid >> 6, r = lane & 31, h = lane >> 5;
  const bf16* Qp = (const bf16*)(p.ws + OFF_Q) + (size_t)(tok0 + w * 32 + r) * 256 + head * 64 + h * 8;
  s16x8 qf[4];
#pragma unroll
  for (int s = 0; s < 4; ++s) qf[s] = __builtin_bit_cast(s16x8, ldg16(Qp + s * 16));
  const bf16* kp[2];
  const bf16* vp[2];
#pragma unroll
  for (int i = 0; i < 2; ++i) {
    const int row = w * 16 + i * 8 + (lane >> 3);
    const int c = (lane & 7) ^ ((row >> 1) & 7);
    kp[i] = (const bf16*)(p.ws + OFF_K) + ((size_t)b * TT + row) * 128 + kvh * 64 + c * 8;
    vp[i] = (const bf16*)(p.ws + OFF_VT) + ((size_t)(b * 2 + kvh) * 64 + row) * TT + c * 8;
  }
  const int ldst = (w * 128 + lane) * 16;
#define AT_DMA(BUF, T)                                                                                              \
  {                                                                                                                 \
    char* sb_ = smem + (BUF) * 32768;                                                                               \
    _Pragma("unroll") for (int hh = 0; hh < 2; ++hh)                                                                \
    _Pragma("unroll") for (int i = 0; i < 2; ++i) {                                                                 \
      __builtin_amdgcn_global_load_lds((const unsigned*)(kp[i] + (size_t)((T) * 128 + hh * 64) * 128), (unsigned*)(sb_ + hh * 8192 + ldst + i * 1024), 16, 0, 0); \
      __builtin_amdgcn_global_load_lds((const unsigned*)(vp[i] + (T) * 128 + hh * 64), (unsigned*)(sb_ + 16384 + hh * 8192 + ldst + i * 1024), 16, 0, 0);        \
    }                                                                                                               \
  }
  const int xr = (r >> 1) & 7;
  AT_DMA(0, 0)
  asm volatile("s_waitcnt vmcnt(0)" ::: "memory");
  __syncthreads();
  f32x16 oacc[2];
#pragma unroll
  for (int i = 0; i < 16; ++i) { oacc[0][i] = 0.f; oacc[1][i] = 0.f; }
  float mrow = -INFINITY, lrow = 0.f;
  for (int kt = 0; kt < nkt; ++kt) {
    const int buf = kt & 1;
    if (kt + 1 < nkt) AT_DMA(buf ^ 1, kt + 1)
    const char* Kb = smem + buf * 32768;
    const char* Vb = Kb + 16384;
    f32x16 sacc[4];
#pragma unroll
    for (int q = 0; q < 4; ++q)
#pragma unroll
      for (int i = 0; i < 16; ++i) sacc[q][i] = 0.f;
#pragma unroll
    for (int s = 0; s < 4; ++s) {
      const int co = ((2 * s + h) ^ xr) * 16;
#pragma unroll
      for (int q = 0; q < 4; ++q) {
        const s16x8 a = *(const s16x8*)(Kb + (q >> 1) * 8192 + ((q & 1) * 32 + r) * 128 + co);
        sacc[q] = MFMA32(a, qf[s], sacc[q]);
      }
    }
    float mx = sacc[0][0];
#pragma unroll
    for (int q = 0; q < 4; ++q)
#pragma unroll
      for (int i = 0; i < 16; ++i) mx = fmaxf(mx, sacc[q][i]);
    mx = fmaxf(mx, __shfl_xor(mx, 32, 64));
    const float mnew = fmaxf(mrow, mx);
    const float alpha = __builtin_amdgcn_exp2f(mrow - mnew);
    mrow = mnew;
    float psum = 0.f;
#pragma unroll
    for (int q = 0; q < 4; ++q)
#pragma unroll
      for (int i = 0; i < 16; ++i) { sacc[q][i] = __builtin_amdgcn_exp2f(sacc[q][i] - mnew); psum += sacc[q][i]; }
    lrow = lrow * alpha + psum;
#pragma unroll
    for (int i = 0; i < 16; ++i) { oacc[0][i] *= alpha; oacc[1][i] *= alpha; }
#pragma unroll
    for (int q = 0; q < 4; ++q)
#pragma unroll
      for (int s2 = 0; s2 < 2; ++s2) {
        u32x4 pu;
#pragma unroll
        for (int e = 0; e < 4; ++e) pu[e] = pack2(sacc[q][8 * s2 + 2 * e], sacc[q][8 * s2 + 2 * e + 1]);
        const s16x8 pf = __builtin_bit_cast(s16x8, pu);
        const int c0 = (q & 1) * 4 + 2 * s2;
        const int o0 = ((c0 ^ xr) * 16) + 8 * h, o1 = (((c0 + 1) ^ xr) * 16) + 8 * h;
#pragma unroll
        for (int dt = 0; dt < 2; ++dt) {
          const s16x4 lo = *(const s16x4*)(Vb + (q >> 1) * 8192 + (dt * 32 + r) * 128 + o0);
          const s16x4 hi = *(const s16x4*)(Vb + (q >> 1) * 8192 + (dt * 32 + r) * 128 + o1);
          const s16x8 a = __builtin_shufflevector(lo, hi, 0, 1, 2, 3, 4, 5, 6, 7);
          oacc[dt] = MFMA32(a, pf, oacc[dt]);
        }
      }
    asm volatile("s_waitcnt vmcnt(0)" ::: "memory");
    __syncthreads();
  }
#undef AT_DMA
  const float ltot = lrow + __shfl_xor(lrow, 32, 64);
  const float inv = 1.f / ltot;
  bf16* Op = (bf16*)(p.ws + OFF_OATT) + (size_t)(tok0 + w * 32 + r) * 256 + head * 64;
#pragma unroll
  for (int dt = 0; dt < 2; ++dt)
#pragma unroll
    for (int i = 0; i < 16; i += 4) {
      u32x2 uu;
      uu[0] = pack2(oacc[dt][i] * inv, oacc[dt][i + 1] * inv);
      uu[1] = pack2(oacc[dt][i + 2] * inv, oacc[dt][i + 3] * inv);
      *(u32x2*)(Op + dt * 32 + crow(i, h)) = uu;
    }
}

constexpr int GL_LOW = 0, GL_TOT = 4096, GL_DEC = 5120, GL_QIN = 5376, GL_KIN = 14592, GL_KET = 23808, GL_OST = 0,
              GL_VT = 33792, GL_ST = 52224;
static_assert(GL_ST + 128 * LDT * 2 <= SMEM_BYTES, "gla lds");

template <bool WITH_OUT>
DI void gla_unit(const Params& p, int l, int u, char* smem) {
  float* lowt = (float*)(smem + GL_LOW);
  float* tots = (float*)(smem + GL_TOT);
  float* decs = (float*)(smem + GL_DEC);
  bf16* qin = (bf16*)(smem + GL_QIN);
  bf16* kin = (bf16*)(smem + GL_KIN);
  bf16* ket = (bf16*)(smem + GL_KET);
  float* ost = (float*)(smem + GL_OST);
  bf16* vts = (bf16*)(smem + GL_VT);
  bf16* sts = (bf16*)(smem + GL_ST);
  const int tid = TIDX, lane = tid & 63, w = tid >> 6, r = lane & 31, h = lane >> 5;
  int b, hd, gi, dir0, ndir;
  if (WITH_OUT) { gi = u % NG33; hd = (u / NG33) & 3; b = u / (NG33 * 4); dir0 = 1; ndir = 2; }
  else { gi = u % NG33; const int v = u / NG33; dir0 = v & 1; hd = (v >> 1) & 3; b = v >> 3; ndir = 1; }
  const int dk = tid & 63, part = tid >> 6;
  const bf16* GQ = (const bf16*)(p.ws + OFF_GQ);
  const bf16* GK = (const bf16*)(p.ws + OFF_GK);
  const bf16* GVT = (const bf16*)(p.ws + OFF_GVT) + (size_t)(b * 4 + hd) * 128 * TT;
  const float* LOW = (const float*)(p.ws + OFF_LOW);
  for (int dd = 0; dd < ndir; ++dd) {
    const int dir = WITH_OUT ? (dir0 - dd) : dir0;
    float* GSu = (float*)(p.ws + OFF_GS) + ((size_t)((b * 4 + hd) * 2 + dir) * NG33 + gi) * 8192;
    float gwreg[16];
#pragma unroll
    for (int rr = 0; rr < 16; ++rr) gwreg[rr] = p.in[I_GGW][((size_t)(l * 2 + dir) * 16 + rr) * 256 + hd * 64 + dk];
    const float gb = p.in[I_GGB][(l * 2 + dir) * 256 + hd * 64 + dk];
    f32x16 sacc[2];
    if (WITH_OUT) {
#pragma unroll
      for (int dkt = 0; dkt < 2; ++dkt)
#pragma unroll
        for (int i = 0; i < 16; ++i) {
          const float v = GSu[(w * 32 + crow(i, h)) * 64 + dkt * 32 + r];
          sacc[dkt][i] = v;
          sts[(w * 32 + crow(i, h)) * LDT + dkt * 32 + r] = f2bf(v);
        }
    } else {
#pragma unroll
      for (int i = 0; i < 16; ++i) { sacc[0][i] = 0.f; sacc[1][i] = 0.f; }
    }
    float gtot = 0.f;
    for (int cc = 0; cc < 4; ++cc) {
      const int ci = dir ? 3 - cc : cc;
      const int tb = gi * 256 + ci * 64;
      const size_t tokb = (size_t)b * TT + tb;
      {
        const int row = tid >> 2, c4 = (tid & 3) * 4;
        const u32x4 lw = ldg16(LOW + (tokb + row) * 32 + dir * 16 + c4);
        u32x4 vv[4], kq[2], qq[2];
#pragma unroll
        for (int i = 0; i < 4; ++i) {
          const int c = tid + 256 * i, e = c >> 3, k8 = (c & 7) * 8;
          vv[i] = ldg16(GVT + (size_t)e * TT + tb + k8);
        }
#pragma unroll
        for (int i = 0; i < 2; ++i) {
          const int c = tid + 256 * i, rw = c >> 3, k8 = (c & 7) * 8;
          kq[i] = ldg16(GK + (tokb + rw) * 256 + hd * 64 + k8);
          if (WITH_OUT) qq[i] = ldg16(GQ + (tokb + rw) * 256 + hd * 64 + k8);
        }
        *(u32x4*)(lowt + row * 16 + c4) = lw;
#pragma unroll
        for (int i = 0; i < 4; ++i) {
          const int c = tid + 256 * i, e = c >> 3, k8 = (c & 7) * 8;
          *(u32x4*)(vts + e * LDT + k8) = vv[i];
        }
#pragma unroll
        for (int i = 0; i < 2; ++i) {
          const int c = tid + 256 * i, rw = c >> 3, k8 = (c & 7) * 8;
          *(u32x4*)(kin + rw * LDT + k8) = kq[i];
          if (WITH_OUT) *(u32x4*)(qin + rw * LDT + k8) = qq[i];
        }
      }
      __syncthreads();
      float cum = 0.f;
#pragma unroll 2
      for (int ii = 0; ii < 16; ++ii) {
        const int pos = part * 16 + ii, t = dir ? 63 - pos : pos;
        float z = gb;
#pragma unroll
        for (int rr = 0; rr < 16; ++rr) z += lowt[t * 16 + rr] * gwreg[rr];
        cum += (fminf(z, 0.f) - log1pf(__expf(-fabsf(z)))) * (1.f / 16.f);
      }
      tots[part * 64 + dk] = cum;
      __syncthreads();
      float offs = 0.f, total = 0.f;
#pragma unroll
      for (int pp = 0; pp < 4; ++pp) { const float tv = tots[pp * 64 + dk]; total += tv; if (pp < part) offs += tv; }
      if (part == 0) decs[dk] = __expf(total);
      gtot += total;
      float bq = offs;
#pragma unroll 2
      for (int ii = 0; ii < 16; ++ii) {
        const int pos = part * 16 + ii, t = dir ? 63 - pos : pos;
        float z = gb;
#pragma unroll
        for (int rr = 0; rr < 16; ++rr) z += lowt[t * 16 + rr] * gwreg[rr];
        bq += (fminf(z, 0.f) - log1pf(__expf(-fabsf(z)))) * (1.f / 16.f);
        const float kv = bf2f(kin[t * LDT + dk]);
        ket[dk * LDT + t] = f2bf(kv * __expf(total - bq));
        if (WITH_OUT) {
          const float qv = bf2f(qin[t * LDT + dk]);
          qin[t * LDT + dk] = f2bf(qv * __expf(bq));
          kin[t * LDT + dk] = f2bf(kv * __expf(-bq));
        }
      }
      __syncthreads();
      f32x16 oo[2];
      const int it = w & 1, ep = w >> 1;
      if (WITH_OUT) {
        const int ti = w >> 1, tj = w & 1;
        f32x16 aa;
#pragma unroll
        for (int i = 0; i < 16; ++i) aa[i] = 0.f;
#pragma unroll
        for (int s = 0; s < 4; ++s) {
          const s16x8 A = *(const s16x8*)(qin + (ti * 32 + r) * LDT + s * 16 + h * 8);
          const s16x8 Bv = *(const s16x8*)(kin + (tj * 32 + r) * LDT + s * 16 + h * 8);
          aa = MFMA32(A, Bv, aa);
        }
        __syncthreads();
#pragma unroll
        for (int i = 0; i < 16; ++i) {
          const int qi = ti * 32 + crow(i, h), kj = tj * 32 + r;
          const bool keep = dir ? (kj >= qi) : (kj <= qi);
          kin[qi * LDT + kj] = f2bf(keep ? aa[i] : 0.f);
        }
        __syncthreads();
#pragma unroll
        for (int i = 0; i < 16; ++i) { oo[0][i] = 0.f; oo[1][i] = 0.f; }
#pragma unroll
        for (int s = 0; s < 4; ++s) {
          const s16x8 A1 = *(const s16x8*)(kin + (it * 32 + r) * LDT + s * 16 + h * 8);
          const s16x8 A2 = *(const s16x8*)(qin + (it * 32 + r) * LDT + s * 16 + h * 8);
#pragma unroll
          for (int x = 0; x < 2; ++x) {
            const int et = 2 * ep + x;
            const s16x8 B1 = *(const s16x8*)(vts + (et * 32 + r) * LDT + s * 16 + h * 8);
            const s16x8 B2 = *(const s16x8*)(sts + (et * 32 + r) * LDT + s * 16 + h * 8);
            oo[x] = MFMA32(A1, B1, oo[x]);
            oo[x] = MFMA32(A2, B2, oo[x]);
          }
        }
      }
#pragma unroll
      for (int dkt = 0; dkt < 2; ++dkt) {
        const float dv = decs[dkt * 32 + r];
#pragma unroll
        for (int i = 0; i < 16; ++i) sacc[dkt][i] *= dv;
      }
#pragma unroll
      for (int s = 0; s < 4; ++s) {
        const s16x8 A = *(const s16x8*)(vts + (w * 32 + r) * LDT + s * 16 + h * 8);
#pragma unroll
        for (int dkt = 0; dkt < 2; ++dkt) {
          const s16x8 Bv = *(const s16x8*)(ket + (dkt * 32 + r) * LDT + s * 16 + h * 8);
          sacc[dkt] = MFMA32(A, Bv, sacc[dkt]);
        }
      }
      __syncthreads();
      if (WITH_OUT) {
#pragma unroll
        for (int dkt = 0; dkt < 2; ++dkt)
#pragma unroll
          for (int i = 0; i < 16; ++i) sts[(w * 32 + crow(i, h)) * LDT + dkt * 32 + r] = f2bf(sacc[dkt][i]);
#pragma unroll
        for (int x = 0; x < 2; ++x)
#pragma unroll
          for (int i = 0; i < 16; ++i) ost[(it * 32 + crow(i, h)) * CLD + (2 * ep + x) * 32 + r] = oo[x][i];
        __syncthreads();
        const int row = tid >> 2, qd = tid & 3;
        const size_t tok = tokb + row;
        bf16* og = (bf16*)(p.ws + OFF_OGLA) + tok * 512 + hd * 128 + qd * 32;
        const float* os = ost + row * CLD + qd * 32;
        if (dir == 1) {
#pragma unroll
          for (int i = 0; i < 4; ++i) {
            u32x4 uu;
#pragma unroll
            for (int e = 0; e < 4; ++e) uu[e] = pack2(os[i * 8 + 2 * e], os[i * 8 + 2 * e + 1]);
            *(u32x4*)(og + i * 8) = uu;
          }
        } else {
          float ss = 0.f;
#pragma unroll 1
          for (int i = 0; i < 4; ++i) {
            const u32x4 uu = *(const u32x4*)(og + i * 8);
#pragma unroll
            for (int e = 0; e < 4; ++e) {
              const float a0 = os[i * 8 + 2 * e] + bflo(uu[e]), a1 = os[i * 8 + 2 * e + 1] + bfhi(uu[e]);
              ss += a0 * a0 + a1 * a1;
            }
          }
          ss += __shfl_xor(ss, 1, 64);
          ss += __shfl_xor(ss, 2, 64);
          const float rstd = rsqrtf(ss * (1.f / 128.f) + EPSF);
          const float* gn = p.in[I_GON] + l * 128 + qd * 32;
          const bf16* gr = (const bf16*)(p.ws + OFF_GR) + tok * 512 + hd * 128 + qd * 32;
#pragma unroll 1
          for (int i = 0; i < 4; ++i) {
            const u32x4 uo = *(const u32x4*)(og + i * 8);
            const u32x4 ug = *(const u32x4*)(gr + i * 8);
            u32x4 uu;
#pragma unroll
            for (int e = 0; e < 4; ++e) {
              const float v0 = os[i * 8 + 2 * e] + bflo(uo[e]), v1 = os[i * 8 + 2 * e + 1] + bfhi(uo[e]);
              const float a0 = v0 * rstd * gn[i * 8 + 2 * e] * siluf_(bflo(ug[e]));
              const float a1 = v1 * rstd * gn[i * 8 + 2 * e + 1] * siluf_(bfhi(ug[e]));
              uu[e] = pack2(a0, a1);
            }
            *(u32x4*)(og + i * 8) = uu;
          }
        }
        __syncthreads();
      }
    }
    if (!WITH_OUT) {
#pragma unroll
      for (int dkt = 0; dkt < 2; ++dkt)
#pragma unroll
        for (int i = 0; i < 16; ++i) GSu[(w * 32 + crow(i, h)) * 64 + dkt * 32 + r] = sacc[dkt][i];
      if (part == 0) ((float*)(p.ws + OFF_DECG))[((size_t)((b * 4 + hd) * 2 + dir) * NG33 + gi) * 64 + dk] = __expf(gtot);
    }
    __syncthreads();
  }
}

DI void gla_scan_job(const Params& p, int j) {
  const int idx = j * 256 + TIDX;
  const int seq = idx >> 13, el = idx & 8191, dk = el & 63, dir = seq & 1;
  float* GS = (float*)(p.ws + OFF_GS) + (size_t)seq * NG33 * 8192 + el;
  const float* DG = (const float*)(p.ws + OFF_DECG) + (size_t)seq * NG33 * 64 + dk;
  float s = 0.f;
  for (int st0 = 0; st0 < 33; st0 += 11) {
    float kv[11], dc[11];
#pragma unroll
    for (int q = 0; q < 11; ++q) {
      const int st = st0 + q;
      const int g = (dir == 0 || st == 0) ? st : 33 - st;
      kv[q] = GS[(size_t)g * 8192];
      dc[q] = DG[g * 64];
    }
#pragma unroll
    for (int q = 0; q < 11; ++q) {
      const int st = st0 + q;
      const int g = (dir == 0 || st == 0) ? st : 33 - st;
      GS[(size_t)g * 8192] = s;
      s = dc[q] * s + kv[q];
    }
  }
}

DI void s5_end_tile(const Params& p, int j, char* smem) {
  const int nt = j & 1, mt = (j >> 1) % 9, g = j / 18;
  const bf16* SU = (const bf16*)(p.ws + OFF_SU);
  const bf16* F = (const bf16*)(p.ws + OFF_F5) + ((size_t)g * 256 + nt * 128) * 512;
  f32x16 acc[2][2];
  acc_zero(acc);
  gemm_main_dma(acc,
            [&](int r) -> const bf16* {
              const int m = mt * 128 + r;
              if (m >= MS5) return (const bf16*)(p.ws + OFF_ZERO);
              const int b = m / NCH, ch = m - b * NCH;
              return SU + ((size_t)(b * 16 + g) * TT + ch * 32) * 16;
            },
            [&](int r) { return F + (size_t)r * 512; }, 512, smem);
  float* Cs = (float*)smem;
  acc_to_lds(acc, Cs);
  __syncthreads();
  float* EN = (float*)(p.ws + OFF_EN);
  for (int c = TIDX; c < 128 * 32; c += 256) {
    const int row = c >> 5, c4 = (c & 31) * 4, m = mt * 128 + row;
    if (m < MS5) {
      const float* s = Cs + row * CLD + c4;
      f32x4 v = {s[0], s[1], s[2], s[3]};
      *(f32x4*)(EN + ((size_t)m * 16 + g) * 256 + nt * 128 + c4) = v;
    }
  }
  __syncthreads();
}

DI void s5_scan_job(const Params& p, int l, int j, char* smem) {
  float2* ends = (float2*)smem;
  const int dir = j & 1, g = (j >> 1) & 15, b = j >> 5;
  const int pp = TIDX & 63, seg = TIDX >> 6;
  const float2 aL = ((const float2*)(p.ws + OFF_PWR))[((size_t)((l * 2 + dir) * 16 + g) * 33 + 32) * 64 + pp];
  const float* EN = (const float*)(p.ws + OFF_EN);
  bf16* SB = (bf16*)(p.ws + OFF_SB);
  float sr = 0.f, si = 0.f;
  for (int q0 = 0; q0 < 66; q0 += 11) {
    float er[11], ei[11];
#pragma unroll
    for (int q = 0; q < 11; ++q) {
      const int pos = seg * 66 + q0 + q;
      const int ch = dir ? (pos < 8 ? 7 - pos : 271 - pos) : pos;
      const float* e = EN + ((size_t)(b * NCH + ch) * 16 + g) * 256 + dir * 128 + pp;
      er[q] = e[0]; ei[q] = e[64];
    }
#pragma unroll
    for (int q = 0; q < 11; ++q) {
      const float nr = aL.x * sr - aL.y * si + er[q], ni = aL.x * si + aL.y * sr + ei[q];
      sr = nr; si = ni;
    }
  }
  ends[seg * 64 + pp] = make_float2(sr, si);
  float pr = 1.f, pi = 0.f;
  for (int q = 0; q < 66; ++q) { const float nr = pr * aL.x - pi * aL.y, ni = pr * aL.y + pi * aL.x; pr = nr; pi = ni; }
  __syncthreads();
  sr = 0.f; si = 0.f;
  for (int k = 0; k < seg; ++k) {
    const float2 e = ends[k * 64 + pp];
    const float nr = pr * sr - pi * si + e.x, ni = pr * si + pi * sr + e.y;
    sr = nr; si = ni;
  }
  for (int q0 = 0; q0 < 66; q0 += 11) {
    float er[11], ei[11];
#pragma unroll
    for (int q = 0; q < 11; ++q) {
      const int pos = seg * 66 + q0 + q;
      const int ch = dir ? (pos < 8 ? 7 - pos : 271 - pos) : pos;
      const float* e = EN + ((size_t)(b * NCH + ch) * 16 + g) * 256 + dir * 128 + pp;
      er[q] = e[0]; ei[q] = e[64];
    }
#pragma unroll
    for (int q = 0; q < 11; ++q) {
      const int pos = seg * 66 + q0 + q;
      const int ch = dir ? (pos < 8 ? 7 - pos : 271 - pos) : pos;
      bf16* sb = SB + ((size_t)(b * NCH + ch) * 16 + g) * 256 + dir * 128 + pp;
      sb[0] = f2bf(sr); sb[64] = f2bf(si);
      const float nr = aL.x * sr - aL.y * si + er[q], ni = aL.x * si + aL.y * sr + ei[q];
      sr = nr; si = ni;
    }
  }
  __syncthreads();
}

DI float gelu_tanh(float x) {
  const float u = 0.7978845608028654f * (x + 0.044715f * x * x * x);
  return 0.5f * x * (1.f + tanhf(u));
}

DI void s5_out_tile(const Params& p, int j, char* smem) {
  const int nt = j & 3, mt = (j >> 2) % 9, g = j / 36;
  const bf16* SU = (const bf16*)(p.ws + OFF_SU);
  const bf16* SB = (const bf16*)(p.ws + OFF_SB);
  const bf16* Tm = (const bf16*)(p.ws + OFF_T5) + ((size_t)g * 512 + nt * 128) * 512;
  const bf16* Em = (const bf16*)(p.ws + OFF_E5) + ((size_t)g * 512 + nt * 128) * 256;
  f32x16 acc[2][2];
  acc_zero(acc);
  gemm_main_dma(acc,
            [&](int r) -> const bf16* {
              const int m = mt * 128 + r;
              if (m >= MS5) return (const bf16*)(p.ws + OFF_ZERO);
              const int b = m / NCH, ch = m - b * NCH;
              return SU + ((size_t)(b * 16 + g) * TT + ch * 32) * 16;
            },
            [&](int r) { return Tm + (size_t)r * 512; }, 512, smem);
  gemm_main_dma(acc,
            [&](int r) -> const bf16* {
              const int m = mt * 128 + r;
              if (m >= MS5) return (const bf16*)(p.ws + OFF_ZERO);
              return SB + ((size_t)m * 16 + g) * 256;
            },
            [&](int r) { return Em + (size_t)r * 256; }, 256, smem);
  float* Cs = (float*)smem;
  acc_to_lds(acc, Cs);
  __syncthreads();
  bf16* Y5 = (bf16*)(p.ws + OFF_Y5);
  for (int c = TIDX; c < 2048; c += 256) {
    const int row = c >> 4, c8 = c & 15, m = mt * 128 + row;
    if (m < MS5) {
      const int b = m / NCH, ch = m - b * NCH;
      const int n = nt * 128 + c8 * 8, i = n >> 4, hh = n & 15;
      const float* s = Cs + row * CLD + c8 * 8;
      u32x4 u;
#pragma unroll
      for (int e = 0; e < 4; ++e) u[e] = pack2(gelu_tanh(s[2 * e]), gelu_tanh(s[2 * e + 1]));
      *(u32x4*)(Y5 + ((size_t)b * TT + ch * 32 + i) * 256 + g * 16 + hh) = u;
    }
  }
  __syncthreads();
}

DI void glu_tile(const Params& p, int l, int j, char* smem) {
  const int nt = j & 1, mt = j >> 1;
  const bf16* Y5 = (const bf16*)(p.ws + OFF_Y5) + (size_t)mt * 128 * 256;
  const bf16* W = wl(p, l, WL_GLU) + (size_t)nt * 128 * 256;
  f32x16 acc[2][2];
  acc_zero(acc);
  gemm_main_dma(acc, [&](int r) { return Y5 + (size_t)r * 256; }, [&](int r) { return W + (size_t)r * 256; }, 256, smem);
  float* Cs = (float*)smem;
  acc_to_lds(acc, Cs);
  __syncthreads();
  const float* gb = p.in[I_GLUB] + l * 256 + nt * 128;
  bf16* O = (bf16*)(p.ws + OFF_OS5) + (size_t)mt * 128 * 256 + nt * 128;
  for (int c = TIDX; c < 2048; c += 256) {
    const int row = c >> 4, cc = (c & 15) * 8;
    const float* s = Cs + row * CLD + cc;
    const u32x4 yu = *(const u32x4*)(Y5 + (size_t)row * 256 + nt * 128 + cc);
    u32x4 u;
#pragma unroll
    for (int e = 0; e < 4; ++e) {
      const float y0 = bflo(yu[e]), y1 = bfhi(yu[e]);
      u[e] = pack2(y0 * sigmoidf_(s[2 * e] + gb[cc + 2 * e]), y1 * sigmoidf_(s[2 * e + 1] + gb[cc + 2 * e + 1]));
    }
    *(u32x4*)(O + (size_t)row * 256 + cc) = u;
  }
  __syncthreads();
}

struct DmaStream { const bf16* ap[4]; const bf16* bp[4]; };
template <class FA, class FB>
DI void stream_setup(DmaStream& st, FA fa, FB fb) {
  const int tid = TIDX, lane = tid & 63, w = tid >> 6;
#pragma unroll
  for (int i = 0; i < 4; ++i) {
    const int row = w * 32 + i * 8 + (lane >> 3);
    const int c = (lane & 7) ^ ((row >> 1) & 7);
    st.ap[i] = fa(row) + c * 8;
    st.bp[i] = fb(row) + c * 8;
  }
}
DI void stream_issue(const DmaStream& st, int buf, int kt, char* smem) {
  const int tid = TIDX, lane = tid & 63, w = tid >> 6;
  const int ldst = (w * 256 + lane) * 16;
  const int k0 = kt * 64;
#pragma unroll
  for (int i = 0; i < 4; ++i) {
    __builtin_amdgcn_global_load_lds((const unsigned*)(st.ap[i] + k0), (unsigned*)(smem + buf * 16384 + ldst + i * 1024), 16, 0, 0);
    __builtin_amdgcn_global_load_lds((const unsigned*)(st.bp[i] + k0), (unsigned*)(smem + 32768 + buf * 16384 + ldst + i * 1024), 16, 0, 0);
  }
}
DI void stream_run(f32x16 (&acc)[2][2], const DmaStream& cur, int K, char* smem, const DmaStream& next, bool has_next) {
  const int tid = TIDX, lane = tid & 63, w = tid >> 6, wm = w >> 1, wn = w & 1;
  const int r = lane & 31, h = lane >> 5;
  const int xr = (r >> 1) & 7;
  const int arow = (wm * 64 + r) * 128, brow = (wn * 64 + r) * 128;
  const int nk = K / 64;
  for (int kt = 0; kt < nk; ++kt) {
    const int buf = kt & 1;
    if (kt + 1 < nk) stream_issue(cur, buf ^ 1, kt + 1, smem);
    else if (has_next) stream_issue(next, buf ^ 1, 0, smem);
    const char* Ab = smem + buf * 16384 + arow;
    const char* Bb = smem + 32768 + buf * 16384 + brow;
#pragma unroll
    for (int s2 = 0; s2 < 4; ++s2) {
      const int co = ((2 * s2 + h) ^ xr) * 16;
      s16x8 a0 = *(const s16x8*)(Ab + co);
      s16x8 a1 = *(const s16x8*)(Ab + 32 * 128 + co);
      s16x8 b0 = *(const s16x8*)(Bb + co);
      s16x8 b1 = *(const s16x8*)(Bb + 32 * 128 + co);
      acc[0][0] = MFMA32(a0, b0, acc[0][0]);
      acc[0][1] = MFMA32(a0, b1, acc[0][1]);
      acc[1][0] = MFMA32(a1, b0, acc[1][0]);
      acc[1][1] = MFMA32(a1, b1, acc[1][1]);
    }
    asm volatile("s_waitcnt vmcnt(0)" ::: "memory");
    __syncthreads();
  }
}

DI void merge_tile(const Params& p, int l, int j, char* smem) {
  const int nt = j & 7, mt = j >> 3;
  const bf16* H = (const bf16*)(p.ws + OFF_H) + (size_t)mt * 128 * DM;
  unsigned am[2][2][8];
#pragma unroll
  for (int a = 0; a < 2; ++a)
#pragma unroll
    for (int bq = 0; bq < 2; ++bq)
#pragma unroll
      for (int i = 0; i < 8; ++i) am[a][bq][i] = 0u;
  DmaStream sb, sg;
  {
    const bf16* A0 = (const bf16*)(p.ws + OFF_OATT) + (size_t)mt * 128 * 256;
    const bf16* W0 = wl(p, l, WL_BRA) + (size_t)nt * 128 * 256;
    stream_setup(sb, [&](int r) { return A0 + (size_t)r * 256; }, [&](int r) { return W0 + (size_t)r * 256; });
    stream_issue(sb, 0, 0, smem);
    asm volatile("s_waitcnt vmcnt(0)" ::: "memory");
    __syncthreads();
  }
#pragma unroll 1
  for (int x = 0; x < 3; ++x) {
    const int K = (x == 1) ? 512 : 256;
    const bf16* Wg = wl(p, l, WL_WIN) + ((size_t)2432 + x * 1024 + nt * 128) * DM;
    stream_setup(sg, [&](int r) { return H + (size_t)r * DM; }, [&](int r) { return Wg + (size_t)r * DM; });
    unsigned br[2][2][8];
    {
      f32x16 acc[2][2];
      acc_zero(acc);
      stream_run(acc, sb, K, smem, sg, true);
#pragma unroll
      for (int a = 0; a < 2; ++a)
#pragma unroll
        for (int bq = 0; bq < 2; ++bq)
#pragma unroll
          for (int i = 0; i < 8; ++i) br[a][bq][i] = pack2(acc[a][bq][2 * i], acc[a][bq][2 * i + 1]);
    }
    if (x < 2) {
      const bf16* A1; const bf16* W1; int K1;
      if (x == 0) { A1 = (const bf16*)(p.ws + OFF_OGLA) + (size_t)mt * 128 * 512; W1 = wl(p, l, WL_BRG) + (size_t)nt * 128 * 512; K1 = 512; }
      else { A1 = (const bf16*)(p.ws + OFF_OS5) + (size_t)mt * 128 * 256; W1 = wl(p, l, WL_BRS) + (size_t)nt * 128 * 256; K1 = 256; }
      stream_setup(sb, [&](int r) { return A1 + (size_t)r * K1; }, [&](int r) { return W1 + (size_t)r * K1; });
    }
    f32x16 acc[2][2];
    acc_zero(acc);
    stream_run(acc, sg, DM, smem, sb, x < 2);
#pragma unroll
    for (int a = 0; a < 2; ++a)
#pragma unroll
      for (int bq = 0; bq < 2; ++bq)
#pragma unroll
        for (int i = 0; i < 8; ++i) {
          const float v0 = bflo(am[a][bq][i]) + sigmoidf_(acc[a][bq][2 * i]) * bflo(br[a][bq][i]);
          const float v1 = bfhi(am[a][bq][i]) + sigmoidf_(acc[a][bq][2 * i + 1]) * bfhi(br[a][bq][i]);
          am[a][bq][i] = pack2(v0, v1);
        }
  }
  f32x16 accm[2][2];
#pragma unroll
  for (int a = 0; a < 2; ++a)
#pragma unroll
    for (int bq = 0; bq < 2; ++bq)
#pragma unroll
      for (int i = 0; i < 8; ++i) { accm[a][bq][2 * i] = bflo(am[a][bq][i]); accm[a][bq][2 * i + 1] = bfhi(am[a][bq][i]); }
  float* Cs = (float*)smem;
  acc_to_lds(accm, Cs);
  __syncthreads();
  store_tile_bf16(Cs, (bf16*)(p.ws + OFF_MG) + (size_t)mt * 128 * DM + nt * 128, DM, 128, 1.f);
  __syncthreads();
}

DI void plain_tile(const bf16* A, int K, const bf16* W, bf16* dst, int ldd, char* smem) {
  f32x16 acc[2][2];
  acc_zero(acc);
  gemm_main_dma(acc, [&](int r) { return A + (size_t)r * K; }, [&](int r) { return W + (size_t)r * K; }, K, smem);
  float* Cs = (float*)smem;
  acc_to_lds(acc, Cs);
  __syncthreads();
  store_tile_bf16(Cs, dst, ldd, 128, 1.f);
  __syncthreads();
}

DI void plain_wide(const bf16* A, int K, const bf16* W, bf16* dst, int ldd, char* smem) {
  f32x16 acc[2][4];
  accw_zero(acc);
  gemm_wide(acc, [&](int r) { return A + (size_t)r * K; }, [&](int r) { return W + (size_t)r * K; }, K, smem);
  float* Cs = (float*)smem;
  accw_to_lds<0>(acc, Cs);
  __syncthreads();
  store_tile_bf16(Cs, dst, ldd, 128, 1.f);
  __syncthreads();
  accw_to_lds<1>(acc, Cs);
  __syncthreads();
  store_tile_bf16(Cs, dst + 128, ldd, 128, 1.f);
  __syncthreads();
}

DI void up_epi(const Params& p, int l, int jn, int seqbase, int len, int pos0, char* smem) {
  float* Cs = (float*)smem;
  const float* cw = p.in[I_CW] + (size_t)l * 3 * 2 * DFF;
  const float* cb = p.in[I_CB] + (size_t)l * 2 * DFF;
  bf16* G = (bf16*)(p.ws + OFF_G);
  const int tid = TIDX;
  const int c = (tid & 31) * 2;
  float wa[2][3], wv[2][3], ba[2], bv[2];
#pragma unroll
  for (int e = 0; e < 2; ++e) {
    const int ca = jn * 64 + c + e, cv = DFF + ca;
#pragma unroll
    for (int k = 0; k < 3; ++k) { wa[e][k] = cw[k * 2 * DFF + ca]; wv[e][k] = cw[k * 2 * DFF + cv]; }
    ba[e] = cb[ca]; bv[e] = cb[cv];
  }
#pragma unroll 4
  for (int rr = 1 + (tid >> 5); rr < 127; rr += 8) {
    const int pos = pos0 + rr;
    if (pos < len) {
      float gv[2];
#pragma unroll
      for (int e = 0; e < 2; ++e) {
        const float a = wa[e][0] * Cs[(rr - 1) * CLD + c + e] + wa[e][1] * Cs[rr * CLD + c + e] + wa[e][2] * Cs[(rr + 1) * CLD + c + e] + ba[e];
        const float v = wv[e][0] * Cs[(rr - 1) * CLD + 64 + c + e] + wv[e][1] * Cs[rr * CLD + 64 + c + e] +
                        wv[e][2] * Cs[(rr + 1) * CLD + 64 + c + e] + bv[e];
        gv[e] = siluf_(a) * v;
      }
      *(unsigned*)(G + (size_t)(seqbase + pos) * DFF + jn * 64 + c) = pack2(gv[0], gv[1]);
    }
  }
  __syncthreads();
}

DI void up_wide(const Params& p, int l, int mtile, int jp, char* smem) {
  const int b = mtile / 69, rr0 = mtile % 69;
  int seqbase, len, ti;
  if (rr0 < 3) { seqbase = b * TT; len = CTXL; ti = rr0; }
  else { seqbase = b * TT + CTXL; len = SEQ; ti = rr0 - 3; }
  const int pos0 = ti * 126 - 1;
  const bf16* H = (const bf16*)(p.ws + OFF_H);
  const bf16* W = wl(p, l, WL_UP) + (size_t)jp * 256 * DM;
  f32x16 acc[2][4];
  accw_zero(acc);
  gemm_wide(acc,
            [&](int r) -> const bf16* {
              const int pos = pos0 + r;
              return (pos >= 0 && pos < len) ? H + (size_t)(seqbase + pos) * DM : (const bf16*)(p.ws + OFF_ZERO);
            },
            [&](int r) { return W + (size_t)r * DM; }, DM, smem);
  float* Cs = (float*)smem;
  accw_to_lds<0>(acc, Cs);
  __syncthreads();
  up_epi(p, l, jp * 2, seqbase, len, pos0, smem);
  accw_to_lds<1>(acc, Cs);
  __syncthreads();
  up_epi(p, l, jp * 2 + 1, seqbase, len, pos0, smem);
}

DI bool gemm_job(int bid, int G, int it, int MT, int NTL, int& mt, int& nt, int CW = 8) {
  const int x = bid & 7, q = bid >> 3, Q = G >> 3;
  const int m0 = (x * MT) >> 3, m1 = ((x + 1) * MT) >> 3, Mx = m1 - m0;
  const int jl = q + Q * it;
  if (jl >= Mx * NTL) return false;
  const int full = Mx * CW;
  const int c = jl / full, rem = jl - c * full;
  const int wc = min(CW, NTL - CW * c);
  const int mi = rem / wc;
  mt = m0 + mi;
  nt = CW * c + (rem - mi * wc);
  return true;
}

enum { PH_PREP = 0, PH_ROW0, PH_PROJ, PH_MIX1, PH_SCAN, PH_MIX2, PH_GLU, PH_MERGE, PH_WOUT, PH_ROW1, PH_UP, PH_DOWN, PH_ROW2 };
constexpr int N_PHASES = 2 + 11 * NL;

DI void run_phase(const Params& p, int ph, int l, char* smem) {
  const int bid = blockIdx.x;
#ifdef HALFMASK
  const int G = ((HALFMASK >> ph) & 1) ? 256 : gridDim.x;
  if (bid >= G) return;
#else
  const int G = gridDim.x;
#endif
#ifdef PHMASK
  if (!((PHMASK >> ph) & 1)) return;
#endif
  switch (ph) {
    case PH_PREP:
      if (bid < 8) { for (int i = TIDX; i < 512; i += 256) ((u32x4*)(p.ws + OFF_ZERO))[i] = u32x4{0u, 0u, 0u, 0u}; }
      for (int j = bid; j < 128 + 4016; j += G) {
        if (j < 96) prep_mod_job(p, j, smem);
        else if (j < 128) prep_s5_job(p, j - 96);
        else prep_wt_job(p, j - 128, smem);
      }
      break;
    case PH_ROW0:
      row_phase<0>(p, 0, bid, G);
      ktab_phase(p, bid, G, 0, 1);
      break;
    case PH_PROJ:
#ifdef EXP_A
      if (bid < 256) { int mt, nt; for (int it = 0; gemm_job(bid, 256, it, 264, 10, mt, nt, 4); ++it) proj_wide(p, l, mt, nt, smem); }
      else {
        s5mat_phase(p, l, bid - 256, G - 256);
        if (l + 1 < NL) ktab_phase(p, bid - 256, G - 256, l + 1, l + 2);
        if (l + 1 < NL) { for (int jj = (l + 1) * 4016 + (bid - 256); jj < (l + 2) * 4016; jj += G - 256) prep_wt_job(p, jj, smem); }
      }
#elif defined(EXP_C)
      if (bid < 256) for (int j = bid; j < 264 * 19; j += 256) { if ((EXP_C >> (j % 19)) & 1) proj_tile(p, l, j / 19, j % 19, smem); }
      for (int j = bid; j < 264 * 19; j += G) { if (!((EXP_C >> (j % 19)) & 1)) proj_tile(p, l, j / 19, j % 19, smem); }
      s5mat_phase(p, l, bid, G);
#elif defined(EXP_B)
      for (int j = bid; j < 264 * 19; j += G) proj_tile(p, l, j / 19, j % 19, smem);
      if (bid < 256) s5mat_phase(p, l, bid, 256);
#else
      for (int j = bid; j < 264 * 19; j += G) proj_tile(p, l, j / 19, j % 19, smem);
      s5mat_phase(p, l, bid, G);
#endif
      break;
    case PH_MIX1:
      for (int j = bid; j < 1056 + 1056 + 288; j += G) {
        if (j < 1056) attn_unit(p, j, smem);
        else if (j < 2112) gla_unit<false>(p, l, j - 1056, smem);
        else s5_end_tile(p, j - 2112, smem);
      }
      break;
    case PH_SCAN:
      for (int j = bid; j < 1024 + 128; j += G) {
        if (j < 1024) gla_scan_job(p, j);
        else s5_scan_job(p, l, j - 1024, smem);
      }
      break;
    case PH_MIX2:
      for (int j = bid; j < 528 + 576; j += G) {
        if (j < 528) gla_unit<true>(p, l, j, smem);
        else s5_out_tile(p, j - 528, smem);
      }
      break;
    case PH_GLU:
      { int mt, nt; for (int it = 0; gemm_job(bid, G, it, 264, 2, mt, nt); ++it) glu_tile(p, l, mt * 2 + nt, smem); }
      break;
    case PH_MERGE:
      { int mt, nt; for (int it = 0; gemm_job(bid, G, it, 264, 8, mt, nt); ++it) merge_tile(p, l, mt * 8 + nt, smem); }
      break;
    case PH_WOUT:
      for (int it = 0;; ++it) {
        int mt, nt;
        if (!gemm_job(bid, G, it, 264, 8, mt, nt)) break;
        plain_tile((const bf16*)(p.ws + OFF_MG) + (size_t)mt * 128 * DM, DM, wl(p, l, WL_WOUT) + (size_t)nt * 128 * DM,
                   (bf16*)(p.ws + OFF_H) + (size_t)mt * 128 * DM + nt * 128, DM, smem);
      }
      break;
    case PH_ROW1: row_phase<1>(p, l, bid, G); break;
    case PH_UP:
      { int mt, nt; for (int it = 0; gemm_job(bid, G, it, 276, 22, mt, nt, 4); ++it) up_wide(p, l, mt, nt, smem); }
      break;
    case PH_DOWN:
      for (int it = 0;; ++it) {
        int mt, nt;
        if (!gemm_job(bid, G, it, 264, 8, mt, nt)) break;
        plain_tile((const bf16*)(p.ws + OFF_G) + (size_t)mt * 128 * DFF, DFF, wl(p, l, WL_DOWN) + (size_t)nt * 128 * DFF,
                   (bf16*)(p.ws + OFF_H) + (size_t)mt * 128 * DM + nt * 128, DM, smem);
      }
      break;
    case PH_ROW2: row_phase<2>(p, l, bid, G); break;
  }
}

#define XB_TMO      128
#define XB_XCNT(j)  (256  + 64 * (j))
#define XB_XSUB(j)  (1280 + 64 * (j))
#define XB_XGEN(j)  (2304 + 64 * (j))
#define XB_TOP      3328
#define XB_TOPGEN   3392
#define XCD_BAR_WORDS 3456
#define XB_SPIN_CAP (1u << 18)
#define LAS __attribute__((address_space(3)))

__device__ __forceinline__ unsigned xb_ld(unsigned* p)              { return __hip_atomic_load(p, __ATOMIC_RELAXED, __HIP_MEMORY_SCOPE_AGENT); }
__device__ __forceinline__ unsigned xb_add(unsigned* p, unsigned v) { return __hip_atomic_fetch_add(p, v, __ATOMIC_RELAXED, __HIP_MEMORY_SCOPE_AGENT); }
__device__ __forceinline__ unsigned xb_xcc_id() { return (unsigned)__builtin_amdgcn_s_getreg((3 << 11) | 20) & 0xFu; }
#define XB_SPIN(cond, bar) do { unsigned _sp = 0; while (cond) { __builtin_amdgcn_s_sleep(1); \
    if ((++_sp & 255u) == 0u) { if (xb_ld(&(bar)[XB_TMO])) break; if (_sp > XB_SPIN_CAP) { atomicAdd(&(bar)[XB_TMO], 1u); break; } } } } while (0)

struct XcdBarrier {
    unsigned* bar; unsigned x;
    volatile LAS unsigned* st;
};

__device__ __forceinline__ XcdBarrier xcd_barrier_post(unsigned* bar, volatile LAS unsigned* st) {
    XcdBarrier b; b.bar = bar; b.x = xb_xcc_id(); b.st = st;
    if (threadIdx.x == 0) (void)xb_add(&bar[XB_XCNT(b.x)], 1u);
    return b;
}
__device__ __forceinline__ void xcd_barrier_complete(unsigned* bar, unsigned x, unsigned& nloc, unsigned& nx) {
    const unsigned G = gridDim.x * gridDim.y * gridDim.z;
    unsigned sum, cnt, mine, sp = 0u;
    for (;;) {
        sum = 0u; cnt = 0u; mine = 0u;
#pragma unroll
        for (unsigned j = 0; j < 16; ++j) { const unsigned c = xb_ld(&bar[XB_XCNT(j)]); sum += c; cnt += (c > 0u) ? 1u : 0u; mine = (j == x) ? c : mine; }
        if (sum == G) break;
        __builtin_amdgcn_s_sleep(1);
        if ((++sp & 255u) == 0u) { if (xb_ld(&bar[XB_TMO])) break; if (sp > XB_SPIN_CAP) { atomicAdd(&bar[XB_TMO], 1u); break; } }
    }
    nloc = mine > 0u ? mine : 1u; nx = cnt > 0u ? cnt : 1u;
}

__device__ __forceinline__ void xcd_barrier(const XcdBarrier& b) {
    asm volatile("s_waitcnt vmcnt(0)" ::: "memory");
    __syncthreads();
    if (threadIdx.x == 0) {
        unsigned* bar = b.bar;
        __builtin_amdgcn_s_waitcnt(0);
        unsigned nloc = b.st[0], nx = b.st[1];
        if (nloc == 0u) { xcd_barrier_complete(bar, b.x, nloc, nx); b.st[0] = nloc; b.st[1] = nx; }
        const unsigned old = xb_add(&bar[XB_XSUB(b.x)], 1u);
        const unsigned gen = old / nloc;
        if (old + 1u == (gen + 1u) * nloc) {
            __builtin_amdgcn_fence(__ATOMIC_RELEASE, "agent");
            asm volatile("s_waitcnt vmcnt(0)" ::: "memory");
            const unsigned og = xb_add(&bar[XB_TOP], 1u);
            const unsigned tg = og / nx;
            if (og + 1u == (tg + 1u) * nx) xb_add(&bar[XB_TOPGEN], 1u);
            else XB_SPIN(xb_ld(&bar[XB_TOPGEN]) == tg, bar);
            __builtin_amdgcn_fence(__ATOMIC_ACQUIRE, "agent");
            xb_add(&bar[XB_XGEN(b.x)], 1u);
            asm volatile("s_waitcnt vmcnt(0)" ::: "memory");
        } else {
            XB_SPIN(xb_ld(&bar[XB_XGEN(b.x)]) == gen, bar);
            __builtin_amdgcn_fence(__ATOMIC_ACQUIRE, "agent");
            asm volatile("s_waitcnt vmcnt(0)" ::: "memory");
        }
    }
    __syncthreads();
}


DI void grid_barrier(unsigned* bar, unsigned& gen) {
  asm volatile("s_waitcnt vmcnt(0)" ::: "memory");
  __syncthreads();
  gen += 1;
  if (threadIdx.x == 0) {
    __builtin_amdgcn_fence(__ATOMIC_RELEASE, "agent");
    asm volatile("s_waitcnt vmcnt(0)" ::: "memory");
    const unsigned target = gen * gridDim.x;
    __hip_atomic_fetch_add(bar, 1u, __ATOMIC_RELAXED, __HIP_MEMORY_SCOPE_AGENT);
    while (__hip_atomic_load(bar, __ATOMIC_RELAXED, __HIP_MEMORY_SCOPE_AGENT) < target) __builtin_amdgcn_s_sleep(2);
  }
  __syncthreads();
  __builtin_amdgcn_fence(__ATOMIC_ACQUIRE, "agent");
  asm volatile("s_waitcnt vmcnt(0)" ::: "memory");
}

__global__ void __launch_bounds__(256, 2) hybrid_fwd(Params p, int ph_lo, int ph_hi) {
  extern __shared__ __attribute__((aligned(16))) char smem[];
  unsigned* bar = (unsigned*)(p.ws + OFF_BAR);
  unsigned gen = 0;
  __shared__ uint4 xb_words;
  if (threadIdx.x == 0) xb_words = make_uint4(0u, 0u, 0u, 0u);
  __syncthreads();
  XcdBarrier xb = xcd_barrier_post(bar + 64, (volatile LAS unsigned*)&xb_words);
  if (ph_hi - ph_lo > 1) cg::this_grid().sync();
  int i = 0;
#define STEP(PH, L)                                      \
  {                                                      \
    if (i >= ph_lo && i < ph_hi) {                       \
      Params q;                                          \
      q.ws = p.ws; q.out = p.out;                        \
      asm volatile("" : "+s"(q.ws), "+s"(q.out));        \
      _Pragma("unroll") for (int k = 0; k < 34; ++k) { q.in[k] = p.in[k]; asm volatile("" : "+s"(q.in[k])); } \
      run_phase(q, PH, L, smem);                         \
      if ((DUPMASK >> (PH)) & 1) { xcd_barrier(xb); run_phase(q, PH, L, smem); } \
      if (i + 1 < ph_hi) xcd_barrier(xb);                \
    }                                                    \
    ++i;                                                 \
  }
  STEP(PH_PREP, 0)
  STEP(PH_ROW0, 0)
#pragma unroll 1
  for (int l = 0; l < NL; ++l) {
    STEP(PH_PROJ, l)
    STEP(PH_MIX1, l)
    STEP(PH_SCAN, l)
    STEP(PH_MIX2, l)
    STEP(PH_GLU, l)
    STEP(PH_MERGE, l)
    STEP(PH_WOUT, l)
    STEP(PH_ROW1, l)
    STEP(PH_UP, l)
    STEP(PH_DOWN, l)
    STEP(PH_ROW2, l)
  }
#undef STEP
}

extern "C" void kernel_launch(void* const* d_in, const int* in_sizes, int n_in, void* d_out, int out_size, void* d_ws, size_t ws_size,
                              hipStream_t stream) {
  static int grid_blocks = 0;
  if (!grid_blocks) {
    int dev = 0, cus = 0, per_cu = 0;
    hipGetDevice(&dev);
    hipDeviceGetAttribute(&cus, hipDeviceAttributeMultiprocessorCount, dev);
    hipFuncSetAttribute((const void*)hybrid_fwd, hipFuncAttributeMaxDynamicSharedMemorySize, SMEM_BYTES);
    hipOccupancyMaxActiveBlocksPerMultiprocessor(&per_cu, hybrid_fwd, 256, SMEM_BYTES);
    if (per_cu < 1) per_cu = 1;
    if (per_cu > 2) per_cu = 2;
    grid_blocks = cus * per_cu;
    if (ws_size < OFF_ZERO + 8192) fprintf(stderr, "workspace too small: %zu < %zu\n", ws_size, (size_t)OFF_END);
  }
  Params p{};
  for (int i = 0; i < 34; ++i) p.in[i] = (const float*)d_in[i];
  p.out = (float*)d_out;
  p.ws = (char*)d_ws;
#if ONE_LAUNCH
  hipMemsetAsync((char*)d_ws + OFF_BAR, 0, 16384, stream);
  int lo = 0, hi = N_PHASES;
  void* args[] = {&p, &lo, &hi};
  hipError_t e = hipLaunchCooperativeKernel((void*)hybrid_fwd, dim3(grid_blocks), dim3(256), args, SMEM_BYTES, stream);
  if (e != hipSuccess) fprintf(stderr, "cooperative launch failed: %s (grid %d)\n", hipGetErrorString(e), grid_blocks);
#else
  for (int i = 0; i < N_PHASES; ++i) hipLaunchKernelGGL(hybrid_fwd, dim3(grid_blocks), dim3(256), SMEM_BYTES, stream, p, i, i + 1);
#endif
}
```

```cpp
#include <hip/hip_runtime.h>
#include <hip/hip_cooperative_groups.h>
#include <stdint.h>
#include <cstdio>
namespace cg = cooperative_groups;

#define EXP_A 1
#ifndef DUPMASK
#define DUPMASK 0
#endif
#ifndef ONE_LAUNCH
#define ONE_LAUNCH 1
#endif

typedef unsigned short bf16;
typedef __attribute__((ext_vector_type(8))) short s16x8;
typedef __attribute__((ext_vector_type(4))) short s16x4;
typedef __attribute__((ext_vector_type(16))) float f32x16;
typedef __attribute__((ext_vector_type(4))) float f32x4;
typedef __attribute__((ext_vector_type(2))) float f32x2;
typedef __attribute__((ext_vector_type(4))) unsigned u32x4;
typedef __attribute__((ext_vector_type(2))) unsigned u32x2;
typedef __attribute__((ext_vector_type(2))) __bf16 bf16x2_t;

#define DI __device__ __forceinline__
#define MFMA32(a, b, c) __builtin_amdgcn_mfma_f32_32x32x16_bf16((a), (b), (c), 0, 0, 0)

DI int tidx_opaque() { int t = threadIdx.x; asm volatile("" : "+v"(t)); return t; }
#define TIDX tidx_opaque()
DI bf16 f2bf(float x) { return __builtin_bit_cast(unsigned short, (__bf16)x); }
DI float bf2f(bf16 v) { return __uint_as_float(((unsigned)v) << 16); }
DI unsigned pack2(float a, float b) {
  f32x2 v = {a, b};
  return __builtin_bit_cast(unsigned, __builtin_convertvector(v, bf16x2_t));
}
DI float bflo(unsigned u) { return __uint_as_float(u << 16); }
DI float bfhi(unsigned u) { return __uint_as_float(u & 0xffff0000u); }
typedef const __attribute__((address_space(1))) u32x4* gptr16;
DI u32x4 ldg16(const void* q) { return *(gptr16)(uintptr_t)q; }
#define SCHED_FENCE() __builtin_amdgcn_sched_barrier(0)
DI int crow(int i, int h) { return (i & 3) + 8 * (i >> 2) + 4 * h; }
DI void sincos_cw(float x, float& sn, float& cs) {
  const float k = rintf(x * 0.63661977236758134f);
  float r = fmaf(-k, 1.57079637050628662109375f, x);
  r = fmaf(-k, -4.371139000186241e-08f, r);
  const int q = ((int)k) & 3;
  const float r2 = r * r;
  const float sp = r + r * r2 * (-1.6666667163e-01f + r2 * (8.3333337680e-03f + r2 * (-1.9841270114e-04f + r2 * 2.7557314297e-06f)));
  const float cp = 1.f + r2 * (-0.5f + r2 * (4.1666667908e-02f + r2 * (-1.3888889225e-03f + r2 * (2.4801587642e-05f - r2 * 2.7557314297e-07f))));
  sn = (q == 0) ? sp : (q == 1) ? cp : (q == 2) ? -sp : -cp;
  cs = (q == 0) ? cp : (q == 1) ? -sp : (q == 2) ? -cp : sp;
}
DI float sigmoidf_(float x) { return 1.f / (1.f + __expf(-x)); }
DI float siluf_(float x) { return x / (1.f + __expf(-x)); }

constexpr int DM = 1024, NB = 4, SEQ = 8192, CTXL = 256, TT = SEQ + CTXL, NTOK = NB * TT, NL = 4;
constexpr int DFF = 2816, DIN = 5408;
constexpr float EPSF = 1e-6f;
constexpr int NG33 = 33;
constexpr int NCH = 264;
constexpr int MS5 = NB * NCH;

constexpr size_t SZ_H = (size_t)NTOK * 1024 * 2;
constexpr size_t OFF_H = 0;
constexpr size_t OFF_P = OFF_H + SZ_H;
constexpr size_t OFF_Q = OFF_P;
constexpr size_t OFF_K = OFF_Q + (size_t)NTOK * 256 * 2;
constexpr size_t OFF_VT = OFF_K + (size_t)NTOK * 128 * 2;
constexpr size_t OFF_GQ = OFF_VT + (size_t)NTOK * 128 * 2;
constexpr size_t OFF_GK = OFF_GQ + (size_t)NTOK * 256 * 2;
constexpr size_t OFF_GVT = OFF_GK + (size_t)NTOK * 256 * 2;
constexpr size_t OFF_GR = OFF_GVT + (size_t)NTOK * 512 * 2;
constexpr size_t OFF_SU = OFF_GR + (size_t)NTOK * 512 * 2;
constexpr size_t OFF_LOW = OFF_SU + (size_t)NTOK * 256 * 2;
constexpr size_t OFF_O = OFF_LOW + (size_t)NTOK * 32 * 4;
constexpr size_t OFF_OATT = OFF_O;
constexpr size_t OFF_OGLA = OFF_OATT + (size_t)NTOK * 256 * 2;
constexpr size_t OFF_Y5 = OFF_OGLA + (size_t)NTOK * 512 * 2;
constexpr size_t OFF_EN = OFF_Y5;
constexpr size_t OFF_OS5 = OFF_Y5 + (size_t)NTOK * 256 * 2;
constexpr size_t OFF_M = OFF_OS5 + (size_t)NTOK * 256 * 2;
constexpr size_t OFF_MG = OFF_M;
constexpr size_t OFF_GS = OFF_M;
constexpr size_t OFF_DECG = OFF_GS + (size_t)32 * 33 * 8192 * 4;
constexpr size_t OFF_SB = OFF_DECG + (size_t)32 * 33 * 64 * 4;
constexpr size_t OFF_T5 = OFF_SB + (size_t)MS5 * 16 * 256 * 2;
constexpr size_t OFF_E5 = OFF_T5 + (size_t)16 * 512 * 512 * 2;
constexpr size_t OFF_F5 = OFF_E5 + (size_t)16 * 512 * 256 * 2;
constexpr size_t OFF_MEND = OFF_F5 + (size_t)16 * 256 * 512 * 2;
static_assert(OFF_MEND <= OFF_M + SZ_H, "mixer scratch overflows merged area");
constexpr size_t OFF_W = OFF_M + SZ_H;
constexpr size_t WL_WIN = 0, WL_BRA = WL_WIN + (size_t)5504 * 1024, WL_BRG = WL_BRA + 1024 * 256, WL_BRS = WL_BRG + 1024 * 512,
                 WL_WOUT = WL_BRS + 1024 * 256, WL_UP = WL_WOUT + 1024 * 1024, WL_DOWN = WL_UP + (size_t)5632 * 1024,
                 WL_GLU = WL_DOWN + (size_t)1024 * 2816, WL_TOTAL = WL_GLU + 256 * 256;
constexpr size_t OFF_XC = OFF_W + WL_TOTAL * 2 * NL;
constexpr size_t OFF_MOD = OFF_XC + (size_t)NB * CTXL * 1024 * 4;
constexpr size_t OFF_BBR = OFF_MOD + (size_t)NL * 5 * 6144 * 4;
constexpr size_t OFF_BBI = OFF_BBR + (size_t)NL * 2 * 16 * 64 * 16 * 4;
constexpr size_t OFF_PWR = OFF_BBI + (size_t)NL * 2 * 16 * 64 * 16 * 4;
constexpr size_t OFF_KTAB = OFF_PWR + (size_t)NL * 2 * 16 * 33 * 64 * 8;
constexpr size_t OFF_END = OFF_KTAB + (size_t)NL * 16 * 2 * 32 * 256 * 4;
constexpr size_t OFF_BAR = OFF_END;
constexpr size_t OFF_ZERO = OFF_BAR + 16384;
constexpr size_t OFF_G = OFF_P;
static_assert((size_t)NTOK * DFF * 2 <= OFF_M - OFF_P, "G overflows");

constexpr int SMEM_BYTES = 73728;

struct Params {
  const float* in[34];
  float* out;
  char* ws;
};

enum { I_X = 0, I_C, I_CTX, I_CCTX, I_ADAW, I_ADAB, I_NMPRE, I_NMPOST, I_NFPRE, I_NFPOST, I_WIN, I_QN, I_KN, I_GGW, I_GGB, I_GON,
       I_ARE, I_AIM, I_LDT, I_BRE, I_BIM, I_CRE, I_CIM, I_S5D, I_GLUW, I_GLUB, I_WBA, I_WBG, I_WBS, I_WOUT, I_UP, I_CW, I_CB, I_DOWN };

constexpr int LDT = 72;
constexpr int CLD = 132;

template <class FA, class FB>
DI void gemm_main(f32x16 (&acc)[2][2], FA fa, FB fb, int K, char* smem) {
  bf16* As = (bf16*)smem;
  bf16* Bs = (bf16*)(smem + 2 * 128 * LDT * 2);
  const int tid = TIDX, lane = tid & 63, w = tid >> 6, wm = w >> 1, wn = w & 1;
  const int r = lane & 31, h = lane >> 5;
  const int lr = tid >> 3, kc = (tid & 7) * 8;
  const bf16* ap[4];
  const bf16* bp[4];
#pragma unroll
  for (int i = 0; i < 4; ++i) {
    const bf16* a = fa(lr + 32 * i);
    const bf16* b = fb(lr + 32 * i);
    ap[i] = a ? a + kc : nullptr;
    bp[i] = b ? b + kc : nullptr;
  }
  u32x4 ra[4], rb[4];
  const u32x4 z4 = {0u, 0u, 0u, 0u};
#pragma unroll
  for (int i = 0; i < 4; ++i) {
    ra[i] = ap[i] ? ldg16(ap[i]) : z4;
    rb[i] = bp[i] ? ldg16(bp[i]) : z4;
  }
#pragma unroll
  for (int i = 0; i < 4; ++i) {
    *(u32x4*)(As + (lr + 32 * i) * LDT + kc) = ra[i];
    *(u32x4*)(Bs + (lr + 32 * i) * LDT + kc) = rb[i];
  }
  __syncthreads();
  const int nk = K / 64;
  for (int kt = 0; kt < nk; ++kt) {
    const int buf = kt & 1;
    const bool more = (kt + 1 < nk);
    if (more) {
      const int k0 = (kt + 1) * 64;
#pragma unroll
      for (int i = 0; i < 4; ++i) {
        ra[i] = ap[i] ? ldg16(ap[i] + k0) : z4;
        rb[i] = bp[i] ? ldg16(bp[i] + k0) : z4;
      }
    }
    SCHED_FENCE();
    const bf16* Ab = As + buf * 128 * LDT + (wm * 64 + r) * LDT + h * 8;
    const bf16* Bb = Bs + buf * 128 * LDT + (wn * 64 + r) * LDT + h * 8;
#pragma unroll
    for (int s = 0; s < 4; ++s) {
      s16x8 a0 = *(const s16x8*)(Ab + s * 16);
      s16x8 a1 = *(const s16x8*)(Ab + 32 * LDT + s * 16);
      s16x8 b0 = *(const s16x8*)(Bb + s * 16);
      s16x8 b1 = *(const s16x8*)(Bb + 32 * LDT + s * 16);
      acc[0][0] = MFMA32(a0, b0, acc[0][0]);
      acc[0][1] = MFMA32(a0, b1, acc[0][1]);
      acc[1][0] = MFMA32(a1, b0, acc[1][0]);
      acc[1][1] = MFMA32(a1, b1, acc[1][1]);
    }
    SCHED_FENCE();
    if (more) {
      bf16* Aw = As + (buf ^ 1) * 128 * LDT;
      bf16* Bw = Bs + (buf ^ 1) * 128 * LDT;
#pragma unroll
      for (int i = 0; i < 4; ++i) {
        *(u32x4*)(Aw + (lr + 32 * i) * LDT + kc) = ra[i];
        *(u32x4*)(Bw + (lr + 32 * i) * LDT + kc) = rb[i];
      }
    }
    __syncthreads();
  }
}

template <class FA, class FB>
DI void gemm_main_deep(f32x16 (&acc)[2][2], FA fa, FB fb, int K, char* smem) {
  bf16* As = (bf16*)smem;
  bf16* Bs = (bf16*)(smem + 2 * 128 * LDT * 2);
  const int tid = TIDX, lane = tid & 63, w = tid >> 6, wm = w >> 1, wn = w & 1;
  const int r = lane & 31, h = lane >> 5;
  const int lr = tid >> 3, kc = (tid & 7) * 8;
  const bf16* ap[4];
  const bf16* bp[4];
#pragma unroll
  for (int i = 0; i < 4; ++i) {
    const bf16* a = fa(lr + 32 * i);
    const bf16* b = fb(lr + 32 * i);
    ap[i] = a ? a + kc : nullptr;
    bp[i] = b ? b + kc : nullptr;
  }
  const u32x4 z4 = {0u, 0u, 0u, 0u};
  u32x4 a0[4], b0[4], a1[4], b1[4];
  const int nk = K / 64;
#define GD_LOAD(RA, RB, T)                                               \
  {                                                                      \
    const int k0_ = (T) * 64;                                            \
    _Pragma("unroll") for (int i = 0; i < 4; ++i) {                      \
      RA[i] = ap[i] ? ldg16(ap[i] + k0_) : z4;                           \
      RB[i] = bp[i] ? ldg16(bp[i] + k0_) : z4;                           \
    }                                                                    \
  }
#define GD_STORE(RA, RB, BUF)                                            \
  {                                                                      \
    _Pragma("unroll") for (int i = 0; i < 4; ++i) {                      \
      *(u32x4*)(As + (BUF) * 128 * LDT + (lr + 32 * i) * LDT + kc) = RA[i]; \
      *(u32x4*)(Bs + (BUF) * 128 * LDT + (lr + 32 * i) * LDT + kc) = RB[i]; \
    }                                                                    \
  }
#define GD_COMPUTE(BUF)                                                  \
  {                                                                      \
    const bf16* Ab = As + (BUF) * 128 * LDT + (wm * 64 + r) * LDT + h * 8; \
    const bf16* Bb = Bs + (BUF) * 128 * LDT + (wn * 64 + r) * LDT + h * 8; \
    _Pragma("unroll") for (int s = 0; s < 4; ++s) {                      \
      s16x8 fa0 = *(const s16x8*)(Ab + s * 16);                          \
      s16x8 fa1 = *(const s16x8*)(Ab + 32 * LDT + s * 16);               \
      s16x8 fb0 = *(const s16x8*)(Bb + s * 16);                          \
      s16x8 fb1 = *(const s16x8*)(Bb + 32 * LDT + s * 16);               \
      acc[0][0] = MFMA32(fa0, fb0, acc[0][0]);                           \
      acc[0][1] = MFMA32(fa0, fb1, acc[0][1]);                           \
      acc[1][0] = MFMA32(fa1, fb0, acc[1][0]);                           \
      acc[1][1] = MFMA32(fa1, fb1, acc[1][1]);                           \
    }                                                                    \
  }
  GD_LOAD(a0, b0, 0)
  GD_LOAD(a1, b1, 1)
  GD_STORE(a0, b0, 0)
  __syncthreads();
  if (nk > 2) GD_LOAD(a0, b0, 2)
  for (int kt = 0; kt < nk; kt += 2) {
    SCHED_FENCE();
    GD_COMPUTE(0)
    SCHED_FENCE();
    GD_STORE(a1, b1, 1)
    if (kt + 3 < nk) GD_LOAD(a1, b1, kt + 3)
    __syncthreads();
    SCHED_FENCE();
    GD_COMPUTE(1)
    SCHED_FENCE();
    if (kt + 2 < nk) {
      GD_STORE(a0, b0, 0)
      if (kt + 4 < nk) GD_LOAD(a0, b0, kt + 4)
    }
    __syncthreads();
  }
#undef GD_LOAD
#undef GD_STORE
#undef GD_COMPUTE
}

template <class FA, class FB>
DI void gemm_main_dma(f32x16 (&acc)[2][2], FA fa, FB fb, int K, char* smem) {
  char* As = smem;
  char* Bs = smem + 32768;
  const int tid = TIDX, lane = tid & 63, w = tid >> 6, wm = w >> 1, wn = w & 1;
  const int r = lane & 31, h = lane >> 5;
  const bf16* ap[4];
  const bf16* bp[4];
#pragma unroll
  for (int i = 0; i < 4; ++i) {
    const int row = w * 32 + i * 8 + (lane >> 3);
    const int c = (lane & 7) ^ ((row >> 1) & 7);
    ap[i] = fa(row) + c * 8;
    bp[i] = fb(row) + c * 8;
  }
  const int ldst = (w * 256 + lane) * 16;
#define GM_DMA(BUF, T)                                                                                        \
  {                                                                                                           \
    const int k0_ = (T) * 64;                                                                                 \
    _Pragma("unroll") for (int i = 0; i < 4; ++i) {                                                           \
      __builtin_amdgcn_global_load_lds((const unsigned*)(ap[i] + k0_), (unsigned*)(As + (BUF) * 16384 + ldst + i * 1024), 16, 0, 0); \
      __builtin_amdgcn_global_load_lds((const unsigned*)(bp[i] + k0_), (unsigned*)(Bs + (BUF) * 16384 + ldst + i * 1024), 16, 0, 0); \
    }                                                                                                         \
  }
  const int xr = (r >> 1) & 7;
  const int arow = (wm * 64 + r) * 128, brow = (wn * 64 + r) * 128;
  GM_DMA(0, 0)
  asm volatile("s_waitcnt vmcnt(0)" ::: "memory");
  __syncthreads();
  const int nk = K / 64;
  for (int kt = 0; kt < nk; ++kt) {
    const int buf = kt & 1;
    if (kt + 1 < nk) GM_DMA(buf ^ 1, kt + 1)
    const char* Ab = As + buf * 16384 + arow;
    const char* Bb = Bs + buf * 16384 + brow;
#pragma unroll
    for (int s = 0; s < 4; ++s) {
      const int co = ((2 * s + h) ^ xr) * 16;
      s16x8 a0 = *(const s16x8*)(Ab + co);
      s16x8 a1 = *(const s16x8*)(Ab + 32 * 128 + co);
      s16x8 b0 = *(const s16x8*)(Bb + co);
      s16x8 b1 = *(const s16x8*)(Bb + 32 * 128 + co);
      acc[0][0] = MFMA32(a0, b0, acc[0][0]);
      acc[0][1] = MFMA32(a0, b1, acc[0][1]);
      acc[1][0] = MFMA32(a1, b0, acc[1][0]);
      acc[1][1] = MFMA32(a1, b1, acc[1][1]);
    }
    asm volatile("s_waitcnt vmcnt(0)" ::: "memory");
    __syncthreads();
  }
#undef GM_DMA
}

DI void gemm_main_dma_half(f32x16 (&acc)[2], const bf16* A, int lda, const bf16* B, int ldb, int K, int hf, char* smem) {
  char* As = smem;
  char* Bs = smem + 32768;
  const int tid = TIDX, lane = tid & 63, w = tid >> 6, wm = w >> 1, wn = w & 1;
  const int r = lane & 31, h = lane >> 5;
  const bf16* ap[4];
  const bf16* bp[2];
#pragma unroll
  for (int i = 0; i < 4; ++i) {
    const int row = w * 32 + i * 8 + (lane >> 3);
    ap[i] = A + (size_t)row * lda + ((lane & 7) ^ ((row >> 1) & 7)) * 8;
  }
#pragma unroll
  for (int i = 0; i < 2; ++i) {
    const int lrow = w * 16 + i * 8 + (lane >> 3);
    const int grow = (lrow >> 5) * 64 + hf * 32 + (lrow & 31);
    bp[i] = B + (size_t)grow * ldb + ((lane & 7) ^ ((lrow >> 1) & 7)) * 8;
  }
  const int lda_ = (w * 256 + lane) * 16, ldb_ = (w * 128 + lane) * 16;
#define GH_DMA(BUF, T)                                                                                        \
  {                                                                                                           \
    const int k0_ = (T) * 64;                                                                                 \
    _Pragma("unroll") for (int i = 0; i < 4; ++i)                                                             \
      __builtin_amdgcn_global_load_lds((const unsigned*)(ap[i] + k0_), (unsigned*)(As + (BUF) * 16384 + lda_ + i * 1024), 16, 0, 0); \
    _Pragma("unroll") for (int i = 0; i < 2; ++i)                                                             \
      __builtin_amdgcn_global_load_lds((const unsigned*)(bp[i] + k0_), (unsigned*)(Bs + (BUF) * 8192 + ldb_ + i * 1024), 16, 0, 0); \
  }
  const int xr = (r >> 1) & 7;
  const int arow = (wm * 64 + r) * 128, brow = (wn * 32 + r) * 128;
  GH_DMA(0, 0)
  asm volatile("s_waitcnt vmcnt(0)" ::: "memory");
  __syncthreads();
  const int nk = K / 64;
  for (int kt = 0; kt < nk; ++kt) {
    const int buf = kt & 1;
    if (kt + 1 < nk) GH_DMA(buf ^ 1, kt + 1)
    const char* Ab = As + buf * 16384 + arow;
    const char* Bb = Bs + buf * 8192 + brow;
#pragma unroll
    for (int s = 0; s < 4; ++s) {
      const int co = ((2 * s + h) ^ xr) * 16;
      s16x8 a0 = *(const s16x8*)(Ab + co);
      s16x8 a1 = *(const s16x8*)(Ab + 32 * 128 + co);
      s16x8 b0 = *(const s16x8*)(Bb + co);
      acc[0] = MFMA32(a0, b0, acc[0]);
      acc[1] = MFMA32(a1, b0, acc[1]);
    }
    asm volatile("s_waitcnt vmcnt(0)" ::: "memory");
    __syncthreads();
  }
#undef GH_DMA
}

template <class FA, class FB>
DI void gemm_wide(f32x16 (&acc)[2][4], FA fa, FB fb, int K, char* smem) {
  const int tid = TIDX, lane = tid & 63, w = tid >> 6, wm = w >> 1, wn = w & 1;
  const int r = lane & 31, h = lane >> 5;
  const bf16* ap[2];
  const bf16* bp[4];
#pragma unroll
  for (int i = 0; i < 2; ++i) {
    const int row = w * 32 + i * 16 + (lane >> 2);
    ap[i] = fa(row) + ((lane & 3) ^ ((row >> 2) & 3)) * 8;
  }
#pragma unroll
  for (int i = 0; i < 4; ++i) {
    const int row = w * 64 + i * 16 + (lane >> 2);
    bp[i] = fb(row) + ((lane & 3) ^ ((row >> 2) & 3)) * 8;
  }
  const int lda_ = (w * 128 + lane) * 16;
  const int ldb_ = 8192 + (w * 256 + lane) * 16;
#define GW_DMA(T)                                                                                                   \
  {                                                                                                                 \
    char* st_ = smem + ((T) % 3) * 24576;                                                                           \
    const int k0_ = (T) * 32;                                                                                       \
    _Pragma("unroll") for (int i = 0; i < 2; ++i)                                                                   \
      __builtin_amdgcn_global_load_lds((const unsigned*)(ap[i] + k0_), (unsigned*)(st_ + lda_ + i * 1024), 16, 0, 0); \
    _Pragma("unroll") for (int i = 0; i < 4; ++i)                                                                   \
      __builtin_amdgcn_global_load_lds((const unsigned*)(bp[i] + k0_), (unsigned*)(st_ + ldb_ + i * 1024), 16, 0, 0); \
  }
  const int xr = (r >> 2) & 3;
  const int arow = (wm * 64 + r) * 64;
  const int brow = 8192 + (wn * 64 + r) * 64;
  const int nt = K / 32;
  GW_DMA(0)
  if (nt > 1) GW_DMA(1)
  for (int t = 0; t < nt; ++t) {
    if (t + 1 < nt) asm volatile("s_waitcnt vmcnt(6)" ::: "memory");
    else asm volatile("s_waitcnt vmcnt(0)" ::: "memory");
    __syncthreads();
    if (t + 2 < nt) GW_DMA(t + 2)
    const char* st = smem + (t % 3) * 24576;
#pragma unroll
    for (int s = 0; s < 2; ++s) {
      const int co = ((2 * s + h) ^ xr) * 16;
      const s16x8 a0 = *(const s16x8*)(st + arow + co);
      const s16x8 a1 = *(const s16x8*)(st + arow + 32 * 64 + co);
#pragma unroll
      for (int hn = 0; hn < 2; ++hn) {
        const s16x8 b0 = *(const s16x8*)(st + brow + hn * 128 * 64 + co);
        const s16x8 b1 = *(const s16x8*)(st + brow + hn * 128 * 64 + 32 * 64 + co);
        acc[0][hn * 2 + 0] = MFMA32(a0, b0, acc[0][hn * 2 + 0]);
        acc[0][hn * 2 + 1] = MFMA32(a0, b1, acc[0][hn * 2 + 1]);
        acc[1][hn * 2 + 0] = MFMA32(a1, b0, acc[1][hn * 2 + 0]);
        acc[1][hn * 2 + 1] = MFMA32(a1, b1, acc[1][hn * 2 + 1]);
      }
    }
  }
  __syncthreads();
#undef GW_DMA
}

DI void accw_zero(f32x16 (&acc)[2][4]) {
#pragma unroll
  for (int a = 0; a < 2; ++a)
#pragma unroll
    for (int b = 0; b < 4; ++b)
#pragma unroll
      for (int i = 0; i < 16; ++i) acc[a][b][i] = 0.f;
}

DI void gemm_main_s(f32x16 (&acc)[2][2], const bf16* A, int lda, const bf16* B, int ldb, int K, char* smem) {
  bf16* As = (bf16*)smem;
  bf16* Bs = (bf16*)(smem + 2 * 128 * LDT * 2);
  const int tid = TIDX, lane = tid & 63, w = tid >> 6, wm = w >> 1, wn = w & 1;
  const int r = lane & 31, h = lane >> 5;
  const int lr = tid >> 3, kc = (tid & 7) * 8;
  const bf16* ap = A + (size_t)lr * lda + kc;
  const bf16* bp = B + (size_t)lr * ldb + kc;
  const size_t sa = (size_t)32 * lda, sb = (size_t)32 * ldb;
  u32x4 ra[4], rb[4];
#pragma unroll
  for (int i = 0; i < 4; ++i) {
    ra[i] = ldg16(ap + i * sa);
    rb[i] = ldg16(bp + i * sb);
  }
#pragma unroll
  for (int i = 0; i < 4; ++i) {
    *(u32x4*)(As + (lr + 32 * i) * LDT + kc) = ra[i];
    *(u32x4*)(Bs + (lr + 32 * i) * LDT + kc) = rb[i];
  }
  __syncthreads();
  const int nk = K / 64;
  for (int kt = 0; kt < nk; ++kt) {
    const int buf = kt & 1;
    const bool more = (kt + 1 < nk);
    if (more) {
      ap += 64; bp += 64;
#pragma unroll
      for (int i = 0; i < 4; ++i) {
        ra[i] = ldg16(ap + i * sa);
        rb[i] = ldg16(bp + i * sb);
      }
    }
    SCHED_FENCE();
    const bf16* Ab = As + buf * 128 * LDT + (wm * 64 + r) * LDT + h * 8;
    const bf16* Bb = Bs + buf * 128 * LDT + (wn * 64 + r) * LDT + h * 8;
#pragma unroll
    for (int s = 0; s < 4; ++s) {
      s16x8 a0 = *(const s16x8*)(Ab + s * 16);
      s16x8 a1 = *(const s16x8*)(Ab + 32 * LDT + s * 16);
      s16x8 b0 = *(const s16x8*)(Bb + s * 16);
      s16x8 b1 = *(const s16x8*)(Bb + 32 * LDT + s * 16);
      acc[0][0] = MFMA32(a0, b0, acc[0][0]);
      acc[0][1] = MFMA32(a0, b1, acc[0][1]);
      acc[1][0] = MFMA32(a1, b0, acc[1][0]);
      acc[1][1] = MFMA32(a1, b1, acc[1][1]);
    }
    SCHED_FENCE();
    if (more) {
      bf16* Aw = As + (buf ^ 1) * 128 * LDT;
      bf16* Bw = Bs + (buf ^ 1) * 128 * LDT;
#pragma unroll
      for (int i = 0; i < 4; ++i) {
        *(u32x4*)(Aw + (lr + 32 * i) * LDT + kc) = ra[i];
        *(u32x4*)(Bw + (lr + 32 * i) * LDT + kc) = rb[i];
      }
    }
    __syncthreads();
  }
}

DI void gemm_main_half(f32x16 (&acc)[2], const bf16* A, int lda, const bf16* B, int ldb, int K, int hf, char* smem) {
  bf16* As = (bf16*)smem;
  bf16* Bs = (bf16*)(smem + 2 * 128 * LDT * 2);
  const int tid = TIDX, lane = tid & 63, w = tid >> 6, wm = w >> 1, wn = w & 1;
  const int r = lane & 31, h = lane >> 5;
  const int lr = tid >> 3, kc = (tid & 7) * 8;
  const bf16* ap = A + (size_t)lr * lda + kc;
  const bf16* bp = B + (size_t)(hf * 32 + lr) * ldb + kc;
  const size_t sa = (size_t)32 * lda, sb = (size_t)64 * ldb;
  u32x4 ra[4], rb[2];
#pragma unroll
  for (int i = 0; i < 4; ++i) ra[i] = ldg16(ap + i * sa);
#pragma unroll
  for (int i = 0; i < 2; ++i) rb[i] = ldg16(bp + i * sb);
#pragma unroll
  for (int i = 0; i < 4; ++i) *(u32x4*)(As + (lr + 32 * i) * LDT + kc) = ra[i];
#pragma unroll
  for (int i = 0; i < 2; ++i) *(u32x4*)(Bs + (lr + 32 * i) * LDT + kc) = rb[i];
  __syncthreads();
  const int nk = K / 64;
  for (int kt = 0; kt < nk; ++kt) {
    const int buf = kt & 1;
    const bool more = (kt + 1 < nk);
    if (more) {
      ap += 64; bp += 64;
#pragma unroll
      for (int i = 0; i < 4; ++i) ra[i] = ldg16(ap + i * sa);
#pragma unroll
      for (int i = 0; i < 2; ++i) rb[i] = ldg16(bp + i * sb);
    }
    SCHED_FENCE();
    const bf16* Ab = As + buf * 128 * LDT + (wm * 64 + r) * LDT + h * 8;
    const bf16* Bb = Bs + buf * 128 * LDT + (wn * 32 + r) * LDT + h * 8;
#pragma unroll
    for (int s = 0; s < 4; ++s) {
      s16x8 a0 = *(const s16x8*)(Ab + s * 16);
      s16x8 a1 = *(const s16x8*)(Ab + 32 * LDT + s * 16);
      s16x8 b0 = *(const s16x8*)(Bb + s * 16);
      acc[0] = MFMA32(a0, b0, acc[0]);
      acc[1] = MFMA32(a1, b0, acc[1]);
    }
    SCHED_FENCE();
    if (more) {
      bf16* Aw = As + (buf ^ 1) * 128 * LDT;
      bf16* Bw = Bs + (buf ^ 1) * 128 * LDT;
#pragma unroll
      for (int i = 0; i < 4; ++i) *(u32x4*)(Aw + (lr + 32 * i) * LDT + kc) = ra[i];
#pragma unroll
      for (int i = 0; i < 2; ++i) *(u32x4*)(Bw + (lr + 32 * i) * LDT + kc) = rb[i];
    }
    __syncthreads();
  }
}

DI void acc_zero(f32x16 (&acc)[2][2]) {
#pragma unroll
  for (int a = 0; a < 2; ++a)
#pragma unroll
    for (int b = 0; b < 2; ++b)
#pragma unroll
      for (int i = 0; i < 16; ++i) acc[a][b][i] = 0.f;
}

DI void acc_to_lds(const f32x16 (&acc)[2][2], float* Cs) {
  const int lane = TIDX & 63, w = TIDX >> 6, wm = w >> 1, wn = w & 1, r = lane & 31, h = lane >> 5;
#pragma unroll
  for (int tm = 0; tm < 2; ++tm)
#pragma unroll
    for (int tn = 0; tn < 2; ++tn)
#pragma unroll
      for (int i = 0; i < 16; ++i) Cs[(wm * 64 + tm * 32 + crow(i, h)) * CLD + wn * 64 + tn * 32 + r] = acc[tm][tn][i];
}

template <int HN>
DI void accw_to_lds(const f32x16 (&acc)[2][4], float* Cs) {
  const int lane = TIDX & 63, w = TIDX >> 6, wm = w >> 1, wn = w & 1, r = lane & 31, h = lane >> 5;
#pragma unroll
  for (int tm = 0; tm < 2; ++tm)
#pragma unroll
    for (int tn = 0; tn < 2; ++tn)
#pragma unroll
      for (int i = 0; i < 16; ++i) Cs[(wm * 64 + tm * 32 + crow(i, h)) * CLD + wn * 64 + tn * 32 + r] = acc[tm][HN * 2 + tn][i];
}

DI void store_tile_bf16(const float* Cs, bf16* dst, size_t ld, int mvalid, float scale) {
  for (int c = TIDX; c < 2048; c += 256) {
    const int row = c >> 4, cc = (c & 15) * 8;
    if (row < mvalid) {
      const float* s = Cs + row * CLD + cc;
      u32x4 v;
      v[0] = pack2(s[0] * scale, s[1] * scale);
      v[1] = pack2(s[2] * scale, s[3] * scale);
      v[2] = pack2(s[4] * scale, s[5] * scale);
      v[3] = pack2(s[6] * scale, s[7] * scale);
      *(u32x4*)(dst + (size_t)row * ld + cc) = v;
    }
  }
}

DI float* resid_row(const Params& p, int tok) {
  const int b = tok / TT, t = tok - b * TT;
  return (t < CTXL) ? (float*)(p.ws + OFF_XC) + ((size_t)b * CTXL + t) * DM : p.out + ((size_t)b * SEQ + (t - CTXL)) * DM;
}
DI const float* mod_vec(const Params& p, int l, int tok, int which) {
  const int b = tok / TT, t = tok - b * TT;
  const int m = (t < CTXL) ? 4 : b;
  return (const float*)(p.ws + OFF_MOD) + ((size_t)(l * 5 + m) * 6 + which) * DM;
}
DI float wave_sum(float v) {
#pragma unroll
  for (int o = 32; o >= 1; o >>= 1) v += __shfl_xor(v, o, 64);
  return v;
}
DI bf16* wl(const Params& p, int l, size_t off) { return (bf16*)(p.ws + OFF_W) + (size_t)l * WL_TOTAL + off; }

DI void prep_mod_job(const Params& p, int j, char* smem) {
  float* sc = (float*)smem;
  float* part = (float*)(smem + 20480);
  const int l = j / 24, nb = j % 24, tid = TIDX, lane = tid & 63, w = tid >> 6;
  for (int idx = tid; idx < 5120; idx += 256) {
    const int m = idx >> 10, k = idx & 1023;
    const float v = (m < 4) ? p.in[I_C][m * 1024 + k] : p.in[I_CCTX][k];
    sc[idx] = siluf_(v);
  }
  __syncthreads();
  const float* W = p.in[I_ADAW] + (size_t)l * 1024 * 6144 + nb * 256 + lane;
  float a[5][4];
#pragma unroll
  for (int m = 0; m < 5; ++m)
#pragma unroll
    for (int c = 0; c < 4; ++c) a[m][c] = 0.f;
#pragma unroll 4
  for (int kk = 0; kk < 256; ++kk) {
    const int k = w * 256 + kk;
    float wv[4];
#pragma unroll
    for (int c = 0; c < 4; ++c) wv[c] = W[(size_t)k * 6144 + 64 * c];
#pragma unroll
    for (int m = 0; m < 5; ++m) {
      const float sv = sc[m * 1024 + k];
#pragma unroll
      for (int c = 0; c < 4; ++c) a[m][c] += sv * wv[c];
    }
  }
#pragma unroll
  for (int m = 0; m < 5; ++m)
#pragma unroll
    for (int c = 0; c < 4; ++c) part[(w * 5 + m) * 256 + lane + 64 * c] = a[m][c];
  __syncthreads();
  const int n = nb * 256 + tid;
  const float bb = p.in[I_ADAB][l * 6144 + n];
  float* M = (float*)(p.ws + OFF_MOD) + (size_t)l * 5 * 6144 + n;
#pragma unroll
  for (int m = 0; m < 5; ++m)
    M[m * 6144] = part[(0 * 5 + m) * 256 + tid] + part[(1 * 5 + m) * 256 + tid] + part[(2 * 5 + m) * 256 + tid] + part[(3 * 5 + m) * 256 + tid] + bb;
  __syncthreads();
}

DI void prep_s5_job(const Params& p, int j) {
  const int idx = j * 256 + TIDX;
  const int ldg = idx >> 6, pp = idx & 63;
  const float dt = expf(p.in[I_LDT][ldg]);
  const float are = p.in[I_ARE][idx], aim = p.in[I_AIM][idx];
  const float mag = expf(are * dt);
  float sn, cs;
  sincos_cw(aim * dt, sn, cs);
  const float abr = mag * cs, abi = mag * sn;
  const float den = are * are + aim * aim;
  const float fre = ((abr - 1.f) * are + abi * aim) / den;
  const float fim = (abi * are - (abr - 1.f) * aim) / den;
  float* BBR = (float*)(p.ws + OFF_BBR);
  float* BBI = (float*)(p.ws + OFF_BBI);
  for (int hh = 0; hh < 16; ++hh) {
    const float br = p.in[I_BRE][(size_t)idx * 16 + hh], bi = p.in[I_BIM][(size_t)idx * 16 + hh];
    BBR[(size_t)idx * 16 + hh] = fre * br - fim * bi;
    BBI[(size_t)idx * 16 + hh] = fre * bi + fim * br;
  }
  float2* PW = (float2*)(p.ws + OFF_PWR);
  float pr = 1.f, pi = 0.f;
  for (int tau = 0; tau <= 32; ++tau) {
    PW[((size_t)ldg * 33 + tau) * 64 + pp] = make_float2(pr, pi);
    const float nr = pr * abr - pi * abi, ni = pr * abi + pi * abr;
    pr = nr; pi = ni;
  }
}

DI void prep_wt_job(const Params& p, int jj, char* smem) {
  float* tile = (float*)smem;
  const int l = jj / 4016;
  int r = jj % 4016;
  int mat = 0;
  const int cnt[8] = {1376, 64, 128, 64, 256, 1408, 704, 16};
#pragma unroll
  for (int m = 0; m < 8; ++m) {
    if (mat == m && r >= cnt[m]) { r -= cnt[m]; mat = m + 1; }
  }
  const float* src; int K, sld; size_t doff;
  switch (mat) {
    case 0: src = p.in[I_WIN] + (size_t)l * 1024 * DIN; K = 1024; sld = DIN; doff = WL_WIN; break;
    case 1: src = p.in[I_WBA] + (size_t)l * 256 * 1024; K = 256; sld = 1024; doff = WL_BRA; break;
    case 2: src = p.in[I_WBG] + (size_t)l * 512 * 1024; K = 512; sld = 1024; doff = WL_BRG; break;
    case 3: src = p.in[I_WBS] + (size_t)l * 256 * 1024; K = 256; sld = 1024; doff = WL_BRS; break;
    case 4: src = p.in[I_WOUT] + (size_t)l * 1024 * 1024; K = 1024; sld = 1024; doff = WL_WOUT; break;
    case 5: src = p.in[I_UP] + (size_t)l * 1024 * 5632; K = 1024; sld = 5632; doff = WL_UP; break;
    case 6: src = p.in[I_DOWN] + (size_t)l * 2816 * 1024; K = 2816; sld = 1024; doff = WL_DOWN; break;
    default: src = p.in[I_GLUW] + (size_t)l * 256 * 256; K = 256; sld = 256; doff = WL_GLU; break;
  }
  const int kt = K / 64;
  const int n0 = (r / kt) * 64, k0 = (r % kt) * 64;
  const int tid = TIDX;
  {
    const int nn = tid & 63;
    const int np = n0 + nn;
    int col;
    if (mat == 0) {
      if (np < 2048) col = np;
      else if (np < 2304) col = 2080 + (np - 2048);
      else if (np < 2336) col = 2048 + (np - 2304);
      else if (np < 2432) col = -1;
      else col = 2336 + (np - 2432);
    } else if (mat == 5) {
      const int jb = np >> 7, c = np & 127;
      col = (c < 64) ? (jb * 64 + c) : (DFF + jb * 64 + (c - 64));
    } else col = np;
#pragma unroll 4
    for (int kk = tid >> 6; kk < 64; kk += 4) tile[kk * 65 + nn] = (col >= 0) ? src[(size_t)(k0 + kk) * sld + col] : 0.f;
  }
  __syncthreads();
  {
    const int nn = tid >> 2, kq = (tid & 3) * 16;
    bf16* d = wl(p, l, doff) + (size_t)(n0 + nn) * K + k0 + kq;
    u32x4 v0, v1;
#pragma unroll
    for (int e = 0; e < 4; ++e) {
      v0[e] = pack2(tile[(kq + 2 * e) * 65 + nn], tile[(kq + 2 * e + 1) * 65 + nn]);
      v1[e] = pack2(tile[(kq + 8 + 2 * e) * 65 + nn], tile[(kq + 8 + 2 * e + 1) * 65 + nn]);
    }
    *(u32x4*)d = v0;
    *(u32x4*)(d + 8) = v1;
  }
  __syncthreads();
}

template <int MODE>
DI void row_job(const Params& p, int l, int tok) {
  const int lane = TIDX & 63;
  float x[16];
  float* xr = resid_row(p, tok);
  if (MODE == 0) {
    const int b = tok / TT, t = tok - b * TT;
    const float* src = (t < CTXL) ? p.in[I_CTX] + ((size_t)b * CTXL + t) * DM : p.in[I_X] + ((size_t)b * SEQ + (t - CTXL)) * DM;
#pragma unroll
    for (int i = 0; i < 4; ++i) {
      const f32x4 v = *(const f32x4*)(src + lane * 4 + 256 * i);
      x[4 * i] = v[0]; x[4 * i + 1] = v[1]; x[4 * i + 2] = v[2]; x[4 * i + 3] = v[3];
      *(f32x4*)(xr + lane * 4 + 256 * i) = v;
    }
  } else {
    const bf16* yr = (const bf16*)(p.ws + OFF_H) + (size_t)tok * DM;
    const float* gpost = p.in[MODE == 1 ? I_NMPOST : I_NFPOST] + l * DM;
    const float* mg = mod_vec(p, l, tok, MODE == 1 ? 2 : 5);
    float y[16];
    float ss = 0.f;
#pragma unroll
    for (int i = 0; i < 4; ++i) {
      const u32x2 u = *(const u32x2*)(yr + lane * 4 + 256 * i);
      y[4 * i] = bflo(u[0]); y[4 * i + 1] = bfhi(u[0]); y[4 * i + 2] = bflo(u[1]); y[4 * i + 3] = bfhi(u[1]);
#pragma unroll
      for (int e = 0; e < 4; ++e) ss += y[4 * i + e] * y[4 * i + e];
    }
    ss = wave_sum(ss);
    const float rstd = rsqrtf(ss * (1.f / DM) + EPSF);
#pragma unroll
    for (int i = 0; i < 4; ++i) {
      f32x4 v = *(const f32x4*)(xr + lane * 4 + 256 * i);
      const f32x4 g = *(const f32x4*)(gpost + lane * 4 + 256 * i);
      const f32x4 m = *(const f32x4*)(mg + lane * 4 + 256 * i);
#pragma unroll
      for (int e = 0; e < 4; ++e) { v[e] += m[e] * (y[4 * i + e] * rstd * g[e]); x[4 * i + e] = v[e]; }
      *(f32x4*)(xr + lane * 4 + 256 * i) = v;
    }
  }
  if (MODE == 2 && l == NL - 1) return;
  const int ln = (MODE == 2) ? l + 1 : l;
  const float* gpre = p.in[MODE == 1 ? I_NFPRE : I_NMPRE] + ln * DM;
  const float* sh = mod_vec(p, ln, tok, MODE == 1 ? 3 : 0);
  const float* scv = mod_vec(p, ln, tok, MODE == 1 ? 4 : 1);
  float ss = 0.f;
#pragma unroll
  for (int i = 0; i < 16; ++i) ss += x[i] * x[i];
  ss = wave_sum(ss);
  const float rstd = rsqrtf(ss * (1.f / DM) + EPSF);
  bf16* hr = (bf16*)(p.ws + OFF_H) + (size_t)tok * DM;
#pragma unroll
  for (int i = 0; i < 4; ++i) {
    const f32x4 g = *(const f32x4*)(gpre + lane * 4 + 256 * i);
    const f32x4 s1 = *(const f32x4*)(sh + lane * 4 + 256 * i);
    const f32x4 s2 = *(const f32x4*)(scv + lane * 4 + 256 * i);
    float o[4];
#pragma unroll
    for (int e = 0; e < 4; ++e) o[e] = (x[4 * i + e] * rstd * g[e]) * (1.f + s2[e]) + s1[e];
    u32x2 u;
    u[0] = pack2(o[0], o[1]); u[1] = pack2(o[2], o[3]);
    *(u32x2*)(hr + lane * 4 + 256 * i) = u;
  }
}

template <int MODE>
DI void row_phase(const Params& p, int l, int bid, int G) {
  const int lane = TIDX & 63;
  const int wg = bid * 4 + (TIDX >> 6), nw = G * 4;
  const int R = (NTOK + nw - 1) / nw;
  const int t0 = wg * R, t1 = min(NTOK, t0 + R);
  if (t0 >= t1) return;
  const bool has_next = !(MODE == 2 && l == NL - 1);
  const int ln = (MODE == 2) ? l + 1 : l;
  f32x4 gpost[4], gpre[4], mg[4], sh[4], scl[4];
#pragma unroll
  for (int i = 0; i < 4; ++i) {
    if (MODE != 0) gpost[i] = *(const f32x4*)(p.in[MODE == 1 ? I_NMPOST : I_NFPOST] + l * DM + lane * 4 + 256 * i);
    if (has_next) gpre[i] = *(const f32x4*)(p.in[MODE == 1 ? I_NFPRE : I_NMPRE] + ln * DM + lane * 4 + 256 * i);
  }
  int cur_m = -1;
  u32x2 yb[4], yn[4];
  f32x4 xb[4], xn[4];
  const bf16* Hb = (const bf16*)(p.ws + OFF_H);
#define ROW_LOAD(TOK, YY, XX)                                                                              \
  {                                                                                                        \
    const int b_ = (TOK) / TT, t_ = (TOK) - b_ * TT;                                                       \
    const float* src_ = (MODE == 0) ? ((t_ < CTXL) ? p.in[I_CTX] + ((size_t)b_ * CTXL + t_) * DM           \
                                                   : p.in[I_X] + ((size_t)b_ * SEQ + (t_ - CTXL)) * DM)    \
                                    : resid_row(p, (TOK));                                                 \
    _Pragma("unroll") for (int i = 0; i < 4; ++i) {                                                        \
      XX[i] = *(const f32x4*)(src_ + lane * 4 + 256 * i);                                                  \
      if (MODE != 0) YY[i] = *(const u32x2*)(Hb + (size_t)(TOK) * DM + lane * 4 + 256 * i);                \
    }                                                                                                      \
  }
  ROW_LOAD(t0, yb, xb)
  for (int tok = t0; tok < t1; ++tok) {
    if (tok + 1 < t1) ROW_LOAD(tok + 1, yn, xn)
    const int b = tok / TT, t = tok - b * TT;
    const int m = (t < CTXL) ? 4 : b;
    if (m != cur_m) {
      cur_m = m;
      const float* Mv = (const float*)(p.ws + OFF_MOD);
#pragma unroll
      for (int i = 0; i < 4; ++i) {
        if (MODE != 0) mg[i] = *(const f32x4*)(Mv + ((size_t)(l * 5 + m) * 6 + (MODE == 1 ? 2 : 5)) * DM + lane * 4 + 256 * i);
        if (has_next) {
          sh[i] = *(const f32x4*)(Mv + ((size_t)(ln * 5 + m) * 6 + (MODE == 1 ? 3 : 0)) * DM + lane * 4 + 256 * i);
          scl[i] = *(const f32x4*)(Mv + ((size_t)(ln * 5 + m) * 6 + (MODE == 1 ? 4 : 1)) * DM + lane * 4 + 256 * i);
        }
      }
    }
    float* xr = resid_row(p, tok);
    f32x4 x[4];
    if (MODE == 0) {
#pragma unroll
      for (int i = 0; i < 4; ++i) { x[i] = xb[i]; *(f32x4*)(xr + lane * 4 + 256 * i) = x[i]; }
    } else {
      float y[16];
      float ss = 0.f;
#pragma unroll
      for (int i = 0; i < 4; ++i) {
        y[4 * i] = bflo(yb[i][0]); y[4 * i + 1] = bfhi(yb[i][0]); y[4 * i + 2] = bflo(yb[i][1]); y[4 * i + 3] = bfhi(yb[i][1]);
#pragma unroll
        for (int e = 0; e < 4; ++e) ss += y[4 * i + e] * y[4 * i + e];
      }
      ss = wave_sum(ss);
      const float rstd = rsqrtf(ss * (1.f / DM) + EPSF);
#pragma unroll
      for (int i = 0; i < 4; ++i) {
        f32x4 v = xb[i];
#pragma unroll
        for (int e = 0; e < 4; ++e) v[e] += mg[i][e] * (y[4 * i + e] * rstd * gpost[i][e]);
        x[i] = v;
        *(f32x4*)(xr + lane * 4 + 256 * i) = v;
      }
    }
    if (has_next) {
      float ss = 0.f;
#pragma unroll
      for (int i = 0; i < 4; ++i)
#pragma unroll
        for (int e = 0; e < 4; ++e) ss += x[i][e] * x[i][e];
      ss = wave_sum(ss);
      const float rstd = rsqrtf(ss * (1.f / DM) + EPSF);
      bf16* hr = (bf16*)(p.ws + OFF_H) + (size_t)tok * DM;
#pragma unroll
      for (int i = 0; i < 4; ++i) {
        float o[4];
#pragma unroll
        for (int e = 0; e < 4; ++e) o[e] = (x[i][e] * rstd * gpre[i][e]) * (1.f + scl[i][e]) + sh[i][e];
        u32x2 u;
        u[0] = pack2(o[0], o[1]); u[1] = pack2(o[2], o[3]);
        *(u32x2*)(hr + lane * 4 + 256 * i) = u;
      }
    }
#pragma unroll
    for (int i = 0; i < 4; ++i) { yb[i] = yn[i]; xb[i] = xn[i]; }
  }
#undef ROW_LOAD
}

DI void ktab_phase(const Params& p, int bid, int G, int l_lo, int l_hi) {
  const float* BBR = (const float*)(p.ws + OFF_BBR);
  const float* BBI = (const float*)(p.ws + OFF_BBI);
  const float2* PW = (const float2*)(p.ws + OFF_PWR);
  float* KT = (float*)(p.ws + OFF_KTAB);
  const int per_layer = 16 * 2 * 32 * 256;
  for (int idx = l_lo * per_layer + bid * 256 + TIDX; idx < l_hi * per_layer; idx += G * 256) {
    const int hp = idx & 15, hh = (idx >> 4) & 15, tau = (idx >> 8) & 31, d = (idx >> 13) & 1, g = (idx >> 14) & 15, l = idx >> 18;
    const int ldg = (l * 2 + d) * 16 + g;
    const float* cre = p.in[I_CRE] + ((size_t)ldg * 16 + hh) * 64;
    const float* cim = p.in[I_CIM] + ((size_t)ldg * 16 + hh) * 64;
    float acc = 0.f;
    for (int pp = 0; pp < 64; ++pp) {
      const float2 pw = PW[((size_t)ldg * 33 + tau) * 64 + pp];
      const float br = BBR[((size_t)ldg * 64 + pp) * 16 + hp], bi = BBI[((size_t)ldg * 64 + pp) * 16 + hp];
      const float zr = pw.x * br - pw.y * bi, zi = pw.x * bi + pw.y * br;
      acc += cre[pp] * zr - cim[pp] * zi;
    }
    KT[idx] = acc;
  }
}

DI void s5mat_phase(const Params& p, int l, int bid, int G) {
  const float* BBR = (const float*)(p.ws + OFF_BBR);
  const float* BBI = (const float*)(p.ws + OFF_BBI);
  const float2* PW = (const float2*)(p.ws + OFF_PWR);
  const float* KT = (const float*)(p.ws + OFF_KTAB);
  bf16* T5 = (bf16*)(p.ws + OFF_T5);
  bf16* E5 = (bf16*)(p.ws + OFF_E5);
  bf16* F5 = (bf16*)(p.ws + OFF_F5);
  const int nT = 16 * 512 * 64, nE = 16 * 512 * 32, nF = 16 * 256 * 64;
  for (int it = bid * 256 + TIDX; it < nT + nE + nF; it += G * 256) {
    float v[8];
    bf16* dst;
    if (it < nT) {
      const int k8 = it & 63, n = (it >> 6) & 511, g = it >> 15;
      const int i = n >> 4, hh = n & 15, j = k8 >> 1, hp0 = (k8 & 1) * 8;
#pragma unroll
      for (int e = 0; e < 8; ++e) {
        const int hp = hp0 + e;
        float a = 0.f;
        if (j <= i) a += KT[((((size_t)l * 16 + g) * 2 + 0) * 32 + (i - j)) * 256 + hh * 16 + hp];
        if (j >= i) a += KT[((((size_t)l * 16 + g) * 2 + 1) * 32 + (j - i)) * 256 + hh * 16 + hp];
        if (i == j && hh == hp) a += p.in[I_S5D][l * 256 + g * 16 + hh];
        v[e] = a;
      }
      dst = T5 + ((size_t)g * 512 + n) * 512 + k8 * 8;
    } else if (it < nT + nE) {
      const int q = it - nT;
      const int k8 = q & 31, n = (q >> 5) & 511, g = q >> 14;
      const int i = n >> 4, hh = n & 15;
      const int k0 = k8 * 8, d = k0 >> 7, ri = (k0 >> 6) & 1, p0 = k0 & 63;
      const int ldg = (l * 2 + d) * 16 + g;
      const int ex = d ? (32 - i) : (i + 1);
#pragma unroll
      for (int e = 0; e < 8; ++e) {
        const int pp = p0 + e;
        const float2 pw = PW[((size_t)ldg * 33 + ex) * 64 + pp];
        const float cr = p.in[I_CRE][((size_t)ldg * 16 + hh) * 64 + pp], ci = p.in[I_CIM][((size_t)ldg * 16 + hh) * 64 + pp];
        const float zr = cr * pw.x - ci * pw.y, zi = cr * pw.y + ci * pw.x;
        v[e] = ri ? -zi : zr;
      }
      dst = E5 + ((size_t)g * 512 + n) * 256 + k0;
    } else {
      const int q = it - nT - nE;
      const int k8 = q & 63, n = (q >> 6) & 255, g = q >> 14;
      const int d = n >> 7, ri = (n >> 6) & 1, pp = n & 63;
      const int j = k8 >> 1, hp0 = (k8 & 1) * 8;
      const int ldg = (l * 2 + d) * 16 + g;
      const int ex = d ? j : (31 - j);
      const float2 pw = PW[((size_t)ldg * 33 + ex) * 64 + pp];
#pragma unroll
      for (int e = 0; e < 8; ++e) {
        const float br = BBR[((size_t)ldg * 64 + pp) * 16 + hp0 + e], bi = BBI[((size_t)ldg * 64 + pp) * 16 + hp0 + e];
        v[e] = ri ? (pw.x * bi + pw.y * br) : (pw.x * br - pw.y * bi);
      }
      dst = F5 + ((size_t)g * 256 + n) * 512 + k8 * 8;
    }
    u32x4 u;
    u[0] = pack2(v[0], v[1]); u[1] = pack2(v[2], v[3]); u[2] = pack2(v[4], v[5]); u[3] = pack2(v[6], v[7]);
    *(u32x4*)dst = u;
  }
}

DI void proj_epi(const Params& p, int l, int mt, int nt, char* smem);
DI void proj_wide(const Params& p, int l, int mt, int np, char* smem) {
  const bf16* H = (const bf16*)(p.ws + OFF_H) + (size_t)mt * 128 * DM;
  const bf16* W = wl(p, l, WL_WIN) + (size_t)np * 256 * DM;
  if (np == 9) {
    f32x16 acc1[2][2];
    acc_zero(acc1);
    gemm_main_dma(acc1, [&](int r) { return H + (size_t)r * DM; }, [&](int r) { return W + (size_t)r * DM; }, DM, smem);
    acc_to_lds(acc1, (float*)smem);
    __syncthreads();
    proj_epi(p, l, mt, 18, smem);
    return;
  }
  f32x16 acc[2][4];
  accw_zero(acc);
  gemm_wide(acc, [&](int r) { return H + (size_t)r * DM; }, [&](int r) { return W + (size_t)r * DM; }, DM, smem);
  float* Cs = (float*)smem;
  accw_to_lds<0>(acc, Cs);
  __syncthreads();
  proj_epi(p, l, mt, np * 2, smem);
  if (np * 2 + 1 < 19) {
    accw_to_lds<1>(acc, Cs);
    __syncthreads();
    proj_epi(p, l, mt, np * 2 + 1, smem);
  }
}
DI void proj_epi(const Params& p, int l, int mt, int nt, char* smem) {
  float* Cs = (float*)smem;
  const int tid = TIDX;
  const int tok0 = mt * 128;
  const int b = tok0 / TT, t0 = tok0 - b * TT;
  if (nt <= 2) {
    const int row = tid >> 1, seg = tid & 1;
    float* c = Cs + row * CLD + seg * 64;
    const float* gn = p.in[nt < 2 ? I_QN : I_KN] + l * 64;
    float ss = 0.f;
#pragma unroll 8
    for (int i = 0; i < 64; ++i) ss += c[i] * c[i];
    const float rstd = rsqrtf(ss * (1.f / 64.f) + EPSF);
    const int t = t0 + row;
    const bool lat = t >= CTXL;
    const int s = t - CTXL;
#pragma unroll 1
    for (int ax = 0; ax < 2; ++ax) {
      const float pos = (float)(ax ? (s & 63) : (s >> 6));
#pragma unroll 2
      for (int f = 0; f < 16; ++f) {
        float x1 = c[ax * 32 + f] * rstd * gn[ax * 32 + f];
        float x2 = c[ax * 32 + 16 + f] * rstd * gn[ax * 32 + 16 + f];
        if (lat) {
          const float invf = exp2f(-(float)f * (13.287712379549449f / 16.f));
          float sn, cs;
          sincos_cw(pos * invf, sn, cs);
          const float y1 = x1 * cs - x2 * sn, y2 = x2 * cs + x1 * sn;
          x1 = y1; x2 = y2;
        }
        c[ax * 32 + f] = x1;
        c[ax * 32 + 16 + f] = x2;
      }
    }
    __syncthreads();
    if (nt < 2) store_tile_bf16(Cs, (bf16*)(p.ws + OFF_Q) + (size_t)tok0 * 256 + nt * 128, 256, 128, 0.125f * 1.4426950408889634f);
    else store_tile_bf16(Cs, (bf16*)(p.ws + OFF_K) + (size_t)tok0 * 128, 128, 128, 1.f);
  } else if (nt == 3 || (nt >= 8 && nt <= 11)) {
    for (int c = tid; c < 2048; c += 256) {
      const int col = c & 127, rc = (c >> 7) * 8;
      u32x4 u;
#pragma unroll
      for (int e = 0; e < 4; ++e) u[e] = pack2(Cs[(rc + 2 * e) * CLD + col], Cs[(rc + 2 * e + 1) * CLD + col]);
      bf16* dst;
      if (nt == 3) dst = (bf16*)(p.ws + OFF_VT) + ((size_t)(b * 2 + (col >> 6)) * 64 + (col & 63)) * TT + t0 + rc;
      else dst = (bf16*)(p.ws + OFF_GVT) + ((size_t)(b * 4 + (nt - 8)) * 128 + col) * TT + t0 + rc;
      *(u32x4*)dst = u;
    }
  } else if (nt == 4 || nt == 5) {
    store_tile_bf16(Cs, (bf16*)(p.ws + OFF_GQ) + (size_t)tok0 * 256 + (nt - 4) * 128, 256, 128, 0.125f);
  } else if (nt == 6 || nt == 7) {
    store_tile_bf16(Cs, (bf16*)(p.ws + OFF_GK) + (size_t)tok0 * 256 + (nt - 6) * 128, 256, 128, 1.f);
  } else if (nt >= 12 && nt <= 15) {
    store_tile_bf16(Cs, (bf16*)(p.ws + OFF_GR) + (size_t)tok0 * 512 + (nt - 12) * 128, 512, 128, 1.f);
  } else if (nt == 16 || nt == 17) {
    for (int c = tid; c < 2048; c += 256) {
      const int row = c >> 4, c8 = c & 15;
      const float* s = Cs + row * CLD + c8 * 8;
      u32x4 u;
#pragma unroll
      for (int e = 0; e < 4; ++e) u[e] = pack2(s[2 * e], s[2 * e + 1]);
      const int ch = (nt - 16) * 128 + c8 * 8;
      bf16* dst = (bf16*)(p.ws + OFF_SU) + ((size_t)(b * 16 + (ch >> 4)) * TT + t0 + row) * 16 + (ch & 15);
      *(u32x4*)dst = u;
    }
  } else {
    for (int c = tid; c < 128 * 8; c += 256) {
      const int row = c >> 3, c4 = (c & 7) * 4;
      const float* s = Cs + row * CLD + c4;
      f32x4 v = {s[0], s[1], s[2], s[3]};
      *(f32x4*)((float*)(p.ws + OFF_LOW) + (size_t)(tok0 + row) * 32 + c4) = v;
    }
  }
  __syncthreads();
}

DI void attn_unit(const Params& p, int u, char* smem) {
  int b, head, tok0, nkt;
  if (u < 1024) { b = u >> 8; head = (u >> 6) & 3; tok0 = b * TT + CTXL + (u & 63) * 128; nkt = TT / 128; }
  else { const int v = u - 1024; b = v >> 3; head = (v >> 1) & 3; tok0 = b * TT + (v & 1) * 128; nkt = CTXL / 128; }
  const int kvh = head >> 1;
  const int tid = TIDX, lane = tid & 63, w = tid >> 6, r = lane & 31, h = lane >> 5;
  const bf16* Qp = (const bf16*)(p.ws + OFF_Q) + (size_t)(tok0 + w * 32 + r) * 256 + head * 64 + h * 8;
  s16x8 qf[4];
#pragma unroll
  for (int s = 0; s < 4; ++s) qf[s] = __builtin_bit_cast(s16x8, ldg16(Qp + s * 16));
  const bf16* kp[2];
  const bf16* vp[2];
#pragma unroll
  for (int i = 0; i < 2; ++i) {
    const int row = w * 16 + i * 8 + (lane >> 3);
    const int c = (lane & 7) ^ ((row >> 1) & 7);
    kp[i] = (const bf16*)(p.ws + OFF_K) + ((size_t)b * TT + row) * 128 + kvh * 64 + c * 8;
    vp[i] = (const bf16*)(p.ws + OFF_VT) + ((size_t)(b * 2 + kvh) * 64 + row) * TT + c * 8;
  }
  const int ldst = (w * 128 + lane) * 16;
#define AT_DMA(BUF, T)                                                                                              \
  {                                                                                                                 \
    char* sb_ = smem + (BUF) * 32768;                                                                               \
    _Pragma("unroll") for (int hh = 0; hh < 2; ++hh)                                                                \
    _Pragma("unroll") for (int i = 0; i < 2; ++i) {                                                                 \
      __builtin_amdgcn_global_load_lds((const unsigned*)(kp[i] + (size_t)((T) * 128 + hh * 64) * 128), (unsigned*)(sb_ + hh * 8192 + ldst + i * 1024), 16, 0, 0); \
      __builtin_amdgcn_global_load_lds((const unsigned*)(vp[i] + (T) * 128 + hh * 64), (unsigned*)(sb_ + 16384 + hh * 8192 + ldst + i * 1024), 16, 0, 0);        \
    }                                                                                                               \
  }
  const int xr = (r >> 1) & 7;
  AT_DMA(0, 0)
  asm volatile("s_waitcnt vmcnt(0)" ::: "memory");
  __syncthreads();
  f32x16 oacc[2];
#pragma unroll
  for (int i = 0; i < 16; ++i) { oacc[0][i] = 0.f; oacc[1][i] = 0.f; }
  float mrow = -INFINITY, lrow = 0.f;
  for (int kt = 0; kt < nkt; ++kt) {
    const int buf = kt & 1;
    if (kt + 1 < nkt) AT_DMA(buf ^ 1, kt + 1)
    const char* Kb = smem + buf * 32768;
    const char* Vb = Kb + 16384;
    f32x16 sacc[4];
#pragma unroll
    for (int q = 0; q < 4; ++q)
#pragma unroll
      for (int i = 0; i < 16; ++i) sacc[q][i] = 0.f;
#pragma unroll
    for (int s = 0; s < 4; ++s) {
      const int co = ((2 * s + h) ^ xr) * 16;
#pragma unroll
      for (int q = 0; q < 4; ++q) {
        const s16x8 a = *(const s16x8*)(Kb + (q >> 1) * 8192 + ((q & 1) * 32 + r) * 128 + co);
        sacc[q] = MFMA32(a, qf[s], sacc[q]);
      }
    }
    float mx = sacc[0][0];
#pragma unroll
    for (int q = 0; q < 4; ++q)
#pragma unroll
      for (int i = 0; i < 16; ++i) mx = fmaxf(mx, sacc[q][i]);
    mx = fmaxf(mx, __shfl_xor(mx, 32, 64));
    const float mnew = fmaxf(mrow, mx);
    const float alpha = __builtin_amdgcn_exp2f(mrow - mnew);
    mrow = mnew;
    float psum = 0.f;
#pragma unroll
    for (int q = 0; q < 4; ++q)
#pragma unroll
      for (int i = 0; i < 16; ++i) { sacc[q][i] = __builtin_amdgcn_exp2f(sacc[q][i] - mnew); psum += sacc[q][i]; }
    lrow = lrow * alpha + psum;
#pragma unroll
    for (int i = 0; i < 16; ++i) { oacc[0][i] *= alpha; oacc[1][i] *= alpha; }
#pragma unroll
    for (int q = 0; q < 4; ++q)
#pragma unroll
      for (int s2 = 0; s2 < 2; ++s2) {
        u32x4 pu;
#pragma unroll
        for (int e = 0; e < 4; ++e) pu[e] = pack2(sacc[q][8 * s2 + 2 * e], sacc[q][8 * s2 + 2 * e + 1]);
        const s16x8 pf = __builtin_bit_cast(s16x8, pu);
        const int c0 = (q & 1) * 4 + 2 * s2;
        const int o0 = ((c0 ^ xr) * 16) + 8 * h, o1 = (((c0 + 1) ^ xr) * 16) + 8 * h;
#pragma unroll
        for (int dt = 0; dt < 2; ++dt) {
          const s16x4 lo = *(const s16x4*)(Vb + (q >> 1) * 8192 + (dt * 32 + r) * 128 + o0);
          const s16x4 hi = *(const s16x4*)(Vb + (q >> 1) * 8192 + (dt * 32 + r) * 128 + o1);
          const s16x8 a = __builtin_shufflevector(lo, hi, 0, 1, 2, 3, 4, 5, 6, 7);
          oacc[dt] = MFMA32(a, pf, oacc[dt]);
        }
      }
    asm volatile("s_waitcnt vmcnt(0)" ::: "memory");
    __syncthreads();
  }
#undef AT_DMA
  const float ltot = lrow + __shfl_xor(lrow, 32, 64);
  const float inv = 1.f / ltot;
  bf16* Op = (bf16*)(p.ws + OFF_OATT) + (size_t)(tok0 + w * 32 + r) * 256 + head * 64;
#pragma unroll
  for (int dt = 0; dt < 2; ++dt)
#pragma unroll
    for (int i = 0; i < 16; i += 4) {
      u32x2 uu;
      uu[0] = pack2(oacc[dt][i] * inv, oacc[dt][i + 1] * inv);
      uu[1] = pack2(oacc[dt][i + 2] * inv, oacc[dt][i + 3] * inv);
      *(u32x2*)(Op + dt * 32 + crow(i, h)) = uu;
    }
}

constexpr int GL_LOW = 0, GL_TOT = 4096, GL_DEC = 5120, GL_QIN = 5376, GL_KIN = 14592, GL_KET = 23808, GL_OST = 0,
              GL_VT = 33792, GL_ST = 52224;
static_assert(GL_ST + 128 * LDT * 2 <= SMEM_BYTES, "gla lds");

template <bool WITH_OUT>
DI void gla_unit(const Params& p, int l, int u, char* smem) {
  float* lowt = (float*)(smem + GL_LOW);
  float* tots = (float*)(smem + GL_TOT);
  float* decs = (float*)(smem + GL_DEC);
  bf16* qin = (bf16*)(smem + GL_QIN);
  bf16* kin = (bf16*)(smem + GL_KIN);
  bf16* ket = (bf16*)(smem + GL_KET);
  float* ost = (float*)(smem + GL_OST);
  bf16* vts = (bf16*)(smem + GL_VT);
  bf16* sts = (bf16*)(smem + GL_ST);
  const int tid = TIDX, lane = tid & 63, w = tid >> 6, r = lane & 31, h = lane >> 5;
  int b, hd, gi, dir0, ndir;
  if (WITH_OUT) { gi = u % NG33; hd = (u / NG33) & 3; b = u / (NG33 * 4); dir0 = 1; ndir = 2; }
  else { gi = u % NG33; const int v = u / NG33; dir0 = v & 1; hd = (v >> 1) & 3; b = v >> 3; ndir = 1; }
  const int dk = tid & 63, part = tid >> 6;
  const bf16* GQ = (const bf16*)(p.ws + OFF_GQ);
  const bf16* GK = (const bf16*)(p.ws + OFF_GK);
  const bf16* GVT = (const bf16*)(p.ws + OFF_GVT) + (size_t)(b * 4 + hd) * 128 * TT;
  const float* LOW = (const float*)(p.ws + OFF_LOW);
  for (int dd = 0; dd < ndir; ++dd) {
    const int dir = WITH_OUT ? (dir0 - dd) : dir0;
    float* GSu = (float*)(p.ws + OFF_GS) + ((size_t)((b * 4 + hd) * 2 + dir) * NG33 + gi) * 8192;
    float gwreg[16];
#pragma unroll
    for (int rr = 0; rr < 16; ++rr) gwreg[rr] = p.in[I_GGW][((size_t)(l * 2 + dir) * 16 + rr) * 256 + hd * 64 + dk];
    const float gb = p.in[I_GGB][(l * 2 + dir) * 256 + hd * 64 + dk];
    f32x16 sacc[2];
    if (WITH_OUT) {
#pragma unroll
      for (int dkt = 0; dkt < 2; ++dkt)
#pragma unroll
        for (int i = 0; i < 16; ++i) {
          const float v = GSu[(w * 32 + crow(i, h)) * 64 + dkt * 32 + r];
          sacc[dkt][i] = v;
          sts[(w * 32 + crow(i, h)) * LDT + dkt * 32 + r] = f2bf(v);
        }
    } else {
#pragma unroll
      for (int i = 0; i < 16; ++i) { sacc[0][i] = 0.f; sacc[1][i] = 0.f; }
    }
    float gtot = 0.f;
    for (int cc = 0; cc < 4; ++cc) {
      const int ci = dir ? 3 - cc : cc;
      const int tb = gi * 256 + ci * 64;
      const size_t tokb = (size_t)b * TT + tb;
      {
        const int row = tid >> 2, c4 = (tid & 3) * 4;
        const u32x4 lw = ldg16(LOW + (tokb + row) * 32 + dir * 16 + c4);
        u32x4 vv[4], kq[2], qq[2];
#pragma unroll
        for (int i = 0; i < 4; ++i) {
          const int c = tid + 256 * i, e = c >> 3, k8 = (c & 7) * 8;
          vv[i] = ldg16(GVT + (size_t)e * TT + tb + k8);
        }
#pragma unroll
        for (int i = 0; i < 2; ++i) {
          const int c = tid + 256 * i, rw = c >> 3, k8 = (c & 7) * 8;
          kq[i] = ldg16(GK + (tokb + rw) * 256 + hd * 64 + k8);
          if (WITH_OUT) qq[i] = ldg16(GQ + (tokb + rw) * 256 + hd * 64 + k8);
        }
        *(u32x4*)(lowt + row * 16 + c4) = lw;
#pragma unroll
        for (int i = 0; i < 4; ++i) {
          const int c = tid + 256 * i, e = c >> 3, k8 = (c & 7) * 8;
          *(u32x4*)(vts + e * LDT + k8) = vv[i];
        }
#pragma unroll
        for (int i = 0; i < 2; ++i) {
          const int c = tid + 256 * i, rw = c >> 3, k8 = (c & 7) * 8;
          *(u32x4*)(kin + rw * LDT + k8) = kq[i];
          if (WITH_OUT) *(u32x4*)(qin + rw * LDT + k8) = qq[i];
        }
      }
      __syncthreads();
      float cum = 0.f;
#pragma unroll 2
      for (int ii = 0; ii < 16; ++ii) {
        const int pos = part * 16 + ii, t = dir ? 63 - pos : pos;
        float z = gb;
#pragma unroll
        for (int rr = 0; rr < 16; ++rr) z += lowt[t * 16 + rr] * gwreg[rr];
        cum += (fminf(z, 0.f) - log1pf(__expf(-fabsf(z)))) * (1.f / 16.f);
      }
      tots[part * 64 + dk] = cum;
      __syncthreads();
      float offs = 0.f, total = 0.f;
#pragma unroll
      for (int pp = 0; pp < 4; ++pp) { const float tv = tots[pp * 64 + dk]; total += tv; if (pp < part) offs += tv; }
      if (part == 0) decs[dk] = __expf(total);
      gtot += total;
      float bq = offs;
#pragma unroll 2
      for (int ii = 0; ii < 16; ++ii) {
        const int pos = part * 16 + ii, t = dir ? 63 - pos : pos;
        float z = gb;
#pragma unroll
        for (int rr = 0; rr < 16; ++rr) z += lowt[t * 16 + rr] * gwreg[rr];
        bq += (fminf(z, 0.f) - log1pf(__expf(-fabsf(z)))) * (1.f / 16.f);
        const float kv = bf2f(kin[t * LDT + dk]);
        ket[dk * LDT + t] = f2bf(kv * __expf(total - bq));
        if (WITH_OUT) {
          const float qv = bf2f(qin[t * LDT + dk]);
          qin[t * LDT + dk] = f2bf(qv * __expf(bq));
          kin[t * LDT + dk] = f2bf(kv * __expf(-bq));
        }
      }
      __syncthreads();
      f32x16 oo[2];
      const int it = w & 1, ep = w >> 1;
      if (WITH_OUT) {
        const int ti = w >> 1, tj = w & 1;
        f32x16 aa;
#pragma unroll
        for (int i = 0; i < 16; ++i) aa[i] = 0.f;
#pragma unroll
        for (int s = 0; s < 4; ++s) {
          const s16x8 A = *(const s16x8*)(qin + (ti * 32 + r) * LDT + s * 16 + h * 8);
          const s16x8 Bv = *(const s16x8*)(kin + (tj * 32 + r) * LDT + s * 16 + h * 8);
          aa = MFMA32(A, Bv, aa);
        }
        __syncthreads();
#pragma unroll
        for (int i = 0; i < 16; ++i) {
          const int qi = ti * 32 + crow(i, h), kj = tj * 32 + r;
          const bool keep = dir ? (kj >= qi) : (kj <= qi);
          kin[qi * LDT + kj] = f2bf(keep ? aa[i] : 0.f);
        }
        __syncthreads();
#pragma unroll
        for (int i = 0; i < 16; ++i) { oo[0][i] = 0.f; oo[1][i] = 0.f; }
#pragma unroll
        for (int s = 0; s < 4; ++s) {
          const s16x8 A1 = *(const s16x8*)(kin + (it * 32 + r) * LDT + s * 16 + h * 8);
          const s16x8 A2 = *(const s16x8*)(qin + (it * 32 + r) * LDT + s * 16 + h * 8);
#pragma unroll
          for (int x = 0; x < 2; ++x) {
            const int et = 2 * ep + x;
            const s16x8 B1 = *(const s16x8*)(vts + (et * 32 + r) * LDT + s * 16 + h * 8);
            const s16x8 B2 = *(const s16x8*)(sts + (et * 32 + r) * LDT + s * 16 + h * 8);
            oo[x] = MFMA32(A1, B1, oo[x]);
            oo[x] = MFMA32(A2, B2, oo[x]);
          }
        }
      }
#pragma unroll
      for (int dkt = 0; dkt < 2; ++dkt) {
        const float dv = decs[dkt * 32 + r];
#pragma unroll
        for (int i = 0; i < 16; ++i) sacc[dkt][i] *= dv;
      }
#pragma unroll
      for (int s = 0; s < 4; ++s) {
        const s16x8 A = *(const s16x8*)(vts + (w * 32 + r) * LDT + s * 16 + h * 8);
#pragma unroll
        for (int dkt = 0; dkt < 2; ++dkt) {
          const s16x8 Bv = *(const s16x8*)(ket + (dkt * 32 + r) * LDT + s * 16 + h * 8);
          sacc[dkt] = MFMA32(A, Bv, sacc[dkt]);
        }
      }
      __syncthreads();
      if (WITH_OUT) {
#pragma unroll
        for (int dkt = 0; dkt < 2; ++dkt)
#pragma unroll
          for (int i = 0; i < 16; ++i) sts[(w * 32 + crow(i, h)) * LDT + dkt * 32 + r] = f2bf(sacc[dkt][i]);
#pragma unroll
        for (int x = 0; x < 2; ++x)
#pragma unroll
          for (int i = 0; i < 16; ++i) ost[(it * 32 + crow(i, h)) * CLD + (2 * ep + x) * 32 + r] = oo[x][i];
        __syncthreads();
        const int row = tid >> 2, qd = tid & 3;
        const size_t tok = tokb + row;
        bf16* og = (bf16*)(p.ws + OFF_OGLA) + tok * 512 + hd * 128 + qd * 32;
        const float* os = ost + row * CLD + qd * 32;
        if (dir == 1) {
#pragma unroll
          for (int i = 0; i < 4; ++i) {
            u32x4 uu;
#pragma unroll
            for (int e = 0; e < 4; ++e) uu[e] = pack2(os[i * 8 + 2 * e], os[i * 8 + 2 * e + 1]);
            *(u32x4*)(og + i * 8) = uu;
          }
        } else {
          float ss = 0.f;
#pragma unroll 1
          for (int i = 0; i < 4; ++i) {
            const u32x4 uu = *(const u32x4*)(og + i * 8);
#pragma unroll
            for (int e = 0; e < 4; ++e) {
              const float a0 = os[i * 8 + 2 * e] + bflo(uu[e]), a1 = os[i * 8 + 2 * e + 1] + bfhi(uu[e]);
              ss += a0 * a0 + a1 * a1;
            }
          }
          ss += __shfl_xor(ss, 1, 64);
          ss += __shfl_xor(ss, 2, 64);
          const float rstd = rsqrtf(ss * (1.f / 128.f) + EPSF);
          const float* gn = p.in[I_GON] + l * 128 + qd * 32;
          const bf16* gr = (const bf16*)(p.ws + OFF_GR) + tok * 512 + hd * 128 + qd * 32;
#pragma unroll 1
          for (int i = 0; i < 4; ++i) {
            const u32x4 uo = *(const u32x4*)(og + i * 8);
            const u32x4 ug = *(const u32x4*)(gr + i * 8);
            u32x4 uu;
#pragma unroll
            for (int e = 0; e < 4; ++e) {
              const float v0 = os[i * 8 + 2 * e] + bflo(uo[e]), v1 = os[i * 8 + 2 * e + 1] + bfhi(uo[e]);
              const float a0 = v0 * rstd * gn[i * 8 + 2 * e] * siluf_(bflo(ug[e]));
              const float a1 = v1 * rstd * gn[i * 8 + 2 * e + 1] * siluf_(bfhi(ug[e]));
              uu[e] = pack2(a0, a1);
            }
            *(u32x4*)(og + i * 8) = uu;
          }
        }
        __syncthreads();
      }
    }
    if (!WITH_OUT) {
#pragma unroll
      for (int dkt = 0; dkt < 2; ++dkt)
#pragma unroll
        for (int i = 0; i < 16; ++i) GSu[(w * 32 + crow(i, h)) * 64 + dkt * 32 + r] = sacc[dkt][i];
      if (part == 0) ((float*)(p.ws + OFF_DECG))[((size_t)((b * 4 + hd) * 2 + dir) * NG33 + gi) * 64 + dk] = __expf(gtot);
    }
    __syncthreads();
  }
}

DI void gla_scan_job(const Params& p, int j) {
  const int idx = j * 256 + TIDX;
  const int seq = idx >> 13, el = idx & 8191, dk = el & 63, dir = seq & 1;
  float* GS = (float*)(p.ws + OFF_GS) + (size_t)seq * NG33 * 8192 + el;
  const float* DG = (const float*)(p.ws + OFF_DECG) + (size_t)seq * NG33 * 64 + dk;
  float s = 0.f;
  for (int st0 = 0; st0 < 33; st0 += 11) {
    float kv[11], dc[11];
#pragma unroll
    for (int q = 0; q < 11; ++q) {
      const int st = st0 + q;
      const int g = (dir == 0 || st == 0) ? st : 33 - st;
      kv[q] = GS[(size_t)g * 8192];
      dc[q] = DG[g * 64];
    }
#pragma unroll
    for (int q = 0; q < 11; ++q) {
      const int st = st0 + q;
      const int g = (dir == 0 || st == 0) ? st : 33 - st;
      GS[(size_t)g * 8192] = s;
      s = dc[q] * s + kv[q];
    }
  }
}

DI void s5_end_tile(const Params& p, int j, char* smem) {
  const int nt = j & 1, mt = (j >> 1) % 9, g = j / 18;
  const bf16* SU = (const bf16*)(p.ws + OFF_SU);
  const bf16* F = (const bf16*)(p.ws + OFF_F5) + ((size_t)g * 256 + nt * 128) * 512;
  f32x16 acc[2][2];
  acc_zero(acc);
  gemm_main_dma(acc,
            [&](int r) -> const bf16* {
              const int m = mt * 128 + r;
              if (m >= MS5) return (const bf16*)(p.ws + OFF_ZERO);
              const int b = m / NCH, ch = m - b * NCH;
              return SU + ((size_t)(b * 16 + g) * TT + ch * 32) * 16;
            },
            [&](int r) { return F + (size_t)r * 512; }, 512, smem);
  float* Cs = (float*)smem;
  acc_to_lds(acc, Cs);
  __syncthreads();
  float* EN = (float*)(p.ws + OFF_EN);
  for (int c = TIDX; c < 128 * 32; c += 256) {
    const int row = c >> 5, c4 = (c & 31) * 4, m = mt * 128 + row;
    if (m < MS5) {
      const float* s = Cs + row * CLD + c4;
      f32x4 v = {s[0], s[1], s[2], s[3]};
      *(f32x4*)(EN + ((size_t)m * 16 + g) * 256 + nt * 128 + c4) = v;
    }
  }
  __syncthreads();
}

DI void s5_scan_job(const Params& p, int l, int j, char* smem) {
  float2* ends = (float2*)smem;
  const int dir = j & 1, g = (j >> 1) & 15, b = j >> 5;
  const int pp = TIDX & 63, seg = TIDX >> 6;
  const float2 aL = ((const float2*)(p.ws + OFF_PWR))[((size_t)((l * 2 + dir) * 16 + g) * 33 + 32) * 64 + pp];
  const float* EN = (const float*)(p.ws + OFF_EN);
  bf16* SB = (bf16*)(p.ws + OFF_SB);
  float sr = 0.f, si = 0.f;
  for (int q0 = 0; q0 < 66; q0 += 11) {
    float er[11], ei[11];
#pragma unroll
    for (int q = 0; q < 11; ++q) {
      const int pos = seg * 66 + q0 + q;
      const int ch = dir ? (pos < 8 ? 7 - pos : 271 - pos) : pos;
      const float* e = EN + ((size_t)(b * NCH + ch) * 16 + g) * 256 + dir * 128 + pp;
      er[q] = e[0]; ei[q] = e[64];
    }
#pragma unroll
    for (int q = 0; q < 11; ++q) {
      const float nr = aL.x * sr - aL.y * si + er[q], ni = aL.x * si + aL.y * sr + ei[q];
      sr = nr; si = ni;
    }
  }
  ends[seg * 64 + pp] = make_float2(sr, si);
  float pr = 1.f, pi = 0.f;
  for (int q = 0; q < 66; ++q) { const float nr = pr * aL.x - pi * aL.y, ni = pr * aL.y + pi * aL.x; pr = nr; pi = ni; }
  __syncthreads();
  sr = 0.f; si = 0.f;
  for (int k = 0; k < seg; ++k) {
    const float2 e = ends[k * 64 + pp];
    const float nr = pr * sr - pi * si + e.x, ni = pr * si + pi * sr + e.y;
    sr = nr; si = ni;
  }
  for (int q0 = 0; q0 < 66; q0 += 11) {
    float er[11], ei[11];
#pragma unroll
    for (int q = 0; q < 11; ++q) {
      const int pos = seg * 66 + q0 + q;
      const int ch = dir ? (pos < 8 ? 7 - pos : 271 - pos) : pos;
      const float* e = EN + ((size_t)(b * NCH + ch) * 16 + g) * 256 + dir * 128 + pp;
      er[q] = e[0]; ei[q] = e[64];
    }
#pragma unroll
    for (int q = 0; q < 11; ++q) {
      const int pos = seg * 66 + q0 + q;
      const int ch = dir ? (pos < 8 ? 7 - pos : 271 - pos) : pos;
      bf16* sb = SB + ((size_t)(b * NCH + ch) * 16 + g) * 256 + dir * 128 + pp;
      sb[0] = f2bf(sr); sb[64] = f2bf(si);
      const float nr = aL.x * sr - aL.y * si + er[q], ni = aL.x * si + aL.y * sr + ei[q];
      sr = nr; si = ni;
    }
  }
  __syncthreads();
}

DI float gelu_tanh(float x) {
  const float u = 0.7978845608028654f * (x + 0.044715f * x * x * x);
  return 0.5f * x * (1.f + tanhf(u));
}

DI void s5_out_tile(const Params& p, int j, char* smem) {
  const int nt = j & 3, mt = (j >> 2) % 9, g = j / 36;
  const bf16* SU = (const bf16*)(p.ws + OFF_SU);
  const bf16* SB = (const bf16*)(p.ws + OFF_SB);
  const bf16* Tm = (const bf16*)(p.ws + OFF_T5) + ((size_t)g * 512 + nt * 128) * 512;
  const bf16* Em = (const bf16*)(p.ws + OFF_E5) + ((size_t)g * 512 + nt * 128) * 256;
  f32x16 acc[2][2];
  acc_zero(acc);
  gemm_main_dma(acc,
            [&](int r) -> const bf16* {
              const int m = mt * 128 + r;
              if (m >= MS5) return (const bf16*)(p.ws + OFF_ZERO);
              const int b = m / NCH, ch = m - b * NCH;
              return SU + ((size_t)(b * 16 + g) * TT + ch * 32) * 16;
            },
            [&](int r) { return Tm + (size_t)r * 512; }, 512, smem);
  gemm_main_dma(acc,
            [&](int r) -> const bf16* {
              const int m = mt * 128 + r;
              if (m >= MS5) return (const bf16*)(p.ws + OFF_ZERO);
              return SB + ((size_t)m * 16 + g) * 256;
            },
            [&](int r) { return Em + (size_t)r * 256; }, 256, smem);
  float* Cs = (float*)smem;
  acc_to_lds(acc, Cs);
  __syncthreads();
  bf16* Y5 = (bf16*)(p.ws + OFF_Y5);
  for (int c = TIDX; c < 2048; c += 256) {
    const int row = c >> 4, c8 = c & 15, m = mt * 128 + row;
    if (m < MS5) {
      const int b = m / NCH, ch = m - b * NCH;
      const int n = nt * 128 + c8 * 8, i = n >> 4, hh = n & 15;
      const float* s = Cs + row * CLD + c8 * 8;
      u32x4 u;
#pragma unroll
      for (int e = 0; e < 4; ++e) u[e] = pack2(gelu_tanh(s[2 * e]), gelu_tanh(s[2 * e + 1]));
      *(u32x4*)(Y5 + ((size_t)b * TT + ch * 32 + i) * 256 + g * 16 + hh) = u;
    }
  }
  __syncthreads();
}

DI void glu_tile(const Params& p, int l, int j, char* smem) {
  const int nt = j & 1, mt = j >> 1;
  const bf16* Y5 = (const bf16*)(p.ws + OFF_Y5) + (size_t)mt * 128 * 256;
  const bf16* W = wl(p, l, WL_GLU) + (size_t)nt * 128 * 256;
  f32x16 acc[2][2];
  acc_zero(acc);
  gemm_main_dma(acc, [&](int r) { return Y5 + (size_t)r * 256; }, [&](int r) { return W + (size_t)r * 256; }, 256, smem);
  float* Cs = (float*)smem;
  acc_to_lds(acc, Cs);
  __syncthreads();
  const float* gb = p.in[I_GLUB] + l * 256 + nt * 128;
  bf16* O = (bf16*)(p.ws + OFF_OS5) + (size_t)mt * 128 * 256 + nt * 128;
  for (int c = TIDX; c < 2048; c += 256) {
    const int row = c >> 4, cc = (c & 15) * 8;
    const float* s = Cs + row * CLD + cc;
    const u32x4 yu = *(const u32x4*)(Y5 + (size_t)row * 256 + nt * 128 + cc);
    u32x4 u;
#pragma unroll
    for (int e = 0; e < 4; ++e) {
      const float y0 = bflo(yu[e]), y1 = bfhi(yu[e]);
      u[e] = pack2(y0 * sigmoidf_(s[2 * e] + gb[cc + 2 * e]), y1 * sigmoidf_(s[2 * e + 1] + gb[cc + 2 * e + 1]));
    }
    *(u32x4*)(O + (size_t)row * 256 + cc) = u;
  }
  __syncthreads();
}

struct DmaStream { const bf16* ap[4]; const bf16* bp[4]; };
template <class FA, class FB>
DI void stream_setup(DmaStream& st, FA fa, FB fb) {
  const int tid = TIDX, lane = tid & 63, w = tid >> 6;
#pragma unroll
  for (int i = 0; i < 4; ++i) {
    const int row = w * 32 + i * 8 + (lane >> 3);
    const int c = (lane & 7) ^ ((row >> 1) & 7);
    st.ap[i] = fa(row) + c * 8;
    st.bp[i] = fb(row) + c * 8;
  }
}
DI void stream_issue(const DmaStream& st, int buf, int kt, char* smem) {
  const int tid = TIDX, lane = tid & 63, w = tid >> 6;
  const int ldst = (w * 256 + lane) * 16;
  const int k0 = kt * 64;
#pragma unroll
  for (int i = 0; i < 4; ++i) {
    __builtin_amdgcn_global_load_lds((const unsigned*)(st.ap[i] + k0), (unsigned*)(smem + buf * 16384 + ldst + i * 1024), 16, 0, 0);
    __builtin_amdgcn_global_load_lds((const unsigned*)(st.bp[i] + k0), (unsigned*)(smem + 32768 + buf * 16384 + ldst + i * 1024), 16, 0, 0);
  }
}
DI void stream_run(f32x16 (&acc)[2][2], const DmaStream& cur, int K, char* smem, const DmaStream& next, bool has_next) {
  const int tid = TIDX, lane = tid & 63, w = tid >> 6, wm = w >> 1, wn = w & 1;
  const int r = lane & 31, h = lane >> 5;
  const int xr = (r >> 1) & 7;
  const int arow = (wm * 64 + r) * 128, brow = (wn * 64 + r) * 128;
  const int nk = K / 64;
  for (int kt = 0; kt < nk; ++kt) {
    const int buf = kt & 1;
    if (kt + 1 < nk) stream_issue(cur, buf ^ 1, kt + 1, smem);
    else if (has_next) stream_issue(next, buf ^ 1, 0, smem);
    const char* Ab = smem + buf * 16384 + arow;
    const char* Bb = smem + 32768 + buf * 16384 + brow;
#pragma unroll
    for (int s2 = 0; s2 < 4; ++s2) {
      const int co = ((2 * s2 + h) ^ xr) * 16;
      s16x8 a0 = *(const s16x8*)(Ab + co);
      s16x8 a1 = *(const s16x8*)(Ab + 32 * 128 + co);
      s16x8 b0 = *(const s16x8*)(Bb + co);
      s16x8 b1 = *(const s16x8*)(Bb + 32 * 128 + co);
      acc[0][0] = MFMA32(a0, b0, acc[0][0]);
      acc[0][1] = MFMA32(a0, b1, acc[0][1]);
      acc[1][0] = MFMA32(a1, b0, acc[1][0]);
      acc[1][1] = MFMA32(a1, b1, acc[1][1]);
    }
    asm volatile("s_waitcnt vmcnt(0)" ::: "memory");
    __syncthreads();
  }
}

DI void merge_tile(const Params& p, int l, int j, char* smem) {
  const int nt = j & 7, mt = j >> 3;
  const bf16* H = (const bf16*)(p.ws + OFF_H) + (size_t)mt * 128 * DM;
  unsigned am[2][2][8];
#pragma unroll
  for (int a = 0; a < 2; ++a)
#pragma unroll
    for (int bq = 0; bq < 2; ++bq)
#pragma unroll
      for (int i = 0; i < 8; ++i) am[a][bq][i] = 0u;
  DmaStream sb, sg;
  {
    const bf16* A0 = (const bf16*)(p.ws + OFF_OATT) + (size_t)mt * 128 * 256;
    const bf16* W0 = wl(p, l, WL_BRA) + (size_t)nt * 128 * 256;
    stream_setup(sb, [&](int r) { return A0 + (size_t)r * 256; }, [&](int r) { return W0 + (size_t)r * 256; });
    stream_issue(sb, 0, 0, smem);
    asm volatile("s_waitcnt vmcnt(0)" ::: "memory");
    __syncthreads();
  }
#pragma unroll 1
  for (int x = 0; x < 3; ++x) {
    const int K = (x == 1) ? 512 : 256;
    const bf16* Wg = wl(p, l, WL_WIN) + ((size_t)2432 + x * 1024 + nt * 128) * DM;
    stream_setup(sg, [&](int r) { return H + (size_t)r * DM; }, [&](int r) { return Wg + (size_t)r * DM; });
    unsigned br[2][2][8];
    {
      f32x16 acc[2][2];
      acc_zero(acc);
      stream_run(acc, sb, K, smem, sg, true);
#pragma unroll
      for (int a = 0; a < 2; ++a)
#pragma unroll
        for (int bq = 0; bq < 2; ++bq)
#pragma unroll
          for (int i = 0; i < 8; ++i) br[a][bq][i] = pack2(acc[a][bq][2 * i], acc[a][bq][2 * i + 1]);
    }
    if (x < 2) {
      const bf16* A1; const bf16* W1; int K1;
      if (x == 0) { A1 = (const bf16*)(p.ws + OFF_OGLA) + (size_t)mt * 128 * 512; W1 = wl(p, l, WL_BRG) + (size_t)nt * 128 * 512; K1 = 512; }
      else { A1 = (const bf16*)(p.ws + OFF_OS5) + (size_t)mt * 128 * 256; W1 = wl(p, l, WL_BRS) + (size_t)nt * 128 * 256; K1 = 256; }
      stream_setup(sb, [&](int r) { return A1 + (size_t)r * K1; }, [&](int r) { return W1 + (size_t)r * K1; });
    }
    f32x16 acc[2][2];
    acc_zero(acc);
    stream_run(acc, sg, DM, smem, sb, x < 2);
#pragma unroll
    for (int a = 0; a < 2; ++a)
#pragma unroll
      for (int bq = 0; bq < 2; ++bq)
#pragma unroll
        for (int i = 0; i < 8; ++i) {
          const float v0 = bflo(am[a][bq][i]) + sigmoidf_(acc[a][bq][2 * i]) * bflo(br[a][bq][i]);
          const float v1 = bfhi(am[a][bq][i]) + sigmoidf_(acc[a][bq][2 * i + 1]) * bfhi(br[a][bq][i]);
          am[a][bq][i] = pack2(v0, v1);
        }
  }
  f32x16 accm[2][2];
#pragma unroll
  for (int a = 0; a < 2; ++a)
#pragma unroll
    for (int bq = 0; bq < 2; ++bq)
#pragma unroll
      for (int i = 0; i < 8; ++i) { accm[a][bq][2 * i] = bflo(am[a][bq][i]); accm[a][bq][2 * i + 1] = bfhi(am[a][bq][i]); }
  float* Cs = (float*)smem;
  acc_to_lds(accm, Cs);
  __syncthreads();
  store_tile_bf16(Cs, (bf16*)(p.ws + OFF_MG) + (size_t)mt * 128 * DM + nt * 128, DM, 128, 1.f);
  __syncthreads();
}

DI void plain_tile(const bf16* A, int K, const bf16* W, bf16* dst, int ldd, char* smem) {
  f32x16 acc[2][2];
  acc_zero(acc);
  gemm_main_dma(acc, [&](int r) { return A + (size_t)r * K; }, [&](int r) { return W + (size_t)r * K; }, K, smem);
  float* Cs = (float*)smem;
  acc_to_lds(acc, Cs);
  __syncthreads();
  store_tile_bf16(Cs, dst, ldd, 128, 1.f);
  __syncthreads();
}

DI void plain_wide(const bf16* A, int K, const bf16* W, bf16* dst, int ldd, char* smem) {
  f32x16 acc[2][4];
  accw_zero(acc);
  gemm_wide(acc, [&](int r) { return A + (size_t)r * K; }, [&](int r) { return W + (size_t)r * K; }, K, smem);
  float* Cs = (float*)smem;
  accw_to_lds<0>(acc, Cs);
  __syncthreads();
  store_tile_bf16(Cs, dst, ldd, 128, 1.f);
  __syncthreads();
  accw_to_lds<1>(acc, Cs);
  __syncthreads();
  store_tile_bf16(Cs, dst + 128, ldd, 128, 1.f);
  __syncthreads();
}

DI void up_epi(const Params& p, int l, int jn, int seqbase, int len, int pos0, char* smem) {
  float* Cs = (float*)smem;
  const float* cw = p.in[I_CW] + (size_t)l * 3 * 2 * DFF;
  const float* cb = p.in[I_CB] + (size_t)l * 2 * DFF;
  bf16* G = (bf16*)(p.ws + OFF_G);
  const int tid = TIDX;
  const int c = (tid & 31) * 2;
  float wa[2][3], wv[2][3], ba[2], bv[2];
#pragma unroll
  for (int e = 0; e < 2; ++e) {
    const int ca = jn * 64 + c + e, cv = DFF + ca;
#pragma unroll
    for (int k = 0; k < 3; ++k) { wa[e][k] = cw[k * 2 * DFF + ca]; wv[e][k] = cw[k * 2 * DFF + cv]; }
    ba[e] = cb[ca]; bv[e] = cb[cv];
  }
#pragma unroll 4
  for (int rr = 1 + (tid >> 5); rr < 127; rr += 8) {
    const int pos = pos0 + rr;
    if (pos < len) {
      float gv[2];
#pragma unroll
      for (int e = 0; e < 2; ++e) {
        const float a = wa[e][0] * Cs[(rr - 1) * CLD + c + e] + wa[e][1] * Cs[rr * CLD + c + e] + wa[e][2] * Cs[(rr + 1) * CLD + c + e] + ba[e];
        const float v = wv[e][0] * Cs[(rr - 1) * CLD + 64 + c + e] + wv[e][1] * Cs[rr * CLD + 64 + c + e] +
                        wv[e][2] * Cs[(rr + 1) * CLD + 64 + c + e] + bv[e];
        gv[e] = siluf_(a) * v;
      }
      *(unsigned*)(G + (size_t)(seqbase + pos) * DFF + jn * 64 + c) = pack2(gv[0], gv[1]);
    }
  }
  __syncthreads();
}

DI void up_wide(const Params& p, int l, int mtile, int jp, char* smem) {
  const int b = mtile / 69, rr0 = mtile % 69;
  int seqbase, len, ti;
  if (rr0 < 3) { seqbase = b * TT; len = CTXL; ti = rr0; }
  else { seqbase = b * TT + CTXL; len = SEQ; ti = rr0 - 3; }
  const int pos0 = ti * 126 - 1;
  const bf16* H = (const bf16*)(p.ws + OFF_H);
  const bf16* W = wl(p, l, WL_UP) + (size_t)jp * 256 * DM;
  f32x16 acc[2][4];
  accw_zero(acc);
  gemm_wide(acc,
            [&](int r) -> const bf16* {
              const int pos = pos0 + r;
              return (pos >= 0 && pos < len) ? H + (size_t)(seqbase + pos) * DM : (const bf16*)(p.ws + OFF_ZERO);
            },
            [&](int r) { return W + (size_t)r * DM; }, DM, smem);
  float* Cs = (float*)smem;
  accw_to_lds<0>(acc, Cs);
  __syncthreads();
  up_epi(p, l, jp * 2, seqbase, len, pos0, smem);
  accw_to_lds<1>(acc, Cs);
  __syncthreads();
  up_epi(p, l, jp * 2 + 1, seqbase, len, pos0, smem);
}

DI bool gemm_job(int bid, int G, int it, int MT, int NTL, int& mt, int& nt, int CW = 8) {
  const int x = bid & 7, q = bid >> 3, Q = G >> 3;
  const int m0 = (x * MT) >> 3, m1 = ((x + 1) * MT) >> 3, Mx = m1 - m0;
  const int jl = q + Q * it;
  if (jl >= Mx * NTL) return false;
  const int full = Mx * CW;
  const int c = jl / full, rem = jl - c * full;
  const int wc = min(CW, NTL - CW * c);
  const int mi = rem / wc;
  mt = m0 + mi;
  nt = CW * c + (rem - mi * wc);
  return true;
}

enum { PH_PREP = 0, PH_ROW0, PH_PROJ, PH_MIX1, PH_SCAN, PH_MIX2, PH_GLU, PH_MERGE, PH_WOUT, PH_ROW1, PH_UP, PH_DOWN, PH_ROW2 };
constexpr int N_PHASES = 2 + 11 * NL;

DI void run_phase(const Params& p, int ph, int l, char* smem) {
  const int bid = blockIdx.x;
#ifdef HALFMASK
  const int G = ((HALFMASK >> ph) & 1) ? 256 : gridDim.x;
  if (bid >= G) return;
#else
  const int G = gridDim.x;
#endif
#ifdef PHMASK
  if (!((PHMASK >> ph) & 1)) return;
#endif
  switch (ph) {
    case PH_PREP:
      if (bid < 8) { for (int i = TIDX; i < 512; i += 256) ((u32x4*)(p.ws + OFF_ZERO))[i] = u32x4{0u, 0u, 0u, 0u}; }
      for (int j = bid; j < 128 + 4016; j += G) {
        if (j < 96) prep_mod_job(p, j, smem);
        else if (j < 128) prep_s5_job(p, j - 96);
        else prep_wt_job(p, j - 128, smem);
      }
      break;
    case PH_ROW0:
      row_phase<0>(p, 0, bid, G);
      ktab_phase(p, bid, G, 0, 1);
      break;
    case PH_PROJ:
#ifdef EXP_A
      if (bid < 256) { int mt, nt; for (int it = 0; gemm_job(bid, 256, it, 264, 10, mt, nt, 4); ++it) proj_wide(p, l, mt, nt, smem); }
      else {
        s5mat_phase(p, l, bid - 256, G - 256);
        if (l + 1 < NL) ktab_phase(p, bid - 256, G - 256, l + 1, l + 2);
        if (l + 1 < NL) { for (int jj = (l + 1) * 4016 + (bid - 256); jj < (l + 2) * 4016; jj += G - 256) prep_wt_job(p, jj, smem); }
      }
#elif defined(EXP_C)
      if (bid < 256) for (int j = bid; j < 264 * 19; j += 256) { if ((EXP_C >> (j % 19)) & 1) proj_tile(p, l, j / 19, j % 19, smem); }
      for (int j = bid; j < 264 * 19; j += G) { if (!((EXP_C >> (j % 19)) & 1)) proj_tile(p, l, j / 19, j % 19, smem); }
      s5mat_phase(p, l, bid, G);
#elif defined(EXP_B)
      for (int j = bid; j < 264 * 19; j += G) proj_tile(p, l, j / 19, j % 19, smem);
      if (bid < 256) s5mat_phase(p, l, bid, 256);
#else
      for (int j = bid; j < 264 * 19; j += G) proj_tile(p, l, j / 19, j % 19, smem);
      s5mat_phase(p, l, bid, G);
#endif
      break;
    case PH_MIX1:
      for (int j = bid; j < 1056; j += G) attn_unit(p, j, smem);
      for (int j = bid; j < 1024; j += G) {
        const int v = j >> 5, k = j & 31;
        const int gi = (v & 1) ? (k == 0 ? 0 : k + 1) : k;
        gla_unit<false>(p, l, v * NG33 + gi, smem);
      }
      for (int j = G - 1 - bid; j < 288; j += G) s5_end_tile(p, j, smem);
      break;
    case PH_SCAN:
      for (int j = bid; j < 1024 + 128; j += G) {
        if (j < 1024) gla_scan_job(p, j);
        else s5_scan_job(p, l, j - 1024, smem);
      }
      break;
    case PH_MIX2:
      for (int j = bid; j < 528 + 576; j += G) {
        if (j < 528) gla_unit<true>(p, l, j, smem);
        else s5_out_tile(p, j - 528, smem);
      }
      break;
    case PH_GLU:
      { int mt, nt; for (int it = 0; gemm_job(bid, G, it, 264, 2, mt, nt); ++it) glu_tile(p, l, mt * 2 + nt, smem); }
      break;
    case PH_MERGE:
      { int mt, nt; for (int it = 0; gemm_job(bid, G, it, 264, 8, mt, nt); ++it) merge_tile(p, l, mt * 8 + nt, smem); }
      break;
    case PH_WOUT:
      for (int it = 0;; ++it) {
        int mt, nt;
        if (!gemm_job(bid, G, it, 264, 8, mt, nt)) break;
        plain_tile((const bf16*)(p.ws + OFF_MG) + (size_t)mt * 128 * DM, DM, wl(p, l, WL_WOUT) + (size_t)nt * 128 * DM,
                   (bf16*)(p.ws + OFF_H) + (size_t)mt * 128 * DM + nt * 128, DM, smem);
      }
      break;
    case PH_ROW1: row_phase<1>(p, l, bid, G); break;
    case PH_UP:
      { int mt, nt; for (int it = 0; gemm_job(bid, G, it, 276, 22, mt, nt, 4); ++it) up_wide(p, l, mt, nt, smem); }
      break;
    case PH_DOWN:
      for (int it = 0;; ++it) {
        int mt, nt;
        if (!gemm_job(bid, G, it, 264, 8, mt, nt)) break;
        plain_tile((const bf16*)(p.ws + OFF_G) + (size_t)mt * 128 * DFF, DFF, wl(p, l, WL_DOWN) + (size_t)nt * 128 * DFF,
                   (bf16*)(p.ws + OFF_H) + (size_t)mt * 128 * DM + nt * 128, DM, smem);
      }
      break;
    case PH_ROW2: row_phase<2>(p, l, bid, G); break;
  }
}

#define XB_TMO      128
#define XB_XCNT(j)  (256  + 64 * (j))
#define XB_XSUB(j)  (1280 + 64 * (j))
#define XB_XGEN(j)  (2304 + 64 * (j))
#define XB_TOP      3328
#define XB_TOPGEN   3392
#define XCD_BAR_WORDS 3456
#define XB_SPIN_CAP (1u << 18)
#define LAS __attribute__((address_space(3)))

__device__ __forceinline__ unsigned xb_ld(unsigned* p)              { return __hip_atomic_load(p, __ATOMIC_RELAXED, __HIP_MEMORY_SCOPE_AGENT); }
__device__ __forceinline__ unsigned xb_add(unsigned* p, unsigned v) { return __hip_atomic_fetch_add(p, v, __ATOMIC_RELAXED, __HIP_MEMORY_SCOPE_AGENT); }
__device__ __forceinline__ unsigned xb_xcc_id() { return (unsigned)__builtin_amdgcn_s_getreg((3 << 11) | 20) & 0xFu; }
#define XB_SPIN(cond, bar) do { unsigned _sp = 0; while (cond) { __builtin_amdgcn_s_sleep(1); \
    if ((++_sp & 255u) == 0u) { if (xb_ld(&(bar)[XB_TMO])) break; if (_sp > XB_SPIN_CAP) { atomicAdd(&(bar)[XB_TMO], 1u); break; } } } } while (0)

struct XcdBarrier {
    unsigned* bar; unsigned x;
    volatile LAS unsigned* st;
};

__device__ __forceinline__ XcdBarrier xcd_barrier_post(unsigned* bar, volatile LAS unsigned* st) {
    XcdBarrier b; b.bar = bar; b.x = xb_xcc_id(); b.st = st;
    if (threadIdx.x == 0) (void)xb_add(&bar[XB_XCNT(b.x)], 1u);
    return b;
}
__device__ __forceinline__ void xcd_barrier_complete(unsigned* bar, unsigned x, unsigned& nloc, unsigned& nx) {
    const unsigned G = gridDim.x * gridDim.y * gridDim.z;
    unsigned sum, cnt, mine, sp = 0u;
    for (;;) {
        sum = 0u; cnt = 0u; mine = 0u;
#pragma unroll
        for (unsigned j = 0; j < 16; ++j) { const unsigned c = xb_ld(&bar[XB_XCNT(j)]); sum += c; cnt += (c > 0u) ? 1u : 0u; mine = (j == x) ? c : mine; }
        if (sum == G) break;
        __builtin_amdgcn_s_sleep(1);
        if ((++sp & 255u) == 0u) { if (xb_ld(&bar[XB_TMO])) break; if (sp > XB_SPIN_CAP) { atomicAdd(&bar[XB_TMO], 1u); break; } }
    }
    nloc = mine > 0u ? mine : 1u; nx = cnt > 0u ? cnt : 1u;
}

__device__ __forceinline__ void xcd_barrier(const XcdBarrier& b) {
    asm volatile("s_waitcnt vmcnt(0)" ::: "memory");
    __syncthreads();
    if (threadIdx.x == 0) {
        unsigned* bar = b.bar;
        __builtin_amdgcn_s_waitcnt(0);
        unsigned nloc = b.st[0], nx = b.st[1];
        if (nloc == 0u) { xcd_barrier_complete(bar, b.x, nloc, nx); b.st[0] = nloc; b.st[1] = nx; }
        const unsigned old = xb_add(&bar[XB_XSUB(b.x)], 1u);
        const unsigned gen = old / nloc;
        if (old + 1u == (gen + 1u) * nloc) {
            __builtin_amdgcn_fence(__ATOMIC_RELEASE, "agent");
            asm volatile("s_waitcnt vmcnt(0)" ::: "memory");
            const unsigned og = xb_add(&bar[XB_TOP], 1u);
            const unsigned tg = og / nx;
            if (og + 1u == (tg + 1u) * nx) xb_add(&bar[XB_TOPGEN], 1u);
            else XB_SPIN(xb_ld(&bar[XB_TOPGEN]) == tg, bar);
            __builtin_amdgcn_fence(__ATOMIC_ACQUIRE, "agent");
            xb_add(&bar[XB_XGEN(b.x)], 1u);
            asm volatile("s_waitcnt vmcnt(0)" ::: "memory");
        } else {
            XB_SPIN(xb_ld(&bar[XB_XGEN(b.x)]) == gen, bar);
            __builtin_amdgcn_fence(__ATOMIC_ACQUIRE, "agent");
            asm volatile("s_waitcnt vmcnt(0)" ::: "memory");
        }
    }
    __syncthreads();
}


DI void grid_barrier(unsigned* bar, unsigned& gen) {
  asm volatile("s_waitcnt vmcnt(0)" ::: "memory");
  __syncthreads();
  gen += 1;
  if (threadIdx.x == 0) {
    __builtin_amdgcn_fence(__ATOMIC_RELEASE, "agent");
    asm volatile("s_waitcnt vmcnt(0)" ::: "memory");
    const unsigned target = gen * gridDim.x;
    __hip_atomic_fetch_add(bar, 1u, __ATOMIC_RELAXED, __HIP_MEMORY_SCOPE_AGENT);
    while (__hip_atomic_load(bar, __ATOMIC_RELAXED, __HIP_MEMORY_SCOPE_AGENT) < target) __builtin_amdgcn_s_sleep(2);
  }
  __syncthreads();
  __builtin_amdgcn_fence(__ATOMIC_ACQUIRE, "agent");
  asm volatile("s_waitcnt vmcnt(0)" ::: "memory");
}

__global__ void __launch_bounds__(256, 2) hybrid_fwd(Params p, int ph_lo, int ph_hi) {
  extern __shared__ __attribute__((aligned(16))) char smem[];
  unsigned* bar = (unsigned*)(p.ws + OFF_BAR);
  unsigned gen = 0;
  __shared__ uint4 xb_words;
  if (threadIdx.x == 0) xb_words = make_uint4(0u, 0u, 0u, 0u);
  __syncthreads();
  XcdBarrier xb = xcd_barrier_post(bar + 64, (volatile LAS unsigned*)&xb_words);
  if (ph_hi - ph_lo > 1) cg::this_grid().sync();
  int i = 0;
#define STEP(PH, L)                                      \
  {                                                      \
    if (i >= ph_lo && i < ph_hi) {                       \
      Params q;                                          \
      q.ws = p.ws; q.out = p.out;                        \
      asm volatile("" : "+s"(q.ws), "+s"(q.out));        \
      _Pragma("unroll") for (int k = 0; k < 34; ++k) { q.in[k] = p.in[k]; asm volatile("" : "+s"(q.in[k])); } \
      run_phase(q, PH, L, smem);                         \
      if ((DUPMASK >> (PH)) & 1) { xcd_barrier(xb); run_phase(q, PH, L, smem); } \
      if (i + 1 < ph_hi) xcd_barrier(xb);                \
    }                                                    \
    ++i;                                                 \
  }
  STEP(PH_PREP, 0)
  STEP(PH_ROW0, 0)
#pragma unroll 1
  for (int l = 0; l < NL; ++l) {
    STEP(PH_PROJ, l)
    STEP(PH_MIX1, l)
    STEP(PH_SCAN, l)
    STEP(PH_MIX2, l)
    STEP(PH_GLU, l)
    STEP(PH_MERGE, l)
    STEP(PH_WOUT, l)
    STEP(PH_ROW1, l)
    STEP(PH_UP, l)
    STEP(PH_DOWN, l)
    STEP(PH_ROW2, l)
  }
#undef STEP
}

extern "C" void kernel_launch(void* const* d_in, const int* in_sizes, int n_in, void* d_out, int out_size, void* d_ws, size_t ws_size,
                              hipStream_t stream) {
  static int grid_blocks = 0;
  if (!grid_blocks) {
    int dev = 0, cus = 0, per_cu = 0;
    hipGetDevice(&dev);
    hipDeviceGetAttribute(&cus, hipDeviceAttributeMultiprocessorCount, dev);
    hipFuncSetAttribute((const void*)hybrid_fwd, hipFuncAttributeMaxDynamicSharedMemorySize, SMEM_BYTES);
    hipOccupancyMaxActiveBlocksPerMultiprocessor(&per_cu, hybrid_fwd, 256, SMEM_BYTES);
    if (per_cu < 1) per_cu = 1;
    if (per_cu > 2) per_cu = 2;
    grid_blocks = cus * per_cu;
    if (ws_size < OFF_ZERO + 8192) fprintf(stderr, "workspace too small: %zu < %zu\n", ws_size, (size_t)OFF_END);
  }
  Params p{};
  for (int i = 0; i < 34; ++i) p.in[i] = (const float*)d_in[i];
  p.out = (float*)d_out;
  p.ws = (char*)d_ws;
#if ONE_LAUNCH
  hipMemsetAsync((char*)d_ws + OFF_BAR, 0, 16384, stream);
  int lo = 0, hi = N_PHASES;
  void* args[] = {&p, &lo, &hi};
  hipError_t e = hipLaunchCooperativeKernel((void*)hybrid_fwd, dim3(grid_blocks), dim3(256), args, SMEM_BYTES, stream);
  if (e != hipSuccess) fprintf(stderr, "cooperative launch failed: %s (grid %d)\n", hipGetErrorString(e), grid_blocks);
#else
  for (int i = 0; i < N_PHASES; ++i) hipLaunchKernelGGL(hybrid_fwd, dim3(grid_blocks), dim3(256), SMEM_BYTES, stream, p, i, i + 1);
#endif
}
```

```cpp
#include <hip/hip_runtime.h>
#include <hip/hip_cooperative_groups.h>
#include <stdint.h>
#include <cstdio>
namespace cg = cooperative_groups;

#define EXP_A 1
#ifndef DUPMASK
#define DUPMASK 0
#endif
#ifndef ONE_LAUNCH
#define ONE_LAUNCH 1
#endif

typedef unsigned short bf16;
typedef __attribute__((ext_vector_type(8))) short s16x8;
typedef __attribute__((ext_vector_type(4))) short s16x4;
typedef __attribute__((ext_vector_type(16))) float f32x16;
typedef __attribute__((ext_vector_type(4))) float f32x4;
typedef __attribute__((ext_vector_type(2))) float f32x2;
typedef __attribute__((ext_vector_type(4))) unsigned u32x4;
typedef __attribute__((ext_vector_type(2))) unsigned u32x2;
typedef __attribute__((ext_vector_type(2))) __bf16 bf16x2_t;

#define DI __device__ __forceinline__
#define MFMA32(a, b, c) __builtin_amdgcn_mfma_f32_32x32x16_bf16((a), (b), (c), 0, 0, 0)

DI int tidx_opaque() { int t = threadIdx.x; asm volatile("" : "+v"(t)); return t; }
#define TIDX tidx_opaque()
DI bf16 f2bf(float x) { return __builtin_bit_cast(unsigned short, (__bf16)x); }
DI float bf2f(bf16 v) { return __uint_as_float(((unsigned)v) << 16); }
DI unsigned pack2(float a, float b) {
  f32x2 v = {a, b};
  return __builtin_bit_cast(unsigned, __builtin_convertvector(v, bf16x2_t));
}
DI float bflo(unsigned u) { return __uint_as_float(u << 16); }
DI float bfhi(unsigned u) { return __uint_as_float(u & 0xffff0000u); }
typedef const __attribute__((address_space(1))) u32x4* gptr16;
DI u32x4 ldg16(const void* q) { return *(gptr16)(uintptr_t)q; }
#define SCHED_FENCE() __builtin_amdgcn_sched_barrier(0)
DI int crow(int i, int h) { return (i & 3) + 8 * (i >> 2) + 4 * h; }
DI void sincos_cw(float x, float& sn, float& cs) {
  const float k = rintf(x * 0.63661977236758134f);
  float r = fmaf(-k, 1.57079637050628662109375f, x);
  r = fmaf(-k, -4.371139000186241e-08f, r);
  const int q = ((int)k) & 3;
  const float r2 = r * r;
  const float sp = r + r * r2 * (-1.6666667163e-01f + r2 * (8.3333337680e-03f + r2 * (-1.9841270114e-04f + r2 * 2.7557314297e-06f)));
  const float cp = 1.f + r2 * (-0.5f + r2 * (4.1666667908e-02f + r2 * (-1.3888889225e-03f + r2 * (2.4801587642e-05f - r2 * 2.7557314297e-07f))));
  sn = (q == 0) ? sp : (q == 1) ? cp : (q == 2) ? -sp : -cp;
  cs = (q == 0) ? cp : (q == 1) ? -sp : (q == 2) ? -cp : sp;
}
DI float sigmoidf_(float x) { return 1.f / (1.f + __expf(-x)); }
DI float siluf_(float x) { return x / (1.f + __expf(-x)); }

constexpr int DM = 1024, NB = 4, SEQ = 8192, CTXL = 256, TT = SEQ + CTXL, NTOK = NB * TT, NL = 4;
constexpr int DFF = 2816, DIN = 5408;
constexpr float EPSF = 1e-6f;
constexpr int NG33 = 33;
constexpr int NCH = 264;
constexpr int MS5 = NB * NCH;

constexpr size_t SZ_H = (size_t)NTOK * 1024 * 2;
constexpr size_t OFF_H = 0;
constexpr size_t OFF_P = OFF_H + SZ_H;
constexpr size_t OFF_Q = OFF_P;
constexpr size_t OFF_K = OFF_Q + (size_t)NTOK * 256 * 2;
constexpr size_t OFF_VT = OFF_K + (size_t)NTOK * 128 * 2;
constexpr size_t OFF_GQ = OFF_VT + (size_t)NTOK * 128 * 2;
constexpr size_t OFF_GK = OFF_GQ + (size_t)NTOK * 256 * 2;
constexpr size_t OFF_GVT = OFF_GK + (size_t)NTOK * 256 * 2;
constexpr size_t OFF_GR = OFF_GVT + (size_t)NTOK * 512 * 2;
constexpr size_t OFF_SU = OFF_GR + (size_t)NTOK * 512 * 2;
constexpr size_t OFF_LOW = OFF_SU + (size_t)NTOK * 256 * 2;
constexpr size_t OFF_O = OFF_LOW + (size_t)NTOK * 32 * 4;
constexpr size_t OFF_OATT = OFF_O;
constexpr size_t OFF_OGLA = OFF_OATT + (size_t)NTOK * 256 * 2;
constexpr size_t OFF_Y5 = OFF_OGLA + (size_t)NTOK * 512 * 2;
constexpr size_t OFF_EN = OFF_Y5;
constexpr size_t OFF_OS5 = OFF_Y5 + (size_t)NTOK * 256 * 2;
constexpr size_t OFF_M = OFF_OS5 + (size_t)NTOK * 256 * 2;
constexpr size_t OFF_MG = OFF_M;
constexpr size_t OFF_GS = OFF_M;
constexpr size_t OFF_DECG = OFF_GS + (size_t)32 * 33 * 8192 * 4;
constexpr size_t OFF_SB = OFF_DECG + (size_t)32 * 33 * 64 * 4;
constexpr size_t OFF_T5 = OFF_SB + (size_t)MS5 * 16 * 256 * 2;
constexpr size_t OFF_E5 = OFF_T5 + (size_t)16 * 512 * 512 * 2;
constexpr size_t OFF_F5 = OFF_E5 + (size_t)16 * 512 * 256 * 2;
constexpr size_t OFF_MEND = OFF_F5 + (size_t)16 * 256 * 512 * 2;
static_assert(OFF_MEND <= OFF_M + SZ_H, "mixer scratch overflows merged area");
constexpr size_t OFF_W = OFF_M + SZ_H;
constexpr size_t WL_WIN = 0, WL_BRA = WL_WIN + (size_t)5504 * 1024, WL_BRG = WL_BRA + 1024 * 256, WL_BRS = WL_BRG + 1024 * 512,
                 WL_WOUT = WL_BRS + 1024 * 256, WL_UP = WL_WOUT + 1024 * 1024, WL_DOWN = WL_UP + (size_t)5632 * 1024,
                 WL_GLU = WL_DOWN + (size_t)1024 * 2816, WL_TOTAL = WL_GLU + 256 * 256;
constexpr size_t OFF_XC = OFF_W + WL_TOTAL * 2 * NL;
constexpr size_t OFF_MOD = OFF_XC + (size_t)NB * CTXL * 1024 * 4;
constexpr size_t OFF_BBR = OFF_MOD + (size_t)NL * 5 * 6144 * 4;
constexpr size_t OFF_BBI = OFF_BBR + (size_t)NL * 2 * 16 * 64 * 16 * 4;
constexpr size_t OFF_PWR = OFF_BBI + (size_t)NL * 2 * 16 * 64 * 16 * 4;
constexpr size_t OFF_KTAB = OFF_PWR + (size_t)NL * 2 * 16 * 33 * 64 * 8;
constexpr size_t OFF_END = OFF_KTAB + (size_t)NL * 16 * 2 * 32 * 256 * 4;
constexpr size_t OFF_BAR = OFF_END;
constexpr size_t OFF_ZERO = OFF_BAR + 16384;
constexpr size_t OFF_G = OFF_P;
static_assert((size_t)NTOK * DFF * 2 <= OFF_M - OFF_P, "G overflows");

constexpr int SMEM_BYTES = 73728;

struct Params {
  const float* in[34];
  float* out;
  char* ws;
};

enum { I_X = 0, I_C, I_CTX, I_CCTX, I_ADAW, I_ADAB, I_NMPRE, I_NMPOST, I_NFPRE, I_NFPOST, I_WIN, I_QN, I_KN, I_GGW, I_GGB, I_GON,
       I_ARE, I_AIM, I_LDT, I_BRE, I_BIM, I_CRE, I_CIM, I_S5D, I_GLUW, I_GLUB, I_WBA, I_WBG, I_WBS, I_WOUT, I_UP, I_CW, I_CB, I_DOWN };

constexpr int LDT = 72;
constexpr int CLD = 132;

template <class FA, class FB>
DI void gemm_main(f32x16 (&acc)[2][2], FA fa, FB fb, int K, char* smem) {
  bf16* As = (bf16*)smem;
  bf16* Bs = (bf16*)(smem + 2 * 128 * LDT * 2);
  const int tid = TIDX, lane = tid & 63, w = tid >> 6, wm = w >> 1, wn = w & 1;
  const int r = lane & 31, h = lane >> 5;
  const int lr = tid >> 3, kc = (tid & 7) * 8;
  const bf16* ap[4];
  const bf16* bp[4];
#pragma unroll
  for (int i = 0; i < 4; ++i) {
    const bf16* a = fa(lr + 32 * i);
    const bf16* b = fb(lr + 32 * i);
    ap[i] = a ? a + kc : nullptr;
    bp[i] = b ? b + kc : nullptr;
  }
  u32x4 ra[4], rb[4];
  const u32x4 z4 = {0u, 0u, 0u, 0u};
#pragma unroll
  for (int i = 0; i < 4; ++i) {
    ra[i] = ap[i] ? ldg16(ap[i]) : z4;
    rb[i] = bp[i] ? ldg16(bp[i]) : z4;
  }
#pragma unroll
  for (int i = 0; i < 4; ++i) {
    *(u32x4*)(As + (lr + 32 * i) * LDT + kc) = ra[i];
    *(u32x4*)(Bs + (lr + 32 * i) * LDT + kc) = rb[i];
  }
  __syncthreads();
  const int nk = K / 64;
  for (int kt = 0; kt < nk; ++kt) {
    const int buf = kt & 1;
    const bool more = (kt + 1 < nk);
    if (more) {
      const int k0 = (kt + 1) * 64;
#pragma unroll
      for (int i = 0; i < 4; ++i) {
        ra[i] = ap[i] ? ldg16(ap[i] + k0) : z4;
        rb[i] = bp[i] ? ldg16(bp[i] + k0) : z4;
      }
    }
    SCHED_FENCE();
    const bf16* Ab = As + buf * 128 * LDT + (wm * 64 + r) * LDT + h * 8;
    const bf16* Bb = Bs + buf * 128 * LDT + (wn * 64 + r) * LDT + h * 8;
#pragma unroll
    for (int s = 0; s < 4; ++s) {
      s16x8 a0 = *(const s16x8*)(Ab + s * 16);
      s16x8 a1 = *(const s16x8*)(Ab + 32 * LDT + s * 16);
      s16x8 b0 = *(const s16x8*)(Bb + s * 16);
      s16x8 b1 = *(const s16x8*)(Bb + 32 * LDT + s * 16);
      acc[0][0] = MFMA32(a0, b0, acc[0][0]);
      acc[0][1] = MFMA32(a0, b1, acc[0][1]);
      acc[1][0] = MFMA32(a1, b0, acc[1][0]);
      acc[1][1] = MFMA32(a1, b1, acc[1][1]);
    }
    SCHED_FENCE();
    if (more) {
      bf16* Aw = As + (buf ^ 1) * 128 * LDT;
      bf16* Bw = Bs + (buf ^ 1) * 128 * LDT;
#pragma unroll
      for (int i = 0; i < 4; ++i) {
        *(u32x4*)(Aw + (lr + 32 * i) * LDT + kc) = ra[i];
        *(u32x4*)(Bw + (lr + 32 * i) * LDT + kc) = rb[i];
      }
    }
    __syncthreads();
  }
}

template <class FA, class FB>
DI void gemm_main_deep(f32x16 (&acc)[2][2], FA fa, FB fb, int K, char* smem) {
  bf16* As = (bf16*)smem;
  bf16* Bs = (bf16*)(smem + 2 * 128 * LDT * 2);
  const int tid = TIDX, lane = tid & 63, w = tid >> 6, wm = w >> 1, wn = w & 1;
  const int r = lane & 31, h = lane >> 5;
  const int lr = tid >> 3, kc = (tid & 7) * 8;
  const bf16* ap[4];
  const bf16* bp[4];
#pragma unroll
  for (int i = 0; i < 4; ++i) {
    const bf16* a = fa(lr + 32 * i);
    const bf16* b = fb(lr + 32 * i);
    ap[i] = a ? a + kc : nullptr;
    bp[i] = b ? b + kc : nullptr;
  }
  const u32x4 z4 = {0u, 0u, 0u, 0u};
  u32x4 a0[4], b0[4], a1[4], b1[4];
  const int nk = K / 64;
#define GD_LOAD(RA, RB, T)                                               \
  {                                                                      \
    const int k0_ = (T) * 64;                                            \
    _Pragma("unroll") for (int i = 0; i < 4; ++i) {                      \
      RA[i] = ap[i] ? ldg16(ap[i] + k0_) : z4;                           \
      RB[i] = bp[i] ? ldg16(bp[i] + k0_) : z4;                           \
    }                                                                    \
  }
#define GD_STORE(RA, RB, BUF)                                            \
  {                                                                      \
    _Pragma("unroll") for (int i = 0; i < 4; ++i) {                      \
      *(u32x4*)(As + (BUF) * 128 * LDT + (lr + 32 * i) * LDT + kc) = RA[i]; \
      *(u32x4*)(Bs + (BUF) * 128 * LDT + (lr + 32 * i) * LDT + kc) = RB[i]; \
    }                                                                    \
  }
#define GD_COMPUTE(BUF)                                                  \
  {                                                                      \
    const bf16* Ab = As + (BUF) * 128 * LDT + (wm * 64 + r) * LDT + h * 8; \
    const bf16* Bb = Bs + (BUF) * 128 * LDT + (wn * 64 + r) * LDT + h * 8; \
    _Pragma("unroll") for (int s = 0; s < 4; ++s) {                      \
      s16x8 fa0 = *(const s16x8*)(Ab + s * 16);                          \
      s16x8 fa1 = *(const s16x8*)(Ab + 32 * LDT + s * 16);               \
      s16x8 fb0 = *(const s16x8*)(Bb + s * 16);                          \
      s16x8 fb1 = *(const s16x8*)(Bb + 32 * LDT + s * 16);               \
      acc[0][0] = MFMA32(fa0, fb0, acc[0][0]);                           \
      acc[0][1] = MFMA32(fa0, fb1, acc[0][1]);                           \
      acc[1][0] = MFMA32(fa1, fb0, acc[1][0]);                           \
      acc[1][1] = MFMA32(fa1, fb1, acc[1][1]);                           \
    }                                                                    \
  }
  GD_LOAD(a0, b0, 0)
  GD_LOAD(a1, b1, 1)
  GD_STORE(a0, b0, 0)
  __syncthreads();
  if (nk > 2) GD_LOAD(a0, b0, 2)
  for (int kt = 0; kt < nk; kt += 2) {
    SCHED_FENCE();
    GD_COMPUTE(0)
    SCHED_FENCE();
    GD_STORE(a1, b1, 1)
    if (kt + 3 < nk) GD_LOAD(a1, b1, kt + 3)
    __syncthreads();
    SCHED_FENCE();
    GD_COMPUTE(1)
    SCHED_FENCE();
    if (kt + 2 < nk) {
      GD_STORE(a0, b0, 0)
      if (kt + 4 < nk) GD_LOAD(a0, b0, kt + 4)
    }
    __syncthreads();
  }
#undef GD_LOAD
#undef GD_STORE
#undef GD_COMPUTE
}

template <class FA, class FB>
DI void gemm_main_dma(f32x16 (&acc)[2][2], FA fa, FB fb, int K, char* smem) {
  char* As = smem;
  char* Bs = smem + 32768;
  const int tid = TIDX, lane = tid & 63, w = tid >> 6, wm = w >> 1, wn = w & 1;
  const int r = lane & 31, h = lane >> 5;
  const bf16* ap[4];
  const bf16* bp[4];
#pragma unroll
  for (int i = 0; i < 4; ++i) {
    const int row = w * 32 + i * 8 + (lane >> 3);
    const int c = (lane & 7) ^ ((row >> 1) & 7);
    ap[i] = fa(row) + c * 8;
    bp[i] = fb(row) + c * 8;
  }
  const int ldst = (w * 256 + lane) * 16;
#define GM_DMA(BUF, T)                                                                                        \
  {                                                                                                           \
    const int k0_ = (T) * 64;                                                                                 \
    _Pragma("unroll") for (int i = 0; i < 4; ++i) {                                                           \
      __builtin_amdgcn_global_load_lds((const unsigned*)(ap[i] + k0_), (unsigned*)(As + (BUF) * 16384 + ldst + i * 1024), 16, 0, 0); \
      __builtin_amdgcn_global_load_lds((const unsigned*)(bp[i] + k0_), (unsigned*)(Bs + (BUF) * 16384 + ldst + i * 1024), 16, 0, 0); \
    }                                                                                                         \
  }
  const int xr = (r >> 1) & 7;
  const int arow = (wm * 64 + r) * 128, brow = (wn * 64 + r) * 128;
  GM_DMA(0, 0)
  asm volatile("s_waitcnt vmcnt(0)" ::: "memory");
  __syncthreads();
  const int nk = K / 64;
  for (int kt = 0; kt < nk; ++kt) {
    const int buf = kt & 1;
    if (kt + 1 < nk) GM_DMA(buf ^ 1, kt + 1)
    const char* Ab = As + buf * 16384 + arow;
    const char* Bb = Bs + buf * 16384 + brow;
#pragma unroll
    for (int s = 0; s < 4; ++s) {
      const int co = ((2 * s + h) ^ xr) * 16;
      s16x8 a0 = *(const s16x8*)(Ab + co);
      s16x8 a1 = *(const s16x8*)(Ab + 32 * 128 + co);
      s16x8 b0 = *(const s16x8*)(Bb + co);
      s16x8 b1 = *(const s16x8*)(Bb + 32 * 128 + co);
      acc[0][0] = MFMA32(a0, b0, acc[0][0]);
      acc[0][1] = MFMA32(a0, b1, acc[0][1]);
      acc[1][0] = MFMA32(a1, b0, acc[1][0]);
      acc[1][1] = MFMA32(a1, b1, acc[1][1]);
    }
    asm volatile("s_waitcnt vmcnt(0)" ::: "memory");
    __syncthreads();
  }
#undef GM_DMA
}

DI void gemm_main_dma_half(f32x16 (&acc)[2], const bf16* A, int lda, const bf16* B, int ldb, int K, int hf, char* smem) {
  char* As = smem;
  char* Bs = smem + 32768;
  const int tid = TIDX, lane = tid & 63, w = tid >> 6, wm = w >> 1, wn = w & 1;
  const int r = lane & 31, h = lane >> 5;
  const bf16* ap[4];
  const bf16* bp[2];
#pragma unroll
  for (int i = 0; i < 4; ++i) {
    const int row = w * 32 + i * 8 + (lane >> 3);
    ap[i] = A + (size_t)row * lda + ((lane & 7) ^ ((row >> 1) & 7)) * 8;
  }
#pragma unroll
  for (int i = 0; i < 2; ++i) {
    const int lrow = w * 16 + i * 8 + (lane >> 3);
    const int grow = (lrow >> 5) * 64 + hf * 32 + (lrow & 31);
    bp[i] = B + (size_t)grow * ldb + ((lane & 7) ^ ((lrow >> 1) & 7)) * 8;
  }
  const int lda_ = (w * 256 + lane) * 16, ldb_ = (w * 128 + lane) * 16;
#define GH_DMA(BUF, T)                                                                                        \
  {                                                                                                           \
    const int k0_ = (T) * 64;                                                                                 \
    _Pragma("unroll") for (int i = 0; i < 4; ++i)                                                             \
      __builtin_amdgcn_global_load_lds((const unsigned*)(ap[i] + k0_), (unsigned*)(As + (BUF) * 16384 + lda_ + i * 1024), 16, 0, 0); \
    _Pragma("unroll") for (int i = 0; i < 2; ++i)                                                             \
      __builtin_amdgcn_global_load_lds((const unsigned*)(bp[i] + k0_), (unsigned*)(Bs + (BUF) * 8192 + ldb_ + i * 1024), 16, 0, 0); \
  }
  const int xr = (r >> 1) & 7;
  const int arow = (wm * 64 + r) * 128, brow = (wn * 32 + r) * 128;
  GH_DMA(0, 0)
  asm volatile("s_waitcnt vmcnt(0)" ::: "memory");
  __syncthreads();
  const int nk = K / 64;
  for (int kt = 0; kt < nk; ++kt) {
    const int buf = kt & 1;
    if (kt + 1 < nk) GH_DMA(buf ^ 1, kt + 1)
    const char* Ab = As + buf * 16384 + arow;
    const char* Bb = Bs + buf * 8192 + brow;
#pragma unroll
    for (int s = 0; s < 4; ++s) {
      const int co = ((2 * s + h) ^ xr) * 16;
      s16x8 a0 = *(const s16x8*)(Ab + co);
      s16x8 a1 = *(const s16x8*)(Ab + 32 * 128 + co);
      s16x8 b0 = *(const s16x8*)(Bb + co);
      acc[0] = MFMA32(a0, b0, acc[0]);
      acc[1] = MFMA32(a1, b0, acc[1]);
    }
    asm volatile("s_waitcnt vmcnt(0)" ::: "memory");
    __syncthreads();
  }
#undef GH_DMA
}

template <class FA, class FB>
DI void gemm_wide(f32x16 (&acc)[2][4], FA fa, FB fb, int K, char* smem) {
  const int tid = TIDX, lane = tid & 63, w = tid >> 6, wm = w >> 1, wn = w & 1;
  const int r = lane & 31, h = lane >> 5;
  const bf16* ap[2];
  const bf16* bp[4];
#pragma unroll
  for (int i = 0; i < 2; ++i) {
    const int row = w * 32 + i * 16 + (lane >> 2);
    ap[i] = fa(row) + ((lane & 3) ^ ((row >> 2) & 3)) * 8;
  }
#pragma unroll
  for (int i = 0; i < 4; ++i) {
    const int row = w * 64 + i * 16 + (lane >> 2);
    bp[i] = fb(row) + ((lane & 3) ^ ((row >> 2) & 3)) * 8;
  }
  const int lda_ = (w * 128 + lane) * 16;
  const int ldb_ = 8192 + (w * 256 + lane) * 16;
#define GW_DMA(T)                                                                                                   \
  {                                                                                                                 \
    char* st_ = smem + ((T) % 3) * 24576;                                                                           \
    const int k0_ = (T) * 32;                                                                                       \
    _Pragma("unroll") for (int i = 0; i < 2; ++i)                                                                   \
      __builtin_amdgcn_global_load_lds((const unsigned*)(ap[i] + k0_), (unsigned*)(st_ + lda_ + i * 1024), 16, 0, 0); \
    _Pragma("unroll") for (int i = 0; i < 4; ++i)                                                                   \
      __builtin_amdgcn_global_load_lds((const unsigned*)(bp[i] + k0_), (unsigned*)(st_ + ldb_ + i * 1024), 16, 0, 0); \
  }
  const int xr = (r >> 2) & 3;
  const int arow = (wm * 64 + r) * 64;
  const int brow = 8192 + (wn * 64 + r) * 64;
  const int nt = K / 32;
  GW_DMA(0)
  if (nt > 1) GW_DMA(1)
  for (int t = 0; t < nt; ++t) {
    if (t + 1 < nt) asm volatile("s_waitcnt vmcnt(6)" ::: "memory");
    else asm volatile("s_waitcnt vmcnt(0)" ::: "memory");
    __syncthreads();
    if (t + 2 < nt) GW_DMA(t + 2)
    const char* st = smem + (t % 3) * 24576;
#pragma unroll
    for (int s = 0; s < 2; ++s) {
      const int co = ((2 * s + h) ^ xr) * 16;
      const s16x8 a0 = *(const s16x8*)(st + arow + co);
      const s16x8 a1 = *(const s16x8*)(st + arow + 32 * 64 + co);
#pragma unroll
      for (int hn = 0; hn < 2; ++hn) {
        const s16x8 b0 = *(const s16x8*)(st + brow + hn * 128 * 64 + co);
        const s16x8 b1 = *(const s16x8*)(st + brow + hn * 128 * 64 + 32 * 64 + co);
        acc[0][hn * 2 + 0] = MFMA32(a0, b0, acc[0][hn * 2 + 0]);
        acc[0][hn * 2 + 1] = MFMA32(a0, b1, acc[0][hn * 2 + 1]);
        acc[1][hn * 2 + 0] = MFMA32(a1, b0, acc[1][hn * 2 + 0]);
        acc[1][hn * 2 + 1] = MFMA32(a1, b1, acc[1][hn * 2 + 1]);
      }
    }
  }
  __syncthreads();
#undef GW_DMA
}

DI void accw_zero(f32x16 (&acc)[2][4]) {
#pragma unroll
  for (int a = 0; a < 2; ++a)
#pragma unroll
    for (int b = 0; b < 4; ++b)
#pragma unroll
      for (int i = 0; i < 16; ++i) acc[a][b][i] = 0.f;
}

DI void gemm_main_s(f32x16 (&acc)[2][2], const bf16* A, int lda, const bf16* B, int ldb, int K, char* smem) {
  bf16* As = (bf16*)smem;
  bf16* Bs = (bf16*)(smem + 2 * 128 * LDT * 2);
  const int tid = TIDX, lane = tid & 63, w = tid >> 6, wm = w >> 1, wn = w & 1;
  const int r = lane & 31, h = lane >> 5;
  const int lr = tid >> 3, kc = (tid & 7) * 8;
  const bf16* ap = A + (size_t)lr * lda + kc;
  const bf16* bp = B + (size_t)lr * ldb + kc;
  const size_t sa = (size_t)32 * lda, sb = (size_t)32 * ldb;
  u32x4 ra[4], rb[4];
#pragma unroll
  for (int i = 0; i < 4; ++i) {
    ra[i] = ldg16(ap + i * sa);
    rb[i] = ldg16(bp + i * sb);
  }
#pragma unroll
  for (int i = 0; i < 4; ++i) {
    *(u32x4*)(As + (lr + 32 * i) * LDT + kc) = ra[i];
    *(u32x4*)(Bs + (lr + 32 * i) * LDT + kc) = rb[i];
  }
  __syncthreads();
  const int nk = K / 64;
  for (int kt = 0; kt < nk; ++kt) {
    const int buf = kt & 1;
    const bool more = (kt + 1 < nk);
    if (more) {
      ap += 64; bp += 64;
#pragma unroll
      for (int i = 0; i < 4; ++i) {
        ra[i] = ldg16(ap + i * sa);
        rb[i] = ldg16(bp + i * sb);
      }
    }
    SCHED_FENCE();
    const bf16* Ab = As + buf * 128 * LDT + (wm * 64 + r) * LDT + h * 8;
    const bf16* Bb = Bs + buf * 128 * LDT + (wn * 64 + r) * LDT + h * 8;
#pragma unroll
    for (int s = 0; s < 4; ++s) {
      s16x8 a0 = *(const s16x8*)(Ab + s * 16);
      s16x8 a1 = *(const s16x8*)(Ab + 32 * LDT + s * 16);
      s16x8 b0 = *(const s16x8*)(Bb + s * 16);
      s16x8 b1 = *(const s16x8*)(Bb + 32 * LDT + s * 16);
      acc[0][0] = MFMA32(a0, b0, acc[0][0]);
      acc[0][1] = MFMA32(a0, b1, acc[0][1]);
      acc[1][0] = MFMA32(a1, b0, acc[1][0]);
      acc[1][1] = MFMA32(a1, b1, acc[1][1]);
    }
    SCHED_FENCE();
    if (more) {
      bf16* Aw = As + (buf ^ 1) * 128 * LDT;
      bf16* Bw = Bs + (buf ^ 1) * 128 * LDT;
#pragma unroll
      for (int i = 0; i < 4; ++i) {
        *(u32x4*)(Aw + (lr + 32 * i) * LDT + kc) = ra[i];
        *(u32x4*)(Bw + (lr + 32 * i) * LDT + kc) = rb[i];
      }
    }
    __syncthreads();
  }
}

DI void gemm_main_half(f32x16 (&acc)[2], const bf16* A, int lda, const bf16* B, int ldb, int K, int hf, char* smem) {
  bf16* As = (bf16*)smem;
  bf16* Bs = (bf16*)(smem + 2 * 128 * LDT * 2);
  const int tid = TIDX, lane = tid & 63, w = tid >> 6, wm = w >> 1, wn = w & 1;
  const int r = lane & 31, h = lane >> 5;
  const int lr = tid >> 3, kc = (tid & 7) * 8;
  const bf16* ap = A + (size_t)lr * lda + kc;
  const bf16* bp = B + (size_t)(hf * 32 + lr) * ldb + kc;
  const size_t sa = (size_t)32 * lda, sb = (size_t)64 * ldb;
  u32x4 ra[4], rb[2];
#pragma unroll
  for (int i = 0; i < 4; ++i) ra[i] = ldg16(ap + i * sa);
#pragma unroll
  for (int i = 0; i < 2; ++i) rb[i] = ldg16(bp + i * sb);
#pragma unroll
  for (int i = 0; i < 4; ++i) *(u32x4*)(As + (lr + 32 * i) * LDT + kc) = ra[i];
#pragma unroll
  for (int i = 0; i < 2; ++i) *(u32x4*)(Bs + (lr + 32 * i) * LDT + kc) = rb[i];
  __syncthreads();
  const int nk = K / 64;
  for (int kt = 0; kt < nk; ++kt) {
    const int buf = kt & 1;
    const bool more = (kt + 1 < nk);
    if (more) {
      ap += 64; bp += 64;
#pragma unroll
      for (int i = 0; i < 4; ++i) ra[i] = ldg16(ap + i * sa);
#pragma unroll
      for (int i = 0; i < 2; ++i) rb[i] = ldg16(bp + i * sb);
    }
    SCHED_FENCE();
    const bf16* Ab = As + buf * 128 * LDT + (wm * 64 + r) * LDT + h * 8;
    const bf16* Bb = Bs + buf * 128 * LDT + (wn * 32 + r) * LDT + h * 8;
#pragma unroll
    for (int s = 0; s < 4; ++s) {
      s16x8 a0 = *(const s16x8*)(Ab + s * 16);
      s16x8 a1 = *(const s16x8*)(Ab + 32 * LDT + s * 16);
      s16x8 b0 = *(const s16x8*)(Bb + s * 16);
      acc[0] = MFMA32(a0, b0, acc[0]);
      acc[1] = MFMA32(a1, b0, acc[1]);
    }
    SCHED_FENCE();
    if (more) {
      bf16* Aw = As + (buf ^ 1) * 128 * LDT;
      bf16* Bw = Bs + (buf ^ 1) * 128 * LDT;
#pragma unroll
      for (int i = 0; i < 4; ++i) *(u32x4*)(Aw + (lr + 32 * i) * LDT + kc) = ra[i];
#pragma unroll
      for (int i = 0; i < 2; ++i) *(u32x4*)(Bw + (lr + 32 * i) * LDT + kc) = rb[i];
    }
    __syncthreads();
  }
}

DI void acc_zero(f32x16 (&acc)[2][2]) {
#pragma unroll
  for (int a = 0; a < 2; ++a)
#pragma unroll
    for (int b = 0; b < 2; ++b)
#pragma unroll
      for (int i = 0; i < 16; ++i) acc[a][b][i] = 0.f;
}

DI void acc_to_lds(const f32x16 (&acc)[2][2], float* Cs) {
  const int lane = TIDX & 63, w = TIDX >> 6, wm = w >> 1, wn = w & 1, r = lane & 31, h = lane >> 5;
#pragma unroll
  for (int tm = 0; tm < 2; ++tm)
#pragma unroll
    for (int tn = 0; tn < 2; ++tn)
#pragma unroll
      for (int i = 0; i < 16; ++i) Cs[(wm * 64 + tm * 32 + crow(i, h)) * CLD + wn * 64 + tn * 32 + r] = acc[tm][tn][i];
}

template <int HN>
DI void accw_to_lds(const f32x16 (&acc)[2][4], float* Cs) {
  const int lane = TIDX & 63, w = TIDX >> 6, wm = w >> 1, wn = w & 1, r = lane & 31, h = lane >> 5;
#pragma unroll
  for (int tm = 0; tm < 2; ++tm)
#pragma unroll
    for (int tn = 0; tn < 2; ++tn)
#pragma unroll
      for (int i = 0; i < 16; ++i) Cs[(wm * 64 + tm * 32 + crow(i, h)) * CLD + wn * 64 + tn * 32 + r] = acc[tm][HN * 2 + tn][i];
}

DI void store_tile_bf16(const float* Cs, bf16* dst, size_t ld, int mvalid, float scale) {
  for (int c = TIDX; c < 2048; c += 256) {
    const int row = c >> 4, cc = (c & 15) * 8;
    if (row < mvalid) {
      const float* s = Cs + row * CLD + cc;
      u32x4 v;
      v[0] = pack2(s[0] * scale, s[1] * scale);
      v[1] = pack2(s[2] * scale, s[3] * scale);
      v[2] = pack2(s[4] * scale, s[5] * scale);
      v[3] = pack2(s[6] * scale, s[7] * scale);
      *(u32x4*)(dst + (size_t)row * ld + cc) = v;
    }
  }
}

DI float* resid_row(const Params& p, int tok) {
  const int b = tok / TT, t = tok - b * TT;
  return (t < CTXL) ? (float*)(p.ws + OFF_XC) + ((size_t)b * CTXL + t) * DM : p.out + ((size_t)b * SEQ + (t - CTXL)) * DM;
}
DI const float* mod_vec(const Params& p, int l, int tok, int which) {
  const int b = tok / TT, t = tok - b * TT;
  const int m = (t < CTXL) ? 4 : b;
  return (const float*)(p.ws + OFF_MOD) + ((size_t)(l * 5 + m) * 6 + which) * DM;
}
DI float wave_sum(float v) {
#pragma unroll
  for (int o = 32; o >= 1; o >>= 1) v += __shfl_xor(v, o, 64);
  return v;
}
DI bf16* wl(const Params& p, int l, size_t off) { return (bf16*)(p.ws + OFF_W) + (size_t)l * WL_TOTAL + off; }

DI void prep_mod_job(const Params& p, int j, char* smem) {
  float* sc = (float*)smem;
  float* part = (float*)(smem + 20480);
  const int l = j / 24, nb = j % 24, tid = TIDX, lane = tid & 63, w = tid >> 6;
  for (int idx = tid; idx < 5120; idx += 256) {
    const int m = idx >> 10, k = idx & 1023;
    const float v = (m < 4) ? p.in[I_C][m * 1024 + k] : p.in[I_CCTX][k];
    sc[idx] = siluf_(v);
  }
  __syncthreads();
  const float* W = p.in[I_ADAW] + (size_t)l * 1024 * 6144 + nb * 256 + lane;
  float a[5][4];
#pragma unroll
  for (int m = 0; m < 5; ++m)
#pragma unroll
    for (int c = 0; c < 4; ++c) a[m][c] = 0.f;
#pragma unroll 4
  for (int kk = 0; kk < 256; ++kk) {
    const int k = w * 256 + kk;
    float wv[4];
#pragma unroll
    for (int c = 0; c < 4; ++c) wv[c] = W[(size_t)k * 6144 + 64 * c];
#pragma unroll
    for (int m = 0; m < 5; ++m) {
      const float sv = sc[m * 1024 + k];
#pragma unroll
      for (int c = 0; c < 4; ++c) a[m][c] += sv * wv[c];
    }
  }
#pragma unroll
  for (int m = 0; m < 5; ++m)
#pragma unroll
    for (int c = 0; c < 4; ++c) part[(w * 5 + m) * 256 + lane + 64 * c] = a[m][c];
  __syncthreads();
  const int n = nb * 256 + tid;
  const float bb = p.in[I_ADAB][l * 6144 + n];
  float* M = (float*)(p.ws + OFF_MOD) + (size_t)l * 5 * 6144 + n;
#pragma unroll
  for (int m = 0; m < 5; ++m)
    M[m * 6144] = part[(0 * 5 + m) * 256 + tid] + part[(1 * 5 + m) * 256 + tid] + part[(2 * 5 + m) * 256 + tid] + part[(3 * 5 + m) * 256 + tid] + bb;
  __syncthreads();
}

DI void prep_s5_job(const Params& p, int j) {
  const int idx = j * 256 + TIDX;
  const int ldg = idx >> 6, pp = idx & 63;
  const float dt = expf(p.in[I_LDT][ldg]);
  const float are = p.in[I_ARE][idx], aim = p.in[I_AIM][idx];
  const float mag = expf(are * dt);
  float sn, cs;
  sincos_cw(aim * dt, sn, cs);
  const float abr = mag * cs, abi = mag * sn;
  const float den = are * are + aim * aim;
  const float fre = ((abr - 1.f) * are + abi * aim) / den;
  const float fim = (abi * are - (abr - 1.f) * aim) / den;
  float* BBR = (float*)(p.ws + OFF_BBR);
  float* BBI = (float*)(p.ws + OFF_BBI);
  for (int hh = 0; hh < 16; ++hh) {
    const float br = p.in[I_BRE][(size_t)idx * 16 + hh], bi = p.in[I_BIM][(size_t)idx * 16 + hh];
    BBR[(size_t)idx * 16 + hh] = fre * br - fim * bi;
    BBI[(size_t)idx * 16 + hh] = fre * bi + fim * br;
  }
  float2* PW = (float2*)(p.ws + OFF_PWR);
  float pr = 1.f, pi = 0.f;
  for (int tau = 0; tau <= 32; ++tau) {
    PW[((size_t)ldg * 33 + tau) * 64 + pp] = make_float2(pr, pi);
    const float nr = pr * abr - pi * abi, ni = pr * abi + pi * abr;
    pr = nr; pi = ni;
  }
}

DI void prep_wt_job(const Params& p, int jj, char* smem) {
  float* tile = (float*)smem;
  const int l = jj / 4016;
  int r = jj % 4016;
  int mat = 0;
  const int cnt[8] = {1376, 64, 128, 64, 256, 1408, 704, 16};
#pragma unroll
  for (int m = 0; m < 8; ++m) {
    if (mat == m && r >= cnt[m]) { r -= cnt[m]; mat = m + 1; }
  }
  const float* src; int K, sld; size_t doff;
  switch (mat) {
    case 0: src = p.in[I_WIN] + (size_t)l * 1024 * DIN; K = 1024; sld = DIN; doff = WL_WIN; break;
    case 1: src = p.in[I_WBA] + (size_t)l * 256 * 1024; K = 256; sld = 1024; doff = WL_BRA; break;
    case 2: src = p.in[I_WBG] + (size_t)l * 512 * 1024; K = 512; sld = 1024; doff = WL_BRG; break;
    case 3: src = p.in[I_WBS] + (size_t)l * 256 * 1024; K = 256; sld = 1024; doff = WL_BRS; break;
    case 4: src = p.in[I_WOUT] + (size_t)l * 1024 * 1024; K = 1024; sld = 1024; doff = WL_WOUT; break;
    case 5: src = p.in[I_UP] + (size_t)l * 1024 * 5632; K = 1024; sld = 5632; doff = WL_UP; break;
    case 6: src = p.in[I_DOWN] + (size_t)l * 2816 * 1024; K = 2816; sld = 1024; doff = WL_DOWN; break;
    default: src = p.in[I_GLUW] + (size_t)l * 256 * 256; K = 256; sld = 256; doff = WL_GLU; break;
  }
  const int kt = K / 64;
  const int n0 = (r / kt) * 64, k0 = (r % kt) * 64;
  const int tid = TIDX;
  {
    const int nn = tid & 63;
    const int np = n0 + nn;
    int col;
    if (mat == 0) {
      if (np < 2048) col = np;
      else if (np < 2304) col = 2080 + (np - 2048);
      else if (np < 2336) col = 2048 + (np - 2304);
      else if (np < 2432) col = -1;
      else col = 2336 + (np - 2432);
    } else if (mat == 5) {
      const int jb = np >> 7, c = np & 127;
      col = (c < 64) ? (jb * 64 + c) : (DFF + jb * 64 + (c - 64));
    } else col = np;
#pragma unroll 4
    for (int kk = tid >> 6; kk < 64; kk += 4) tile[kk * 65 + nn] = (col >= 0) ? src[(size_t)(k0 + kk) * sld + col] : 0.f;
  }
  __syncthreads();
  {
    const int nn = tid >> 2, kq = (tid & 3) * 16;
    bf16* d = wl(p, l, doff) + (size_t)(n0 + nn) * K + k0 + kq;
    u32x4 v0, v1;
#pragma unroll
    for (int e = 0; e < 4; ++e) {
      v0[e] = pack2(tile[(kq + 2 * e) * 65 + nn], tile[(kq + 2 * e + 1) * 65 + nn]);
      v1[e] = pack2(tile[(kq + 8 + 2 * e) * 65 + nn], tile[(kq + 8 + 2 * e + 1) * 65 + nn]);
    }
    *(u32x4*)d = v0;
    *(u32x4*)(d + 8) = v1;
  }
  __syncthreads();
}

template <int MODE>
DI void row_job(const Params& p, int l, int tok) {
  const int lane = TIDX & 63;
  float x[16];
  float* xr = resid_row(p, tok);
  if (MODE == 0) {
    const int b = tok / TT, t = tok - b * TT;
    const float* src = (t < CTXL) ? p.in[I_CTX] + ((size_t)b * CTXL + t) * DM : p.in[I_X] + ((size_t)b * SEQ + (t - CTXL)) * DM;
#pragma unroll
    for (int i = 0; i < 4; ++i) {
      const f32x4 v = *(const f32x4*)(src + lane * 4 + 256 * i);
      x[4 * i] = v[0]; x[4 * i + 1] = v[1]; x[4 * i + 2] = v[2]; x[4 * i + 3] = v[3];
      *(f32x4*)(xr + lane * 4 + 256 * i) = v;
    }
  } else {
    const bf16* yr = (const bf16*)(p.ws + OFF_H) + (size_t)tok * DM;
    const float* gpost = p.in[MODE == 1 ? I_NMPOST : I_NFPOST] + l * DM;
    const float* mg = mod_vec(p, l, tok, MODE == 1 ? 2 : 5);
    float y[16];
    float ss = 0.f;
#pragma unroll
    for (int i = 0; i < 4; ++i) {
      const u32x2 u = *(const u32x2*)(yr + lane * 4 + 256 * i);
      y[4 * i] = bflo(u[0]); y[4 * i + 1] = bfhi(u[0]); y[4 * i + 2] = bflo(u[1]); y[4 * i + 3] = bfhi(u[1]);
#pragma unroll
      for (int e = 0; e < 4; ++e) ss += y[4 * i + e] * y[4 * i + e];
    }
    ss = wave_sum(ss);
    const float rstd = rsqrtf(ss * (1.f / DM) + EPSF);
#pragma unroll
    for (int i = 0; i < 4; ++i) {
      f32x4 v = *(const f32x4*)(xr + lane * 4 + 256 * i);
      const f32x4 g = *(const f32x4*)(gpost + lane * 4 + 256 * i);
      const f32x4 m = *(const f32x4*)(mg + lane * 4 + 256 * i);
#pragma unroll
      for (int e = 0; e < 4; ++e) { v[e] += m[e] * (y[4 * i + e] * rstd * g[e]); x[4 * i + e] = v[e]; }
      *(f32x4*)(xr + lane * 4 + 256 * i) = v;
    }
  }
  if (MODE == 2 && l == NL - 1) return;
  const int ln = (MODE == 2) ? l + 1 : l;
  const float* gpre = p.in[MODE == 1 ? I_NFPRE : I_NMPRE] + ln * DM;
  const float* sh = mod_vec(p, ln, tok, MODE == 1 ? 3 : 0);
  const float* scv = mod_vec(p, ln, tok, MODE == 1 ? 4 : 1);
  float ss = 0.f;
#pragma unroll
  for (int i = 0; i < 16; ++i) ss += x[i] * x[i];
  ss = wave_sum(ss);
  const float rstd = rsqrtf(ss * (1.f / DM) + EPSF);
  bf16* hr = (bf16*)(p.ws + OFF_H) + (size_t)tok * DM;
#pragma unroll
  for (int i = 0; i < 4; ++i) {
    const f32x4 g = *(const f32x4*)(gpre + lane * 4 + 256 * i);
    const f32x4 s1 = *(const f32x4*)(sh + lane * 4 + 256 * i);
    const f32x4 s2 = *(const f32x4*)(scv + lane * 4 + 256 * i);
    float o[4];
#pragma unroll
    for (int e = 0; e < 4; ++e) o[e] = (x[4 * i + e] * rstd * g[e]) * (1.f + s2[e]) + s1[e];
    u32x2 u;
    u[0] = pack2(o[0], o[1]); u[1] = pack2(o[2], o[3]);
    *(u32x2*)(hr + lane * 4 + 256 * i) = u;
  }
}

template <int MODE>
DI void row_phase(const Params& p, int l, int bid, int G) {
  const int lane = TIDX & 63;
  const int wg = bid * 4 + (TIDX >> 6), nw = G * 4;
  const int R = (NTOK + nw - 1) / nw;
  const int t0 = wg * R, t1 = min(NTOK, t0 + R);
  if (t0 >= t1) return;
  const bool has_next = !(MODE == 2 && l == NL - 1);
  const int ln = (MODE == 2) ? l + 1 : l;
  f32x4 gpost[4], gpre[4], mg[4], sh[4], scl[4];
#pragma unroll
  for (int i = 0; i < 4; ++i) {
    if (MODE != 0) gpost[i] = *(const f32x4*)(p.in[MODE == 1 ? I_NMPOST : I_NFPOST] + l * DM + lane * 4 + 256 * i);
    if (has_next) gpre[i] = *(const f32x4*)(p.in[MODE == 1 ? I_NFPRE : I_NMPRE] + ln * DM + lane * 4 + 256 * i);
  }
  int cur_m = -1;
  u32x2 yb[4], yn[4];
  f32x4 xb[4], xn[4];
  const bf16* Hb = (const bf16*)(p.ws + OFF_H);
#define ROW_LOAD(TOK, YY, XX)                                                                              \
  {                                                                                                        \
    const int b_ = (TOK) / TT, t_ = (TOK) - b_ * TT;                                                       \
    const float* src_ = (MODE == 0) ? ((t_ < CTXL) ? p.in[I_CTX] + ((size_t)b_ * CTXL + t_) * DM           \
                                                   : p.in[I_X] + ((size_t)b_ * SEQ + (t_ - CTXL)) * DM)    \
                                    : resid_row(p, (TOK));                                                 \
    _Pragma("unroll") for (int i = 0; i < 4; ++i) {                                                        \
      XX[i] = *(const f32x4*)(src_ + lane * 4 + 256 * i);                                                  \
      if (MODE != 0) YY[i] = *(const u32x2*)(Hb + (size_t)(TOK) * DM + lane * 4 + 256 * i);                \
    }                                                                                                      \
  }
  ROW_LOAD(t0, yb, xb)
  for (int tok = t0; tok < t1; ++tok) {
    if (tok + 1 < t1) ROW_LOAD(tok + 1, yn, xn)
    const int b = tok / TT, t = tok - b * TT;
    const int m = (t < CTXL) ? 4 : b;
    if (m != cur_m) {
      cur_m = m;
      const float* Mv = (const float*)(p.ws + OFF_MOD);
#pragma unroll
      for (int i = 0; i < 4; ++i) {
        if (MODE != 0) mg[i] = *(const f32x4*)(Mv + ((size_t)(l * 5 + m) * 6 + (MODE == 1 ? 2 : 5)) * DM + lane * 4 + 256 * i);
        if (has_next) {
          sh[i] = *(const f32x4*)(Mv + ((size_t)(ln * 5 + m) * 6 + (MODE == 1 ? 3 : 0)) * DM + lane * 4 + 256 * i);
          scl[i] = *(const f32x4*)(Mv + ((size_t)(ln * 5 + m) * 6 + (MODE == 1 ? 4 : 1)) * DM + lane * 4 + 256 * i);
        }
      }
    }
    float* xr = resid_row(p, tok);
    f32x4 x[4];
    if (MODE == 0) {
#pragma unroll
      for (int i = 0; i < 4; ++i) { x[i] = xb[i]; *(f32x4*)(xr + lane * 4 + 256 * i) = x[i]; }
    } else {
      float y[16];
      float ss = 0.f;
#pragma unroll
      for (int i = 0; i < 4; ++i) {
        y[4 * i] = bflo(yb[i][0]); y[4 * i + 1] = bfhi(yb[i][0]); y[4 * i + 2] = bflo(yb[i][1]); y[4 * i + 3] = bfhi(yb[i][1]);
#pragma unroll
        for (int e = 0; e < 4; ++e) ss += y[4 * i + e] * y[4 * i + e];
      }
      ss = wave_sum(ss);
      const float rstd = rsqrtf(ss * (1.f / DM) + EPSF);
#pragma unroll
      for (int i = 0; i < 4; ++i) {
        f32x4 v = xb[i];
#pragma unroll
        for (int e = 0; e < 4; ++e) v[e] += mg[i][e] * (y[4 * i + e] * rstd * gpost[i][e]);
        x[i] = v;
        *(f32x4*)(xr + lane * 4 + 256 * i) = v;
      }
    }
    if (has_next) {
      float ss = 0.f;
#pragma unroll
      for (int i = 0; i < 4; ++i)
#pragma unroll
        for (int e = 0; e < 4; ++e) ss += x[i][e] * x[i][e];
      ss = wave_sum(ss);
      const float rstd = rsqrtf(ss * (1.f / DM) + EPSF);
      bf16* hr = (bf16*)(p.ws + OFF_H) + (size_t)tok * DM;
#pragma unroll
      for (int i = 0; i < 4; ++i) {
        float o[4];
#pragma unroll
        for (int e = 0; e < 4; ++e) o[e] = (x[i][e] * rstd * gpre[i][e]) * (1.f + scl[i][e]) + sh[i][e];
        u32x2 u;
        u[0] = pack2(o[0], o[1]); u[1] = pack2(o[2], o[3]);
        *(u32x2*)(hr + lane * 4 + 256 * i) = u;
      }
    }
#pragma unroll
    for (int i = 0; i < 4; ++i) { yb[i] = yn[i]; xb[i] = xn[i]; }
  }
#undef ROW_LOAD
}

DI void ktab_phase(const Params& p, int bid, int G, int l_lo, int l_hi) {
  const float* BBR = (const float*)(p.ws + OFF_BBR);
  const float* BBI = (const float*)(p.ws + OFF_BBI);
  const float2* PW = (const float2*)(p.ws + OFF_PWR);
  float* KT = (float*)(p.ws + OFF_KTAB);
  const int per_layer = 16 * 2 * 32 * 256;
  for (int idx = l_lo * per_layer + bid * 256 + TIDX; idx < l_hi * per_layer; idx += G * 256) {
    const int hp = idx & 15, hh = (idx >> 4) & 15, tau = (idx >> 8) & 31, d = (idx >> 13) & 1, g = (idx >> 14) & 15, l = idx >> 18;
    const int ldg = (l * 2 + d) * 16 + g;
    const float* cre = p.in[I_CRE] + ((size_t)ldg * 16 + hh) * 64;
    const float* cim = p.in[I_CIM] + ((size_t)ldg * 16 + hh) * 64;
    float acc = 0.f;
    for (int pp = 0; pp < 64; ++pp) {
      const float2 pw = PW[((size_t)ldg * 33 + tau) * 64 + pp];
      const float br = BBR[((size_t)ldg * 64 + pp) * 16 + hp], bi = BBI[((size_t)ldg * 64 + pp) * 16 + hp];
      const float zr = pw.x * br - pw.y * bi, zi = pw.x * bi + pw.y * br;
      acc += cre[pp] * zr - cim[pp] * zi;
    }
    KT[idx] = acc;
  }
}

DI void s5mat_phase(const Params& p, int l, int bid, int G) {
  const float* BBR = (const float*)(p.ws + OFF_BBR);
  const float* BBI = (const float*)(p.ws + OFF_BBI);
  const float2* PW = (const float2*)(p.ws + OFF_PWR);
  const float* KT = (const float*)(p.ws + OFF_KTAB);
  bf16* T5 = (bf16*)(p.ws + OFF_T5);
  bf16* E5 = (bf16*)(p.ws + OFF_E5);
  bf16* F5 = (bf16*)(p.ws + OFF_F5);
  const int nT = 16 * 512 * 64, nE = 16 * 512 * 32, nF = 16 * 256 * 64;
  for (int it = bid * 256 + TIDX; it < nT + nE + nF; it += G * 256) {
    float v[8];
    bf16* dst;
    if (it < nT) {
      const int k8 = it & 63, n = (it >> 6) & 511, g = it >> 15;
      const int i = n >> 4, hh = n & 15, j = k8 >> 1, hp0 = (k8 & 1) * 8;
#pragma unroll
      for (int e = 0; e < 8; ++e) {
        const int hp = hp0 + e;
        float a = 0.f;
        if (j <= i) a += KT[((((size_t)l * 16 + g) * 2 + 0) * 32 + (i - j)) * 256 + hh * 16 + hp];
        if (j >= i) a += KT[((((size_t)l * 16 + g) * 2 + 1) * 32 + (j - i)) * 256 + hh * 16 + hp];
        if (i == j && hh == hp) a += p.in[I_S5D][l * 256 + g * 16 + hh];
        v[e] = a;
      }
      dst = T5 + ((size_t)g * 512 + n) * 512 + k8 * 8;
    } else if (it < nT + nE) {
      const int q = it - nT;
      const int k8 = q & 31, n = (q >> 5) & 511, g = q >> 14;
      const int i = n >> 4, hh = n & 15;
      const int k0 = k8 * 8, d = k0 >> 7, ri = (k0 >> 6) & 1, p0 = k0 & 63;
      const int ldg = (l * 2 + d) * 16 + g;
      const int ex = d ? (32 - i) : (i + 1);
#pragma unroll
      for (int e = 0; e < 8; ++e) {
        const int pp = p0 + e;
        const float2 pw = PW[((size_t)ldg * 33 + ex) * 64 + pp];
        const float cr = p.in[I_CRE][((size_t)ldg * 16 + hh) * 64 + pp], ci = p.in[I_CIM][((size_t)ldg * 16 + hh) * 64 + pp];
        const float zr = cr * pw.x - ci * pw.y, zi = cr * pw.y + ci * pw.x;
        v[e] = ri ? -zi : zr;
      }
      dst = E5 + ((size_t)g * 512 + n) * 256 + k0;
    } else {
      const int q = it - nT - nE;
      const int k8 = q & 63, n = (q >> 6) & 255, g = q >> 14;
      const int d = n >> 7, ri = (n >> 6) & 1, pp = n & 63;
      const int j = k8 >> 1, hp0 = (k8 & 1) * 8;
      const int ldg = (l * 2 + d) * 16 + g;
      const int ex = d ? j : (31 - j);
      const float2 pw = PW[((size_t)ldg * 33 + ex) * 64 + pp];
#pragma unroll
      for (int e = 0; e < 8; ++e) {
        const float br = BBR[((size_t)ldg * 64 + pp) * 16 + hp0 + e], bi = BBI[((size_t)ldg * 64 + pp) * 16 + hp0 + e];
        v[e] = ri ? (pw.x * bi + pw.y * br) : (pw.x * br - pw.y * bi);
      }
      dst = F5 + ((size_t)g * 256 + n) * 512 + k8 * 8;
    }
    u32x4 u;
    u[0] = pack2(v[0], v[1]); u[1] = pack2(v[2], v[3]); u[2] = pack2(v[4], v[5]); u[3] = pack2(v[6], v[7]);
    *(u32x4*)dst = u;
  }
}

DI void proj_epi(const Params& p, int l, int mt, int nt, char* smem);
DI void proj_wide(const Params& p, int l, int mt, int np, char* smem) {
  const bf16* H = (const bf16*)(p.ws + OFF_H) + (size_t)mt * 128 * DM;
  const bf16* W = wl(p, l, WL_WIN) + (size_t)np * 256 * DM;
  if (np == 9) {
    f32x16 acc1[2][2];
    acc_zero(acc1);
    gemm_main_dma(acc1, [&](int r) { return H + (size_t)r * DM; }, [&](int r) { return W + (size_t)r * DM; }, DM, smem);
    acc_to_lds(acc1, (float*)smem);
    __syncthreads();
    proj_epi(p, l, mt, 18, smem);
    return;
  }
  f32x16 acc[2][4];
  accw_zero(acc);
  gemm_wide(acc, [&](int r) { return H + (size_t)r * DM; }, [&](int r) { return W + (size_t)r * DM; }, DM, smem);
  float* Cs = (float*)smem;
  accw_to_lds<0>(acc, Cs);
  __syncthreads();
  proj_epi(p, l, mt, np * 2, smem);
  if (np * 2 + 1 < 19) {
    accw_to_lds<1>(acc, Cs);
    __syncthreads();
    proj_epi(p, l, mt, np * 2 + 1, smem);
  }
}
DI void proj_epi(const Params& p, int l, int mt, int nt, char* smem) {
  float* Cs = (float*)smem;
  const int tid = TIDX;
  const int tok0 = mt * 128;
  const int b = tok0 / TT, t0 = tok0 - b * TT;
  if (nt <= 2) {
    const int row = tid >> 1, seg = tid & 1;
    float* c = Cs + row * CLD + seg * 64;
    const float* gn = p.in[nt < 2 ? I_QN : I_KN] + l * 64;
    float ss = 0.f;
#pragma unroll 8
    for (int i = 0; i < 64; ++i) ss += c[i] * c[i];
    const float rstd = rsqrtf(ss * (1.f / 64.f) + EPSF);
    const int t = t0 + row;
    const bool lat = t >= CTXL;
    const int s = t - CTXL;
#pragma unroll 1
    for (int ax = 0; ax < 2; ++ax) {
      const float pos = (float)(ax ? (s & 63) : (s >> 6));
#pragma unroll 2
      for (int f = 0; f < 16; ++f) {
        float x1 = c[ax * 32 + f] * rstd * gn[ax * 32 + f];
        float x2 = c[ax * 32 + 16 + f] * rstd * gn[ax * 32 + 16 + f];
        if (lat) {
          const float invf = exp2f(-(float)f * (13.287712379549449f / 16.f));
          float sn, cs;
          sincos_cw(pos * invf, sn, cs);
          const float y1 = x1 * cs - x2 * sn, y2 = x2 * cs + x1 * sn;
          x1 = y1; x2 = y2;
        }
        c[ax * 32 + f] = x1;
        c[ax * 32 + 16 + f] = x2;
      }
    }
    __syncthreads();
    if (nt < 2) store_tile_bf16(Cs, (bf16*)(p.ws + OFF_Q) + (size_t)tok0 * 256 + nt * 128, 256, 128, 0.125f * 1.4426950408889634f);
    else store_tile_bf16(Cs, (bf16*)(p.ws + OFF_K) + (size_t)tok0 * 128, 128, 128, 1.f);
  } else if (nt == 3 || (nt >= 8 && nt <= 11)) {
    for (int c = tid; c < 2048; c += 256) {
      const int col = c & 127, rc = (c >> 7) * 8;
      u32x4 u;
#pragma unroll
      for (int e = 0; e < 4; ++e) u[e] = pack2(Cs[(rc + 2 * e) * CLD + col], Cs[(rc + 2 * e + 1) * CLD + col]);
      bf16* dst;
      if (nt == 3) dst = (bf16*)(p.ws + OFF_VT) + ((size_t)(b * 2 + (col >> 6)) * 64 + (col & 63)) * TT + t0 + rc;
      else dst = (bf16*)(p.ws + OFF_GVT) + ((size_t)(b * 4 + (nt - 8)) * 128 + col) * TT + t0 + rc;
      *(u32x4*)dst = u;
    }
  } else if (nt == 4 || nt == 5) {
    store_tile_bf16(Cs, (bf16*)(p.ws + OFF_GQ) + (size_t)tok0 * 256 + (nt - 4) * 128, 256, 128, 0.125f);
  } else if (nt == 6 || nt == 7) {
    store_tile_bf16(Cs, (bf16*)(p.ws + OFF_GK) + (size_t)tok0 * 256 + (nt - 6) * 128, 256, 128, 1.f);
  } else if (nt >= 12 && nt <= 15) {
    store_tile_bf16(Cs, (bf16*)(p.ws + OFF_GR) + (size_t)tok0 * 512 + (nt - 12) * 128, 512, 128, 1.f);
  } else if (nt == 16 || nt == 17) {
    for (int c = tid; c < 2048; c += 256) {
      const int row = c >> 4, c8 = c & 15;
      const float* s = Cs + row * CLD + c8 * 8;
      u32x4 u;
#pragma unroll
      for (int e = 0; e < 4; ++e) u[e] = pack2(s[2 * e], s[2 * e + 1]);
      const int ch = (nt - 16) * 128 + c8 * 8;
      bf16* dst = (bf16*)(p.ws + OFF_SU) + ((size_t)(b * 16 + (ch >> 4)) * TT + t0 + row) * 16 + (ch & 15);
      *(u32x4*)dst = u;
    }
  } else {
    for (int c = tid; c < 128 * 8; c += 256) {
      const int row = c >> 3, c4 = (c & 7) * 4;
      const float* s = Cs + row * CLD + c4;
      f32x4 v = {s[0], s[1], s[2], s[3]};
      *(f32x4*)((float*)(p.ws + OFF_LOW) + (size_t)(tok0 + row) * 32 + c4) = v;
    }
  }
  __syncthreads();
}

DI void attn_unit(const Params& p, int u, char* smem) {
  int b, head, tok0, nkt;
  if (u < 1024) { b = u >> 8; head = (u >> 6) & 3; tok0 = b * TT + CTXL + (u & 63) * 128; nkt = TT / 128; }
  else { const int v = u - 1024; b = v >> 3; head = (v >> 1) & 3; tok0 = b * TT + (v & 1) * 128; nkt = CTXL / 128; }
  const int kvh = head >> 1;
  const int tid = TIDX, lane = tid & 63, w = tid >> 6, r = lane & 31, h = lane >> 5;
  const bf16* Qp = (const bf16*)(p.ws + OFF_Q) + (size_t)(tok0 + w * 32 + r) * 256 + head * 64 + h * 8;
  s16x8 qf[4];
#pragma unroll
  for (int s = 0; s < 4; ++s) qf[s] = __builtin_bit_cast(s16x8, ldg16(Qp + s * 16));
  const bf16* kp[2];
  const bf16* vp[2];
#pragma unroll
  for (int i = 0; i < 2; ++i) {
    const int row = w * 16 + i * 8 + (lane >> 3);
    const int c = (lane & 7) ^ ((row >> 1) & 7);
    kp[i] = (const bf16*)(p.ws + OFF_K) + ((size_t)b * TT + row) * 128 + kvh * 64 + c * 8;
    vp[i] = (const bf16*)(p.ws + OFF_VT) + ((size_t)(b * 2 + kvh) * 64 + row) * TT + c * 8;
  }
  const int ldst = (w * 128 + lane) * 16;
#define AT_DMA(BUF, T)                                                                                              \
  {                                                                                                                 \
    char* sb_ = smem + (BUF) * 32768;                                                                               \
    _Pragma("unroll") for (int hh = 0; hh < 2; ++hh)                                                                \
    _Pragma("unroll") for (int i = 0; i < 2; ++i) {                                                                 \
      __builtin_amdgcn_global_load_lds((const unsigned*)(kp[i] + (size_t)((T) * 128 + hh * 64) * 128), (unsigned*)(sb_ + hh * 8192 + ldst + i * 1024), 16, 0, 0); \
      __builtin_amdgcn_global_load_lds((const unsigned*)(vp[i] + (T) * 128 + hh * 64), (unsigned*)(sb_ + 16384 + hh * 8192 + ldst + i * 1024), 16, 0, 0);        \
    }                                                                                                               \
  }
  const int xr = (r >> 1) & 7;
  AT_DMA(0, 0)
  asm volatile("s_waitcnt vmcnt(0)" ::: "memory");
  __syncthreads();
  f32x16 oacc[2];
#pragma unroll
  for (int i = 0; i < 16; ++i) { oacc[0][i] = 0.f; oacc[1][i] = 0.f; }
  float mrow = -INFINITY, lrow = 0.f;
  for (int kt = 0; kt < nkt; ++kt) {
    const int buf = kt & 1;
    if (kt + 1 < nkt) AT_DMA(buf ^ 1, kt + 1)
    const char* Kb = smem + buf * 32768;
    const char* Vb = Kb + 16384;
    f32x16 sacc[4];
#pragma unroll
    for (int q = 0; q < 4; ++q)
#pragma unroll
      for (int i = 0; i < 16; ++i) sacc[q][i] = 0.f;
#pragma unroll
    for (int s = 0; s < 4; ++s) {
      const int co = ((2 * s + h) ^ xr) * 16;
#pragma unroll
      for (int q = 0; q < 4; ++q) {
        const s16x8 a = *(const s16x8*)(Kb + (q >> 1) * 8192 + ((q & 1) * 32 + r) * 128 + co);
        sacc[q] = MFMA32(a, qf[s], sacc[q]);
      }
    }
    float mx = sacc[0][0];
#pragma unroll
    for (int q = 0; q < 4; ++q)
#pragma unroll
      for (int i = 0; i < 16; ++i) mx = fmaxf(mx, sacc[q][i]);
    mx = fmaxf(mx, __shfl_xor(mx, 32, 64));
    const float mnew = fmaxf(mrow, mx);
    const float alpha = __builtin_amdgcn_exp2f(mrow - mnew);
    mrow = mnew;
    float psum = 0.f;
#pragma unroll
    for (int q = 0; q < 4; ++q)
#pragma unroll
      for (int i = 0; i < 16; ++i) { sacc[q][i] = __builtin_amdgcn_exp2f(sacc[q][i] - mnew); psum += sacc[q][i]; }
    lrow = lrow * alpha + psum;
#pragma unroll
    for (int i = 0; i < 16; ++i) { oacc[0][i] *= alpha; oacc[1][i] *= alpha; }
#pragma unroll
    for (int q = 0; q < 4; ++q)
#pragma unroll
      for (int s2 = 0; s2 < 2; ++s2) {
        u32x4 pu;
#pragma unroll
        for (int e = 0; e < 4; ++e) pu[e] = pack2(sacc[q][8 * s2 + 2 * e], sacc[q][8 * s2 + 2 * e + 1]);
        const s16x8 pf = __builtin_bit_cast(s16x8, pu);
        const int c0 = (q & 1) * 4 + 2 * s2;
        const int o0 = ((c0 ^ xr) * 16) + 8 * h, o1 = (((c0 + 1) ^ xr) * 16) + 8 * h;
#pragma unroll
        for (int dt = 0; dt < 2; ++dt) {
          const s16x4 lo = *(const s16x4*)(Vb + (q >> 1) * 8192 + (dt * 32 + r) * 128 + o0);
          const s16x4 hi = *(const s16x4*)(Vb + (q >> 1) * 8192 + (dt * 32 + r) * 128 + o1);
          const s16x8 a = __builtin_shufflevector(lo, hi, 0, 1, 2, 3, 4, 5, 6, 7);
          oacc[dt] = MFMA32(a, pf, oacc[dt]);
        }
      }
    asm volatile("s_waitcnt vmcnt(0)" ::: "memory");
    __syncthreads();
  }
#undef AT_DMA
  const float ltot = lrow + __shfl_xor(lrow, 32, 64);
  const float inv = 1.f / ltot;
  bf16* Op = (bf16*)(p.ws + OFF_OATT) + (size_t)(tok0 + w * 32 + r) * 256 + head * 64;
#pragma unroll
  for (int dt = 0; dt < 2; ++dt)
#pragma unroll
    for (int i = 0; i < 16; i += 4) {
      u32x2 uu;
      uu[0] = pack2(oacc[dt][i] * inv, oacc[dt][i + 1] * inv);
      uu[1] = pack2(oacc[dt][i + 2] * inv, oacc[dt][i + 3] * inv);
      *(u32x2*)(Op + dt * 32 + crow(i, h)) = uu;
    }
}

constexpr int GL_LOW = 0, GL_TOT = 4096, GL_DEC = 5120, GL_QIN = 5376, GL_KIN = 14592, GL_KET = 23808, GL_OST = 0,
              GL_VT = 33792, GL_ST = 52224;
static_assert(GL_ST + 128 * LDT * 2 <= SMEM_BYTES, "gla lds");

template <bool WITH_OUT>
DI void gla_unit(const Params& p, int l, int u, char* smem) {
  float* lowt = (float*)(smem + GL_LOW);
  float* tots = (float*)(smem + GL_TOT);
  float* decs = (float*)(smem + GL_DEC);
  bf16* qin = (bf16*)(smem + GL_QIN);
  bf16* kin = (bf16*)(smem + GL_KIN);
  bf16* ket = (bf16*)(smem + GL_KET);
  float* ost = (float*)(smem + GL_OST);
  bf16* vts = (bf16*)(smem + GL_VT);
  bf16* sts = (bf16*)(smem + GL_ST);
  const int tid = TIDX, lane = tid & 63, w = tid >> 6, r = lane & 31, h = lane >> 5;
  int b, hd, gi, dir0, ndir;
  if (WITH_OUT) { gi = u % NG33; hd = (u / NG33) & 3; b = u / (NG33 * 4); dir0 = 1; ndir = 2; }
  else { gi = u % NG33; const int v = u / NG33; dir0 = v & 1; hd = (v >> 1) & 3; b = v >> 3; ndir = 1; }
  const int dk = tid & 63, part = tid >> 6;
  const bf16* GQ = (const bf16*)(p.ws + OFF_GQ);
  const bf16* GK = (const bf16*)(p.ws + OFF_GK);
  const bf16* GVT = (const bf16*)(p.ws + OFF_GVT) + (size_t)(b * 4 + hd) * 128 * TT;
  const float* LOW = (const float*)(p.ws + OFF_LOW);
  for (int dd = 0; dd < ndir; ++dd) {
    const int dir = WITH_OUT ? (dir0 - dd) : dir0;
    float* GSu = (float*)(p.ws + OFF_GS) + ((size_t)((b * 4 + hd) * 2 + dir) * NG33 + gi) * 8192;
    float gwreg[16];
#pragma unroll
    for (int rr = 0; rr < 16; ++rr) gwreg[rr] = p.in[I_GGW][((size_t)(l * 2 + dir) * 16 + rr) * 256 + hd * 64 + dk];
    const float gb = p.in[I_GGB][(l * 2 + dir) * 256 + hd * 64 + dk];
    f32x16 sacc[2];
    if (WITH_OUT) {
#pragma unroll
      for (int dkt = 0; dkt < 2; ++dkt)
#pragma unroll
        for (int i = 0; i < 16; ++i) {
          const float v = GSu[(w * 32 + crow(i, h)) * 64 + dkt * 32 + r];
          sacc[dkt][i] = v;
          sts[(w * 32 + crow(i, h)) * LDT + dkt * 32 + r] = f2bf(v);
        }
    } else {
#pragma unroll
      for (int i = 0; i < 16; ++i) { sacc[0][i] = 0.f; sacc[1][i] = 0.f; }
    }
    float gtot = 0.f;
    for (int cc = 0; cc < 4; ++cc) {
      const int ci = dir ? 3 - cc : cc;
      const int tb = gi * 256 + ci * 64;
      const size_t tokb = (size_t)b * TT + tb;
      {
        const int row = tid >> 2, c4 = (tid & 3) * 4;
        const u32x4 lw = ldg16(LOW + (tokb + row) * 32 + dir * 16 + c4);
        u32x4 vv[4], kq[2], qq[2];
#pragma unroll
        for (int i = 0; i < 4; ++i) {
          const int c = tid + 256 * i, e = c >> 3, k8 = (c & 7) * 8;
          vv[i] = ldg16(GVT + (size_t)e * TT + tb + k8);
        }
#pragma unroll
        for (int i = 0; i < 2; ++i) {
          const int c = tid + 256 * i, rw = c >> 3, k8 = (c & 7) * 8;
          kq[i] = ldg16(GK + (tokb + rw) * 256 + hd * 64 + k8);
          if (WITH_OUT) qq[i] = ldg16(GQ + (tokb + rw) * 256 + hd * 64 + k8);
        }
        *(u32x4*)(lowt + row * 16 + c4) = lw;
#pragma unroll
        for (int i = 0; i < 4; ++i) {
          const int c = tid + 256 * i, e = c >> 3, k8 = (c & 7) * 8;
          *(u32x4*)(vts + e * LDT + k8) = vv[i];
        }
#pragma unroll
        for (int i = 0; i < 2; ++i) {
          const int c = tid + 256 * i, rw = c >> 3, k8 = (c & 7) * 8;
          *(u32x4*)(kin + rw * LDT + k8) = kq[i];
          if (WITH_OUT) *(u32x4*)(qin + rw * LDT + k8) = qq[i];
        }
      }
      __syncthreads();
      float cum = 0.f;
#pragma unroll 2
      for (int ii = 0; ii < 16; ++ii) {
        const int pos = part * 16 + ii, t = dir ? 63 - pos : pos;
        float z = gb;
#pragma unroll
        for (int rr = 0; rr < 16; ++rr) z += lowt[t * 16 + rr] * gwreg[rr];
        cum += (fminf(z, 0.f) - log1pf(__expf(-fabsf(z)))) * (1.f / 16.f);
      }
      tots[part * 64 + dk] = cum;
      __syncthreads();
      float offs = 0.f, total = 0.f;
#pragma unroll
      for (int pp = 0; pp < 4; ++pp) { const float tv = tots[pp * 64 + dk]; total += tv; if (pp < part) offs += tv; }
      if (part == 0) decs[dk] = __expf(total);
      gtot += total;
      float bq = offs;
#pragma unroll 2
      for (int ii = 0; ii < 16; ++ii) {
        const int pos = part * 16 + ii, t = dir ? 63 - pos : pos;
        float z = gb;
#pragma unroll
        for (int rr = 0; rr < 16; ++rr) z += lowt[t * 16 + rr] * gwreg[rr];
        bq += (fminf(z, 0.f) - log1pf(__expf(-fabsf(z)))) * (1.f / 16.f);
        const float kv = bf2f(kin[t * LDT + dk]);
        ket[dk * LDT + t] = f2bf(kv * __expf(total - bq));
        if (WITH_OUT) {
          const float qv = bf2f(qin[t * LDT + dk]);
          qin[t * LDT + dk] = f2bf(qv * __expf(bq));
          kin[t * LDT + dk] = f2bf(kv * __expf(-bq));
        }
      }
      __syncthreads();
      f32x16 oo[2];
      const int it = w & 1, ep = w >> 1;
      if (WITH_OUT) {
        const int ti = w >> 1, tj = w & 1;
        f32x16 aa;
#pragma unroll
        for (int i = 0; i < 16; ++i) aa[i] = 0.f;
#pragma unroll
        for (int s = 0; s < 4; ++s) {
          const s16x8 A = *(const s16x8*)(qin + (ti * 32 + r) * LDT + s * 16 + h * 8);
          const s16x8 Bv = *(const s16x8*)(kin + (tj * 32 + r) * LDT + s * 16 + h * 8);
          aa = MFMA32(A, Bv, aa);
        }
        __syncthreads();
#pragma unroll
        for (int i = 0; i < 16; ++i) {
          const int qi = ti * 32 + crow(i, h), kj = tj * 32 + r;
          const bool keep = dir ? (kj >= qi) : (kj <= qi);
          kin[qi * LDT + kj] = f2bf(keep ? aa[i] : 0.f);
        }
        __syncthreads();
#pragma unroll
        for (int i = 0; i < 16; ++i) { oo[0][i] = 0.f; oo[1][i] = 0.f; }
#pragma unroll
        for (int s = 0; s < 4; ++s) {
          const s16x8 A1 = *(const s16x8*)(kin + (it * 32 + r) * LDT + s * 16 + h * 8);
          const s16x8 A2 = *(const s16x8*)(qin + (it * 32 + r) * LDT + s * 16 + h * 8);
#pragma unroll
          for (int x = 0; x < 2; ++x) {
            const int et = 2 * ep + x;
            const s16x8 B1 = *(const s16x8*)(vts + (et * 32 + r) * LDT + s * 16 + h * 8);
            const s16x8 B2 = *(const s16x8*)(sts + (et * 32 + r) * LDT + s * 16 + h * 8);
            oo[x] = MFMA32(A1, B1, oo[x]);
            oo[x] = MFMA32(A2, B2, oo[x]);
          }
        }
      }
#pragma unroll
      for (int dkt = 0; dkt < 2; ++dkt) {
        const float dv = decs[dkt * 32 + r];
#pragma unroll
        for (int i = 0; i < 16; ++i) sacc[dkt][i] *= dv;
      }
#pragma unroll
      for (int s = 0; s < 4; ++s) {
        const s16x8 A = *(const s16x8*)(vts + (w * 32 + r) * LDT + s * 16 + h * 8);
#pragma unroll
        for (int dkt = 0; dkt < 2; ++dkt) {
          const s16x8 Bv = *(const s16x8*)(ket + (dkt * 32 + r) * LDT + s * 16 + h * 8);
          sacc[dkt] = MFMA32(A, Bv, sacc[dkt]);
        }
      }
      __syncthreads();
      if (WITH_OUT) {
#pragma unroll
        for (int dkt = 0; dkt < 2; ++dkt)
#pragma unroll
          for (int i = 0; i < 16; ++i) sts[(w * 32 + crow(i, h)) * LDT + dkt * 32 + r] = f2bf(sacc[dkt][i]);
#pragma unroll
        for (int x = 0; x < 2; ++x)
#pragma unroll
          for (int i = 0; i < 16; ++i) ost[(it * 32 + crow(i, h)) * CLD + (2 * ep + x) * 32 + r] = oo[x][i];
        __syncthreads();
        const int row = tid >> 2, qd = tid & 3;
        const size_t tok = tokb + row;
        bf16* og = (bf16*)(p.ws + OFF_OGLA) + tok * 512 + hd * 128 + qd * 32;
        const float* os = ost + row * CLD + qd * 32;
        if (dir == 1) {
#pragma unroll
          for (int i = 0; i < 4; ++i) {
            u32x4 uu;
#pragma unroll
            for (int e = 0; e < 4; ++e) uu[e] = pack2(os[i * 8 + 2 * e], os[i * 8 + 2 * e + 1]);
            *(u32x4*)(og + i * 8) = uu;
          }
        } else {
          float ss = 0.f;
#pragma unroll 1
          for (int i = 0; i < 4; ++i) {
            const u32x4 uu = *(const u32x4*)(og + i * 8);
#pragma unroll
            for (int e = 0; e < 4; ++e) {
              const float a0 = os[i * 8 + 2 * e] + bflo(uu[e]), a1 = os[i * 8 + 2 * e + 1] + bfhi(uu[e]);
              ss += a0 * a0 + a1 * a1;
            }
          }
          ss += __shfl_xor(ss, 1, 64);
          ss += __shfl_xor(ss, 2, 64);
          const float rstd = rsqrtf(ss * (1.f / 128.f) + EPSF);
          const float* gn = p.in[I_GON] + l * 128 + qd * 32;
          const bf16* gr = (const bf16*)(p.ws + OFF_GR) + tok * 512 + hd * 128 + qd * 32;
#pragma unroll 1
          for (int i = 0; i < 4; ++i) {
            const u32x4 uo = *(const u32x4*)(og + i * 8);
            const u32x4 ug = *(const u32x4*)(gr + i * 8);
            u32x4 uu;
#pragma unroll
            for (int e = 0; e < 4; ++e) {
              const float v0 = os[i * 8 + 2 * e] + bflo(uo[e]), v1 = os[i * 8 + 2 * e + 1] + bfhi(uo[e]);
              const float a0 = v0 * rstd * gn[i * 8 + 2 * e] * siluf_(bflo(ug[e]));
              const float a1 = v1 * rstd * gn[i * 8 + 2 * e + 1] * siluf_(bfhi(ug[e]));
              uu[e] = pack2(a0, a1);
            }
            *(u32x4*)(og + i * 8) = uu;
          }
        }
        __syncthreads();
      }
    }
    if (!WITH_OUT) {
#pragma unroll
      for (int dkt = 0; dkt < 2; ++dkt)
#pragma unroll
        for (int i = 0; i < 16; ++i) GSu[(w * 32 + crow(i, h)) * 64 + dkt * 32 + r] = sacc[dkt][i];
      if (part == 0) ((float*)(p.ws + OFF_DECG))[((size_t)((b * 4 + hd) * 2 + dir) * NG33 + gi) * 64 + dk] = __expf(gtot);
    }
    __syncthreads();
  }
}

DI void gla_scan_job(const Params& p, int j) {
  const int idx = j * 256 + TIDX;
  const int seq = idx >> 13, el = idx & 8191, dk = el & 63, dir = seq & 1;
  float* GS = (float*)(p.ws + OFF_GS) + (size_t)seq * NG33 * 8192 + el;
  const float* DG = (const float*)(p.ws + OFF_DECG) + (size_t)seq * NG33 * 64 + dk;
  float s = 0.f;
  for (int st0 = 0; st0 < 33; st0 += 11) {
    float kv[11], dc[11];
#pragma unroll
    for (int q = 0; q < 11; ++q) {
      const int st = st0 + q;
      const int g = (dir == 0 || st == 0) ? st : 33 - st;
      kv[q] = GS[(size_t)g * 8192];
      dc[q] = DG[g * 64];
    }
#pragma unroll
    for (int q = 0; q < 11; ++q) {
      const int st = st0 + q;
      const int g = (dir == 0 || st == 0) ? st : 33 - st;
      GS[(size_t)g * 8192] = s;
      s = dc[q] * s + kv[q];
    }
  }
}

DI void s5_end_tile(const Params& p, int j, char* smem) {
  const int nt = j & 1, mt = (j >> 1) % 9, g = j / 18;
  const bf16* SU = (const bf16*)(p.ws + OFF_SU);
  const bf16* F = (const bf16*)(p.ws + OFF_F5) + ((size_t)g * 256 + nt * 128) * 512;
  f32x16 acc[2][2];
  acc_zero(acc);
  gemm_main_dma(acc,
            [&](int r) -> const bf16* {
              const int m = mt * 128 + r;
              if (m >= MS5) return (const bf16*)(p.ws + OFF_ZERO);
              const int b = m / NCH, ch = m - b * NCH;
              return SU + ((size_t)(b * 16 + g) * TT + ch * 32) * 16;
            },
            [&](int r) { return F + (size_t)r * 512; }, 512, smem);
  float* Cs = (float*)smem;
  acc_to_lds(acc, Cs);
  __syncthreads();
  float* EN = (float*)(p.ws + OFF_EN);
  for (int c = TIDX; c < 128 * 32; c += 256) {
    const int row = c >> 5, c4 = (c & 31) * 4, m = mt * 128 + row;
    if (m < MS5) {
      const float* s = Cs + row * CLD + c4;
      f32x4 v = {s[0], s[1], s[2], s[3]};
      *(f32x4*)(EN + ((size_t)m * 16 + g) * 256 + nt * 128 + c4) = v;
    }
  }
  __syncthreads();
}

DI void s5_scan_job(const Params& p, int l, int j, char* smem) {
  float2* ends = (float2*)smem;
  const int dir = j & 1, g = (j >> 1) & 15, b = j >> 5;
  const int pp = TIDX & 63, seg = TIDX >> 6;
  const float2 aL = ((const float2*)(p.ws + OFF_PWR))[((size_t)((l * 2 + dir) * 16 + g) * 33 + 32) * 64 + pp];
  const float* EN = (const float*)(p.ws + OFF_EN);
  bf16* SB = (bf16*)(p.ws + OFF_SB);
  float sr = 0.f, si = 0.f;
  for (int q0 = 0; q0 < 66; q0 += 11) {
    float er[11], ei[11];
#pragma unroll
    for (int q = 0; q < 11; ++q) {
      const int pos = seg * 66 + q0 + q;
      const int ch = dir ? (pos < 8 ? 7 - pos : 271 - pos) : pos;
      const float* e = EN + ((size_t)(b * NCH + ch) * 16 + g) * 256 + dir * 128 + pp;
      er[q] = e[0]; ei[q] = e[64];
    }
#pragma unroll
    for (int q = 0; q < 11; ++q) {
      const float nr = aL.x * sr - aL.y * si + er[q], ni = aL.x * si + aL.y * sr + ei[q];
      sr = nr; si = ni;
    }
  }
  ends[seg * 64 + pp] = make_float2(sr, si);
  float pr = 1.f, pi = 0.f;
  for (int q = 0; q < 66; ++q) { const float nr = pr * aL.x - pi * aL.y, ni = pr * aL.y + pi * aL.x; pr = nr; pi = ni; }
  __syncthreads();
  sr = 0.f; si = 0.f;
  for (int k = 0; k < seg; ++k) {
    const float2 e = ends[k * 64 + pp];
    const float nr = pr * sr - pi * si + e.x, ni = pr * si + pi * sr + e.y;
    sr = nr; si = ni;
  }
  for (int q0 = 0; q0 < 66; q0 += 11) {
    float er[11], ei[11];
#pragma unroll
    for (int q = 0; q < 11; ++q) {
      const int pos = seg * 66 + q0 + q;
      const int ch = dir ? (pos < 8 ? 7 - pos : 271 - pos) : pos;
      const float* e = EN + ((size_t)(b * NCH + ch) * 16 + g) * 256 + dir * 128 + pp;
      er[q] = e[0]; ei[q] = e[64];
    }
#pragma unroll
    for (int q = 0; q < 11; ++q) {
      const int pos = seg * 66 + q0 + q;
      const int ch = dir ? (pos < 8 ? 7 - pos : 271 - pos) : pos;
      bf16* sb = SB + ((size_t)(b * NCH + ch) * 16 + g) * 256 + dir * 128 + pp;
      sb[0] = f2bf(sr); sb[64] = f2bf(si);
      const float nr = aL.x * sr - aL.y * si + er[q], ni = aL.x * si + aL.y * sr + ei[q];
      sr = nr; si = ni;
    }
  }
  __syncthreads();
}

DI float gelu_tanh(float x) {
  const float u = 0.7978845608028654f * (x + 0.044715f * x * x * x);
  return 0.5f * x * (1.f + tanhf(u));
}

DI void s5_out_tile(const Params& p, int j, char* smem) {
  const int nt = j & 3, mt = (j >> 2) % 9, g = j / 36;
  const bf16* SU = (const bf16*)(p.ws + OFF_SU);
  const bf16* SB = (const bf16*)(p.ws + OFF_SB);
  const bf16* Tm = (const bf16*)(p.ws + OFF_T5) + ((size_t)g * 512 + nt * 128) * 512;
  const bf16* Em = (const bf16*)(p.ws + OFF_E5) + ((size_t)g * 512 + nt * 128) * 256;
  f32x16 acc[2][2];
  acc_zero(acc);
  gemm_main_dma(acc,
            [&](int r) -> const bf16* {
              const int m = mt * 128 + r;
              if (m >= MS5) return (const bf16*)(p.ws + OFF_ZERO);
              const int b = m / NCH, ch = m - b * NCH;
              return SU + ((size_t)(b * 16 + g) * TT + ch * 32) * 16;
            },
            [&](int r) { return Tm + (size_t)r * 512; }, 512, smem);
  gemm_main_dma(acc,
            [&](int r) -> const bf16* {
              const int m = mt * 128 + r;
              if (m >= MS5) return (const bf16*)(p.ws + OFF_ZERO);
              return SB + ((size_t)m * 16 + g) * 256;
            },
            [&](int r) { return Em + (size_t)r * 256; }, 256, smem);
  float* Cs = (float*)smem;
  acc_to_lds(acc, Cs);
  __syncthreads();
  bf16* Y5 = (bf16*)(p.ws + OFF_Y5);
  for (int c = TIDX; c < 2048; c += 256) {
    const int row = c >> 4, c8 = c & 15, m = mt * 128 + row;
    if (m < MS5) {
      const int b = m / NCH, ch = m - b * NCH;
      const int n = nt * 128 + c8 * 8, i = n >> 4, hh = n & 15;
      const float* s = Cs + row * CLD + c8 * 8;
      u32x4 u;
#pragma unroll
      for (int e = 0; e < 4; ++e) u[e] = pack2(gelu_tanh(s[2 * e]), gelu_tanh(s[2 * e + 1]));
      *(u32x4*)(Y5 + ((size_t)b * TT + ch * 32 + i) * 256 + g * 16 + hh) = u;
    }
  }
  __syncthreads();
}

DI void glu_tile(const Params& p, int l, int j, char* smem) {
  const int nt = j & 1, mt = j >> 1;
  const bf16* Y5 = (const bf16*)(p.ws + OFF_Y5) + (size_t)mt * 128 * 256;
  const bf16* W = wl(p, l, WL_GLU) + (size_t)nt * 128 * 256;
  f32x16 acc[2][2];
  acc_zero(acc);
  gemm_main_dma(acc, [&](int r) { return Y5 + (size_t)r * 256; }, [&](int r) { return W + (size_t)r * 256; }, 256, smem);
  float* Cs = (float*)smem;
  acc_to_lds(acc, Cs);
  __syncthreads();
  const float* gb = p.in[I_GLUB] + l * 256 + nt * 128;
  bf16* O = (bf16*)(p.ws + OFF_OS5) + (size_t)mt * 128 * 256 + nt * 128;
  for (int c = TIDX; c < 2048; c += 256) {
    const int row = c >> 4, cc = (c & 15) * 8;
    const float* s = Cs + row * CLD + cc;
    const u32x4 yu = *(const u32x4*)(Y5 + (size_t)row * 256 + nt * 128 + cc);
    u32x4 u;
#pragma unroll
    for (int e = 0; e < 4; ++e) {
      const float y0 = bflo(yu[e]), y1 = bfhi(yu[e]);
      u[e] = pack2(y0 * sigmoidf_(s[2 * e] + gb[cc + 2 * e]), y1 * sigmoidf_(s[2 * e + 1] + gb[cc + 2 * e + 1]));
    }
    *(u32x4*)(O + (size_t)row * 256 + cc) = u;
  }
  __syncthreads();
}

struct DmaStream { const bf16* ap[4]; const bf16* bp[4]; };
template <class FA, class FB>
DI void stream_setup(DmaStream& st, FA fa, FB fb) {
  const int tid = TIDX, lane = tid & 63, w = tid >> 6;
#pragma unroll
  for (int i = 0; i < 4; ++i) {
    const int row = w * 32 + i * 8 + (lane >> 3);
    const int c = (lane & 7) ^ ((row >> 1) & 7);
    st.ap[i] = fa(row) + c * 8;
    st.bp[i] = fb(row) + c * 8;
  }
}
DI void stream_issue(const DmaStream& st, int buf, int kt, char* smem) {
  const int tid = TIDX, lane = tid & 63, w = tid >> 6;
  const int ldst = (w * 256 + lane) * 16;
  const int k0 = kt * 64;
#pragma unroll
  for (int i = 0; i < 4; ++i) {
    __builtin_amdgcn_global_load_lds((const unsigned*)(st.ap[i] + k0), (unsigned*)(smem + buf * 16384 + ldst + i * 1024), 16, 0, 0);
    __builtin_amdgcn_global_load_lds((const unsigned*)(st.bp[i] + k0), (unsigned*)(smem + 32768 + buf * 16384 + ldst + i * 1024), 16, 0, 0);
  }
}
DI void stream_run(f32x16 (&acc)[2][2], const DmaStream& cur, int K, char* smem, const DmaStream& next, bool has_next) {
  const int tid = TIDX, lane = tid & 63, w = tid >> 6, wm = w >> 1, wn = w & 1;
  const int r = lane & 31, h = lane >> 5;
  const int xr = (r >> 1) & 7;
  const int arow = (wm * 64 + r) * 128, brow = (wn * 64 + r) * 128;
  const int nk = K / 64;
  for (int kt = 0; kt < nk; ++kt) {
    const int buf = kt & 1;
    if (kt + 1 < nk) stream_issue(cur, buf ^ 1, kt + 1, smem);
    else if (has_next) stream_issue(next, buf ^ 1, 0, smem);
    const char* Ab = smem + buf * 16384 + arow;
    const char* Bb = smem + 32768 + buf * 16384 + brow;
#pragma unroll
    for (int s2 = 0; s2 < 4; ++s2) {
      const int co = ((2 * s2 + h) ^ xr) * 16;
      s16x8 a0 = *(const s16x8*)(Ab + co);
      s16x8 a1 = *(const s16x8*)(Ab + 32 * 128 + co);
      s16x8 b0 = *(const s16x8*)(Bb + co);
      s16x8 b1 = *(const s16x8*)(Bb + 32 * 128 + co);
      acc[0][0] = MFMA32(a0, b0, acc[0][0]);
      acc[0][1] = MFMA32(a0, b1, acc[0][1]);
      acc[1][0] = MFMA32(a1, b0, acc[1][0]);
      acc[1][1] = MFMA32(a1, b1, acc[1][1]);
    }
    asm volatile("s_waitcnt vmcnt(0)" ::: "memory");
    __syncthreads();
  }
}

DI void merge_tile(const Params& p, int l, int j, char* smem) {
  const int nt = j & 7, mt = j >> 3;
  const bf16* H = (const bf16*)(p.ws + OFF_H) + (size_t)mt * 128 * DM;
  unsigned am[2][2][8];
#pragma unroll
  for (int a = 0; a < 2; ++a)
#pragma unroll
    for (int bq = 0; bq < 2; ++bq)
#pragma unroll
      for (int i = 0; i < 8; ++i) am[a][bq][i] = 0u;
  DmaStream sb, sg;
  {
    const bf16* A0 = (const bf16*)(p.ws + OFF_OATT) + (size_t)mt * 128 * 256;
    const bf16* W0 = wl(p, l, WL_BRA) + (size_t)nt * 128 * 256;
    stream_setup(sb, [&](int r) { return A0 + (size_t)r * 256; }, [&](int r) { return W0 + (size_t)r * 256; });
    stream_issue(sb, 0, 0, smem);
    asm volatile("s_waitcnt vmcnt(0)" ::: "memory");
    __syncthreads();
  }
#pragma unroll 1
  for (int x = 0; x < 3; ++x) {
    const int K = (x == 1) ? 512 : 256;
    const bf16* Wg = wl(p, l, WL_WIN) + ((size_t)2432 + x * 1024 + nt * 128) * DM;
    stream_setup(sg, [&](int r) { return H + (size_t)r * DM; }, [&](int r) { return Wg + (size_t)r * DM; });
    unsigned br[2][2][8];
    {
      f32x16 acc[2][2];
      acc_zero(acc);
      stream_run(acc, sb, K, smem, sg, true);
#pragma unroll
      for (int a = 0; a < 2; ++a)
#pragma unroll
        for (int bq = 0; bq < 2; ++bq)
#pragma unroll
          for (int i = 0; i < 8; ++i) br[a][bq][i] = pack2(acc[a][bq][2 * i], acc[a][bq][2 * i + 1]);
    }
    if (x < 2) {
      const bf16* A1; const bf16* W1; int K1;
      if (x == 0) { A1 = (const bf16*)(p.ws + OFF_OGLA) + (size_t)mt * 128 * 512; W1 = wl(p, l, WL_BRG) + (size_t)nt * 128 * 512; K1 = 512; }
      else { A1 = (const bf16*)(p.ws + OFF_OS5) + (size_t)mt * 128 * 256; W1 = wl(p, l, WL_BRS) + (size_t)nt * 128 * 256; K1 = 256; }
      stream_setup(sb, [&](int r) { return A1 + (size_t)r * K1; }, [&](int r) { return W1 + (size_t)r * K1; });
    }
    f32x16 acc[2][2];
    acc_zero(acc);
    stream_run(acc, sg, DM, smem, sb, x < 2);
#pragma unroll
    for (int a = 0; a < 2; ++a)
#pragma unroll
      for (int bq = 0; bq < 2; ++bq)
#pragma unroll
        for (int i = 0; i < 8; ++i) {
          const float v0 = bflo(am[a][bq][i]) + sigmoidf_(acc[a][bq][2 * i]) * bflo(br[a][bq][i]);
          const float v1 = bfhi(am[a][bq][i]) + sigmoidf_(acc[a][bq][2 * i + 1]) * bfhi(br[a][bq][i]);
          am[a][bq][i] = pack2(v0, v1);
        }
  }
  f32x16 accm[2][2];
#pragma unroll
  for (int a = 0; a < 2; ++a)
#pragma unroll
    for (int bq = 0; bq < 2; ++bq)
#pragma unroll
      for (int i = 0; i < 8; ++i) { accm[a][bq][2 * i] = bflo(am[a][bq][i]); accm[a][bq][2 * i + 1] = bfhi(am[a][bq][i]); }
  float* Cs = (float*)smem;
  acc_to_lds(accm, Cs);
  __syncthreads();
  store_tile_bf16(Cs, (bf16*)(p.ws + OFF_MG) + (size_t)mt * 128 * DM + nt * 128, DM, 128, 1.f);
  __syncthreads();
}

DI void plain_tile(const bf16* A, int K, const bf16* W, bf16* dst, int ldd, char* smem) {
  f32x16 acc[2][2];
  acc_zero(acc);
  gemm_main_dma(acc, [&](int r) { return A + (size_t)r * K; }, [&](int r) { return W + (size_t)r * K; }, K, smem);
  float* Cs = (float*)smem;
  acc_to_lds(acc, Cs);
  __syncthreads();
  store_tile_bf16(Cs, dst, ldd, 128, 1.f);
  __syncthreads();
}

DI void plain_wide(const bf16* A, int K, const bf16* W, bf16* dst, int ldd, char* smem) {
  f32x16 acc[2][4];
  accw_zero(acc);
  gemm_wide(acc, [&](int r) { return A + (size_t)r * K; }, [&](int r) { return W + (size_t)r * K; }, K, smem);
  float* Cs = (float*)smem;
  accw_to_lds<0>(acc, Cs);
  __syncthreads();
  store_tile_bf16(Cs, dst, ldd, 128, 1.f);
  __syncthreads();
  accw_to_lds<1>(acc, Cs);
  __syncthreads();
  store_tile_bf16(Cs, dst + 128, ldd, 128, 1.f);
  __syncthreads();
}

DI void up_epi(const Params& p, int l, int jn, int seqbase, int len, int pos0, char* smem) {
  float* Cs = (float*)smem;
  const float* cw = p.in[I_CW] + (size_t)l * 3 * 2 * DFF;
  const float* cb = p.in[I_CB] + (size_t)l * 2 * DFF;
  bf16* G = (bf16*)(p.ws + OFF_G);
  const int tid = TIDX;
  const int c = (tid & 31) * 2;
  float wa[2][3], wv[2][3], ba[2], bv[2];
#pragma unroll
  for (int e = 0; e < 2; ++e) {
    const int ca = jn * 64 + c + e, cv = DFF + ca;
#pragma unroll
    for (int k = 0; k < 3; ++k) { wa[e][k] = cw[k * 2 * DFF + ca]; wv[e][k] = cw[k * 2 * DFF + cv]; }
    ba[e] = cb[ca]; bv[e] = cb[cv];
  }
#pragma unroll 4
  for (int rr = 1 + (tid >> 5); rr < 127; rr += 8) {
    const int pos = pos0 + rr;
    if (pos < len) {
      float gv[2];
#pragma unroll
      for (int e = 0; e < 2; ++e) {
        const float a = wa[e][0] * Cs[(rr - 1) * CLD + c + e] + wa[e][1] * Cs[rr * CLD + c + e] + wa[e][2] * Cs[(rr + 1) * CLD + c + e] + ba[e];
        const float v = wv[e][0] * Cs[(rr - 1) * CLD + 64 + c + e] + wv[e][1] * Cs[rr * CLD + 64 + c + e] +
                        wv[e][2] * Cs[(rr + 1) * CLD + 64 + c + e] + bv[e];
        gv[e] = siluf_(a) * v;
      }
      *(unsigned*)(G + (size_t)(seqbase + pos) * DFF + jn * 64 + c) = pack2(gv[0], gv[1]);
    }
  }
  __syncthreads();
}

DI void up_wide(const Params& p, int l, int mtile, int jp, char* smem) {
  const int b = mtile / 69, rr0 = mtile % 69;
  int seqbase, len, ti;
  if (rr0 < 3) { seqbase = b * TT; len = CTXL; ti = rr0; }
  else { seqbase = b * TT + CTXL; len = SEQ; ti = rr0 - 3; }
  const int pos0 = ti * 126 - 1;
  const bf16* H = (const bf16*)(p.ws + OFF_H);
  const bf16* W = wl(p, l, WL_UP) + (size_t)jp * 256 * DM;
  f32x16 acc[2][4];
  accw_zero(acc);
  gemm_wide(acc,
            [&](int r) -> const bf16* {
              const int pos = pos0 + r;
              return (pos >= 0 && pos < len) ? H + (size_t)(seqbase + pos) * DM : (const bf16*)(p.ws + OFF_ZERO);
            },
            [&](int r) { return W + (size_t)r * DM; }, DM, smem);
  float* Cs = (float*)smem;
  accw_to_lds<0>(acc, Cs);
  __syncthreads();
  up_epi(p, l, jp * 2, seqbase, len, pos0, smem);
  accw_to_lds<1>(acc, Cs);
  __syncthreads();
  up_epi(p, l, jp * 2 + 1, seqbase, len, pos0, smem);
}

DI bool gemm_job(int bid, int G, int it, int MT, int NTL, int& mt, int& nt, int CW = 8) {
  const int x = bid & 7, q = bid >> 3, Q = G >> 3;
  const int m0 = (x * MT) >> 3, m1 = ((x + 1) * MT) >> 3, Mx = m1 - m0;
  const int jl = q + Q * it;
  if (jl >= Mx * NTL) return false;
  const int full = Mx * CW;
  const int c = jl / full, rem = jl - c * full;
  const int wc = min(CW, NTL - CW * c);
  const int mi = rem / wc;
  mt = m0 + mi;
  nt = CW * c + (rem - mi * wc);
  return true;
}

DI int lat_mt(int i) { return (i >> 6) * 66 + 2 + (i & 63); }
DI int lat_up(int i) { return (i / 66) * 69 + 3 + (i % 66); }

enum { PH_PREP = 0, PH_ROW0, PH_PROJ, PH_MIX1, PH_SCAN, PH_MIX2, PH_GLU, PH_MERGE, PH_WOUT, PH_ROW1, PH_UP, PH_DOWN, PH_ROW2 };
constexpr int N_PHASES = 2 + 11 * NL;

DI void run_phase(const Params& p, int ph, int l, char* smem) {
  const int bid = blockIdx.x;
#ifdef HALFMASK
  const int G = ((HALFMASK >> ph) & 1) ? 256 : gridDim.x;
  if (bid >= G) return;
#else
  const int G = gridDim.x;
#endif
#ifdef PHMASK
  if (!((PHMASK >> ph) & 1)) return;
#endif
  switch (ph) {
    case PH_PREP:
      if (bid < 8) { for (int i = TIDX; i < 512; i += 256) ((u32x4*)(p.ws + OFF_ZERO))[i] = u32x4{0u, 0u, 0u, 0u}; }
      for (int j = bid; j < 128 + 4016; j += G) {
        if (j < 96) prep_mod_job(p, j, smem);
        else if (j < 128) prep_s5_job(p, j - 96);
        else prep_wt_job(p, j - 128, smem);
      }
      break;
    case PH_ROW0:
      row_phase<0>(p, 0, bid, G);
      ktab_phase(p, bid, G, 0, 1);
      break;
    case PH_PROJ:
#ifdef EXP_A
      if (bid < 256) { int mt, nt; for (int it = 0; gemm_job(bid, 256, it, 264, 10, mt, nt, 4); ++it) proj_wide(p, l, mt, nt, smem); }
      else {
        s5mat_phase(p, l, bid - 256, G - 256);
        if (l + 1 < NL) ktab_phase(p, bid - 256, G - 256, l + 1, l + 2);
        if (l + 1 < NL) { for (int jj = (l + 1) * 4016 + (bid - 256); jj < (l + 2) * 4016; jj += G - 256) prep_wt_job(p, jj, smem); }
      }
#elif defined(EXP_C)
      if (bid < 256) for (int j = bid; j < 264 * 19; j += 256) { if ((EXP_C >> (j % 19)) & 1) proj_tile(p, l, j / 19, j % 19, smem); }
      for (int j = bid; j < 264 * 19; j += G) { if (!((EXP_C >> (j % 19)) & 1)) proj_tile(p, l, j / 19, j % 19, smem); }
      s5mat_phase(p, l, bid, G);
#elif defined(EXP_B)
      for (int j = bid; j < 264 * 19; j += G) proj_tile(p, l, j / 19, j % 19, smem);
      if (bid < 256) s5mat_phase(p, l, bid, 256);
#else
      for (int j = bid; j < 264 * 19; j += G) proj_tile(p, l, j / 19, j % 19, smem);
      s5mat_phase(p, l, bid, G);
#endif
      break;
    case PH_MIX1:
      for (int j = bid; j < (l == NL - 1 ? 1024 : 1056); j += G) attn_unit(p, j, smem);
      for (int j = bid; j < 1024; j += G) {
        const int v = j >> 5, k = j & 31;
        const int gi = (v & 1) ? (k == 0 ? 0 : k + 1) : k;
        gla_unit<false>(p, l, v * NG33 + gi, smem);
      }
      for (int j = G - 1 - bid; j < 288; j += G) s5_end_tile(p, j, smem);
      break;
    case PH_SCAN:
      for (int j = bid; j < 1024 + 128; j += G) {
        if (j < 1024) gla_scan_job(p, j);
        else s5_scan_job(p, l, j - 1024, smem);
      }
      break;
    case PH_MIX2:
      if (l == NL - 1) {
        for (int j = bid; j < 512 + 576; j += G) {
          if (j < 512) gla_unit<true>(p, l, (j >> 5) * NG33 + 1 + (j & 31), smem);
          else s5_out_tile(p, j - 512, smem);
        }
      } else {
        for (int j = bid; j < 528 + 576; j += G) {
          if (j < 528) gla_unit<true>(p, l, j, smem);
          else s5_out_tile(p, j - 528, smem);
        }
      }
      break;
    case PH_GLU:
      { const bool last = (l == NL - 1); int mt, nt;
        for (int it = 0; gemm_job(bid, G, it, last ? 256 : 264, 2, mt, nt); ++it) glu_tile(p, l, (last ? lat_mt(mt) : mt) * 2 + nt, smem); }
      break;
    case PH_MERGE:
      { const bool last = (l == NL - 1); int mt, nt;
        for (int it = 0; gemm_job(bid, G, it, last ? 256 : 264, 8, mt, nt); ++it) merge_tile(p, l, (last ? lat_mt(mt) : mt) * 8 + nt, smem); }
      break;
    case PH_WOUT:
      for (int it = 0;; ++it) {
        int mt, nt;
        if (!gemm_job(bid, G, it, (l == NL - 1) ? 256 : 264, 8, mt, nt)) break;
        if (l == NL - 1) mt = lat_mt(mt);
        plain_tile((const bf16*)(p.ws + OFF_MG) + (size_t)mt * 128 * DM, DM, wl(p, l, WL_WOUT) + (size_t)nt * 128 * DM,
                   (bf16*)(p.ws + OFF_H) + (size_t)mt * 128 * DM + nt * 128, DM, smem);
      }
      break;
    case PH_ROW1: row_phase<1>(p, l, bid, G); break;
    case PH_UP:
      { const bool last = (l == NL - 1); int mt, nt;
        for (int it = 0; gemm_job(bid, G, it, last ? 264 : 276, 22, mt, nt, 4); ++it) up_wide(p, l, last ? lat_up(mt) : mt, nt, smem); }
      break;
    case PH_DOWN:
      for (int it = 0;; ++it) {
        int mt, nt;
        if (!gemm_job(bid, G, it, (l == NL - 1) ? 256 : 264, 8, mt, nt)) break;
        if (l == NL - 1) mt = lat_mt(mt);
        plain_tile((const bf16*)(p.ws + OFF_G) + (size_t)mt * 128 * DFF, DFF, wl(p, l, WL_DOWN) + (size_t)nt * 128 * DFF,
                   (bf16*)(p.ws + OFF_H) + (size_t)mt * 128 * DM + nt * 128, DM, smem);
      }
      break;
    case PH_ROW2: row_phase<2>(p, l, bid, G); break;
  }
}

#define XB_TMO      128
#define XB_XCNT(j)  (256  + 64 * (j))
#define XB_XSUB(j)  (1280 + 64 * (j))
#define XB_XGEN(j)  (2304 + 64 * (j))
#define XB_TOP      3328
#define XB_TOPGEN   3392
#define XCD_BAR_WORDS 3456
#define XB_SPIN_CAP (1u << 18)
#define LAS __attribute__((address_space(3)))

__device__ __forceinline__ unsigned xb_ld(unsigned* p)              { return __hip_atomic_load(p, __ATOMIC_RELAXED, __HIP_MEMORY_SCOPE_AGENT); }
__device__ __forceinline__ unsigned xb_add(unsigned* p, unsigned v) { return __hip_atomic_fetch_add(p, v, __ATOMIC_RELAXED, __HIP_MEMORY_SCOPE_AGENT); }
__device__ __forceinline__ unsigned xb_xcc_id() { return (unsigned)__builtin_amdgcn_s_getreg((3 << 11) | 20) & 0xFu; }
#define XB_SPIN(cond, bar) do { unsigned _sp = 0; while (cond) { __builtin_amdgcn_s_sleep(1); \
    if ((++_sp & 255u) == 0u) { if (xb_ld(&(bar)[XB_TMO])) break; if (_sp > XB_SPIN_CAP) { atomicAdd(&(bar)[XB_TMO], 1u); break; } } } } while (0)

struct XcdBarrier {
    unsigned* bar; unsigned x;
    volatile LAS unsigned* st;
};

__device__ __forceinline__ XcdBarrier xcd_barrier_post(unsigned* bar, volatile LAS unsigned* st) {
    XcdBarrier b; b.bar = bar; b.x = xb_xcc_id(); b.st = st;
    if (threadIdx.x == 0) (void)xb_add(&bar[XB_XCNT(b.x)], 1u);
    return b;
}
__device__ __forceinline__ void xcd_barrier_complete(unsigned* bar, unsigned x, unsigned& nloc, unsigned& nx) {
    const unsigned G = gridDim.x * gridDim.y * gridDim.z;
    unsigned sum, cnt, mine, sp = 0u;
    for (;;) {
        sum = 0u; cnt = 0u; mine = 0u;
#pragma unroll
        for (unsigned j = 0; j < 16; ++j) { const unsigned c = xb_ld(&bar[XB_XCNT(j)]); sum += c; cnt += (c > 0u) ? 1u : 0u; mine = (j == x) ? c : mine; }
        if (sum == G) break;
        __builtin_amdgcn_s_sleep(1);
        if ((++sp & 255u) == 0u) { if (xb_ld(&bar[XB_TMO])) break; if (sp > XB_SPIN_CAP) { atomicAdd(&bar[XB_TMO], 1u); break; } }
    }
    nloc = mine > 0u ? mine : 1u; nx = cnt > 0u ? cnt : 1u;
}

__device__ __forceinline__ void xcd_barrier(const XcdBarrier& b) {
    asm volatile("s_waitcnt vmcnt(0)" ::: "memory");
    __syncthreads();
    if (threadIdx.x == 0) {
        unsigned* bar = b.bar;
        __builtin_amdgcn_s_waitcnt(0);
        unsigned nloc = b.st[0], nx = b.st[1];
        if (nloc == 0u) { xcd_barrier_complete(bar, b.x, nloc, nx); b.st[0] = nloc; b.st[1] = nx; }
        const unsigned old = xb_add(&bar[XB_XSUB(b.x)], 1u);
        const unsigned gen = old / nloc;
        if (old + 1u == (gen + 1u) * nloc) {
            __builtin_amdgcn_fence(__ATOMIC_RELEASE, "agent");
            asm volatile("s_waitcnt vmcnt(0)" ::: "memory");
            const unsigned og = xb_add(&bar[XB_TOP], 1u);
            const unsigned tg = og / nx;
            if (og + 1u == (tg + 1u) * nx) xb_add(&bar[XB_TOPGEN], 1u);
            else XB_SPIN(xb_ld(&bar[XB_TOPGEN]) == tg, bar);
            __builtin_amdgcn_fence(__ATOMIC_ACQUIRE, "agent");
            xb_add(&bar[XB_XGEN(b.x)], 1u);
            asm volatile("s_waitcnt vmcnt(0)" ::: "memory");
        } else {
            XB_SPIN(xb_ld(&bar[XB_XGEN(b.x)]) == gen, bar);
            __builtin_amdgcn_fence(__ATOMIC_ACQUIRE, "agent");
            asm volatile("s_waitcnt vmcnt(0)" ::: "memory");
        }
    }
    __syncthreads();
}


DI void grid_barrier(unsigned* bar, unsigned& gen) {
  asm volatile("s_waitcnt vmcnt(0)" ::: "memory");
  __syncthreads();
  gen += 1;
  if (threadIdx.x == 0) {
    __builtin_amdgcn_fence(__ATOMIC_RELEASE, "agent");
    asm volatile("s_waitcnt vmcnt(0)" ::: "memory");
    const unsigned target = gen * gridDim.x;
    __hip_atomic_fetch_add(bar, 1u, __ATOMIC_RELAXED, __HIP_MEMORY_SCOPE_AGENT);
    while (__hip_atomic_load(bar, __ATOMIC_RELAXED, __HIP_MEMORY_SCOPE_AGENT) < target) __builtin_amdgcn_s_sleep(2);
  }
  __syncthreads();
  __builtin_amdgcn_fence(__ATOMIC_ACQUIRE, "agent");
  asm volatile("s_waitcnt vmcnt(0)" ::: "memory");
}

__global__ void __launch_bounds__(256, 2) hybrid_fwd(Params p, int ph_lo, int ph_hi) {
  extern __shared__ __attribute__((aligned(16))) char smem[];
  unsigned* bar = (unsigned*)(p.ws + OFF_BAR);
  unsigned gen = 0;
  __shared__ uint4 xb_words;
  if (threadIdx.x == 0) xb_words = make_uint4(0u, 0u, 0u, 0u);
  __syncthreads();
  XcdBarrier xb = xcd_barrier_post(bar + 64, (volatile LAS unsigned*)&xb_words);
  if (ph_hi - ph_lo > 1) cg::this_grid().sync();
  int i = 0;
#define STEP(PH, L)                                      \
  {                                                      \
    if (i >= ph_lo && i < ph_hi) {                       \
      Params q;                                          \
      q.ws = p.ws; q.out = p.out;                        \
      asm volatile("" : "+s"(q.ws), "+s"(q.out));        \
      _Pragma("unroll") for (int k = 0; k < 34; ++k) { q.in[k] = p.in[k]; asm volatile("" : "+s"(q.in[k])); } \
      run_phase(q, PH, L, smem);                         \
      if ((DUPMASK >> (PH)) & 1) { xcd_barrier(xb); run_phase(q, PH, L, smem); } \
      if (i + 1 < ph_hi) xcd_barrier(xb);                \
    }                                                    \
    ++i;                                                 \
  }
  STEP(PH_PREP, 0)
  STEP(PH_ROW0, 0)
#pragma unroll 1
  for (int l = 0; l < NL; ++l) {
    STEP(PH_PROJ, l)
    STEP(PH_MIX1, l)
    STEP(PH_SCAN, l)
    STEP(PH_MIX2, l)
    STEP(PH_GLU, l)
    STEP(PH_MERGE, l)
    STEP(PH_WOUT, l)
    STEP(PH_ROW1, l)
    STEP(PH_UP, l)
    STEP(PH_DOWN, l)
    STEP(PH_ROW2, l)
  }
#undef STEP
}

extern "C" void kernel_launch(void* const* d_in, const int* in_sizes, int n_in, void* d_out, int out_size, void* d_ws, size_t ws_size,
                              hipStream_t stream) {
  static int grid_blocks = 0;
  if (!grid_blocks) {
    int dev = 0, cus = 0, per_cu = 0;
    hipGetDevice(&dev);
    hipDeviceGetAttribute(&cus, hipDeviceAttributeMultiprocessorCount, dev);
    hipFuncSetAttribute((const void*)hybrid_fwd, hipFuncAttributeMaxDynamicSharedMemorySize, SMEM_BYTES);
    hipOccupancyMaxActiveBlocksPerMultiprocessor(&per_cu, hybrid_fwd, 256, SMEM_BYTES);
    if (per_cu < 1) per_cu = 1;
    if (per_cu > 2) per_cu = 2;
    grid_blocks = cus * per_cu;
    if (ws_size < OFF_ZERO + 8192) fprintf(stderr, "workspace too small: %zu < %zu\n", ws_size, (size_t)OFF_END);
  }
  Params p{};
  for (int i = 0; i < 34; ++i) p.in[i] = (const float*)d_in[i];
  p.out = (float*)d_out;
  p.ws = (char*)d_ws;
#if ONE_LAUNCH
  hipMemsetAsync((char*)d_ws + OFF_BAR, 0, 16384, stream);
  int lo = 0, hi = N_PHASES;
  void* args[] = {&p, &lo, &hi};
  hipError_t e = hipLaunchCooperativeKernel((void*)hybrid_fwd, dim3(grid_blocks), dim3(256), args, SMEM_BYTES, stream);
  if (e != hipSuccess) fprintf(stderr, "cooperative launch failed: %s (grid %d)\n", hipGetErrorString(e), grid_blocks);
#else
  for (int i = 0; i < N_PHASES; ++i) hipLaunchKernelGGL(hybrid_fwd, dim3(grid_blocks), dim3(256), SMEM_BYTES, stream, p, i, i + 1);
#endif
}
```

```cpp
#include <hip/hip_runtime.h>
#include <hip/hip_cooperative_groups.h>
#include <stdint.h>
#include <cstdio>
namespace cg = cooperative_groups;

#define EXP_A 1
#ifndef DUPMASK
#define DUPMASK 0
#endif
#ifndef ONE_LAUNCH
#define ONE_LAUNCH 1
#endif

typedef unsigned short bf16;
typedef __attribute__((ext_vector_type(8))) short s16x8;
typedef __attribute__((ext_vector_type(4))) short s16x4;
typedef __attribute__((ext_vector_type(16))) float f32x16;
typedef __attribute__((ext_vector_type(4))) float f32x4;
typedef __attribute__((ext_vector_type(2))) float f32x2;
typedef __attribute__((ext_vector_type(4))) unsigned u32x4;
typedef __attribute__((ext_vector_type(2))) unsigned u32x2;
typedef __attribute__((ext_vector_type(2))) __bf16 bf16x2_t;

#define DI __device__ __forceinline__
#define MFMA32(a, b, c) __builtin_amdgcn_mfma_f32_32x32x16_bf16((a), (b), (c), 0, 0, 0)

DI int tidx_opaque() { int t = threadIdx.x; asm volatile("" : "+v"(t)); return t; }
#define TIDX tidx_opaque()
DI bf16 f2bf(float x) { return __builtin_bit_cast(unsigned short, (__bf16)x); }
DI float bf2f(bf16 v) { return __uint_as_float(((unsigned)v) << 16); }
DI unsigned pack2(float a, float b) {
  f32x2 v = {a, b};
  return __builtin_bit_cast(unsigned, __builtin_convertvector(v, bf16x2_t));
}
DI float bflo(unsigned u) { return __uint_as_float(u << 16); }
DI float bfhi(unsigned u) { return __uint_as_float(u & 0xffff0000u); }
typedef const __attribute__((address_space(1))) u32x4* gptr16;
DI u32x4 ldg16(const void* q) { return *(gptr16)(uintptr_t)q; }
#define SCHED_FENCE() __builtin_amdgcn_sched_barrier(0)
DI int crow(int i, int h) { return (i & 3) + 8 * (i >> 2) + 4 * h; }
DI void sincos_cw(float x, float& sn, float& cs) {
  const float k = rintf(x * 0.63661977236758134f);
  float r = fmaf(-k, 1.57079637050628662109375f, x);
  r = fmaf(-k, -4.371139000186241e-08f, r);
  const int q = ((int)k) & 3;
  const float r2 = r * r;
  const float sp = r + r * r2 * (-1.6666667163e-01f + r2 * (8.3333337680e-03f + r2 * (-1.9841270114e-04f + r2 * 2.7557314297e-06f)));
  const float cp = 1.f + r2 * (-0.5f + r2 * (4.1666667908e-02f + r2 * (-1.3888889225e-03f + r2 * (2.4801587642e-05f - r2 * 2.7557314297e-07f))));
  sn = (q == 0) ? sp : (q == 1) ? cp : (q == 2) ? -sp : -cp;
  cs = (q == 0) ? cp : (q == 1) ? -sp : (q == 2) ? -cp : sp;
}
DI float sigmoidf_(float x) { return 1.f / (1.f + __expf(-x)); }
DI float siluf_(float x) { return x / (1.f + __expf(-x)); }

constexpr int DM = 1024, NB = 4, SEQ = 8192, CTXL = 256, TT = SEQ + CTXL, NTOK = NB * TT, NL = 4;
constexpr int DFF = 2816, DIN = 5408;
constexpr float EPSF = 1e-6f;
constexpr int NG33 = 33;
constexpr int NCH = 264;
constexpr int MS5 = NB * NCH;

constexpr size_t SZ_H = (size_t)NTOK * 1024 * 2;
constexpr size_t OFF_H = 0;
constexpr size_t OFF_P = OFF_H + SZ_H;
constexpr size_t OFF_Q = OFF_P;
constexpr size_t OFF_K = OFF_Q + (size_t)NTOK * 256 * 2;
constexpr size_t OFF_VT = OFF_K + (size_t)NTOK * 128 * 2;
constexpr size_t OFF_GQ = OFF_VT + (size_t)NTOK * 128 * 2;
constexpr size_t OFF_GK = OFF_GQ + (size_t)NTOK * 256 * 2;
constexpr size_t OFF_GVT = OFF_GK + (size_t)NTOK * 256 * 2;
constexpr size_t OFF_GR = OFF_GVT + (size_t)NTOK * 512 * 2;
constexpr size_t OFF_SU = OFF_GR + (size_t)NTOK * 512 * 2;
constexpr size_t OFF_LOW = OFF_SU + (size_t)NTOK * 256 * 2;
constexpr size_t OFF_O = OFF_LOW + (size_t)NTOK * 32 * 4;
constexpr size_t OFF_OATT = OFF_O;
constexpr size_t OFF_OGLA = OFF_OATT + (size_t)NTOK * 256 * 2;
constexpr size_t OFF_Y5 = OFF_OGLA + (size_t)NTOK * 512 * 2;
constexpr size_t OFF_EN = OFF_Y5;
constexpr size_t OFF_OS5 = OFF_Y5 + (size_t)NTOK * 256 * 2;
constexpr size_t OFF_M = OFF_OS5 + (size_t)NTOK * 256 * 2;
constexpr size_t OFF_MG = OFF_M;
constexpr size_t OFF_GS = OFF_M;
constexpr size_t OFF_DECG = OFF_GS + (size_t)32 * 33 * 8192 * 4;
constexpr size_t OFF_SB = OFF_DECG + (size_t)32 * 33 * 64 * 4;
constexpr size_t OFF_T5 = OFF_SB + (size_t)MS5 * 16 * 256 * 2;
constexpr size_t OFF_E5 = OFF_T5 + (size_t)16 * 512 * 512 * 2;
constexpr size_t OFF_F5 = OFF_E5 + (size_t)16 * 512 * 256 * 2;
constexpr size_t OFF_MEND = OFF_F5 + (size_t)16 * 256 * 512 * 2;
static_assert(OFF_MEND <= OFF_M + SZ_H, "mixer scratch overflows merged area");
constexpr size_t OFF_W = OFF_M + SZ_H;
constexpr size_t WL_WIN = 0, WL_BRA = WL_WIN + (size_t)5504 * 1024, WL_BRG = WL_BRA + 1024 * 256, WL_BRS = WL_BRG + 1024 * 512,
                 WL_WOUT = WL_BRS + 1024 * 256, WL_UP = WL_WOUT + 1024 * 1024, WL_DOWN = WL_UP + (size_t)5632 * 1024,
                 WL_GLU = WL_DOWN + (size_t)1024 * 2816, WL_TOTAL = WL_GLU + 256 * 256;
constexpr size_t OFF_XC = OFF_W + WL_TOTAL * 2 * NL;
constexpr size_t OFF_MOD = OFF_XC + (size_t)NB * CTXL * 1024 * 4;
constexpr size_t OFF_BBR = OFF_MOD + (size_t)NL * 5 * 6144 * 4;
constexpr size_t OFF_BBI = OFF_BBR + (size_t)NL * 2 * 16 * 64 * 16 * 4;
constexpr size_t OFF_PWR = OFF_BBI + (size_t)NL * 2 * 16 * 64 * 16 * 4;
constexpr size_t OFF_KTAB = OFF_PWR + (size_t)NL * 2 * 16 * 33 * 64 * 8;
constexpr size_t OFF_END = OFF_KTAB + (size_t)NL * 16 * 2 * 32 * 256 * 4;
constexpr size_t OFF_BAR = OFF_END;
constexpr size_t OFF_ZERO = OFF_BAR + 16384;
constexpr size_t OFF_G = OFF_P;
static_assert((size_t)NTOK * DFF * 2 <= OFF_M - OFF_P, "G overflows");

constexpr int SMEM_BYTES = 73728;

struct Params {
  const float* in[34];
  float* out;
  char* ws;
};

enum { I_X = 0, I_C, I_CTX, I_CCTX, I_ADAW, I_ADAB, I_NMPRE, I_NMPOST, I_NFPRE, I_NFPOST, I_WIN, I_QN, I_KN, I_GGW, I_GGB, I_GON,
       I_ARE, I_AIM, I_LDT, I_BRE, I_BIM, I_CRE, I_CIM, I_S5D, I_GLUW, I_GLUB, I_WBA, I_WBG, I_WBS, I_WOUT, I_UP, I_CW, I_CB, I_DOWN };

constexpr int LDT = 72;
constexpr int CLD = 132;

template <class FA, class FB>
DI void gemm_main(f32x16 (&acc)[2][2], FA fa, FB fb, int K, char* smem) {
  bf16* As = (bf16*)smem;
  bf16* Bs = (bf16*)(smem + 2 * 128 * LDT * 2);
  const int tid = TIDX, lane = tid & 63, w = tid >> 6, wm = w >> 1, wn = w & 1;
  const int r = lane & 31, h = lane >> 5;
  const int lr = tid >> 3, kc = (tid & 7) * 8;
  const bf16* ap[4];
  const bf16* bp[4];
#pragma unroll
  for (int i = 0; i < 4; ++i) {
    const bf16* a = fa(lr + 32 * i);
    const bf16* b = fb(lr + 32 * i);
    ap[i] = a ? a + kc : nullptr;
    bp[i] = b ? b + kc : nullptr;
  }
  u32x4 ra[4], rb[4];
  const u32x4 z4 = {0u, 0u, 0u, 0u};
#pragma unroll
  for (int i = 0; i < 4; ++i) {
    ra[i] = ap[i] ? ldg16(ap[i]) : z4;
    rb[i] = bp[i] ? ldg16(bp[i]) : z4;
  }
#pragma unroll
  for (int i = 0; i < 4; ++i) {
    *(u32x4*)(As + (lr + 32 * i) * LDT + kc) = ra[i];
    *(u32x4*)(Bs + (lr + 32 * i) * LDT + kc) = rb[i];
  }
  __syncthreads();
  const int nk = K / 64;
  for (int kt = 0; kt < nk; ++kt) {
    const int buf = kt & 1;
    const bool more = (kt + 1 < nk);
    if (more) {
      const int k0 = (kt + 1) * 64;
#pragma unroll
      for (int i = 0; i < 4; ++i) {
        ra[i] = ap[i] ? ldg16(ap[i] + k0) : z4;
        rb[i] = bp[i] ? ldg16(bp[i] + k0) : z4;
      }
    }
    SCHED_FENCE();
    const bf16* Ab = As + buf * 128 * LDT + (wm * 64 + r) * LDT + h * 8;
    const bf16* Bb = Bs + buf * 128 * LDT + (wn * 64 + r) * LDT + h * 8;
#pragma unroll
    for (int s = 0; s < 4; ++s) {
      s16x8 a0 = *(const s16x8*)(Ab + s * 16);
      s16x8 a1 = *(const s16x8*)(Ab + 32 * LDT + s * 16);
      s16x8 b0 = *(const s16x8*)(Bb + s * 16);
      s16x8 b1 = *(const s16x8*)(Bb + 32 * LDT + s * 16);
      acc[0][0] = MFMA32(a0, b0, acc[0][0]);
      acc[0][1] = MFMA32(a0, b1, acc[0][1]);
      acc[1][0] = MFMA32(a1, b0, acc[1][0]);
      acc[1][1] = MFMA32(a1, b1, acc[1][1]);
    }
    SCHED_FENCE();
    if (more) {
      bf16* Aw = As + (buf ^ 1) * 128 * LDT;
      bf16* Bw = Bs + (buf ^ 1) * 128 * LDT;
#pragma unroll
      for (int i = 0; i < 4; ++i) {
        *(u32x4*)(Aw + (lr + 32 * i) * LDT + kc) = ra[i];
        *(u32x4*)(Bw + (lr + 32 * i) * LDT + kc) = rb[i];
      }
    }
    __syncthreads();
  }
}

template <class FA, class FB>
DI void gemm_main_deep(f32x16 (&acc)[2][2], FA fa, FB fb, int K, char* smem) {
  bf16* As = (bf16*)smem;
  bf16* Bs = (bf16*)(smem + 2 * 128 * LDT * 2);
  const int tid = TIDX, lane = tid & 63, w = tid >> 6, wm = w >> 1, wn = w & 1;
  const int r = lane & 31, h = lane >> 5;
  const int lr = tid >> 3, kc = (tid & 7) * 8;
  const bf16* ap[4];
  const bf16* bp[4];
#pragma unroll
  for (int i = 0; i < 4; ++i) {
    const bf16* a = fa(lr + 32 * i);
    const bf16* b = fb(lr + 32 * i);
    ap[i] = a ? a + kc : nullptr;
    bp[i] = b ? b + kc : nullptr;
  }
  const u32x4 z4 = {0u, 0u, 0u, 0u};
  u32x4 a0[4], b0[4], a1[4], b1[4];
  const int nk = K / 64;
#define GD_LOAD(RA, RB, T)                                               \
  {                                                                      \
    const int k0_ = (T) * 64;                                            \
    _Pragma("unroll") for (int i = 0; i < 4; ++i) {                      \
      RA[i] = ap[i] ? ldg16(ap[i] + k0_) : z4;                           \
      RB[i] = bp[i] ? ldg16(bp[i] + k0_) : z4;                           \
    }                                                                    \
  }
#define GD_STORE(RA, RB, BUF)                                            \
  {                                                                      \
    _Pragma("unroll") for (int i = 0; i < 4; ++i) {                      \
      *(u32x4*)(As + (BUF) * 128 * LDT + (lr + 32 * i) * LDT + kc) = RA[i]; \
      *(u32x4*)(Bs + (BUF) * 128 * LDT + (lr + 32 * i) * LDT + kc) = RB[i]; \
    }                                                                    \
  }
#define GD_COMPUTE(BUF)                                                  \
  {                                                                      \
    const bf16* Ab = As + (BUF) * 128 * LDT + (wm * 64 + r) * LDT + h * 8; \
    const bf16* Bb = Bs + (BUF) * 128 * LDT + (wn * 64 + r) * LDT + h * 8; \
    _Pragma("unroll") for (int s = 0; s < 4; ++s) {                      \
      s16x8 fa0 = *(const s16x8*)(Ab + s * 16);                          \
      s16x8 fa1 = *(const s16x8*)(Ab + 32 * LDT + s * 16);               \
      s16x8 fb0 = *(const s16x8*)(Bb + s * 16);                          \
      s16x8 fb1 = *(const s16x8*)(Bb + 32 * LDT + s * 16);               \
      acc[0][0] = MFMA32(fa0, fb0, acc[0][0]);                           \
      acc[0][1] = MFMA32(fa0, fb1, acc[0][1]);                           \
      acc[1][0] = MFMA32(fa1, fb0, acc[1][0]);                           \
      acc[1][1] = MFMA32(fa1, fb1, acc[1][1]);                           \
    }                                                                    \
  }
  GD_LOAD(a0, b0, 0)
  GD_LOAD(a1, b1, 1)
  GD_STORE(a0, b0, 0)
  __syncthreads();
  if (nk > 2) GD_LOAD(a0, b0, 2)
  for (int kt = 0; kt < nk; kt += 2) {
    SCHED_FENCE();
    GD_COMPUTE(0)
    SCHED_FENCE();
    GD_STORE(a1, b1, 1)
    if (kt + 3 < nk) GD_LOAD(a1, b1, kt + 3)
    __syncthreads();
    SCHED_FENCE();
    GD_COMPUTE(1)
    SCHED_FENCE();
    if (kt + 2 < nk) {
      GD_STORE(a0, b0, 0)
      if (kt + 4 < nk) GD_LOAD(a0, b0, kt + 4)
    }
    __syncthreads();
  }
#undef GD_LOAD
#undef GD_STORE
#undef GD_COMPUTE
}

template <class FA, class FB>
DI void gemm_main_dma(f32x16 (&acc)[2][2], FA fa, FB fb, int K, char* smem) {
  char* As = smem;
  char* Bs = smem + 32768;
  const int tid = TIDX, lane = tid & 63, w = tid >> 6, wm = w >> 1, wn = w & 1;
  const int r = lane & 31, h = lane >> 5;
  const bf16* ap[4];
  const bf16* bp[4];
#pragma unroll
  for (int i = 0; i < 4; ++i) {
    const int row = w * 32 + i * 8 + (lane >> 3);
    const int c = (lane & 7) ^ ((row >> 1) & 7);
    ap[i] = fa(row) + c * 8;
    bp[i] = fb(row) + c * 8;
  }
  const int ldst = (w * 256 + lane) * 16;
#define GM_DMA(BUF, T)                                                                                        \
  {                                                                                                           \
    const int k0_ = (T) * 64;                                                                                 \
    _Pragma("unroll") for (int i = 0; i < 4; ++i) {                                                           \
      __builtin_amdgcn_global_load_lds((const unsigned*)(ap[i] + k0_), (unsigned*)(As + (BUF) * 16384 + ldst + i * 1024), 16, 0, 0); \
      __builtin_amdgcn_global_load_lds((const unsigned*)(bp[i] + k0_), (unsigned*)(Bs + (BUF) * 16384 + ldst + i * 1024), 16, 0, 0); \
    }                                                                                                         \
  }
  const int xr = (r >> 1) & 7;
  const int arow = (wm * 64 + r) * 128, brow = (wn * 64 + r) * 128;
  GM_DMA(0, 0)
  asm volatile("s_waitcnt vmcnt(0)" ::: "memory");
  __syncthreads();
  const int nk = K / 64;
  for (int kt = 0; kt < nk; ++kt) {
    const int buf = kt & 1;
    if (kt + 1 < nk) GM_DMA(buf ^ 1, kt + 1)
    const char* Ab = As + buf * 16384 + arow;
    const char* Bb = Bs + buf * 16384 + brow;
#pragma unroll
    for (int s = 0; s < 4; ++s) {
      const int co = ((2 * s + h) ^ xr) * 16;
      s16x8 a0 = *(const s16x8*)(Ab + co);
      s16x8 a1 = *(const s16x8*)(Ab + 32 * 128 + co);
      s16x8 b0 = *(const s16x8*)(Bb + co);
      s16x8 b1 = *(const s16x8*)(Bb + 32 * 128 + co);
      acc[0][0] = MFMA32(a0, b0, acc[0][0]);
      acc[0][1] = MFMA32(a0, b1, acc[0][1]);
      acc[1][0] = MFMA32(a1, b0, acc[1][0]);
      acc[1][1] = MFMA32(a1, b1, acc[1][1]);
    }
    asm volatile("s_waitcnt vmcnt(0)" ::: "memory");
    __syncthreads();
  }
#undef GM_DMA
}

DI void gemm_main_dma_half(f32x16 (&acc)[2], const bf16* A, int lda, const bf16* B, int ldb, int K, int hf, char* smem) {
  char* As = smem;
  char* Bs = smem + 32768;
  const int tid = TIDX, lane = tid & 63, w = tid >> 6, wm = w >> 1, wn = w & 1;
  const int r = lane & 31, h = lane >> 5;
  const bf16* ap[4];
  const bf16* bp[2];
#pragma unroll
  for (int i = 0; i < 4; ++i) {
    const int row = w * 32 + i * 8 + (lane >> 3);
    ap[i] = A + (size_t)row * lda + ((lane & 7) ^ ((row >> 1) & 7)) * 8;
  }
#pragma unroll
  for (int i = 0; i < 2; ++i) {
    const int lrow = w * 16 + i * 8 + (lane >> 3);
    const int grow = (lrow >> 5) * 64 + hf * 32 + (lrow & 31);
    bp[i] = B + (size_t)grow * ldb + ((lane & 7) ^ ((lrow >> 1) & 7)) * 8;
  }
  const int lda_ = (w * 256 + lane) * 16, ldb_ = (w * 128 + lane) * 16;
#define GH_DMA(BUF, T)                                                                                        \
  {                                                                                                           \
    const int k0_ = (T) * 64;                                                                                 \
    _Pragma("unroll") for (int i = 0; i < 4; ++i)                                                             \
      __builtin_amdgcn_global_load_lds((const unsigned*)(ap[i] + k0_), (unsigned*)(As + (BUF) * 16384 + lda_ + i * 1024), 16, 0, 0); \
    _Pragma("unroll") for (int i = 0; i < 2; ++i)                                                             \
      __builtin_amdgcn_global_load_lds((const unsigned*)(bp[i] + k0_), (unsigned*)(Bs + (BUF) * 8192 + ldb_ + i * 1024), 16, 0, 0); \
  }
  const int xr = (r >> 1) & 7;
  const int arow = (wm * 64 + r) * 128, brow = (wn * 32 + r) * 128;
  GH_DMA(0, 0)
  asm volatile("s_waitcnt vmcnt(0)" ::: "memory");
  __syncthreads();
  const int nk = K / 64;
  for (int kt = 0; kt < nk; ++kt) {
    const int buf = kt & 1;
    if (kt + 1 < nk) GH_DMA(buf ^ 1, kt + 1)
    const char* Ab = As + buf * 16384 + arow;
    const char* Bb = Bs + buf * 8192 + brow;
#pragma unroll
    for (int s = 0; s < 4; ++s) {
      const int co = ((2 * s + h) ^ xr) * 16;
      s16x8 a0 = *(const s16x8*)(Ab + co);
      s16x8 a1 = *(const s16x8*)(Ab + 32 * 128 + co);
      s16x8 b0 = *(const s16x8*)(Bb + co);
      acc[0] = MFMA32(a0, b0, acc[0]);
      acc[1] = MFMA32(a1, b0, acc[1]);
    }
    asm volatile("s_waitcnt vmcnt(0)" ::: "memory");
    __syncthreads();
  }
#undef GH_DMA
}

template <class FA, class FB>
DI void gemm_wide(f32x16 (&acc)[2][4], FA fa, FB fb, int K, char* smem) {
  const int tid = TIDX, lane = tid & 63, w = tid >> 6, wm = w >> 1, wn = w & 1;
  const int r = lane & 31, h = lane >> 5;
  const bf16* ap[2];
  const bf16* bp[4];
#pragma unroll
  for (int i = 0; i < 2; ++i) {
    const int row = w * 32 + i * 16 + (lane >> 2);
    ap[i] = fa(row) + ((lane & 3) ^ ((row >> 2) & 3)) * 8;
  }
#pragma unroll
  for (int i = 0; i < 4; ++i) {
    const int row = w * 64 + i * 16 + (lane >> 2);
    bp[i] = fb(row) + ((lane & 3) ^ ((row >> 2) & 3)) * 8;
  }
  const int lda_ = (w * 128 + lane) * 16;
  const int ldb_ = 8192 + (w * 256 + lane) * 16;
#define GW_DMA(T)                                                                                                   \
  {                                                                                                                 \
    char* st_ = smem + ((T) % 3) * 24576;                                                                           \
    const int k0_ = (T) * 32;                                                                                       \
    _Pragma("unroll") for (int i = 0; i < 2; ++i)                                                                   \
      __builtin_amdgcn_global_load_lds((const unsigned*)(ap[i] + k0_), (unsigned*)(st_ + lda_ + i * 1024), 16, 0, 0); \
    _Pragma("unroll") for (int i = 0; i < 4; ++i)                                                                   \
      __builtin_amdgcn_global_load_lds((const unsigned*)(bp[i] + k0_), (unsigned*)(st_ + ldb_ + i * 1024), 16, 0, 0); \
  }
  const int xr = (r >> 2) & 3;
  const int arow = (wm * 64 + r) * 64;
  const int brow = 8192 + (wn * 64 + r) * 64;
  const int nt = K / 32;
  GW_DMA(0)
  if (nt > 1) GW_DMA(1)
  for (int t = 0; t < nt; ++t) {
    if (t + 1 < nt) asm volatile("s_waitcnt vmcnt(6)" ::: "memory");
    else asm volatile("s_waitcnt vmcnt(0)" ::: "memory");
    __syncthreads();
    if (t + 2 < nt) GW_DMA(t + 2)
    const char* st = smem + (t % 3) * 24576;
#pragma unroll
    for (int s = 0; s < 2; ++s) {
      const int co = ((2 * s + h) ^ xr) * 16;
      const s16x8 a0 = *(const s16x8*)(st + arow + co);
      const s16x8 a1 = *(const s16x8*)(st + arow + 32 * 64 + co);
#pragma unroll
      for (int hn = 0; hn < 2; ++hn) {
        const s16x8 b0 = *(const s16x8*)(st + brow + hn * 128 * 64 + co);
        const s16x8 b1 = *(const s16x8*)(st + brow + hn * 128 * 64 + 32 * 64 + co);
        acc[0][hn * 2 + 0] = MFMA32(a0, b0, acc[0][hn * 2 + 0]);
        acc[0][hn * 2 + 1] = MFMA32(a0, b1, acc[0][hn * 2 + 1]);
        acc[1][hn * 2 + 0] = MFMA32(a1, b0, acc[1][hn * 2 + 0]);
        acc[1][hn * 2 + 1] = MFMA32(a1, b1, acc[1][hn * 2 + 1]);
      }
    }
  }
  __syncthreads();
#undef GW_DMA
}

DI void accw_zero(f32x16 (&acc)[2][4]) {
#pragma unroll
  for (int a = 0; a < 2; ++a)
#pragma unroll
    for (int b = 0; b < 4; ++b)
#pragma unroll
      for (int i = 0; i < 16; ++i) acc[a][b][i] = 0.f;
}

DI void gemm_main_s(f32x16 (&acc)[2][2], const bf16* A, int lda, const bf16* B, int ldb, int K, char* smem) {
  bf16* As = (bf16*)smem;
  bf16* Bs = (bf16*)(smem + 2 * 128 * LDT * 2);
  const int tid = TIDX, lane = tid & 63, w = tid >> 6, wm = w >> 1, wn = w & 1;
  const int r = lane & 31, h = lane >> 5;
  const int lr = tid >> 3, kc = (tid & 7) * 8;
  const bf16* ap = A + (size_t)lr * lda + kc;
  const bf16* bp = B + (size_t)lr * ldb + kc;
  const size_t sa = (size_t)32 * lda, sb = (size_t)32 * ldb;
  u32x4 ra[4], rb[4];
#pragma unroll
  for (int i = 0; i < 4; ++i) {
    ra[i] = ldg16(ap + i * sa);
    rb[i] = ldg16(bp + i * sb);
  }
#pragma unroll
  for (int i = 0; i < 4; ++i) {
    *(u32x4*)(As + (lr + 32 * i) * LDT + kc) = ra[i];
    *(u32x4*)(Bs + (lr + 32 * i) * LDT + kc) = rb[i];
  }
  __syncthreads();
  const int nk = K / 64;
  for (int kt = 0; kt < nk; ++kt) {
    const int buf = kt & 1;
    const bool more = (kt + 1 < nk);
    if (more) {
      ap += 64; bp += 64;
#pragma unroll
      for (int i = 0; i < 4; ++i) {
        ra[i] = ldg16(ap + i * sa);
        rb[i] = ldg16(bp + i * sb);
      }
    }
    SCHED_FENCE();
    const bf16* Ab = As + buf * 128 * LDT + (wm * 64 + r) * LDT + h * 8;
    const bf16* Bb = Bs + buf * 128 * LDT + (wn * 64 + r) * LDT + h * 8;
#pragma unroll
    for (int s = 0; s < 4; ++s) {
      s16x8 a0 = *(const s16x8*)(Ab + s * 16);
      s16x8 a1 = *(const s16x8*)(Ab + 32 * LDT + s * 16);
      s16x8 b0 = *(const s16x8*)(Bb + s * 16);
      s16x8 b1 = *(const s16x8*)(Bb + 32 * LDT + s * 16);
      acc[0][0] = MFMA32(a0, b0, acc[0][0]);
      acc[0][1] = MFMA32(a0, b1, acc[0][1]);
      acc[1][0] = MFMA32(a1, b0, acc[1][0]);
      acc[1][1] = MFMA32(a1, b1, acc[1][1]);
    }
    SCHED_FENCE();
    if (more) {
      bf16* Aw = As + (buf ^ 1) * 128 * LDT;
      bf16* Bw = Bs + (buf ^ 1) * 128 * LDT;
#pragma unroll
      for (int i = 0; i < 4; ++i) {
        *(u32x4*)(Aw + (lr + 32 * i) * LDT + kc) = ra[i];
        *(u32x4*)(Bw + (lr + 32 * i) * LDT + kc) = rb[i];
      }
    }
    __syncthreads();
  }
}

DI void gemm_main_half(f32x16 (&acc)[2], const bf16* A, int lda, const bf16* B, int ldb, int K, int hf, char* smem) {
  bf16* As = (bf16*)smem;
  bf16* Bs = (bf16*)(smem + 2 * 128 * LDT * 2);
  const int tid = TIDX, lane = tid & 63, w = tid >> 6, wm = w >> 1, wn = w & 1;
  const int r = lane & 31, h = lane >> 5;
  const int lr = tid >> 3, kc = (tid & 7) * 8;
  const bf16* ap = A + (size_t)lr * lda + kc;
  const bf16* bp = B + (size_t)(hf * 32 + lr) * ldb + kc;
  const size_t sa = (size_t)32 * lda, sb = (size_t)64 * ldb;
  u32x4 ra[4], rb[2];
#pragma unroll
  for (int i = 0; i < 4; ++i) ra[i] = ldg16(ap + i * sa);
#pragma unroll
  for (int i = 0; i < 2; ++i) rb[i] = ldg16(bp + i * sb);
#pragma unroll
  for (int i = 0; i < 4; ++i) *(u32x4*)(As + (lr + 32 * i) * LDT + kc) = ra[i];
#pragma unroll
  for (int i = 0; i < 2; ++i) *(u32x4*)(Bs + (lr + 32 * i) * LDT + kc) = rb[i];
  __syncthreads();
  const int nk = K / 64;
  for (int kt = 0; kt < nk; ++kt) {
    const int buf = kt & 1;
    const bool more = (kt + 1 < nk);
    if (more) {
      ap += 64; bp += 64;
#pragma unroll
      for (int i = 0; i < 4; ++i) ra[i] = ldg16(ap + i * sa);
#pragma unroll
      for (int i = 0; i < 2; ++i) rb[i] = ldg16(bp + i * sb);
    }
    SCHED_FENCE();
    const bf16* Ab = As + buf * 128 * LDT + (wm * 64 + r) * LDT + h * 8;
    const bf16* Bb = Bs + buf * 128 * LDT + (wn * 32 + r) * LDT + h * 8;
#pragma unroll
    for (int s = 0; s < 4; ++s) {
      s16x8 a0 = *(const s16x8*)(Ab + s * 16);
      s16x8 a1 = *(const s16x8*)(Ab + 32 * LDT + s * 16);
      s16x8 b0 = *(const s16x8*)(Bb + s * 16);
      acc[0] = MFMA32(a0, b0, acc[0]);
      acc[1] = MFMA32(a1, b0, acc[1]);
    }
    SCHED_FENCE();
    if (more) {
      bf16* Aw = As + (buf ^ 1) * 128 * LDT;
      bf16* Bw = Bs + (buf ^ 1) * 128 * LDT;
#pragma unroll
      for (int i = 0; i < 4; ++i) *(u32x4*)(Aw + (lr + 32 * i) * LDT + kc) = ra[i];
#pragma unroll
      for (int i = 0; i < 2; ++i) *(u32x4*)(Bw + (lr + 32 * i) * LDT + kc) = rb[i];
    }
    __syncthreads();
  }
}

DI void acc_zero(f32x16 (&acc)[2][2]) {
#pragma unroll
  for (int a = 0; a < 2; ++a)
#pragma unroll
    for (int b = 0; b < 2; ++b)
#pragma unroll
      for (int i = 0; i < 16; ++i) acc[a][b][i] = 0.f;
}

DI void acc_to_lds(const f32x16 (&acc)[2][2], float* Cs) {
  const int lane = TIDX & 63, w = TIDX >> 6, wm = w >> 1, wn = w & 1, r = lane & 31, h = lane >> 5;
#pragma unroll
  for (int tm = 0; tm < 2; ++tm)
#pragma unroll
    for (int tn = 0; tn < 2; ++tn)
#pragma unroll
      for (int i = 0; i < 16; ++i) Cs[(wm * 64 + tm * 32 + crow(i, h)) * CLD + wn * 64 + tn * 32 + r] = acc[tm][tn][i];
}

template <int HN>
DI void accw_to_lds(const f32x16 (&acc)[2][4], float* Cs) {
  const int lane = TIDX & 63, w = TIDX >> 6, wm = w >> 1, wn = w & 1, r = lane & 31, h = lane >> 5;
#pragma unroll
  for (int tm = 0; tm < 2; ++tm)
#pragma unroll
    for (int tn = 0; tn < 2; ++tn)
#pragma unroll
      for (int i = 0; i < 16; ++i) Cs[(wm * 64 + tm * 32 + crow(i, h)) * CLD + wn * 64 + tn * 32 + r] = acc[tm][HN * 2 + tn][i];
}

DI void store_tile_bf16(const float* Cs, bf16* dst, size_t ld, int mvalid, float scale) {
  for (int c = TIDX; c < 2048; c += 256) {
    const int row = c >> 4, cc = (c & 15) * 8;
    if (row < mvalid) {
      const float* s = Cs + row * CLD + cc;
      u32x4 v;
      v[0] = pack2(s[0] * scale, s[1] * scale);
      v[1] = pack2(s[2] * scale, s[3] * scale);
      v[2] = pack2(s[4] * scale, s[5] * scale);
      v[3] = pack2(s[6] * scale, s[7] * scale);
      *(u32x4*)(dst + (size_t)row * ld + cc) = v;
    }
  }
}

DI float* resid_row(const Params& p, int tok) {
  const int b = tok / TT, t = tok - b * TT;
  return (t < CTXL) ? (float*)(p.ws + OFF_XC) + ((size_t)b * CTXL + t) * DM : p.out + ((size_t)b * SEQ + (t - CTXL)) * DM;
}
DI const float* mod_vec(const Params& p, int l, int tok, int which) {
  const int b = tok / TT, t = tok - b * TT;
  const int m = (t < CTXL) ? 4 : b;
  return (const float*)(p.ws + OFF_MOD) + ((size_t)(l * 5 + m) * 6 + which) * DM;
}
DI float wave_sum(float v) {
#pragma unroll
  for (int o = 32; o >= 1; o >>= 1) v += __shfl_xor(v, o, 64);
  return v;
}
DI bf16* wl(const Params& p, int l, size_t off) { return (bf16*)(p.ws + OFF_W) + (size_t)l * WL_TOTAL + off; }

DI void prep_mod_job(const Params& p, int j, char* smem) {
  float* sc = (float*)smem;
  float* part = (float*)(smem + 20480);
  const int l = j / 24, nb = j % 24, tid = TIDX, lane = tid & 63, w = tid >> 6;
  for (int idx = tid; idx < 5120; idx += 256) {
    const int m = idx >> 10, k = idx & 1023;
    const float v = (m < 4) ? p.in[I_C][m * 1024 + k] : p.in[I_CCTX][k];
    sc[idx] = siluf_(v);
  }
  __syncthreads();
  const float* W = p.in[I_ADAW] + (size_t)l * 1024 * 6144 + nb * 256 + lane;
  float a[5][4];
#pragma unroll
  for (int m = 0; m < 5; ++m)
#pragma unroll
    for (int c = 0; c < 4; ++c) a[m][c] = 0.f;
#pragma unroll 4
  for (int kk = 0; kk < 256; ++kk) {
    const int k = w * 256 + kk;
    float wv[4];
#pragma unroll
    for (int c = 0; c < 4; ++c) wv[c] = W[(size_t)k * 6144 + 64 * c];
#pragma unroll
    for (int m = 0; m < 5; ++m) {
      const float sv = sc[m * 1024 + k];
#pragma unroll
      for (int c = 0; c < 4; ++c) a[m][c] += sv * wv[c];
    }
  }
#pragma unroll
  for (int m = 0; m < 5; ++m)
#pragma unroll
    for (int c = 0; c < 4; ++c) part[(w * 5 + m) * 256 + lane + 64 * c] = a[m][c];
  __syncthreads();
  const int n = nb * 256 + tid;
  const float bb = p.in[I_ADAB][l * 6144 + n];
  float* M = (float*)(p.ws + OFF_MOD) + (size_t)l * 5 * 6144 + n;
#pragma unroll
  for (int m = 0; m < 5; ++m)
    M[m * 6144] = part[(0 * 5 + m) * 256 + tid] + part[(1 * 5 + m) * 256 + tid] + part[(2 * 5 + m) * 256 + tid] + part[(3 * 5 + m) * 256 + tid] + bb;
  __syncthreads();
}

DI void prep_s5_job(const Params& p, int j) {
  const int idx = j * 256 + TIDX;
  const int ldg = idx >> 6, pp = idx & 63;
  const float dt = expf(p.in[I_LDT][ldg]);
  const float are = p.in[I_ARE][idx], aim = p.in[I_AIM][idx];
  const float mag = expf(are * dt);
  float sn, cs;
  sincos_cw(aim * dt, sn, cs);
  const float abr = mag * cs, abi = mag * sn;
  const float den = are * are + aim * aim;
  const float fre = ((abr - 1.f) * are + abi * aim) / den;
  const float fim = (abi * are - (abr - 1.f) * aim) / den;
  float* BBR = (float*)(p.ws + OFF_BBR);
  float* BBI = (float*)(p.ws + OFF_BBI);
  for (int hh = 0; hh < 16; ++hh) {
    const float br = p.in[I_BRE][(size_t)idx * 16 + hh], bi = p.in[I_BIM][(size_t)idx * 16 + hh];
    BBR[(size_t)idx * 16 + hh] = fre * br - fim * bi;
    BBI[(size_t)idx * 16 + hh] = fre * bi + fim * br;
  }
  float2* PW = (float2*)(p.ws + OFF_PWR);
  float pr = 1.f, pi = 0.f;
  for (int tau = 0; tau <= 32; ++tau) {
    PW[((size_t)ldg * 33 + tau) * 64 + pp] = make_float2(pr, pi);
    const float nr = pr * abr - pi * abi, ni = pr * abi + pi * abr;
    pr = nr; pi = ni;
  }
}

DI void prep_wt_job(const Params& p, int jj, char* smem) {
  float* tile = (float*)smem;
  const int l = jj / 4016;
  int r = jj % 4016;
  int mat = 0;
  const int cnt[8] = {1376, 64, 128, 64, 256, 1408, 704, 16};
#pragma unroll
  for (int m = 0; m < 8; ++m) {
    if (mat == m && r >= cnt[m]) { r -= cnt[m]; mat = m + 1; }
  }
  const float* src; int K, sld; size_t doff;
  switch (mat) {
    case 0: src = p.in[I_WIN] + (size_t)l * 1024 * DIN; K = 1024; sld = DIN; doff = WL_WIN; break;
    case 1: src = p.in[I_WBA] + (size_t)l * 256 * 1024; K = 256; sld = 1024; doff = WL_BRA; break;
    case 2: src = p.in[I_WBG] + (size_t)l * 512 * 1024; K = 512; sld = 1024; doff = WL_BRG; break;
    case 3: src = p.in[I_WBS] + (size_t)l * 256 * 1024; K = 256; sld = 1024; doff = WL_BRS; break;
    case 4: src = p.in[I_WOUT] + (size_t)l * 1024 * 1024; K = 1024; sld = 1024; doff = WL_WOUT; break;
    case 5: src = p.in[I_UP] + (size_t)l * 1024 * 5632; K = 1024; sld = 5632; doff = WL_UP; break;
    case 6: src = p.in[I_DOWN] + (size_t)l * 2816 * 1024; K = 2816; sld = 1024; doff = WL_DOWN; break;
    default: src = p.in[I_GLUW] + (size_t)l * 256 * 256; K = 256; sld = 256; doff = WL_GLU; break;
  }
  const int kt = K / 64;
  const int n0 = (r / kt) * 64, k0 = (r % kt) * 64;
  const int tid = TIDX;
  {
    const int nn = tid & 63;
    const int np = n0 + nn;
    int col;
    if (mat == 0) {
      if (np < 2048) col = np;
      else if (np < 2304) col = 2080 + (np - 2048);
      else if (np < 2336) col = 2048 + (np - 2304);
      else if (np < 2432) col = -1;
      else col = 2336 + (np - 2432);
    } else if (mat == 5) {
      const int jb = np >> 7, c = np & 127;
      col = (c < 64) ? (jb * 64 + c) : (DFF + jb * 64 + (c - 64));
    } else col = np;
#pragma unroll 4
    for (int kk = tid >> 6; kk < 64; kk += 4) tile[kk * 65 + nn] = (col >= 0) ? src[(size_t)(k0 + kk) * sld + col] : 0.f;
  }
  __syncthreads();
  {
    const int nn = tid >> 2, kq = (tid & 3) * 16;
    bf16* d = wl(p, l, doff) + (size_t)(n0 + nn) * K + k0 + kq;
    u32x4 v0, v1;
#pragma unroll
    for (int e = 0; e < 4; ++e) {
      v0[e] = pack2(tile[(kq + 2 * e) * 65 + nn], tile[(kq + 2 * e + 1) * 65 + nn]);
      v1[e] = pack2(tile[(kq + 8 + 2 * e) * 65 + nn], tile[(kq + 8 + 2 * e + 1) * 65 + nn]);
    }
    *(u32x4*)d = v0;
    *(u32x4*)(d + 8) = v1;
  }
  __syncthreads();
}

template <int MODE>
DI void row_job(const Params& p, int l, int tok) {
  const int lane = TIDX & 63;
  float x[16];
  float* xr = resid_row(p, tok);
  if (MODE == 0) {
    const int b = tok / TT, t = tok - b * TT;
    const float* src = (t < CTXL) ? p.in[I_CTX] + ((size_t)b * CTXL + t) * DM : p.in[I_X] + ((size_t)b * SEQ + (t - CTXL)) * DM;
#pragma unroll
    for (int i = 0; i < 4; ++i) {
      const f32x4 v = *(const f32x4*)(src + lane * 4 + 256 * i);
      x[4 * i] = v[0]; x[4 * i + 1] = v[1]; x[4 * i + 2] = v[2]; x[4 * i + 3] = v[3];
      *(f32x4*)(xr + lane * 4 + 256 * i) = v;
    }
  } else {
    const bf16* yr = (const bf16*)(p.ws + OFF_H) + (size_t)tok * DM;
    const float* gpost = p.in[MODE == 1 ? I_NMPOST : I_NFPOST] + l * DM;
    const float* mg = mod_vec(p, l, tok, MODE == 1 ? 2 : 5);
    float y[16];
    float ss = 0.f;
#pragma unroll
    for (int i = 0; i < 4; ++i) {
      const u32x2 u = *(const u32x2*)(yr + lane * 4 + 256 * i);
      y[4 * i] = bflo(u[0]); y[4 * i + 1] = bfhi(u[0]); y[4 * i + 2] = bflo(u[1]); y[4 * i + 3] = bfhi(u[1]);
#pragma unroll
      for (int e = 0; e < 4; ++e) ss += y[4 * i + e] * y[4 * i + e];
    }
    ss = wave_sum(ss);
    const float rstd = rsqrtf(ss * (1.f / DM) + EPSF);
#pragma unroll
    for (int i = 0; i < 4; ++i) {
      f32x4 v = *(const f32x4*)(xr + lane * 4 + 256 * i);
      const f32x4 g = *(const f32x4*)(gpost + lane * 4 + 256 * i);
      const f32x4 m = *(const f32x4*)(mg + lane * 4 + 256 * i);
#pragma unroll
      for (int e = 0; e < 4; ++e) { v[e] += m[e] * (y[4 * i + e] * rstd * g[e]); x[4 * i + e] = v[e]; }
      *(f32x4*)(xr + lane * 4 + 256 * i) = v;
    }
  }
  if (MODE == 2 && l == NL - 1) return;
  const int ln = (MODE == 2) ? l + 1 : l;
  const float* gpre = p.in[MODE == 1 ? I_NFPRE : I_NMPRE] + ln * DM;
  const float* sh = mod_vec(p, ln, tok, MODE == 1 ? 3 : 0);
  const float* scv = mod_vec(p, ln, tok, MODE == 1 ? 4 : 1);
  float ss = 0.f;
#pragma unroll
  for (int i = 0; i < 16; ++i) ss += x[i] * x[i];
  ss = wave_sum(ss);
  const float rstd = rsqrtf(ss * (1.f / DM) + EPSF);
  bf16* hr = (bf16*)(p.ws + OFF_H) + (size_t)tok * DM;
#pragma unroll
  for (int i = 0; i < 4; ++i) {
    const f32x4 g = *(const f32x4*)(gpre + lane * 4 + 256 * i);
    const f32x4 s1 = *(const f32x4*)(sh + lane * 4 + 256 * i);
    const f32x4 s2 = *(const f32x4*)(scv + lane * 4 + 256 * i);
    float o[4];
#pragma unroll
    for (int e = 0; e < 4; ++e) o[e] = (x[4 * i + e] * rstd * g[e]) * (1.f + s2[e]) + s1[e];
    u32x2 u;
    u[0] = pack2(o[0], o[1]); u[1] = pack2(o[2], o[3]);
    *(u32x2*)(hr + lane * 4 + 256 * i) = u;
  }
}

template <int MODE>
DI void row_phase(const Params& p, int l, int bid, int G) {
  const int lane = TIDX & 63;
  const int wg = bid * 4 + (TIDX >> 6), nw = G * 4;
  const int R = (NTOK + nw - 1) / nw;
  const int t0 = wg * R, t1 = min(NTOK, t0 + R);
  if (t0 >= t1) return;
  const bool has_next = !(MODE == 2 && l == NL - 1);
  const int ln = (MODE == 2) ? l + 1 : l;
  f32x4 gpost[4], gpre[4], mg[4], sh[4], scl[4];
#pragma unroll
  for (int i = 0; i < 4; ++i) {
    if (MODE != 0) gpost[i] = *(const f32x4*)(p.in[MODE == 1 ? I_NMPOST : I_NFPOST] + l * DM + lane * 4 + 256 * i);
    if (has_next) gpre[i] = *(const f32x4*)(p.in[MODE == 1 ? I_NFPRE : I_NMPRE] + ln * DM + lane * 4 + 256 * i);
  }
  int cur_m = -1;
  u32x2 yb[4], yn[4];
  f32x4 xb[4], xn[4];
  const bf16* Hb = (const bf16*)(p.ws + OFF_H);
#define ROW_LOAD(TOK, YY, XX)                                                                              \
  {                                                                                                        \
    const int b_ = (TOK) / TT, t_ = (TOK) - b_ * TT;                                                       \
    const float* src_ = (MODE == 0) ? ((t_ < CTXL) ? p.in[I_CTX] + ((size_t)b_ * CTXL + t_) * DM           \
                                                   : p.in[I_X] + ((size_t)b_ * SEQ + (t_ - CTXL)) * DM)    \
                                    : resid_row(p, (TOK));                                                 \
    _Pragma("unroll") for (int i = 0; i < 4; ++i) {                                                        \
      XX[i] = *(const f32x4*)(src_ + lane * 4 + 256 * i);                                                  \
      if (MODE != 0) YY[i] = *(const u32x2*)(Hb + (size_t)(TOK) * DM + lane * 4 + 256 * i);                \
    }                                                                                                      \
  }
  ROW_LOAD(t0, yb, xb)
  for (int tok = t0; tok < t1; ++tok) {
    if (tok + 1 < t1) ROW_LOAD(tok + 1, yn, xn)
    const int b = tok / TT, t = tok - b * TT;
    const int m = (t < CTXL) ? 4 : b;
    if (m != cur_m) {
      cur_m = m;
      const float* Mv = (const float*)(p.ws + OFF_MOD);
#pragma unroll
      for (int i = 0; i < 4; ++i) {
        if (MODE != 0) mg[i] = *(const f32x4*)(Mv + ((size_t)(l * 5 + m) * 6 + (MODE == 1 ? 2 : 5)) * DM + lane * 4 + 256 * i);
        if (has_next) {
          sh[i] = *(const f32x4*)(Mv + ((size_t)(ln * 5 + m) * 6 + (MODE == 1 ? 3 : 0)) * DM + lane * 4 + 256 * i);
          scl[i] = *(const f32x4*)(Mv + ((size_t)(ln * 5 + m) * 6 + (MODE == 1 ? 4 : 1)) * DM + lane * 4 + 256 * i);
        }
      }
    }
    float* xr = resid_row(p, tok);
    f32x4 x[4];
    if (MODE == 0) {
#pragma unroll
      for (int i = 0; i < 4; ++i) { x[i] = xb[i]; *(f32x4*)(xr + lane * 4 + 256 * i) = x[i]; }
    } else {
      float y[16];
      float ss = 0.f;
#pragma unroll
      for (int i = 0; i < 4; ++i) {
        y[4 * i] = bflo(yb[i][0]); y[4 * i + 1] = bfhi(yb[i][0]); y[4 * i + 2] = bflo(yb[i][1]); y[4 * i + 3] = bfhi(yb[i][1]);
#pragma unroll
        for (int e = 0; e < 4; ++e) ss += y[4 * i + e] * y[4 * i + e];
      }
      ss = wave_sum(ss);
      const float rstd = rsqrtf(ss * (1.f / DM) + EPSF);
#pragma unroll
      for (int i = 0; i < 4; ++i) {
        f32x4 v = xb[i];
#pragma unroll
        for (int e = 0; e < 4; ++e) v[e] += mg[i][e] * (y[4 * i + e] * rstd * gpost[i][e]);
        x[i] = v;
        *(f32x4*)(xr + lane * 4 + 256 * i) = v;
      }
    }
    if (has_next) {
      float ss = 0.f;
#pragma unroll
      for (int i = 0; i < 4; ++i)
#pragma unroll
        for (int e = 0; e < 4; ++e) ss += x[i][e] * x[i][e];
      ss = wave_sum(ss);
      const float rstd = rsqrtf(ss * (1.f / DM) + EPSF);
      bf16* hr = (bf16*)(p.ws + OFF_H) + (size_t)tok * DM;
#pragma unroll
      for (int i = 0; i < 4; ++i) {
        float o[4];
#pragma unroll
        for (int e = 0; e < 4; ++e) o[e] = (x[i][e] * rstd * gpre[i][e]) * (1.f + scl[i][e]) + sh[i][e];
        u32x2 u;
        u[0] = pack2(o[0], o[1]); u[1] = pack2(o[2], o[3]);
        *(u32x2*)(hr + lane * 4 + 256 * i) = u;
      }
    }
#pragma unroll
    for (int i = 0; i < 4; ++i) { yb[i] = yn[i]; xb[i] = xn[i]; }
  }
#undef ROW_LOAD
}

DI void ktab_phase(const Params& p, int bid, int G, int l_lo, int l_hi) {
  const float* BBR = (const float*)(p.ws + OFF_BBR);
  const float* BBI = (const float*)(p.ws + OFF_BBI);
  const float2* PW = (const float2*)(p.ws + OFF_PWR);
  float* KT = (float*)(p.ws + OFF_KTAB);
  const int per_layer = 16 * 2 * 32 * 256;
  for (int idx = l_lo * per_layer + bid * 256 + TIDX; idx < l_hi * per_layer; idx += G * 256) {
    const int hp = idx & 15, hh = (idx >> 4) & 15, tau = (idx >> 8) & 31, d = (idx >> 13) & 1, g = (idx >> 14) & 15, l = idx >> 18;
    const int ldg = (l * 2 + d) * 16 + g;
    const float* cre = p.in[I_CRE] + ((size_t)ldg * 16 + hh) * 64;
    const float* cim = p.in[I_CIM] + ((size_t)ldg * 16 + hh) * 64;
    float acc = 0.f;
    for (int pp = 0; pp < 64; ++pp) {
      const float2 pw = PW[((size_t)ldg * 33 + tau) * 64 + pp];
      const float br = BBR[((size_t)ldg * 64 + pp) * 16 + hp], bi = BBI[((size_t)ldg * 64 + pp) * 16 + hp];
      const float zr = pw.x * br - pw.y * bi, zi = pw.x * bi + pw.y * br;
      acc += cre[pp] * zr - cim[pp] * zi;
    }
    KT[idx] = acc;
  }
}

DI void s5mat_phase(const Params& p, int l, int bid, int G) {
  const float* BBR = (const float*)(p.ws + OFF_BBR);
  const float* BBI = (const float*)(p.ws + OFF_BBI);
  const float2* PW = (const float2*)(p.ws + OFF_PWR);
  const float* KT = (const float*)(p.ws + OFF_KTAB);
  bf16* T5 = (bf16*)(p.ws + OFF_T5);
  bf16* E5 = (bf16*)(p.ws + OFF_E5);
  bf16* F5 = (bf16*)(p.ws + OFF_F5);
  const int nT = 16 * 512 * 64, nE = 16 * 512 * 32, nF = 16 * 256 * 64;
  for (int it = bid * 256 + TIDX; it < nT + nE + nF; it += G * 256) {
    float v[8];
    bf16* dst;
    if (it < nT) {
      const int k8 = it & 63, n = (it >> 6) & 511, g = it >> 15;
      const int i = n >> 4, hh = n & 15, j = k8 >> 1, hp0 = (k8 & 1) * 8;
#pragma unroll
      for (int e = 0; e < 8; ++e) {
        const int hp = hp0 + e;
        float a = 0.f;
        if (j <= i) a += KT[((((size_t)l * 16 + g) * 2 + 0) * 32 + (i - j)) * 256 + hh * 16 + hp];
        if (j >= i) a += KT[((((size_t)l * 16 + g) * 2 + 1) * 32 + (j - i)) * 256 + hh * 16 + hp];
        if (i == j && hh == hp) a += p.in[I_S5D][l * 256 + g * 16 + hh];
        v[e] = a;
      }
      dst = T5 + ((size_t)g * 512 + n) * 512 + k8 * 8;
    } else if (it < nT + nE) {
      const int q = it - nT;
      const int k8 = q & 31, n = (q >> 5) & 511, g = q >> 14;
      const int i = n >> 4, hh = n & 15;
      const int k0 = k8 * 8, d = k0 >> 7, ri = (k0 >> 6) & 1, p0 = k0 & 63;
      const int ldg = (l * 2 + d) * 16 + g;
      const int ex = d ? (32 - i) : (i + 1);
#pragma unroll
      for (int e = 0; e < 8; ++e) {
        const int pp = p0 + e;
        const float2 pw = PW[((size_t)ldg * 33 + ex) * 64 + pp];
        const float cr = p.in[I_CRE][((size_t)ldg * 16 + hh) * 64 + pp], ci = p.in[I_CIM][((size_t)ldg * 16 + hh) * 64 + pp];
        const float zr = cr * pw.x - ci * pw.y, zi = cr * pw.y + ci * pw.x;
        v[e] = ri ? -zi : zr;
      }
      dst = E5 + ((size_t)g * 512 + n) * 256 + k0;
    } else {
      const int q = it - nT - nE;
      const int k8 = q & 63, n = (q >> 6) & 255, g = q >> 14;
      const int d = n >> 7, ri = (n >> 6) & 1, pp = n & 63;
      const int j = k8 >> 1, hp0 = (k8 & 1) * 8;
      const int ldg = (l * 2 + d) * 16 + g;
      const int ex = d ? j : (31 - j);
      const float2 pw = PW[((size_t)ldg * 33 + ex) * 64 + pp];
#pragma unroll
      for (int e = 0; e < 8; ++e) {
        const float br = BBR[((size_t)ldg * 64 + pp) * 16 + hp0 + e], bi = BBI[((size_t)ldg * 64 + pp) * 16 + hp0 + e];
        v[e] = ri ? (pw.x * bi + pw.y * br) : (pw.x * br - pw.y * bi);
      }
      dst = F5 + ((size_t)g * 256 + n) * 512 + k8 * 8;
    }
    u32x4 u;
    u[0] = pack2(v[0], v[1]); u[1] = pack2(v[2], v[3]); u[2] = pack2(v[4], v[5]); u[3] = pack2(v[6], v[7]);
    *(u32x4*)dst = u;
  }
}

DI void proj_epi(const Params& p, int l, int mt, int nt, char* smem);
DI void proj_wide(const Params& p, int l, int mt, int np, char* smem) {
  const bf16* H = (const bf16*)(p.ws + OFF_H) + (size_t)mt * 128 * DM;
  const bf16* W = wl(p, l, WL_WIN) + (size_t)np * 256 * DM;
  if (np == 9) {
    f32x16 acc1[2][2];
    acc_zero(acc1);
    gemm_main_dma(acc1, [&](int r) { return H + (size_t)r * DM; }, [&](int r) { return W + (size_t)r * DM; }, DM, smem);
    acc_to_lds(acc1, (float*)smem);
    __syncthreads();
    proj_epi(p, l, mt, 18, smem);
    return;
  }
  f32x16 acc[2][4];
  accw_zero(acc);
  gemm_wide(acc, [&](int r) { return H + (size_t)r * DM; }, [&](int r) { return W + (size_t)r * DM; }, DM, smem);
  float* Cs = (float*)smem;
  accw_to_lds<0>(acc, Cs);
  __syncthreads();
  proj_epi(p, l, mt, np * 2, smem);
  if (np * 2 + 1 < 19) {
    accw_to_lds<1>(acc, Cs);
    __syncthreads();
    proj_epi(p, l, mt, np * 2 + 1, smem);
  }
}
DI void proj_epi(const Params& p, int l, int mt, int nt, char* smem) {
  float* Cs = (float*)smem;
  const int tid = TIDX;
  const int tok0 = mt * 128;
  const int b = tok0 / TT, t0 = tok0 - b * TT;
  if (nt <= 2) {
    const int row = tid >> 1, seg = tid & 1;
    float* c = Cs + row * CLD + seg * 64;
    const float* gn = p.in[nt < 2 ? I_QN : I_KN] + l * 64;
    float ss = 0.f;
#pragma unroll 8
    for (int i = 0; i < 64; ++i) ss += c[i] * c[i];
    const float rstd = rsqrtf(ss * (1.f / 64.f) + EPSF);
    const int t = t0 + row;
    const bool lat = t >= CTXL;
    const int s = t - CTXL;
#pragma unroll 1
    for (int ax = 0; ax < 2; ++ax) {
      const float pos = (float)(ax ? (s & 63) : (s >> 6));
#pragma unroll 2
      for (int f = 0; f < 16; ++f) {
        float x1 = c[ax * 32 + f] * rstd * gn[ax * 32 + f];
        float x2 = c[ax * 32 + 16 + f] * rstd * gn[ax * 32 + 16 + f];
        if (lat) {
          const float invf = exp2f(-(float)f * (13.287712379549449f / 16.f));
          float sn, cs;
          sincos_cw(pos * invf, sn, cs);
          const float y1 = x1 * cs - x2 * sn, y2 = x2 * cs + x1 * sn;
          x1 = y1; x2 = y2;
        }
        c[ax * 32 + f] = x1;
        c[ax * 32 + 16 + f] = x2;
      }
    }
    __syncthreads();
    if (nt < 2) store_tile_bf16(Cs, (bf16*)(p.ws + OFF_Q) + (size_t)tok0 * 256 + nt * 128, 256, 128, 0.125f * 1.4426950408889634f);
    else store_tile_bf16(Cs, (bf16*)(p.ws + OFF_K) + (size_t)tok0 * 128, 128, 128, 1.f);
  } else if (nt == 3 || (nt >= 8 && nt <= 11)) {
    for (int c = tid; c < 2048; c += 256) {
      const int col = c & 127, rc = (c >> 7) * 8;
      u32x4 u;
#pragma unroll
      for (int e = 0; e < 4; ++e) u[e] = pack2(Cs[(rc + 2 * e) * CLD + col], Cs[(rc + 2 * e + 1) * CLD + col]);
      bf16* dst;
      if (nt == 3) dst = (bf16*)(p.ws + OFF_VT) + ((size_t)(b * 2 + (col >> 6)) * 64 + (col & 63)) * TT + t0 + rc;
      else dst = (bf16*)(p.ws + OFF_GVT) + ((size_t)(b * 4 + (nt - 8)) * 128 + col) * TT + t0 + rc;
      *(u32x4*)dst = u;
    }
  } else if (nt == 4 || nt == 5) {
    store_tile_bf16(Cs, (bf16*)(p.ws + OFF_GQ) + (size_t)tok0 * 256 + (nt - 4) * 128, 256, 128, 0.125f);
  } else if (nt == 6 || nt == 7) {
    store_tile_bf16(Cs, (bf16*)(p.ws + OFF_GK) + (size_t)tok0 * 256 + (nt - 6) * 128, 256, 128, 1.f);
  } else if (nt >= 12 && nt <= 15) {
    store_tile_bf16(Cs, (bf16*)(p.ws + OFF_GR) + (size_t)tok0 * 512 + (nt - 12) * 128, 512, 128, 1.f);
  } else if (nt == 16 || nt == 17) {
    for (int c = tid; c < 2048; c += 256) {
      const int row = c >> 4, c8 = c & 15;
      const float* s = Cs + row * CLD + c8 * 8;
      u32x4 u;
#pragma unroll
      for (int e = 0; e < 4; ++e) u[e] = pack2(s[2 * e], s[2 * e + 1]);
      const int ch = (nt - 16) * 128 + c8 * 8;
      bf16* dst = (bf16*)(p.ws + OFF_SU) + ((size_t)(b * 16 + (ch >> 4)) * TT + t0 + row) * 16 + (ch & 15);
      *(u32x4*)dst = u;
    }
  } else {
    for (int c = tid; c < 128 * 8; c += 256) {
      const int row = c >> 3, c4 = (c & 7) * 4;
      const float* s = Cs + row * CLD + c4;
      f32x4 v = {s[0], s[1], s[2], s[3]};
      *(f32x4*)((float*)(p.ws + OFF_LOW) + (size_t)(tok0 + row) * 32 + c4) = v;
    }
  }
  __syncthreads();
}

DI void attn_unit(const Params& p, int u, char* smem) {
  int b, head, tok0, nkt;
  if (u < 1024) { b = u >> 8; head = (u >> 6) & 3; tok0 = b * TT + CTXL + (u & 63) * 128; nkt = TT / 128; }
  else { const int v = u - 1024; b = v >> 3; head = (v >> 1) & 3; tok0 = b * TT + (v & 1) * 128; nkt = CTXL / 128; }
  const int kvh = head >> 1;
  const int tid = TIDX, lane = tid & 63, w = tid >> 6, r = lane & 31, h = lane >> 5;
  const bf16* Qp = (const bf16*)(p.ws + OFF_Q) + (size_t)(tok0 + w * 32 + r) * 256 + head * 64 + h * 8;
  s16x8 qf[4];
#pragma unroll
  for (int s = 0; s < 4; ++s) qf[s] = __builtin_bit_cast(s16x8, ldg16(Qp + s * 16));
  const bf16* kp[2];
  const bf16* vp[2];
#pragma unroll
  for (int i = 0; i < 2; ++i) {
    const int row = w * 16 + i * 8 + (lane >> 3);
    const int c = (lane & 7) ^ ((row >> 1) & 7);
    kp[i] = (const bf16*)(p.ws + OFF_K) + ((size_t)b * TT + row) * 128 + kvh * 64 + c * 8;
    vp[i] = (const bf16*)(p.ws + OFF_VT) + ((size_t)(b * 2 + kvh) * 64 + row) * TT + c * 8;
  }
  const int ldst = (w * 128 + lane) * 16;
#define AT_DMA(BUF, T)                                                                                              \
  {                                                                                                                 \
    char* sb_ = smem + (BUF) * 32768;                                                                               \
    _Pragma("unroll") for (int hh = 0; hh < 2; ++hh)                                                                \
    _Pragma("unroll") for (int i = 0; i < 2; ++i) {                                                                 \
      __builtin_amdgcn_global_load_lds((const unsigned*)(kp[i] + (size_t)((T) * 128 + hh * 64) * 128), (unsigned*)(sb_ + hh * 8192 + ldst + i * 1024), 16, 0, 0); \
      __builtin_amdgcn_global_load_lds((const unsigned*)(vp[i] + (T) * 128 + hh * 64), (unsigned*)(sb_ + 16384 + hh * 8192 + ldst + i * 1024), 16, 0, 0);        \
    }                                                                                                               \
  }
  const int xr = (r >> 1) & 7;
  AT_DMA(0, 0)
  asm volatile("s_waitcnt vmcnt(0)" ::: "memory");
  __syncthreads();
  f32x16 oacc[2];
#pragma unroll
  for (int i = 0; i < 16; ++i) { oacc[0][i] = 0.f; oacc[1][i] = 0.f; }
  float mrow = -INFINITY, lrow = 0.f;
  for (int kt = 0; kt < nkt; ++kt) {
    const int buf = kt & 1;
    if (kt + 1 < nkt) AT_DMA(buf ^ 1, kt + 1)
    const char* Kb = smem + buf * 32768;
    const char* Vb = Kb + 16384;
    f32x16 sacc[4];
#pragma unroll
    for (int q = 0; q < 4; ++q)
#pragma unroll
      for (int i = 0; i < 16; ++i) sacc[q][i] = 0.f;
#pragma unroll
    for (int s = 0; s < 4; ++s) {
      const int co = ((2 * s + h) ^ xr) * 16;
#pragma unroll
      for (int q = 0; q < 4; ++q) {
        const s16x8 a = *(const s16x8*)(Kb + (q >> 1) * 8192 + ((q & 1) * 32 + r) * 128 + co);
        sacc[q] = MFMA32(a, qf[s], sacc[q]);
      }
    }
    float mx = sacc[0][0];
#pragma unroll
    for (int q = 0; q < 4; ++q)
#pragma unroll
      for (int i = 0; i < 16; ++i) mx = fmaxf(mx, sacc[q][i]);
    mx = fmaxf(mx, __shfl_xor(mx, 32, 64));
    const float mnew = fmaxf(mrow, mx);
    const float alpha = __builtin_amdgcn_exp2f(mrow - mnew);
    mrow = mnew;
    float psum = 0.f;
#pragma unroll
    for (int q = 0; q < 4; ++q)
#pragma unroll
      for (int i = 0; i < 16; ++i) { sacc[q][i] = __builtin_amdgcn_exp2f(sacc[q][i] - mnew); psum += sacc[q][i]; }
    lrow = lrow * alpha + psum;
#pragma unroll
    for (int i = 0; i < 16; ++i) { oacc[0][i] *= alpha; oacc[1][i] *= alpha; }
#pragma unroll
    for (int q = 0; q < 4; ++q)
#pragma unroll
      for (int s2 = 0; s2 < 2; ++s2) {
        u32x4 pu;
#pragma unroll
        for (int e = 0; e < 4; ++e) pu[e] = pack2(sacc[q][8 * s2 + 2 * e], sacc[q][8 * s2 + 2 * e + 1]);
        const s16x8 pf = __builtin_bit_cast(s16x8, pu);
        const int c0 = (q & 1) * 4 + 2 * s2;
        const int o0 = ((c0 ^ xr) * 16) + 8 * h, o1 = (((c0 + 1) ^ xr) * 16) + 8 * h;
#pragma unroll
        for (int dt = 0; dt < 2; ++dt) {
          const s16x4 lo = *(const s16x4*)(Vb + (q >> 1) * 8192 + (dt * 32 + r) * 128 + o0);
          const s16x4 hi = *(const s16x4*)(Vb + (q >> 1) * 8192 + (dt * 32 + r) * 128 + o1);
          const s16x8 a = __builtin_shufflevector(lo, hi, 0, 1, 2, 3, 4, 5, 6, 7);
          oacc[dt] = MFMA32(a, pf, oacc[dt]);
        }
      }
    asm volatile("s_waitcnt vmcnt(0)" ::: "memory");
    __syncthreads();
  }
#undef AT_DMA
  const float ltot = lrow + __shfl_xor(lrow, 32, 64);
  const float inv = 1.f / ltot;
  bf16* Op = (bf16*)(p.ws + OFF_OATT) + (size_t)(tok0 + w * 32 + r) * 256 + head * 64;
#pragma unroll
  for (int dt = 0; dt < 2; ++dt)
#pragma unroll
    for (int i = 0; i < 16; i += 4) {
      u32x2 uu;
      uu[0] = pack2(oacc[dt][i] * inv, oacc[dt][i + 1] * inv);
      uu[1] = pack2(oacc[dt][i + 2] * inv, oacc[dt][i + 3] * inv);
      *(u32x2*)(Op + dt * 32 + crow(i, h)) = uu;
    }
}

constexpr int GL_LOW = 0, GL_TOT = 4096, GL_DEC = 5120, GL_QIN = 5376, GL_KIN = 14592, GL_KET = 23808, GL_OST = 0,
              GL_VT = 33792, GL_ST = 52224;
static_assert(GL_ST + 128 * LDT * 2 <= SMEM_BYTES, "gla lds");

template <bool WITH_OUT>
DI void gla_unit(const Params& p, int l, int u, char* smem) {
  float* lowt = (float*)(smem + GL_LOW);
  float* tots = (float*)(smem + GL_TOT);
  float* decs = (float*)(smem + GL_DEC);
  bf16* qin = (bf16*)(smem + GL_QIN);
  bf16* kin = (bf16*)(smem + GL_KIN);
  bf16* ket = (bf16*)(smem + GL_KET);
  float* ost = (float*)(smem + GL_OST);
  bf16* vts = (bf16*)(smem + GL_VT);
  bf16* sts = (bf16*)(smem + GL_ST);
  const int tid = TIDX, lane = tid & 63, w = tid >> 6, r = lane & 31, h = lane >> 5;
  int b, hd, gi, dir0, ndir;
  if (WITH_OUT) { gi = u % NG33; hd = (u / NG33) & 3; b = u / (NG33 * 4); dir0 = 1; ndir = 2; }
  else { gi = u % NG33; const int v = u / NG33; dir0 = v & 1; hd = (v >> 1) & 3; b = v >> 3; ndir = 1; }
  const int dk = tid & 63, part = tid >> 6;
  const bf16* GQ = (const bf16*)(p.ws + OFF_GQ);
  const bf16* GK = (const bf16*)(p.ws + OFF_GK);
  const bf16* GVT = (const bf16*)(p.ws + OFF_GVT) + (size_t)(b * 4 + hd) * 128 * TT;
  const float* LOW = (const float*)(p.ws + OFF_LOW);
  for (int dd = 0; dd < ndir; ++dd) {
    const int dir = WITH_OUT ? (dir0 - dd) : dir0;
    float* GSu = (float*)(p.ws + OFF_GS) + ((size_t)((b * 4 + hd) * 2 + dir) * NG33 + gi) * 8192;
    float gwreg[16];
#pragma unroll
    for (int rr = 0; rr < 16; ++rr) gwreg[rr] = p.in[I_GGW][((size_t)(l * 2 + dir) * 16 + rr) * 256 + hd * 64 + dk];
    const float gb = p.in[I_GGB][(l * 2 + dir) * 256 + hd * 64 + dk];
    f32x16 sacc[2];
    if (WITH_OUT) {
#pragma unroll
      for (int dkt = 0; dkt < 2; ++dkt)
#pragma unroll
        for (int i = 0; i < 16; ++i) {
          const float v = GSu[(w * 32 + crow(i, h)) * 64 + dkt * 32 + r];
          sacc[dkt][i] = v;
          sts[(w * 32 + crow(i, h)) * LDT + dkt * 32 + r] = f2bf(v);
        }
    } else {
#pragma unroll
      for (int i = 0; i < 16; ++i) { sacc[0][i] = 0.f; sacc[1][i] = 0.f; }
    }
    float gtot = 0.f;
    for (int cc = 0; cc < 4; ++cc) {
      const int ci = dir ? 3 - cc : cc;
      const int tb = gi * 256 + ci * 64;
      const size_t tokb = (size_t)b * TT + tb;
      {
        const int row = tid >> 2, c4 = (tid & 3) * 4;
        const u32x4 lw = ldg16(LOW + (tokb + row) * 32 + dir * 16 + c4);
        u32x4 vv[4], kq[2], qq[2];
#pragma unroll
        for (int i = 0; i < 4; ++i) {
          const int c = tid + 256 * i, e = c >> 3, k8 = (c & 7) * 8;
          vv[i] = ldg16(GVT + (size_t)e * TT + tb + k8);
        }
#pragma unroll
        for (int i = 0; i < 2; ++i) {
          const int c = tid + 256 * i, rw = c >> 3, k8 = (c & 7) * 8;
          kq[i] = ldg16(GK + (tokb + rw) * 256 + hd * 64 + k8);
          if (WITH_OUT) qq[i] = ldg16(GQ + (tokb + rw) * 256 + hd * 64 + k8);
        }
        *(u32x4*)(lowt + row * 16 + c4) = lw;
#pragma unroll
        for (int i = 0; i < 4; ++i) {
          const int c = tid + 256 * i, e = c >> 3, k8 = (c & 7) * 8;
          *(u32x4*)(vts + e * LDT + k8) = vv[i];
        }
#pragma unroll
        for (int i = 0; i < 2; ++i) {
          const int c = tid + 256 * i, rw = c >> 3, k8 = (c & 7) * 8;
          *(u32x4*)(kin + rw * LDT + k8) = kq[i];
          if (WITH_OUT) *(u32x4*)(qin + rw * LDT + k8) = qq[i];
        }
      }
      __syncthreads();
      float cum = 0.f;
#pragma unroll 2
      for (int ii = 0; ii < 16; ++ii) {
        const int pos = part * 16 + ii, t = dir ? 63 - pos : pos;
        float z = gb;
#pragma unroll
        for (int rr = 0; rr < 16; ++rr) z += lowt[t * 16 + rr] * gwreg[rr];
        cum += (fminf(z, 0.f) - log1pf(__expf(-fabsf(z)))) * (1.f / 16.f);
      }
      tots[part * 64 + dk] = cum;
      __syncthreads();
      float offs = 0.f, total = 0.f;
#pragma unroll
      for (int pp = 0; pp < 4; ++pp) { const float tv = tots[pp * 64 + dk]; total += tv; if (pp < part) offs += tv; }
      if (part == 0) decs[dk] = __expf(total);
      gtot += total;
      float bq = offs;
#pragma unroll 2
      for (int ii = 0; ii < 16; ++ii) {
        const int pos = part * 16 + ii, t = dir ? 63 - pos : pos;
        float z = gb;
#pragma unroll
        for (int rr = 0; rr < 16; ++rr) z += lowt[t * 16 + rr] * gwreg[rr];
        bq += (fminf(z, 0.f) - log1pf(__expf(-fabsf(z)))) * (1.f / 16.f);
        const float kv = bf2f(kin[t * LDT + dk]);
        ket[dk * LDT + t] = f2bf(kv * __expf(total - bq));
        if (WITH_OUT) {
          const float qv = bf2f(qin[t * LDT + dk]);
          qin[t * LDT + dk] = f2bf(qv * __expf(bq));
          kin[t * LDT + dk] = f2bf(kv * __expf(-bq));
        }
      }
      __syncthreads();
      f32x16 oo[2];
      const int it = w & 1, ep = w >> 1;
      if (WITH_OUT) {
        const int ti = w >> 1, tj = w & 1;
        f32x16 aa;
#pragma unroll
        for (int i = 0; i < 16; ++i) aa[i] = 0.f;
#pragma unroll
        for (int s = 0; s < 4; ++s) {
          const s16x8 A = *(const s16x8*)(qin + (ti * 32 + r) * LDT + s * 16 + h * 8);
          const s16x8 Bv = *(const s16x8*)(kin + (tj * 32 + r) * LDT + s * 16 + h * 8);
          aa = MFMA32(A, Bv, aa);
        }
        __syncthreads();
#pragma unroll
        for (int i = 0; i < 16; ++i) {
          const int qi = ti * 32 + crow(i, h), kj = tj * 32 + r;
          const bool keep = dir ? (kj >= qi) : (kj <= qi);
          kin[qi * LDT + kj] = f2bf(keep ? aa[i] : 0.f);
        }
        __syncthreads();
#pragma unroll
        for (int i = 0; i < 16; ++i) { oo[0][i] = 0.f; oo[1][i] = 0.f; }
#pragma unroll
        for (int s = 0; s < 4; ++s) {
          const s16x8 A1 = *(const s16x8*)(kin + (it * 32 + r) * LDT + s * 16 + h * 8);
          const s16x8 A2 = *(const s16x8*)(qin + (it * 32 + r) * LDT + s * 16 + h * 8);
#pragma unroll
          for (int x = 0; x < 2; ++x) {
            const int et = 2 * ep + x;
            const s16x8 B1 = *(const s16x8*)(vts + (et * 32 + r) * LDT + s * 16 + h * 8);
            const s16x8 B2 = *(const s16x8*)(sts + (et * 32 + r) * LDT + s * 16 + h * 8);
            oo[x] = MFMA32(A1, B1, oo[x]);
            oo[x] = MFMA32(A2, B2, oo[x]);
          }
        }
      }
#pragma unroll
      for (int dkt = 0; dkt < 2; ++dkt) {
        const float dv = decs[dkt * 32 + r];
#pragma unroll
        for (int i = 0; i < 16; ++i) sacc[dkt][i] *= dv;
      }
#pragma unroll
      for (int s = 0; s < 4; ++s) {
        const s16x8 A = *(const s16x8*)(vts + (w * 32 + r) * LDT + s * 16 + h * 8);
#pragma unroll
        for (int dkt = 0; dkt < 2; ++dkt) {
          const s16x8 Bv = *(const s16x8*)(ket + (dkt * 32 + r) * LDT + s * 16 + h * 8);
          sacc[dkt] = MFMA32(A, Bv, sacc[dkt]);
        }
      }
      __syncthreads();
      if (WITH_OUT) {
#pragma unroll
        for (int dkt = 0; dkt < 2; ++dkt)
#pragma unroll
          for (int i = 0; i < 16; ++i) sts[(w * 32 + crow(i, h)) * LDT + dkt * 32 + r] = f2bf(sacc[dkt][i]);
#pragma unroll
        for (int x = 0; x < 2; ++x)
#pragma unroll
          for (int i = 0; i < 16; ++i) ost[(it * 32 + crow(i, h)) * CLD + (2 * ep + x) * 32 + r] = oo[x][i];
        __syncthreads();
        const int row = tid >> 2, qd = tid & 3;
        const size_t tok = tokb + row;
        bf16* og = (bf16*)(p.ws + OFF_OGLA) + tok * 512 + hd * 128 + qd * 32;
        const float* os = ost + row * CLD + qd * 32;
        if (dir == 1) {
#pragma unroll
          for (int i = 0; i < 4; ++i) {
            u32x4 uu;
#pragma unroll
            for (int e = 0; e < 4; ++e) uu[e] = pack2(os[i * 8 + 2 * e], os[i * 8 + 2 * e + 1]);
            *(u32x4*)(og + i * 8) = uu;
          }
        } else {
          float ss = 0.f;
#pragma unroll 1
          for (int i = 0; i < 4; ++i) {
            const u32x4 uu = *(const u32x4*)(og + i * 8);
#pragma unroll
            for (int e = 0; e < 4; ++e) {
              const float a0 = os[i * 8 + 2 * e] + bflo(uu[e]), a1 = os[i * 8 + 2 * e + 1] + bfhi(uu[e]);
              ss += a0 * a0 + a1 * a1;
            }
          }
          ss += __shfl_xor(ss, 1, 64);
          ss += __shfl_xor(ss, 2, 64);
          const float rstd = rsqrtf(ss * (1.f / 128.f) + EPSF);
          const float* gn = p.in[I_GON] + l * 128 + qd * 32;
          const bf16* gr = (const bf16*)(p.ws + OFF_GR) + tok * 512 + hd * 128 + qd * 32;
#pragma unroll 1
          for (int i = 0; i < 4; ++i) {
            const u32x4 uo = *(const u32x4*)(og + i * 8);
            const u32x4 ug = *(const u32x4*)(gr + i * 8);
            u32x4 uu;
#pragma unroll
            for (int e = 0; e < 4; ++e) {
              const float v0 = os[i * 8 + 2 * e] + bflo(uo[e]), v1 = os[i * 8 + 2 * e + 1] + bfhi(uo[e]);
              const float a0 = v0 * rstd * gn[i * 8 + 2 * e] * siluf_(bflo(ug[e]));
              const float a1 = v1 * rstd * gn[i * 8 + 2 * e + 1] * siluf_(bfhi(ug[e]));
              uu[e] = pack2(a0, a1);
            }
            *(u32x4*)(og + i * 8) = uu;
          }
        }
        __syncthreads();
      }
    }
    if (!WITH_OUT) {
#pragma unroll
      for (int dkt = 0; dkt < 2; ++dkt)
#pragma unroll
        for (int i = 0; i < 16; ++i) GSu[(w * 32 + crow(i, h)) * 64 + dkt * 32 + r] = sacc[dkt][i];
      if (part == 0) ((float*)(p.ws + OFF_DECG))[((size_t)((b * 4 + hd) * 2 + dir) * NG33 + gi) * 64 + dk] = __expf(gtot);
    }
    __syncthreads();
  }
}

DI void gla_scan_job(const Params& p, int j) {
  const int idx = j * 256 + TIDX;
  const int seq = idx >> 13, el = idx & 8191, dk = el & 63, dir = seq & 1;
  float* GS = (float*)(p.ws + OFF_GS) + (size_t)seq * NG33 * 8192 + el;
  const float* DG = (const float*)(p.ws + OFF_DECG) + (size_t)seq * NG33 * 64 + dk;
  float s = 0.f;
  for (int st0 = 0; st0 < 33; st0 += 11) {
    float kv[11], dc[11];
#pragma unroll
    for (int q = 0; q < 11; ++q) {
      const int st = st0 + q;
      const int g = (dir == 0 || st == 0) ? st : 33 - st;
      kv[q] = GS[(size_t)g * 8192];
      dc[q] = DG[g * 64];
    }
#pragma unroll
    for (int q = 0; q < 11; ++q) {
      const int st = st0 + q;
      const int g = (dir == 0 || st == 0) ? st : 33 - st;
      GS[(size_t)g * 8192] = s;
      s = dc[q] * s + kv[q];
    }
  }
}

DI void s5_end_tile(const Params& p, int j, char* smem) {
  const int nt = j & 1, mt = (j >> 1) % 9, g = j / 18;
  const bf16* SU = (const bf16*)(p.ws + OFF_SU);
  const bf16* F = (const bf16*)(p.ws + OFF_F5) + ((size_t)g * 256 + nt * 128) * 512;
  f32x16 acc[2][2];
  acc_zero(acc);
  gemm_main_dma(acc,
            [&](int r) -> const bf16* {
              const int m = mt * 128 + r;
              if (m >= MS5) return (const bf16*)(p.ws + OFF_ZERO);
              const int b = m / NCH, ch = m - b * NCH;
              return SU + ((size_t)(b * 16 + g) * TT + ch * 32) * 16;
            },
            [&](int r) { return F + (size_t)r * 512; }, 512, smem);
  float* Cs = (float*)smem;
  acc_to_lds(acc, Cs);
  __syncthreads();
  float* EN = (float*)(p.ws + OFF_EN);
  for (int c = TIDX; c < 128 * 32; c += 256) {
    const int row = c >> 5, c4 = (c & 31) * 4, m = mt * 128 + row;
    if (m < MS5) {
      const float* s = Cs + row * CLD + c4;
      f32x4 v = {s[0], s[1], s[2], s[3]};
      *(f32x4*)(EN + ((size_t)m * 16 + g) * 256 + nt * 128 + c4) = v;
    }
  }
  __syncthreads();
}

DI void s5_scan_job(const Params& p, int l, int j, char* smem) {
  float2* ends = (float2*)smem;
  const int dir = j & 1, g = (j >> 1) & 15, b = j >> 5;
  const int pp = TIDX & 63, seg = TIDX >> 6;
  const float2 aL = ((const float2*)(p.ws + OFF_PWR))[((size_t)((l * 2 + dir) * 16 + g) * 33 + 32) * 64 + pp];
  const float* EN = (const float*)(p.ws + OFF_EN);
  bf16* SB = (bf16*)(p.ws + OFF_SB);
  float sr = 0.f, si = 0.f;
  for (int q0 = 0; q0 < 66; q0 += 11) {
    float er[11], ei[11];
#pragma unroll
    for (int q = 0; q < 11; ++q) {
      const int pos = seg * 66 + q0 + q;
      const int ch = dir ? (pos < 8 ? 7 - pos : 271 - pos) : pos;
      const float* e = EN + ((size_t)(b * NCH + ch) * 16 + g) * 256 + dir * 128 + pp;
      er[q] = e[0]; ei[q] = e[64];
    }
#pragma unroll
    for (int q = 0; q < 11; ++q) {
      const float nr = aL.x * sr - aL.y * si + er[q], ni = aL.x * si + aL.y * sr + ei[q];
      sr = nr; si = ni;
    }
  }
  ends[seg * 64 + pp] = make_float2(sr, si);
  float pr = 1.f, pi = 0.f;
  for (int q = 0; q < 66; ++q) { const float nr = pr * aL.x - pi * aL.y, ni = pr * aL.y + pi * aL.x; pr = nr; pi = ni; }
  __syncthreads();
  sr = 0.f; si = 0.f;
  for (int k = 0; k < seg; ++k) {
    const float2 e = ends[k * 64 + pp];
    const float nr = pr * sr - pi * si + e.x, ni = pr * si + pi * sr + e.y;
    sr = nr; si = ni;
  }
  for (int q0 = 0; q0 < 66; q0 += 11) {
    float er[11], ei[11];
#pragma unroll
    for (int q = 0; q < 11; ++q) {
      const int pos = seg * 66 + q0 + q;
      const int ch = dir ? (pos < 8 ? 7 - pos : 271 - pos) : pos;
      const float* e = EN + ((size_t)(b * NCH + ch) * 16 + g) * 256 + dir * 128 + pp;
      er[q] = e[0]; ei[q] = e[64];
    }
#pragma unroll
    for (int q = 0; q < 11; ++q) {
      const int pos = seg * 66 + q0 + q;
      const int ch = dir ? (pos < 8 ? 7 - pos : 271 - pos) : pos;
      bf16* sb = SB + ((size_t)(b * NCH + ch) * 16 + g) * 256 + dir * 128 + pp;
      sb[0] = f2bf(sr); sb[64] = f2bf(si);
      const float nr = aL.x * sr - aL.y * si + er[q], ni = aL.x * si + aL.y * sr + ei[q];
      sr = nr; si = ni;
    }
  }
  __syncthreads();
}

DI float gelu_tanh(float x) {
  const float u = 0.7978845608028654f * (x + 0.044715f * x * x * x);
  return 0.5f * x * (1.f + tanhf(u));
}

DI void s5_out_tile(const Params& p, int j, char* smem) {
  const int nt = j & 3, mt = (j >> 2) % 9, g = j / 36;
  const bf16* SU = (const bf16*)(p.ws + OFF_SU);
  const bf16* SB = (const bf16*)(p.ws + OFF_SB);
  const bf16* Tm = (const bf16*)(p.ws + OFF_T5) + ((size_t)g * 512 + nt * 128) * 512;
  const bf16* Em = (const bf16*)(p.ws + OFF_E5) + ((size_t)g * 512 + nt * 128) * 256;
  f32x16 acc[2][2];
  acc_zero(acc);
  gemm_main_dma(acc,
            [&](int r) -> const bf16* {
              const int m = mt * 128 + r;
              if (m >= MS5) return (const bf16*)(p.ws + OFF_ZERO);
              const int b = m / NCH, ch = m - b * NCH;
              return SU + ((size_t)(b * 16 + g) * TT + ch * 32) * 16;
            },
            [&](int r) { return Tm + (size_t)r * 512; }, 512, smem);
  gemm_main_dma(acc,
            [&](int r) -> const bf16* {
              const int m = mt * 128 + r;
              if (m >= MS5) return (const bf16*)(p.ws + OFF_ZERO);
              return SB + ((size_t)m * 16 + g) * 256;
            },
            [&](int r) { return Em + (size_t)r * 256; }, 256, smem);
  float* Cs = (float*)smem;
  acc_to_lds(acc, Cs);
  __syncthreads();
  bf16* Y5 = (bf16*)(p.ws + OFF_Y5);
  for (int c = TIDX; c < 2048; c += 256) {
    const int row = c >> 4, c8 = c & 15, m = mt * 128 + row;
    if (m < MS5) {
      const int b = m / NCH, ch = m - b * NCH;
      const int n = nt * 128 + c8 * 8, i = n >> 4, hh = n & 15;
      const float* s = Cs + row * CLD + c8 * 8;
      u32x4 u;
#pragma unroll
      for (int e = 0; e < 4; ++e) u[e] = pack2(gelu_tanh(s[2 * e]), gelu_tanh(s[2 * e + 1]));
      *(u32x4*)(Y5 + ((size_t)b * TT + ch * 32 + i) * 256 + g * 16 + hh) = u;
    }
  }
  __syncthreads();
}

DI void glu_tile(const Params& p, int l, int j, char* smem) {
  const int nt = j & 1, mt = j >> 1;
  const bf16* Y5 = (const bf16*)(p.ws + OFF_Y5) + (size_t)mt * 128 * 256;
  const bf16* W = wl(p, l, WL_GLU) + (size_t)nt * 128 * 256;
  f32x16 acc[2][2];
  acc_zero(acc);
  gemm_main_dma(acc, [&](int r) { return Y5 + (size_t)r * 256; }, [&](int r) { return W + (size_t)r * 256; }, 256, smem);
  float* Cs = (float*)smem;
  acc_to_lds(acc, Cs);
  __syncthreads();
  const float* gb = p.in[I_GLUB] + l * 256 + nt * 128;
  bf16* O = (bf16*)(p.ws + OFF_OS5) + (size_t)mt * 128 * 256 + nt * 128;
  for (int c = TIDX; c < 2048; c += 256) {
    const int row = c >> 4, cc = (c & 15) * 8;
    const float* s = Cs + row * CLD + cc;
    const u32x4 yu = *(const u32x4*)(Y5 + (size_t)row * 256 + nt * 128 + cc);
    u32x4 u;
#pragma unroll
    for (int e = 0; e < 4; ++e) {
      const float y0 = bflo(yu[e]), y1 = bfhi(yu[e]);
      u[e] = pack2(y0 * sigmoidf_(s[2 * e] + gb[cc + 2 * e]), y1 * sigmoidf_(s[2 * e + 1] + gb[cc + 2 * e + 1]));
    }
    *(u32x4*)(O + (size_t)row * 256 + cc) = u;
  }
  __syncthreads();
}

struct DmaStream { const bf16* ap[4]; const bf16* bp[4]; };
template <class FA, class FB>
DI void stream_setup(DmaStream& st, FA fa, FB fb) {
  const int tid = TIDX, lane = tid & 63, w = tid >> 6;
#pragma unroll
  for (int i = 0; i < 4; ++i) {
    const int row = w * 32 + i * 8 + (lane >> 3);
    const int c = (lane & 7) ^ ((row >> 1) & 7);
    st.ap[i] = fa(row) + c * 8;
    st.bp[i] = fb(row) + c * 8;
  }
}
DI void stream_issue(const DmaStream& st, int buf, int kt, char* smem) {
  const int tid = TIDX, lane = tid & 63, w = tid >> 6;
  const int ldst = (w * 256 + lane) * 16;
  const int k0 = kt * 64;
#pragma unroll
  for (int i = 0; i < 4; ++i) {
    __builtin_amdgcn_global_load_lds((const unsigned*)(st.ap[i] + k0), (unsigned*)(smem + buf * 16384 + ldst + i * 1024), 16, 0, 0);
    __builtin_amdgcn_global_load_lds((const unsigned*)(st.bp[i] + k0), (unsigned*)(smem + 32768 + buf * 16384 + ldst + i * 1024), 16, 0, 0);
  }
}
DI void stream_run(f32x16 (&acc)[2][2], const DmaStream& cur, int K, char* smem, const DmaStream& next, bool has_next) {
  const int tid = TIDX, lane = tid & 63, w = tid >> 6, wm = w >> 1, wn = w & 1;
  const int r = lane & 31, h = lane >> 5;
  const int xr = (r >> 1) & 7;
  const int arow = (wm * 64 + r) * 128, brow = (wn * 64 + r) * 128;
  const int nk = K / 64;
  for (int kt = 0; kt < nk; ++kt) {
    const int buf = kt & 1;
    if (kt + 1 < nk) stream_issue(cur, buf ^ 1, kt + 1, smem);
    else if (has_next) stream_issue(next, buf ^ 1, 0, smem);
    const char* Ab = smem + buf * 16384 + arow;
    const char* Bb = smem + 32768 + buf * 16384 + brow;
#pragma unroll
    for (int s2 = 0; s2 < 4; ++s2) {
      const int co = ((2 * s2 + h) ^ xr) * 16;
      s16x8 a0 = *(const s16x8*)(Ab + co);
      s16x8 a1 = *(const s16x8*)(Ab + 32 * 128 + co);
      s16x8 b0 = *(const s16x8*)(Bb + co);
      s16x8 b1 = *(const s16x8*)(Bb + 32 * 128 + co);
      acc[0][0] = MFMA32(a0, b0, acc[0][0]);
      acc[0][1] = MFMA32(a0, b1, acc[0][1]);
      acc[1][0] = MFMA32(a1, b0, acc[1][0]);
      acc[1][1] = MFMA32(a1, b1, acc[1][1]);
    }
    asm volatile("s_waitcnt vmcnt(0)" ::: "memory");
    __syncthreads();
  }
}

DI void merge_tile(const Params& p, int l, int j, char* smem) {
  const int nt = j & 7, mt = j >> 3;
  const bf16* H = (const bf16*)(p.ws + OFF_H) + (size_t)mt * 128 * DM;
  unsigned am[2][2][8];
#pragma unroll
  for (int a = 0; a < 2; ++a)
#pragma unroll
    for (int bq = 0; bq < 2; ++bq)
#pragma unroll
      for (int i = 0; i < 8; ++i) am[a][bq][i] = 0u;
  DmaStream sb, sg;
  {
    const bf16* A0 = (const bf16*)(p.ws + OFF_OATT) + (size_t)mt * 128 * 256;
    const bf16* W0 = wl(p, l, WL_BRA) + (size_t)nt * 128 * 256;
    stream_setup(sb, [&](int r) { return A0 + (size_t)r * 256; }, [&](int r) { return W0 + (size_t)r * 256; });
    stream_issue(sb, 0, 0, smem);
    asm volatile("s_waitcnt vmcnt(0)" ::: "memory");
    __syncthreads();
  }
#pragma unroll 1
  for (int x = 0; x < 3; ++x) {
    const int K = (x == 1) ? 512 : 256;
    const bf16* Wg = wl(p, l, WL_WIN) + ((size_t)2432 + x * 1024 + nt * 128) * DM;
    stream_setup(sg, [&](int r) { return H + (size_t)r * DM; }, [&](int r) { return Wg + (size_t)r * DM; });
    unsigned br[2][2][8];
    {
      f32x16 acc[2][2];
      acc_zero(acc);
      stream_run(acc, sb, K, smem, sg, true);
#pragma unroll
      for (int a = 0; a < 2; ++a)
#pragma unroll
        for (int bq = 0; bq < 2; ++bq)
#pragma unroll
          for (int i = 0; i < 8; ++i) br[a][bq][i] = pack2(acc[a][bq][2 * i], acc[a][bq][2 * i + 1]);
    }
    if (x < 2) {
      const bf16* A1; const bf16* W1; int K1;
      if (x == 0) { A1 = (const bf16*)(p.ws + OFF_OGLA) + (size_t)mt * 128 * 512; W1 = wl(p, l, WL_BRG) + (size_t)nt * 128 * 512; K1 = 512; }
      else { A1 = (const bf16*)(p.ws + OFF_OS5) + (size_t)mt * 128 * 256; W1 = wl(p, l, WL_BRS) + (size_t)nt * 128 * 256; K1 = 256; }
      stream_setup(sb, [&](int r) { return A1 + (size_t)r * K1; }, [&](int r) { return W1 + (size_t)r * K1; });
    }
    f32x16 acc[2][2];
    acc_zero(acc);
    stream_run(acc, sg, DM, smem, sb, x < 2);
#pragma unroll
    for (int a = 0; a < 2; ++a)
#pragma unroll
      for (int bq = 0; bq < 2; ++bq)
#pragma unroll
        for (int i = 0; i < 8; ++i) {
          const float v0 = bflo(am[a][bq][i]) + sigmoidf_(acc[a][bq][2 * i]) * bflo(br[a][bq][i]);
          const float v1 = bfhi(am[a][bq][i]) + sigmoidf_(acc[a][bq][2 * i + 1]) * bfhi(br[a][bq][i]);
          am[a][bq][i] = pack2(v0, v1);
        }
  }
  f32x16 accm[2][2];
#pragma unroll
  for (int a = 0; a < 2; ++a)
#pragma unroll
    for (int bq = 0; bq < 2; ++bq)
#pragma unroll
      for (int i = 0; i < 8; ++i) { accm[a][bq][2 * i] = bflo(am[a][bq][i]); accm[a][bq][2 * i + 1] = bfhi(am[a][bq][i]); }
  float* Cs = (float*)smem;
  acc_to_lds(accm, Cs);
  __syncthreads();
  store_tile_bf16(Cs, (bf16*)(p.ws + OFF_MG) + (size_t)mt * 128 * DM + nt * 128, DM, 128, 1.f);
  __syncthreads();
}

DI void plain_tile(const bf16* A, int K, const bf16* W, bf16* dst, int ldd, char* smem) {
  f32x16 acc[2][2];
  acc_zero(acc);
  gemm_main_dma(acc, [&](int r) { return A + (size_t)r * K; }, [&](int r) { return W + (size_t)r * K; }, K, smem);
  float* Cs = (float*)smem;
  acc_to_lds(acc, Cs);
  __syncthreads();
  store_tile_bf16(Cs, dst, ldd, 128, 1.f);
  __syncthreads();
}

DI void store_half_bf16(const float* Cs, bf16* dst, size_t ld, int hf) {
  for (int c = TIDX; c < 1024; c += 256) {
    const int row = c >> 3, seg = (c >> 2) & 1, c8 = (c & 3) * 8;
    const int col = seg * 64 + hf * 32 + c8;
    const float* s = Cs + row * CLD + col;
    u32x4 v;
    v[0] = pack2(s[0], s[1]); v[1] = pack2(s[2], s[3]); v[2] = pack2(s[4], s[5]); v[3] = pack2(s[6], s[7]);
    *(u32x4*)(dst + (size_t)row * ld + col) = v;
  }
}
DI void plain_half(const bf16* A, int K, const bf16* W, bf16* dst, int ldd, int hf, char* smem) {
  f32x16 acc[2];
#pragma unroll
  for (int i = 0; i < 16; ++i) { acc[0][i] = 0.f; acc[1][i] = 0.f; }
  gemm_main_dma_half(acc, A, K, W, K, K, hf, smem);
  float* Cs = (float*)smem;
  {
    const int lane = TIDX & 63, w = TIDX >> 6, wm = w >> 1, wn = w & 1, r = lane & 31, h = lane >> 5;
#pragma unroll
    for (int tm = 0; tm < 2; ++tm)
#pragma unroll
      for (int i = 0; i < 16; ++i) Cs[(wm * 64 + tm * 32 + crow(i, h)) * CLD + wn * 64 + hf * 32 + r] = acc[tm][i];
  }
  __syncthreads();
  store_half_bf16(Cs, dst, ldd, hf);
  __syncthreads();
}

DI void plain_wide(const bf16* A, int K, const bf16* W, bf16* dst, int ldd, char* smem) {
  f32x16 acc[2][4];
  accw_zero(acc);
  gemm_wide(acc, [&](int r) { return A + (size_t)r * K; }, [&](int r) { return W + (size_t)r * K; }, K, smem);
  float* Cs = (float*)smem;
  accw_to_lds<0>(acc, Cs);
  __syncthreads();
  store_tile_bf16(Cs, dst, ldd, 128, 1.f);
  __syncthreads();
  accw_to_lds<1>(acc, Cs);
  __syncthreads();
  store_tile_bf16(Cs, dst + 128, ldd, 128, 1.f);
  __syncthreads();
}

DI void up_epi(const Params& p, int l, int jn, int seqbase, int len, int pos0, char* smem) {
  float* Cs = (float*)smem;
  const float* cw = p.in[I_CW] + (size_t)l * 3 * 2 * DFF;
  const float* cb = p.in[I_CB] + (size_t)l * 2 * DFF;
  bf16* G = (bf16*)(p.ws + OFF_G);
  const int tid = TIDX;
  const int c = (tid & 31) * 2;
  float wa[2][3], wv[2][3], ba[2], bv[2];
#pragma unroll
  for (int e = 0; e < 2; ++e) {
    const int ca = jn * 64 + c + e, cv = DFF + ca;
#pragma unroll
    for (int k = 0; k < 3; ++k) { wa[e][k] = cw[k * 2 * DFF + ca]; wv[e][k] = cw[k * 2 * DFF + cv]; }
    ba[e] = cb[ca]; bv[e] = cb[cv];
  }
#pragma unroll 4
  for (int rr = 1 + (tid >> 5); rr < 127; rr += 8) {
    const int pos = pos0 + rr;
    if (pos < len) {
      float gv[2];
#pragma unroll
      for (int e = 0; e < 2; ++e) {
        const float a = wa[e][0] * Cs[(rr - 1) * CLD + c + e] + wa[e][1] * Cs[rr * CLD + c + e] + wa[e][2] * Cs[(rr + 1) * CLD + c + e] + ba[e];
        const float v = wv[e][0] * Cs[(rr - 1) * CLD + 64 + c + e] + wv[e][1] * Cs[rr * CLD + 64 + c + e] +
                        wv[e][2] * Cs[(rr + 1) * CLD + 64 + c + e] + bv[e];
        gv[e] = siluf_(a) * v;
      }
      *(unsigned*)(G + (size_t)(seqbase + pos) * DFF + jn * 64 + c) = pack2(gv[0], gv[1]);
    }
  }
  __syncthreads();
}

DI void up_wide(const Params& p, int l, int mtile, int jp, char* smem) {
  const int b = mtile / 69, rr0 = mtile % 69;
  int seqbase, len, ti;
  if (rr0 < 3) { seqbase = b * TT; len = CTXL; ti = rr0; }
  else { seqbase = b * TT + CTXL; len = SEQ; ti = rr0 - 3; }
  const int pos0 = ti * 126 - 1;
  const bf16* H = (const bf16*)(p.ws + OFF_H);
  const bf16* W = wl(p, l, WL_UP) + (size_t)jp * 256 * DM;
  f32x16 acc[2][4];
  accw_zero(acc);
  gemm_wide(acc,
            [&](int r) -> const bf16* {
              const int pos = pos0 + r;
              return (pos >= 0 && pos < len) ? H + (size_t)(seqbase + pos) * DM : (const bf16*)(p.ws + OFF_ZERO);
            },
            [&](int r) { return W + (size_t)r * DM; }, DM, smem);
  float* Cs = (float*)smem;
  accw_to_lds<0>(acc, Cs);
  __syncthreads();
  up_epi(p, l, jp * 2, seqbase, len, pos0, smem);
  accw_to_lds<1>(acc, Cs);
  __syncthreads();
  up_epi(p, l, jp * 2 + 1, seqbase, len, pos0, smem);
}

DI bool gemm_job(int bid, int G, int it, int MT, int NTL, int& mt, int& nt, int CW = 8) {
  const int x = bid & 7, q = bid >> 3, Q = G >> 3;
  const int m0 = (x * MT) >> 3, m1 = ((x + 1) * MT) >> 3, Mx = m1 - m0;
  const int jl = q + Q * it;
  if (jl >= Mx * NTL) return false;
  const int full = Mx * CW;
  const int c = jl / full, rem = jl - c * full;
  const int wc = min(CW, NTL - CW * c);
  const int mi = rem / wc;
  mt = m0 + mi;
  nt = CW * c + (rem - mi * wc);
  return true;
}

DI int lat_mt(int i) { return (i >> 6) * 66 + 2 + (i & 63); }
DI int lat_up(int i) { return (i / 66) * 69 + 3 + (i % 66); }

enum { PH_PREP = 0, PH_ROW0, PH_PROJ, PH_MIX1, PH_SCAN, PH_MIX2, PH_GLU, PH_MERGE, PH_WOUT, PH_ROW1, PH_UP, PH_DOWN, PH_ROW2 };
constexpr int N_PHASES = 2 + 11 * NL;

DI void run_phase(const Params& p, int ph, int l, char* smem) {
  const int bid = blockIdx.x;
#ifdef HALFMASK
  const int G = ((HALFMASK >> ph) & 1) ? 256 : gridDim.x;
  if (bid >= G) return;
#else
  const int G = gridDim.x;
#endif
#ifdef PHMASK
  if (!((PHMASK >> ph) & 1)) return;
#endif
  switch (ph) {
    case PH_PREP:
      if (bid < 8) { for (int i = TIDX; i < 512; i += 256) ((u32x4*)(p.ws + OFF_ZERO))[i] = u32x4{0u, 0u, 0u, 0u}; }
      for (int j = bid; j < 128 + 4016; j += G) {
        if (j < 96) prep_mod_job(p, j, smem);
        else if (j < 128) prep_s5_job(p, j - 96);
        else prep_wt_job(p, j - 128, smem);
      }
      break;
    case PH_ROW0:
      row_phase<0>(p, 0, bid, G);
      ktab_phase(p, bid, G, 0, 1);
      break;
    case PH_PROJ:
#ifdef EXP_A
      if (bid < 256) { int mt, nt; for (int it = 0; gemm_job(bid, 256, it, 264, 10, mt, nt, 4); ++it) proj_wide(p, l, mt, nt, smem); }
      else {
        s5mat_phase(p, l, bid - 256, G - 256);
        if (l + 1 < NL) ktab_phase(p, bid - 256, G - 256, l + 1, l + 2);
        if (l + 1 < NL) { for (int jj = (l + 1) * 4016 + (bid - 256); jj < (l + 2) * 4016; jj += G - 256) prep_wt_job(p, jj, smem); }
      }
#elif defined(EXP_C)
      if (bid < 256) for (int j = bid; j < 264 * 19; j += 256) { if ((EXP_C >> (j % 19)) & 1) proj_tile(p, l, j / 19, j % 19, smem); }
      for (int j = bid; j < 264 * 19; j += G) { if (!((EXP_C >> (j % 19)) & 1)) proj_tile(p, l, j / 19, j % 19, smem); }
      s5mat_phase(p, l, bid, G);
#elif defined(EXP_B)
      for (int j = bid; j < 264 * 19; j += G) proj_tile(p, l, j / 19, j % 19, smem);
      if (bid < 256) s5mat_phase(p, l, bid, 256);
#else
      for (int j = bid; j < 264 * 19; j += G) proj_tile(p, l, j / 19, j % 19, smem);
      s5mat_phase(p, l, bid, G);
#endif
      break;
    case PH_MIX1:
      for (int j = bid; j < (l == NL - 1 ? 1024 : 1056); j += G) attn_unit(p, j, smem);
      for (int j = bid; j < 1024; j += G) {
        const int v = j >> 5, k = j & 31;
        const int gi = (v & 1) ? (k == 0 ? 0 : k + 1) : k;
        gla_unit<false>(p, l, v * NG33 + gi, smem);
      }
      for (int j = G - 1 - bid; j < 288; j += G) s5_end_tile(p, j, smem);
      break;
    case PH_SCAN:
      for (int j = bid; j < 1024 + 128; j += G) {
        if (j < 1024) gla_scan_job(p, j);
        else s5_scan_job(p, l, j - 1024, smem);
      }
      break;
    case PH_MIX2:
      if (l == NL - 1) {
        for (int j = bid; j < 512 + 576; j += G) {
          if (j < 512) gla_unit<true>(p, l, (j >> 5) * NG33 + 1 + (j & 31), smem);
          else s5_out_tile(p, j - 512, smem);
        }
      } else {
        for (int j = bid; j < 528 + 576; j += G) {
          if (j < 528) gla_unit<true>(p, l, j, smem);
          else s5_out_tile(p, j - 528, smem);
        }
      }
      break;
    case PH_GLU:
      { const bool last = (l == NL - 1); int mt, nt;
        for (int it = 0; gemm_job(bid, G, it, last ? 256 : 264, 2, mt, nt); ++it) glu_tile(p, l, (last ? lat_mt(mt) : mt) * 2 + nt, smem); }
      break;
    case PH_MERGE:
      { const bool last = (l == NL - 1); int mt, nt;
        for (int it = 0; gemm_job(bid, G, it, last ? 256 : 264, 8, mt, nt); ++it) merge_tile(p, l, (last ? lat_mt(mt) : mt) * 8 + nt, smem); }
      break;
    case PH_WOUT:
      for (int it = 0;; ++it) {
        int mt, nt;
        if (!gemm_job(bid, G, it, 256, 8, mt, nt)) break;
        mt = lat_mt(mt);
        plain_tile((const bf16*)(p.ws + OFF_MG) + (size_t)mt * 128 * DM, DM, wl(p, l, WL_WOUT) + (size_t)nt * 128 * DM,
                   (bf16*)(p.ws + OFF_H) + (size_t)mt * 128 * DM + nt * 128, DM, smem);
      }
      if (l != NL - 1 && bid < 128) {
        const int c = bid >> 1, hf = bid & 1;
        const int mt = (c >> 4) * 66 + ((c >> 3) & 1), nt = c & 7;
        plain_half((const bf16*)(p.ws + OFF_MG) + (size_t)mt * 128 * DM, DM, wl(p, l, WL_WOUT) + (size_t)nt * 128 * DM,
                   (bf16*)(p.ws + OFF_H) + (size_t)mt * 128 * DM + nt * 128, DM, hf, smem);
      }
      break;
    case PH_ROW1: row_phase<1>(p, l, bid, G); break;
    case PH_UP:
      { const bool last = (l == NL - 1); int mt, nt;
        for (int it = 0; gemm_job(bid, G, it, last ? 264 : 276, 22, mt, nt, 4); ++it) up_wide(p, l, last ? lat_up(mt) : mt, nt, smem); }
      break;
    case PH_DOWN:
      for (int it = 0;; ++it) {
        int mt, nt;
        if (!gemm_job(bid, G, it, 256, 8, mt, nt)) break;
        mt = lat_mt(mt);
        plain_tile((const bf16*)(p.ws + OFF_G) + (size_t)mt * 128 * DFF, DFF, wl(p, l, WL_DOWN) + (size_t)nt * 128 * DFF,
                   (bf16*)(p.ws + OFF_H) + (size_t)mt * 128 * DM + nt * 128, DM, smem);
      }
      if (l != NL - 1 && bid < 128) {
        const int c = bid >> 1, hf = bid & 1;
        const int mt = (c >> 4) * 66 + ((c >> 3) & 1), nt = c & 7;
        plain_half((const bf16*)(p.ws + OFF_G) + (size_t)mt * 128 * DFF, DFF, wl(p, l, WL_DOWN) + (size_t)nt * 128 * DFF,
                   (bf16*)(p.ws + OFF_H) + (size_t)mt * 128 * DM + nt * 128, DM, hf, smem);
      }
      break;
    case PH_ROW2: row_phase<2>(p, l, bid, G); break;
  }
}

#define XB_TMO      128
#define XB_XCNT(j)  (256  + 64 * (j))
#define XB_XSUB(j)  (1280 + 64 * (j))
#define XB_XGEN(j)  (2304 + 64 * (j))
#define XB_TOP      3328
#define XB_TOPGEN   3392
#define XCD_BAR_WORDS 3456
#define XB_SPIN_CAP (1u << 18)
#define LAS __attribute__((address_space(3)))

__device__ __forceinline__ unsigned xb_ld(unsigned* p)              { return __hip_atomic_load(p, __ATOMIC_RELAXED, __HIP_MEMORY_SCOPE_AGENT); }
__device__ __forceinline__ unsigned xb_add(unsigned* p, unsigned v) { return __hip_atomic_fetch_add(p, v, __ATOMIC_RELAXED, __HIP_MEMORY_SCOPE_AGENT); }
__device__ __forceinline__ unsigned xb_xcc_id() { return (unsigned)__builtin_amdgcn_s_getreg((3 << 11) | 20) & 0xFu; }
#define XB_SPIN(cond, bar) do { unsigned _sp = 0; while (cond) { __builtin_amdgcn_s_sleep(1); \
    if ((++_sp & 255u) == 0u) { if (xb_ld(&(bar)[XB_TMO])) break; if (_sp > XB_SPIN_CAP) { atomicAdd(&(bar)[XB_TMO], 1u); break; } } } } while (0)

struct XcdBarrier {
    unsigned* bar; unsigned x;
    volatile LAS unsigned* st;
};

__device__ __forceinline__ XcdBarrier xcd_barrier_post(unsigned* bar, volatile LAS unsigned* st) {
    XcdBarrier b; b.bar = bar; b.x = xb_xcc_id(); b.st = st;
    if (threadIdx.x == 0) (void)xb_add(&bar[XB_XCNT(b.x)], 1u);
    return b;
}
__device__ __forceinline__ void xcd_barrier_complete(unsigned* bar, unsigned x, unsigned& nloc, unsigned& nx) {
    const unsigned G = gridDim.x * gridDim.y * gridDim.z;
    unsigned sum, cnt, mine, sp = 0u;
    for (;;) {
        sum = 0u; cnt = 0u; mine = 0u;
#pragma unroll
        for (unsigned j = 0; j < 16; ++j) { const unsigned c = xb_ld(&bar[XB_XCNT(j)]); sum += c; cnt += (c > 0u) ? 1u : 0u; mine = (j == x) ? c : mine; }
        if (sum == G) break;
        __builtin_amdgcn_s_sleep(1);
        if ((++sp & 255u) == 0u) { if (xb_ld(&bar[XB_TMO])) break; if (sp > XB_SPIN_CAP) { atomicAdd(&bar[XB_TMO], 1u); break; } }
    }
    nloc = mine > 0u ? mine : 1u; nx = cnt > 0u ? cnt : 1u;
}

__device__ __forceinline__ void xcd_barrier(const XcdBarrier& b) {
    asm volatile("s_waitcnt vmcnt(0)" ::: "memory");
    __syncthreads();
    if (threadIdx.x == 0) {
        unsigned* bar = b.bar;
        __builtin_amdgcn_s_waitcnt(0);
        unsigned nloc = b.st[0], nx = b.st[1];
        if (nloc == 0u) { xcd_barrier_complete(bar, b.x, nloc, nx); b.st[0] = nloc; b.st[1] = nx; }
        const unsigned old = xb_add(&bar[XB_XSUB(b.x)], 1u);
        const unsigned gen = old / nloc;
        if (old + 1u == (gen + 1u) * nloc) {
            __builtin_amdgcn_fence(__ATOMIC_RELEASE, "agent");
            asm volatile("s_waitcnt vmcnt(0)" ::: "memory");
            const unsigned og = xb_add(&bar[XB_TOP], 1u);
            const unsigned tg = og / nx;
            if (og + 1u == (tg + 1u) * nx) xb_add(&bar[XB_TOPGEN], 1u);
            else XB_SPIN(xb_ld(&bar[XB_TOPGEN]) == tg, bar);
            __builtin_amdgcn_fence(__ATOMIC_ACQUIRE, "agent");
            xb_add(&bar[XB_XGEN(b.x)], 1u);
            asm volatile("s_waitcnt vmcnt(0)" ::: "memory");
        } else {
            XB_SPIN(xb_ld(&bar[XB_XGEN(b.x)]) == gen, bar);
            __builtin_amdgcn_fence(__ATOMIC_ACQUIRE, "agent");
            asm volatile("s_waitcnt vmcnt(0)" ::: "memory");
        }
    }
    __syncthreads();
}


DI void grid_barrier(unsigned* bar, unsigned& gen) {
  asm volatile("s_waitcnt vmcnt(0)" ::: "memory");
  __syncthreads();
  gen += 1;
  if (threadIdx.x == 0) {
    __builtin_amdgcn_fence(__ATOMIC_RELEASE, "agent");
    asm volatile("s_waitcnt vmcnt(0)" ::: "memory");
    const unsigned target = gen * gridDim.x;
    __hip_atomic_fetch_add(bar, 1u, __ATOMIC_RELAXED, __HIP_MEMORY_SCOPE_AGENT);
    while (__hip_atomic_load(bar, __ATOMIC_RELAXED, __HIP_MEMORY_SCOPE_AGENT) < target) __builtin_amdgcn_s_sleep(2);
  }
  __syncthreads();
  __builtin_amdgcn_fence(__ATOMIC_ACQUIRE, "agent");
  asm volatile("s_waitcnt vmcnt(0)" ::: "memory");
}

__global__ void __launch_bounds__(256, 2) hybrid_fwd(Params p, int ph_lo, int ph_hi) {
  extern __shared__ __attribute__((aligned(16))) char smem[];
  unsigned* bar = (unsigned*)(p.ws + OFF_BAR);
  unsigned gen = 0;
  __shared__ uint4 xb_words;
  if (threadIdx.x == 0) xb_words = make_uint4(0u, 0u, 0u, 0u);
  __syncthreads();
  XcdBarrier xb = xcd_barrier_post(bar + 64, (volatile LAS unsigned*)&xb_words);
  if (ph_hi - ph_lo > 1) cg::this_grid().sync();
  int i = 0;
#define STEP(PH, L)                                      \
  {                                                      \
    if (i >= ph_lo && i < ph_hi) {                       \
      Params q;                                          \
      q.ws = p.ws; q.out = p.out;                        \
      asm volatile("" : "+s"(q.ws), "+s"(q.out));        \
      _Pragma("unroll") for (int k = 0; k < 34; ++k) { q.in[k] = p.in[k]; asm volatile("" : "+s"(q.in[k])); } \
      run_phase(q, PH, L, smem);                         \
      if ((DUPMASK >> (PH)) & 1) { xcd_barrier(xb); run_phase(q, PH, L, smem); } \
      if (i + 1 < ph_hi) xcd_barrier(xb);                \
    }                                                    \
    ++i;                                                 \
  }
  STEP(PH_PREP, 0)
  STEP(PH_ROW0, 0)
#pragma unroll 1
  for (int l = 0; l < NL; ++l) {
    STEP(PH_PROJ, l)
    STEP(PH_MIX1, l)
    STEP(PH_SCAN, l)
    STEP(PH_MIX2, l)
    STEP(PH_GLU, l)
    STEP(PH_MERGE, l)
    STEP(PH_WOUT, l)
    STEP(PH_ROW1, l)
    STEP(PH_UP, l)
    STEP(PH_DOWN, l)
    STEP(PH_ROW2, l)
  }
#undef STEP
}

extern "C" void kernel_launch(void* const* d_in, const int* in_sizes, int n_in, void* d_out, int out_size, void* d_ws, size_t ws_size,
                              hipStream_t stream) {
  static int grid_blocks = 0;
  if (!grid_blocks) {
    int dev = 0, cus = 0, per_cu = 0;
    hipGetDevice(&dev);
    hipDeviceGetAttribute(&cus, hipDeviceAttributeMultiprocessorCount, dev);
    hipFuncSetAttribute((const void*)hybrid_fwd, hipFuncAttributeMaxDynamicSharedMemorySize, SMEM_BYTES);
    hipOccupancyMaxActiveBlocksPerMultiprocessor(&per_cu, hybrid_fwd, 256, SMEM_BYTES);
    if (per_cu < 1) per_cu = 1;
    if (per_cu > 2) per_cu = 2;
    grid_blocks = cus * per_cu;
    if (ws_size < OFF_ZERO + 8192) fprintf(stderr, "workspace too small: %zu < %zu\n", ws_size, (size_t)OFF_END);
  }
  Params p{};
  for (int i = 0; i < 34; ++i) p.in[i] = (const float*)d_in[i];
  p.out = (float*)d_out;
  p.ws = (char*)d_ws;
#if ONE_LAUNCH
  hipMemsetAsync((char*)d_ws + OFF_BAR, 0, 16384, stream);
  int lo = 0, hi = N_PHASES;
  void* args[] = {&p, &lo, &hi};
  hipError_t e = hipLaunchCooperativeKernel((void*)hybrid_fwd, dim3(grid_blocks), dim3(256), args, SMEM_BYTES, stream);
  if (e != hipSuccess) fprintf(stderr, "cooperative launch failed: %s (grid %d)\n", hipGetErrorString(e), grid_blocks);
#else
  for (int i = 0; i < N_PHASES; ++i) hipLaunchKernelGGL(hybrid_fwd, dim3(grid_blocks), dim3(256), SMEM_BYTES, stream, p, i, i + 1);
#endif
}
```

```cpp
#include <hip/hip_runtime.h>
#include <hip/hip_cooperative_groups.h>
#include <stdint.h>
#include <cstdio>
namespace cg = cooperative_groups;

#define EXP_A 1
#ifndef DUPMASK
#define DUPMASK 0
#endif
#ifndef ONE_LAUNCH
#define ONE_LAUNCH 1
#endif

typedef unsigned short bf16;
typedef __attribute__((ext_vector_type(8))) short s16x8;
typedef __attribute__((ext_vector_type(4))) short s16x4;
typedef __attribute__((ext_vector_type(16))) float f32x16;
typedef __attribute__((ext_vector_type(4))) float f32x4;
typedef __attribute__((ext_vector_type(2))) float f32x2;
typedef __attribute__((ext_vector_type(4))) unsigned u32x4;
typedef __attribute__((ext_vector_type(2))) unsigned u32x2;
typedef __attribute__((ext_vector_type(2))) __bf16 bf16x2_t;

#define DI __device__ __forceinline__
#define MFMA32(a, b, c) __builtin_amdgcn_mfma_f32_32x32x16_bf16((a), (b), (c), 0, 0, 0)

DI int tidx_opaque() { int t = threadIdx.x; asm volatile("" : "+v"(t)); return t; }
#define TIDX tidx_opaque()
DI bf16 f2bf(float x) { return __builtin_bit_cast(unsigned short, (__bf16)x); }
DI float bf2f(bf16 v) { return __uint_as_float(((unsigned)v) << 16); }
DI unsigned pack2(float a, float b) {
  f32x2 v = {a, b};
  return __builtin_bit_cast(unsigned, __builtin_convertvector(v, bf16x2_t));
}
DI float bflo(unsigned u) { return __uint_as_float(u << 16); }
DI float bfhi(unsigned u) { return __uint_as_float(u & 0xffff0000u); }
typedef const __attribute__((address_space(1))) u32x4* gptr16;
DI u32x4 ldg16(const void* q) { return *(gptr16)(uintptr_t)q; }
#define SCHED_FENCE() __builtin_amdgcn_sched_barrier(0)
DI int crow(int i, int h) { return (i & 3) + 8 * (i >> 2) + 4 * h; }
DI void sincos_cw(float x, float& sn, float& cs) {
  const float k = rintf(x * 0.63661977236758134f);
  float r = fmaf(-k, 1.57079637050628662109375f, x);
  r = fmaf(-k, -4.371139000186241e-08f, r);
  const int q = ((int)k) & 3;
  const float r2 = r * r;
  const float sp = r + r * r2 * (-1.6666667163e-01f + r2 * (8.3333337680e-03f + r2 * (-1.9841270114e-04f + r2 * 2.7557314297e-06f)));
  const float cp = 1.f + r2 * (-0.5f + r2 * (4.1666667908e-02f + r2 * (-1.3888889225e-03f + r2 * (2.4801587642e-05f - r2 * 2.7557314297e-07f))));
  sn = (q == 0) ? sp : (q == 1) ? cp : (q == 2) ? -sp : -cp;
  cs = (q == 0) ? cp : (q == 1) ? -sp : (q == 2) ? -cp : sp;
}
DI float sigmoidf_(float x) { return 1.f / (1.f + __expf(-x)); }
DI float siluf_(float x) { return x / (1.f + __expf(-x)); }

constexpr int DM = 1024, NB = 4, SEQ = 8192, CTXL = 256, TT = SEQ + CTXL, NTOK = NB * TT, NL = 4;
constexpr int DFF = 2816, DIN = 5408;
constexpr float EPSF = 1e-6f;
constexpr int NG33 = 33;
constexpr int NCH = 264;
constexpr int MS5 = NB * NCH;

constexpr size_t SZ_H = (size_t)NTOK * 1024 * 2;
constexpr size_t OFF_H = 0;
constexpr size_t OFF_P = OFF_H + SZ_H;
constexpr size_t OFF_Q = OFF_P;
constexpr size_t OFF_K = OFF_Q + (size_t)NTOK * 256 * 2;
constexpr size_t OFF_VT = OFF_K + (size_t)NTOK * 128 * 2;
constexpr size_t OFF_GQ = OFF_VT + (size_t)NTOK * 128 * 2;
constexpr size_t OFF_GK = OFF_GQ + (size_t)NTOK * 256 * 2;
constexpr size_t OFF_GVT = OFF_GK + (size_t)NTOK * 256 * 2;
constexpr size_t OFF_GR = OFF_GVT + (size_t)NTOK * 512 * 2;
constexpr size_t OFF_SU = OFF_GR + (size_t)NTOK * 512 * 2;
constexpr size_t OFF_LOW = OFF_SU + (size_t)NTOK * 256 * 2;
constexpr size_t OFF_O = OFF_LOW + (size_t)NTOK * 32 * 4;
constexpr size_t OFF_OATT = OFF_O;
constexpr size_t OFF_OGLA = OFF_OATT + (size_t)NTOK * 256 * 2;
constexpr size_t OFF_Y5 = OFF_OGLA + (size_t)NTOK * 512 * 2;
constexpr size_t OFF_EN = OFF_Y5;
constexpr size_t OFF_OS5 = OFF_Y5 + (size_t)NTOK * 256 * 2;
constexpr size_t OFF_M = OFF_OS5 + (size_t)NTOK * 256 * 2;
constexpr size_t OFF_MG = OFF_M;
constexpr size_t OFF_GS = OFF_M;
constexpr size_t OFF_DECG = OFF_GS + (size_t)32 * 33 * 8192 * 4;
constexpr size_t OFF_SB = OFF_DECG + (size_t)32 * 33 * 64 * 4;
constexpr size_t OFF_T5 = OFF_SB + (size_t)MS5 * 16 * 256 * 2;
constexpr size_t OFF_E5 = OFF_T5 + (size_t)16 * 512 * 512 * 2;
constexpr size_t OFF_F5 = OFF_E5 + (size_t)16 * 512 * 256 * 2;
constexpr size_t OFF_MEND = OFF_F5 + (size_t)16 * 256 * 512 * 2;
static_assert(OFF_MEND <= OFF_M + SZ_H, "mixer scratch overflows merged area");
constexpr size_t OFF_W = OFF_M + SZ_H;
constexpr size_t WL_WIN = 0, WL_BRA = WL_WIN + (size_t)5504 * 1024, WL_BRG = WL_BRA + 1024 * 256, WL_BRS = WL_BRG + 1024 * 512,
                 WL_WOUT = WL_BRS + 1024 * 256, WL_UP = WL_WOUT + 1024 * 1024, WL_DOWN = WL_UP + (size_t)5632 * 1024,
                 WL_GLU = WL_DOWN + (size_t)1024 * 2816, WL_TOTAL = WL_GLU + 256 * 256;
constexpr size_t OFF_XC = OFF_W + WL_TOTAL * 2 * NL;
constexpr size_t OFF_MOD = OFF_XC + (size_t)NB * CTXL * 1024 * 4;
constexpr size_t OFF_BBR = OFF_MOD + (size_t)NL * 5 * 6144 * 4;
constexpr size_t OFF_BBI = OFF_BBR + (size_t)NL * 2 * 16 * 64 * 16 * 4;
constexpr size_t OFF_PWR = OFF_BBI + (size_t)NL * 2 * 16 * 64 * 16 * 4;
constexpr size_t OFF_KTAB = OFF_PWR + (size_t)NL * 2 * 16 * 33 * 64 * 8;
constexpr size_t OFF_END = OFF_KTAB + (size_t)NL * 16 * 2 * 32 * 256 * 4;
constexpr size_t OFF_BAR = OFF_END;
constexpr size_t OFF_ZERO = OFF_BAR + 16384;
constexpr size_t OFF_G = OFF_P;
static_assert((size_t)NTOK * DFF * 2 <= OFF_M - OFF_P, "G overflows");

constexpr int SMEM_BYTES = 73728;

struct Params {
  const float* in[34];
  float* out;
  char* ws;
};

enum { I_X = 0, I_C, I_CTX, I_CCTX, I_ADAW, I_ADAB, I_NMPRE, I_NMPOST, I_NFPRE, I_NFPOST, I_WIN, I_QN, I_KN, I_GGW, I_GGB, I_GON,
       I_ARE, I_AIM, I_LDT, I_BRE, I_BIM, I_CRE, I_CIM, I_S5D, I_GLUW, I_GLUB, I_WBA, I_WBG, I_WBS, I_WOUT, I_UP, I_CW, I_CB, I_DOWN };

constexpr int LDT = 72;
constexpr int CLD = 132;

template <class FA, class FB>
DI void gemm_main(f32x16 (&acc)[2][2], FA fa, FB fb, int K, char* smem) {
  bf16* As = (bf16*)smem;
  bf16* Bs = (bf16*)(smem + 2 * 128 * LDT * 2);
  const int tid = TIDX, lane = tid & 63, w = tid >> 6, wm = w >> 1, wn = w & 1;
  const int r = lane & 31, h = lane >> 5;
  const int lr = tid >> 3, kc = (tid & 7) * 8;
  const bf16* ap[4];
  const bf16* bp[4];
#pragma unroll
  for (int i = 0; i < 4; ++i) {
    const bf16* a = fa(lr + 32 * i);
    const bf16* b = fb(lr + 32 * i);
    ap[i] = a ? a + kc : nullptr;
    bp[i] = b ? b + kc : nullptr;
  }
  u32x4 ra[4], rb[4];
  const u32x4 z4 = {0u, 0u, 0u, 0u};
#pragma unroll
  for (int i = 0; i < 4; ++i) {
    ra[i] = ap[i] ? ldg16(ap[i]) : z4;
    rb[i] = bp[i] ? ldg16(bp[i]) : z4;
  }
#pragma unroll
  for (int i = 0; i < 4; ++i) {
    *(u32x4*)(As + (lr + 32 * i) * LDT + kc) = ra[i];
    *(u32x4*)(Bs + (lr + 32 * i) * LDT + kc) = rb[i];
  }
  __syncthreads();
  const int nk = K / 64;
  for (int kt = 0; kt < nk; ++kt) {
    const int buf = kt & 1;
    const bool more = (kt + 1 < nk);
    if (more) {
      const int k0 = (kt + 1) * 64;
#pragma unroll
      for (int i = 0; i < 4; ++i) {
        ra[i] = ap[i] ? ldg16(ap[i] + k0) : z4;
        rb[i] = bp[i] ? ldg16(bp[i] + k0) : z4;
      }
    }
    SCHED_FENCE();
    const bf16* Ab = As + buf * 128 * LDT + (wm * 64 + r) * LDT + h * 8;
    const bf16* Bb = Bs + buf * 128 * LDT + (wn * 64 + r) * LDT + h * 8;
#pragma unroll
    for (int s = 0; s < 4; ++s) {
      s16x8 a0 = *(const s16x8*)(Ab + s * 16);
      s16x8 a1 = *(const s16x8*)(Ab + 32 * LDT + s * 16);
      s16x8 b0 = *(const s16x8*)(Bb + s * 16);
      s16x8 b1 = *(const s16x8*)(Bb + 32 * LDT + s * 16);
      acc[0][0] = MFMA32(a0, b0, acc[0][0]);
      acc[0][1] = MFMA32(a0, b1, acc[0][1]);
      acc[1][0] = MFMA32(a1, b0, acc[1][0]);
      acc[1][1] = MFMA32(a1, b1, acc[1][1]);
    }
    SCHED_FENCE();
    if (more) {
      bf16* Aw = As + (buf ^ 1) * 128 * LDT;
      bf16* Bw = Bs + (buf ^ 1) * 128 * LDT;
#pragma unroll
      for (int i = 0; i < 4; ++i) {
        *(u32x4*)(Aw + (lr + 32 * i) * LDT + kc) = ra[i];
        *(u32x4*)(Bw + (lr + 32 * i) * LDT + kc) = rb[i];
      }
    }
    __syncthreads();
  }
}

template <class FA, class FB>
DI void gemm_main_deep(f32x16 (&acc)[2][2], FA fa, FB fb, int K, char* smem) {
  bf16* As = (bf16*)smem;
  bf16* Bs = (bf16*)(smem + 2 * 128 * LDT * 2);
  const int tid = TIDX, lane = tid & 63, w = tid >> 6, wm = w >> 1, wn = w & 1;
  const int r = lane & 31, h = lane >> 5;
  const int lr = tid >> 3, kc = (tid & 7) * 8;
  const bf16* ap[4];
  const bf16* bp[4];
#pragma unroll
  for (int i = 0; i < 4; ++i) {
    const bf16* a = fa(lr + 32 * i);
    const bf16* b = fb(lr + 32 * i);
    ap[i] = a ? a + kc : nullptr;
    bp[i] = b ? b + kc : nullptr;
  }
  const u32x4 z4 = {0u, 0u, 0u, 0u};
  u32x4 a0[4], b0[4], a1[4], b1[4];
  const int nk = K / 64;
#define GD_LOAD(RA, RB, T)                                               \
  {                                                                      \
    const int k0_ = (T) * 64;                                            \
    _Pragma("unroll") for (int i = 0; i < 4; ++i) {                      \
      RA[i] = ap[i] ? ldg16(ap[i] + k0_) : z4;                           \
      RB[i] = bp[i] ? ldg16(bp[i] + k0_) : z4;                           \
    }                                                                    \
  }
#define GD_STORE(RA, RB, BUF)                                            \
  {                                                                      \
    _Pragma("unroll") for (int i = 0; i < 4; ++i) {                      \
      *(u32x4*)(As + (BUF) * 128 * LDT + (lr + 32 * i) * LDT + kc) = RA[i]; \
      *(u32x4*)(Bs + (BUF) * 128 * LDT + (lr + 32 * i) * LDT + kc) = RB[i]; \
    }                                                                    \
  }
#define GD_COMPUTE(BUF)                                                  \
  {                                                                      \
    const bf16* Ab = As + (BUF) * 128 * LDT + (wm * 64 + r) * LDT + h * 8; \
    const bf16* Bb = Bs + (BUF) * 128 * LDT + (wn * 64 + r) * LDT + h * 8; \
    _Pragma("unroll") for (int s = 0; s < 4; ++s) {                      \
      s16x8 fa0 = *(const s16x8*)(Ab + s * 16);                          \
      s16x8 fa1 = *(const s16x8*)(Ab + 32 * LDT + s * 16);               \
      s16x8 fb0 = *(const s16x8*)(Bb + s * 16);                          \
      s16x8 fb1 = *(const s16x8*)(Bb + 32 * LDT + s * 16);               \
      acc[0][0] = MFMA32(fa0, fb0, acc[0][0]);                           \
      acc[0][1] = MFMA32(fa0, fb1, acc[0][1]);                           \
      acc[1][0] = MFMA32(fa1, fb0, acc[1][0]);                           \
      acc[1][1] = MFMA32(fa1, fb1, acc[1][1]);                           \
    }                                                                    \
  }
  GD_LOAD(a0, b0, 0)
  GD_LOAD(a1, b1, 1)
  GD_STORE(a0, b0, 0)
  __syncthreads();
  if (nk > 2) GD_LOAD(a0, b0, 2)
  for (int kt = 0; kt < nk; kt += 2) {
    SCHED_FENCE();
    GD_COMPUTE(0)
    SCHED_FENCE();
    GD_STORE(a1, b1, 1)
    if (kt + 3 < nk) GD_LOAD(a1, b1, kt + 3)
    __syncthreads();
    SCHED_FENCE();
    GD_COMPUTE(1)
    SCHED_FENCE();
    if (kt + 2 < nk) {
      GD_STORE(a0, b0, 0)
      if (kt + 4 < nk) GD_LOAD(a0, b0, kt + 4)
    }
    __syncthreads();
  }
#undef GD_LOAD
#undef GD_STORE
#undef GD_COMPUTE
}

template <class FA, class FB>
DI void gemm_main_dma(f32x16 (&acc)[2][2], FA fa, FB fb, int K, char* smem) {
  char* As = smem;
  char* Bs = smem + 32768;
  const int tid = TIDX, lane = tid & 63, w = tid >> 6, wm = w >> 1, wn = w & 1;
  const int r = lane & 31, h = lane >> 5;
  const bf16* ap[4];
  const bf16* bp[4];
#pragma unroll
  for (int i = 0; i < 4; ++i) {
    const int row = w * 32 + i * 8 + (lane >> 3);
    const int c = (lane & 7) ^ ((row >> 1) & 7);
    ap[i] = fa(row) + c * 8;
    bp[i] = fb(row) + c * 8;
  }
  const int ldst = (w * 256 + lane) * 16;
#define GM_DMA(BUF, T)                                                                                        \
  {                                                                                                           \
    const int k0_ = (T) * 64;                                                                                 \
    _Pragma("unroll") for (int i = 0; i < 4; ++i) {                                                           \
      __builtin_amdgcn_global_load_lds((const unsigned*)(ap[i] + k0_), (unsigned*)(As + (BUF) * 16384 + ldst + i * 1024), 16, 0, 0); \
      __builtin_amdgcn_global_load_lds((const unsigned*)(bp[i] + k0_), (unsigned*)(Bs + (BUF) * 16384 + ldst + i * 1024), 16, 0, 0); \
    }                                                                                                         \
  }
  const int xr = (r >> 1) & 7;
  const int arow = (wm * 64 + r) * 128, brow = (wn * 64 + r) * 128;
  GM_DMA(0, 0)
  asm volatile("s_waitcnt vmcnt(0)" ::: "memory");
  __syncthreads();
  const int nk = K / 64;
  for (int kt = 0; kt < nk; ++kt) {
    const int buf = kt & 1;
    if (kt + 1 < nk) GM_DMA(buf ^ 1, kt + 1)
    const char* Ab = As + buf * 16384 + arow;
    const char* Bb = Bs + buf * 16384 + brow;
#pragma unroll
    for (int s = 0; s < 4; ++s) {
      const int co = ((2 * s + h) ^ xr) * 16;
      s16x8 a0 = *(const s16x8*)(Ab + co);
      s16x8 a1 = *(const s16x8*)(Ab + 32 * 128 + co);
      s16x8 b0 = *(const s16x8*)(Bb + co);
      s16x8 b1 = *(const s16x8*)(Bb + 32 * 128 + co);
      acc[0][0] = MFMA32(a0, b0, acc[0][0]);
      acc[0][1] = MFMA32(a0, b1, acc[0][1]);
      acc[1][0] = MFMA32(a1, b0, acc[1][0]);
      acc[1][1] = MFMA32(a1, b1, acc[1][1]);
    }
    asm volatile("s_waitcnt vmcnt(0)" ::: "memory");
    __syncthreads();
  }
#undef GM_DMA
}

DI void gemm_main_dma_half(f32x16 (&acc)[2], const bf16* A, int lda, const bf16* B, int ldb, int K, int hf, char* smem) {
  char* As = smem;
  char* Bs = smem + 32768;
  const int tid = TIDX, lane = tid & 63, w = tid >> 6, wm = w >> 1, wn = w & 1;
  const int r = lane & 31, h = lane >> 5;
  const bf16* ap[4];
  const bf16* bp[2];
#pragma unroll
  for (int i = 0; i < 4; ++i) {
    const int row = w * 32 + i * 8 + (lane >> 3);
    ap[i] = A + (size_t)row * lda + ((lane & 7) ^ ((row >> 1) & 7)) * 8;
  }
#pragma unroll
  for (int i = 0; i < 2; ++i) {
    const int lrow = w * 16 + i * 8 + (lane >> 3);
    const int grow = (lrow >> 5) * 64 + hf * 32 + (lrow & 31);
    bp[i] = B + (size_t)grow * ldb + ((lane & 7) ^ ((lrow >> 1) & 7)) * 8;
  }
  const int lda_ = (w * 256 + lane) * 16, ldb_ = (w * 128 + lane) * 16;
#define GH_DMA(BUF, T)                                                                                        \
  {                                                                                                           \
    const int k0_ = (T) * 64;                                                                                 \
    _Pragma("unroll") for (int i = 0; i < 4; ++i)                                                             \
      __builtin_amdgcn_global_load_lds((const unsigned*)(ap[i] + k0_), (unsigned*)(As + (BUF) * 16384 + lda_ + i * 1024), 16, 0, 0); \
    _Pragma("unroll") for (int i = 0; i < 2; ++i)                                                             \
      __builtin_amdgcn_global_load_lds((const unsigned*)(bp[i] + k0_), (unsigned*)(Bs + (BUF) * 8192 + ldb_ + i * 1024), 16, 0, 0); \
  }
  const int xr = (r >> 1) & 7;
  const int arow = (wm * 64 + r) * 128, brow = (wn * 32 + r) * 128;
  GH_DMA(0, 0)
  asm volatile("s_waitcnt vmcnt(0)" ::: "memory");
  __syncthreads();
  const int nk = K / 64;
  for (int kt = 0; kt < nk; ++kt) {
    const int buf = kt & 1;
    if (kt + 1 < nk) GH_DMA(buf ^ 1, kt + 1)
    const char* Ab = As + buf * 16384 + arow;
    const char* Bb = Bs + buf * 8192 + brow;
#pragma unroll
    for (int s = 0; s < 4; ++s) {
      const int co = ((2 * s + h) ^ xr) * 16;
      s16x8 a0 = *(const s16x8*)(Ab + co);
      s16x8 a1 = *(const s16x8*)(Ab + 32 * 128 + co);
      s16x8 b0 = *(const s16x8*)(Bb + co);
      acc[0] = MFMA32(a0, b0, acc[0]);
      acc[1] = MFMA32(a1, b0, acc[1]);
    }
    asm volatile("s_waitcnt vmcnt(0)" ::: "memory");
    __syncthreads();
  }
#undef GH_DMA
}

template <class FA, class FB>
DI void gemm_wide(f32x16 (&acc)[2][4], FA fa, FB fb, int K, char* smem) {
  const int tid = TIDX, lane = tid & 63, w = tid >> 6, wm = w >> 1, wn = w & 1;
  const int r = lane & 31, h = lane >> 5;
  const bf16* ap[2];
  const bf16* bp[4];
#pragma unroll
  for (int i = 0; i < 2; ++i) {
    const int row = w * 32 + i * 16 + (lane >> 2);
    ap[i] = fa(row) + ((lane & 3) ^ ((row >> 2) & 3)) * 8;
  }
#pragma unroll
  for (int i = 0; i < 4; ++i) {
    const int row = w * 64 + i * 16 + (lane >> 2);
    bp[i] = fb(row) + ((lane & 3) ^ ((row >> 2) & 3)) * 8;
  }
  const int lda_ = (w * 128 + lane) * 16;
  const int ldb_ = 8192 + (w * 256 + lane) * 16;
#define GW_DMA(T)                                                                                                   \
  {                                                                                                                 \
    char* st_ = smem + ((T) % 3) * 24576;                                                                           \
    const int k0_ = (T) * 32;                                                                                       \
    _Pragma("unroll") for (int i = 0; i < 2; ++i)                                                                   \
      __builtin_amdgcn_global_load_lds((const unsigned*)(ap[i] + k0_), (unsigned*)(st_ + lda_ + i * 1024), 16, 0, 0); \
    _Pragma("unroll") for (int i = 0; i < 4; ++i)                                                                   \
      __builtin_amdgcn_global_load_lds((const unsigned*)(bp[i] + k0_), (unsigned*)(st_ + ldb_ + i * 1024), 16, 0, 0); \
  }
  const int xr = (r >> 2) & 3;
  const int arow = (wm * 64 + r) * 64;
  const int brow = 8192 + (wn * 64 + r) * 64;
  const int nt = K / 32;
  GW_DMA(0)
  if (nt > 1) GW_DMA(1)
  for (int t = 0; t < nt; ++t) {
    if (t + 1 < nt) asm volatile("s_waitcnt vmcnt(6)" ::: "memory");
    else asm volatile("s_waitcnt vmcnt(0)" ::: "memory");
    __syncthreads();
    if (t + 2 < nt) GW_DMA(t + 2)
    const char* st = smem + (t % 3) * 24576;
#pragma unroll
    for (int s = 0; s < 2; ++s) {
      const int co = ((2 * s + h) ^ xr) * 16;
      const s16x8 a0 = *(const s16x8*)(st + arow + co);
      const s16x8 a1 = *(const s16x8*)(st + arow + 32 * 64 + co);
#pragma unroll
      for (int hn = 0; hn < 2; ++hn) {
        const s16x8 b0 = *(const s16x8*)(st + brow + hn * 128 * 64 + co);
        const s16x8 b1 = *(const s16x8*)(st + brow + hn * 128 * 64 + 32 * 64 + co);
        acc[0][hn * 2 + 0] = MFMA32(a0, b0, acc[0][hn * 2 + 0]);
        acc[0][hn * 2 + 1] = MFMA32(a0, b1, acc[0][hn * 2 + 1]);
        acc[1][hn * 2 + 0] = MFMA32(a1, b0, acc[1][hn * 2 + 0]);
        acc[1][hn * 2 + 1] = MFMA32(a1, b1, acc[1][hn * 2 + 1]);
      }
    }
  }
  __syncthreads();
#undef GW_DMA
}

DI void accw_zero(f32x16 (&acc)[2][4]) {
#pragma unroll
  for (int a = 0; a < 2; ++a)
#pragma unroll
    for (int b = 0; b < 4; ++b)
#pragma unroll
      for (int i = 0; i < 16; ++i) acc[a][b][i] = 0.f;
}

DI void gemm_main_s(f32x16 (&acc)[2][2], const bf16* A, int lda, const bf16* B, int ldb, int K, char* smem) {
  bf16* As = (bf16*)smem;
  bf16* Bs = (bf16*)(smem + 2 * 128 * LDT * 2);
  const int tid = TIDX, lane = tid & 63, w = tid >> 6, wm = w >> 1, wn = w & 1;
  const int r = lane & 31, h = lane >> 5;
  const int lr = tid >> 3, kc = (tid & 7) * 8;
  const bf16* ap = A + (size_t)lr * lda + kc;
  const bf16* bp = B + (size_t)lr * ldb + kc;
  const size_t sa = (size_t)32 * lda, sb = (size_t)32 * ldb;
  u32x4 ra[4], rb[4];
#pragma unroll
  for (int i = 0; i < 4; ++i) {
    ra[i] = ldg16(ap + i * sa);
    rb[i] = ldg16(bp + i * sb);
  }
#pragma unroll
  for (int i = 0; i < 4; ++i) {
    *(u32x4*)(As + (lr + 32 * i) * LDT + kc) = ra[i];
    *(u32x4*)(Bs + (lr + 32 * i) * LDT + kc) = rb[i];
  }
  __syncthreads();
  const int nk = K / 64;
  for (int kt = 0; kt < nk; ++kt) {
    const int buf = kt & 1;
    const bool more = (kt + 1 < nk);
    if (more) {
      ap += 64; bp += 64;
#pragma unroll
      for (int i = 0; i < 4; ++i) {
        ra[i] = ldg16(ap + i * sa);
        rb[i] = ldg16(bp + i * sb);
      }
    }
    SCHED_FENCE();
    const bf16* Ab = As + buf * 128 * LDT + (wm * 64 + r) * LDT + h * 8;
    const bf16* Bb = Bs + buf * 128 * LDT + (wn * 64 + r) * LDT + h * 8;
#pragma unroll
    for (int s = 0; s < 4; ++s) {
      s16x8 a0 = *(const s16x8*)(Ab + s * 16);
      s16x8 a1 = *(const s16x8*)(Ab + 32 * LDT + s * 16);
      s16x8 b0 = *(const s16x8*)(Bb + s * 16);
      s16x8 b1 = *(const s16x8*)(Bb + 32 * LDT + s * 16);
      acc[0][0] = MFMA32(a0, b0, acc[0][0]);
      acc[0][1] = MFMA32(a0, b1, acc[0][1]);
      acc[1][0] = MFMA32(a1, b0, acc[1][0]);
      acc[1][1] = MFMA32(a1, b1, acc[1][1]);
    }
    SCHED_FENCE();
    if (more) {
      bf16* Aw = As + (buf ^ 1) * 128 * LDT;
      bf16* Bw = Bs + (buf ^ 1) * 128 * LDT;
#pragma unroll
      for (int i = 0; i < 4; ++i) {
        *(u32x4*)(Aw + (lr + 32 * i) * LDT + kc) = ra[i];
        *(u32x4*)(Bw + (lr + 32 * i) * LDT + kc) = rb[i];
      }
    }
    __syncthreads();
  }
}

DI void gemm_main_half(f32x16 (&acc)[2], const bf16* A, int lda, const bf16* B, int ldb, int K, int hf, char* smem) {
  bf16* As = (bf16*)smem;
  bf16* Bs = (bf16*)(smem + 2 * 128 * LDT * 2);
  const int tid = TIDX, lane = tid & 63, w = tid >> 6, wm = w >> 1, wn = w & 1;
  const int r = lane & 31, h = lane >> 5;
  const int lr = tid >> 3, kc = (tid & 7) * 8;
  const bf16* ap = A + (size_t)lr * lda + kc;
  const bf16* bp = B + (size_t)(hf * 32 + lr) * ldb + kc;
  const size_t sa = (size_t)32 * lda, sb = (size_t)64 * ldb;
  u32x4 ra[4], rb[2];
#pragma unroll
  for (int i = 0; i < 4; ++i) ra[i] = ldg16(ap + i * sa);
#pragma unroll
  for (int i = 0; i < 2; ++i) rb[i] = ldg16(bp + i * sb);
#pragma unroll
  for (int i = 0; i < 4; ++i) *(u32x4*)(As + (lr + 32 * i) * LDT + kc) = ra[i];
#pragma unroll
  for (int i = 0; i < 2; ++i) *(u32x4*)(Bs + (lr + 32 * i) * LDT + kc) = rb[i];
  __syncthreads();
  const int nk = K / 64;
  for (int kt = 0; kt < nk; ++kt) {
    const int buf = kt & 1;
    const bool more = (kt + 1 < nk);
    if (more) {
      ap += 64; bp += 64;
#pragma unroll
      for (int i = 0; i < 4; ++i) ra[i] = ldg16(ap + i * sa);
#pragma unroll
      for (int i = 0; i < 2; ++i) rb[i] = ldg16(bp + i * sb);
    }
    SCHED_FENCE();
    const bf16* Ab = As + buf * 128 * LDT + (wm * 64 + r) * LDT + h * 8;
    const bf16* Bb = Bs + buf * 128 * LDT + (wn * 32 + r) * LDT + h * 8;
#pragma unroll
    for (int s = 0; s < 4; ++s) {
      s16x8 a0 = *(const s16x8*)(Ab + s * 16);
      s16x8 a1 = *(const s16x8*)(Ab + 32 * LDT + s * 16);
      s16x8 b0 = *(const s16x8*)(Bb + s * 16);
      acc[0] = MFMA32(a0, b0, acc[0]);
      acc[1] = MFMA32(a1, b0, acc[1]);
    }
    SCHED_FENCE();
    if (more) {
      bf16* Aw = As + (buf ^ 1) * 128 * LDT;
      bf16* Bw = Bs + (buf ^ 1) * 128 * LDT;
#pragma unroll
      for (int i = 0; i < 4; ++i) *(u32x4*)(Aw + (lr + 32 * i) * LDT + kc) = ra[i];
#pragma unroll
      for (int i = 0; i < 2; ++i) *(u32x4*)(Bw + (lr + 32 * i) * LDT + kc) = rb[i];
    }
    __syncthreads();
  }
}

DI void acc_zero(f32x16 (&acc)[2][2]) {
#pragma unroll
  for (int a = 0; a < 2; ++a)
#pragma unroll
    for (int b = 0; b < 2; ++b)
#pragma unroll
      for (int i = 0; i < 16; ++i) acc[a][b][i] = 0.f;
}

DI void acc_to_lds(const f32x16 (&acc)[2][2], float* Cs) {
  const int lane = TIDX & 63, w = TIDX >> 6, wm = w >> 1, wn = w & 1, r = lane & 31, h = lane >> 5;
#pragma unroll
  for (int tm = 0; tm < 2; ++tm)
#pragma unroll
    for (int tn = 0; tn < 2; ++tn)
#pragma unroll
      for (int i = 0; i < 16; ++i) Cs[(wm * 64 + tm * 32 + crow(i, h)) * CLD + wn * 64 + tn * 32 + r] = acc[tm][tn][i];
}

template <int HN>
DI void accw_to_lds(const f32x16 (&acc)[2][4], float* Cs) {
  const int lane = TIDX & 63, w = TIDX >> 6, wm = w >> 1, wn = w & 1, r = lane & 31, h = lane >> 5;
#pragma unroll
  for (int tm = 0; tm < 2; ++tm)
#pragma unroll
    for (int tn = 0; tn < 2; ++tn)
#pragma unroll
      for (int i = 0; i < 16; ++i) Cs[(wm * 64 + tm * 32 + crow(i, h)) * CLD + wn * 64 + tn * 32 + r] = acc[tm][HN * 2 + tn][i];
}

DI void store_tile_bf16(const float* Cs, bf16* dst, size_t ld, int mvalid, float scale) {
  for (int c = TIDX; c < 2048; c += 256) {
    const int row = c >> 4, cc = (c & 15) * 8;
    if (row < mvalid) {
      const float* s = Cs + row * CLD + cc;
      u32x4 v;
      v[0] = pack2(s[0] * scale, s[1] * scale);
      v[1] = pack2(s[2] * scale, s[3] * scale);
      v[2] = pack2(s[4] * scale, s[5] * scale);
      v[3] = pack2(s[6] * scale, s[7] * scale);
      *(u32x4*)(dst + (size_t)row * ld + cc) = v;
    }
  }
}

DI float* resid_row(const Params& p, int tok) {
  const int b = tok / TT, t = tok - b * TT;
  return (t < CTXL) ? (float*)(p.ws + OFF_XC) + ((size_t)b * CTXL + t) * DM : p.out + ((size_t)b * SEQ + (t - CTXL)) * DM;
}
DI const float* mod_vec(const Params& p, int l, int tok, int which) {
  const int b = tok / TT, t = tok - b * TT;
  const int m = (t < CTXL) ? 4 : b;
  return (const float*)(p.ws + OFF_MOD) + ((size_t)(l * 5 + m) * 6 + which) * DM;
}
DI float wave_sum(float v) {
#pragma unroll
  for (int o = 32; o >= 1; o >>= 1) v += __shfl_xor(v, o, 64);
  return v;
}
DI bf16* wl(const Params& p, int l, size_t off) { return (bf16*)(p.ws + OFF_W) + (size_t)l * WL_TOTAL + off; }

DI void prep_mod_job(const Params& p, int j, char* smem) {
  float* sc = (float*)smem;
  float* part = (float*)(smem + 20480);
  const int l = j / 24, nb = j % 24, tid = TIDX, lane = tid & 63, w = tid >> 6;
  for (int idx = tid; idx < 5120; idx += 256) {
    const int m = idx >> 10, k = idx & 1023;
    const float v = (m < 4) ? p.in[I_C][m * 1024 + k] : p.in[I_CCTX][k];
    sc[idx] = siluf_(v);
  }
  __syncthreads();
  const float* W = p.in[I_ADAW] + (size_t)l * 1024 * 6144 + nb * 256 + lane;
  float a[5][4];
#pragma unroll
  for (int m = 0; m < 5; ++m)
#pragma unroll
    for (int c = 0; c < 4; ++c) a[m][c] = 0.f;
#pragma unroll 4
  for (int kk = 0; kk < 256; ++kk) {
    const int k = w * 256 + kk;
    float wv[4];
#pragma unroll
    for (int c = 0; c < 4; ++c) wv[c] = W[(size_t)k * 6144 + 64 * c];
#pragma unroll
    for (int m = 0; m < 5; ++m) {
      const float sv = sc[m * 1024 + k];
#pragma unroll
      for (int c = 0; c < 4; ++c) a[m][c] += sv * wv[c];
    }
  }
#pragma unroll
  for (int m = 0; m < 5; ++m)
#pragma unroll
    for (int c = 0; c < 4; ++c) part[(w * 5 + m) * 256 + lane + 64 * c] = a[m][c];
  __syncthreads();
  const int n = nb * 256 + tid;
  const float bb = p.in[I_ADAB][l * 6144 + n];
  float* M = (float*)(p.ws + OFF_MOD) + (size_t)l * 5 * 6144 + n;
#pragma unroll
  for (int m = 0; m < 5; ++m)
    M[m * 6144] = part[(0 * 5 + m) * 256 + tid] + part[(1 * 5 + m) * 256 + tid] + part[(2 * 5 + m) * 256 + tid] + part[(3 * 5 + m) * 256 + tid] + bb;
  __syncthreads();
}

DI void prep_s5_job(const Params& p, int j) {
  const int idx = j * 256 + TIDX;
  const int ldg = idx >> 6, pp = idx & 63;
  const float dt = expf(p.in[I_LDT][ldg]);
  const float are = p.in[I_ARE][idx], aim = p.in[I_AIM][idx];
  const float mag = expf(are * dt);
  float sn, cs;
  sincos_cw(aim * dt, sn, cs);
  const float abr = mag * cs, abi = mag * sn;
  const float den = are * are + aim * aim;
  const float fre = ((abr - 1.f) * are + abi * aim) / den;
  const float fim = (abi * are - (abr - 1.f) * aim) / den;
  float* BBR = (float*)(p.ws + OFF_BBR);
  float* BBI = (float*)(p.ws + OFF_BBI);
  for (int hh = 0; hh < 16; ++hh) {
    const float br = p.in[I_BRE][(size_t)idx * 16 + hh], bi = p.in[I_BIM][(size_t)idx * 16 + hh];
    BBR[(size_t)idx * 16 + hh] = fre * br - fim * bi;
    BBI[(size_t)idx * 16 + hh] = fre * bi + fim * br;
  }
  float2* PW = (float2*)(p.ws + OFF_PWR);
  float pr = 1.f, pi = 0.f;
  for (int tau = 0; tau <= 32; ++tau) {
    PW[((size_t)ldg * 33 + tau) * 64 + pp] = make_float2(pr, pi);
    const float nr = pr * abr - pi * abi, ni = pr * abi + pi * abr;
    pr = nr; pi = ni;
  }
}

DI void prep_wt_job(const Params& p, int jj, char* smem) {
  float* tile = (float*)smem;
  const int l = jj / 4016;
  int r = jj % 4016;
  int mat = 0;
  const int cnt[8] = {1376, 64, 128, 64, 256, 1408, 704, 16};
#pragma unroll
  for (int m = 0; m < 8; ++m) {
    if (mat == m && r >= cnt[m]) { r -= cnt[m]; mat = m + 1; }
  }
  const float* src; int K, sld; size_t doff;
  switch (mat) {
    case 0: src = p.in[I_WIN] + (size_t)l * 1024 * DIN; K = 1024; sld = DIN; doff = WL_WIN; break;
    case 1: src = p.in[I_WBA] + (size_t)l * 256 * 1024; K = 256; sld = 1024; doff = WL_BRA; break;
    case 2: src = p.in[I_WBG] + (size_t)l * 512 * 1024; K = 512; sld = 1024; doff = WL_BRG; break;
    case 3: src = p.in[I_WBS] + (size_t)l * 256 * 1024; K = 256; sld = 1024; doff = WL_BRS; break;
    case 4: src = p.in[I_WOUT] + (size_t)l * 1024 * 1024; K = 1024; sld = 1024; doff = WL_WOUT; break;
    case 5: src = p.in[I_UP] + (size_t)l * 1024 * 5632; K = 1024; sld = 5632; doff = WL_UP; break;
    case 6: src = p.in[I_DOWN] + (size_t)l * 2816 * 1024; K = 2816; sld = 1024; doff = WL_DOWN; break;
    default: src = p.in[I_GLUW] + (size_t)l * 256 * 256; K = 256; sld = 256; doff = WL_GLU; break;
  }
  const int kt = K / 64;
  const int n0 = (r / kt) * 64, k0 = (r % kt) * 64;
  const int tid = TIDX;
  {
    const int nn = tid & 63;
    const int np = n0 + nn;
    int col;
    if (mat == 0) {
      if (np < 2048) col = np;
      else if (np < 2304) col = 2080 + (np - 2048);
      else if (np < 2336) col = 2048 + (np - 2304);
      else if (np < 2432) col = -1;
      else col = 2336 + (np - 2432);
    } else if (mat == 5) {
      const int jb = np >> 7, c = np & 127;
      col = (c < 64) ? (jb * 64 + c) : (DFF + jb * 64 + (c - 64));
    } else col = np;
#pragma unroll 4
    for (int kk = tid >> 6; kk < 64; kk += 4) tile[kk * 65 + nn] = (col >= 0) ? src[(size_t)(k0 + kk) * sld + col] : 0.f;
  }
  __syncthreads();
  {
    const int nn = tid >> 2, kq = (tid & 3) * 16;
    bf16* d = wl(p, l, doff) + (size_t)(n0 + nn) * K + k0 + kq;
    u32x4 v0, v1;
#pragma unroll
    for (int e = 0; e < 4; ++e) {
      v0[e] = pack2(tile[(kq + 2 * e) * 65 + nn], tile[(kq + 2 * e + 1) * 65 + nn]);
      v1[e] = pack2(tile[(kq + 8 + 2 * e) * 65 + nn], tile[(kq + 8 + 2 * e + 1) * 65 + nn]);
    }
    *(u32x4*)d = v0;
    *(u32x4*)(d + 8) = v1;
  }
  __syncthreads();
}

template <int MODE>
DI void row_job(const Params& p, int l, int tok) {
  const int lane = TIDX & 63;
  float x[16];
  float* xr = resid_row(p, tok);
  if (MODE == 0) {
    const int b = tok / TT, t = tok - b * TT;
    const float* src = (t < CTXL) ? p.in[I_CTX] + ((size_t)b * CTXL + t) * DM : p.in[I_X] + ((size_t)b * SEQ + (t - CTXL)) * DM;
#pragma unroll
    for (int i = 0; i < 4; ++i) {
      const f32x4 v = *(const f32x4*)(src + lane * 4 + 256 * i);
      x[4 * i] = v[0]; x[4 * i + 1] = v[1]; x[4 * i + 2] = v[2]; x[4 * i + 3] = v[3];
      *(f32x4*)(xr + lane * 4 + 256 * i) = v;
    }
  } else {
    const bf16* yr = (const bf16*)(p.ws + OFF_H) + (size_t)tok * DM;
    const float* gpost = p.in[MODE == 1 ? I_NMPOST : I_NFPOST] + l * DM;
    const float* mg = mod_vec(p, l, tok, MODE == 1 ? 2 : 5);
    float y[16];
    float ss = 0.f;
#pragma unroll
    for (int i = 0; i < 4; ++i) {
      const u32x2 u = *(const u32x2*)(yr + lane * 4 + 256 * i);
      y[4 * i] = bflo(u[0]); y[4 * i + 1] = bfhi(u[0]); y[4 * i + 2] = bflo(u[1]); y[4 * i + 3] = bfhi(u[1]);
#pragma unroll
      for (int e = 0; e < 4; ++e) ss += y[4 * i + e] * y[4 * i + e];
    }
    ss = wave_sum(ss);
    const float rstd = rsqrtf(ss * (1.f / DM) + EPSF);
#pragma unroll
    for (int i = 0; i < 4; ++i) {
      f32x4 v = *(const f32x4*)(xr + lane * 4 + 256 * i);
      const f32x4 g = *(const f32x4*)(gpost + lane * 4 + 256 * i);
      const f32x4 m = *(const f32x4*)(mg + lane * 4 + 256 * i);
#pragma unroll
      for (int e = 0; e < 4; ++e) { v[e] += m[e] * (y[4 * i + e] * rstd * g[e]); x[4 * i + e] = v[e]; }
      *(f32x4*)(xr + lane * 4 + 256 * i) = v;
    }
  }
  if (MODE == 2 && l == NL - 1) return;
  const int ln = (MODE == 2) ? l + 1 : l;
  const float* gpre = p.in[MODE == 1 ? I_NFPRE : I_NMPRE] + ln * DM;
  const float* sh = mod_vec(p, ln, tok, MODE == 1 ? 3 : 0);
  const float* scv = mod_vec(p, ln, tok, MODE == 1 ? 4 : 1);
  float ss = 0.f;
#pragma unroll
  for (int i = 0; i < 16; ++i) ss += x[i] * x[i];
  ss = wave_sum(ss);
  const float rstd = rsqrtf(ss * (1.f / DM) + EPSF);
  bf16* hr = (bf16*)(p.ws + OFF_H) + (size_t)tok * DM;
#pragma unroll
  for (int i = 0; i < 4; ++i) {
    const f32x4 g = *(const f32x4*)(gpre + lane * 4 + 256 * i);
    const f32x4 s1 = *(const f32x4*)(sh + lane * 4 + 256 * i);
    const f32x4 s2 = *(const f32x4*)(scv + lane * 4 + 256 * i);
    float o[4];
#pragma unroll
    for (int e = 0; e < 4; ++e) o[e] = (x[4 * i + e] * rstd * g[e]) * (1.f + s2[e]) + s1[e];
    u32x2 u;
    u[0] = pack2(o[0], o[1]); u[1] = pack2(o[2], o[3]);
    *(u32x2*)(hr + lane * 4 + 256 * i) = u;
  }
}

template <int MODE>
DI void row_phase(const Params& p, int l, int bid, int G) {
  const int lane = TIDX & 63;
  const int wg = bid * 4 + (TIDX >> 6), nw = G * 4;
  const int R = (NTOK + nw - 1) / nw;
  const int t0 = wg * R, t1 = min(NTOK, t0 + R);
  if (t0 >= t1) return;
  const bool has_next = !(MODE == 2 && l == NL - 1);
  const int ln = (MODE == 2) ? l + 1 : l;
  f32x4 gpost[4], gpre[4], mg[4], sh[4], scl[4];
#pragma unroll
  for (int i = 0; i < 4; ++i) {
    if (MODE != 0) gpost[i] = *(const f32x4*)(p.in[MODE == 1 ? I_NMPOST : I_NFPOST] + l * DM + lane * 4 + 256 * i);
    if (has_next) gpre[i] = *(const f32x4*)(p.in[MODE == 1 ? I_NFPRE : I_NMPRE] + ln * DM + lane * 4 + 256 * i);
  }
  int cur_m = -1;
  u32x2 yb[4], yn[4];
  f32x4 xb[4], xn[4];
  const bf16* Hb = (const bf16*)(p.ws + OFF_H);
#define ROW_LOAD(TOK, YY, XX)                                                                              \
  {                                                                                                        \
    const int b_ = (TOK) / TT, t_ = (TOK) - b_ * TT;                                                       \
    const float* src_ = (MODE == 0) ? ((t_ < CTXL) ? p.in[I_CTX] + ((size_t)b_ * CTXL + t_) * DM           \
                                                   : p.in[I_X] + ((size_t)b_ * SEQ + (t_ - CTXL)) * DM)    \
                                    : resid_row(p, (TOK));                                                 \
    _Pragma("unroll") for (int i = 0; i < 4; ++i) {                                                        \
      XX[i] = *(const f32x4*)(src_ + lane * 4 + 256 * i);                                                  \
      if (MODE != 0) YY[i] = *(const u32x2*)(Hb + (size_t)(TOK) * DM + lane * 4 + 256 * i);                \
    }                                                                                                      \
  }
  ROW_LOAD(t0, yb, xb)
  for (int tok = t0; tok < t1; ++tok) {
    if (tok + 1 < t1) ROW_LOAD(tok + 1, yn, xn)
    const int b = tok / TT, t = tok - b * TT;
    const int m = (t < CTXL) ? 4 : b;
    if (m != cur_m) {
      cur_m = m;
      const float* Mv = (const float*)(p.ws + OFF_MOD);
#pragma unroll
      for (int i = 0; i < 4; ++i) {
        if (MODE != 0) mg[i] = *(const f32x4*)(Mv + ((size_t)(l * 5 + m) * 6 + (MODE == 1 ? 2 : 5)) * DM + lane * 4 + 256 * i);
        if (has_next) {
          sh[i] = *(const f32x4*)(Mv + ((size_t)(ln * 5 + m) * 6 + (MODE == 1 ? 3 : 0)) * DM + lane * 4 + 256 * i);
          scl[i] = *(const f32x4*)(Mv + ((size_t)(ln * 5 + m) * 6 + (MODE == 1 ? 4 : 1)) * DM + lane * 4 + 256 * i);
        }
      }
    }
    float* xr = resid_row(p, tok);
    f32x4 x[4];
    if (MODE == 0) {
#pragma unroll
      for (int i = 0; i < 4; ++i) { x[i] = xb[i]; *(f32x4*)(xr + lane * 4 + 256 * i) = x[i]; }
    } else {
      float y[16];
      float ss = 0.f;
#pragma unroll
      for (int i = 0; i < 4; ++i) {
        y[4 * i] = bflo(yb[i][0]); y[4 * i + 1] = bfhi(yb[i][0]); y[4 * i + 2] = bflo(yb[i][1]); y[4 * i + 3] = bfhi(yb[i][1]);
#pragma unroll
        for (int e = 0; e < 4; ++e) ss += y[4 * i + e] * y[4 * i + e];
      }
      ss = wave_sum(ss);
      const float rstd = rsqrtf(ss * (1.f / DM) + EPSF);
#pragma unroll
      for (int i = 0; i < 4; ++i) {
        f32x4 v = xb[i];
#pragma unroll
        for (int e = 0; e < 4; ++e) v[e] += mg[i][e] * (y[4 * i + e] * rstd * gpost[i][e]);
        x[i] = v;
        *(f32x4*)(xr + lane * 4 + 256 * i) = v;
      }
    }
    if (has_next) {
      float ss = 0.f;
#pragma unroll
      for (int i = 0; i < 4; ++i)
#pragma unroll
        for (int e = 0; e < 4; ++e) ss += x[i][e] * x[i][e];
      ss = wave_sum(ss);
      const float rstd = rsqrtf(ss * (1.f / DM) + EPSF);
      bf16* hr = (bf16*)(p.ws + OFF_H) + (size_t)tok * DM;
#pragma unroll
      for (int i = 0; i < 4; ++i) {
        float o[4];
#pragma unroll
        for (int e = 0; e < 4; ++e) o[e] = (x[i][e] * rstd * gpre[i][e]) * (1.f + scl[i][e]) + sh[i][e];
        u32x2 u;
        u[0] = pack2(o[0], o[1]); u[1] = pack2(o[2], o[3]);
        *(u32x2*)(hr + lane * 4 + 256 * i) = u;
      }
    }
#pragma unroll
    for (int i = 0; i < 4; ++i) { yb[i] = yn[i]; xb[i] = xn[i]; }
  }
#undef ROW_LOAD
}

DI void ktab_phase(const Params& p, int bid, int G, int l_lo, int l_hi) {
  const float* BBR = (const float*)(p.ws + OFF_BBR);
  const float* BBI = (const float*)(p.ws + OFF_BBI);
  const float2* PW = (const float2*)(p.ws + OFF_PWR);
  float* KT = (float*)(p.ws + OFF_KTAB);
  const int per_layer = 16 * 2 * 32 * 256;
  for (int idx = l_lo * per_layer + bid * 256 + TIDX; idx < l_hi * per_layer; idx += G * 256) {
    const int hp = idx & 15, hh = (idx >> 4) & 15, tau = (idx >> 8) & 31, d = (idx >> 13) & 1, g = (idx >> 14) & 15, l = idx >> 18;
    const int ldg = (l * 2 + d) * 16 + g;
    const float* cre = p.in[I_CRE] + ((size_t)ldg * 16 + hh) * 64;
    const float* cim = p.in[I_CIM] + ((size_t)ldg * 16 + hh) * 64;
    float acc = 0.f;
    for (int pp = 0; pp < 64; ++pp) {
      const float2 pw = PW[((size_t)ldg * 33 + tau) * 64 + pp];
      const float br = BBR[((size_t)ldg * 64 + pp) * 16 + hp], bi = BBI[((size_t)ldg * 64 + pp) * 16 + hp];
      const float zr = pw.x * br - pw.y * bi, zi = pw.x * bi + pw.y * br;
      acc += cre[pp] * zr - cim[pp] * zi;
    }
    KT[idx] = acc;
  }
}

DI void s5mat_phase(const Params& p, int l, int bid, int G) {
  const float* BBR = (const float*)(p.ws + OFF_BBR);
  const float* BBI = (const float*)(p.ws + OFF_BBI);
  const float2* PW = (const float2*)(p.ws + OFF_PWR);
  const float* KT = (const float*)(p.ws + OFF_KTAB);
  bf16* T5 = (bf16*)(p.ws + OFF_T5);
  bf16* E5 = (bf16*)(p.ws + OFF_E5);
  bf16* F5 = (bf16*)(p.ws + OFF_F5);
  const int nT = 16 * 512 * 64, nE = 16 * 512 * 32, nF = 16 * 256 * 64;
  for (int it = bid * 256 + TIDX; it < nT + nE + nF; it += G * 256) {
    float v[8];
    bf16* dst;
    if (it < nT) {
      const int k8 = it & 63, n = (it >> 6) & 511, g = it >> 15;
      const int i = n >> 4, hh = n & 15, j = k8 >> 1, hp0 = (k8 & 1) * 8;
#pragma unroll
      for (int e = 0; e < 8; ++e) {
        const int hp = hp0 + e;
        float a = 0.f;
        if (j <= i) a += KT[((((size_t)l * 16 + g) * 2 + 0) * 32 + (i - j)) * 256 + hh * 16 + hp];
        if (j >= i) a += KT[((((size_t)l * 16 + g) * 2 + 1) * 32 + (j - i)) * 256 + hh * 16 + hp];
        if (i == j && hh == hp) a += p.in[I_S5D][l * 256 + g * 16 + hh];
        v[e] = a;
      }
      dst = T5 + ((size_t)g * 512 + n) * 512 + k8 * 8;
    } else if (it < nT + nE) {
      const int q = it - nT;
      const int k8 = q & 31, n = (q >> 5) & 511, g = q >> 14;
      const int i = n >> 4, hh = n & 15;
      const int k0 = k8 * 8, d = k0 >> 7, ri = (k0 >> 6) & 1, p0 = k0 & 63;
      const int ldg = (l * 2 + d) * 16 + g;
      const int ex = d ? (32 - i) : (i + 1);
#pragma unroll
      for (int e = 0; e < 8; ++e) {
        const int pp = p0 + e;
        const float2 pw = PW[((size_t)ldg * 33 + ex) * 64 + pp];
        const float cr = p.in[I_CRE][((size_t)ldg * 16 + hh) * 64 + pp], ci = p.in[I_CIM][((size_t)ldg * 16 + hh) * 64 + pp];
        const float zr = cr * pw.x - ci * pw.y, zi = cr * pw.y + ci * pw.x;
        v[e] = ri ? -zi : zr;
      }
      dst = E5 + ((size_t)g * 512 + n) * 256 + k0;
    } else {
      const int q = it - nT - nE;
      const int k8 = q & 63, n = (q >> 6) & 255, g = q >> 14;
      const int d = n >> 7, ri = (n >> 6) & 1, pp = n & 63;
      const int j = k8 >> 1, hp0 = (k8 & 1) * 8;
      const int ldg = (l * 2 + d) * 16 + g;
      const int ex = d ? j : (31 - j);
      const float2 pw = PW[((size_t)ldg * 33 + ex) * 64 + pp];
#pragma unroll
      for (int e = 0; e < 8; ++e) {
        const float br = BBR[((size_t)ldg * 64 + pp) * 16 + hp0 + e], bi = BBI[((size_t)ldg * 64 + pp) * 16 + hp0 + e];
        v[e] = ri ? (pw.x * bi + pw.y * br) : (pw.x * br - pw.y * bi);
      }
      dst = F5 + ((size_t)g * 256 + n) * 512 + k8 * 8;
    }
    u32x4 u;
    u[0] = pack2(v[0], v[1]); u[1] = pack2(v[2], v[3]); u[2] = pack2(v[4], v[5]); u[3] = pack2(v[6], v[7]);
    *(u32x4*)dst = u;
  }
}

DI void proj_epi(const Params& p, int l, int mt, int nt, char* smem);
DI void proj_wide(const Params& p, int l, int mt, int np, char* smem) {
  const bf16* H = (const bf16*)(p.ws + OFF_H) + (size_t)mt * 128 * DM;
  const bf16* W = wl(p, l, WL_WIN) + (size_t)np * 256 * DM;
  if (np == 9) {
    f32x16 acc1[2][2];
    acc_zero(acc1);
    gemm_main_dma(acc1, [&](int r) { return H + (size_t)r * DM; }, [&](int r) { return W + (size_t)r * DM; }, DM, smem);
    acc_to_lds(acc1, (float*)smem);
    __syncthreads();
    proj_epi(p, l, mt, 18, smem);
    return;
  }
  f32x16 acc[2][4];
  accw_zero(acc);
  gemm_wide(acc, [&](int r) { return H + (size_t)r * DM; }, [&](int r) { return W + (size_t)r * DM; }, DM, smem);
  float* Cs = (float*)smem;
  accw_to_lds<0>(acc, Cs);
  __syncthreads();
  proj_epi(p, l, mt, np * 2, smem);
  if (np * 2 + 1 < 19) {
    accw_to_lds<1>(acc, Cs);
    __syncthreads();
    proj_epi(p, l, mt, np * 2 + 1, smem);
  }
}
DI void proj_epi(const Params& p, int l, int mt, int nt, char* smem) {
  float* Cs = (float*)smem;
  const int tid = TIDX;
  const int tok0 = mt * 128;
  const int b = tok0 / TT, t0 = tok0 - b * TT;
  if (nt <= 2) {
    const int row = tid >> 1, seg = tid & 1;
    float* c = Cs + row * CLD + seg * 64;
    const float* gn = p.in[nt < 2 ? I_QN : I_KN] + l * 64;
    float ss = 0.f;
#pragma unroll 8
    for (int i = 0; i < 64; ++i) ss += c[i] * c[i];
    const float rstd = rsqrtf(ss * (1.f / 64.f) + EPSF);
    const int t = t0 + row;
    const bool lat = t >= CTXL;
    const int s = t - CTXL;
#pragma unroll 1
    for (int ax = 0; ax < 2; ++ax) {
      const float pos = (float)(ax ? (s & 63) : (s >> 6));
#pragma unroll 2
      for (int f = 0; f < 16; ++f) {
        float x1 = c[ax * 32 + f] * rstd * gn[ax * 32 + f];
        float x2 = c[ax * 32 + 16 + f] * rstd * gn[ax * 32 + 16 + f];
        if (lat) {
          const float invf = exp2f(-(float)f * (13.287712379549449f / 16.f));
          float sn, cs;
          sincos_cw(pos * invf, sn, cs);
          const float y1 = x1 * cs - x2 * sn, y2 = x2 * cs + x1 * sn;
          x1 = y1; x2 = y2;
        }
        c[ax * 32 + f] = x1;
        c[ax * 32 + 16 + f] = x2;
      }
    }
    __syncthreads();
    if (nt < 2) store_tile_bf16(Cs, (bf16*)(p.ws + OFF_Q) + (size_t)tok0 * 256 + nt * 128, 256, 128, 0.125f * 1.4426950408889634f);
    else store_tile_bf16(Cs, (bf16*)(p.ws + OFF_K) + (size_t)tok0 * 128, 128, 128, 1.f);
  } else if (nt == 3 || (nt >= 8 && nt <= 11)) {
    for (int c = tid; c < 2048; c += 256) {
      const int col = c & 127, rc = (c >> 7) * 8;
      u32x4 u;
#pragma unroll
      for (int e = 0; e < 4; ++e) u[e] = pack2(Cs[(rc + 2 * e) * CLD + col], Cs[(rc + 2 * e + 1) * CLD + col]);
      bf16* dst;
      if (nt == 3) dst = (bf16*)(p.ws + OFF_VT) + ((size_t)(b * 2 + (col >> 6)) * 64 + (col & 63)) * TT + t0 + rc;
      else dst = (bf16*)(p.ws + OFF_GVT) + ((size_t)(b * 4 + (nt - 8)) * 128 + col) * TT + t0 + rc;
      *(u32x4*)dst = u;
    }
  } else if (nt == 4 || nt == 5) {
    store_tile_bf16(Cs, (bf16*)(p.ws + OFF_GQ) + (size_t)tok0 * 256 + (nt - 4) * 128, 256, 128, 0.125f);
  } else if (nt == 6 || nt == 7) {
    store_tile_bf16(Cs, (bf16*)(p.ws + OFF_GK) + (size_t)tok0 * 256 + (nt - 6) * 128, 256, 128, 1.f);
  } else if (nt >= 12 && nt <= 15) {
    store_tile_bf16(Cs, (bf16*)(p.ws + OFF_GR) + (size_t)tok0 * 512 + (nt - 12) * 128, 512, 128, 1.f);
  } else if (nt == 16 || nt == 17) {
    for (int c = tid; c < 2048; c += 256) {
      const int row = c >> 4, c8 = c & 15;
      const float* s = Cs + row * CLD + c8 * 8;
      u32x4 u;
#pragma unroll
      for (int e = 0; e < 4; ++e) u[e] = pack2(s[2 * e], s[2 * e + 1]);
      const int ch = (nt - 16) * 128 + c8 * 8;
      bf16* dst = (bf16*)(p.ws + OFF_SU) + ((size_t)(b * 16 + (ch >> 4)) * TT + t0 + row) * 16 + (ch & 15);
      *(u32x4*)dst = u;
    }
  } else {
    for (int c = tid; c < 128 * 8; c += 256) {
      const int row = c >> 3, c4 = (c & 7) * 4;
      const float* s = Cs + row * CLD + c4;
      f32x4 v = {s[0], s[1], s[2], s[3]};
      *(f32x4*)((float*)(p.ws + OFF_LOW) + (size_t)(tok0 + row) * 32 + c4) = v;
    }
  }
  __syncthreads();
}

DI void attn_unit(const Params& p, int u, char* smem) {
  int b, head, tok0, nkt;
  if (u < 1024) { b = u >> 8; head = (u >> 6) & 3; tok0 = b * TT + CTXL + (u & 63) * 128; nkt = TT / 128; }
  else { const int v = u - 1024; b = v >> 3; head = (v >> 1) & 3; tok0 = b * TT + (v & 1) * 128; nkt = CTXL / 128; }
  const int kvh = head >> 1;
  const int tid = TIDX, lane = tid & 63, w = tid >> 6, r = lane & 31, h = lane >> 5;
  const bf16* Qp = (const bf16*)(p.ws + OFF_Q) + (size_t)(tok0 + w * 32 + r) * 256 + head * 64 + h * 8;
  s16x8 qf[4];
#pragma unroll
  for (int s = 0; s < 4; ++s) qf[s] = __builtin_bit_cast(s16x8, ldg16(Qp + s * 16));
  const bf16* kp[2];
  const bf16* vp[2];
#pragma unroll
  for (int i = 0; i < 2; ++i) {
    const int row = w * 16 + i * 8 + (lane >> 3);
    const int c = (lane & 7) ^ ((row >> 1) & 7);
    kp[i] = (const bf16*)(p.ws + OFF_K) + ((size_t)b * TT + row) * 128 + kvh * 64 + c * 8;
    vp[i] = (const bf16*)(p.ws + OFF_VT) + ((size_t)(b * 2 + kvh) * 64 + row) * TT + c * 8;
  }
  const int ldst = (w * 128 + lane) * 16;
#define AT_DMA(BUF, T)                                                                                              \
  {                                                                                                                 \
    char* sb_ = smem + (BUF) * 32768;                                                                               \
    _Pragma("unroll") for (int hh = 0; hh < 2; ++hh)                                                                \
    _Pragma("unroll") for (int i = 0; i < 2; ++i) {                                                                 \
      __builtin_amdgcn_global_load_lds((const unsigned*)(kp[i] + (size_t)((T) * 128 + hh * 64) * 128), (unsigned*)(sb_ + hh * 8192 + ldst + i * 1024), 16, 0, 0); \
      __builtin_amdgcn_global_load_lds((const unsigned*)(vp[i] + (T) * 128 + hh * 64), (unsigned*)(sb_ + 16384 + hh * 8192 + ldst + i * 1024), 16, 0, 0);        \
    }                                                                                                               \
  }
  const int xr = (r >> 1) & 7;
  AT_DMA(0, 0)
  asm volatile("s_waitcnt vmcnt(0)" ::: "memory");
  __syncthreads();
  f32x16 oacc[2];
#pragma unroll
  for (int i = 0; i < 16; ++i) { oacc[0][i] = 0.f; oacc[1][i] = 0.f; }
  float mrow = -INFINITY, lrow = 0.f;
  for (int kt = 0; kt < nkt; ++kt) {
    const int buf = kt & 1;
    if (kt + 1 < nkt) AT_DMA(buf ^ 1, kt + 1)
    const char* Kb = smem + buf * 32768;
    const char* Vb = Kb + 16384;
    f32x16 sacc[4];
#pragma unroll
    for (int q = 0; q < 4; ++q)
#pragma unroll
      for (int i = 0; i < 16; ++i) sacc[q][i] = 0.f;
#pragma unroll
    for (int s = 0; s < 4; ++s) {
      const int co = ((2 * s + h) ^ xr) * 16;
#pragma unroll
      for (int q = 0; q < 4; ++q) {
        const s16x8 a = *(const s16x8*)(Kb + (q >> 1) * 8192 + ((q & 1) * 32 + r) * 128 + co);
        sacc[q] = MFMA32(a, qf[s], sacc[q]);
      }
    }
    float mx = sacc[0][0];
#pragma unroll
    for (int q = 0; q < 4; ++q)
#pragma unroll
      for (int i = 0; i < 16; ++i) mx = fmaxf(mx, sacc[q][i]);
    mx = fmaxf(mx, __shfl_xor(mx, 32, 64));
    const float mnew = fmaxf(mrow, mx);
    const float alpha = __builtin_amdgcn_exp2f(mrow - mnew);
    mrow = mnew;
    float psum = 0.f;
#pragma unroll
    for (int q = 0; q < 4; ++q)
#pragma unroll
      for (int i = 0; i < 16; ++i) { sacc[q][i] = __builtin_amdgcn_exp2f(sacc[q][i] - mnew); psum += sacc[q][i]; }
    lrow = lrow * alpha + psum;
#pragma unroll
    for (int i = 0; i < 16; ++i) { oacc[0][i] *= alpha; oacc[1][i] *= alpha; }
#pragma unroll
    for (int q = 0; q < 4; ++q)
#pragma unroll
      for (int s2 = 0; s2 < 2; ++s2) {
        u32x4 pu;
#pragma unroll
        for (int e = 0; e < 4; ++e) pu[e] = pack2(sacc[q][8 * s2 + 2 * e], sacc[q][8 * s2 + 2 * e + 1]);
        const s16x8 pf = __builtin_bit_cast(s16x8, pu);
        const int c0 = (q & 1) * 4 + 2 * s2;
        const int o0 = ((c0 ^ xr) * 16) + 8 * h, o1 = (((c0 + 1) ^ xr) * 16) + 8 * h;
#pragma unroll
        for (int dt = 0; dt < 2; ++dt) {
          const s16x4 lo = *(const s16x4*)(Vb + (q >> 1) * 8192 + (dt * 32 + r) * 128 + o0);
          const s16x4 hi = *(const s16x4*)(Vb + (q >> 1) * 8192 + (dt * 32 + r) * 128 + o1);
          const s16x8 a = __builtin_shufflevector(lo, hi, 0, 1, 2, 3, 4, 5, 6, 7);
          oacc[dt] = MFMA32(a, pf, oacc[dt]);
        }
      }
    asm volatile("s_waitcnt vmcnt(0)" ::: "memory");
    __syncthreads();
  }
#undef AT_DMA
  const float ltot = lrow + __shfl_xor(lrow, 32, 64);
  const float inv = 1.f / ltot;
  bf16* Op = (bf16*)(p.ws + OFF_OATT) + (size_t)(tok0 + w * 32 + r) * 256 + head * 64;
#pragma unroll
  for (int dt = 0; dt < 2; ++dt)
#pragma unroll
    for (int i = 0; i < 16; i += 4) {
      u32x2 uu;
      uu[0] = pack2(oacc[dt][i] * inv, oacc[dt][i + 1] * inv);
      uu[1] = pack2(oacc[dt][i + 2] * inv, oacc[dt][i + 3] * inv);
      *(u32x2*)(Op + dt * 32 + crow(i, h)) = uu;
    }
}

constexpr int GL_LOW = 0, GL_TOT = 4096, GL_DEC = 5120, GL_QIN = 5376, GL_KIN = 14592, GL_KET = 23808, GL_OST = 0,
              GL_VT = 33792, GL_ST = 52224;
static_assert(GL_ST + 128 * LDT * 2 <= SMEM_BYTES, "gla lds");

template <bool WITH_OUT>
DI void gla_unit(const Params& p, int l, int u, char* smem) {
  float* lowt = (float*)(smem + GL_LOW);
  float* tots = (float*)(smem + GL_TOT);
  float* decs = (float*)(smem + GL_DEC);
  bf16* qin = (bf16*)(smem + GL_QIN);
  bf16* kin = (bf16*)(smem + GL_KIN);
  bf16* ket = (bf16*)(smem + GL_KET);
  float* ost = (float*)(smem + GL_OST);
  bf16* vts = (bf16*)(smem + GL_VT);
  bf16* sts = (bf16*)(smem + GL_ST);
  const int tid = TIDX, lane = tid & 63, w = tid >> 6, r = lane & 31, h = lane >> 5;
  int b, hd, gi, dir0, ndir;
  if (WITH_OUT) { gi = u % NG33; hd = (u / NG33) & 3; b = u / (NG33 * 4); dir0 = 1; ndir = 2; }
  else { gi = u % NG33; const int v = u / NG33; dir0 = v & 1; hd = (v >> 1) & 3; b = v >> 3; ndir = 1; }
  const int dk = tid & 63, part = tid >> 6;
  const bf16* GQ = (const bf16*)(p.ws + OFF_GQ);
  const bf16* GK = (const bf16*)(p.ws + OFF_GK);
  const bf16* GVT = (const bf16*)(p.ws + OFF_GVT) + (size_t)(b * 4 + hd) * 128 * TT;
  const float* LOW = (const float*)(p.ws + OFF_LOW);
  for (int dd = 0; dd < ndir; ++dd) {
    const int dir = WITH_OUT ? (dir0 - dd) : dir0;
    float* GSu = (float*)(p.ws + OFF_GS) + ((size_t)((b * 4 + hd) * 2 + dir) * NG33 + gi) * 8192;
    float gwreg[16];
#pragma unroll
    for (int rr = 0; rr < 16; ++rr) gwreg[rr] = p.in[I_GGW][((size_t)(l * 2 + dir) * 16 + rr) * 256 + hd * 64 + dk];
    const float gb = p.in[I_GGB][(l * 2 + dir) * 256 + hd * 64 + dk];
    f32x16 sacc[2];
    if (WITH_OUT) {
#pragma unroll
      for (int dkt = 0; dkt < 2; ++dkt)
#pragma unroll
        for (int i = 0; i < 16; ++i) {
          const float v = GSu[(w * 32 + crow(i, h)) * 64 + dkt * 32 + r];
          sacc[dkt][i] = v;
          sts[(w * 32 + crow(i, h)) * LDT + dkt * 32 + r] = f2bf(v);
        }
    } else {
#pragma unroll
      for (int i = 0; i < 16; ++i) { sacc[0][i] = 0.f; sacc[1][i] = 0.f; }
    }
    float gtot = 0.f;
    for (int cc = 0; cc < 4; ++cc) {
      const int ci = dir ? 3 - cc : cc;
      const int tb = gi * 256 + ci * 64;
      const size_t tokb = (size_t)b * TT + tb;
      {
        const int row = tid >> 2, c4 = (tid & 3) * 4;
        const u32x4 lw = ldg16(LOW + (tokb + row) * 32 + dir * 16 + c4);
        u32x4 vv[4], kq[2], qq[2];
#pragma unroll
        for (int i = 0; i < 4; ++i) {
          const int c = tid + 256 * i, e = c >> 3, k8 = (c & 7) * 8;
          vv[i] = ldg16(GVT + (size_t)e * TT + tb + k8);
        }
#pragma unroll
        for (int i = 0; i < 2; ++i) {
          const int c = tid + 256 * i, rw = c >> 3, k8 = (c & 7) * 8;
          kq[i] = ldg16(GK + (tokb + rw) * 256 + hd * 64 + k8);
          if (WITH_OUT) qq[i] = ldg16(GQ + (tokb + rw) * 256 + hd * 64 + k8);
        }
        *(u32x4*)(lowt + row * 16 + c4) = lw;
#pragma unroll
        for (int i = 0; i < 4; ++i) {
          const int c = tid + 256 * i, e = c >> 3, k8 = (c & 7) * 8;
          *(u32x4*)(vts + e * LDT + k8) = vv[i];
        }
#pragma unroll
        for (int i = 0; i < 2; ++i) {
          const int c = tid + 256 * i, rw = c >> 3, k8 = (c & 7) * 8;
          *(u32x4*)(kin + rw * LDT + k8) = kq[i];
          if (WITH_OUT) *(u32x4*)(qin + rw * LDT + k8) = qq[i];
        }
      }
      __syncthreads();
      float cum = 0.f;
#pragma unroll 2
      for (int ii = 0; ii < 16; ++ii) {
        const int pos = part * 16 + ii, t = dir ? 63 - pos : pos;
        float z = gb;
#pragma unroll
        for (int rr = 0; rr < 16; ++rr) z += lowt[t * 16 + rr] * gwreg[rr];
        cum += (fminf(z, 0.f) - log1pf(__expf(-fabsf(z)))) * (1.f / 16.f);
      }
      tots[part * 64 + dk] = cum;
      __syncthreads();
      float offs = 0.f, total = 0.f;
#pragma unroll
      for (int pp = 0; pp < 4; ++pp) { const float tv = tots[pp * 64 + dk]; total += tv; if (pp < part) offs += tv; }
      if (part == 0) decs[dk] = __expf(total);
      gtot += total;
      float bq = offs;
#pragma unroll 2
      for (int ii = 0; ii < 16; ++ii) {
        const int pos = part * 16 + ii, t = dir ? 63 - pos : pos;
        float z = gb;
#pragma unroll
        for (int rr = 0; rr < 16; ++rr) z += lowt[t * 16 + rr] * gwreg[rr];
        bq += (fminf(z, 0.f) - log1pf(__expf(-fabsf(z)))) * (1.f / 16.f);
        const float kv = bf2f(kin[t * LDT + dk]);
        ket[dk * LDT + t] = f2bf(kv * __expf(total - bq));
        if (WITH_OUT) {
          const float qv = bf2f(qin[t * LDT + dk]);
          qin[t * LDT + dk] = f2bf(qv * __expf(bq));
          kin[t * LDT + dk] = f2bf(kv * __expf(-bq));
        }
      }
      __syncthreads();
      f32x16 oo[2];
      const int it = w & 1, ep = w >> 1;
      if (WITH_OUT) {
        const int ti = w >> 1, tj = w & 1;
        f32x16 aa;
#pragma unroll
        for (int i = 0; i < 16; ++i) aa[i] = 0.f;
#pragma unroll
        for (int s = 0; s < 4; ++s) {
          const s16x8 A = *(const s16x8*)(qin + (ti * 32 + r) * LDT + s * 16 + h * 8);
          const s16x8 Bv = *(const s16x8*)(kin + (tj * 32 + r) * LDT + s * 16 + h * 8);
          aa = MFMA32(A, Bv, aa);
        }
        __syncthreads();
#pragma unroll
        for (int i = 0; i < 16; ++i) {
          const int qi = ti * 32 + crow(i, h), kj = tj * 32 + r;
          const bool keep = dir ? (kj >= qi) : (kj <= qi);
          kin[qi * LDT + kj] = f2bf(keep ? aa[i] : 0.f);
        }
        __syncthreads();
#pragma unroll
        for (int i = 0; i < 16; ++i) { oo[0][i] = 0.f; oo[1][i] = 0.f; }
#pragma unroll
        for (int s = 0; s < 4; ++s) {
          const s16x8 A1 = *(const s16x8*)(kin + (it * 32 + r) * LDT + s * 16 + h * 8);
          const s16x8 A2 = *(const s16x8*)(qin + (it * 32 + r) * LDT + s * 16 + h * 8);
#pragma unroll
          for (int x = 0; x < 2; ++x) {
            const int et = 2 * ep + x;
            const s16x8 B1 = *(const s16x8*)(vts + (et * 32 + r) * LDT + s * 16 + h * 8);
            const s16x8 B2 = *(const s16x8*)(sts + (et * 32 + r) * LDT + s * 16 + h * 8);
            oo[x] = MFMA32(A1, B1, oo[x]);
            oo[x] = MFMA32(A2, B2, oo[x]);
          }
        }
      }
#pragma unroll
      for (int dkt = 0; dkt < 2; ++dkt) {
        const float dv = decs[dkt * 32 + r];
#pragma unroll
        for (int i = 0; i < 16; ++i) sacc[dkt][i] *= dv;
      }
#pragma unroll
      for (int s = 0; s < 4; ++s) {
        const s16x8 A = *(const s16x8*)(vts + (w * 32 + r) * LDT + s * 16 + h * 8);
#pragma unroll
        for (int dkt = 0; dkt < 2; ++dkt) {
          const s16x8 Bv = *(const s16x8*)(ket + (dkt * 32 + r) * LDT + s * 16 + h * 8);
          sacc[dkt] = MFMA32(A, Bv, sacc[dkt]);
        }
      }
      __syncthreads();
      if (WITH_OUT) {
#pragma unroll
        for (int dkt = 0; dkt < 2; ++dkt)
#pragma unroll
          for (int i = 0; i < 16; ++i) sts[(w * 32 + crow(i, h)) * LDT + dkt * 32 + r] = f2bf(sacc[dkt][i]);
#pragma unroll
        for (int x = 0; x < 2; ++x)
#pragma unroll
          for (int i = 0; i < 16; ++i) ost[(it * 32 + crow(i, h)) * CLD + (2 * ep + x) * 32 + r] = oo[x][i];
        __syncthreads();
        const int row = tid >> 2, qd = tid & 3;
        const size_t tok = tokb + row;
        bf16* og = (bf16*)(p.ws + OFF_OGLA) + tok * 512 + hd * 128 + qd * 32;
        const float* os = ost + row * CLD + qd * 32;
        if (dir == 1) {
#pragma unroll
          for (int i = 0; i < 4; ++i) {
            u32x4 uu;
#pragma unroll
            for (int e = 0; e < 4; ++e) uu[e] = pack2(os[i * 8 + 2 * e], os[i * 8 + 2 * e + 1]);
            *(u32x4*)(og + i * 8) = uu;
          }
        } else {
          float ss = 0.f;
#pragma unroll 1
          for (int i = 0; i < 4; ++i) {
            const u32x4 uu = *(const u32x4*)(og + i * 8);
#pragma unroll
            for (int e = 0; e < 4; ++e) {
              const float a0 = os[i * 8 + 2 * e] + bflo(uu[e]), a1 = os[i * 8 + 2 * e + 1] + bfhi(uu[e]);
              ss += a0 * a0 + a1 * a1;
            }
          }
          ss += __shfl_xor(ss, 1, 64);
          ss += __shfl_xor(ss, 2, 64);
          const float rstd = rsqrtf(ss * (1.f / 128.f) + EPSF);
          const float* gn = p.in[I_GON] + l * 128 + qd * 32;
          const bf16* gr = (const bf16*)(p.ws + OFF_GR) + tok * 512 + hd * 128 + qd * 32;
#pragma unroll 1
          for (int i = 0; i < 4; ++i) {
            const u32x4 uo = *(const u32x4*)(og + i * 8);
            const u32x4 ug = *(const u32x4*)(gr + i * 8);
            u32x4 uu;
#pragma unroll
            for (int e = 0; e < 4; ++e) {
              const float v0 = os[i * 8 + 2 * e] + bflo(uo[e]), v1 = os[i * 8 + 2 * e + 1] + bfhi(uo[e]);
              const float a0 = v0 * rstd * gn[i * 8 + 2 * e] * siluf_(bflo(ug[e]));
              const float a1 = v1 * rstd * gn[i * 8 + 2 * e + 1] * siluf_(bfhi(ug[e]));
              uu[e] = pack2(a0, a1);
            }
            *(u32x4*)(og + i * 8) = uu;
          }
        }
        __syncthreads();
      }
    }
    if (!WITH_OUT) {
#pragma unroll
      for (int dkt = 0; dkt < 2; ++dkt)
#pragma unroll
        for (int i = 0; i < 16; ++i) GSu[(w * 32 + crow(i, h)) * 64 + dkt * 32 + r] = sacc[dkt][i];
      if (part == 0) ((float*)(p.ws + OFF_DECG))[((size_t)((b * 4 + hd) * 2 + dir) * NG33 + gi) * 64 + dk] = __expf(gtot);
    }
    __syncthreads();
  }
}

DI void gla_scan_job(const Params& p, int j) {
  const int idx = j * 256 + TIDX;
  const int seq = idx >> 13, el = idx & 8191, dk = el & 63, dir = seq & 1;
  float* GS = (float*)(p.ws + OFF_GS) + (size_t)seq * NG33 * 8192 + el;
  const float* DG = (const float*)(p.ws + OFF_DECG) + (size_t)seq * NG33 * 64 + dk;
  float s = 0.f;
  for (int st0 = 0; st0 < 33; st0 += 11) {
    float kv[11], dc[11];
#pragma unroll
    for (int q = 0; q < 11; ++q) {
      const int st = st0 + q;
      const int g = (dir == 0 || st == 0) ? st : 33 - st;
      kv[q] = GS[(size_t)g * 8192];
      dc[q] = DG[g * 64];
    }
#pragma unroll
    for (int q = 0; q < 11; ++q) {
      const int st = st0 + q;
      const int g = (dir == 0 || st == 0) ? st : 33 - st;
      GS[(size_t)g * 8192] = s;
      s = dc[q] * s + kv[q];
    }
  }
}

DI void s5_end_tile(const Params& p, int j, char* smem) {
  const int nt = j & 1, mt = (j >> 1) % 9, g = j / 18;
  const bf16* SU = (const bf16*)(p.ws + OFF_SU);
  const bf16* F = (const bf16*)(p.ws + OFF_F5) + ((size_t)g * 256 + nt * 128) * 512;
  f32x16 acc[2][2];
  acc_zero(acc);
  gemm_main_dma(acc,
            [&](int r) -> const bf16* {
              const int m = mt * 128 + r;
              if (m >= MS5) return (const bf16*)(p.ws + OFF_ZERO);
              const int b = m / NCH, ch = m - b * NCH;
              return SU + ((size_t)(b * 16 + g) * TT + ch * 32) * 16;
            },
            [&](int r) { return F + (size_t)r * 512; }, 512, smem);
  float* Cs = (float*)smem;
  acc_to_lds(acc, Cs);
  __syncthreads();
  float* EN = (float*)(p.ws + OFF_EN);
  for (int c = TIDX; c < 128 * 32; c += 256) {
    const int row = c >> 5, c4 = (c & 31) * 4, m = mt * 128 + row;
    if (m < MS5) {
      const float* s = Cs + row * CLD + c4;
      f32x4 v = {s[0], s[1], s[2], s[3]};
      *(f32x4*)(EN + ((size_t)m * 16 + g) * 256 + nt * 128 + c4) = v;
    }
  }
  __syncthreads();
}

DI void s5_scan_job(const Params& p, int l, int j, char* smem) {
  float2* ends = (float2*)smem;
  const int dir = j & 1, g = (j >> 1) & 15, b = j >> 5;
  const int pp = TIDX & 63, seg = TIDX >> 6;
  const float2 aL = ((const float2*)(p.ws + OFF_PWR))[((size_t)((l * 2 + dir) * 16 + g) * 33 + 32) * 64 + pp];
  const float* EN = (const float*)(p.ws + OFF_EN);
  bf16* SB = (bf16*)(p.ws + OFF_SB);
  float sr = 0.f, si = 0.f;
  for (int q0 = 0; q0 < 66; q0 += 11) {
    float er[11], ei[11];
#pragma unroll
    for (int q = 0; q < 11; ++q) {
      const int pos = seg * 66 + q0 + q;
      const int ch = dir ? (pos < 8 ? 7 - pos : 271 - pos) : pos;
      const float* e = EN + ((size_t)(b * NCH + ch) * 16 + g) * 256 + dir * 128 + pp;
      er[q] = e[0]; ei[q] = e[64];
    }
#pragma unroll
    for (int q = 0; q < 11; ++q) {
      const float nr = aL.x * sr - aL.y * si + er[q], ni = aL.x * si + aL.y * sr + ei[q];
      sr = nr; si = ni;
    }
  }
  ends[seg * 64 + pp] = make_float2(sr, si);
  float pr = 1.f, pi = 0.f;
  for (int q = 0; q < 66; ++q) { const float nr = pr * aL.x - pi * aL.y, ni = pr * aL.y + pi * aL.x; pr = nr; pi = ni; }
  __syncthreads();
  sr = 0.f; si = 0.f;
  for (int k = 0; k < seg; ++k) {
    const float2 e = ends[k * 64 + pp];
    const float nr = pr * sr - pi * si + e.x, ni = pr * si + pi * sr + e.y;
    sr = nr; si = ni;
  }
  for (int q0 = 0; q0 < 66; q0 += 11) {
    float er[11], ei[11];
#pragma unroll
    for (int q = 0; q < 11; ++q) {
      const int pos = seg * 66 + q0 + q;
      const int ch = dir ? (pos < 8 ? 7 - pos : 271 - pos) : pos;
      const float* e = EN + ((size_t)(b * NCH + ch) * 16 + g) * 256 + dir * 128 + pp;
      er[q] = e[0]; ei[q] = e[64];
    }
#pragma unroll
    for (int q = 0; q < 11; ++q) {
      const int pos = seg * 66 + q0 + q;
      const int ch = dir ? (pos < 8 ? 7 - pos : 271 - pos) : pos;
      bf16* sb = SB + ((size_t)(b * NCH + ch) * 16 + g) * 256 + dir * 128 + pp;
      sb[0] = f2bf(sr); sb[64] = f2bf(si);
      const float nr = aL.x * sr - aL.y * si + er[q], ni = aL.x * si + aL.y * sr + ei[q];
      sr = nr; si = ni;
    }
  }
  __syncthreads();
}

DI float gelu_tanh(float x) {
  const float u = 0.7978845608028654f * (x + 0.044715f * x * x * x);
  return 0.5f * x * (1.f + tanhf(u));
}

DI void s5_out_tile(const Params& p, int j, char* smem) {
  const int nt = j & 3, mt = (j >> 2) % 9, g = j / 36;
  const bf16* SU = (const bf16*)(p.ws + OFF_SU);
  const bf16* SB = (const bf16*)(p.ws + OFF_SB);
  const bf16* Tm = (const bf16*)(p.ws + OFF_T5) + ((size_t)g * 512 + nt * 128) * 512;
  const bf16* Em = (const bf16*)(p.ws + OFF_E5) + ((size_t)g * 512 + nt * 128) * 256;
  f32x16 acc[2][2];
  acc_zero(acc);
  gemm_main_dma(acc,
            [&](int r) -> const bf16* {
              const int m = mt * 128 + r;
              if (m >= MS5) return (const bf16*)(p.ws + OFF_ZERO);
              const int b = m / NCH, ch = m - b * NCH;
              return SU + ((size_t)(b * 16 + g) * TT + ch * 32) * 16;
            },
            [&](int r) { return Tm + (size_t)r * 512; }, 512, smem);
  gemm_main_dma(acc,
            [&](int r) -> const bf16* {
              const int m = mt * 128 + r;
              if (m >= MS5) return (const bf16*)(p.ws + OFF_ZERO);
              return SB + ((size_t)m * 16 + g) * 256;
            },
            [&](int r) { return Em + (size_t)r * 256; }, 256, smem);
  float* Cs = (float*)smem;
  acc_to_lds(acc, Cs);
  __syncthreads();
  bf16* Y5 = (bf16*)(p.ws + OFF_Y5);
  for (int c = TIDX; c < 2048; c += 256) {
    const int row = c >> 4, c8 = c & 15, m = mt * 128 + row;
    if (m < MS5) {
      const int b = m / NCH, ch = m - b * NCH;
      const int n = nt * 128 + c8 * 8, i = n >> 4, hh = n & 15;
      const float* s = Cs + row * CLD + c8 * 8;
      u32x4 u;
#pragma unroll
      for (int e = 0; e < 4; ++e) u[e] = pack2(gelu_tanh(s[2 * e]), gelu_tanh(s[2 * e + 1]));
      *(u32x4*)(Y5 + ((size_t)b * TT + ch * 32 + i) * 256 + g * 16 + hh) = u;
    }
  }
  __syncthreads();
}

DI void glu_tile(const Params& p, int l, int j, char* smem) {
  const int nt = j & 1, mt = j >> 1;
  const bf16* Y5 = (const bf16*)(p.ws + OFF_Y5) + (size_t)mt * 128 * 256;
  const bf16* W = wl(p, l, WL_GLU) + (size_t)nt * 128 * 256;
  f32x16 acc[2][2];
  acc_zero(acc);
  gemm_main_dma(acc, [&](int r) { return Y5 + (size_t)r * 256; }, [&](int r) { return W + (size_t)r * 256; }, 256, smem);
  float* Cs = (float*)smem;
  acc_to_lds(acc, Cs);
  __syncthreads();
  const float* gb = p.in[I_GLUB] + l * 256 + nt * 128;
  bf16* O = (bf16*)(p.ws + OFF_OS5) + (size_t)mt * 128 * 256 + nt * 128;
  for (int c = TIDX; c < 2048; c += 256) {
    const int row = c >> 4, cc = (c & 15) * 8;
    const float* s = Cs + row * CLD + cc;
    const u32x4 yu = *(const u32x4*)(Y5 + (size_t)row * 256 + nt * 128 + cc);
    u32x4 u;
#pragma unroll
    for (int e = 0; e < 4; ++e) {
      const float y0 = bflo(yu[e]), y1 = bfhi(yu[e]);
      u[e] = pack2(y0 * sigmoidf_(s[2 * e] + gb[cc + 2 * e]), y1 * sigmoidf_(s[2 * e + 1] + gb[cc + 2 * e + 1]));
    }
    *(u32x4*)(O + (size_t)row * 256 + cc) = u;
  }
  __syncthreads();
}

struct DmaStream { const bf16* ap[4]; const bf16* bp[4]; };
template <class FA, class FB>
DI void stream_setup(DmaStream& st, FA fa, FB fb) {
  const int tid = TIDX, lane = tid & 63, w = tid >> 6;
#pragma unroll
  for (int i = 0; i < 4; ++i) {
    const int row = w * 32 + i * 8 + (lane >> 3);
    const int c = (lane & 7) ^ ((row >> 1) & 7);
    st.ap[i] = fa(row) + c * 8;
    st.bp[i] = fb(row) + c * 8;
  }
}
DI void stream_issue(const DmaStream& st, int buf, int kt, char* smem) {
  const int tid = TIDX, lane = tid & 63, w = tid >> 6;
  const int ldst = (w * 256 + lane) * 16;
  const int k0 = kt * 64;
#pragma unroll
  for (int i = 0; i < 4; ++i) {
    __builtin_amdgcn_global_load_lds((const unsigned*)(st.ap[i] + k0), (unsigned*)(smem + buf * 16384 + ldst + i * 1024), 16, 0, 0);
    __builtin_amdgcn_global_load_lds((const unsigned*)(st.bp[i] + k0), (unsigned*)(smem + 32768 + buf * 16384 + ldst + i * 1024), 16, 0, 0);
  }
}
DI void stream_run(f32x16 (&acc)[2][2], const DmaStream& cur, int K, char* smem, const DmaStream& next, bool has_next) {
  const int tid = TIDX, lane = tid & 63, w = tid >> 6, wm = w >> 1, wn = w & 1;
  const int r = lane & 31, h = lane >> 5;
  const int xr = (r >> 1) & 7;
  const int arow = (wm * 64 + r) * 128, brow = (wn * 64 + r) * 128;
  const int nk = K / 64;
  for (int kt = 0; kt < nk; ++kt) {
    const int buf = kt & 1;
    if (kt + 1 < nk) stream_issue(cur, buf ^ 1, kt + 1, smem);
    else if (has_next) stream_issue(next, buf ^ 1, 0, smem);
    const char* Ab = smem + buf * 16384 + arow;
    const char* Bb = smem + 32768 + buf * 16384 + brow;
#pragma unroll
    for (int s2 = 0; s2 < 4; ++s2) {
      const int co = ((2 * s2 + h) ^ xr) * 16;
      s16x8 a0 = *(const s16x8*)(Ab + co);
      s16x8 a1 = *(const s16x8*)(Ab + 32 * 128 + co);
      s16x8 b0 = *(const s16x8*)(Bb + co);
      s16x8 b1 = *(const s16x8*)(Bb + 32 * 128 + co);
      acc[0][0] = MFMA32(a0, b0, acc[0][0]);
      acc[0][1] = MFMA32(a0, b1, acc[0][1]);
      acc[1][0] = MFMA32(a1, b0, acc[1][0]);
      acc[1][1] = MFMA32(a1, b1, acc[1][1]);
    }
    asm volatile("s_waitcnt vmcnt(0)" ::: "memory");
    __syncthreads();
  }
}

DI void merge_tile(const Params& p, int l, int j, char* smem) {
  const int nt = j & 7, mt = j >> 3;
  const bf16* H = (const bf16*)(p.ws + OFF_H) + (size_t)mt * 128 * DM;
  unsigned am[2][2][8];
#pragma unroll
  for (int a = 0; a < 2; ++a)
#pragma unroll
    for (int bq = 0; bq < 2; ++bq)
#pragma unroll
      for (int i = 0; i < 8; ++i) am[a][bq][i] = 0u;
  DmaStream sb, sg;
  {
    const bf16* A0 = (const bf16*)(p.ws + OFF_OATT) + (size_t)mt * 128 * 256;
    const bf16* W0 = wl(p, l, WL_BRA) + (size_t)nt * 128 * 256;
    stream_setup(sb, [&](int r) { return A0 + (size_t)r * 256; }, [&](int r) { return W0 + (size_t)r * 256; });
    stream_issue(sb, 0, 0, smem);
    asm volatile("s_waitcnt vmcnt(0)" ::: "memory");
    __syncthreads();
  }
#pragma unroll 1
  for (int x = 0; x < 3; ++x) {
    const int K = (x == 1) ? 512 : 256;
    const bf16* Wg = wl(p, l, WL_WIN) + ((size_t)2432 + x * 1024 + nt * 128) * DM;
    stream_setup(sg, [&](int r) { return H + (size_t)r * DM; }, [&](int r) { return Wg + (size_t)r * DM; });
    unsigned br[2][2][8];
    {
      f32x16 acc[2][2];
      acc_zero(acc);
      stream_run(acc, sb, K, smem, sg, true);
#pragma unroll
      for (int a = 0; a < 2; ++a)
#pragma unroll
        for (int bq = 0; bq < 2; ++bq)
#pragma unroll
          for (int i = 0; i < 8; ++i) br[a][bq][i] = pack2(acc[a][bq][2 * i], acc[a][bq][2 * i + 1]);
    }
    if (x < 2) {
      const bf16* A1; const bf16* W1; int K1;
      if (x == 0) { A1 = (const bf16*)(p.ws + OFF_OGLA) + (size_t)mt * 128 * 512; W1 = wl(p, l, WL_BRG) + (size_t)nt * 128 * 512; K1 = 512; }
      else { A1 = (const bf16*)(p.ws + OFF_OS5) + (size_t)mt * 128 * 256; W1 = wl(p, l, WL_BRS) + (size_t)nt * 128 * 256; K1 = 256; }
      stream_setup(sb, [&](int r) { return A1 + (size_t)r * K1; }, [&](int r) { return W1 + (size_t)r * K1; });
    }
    f32x16 acc[2][2];
    acc_zero(acc);
    stream_run(acc, sg, DM, smem, sb, x < 2);
#pragma unroll
    for (int a = 0; a < 2; ++a)
#pragma unroll
      for (int bq = 0; bq < 2; ++bq)
#pragma unroll
        for (int i = 0; i < 8; ++i) {
          const float v0 = bflo(am[a][bq][i]) + sigmoidf_(acc[a][bq][2 * i]) * bflo(br[a][bq][i]);
          const float v1 = bfhi(am[a][bq][i]) + sigmoidf_(acc[a][bq][2 * i + 1]) * bfhi(br[a][bq][i]);
          am[a][bq][i] = pack2(v0, v1);
        }
  }
  f32x16 accm[2][2];
#pragma unroll
  for (int a = 0; a < 2; ++a)
#pragma unroll
    for (int bq = 0; bq < 2; ++bq)
#pragma unroll
      for (int i = 0; i < 8; ++i) { accm[a][bq][2 * i] = bflo(am[a][bq][i]); accm[a][bq][2 * i + 1] = bfhi(am[a][bq][i]); }
  float* Cs = (float*)smem;
  acc_to_lds(accm, Cs);
  __syncthreads();
  store_tile_bf16(Cs, (bf16*)(p.ws + OFF_MG) + (size_t)mt * 128 * DM + nt * 128, DM, 128, 1.f);
  __syncthreads();
}

DI void plain_tile(const bf16* A, int K, const bf16* W, bf16* dst, int ldd, char* smem) {
  f32x16 acc[2][2];
  acc_zero(acc);
  gemm_main_dma(acc, [&](int r) { return A + (size_t)r * K; }, [&](int r) { return W + (size_t)r * K; }, K, smem);
  float* Cs = (float*)smem;
  acc_to_lds(acc, Cs);
  __syncthreads();
  store_tile_bf16(Cs, dst, ldd, 128, 1.f);
  __syncthreads();
}

DI void store_half_bf16(const float* Cs, bf16* dst, size_t ld, int hf) {
  for (int c = TIDX; c < 1024; c += 256) {
    const int row = c >> 3, seg = (c >> 2) & 1, c8 = (c & 3) * 8;
    const int col = seg * 64 + hf * 32 + c8;
    const float* s = Cs + row * CLD + col;
    u32x4 v;
    v[0] = pack2(s[0], s[1]); v[1] = pack2(s[2], s[3]); v[2] = pack2(s[4], s[5]); v[3] = pack2(s[6], s[7]);
    *(u32x4*)(dst + (size_t)row * ld + col) = v;
  }
}
DI void plain_half(const bf16* A, int K, const bf16* W, bf16* dst, int ldd, int hf, char* smem) {
  f32x16 acc[2];
#pragma unroll
  for (int i = 0; i < 16; ++i) { acc[0][i] = 0.f; acc[1][i] = 0.f; }
  gemm_main_dma_half(acc, A, K, W, K, K, hf, smem);
  float* Cs = (float*)smem;
  {
    const int lane = TIDX & 63, w = TIDX >> 6, wm = w >> 1, wn = w & 1, r = lane & 31, h = lane >> 5;
#pragma unroll
    for (int tm = 0; tm < 2; ++tm)
#pragma unroll
      for (int i = 0; i < 16; ++i) Cs[(wm * 64 + tm * 32 + crow(i, h)) * CLD + wn * 64 + hf * 32 + r] = acc[tm][i];
  }
  __syncthreads();
  store_half_bf16(Cs, dst, ldd, hf);
  __syncthreads();
}

DI void merge_half(const Params& p, int l, int mt, int nt, int hf, char* smem) {
  const bf16* H = (const bf16*)(p.ws + OFF_H) + (size_t)mt * 128 * DM;
  unsigned am[2][8];
#pragma unroll
  for (int a = 0; a < 2; ++a)
#pragma unroll
    for (int i = 0; i < 8; ++i) am[a][i] = 0u;
#pragma unroll 1
  for (int x = 0; x < 3; ++x) {
    const bf16* A; const bf16* Wb; int K;
    if (x == 0) { A = (const bf16*)(p.ws + OFF_OATT) + (size_t)mt * 128 * 256; Wb = wl(p, l, WL_BRA) + (size_t)nt * 128 * 256; K = 256; }
    else if (x == 1) { A = (const bf16*)(p.ws + OFF_OGLA) + (size_t)mt * 128 * 512; Wb = wl(p, l, WL_BRG) + (size_t)nt * 128 * 512; K = 512; }
    else { A = (const bf16*)(p.ws + OFF_OS5) + (size_t)mt * 128 * 256; Wb = wl(p, l, WL_BRS) + (size_t)nt * 128 * 256; K = 256; }
    unsigned br[2][8];
    {
      f32x16 a2[2];
#pragma unroll
      for (int i = 0; i < 16; ++i) { a2[0][i] = 0.f; a2[1][i] = 0.f; }
      gemm_main_dma_half(a2, A, K, Wb, K, K, hf, smem);
#pragma unroll
      for (int a = 0; a < 2; ++a)
#pragma unroll
        for (int i = 0; i < 8; ++i) br[a][i] = pack2(a2[a][2 * i], a2[a][2 * i + 1]);
    }
    const bf16* Wg = wl(p, l, WL_WIN) + ((size_t)2432 + x * 1024 + nt * 128) * DM;
    f32x16 g2[2];
#pragma unroll
    for (int i = 0; i < 16; ++i) { g2[0][i] = 0.f; g2[1][i] = 0.f; }
    gemm_main_dma_half(g2, H, DM, Wg, DM, DM, hf, smem);
#pragma unroll
    for (int a = 0; a < 2; ++a)
#pragma unroll
      for (int i = 0; i < 8; ++i) {
        const float v0 = bflo(am[a][i]) + sigmoidf_(g2[a][2 * i]) * bflo(br[a][i]);
        const float v1 = bfhi(am[a][i]) + sigmoidf_(g2[a][2 * i + 1]) * bfhi(br[a][i]);
        am[a][i] = pack2(v0, v1);
      }
  }
  float* Cs = (float*)smem;
  {
    const int lane = TIDX & 63, w = TIDX >> 6, wm = w >> 1, wn = w & 1, r = lane & 31, h = lane >> 5;
#pragma unroll
    for (int tm = 0; tm < 2; ++tm)
#pragma unroll
      for (int i = 0; i < 8; ++i) {
        Cs[(wm * 64 + tm * 32 + crow(2 * i, h)) * CLD + wn * 64 + hf * 32 + r] = bflo(am[tm][i]);
        Cs[(wm * 64 + tm * 32 + crow(2 * i + 1, h)) * CLD + wn * 64 + hf * 32 + r] = bfhi(am[tm][i]);
      }
  }
  __syncthreads();
  store_half_bf16(Cs, (bf16*)(p.ws + OFF_MG) + (size_t)mt * 128 * DM + nt * 128, DM, hf);
  __syncthreads();
}

DI void plain_wide(const bf16* A, int K, const bf16* W, bf16* dst, int ldd, char* smem) {
  f32x16 acc[2][4];
  accw_zero(acc);
  gemm_wide(acc, [&](int r) { return A + (size_t)r * K; }, [&](int r) { return W + (size_t)r * K; }, K, smem);
  float* Cs = (float*)smem;
  accw_to_lds<0>(acc, Cs);
  __syncthreads();
  store_tile_bf16(Cs, dst, ldd, 128, 1.f);
  __syncthreads();
  accw_to_lds<1>(acc, Cs);
  __syncthreads();
  store_tile_bf16(Cs, dst + 128, ldd, 128, 1.f);
  __syncthreads();
}

DI void up_epi(const Params& p, int l, int jn, int seqbase, int len, int pos0, char* smem) {
  float* Cs = (float*)smem;
  const float* cw = p.in[I_CW] + (size_t)l * 3 * 2 * DFF;
  const float* cb = p.in[I_CB] + (size_t)l * 2 * DFF;
  bf16* G = (bf16*)(p.ws + OFF_G);
  const int tid = TIDX;
  const int c = (tid & 31) * 2;
  float wa[2][3], wv[2][3], ba[2], bv[2];
#pragma unroll
  for (int e = 0; e < 2; ++e) {
    const int ca = jn * 64 + c + e, cv = DFF + ca;
#pragma unroll
    for (int k = 0; k < 3; ++k) { wa[e][k] = cw[k * 2 * DFF + ca]; wv[e][k] = cw[k * 2 * DFF + cv]; }
    ba[e] = cb[ca]; bv[e] = cb[cv];
  }
#pragma unroll 4
  for (int rr = 1 + (tid >> 5); rr < 127; rr += 8) {
    const int pos = pos0 + rr;
    if (pos < len) {
      float gv[2];
#pragma unroll
      for (int e = 0; e < 2; ++e) {
        const float a = wa[e][0] * Cs[(rr - 1) * CLD + c + e] + wa[e][1] * Cs[rr * CLD + c + e] + wa[e][2] * Cs[(rr + 1) * CLD + c + e] + ba[e];
        const float v = wv[e][0] * Cs[(rr - 1) * CLD + 64 + c + e] + wv[e][1] * Cs[rr * CLD + 64 + c + e] +
                        wv[e][2] * Cs[(rr + 1) * CLD + 64 + c + e] + bv[e];
        gv[e] = siluf_(a) * v;
      }
      *(unsigned*)(G + (size_t)(seqbase + pos) * DFF + jn * 64 + c) = pack2(gv[0], gv[1]);
    }
  }
  __syncthreads();
}

DI void up_wide(const Params& p, int l, int mtile, int jp, char* smem) {
  const int b = mtile / 69, rr0 = mtile % 69;
  int seqbase, len, ti;
  if (rr0 < 3) { seqbase = b * TT; len = CTXL; ti = rr0; }
  else { seqbase = b * TT + CTXL; len = SEQ; ti = rr0 - 3; }
  const int pos0 = ti * 126 - 1;
  const bf16* H = (const bf16*)(p.ws + OFF_H);
  const bf16* W = wl(p, l, WL_UP) + (size_t)jp * 256 * DM;
  f32x16 acc[2][4];
  accw_zero(acc);
  gemm_wide(acc,
            [&](int r) -> const bf16* {
              const int pos = pos0 + r;
              return (pos >= 0 && pos < len) ? H + (size_t)(seqbase + pos) * DM : (const bf16*)(p.ws + OFF_ZERO);
            },
            [&](int r) { return W + (size_t)r * DM; }, DM, smem);
  float* Cs = (float*)smem;
  accw_to_lds<0>(acc, Cs);
  __syncthreads();
  up_epi(p, l, jp * 2, seqbase, len, pos0, smem);
  accw_to_lds<1>(acc, Cs);
  __syncthreads();
  up_epi(p, l, jp * 2 + 1, seqbase, len, pos0, smem);
}

DI bool gemm_job(int bid, int G, int it, int MT, int NTL, int& mt, int& nt, int CW = 8) {
  const int x = bid & 7, q = bid >> 3, Q = G >> 3;
  const int m0 = (x * MT) >> 3, m1 = ((x + 1) * MT) >> 3, Mx = m1 - m0;
  const int jl = q + Q * it;
  if (jl >= Mx * NTL) return false;
  const int full = Mx * CW;
  const int c = jl / full, rem = jl - c * full;
  const int wc = min(CW, NTL - CW * c);
  const int mi = rem / wc;
  mt = m0 + mi;
  nt = CW * c + (rem - mi * wc);
  return true;
}

DI int lat_mt(int i) { return (i >> 6) * 66 + 2 + (i & 63); }
DI int lat_up(int i) { return (i / 66) * 69 + 3 + (i % 66); }

enum { PH_PREP = 0, PH_ROW0, PH_PROJ, PH_MIX1, PH_SCAN, PH_MIX2, PH_GLU, PH_MERGE, PH_WOUT, PH_ROW1, PH_UP, PH_DOWN, PH_ROW2 };
constexpr int N_PHASES = 2 + 11 * NL;

DI void run_phase(const Params& p, int ph, int l, char* smem) {
  const int bid = blockIdx.x;
#ifdef HALFMASK
  const int G = ((HALFMASK >> ph) & 1) ? 256 : gridDim.x;
  if (bid >= G) return;
#else
  const int G = gridDim.x;
#endif
#ifdef PHMASK
  if (!((PHMASK >> ph) & 1)) return;
#endif
  switch (ph) {
    case PH_PREP:
      if (bid < 8) { for (int i = TIDX; i < 512; i += 256) ((u32x4*)(p.ws + OFF_ZERO))[i] = u32x4{0u, 0u, 0u, 0u}; }
      for (int j = bid; j < 128 + 4016; j += G) {
        if (j < 96) prep_mod_job(p, j, smem);
        else if (j < 128) prep_s5_job(p, j - 96);
        else prep_wt_job(p, j - 128, smem);
      }
      break;
    case PH_ROW0:
      row_phase<0>(p, 0, bid, G);
      ktab_phase(p, bid, G, 0, 1);
      break;
    case PH_PROJ:
#ifdef EXP_A
      if (bid < 256) { int mt, nt; for (int it = 0; gemm_job(bid, 256, it, 264, 10, mt, nt, 4); ++it) proj_wide(p, l, mt, nt, smem); }
      else {
        s5mat_phase(p, l, bid - 256, G - 256);
        if (l + 1 < NL) ktab_phase(p, bid - 256, G - 256, l + 1, l + 2);
        if (l + 1 < NL) { for (int jj = (l + 1) * 4016 + (bid - 256); jj < (l + 2) * 4016; jj += G - 256) prep_wt_job(p, jj, smem); }
      }
#elif defined(EXP_C)
      if (bid < 256) for (int j = bid; j < 264 * 19; j += 256) { if ((EXP_C >> (j % 19)) & 1) proj_tile(p, l, j / 19, j % 19, smem); }
      for (int j = bid; j < 264 * 19; j += G) { if (!((EXP_C >> (j % 19)) & 1)) proj_tile(p, l, j / 19, j % 19, smem); }
      s5mat_phase(p, l, bid, G);
#elif defined(EXP_B)
      for (int j = bid; j < 264 * 19; j += G) proj_tile(p, l, j / 19, j % 19, smem);
      if (bid < 256) s5mat_phase(p, l, bid, 256);
#else
      for (int j = bid; j < 264 * 19; j += G) proj_tile(p, l, j / 19, j % 19, smem);
      s5mat_phase(p, l, bid, G);
#endif
      break;
    case PH_MIX1:
      for (int j = bid; j < (l == NL - 1 ? 1024 : 1056); j += G) attn_unit(p, j, smem);
      for (int j = bid; j < 1024; j += G) {
        const int v = j >> 5, k = j & 31;
        const int gi = (v & 1) ? (k == 0 ? 0 : k + 1) : k;
        gla_unit<false>(p, l, v * NG33 + gi, smem);
      }
      for (int j = G - 1 - bid; j < 288; j += G) s5_end_tile(p, j, smem);
      break;
    case PH_SCAN:
      for (int j = bid; j < 1024 + 128; j += G) {
        if (j < 1024) gla_scan_job(p, j);
        else s5_scan_job(p, l, j - 1024, smem);
      }
      break;
    case PH_MIX2:
      if (l == NL - 1) {
        for (int j = bid; j < 512 + 576; j += G) {
          if (j < 512) gla_unit<true>(p, l, (j >> 5) * NG33 + 1 + (j & 31), smem);
          else s5_out_tile(p, j - 512, smem);
        }
      } else {
        for (int j = bid; j < 528 + 576; j += G) {
          if (j < 528) gla_unit<true>(p, l, j, smem);
          else s5_out_tile(p, j - 528, smem);
        }
      }
      break;
    case PH_GLU:
      { const bool last = (l == NL - 1); int mt, nt;
        for (int it = 0; gemm_job(bid, G, it, last ? 256 : 264, 2, mt, nt); ++it) glu_tile(p, l, (last ? lat_mt(mt) : mt) * 2 + nt, smem); }
      break;
    case PH_MERGE:
      { int mt, nt;
        for (int it = 0; gemm_job(bid, G, it, 256, 8, mt, nt); ++it) merge_tile(p, l, lat_mt(mt) * 8 + nt, smem); }
      if (l != NL - 1 && bid < 128) {
        const int c = bid >> 1, hf = bid & 1;
        merge_half(p, l, (c >> 4) * 66 + ((c >> 3) & 1), c & 7, hf, smem);
      }
      break;
    case PH_WOUT:
      for (int it = 0;; ++it) {
        int mt, nt;
        if (!gemm_job(bid, G, it, 256, 8, mt, nt)) break;
        mt = lat_mt(mt);
        plain_tile((const bf16*)(p.ws + OFF_MG) + (size_t)mt * 128 * DM, DM, wl(p, l, WL_WOUT) + (size_t)nt * 128 * DM,
                   (bf16*)(p.ws + OFF_H) + (size_t)mt * 128 * DM + nt * 128, DM, smem);
      }
      if (l != NL - 1 && bid < 128) {
        const int c = bid >> 1, hf = bid & 1;
        const int mt = (c >> 4) * 66 + ((c >> 3) & 1), nt = c & 7;
        plain_half((const bf16*)(p.ws + OFF_MG) + (size_t)mt * 128 * DM, DM, wl(p, l, WL_WOUT) + (size_t)nt * 128 * DM,
                   (bf16*)(p.ws + OFF_H) + (size_t)mt * 128 * DM + nt * 128, DM, hf, smem);
      }
      break;
    case PH_ROW1: row_phase<1>(p, l, bid, G); break;
    case PH_UP:
      { const bool last = (l == NL - 1); int mt, nt;
        for (int it = 0; gemm_job(bid, G, it, last ? 264 : 276, 22, mt, nt, 4); ++it) up_wide(p, l, last ? lat_up(mt) : mt, nt, smem); }
      break;
    case PH_DOWN:
      for (int it = 0;; ++it) {
        int mt, nt;
        if (!gemm_job(bid, G, it, 256, 8, mt, nt)) break;
        mt = lat_mt(mt);
        plain_tile((const bf16*)(p.ws + OFF_G) + (size_t)mt * 128 * DFF, DFF, wl(p, l, WL_DOWN) + (size_t)nt * 128 * DFF,
                   (bf16*)(p.ws + OFF_H) + (size_t)mt * 128 * DM + nt * 128, DM, smem);
      }
      if (l != NL - 1 && bid < 128) {
        const int c = bid >> 1, hf = bid & 1;
        const int mt = (c >> 4) * 66 + ((c >> 3) & 1), nt = c & 7;
        plain_half((const bf16*)(p.ws + OFF_G) + (size_t)mt * 128 * DFF, DFF, wl(p, l, WL_DOWN) + (size_t)nt * 128 * DFF,
                   (bf16*)(p.ws + OFF_H) + (size_t)mt * 128 * DM + nt * 128, DM, hf, smem);
      }
      break;
    case PH_ROW2: row_phase<2>(p, l, bid, G); break;
  }
}

#define XB_TMO      128
#define XB_XCNT(j)  (256  + 64 * (j))
#define XB_XSUB(j)  (1280 + 64 * (j))
#define XB_XGEN(j)  (2304 + 64 * (j))
#define XB_TOP      3328
#define XB_TOPGEN   3392
#define XCD_BAR_WORDS 3456
#define XB_SPIN_CAP (1u << 18)
#define LAS __attribute__((address_space(3)))

__device__ __forceinline__ unsigned xb_ld(unsigned* p)              { return __hip_atomic_load(p, __ATOMIC_RELAXED, __HIP_MEMORY_SCOPE_AGENT); }
__device__ __forceinline__ unsigned xb_add(unsigned* p, unsigned v) { return __hip_atomic_fetch_add(p, v, __ATOMIC_RELAXED, __HIP_MEMORY_SCOPE_AGENT); }
__device__ __forceinline__ unsigned xb_xcc_id() { return (unsigned)__builtin_amdgcn_s_getreg((3 << 11) | 20) & 0xFu; }
#define XB_SPIN(cond, bar) do { unsigned _sp = 0; while (cond) { __builtin_amdgcn_s_sleep(1); \
    if ((++_sp & 255u) == 0u) { if (xb_ld(&(bar)[XB_TMO])) break; if (_sp > XB_SPIN_CAP) { atomicAdd(&(bar)[XB_TMO], 1u); break; } } } } while (0)

struct XcdBarrier {
    unsigned* bar; unsigned x;
    volatile LAS unsigned* st;
};

__device__ __forceinline__ XcdBarrier xcd_barrier_post(unsigned* bar, volatile LAS unsigned* st) {
    XcdBarrier b; b.bar = bar; b.x = xb_xcc_id(); b.st = st;
    if (threadIdx.x == 0) (void)xb_add(&bar[XB_XCNT(b.x)], 1u);
    return b;
}
__device__ __forceinline__ void xcd_barrier_complete(unsigned* bar, unsigned x, unsigned& nloc, unsigned& nx) {
    const unsigned G = gridDim.x * gridDim.y * gridDim.z;
    unsigned sum, cnt, mine, sp = 0u;
    for (;;) {
        sum = 0u; cnt = 0u; mine = 0u;
#pragma unroll
        for (unsigned j = 0; j < 16; ++j) { const unsigned c = xb_ld(&bar[XB_XCNT(j)]); sum += c; cnt += (c > 0u) ? 1u : 0u; mine = (j == x) ? c : mine; }
        if (sum == G) break;
        __builtin_amdgcn_s_sleep(1);
        if ((++sp & 255u) == 0u) { if (xb_ld(&bar[XB_TMO])) break; if (sp > XB_SPIN_CAP) { atomicAdd(&bar[XB_TMO], 1u); break; } }
    }
    nloc = mine > 0u ? mine : 1u; nx = cnt > 0u ? cnt : 1u;
}

__device__ __forceinline__ void xcd_barrier(const XcdBarrier& b) {
    asm volatile("s_waitcnt vmcnt(0)" ::: "memory");
    __syncthreads();
    if (threadIdx.x == 0) {
        unsigned* bar = b.bar;
        __builtin_amdgcn_s_waitcnt(0);
        unsigned nloc = b.st[0], nx = b.st[1];
        if (nloc == 0u) { xcd_barrier_complete(bar, b.x, nloc, nx); b.st[0] = nloc; b.st[1] = nx; }
        const unsigned old = xb_add(&bar[XB_XSUB(b.x)], 1u);
        const unsigned gen = old / nloc;
        if (old + 1u == (gen + 1u) * nloc) {
            __builtin_amdgcn_fence(__ATOMIC_RELEASE, "agent");
            asm volatile("s_waitcnt vmcnt(0)" ::: "memory");
            const unsigned og = xb_add(&bar[XB_TOP], 1u);
            const unsigned tg = og / nx;
            if (og + 1u == (tg + 1u) * nx) xb_add(&bar[XB_TOPGEN], 1u);
            else XB_SPIN(xb_ld(&bar[XB_TOPGEN]) == tg, bar);
            __builtin_amdgcn_fence(__ATOMIC_ACQUIRE, "agent");
            xb_add(&bar[XB_XGEN(b.x)], 1u);
            asm volatile("s_waitcnt vmcnt(0)" ::: "memory");
        } else {
            XB_SPIN(xb_ld(&bar[XB_XGEN(b.x)]) == gen, bar);
            __builtin_amdgcn_fence(__ATOMIC_ACQUIRE, "agent");
            asm volatile("s_waitcnt vmcnt(0)" ::: "memory");
        }
    }
    __syncthreads();
}


DI void grid_barrier(unsigned* bar, unsigned& gen) {
  asm volatile("s_waitcnt vmcnt(0)" ::: "memory");
  __syncthreads();
  gen += 1;
  if (threadIdx.x == 0) {
    __builtin_amdgcn_fence(__ATOMIC_RELEASE, "agent");
    asm volatile("s_waitcnt vmcnt(0)" ::: "memory");
    const unsigned target = gen * gridDim.x;
    __hip_atomic_fetch_add(bar, 1u, __ATOMIC_RELAXED, __HIP_MEMORY_SCOPE_AGENT);
    while (__hip_atomic_load(bar, __ATOMIC_RELAXED, __HIP_MEMORY_SCOPE_AGENT) < target) __builtin_amdgcn_s_sleep(2);
  }
  __syncthreads();
  __builtin_amdgcn_fence(__ATOMIC_ACQUIRE, "agent");
  asm volatile("s_waitcnt vmcnt(0)" ::: "memory");
}

__global__ void __launch_bounds__(256, 2) hybrid_fwd(Params p, int ph_lo, int ph_hi) {
  extern __shared__ __attribute__((aligned(16))) char smem[];
  unsigned* bar = (unsigned*)(p.ws + OFF_BAR);
  unsigned gen = 0;
  __shared__ uint4 xb_words;
  if (threadIdx.x == 0) xb_words = make_uint4(0u, 0u, 0u, 0u);
  __syncthreads();
  XcdBarrier xb = xcd_barrier_post(bar + 64, (volatile LAS unsigned*)&xb_words);
  if (ph_hi - ph_lo > 1) cg::this_grid().sync();
  int i = 0;
#define STEP(PH, L)                                      \
  {                                                      \
    if (i >= ph_lo && i < ph_hi) {                       \
      Params q;                                          \
      q.ws = p.ws; q.out = p.out;                        \
      asm volatile("" : "+s"(q.ws), "+s"(q.out));        \
      _Pragma("unroll") for (int k = 0; k < 34; ++k) { q.in[k] = p.in[k]; asm volatile("" : "+s"(q.in[k])); } \
      run_phase(q, PH, L, smem);                         \
      if ((DUPMASK >> (PH)) & 1) { xcd_barrier(xb); run_phase(q, PH, L, smem); } \
      if (i + 1 < ph_hi) xcd_barrier(xb);                \
    }                                                    \
    ++i;                                                 \
  }
  STEP(PH_PREP, 0)
  STEP(PH_ROW0, 0)
#pragma unroll 1
  for (int l = 0; l < NL; ++l) {
    STEP(PH_PROJ, l)
    STEP(PH_MIX1, l)
    STEP(PH_SCAN, l)
    STEP(PH_MIX2, l)
    STEP(PH_GLU, l)
    STEP(PH_MERGE, l)
    STEP(PH_WOUT, l)
    STEP(PH_ROW1, l)
    STEP(PH_UP, l)
    STEP(PH_DOWN, l)
    STEP(PH_ROW2, l)
  }
#undef STEP
}

extern "C" void kernel_launch(void* const* d_in, const int* in_sizes, int n_in, void* d_out, int out_size, void* d_ws, size_t ws_size,
                              hipStream_t stream) {
  static int grid_blocks = 0;
  if (!grid_blocks) {
    int dev = 0, cus = 0, per_cu = 0;
    hipGetDevice(&dev);
    hipDeviceGetAttribute(&cus, hipDeviceAttributeMultiprocessorCount, dev);
    hipFuncSetAttribute((const void*)hybrid_fwd, hipFuncAttributeMaxDynamicSharedMemorySize, SMEM_BYTES);
    hipOccupancyMaxActiveBlocksPerMultiprocessor(&per_cu, hybrid_fwd, 256, SMEM_BYTES);
    if (per_cu < 1) per_cu = 1;
    if (per_cu > 2) per_cu = 2;
    grid_blocks = cus * per_cu;
    if (ws_size < OFF_ZERO + 8192) fprintf(stderr, "workspace too small: %zu < %zu\n", ws_size, (size_t)OFF_END);
  }
  Params p{};
  for (int i = 0; i < 34; ++i) p.in[i] = (const float*)d_in[i];
  p.out = (float*)d_out;
  p.ws = (char*)d_ws;
#if ONE_LAUNCH
  hipMemsetAsync((char*)d_ws + OFF_BAR, 0, 16384, stream);
  int lo = 0, hi = N_PHASES;
  void* args[] = {&p, &lo, &hi};
  hipError_t e = hipLaunchCooperativeKernel((void*)hybrid_fwd, dim3(grid_blocks), dim3(256), args, SMEM_BYTES, stream);
  if (e != hipSuccess) fprintf(stderr, "cooperative launch failed: %s (grid %d)\n", hipGetErrorString(e), grid_blocks);
#else
  for (int i = 0; i < N_PHASES; ++i) hipLaunchKernelGGL(hybrid_fwd, dim3(grid_blocks), dim3(256), SMEM_BYTES, stream, p, i, i + 1);
#endif
}
```

```cpp
#include <hip/hip_runtime.h>
#include <hip/hip_cooperative_groups.h>
#include <stdint.h>
#include <cstdio>
namespace cg = cooperative_groups;

#define EXP_A 1
#ifndef DUPMASK
#define DUPMASK 0
#endif
#ifndef ONE_LAUNCH
#define ONE_LAUNCH 1
#endif

typedef unsigned short bf16;
typedef __attribute__((ext_vector_type(8))) short s16x8;
typedef __attribute__((ext_vector_type(4))) short s16x4;
typedef __attribute__((ext_vector_type(16))) float f32x16;
typedef __attribute__((ext_vector_type(4))) float f32x4;
typedef __attribute__((ext_vector_type(2))) float f32x2;
typedef __attribute__((ext_vector_type(4))) unsigned u32x4;
typedef __attribute__((ext_vector_type(2))) unsigned u32x2;
typedef __attribute__((ext_vector_type(2))) __bf16 bf16x2_t;

#define DI __device__ __forceinline__
#define MFMA32(a, b, c) __builtin_amdgcn_mfma_f32_32x32x16_bf16((a), (b), (c), 0, 0, 0)

DI int tidx_opaque() { int t = threadIdx.x; asm volatile("" : "+v"(t)); return t; }
#define TIDX tidx_opaque()
DI bf16 f2bf(float x) { return __builtin_bit_cast(unsigned short, (__bf16)x); }
DI float bf2f(bf16 v) { return __uint_as_float(((unsigned)v) << 16); }
DI unsigned pack2(float a, float b) {
  f32x2 v = {a, b};
  return __builtin_bit_cast(unsigned, __builtin_convertvector(v, bf16x2_t));
}
DI float bflo(unsigned u) { return __uint_as_float(u << 16); }
DI float bfhi(unsigned u) { return __uint_as_float(u & 0xffff0000u); }
typedef const __attribute__((address_space(1))) u32x4* gptr16;
DI u32x4 ldg16(const void* q) { return *(gptr16)(uintptr_t)q; }
#define SCHED_FENCE() __builtin_amdgcn_sched_barrier(0)
DI int crow(int i, int h) { return (i & 3) + 8 * (i >> 2) + 4 * h; }
DI void sincos_cw(float x, float& sn, float& cs) {
  const float k = rintf(x * 0.63661977236758134f);
  float r = fmaf(-k, 1.57079637050628662109375f, x);
  r = fmaf(-k, -4.371139000186241e-08f, r);
  const int q = ((int)k) & 3;
  const float r2 = r * r;
  const float sp = r + r * r2 * (-1.6666667163e-01f + r2 * (8.3333337680e-03f + r2 * (-1.9841270114e-04f + r2 * 2.7557314297e-06f)));
  const float cp = 1.f + r2 * (-0.5f + r2 * (4.1666667908e-02f + r2 * (-1.3888889225e-03f + r2 * (2.4801587642e-05f - r2 * 2.7557314297e-07f))));
  sn = (q == 0) ? sp : (q == 1) ? cp : (q == 2) ? -sp : -cp;
  cs = (q == 0) ? cp : (q == 1) ? -sp : (q == 2) ? -cp : sp;
}
DI float sigmoidf_(float x) { return 1.f / (1.f + __expf(-x)); }
DI float siluf_(float x) { return x / (1.f + __expf(-x)); }

constexpr int DM = 1024, NB = 4, SEQ = 8192, CTXL = 256, TT = SEQ + CTXL, NTOK = NB * TT, NL = 4;
constexpr int DFF = 2816, DIN = 5408;
constexpr float EPSF = 1e-6f;
constexpr int NG33 = 33;
constexpr int NCH = 264;
constexpr int MS5 = NB * NCH;

constexpr size_t SZ_H = (size_t)NTOK * 1024 * 2;
constexpr size_t OFF_H = 0;
constexpr size_t OFF_P = OFF_H + SZ_H;
constexpr size_t OFF_Q = OFF_P;
constexpr size_t OFF_K = OFF_Q + (size_t)NTOK * 256 * 2;
constexpr size_t OFF_VT = OFF_K + (size_t)NTOK * 128 * 2;
constexpr size_t OFF_GQ = OFF_VT + (size_t)NTOK * 128 * 2;
constexpr size_t OFF_GK = OFF_GQ + (size_t)NTOK * 256 * 2;
constexpr size_t OFF_GVT = OFF_GK + (size_t)NTOK * 256 * 2;
constexpr size_t OFF_GR = OFF_GVT + (size_t)NTOK * 512 * 2;
constexpr size_t OFF_SU = OFF_GR + (size_t)NTOK * 512 * 2;
constexpr size_t OFF_LOW = OFF_SU + (size_t)NTOK * 256 * 2;
constexpr size_t OFF_O = OFF_LOW + (size_t)NTOK * 32 * 4;
constexpr size_t OFF_OATT = OFF_O;
constexpr size_t OFF_OGLA = OFF_OATT + (size_t)NTOK * 256 * 2;
constexpr size_t OFF_Y5 = OFF_OGLA + (size_t)NTOK * 512 * 2;
constexpr size_t OFF_EN = OFF_Y5;
constexpr size_t OFF_OS5 = OFF_Y5 + (size_t)NTOK * 256 * 2;
constexpr size_t OFF_M = OFF_OS5 + (size_t)NTOK * 256 * 2;
constexpr size_t OFF_MG = OFF_M;
constexpr size_t OFF_GS = OFF_M;
constexpr size_t OFF_DECG = OFF_GS + (size_t)32 * 33 * 8192 * 4;
constexpr size_t OFF_SB = OFF_DECG + (size_t)32 * 33 * 64 * 4;
constexpr size_t OFF_T5 = OFF_SB + (size_t)MS5 * 16 * 256 * 2;
constexpr size_t OFF_E5 = OFF_T5 + (size_t)16 * 512 * 512 * 2;
constexpr size_t OFF_F5 = OFF_E5 + (size_t)16 * 512 * 256 * 2;
constexpr size_t OFF_MEND = OFF_F5 + (size_t)16 * 256 * 512 * 2;
static_assert(OFF_MEND <= OFF_M + SZ_H, "mixer scratch overflows merged area");
constexpr size_t OFF_W = OFF_M + SZ_H;
constexpr size_t WL_WIN = 0, WL_BRA = WL_WIN + (size_t)5504 * 1024, WL_BRG = WL_BRA + 1024 * 256, WL_BRS = WL_BRG + 1024 * 512,
                 WL_WOUT = WL_BRS + 1024 * 256, WL_UP = WL_WOUT + 1024 * 1024, WL_DOWN = WL_UP + (size_t)5632 * 1024,
                 WL_GLU = WL_DOWN + (size_t)1024 * 2816, WL_TOTAL = WL_GLU + 256 * 256;
constexpr size_t OFF_XC = OFF_W + WL_TOTAL * 2 * NL;
constexpr size_t OFF_MOD = OFF_XC + (size_t)NB * CTXL * 1024 * 4;
constexpr size_t OFF_BBR = OFF_MOD + (size_t)NL * 5 * 6144 * 4;
constexpr size_t OFF_BBI = OFF_BBR + (size_t)NL * 2 * 16 * 64 * 16 * 4;
constexpr size_t OFF_PWR = OFF_BBI + (size_t)NL * 2 * 16 * 64 * 16 * 4;
constexpr size_t OFF_KTAB = OFF_PWR + (size_t)NL * 2 * 16 * 33 * 64 * 8;
constexpr size_t OFF_END = OFF_KTAB + (size_t)NL * 16 * 2 * 32 * 256 * 4;
constexpr size_t OFF_BAR = OFF_END;
constexpr size_t OFF_ZERO = OFF_BAR + 16384;
constexpr size_t OFF_G = OFF_P;
static_assert((size_t)NTOK * DFF * 2 <= OFF_M - OFF_P, "G overflows");

constexpr int SMEM_BYTES = 73728;

struct Params {
  const float* in[34];
  float* out;
  char* ws;
};

enum { I_X = 0, I_C, I_CTX, I_CCTX, I_ADAW, I_ADAB, I_NMPRE, I_NMPOST, I_NFPRE, I_NFPOST, I_WIN, I_QN, I_KN, I_GGW, I_GGB, I_GON,
       I_ARE, I_AIM, I_LDT, I_BRE, I_BIM, I_CRE, I_CIM, I_S5D, I_GLUW, I_GLUB, I_WBA, I_WBG, I_WBS, I_WOUT, I_UP, I_CW, I_CB, I_DOWN };

constexpr int LDT = 72;
constexpr int CLD = 132;

template <class FA, class FB>
DI void gemm_main(f32x16 (&acc)[2][2], FA fa, FB fb, int K, char* smem) {
  bf16* As = (bf16*)smem;
  bf16* Bs = (bf16*)(smem + 2 * 128 * LDT * 2);
  const int tid = TIDX, lane = tid & 63, w = tid >> 6, wm = w >> 1, wn = w & 1;
  const int r = lane & 31, h = lane >> 5;
  const int lr = tid >> 3, kc = (tid & 7) * 8;
  const bf16* ap[4];
  const bf16* bp[4];
#pragma unroll
  for (int i = 0; i < 4; ++i) {
    const bf16* a = fa(lr + 32 * i);
    const bf16* b = fb(lr + 32 * i);
    ap[i] = a ? a + kc : nullptr;
    bp[i] = b ? b + kc : nullptr;
  }
  u32x4 ra[4], rb[4];
  const u32x4 z4 = {0u, 0u, 0u, 0u};
#pragma unroll
  for (int i = 0; i < 4; ++i) {
    ra[i] = ap[i] ? ldg16(ap[i]) : z4;
    rb[i] = bp[i] ? ldg16(bp[i]) : z4;
  }
#pragma unroll
  for (int i = 0; i < 4; ++i) {
    *(u32x4*)(As + (lr + 32 * i) * LDT + kc) = ra[i];
    *(u32x4*)(Bs + (lr + 32 * i) * LDT + kc) = rb[i];
  }
  __syncthreads();
  const int nk = K / 64;
  for (int kt = 0; kt < nk; ++kt) {
    const int buf = kt & 1;
    const bool more = (kt + 1 < nk);
    if (more) {
      const int k0 = (kt + 1) * 64;
#pragma unroll
      for (int i = 0; i < 4; ++i) {
        ra[i] = ap[i] ? ldg16(ap[i] + k0) : z4;
        rb[i] = bp[i] ? ldg16(bp[i] + k0) : z4;
      }
    }
    SCHED_FENCE();
    const bf16* Ab = As + buf * 128 * LDT + (wm * 64 + r) * LDT + h * 8;
    const bf16* Bb = Bs + buf * 128 * LDT + (wn * 64 + r) * LDT + h * 8;
#pragma unroll
    for (int s = 0; s < 4; ++s) {
      s16x8 a0 = *(const s16x8*)(Ab + s * 16);
      s16x8 a1 = *(const s16x8*)(Ab + 32 * LDT + s * 16);
      s16x8 b0 = *(const s16x8*)(Bb + s * 16);
      s16x8 b1 = *(const s16x8*)(Bb + 32 * LDT + s * 16);
      acc[0][0] = MFMA32(a0, b0, acc[0][0]);
      acc[0][1] = MFMA32(a0, b1, acc[0][1]);
      acc[1][0] = MFMA32(a1, b0, acc[1][0]);
      acc[1][1] = MFMA32(a1, b1, acc[1][1]);
    }
    SCHED_FENCE();
    if (more) {
      bf16* Aw = As + (buf ^ 1) * 128 * LDT;
      bf16* Bw = Bs + (buf ^ 1) * 128 * LDT;
#pragma unroll
      for (int i = 0; i < 4; ++i) {
        *(u32x4*)(Aw + (lr + 32 * i) * LDT + kc) = ra[i];
        *(u32x4*)(Bw + (lr + 32 * i) * LDT + kc) = rb[i];
      }
    }
    __syncthreads();
  }
}

template <class FA, class FB>
DI void gemm_main_deep(f32x16 (&acc)[2][2], FA fa, FB fb, int K, char* smem) {
  bf16* As = (bf16*)smem;
  bf16* Bs = (bf16*)(smem + 2 * 128 * LDT * 2);
  const int tid = TIDX, lane = tid & 63, w = tid >> 6, wm = w >> 1, wn = w & 1;
  const int r = lane & 31, h = lane >> 5;
  const int lr = tid >> 3, kc = (tid & 7) * 8;
  const bf16* ap[4];
  const bf16* bp[4];
#pragma unroll
  for (int i = 0; i < 4; ++i) {
    const bf16* a = fa(lr + 32 * i);
    const bf16* b = fb(lr + 32 * i);
    ap[i] = a ? a + kc : nullptr;
    bp[i] = b ? b + kc : nullptr;
  }
  const u32x4 z4 = {0u, 0u, 0u, 0u};
  u32x4 a0[4], b0[4], a1[4], b1[4];
  const int nk = K / 64;
#define GD_LOAD(RA, RB, T)                                               \
  {                                                                      \
    const int k0_ = (T) * 64;                                            \
    _Pragma("unroll") for (int i = 0; i < 4; ++i) {                      \
      RA[i] = ap[i] ? ldg16(ap[i] + k0_) : z4;                           \
      RB[i] = bp[i] ? ldg16(bp[i] + k0_) : z4;                           \
    }                                                                    \
  }
#define GD_STORE(RA, RB, BUF)                                            \
  {                                                                      \
    _Pragma("unroll") for (int i = 0; i < 4; ++i) {                      \
      *(u32x4*)(As + (BUF) * 128 * LDT + (lr + 32 * i) * LDT + kc) = RA[i]; \
      *(u32x4*)(Bs + (BUF) * 128 * LDT + (lr + 32 * i) * LDT + kc) = RB[i]; \
    }                                                                    \
  }
#define GD_COMPUTE(BUF)                                                  \
  {                                                                      \
    const bf16* Ab = As + (BUF) * 128 * LDT + (wm * 64 + r) * LDT + h * 8; \
    const bf16* Bb = Bs + (BUF) * 128 * LDT + (wn * 64 + r) * LDT + h * 8; \
    _Pragma("unroll") for (int s = 0; s < 4; ++s) {                      \
      s16x8 fa0 = *(const s16x8*)(Ab + s * 16);                          \
      s16x8 fa1 = *(const s16x8*)(Ab + 32 * LDT + s * 16);               \
      s16x8 fb0 = *(const s16x8*)(Bb + s * 16);                          \
      s16x8 fb1 = *(const s16x8*)(Bb + 32 * LDT + s * 16);               \
      acc[0][0] = MFMA32(fa0, fb0, acc[0][0]);                           \
      acc[0][1] = MFMA32(fa0, fb1, acc[0][1]);                           \
      acc[1][0] = MFMA32(fa1, fb0, acc[1][0]);                           \
      acc[1][1] = MFMA32(fa1, fb1, acc[1][1]);                           \
    }                                                                    \
  }
  GD_LOAD(a0, b0, 0)
  GD_LOAD(a1, b1, 1)
  GD_STORE(a0, b0, 0)
  __syncthreads();
  if (nk > 2) GD_LOAD(a0, b0, 2)
  for (int kt = 0; kt < nk; kt += 2) {
    SCHED_FENCE();
    GD_COMPUTE(0)
    SCHED_FENCE();
    GD_STORE(a1, b1, 1)
    if (kt + 3 < nk) GD_LOAD(a1, b1, kt + 3)
    __syncthreads();
    SCHED_FENCE();
    GD_COMPUTE(1)
    SCHED_FENCE();
    if (kt + 2 < nk) {
      GD_STORE(a0, b0, 0)
      if (kt + 4 < nk) GD_LOAD(a0, b0, kt + 4)
    }
    __syncthreads();
  }
#undef GD_LOAD
#undef GD_STORE
#undef GD_COMPUTE
}

template <class FA, class FB>
DI void gemm_main_dma(f32x16 (&acc)[2][2], FA fa, FB fb, int K, char* smem) {
  char* As = smem;
  char* Bs = smem + 32768;
  const int tid = TIDX, lane = tid & 63, w = tid >> 6, wm = w >> 1, wn = w & 1;
  const int r = lane & 31, h = lane >> 5;
  const bf16* ap[4];
  const bf16* bp[4];
#pragma unroll
  for (int i = 0; i < 4; ++i) {
    const int row = w * 32 + i * 8 + (lane >> 3);
    const int c = (lane & 7) ^ ((row >> 1) & 7);
    ap[i] = fa(row) + c * 8;
    bp[i] = fb(row) + c * 8;
  }
  const int ldst = (w * 256 + lane) * 16;
#define GM_DMA(BUF, T)                                                                                        \
  {                                                                                                           \
    const int k0_ = (T) * 64;                                                                                 \
    _Pragma("unroll") for (int i = 0; i < 4; ++i) {                                                           \
      __builtin_amdgcn_global_load_lds((const unsigned*)(ap[i] + k0_), (unsigned*)(As + (BUF) * 16384 + ldst + i * 1024), 16, 0, 0); \
      __builtin_amdgcn_global_load_lds((const unsigned*)(bp[i] + k0_), (unsigned*)(Bs + (BUF) * 16384 + ldst + i * 1024), 16, 0, 0); \
    }                                                                                                         \
  }
  const int xr = (r >> 1) & 7;
  const int arow = (wm * 64 + r) * 128, brow = (wn * 64 + r) * 128;
  GM_DMA(0, 0)
  asm volatile("s_waitcnt vmcnt(0)" ::: "memory");
  __syncthreads();
  const int nk = K / 64;
  for (int kt = 0; kt < nk; ++kt) {
    const int buf = kt & 1;
    if (kt + 1 < nk) GM_DMA(buf ^ 1, kt + 1)
    const char* Ab = As + buf * 16384 + arow;
    const char* Bb = Bs + buf * 16384 + brow;
#pragma unroll
    for (int s = 0; s < 4; ++s) {
      const int co = ((2 * s + h) ^ xr) * 16;
      s16x8 a0 = *(const s16x8*)(Ab + co);
      s16x8 a1 = *(const s16x8*)(Ab + 32 * 128 + co);
      s16x8 b0 = *(const s16x8*)(Bb + co);
      s16x8 b1 = *(const s16x8*)(Bb + 32 * 128 + co);
      acc[0][0] = MFMA32(a0, b0, acc[0][0]);
      acc[0][1] = MFMA32(a0, b1, acc[0][1]);
      acc[1][0] = MFMA32(a1, b0, acc[1][0]);
      acc[1][1] = MFMA32(a1, b1, acc[1][1]);
    }
    asm volatile("s_waitcnt vmcnt(0)" ::: "memory");
    __syncthreads();
  }
#undef GM_DMA
}

DI void gemm_main_dma_half(f32x16 (&acc)[2], const bf16* A, int lda, const bf16* B, int ldb, int K, int hf, char* smem) {
  char* As = smem;
  char* Bs = smem + 32768;
  const int tid = TIDX, lane = tid & 63, w = tid >> 6, wm = w >> 1, wn = w & 1;
  const int r = lane & 31, h = lane >> 5;
  const bf16* ap[4];
  const bf16* bp[2];
#pragma unroll
  for (int i = 0; i < 4; ++i) {
    const int row = w * 32 + i * 8 + (lane >> 3);
    ap[i] = A + (size_t)row * lda + ((lane & 7) ^ ((row >> 1) & 7)) * 8;
  }
#pragma unroll
  for (int i = 0; i < 2; ++i) {
    const int lrow = w * 16 + i * 8 + (lane >> 3);
    const int grow = (lrow >> 5) * 64 + hf * 32 + (lrow & 31);
    bp[i] = B + (size_t)grow * ldb + ((lane & 7) ^ ((lrow >> 1) & 7)) * 8;
  }
  const int lda_ = (w * 256 + lane) * 16, ldb_ = (w * 128 + lane) * 16;
#define GH_DMA(BUF, T)                                                                                        \
  {                                                                                                           \
    const int k0_ = (T) * 64;                                                                                 \
    _Pragma("unroll") for (int i = 0; i < 4; ++i)                                                             \
      __builtin_amdgcn_global_load_lds((const unsigned*)(ap[i] + k0_), (unsigned*)(As + (BUF) * 16384 + lda_ + i * 1024), 16, 0, 0); \
    _Pragma("unroll") for (int i = 0; i < 2; ++i)                                                             \
      __builtin_amdgcn_global_load_lds((const unsigned*)(bp[i] + k0_), (unsigned*)(Bs + (BUF) * 8192 + ldb_ + i * 1024), 16, 0, 0); \
  }
  const int xr = (r >> 1) & 7;
  const int arow = (wm * 64 + r) * 128, brow = (wn * 32 + r) * 128;
  GH_DMA(0, 0)
  asm volatile("s_waitcnt vmcnt(0)" ::: "memory");
  __syncthreads();
  const int nk = K / 64;
  for (int kt = 0; kt < nk; ++kt) {
    const int buf = kt & 1;
    if (kt + 1 < nk) GH_DMA(buf ^ 1, kt + 1)
    const char* Ab = As + buf * 16384 + arow;
    const char* Bb = Bs + buf * 8192 + brow;
#pragma unroll
    for (int s = 0; s < 4; ++s) {
      const int co = ((2 * s + h) ^ xr) * 16;
      s16x8 a0 = *(const s16x8*)(Ab + co);
      s16x8 a1 = *(const s16x8*)(Ab + 32 * 128 + co);
      s16x8 b0 = *(const s16x8*)(Bb + co);
      acc[0] = MFMA32(a0, b0, acc[0]);
      acc[1] = MFMA32(a1, b0, acc[1]);
    }
    asm volatile("s_waitcnt vmcnt(0)" ::: "memory");
    __syncthreads();
  }
#undef GH_DMA
}

template <class FA, class FB>
DI void gemm_wide(f32x16 (&acc)[2][4], FA fa, FB fb, int K, char* smem) {
  const int tid = TIDX, lane = tid & 63, w = tid >> 6, wm = w >> 1, wn = w & 1;
  const int r = lane & 31, h = lane >> 5;
  const bf16* ap[2];
  const bf16* bp[4];
#pragma unroll
  for (int i = 0; i < 2; ++i) {
    const int row = w * 32 + i * 16 + (lane >> 2);
    ap[i] = fa(row) + ((lane & 3) ^ ((row >> 2) & 3)) * 8;
  }
#pragma unroll
  for (int i = 0; i < 4; ++i) {
    const int row = w * 64 + i * 16 + (lane >> 2);
    bp[i] = fb(row) + ((lane & 3) ^ ((row >> 2) & 3)) * 8;
  }
  const int lda_ = (w * 128 + lane) * 16;
  const int ldb_ = 8192 + (w * 256 + lane) * 16;
#define GW_DMA(T)                                                                                                   \
  {                                                                                                                 \
    char* st_ = smem + ((T) % 3) * 24576;                                                                           \
    const int k0_ = (T) * 32;                                                                                       \
    _Pragma("unroll") for (int i = 0; i < 2; ++i)                                                                   \
      __builtin_amdgcn_global_load_lds((const unsigned*)(ap[i] + k0_), (unsigned*)(st_ + lda_ + i * 1024), 16, 0, 0); \
    _Pragma("unroll") for (int i = 0; i < 4; ++i)                                                                   \
      __builtin_amdgcn_global_load_lds((const unsigned*)(bp[i] + k0_), (unsigned*)(st_ + ldb_ + i * 1024), 16, 0, 0); \
  }
  const int xr = (r >> 2) & 3;
  const int arow = (wm * 64 + r) * 64;
  const int brow = 8192 + (wn * 64 + r) * 64;
  const int nt = K / 32;
  GW_DMA(0)
  if (nt > 1) GW_DMA(1)
  for (int t = 0; t < nt; ++t) {
    if (t + 1 < nt) asm volatile("s_waitcnt vmcnt(6)" ::: "memory");
    else asm volatile("s_waitcnt vmcnt(0)" ::: "memory");
    __syncthreads();
    if (t + 2 < nt) GW_DMA(t + 2)
    const char* st = smem + (t % 3) * 24576;
#pragma unroll
    for (int s = 0; s < 2; ++s) {
      const int co = ((2 * s + h) ^ xr) * 16;
      const s16x8 a0 = *(const s16x8*)(st + arow + co);
      const s16x8 a1 = *(const s16x8*)(st + arow + 32 * 64 + co);
#pragma unroll
      for (int hn = 0; hn < 2; ++hn) {
        const s16x8 b0 = *(const s16x8*)(st + brow + hn * 128 * 64 + co);
        const s16x8 b1 = *(const s16x8*)(st + brow + hn * 128 * 64 + 32 * 64 + co);
        acc[0][hn * 2 + 0] = MFMA32(a0, b0, acc[0][hn * 2 + 0]);
        acc[0][hn * 2 + 1] = MFMA32(a0, b1, acc[0][hn * 2 + 1]);
        acc[1][hn * 2 + 0] = MFMA32(a1, b0, acc[1][hn * 2 + 0]);
        acc[1][hn * 2 + 1] = MFMA32(a1, b1, acc[1][hn * 2 + 1]);
      }
    }
  }
  __syncthreads();
#undef GW_DMA
}

DI void accw_zero(f32x16 (&acc)[2][4]) {
#pragma unroll
  for (int a = 0; a < 2; ++a)
#pragma unroll
    for (int b = 0; b < 4; ++b)
#pragma unroll
      for (int i = 0; i < 16; ++i) acc[a][b][i] = 0.f;
}

DI void gemm_main_s(f32x16 (&acc)[2][2], const bf16* A, int lda, const bf16* B, int ldb, int K, char* smem) {
  bf16* As = (bf16*)smem;
  bf16* Bs = (bf16*)(smem + 2 * 128 * LDT * 2);
  const int tid = TIDX, lane = tid & 63, w = tid >> 6, wm = w >> 1, wn = w & 1;
  const int r = lane & 31, h = lane >> 5;
  const int lr = tid >> 3, kc = (tid & 7) * 8;
  const bf16* ap = A + (size_t)lr * lda + kc;
  const bf16* bp = B + (size_t)lr * ldb + kc;
  const size_t sa = (size_t)32 * lda, sb = (size_t)32 * ldb;
  u32x4 ra[4], rb[4];
#pragma unroll
  for (int i = 0; i < 4; ++i) {
    ra[i] = ldg16(ap + i * sa);
    rb[i] = ldg16(bp + i * sb);
  }
#pragma unroll
  for (int i = 0; i < 4; ++i) {
    *(u32x4*)(As + (lr + 32 * i) * LDT + kc) = ra[i];
    *(u32x4*)(Bs + (lr + 32 * i) * LDT + kc) = rb[i];
  }
  __syncthreads();
  const int nk = K / 64;
  for (int kt = 0; kt < nk; ++kt) {
    const int buf = kt & 1;
    const bool more = (kt + 1 < nk);
    if (more) {
      ap += 64; bp += 64;
#pragma unroll
      for (int i = 0; i < 4; ++i) {
        ra[i] = ldg16(ap + i * sa);
        rb[i] = ldg16(bp + i * sb);
      }
    }
    SCHED_FENCE();
    const bf16* Ab = As + buf * 128 * LDT + (wm * 64 + r) * LDT + h * 8;
    const bf16* Bb = Bs + buf * 128 * LDT + (wn * 64 + r) * LDT + h * 8;
#pragma unroll
    for (int s = 0; s < 4; ++s) {
      s16x8 a0 = *(const s16x8*)(Ab + s * 16);
      s16x8 a1 = *(const s16x8*)(Ab + 32 * LDT + s * 16);
      s16x8 b0 = *(const s16x8*)(Bb + s * 16);
      s16x8 b1 = *(const s16x8*)(Bb + 32 * LDT + s * 16);
      acc[0][0] = MFMA32(a0, b0, acc[0][0]);
      acc[0][1] = MFMA32(a0, b1, acc[0][1]);
      acc[1][0] = MFMA32(a1, b0, acc[1][0]);
      acc[1][1] = MFMA32(a1, b1, acc[1][1]);
    }
    SCHED_FENCE();
    if (more) {
      bf16* Aw = As + (buf ^ 1) * 128 * LDT;
      bf16* Bw = Bs + (buf ^ 1) * 128 * LDT;
#pragma unroll
      for (int i = 0; i < 4; ++i) {
        *(u32x4*)(Aw + (lr + 32 * i) * LDT + kc) = ra[i];
        *(u32x4*)(Bw + (lr + 32 * i) * LDT + kc) = rb[i];
      }
    }
    __syncthreads();
  }
}

DI void gemm_main_half(f32x16 (&acc)[2], const bf16* A, int lda, const bf16* B, int ldb, int K, int hf, char* smem) {
  bf16* As = (bf16*)smem;
  bf16* Bs = (bf16*)(smem + 2 * 128 * LDT * 2);
  const int tid = TIDX, lane = tid & 63, w = tid >> 6, wm = w >> 1, wn = w & 1;
  const int r = lane & 31, h = lane >> 5;
  const int lr = tid >> 3, kc = (tid & 7) * 8;
  const bf16* ap = A + (size_t)lr * lda + kc;
  const bf16* bp = B + (size_t)(hf * 32 + lr) * ldb + kc;
  const size_t sa = (size_t)32 * lda, sb = (size_t)64 * ldb;
  u32x4 ra[4], rb[2];
#pragma unroll
  for (int i = 0; i < 4; ++i) ra[i] = ldg16(ap + i * sa);
#pragma unroll
  for (int i = 0; i < 2; ++i) rb[i] = ldg16(bp + i * sb);
#pragma unroll
  for (int i = 0; i < 4; ++i) *(u32x4*)(As + (lr + 32 * i) * LDT + kc) = ra[i];
#pragma unroll
  for (int i = 0; i < 2; ++i) *(u32x4*)(Bs + (lr + 32 * i) * LDT + kc) = rb[i];
  __syncthreads();
  const int nk = K / 64;
  for (int kt = 0; kt < nk; ++kt) {
    const int buf = kt & 1;
    const bool more = (kt + 1 < nk);
    if (more) {
      ap += 64; bp += 64;
#pragma unroll
      for (int i = 0; i < 4; ++i) ra[i] = ldg16(ap + i * sa);
#pragma unroll
      for (int i = 0; i < 2; ++i) rb[i] = ldg16(bp + i * sb);
    }
    SCHED_FENCE();
    const bf16* Ab = As + buf * 128 * LDT + (wm * 64 + r) * LDT + h * 8;
    const bf16* Bb = Bs + buf * 128 * LDT + (wn * 32 + r) * LDT + h * 8;
#pragma unroll
    for (int s = 0; s < 4; ++s) {
      s16x8 a0 = *(const s16x8*)(Ab + s * 16);
      s16x8 a1 = *(const s16x8*)(Ab + 32 * LDT + s * 16);
      s16x8 b0 = *(const s16x8*)(Bb + s * 16);
      acc[0] = MFMA32(a0, b0, acc[0]);
      acc[1] = MFMA32(a1, b0, acc[1]);
    }
    SCHED_FENCE();
    if (more) {
      bf16* Aw = As + (buf ^ 1) * 128 * LDT;
      bf16* Bw = Bs + (buf ^ 1) * 128 * LDT;
#pragma unroll
      for (int i = 0; i < 4; ++i) *(u32x4*)(Aw + (lr + 32 * i) * LDT + kc) = ra[i];
#pragma unroll
      for (int i = 0; i < 2; ++i) *(u32x4*)(Bw + (lr + 32 * i) * LDT + kc) = rb[i];
    }
    __syncthreads();
  }
}

DI void acc_zero(f32x16 (&acc)[2][2]) {
#pragma unroll
  for (int a = 0; a < 2; ++a)
#pragma unroll
    for (int b = 0; b < 2; ++b)
#pragma unroll
      for (int i = 0; i < 16; ++i) acc[a][b][i] = 0.f;
}

DI void acc_to_lds(const f32x16 (&acc)[2][2], float* Cs) {
  const int lane = TIDX & 63, w = TIDX >> 6, wm = w >> 1, wn = w & 1, r = lane & 31, h = lane >> 5;
#pragma unroll
  for (int tm = 0; tm < 2; ++tm)
#pragma unroll
    for (int tn = 0; tn < 2; ++tn)
#pragma unroll
      for (int i = 0; i < 16; ++i) Cs[(wm * 64 + tm * 32 + crow(i, h)) * CLD + wn * 64 + tn * 32 + r] = acc[tm][tn][i];
}

template <int HN>
DI void accw_to_lds(const f32x16 (&acc)[2][4], float* Cs) {
  const int lane = TIDX & 63, w = TIDX >> 6, wm = w >> 1, wn = w & 1, r = lane & 31, h = lane >> 5;
#pragma unroll
  for (int tm = 0; tm < 2; ++tm)
#pragma unroll
    for (int tn = 0; tn < 2; ++tn)
#pragma unroll
      for (int i = 0; i < 16; ++i) Cs[(wm * 64 + tm * 32 + crow(i, h)) * CLD + wn * 64 + tn * 32 + r] = acc[tm][HN * 2 + tn][i];
}

DI void store_tile_bf16(const float* Cs, bf16* dst, size_t ld, int mvalid, float scale) {
  for (int c = TIDX; c < 2048; c += 256) {
    const int row = c >> 4, cc = (c & 15) * 8;
    if (row < mvalid) {
      const float* s = Cs + row * CLD + cc;
      u32x4 v;
      v[0] = pack2(s[0] * scale, s[1] * scale);
      v[1] = pack2(s[2] * scale, s[3] * scale);
      v[2] = pack2(s[4] * scale, s[5] * scale);
      v[3] = pack2(s[6] * scale, s[7] * scale);
      *(u32x4*)(dst + (size_t)row * ld + cc) = v;
    }
  }
}

DI float* resid_row(const Params& p, int tok) {
  const int b = tok / TT, t = tok - b * TT;
  return (t < CTXL) ? (float*)(p.ws + OFF_XC) + ((size_t)b * CTXL + t) * DM : p.out + ((size_t)b * SEQ + (t - CTXL)) * DM;
}
DI const float* mod_vec(const Params& p, int l, int tok, int which) {
  const int b = tok / TT, t = tok - b * TT;
  const int m = (t < CTXL) ? 4 : b;
  return (const float*)(p.ws + OFF_MOD) + ((size_t)(l * 5 + m) * 6 + which) * DM;
}
DI float wave_sum(float v) {
#pragma unroll
  for (int o = 32; o >= 1; o >>= 1) v += __shfl_xor(v, o, 64);
  return v;
}
DI bf16* wl(const Params& p, int l, size_t off) { return (bf16*)(p.ws + OFF_W) + (size_t)l * WL_TOTAL + off; }

DI void prep_mod_job(const Params& p, int j, char* smem) {
  float* sc = (float*)smem;
  float* part = (float*)(smem + 20480);
  const int l = j / 24, nb = j % 24, tid = TIDX, lane = tid & 63, w = tid >> 6;
  for (int idx = tid; idx < 5120; idx += 256) {
    const int m = idx >> 10, k = idx & 1023;
    const float v = (m < 4) ? p.in[I_C][m * 1024 + k] : p.in[I_CCTX][k];
    sc[idx] = siluf_(v);
  }
  __syncthreads();
  const float* W = p.in[I_ADAW] + (size_t)l * 1024 * 6144 + nb * 256 + lane;
  float a[5][4];
#pragma unroll
  for (int m = 0; m < 5; ++m)
#pragma unroll
    for (int c = 0; c < 4; ++c) a[m][c] = 0.f;
#pragma unroll 4
  for (int kk = 0; kk < 256; ++kk) {
    const int k = w * 256 + kk;
    float wv[4];
#pragma unroll
    for (int c = 0; c < 4; ++c) wv[c] = W[(size_t)k * 6144 + 64 * c];
#pragma unroll
    for (int m = 0; m < 5; ++m) {
      const float sv = sc[m * 1024 + k];
#pragma unroll
      for (int c = 0; c < 4; ++c) a[m][c] += sv * wv[c];
    }
  }
#pragma unroll
  for (int m = 0; m < 5; ++m)
#pragma unroll
    for (int c = 0; c < 4; ++c) part[(w * 5 + m) * 256 + lane + 64 * c] = a[m][c];
  __syncthreads();
  const int n = nb * 256 + tid;
  const float bb = p.in[I_ADAB][l * 6144 + n];
  float* M = (float*)(p.ws + OFF_MOD) + (size_t)l * 5 * 6144 + n;
#pragma unroll
  for (int m = 0; m < 5; ++m)
    M[m * 6144] = part[(0 * 5 + m) * 256 + tid] + part[(1 * 5 + m) * 256 + tid] + part[(2 * 5 + m) * 256 + tid] + part[(3 * 5 + m) * 256 + tid] + bb;
  __syncthreads();
}

DI void prep_s5_job(const Params& p, int j) {
  const int idx = j * 256 + TIDX;
  const int ldg = idx >> 6, pp = idx & 63;
  const float dt = expf(p.in[I_LDT][ldg]);
  const float are = p.in[I_ARE][idx], aim = p.in[I_AIM][idx];
  const float mag = expf(are * dt);
  float sn, cs;
  sincos_cw(aim * dt, sn, cs);
  const float abr = mag * cs, abi = mag * sn;
  const float den = are * are + aim * aim;
  const float fre = ((abr - 1.f) * are + abi * aim) / den;
  const float fim = (abi * are - (abr - 1.f) * aim) / den;
  float* BBR = (float*)(p.ws + OFF_BBR);
  float* BBI = (float*)(p.ws + OFF_BBI);
  for (int hh = 0; hh < 16; ++hh) {
    const float br = p.in[I_BRE][(size_t)idx * 16 + hh], bi = p.in[I_BIM][(size_t)idx * 16 + hh];
    BBR[(size_t)idx * 16 + hh] = fre * br - fim * bi;
    BBI[(size_t)idx * 16 + hh] = fre * bi + fim * br;
  }
  float2* PW = (float2*)(p.ws + OFF_PWR);
  float pr = 1.f, pi = 0.f;
  for (int tau = 0; tau <= 32; ++tau) {
    PW[((size_t)ldg * 33 + tau) * 64 + pp] = make_float2(pr, pi);
    const float nr = pr * abr - pi * abi, ni = pr * abi + pi * abr;
    pr = nr; pi = ni;
  }
}

DI void prep_wt_job(const Params& p, int jj, char* smem) {
  float* tile = (float*)smem;
  const int l = jj / 4016;
  int r = jj % 4016;
  int mat = 0;
  const int cnt[8] = {1376, 64, 128, 64, 256, 1408, 704, 16};
#pragma unroll
  for (int m = 0; m < 8; ++m) {
    if (mat == m && r >= cnt[m]) { r -= cnt[m]; mat = m + 1; }
  }
  const float* src; int K, sld; size_t doff;
  switch (mat) {
    case 0: src = p.in[I_WIN] + (size_t)l * 1024 * DIN; K = 1024; sld = DIN; doff = WL_WIN; break;
    case 1: src = p.in[I_WBA] + (size_t)l * 256 * 1024; K = 256; sld = 1024; doff = WL_BRA; break;
    case 2: src = p.in[I_WBG] + (size_t)l * 512 * 1024; K = 512; sld = 1024; doff = WL_BRG; break;
    case 3: src = p.in[I_WBS] + (size_t)l * 256 * 1024; K = 256; sld = 1024; doff = WL_BRS; break;
    case 4: src = p.in[I_WOUT] + (size_t)l * 1024 * 1024; K = 1024; sld = 1024; doff = WL_WOUT; break;
    case 5: src = p.in[I_UP] + (size_t)l * 1024 * 5632; K = 1024; sld = 5632; doff = WL_UP; break;
    case 6: src = p.in[I_DOWN] + (size_t)l * 2816 * 1024; K = 2816; sld = 1024; doff = WL_DOWN; break;
    default: src = p.in[I_GLUW] + (size_t)l * 256 * 256; K = 256; sld = 256; doff = WL_GLU; break;
  }
  const int kt = K / 64;
  const int n0 = (r / kt) * 64, k0 = (r % kt) * 64;
  const int tid = TIDX;
  {
    const int nn = tid & 63;
    const int np = n0 + nn;
    int col;
    if (mat == 0) {
      if (np < 2048) col = np;
      else if (np < 2304) col = 2080 + (np - 2048);
      else if (np < 2336) col = 2048 + (np - 2304);
      else if (np < 2432) col = -1;
      else col = 2336 + (np - 2432);
    } else if (mat == 5) {
      const int jb = np >> 7, c = np & 127;
      col = (c < 64) ? (jb * 64 + c) : (DFF + jb * 64 + (c - 64));
    } else col = np;
#pragma unroll 4
    for (int kk = tid >> 6; kk < 64; kk += 4) tile[kk * 65 + nn] = (col >= 0) ? src[(size_t)(k0 + kk) * sld + col] : 0.f;
  }
  __syncthreads();
  {
    const int nn = tid >> 2, kq = (tid & 3) * 16;
    bf16* d = wl(p, l, doff) + (size_t)(n0 + nn) * K + k0 + kq;
    u32x4 v0, v1;
#pragma unroll
    for (int e = 0; e < 4; ++e) {
      v0[e] = pack2(tile[(kq + 2 * e) * 65 + nn], tile[(kq + 2 * e + 1) * 65 + nn]);
      v1[e] = pack2(tile[(kq + 8 + 2 * e) * 65 + nn], tile[(kq + 8 + 2 * e + 1) * 65 + nn]);
    }
    *(u32x4*)d = v0;
    *(u32x4*)(d + 8) = v1;
  }
  __syncthreads();
}

template <int MODE>
DI void row_job(const Params& p, int l, int tok) {
  const int lane = TIDX & 63;
  float x[16];
  float* xr = resid_row(p, tok);
  if (MODE == 0) {
    const int b = tok / TT, t = tok - b * TT;
    const float* src = (t < CTXL) ? p.in[I_CTX] + ((size_t)b * CTXL + t) * DM : p.in[I_X] + ((size_t)b * SEQ + (t - CTXL)) * DM;
#pragma unroll
    for (int i = 0; i < 4; ++i) {
      const f32x4 v = *(const f32x4*)(src + lane * 4 + 256 * i);
      x[4 * i] = v[0]; x[4 * i + 1] = v[1]; x[4 * i + 2] = v[2]; x[4 * i + 3] = v[3];
      *(f32x4*)(xr + lane * 4 + 256 * i) = v;
    }
  } else {
    const bf16* yr = (const bf16*)(p.ws + OFF_H) + (size_t)tok * DM;
    const float* gpost = p.in[MODE == 1 ? I_NMPOST : I_NFPOST] + l * DM;
    const float* mg = mod_vec(p, l, tok, MODE == 1 ? 2 : 5);
    float y[16];
    float ss = 0.f;
#pragma unroll
    for (int i = 0; i < 4; ++i) {
      const u32x2 u = *(const u32x2*)(yr + lane * 4 + 256 * i);
      y[4 * i] = bflo(u[0]); y[4 * i + 1] = bfhi(u[0]); y[4 * i + 2] = bflo(u[1]); y[4 * i + 3] = bfhi(u[1]);
#pragma unroll
      for (int e = 0; e < 4; ++e) ss += y[4 * i + e] * y[4 * i + e];
    }
    ss = wave_sum(ss);
    const float rstd = rsqrtf(ss * (1.f / DM) + EPSF);
#pragma unroll
    for (int i = 0; i < 4; ++i) {
      f32x4 v = *(const f32x4*)(xr + lane * 4 + 256 * i);
      const f32x4 g = *(const f32x4*)(gpost + lane * 4 + 256 * i);
      const f32x4 m = *(const f32x4*)(mg + lane * 4 + 256 * i);
#pragma unroll
      for (int e = 0; e < 4; ++e) { v[e] += m[e] * (y[4 * i + e] * rstd * g[e]); x[4 * i + e] = v[e]; }
      *(f32x4*)(xr + lane * 4 + 256 * i) = v;
    }
  }
  if (MODE == 2 && l == NL - 1) return;
  const int ln = (MODE == 2) ? l + 1 : l;
  const float* gpre = p.in[MODE == 1 ? I_NFPRE : I_NMPRE] + ln * DM;
  const float* sh = mod_vec(p, ln, tok, MODE == 1 ? 3 : 0);
  const float* scv = mod_vec(p, ln, tok, MODE == 1 ? 4 : 1);
  float ss = 0.f;
#pragma unroll
  for (int i = 0; i < 16; ++i) ss += x[i] * x[i];
  ss = wave_sum(ss);
  const float rstd = rsqrtf(ss * (1.f / DM) + EPSF);
  bf16* hr = (bf16*)(p.ws + OFF_H) + (size_t)tok * DM;
#pragma unroll
  for (int i = 0; i < 4; ++i) {
    const f32x4 g = *(const f32x4*)(gpre + lane * 4 + 256 * i);
    const f32x4 s1 = *(const f32x4*)(sh + lane * 4 + 256 * i);
    const f32x4 s2 = *(const f32x4*)(scv + lane * 4 + 256 * i);
    float o[4];
#pragma unroll
    for (int e = 0; e < 4; ++e) o[e] = (x[4 * i + e] * rstd * g[e]) * (1.f + s2[e]) + s1[e];
    u32x2 u;
    u[0] = pack2(o[0], o[1]); u[1] = pack2(o[2], o[3]);
    *(u32x2*)(hr + lane * 4 + 256 * i) = u;
  }
}

template <int MODE>
DI void row_phase(const Params& p, int l, int bid, int G) {
  const int lane = TIDX & 63;
  const int wg = bid * 4 + (TIDX >> 6), nw = G * 4;
  const int R = (NTOK + nw - 1) / nw;
  const int t0 = wg * R, t1 = min(NTOK, t0 + R);
  if (t0 >= t1) return;
  const bool has_next = !(MODE == 2 && l == NL - 1);
  const int ln = (MODE == 2) ? l + 1 : l;
  f32x4 gpost[4], gpre[4], mg[4], sh[4], scl[4];
#pragma unroll
  for (int i = 0; i < 4; ++i) {
    if (MODE != 0) gpost[i] = *(const f32x4*)(p.in[MODE == 1 ? I_NMPOST : I_NFPOST] + l * DM + lane * 4 + 256 * i);
    if (has_next) gpre[i] = *(const f32x4*)(p.in[MODE == 1 ? I_NFPRE : I_NMPRE] + ln * DM + lane * 4 + 256 * i);
  }
  int cur_m = -1;
  u32x2 yb[4], yn[4];
  f32x4 xb[4], xn[4];
  const bf16* Hb = (const bf16*)(p.ws + OFF_H);
#define ROW_LOAD(TOK, YY, XX)                                                                              \
  {                                                                                                        \
    const int b_ = (TOK) / TT, t_ = (TOK) - b_ * TT;                                                       \
    const float* src_ = (MODE == 0 || (MODE == 1 && l == 0)) ? ((t_ < CTXL) ? p.in[I_CTX] + ((size_t)b_ * CTXL + t_) * DM \
                                                   : p.in[I_X] + ((size_t)b_ * SEQ + (t_ - CTXL)) * DM)    \
                                    : resid_row(p, (TOK));                                                 \
    _Pragma("unroll") for (int i = 0; i < 4; ++i) {                                                        \
      XX[i] = *(const f32x4*)(src_ + lane * 4 + 256 * i);                                                  \
      if (MODE != 0) YY[i] = *(const u32x2*)(Hb + (size_t)(TOK) * DM + lane * 4 + 256 * i);                \
    }                                                                                                      \
  }
  ROW_LOAD(t0, yb, xb)
  for (int tok = t0; tok < t1; ++tok) {
    if (tok + 1 < t1) ROW_LOAD(tok + 1, yn, xn)
    const int b = tok / TT, t = tok - b * TT;
    const int m = (t < CTXL) ? 4 : b;
    if (m != cur_m) {
      cur_m = m;
      const float* Mv = (const float*)(p.ws + OFF_MOD);
#pragma unroll
      for (int i = 0; i < 4; ++i) {
        if (MODE != 0) mg[i] = *(const f32x4*)(Mv + ((size_t)(l * 5 + m) * 6 + (MODE == 1 ? 2 : 5)) * DM + lane * 4 + 256 * i);
        if (has_next) {
          sh[i] = *(const f32x4*)(Mv + ((size_t)(ln * 5 + m) * 6 + (MODE == 1 ? 3 : 0)) * DM + lane * 4 + 256 * i);
          scl[i] = *(const f32x4*)(Mv + ((size_t)(ln * 5 + m) * 6 + (MODE == 1 ? 4 : 1)) * DM + lane * 4 + 256 * i);
        }
      }
    }
    float* xr = resid_row(p, tok);
    f32x4 x[4];
    if (MODE == 0) {
#pragma unroll
      for (int i = 0; i < 4; ++i) x[i] = xb[i];
    } else {
      float y[16];
      float ss = 0.f;
#pragma unroll
      for (int i = 0; i < 4; ++i) {
        y[4 * i] = bflo(yb[i][0]); y[4 * i + 1] = bfhi(yb[i][0]); y[4 * i + 2] = bflo(yb[i][1]); y[4 * i + 3] = bfhi(yb[i][1]);
#pragma unroll
        for (int e = 0; e < 4; ++e) ss += y[4 * i + e] * y[4 * i + e];
      }
      ss = wave_sum(ss);
      const float rstd = rsqrtf(ss * (1.f / DM) + EPSF);
#pragma unroll
      for (int i = 0; i < 4; ++i) {
        f32x4 v = xb[i];
#pragma unroll
        for (int e = 0; e < 4; ++e) v[e] += mg[i][e] * (y[4 * i + e] * rstd * gpost[i][e]);
        x[i] = v;
        *(f32x4*)(xr + lane * 4 + 256 * i) = v;
      }
    }
    if (has_next) {
      float ss = 0.f;
#pragma unroll
      for (int i = 0; i < 4; ++i)
#pragma unroll
        for (int e = 0; e < 4; ++e) ss += x[i][e] * x[i][e];
      ss = wave_sum(ss);
      const float rstd = rsqrtf(ss * (1.f / DM) + EPSF);
      bf16* hr = (bf16*)(p.ws + OFF_H) + (size_t)tok * DM;
#pragma unroll
      for (int i = 0; i < 4; ++i) {
        float o[4];
#pragma unroll
        for (int e = 0; e < 4; ++e) o[e] = (x[i][e] * rstd * gpre[i][e]) * (1.f + scl[i][e]) + sh[i][e];
        u32x2 u;
        u[0] = pack2(o[0], o[1]); u[1] = pack2(o[2], o[3]);
        *(u32x2*)(hr + lane * 4 + 256 * i) = u;
      }
    }
#pragma unroll
    for (int i = 0; i < 4; ++i) { yb[i] = yn[i]; xb[i] = xn[i]; }
  }
#undef ROW_LOAD
}

DI void ktab_phase(const Params& p, int bid, int G, int l_lo, int l_hi) {
  const float* BBR = (const float*)(p.ws + OFF_BBR);
  const float* BBI = (const float*)(p.ws + OFF_BBI);
  const float2* PW = (const float2*)(p.ws + OFF_PWR);
  float* KT = (float*)(p.ws + OFF_KTAB);
  const int per_layer = 16 * 2 * 32 * 256;
  for (int idx = l_lo * per_layer + bid * 256 + TIDX; idx < l_hi * per_layer; idx += G * 256) {
    const int hp = idx & 15, hh = (idx >> 4) & 15, tau = (idx >> 8) & 31, d = (idx >> 13) & 1, g = (idx >> 14) & 15, l = idx >> 18;
    const int ldg = (l * 2 + d) * 16 + g;
    const float* cre = p.in[I_CRE] + ((size_t)ldg * 16 + hh) * 64;
    const float* cim = p.in[I_CIM] + ((size_t)ldg * 16 + hh) * 64;
    float acc = 0.f;
    for (int pp = 0; pp < 64; ++pp) {
      const float2 pw = PW[((size_t)ldg * 33 + tau) * 64 + pp];
      const float br = BBR[((size_t)ldg * 64 + pp) * 16 + hp], bi = BBI[((size_t)ldg * 64 + pp) * 16 + hp];
      const float zr = pw.x * br - pw.y * bi, zi = pw.x * bi + pw.y * br;
      acc += cre[pp] * zr - cim[pp] * zi;
    }
    KT[idx] = acc;
  }
}

DI void s5mat_phase(const Params& p, int l, int bid, int G) {
  const float* BBR = (const float*)(p.ws + OFF_BBR);
  const float* BBI = (const float*)(p.ws + OFF_BBI);
  const float2* PW = (const float2*)(p.ws + OFF_PWR);
  const float* KT = (const float*)(p.ws + OFF_KTAB);
  bf16* T5 = (bf16*)(p.ws + OFF_T5);
  bf16* E5 = (bf16*)(p.ws + OFF_E5);
  bf16* F5 = (bf16*)(p.ws + OFF_F5);
  const int nT = 16 * 512 * 64, nE = 16 * 512 * 32, nF = 16 * 256 * 64;
  for (int it = bid * 256 + TIDX; it < nT + nE + nF; it += G * 256) {
    float v[8];
    bf16* dst;
    if (it < nT) {
      const int k8 = it & 63, n = (it >> 6) & 511, g = it >> 15;
      const int i = n >> 4, hh = n & 15, j = k8 >> 1, hp0 = (k8 & 1) * 8;
#pragma unroll
      for (int e = 0; e < 8; ++e) {
        const int hp = hp0 + e;
        float a = 0.f;
        if (j <= i) a += KT[((((size_t)l * 16 + g) * 2 + 0) * 32 + (i - j)) * 256 + hh * 16 + hp];
        if (j >= i) a += KT[((((size_t)l * 16 + g) * 2 + 1) * 32 + (j - i)) * 256 + hh * 16 + hp];
        if (i == j && hh == hp) a += p.in[I_S5D][l * 256 + g * 16 + hh];
        v[e] = a;
      }
      dst = T5 + ((size_t)g * 512 + n) * 512 + k8 * 8;
    } else if (it < nT + nE) {
      const int q = it - nT;
      const int k8 = q & 31, n = (q >> 5) & 511, g = q >> 14;
      const int i = n >> 4, hh = n & 15;
      const int k0 = k8 * 8, d = k0 >> 7, ri = (k0 >> 6) & 1, p0 = k0 & 63;
      const int ldg = (l * 2 + d) * 16 + g;
      const int ex = d ? (32 - i) : (i + 1);
#pragma unroll
      for (int e = 0; e < 8; ++e) {
        const int pp = p0 + e;
        const float2 pw = PW[((size_t)ldg * 33 + ex) * 64 + pp];
        const float cr = p.in[I_CRE][((size_t)ldg * 16 + hh) * 64 + pp], ci = p.in[I_CIM][((size_t)ldg * 16 + hh) * 64 + pp];
        const float zr = cr * pw.x - ci * pw.y, zi = cr * pw.y + ci * pw.x;
        v[e] = ri ? -zi : zr;
      }
      dst = E5 + ((size_t)g * 512 + n) * 256 + k0;
    } else {
      const int q = it - nT - nE;
      const int k8 = q & 63, n = (q >> 6) & 255, g = q >> 14;
      const int d = n >> 7, ri = (n >> 6) & 1, pp = n & 63;
      const int j = k8 >> 1, hp0 = (k8 & 1) * 8;
      const int ldg = (l * 2 + d) * 16 + g;
      const int ex = d ? j : (31 - j);
      const float2 pw = PW[((size_t)ldg * 33 + ex) * 64 + pp];
#pragma unroll
      for (int e = 0; e < 8; ++e) {
        const float br = BBR[((size_t)ldg * 64 + pp) * 16 + hp0 + e], bi = BBI[((size_t)ldg * 64 + pp) * 16 + hp0 + e];
        v[e] = ri ? (pw.x * bi + pw.y * br) : (pw.x * br - pw.y * bi);
      }
      dst = F5 + ((size_t)g * 256 + n) * 512 + k8 * 8;
    }
    u32x4 u;
    u[0] = pack2(v[0], v[1]); u[1] = pack2(v[2], v[3]); u[2] = pack2(v[4], v[5]); u[3] = pack2(v[6], v[7]);
    *(u32x4*)dst = u;
  }
}

DI void proj_epi(const Params& p, int l, int mt, int nt, char* smem);
DI void proj_wide(const Params& p, int l, int mt, int np, char* smem) {
  const bf16* H = (const bf16*)(p.ws + OFF_H) + (size_t)mt * 128 * DM;
  const bf16* W = wl(p, l, WL_WIN) + (size_t)np * 256 * DM;
  if (np == 9) {
    f32x16 acc1[2][2];
    acc_zero(acc1);
    gemm_main_dma(acc1, [&](int r) { return H + (size_t)r * DM; }, [&](int r) { return W + (size_t)r * DM; }, DM, smem);
    acc_to_lds(acc1, (float*)smem);
    __syncthreads();
    proj_epi(p, l, mt, 18, smem);
    return;
  }
  f32x16 acc[2][4];
  accw_zero(acc);
  gemm_wide(acc, [&](int r) { return H + (size_t)r * DM; }, [&](int r) { return W + (size_t)r * DM; }, DM, smem);
  float* Cs = (float*)smem;
  accw_to_lds<0>(acc, Cs);
  __syncthreads();
  proj_epi(p, l, mt, np * 2, smem);
  if (np * 2 + 1 < 19) {
    accw_to_lds<1>(acc, Cs);
    __syncthreads();
    proj_epi(p, l, mt, np * 2 + 1, smem);
  }
}
DI void proj_epi(const Params& p, int l, int mt, int nt, char* smem) {
  float* Cs = (float*)smem;
  const int tid = TIDX;
  const int tok0 = mt * 128;
  const int b = tok0 / TT, t0 = tok0 - b * TT;
  if (nt <= 2) {
    const int row = tid >> 1, seg = tid & 1;
    float* c = Cs + row * CLD + seg * 64;
    const float* gn = p.in[nt < 2 ? I_QN : I_KN] + l * 64;
    float ss = 0.f;
#pragma unroll 8
    for (int i = 0; i < 64; ++i) ss += c[i] * c[i];
    const float rstd = rsqrtf(ss * (1.f / 64.f) + EPSF);
    const int t = t0 + row;
    const bool lat = t >= CTXL;
    const int s = t - CTXL;
#pragma unroll 1
    for (int ax = 0; ax < 2; ++ax) {
      const float pos = (float)(ax ? (s & 63) : (s >> 6));
#pragma unroll 2
      for (int f = 0; f < 16; ++f) {
        float x1 = c[ax * 32 + f] * rstd * gn[ax * 32 + f];
        float x2 = c[ax * 32 + 16 + f] * rstd * gn[ax * 32 + 16 + f];
        if (lat) {
          const float invf = exp2f(-(float)f * (13.287712379549449f / 16.f));
          float sn, cs;
          sincos_cw(pos * invf, sn, cs);
          const float y1 = x1 * cs - x2 * sn, y2 = x2 * cs + x1 * sn;
          x1 = y1; x2 = y2;
        }
        c[ax * 32 + f] = x1;
        c[ax * 32 + 16 + f] = x2;
      }
    }
    __syncthreads();
    if (nt < 2) store_tile_bf16(Cs, (bf16*)(p.ws + OFF_Q) + (size_t)tok0 * 256 + nt * 128, 256, 128, 0.125f * 1.4426950408889634f);
    else store_tile_bf16(Cs, (bf16*)(p.ws + OFF_K) + (size_t)tok0 * 128, 128, 128, 1.f);
  } else if (nt == 3 || (nt >= 8 && nt <= 11)) {
    for (int c = tid; c < 2048; c += 256) {
      const int col = c & 127, rc = (c >> 7) * 8;
      u32x4 u;
#pragma unroll
      for (int e = 0; e < 4; ++e) u[e] = pack2(Cs[(rc + 2 * e) * CLD + col], Cs[(rc + 2 * e + 1) * CLD + col]);
      bf16* dst;
      if (nt == 3) dst = (bf16*)(p.ws + OFF_VT) + ((size_t)(b * 2 + (col >> 6)) * 64 + (col & 63)) * TT + t0 + rc;
      else dst = (bf16*)(p.ws + OFF_GVT) + ((size_t)(b * 4 + (nt - 8)) * 128 + col) * TT + t0 + rc;
      *(u32x4*)dst = u;
    }
  } else if (nt == 4 || nt == 5) {
    store_tile_bf16(Cs, (bf16*)(p.ws + OFF_GQ) + (size_t)tok0 * 256 + (nt - 4) * 128, 256, 128, 0.125f);
  } else if (nt == 6 || nt == 7) {
    store_tile_bf16(Cs, (bf16*)(p.ws + OFF_GK) + (size_t)tok0 * 256 + (nt - 6) * 128, 256, 128, 1.f);
  } else if (nt >= 12 && nt <= 15) {
    store_tile_bf16(Cs, (bf16*)(p.ws + OFF_GR) + (size_t)tok0 * 512 + (nt - 12) * 128, 512, 128, 1.f);
  } else if (nt == 16 || nt == 17) {
    for (int c = tid; c < 2048; c += 256) {
      const int row = c >> 4, c8 = c & 15;
      const float* s = Cs + row * CLD + c8 * 8;
      u32x4 u;
#pragma unroll
      for (int e = 0; e < 4; ++e) u[e] = pack2(s[2 * e], s[2 * e + 1]);
      const int ch = (nt - 16) * 128 + c8 * 8;
      bf16* dst = (bf16*)(p.ws + OFF_SU) + ((size_t)(b * 16 + (ch >> 4)) * TT + t0 + row) * 16 + (ch & 15);
      *(u32x4*)dst = u;
    }
  } else {
    for (int c = tid; c < 128 * 8; c += 256) {
      const int row = c >> 3, c4 = (c & 7) * 4;
      const float* s = Cs + row * CLD + c4;
      f32x4 v = {s[0], s[1], s[2], s[3]};
      *(f32x4*)((float*)(p.ws + OFF_LOW) + (size_t)(tok0 + row) * 32 + c4) = v;
    }
  }
  __syncthreads();
}

DI void attn_unit(const Params& p, int u, char* smem) {
  int b, head, tok0, nkt;
  if (u < 1024) { b = u >> 8; head = (u >> 6) & 3; tok0 = b * TT + CTXL + (u & 63) * 128; nkt = TT / 128; }
  else { const int v = u - 1024; b = v >> 3; head = (v >> 1) & 3; tok0 = b * TT + (v & 1) * 128; nkt = CTXL / 128; }
  const int kvh = head >> 1;
  const int tid = TIDX, lane = tid & 63, w = tid >> 6, r = lane & 31, h = lane >> 5;
  const bf16* Qp = (const bf16*)(p.ws + OFF_Q) + (size_t)(tok0 + w * 32 + r) * 256 + head * 64 + h * 8;
  s16x8 qf[4];
#pragma unroll
  for (int s = 0; s < 4; ++s) qf[s] = __builtin_bit_cast(s16x8, ldg16(Qp + s * 16));
  const bf16* kp[2];
  const bf16* vp[2];
#pragma unroll
  for (int i = 0; i < 2; ++i) {
    const int row = w * 16 + i * 8 + (lane >> 3);
    const int c = (lane & 7) ^ ((row >> 1) & 7);
    kp[i] = (const bf16*)(p.ws + OFF_K) + ((size_t)b * TT + row) * 128 + kvh * 64 + c * 8;
    vp[i] = (const bf16*)(p.ws + OFF_VT) + ((size_t)(b * 2 + kvh) * 64 + row) * TT + c * 8;
  }
  const int ldst = (w * 128 + lane) * 16;
#define AT_DMA(BUF, T)                                                                                              \
  {                                                                                                                 \
    char* sb_ = smem + (BUF) * 32768;                                                                               \
    _Pragma("unroll") for (int hh = 0; hh < 2; ++hh)                                                                \
    _Pragma("unroll") for (int i = 0; i < 2; ++i) {                                                                 \
      __builtin_amdgcn_global_load_lds((const unsigned*)(kp[i] + (size_t)((T) * 128 + hh * 64) * 128), (unsigned*)(sb_ + hh * 8192 + ldst + i * 1024), 16, 0, 0); \
      __builtin_amdgcn_global_load_lds((const unsigned*)(vp[i] + (T) * 128 + hh * 64), (unsigned*)(sb_ + 16384 + hh * 8192 + ldst + i * 1024), 16, 0, 0);        \
    }                                                                                                               \
  }
  const int xr = (r >> 1) & 7;
  AT_DMA(0, 0)
  asm volatile("s_waitcnt vmcnt(0)" ::: "memory");
  __syncthreads();
  f32x16 oacc[2];
#pragma unroll
  for (int i = 0; i < 16; ++i) { oacc[0][i] = 0.f; oacc[1][i] = 0.f; }
  float mrow = -INFINITY, lrow = 0.f;
  for (int kt = 0; kt < nkt; ++kt) {
    const int buf = kt & 1;
    if (kt + 1 < nkt) AT_DMA(buf ^ 1, kt + 1)
    const char* Kb = smem + buf * 32768;
    const char* Vb = Kb + 16384;
    f32x16 sacc[4];
#pragma unroll
    for (int q = 0; q < 4; ++q)
#pragma unroll
      for (int i = 0; i < 16; ++i) sacc[q][i] = 0.f;
#pragma unroll
    for (int s = 0; s < 4; ++s) {
      const int co = ((2 * s + h) ^ xr) * 16;
#pragma unroll
      for (int q = 0; q < 4; ++q) {
        const s16x8 a = *(const s16x8*)(Kb + (q >> 1) * 8192 + ((q & 1) * 32 + r) * 128 + co);
        sacc[q] = MFMA32(a, qf[s], sacc[q]);
      }
    }
    float mx = sacc[0][0];
#pragma unroll
    for (int q = 0; q < 4; ++q)
#pragma unroll
      for (int i = 0; i < 16; ++i) mx = fmaxf(mx, sacc[q][i]);
    mx = fmaxf(mx, __shfl_xor(mx, 32, 64));
    const float mnew = fmaxf(mrow, mx);
    const float alpha = __builtin_amdgcn_exp2f(mrow - mnew);
    mrow = mnew;
    float psum = 0.f;
#pragma unroll
    for (int q = 0; q < 4; ++q)
#pragma unroll
      for (int i = 0; i < 16; ++i) { sacc[q][i] = __builtin_amdgcn_exp2f(sacc[q][i] - mnew); psum += sacc[q][i]; }
    lrow = lrow * alpha + psum;
#pragma unroll
    for (int i = 0; i < 16; ++i) { oacc[0][i] *= alpha; oacc[1][i] *= alpha; }
#pragma unroll
    for (int q = 0; q < 4; ++q)
#pragma unroll
      for (int s2 = 0; s2 < 2; ++s2) {
        u32x4 pu;
#pragma unroll
        for (int e = 0; e < 4; ++e) pu[e] = pack2(sacc[q][8 * s2 + 2 * e], sacc[q][8 * s2 + 2 * e + 1]);
        const s16x8 pf = __builtin_bit_cast(s16x8, pu);
        const int c0 = (q & 1) * 4 + 2 * s2;
        const int o0 = ((c0 ^ xr) * 16) + 8 * h, o1 = (((c0 + 1) ^ xr) * 16) + 8 * h;
#pragma unroll
        for (int dt = 0; dt < 2; ++dt) {
          const s16x4 lo = *(const s16x4*)(Vb + (q >> 1) * 8192 + (dt * 32 + r) * 128 + o0);
          const s16x4 hi = *(const s16x4*)(Vb + (q >> 1) * 8192 + (dt * 32 + r) * 128 + o1);
          const s16x8 a = __builtin_shufflevector(lo, hi, 0, 1, 2, 3, 4, 5, 6, 7);
          oacc[dt] = MFMA32(a, pf, oacc[dt]);
        }
      }
    asm volatile("s_waitcnt vmcnt(0)" ::: "memory");
    __syncthreads();
  }
#undef AT_DMA
  const float ltot = lrow + __shfl_xor(lrow, 32, 64);
  const float inv = 1.f / ltot;
  bf16* Op = (bf16*)(p.ws + OFF_OATT) + (size_t)(tok0 + w * 32 + r) * 256 + head * 64;
#pragma unroll
  for (int dt = 0; dt < 2; ++dt)
#pragma unroll
    for (int i = 0; i < 16; i += 4) {
      u32x2 uu;
      uu[0] = pack2(oacc[dt][i] * inv, oacc[dt][i + 1] * inv);
      uu[1] = pack2(oacc[dt][i + 2] * inv, oacc[dt][i + 3] * inv);
      *(u32x2*)(Op + dt * 32 + crow(i, h)) = uu;
    }
}

constexpr int GL_LOW = 0, GL_TOT = 4096, GL_DEC = 5120, GL_QIN = 5376, GL_KIN = 14592, GL_KET = 23808, GL_OST = 0,
              GL_VT = 33792, GL_ST = 52224;
static_assert(GL_ST + 128 * LDT * 2 <= SMEM_BYTES, "gla lds");

template <bool WITH_OUT>
DI void gla_unit(const Params& p, int l, int u, char* smem) {
  float* lowt = (float*)(smem + GL_LOW);
  float* tots = (float*)(smem + GL_TOT);
  float* decs = (float*)(smem + GL_DEC);
  bf16* qin = (bf16*)(smem + GL_QIN);
  bf16* kin = (bf16*)(smem + GL_KIN);
  bf16* ket = (bf16*)(smem + GL_KET);
  float* ost = (float*)(smem + GL_OST);
  bf16* vts = (bf16*)(smem + GL_VT);
  bf16* sts = (bf16*)(smem + GL_ST);
  const int tid = TIDX, lane = tid & 63, w = tid >> 6, r = lane & 31, h = lane >> 5;
  int b, hd, gi, dir0, ndir;
  if (WITH_OUT) { gi = u % NG33; hd = (u / NG33) & 3; b = u / (NG33 * 4); dir0 = 1; ndir = 2; }
  else { gi = u % NG33; const int v = u / NG33; dir0 = v & 1; hd = (v >> 1) & 3; b = v >> 3; ndir = 1; }
  const int dk = tid & 63, part = tid >> 6;
  const bf16* GQ = (const bf16*)(p.ws + OFF_GQ);
  const bf16* GK = (const bf16*)(p.ws + OFF_GK);
  const bf16* GVT = (const bf16*)(p.ws + OFF_GVT) + (size_t)(b * 4 + hd) * 128 * TT;
  const float* LOW = (const float*)(p.ws + OFF_LOW);
  for (int dd = 0; dd < ndir; ++dd) {
    const int dir = WITH_OUT ? (dir0 - dd) : dir0;
    float* GSu = (float*)(p.ws + OFF_GS) + ((size_t)((b * 4 + hd) * 2 + dir) * NG33 + gi) * 8192;
    float gwreg[16];
#pragma unroll
    for (int rr = 0; rr < 16; ++rr) gwreg[rr] = p.in[I_GGW][((size_t)(l * 2 + dir) * 16 + rr) * 256 + hd * 64 + dk];
    const float gb = p.in[I_GGB][(l * 2 + dir) * 256 + hd * 64 + dk];
    f32x16 sacc[2];
    if (WITH_OUT) {
#pragma unroll
      for (int dkt = 0; dkt < 2; ++dkt)
#pragma unroll
        for (int i = 0; i < 16; ++i) {
          const float v = GSu[(w * 32 + crow(i, h)) * 64 + dkt * 32 + r];
          sacc[dkt][i] = v;
          sts[(w * 32 + crow(i, h)) * LDT + dkt * 32 + r] = f2bf(v);
        }
    } else {
#pragma unroll
      for (int i = 0; i < 16; ++i) { sacc[0][i] = 0.f; sacc[1][i] = 0.f; }
    }
    float gtot = 0.f;
    for (int cc = 0; cc < 4; ++cc) {
      const int ci = dir ? 3 - cc : cc;
      const int tb = gi * 256 + ci * 64;
      const size_t tokb = (size_t)b * TT + tb;
      {
        const int row = tid >> 2, c4 = (tid & 3) * 4;
        const u32x4 lw = ldg16(LOW + (tokb + row) * 32 + dir * 16 + c4);
        u32x4 vv[4], kq[2], qq[2];
#pragma unroll
        for (int i = 0; i < 4; ++i) {
          const int c = tid + 256 * i, e = c >> 3, k8 = (c & 7) * 8;
          vv[i] = ldg16(GVT + (size_t)e * TT + tb + k8);
        }
#pragma unroll
        for (int i = 0; i < 2; ++i) {
          const int c = tid + 256 * i, rw = c >> 3, k8 = (c & 7) * 8;
          kq[i] = ldg16(GK + (tokb + rw) * 256 + hd * 64 + k8);
          if (WITH_OUT) qq[i] = ldg16(GQ + (tokb + rw) * 256 + hd * 64 + k8);
        }
        *(u32x4*)(lowt + row * 16 + c4) = lw;
#pragma unroll
        for (int i = 0; i < 4; ++i) {
          const int c = tid + 256 * i, e = c >> 3, k8 = (c & 7) * 8;
          *(u32x4*)(vts + e * LDT + k8) = vv[i];
        }
#pragma unroll
        for (int i = 0; i < 2; ++i) {
          const int c = tid + 256 * i, rw = c >> 3, k8 = (c & 7) * 8;
          *(u32x4*)(kin + rw * LDT + k8) = kq[i];
          if (WITH_OUT) *(u32x4*)(qin + rw * LDT + k8) = qq[i];
        }
      }
      __syncthreads();
      float cum = 0.f;
#pragma unroll 2
      for (int ii = 0; ii < 16; ++ii) {
        const int pos = part * 16 + ii, t = dir ? 63 - pos : pos;
        float z = gb;
#pragma unroll
        for (int rr = 0; rr < 16; ++rr) z += lowt[t * 16 + rr] * gwreg[rr];
        cum += (fminf(z, 0.f) - log1pf(__expf(-fabsf(z)))) * (1.f / 16.f);
      }
      tots[part * 64 + dk] = cum;
      __syncthreads();
      float offs = 0.f, total = 0.f;
#pragma unroll
      for (int pp = 0; pp < 4; ++pp) { const float tv = tots[pp * 64 + dk]; total += tv; if (pp < part) offs += tv; }
      if (part == 0) decs[dk] = __expf(total);
      gtot += total;
      float bq = offs;
#pragma unroll 2
      for (int ii = 0; ii < 16; ++ii) {
        const int pos = part * 16 + ii, t = dir ? 63 - pos : pos;
        float z = gb;
#pragma unroll
        for (int rr = 0; rr < 16; ++rr) z += lowt[t * 16 + rr] * gwreg[rr];
        bq += (fminf(z, 0.f) - log1pf(__expf(-fabsf(z)))) * (1.f / 16.f);
        const float kv = bf2f(kin[t * LDT + dk]);
        ket[dk * LDT + t] = f2bf(kv * __expf(total - bq));
        if (WITH_OUT) {
          const float qv = bf2f(qin[t * LDT + dk]);
          qin[t * LDT + dk] = f2bf(qv * __expf(bq));
          kin[t * LDT + dk] = f2bf(kv * __expf(-bq));
        }
      }
      __syncthreads();
      f32x16 oo[2];
      const int it = w & 1, ep = w >> 1;
      if (WITH_OUT) {
        const int ti = w >> 1, tj = w & 1;
        f32x16 aa;
#pragma unroll
        for (int i = 0; i < 16; ++i) aa[i] = 0.f;
#pragma unroll
        for (int s = 0; s < 4; ++s) {
          const s16x8 A = *(const s16x8*)(qin + (ti * 32 + r) * LDT + s * 16 + h * 8);
          const s16x8 Bv = *(const s16x8*)(kin + (tj * 32 + r) * LDT + s * 16 + h * 8);
          aa = MFMA32(A, Bv, aa);
        }
        __syncthreads();
#pragma unroll
        for (int i = 0; i < 16; ++i) {
          const int qi = ti * 32 + crow(i, h), kj = tj * 32 + r;
          const bool keep = dir ? (kj >= qi) : (kj <= qi);
          kin[qi * LDT + kj] = f2bf(keep ? aa[i] : 0.f);
        }
        __syncthreads();
#pragma unroll
        for (int i = 0; i < 16; ++i) { oo[0][i] = 0.f; oo[1][i] = 0.f; }
#pragma unroll
        for (int s = 0; s < 4; ++s) {
          const s16x8 A1 = *(const s16x8*)(kin + (it * 32 + r) * LDT + s * 16 + h * 8);
          const s16x8 A2 = *(const s16x8*)(qin + (it * 32 + r) * LDT + s * 16 + h * 8);
#pragma unroll
          for (int x = 0; x < 2; ++x) {
            const int et = 2 * ep + x;
            const s16x8 B1 = *(const s16x8*)(vts + (et * 32 + r) * LDT + s * 16 + h * 8);
            const s16x8 B2 = *(const s16x8*)(sts + (et * 32 + r) * LDT + s * 16 + h * 8);
            oo[x] = MFMA32(A1, B1, oo[x]);
            oo[x] = MFMA32(A2, B2, oo[x]);
          }
        }
      }
#pragma unroll
      for (int dkt = 0; dkt < 2; ++dkt) {
        const float dv = decs[dkt * 32 + r];
#pragma unroll
        for (int i = 0; i < 16; ++i) sacc[dkt][i] *= dv;
      }
#pragma unroll
      for (int s = 0; s < 4; ++s) {
        const s16x8 A = *(const s16x8*)(vts + (w * 32 + r) * LDT + s * 16 + h * 8);
#pragma unroll
        for (int dkt = 0; dkt < 2; ++dkt) {
          const s16x8 Bv = *(const s16x8*)(ket + (dkt * 32 + r) * LDT + s * 16 + h * 8);
          sacc[dkt] = MFMA32(A, Bv, sacc[dkt]);
        }
      }
      __syncthreads();
      if (WITH_OUT) {
#pragma unroll
        for (int dkt = 0; dkt < 2; ++dkt)
#pragma unroll
          for (int i = 0; i < 16; ++i) sts[(w * 32 + crow(i, h)) * LDT + dkt * 32 + r] = f2bf(sacc[dkt][i]);
#pragma unroll
        for (int x = 0; x < 2; ++x)
#pragma unroll
          for (int i = 0; i < 16; ++i) ost[(it * 32 + crow(i, h)) * CLD + (2 * ep + x) * 32 + r] = oo[x][i];
        __syncthreads();
        const int row = tid >> 2, qd = tid & 3;
        const size_t tok = tokb + row;
        bf16* og = (bf16*)(p.ws + OFF_OGLA) + tok * 512 + hd * 128 + qd * 32;
        const float* os = ost + row * CLD + qd * 32;
        if (dir == 1) {
#pragma unroll
          for (int i = 0; i < 4; ++i) {
            u32x4 uu;
#pragma unroll
            for (int e = 0; e < 4; ++e) uu[e] = pack2(os[i * 8 + 2 * e], os[i * 8 + 2 * e + 1]);
            *(u32x4*)(og + i * 8) = uu;
          }
        } else {
          float ss = 0.f;
#pragma unroll 1
          for (int i = 0; i < 4; ++i) {
            const u32x4 uu = *(const u32x4*)(og + i * 8);
#pragma unroll
            for (int e = 0; e < 4; ++e) {
              const float a0 = os[i * 8 + 2 * e] + bflo(uu[e]), a1 = os[i * 8 + 2 * e + 1] + bfhi(uu[e]);
              ss += a0 * a0 + a1 * a1;
            }
          }
          ss += __shfl_xor(ss, 1, 64);
          ss += __shfl_xor(ss, 2, 64);
          const float rstd = rsqrtf(ss * (1.f / 128.f) + EPSF);
          const float* gn = p.in[I_GON] + l * 128 + qd * 32;
          const bf16* gr = (const bf16*)(p.ws + OFF_GR) + tok * 512 + hd * 128 + qd * 32;
#pragma unroll 1
          for (int i = 0; i < 4; ++i) {
            const u32x4 uo = *(const u32x4*)(og + i * 8);
            const u32x4 ug = *(const u32x4*)(gr + i * 8);
            u32x4 uu;
#pragma unroll
            for (int e = 0; e < 4; ++e) {
              const float v0 = os[i * 8 + 2 * e] + bflo(uo[e]), v1 = os[i * 8 + 2 * e + 1] + bfhi(uo[e]);
              const float a0 = v0 * rstd * gn[i * 8 + 2 * e] * siluf_(bflo(ug[e]));
              const float a1 = v1 * rstd * gn[i * 8 + 2 * e + 1] * siluf_(bfhi(ug[e]));
              uu[e] = pack2(a0, a1);
            }
            *(u32x4*)(og + i * 8) = uu;
          }
        }
        __syncthreads();
      }
    }
    if (!WITH_OUT) {
#pragma unroll
      for (int dkt = 0; dkt < 2; ++dkt)
#pragma unroll
        for (int i = 0; i < 16; ++i) GSu[(w * 32 + crow(i, h)) * 64 + dkt * 32 + r] = sacc[dkt][i];
      if (part == 0) ((float*)(p.ws + OFF_DECG))[((size_t)((b * 4 + hd) * 2 + dir) * NG33 + gi) * 64 + dk] = __expf(gtot);
    }
    __syncthreads();
  }
}

DI void gla_scan_job(const Params& p, int j) {
  const int idx = j * 256 + TIDX;
  const int seq = idx >> 13, el = idx & 8191, dk = el & 63, dir = seq & 1;
  float* GS = (float*)(p.ws + OFF_GS) + (size_t)seq * NG33 * 8192 + el;
  const float* DG = (const float*)(p.ws + OFF_DECG) + (size_t)seq * NG33 * 64 + dk;
  float s = 0.f;
  for (int st0 = 0; st0 < 33; st0 += 11) {
    float kv[11], dc[11];
#pragma unroll
    for (int q = 0; q < 11; ++q) {
      const int st = st0 + q;
      const int g = (dir == 0 || st == 0) ? st : 33 - st;
      kv[q] = GS[(size_t)g * 8192];
      dc[q] = DG[g * 64];
    }
#pragma unroll
    for (int q = 0; q < 11; ++q) {
      const int st = st0 + q;
      const int g = (dir == 0 || st == 0) ? st : 33 - st;
      GS[(size_t)g * 8192] = s;
      s = dc[q] * s + kv[q];
    }
  }
}

DI void s5_end_tile(const Params& p, int j, char* smem) {
  const int nt = j & 1, mt = (j >> 1) % 9, g = j / 18;
  const bf16* SU = (const bf16*)(p.ws + OFF_SU);
  const bf16* F = (const bf16*)(p.ws + OFF_F5) + ((size_t)g * 256 + nt * 128) * 512;
  f32x16 acc[2][2];
  acc_zero(acc);
  gemm_main_dma(acc,
            [&](int r) -> const bf16* {
              const int m = mt * 128 + r;
              if (m >= MS5) return (const bf16*)(p.ws + OFF_ZERO);
              const int b = m / NCH, ch = m - b * NCH;
              return SU + ((size_t)(b * 16 + g) * TT + ch * 32) * 16;
            },
            [&](int r) { return F + (size_t)r * 512; }, 512, smem);
  float* Cs = (float*)smem;
  acc_to_lds(acc, Cs);
  __syncthreads();
  float* EN = (float*)(p.ws + OFF_EN);
  for (int c = TIDX; c < 128 * 32; c += 256) {
    const int row = c >> 5, c4 = (c & 31) * 4, m = mt * 128 + row;
    if (m < MS5) {
      const float* s = Cs + row * CLD + c4;
      f32x4 v = {s[0], s[1], s[2], s[3]};
      *(f32x4*)(EN + ((size_t)m * 16 + g) * 256 + nt * 128 + c4) = v;
    }
  }
  __syncthreads();
}

DI void s5_scan_job(const Params& p, int l, int j, char* smem) {
  float2* ends = (float2*)smem;
  const int dir = j & 1, g = (j >> 1) & 15, b = j >> 5;
  const int pp = TIDX & 63, seg = TIDX >> 6;
  const float2 aL = ((const float2*)(p.ws + OFF_PWR))[((size_t)((l * 2 + dir) * 16 + g) * 33 + 32) * 64 + pp];
  const float* EN = (const float*)(p.ws + OFF_EN);
  bf16* SB = (bf16*)(p.ws + OFF_SB);
  float sr = 0.f, si = 0.f;
  for (int q0 = 0; q0 < 66; q0 += 11) {
    float er[11], ei[11];
#pragma unroll
    for (int q = 0; q < 11; ++q) {
      const int pos = seg * 66 + q0 + q;
      const int ch = dir ? (pos < 8 ? 7 - pos : 271 - pos) : pos;
      const float* e = EN + ((size_t)(b * NCH + ch) * 16 + g) * 256 + dir * 128 + pp;
      er[q] = e[0]; ei[q] = e[64];
    }
#pragma unroll
    for (int q = 0; q < 11; ++q) {
      const float nr = aL.x * sr - aL.y * si + er[q], ni = aL.x * si + aL.y * sr + ei[q];
      sr = nr; si = ni;
    }
  }
  ends[seg * 64 + pp] = make_float2(sr, si);
  float pr = 1.f, pi = 0.f;
  for (int q = 0; q < 66; ++q) { const float nr = pr * aL.x - pi * aL.y, ni = pr * aL.y + pi * aL.x; pr = nr; pi = ni; }
  __syncthreads();
  sr = 0.f; si = 0.f;
  for (int k = 0; k < seg; ++k) {
    const float2 e = ends[k * 64 + pp];
    const float nr = pr * sr - pi * si + e.x, ni = pr * si + pi * sr + e.y;
    sr = nr; si = ni;
  }
  for (int q0 = 0; q0 < 66; q0 += 11) {
    float er[11], ei[11];
#pragma unroll
    for (int q = 0; q < 11; ++q) {
      const int pos = seg * 66 + q0 + q;
      const int ch = dir ? (pos < 8 ? 7 - pos : 271 - pos) : pos;
      const float* e = EN + ((size_t)(b * NCH + ch) * 16 + g) * 256 + dir * 128 + pp;
      er[q] = e[0]; ei[q] = e[64];
    }
#pragma unroll
    for (int q = 0; q < 11; ++q) {
      const int pos = seg * 66 + q0 + q;
      const int ch = dir ? (pos < 8 ? 7 - pos : 271 - pos) : pos;
      bf16* sb = SB + ((size_t)(b * NCH + ch) * 16 + g) * 256 + dir * 128 + pp;
      sb[0] = f2bf(sr); sb[64] = f2bf(si);
      const float nr = aL.x * sr - aL.y * si + er[q], ni = aL.x * si + aL.y * sr + ei[q];
      sr = nr; si = ni;
    }
  }
  __syncthreads();
}

DI float gelu_tanh(float x) {
  const float u = 0.7978845608028654f * (x + 0.044715f * x * x * x);
  return 0.5f * x * (1.f + tanhf(u));
}

DI void s5_out_tile(const Params& p, int j, char* smem) {
  const int nt = j & 3, mt = (j >> 2) % 9, g = j / 36;
  const bf16* SU = (const bf16*)(p.ws + OFF_SU);
  const bf16* SB = (const bf16*)(p.ws + OFF_SB);
  const bf16* Tm = (const bf16*)(p.ws + OFF_T5) + ((size_t)g * 512 + nt * 128) * 512;
  const bf16* Em = (const bf16*)(p.ws + OFF_E5) + ((size_t)g * 512 + nt * 128) * 256;
  f32x16 acc[2][2];
  acc_zero(acc);
  gemm_main_dma(acc,
            [&](int r) -> const bf16* {
              const int m = mt * 128 + r;
              if (m >= MS5) return (const bf16*)(p.ws + OFF_ZERO);
              const int b = m / NCH, ch = m - b * NCH;
              return SU + ((size_t)(b * 16 + g) * TT + ch * 32) * 16;
            },
            [&](int r) { return Tm + (size_t)r * 512; }, 512, smem);
  gemm_main_dma(acc,
            [&](int r) -> const bf16* {
              const int m = mt * 128 + r;
              if (m >= MS5) return (const bf16*)(p.ws + OFF_ZERO);
              return SB + ((size_t)m * 16 + g) * 256;
            },
            [&](int r) { return Em + (size_t)r * 256; }, 256, smem);
  float* Cs = (float*)smem;
  acc_to_lds(acc, Cs);
  __syncthreads();
  bf16* Y5 = (bf16*)(p.ws + OFF_Y5);
  for (int c = TIDX; c < 2048; c += 256) {
    const int row = c >> 4, c8 = c & 15, m = mt * 128 + row;
    if (m < MS5) {
      const int b = m / NCH, ch = m - b * NCH;
      const int n = nt * 128 + c8 * 8, i = n >> 4, hh = n & 15;
      const float* s = Cs + row * CLD + c8 * 8;
      u32x4 u;
#pragma unroll
      for (int e = 0; e < 4; ++e) u[e] = pack2(gelu_tanh(s[2 * e]), gelu_tanh(s[2 * e + 1]));
      *(u32x4*)(Y5 + ((size_t)b * TT + ch * 32 + i) * 256 + g * 16 + hh) = u;
    }
  }
  __syncthreads();
}

DI void glu_tile(const Params& p, int l, int j, char* smem) {
  const int nt = j & 1, mt = j >> 1;
  const bf16* Y5 = (const bf16*)(p.ws + OFF_Y5) + (size_t)mt * 128 * 256;
  const bf16* W = wl(p, l, WL_GLU) + (size_t)nt * 128 * 256;
  f32x16 acc[2][2];
  acc_zero(acc);
  gemm_main_dma(acc, [&](int r) { return Y5 + (size_t)r * 256; }, [&](int r) { return W + (size_t)r * 256; }, 256, smem);
  float* Cs = (float*)smem;
  acc_to_lds(acc, Cs);
  __syncthreads();
  const float* gb = p.in[I_GLUB] + l * 256 + nt * 128;
  bf16* O = (bf16*)(p.ws + OFF_OS5) + (size_t)mt * 128 * 256 + nt * 128;
  for (int c = TIDX; c < 2048; c += 256) {
    const int row = c >> 4, cc = (c & 15) * 8;
    const float* s = Cs + row * CLD + cc;
    const u32x4 yu = *(const u32x4*)(Y5 + (size_t)row * 256 + nt * 128 + cc);
    u32x4 u;
#pragma unroll
    for (int e = 0; e < 4; ++e) {
      const float y0 = bflo(yu[e]), y1 = bfhi(yu[e]);
      u[e] = pack2(y0 * sigmoidf_(s[2 * e] + gb[cc + 2 * e]), y1 * sigmoidf_(s[2 * e + 1] + gb[cc + 2 * e + 1]));
    }
    *(u32x4*)(O + (size_t)row * 256 + cc) = u;
  }
  __syncthreads();
}

struct DmaStream { const bf16* ap[4]; const bf16* bp[4]; };
template <class FA, class FB>
DI void stream_setup(DmaStream& st, FA fa, FB fb) {
  const int tid = TIDX, lane = tid & 63, w = tid >> 6;
#pragma unroll
  for (int i = 0; i < 4; ++i) {
    const int row = w * 32 + i * 8 + (lane >> 3);
    const int c = (lane & 7) ^ ((row >> 1) & 7);
    st.ap[i] = fa(row) + c * 8;
    st.bp[i] = fb(row) + c * 8;
  }
}
DI void stream_issue(const DmaStream& st, int buf, int kt, char* smem) {
  const int tid = TIDX, lane = tid & 63, w = tid >> 6;
  const int ldst = (w * 256 + lane) * 16;
  const int k0 = kt * 64;
#pragma unroll
  for (int i = 0; i < 4; ++i) {
    __builtin_amdgcn_global_load_lds((const unsigned*)(st.ap[i] + k0), (unsigned*)(smem + buf * 16384 + ldst + i * 1024), 16, 0, 0);
    __builtin_amdgcn_global_load_lds((const unsigned*)(st.bp[i] + k0), (unsigned*)(smem + 32768 + buf * 16384 + ldst + i * 1024), 16, 0, 0);
  }
}
DI void stream_run(f32x16 (&acc)[2][2], const DmaStream& cur, int K, char* smem, const DmaStream& next, bool has_next) {
  const int tid = TIDX, lane = tid & 63, w = tid >> 6, wm = w >> 1, wn = w & 1;
  const int r = lane & 31, h = lane >> 5;
  const int xr = (r >> 1) & 7;
  const int arow = (wm * 64 + r) * 128, brow = (wn * 64 + r) * 128;
  const int nk = K / 64;
  for (int kt = 0; kt < nk; ++kt) {
    const int buf = kt & 1;
    if (kt + 1 < nk) stream_issue(cur, buf ^ 1, kt + 1, smem);
    else if (has_next) stream_issue(next, buf ^ 1, 0, smem);
    const char* Ab = smem + buf * 16384 + arow;
    const char* Bb = smem + 32768 + buf * 16384 + brow;
#pragma unroll
    for (int s2 = 0; s2 < 4; ++s2) {
      const int co = ((2 * s2 + h) ^ xr) * 16;
      s16x8 a0 = *(const s16x8*)(Ab + co);
      s16x8 a1 = *(const s16x8*)(Ab + 32 * 128 + co);
      s16x8 b0 = *(const s16x8*)(Bb + co);
      s16x8 b1 = *(const s16x8*)(Bb + 32 * 128 + co);
      acc[0][0] = MFMA32(a0, b0, acc[0][0]);
      acc[0][1] = MFMA32(a0, b1, acc[0][1]);
      acc[1][0] = MFMA32(a1, b0, acc[1][0]);
      acc[1][1] = MFMA32(a1, b1, acc[1][1]);
    }
    asm volatile("s_waitcnt vmcnt(0)" ::: "memory");
    __syncthreads();
  }
}

DI void merge_tile(const Params& p, int l, int j, char* smem) {
  const int nt = j & 7, mt = j >> 3;
  const bf16* H = (const bf16*)(p.ws + OFF_H) + (size_t)mt * 128 * DM;
  unsigned am[2][2][8];
#pragma unroll
  for (int a = 0; a < 2; ++a)
#pragma unroll
    for (int bq = 0; bq < 2; ++bq)
#pragma unroll
      for (int i = 0; i < 8; ++i) am[a][bq][i] = 0u;
  DmaStream sb, sg;
  {
    const bf16* A0 = (const bf16*)(p.ws + OFF_OATT) + (size_t)mt * 128 * 256;
    const bf16* W0 = wl(p, l, WL_BRA) + (size_t)nt * 128 * 256;
    stream_setup(sb, [&](int r) { return A0 + (size_t)r * 256; }, [&](int r) { return W0 + (size_t)r * 256; });
    stream_issue(sb, 0, 0, smem);
    asm volatile("s_waitcnt vmcnt(0)" ::: "memory");
    __syncthreads();
  }
#pragma unroll 1
  for (int x = 0; x < 3; ++x) {
    const int K = (x == 1) ? 512 : 256;
    const bf16* Wg = wl(p, l, WL_WIN) + ((size_t)2432 + x * 1024 + nt * 128) * DM;
    stream_setup(sg, [&](int r) { return H + (size_t)r * DM; }, [&](int r) { return Wg + (size_t)r * DM; });
    unsigned br[2][2][8];
    {
      f32x16 acc[2][2];
      acc_zero(acc);
      stream_run(acc, sb, K, smem, sg, true);
#pragma unroll
      for (int a = 0; a < 2; ++a)
#pragma unroll
        for (int bq = 0; bq < 2; ++bq)
#pragma unroll
          for (int i = 0; i < 8; ++i) br[a][bq][i] = pack2(acc[a][bq][2 * i], acc[a][bq][2 * i + 1]);
    }
    if (x < 2) {
      const bf16* A1; const bf16* W1; int K1;
      if (x == 0) { A1 = (const bf16*)(p.ws + OFF_OGLA) + (size_t)mt * 128 * 512; W1 = wl(p, l, WL_BRG) + (size_t)nt * 128 * 512; K1 = 512; }
      else { A1 = (const bf16*)(p.ws + OFF_OS5) + (size_t)mt * 128 * 256; W1 = wl(p, l, WL_BRS) + (size_t)nt * 128 * 256; K1 = 256; }
      stream_setup(sb, [&](int r) { return A1 + (size_t)r * K1; }, [&](int r) { return W1 + (size_t)r * K1; });
    }
    f32x16 acc[2][2];
    acc_zero(acc);
    stream_run(acc, sg, DM, smem, sb, x < 2);
#pragma unroll
    for (int a = 0; a < 2; ++a)
#pragma unroll
      for (int bq = 0; bq < 2; ++bq)
#pragma unroll
        for (int i = 0; i < 8; ++i) {
          const float v0 = bflo(am[a][bq][i]) + sigmoidf_(acc[a][bq][2 * i]) * bflo(br[a][bq][i]);
          const float v1 = bfhi(am[a][bq][i]) + sigmoidf_(acc[a][bq][2 * i + 1]) * bfhi(br[a][bq][i]);
          am[a][bq][i] = pack2(v0, v1);
        }
  }
  f32x16 accm[2][2];
#pragma unroll
  for (int a = 0; a < 2; ++a)
#pragma unroll
    for (int bq = 0; bq < 2; ++bq)
#pragma unroll
      for (int i = 0; i < 8; ++i) { accm[a][bq][2 * i] = bflo(am[a][bq][i]); accm[a][bq][2 * i + 1] = bfhi(am[a][bq][i]); }
  float* Cs = (float*)smem;
  acc_to_lds(accm, Cs);
  __syncthreads();
  store_tile_bf16(Cs, (bf16*)(p.ws + OFF_MG) + (size_t)mt * 128 * DM + nt * 128, DM, 128, 1.f);
  __syncthreads();
}

DI void plain_tile(const bf16* A, int K, const bf16* W, bf16* dst, int ldd, char* smem) {
  f32x16 acc[2][2];
  acc_zero(acc);
  gemm_main_dma(acc, [&](int r) { return A + (size_t)r * K; }, [&](int r) { return W + (size_t)r * K; }, K, smem);
  float* Cs = (float*)smem;
  acc_to_lds(acc, Cs);
  __syncthreads();
  store_tile_bf16(Cs, dst, ldd, 128, 1.f);
  __syncthreads();
}

DI void store_half_bf16(const float* Cs, bf16* dst, size_t ld, int hf) {
  for (int c = TIDX; c < 1024; c += 256) {
    const int row = c >> 3, seg = (c >> 2) & 1, c8 = (c & 3) * 8;
    const int col = seg * 64 + hf * 32 + c8;
    const float* s = Cs + row * CLD + col;
    u32x4 v;
    v[0] = pack2(s[0], s[1]); v[1] = pack2(s[2], s[3]); v[2] = pack2(s[4], s[5]); v[3] = pack2(s[6], s[7]);
    *(u32x4*)(dst + (size_t)row * ld + col) = v;
  }
}
DI void plain_half(const bf16* A, int K, const bf16* W, bf16* dst, int ldd, int hf, char* smem) {
  f32x16 acc[2];
#pragma unroll
  for (int i = 0; i < 16; ++i) { acc[0][i] = 0.f; acc[1][i] = 0.f; }
  gemm_main_dma_half(acc, A, K, W, K, K, hf, smem);
  float* Cs = (float*)smem;
  {
    const int lane = TIDX & 63, w = TIDX >> 6, wm = w >> 1, wn = w & 1, r = lane & 31, h = lane >> 5;
#pragma unroll
    for (int tm = 0; tm < 2; ++tm)
#pragma unroll
      for (int i = 0; i < 16; ++i) Cs[(wm * 64 + tm * 32 + crow(i, h)) * CLD + wn * 64 + hf * 32 + r] = acc[tm][i];
  }
  __syncthreads();
  store_half_bf16(Cs, dst, ldd, hf);
  __syncthreads();
}

DI void merge_half(const Params& p, int l, int mt, int nt, int hf, char* smem) {
  const bf16* H = (const bf16*)(p.ws + OFF_H) + (size_t)mt * 128 * DM;
  unsigned am[2][8];
#pragma unroll
  for (int a = 0; a < 2; ++a)
#pragma unroll
    for (int i = 0; i < 8; ++i) am[a][i] = 0u;
#pragma unroll 1
  for (int x = 0; x < 3; ++x) {
    const bf16* A; const bf16* Wb; int K;
    if (x == 0) { A = (const bf16*)(p.ws + OFF_OATT) + (size_t)mt * 128 * 256; Wb = wl(p, l, WL_BRA) + (size_t)nt * 128 * 256; K = 256; }
    else if (x == 1) { A = (const bf16*)(p.ws + OFF_OGLA) + (size_t)mt * 128 * 512; Wb = wl(p, l, WL_BRG) + (size_t)nt * 128 * 512; K = 512; }
    else { A = (const bf16*)(p.ws + OFF_OS5) + (size_t)mt * 128 * 256; Wb = wl(p, l, WL_BRS) + (size_t)nt * 128 * 256; K = 256; }
    unsigned br[2][8];
    {
      f32x16 a2[2];
#pragma unroll
      for (int i = 0; i < 16; ++i) { a2[0][i] = 0.f; a2[1][i] = 0.f; }
      gemm_main_dma_half(a2, A, K, Wb, K, K, hf, smem);
#pragma unroll
      for (int a = 0; a < 2; ++a)
#pragma unroll
        for (int i = 0; i < 8; ++i) br[a][i] = pack2(a2[a][2 * i], a2[a][2 * i + 1]);
    }
    const bf16* Wg = wl(p, l, WL_WIN) + ((size_t)2432 + x * 1024 + nt * 128) * DM;
    f32x16 g2[2];
#pragma unroll
    for (int i = 0; i < 16; ++i) { g2[0][i] = 0.f; g2[1][i] = 0.f; }
    gemm_main_dma_half(g2, H, DM, Wg, DM, DM, hf, smem);
#pragma unroll
    for (int a = 0; a < 2; ++a)
#pragma unroll
      for (int i = 0; i < 8; ++i) {
        const float v0 = bflo(am[a][i]) + sigmoidf_(g2[a][2 * i]) * bflo(br[a][i]);
        const float v1 = bfhi(am[a][i]) + sigmoidf_(g2[a][2 * i + 1]) * bfhi(br[a][i]);
        am[a][i] = pack2(v0, v1);
      }
  }
  float* Cs = (float*)smem;
  {
    const int lane = TIDX & 63, w = TIDX >> 6, wm = w >> 1, wn = w & 1, r = lane & 31, h = lane >> 5;
#pragma unroll
    for (int tm = 0; tm < 2; ++tm)
#pragma unroll
      for (int i = 0; i < 8; ++i) {
        Cs[(wm * 64 + tm * 32 + crow(2 * i, h)) * CLD + wn * 64 + hf * 32 + r] = bflo(am[tm][i]);
        Cs[(wm * 64 + tm * 32 + crow(2 * i + 1, h)) * CLD + wn * 64 + hf * 32 + r] = bfhi(am[tm][i]);
      }
  }
  __syncthreads();
  store_half_bf16(Cs, (bf16*)(p.ws + OFF_MG) + (size_t)mt * 128 * DM + nt * 128, DM, hf);
  __syncthreads();
}

DI void plain_wide(const bf16* A, int K, const bf16* W, bf16* dst, int ldd, char* smem) {
  f32x16 acc[2][4];
  accw_zero(acc);
  gemm_wide(acc, [&](int r) { return A + (size_t)r * K; }, [&](int r) { return W + (size_t)r * K; }, K, smem);
  float* Cs = (float*)smem;
  accw_to_lds<0>(acc, Cs);
  __syncthreads();
  store_tile_bf16(Cs, dst, ldd, 128, 1.f);
  __syncthreads();
  accw_to_lds<1>(acc, Cs);
  __syncthreads();
  store_tile_bf16(Cs, dst + 128, ldd, 128, 1.f);
  __syncthreads();
}

DI void up_epi(const Params& p, int l, int jn, int seqbase, int len, int pos0, char* smem) {
  float* Cs = (float*)smem;
  const float* cw = p.in[I_CW] + (size_t)l * 3 * 2 * DFF;
  const float* cb = p.in[I_CB] + (size_t)l * 2 * DFF;
  bf16* G = (bf16*)(p.ws + OFF_G);
  const int tid = TIDX;
  const int c = (tid & 31) * 2;
  float wa[2][3], wv[2][3], ba[2], bv[2];
#pragma unroll
  for (int e = 0; e < 2; ++e) {
    const int ca = jn * 64 + c + e, cv = DFF + ca;
#pragma unroll
    for (int k = 0; k < 3; ++k) { wa[e][k] = cw[k * 2 * DFF + ca]; wv[e][k] = cw[k * 2 * DFF + cv]; }
    ba[e] = cb[ca]; bv[e] = cb[cv];
  }
#pragma unroll 4
  for (int rr = 1 + (tid >> 5); rr < 127; rr += 8) {
    const int pos = pos0 + rr;
    if (pos < len) {
      float gv[2];
#pragma unroll
      for (int e = 0; e < 2; ++e) {
        const float a = wa[e][0] * Cs[(rr - 1) * CLD + c + e] + wa[e][1] * Cs[rr * CLD + c + e] + wa[e][2] * Cs[(rr + 1) * CLD + c + e] + ba[e];
        const float v = wv[e][0] * Cs[(rr - 1) * CLD + 64 + c + e] + wv[e][1] * Cs[rr * CLD + 64 + c + e] +
                        wv[e][2] * Cs[(rr + 1) * CLD + 64 + c + e] + bv[e];
        gv[e] = siluf_(a) * v;
      }
      *(unsigned*)(G + (size_t)(seqbase + pos) * DFF + jn * 64 + c) = pack2(gv[0], gv[1]);
    }
  }
  __syncthreads();
}

DI void up_wide(const Params& p, int l, int mtile, int jp, char* smem) {
  const int b = mtile / 69, rr0 = mtile % 69;
  int seqbase, len, ti;
  if (rr0 < 3) { seqbase = b * TT; len = CTXL; ti = rr0; }
  else { seqbase = b * TT + CTXL; len = SEQ; ti = rr0 - 3; }
  const int pos0 = ti * 126 - 1;
  const bf16* H = (const bf16*)(p.ws + OFF_H);
  const bf16* W = wl(p, l, WL_UP) + (size_t)jp * 256 * DM;
  f32x16 acc[2][4];
  accw_zero(acc);
  gemm_wide(acc,
            [&](int r) -> const bf16* {
              const int pos = pos0 + r;
              return (pos >= 0 && pos < len) ? H + (size_t)(seqbase + pos) * DM : (const bf16*)(p.ws + OFF_ZERO);
            },
            [&](int r) { return W + (size_t)r * DM; }, DM, smem);
  float* Cs = (float*)smem;
  accw_to_lds<0>(acc, Cs);
  __syncthreads();
  up_epi(p, l, jp * 2, seqbase, len, pos0, smem);
  accw_to_lds<1>(acc, Cs);
  __syncthreads();
  up_epi(p, l, jp * 2 + 1, seqbase, len, pos0, smem);
}

DI bool gemm_job(int bid, int G, int it, int MT, int NTL, int& mt, int& nt, int CW = 8) {
  const int x = bid & 7, q = bid >> 3, Q = G >> 3;
  const int m0 = (x * MT) >> 3, m1 = ((x + 1) * MT) >> 3, Mx = m1 - m0;
  const int jl = q + Q * it;
  if (jl >= Mx * NTL) return false;
  const int full = Mx * CW;
  const int c = jl / full, rem = jl - c * full;
  const int wc = min(CW, NTL - CW * c);
  const int mi = rem / wc;
  mt = m0 + mi;
  nt = CW * c + (rem - mi * wc);
  return true;
}

DI int lat_mt(int i) { return (i >> 6) * 66 + 2 + (i & 63); }
DI int lat_up(int i) { return (i / 66) * 69 + 3 + (i % 66); }

enum { PH_PREP = 0, PH_ROW0, PH_PROJ, PH_MIX1, PH_SCAN, PH_MIX2, PH_GLU, PH_MERGE, PH_WOUT, PH_ROW1, PH_UP, PH_DOWN, PH_ROW2 };
constexpr int N_PHASES = 2 + 11 * NL;

DI void run_phase(const Params& p, int ph, int l, char* smem) {
  const int bid = blockIdx.x;
#ifdef HALFMASK
  const int G = ((HALFMASK >> ph) & 1) ? 256 : gridDim.x;
  if (bid >= G) return;
#else
  const int G = gridDim.x;
#endif
#ifdef PHMASK
  if (!((PHMASK >> ph) & 1)) return;
#endif
  switch (ph) {
    case PH_PREP:
      if (bid < 8) { for (int i = TIDX; i < 512; i += 256) ((u32x4*)(p.ws + OFF_ZERO))[i] = u32x4{0u, 0u, 0u, 0u}; }
      if (bid < 96) prep_mod_job(p, bid, smem);
      else if (bid < 128) prep_s5_job(p, bid - 96);
      else { for (int j = bid - 128; j < 4016; j += G - 128) prep_wt_job(p, j, smem); }
      break;
    case PH_ROW0:
      row_phase<0>(p, 0, bid, G);
      ktab_phase(p, bid, G, 0, 1);
      break;
    case PH_PROJ:
#ifdef EXP_A
      if (bid < 256) { int mt, nt; for (int it = 0; gemm_job(bid, 256, it, 264, 10, mt, nt, 4); ++it) proj_wide(p, l, mt, nt, smem); }
      else {
        s5mat_phase(p, l, bid - 256, G - 256);
        if (l + 1 < NL) ktab_phase(p, bid - 256, G - 256, l + 1, l + 2);
        if (l + 1 < NL) { for (int jj = (l + 1) * 4016 + (bid - 256); jj < (l + 2) * 4016; jj += G - 256) prep_wt_job(p, jj, smem); }
      }
#elif defined(EXP_C)
      if (bid < 256) for (int j = bid; j < 264 * 19; j += 256) { if ((EXP_C >> (j % 19)) & 1) proj_tile(p, l, j / 19, j % 19, smem); }
      for (int j = bid; j < 264 * 19; j += G) { if (!((EXP_C >> (j % 19)) & 1)) proj_tile(p, l, j / 19, j % 19, smem); }
      s5mat_phase(p, l, bid, G);
#elif defined(EXP_B)
      for (int j = bid; j < 264 * 19; j += G) proj_tile(p, l, j / 19, j % 19, smem);
      if (bid < 256) s5mat_phase(p, l, bid, 256);
#else
      for (int j = bid; j < 264 * 19; j += G) proj_tile(p, l, j / 19, j % 19, smem);
      s5mat_phase(p, l, bid, G);
#endif
      break;
    case PH_MIX1:
      for (int j = bid; j < (l == NL - 1 ? 1024 : 1056); j += G) attn_unit(p, j, smem);
      for (int j = bid; j < 1024; j += G) {
        const int v = j >> 5, k = j & 31;
        const int gi = (v & 1) ? (k == 0 ? 0 : k + 1) : k;
        gla_unit<false>(p, l, v * NG33 + gi, smem);
      }
      for (int j = G - 1 - bid; j < 288; j += G) s5_end_tile(p, j, smem);
      break;
    case PH_SCAN:
      for (int j = bid; j < 1024 + 128; j += G) {
        if (j < 1024) gla_scan_job(p, j);
        else s5_scan_job(p, l, j - 1024, smem);
      }
      break;
    case PH_MIX2:
      if (l == NL - 1) {
        for (int j = bid; j < 512 + 576; j += G) {
          if (j < 512) gla_unit<true>(p, l, (j >> 5) * NG33 + 1 + (j & 31), smem);
          else s5_out_tile(p, j - 512, smem);
        }
      } else {
        for (int j = bid; j < 528 + 576; j += G) {
          if (j < 528) gla_unit<true>(p, l, j, smem);
          else s5_out_tile(p, j - 528, smem);
        }
      }
      break;
    case PH_GLU:
      { const bool last = (l == NL - 1); int mt, nt;
        for (int it = 0; gemm_job(bid, G, it, last ? 256 : 264, 2, mt, nt); ++it) glu_tile(p, l, (last ? lat_mt(mt) : mt) * 2 + nt, smem); }
      break;
    case PH_MERGE:
      { int mt, nt;
        for (int it = 0; gemm_job(bid, G, it, 256, 8, mt, nt); ++it) merge_tile(p, l, lat_mt(mt) * 8 + nt, smem); }
      if (l != NL - 1 && bid < 128) {
        const int c = bid >> 1, hf = bid & 1;
        merge_half(p, l, (c >> 4) * 66 + ((c >> 3) & 1), c & 7, hf, smem);
      }
      break;
    case PH_WOUT:
      for (int it = 0;; ++it) {
        int mt, nt;
        if (!gemm_job(bid, G, it, 256, 8, mt, nt)) break;
        mt = lat_mt(mt);
        plain_tile((const bf16*)(p.ws + OFF_MG) + (size_t)mt * 128 * DM, DM, wl(p, l, WL_WOUT) + (size_t)nt * 128 * DM,
                   (bf16*)(p.ws + OFF_H) + (size_t)mt * 128 * DM + nt * 128, DM, smem);
      }
      if (l != NL - 1 && bid < 128) {
        const int c = bid >> 1, hf = bid & 1;
        const int mt = (c >> 4) * 66 + ((c >> 3) & 1), nt = c & 7;
        plain_half((const bf16*)(p.ws + OFF_MG) + (size_t)mt * 128 * DM, DM, wl(p, l, WL_WOUT) + (size_t)nt * 128 * DM,
                   (bf16*)(p.ws + OFF_H) + (size_t)mt * 128 * DM + nt * 128, DM, hf, smem);
      }
      break;
    case PH_ROW1: row_phase<1>(p, l, bid, G); break;
    case PH_UP:
      { const bool last = (l == NL - 1); int mt, nt;
        for (int it = 0; gemm_job(bid, G, it, last ? 264 : 276, 22, mt, nt, 4); ++it) up_wide(p, l, last ? lat_up(mt) : mt, nt, smem); }
      break;
    case PH_DOWN:
      for (int it = 0;; ++it) {
        int mt, nt;
        if (!gemm_job(bid, G, it, 256, 8, mt, nt)) break;
        mt = lat_mt(mt);
        plain_tile((const bf16*)(p.ws + OFF_G) + (size_t)mt * 128 * DFF, DFF, wl(p, l, WL_DOWN) + (size_t)nt * 128 * DFF,
                   (bf16*)(p.ws + OFF_H) + (size_t)mt * 128 * DM + nt * 128, DM, smem);
      }
      if (l != NL - 1 && bid < 128) {
        const int c = bid >> 1, hf = bid & 1;
        const int mt = (c >> 4) * 66 + ((c >> 3) & 1), nt = c & 7;
        plain_half((const bf16*)(p.ws + OFF_G) + (size_t)mt * 128 * DFF, DFF, wl(p, l, WL_DOWN) + (size_t)nt * 128 * DFF,
                   (bf16*)(p.ws + OFF_H) + (size_t)mt * 128 * DM + nt * 128, DM, hf, smem);
      }
      break;
    case PH_ROW2: row_phase<2>(p, l, bid, G); break;
  }
}

#define XB_TMO      128
#define XB_XCNT(j)  (256  + 64 * (j))
#define XB_XSUB(j)  (1280 + 64 * (j))
#define XB_XGEN(j)  (2304 + 64 * (j))
#define XB_TOP      3328
#define XB_TOPGEN   3392
#define XCD_BAR_WORDS 3456
#define XB_SPIN_CAP (1u << 18)
#define LAS __attribute__((address_space(3)))

__device__ __forceinline__ unsigned xb_ld(unsigned* p)              { return __hip_atomic_load(p, __ATOMIC_RELAXED, __HIP_MEMORY_SCOPE_AGENT); }
__device__ __forceinline__ unsigned xb_add(unsigned* p, unsigned v) { return __hip_atomic_fetch_add(p, v, __ATOMIC_RELAXED, __HIP_MEMORY_SCOPE_AGENT); }
__device__ __forceinline__ unsigned xb_xcc_id() { return (unsigned)__builtin_amdgcn_s_getreg((3 << 11) | 20) & 0xFu; }
#define XB_SPIN(cond, bar) do { unsigned _sp = 0; while (cond) { __builtin_amdgcn_s_sleep(1); \
    if ((++_sp & 255u) == 0u) { if (xb_ld(&(bar)[XB_TMO])) break; if (_sp > XB_SPIN_CAP) { atomicAdd(&(bar)[XB_TMO], 1u); break; } } } } while (0)

struct XcdBarrier {
    unsigned* bar; unsigned x;
    volatile LAS unsigned* st;
};

__device__ __forceinline__ XcdBarrier xcd_barrier_post(unsigned* bar, volatile LAS unsigned* st) {
    XcdBarrier b; b.bar = bar; b.x = xb_xcc_id(); b.st = st;
    if (threadIdx.x == 0) (void)xb_add(&bar[XB_XCNT(b.x)], 1u);
    return b;
}
__device__ __forceinline__ void xcd_barrier_complete(unsigned* bar, unsigned x, unsigned& nloc, unsigned& nx) {
    const unsigned G = gridDim.x * gridDim.y * gridDim.z;
    unsigned sum, cnt, mine, sp = 0u;
    for (;;) {
        sum = 0u; cnt = 0u; mine = 0u;
#pragma unroll
        for (unsigned j = 0; j < 16; ++j) { const unsigned c = xb_ld(&bar[XB_XCNT(j)]); sum += c; cnt += (c > 0u) ? 1u : 0u; mine = (j == x) ? c : mine; }
        if (sum == G) break;
        __builtin_amdgcn_s_sleep(1);
        if ((++sp & 255u) == 0u) { if (xb_ld(&bar[XB_TMO])) break; if (sp > XB_SPIN_CAP) { atomicAdd(&bar[XB_TMO], 1u); break; } }
    }
    nloc = mine > 0u ? mine : 1u; nx = cnt > 0u ? cnt : 1u;
}

__device__ __forceinline__ void xcd_barrier(const XcdBarrier& b) {
    asm volatile("s_waitcnt vmcnt(0)" ::: "memory");
    __syncthreads();
    if (threadIdx.x == 0) {
        unsigned* bar = b.bar;
        __builtin_amdgcn_s_waitcnt(0);
        unsigned nloc = b.st[0], nx = b.st[1];
        if (nloc == 0u) { xcd_barrier_complete(bar, b.x, nloc, nx); b.st[0] = nloc; b.st[1] = nx; }
        const unsigned old = xb_add(&bar[XB_XSUB(b.x)], 1u);
        const unsigned gen = old / nloc;
        if (old + 1u == (gen + 1u) * nloc) {
            __builtin_amdgcn_fence(__ATOMIC_RELEASE, "agent");
            asm volatile("s_waitcnt vmcnt(0)" ::: "memory");
            const unsigned og = xb_add(&bar[XB_TOP], 1u);
            const unsigned tg = og / nx;
            if (og + 1u == (tg + 1u) * nx) xb_add(&bar[XB_TOPGEN], 1u);
            else XB_SPIN(xb_ld(&bar[XB_TOPGEN]) == tg, bar);
            __builtin_amdgcn_fence(__ATOMIC_ACQUIRE, "agent");
            xb_add(&bar[XB_XGEN(b.x)], 1u);
            asm volatile("s_waitcnt vmcnt(0)" ::: "memory");
        } else {
            XB_SPIN(xb_ld(&bar[XB_XGEN(b.x)]) == gen, bar);
            __builtin_amdgcn_fence(__ATOMIC_ACQUIRE, "agent");
            asm volatile("s_waitcnt vmcnt(0)" ::: "memory");
        }
    }
    __syncthreads();
}


DI void grid_barrier(unsigned* bar, unsigned& gen) {
  asm volatile("s_waitcnt vmcnt(0)" ::: "memory");
  __syncthreads();
  gen += 1;
  if (threadIdx.x == 0) {
    __builtin_amdgcn_fence(__ATOMIC_RELEASE, "agent");
    asm volatile("s_waitcnt vmcnt(0)" ::: "memory");
    const unsigned target = gen * gridDim.x;
    __hip_atomic_fetch_add(bar, 1u, __ATOMIC_RELAXED, __HIP_MEMORY_SCOPE_AGENT);
    while (__hip_atomic_load(bar, __ATOMIC_RELAXED, __HIP_MEMORY_SCOPE_AGENT) < target) __builtin_amdgcn_s_sleep(2);
  }
  __syncthreads();
  __builtin_amdgcn_fence(__ATOMIC_ACQUIRE, "agent");
  asm volatile("s_waitcnt vmcnt(0)" ::: "memory");
}

__global__ void __launch_bounds__(256, 2) hybrid_fwd(Params p, int ph_lo, int ph_hi) {
  extern __shared__ __attribute__((aligned(16))) char smem[];
  unsigned* bar = (unsigned*)(p.ws + OFF_BAR);
  unsigned gen = 0;
  __shared__ uint4 xb_words;
  if (threadIdx.x == 0) xb_words = make_uint4(0u, 0u, 0u, 0u);
  __syncthreads();
  XcdBarrier xb = xcd_barrier_post(bar + 64, (volatile LAS unsigned*)&xb_words);
  if (ph_lo < 0) cg::this_grid().sync();
  int i = 0;
#define STEP(PH, L)                                      \
  {                                                      \
    if (i >= ph_lo && i < ph_hi) {                       \
      Params q;                                          \
      q.ws = p.ws; q.out = p.out;                        \
      asm volatile("" : "+s"(q.ws), "+s"(q.out));        \
      _Pragma("unroll") for (int k = 0; k < 34; ++k) { q.in[k] = p.in[k]; asm volatile("" : "+s"(q.in[k])); } \
      run_phase(q, PH, L, smem);                         \
      if ((DUPMASK >> (PH)) & 1) { xcd_barrier(xb); run_phase(q, PH, L, smem); } \
      if (i + 1 < ph_hi) xcd_barrier(xb);                \
    }                                                    \
    ++i;                                                 \
  }
  STEP(PH_PREP, 0)
  STEP(PH_ROW0, 0)
#pragma unroll 1
  for (int l = 0; l < NL; ++l) {
    STEP(PH_PROJ, l)
    STEP(PH_MIX1, l)
    STEP(PH_SCAN, l)
    STEP(PH_MIX2, l)
    STEP(PH_GLU, l)
    STEP(PH_MERGE, l)
    STEP(PH_WOUT, l)
    STEP(PH_ROW1, l)
    STEP(PH_UP, l)
    STEP(PH_DOWN, l)
    STEP(PH_ROW2, l)
  }
#undef STEP
}

extern "C" void kernel_launch(void* const* d_in, const int* in_sizes, int n_in, void* d_out, int out_size, void* d_ws, size_t ws_size,
                              hipStream_t stream) {
  static int grid_blocks = 0;
  if (!grid_blocks) {
    int dev = 0, cus = 0, per_cu = 0;
    hipGetDevice(&dev);
    hipDeviceGetAttribute(&cus, hipDeviceAttributeMultiprocessorCount, dev);
    hipFuncSetAttribute((const void*)hybrid_fwd, hipFuncAttributeMaxDynamicSharedMemorySize, SMEM_BYTES);
    hipOccupancyMaxActiveBlocksPerMultiprocessor(&per_cu, hybrid_fwd, 256, SMEM_BYTES);
    if (per_cu < 1) per_cu = 1;
    if (per_cu > 2) per_cu = 2;
    grid_blocks = cus * per_cu;
    if (ws_size < OFF_ZERO + 8192) fprintf(stderr, "workspace too small: %zu < %zu\n", ws_size, (size_t)OFF_END);
  }
  Params p{};
  for (int i = 0; i < 34; ++i) p.in[i] = (const float*)d_in[i];
  p.out = (float*)d_out;
  p.ws = (char*)d_ws;
#if ONE_LAUNCH
  hipMemsetAsync((char*)d_ws + OFF_BAR, 0, 16384, stream);
  int lo = 0, hi = N_PHASES;
  void* args[] = {&p, &lo, &hi};
  hipError_t e = hipLaunchCooperativeKernel((void*)hybrid_fwd, dim3(grid_blocks), dim3(256), args, SMEM_BYTES, stream);
  if (e != hipSuccess) fprintf(stderr, "cooperative launch failed: %s (grid %d)\n", hipGetErrorString(e), grid_blocks);
#else
  for (int i = 0; i < N_PHASES; ++i) hipLaunchKernelGGL(hybrid_fwd, dim3(grid_blocks), dim3(256), SMEM_BYTES, stream, p, i, i + 1);
#endif
}
```

```cpp
#include <hip/hip_runtime.h>
#include <hip/hip_cooperative_groups.h>
#include <stdint.h>
#include <cstdio>
namespace cg = cooperative_groups;

#define EXP_A 1
#ifndef DUPMASK
#define DUPMASK 0
#endif
#ifndef ONE_LAUNCH
#define ONE_LAUNCH 1
#endif

typedef unsigned short bf16;
typedef __attribute__((ext_vector_type(8))) short s16x8;
typedef __attribute__((ext_vector_type(4))) short s16x4;
typedef __attribute__((ext_vector_type(16))) float f32x16;
typedef __attribute__((ext_vector_type(4))) float f32x4;
typedef __attribute__((ext_vector_type(2))) float f32x2;
typedef __attribute__((ext_vector_type(4))) unsigned u32x4;
typedef __attribute__((ext_vector_type(2))) unsigned u32x2;
typedef __attribute__((ext_vector_type(2))) __bf16 bf16x2_t;

#define DI __device__ __forceinline__
#define MFMA32(a, b, c) __builtin_amdgcn_mfma_f32_32x32x16_bf16((a), (b), (c), 0, 0, 0)

DI int tidx_opaque() { int t = threadIdx.x; asm volatile("" : "+v"(t)); return t; }
#define TIDX tidx_opaque()
DI bf16 f2bf(float x) { return __builtin_bit_cast(unsigned short, (__bf16)x); }
DI float bf2f(bf16 v) { return __uint_as_float(((unsigned)v) << 16); }
DI unsigned pack2(float a, float b) {
  f32x2 v = {a, b};
  return __builtin_bit_cast(unsigned, __builtin_convertvector(v, bf16x2_t));
}
DI float bflo(unsigned u) { return __uint_as_float(u << 16); }
DI float bfhi(unsigned u) { return __uint_as_float(u & 0xffff0000u); }
typedef const __attribute__((address_space(1))) u32x4* gptr16;
DI u32x4 ldg16(const void* q) { return *(gptr16)(uintptr_t)q; }
#define SCHED_FENCE() __builtin_amdgcn_sched_barrier(0)
DI int crow(int i, int h) { return (i & 3) + 8 * (i >> 2) + 4 * h; }
DI void sincos_cw(float x, float& sn, float& cs) {
  const float k = rintf(x * 0.63661977236758134f);
  float r = fmaf(-k, 1.57079637050628662109375f, x);
  r = fmaf(-k, -4.371139000186241e-08f, r);
  const int q = ((int)k) & 3;
  const float r2 = r * r;
  const float sp = r + r * r2 * (-1.6666667163e-01f + r2 * (8.3333337680e-03f + r2 * (-1.9841270114e-04f + r2 * 2.7557314297e-06f)));
  const float cp = 1.f + r2 * (-0.5f + r2 * (4.1666667908e-02f + r2 * (-1.3888889225e-03f + r2 * (2.4801587642e-05f - r2 * 2.7557314297e-07f))));
  sn = (q == 0) ? sp : (q == 1) ? cp : (q == 2) ? -sp : -cp;
  cs = (q == 0) ? cp : (q == 1) ? -sp : (q == 2) ? -cp : sp;
}
DI float sigmoidf_(float x) { return 1.f / (1.f + __expf(-x)); }
DI float siluf_(float x) { return x / (1.f + __expf(-x)); }

constexpr int DM = 1024, NB = 4, SEQ = 8192, CTXL = 256, TT = SEQ + CTXL, NTOK = NB * TT, NL = 4;
constexpr int DFF = 2816, DIN = 5408;
constexpr float EPSF = 1e-6f;
constexpr int NG33 = 33;
constexpr int NCH = 264;
constexpr int MS5 = NB * NCH;

constexpr size_t SZ_H = (size_t)NTOK * 1024 * 2;
constexpr size_t OFF_H = 0;
constexpr size_t OFF_P = OFF_H + SZ_H;
constexpr size_t OFF_Q = OFF_P;
constexpr size_t OFF_K = OFF_Q + (size_t)NTOK * 256 * 2;
constexpr size_t OFF_VT = OFF_K + (size_t)NTOK * 128 * 2;
constexpr size_t OFF_GQ = OFF_VT + (size_t)NTOK * 128 * 2;
constexpr size_t OFF_GK = OFF_GQ + (size_t)NTOK * 256 * 2;
constexpr size_t OFF_GVT = OFF_GK + (size_t)NTOK * 256 * 2;
constexpr size_t OFF_GR = OFF_GVT + (size_t)NTOK * 512 * 2;
constexpr size_t OFF_SU = OFF_GR + (size_t)NTOK * 512 * 2;
constexpr size_t OFF_LOW = OFF_SU + (size_t)NTOK * 256 * 2;
constexpr size_t OFF_O = OFF_LOW + (size_t)NTOK * 32 * 4;
constexpr size_t OFF_OATT = OFF_O;
constexpr size_t OFF_OGLA = OFF_OATT + (size_t)NTOK * 256 * 2;
constexpr size_t OFF_Y5 = OFF_OGLA + (size_t)NTOK * 512 * 2;
constexpr size_t OFF_EN = OFF_Y5;
constexpr size_t OFF_OS5 = OFF_Y5 + (size_t)NTOK * 256 * 2;
constexpr size_t OFF_M = OFF_OS5 + (size_t)NTOK * 256 * 2;
constexpr size_t OFF_MG = OFF_M;
constexpr size_t OFF_GS = OFF_M;
constexpr size_t OFF_DECG = OFF_GS + (size_t)32 * 33 * 8192 * 4;
constexpr size_t OFF_SB = OFF_DECG + (size_t)32 * 33 * 64 * 4;
constexpr size_t OFF_T5 = OFF_SB + (size_t)MS5 * 16 * 256 * 2;
constexpr size_t OFF_E5 = OFF_T5 + (size_t)16 * 512 * 512 * 2;
constexpr size_t OFF_F5 = OFF_E5 + (size_t)16 * 512 * 256 * 2;
constexpr size_t OFF_MEND = OFF_F5 + (size_t)16 * 256 * 512 * 2;
static_assert(OFF_MEND <= OFF_M + SZ_H, "mixer scratch overflows merged area");
constexpr size_t OFF_W = OFF_M + SZ_H;
constexpr size_t WL_WIN = 0, WL_BRA = WL_WIN + (size_t)5504 * 1024, WL_BRG = WL_BRA + 1024 * 256, WL_BRS = WL_BRG + 1024 * 512,
                 WL_WOUT = WL_BRS + 1024 * 256, WL_UP = WL_WOUT + 1024 * 1024, WL_DOWN = WL_UP + (size_t)5632 * 1024,
                 WL_GLU = WL_DOWN + (size_t)1024 * 2816, WL_TOTAL = WL_GLU + 256 * 256;
constexpr size_t OFF_XC = OFF_W + WL_TOTAL * 2 * NL;
constexpr size_t OFF_MOD = OFF_XC + (size_t)NB * CTXL * 1024 * 4;
constexpr size_t OFF_BBR = OFF_MOD + (size_t)NL * 5 * 6144 * 4;
constexpr size_t OFF_BBI = OFF_BBR + (size_t)NL * 2 * 16 * 64 * 16 * 4;
constexpr size_t OFF_PWR = OFF_BBI + (size_t)NL * 2 * 16 * 64 * 16 * 4;
constexpr size_t OFF_KTAB = OFF_PWR + (size_t)NL * 2 * 16 * 33 * 64 * 8;
constexpr size_t OFF_END = OFF_KTAB + (size_t)NL * 16 * 2 * 32 * 256 * 4;
constexpr size_t OFF_BAR = OFF_END;
constexpr size_t OFF_ZERO = OFF_BAR + 16384;
constexpr size_t OFF_G = OFF_P;
static_assert((size_t)NTOK * DFF * 2 <= OFF_M - OFF_P, "G overflows");

constexpr int SMEM_BYTES = 73728;

struct Params {
  const float* in[34];
  float* out;
  char* ws;
};

enum { I_X = 0, I_C, I_CTX, I_CCTX, I_ADAW, I_ADAB, I_NMPRE, I_NMPOST, I_NFPRE, I_NFPOST, I_WIN, I_QN, I_KN, I_GGW, I_GGB, I_GON,
       I_ARE, I_AIM, I_LDT, I_BRE, I_BIM, I_CRE, I_CIM, I_S5D, I_GLUW, I_GLUB, I_WBA, I_WBG, I_WBS, I_WOUT, I_UP, I_CW, I_CB, I_DOWN };

constexpr int LDT = 72;
constexpr int CLD = 132;

template <class FA, class FB>
DI void gemm_main(f32x16 (&acc)[2][2], FA fa, FB fb, int K, char* smem) {
  bf16* As = (bf16*)smem;
  bf16* Bs = (bf16*)(smem + 2 * 128 * LDT * 2);
  const int tid = TIDX, lane = tid & 63, w = tid >> 6, wm = w >> 1, wn = w & 1;
  const int r = lane & 31, h = lane >> 5;
  const int lr = tid >> 3, kc = (tid & 7) * 8;
  const bf16* ap[4];
  const bf16* bp[4];
#pragma unroll
  for (int i = 0; i < 4; ++i) {
    const bf16* a = fa(lr + 32 * i);
    const bf16* b = fb(lr + 32 * i);
    ap[i] = a ? a + kc : nullptr;
    bp[i] = b ? b + kc : nullptr;
  }
  u32x4 ra[4], rb[4];
  const u32x4 z4 = {0u, 0u, 0u, 0u};
#pragma unroll
  for (int i = 0; i < 4; ++i) {
    ra[i] = ap[i] ? ldg16(ap[i]) : z4;
    rb[i] = bp[i] ? ldg16(bp[i]) : z4;
  }
#pragma unroll
  for (int i = 0; i < 4; ++i) {
    *(u32x4*)(As + (lr + 32 * i) * LDT + kc) = ra[i];
    *(u32x4*)(Bs + (lr + 32 * i) * LDT + kc) = rb[i];
  }
  __syncthreads();
  const int nk = K / 64;
  for (int kt = 0; kt < nk; ++kt) {
    const int buf = kt & 1;
    const bool more = (kt + 1 < nk);
    if (more) {
      const int k0 = (kt + 1) * 64;
#pragma unroll
      for (int i = 0; i < 4; ++i) {
        ra[i] = ap[i] ? ldg16(ap[i] + k0) : z4;
        rb[i] = bp[i] ? ldg16(bp[i] + k0) : z4;
      }
    }
    SCHED_FENCE();
    const bf16* Ab = As + buf * 128 * LDT + (wm * 64 + r) * LDT + h * 8;
    const bf16* Bb = Bs + buf * 128 * LDT + (wn * 64 + r) * LDT + h * 8;
#pragma unroll
    for (int s = 0; s < 4; ++s) {
      s16x8 a0 = *(const s16x8*)(Ab + s * 16);
      s16x8 a1 = *(const s16x8*)(Ab + 32 * LDT + s * 16);
      s16x8 b0 = *(const s16x8*)(Bb + s * 16);
      s16x8 b1 = *(const s16x8*)(Bb + 32 * LDT + s * 16);
      acc[0][0] = MFMA32(a0, b0, acc[0][0]);
      acc[0][1] = MFMA32(a0, b1, acc[0][1]);
      acc[1][0] = MFMA32(a1, b0, acc[1][0]);
      acc[1][1] = MFMA32(a1, b1, acc[1][1]);
    }
    SCHED_FENCE();
    if (more) {
      bf16* Aw = As + (buf ^ 1) * 128 * LDT;
      bf16* Bw = Bs + (buf ^ 1) * 128 * LDT;
#pragma unroll
      for (int i = 0; i < 4; ++i) {
        *(u32x4*)(Aw + (lr + 32 * i) * LDT + kc) = ra[i];
        *(u32x4*)(Bw + (lr + 32 * i) * LDT + kc) = rb[i];
      }
    }
    __syncthreads();
  }
}

template <class FA, class FB>
DI void gemm_main_deep(f32x16 (&acc)[2][2], FA fa, FB fb, int K, char* smem) {
  bf16* As = (bf16*)smem;
  bf16* Bs = (bf16*)(smem + 2 * 128 * LDT * 2);
  const int tid = TIDX, lane = tid & 63, w = tid >> 6, wm = w >> 1, wn = w & 1;
  const int r = lane & 31, h = lane >> 5;
  const int lr = tid >> 3, kc = (tid & 7) * 8;
  const bf16* ap[4];
  const bf16* bp[4];
#pragma unroll
  for (int i = 0; i < 4; ++i) {
    const bf16* a = fa(lr + 32 * i);
    const bf16* b = fb(lr + 32 * i);
    ap[i] = a ? a + kc : nullptr;
    bp[i] = b ? b + kc : nullptr;
  }
  const u32x4 z4 = {0u, 0u, 0u, 0u};
  u32x4 a0[4], b0[4], a1[4], b1[4];
  const int nk = K / 64;
#define GD_LOAD(RA, RB, T)                                               \
  {                                                                      \
    const int k0_ = (T) * 64;                                            \
    _Pragma("unroll") for (int i = 0; i < 4; ++i) {                      \
      RA[i] = ap[i] ? ldg16(ap[i] + k0_) : z4;                           \
      RB[i] = bp[i] ? ldg16(bp[i] + k0_) : z4;                           \
    }                                                                    \
  }
#define GD_STORE(RA, RB, BUF)                                            \
  {                                                                      \
    _Pragma("unroll") for (int i = 0; i < 4; ++i) {                      \
      *(u32x4*)(As + (BUF) * 128 * LDT + (lr + 32 * i) * LDT + kc) = RA[i]; \
      *(u32x4*)(Bs + (BUF) * 128 * LDT + (lr + 32 * i) * LDT + kc) = RB[i]; \
    }                                                                    \
  }
#define GD_COMPUTE(BUF)                                                  \
  {                                                                      \
    const bf16* Ab = As + (BUF) * 128 * LDT + (wm * 64 + r) * LDT + h * 8; \
    const bf16* Bb = Bs + (BUF) * 128 * LDT + (wn * 64 + r) * LDT + h * 8; \
    _Pragma("unroll") for (int s = 0; s < 4; ++s) {                      \
      s16x8 fa0 = *(const s16x8*)(Ab + s * 16);                          \
      s16x8 fa1 = *(const s16x8*)(Ab + 32 * LDT + s * 16);               \
      s16x8 fb0 = *(const s16x8*)(Bb + s * 16);                          \
      s16x8 fb1 = *(const s16x8*)(Bb + 32 * LDT + s * 16);               \
      acc[0][0] = MFMA32(fa0, fb0, acc[0][0]);                           \
      acc[0][1] = MFMA32(fa0, fb1, acc[0][1]);                           \
      acc[1][0] = MFMA32(fa1, fb0, acc[1][0]);                           \
      acc[1][1] = MFMA32(fa1, fb1, acc[1][1]);                           \
    }                                                                    \
  }
  GD_LOAD(a0, b0, 0)
  GD_LOAD(a1, b1, 1)
  GD_STORE(a0, b0, 0)
  __syncthreads();
  if (nk > 2) GD_LOAD(a0, b0, 2)
  for (int kt = 0; kt < nk; kt += 2) {
    SCHED_FENCE();
    GD_COMPUTE(0)
    SCHED_FENCE();
    GD_STORE(a1, b1, 1)
    if (kt + 3 < nk) GD_LOAD(a1, b1, kt + 3)
    __syncthreads();
    SCHED_FENCE();
    GD_COMPUTE(1)
    SCHED_FENCE();
    if (kt + 2 < nk) {
      GD_STORE(a0, b0, 0)
      if (kt + 4 < nk) GD_LOAD(a0, b0, kt + 4)
    }
    __syncthreads();
  }
#undef GD_LOAD
#undef GD_STORE
#undef GD_COMPUTE
}

template <class FA, class FB>
DI void gemm_main_dma(f32x16 (&acc)[2][2], FA fa, FB fb, int K, char* smem) {
  char* As = smem;
  char* Bs = smem + 32768;
  const int tid = TIDX, lane = tid & 63, w = tid >> 6, wm = w >> 1, wn = w & 1;
  const int r = lane & 31, h = lane >> 5;
  const bf16* ap[4];
  const bf16* bp[4];
#pragma unroll
  for (int i = 0; i < 4; ++i) {
    const int row = w * 32 + i * 8 + (lane >> 3);
    const int c = (lane & 7) ^ ((row >> 1) & 7);
    ap[i] = fa(row) + c * 8;
    bp[i] = fb(row) + c * 8;
  }
  const int ldst = (w * 256 + lane) * 16;
#define GM_DMA(BUF, T)                                                                                        \
  {                                                                                                           \
    const int k0_ = (T) * 64;                                                                                 \
    _Pragma("unroll") for (int i = 0; i < 4; ++i) {                                                           \
      __builtin_amdgcn_global_load_lds((const unsigned*)(ap[i] + k0_), (unsigned*)(As + (BUF) * 16384 + ldst + i * 1024), 16, 0, 0); \
      __builtin_amdgcn_global_load_lds((const unsigned*)(bp[i] + k0_), (unsigned*)(Bs + (BUF) * 16384 + ldst + i * 1024), 16, 0, 0); \
    }                                                                                                         \
  }
  const int xr = (r >> 1) & 7;
  const int arow = (wm * 64 + r) * 128, brow = (wn * 64 + r) * 128;
  GM_DMA(0, 0)
  asm volatile("s_waitcnt vmcnt(0)" ::: "memory");
  __syncthreads();
  const int nk = K / 64;
  for (int kt = 0; kt < nk; ++kt) {
    const int buf = kt & 1;
    if (kt + 1 < nk) GM_DMA(buf ^ 1, kt + 1)
    const char* Ab = As + buf * 16384 + arow;
    const char* Bb = Bs + buf * 16384 + brow;
#pragma unroll
    for (int s = 0; s < 4; ++s) {
      const int co = ((2 * s + h) ^ xr) * 16;
      s16x8 a0 = *(const s16x8*)(Ab + co);
      s16x8 a1 = *(const s16x8*)(Ab + 32 * 128 + co);
      s16x8 b0 = *(const s16x8*)(Bb + co);
      s16x8 b1 = *(const s16x8*)(Bb + 32 * 128 + co);
      acc[0][0] = MFMA32(a0, b0, acc[0][0]);
      acc[0][1] = MFMA32(a0, b1, acc[0][1]);
      acc[1][0] = MFMA32(a1, b0, acc[1][0]);
      acc[1][1] = MFMA32(a1, b1, acc[1][1]);
    }
    asm volatile("s_waitcnt vmcnt(0)" ::: "memory");
    __syncthreads();
  }
#undef GM_DMA
}

DI void gemm_main_dma_half(f32x16 (&acc)[2], const bf16* A, int lda, const bf16* B, int ldb, int K, int hf, char* smem) {
  char* As = smem;
  char* Bs = smem + 32768;
  const int tid = TIDX, lane = tid & 63, w = tid >> 6, wm = w >> 1, wn = w & 1;
  const int r = lane & 31, h = lane >> 5;
  const bf16* ap[4];
  const bf16* bp[2];
#pragma unroll
  for (int i = 0; i < 4; ++i) {
    const int row = w * 32 + i * 8 + (lane >> 3);
    ap[i] = A + (size_t)row * lda + ((lane & 7) ^ ((row >> 1) & 7)) * 8;
  }
#pragma unroll
  for (int i = 0; i < 2; ++i) {
    const int lrow = w * 16 + i * 8 + (lane >> 3);
    const int grow = (lrow >> 5) * 64 + hf * 32 + (lrow & 31);
    bp[i] = B + (size_t)grow * ldb + ((lane & 7) ^ ((lrow >> 1) & 7)) * 8;
  }
  const int lda_ = (w * 256 + lane) * 16, ldb_ = (w * 128 + lane) * 16;
#define GH_DMA(BUF, T)                                                                                        \
  {                                                                                                           \
    const int k0_ = (T) * 64;                                                                                 \
    _Pragma("unroll") for (int i = 0; i < 4; ++i)                                                             \
      __builtin_amdgcn_global_load_lds((const unsigned*)(ap[i] + k0_), (unsigned*)(As + (BUF) * 16384 + lda_ + i * 1024), 16, 0, 0); \
    _Pragma("unroll") for (int i = 0; i < 2; ++i)                                                             \
      __builtin_amdgcn_global_load_lds((const unsigned*)(bp[i] + k0_), (unsigned*)(Bs + (BUF) * 8192 + ldb_ + i * 1024), 16, 0, 0); \
  }
  const int xr = (r >> 1) & 7;
  const int arow = (wm * 64 + r) * 128, brow = (wn * 32 + r) * 128;
  GH_DMA(0, 0)
  asm volatile("s_waitcnt vmcnt(0)" ::: "memory");
  __syncthreads();
  const int nk = K / 64;
  for (int kt = 0; kt < nk; ++kt) {
    const int buf = kt & 1;
    if (kt + 1 < nk) GH_DMA(buf ^ 1, kt + 1)
    const char* Ab = As + buf * 16384 + arow;
    const char* Bb = Bs + buf * 8192 + brow;
#pragma unroll
    for (int s = 0; s < 4; ++s) {
      const int co = ((2 * s + h) ^ xr) * 16;
      s16x8 a0 = *(const s16x8*)(Ab + co);
      s16x8 a1 = *(const s16x8*)(Ab + 32 * 128 + co);
      s16x8 b0 = *(const s16x8*)(Bb + co);
      acc[0] = MFMA32(a0, b0, acc[0]);
      acc[1] = MFMA32(a1, b0, acc[1]);
    }
    asm volatile("s_waitcnt vmcnt(0)" ::: "memory");
    __syncthreads();
  }
#undef GH_DMA
}

template <class FA, class FB>
DI void gemm_wide(f32x16 (&acc)[2][4], FA fa, FB fb, int K, char* smem) {
  const int tid = TIDX, lane = tid & 63, w = tid >> 6, wm = w >> 1, wn = w & 1;
  const int r = lane & 31, h = lane >> 5;
  const bf16* ap[2];
  const bf16* bp[4];
#pragma unroll
  for (int i = 0; i < 2; ++i) {
    const int row = w * 32 + i * 16 + (lane >> 2);
    ap[i] = fa(row) + ((lane & 3) ^ ((row >> 2) & 3)) * 8;
  }
#pragma unroll
  for (int i = 0; i < 4; ++i) {
    const int row = w * 64 + i * 16 + (lane >> 2);
    bp[i] = fb(row) + ((lane & 3) ^ ((row >> 2) & 3)) * 8;
  }
  const int lda_ = (w * 128 + lane) * 16;
  const int ldb_ = 8192 + (w * 256 + lane) * 16;
#define GW_DMA(T)                                                                                                   \
  {                                                                                                                 \
    char* st_ = smem + ((T) % 3) * 24576;                                                                           \
    const int k0_ = (T) * 32;                                                                                       \
    _Pragma("unroll") for (int i = 0; i < 2; ++i)                                                                   \
      __builtin_amdgcn_global_load_lds((const unsigned*)(ap[i] + k0_), (unsigned*)(st_ + lda_ + i * 1024), 16, 0, 0); \
    _Pragma("unroll") for (int i = 0; i < 4; ++i)                                                                   \
      __builtin_amdgcn_global_load_lds((const unsigned*)(bp[i] + k0_), (unsigned*)(st_ + ldb_ + i * 1024), 16, 0, 0); \
  }
  const int xr = (r >> 2) & 3;
  const int arow = (wm * 64 + r) * 64;
  const int brow = 8192 + (wn * 64 + r) * 64;
  const int nt = K / 32;
  GW_DMA(0)
  if (nt > 1) GW_DMA(1)
  for (int t = 0; t < nt; ++t) {
    if (t + 1 < nt) asm volatile("s_waitcnt vmcnt(6)" ::: "memory");
    else asm volatile("s_waitcnt vmcnt(0)" ::: "memory");
    __syncthreads();
    if (t + 2 < nt) GW_DMA(t + 2)
    const char* st = smem + (t % 3) * 24576;
#pragma unroll
    for (int s = 0; s < 2; ++s) {
      const int co = ((2 * s + h) ^ xr) * 16;
      const s16x8 a0 = *(const s16x8*)(st + arow + co);
      const s16x8 a1 = *(const s16x8*)(st + arow + 32 * 64 + co);
#pragma unroll
      for (int hn = 0; hn < 2; ++hn) {
        const s16x8 b0 = *(const s16x8*)(st + brow + hn * 128 * 64 + co);
        const s16x8 b1 = *(const s16x8*)(st + brow + hn * 128 * 64 + 32 * 64 + co);
        acc[0][hn * 2 + 0] = MFMA32(a0, b0, acc[0][hn * 2 + 0]);
        acc[0][hn * 2 + 1] = MFMA32(a0, b1, acc[0][hn * 2 + 1]);
        acc[1][hn * 2 + 0] = MFMA32(a1, b0, acc[1][hn * 2 + 0]);
        acc[1][hn * 2 + 1] = MFMA32(a1, b1, acc[1][hn * 2 + 1]);
      }
    }
  }
  __syncthreads();
#undef GW_DMA
}

DI void accw_zero(f32x16 (&acc)[2][4]) {
#pragma unroll
  for (int a = 0; a < 2; ++a)
#pragma unroll
    for (int b = 0; b < 4; ++b)
#pragma unroll
      for (int i = 0; i < 16; ++i) acc[a][b][i] = 0.f;
}

DI void gemm_main_s(f32x16 (&acc)[2][2], const bf16* A, int lda, const bf16* B, int ldb, int K, char* smem) {
  bf16* As = (bf16*)smem;
  bf16* Bs = (bf16*)(smem + 2 * 128 * LDT * 2);
  const int tid = TIDX, lane = tid & 63, w = tid >> 6, wm = w >> 1, wn = w & 1;
  const int r = lane & 31, h = lane >> 5;
  const int lr = tid >> 3, kc = (tid & 7) * 8;
  const bf16* ap = A + (size_t)lr * lda + kc;
  const bf16* bp = B + (size_t)lr * ldb + kc;
  const size_t sa = (size_t)32 * lda, sb = (size_t)32 * ldb;
  u32x4 ra[4], rb[4];
#pragma unroll
  for (int i = 0; i < 4; ++i) {
    ra[i] = ldg16(ap + i * sa);
    rb[i] = ldg16(bp + i * sb);
  }
#pragma unroll
  for (int i = 0; i < 4; ++i) {
    *(u32x4*)(As + (lr + 32 * i) * LDT + kc) = ra[i];
    *(u32x4*)(Bs + (lr + 32 * i) * LDT + kc) = rb[i];
  }
  __syncthreads();
  const int nk = K / 64;
  for (int kt = 0; kt < nk; ++kt) {
    const int buf = kt & 1;
    const bool more = (kt + 1 < nk);
    if (more) {
      ap += 64; bp += 64;
#pragma unroll
      for (int i = 0; i < 4; ++i) {
        ra[i] = ldg16(ap + i * sa);
        rb[i] = ldg16(bp + i * sb);
      }
    }
    SCHED_FENCE();
    const bf16* Ab = As + buf * 128 * LDT + (wm * 64 + r) * LDT + h * 8;
    const bf16* Bb = Bs + buf * 128 * LDT + (wn * 64 + r) * LDT + h * 8;
#pragma unroll
    for (int s = 0; s < 4; ++s) {
      s16x8 a0 = *(const s16x8*)(Ab + s * 16);
      s16x8 a1 = *(const s16x8*)(Ab + 32 * LDT + s * 16);
      s16x8 b0 = *(const s16x8*)(Bb + s * 16);
      s16x8 b1 = *(const s16x8*)(Bb + 32 * LDT + s * 16);
      acc[0][0] = MFMA32(a0, b0, acc[0][0]);
      acc[0][1] = MFMA32(a0, b1, acc[0][1]);
      acc[1][0] = MFMA32(a1, b0, acc[1][0]);
      acc[1][1] = MFMA32(a1, b1, acc[1][1]);
    }
    SCHED_FENCE();
    if (more) {
      bf16* Aw = As + (buf ^ 1) * 128 * LDT;
      bf16* Bw = Bs + (buf ^ 1) * 128 * LDT;
#pragma unroll
      for (int i = 0; i < 4; ++i) {
        *(u32x4*)(Aw + (lr + 32 * i) * LDT + kc) = ra[i];
        *(u32x4*)(Bw + (lr + 32 * i) * LDT + kc) = rb[i];
      }
    }
    __syncthreads();
  }
}

DI void gemm_main_half(f32x16 (&acc)[2], const bf16* A, int lda, const bf16* B, int ldb, int K, int hf, char* smem) {
  bf16* As = (bf16*)smem;
  bf16* Bs = (bf16*)(smem + 2 * 128 * LDT * 2);
  const int tid = TIDX, lane = tid & 63, w = tid >> 6, wm = w >> 1, wn = w & 1;
  const int r = lane & 31, h = lane >> 5;
  const int lr = tid >> 3, kc = (tid & 7) * 8;
  const bf16* ap = A + (size_t)lr * lda + kc;
  const bf16* bp = B + (size_t)(hf * 32 + lr) * ldb + kc;
  const size_t sa = (size_t)32 * lda, sb = (size_t)64 * ldb;
  u32x4 ra[4], rb[2];
#pragma unroll
  for (int i = 0; i < 4; ++i) ra[i] = ldg16(ap + i * sa);
#pragma unroll
  for (int i = 0; i < 2; ++i) rb[i] = ldg16(bp + i * sb);
#pragma unroll
  for (int i = 0; i < 4; ++i) *(u32x4*)(As + (lr + 32 * i) * LDT + kc) = ra[i];
#pragma unroll
  for (int i = 0; i < 2; ++i) *(u32x4*)(Bs + (lr + 32 * i) * LDT + kc) = rb[i];
  __syncthreads();
  const int nk = K / 64;
  for (int kt = 0; kt < nk; ++kt) {
    const int buf = kt & 1;
    const bool more = (kt + 1 < nk);
    if (more) {
      ap += 64; bp += 64;
#pragma unroll
      for (int i = 0; i < 4; ++i) ra[i] = ldg16(ap + i * sa);
#pragma unroll
      for (int i = 0; i < 2; ++i) rb[i] = ldg16(bp + i * sb);
    }
    SCHED_FENCE();
    const bf16* Ab = As + buf * 128 * LDT + (wm * 64 + r) * LDT + h * 8;
    const bf16* Bb = Bs + buf * 128 * LDT + (wn * 32 + r) * LDT + h * 8;
#pragma unroll
    for (int s = 0; s < 4; ++s) {
      s16x8 a0 = *(const s16x8*)(Ab + s * 16);
      s16x8 a1 = *(const s16x8*)(Ab + 32 * LDT + s * 16);
      s16x8 b0 = *(const s16x8*)(Bb + s * 16);
      acc[0] = MFMA32(a0, b0, acc[0]);
      acc[1] = MFMA32(a1, b0, acc[1]);
    }
    SCHED_FENCE();
    if (more) {
      bf16* Aw = As + (buf ^ 1) * 128 * LDT;
      bf16* Bw = Bs + (buf ^ 1) * 128 * LDT;
#pragma unroll
      for (int i = 0; i < 4; ++i) *(u32x4*)(Aw + (lr + 32 * i) * LDT + kc) = ra[i];
#pragma unroll
      for (int i = 0; i < 2; ++i) *(u32x4*)(Bw + (lr + 32 * i) * LDT + kc) = rb[i];
    }
    __syncthreads();
  }
}

DI void acc_zero(f32x16 (&acc)[2][2]) {
#pragma unroll
  for (int a = 0; a < 2; ++a)
#pragma unroll
    for (int b = 0; b < 2; ++b)
#pragma unroll
      for (int i = 0; i < 16; ++i) acc[a][b][i] = 0.f;
}

DI void acc_to_lds(const f32x16 (&acc)[2][2], float* Cs) {
  const int lane = TIDX & 63, w = TIDX >> 6, wm = w >> 1, wn = w & 1, r = lane & 31, h = lane >> 5;
#pragma unroll
  for (int tm = 0; tm < 2; ++tm)
#pragma unroll
    for (int tn = 0; tn < 2; ++tn)
#pragma unroll
      for (int i = 0; i < 16; ++i) Cs[(wm * 64 + tm * 32 + crow(i, h)) * CLD + wn * 64 + tn * 32 + r] = acc[tm][tn][i];
}

template <int HN>
DI void accw_to_lds(const f32x16 (&acc)[2][4], float* Cs) {
  const int lane = TIDX & 63, w = TIDX >> 6, wm = w >> 1, wn = w & 1, r = lane & 31, h = lane >> 5;
#pragma unroll
  for (int tm = 0; tm < 2; ++tm)
#pragma unroll
    for (int tn = 0; tn < 2; ++tn)
#pragma unroll
      for (int i = 0; i < 16; ++i) Cs[(wm * 64 + tm * 32 + crow(i, h)) * CLD + wn * 64 + tn * 32 + r] = acc[tm][HN * 2 + tn][i];
}

DI void store_tile_bf16(const float* Cs, bf16* dst, size_t ld, int mvalid, float scale) {
  for (int c = TIDX; c < 2048; c += 256) {
    const int row = c >> 4, cc = (c & 15) * 8;
    if (row < mvalid) {
      const float* s = Cs + row * CLD + cc;
      u32x4 v;
      v[0] = pack2(s[0] * scale, s[1] * scale);
      v[1] = pack2(s[2] * scale, s[3] * scale);
      v[2] = pack2(s[4] * scale, s[5] * scale);
      v[3] = pack2(s[6] * scale, s[7] * scale);
      *(u32x4*)(dst + (size_t)row * ld + cc) = v;
    }
  }
}

DI float* resid_row(const Params& p, int tok) {
  const int b = tok / TT, t = tok - b * TT;
  return (t < CTXL) ? (float*)(p.ws + OFF_XC) + ((size_t)b * CTXL + t) * DM : p.out + ((size_t)b * SEQ + (t - CTXL)) * DM;
}
DI const float* mod_vec(const Params& p, int l, int tok, int which) {
  const int b = tok / TT, t = tok - b * TT;
  const int m = (t < CTXL) ? 4 : b;
  return (const float*)(p.ws + OFF_MOD) + ((size_t)(l * 5 + m) * 6 + which) * DM;
}
DI float wave_sum(float v) {
#pragma unroll
  for (int o = 32; o >= 1; o >>= 1) v += __shfl_xor(v, o, 64);
  return v;
}
DI bf16* wl(const Params& p, int l, size_t off) { return (bf16*)(p.ws + OFF_W) + (size_t)l * WL_TOTAL + off; }

DI void prep_mod_job(const Params& p, int j, char* smem) {
  float* sc = (float*)smem;
  float* part = (float*)(smem + 20480);
  const int l = j / 24, nb = j % 24, tid = TIDX, lane = tid & 63, w = tid >> 6;
  for (int idx = tid; idx < 5120; idx += 256) {
    const int m = idx >> 10, k = idx & 1023;
    const float v = (m < 4) ? p.in[I_C][m * 1024 + k] : p.in[I_CCTX][k];
    sc[idx] = siluf_(v);
  }
  __syncthreads();
  const float* W = p.in[I_ADAW] + (size_t)l * 1024 * 6144 + nb * 256 + lane;
  float a[5][4];
#pragma unroll
  for (int m = 0; m < 5; ++m)
#pragma unroll
    for (int c = 0; c < 4; ++c) a[m][c] = 0.f;
#pragma unroll 4
  for (int kk = 0; kk < 256; ++kk) {
    const int k = w * 256 + kk;
    float wv[4];
#pragma unroll
    for (int c = 0; c < 4; ++c) wv[c] = W[(size_t)k * 6144 + 64 * c];
#pragma unroll
    for (int m = 0; m < 5; ++m) {
      const float sv = sc[m * 1024 + k];
#pragma unroll
      for (int c = 0; c < 4; ++c) a[m][c] += sv * wv[c];
    }
  }
#pragma unroll
  for (int m = 0; m < 5; ++m)
#pragma unroll
    for (int c = 0; c < 4; ++c) part[(w * 5 + m) * 256 + lane + 64 * c] = a[m][c];
  __syncthreads();
  const int n = nb * 256 + tid;
  const float bb = p.in[I_ADAB][l * 6144 + n];
  float* M = (float*)(p.ws + OFF_MOD) + (size_t)l * 5 * 6144 + n;
#pragma unroll
  for (int m = 0; m < 5; ++m)
    M[m * 6144] = part[(0 * 5 + m) * 256 + tid] + part[(1 * 5 + m) * 256 + tid] + part[(2 * 5 + m) * 256 + tid] + part[(3 * 5 + m) * 256 + tid] + bb;
  __syncthreads();
}

DI void prep_s5_job(const Params& p, int j) {
  const int idx = j * 256 + TIDX;
  const int ldg = idx >> 6, pp = idx & 63;
  const float dt = expf(p.in[I_LDT][ldg]);
  const float are = p.in[I_ARE][idx], aim = p.in[I_AIM][idx];
  const float mag = expf(are * dt);
  float sn, cs;
  sincos_cw(aim * dt, sn, cs);
  const float abr = mag * cs, abi = mag * sn;
  const float den = are * are + aim * aim;
  const float fre = ((abr - 1.f) * are + abi * aim) / den;
  const float fim = (abi * are - (abr - 1.f) * aim) / den;
  float* BBR = (float*)(p.ws + OFF_BBR);
  float* BBI = (float*)(p.ws + OFF_BBI);
  for (int hh = 0; hh < 16; ++hh) {
    const float br = p.in[I_BRE][(size_t)idx * 16 + hh], bi = p.in[I_BIM][(size_t)idx * 16 + hh];
    BBR[(size_t)idx * 16 + hh] = fre * br - fim * bi;
    BBI[(size_t)idx * 16 + hh] = fre * bi + fim * br;
  }
  float2* PW = (float2*)(p.ws + OFF_PWR);
  float pr = 1.f, pi = 0.f;
  for (int tau = 0; tau <= 32; ++tau) {
    PW[((size_t)ldg * 33 + tau) * 64 + pp] = make_float2(pr, pi);
    const float nr = pr * abr - pi * abi, ni = pr * abi + pi * abr;
    pr = nr; pi = ni;
  }
}

DI void prep_wt_job(const Params& p, int jj, char* smem) {
  float* tile = (float*)smem;
  const int l = jj / 4016;
  int r = jj % 4016;
  int mat = 0;
  const int cnt[8] = {1376, 64, 128, 64, 256, 1408, 704, 16};
#pragma unroll
  for (int m = 0; m < 8; ++m) {
    if (mat == m && r >= cnt[m]) { r -= cnt[m]; mat = m + 1; }
  }
  const float* src; int K, sld; size_t doff;
  switch (mat) {
    case 0: src = p.in[I_WIN] + (size_t)l * 1024 * DIN; K = 1024; sld = DIN; doff = WL_WIN; break;
    case 1: src = p.in[I_WBA] + (size_t)l * 256 * 1024; K = 256; sld = 1024; doff = WL_BRA; break;
    case 2: src = p.in[I_WBG] + (size_t)l * 512 * 1024; K = 512; sld = 1024; doff = WL_BRG; break;
    case 3: src = p.in[I_WBS] + (size_t)l * 256 * 1024; K = 256; sld = 1024; doff = WL_BRS; break;
    case 4: src = p.in[I_WOUT] + (size_t)l * 1024 * 1024; K = 1024; sld = 1024; doff = WL_WOUT; break;
    case 5: src = p.in[I_UP] + (size_t)l * 1024 * 5632; K = 1024; sld = 5632; doff = WL_UP; break;
    case 6: src = p.in[I_DOWN] + (size_t)l * 2816 * 1024; K = 2816; sld = 1024; doff = WL_DOWN; break;
    default: src = p.in[I_GLUW] + (size_t)l * 256 * 256; K = 256; sld = 256; doff = WL_GLU; break;
  }
  const int kt = K / 64;
  const int n0 = (r / kt) * 64, k0 = (r % kt) * 64;
  const int tid = TIDX;
  {
    const int nn = tid & 63;
    const int np = n0 + nn;
    int col;
    if (mat == 0) {
      if (np < 2048) col = np;
      else if (np < 2304) col = 2080 + (np - 2048);
      else if (np < 2336) col = 2048 + (np - 2304);
      else if (np < 2432) col = -1;
      else col = 2336 + (np - 2432);
    } else if (mat == 5) {
      const int jb = np >> 7, c = np & 127;
      col = (c < 64) ? (jb * 64 + c) : (DFF + jb * 64 + (c - 64));
    } else col = np;
#pragma unroll 4
    for (int kk = tid >> 6; kk < 64; kk += 4) tile[kk * 65 + nn] = (col >= 0) ? src[(size_t)(k0 + kk) * sld + col] : 0.f;
  }
  __syncthreads();
  {
    const int nn = tid >> 2, kq = (tid & 3) * 16;
    bf16* d = wl(p, l, doff) + (size_t)(n0 + nn) * K + k0 + kq;
    u32x4 v0, v1;
#pragma unroll
    for (int e = 0; e < 4; ++e) {
      v0[e] = pack2(tile[(kq + 2 * e) * 65 + nn], tile[(kq + 2 * e + 1) * 65 + nn]);
      v1[e] = pack2(tile[(kq + 8 + 2 * e) * 65 + nn], tile[(kq + 8 + 2 * e + 1) * 65 + nn]);
    }
    *(u32x4*)d = v0;
    *(u32x4*)(d + 8) = v1;
  }
  __syncthreads();
}

template <int MODE>
DI void row_job(const Params& p, int l, int tok) {
  const int lane = TIDX & 63;
  float x[16];
  float* xr = resid_row(p, tok);
  if (MODE == 0) {
    const int b = tok / TT, t = tok - b * TT;
    const float* src = (t < CTXL) ? p.in[I_CTX] + ((size_t)b * CTXL + t) * DM : p.in[I_X] + ((size_t)b * SEQ + (t - CTXL)) * DM;
#pragma unroll
    for (int i = 0; i < 4; ++i) {
      const f32x4 v = *(const f32x4*)(src + lane * 4 + 256 * i);
      x[4 * i] = v[0]; x[4 * i + 1] = v[1]; x[4 * i + 2] = v[2]; x[4 * i + 3] = v[3];
      *(f32x4*)(xr + lane * 4 + 256 * i) = v;
    }
  } else {
    const bf16* yr = (const bf16*)(p.ws + OFF_H) + (size_t)tok * DM;
    const float* gpost = p.in[MODE == 1 ? I_NMPOST : I_NFPOST] + l * DM;
    const float* mg = mod_vec(p, l, tok, MODE == 1 ? 2 : 5);
    float y[16];
    float ss = 0.f;
#pragma unroll
    for (int i = 0; i < 4; ++i) {
      const u32x2 u = *(const u32x2*)(yr + lane * 4 + 256 * i);
      y[4 * i] = bflo(u[0]); y[4 * i + 1] = bfhi(u[0]); y[4 * i + 2] = bflo(u[1]); y[4 * i + 3] = bfhi(u[1]);
#pragma unroll
      for (int e = 0; e < 4; ++e) ss += y[4 * i + e] * y[4 * i + e];
    }
    ss = wave_sum(ss);
    const float rstd = rsqrtf(ss * (1.f / DM) + EPSF);
#pragma unroll
    for (int i = 0; i < 4; ++i) {
      f32x4 v = *(const f32x4*)(xr + lane * 4 + 256 * i);
      const f32x4 g = *(const f32x4*)(gpost + lane * 4 + 256 * i);
      const f32x4 m = *(const f32x4*)(mg + lane * 4 + 256 * i);
#pragma unroll
      for (int e = 0; e < 4; ++e) { v[e] += m[e] * (y[4 * i + e] * rstd * g[e]); x[4 * i + e] = v[e]; }
      *(f32x4*)(xr + lane * 4 + 256 * i) = v;
    }
  }
  if (MODE == 2 && l == NL - 1) return;
  const int ln = (MODE == 2) ? l + 1 : l;
  const float* gpre = p.in[MODE == 1 ? I_NFPRE : I_NMPRE] + ln * DM;
  const float* sh = mod_vec(p, ln, tok, MODE == 1 ? 3 : 0);
  const float* scv = mod_vec(p, ln, tok, MODE == 1 ? 4 : 1);
  float ss = 0.f;
#pragma unroll
  for (int i = 0; i < 16; ++i) ss += x[i] * x[i];
  ss = wave_sum(ss);
  const float rstd = rsqrtf(ss * (1.f / DM) + EPSF);
  bf16* hr = (bf16*)(p.ws + OFF_H) + (size_t)tok * DM;
#pragma unroll
  for (int i = 0; i < 4; ++i) {
    const f32x4 g = *(const f32x4*)(gpre + lane * 4 + 256 * i);
    const f32x4 s1 = *(const f32x4*)(sh + lane * 4 + 256 * i);
    const f32x4 s2 = *(const f32x4*)(scv + lane * 4 + 256 * i);
    float o[4];
#pragma unroll
    for (int e = 0; e < 4; ++e) o[e] = (x[4 * i + e] * rstd * g[e]) * (1.f + s2[e]) + s1[e];
    u32x2 u;
    u[0] = pack2(o[0], o[1]); u[1] = pack2(o[2], o[3]);
    *(u32x2*)(hr + lane * 4 + 256 * i) = u;
  }
}

template <int MODE>
DI void row_phase(const Params& p, int l, int bid, int G) {
  const int lane = TIDX & 63;
  const int wg = bid * 4 + (TIDX >> 6), nw = G * 4;
  const int R = (NTOK + nw - 1) / nw;
  const int t0 = wg * R, t1 = min(NTOK, t0 + R);
  if (t0 >= t1) return;
  const bool has_next = !(MODE == 2 && l == NL - 1);
  const int ln = (MODE == 2) ? l + 1 : l;
  f32x4 gpost[4], gpre[4], mg[4], sh[4], scl[4];
#pragma unroll
  for (int i = 0; i < 4; ++i) {
    if (MODE != 0) gpost[i] = *(const f32x4*)(p.in[MODE == 1 ? I_NMPOST : I_NFPOST] + l * DM + lane * 4 + 256 * i);
    if (has_next) gpre[i] = *(const f32x4*)(p.in[MODE == 1 ? I_NFPRE : I_NMPRE] + ln * DM + lane * 4 + 256 * i);
  }
  int cur_m = -1;
  u32x2 yb[4], yn[4];
  f32x4 xb[4], xn[4];
  const bf16* Hb = (const bf16*)(p.ws + OFF_H);
#define ROW_LOAD(TOK, YY, XX)                                                                              \
  {                                                                                                        \
    const int b_ = (TOK) / TT, t_ = (TOK) - b_ * TT;                                                       \
    const float* src_ = (MODE == 0 || (MODE == 1 && l == 0)) ? ((t_ < CTXL) ? p.in[I_CTX] + ((size_t)b_ * CTXL + t_) * DM \
                                                   : p.in[I_X] + ((size_t)b_ * SEQ + (t_ - CTXL)) * DM)    \
                                    : resid_row(p, (TOK));                                                 \
    _Pragma("unroll") for (int i = 0; i < 4; ++i) {                                                        \
      XX[i] = *(const f32x4*)(src_ + lane * 4 + 256 * i);                                                  \
      if (MODE != 0) YY[i] = *(const u32x2*)(Hb + (size_t)(TOK) * DM + lane * 4 + 256 * i);                \
    }                                                                                                      \
  }
  ROW_LOAD(t0, yb, xb)
  for (int tok = t0; tok < t1; ++tok) {
    if (tok + 1 < t1) ROW_LOAD(tok + 1, yn, xn)
    const int b = tok / TT, t = tok - b * TT;
    const int m = (t < CTXL) ? 4 : b;
    if (m != cur_m) {
      cur_m = m;
      const float* Mv = (const float*)(p.ws + OFF_MOD);
#pragma unroll
      for (int i = 0; i < 4; ++i) {
        if (MODE != 0) mg[i] = *(const f32x4*)(Mv + ((size_t)(l * 5 + m) * 6 + (MODE == 1 ? 2 : 5)) * DM + lane * 4 + 256 * i);
        if (has_next) {
          sh[i] = *(const f32x4*)(Mv + ((size_t)(ln * 5 + m) * 6 + (MODE == 1 ? 3 : 0)) * DM + lane * 4 + 256 * i);
          scl[i] = *(const f32x4*)(Mv + ((size_t)(ln * 5 + m) * 6 + (MODE == 1 ? 4 : 1)) * DM + lane * 4 + 256 * i);
        }
      }
    }
    float* xr = resid_row(p, tok);
    f32x4 x[4];
    if (MODE == 0) {
#pragma unroll
      for (int i = 0; i < 4; ++i) x[i] = xb[i];
    } else {
      float y[16];
      float ss = 0.f;
#pragma unroll
      for (int i = 0; i < 4; ++i) {
        y[4 * i] = bflo(yb[i][0]); y[4 * i + 1] = bfhi(yb[i][0]); y[4 * i + 2] = bflo(yb[i][1]); y[4 * i + 3] = bfhi(yb[i][1]);
#pragma unroll
        for (int e = 0; e < 4; ++e) ss += y[4 * i + e] * y[4 * i + e];
      }
      ss = wave_sum(ss);
      const float rstd = rsqrtf(ss * (1.f / DM) + EPSF);
#pragma unroll
      for (int i = 0; i < 4; ++i) {
        f32x4 v = xb[i];
#pragma unroll
        for (int e = 0; e < 4; ++e) v[e] += mg[i][e] * (y[4 * i + e] * rstd * gpost[i][e]);
        x[i] = v;
        *(f32x4*)(xr + lane * 4 + 256 * i) = v;
      }
    }
    if (has_next) {
      float ss = 0.f;
#pragma unroll
      for (int i = 0; i < 4; ++i)
#pragma unroll
        for (int e = 0; e < 4; ++e) ss += x[i][e] * x[i][e];
      ss = wave_sum(ss);
      const float rstd = rsqrtf(ss * (1.f / DM) + EPSF);
      bf16* hr = (bf16*)(p.ws + OFF_H) + (size_t)tok * DM;
#pragma unroll
      for (int i = 0; i < 4; ++i) {
        float o[4];
#pragma unroll
        for (int e = 0; e < 4; ++e) o[e] = (x[i][e] * rstd * gpre[i][e]) * (1.f + scl[i][e]) + sh[i][e];
        u32x2 u;
        u[0] = pack2(o[0], o[1]); u[1] = pack2(o[2], o[3]);
        *(u32x2*)(hr + lane * 4 + 256 * i) = u;
      }
    }
#pragma unroll
    for (int i = 0; i < 4; ++i) { yb[i] = yn[i]; xb[i] = xn[i]; }
  }
#undef ROW_LOAD
}

DI void ktab_phase(const Params& p, int bid, int G, int l_lo, int l_hi) {
  const float* BBR = (const float*)(p.ws + OFF_BBR);
  const float* BBI = (const float*)(p.ws + OFF_BBI);
  const float2* PW = (const float2*)(p.ws + OFF_PWR);
  float* KT = (float*)(p.ws + OFF_KTAB);
  const int per_layer = 16 * 2 * 32 * 256;
  for (int idx = l_lo * per_layer + bid * 256 + TIDX; idx < l_hi * per_layer; idx += G * 256) {
    const int hp = idx & 15, hh = (idx >> 4) & 15, tau = (idx >> 8) & 31, d = (idx >> 13) & 1, g = (idx >> 14) & 15, l = idx >> 18;
    const int ldg = (l * 2 + d) * 16 + g;
    const float* cre = p.in[I_CRE] + ((size_t)ldg * 16 + hh) * 64;
    const float* cim = p.in[I_CIM] + ((size_t)ldg * 16 + hh) * 64;
    float acc = 0.f;
    for (int pp = 0; pp < 64; ++pp) {
      const float2 pw = PW[((size_t)ldg * 33 + tau) * 64 + pp];
      const float br = BBR[((size_t)ldg * 64 + pp) * 16 + hp], bi = BBI[((size_t)ldg * 64 + pp) * 16 + hp];
      const float zr = pw.x * br - pw.y * bi, zi = pw.x * bi + pw.y * br;
      acc += cre[pp] * zr - cim[pp] * zi;
    }
    KT[idx] = acc;
  }
}

DI void s5mat_phase(const Params& p, int l, int bid, int G) {
  const float* BBR = (const float*)(p.ws + OFF_BBR);
  const float* BBI = (const float*)(p.ws + OFF_BBI);
  const float2* PW = (const float2*)(p.ws + OFF_PWR);
  const float* KT = (const float*)(p.ws + OFF_KTAB);
  bf16* T5 = (bf16*)(p.ws + OFF_T5);
  bf16* E5 = (bf16*)(p.ws + OFF_E5);
  bf16* F5 = (bf16*)(p.ws + OFF_F5);
  const int nT = 16 * 512 * 64, nE = 16 * 512 * 32, nF = 16 * 256 * 64;
  for (int it = bid * 256 + TIDX; it < nT + nE + nF; it += G * 256) {
    float v[8];
    bf16* dst;
    if (it < nT) {
      const int k8 = it & 63, n = (it >> 6) & 511, g = it >> 15;
      const int i = n >> 4, hh = n & 15, j = k8 >> 1, hp0 = (k8 & 1) * 8;
#pragma unroll
      for (int e = 0; e < 8; ++e) {
        const int hp = hp0 + e;
        float a = 0.f;
        if (j <= i) a += KT[((((size_t)l * 16 + g) * 2 + 0) * 32 + (i - j)) * 256 + hh * 16 + hp];
        if (j >= i) a += KT[((((size_t)l * 16 + g) * 2 + 1) * 32 + (j - i)) * 256 + hh * 16 + hp];
        if (i == j && hh == hp) a += p.in[I_S5D][l * 256 + g * 16 + hh];
        v[e] = a;
      }
      dst = T5 + ((size_t)g * 512 + n) * 512 + k8 * 8;
    } else if (it < nT + nE) {
      const int q = it - nT;
      const int k8 = q & 31, n = (q >> 5) & 511, g = q >> 14;
      const int i = n >> 4, hh = n & 15;
      const int k0 = k8 * 8, d = k0 >> 7, ri = (k0 >> 6) & 1, p0 = k0 & 63;
      const int ldg = (l * 2 + d) * 16 + g;
      const int ex = d ? (32 - i) : (i + 1);
#pragma unroll
      for (int e = 0; e < 8; ++e) {
        const int pp = p0 + e;
        const float2 pw = PW[((size_t)ldg * 33 + ex) * 64 + pp];
        const float cr = p.in[I_CRE][((size_t)ldg * 16 + hh) * 64 + pp], ci = p.in[I_CIM][((size_t)ldg * 16 + hh) * 64 + pp];
        const float zr = cr * pw.x - ci * pw.y, zi = cr * pw.y + ci * pw.x;
        v[e] = ri ? -zi : zr;
      }
      dst = E5 + ((size_t)g * 512 + n) * 256 + k0;
    } else {
      const int q = it - nT - nE;
      const int k8 = q & 63, n = (q >> 6) & 255, g = q >> 14;
      const int d = n >> 7, ri = (n >> 6) & 1, pp = n & 63;
      const int j = k8 >> 1, hp0 = (k8 & 1) * 8;
      const int ldg = (l * 2 + d) * 16 + g;
      const int ex = d ? j : (31 - j);
      const float2 pw = PW[((size_t)ldg * 33 + ex) * 64 + pp];
#pragma unroll
      for (int e = 0; e < 8; ++e) {
        const float br = BBR[((size_t)ldg * 64 + pp) * 16 + hp0 + e], bi = BBI[((size_t)ldg * 64 + pp) * 16 + hp0 + e];
        v[e] = ri ? (pw.x * bi + pw.y * br) : (pw.x * br - pw.y * bi);
      }
      dst = F5 + ((size_t)g * 256 + n) * 512 + k8 * 8;
    }
    u32x4 u;
    u[0] = pack2(v[0], v[1]); u[1] = pack2(v[2], v[3]); u[2] = pack2(v[4], v[5]); u[3] = pack2(v[6], v[7]);
    *(u32x4*)dst = u;
  }
}

DI void proj_epi(const Params& p, int l, int mt, int nt, char* smem);
DI void proj_wide(const Params& p, int l, int mt, int np, char* smem) {
  const bf16* H = (const bf16*)(p.ws + OFF_H) + (size_t)mt * 128 * DM;
  const bf16* W = wl(p, l, WL_WIN) + (size_t)np * 256 * DM;
  if (np == 9) {
    f32x16 acc1[2][2];
    acc_zero(acc1);
    gemm_main_dma(acc1, [&](int r) { return H + (size_t)r * DM; }, [&](int r) { return W + (size_t)r * DM; }, DM, smem);
    acc_to_lds(acc1, (float*)smem);
    __syncthreads();
    proj_epi(p, l, mt, 18, smem);
    return;
  }
  f32x16 acc[2][4];
  accw_zero(acc);
  gemm_wide(acc, [&](int r) { return H + (size_t)r * DM; }, [&](int r) { return W + (size_t)r * DM; }, DM, smem);
  float* Cs = (float*)smem;
  accw_to_lds<0>(acc, Cs);
  __syncthreads();
  proj_epi(p, l, mt, np * 2, smem);
  if (np * 2 + 1 < 19) {
    accw_to_lds<1>(acc, Cs);
    __syncthreads();
    proj_epi(p, l, mt, np * 2 + 1, smem);
  }
}
DI void proj_epi(const Params& p, int l, int mt, int nt, char* smem) {
  float* Cs = (float*)smem;
  const int tid = TIDX;
  const int tok0 = mt * 128;
  const int b = tok0 / TT, t0 = tok0 - b * TT;
  if (nt <= 2) {
    const int row = tid >> 1, seg = tid & 1;
    float* c = Cs + row * CLD + seg * 64;
    const float* gn = p.in[nt < 2 ? I_QN : I_KN] + l * 64;
    float ss = 0.f;
#pragma unroll 8
    for (int i = 0; i < 64; ++i) ss += c[i] * c[i];
    const float rstd = rsqrtf(ss * (1.f / 64.f) + EPSF);
    const int t = t0 + row;
    const bool lat = t >= CTXL;
    const int s = t - CTXL;
#pragma unroll 1
    for (int ax = 0; ax < 2; ++ax) {
      const float pos = (float)(ax ? (s & 63) : (s >> 6));
#pragma unroll 2
      for (int f = 0; f < 16; ++f) {
        float x1 = c[ax * 32 + f] * rstd * gn[ax * 32 + f];
        float x2 = c[ax * 32 + 16 + f] * rstd * gn[ax * 32 + 16 + f];
        if (lat) {
          const float invf = exp2f(-(float)f * (13.287712379549449f / 16.f));
          float sn, cs;
          sincos_cw(pos * invf, sn, cs);
          const float y1 = x1 * cs - x2 * sn, y2 = x2 * cs + x1 * sn;
          x1 = y1; x2 = y2;
        }
        c[ax * 32 + f] = x1;
        c[ax * 32 + 16 + f] = x2;
      }
    }
    __syncthreads();
    if (nt < 2) store_tile_bf16(Cs, (bf16*)(p.ws + OFF_Q) + (size_t)tok0 * 256 + nt * 128, 256, 128, 0.125f * 1.4426950408889634f);
    else store_tile_bf16(Cs, (bf16*)(p.ws + OFF_K) + (size_t)tok0 * 128, 128, 128, 1.f);
  } else if (nt == 3 || (nt >= 8 && nt <= 11)) {
    for (int c = tid; c < 2048; c += 256) {
      const int col = c & 127, rc = (c >> 7) * 8;
      u32x4 u;
#pragma unroll
      for (int e = 0; e < 4; ++e) u[e] = pack2(Cs[(rc + 2 * e) * CLD + col], Cs[(rc + 2 * e + 1) * CLD + col]);
      bf16* dst;
      if (nt == 3) dst = (bf16*)(p.ws + OFF_VT) + ((size_t)(b * 2 + (col >> 6)) * 64 + (col & 63)) * TT + t0 + rc;
      else dst = (bf16*)(p.ws + OFF_GVT) + ((size_t)(b * 4 + (nt - 8)) * 128 + col) * TT + t0 + rc;
      *(u32x4*)dst = u;
    }
  } else if (nt == 4 || nt == 5) {
    store_tile_bf16(Cs, (bf16*)(p.ws + OFF_GQ) + (size_t)tok0 * 256 + (nt - 4) * 128, 256, 128, 0.125f);
  } else if (nt == 6 || nt == 7) {
    store_tile_bf16(Cs, (bf16*)(p.ws + OFF_GK) + (size_t)tok0 * 256 + (nt - 6) * 128, 256, 128, 1.f);
  } else if (nt >= 12 && nt <= 15) {
    store_tile_bf16(Cs, (bf16*)(p.ws + OFF_GR) + (size_t)tok0 * 512 + (nt - 12) * 128, 512, 128, 1.f);
  } else if (nt == 16 || nt == 17) {
    for (int c = tid; c < 2048; c += 256) {
      const int row = c >> 4, c8 = c & 15;
      const float* s = Cs + row * CLD + c8 * 8;
      u32x4 u;
#pragma unroll
      for (int e = 0; e < 4; ++e) u[e] = pack2(s[2 * e], s[2 * e + 1]);
      const int ch = (nt - 16) * 128 + c8 * 8;
      bf16* dst = (bf16*)(p.ws + OFF_SU) + ((size_t)(b * 16 + (ch >> 4)) * TT + t0 + row) * 16 + (ch & 15);
      *(u32x4*)dst = u;
    }
  } else {
    for (int c = tid; c < 128 * 8; c += 256) {
      const int row = c >> 3, c4 = (c & 7) * 4;
      const float* s = Cs + row * CLD + c4;
      f32x4 v = {s[0], s[1], s[2], s[3]};
      *(f32x4*)((float*)(p.ws + OFF_LOW) + (size_t)(tok0 + row) * 32 + c4) = v;
    }
  }
  __syncthreads();
}

DI void attn_unit(const Params& p, int u, char* smem) {
  int b, head, tok0, nkt;
  if (u < 1024) { b = u >> 8; head = (u >> 6) & 3; tok0 = b * TT + CTXL + (u & 63) * 128; nkt = TT / 128; }
  else { const int v = u - 1024; b = v >> 3; head = (v >> 1) & 3; tok0 = b * TT + (v & 1) * 128; nkt = CTXL / 128; }
  const int kvh = head >> 1;
  const int tid = TIDX, lane = tid & 63, w = tid >> 6, r = lane & 31, h = lane >> 5;
  const bf16* Qp = (const bf16*)(p.ws + OFF_Q) + (size_t)(tok0 + w * 32 + r) * 256 + head * 64 + h * 8;
  s16x8 qf[4];
#pragma unroll
  for (int s = 0; s < 4; ++s) qf[s] = __builtin_bit_cast(s16x8, ldg16(Qp + s * 16));
  const bf16* kp[2];
  const bf16* vp[2];
#pragma unroll
  for (int i = 0; i < 2; ++i) {
    const int row = w * 16 + i * 8 + (lane >> 3);
    const int c = (lane & 7) ^ ((row >> 1) & 7);
    kp[i] = (const bf16*)(p.ws + OFF_K) + ((size_t)b * TT + row) * 128 + kvh * 64 + c * 8;
    vp[i] = (const bf16*)(p.ws + OFF_VT) + ((size_t)(b * 2 + kvh) * 64 + row) * TT + c * 8;
  }
  const int ldst = (w * 128 + lane) * 16;
#define AT_DMA(BUF, T)                                                                                              \
  {                                                                                                                 \
    char* sb_ = smem + (BUF) * 32768;                                                                               \
    _Pragma("unroll") for (int hh = 0; hh < 2; ++hh)                                                                \
    _Pragma("unroll") for (int i = 0; i < 2; ++i) {                                                                 \
      __builtin_amdgcn_global_load_lds((const unsigned*)(kp[i] + (size_t)((T) * 128 + hh * 64) * 128), (unsigned*)(sb_ + hh * 8192 + ldst + i * 1024), 16, 0, 0); \
      __builtin_amdgcn_global_load_lds((const unsigned*)(vp[i] + (T) * 128 + hh * 64), (unsigned*)(sb_ + 16384 + hh * 8192 + ldst + i * 1024), 16, 0, 0);        \
    }                                                                                                               \
  }
  const int xr = (r >> 1) & 7;
  AT_DMA(0, 0)
  asm volatile("s_waitcnt vmcnt(0)" ::: "memory");
  __syncthreads();
  f32x16 oacc[2];
#pragma unroll
  for (int i = 0; i < 16; ++i) { oacc[0][i] = 0.f; oacc[1][i] = 0.f; }
  float mrow = -INFINITY, lrow = 0.f;
  for (int kt = 0; kt < nkt; ++kt) {
    const int buf = kt & 1;
    if (kt + 1 < nkt) AT_DMA(buf ^ 1, kt + 1)
    const char* Kb = smem + buf * 32768;
    const char* Vb = Kb + 16384;
    f32x16 sacc[4];
#pragma unroll
    for (int q = 0; q < 4; ++q)
#pragma unroll
      for (int i = 0; i < 16; ++i) sacc[q][i] = 0.f;
#pragma unroll
    for (int s = 0; s < 4; ++s) {
      const int co = ((2 * s + h) ^ xr) * 16;
#pragma unroll
      for (int q = 0; q < 4; ++q) {
        const s16x8 a = *(const s16x8*)(Kb + (q >> 1) * 8192 + ((q & 1) * 32 + r) * 128 + co);
        sacc[q] = MFMA32(a, qf[s], sacc[q]);
      }
    }
    float mx = sacc[0][0];
#pragma unroll
    for (int q = 0; q < 4; ++q)
#pragma unroll
      for (int i = 0; i < 16; ++i) mx = fmaxf(mx, sacc[q][i]);
    mx = fmaxf(mx, __shfl_xor(mx, 32, 64));
    const float mnew = fmaxf(mrow, mx);
    const float alpha = __builtin_amdgcn_exp2f(mrow - mnew);
    mrow = mnew;
    float psum = 0.f;
#pragma unroll
    for (int q = 0; q < 4; ++q)
#pragma unroll
      for (int i = 0; i < 16; ++i) { sacc[q][i] = __builtin_amdgcn_exp2f(sacc[q][i] - mnew); psum += sacc[q][i]; }
    lrow = lrow * alpha + psum;
#pragma unroll
    for (int i = 0; i < 16; ++i) { oacc[0][i] *= alpha; oacc[1][i] *= alpha; }
#pragma unroll
    for (int q = 0; q < 4; ++q)
#pragma unroll
      for (int s2 = 0; s2 < 2; ++s2) {
        u32x4 pu;
#pragma unroll
        for (int e = 0; e < 4; ++e) pu[e] = pack2(sacc[q][8 * s2 + 2 * e], sacc[q][8 * s2 + 2 * e + 1]);
        const s16x8 pf = __builtin_bit_cast(s16x8, pu);
        const int c0 = (q & 1) * 4 + 2 * s2;
        const int o0 = ((c0 ^ xr) * 16) + 8 * h, o1 = (((c0 + 1) ^ xr) * 16) + 8 * h;
#pragma unroll
        for (int dt = 0; dt < 2; ++dt) {
          const s16x4 lo = *(const s16x4*)(Vb + (q >> 1) * 8192 + (dt * 32 + r) * 128 + o0);
          const s16x4 hi = *(const s16x4*)(Vb + (q >> 1) * 8192 + (dt * 32 + r) * 128 + o1);
          const s16x8 a = __builtin_shufflevector(lo, hi, 0, 1, 2, 3, 4, 5, 6, 7);
          oacc[dt] = MFMA32(a, pf, oacc[dt]);
        }
      }
    asm volatile("s_waitcnt vmcnt(0)" ::: "memory");
    __syncthreads();
  }
#undef AT_DMA
  const float ltot = lrow + __shfl_xor(lrow, 32, 64);
  const float inv = 1.f / ltot;
  bf16* Op = (bf16*)(p.ws + OFF_OATT) + (size_t)(tok0 + w * 32 + r) * 256 + head * 64;
#pragma unroll
  for (int dt = 0; dt < 2; ++dt)
#pragma unroll
    for (int i = 0; i < 16; i += 4) {
      u32x2 uu;
      uu[0] = pack2(oacc[dt][i] * inv, oacc[dt][i + 1] * inv);
      uu[1] = pack2(oacc[dt][i + 2] * inv, oacc[dt][i + 3] * inv);
      *(u32x2*)(Op + dt * 32 + crow(i, h)) = uu;
    }
}

constexpr int GL_LOW = 0, GL_TOT = 4096, GL_DEC = 5120, GL_QIN = 5376, GL_KIN = 14592, GL_KET = 23808, GL_OST = 0,
              GL_VT = 33792, GL_ST = 52224;
static_assert(GL_ST + 128 * LDT * 2 <= SMEM_BYTES, "gla lds");

template <bool WITH_OUT>
DI void gla_unit(const Params& p, int l, int u, char* smem) {
  float* lowt = (float*)(smem + GL_LOW);
  float* tots = (float*)(smem + GL_TOT);
  float* decs = (float*)(smem + GL_DEC);
  bf16* qin = (bf16*)(smem + GL_QIN);
  bf16* kin = (bf16*)(smem + GL_KIN);
  bf16* ket = (bf16*)(smem + GL_KET);
  float* ost = (float*)(smem + GL_OST);
  bf16* vts = (bf16*)(smem + GL_VT);
  bf16* sts = (bf16*)(smem + GL_ST);
  const int tid = TIDX, lane = tid & 63, w = tid >> 6, r = lane & 31, h = lane >> 5;
  int b, hd, gi, dir0, ndir;
  if (WITH_OUT) { gi = u % NG33; hd = (u / NG33) & 3; b = u / (NG33 * 4); dir0 = 1; ndir = 2; }
  else { gi = u % NG33; const int v = u / NG33; dir0 = v & 1; hd = (v >> 1) & 3; b = v >> 3; ndir = 1; }
  const int dk = tid & 63, part = tid >> 6;
  const bf16* GQ = (const bf16*)(p.ws + OFF_GQ);
  const bf16* GK = (const bf16*)(p.ws + OFF_GK);
  const bf16* GVT = (const bf16*)(p.ws + OFF_GVT) + (size_t)(b * 4 + hd) * 128 * TT;
  const float* LOW = (const float*)(p.ws + OFF_LOW);
  for (int dd = 0; dd < ndir; ++dd) {
    const int dir = WITH_OUT ? (dir0 - dd) : dir0;
    float* GSu = (float*)(p.ws + OFF_GS) + ((size_t)((b * 4 + hd) * 2 + dir) * NG33 + gi) * 8192;
    float gwreg[16];
#pragma unroll
    for (int rr = 0; rr < 16; ++rr) gwreg[rr] = p.in[I_GGW][((size_t)(l * 2 + dir) * 16 + rr) * 256 + hd * 64 + dk];
    const float gb = p.in[I_GGB][(l * 2 + dir) * 256 + hd * 64 + dk];
    f32x16 sacc[2];
    if (WITH_OUT) {
#pragma unroll
      for (int dkt = 0; dkt < 2; ++dkt)
#pragma unroll
        for (int i = 0; i < 16; ++i) {
          const float v = GSu[(w * 32 + crow(i, h)) * 64 + dkt * 32 + r];
          sacc[dkt][i] = v;
          sts[(w * 32 + crow(i, h)) * LDT + dkt * 32 + r] = f2bf(v);
        }
    } else {
#pragma unroll
      for (int i = 0; i < 16; ++i) { sacc[0][i] = 0.f; sacc[1][i] = 0.f; }
    }
    float gtot = 0.f;
    for (int cc = 0; cc < 4; ++cc) {
      const int ci = dir ? 3 - cc : cc;
      const int tb = gi * 256 + ci * 64;
      const size_t tokb = (size_t)b * TT + tb;
      {
        const int row = tid >> 2, c4 = (tid & 3) * 4;
        const u32x4 lw = ldg16(LOW + (tokb + row) * 32 + dir * 16 + c4);
        u32x4 vv[4], kq[2], qq[2];
#pragma unroll
        for (int i = 0; i < 4; ++i) {
          const int c = tid + 256 * i, e = c >> 3, k8 = (c & 7) * 8;
          vv[i] = ldg16(GVT + (size_t)e * TT + tb + k8);
        }
#pragma unroll
        for (int i = 0; i < 2; ++i) {
          const int c = tid + 256 * i, rw = c >> 3, k8 = (c & 7) * 8;
          kq[i] = ldg16(GK + (tokb + rw) * 256 + hd * 64 + k8);
          if (WITH_OUT) qq[i] = ldg16(GQ + (tokb + rw) * 256 + hd * 64 + k8);
        }
        *(u32x4*)(lowt + row * 16 + c4) = lw;
#pragma unroll
        for (int i = 0; i < 4; ++i) {
          const int c = tid + 256 * i, e = c >> 3, k8 = (c & 7) * 8;
          *(u32x4*)(vts + e * LDT + k8) = vv[i];
        }
#pragma unroll
        for (int i = 0; i < 2; ++i) {
          const int c = tid + 256 * i, rw = c >> 3, k8 = (c & 7) * 8;
          *(u32x4*)(kin + rw * LDT + k8) = kq[i];
          if (WITH_OUT) *(u32x4*)(qin + rw * LDT + k8) = qq[i];
        }
      }
      __syncthreads();
      float cum = 0.f;
#pragma unroll 2
      for (int ii = 0; ii < 16; ++ii) {
        const int pos = part * 16 + ii, t = dir ? 63 - pos : pos;
        float z = gb;
#pragma unroll
        for (int rr = 0; rr < 16; ++rr) z += lowt[t * 16 + rr] * gwreg[rr];
        cum += (fminf(z, 0.f) - log1pf(__expf(-fabsf(z)))) * (1.f / 16.f);
      }
      tots[part * 64 + dk] = cum;
      __syncthreads();
      float offs = 0.f, total = 0.f;
#pragma unroll
      for (int pp = 0; pp < 4; ++pp) { const float tv = tots[pp * 64 + dk]; total += tv; if (pp < part) offs += tv; }
      if (part == 0) decs[dk] = __expf(total);
      gtot += total;
      float bq = offs;
#pragma unroll 2
      for (int ii = 0; ii < 16; ++ii) {
        const int pos = part * 16 + ii, t = dir ? 63 - pos : pos;
        float z = gb;
#pragma unroll
        for (int rr = 0; rr < 16; ++rr) z += lowt[t * 16 + rr] * gwreg[rr];
        bq += (fminf(z, 0.f) - log1pf(__expf(-fabsf(z)))) * (1.f / 16.f);
        const float kv = bf2f(kin[t * LDT + dk]);
        ket[dk * LDT + t] = f2bf(kv * __expf(total - bq));
        if (WITH_OUT) {
          const float qv = bf2f(qin[t * LDT + dk]);
          qin[t * LDT + dk] = f2bf(qv * __expf(bq));
          kin[t * LDT + dk] = f2bf(kv * __expf(-bq));
        }
      }
      __syncthreads();
      f32x16 oo[2];
      const int it = w & 1, ep = w >> 1;
      if (WITH_OUT) {
        const int ti = w >> 1, tj = w & 1;
        f32x16 aa;
#pragma unroll
        for (int i = 0; i < 16; ++i) aa[i] = 0.f;
#pragma unroll
        for (int s = 0; s < 4; ++s) {
          const s16x8 A = *(const s16x8*)(qin + (ti * 32 + r) * LDT + s * 16 + h * 8);
          const s16x8 Bv = *(const s16x8*)(kin + (tj * 32 + r) * LDT + s * 16 + h * 8);
          aa = MFMA32(A, Bv, aa);
        }
        __syncthreads();
#pragma unroll
        for (int i = 0; i < 16; ++i) {
          const int qi = ti * 32 + crow(i, h), kj = tj * 32 + r;
          const bool keep = dir ? (kj >= qi) : (kj <= qi);
          kin[qi * LDT + kj] = f2bf(keep ? aa[i] : 0.f);
        }
        __syncthreads();
#pragma unroll
        for (int i = 0; i < 16; ++i) { oo[0][i] = 0.f; oo[1][i] = 0.f; }
#pragma unroll
        for (int s = 0; s < 4; ++s) {
          const s16x8 A1 = *(const s16x8*)(kin + (it * 32 + r) * LDT + s * 16 + h * 8);
          const s16x8 A2 = *(const s16x8*)(qin + (it * 32 + r) * LDT + s * 16 + h * 8);
#pragma unroll
          for (int x = 0; x < 2; ++x) {
            const int et = 2 * ep + x;
            const s16x8 B1 = *(const s16x8*)(vts + (et * 32 + r) * LDT + s * 16 + h * 8);
            const s16x8 B2 = *(const s16x8*)(sts + (et * 32 + r) * LDT + s * 16 + h * 8);
            oo[x] = MFMA32(A1, B1, oo[x]);
            oo[x] = MFMA32(A2, B2, oo[x]);
          }
        }
      }
#pragma unroll
      for (int dkt = 0; dkt < 2; ++dkt) {
        const float dv = decs[dkt * 32 + r];
#pragma unroll
        for (int i = 0; i < 16; ++i) sacc[dkt][i] *= dv;
      }
#pragma unroll
      for (int s = 0; s < 4; ++s) {
        const s16x8 A = *(const s16x8*)(vts + (w * 32 + r) * LDT + s * 16 + h * 8);
#pragma unroll
        for (int dkt = 0; dkt < 2; ++dkt) {
          const s16x8 Bv = *(const s16x8*)(ket + (dkt * 32 + r) * LDT + s * 16 + h * 8);
          sacc[dkt] = MFMA32(A, Bv, sacc[dkt]);
        }
      }
      __syncthreads();
      if (WITH_OUT) {
#pragma unroll
        for (int dkt = 0; dkt < 2; ++dkt)
#pragma unroll
          for (int i = 0; i < 16; ++i) sts[(w * 32 + crow(i, h)) * LDT + dkt * 32 + r] = f2bf(sacc[dkt][i]);
#pragma unroll
        for (int x = 0; x < 2; ++x)
#pragma unroll
          for (int i = 0; i < 16; ++i) ost[(it * 32 + crow(i, h)) * CLD + (2 * ep + x) * 32 + r] = oo[x][i];
        __syncthreads();
        const int row = tid >> 2, qd = tid & 3;
        const size_t tok = tokb + row;
        bf16* og = (bf16*)(p.ws + OFF_OGLA) + tok * 512 + hd * 128 + qd * 32;
        const float* os = ost + row * CLD + qd * 32;
        if (dir == 1) {
#pragma unroll
          for (int i = 0; i < 4; ++i) {
            u32x4 uu;
#pragma unroll
            for (int e = 0; e < 4; ++e) uu[e] = pack2(os[i * 8 + 2 * e], os[i * 8 + 2 * e + 1]);
            *(u32x4*)(og + i * 8) = uu;
          }
        } else {
          float ss = 0.f;
#pragma unroll 1
          for (int i = 0; i < 4; ++i) {
            const u32x4 uu = *(const u32x4*)(og + i * 8);
#pragma unroll
            for (int e = 0; e < 4; ++e) {
              const float a0 = os[i * 8 + 2 * e] + bflo(uu[e]), a1 = os[i * 8 + 2 * e + 1] + bfhi(uu[e]);
              ss += a0 * a0 + a1 * a1;
            }
          }
          ss += __shfl_xor(ss, 1, 64);
          ss += __shfl_xor(ss, 2, 64);
          const float rstd = rsqrtf(ss * (1.f / 128.f) + EPSF);
          const float* gn = p.in[I_GON] + l * 128 + qd * 32;
          const bf16* gr = (const bf16*)(p.ws + OFF_GR) + tok * 512 + hd * 128 + qd * 32;
#pragma unroll 1
          for (int i = 0; i < 4; ++i) {
            const u32x4 uo = *(const u32x4*)(og + i * 8);
            const u32x4 ug = *(const u32x4*)(gr + i * 8);
            u32x4 uu;
#pragma unroll
            for (int e = 0; e < 4; ++e) {
              const float v0 = os[i * 8 + 2 * e] + bflo(uo[e]), v1 = os[i * 8 + 2 * e + 1] + bfhi(uo[e]);
              const float a0 = v0 * rstd * gn[i * 8 + 2 * e] * siluf_(bflo(ug[e]));
              const float a1 = v1 * rstd * gn[i * 8 + 2 * e + 1] * siluf_(bfhi(ug[e]));
              uu[e] = pack2(a0, a1);
            }
            *(u32x4*)(og + i * 8) = uu;
          }
        }
        __syncthreads();
      }
    }
    if (!WITH_OUT) {
#pragma unroll
      for (int dkt = 0; dkt < 2; ++dkt)
#pragma unroll
        for (int i = 0; i < 16; ++i) GSu[(w * 32 + crow(i, h)) * 64 + dkt * 32 + r] = sacc[dkt][i];
      if (part == 0) ((float*)(p.ws + OFF_DECG))[((size_t)((b * 4 + hd) * 2 + dir) * NG33 + gi) * 64 + dk] = __expf(gtot);
    }
    __syncthreads();
  }
}

DI void gla_scan_job(const Params& p, int j) {
  const int idx = j * 256 + TIDX;
  const int seq = idx >> 13, el = idx & 8191, dk = el & 63, dir = seq & 1;
  float* GS = (float*)(p.ws + OFF_GS) + (size_t)seq * NG33 * 8192 + el;
  const float* DG = (const float*)(p.ws + OFF_DECG) + (size_t)seq * NG33 * 64 + dk;
  float s = 0.f;
  for (int st0 = 0; st0 < 33; st0 += 11) {
    float kv[11], dc[11];
#pragma unroll
    for (int q = 0; q < 11; ++q) {
      const int st = st0 + q;
      const int g = (dir == 0 || st == 0) ? st : 33 - st;
      kv[q] = GS[(size_t)g * 8192];
      dc[q] = DG[g * 64];
    }
#pragma unroll
    for (int q = 0; q < 11; ++q) {
      const int st = st0 + q;
      const int g = (dir == 0 || st == 0) ? st : 33 - st;
      GS[(size_t)g * 8192] = s;
      s = dc[q] * s + kv[q];
    }
  }
}

DI void s5_end_tile(const Params& p, int j, char* smem) {
  const int nt = j & 1, mt = (j >> 1) % 9, g = j / 18;
  const bf16* SU = (const bf16*)(p.ws + OFF_SU);
  const bf16* F = (const bf16*)(p.ws + OFF_F5) + ((size_t)g * 256 + nt * 128) * 512;
  f32x16 acc[2][2];
  acc_zero(acc);
  gemm_main_dma(acc,
            [&](int r) -> const bf16* {
              const int m = mt * 128 + r;
              if (m >= MS5) return (const bf16*)(p.ws + OFF_ZERO);
              const int b = m / NCH, ch = m - b * NCH;
              return SU + ((size_t)(b * 16 + g) * TT + ch * 32) * 16;
            },
            [&](int r) { return F + (size_t)r * 512; }, 512, smem);
  float* Cs = (float*)smem;
  acc_to_lds(acc, Cs);
  __syncthreads();
  float* EN = (float*)(p.ws + OFF_EN);
  for (int c = TIDX; c < 128 * 32; c += 256) {
    const int row = c >> 5, c4 = (c & 31) * 4, m = mt * 128 + row;
    if (m < MS5) {
      const float* s = Cs + row * CLD + c4;
      f32x4 v = {s[0], s[1], s[2], s[3]};
      *(f32x4*)(EN + ((size_t)m * 16 + g) * 256 + nt * 128 + c4) = v;
    }
  }
  __syncthreads();
}

DI void s5_scan_job(const Params& p, int l, int j, char* smem) {
  float2* ends = (float2*)smem;
  const int dir = j & 1, g = (j >> 1) & 15, b = j >> 5;
  const int pp = TIDX & 63, seg = TIDX >> 6;
  const float2 aL = ((const float2*)(p.ws + OFF_PWR))[((size_t)((l * 2 + dir) * 16 + g) * 33 + 32) * 64 + pp];
  const float* EN = (const float*)(p.ws + OFF_EN);
  bf16* SB = (bf16*)(p.ws + OFF_SB);
  float sr = 0.f, si = 0.f;
  for (int q0 = 0; q0 < 66; q0 += 11) {
    float er[11], ei[11];
#pragma unroll
    for (int q = 0; q < 11; ++q) {
      const int pos = seg * 66 + q0 + q;
      const int ch = dir ? (pos < 8 ? 7 - pos : 271 - pos) : pos;
      const float* e = EN + ((size_t)(b * NCH + ch) * 16 + g) * 256 + dir * 128 + pp;
      er[q] = e[0]; ei[q] = e[64];
    }
#pragma unroll
    for (int q = 0; q < 11; ++q) {
      const float nr = aL.x * sr - aL.y * si + er[q], ni = aL.x * si + aL.y * sr + ei[q];
      sr = nr; si = ni;
    }
  }
  ends[seg * 64 + pp] = make_float2(sr, si);
  float pr = 1.f, pi = 0.f;
  for (int q = 0; q < 66; ++q) { const float nr = pr * aL.x - pi * aL.y, ni = pr * aL.y + pi * aL.x; pr = nr; pi = ni; }
  __syncthreads();
  sr = 0.f; si = 0.f;
  for (int k = 0; k < seg; ++k) {
    const float2 e = ends[k * 64 + pp];
    const float nr = pr * sr - pi * si + e.x, ni = pr * si + pi * sr + e.y;
    sr = nr; si = ni;
  }
  for (int q0 = 0; q0 < 66; q0 += 11) {
    float er[11], ei[11];
#pragma unroll
    for (int q = 0; q < 11; ++q) {
      const int pos = seg * 66 + q0 + q;
      const int ch = dir ? (pos < 8 ? 7 - pos : 271 - pos) : pos;
      const float* e = EN + ((size_t)(b * NCH + ch) * 16 + g) * 256 + dir * 128 + pp;
      er[q] = e[0]; ei[q] = e[64];
    }
#pragma unroll
    for (int q = 0; q < 11; ++q) {
      const int pos = seg * 66 + q0 + q;
      const int ch = dir ? (pos < 8 ? 7 - pos : 271 - pos) : pos;
      bf16* sb = SB + ((size_t)(b * NCH + ch) * 16 + g) * 256 + dir * 128 + pp;
      sb[0] = f2bf(sr); sb[64] = f2bf(si);
      const float nr = aL.x * sr - aL.y * si + er[q], ni = aL.x * si + aL.y * sr + ei[q];
      sr = nr; si = ni;
    }
  }
  __syncthreads();
}

DI float gelu_tanh(float x) {
  const float u = 0.7978845608028654f * (x + 0.044715f * x * x * x);
  return 0.5f * x * (1.f + tanhf(u));
}

DI void s5_out_tile(const Params& p, int j, char* smem) {
  const int nt = j & 3, mt = (j >> 2) % 9, g = j / 36;
  const bf16* SU = (const bf16*)(p.ws + OFF_SU);
  const bf16* SB = (const bf16*)(p.ws + OFF_SB);
  const bf16* Tm = (const bf16*)(p.ws + OFF_T5) + ((size_t)g * 512 + nt * 128) * 512;
  const bf16* Em = (const bf16*)(p.ws + OFF_E5) + ((size_t)g * 512 + nt * 128) * 256;
  f32x16 acc[2][2];
  acc_zero(acc);
  gemm_main_dma(acc,
            [&](int r) -> const bf16* {
              const int m = mt * 128 + r;
              if (m >= MS5) return (const bf16*)(p.ws + OFF_ZERO);
              const int b = m / NCH, ch = m - b * NCH;
              return SU + ((size_t)(b * 16 + g) * TT + ch * 32) * 16;
            },
            [&](int r) { return Tm + (size_t)r * 512; }, 512, smem);
  gemm_main_dma(acc,
            [&](int r) -> const bf16* {
              const int m = mt * 128 + r;
              if (m >= MS5) return (const bf16*)(p.ws + OFF_ZERO);
              return SB + ((size_t)m * 16 + g) * 256;
            },
            [&](int r) { return Em + (size_t)r * 256; }, 256, smem);
  float* Cs = (float*)smem;
  acc_to_lds(acc, Cs);
  __syncthreads();
  bf16* Y5 = (bf16*)(p.ws + OFF_Y5);
  for (int c = TIDX; c < 2048; c += 256) {
    const int row = c >> 4, c8 = c & 15, m = mt * 128 + row;
    if (m < MS5) {
      const int b = m / NCH, ch = m - b * NCH;
      const int n = nt * 128 + c8 * 8, i = n >> 4, hh = n & 15;
      const float* s = Cs + row * CLD + c8 * 8;
      u32x4 u;
#pragma unroll
      for (int e = 0; e < 4; ++e) u[e] = pack2(gelu_tanh(s[2 * e]), gelu_tanh(s[2 * e + 1]));
      *(u32x4*)(Y5 + ((size_t)b * TT + ch * 32 + i) * 256 + g * 16 + hh) = u;
    }
  }
  __syncthreads();
}

DI void glu_tile(const Params& p, int l, int j, char* smem) {
  const int nt = j & 1, mt = j >> 1;
  const bf16* Y5 = (const bf16*)(p.ws + OFF_Y5) + (size_t)mt * 128 * 256;
  const bf16* W = wl(p, l, WL_GLU) + (size_t)nt * 128 * 256;
  f32x16 acc[2][2];
  acc_zero(acc);
  gemm_main_dma(acc, [&](int r) { return Y5 + (size_t)r * 256; }, [&](int r) { return W + (size_t)r * 256; }, 256, smem);
  float* Cs = (float*)smem;
  acc_to_lds(acc, Cs);
  __syncthreads();
  const float* gb = p.in[I_GLUB] + l * 256 + nt * 128;
  bf16* O = (bf16*)(p.ws + OFF_OS5) + (size_t)mt * 128 * 256 + nt * 128;
  for (int c = TIDX; c < 2048; c += 256) {
    const int row = c >> 4, cc = (c & 15) * 8;
    const float* s = Cs + row * CLD + cc;
    const u32x4 yu = *(const u32x4*)(Y5 + (size_t)row * 256 + nt * 128 + cc);
    u32x4 u;
#pragma unroll
    for (int e = 0; e < 4; ++e) {
      const float y0 = bflo(yu[e]), y1 = bfhi(yu[e]);
      u[e] = pack2(y0 * sigmoidf_(s[2 * e] + gb[cc + 2 * e]), y1 * sigmoidf_(s[2 * e + 1] + gb[cc + 2 * e + 1]));
    }
    *(u32x4*)(O + (size_t)row * 256 + cc) = u;
  }
  __syncthreads();
}

struct DmaStream { const bf16* ap[4]; const bf16* bp[4]; };
template <class FA, class FB>
DI void stream_setup(DmaStream& st, FA fa, FB fb) {
  const int tid = TIDX, lane = tid & 63, w = tid >> 6;
#pragma unroll
  for (int i = 0; i < 4; ++i) {
    const int row = w * 32 + i * 8 + (lane >> 3);
    const int c = (lane & 7) ^ ((row >> 1) & 7);
    st.ap[i] = fa(row) + c * 8;
    st.bp[i] = fb(row) + c * 8;
  }
}
DI void stream_issue(const DmaStream& st, int buf, int kt, char* smem) {
  const int tid = TIDX, lane = tid & 63, w = tid >> 6;
  const int ldst = (w * 256 + lane) * 16;
  const int k0 = kt * 64;
#pragma unroll
  for (int i = 0; i < 4; ++i) {
    __builtin_amdgcn_global_load_lds((const unsigned*)(st.ap[i] + k0), (unsigned*)(smem + buf * 16384 + ldst + i * 1024), 16, 0, 0);
    __builtin_amdgcn_global_load_lds((const unsigned*)(st.bp[i] + k0), (unsigned*)(smem + 32768 + buf * 16384 + ldst + i * 1024), 16, 0, 0);
  }
}
DI void stream_run(f32x16 (&acc)[2][2], const DmaStream& cur, int K, char* smem, const DmaStream& next, bool has_next) {
  const int tid = TIDX, lane = tid & 63, w = tid >> 6, wm = w >> 1, wn = w & 1;
  const int r = lane & 31, h = lane >> 5;
  const int xr = (r >> 1) & 7;
  const int arow = (wm * 64 + r) * 128, brow = (wn * 64 + r) * 128;
  const int nk = K / 64;
  for (int kt = 0; kt < nk; ++kt) {
    const int buf = kt & 1;
    if (kt + 1 < nk) stream_issue(cur, buf ^ 1, kt + 1, smem);
    else if (has_next) stream_issue(next, buf ^ 1, 0, smem);
    const char* Ab = smem + buf * 16384 + arow;
    const char* Bb = smem + 32768 + buf * 16384 + brow;
#pragma unroll
    for (int s2 = 0; s2 < 4; ++s2) {
      const int co = ((2 * s2 + h) ^ xr) * 16;
      s16x8 a0 = *(const s16x8*)(Ab + co);
      s16x8 a1 = *(const s16x8*)(Ab + 32 * 128 + co);
      s16x8 b0 = *(const s16x8*)(Bb + co);
      s16x8 b1 = *(const s16x8*)(Bb + 32 * 128 + co);
      acc[0][0] = MFMA32(a0, b0, acc[0][0]);
      acc[0][1] = MFMA32(a0, b1, acc[0][1]);
      acc[1][0] = MFMA32(a1, b0, acc[1][0]);
      acc[1][1] = MFMA32(a1, b1, acc[1][1]);
    }
    asm volatile("s_waitcnt vmcnt(0)" ::: "memory");
    __syncthreads();
  }
}

DI void merge_tile(const Params& p, int l, int j, char* smem) {
  const int nt = j & 7, mt = j >> 3;
  const bf16* H = (const bf16*)(p.ws + OFF_H) + (size_t)mt * 128 * DM;
  unsigned am[2][2][8];
#pragma unroll
  for (int a = 0; a < 2; ++a)
#pragma unroll
    for (int bq = 0; bq < 2; ++bq)
#pragma unroll
      for (int i = 0; i < 8; ++i) am[a][bq][i] = 0u;
  DmaStream sb, sg;
  {
    const bf16* A0 = (const bf16*)(p.ws + OFF_OATT) + (size_t)mt * 128 * 256;
    const bf16* W0 = wl(p, l, WL_BRA) + (size_t)nt * 128 * 256;
    stream_setup(sb, [&](int r) { return A0 + (size_t)r * 256; }, [&](int r) { return W0 + (size_t)r * 256; });
    stream_issue(sb, 0, 0, smem);
    asm volatile("s_waitcnt vmcnt(0)" ::: "memory");
    __syncthreads();
  }
#pragma unroll 1
  for (int x = 0; x < 3; ++x) {
    const int K = (x == 1) ? 512 : 256;
    const bf16* Wg = wl(p, l, WL_WIN) + ((size_t)2432 + x * 1024 + nt * 128) * DM;
    stream_setup(sg, [&](int r) { return H + (size_t)r * DM; }, [&](int r) { return Wg + (size_t)r * DM; });
    unsigned br[2][2][8];
    {
      f32x16 acc[2][2];
      acc_zero(acc);
      stream_run(acc, sb, K, smem, sg, true);
#pragma unroll
      for (int a = 0; a < 2; ++a)
#pragma unroll
        for (int bq = 0; bq < 2; ++bq)
#pragma unroll
          for (int i = 0; i < 8; ++i) br[a][bq][i] = pack2(acc[a][bq][2 * i], acc[a][bq][2 * i + 1]);
    }
    if (x < 2) {
      const bf16* A1; const bf16* W1; int K1;
      if (x == 0) { A1 = (const bf16*)(p.ws + OFF_OGLA) + (size_t)mt * 128 * 512; W1 = wl(p, l, WL_BRG) + (size_t)nt * 128 * 512; K1 = 512; }
      else { A1 = (const bf16*)(p.ws + OFF_OS5) + (size_t)mt * 128 * 256; W1 = wl(p, l, WL_BRS) + (size_t)nt * 128 * 256; K1 = 256; }
      stream_setup(sb, [&](int r) { return A1 + (size_t)r * K1; }, [&](int r) { return W1 + (size_t)r * K1; });
    }
    f32x16 acc[2][2];
    acc_zero(acc);
    stream_run(acc, sg, DM, smem, sb, x < 2);
#pragma unroll
    for (int a = 0; a < 2; ++a)
#pragma unroll
      for (int bq = 0; bq < 2; ++bq)
#pragma unroll
        for (int i = 0; i < 8; ++i) {
          const float v0 = bflo(am[a][bq][i]) + sigmoidf_(acc[a][bq][2 * i]) * bflo(br[a][bq][i]);
          const float v1 = bfhi(am[a][bq][i]) + sigmoidf_(acc[a][bq][2 * i + 1]) * bfhi(br[a][bq][i]);
          am[a][bq][i] = pack2(v0, v1);
        }
  }
  f32x16 accm[2][2];
#pragma unroll
  for (int a = 0; a < 2; ++a)
#pragma unroll
    for (int bq = 0; bq < 2; ++bq)
#pragma unroll
      for (int i = 0; i < 8; ++i) { accm[a][bq][2 * i] = bflo(am[a][bq][i]); accm[a][bq][2 * i + 1] = bfhi(am[a][bq][i]); }
  float* Cs = (float*)smem;
  acc_to_lds(accm, Cs);
  __syncthreads();
  store_tile_bf16(Cs, (bf16*)(p.ws + OFF_MG) + (size_t)mt * 128 * DM + nt * 128, DM, 128, 1.f);
  __syncthreads();
}

DI void plain_tile(const bf16* A, int K, const bf16* W, bf16* dst, int ldd, char* smem) {
  f32x16 acc[2][2];
  acc_zero(acc);
  gemm_main_dma(acc, [&](int r) { return A + (size_t)r * K; }, [&](int r) { return W + (size_t)r * K; }, K, smem);
  float* Cs = (float*)smem;
  acc_to_lds(acc, Cs);
  __syncthreads();
  store_tile_bf16(Cs, dst, ldd, 128, 1.f);
  __syncthreads();
}

DI void store_half_bf16(const float* Cs, bf16* dst, size_t ld, int hf) {
  for (int c = TIDX; c < 1024; c += 256) {
    const int row = c >> 3, seg = (c >> 2) & 1, c8 = (c & 3) * 8;
    const int col = seg * 64 + hf * 32 + c8;
    const float* s = Cs + row * CLD + col;
    u32x4 v;
    v[0] = pack2(s[0], s[1]); v[1] = pack2(s[2], s[3]); v[2] = pack2(s[4], s[5]); v[3] = pack2(s[6], s[7]);
    *(u32x4*)(dst + (size_t)row * ld + col) = v;
  }
}
DI void plain_half(const bf16* A, int K, const bf16* W, bf16* dst, int ldd, int hf, char* smem) {
  f32x16 acc[2];
#pragma unroll
  for (int i = 0; i < 16; ++i) { acc[0][i] = 0.f; acc[1][i] = 0.f; }
  gemm_main_dma_half(acc, A, K, W, K, K, hf, smem);
  float* Cs = (float*)smem;
  {
    const int lane = TIDX & 63, w = TIDX >> 6, wm = w >> 1, wn = w & 1, r = lane & 31, h = lane >> 5;
#pragma unroll
    for (int tm = 0; tm < 2; ++tm)
#pragma unroll
      for (int i = 0; i < 16; ++i) Cs[(wm * 64 + tm * 32 + crow(i, h)) * CLD + wn * 64 + hf * 32 + r] = acc[tm][i];
  }
  __syncthreads();
  store_half_bf16(Cs, dst, ldd, hf);
  __syncthreads();
}

DI void merge_half(const Params& p, int l, int mt, int nt, int hf, char* smem) {
  const bf16* H = (const bf16*)(p.ws + OFF_H) + (size_t)mt * 128 * DM;
  unsigned am[2][8];
#pragma unroll
  for (int a = 0; a < 2; ++a)
#pragma unroll
    for (int i = 0; i < 8; ++i) am[a][i] = 0u;
#pragma unroll 1
  for (int x = 0; x < 3; ++x) {
    const bf16* A; const bf16* Wb; int K;
    if (x == 0) { A = (const bf16*)(p.ws + OFF_OATT) + (size_t)mt * 128 * 256; Wb = wl(p, l, WL_BRA) + (size_t)nt * 128 * 256; K = 256; }
    else if (x == 1) { A = (const bf16*)(p.ws + OFF_OGLA) + (size_t)mt * 128 * 512; Wb = wl(p, l, WL_BRG) + (size_t)nt * 128 * 512; K = 512; }
    else { A = (const bf16*)(p.ws + OFF_OS5) + (size_t)mt * 128 * 256; Wb = wl(p, l, WL_BRS) + (size_t)nt * 128 * 256; K = 256; }
    unsigned br[2][8];
    {
      f32x16 a2[2];
#pragma unroll
      for (int i = 0; i < 16; ++i) { a2[0][i] = 0.f; a2[1][i] = 0.f; }
      gemm_main_dma_half(a2, A, K, Wb, K, K, hf, smem);
#pragma unroll
      for (int a = 0; a < 2; ++a)
#pragma unroll
        for (int i = 0; i < 8; ++i) br[a][i] = pack2(a2[a][2 * i], a2[a][2 * i + 1]);
    }
    const bf16* Wg = wl(p, l, WL_WIN) + ((size_t)2432 + x * 1024 + nt * 128) * DM;
    f32x16 g2[2];
#pragma unroll
    for (int i = 0; i < 16; ++i) { g2[0][i] = 0.f; g2[1][i] = 0.f; }
    gemm_main_dma_half(g2, H, DM, Wg, DM, DM, hf, smem);
#pragma unroll
    for (int a = 0; a < 2; ++a)
#pragma unroll
      for (int i = 0; i < 8; ++i) {
        const float v0 = bflo(am[a][i]) + sigmoidf_(g2[a][2 * i]) * bflo(br[a][i]);
        const float v1 = bfhi(am[a][i]) + sigmoidf_(g2[a][2 * i + 1]) * bfhi(br[a][i]);
        am[a][i] = pack2(v0, v1);
      }
  }
  float* Cs = (float*)smem;
  {
    const int lane = TIDX & 63, w = TIDX >> 6, wm = w >> 1, wn = w & 1, r = lane & 31, h = lane >> 5;
#pragma unroll
    for (int tm = 0; tm < 2; ++tm)
#pragma unroll
      for (int i = 0; i < 8; ++i) {
        Cs[(wm * 64 + tm * 32 + crow(2 * i, h)) * CLD + wn * 64 + hf * 32 + r] = bflo(am[tm][i]);
        Cs[(wm * 64 + tm * 32 + crow(2 * i + 1, h)) * CLD + wn * 64 + hf * 32 + r] = bfhi(am[tm][i]);
      }
  }
  __syncthreads();
  store_half_bf16(Cs, (bf16*)(p.ws + OFF_MG) + (size_t)mt * 128 * DM + nt * 128, DM, hf);
  __syncthreads();
}

DI void plain_wide(const bf16* A, int K, const bf16* W, bf16* dst, int ldd, char* smem) {
  f32x16 acc[2][4];
  accw_zero(acc);
  gemm_wide(acc, [&](int r) { return A + (size_t)r * K; }, [&](int r) { return W + (size_t)r * K; }, K, smem);
  float* Cs = (float*)smem;
  accw_to_lds<0>(acc, Cs);
  __syncthreads();
  store_tile_bf16(Cs, dst, ldd, 128, 1.f);
  __syncthreads();
  accw_to_lds<1>(acc, Cs);
  __syncthreads();
  store_tile_bf16(Cs, dst + 128, ldd, 128, 1.f);
  __syncthreads();
}

DI void up_epi(const Params& p, int l, int jn, int seqbase, int len, int pos0, char* smem) {
  float* Cs = (float*)smem;
  const float* cw = p.in[I_CW] + (size_t)l * 3 * 2 * DFF;
  const float* cb = p.in[I_CB] + (size_t)l * 2 * DFF;
  bf16* G = (bf16*)(p.ws + OFF_G);
  const int tid = TIDX;
  const int c = (tid & 31) * 2;
  float wa[2][3], wv[2][3], ba[2], bv[2];
#pragma unroll
  for (int e = 0; e < 2; ++e) {
    const int ca = jn * 64 + c + e, cv = DFF + ca;
#pragma unroll
    for (int k = 0; k < 3; ++k) { wa[e][k] = cw[k * 2 * DFF + ca]; wv[e][k] = cw[k * 2 * DFF + cv]; }
    ba[e] = cb[ca]; bv[e] = cb[cv];
  }
#pragma unroll 4
  for (int rr = 1 + (tid >> 5); rr < 127; rr += 8) {
    const int pos = pos0 + rr;
    if (pos < len) {
      float gv[2];
#pragma unroll
      for (int e = 0; e < 2; ++e) {
        const float a = wa[e][0] * Cs[(rr - 1) * CLD + c + e] + wa[e][1] * Cs[rr * CLD + c + e] + wa[e][2] * Cs[(rr + 1) * CLD + c + e] + ba[e];
        const float v = wv[e][0] * Cs[(rr - 1) * CLD + 64 + c + e] + wv[e][1] * Cs[rr * CLD + 64 + c + e] +
                        wv[e][2] * Cs[(rr + 1) * CLD + 64 + c + e] + bv[e];
        gv[e] = siluf_(a) * v;
      }
      *(unsigned*)(G + (size_t)(seqbase + pos) * DFF + jn * 64 + c) = pack2(gv[0], gv[1]);
    }
  }
  __syncthreads();
}

DI void up_wide(const Params& p, int l, int mtile, int jp, char* smem) {
  const int b = mtile / 69, rr0 = mtile % 69;
  int seqbase, len, ti;
  if (rr0 < 3) { seqbase = b * TT; len = CTXL; ti = rr0; }
  else { seqbase = b * TT + CTXL; len = SEQ; ti = rr0 - 3; }
  const int pos0 = ti * 126 - 1;
  const bf16* H = (const bf16*)(p.ws + OFF_H);
  const bf16* W = wl(p, l, WL_UP) + (size_t)jp * 256 * DM;
  f32x16 acc[2][4];
  accw_zero(acc);
  gemm_wide(acc,
            [&](int r) -> const bf16* {
              const int pos = pos0 + r;
              return (pos >= 0 && pos < len) ? H + (size_t)(seqbase + pos) * DM : (const bf16*)(p.ws + OFF_ZERO);
            },
            [&](int r) { return W + (size_t)r * DM; }, DM, smem);
  float* Cs = (float*)smem;
  accw_to_lds<0>(acc, Cs);
  __syncthreads();
  up_epi(p, l, jp * 2, seqbase, len, pos0, smem);
  accw_to_lds<1>(acc, Cs);
  __syncthreads();
  up_epi(p, l, jp * 2 + 1, seqbase, len, pos0, smem);
}

DI bool gemm_job(int bid, int G, int it, int MT, int NTL, int& mt, int& nt, int CW = 8) {
  const int x = bid & 7, q = bid >> 3, Q = G >> 3;
  const int m0 = (x * MT) >> 3, m1 = ((x + 1) * MT) >> 3, Mx = m1 - m0;
  const int jl = q + Q * it;
  if (jl >= Mx * NTL) return false;
  const int full = Mx * CW;
  const int c = jl / full, rem = jl - c * full;
  const int wc = min(CW, NTL - CW * c);
  const int mi = rem / wc;
  mt = m0 + mi;
  nt = CW * c + (rem - mi * wc);
  return true;
}

DI int lat_mt(int i) { return (i >> 6) * 66 + 2 + (i & 63); }
DI int lat_up(int i) { return (i / 66) * 69 + 3 + (i % 66); }

enum { PH_PREP = 0, PH_ROW0, PH_PROJ, PH_MIX1, PH_SCAN, PH_MIX2, PH_GLU, PH_MERGE, PH_WOUT, PH_ROW1, PH_UP, PH_DOWN, PH_ROW2 };
constexpr int N_PHASES = 2 + 11 * NL;

DI void run_phase(const Params& p, int ph, int l, char* smem) {
  const int bid = blockIdx.x;
#ifdef HALFMASK
  const int G = ((HALFMASK >> ph) & 1) ? 256 : gridDim.x;
  if (bid >= G) return;
#else
  const int G = gridDim.x;
#endif
#ifdef PHMASK
  if (!((PHMASK >> ph) & 1)) return;
#endif
  switch (ph) {
    case PH_PREP:
      if (bid < 8) { for (int i = TIDX; i < 512; i += 256) ((u32x4*)(p.ws + OFF_ZERO))[i] = u32x4{0u, 0u, 0u, 0u}; }
      if (bid < 96) prep_mod_job(p, bid, smem);
      else if (bid < 128) prep_s5_job(p, bid - 96);
      else { for (int j = bid - 128; j < 4016; j += G - 128) prep_wt_job(p, j, smem); }
      break;
    case PH_ROW0:
      row_phase<0>(p, 0, bid, G);
      ktab_phase(p, bid, G, 0, 1);
      break;
    case PH_PROJ:
#ifdef EXP_A
      if (bid < 256) { int mt, nt; for (int it = 0; gemm_job(bid, 256, it, 264, 10, mt, nt, 4); ++it) proj_wide(p, l, mt, nt, smem); }
      else {
        s5mat_phase(p, l, bid - 256, G - 256);
        if (l + 1 < NL) ktab_phase(p, bid - 256, G - 256, l + 1, l + 2);
        if (l + 1 < NL) { for (int jj = (l + 1) * 4016 + (bid - 256); jj < (l + 2) * 4016; jj += G - 256) prep_wt_job(p, jj, smem); }
      }
#elif defined(EXP_C)
      if (bid < 256) for (int j = bid; j < 264 * 19; j += 256) { if ((EXP_C >> (j % 19)) & 1) proj_tile(p, l, j / 19, j % 19, smem); }
      for (int j = bid; j < 264 * 19; j += G) { if (!((EXP_C >> (j % 19)) & 1)) proj_tile(p, l, j / 19, j % 19, smem); }
      s5mat_phase(p, l, bid, G);
#elif defined(EXP_B)
      for (int j = bid; j < 264 * 19; j += G) proj_tile(p, l, j / 19, j % 19, smem);
      if (bid < 256) s5mat_phase(p, l, bid, 256);
#else
      for (int j = bid; j < 264 * 19; j += G) proj_tile(p, l, j / 19, j % 19, smem);
      s5mat_phase(p, l, bid, G);
#endif
      break;
    case PH_MIX1:
      for (int j = bid; j < (l == NL - 1 ? 1024 : 1056); j += G) attn_unit(p, j, smem);
      for (int j = bid; j < 1024; j += G) {
        const int v = j >> 5, k = j & 31;
        const int gi = (v & 1) ? (k == 0 ? 0 : k + 1) : k;
        gla_unit<false>(p, l, v * NG33 + gi, smem);
      }
      for (int j = G - 1 - bid; j < 288; j += G) s5_end_tile(p, j, smem);
      break;
    case PH_SCAN:
      if (bid >= G - 128) s5_scan_job(p, l, bid - (G - 128), smem);
      else { for (int j = bid; j < 1024; j += G - 128) gla_scan_job(p, j); }
      break;
    case PH_MIX2:
      if (l == NL - 1) {
        for (int j = bid; j < 512 + 576; j += G) {
          if (j < 512) gla_unit<true>(p, l, (j >> 5) * NG33 + 1 + (j & 31), smem);
          else s5_out_tile(p, j - 512, smem);
        }
      } else {
        for (int j = bid; j < 528 + 576; j += G) {
          if (j < 528) gla_unit<true>(p, l, j, smem);
          else s5_out_tile(p, j - 528, smem);
        }
      }
      break;
    case PH_GLU:
      { const bool last = (l == NL - 1); int mt, nt;
        for (int it = 0; gemm_job(bid, G, it, last ? 256 : 264, 2, mt, nt); ++it) glu_tile(p, l, (last ? lat_mt(mt) : mt) * 2 + nt, smem); }
      break;
    case PH_MERGE:
      { int mt, nt;
        for (int it = 0; gemm_job(bid, G, it, 256, 8, mt, nt); ++it) merge_tile(p, l, lat_mt(mt) * 8 + nt, smem); }
      if (l != NL - 1 && bid < 128) {
        const int c = bid >> 1, hf = bid & 1;
        merge_half(p, l, (c >> 4) * 66 + ((c >> 3) & 1), c & 7, hf, smem);
      }
      break;
    case PH_WOUT:
      for (int it = 0;; ++it) {
        int mt, nt;
        if (!gemm_job(bid, G, it, 256, 8, mt, nt)) break;
        mt = lat_mt(mt);
        plain_tile((const bf16*)(p.ws + OFF_MG) + (size_t)mt * 128 * DM, DM, wl(p, l, WL_WOUT) + (size_t)nt * 128 * DM,
                   (bf16*)(p.ws + OFF_H) + (size_t)mt * 128 * DM + nt * 128, DM, smem);
      }
      if (l != NL - 1 && bid < 128) {
        const int c = bid >> 1, hf = bid & 1;
        const int mt = (c >> 4) * 66 + ((c >> 3) & 1), nt = c & 7;
        plain_half((const bf16*)(p.ws + OFF_MG) + (size_t)mt * 128 * DM, DM, wl(p, l, WL_WOUT) + (size_t)nt * 128 * DM,
                   (bf16*)(p.ws + OFF_H) + (size_t)mt * 128 * DM + nt * 128, DM, hf, smem);
      }
      break;
    case PH_ROW1: row_phase<1>(p, l, bid, G); break;
    case PH_UP:
      { const bool last = (l == NL - 1); int mt, nt;
        for (int it = 0; gemm_job(bid, G, it, last ? 264 : 276, 22, mt, nt, 4); ++it) up_wide(p, l, last ? lat_up(mt) : mt, nt, smem); }
      break;
    case PH_DOWN:
      for (int it = 0;; ++it) {
        int mt, nt;
        if (!gemm_job(bid, G, it, 256, 4, mt, nt, 4)) break;
        mt = lat_mt(mt);
        plain_wide((const bf16*)(p.ws + OFF_G) + (size_t)mt * 128 * DFF, DFF, wl(p, l, WL_DOWN) + (size_t)nt * 256 * DFF,
                   (bf16*)(p.ws + OFF_H) + (size_t)mt * 128 * DM + nt * 256, DM, smem);
      }
      if (l != NL - 1 && bid < 128) {
        const int c = bid >> 1, hf = bid & 1;
        const int mt = (c >> 4) * 66 + ((c >> 3) & 1), nt = c & 7;
        plain_half((const bf16*)(p.ws + OFF_G) + (size_t)mt * 128 * DFF, DFF, wl(p, l, WL_DOWN) + (size_t)nt * 128 * DFF,
                   (bf16*)(p.ws + OFF_H) + (size_t)mt * 128 * DM + nt * 128, DM, hf, smem);
      }
      break;
    case PH_ROW2: row_phase<2>(p, l, bid, G); break;
  }
}

#define XB_TMO      128
#define XB_XCNT(j)  (256  + 64 * (j))
#define XB_XSUB(j)  (1280 + 64 * (j))
#define XB_XGEN(j)  (2304 + 64 * (j))
#define XB_TOP      3328
#define XB_TOPGEN   3392
#define XCD_BAR_WORDS 3456
#define XB_SPIN_CAP (1u << 18)
#define LAS __attribute__((address_space(3)))

__device__ __forceinline__ unsigned xb_ld(unsigned* p)              { return __hip_atomic_load(p, __ATOMIC_RELAXED, __HIP_MEMORY_SCOPE_AGENT); }
__device__ __forceinline__ unsigned xb_add(unsigned* p, unsigned v) { return __hip_atomic_fetch_add(p, v, __ATOMIC_RELAXED, __HIP_MEMORY_SCOPE_AGENT); }
__device__ __forceinline__ unsigned xb_xcc_id() { return (unsigned)__builtin_amdgcn_s_getreg((3 << 11) | 20) & 0xFu; }
#define XB_SPIN(cond, bar) do { unsigned _sp = 0; while (cond) { __builtin_amdgcn_s_sleep(1); \
    if ((++_sp & 255u) == 0u) { if (xb_ld(&(bar)[XB_TMO])) break; if (_sp > XB_SPIN_CAP) { atomicAdd(&(bar)[XB_TMO], 1u); break; } } } } while (0)

struct XcdBarrier {
    unsigned* bar; unsigned x;
    volatile LAS unsigned* st;
};

__device__ __forceinline__ XcdBarrier xcd_barrier_post(unsigned* bar, volatile LAS unsigned* st) {
    XcdBarrier b; b.bar = bar; b.x = xb_xcc_id(); b.st = st;
    if (threadIdx.x == 0) (void)xb_add(&bar[XB_XCNT(b.x)], 1u);
    return b;
}
__device__ __forceinline__ void xcd_barrier_complete(unsigned* bar, unsigned x, unsigned& nloc, unsigned& nx) {
    const unsigned G = gridDim.x * gridDim.y * gridDim.z;
    unsigned sum, cnt, mine, sp = 0u;
    for (;;) {
        sum = 0u; cnt = 0u; mine = 0u;
#pragma unroll
        for (unsigned j = 0; j < 16; ++j) { const unsigned c = xb_ld(&bar[XB_XCNT(j)]); sum += c; cnt += (c > 0u) ? 1u : 0u; mine = (j == x) ? c : mine; }
        if (sum == G) break;
        __builtin_amdgcn_s_sleep(1);
        if ((++sp & 255u) == 0u) { if (xb_ld(&bar[XB_TMO])) break; if (sp > XB_SPIN_CAP) { atomicAdd(&bar[XB_TMO], 1u); break; } }
    }
    nloc = mine > 0u ? mine : 1u; nx = cnt > 0u ? cnt : 1u;
}

__device__ __forceinline__ void xcd_barrier(const XcdBarrier& b) {
    asm volatile("s_waitcnt vmcnt(0)" ::: "memory");
    __syncthreads();
    if (threadIdx.x == 0) {
        unsigned* bar = b.bar;
        __builtin_amdgcn_s_waitcnt(0);
        unsigned nloc = b.st[0], nx = b.st[1];
        if (nloc == 0u) { xcd_barrier_complete(bar, b.x, nloc, nx); b.st[0] = nloc; b.st[1] = nx; }
        const unsigned old = xb_add(&bar[XB_XSUB(b.x)], 1u);
        const unsigned gen = old / nloc;
        if (old + 1u == (gen + 1u) * nloc) {
            __builtin_amdgcn_fence(__ATOMIC_RELEASE, "agent");
            asm volatile("s_waitcnt vmcnt(0)" ::: "memory");
            const unsigned og = xb_add(&bar[XB_TOP], 1u);
            const unsigned tg = og / nx;
            if (og + 1u == (tg + 1u) * nx) xb_add(&bar[XB_TOPGEN], 1u);
            else XB_SPIN(xb_ld(&bar[XB_TOPGEN]) == tg, bar);
            __builtin_amdgcn_fence(__ATOMIC_ACQUIRE, "agent");
            xb_add(&bar[XB_XGEN(b.x)], 1u);
            asm volatile("s_waitcnt vmcnt(0)" ::: "memory");
        } else {
            XB_SPIN(xb_ld(&bar[XB_XGEN(b.x)]) == gen, bar);
            __builtin_amdgcn_fence(__ATOMIC_ACQUIRE, "agent");
            asm volatile("s_waitcnt vmcnt(0)" ::: "memory");
        }
    }
    __syncthreads();
}


DI void grid_barrier(unsigned* bar, unsigned& gen) {
  asm volatile("s_waitcnt vmcnt(0)" ::: "memory");
  __syncthreads();
  gen += 1;
  if (threadIdx.x == 0) {
    __builtin_amdgcn_fence(__ATOMIC_RELEASE, "agent");
    asm volatile("s_waitcnt vmcnt(0)" ::: "memory");
    const unsigned target = gen * gridDim.x;
    __hip_atomic_fetch_add(bar, 1u, __ATOMIC_RELAXED, __HIP_MEMORY_SCOPE_AGENT);
    while (__hip_atomic_load(bar, __ATOMIC_RELAXED, __HIP_MEMORY_SCOPE_AGENT) < target) __builtin_amdgcn_s_sleep(2);
  }
  __syncthreads();
  __builtin_amdgcn_fence(__ATOMIC_ACQUIRE, "agent");
  asm volatile("s_waitcnt vmcnt(0)" ::: "memory");
}

__global__ void __launch_bounds__(256, 2) hybrid_fwd(Params p, int ph_lo, int ph_hi) {
  extern __shared__ __attribute__((aligned(16))) char smem[];
  unsigned* bar = (unsigned*)(p.ws + OFF_BAR);
  unsigned gen = 0;
  __shared__ uint4 xb_words;
  if (threadIdx.x == 0) xb_words = make_uint4(0u, 0u, 0u, 0u);
  __syncthreads();
  XcdBarrier xb = xcd_barrier_post(bar + 64, (volatile LAS unsigned*)&xb_words);
  if (ph_lo < 0) cg::this_grid().sync();
  int i = 0;
#define STEP(PH, L)                                      \
  {                                                      \
    if (i >= ph_lo && i < ph_hi) {                       \
      Params q;                                          \
      q.ws = p.ws; q.out = p.out;                        \
      asm volatile("" : "+s"(q.ws), "+s"(q.out));        \
      _Pragma("unroll") for (int k = 0; k < 34; ++k) { q.in[k] = p.in[k]; asm volatile("" : "+s"(q.in[k])); } \
      run_phase(q, PH, L, smem);                         \
      if ((DUPMASK >> (PH)) & 1) { xcd_barrier(xb); run_phase(q, PH, L, smem); } \
      if (i + 1 < ph_hi) xcd_barrier(xb);                \
    }                                                    \
    ++i;                                                 \
  }
  STEP(PH_PREP, 0)
  STEP(PH_ROW0, 0)
#pragma unroll 1
  for (int l = 0; l < NL; ++l) {
    STEP(PH_PROJ, l)
    STEP(PH_MIX1, l)
    STEP(PH_SCAN, l)
    STEP(PH_MIX2, l)
    STEP(PH_GLU, l)
    STEP(PH_MERGE, l)
    STEP(PH_WOUT, l)
    STEP(PH_ROW1, l)
    STEP(PH_UP, l)
    STEP(PH_DOWN, l)
    STEP(PH_ROW2, l)
  }
#undef STEP
}

extern "C" void kernel_launch(void* const* d_in, const int* in_sizes, int n_in, void* d_out, int out_size, void* d_ws, size_t ws_size,
                              hipStream_t stream) {
  static int grid_blocks = 0;
  if (!grid_blocks) {
    int dev = 0, cus = 0, per_cu = 0;
    hipGetDevice(&dev);
    hipDeviceGetAttribute(&cus, hipDeviceAttributeMultiprocessorCount, dev);
    hipFuncSetAttribute((const void*)hybrid_fwd, hipFuncAttributeMaxDynamicSharedMemorySize, SMEM_BYTES);
    hipOccupancyMaxActiveBlocksPerMultiprocessor(&per_cu, hybrid_fwd, 256, SMEM_BYTES);
    if (per_cu < 1) per_cu = 1;
    if (per_cu > 2) per_cu = 2;
    grid_blocks = cus * per_cu;
    if (ws_size < OFF_ZERO + 8192) fprintf(stderr, "workspace too small: %zu < %zu\n", ws_size, (size_t)OFF_END);
  }
  Params p{};
  for (int i = 0; i < 34; ++i) p.in[i] = (const float*)d_in[i];
  p.out = (float*)d_out;
  p.ws = (char*)d_ws;
#if ONE_LAUNCH
  hipMemsetAsync((char*)d_ws + OFF_BAR, 0, 16384, stream);
  int lo = 0, hi = N_PHASES;
  void* args[] = {&p, &lo, &hi};
  hipError_t e = hipLaunchCooperativeKernel((void*)hybrid_fwd, dim3(grid_blocks), dim3(256), args, SMEM_BYTES, stream);
  if (e != hipSuccess) fprintf(stderr, "cooperative launch failed: %s (grid %d)\n", hipGetErrorString(e), grid_blocks);
#else
  for (int i = 0; i < N_PHASES; ++i) hipLaunchKernelGGL(hybrid_fwd, dim3(grid_blocks), dim3(256), SMEM_BYTES, stream, p, i, i + 1);
#endif
}
```
